# Optimizing an MI355X kernel written in HIP

```python
import jax, jax.numpy as jnp
from jax import lax
import numpy as np

D_MODEL = 1024
BATCH = 8
SEQ = 4096
DEPTH = 2

D_MIX = D_MODEL
HEAD_DIM = 64
D_A = D_MIX // 4
D_B = D_MIX // 4
D_C = D_MIX // 4
D_D = D_MIX - D_A - D_B - D_C
H_B = D_B // HEAD_DIM
H_C = D_C // HEAD_DIM
CONF_KERNEL = 31
LRU_CONV = 4
LRU_C = 8.0
SHORT_CONV = 3
LORA_W = 32
LORA_A = 32
LORA_G = 64
C_COLS = 3 * D_C + LORA_W + LORA_A + LORA_G
P_IN = 2 * D_A + 2 * D_B + C_COLS + 3 * D_D
RWKV_GN_EPS = 64e-5
N_EXPERTS = 64
TOP_K = 8
N_GROUPS = 8
TOPK_GROUPS = 4
E_PER_GROUP = N_EXPERTS // N_GROUPS
D_EXPERT = 256
D_SHARED = 256
ROUTED_SCALE = 2.5
MOE_BLOCK = 128
ALPHA = (2.0 * DEPTH) ** 0.25
BETA = (8.0 * DEPTH) ** -0.25
LN_EPS = 1e-5

kernel_name = "hybrid_conv_lru_rwkv7_shortconv_moe_deepnorm"


def _layer_norm(x, g, b, eps=LN_EPS):
    xf = x.astype(jnp.float32)
    mu = jnp.mean(xf, -1, keepdims=True)
    var = jnp.mean(jnp.square(xf - mu), -1, keepdims=True)
    return ((xf - mu) * lax.rsqrt(var + eps)).astype(x.dtype) * g + b


def _causal_dwconv(x, w):
    k = w.shape[0]
    return lax.conv_general_dilated(
        x, w[:, None, :].astype(x.dtype), window_strides=(1,), padding=[(k - 1, 0)],
        dimension_numbers=("NWC", "WIO", "NWC"), feature_group_count=x.shape[-1])


def _conformer_conv(pa, conv_a, conv_a_bias, ln_a_g, ln_a_b):
    val, gate = jnp.split(pa, 2, axis=-1)
    hid = val * jax.nn.sigmoid(gate)
    hid = _causal_dwconv(hid, conv_a) + conv_a_bias
    return jax.nn.silu(_layer_norm(hid, ln_a_g, ln_a_b))


def _linear_scan(a, bx):
    def combine(left, right):
        a_l, b_l = left
        a_r, b_r = right
        return a_l * a_r, a_r * b_l + b_r
    _, h = lax.associative_scan(combine, (a, bx), axis=1)
    return h


def _rg_lru(pb, conv_b, conv_b_bias, w_rg, b_rg, w_ig, b_ig, lru_lambda):
    bsz, s, _ = pb.shape
    xb, gb = jnp.split(pb, 2, axis=-1)
    u = _causal_dwconv(xb, conv_b) + conv_b_bias
    uh = u.reshape(bsz, s, H_B, HEAD_DIM)
    r = jax.nn.sigmoid((jnp.einsum("bshd,hde->bshe", uh, w_rg).reshape(bsz, s, D_B) + b_rg).astype(jnp.float32))
    i = jax.nn.sigmoid((jnp.einsum("bshd,hde->bshe", uh, w_ig).reshape(bsz, s, D_B) + b_ig).astype(jnp.float32))
    log_a = -LRU_C * r * jax.nn.softplus(-lru_lambda.astype(jnp.float32))
    a = jnp.exp(log_a)
    mult = jnp.sqrt(-jnp.expm1(2.0 * log_a))
    h = _linear_scan(a, mult * (i * u.astype(jnp.float32)))
    return h.astype(pb.dtype) * jax.nn.gelu(gb, approximate=True)


def _rwkv7_scan(r, decay, k, v, kk, a):
    bsz, _, h, n = r.shape

    def step(state, inp):
        r_t, w_t, k_t, v_t, kk_t, a_t = inp
        s_kk = jnp.einsum("bhij,bhj->bhi", state, kk_t)
        state = (state * w_t[:, :, None, :]
                 - s_kk[..., None] * (kk_t * a_t)[:, :, None, :]
                 + v_t[..., None] * k_t[:, :, None, :])
        return state, jnp.einsum("bhij,bhj->bhi", state, r_t)

    seq_major = tuple(jnp.moveaxis(t, 1, 0) for t in (r, decay, k, v, kk, a))
    state0 = jnp.zeros((bsz, h, n, n), jnp.float32)
    _, y = lax.scan(step, state0, seq_major)
    return jnp.moveaxis(y, 0, 1)


def _rwkv7_mix(pc, mu_c, w0, w_w2, a0, w_a2, w_g2, k_k, k_a, r_k, gn_g, gn_b):
    bsz, s, _ = pc.shape
    f32 = jnp.float32
    prev = jnp.pad(pc, ((0, 0), (1, 0), (0, 0)))[:, :-1]
    xs = pc + (prev - pc) * mu_c
    r, k, v, xw, xa, xg = jnp.split(
        xs, [D_C, 2 * D_C, 3 * D_C, 3 * D_C + LORA_W, 3 * D_C + LORA_W + LORA_A], axis=-1)
    wlog = -jax.nn.softplus(-(w0 + jnp.tanh(xw) @ w_w2).astype(f32)) - 0.5
    decay = jnp.exp(-jnp.exp(wlog))
    a = jax.nn.sigmoid((a0 + xa @ w_a2).astype(f32))
    g = (jax.nn.sigmoid(xg) @ w_g2).astype(f32)
    kf = k.astype(f32)
    kk = (kf * k_k).reshape(bsz, s, H_C, HEAD_DIM)
    kk = kk * lax.rsqrt(jnp.sum(kk * kk, -1, keepdims=True) + 1e-12)
    kf = kf * (1.0 + (a - 1.0) * k_a)
    rh = r.astype(f32).reshape(bsz, s, H_C, HEAD_DIM)
    kh = kf.reshape(bsz, s, H_C, HEAD_DIM)
    vh = v.astype(f32).reshape(bsz, s, H_C, HEAD_DIM)
    y = _rwkv7_scan(rh, decay.reshape(bsz, s, H_C, HEAD_DIM), kh, vh, kk,
                    a.reshape(bsz, s, H_C, HEAD_DIM))
    mu = jnp.mean(y, -1, keepdims=True)
    var = jnp.mean(jnp.square(y - mu), -1, keepdims=True)
    y = ((y - mu) * lax.rsqrt(var + RWKV_GN_EPS)).reshape(bsz, s, D_C) * gn_g + gn_b
    bonus = jnp.sum(rh * kh * r_k, -1, keepdims=True) * vh
    y = (y + bonus.reshape(bsz, s, D_C)) * g
    return y.astype(pc.dtype)


def _short_conv(pd, conv_d):
    gb, gc, hd = jnp.split(pd, 3, axis=-1)
    return gb * _causal_dwconv(gc * hd, conv_d)


def _token_mixers(u, w_in, w_out, conv_a, conv_a_bias, ln_a_g, ln_a_b, conv_b, conv_b_bias,
                  w_rg, b_rg, w_ig, b_ig, lru_lambda, mu_c, w0, w_w2, a0, w_a2, w_g2,
                  k_k, k_a, r_k, gn_g, gn_b, conv_d):
    proj = u @ w_in
    pa, pb, pc, pd = jnp.split(
        proj, [2 * D_A, 2 * D_A + 2 * D_B, 2 * D_A + 2 * D_B + C_COLS], axis=-1)
    y_a = _conformer_conv(pa, conv_a, conv_a_bias, ln_a_g, ln_a_b)
    y_b = _rg_lru(pb, conv_b, conv_b_bias, w_rg, b_rg, w_ig, b_ig, lru_lambda)
    y_c = _rwkv7_mix(pc, mu_c, w0, w_w2, a0, w_a2, w_g2, k_k, k_a, r_k, gn_g, gn_b)
    y_d = _short_conv(pd, conv_d)
    y = jnp.concatenate([y_a, y_b, y_c, y_d], axis=-1)
    return y @ w_out


def _moe_ffn(u, w_router, e_bias, w13, w2, ws13, ws2):
    bsz, s, d = u.shape
    n = bsz * s
    h = u.reshape(n, d)
    scores = jax.nn.sigmoid((h @ w_router).astype(jnp.float32))
    biased = scores + e_bias.astype(jnp.float32)
    grp = biased.reshape(n, N_GROUPS, E_PER_GROUP)
    grp_score = jnp.sum(lax.top_k(grp, 2)[0], axis=-1)
    _, top_grp = lax.top_k(grp_score, TOPK_GROUPS)
    keep = jnp.sum(jax.nn.one_hot(top_grp, N_GROUPS, dtype=jnp.int32), axis=-2) > 0
    masked = jnp.where(jnp.repeat(keep, E_PER_GROUP, axis=-1), biased, -jnp.inf)
    _, idx = lax.top_k(masked, TOP_K)
    wts = jnp.take_along_axis(scores, idx, axis=-1)
    wts = wts / jnp.sum(wts, -1, keepdims=True) * ROUTED_SCALE
    nk = n * TOP_K
    flat_e = idx.reshape(nk)
    flat_w = wts.reshape(nk)
    flat_tok = jnp.arange(nk, dtype=jnp.int32) // TOP_K
    order = jnp.argsort(flat_e)
    se = flat_e[order]
    counts = jnp.bincount(flat_e, length=N_EXPERTS)
    padded = (counts + MOE_BLOCK - 1) // MOE_BLOCK * MOE_BLOCK
    pad_end = jnp.cumsum(padded)
    pad_start = pad_end - padded
    start = jnp.cumsum(counts) - counts
    dest = pad_start[se] + jnp.arange(nk, dtype=jnp.int32) - start[se]
    n_blocks = (nk + N_EXPERTS * (MOE_BLOCK - 1) + MOE_BLOCK - 1) // MOE_BLOCK
    cap = n_blocks * MOE_BLOCK
    buf_tok = jnp.full((cap,), n, jnp.int32).at[dest].set(flat_tok[order])
    buf_w = jnp.zeros((cap,), jnp.float32).at[dest].set(flat_w[order])
    block_start = jnp.arange(n_blocks, dtype=jnp.int32) * MOE_BLOCK
    block_e = jnp.minimum(jnp.searchsorted(pad_end, block_start, side="right"), N_EXPERTS - 1)
    h_pad = jnp.concatenate([h, jnp.zeros((1, d), h.dtype)], axis=0)

    def body(acc, blk):
        tok, wt, e = blk
        xb = jnp.take(h_pad, tok, axis=0)
        gate, up = jnp.split(xb @ w13[e], 2, axis=-1)
        y = (jax.nn.silu(gate) * up) @ w2[e]
        return acc.at[tok].add(y.astype(jnp.float32) * wt[:, None]), None

    acc0 = jnp.zeros((n + 1, d), jnp.float32)
    acc, _ = lax.scan(body, acc0, (buf_tok.reshape(n_blocks, MOE_BLOCK),
                                   buf_w.reshape(n_blocks, MOE_BLOCK), block_e))
    sg, su = jnp.split(h @ ws13, 2, axis=-1)
    shared = (jax.nn.silu(sg) * su) @ ws2
    return (acc[:n].astype(u.dtype) + shared).reshape(bsz, s, d)


def setup_inputs(seed: int = 0) -> dict:
    key = jax.random.key(seed)
    ks = iter(jax.random.split(key, 64))
    L = DEPTH

    def nrm(shape, scale):
        return jax.random.normal(next(ks), shape, jnp.float32) * scale

    def near_one(shape):
        return 1.0 + nrm(shape, 0.02)

    out = {}
    out["x"] = nrm((BATCH, SEQ, D_MODEL), 1.0)
    out["c"] = nrm((BATCH, D_MODEL), 1.0)
    out["w_mod"] = nrm((L, D_MODEL, 6 * D_MODEL), 0.1 * D_MODEL ** -0.5)
    out["b_mod"] = nrm((L, 6 * D_MODEL), 0.01)
    out["w_in"] = nrm((L, D_MODEL, P_IN), D_MODEL ** -0.5)
    out["w_out"] = nrm((L, D_MIX, D_MODEL), BETA * D_MIX ** -0.5)
    out["conv_a"] = nrm((L, CONF_KERNEL, D_A), CONF_KERNEL ** -0.5)
    out["conv_a_bias"] = nrm((L, D_A), 0.01)
    out["ln_a_g"] = near_one((L, D_A))
    out["ln_a_b"] = nrm((L, D_A), 0.01)
    out["conv_b"] = nrm((L, LRU_CONV, D_B), LRU_CONV ** -0.5)
    out["conv_b_bias"] = nrm((L, D_B), 0.01)
    out["w_rg"] = nrm((L, H_B, HEAD_DIM, HEAD_DIM), HEAD_DIM ** -0.5)
    out["b_rg"] = nrm((L, D_B), 0.01)
    out["w_ig"] = nrm((L, H_B, HEAD_DIM, HEAD_DIM), HEAD_DIM ** -0.5)
    out["b_ig"] = nrm((L, D_B), 0.01)
    ua = jax.random.uniform(next(ks), (L, D_B), jnp.float32, 0.9, 0.999)
    sa = ua ** (1.0 / LRU_C)
    out["lru_lambda"] = jnp.log(sa) - jnp.log1p(-sa)
    out["mu_c"] = jax.random.uniform(next(ks), (L, C_COLS), jnp.float32)
    out["w0"] = jax.random.uniform(next(ks), (L, D_C), jnp.float32, -6.5, -1.5)
    out["w_w2"] = nrm((L, LORA_W, D_C), 0.1 * LORA_W ** -0.5)
    out["a0"] = nrm((L, D_C), 0.1)
    out["w_a2"] = nrm((L, LORA_A, D_C), 0.1 * LORA_A ** -0.5)
    out["w_g2"] = nrm((L, LORA_G, D_C), LORA_G ** -0.5)
    out["k_k"] = 0.85 + nrm((L, D_C), 0.02)
    out["k_a"] = near_one((L, D_C))
    out["r_k"] = nrm((L, H_C, HEAD_DIM), 0.1)
    out["gn_g"] = near_one((L, D_C))
    out["gn_b"] = nrm((L, D_C), 0.01)
    out["conv_d"] = nrm((L, SHORT_CONV, D_D), SHORT_CONV ** -0.5)
    out["ln1_g"] = near_one((L, D_MODEL))
    out["ln1_b"] = nrm((L, D_MODEL), 0.01)
    out["w_router"] = nrm((L, D_MODEL, N_EXPERTS), D_MODEL ** -0.5)
    out["e_bias"] = nrm((L, N_EXPERTS), 0.01)
    out["w13"] = nrm((L, N_EXPERTS, D_MODEL, 2 * D_EXPERT), D_MODEL ** -0.5)
    out["w2"] = nrm((L, N_EXPERTS, D_EXPERT, D_MODEL), BETA * D_EXPERT ** -0.5)
    out["ws13"] = nrm((L, D_MODEL, 2 * D_SHARED), D_MODEL ** -0.5)
    out["ws2"] = nrm((L, D_SHARED, D_MODEL), BETA * D_SHARED ** -0.5)
    out["ln2_g"] = near_one((L, D_MODEL))
    out["ln2_b"] = nrm((L, D_MODEL), 0.01)
    return out


def reference(x, c, w_mod, b_mod, w_in, w_out, conv_a, conv_a_bias, ln_a_g, ln_a_b,
              conv_b, conv_b_bias, w_rg, b_rg, w_ig, b_ig, lru_lambda, mu_c, w0, w_w2,
              a0, w_a2, w_g2, k_k, k_a, r_k, gn_g, gn_b, conv_d, ln1_g, ln1_b,
              w_router, e_bias, w13, w2, ws13, ws2, ln2_g, ln2_b):
    c_act = jax.nn.silu(c)
    for l in range(DEPTH):
        mod = (c_act @ w_mod[l] + b_mod[l])[:, None, :]
        sh1, sc1, g1, sh2, sc2, g2 = jnp.split(mod, 6, axis=-1)
        u = x * (1.0 + sc1) + sh1
        mix = _token_mixers(u, w_in[l], w_out[l], conv_a[l], conv_a_bias[l], ln_a_g[l], ln_a_b[l],
                            conv_b[l], conv_b_bias[l], w_rg[l], b_rg[l], w_ig[l], b_ig[l],
                            lru_lambda[l], mu_c[l], w0[l], w_w2[l], a0[l], w_a2[l], w_g2[l],
                            k_k[l], k_a[l], r_k[l], gn_g[l], gn_b[l], conv_d[l])
        x = _layer_norm(ALPHA * x + (1.0 + g1) * mix, ln1_g[l], ln1_b[l])
        u = x * (1.0 + sc2) + sh2
        ffn = _moe_ffn(u, w_router[l], e_bias[l], w13[l], w2[l], ws13[l], ws2[l])
        x = _layer_norm(ALPHA * x + (1.0 + g2) * ffn, ln2_g[l], ln2_b[l])
    return x
```

```cpp
#include <hip/hip_runtime.h>
#include <hip/hip_cooperative_groups.h>
#include <stdio.h>
#include <stdint.h>
namespace cg = cooperative_groups;

typedef unsigned short bf16_t;
typedef short bf16x8 __attribute__((ext_vector_type(8)));
typedef float f32x4 __attribute__((ext_vector_type(4)));
#define DEVINL __device__ __forceinline__

constexpr int NTOK = 32768, SEQ = 4096, NBATCH = 8, DM = 1024, PIN = 2688, DEPTH = 2;
constexpr int NEXP = 64;
constexpr float ALPHA = 1.41421356237f;
constexpr float LN_EPS = 1e-5f, GN_EPS = 64e-5f;
constexpr int NTHREADS = 256;
constexpr int LDS_BYTES = 73728;

constexpr size_t OFF_CNT   = 0;
constexpr size_t OFF_MOD   = 65536;
constexpr size_t OFF_WIN   = 1048576;
constexpr size_t OFF_WOUT  = OFF_WIN + 11010048;
constexpr size_t OFF_W13   = OFF_WOUT + 4194304;
constexpr size_t OFF_W2    = OFF_W13 + 136314880;
constexpr size_t OFF_UBUF  = OFF_W2 + 68157440;
constexpr size_t OFF_ARENA = OFF_UBUF + 67108864;
constexpr size_t A_P      = OFF_ARENA;
constexpr size_t A_YMIX   = A_P + 176160768;
constexpr size_t A_SCAN   = A_YMIX + 67108864;
constexpr size_t A_HLOC   = A_SCAN + 134217728;
constexpr size_t A_CUMA   = A_HLOC + 33554432;
constexpr size_t A_G      = A_CUMA + 33554432;
constexpr size_t A_BONUS  = A_G + 33554432;
constexpr size_t A_YRAW   = A_BONUS + 33554432;
constexpr size_t A_CARRYA = A_YRAW + 33554432;
constexpr size_t A_CARRYH = A_CARRYA + 1048576;
constexpr size_t A_HSTART = A_CARRYH + 1048576;
constexpr size_t M_YBUF   = OFF_ARENA;
constexpr size_t M_HBUF   = M_YBUF + 603979776;
constexpr size_t M_LIST   = M_HBUF + 155189248;
constexpr size_t M_WSEL   = M_LIST + 8388608;
constexpr size_t WS_NEED  = M_WSEL + 1048576;

struct Params {
    const float* in[39];
    float* out;
    unsigned char* ws;
};
typedef const __attribute__((address_space(4))) Params* KP;
__device__ __forceinline__ int TIDX() { int t = threadIdx.x; asm volatile("" : "+v"(t)); return t; }
__device__ __forceinline__ int BIDX() { int b = blockIdx.x; asm volatile("" : "+s"(b)); return b; }
enum { I_X = 0, I_C, I_WMOD, I_BMOD, I_WIN, I_WOUT, I_CONVA, I_CONVAB, I_LNAG, I_LNAB, I_CONVB, I_CONVBB, I_WRG, I_BRG, I_WIG, I_BIG,
       I_LAMBDA, I_MUC, I_W0, I_WW2, I_A0, I_WA2, I_WG2, I_KK, I_KA, I_RK, I_GNG, I_GNB, I_CONVD, I_LN1G, I_LN1B, I_WROUTER, I_EBIAS,
       I_W13, I_W2, I_WS13, I_WS2, I_LN2G, I_LN2B };

DEVINL bf16_t f2bf(float f) { unsigned u = __float_as_uint(f); u += 0x7FFFu + ((u >> 16) & 1u); return (bf16_t)(u >> 16); }
DEVINL float bf2f(bf16_t h) { return __uint_as_float(((unsigned)h) << 16); }
DEVINL unsigned pack2(float a, float b) { return (unsigned)f2bf(a) | ((unsigned)f2bf(b) << 16); }
DEVINL float sigm(float x) { return 1.f / (1.f + __expf(-x)); }
DEVINL float softplusf(float z) { return fmaxf(z, 0.f) + log1pf(__expf(-fabsf(z))); }
DEVINL float gelu_tanh(float x) { float u = 0.7978845608028654f * (x + 0.044715f * x * x * x); return 0.5f * x * (1.f + tanhf(u)); }
DEVINL float wave_sum(float x) {
#pragma unroll
    for (int o = 32; o > 0; o >>= 1) x += __shfl_xor(x, o);
    return x;
}
DEVINL float dppf(float x, const int ctrl_unused) { return x; }
DEVINL float wave_sum_dpp(float x) {
    x += __builtin_bit_cast(float, __builtin_amdgcn_update_dpp(0, __builtin_bit_cast(int, x), 0xB1, 0xf, 0xf, true));
    x += __builtin_bit_cast(float, __builtin_amdgcn_update_dpp(0, __builtin_bit_cast(int, x), 0x4E, 0xf, 0xf, true));
    x += __builtin_bit_cast(float, __builtin_amdgcn_update_dpp(0, __builtin_bit_cast(int, x), 0x141, 0xf, 0xf, true));
    x += __builtin_bit_cast(float, __builtin_amdgcn_update_dpp(0, __builtin_bit_cast(int, x), 0x140, 0xf, 0xf, true));
    x += __builtin_bit_cast(float, __builtin_amdgcn_update_dpp(0, __builtin_bit_cast(int, x), 0x142, 0xa, 0xf, false));
    x += __builtin_bit_cast(float, __builtin_amdgcn_update_dpp(0, __builtin_bit_cast(int, x), 0x143, 0xc, 0xf, false));
    return __builtin_bit_cast(float, __builtin_amdgcn_readlane(__builtin_bit_cast(int, x), 63));
}

DEVINL int lds_byte(int r, int c) { int st = (r >> 4) * 2 + (c >> 5), rr = r & 15, cc = c & 31, ob = rr * 64 + cc * 2; return st * 1024 + (ob ^ (((ob >> 9) & 1) << 5)); }
DEVINL void stage_rc(int b, int& R, int& C) { int st = b / 1024, sb = b % 1024, swz = sb ^ (((sb >> 9) & 1) << 5); R = (st >> 1) * 16 + swz / 64; C = (st & 1) * 32 + (swz % 64) / 2; }

template <class RowPtr, class Epi>
DEVINL void gemm_tile128(char* lds, RowPtr arow, const bf16_t* Bt, int K, Epi epi) {
    const int tid = TIDX();
    const bf16_t* ap[4]; const bf16_t* bp[4];
#pragma unroll
    for (int i = 0; i < 4; ++i) { int R, C; stage_rc(tid * 16 + i * 4096, R, C); ap[i] = arow(R) + C; bp[i] = Bt + (size_t)R * K + C; }
    const int wid = tid >> 6, lane = tid & 63, wr = wid >> 1, wc = wid & 1, fr = lane & 15, fq = lane >> 4;
    f32x4 acc[4][4];
#pragma unroll
    for (int m = 0; m < 4; ++m)
#pragma unroll
        for (int n = 0; n < 4; ++n) acc[m][n] = (f32x4){0.f, 0.f, 0.f, 0.f};
    const int nk = K >> 6;
#pragma unroll
    for (int i = 0; i < 4; ++i) {
        __builtin_amdgcn_global_load_lds((const unsigned*)(ap[i]), (unsigned*)(lds + tid * 16 + i * 4096), 16, 0, 0);
        __builtin_amdgcn_global_load_lds((const unsigned*)(bp[i]), (unsigned*)(lds + 16384 + tid * 16 + i * 4096), 16, 0, 0);
    }
    for (int kt = 0; kt < nk; ++kt) {
        asm volatile("s_waitcnt vmcnt(0)" ::: "memory");
        __syncthreads();
        char* cur = lds + (kt & 1) * 32768;
        if (kt + 1 < nk) {
            char* nxt = lds + ((kt + 1) & 1) * 32768;
            const int ko = (kt + 1) * 64;
#pragma unroll
            for (int i = 0; i < 4; ++i) {
                __builtin_amdgcn_global_load_lds((const unsigned*)(ap[i] + ko), (unsigned*)(nxt + tid * 16 + i * 4096), 16, 0, 0);
                __builtin_amdgcn_global_load_lds((const unsigned*)(bp[i] + ko), (unsigned*)(nxt + 16384 + tid * 16 + i * 4096), 16, 0, 0);
            }
        }
        bf16x8 af[4][2], bfr[4][2];
#pragma unroll
        for (int m = 0; m < 4; ++m)
#pragma unroll
            for (int kk = 0; kk < 2; ++kk) af[m][kk] = *reinterpret_cast<const bf16x8*>(cur + lds_byte(wr * 64 + m * 16 + fr, kk * 32 + fq * 8));
#pragma unroll
        for (int n = 0; n < 4; ++n)
#pragma unroll
            for (int kk = 0; kk < 2; ++kk) bfr[n][kk] = *reinterpret_cast<const bf16x8*>(cur + 16384 + lds_byte(wc * 64 + n * 16 + fr, kk * 32 + fq * 8));
#pragma unroll
        for (int kk = 0; kk < 2; ++kk)
#pragma unroll
            for (int m = 0; m < 4; ++m)
#pragma unroll
                for (int n = 0; n < 4; ++n) acc[m][n] = __builtin_amdgcn_mfma_f32_16x16x32_bf16(bfr[n][kk], af[m][kk], acc[m][n], 0, 0, 0);
    }
    __syncthreads();
    epi(acc, wr, wc, fr, fq);
}

DEVINL void phase0(KP p, char* lds) {
    const int tid = TIDX(), nb = gridDim.x, blk = BIDX();
    if (blk == 0 && tid < 128) ((unsigned*)(p->ws + OFF_CNT))[tid] = 0u;
    if (blk < 48) {
        float* sc = (float*)lds;
        for (int i = tid; i < 8192; i += NTHREADS) { float c = p->in[I_C][i]; sc[i] = c * sigm(c); }
        __syncthreads();
        const int n = blk * 256 + tid, l = n / 6144, nn = n % 6144;
        const float* w = p->in[I_WMOD] + (size_t)l * 1024 * 6144 + nn;
        float acc[8];
#pragma unroll
        for (int b = 0; b < 8; ++b) acc[b] = 0.f;
#pragma unroll 8
        for (int k = 0; k < 1024; ++k) {
            const float wv = w[(size_t)k * 6144];
#pragma unroll
            for (int b = 0; b < 8; ++b) acc[b] = fmaf(sc[b * 1024 + k], wv, acc[b]);
        }
        const float bm = p->in[I_BMOD][l * 6144 + nn];
        float* mod = (float*)(p->ws + OFF_MOD);
#pragma unroll
        for (int b = 0; b < 8; ++b) mod[(size_t)(l * 8 + b) * 6144 + nn] = acc[b] + bm;
        __syncthreads();
    }
    float* tile = (float*)lds;
    const int PER_L = 672 + 256 + 8320 + 4160;
    for (int id = blk; id < 2 * PER_L; id += nb) {
        const int l = id / PER_L; int r = id % PER_L;
        const float* src; bf16_t* dst; int K, ld, perm, kt, nt;
        if (r < 672) { src = p->in[I_WIN] + (size_t)l * 1024 * 2688; K = 1024; ld = 2688; perm = 0; dst = (bf16_t*)(p->ws + OFF_WIN) + (size_t)l * 2688 * 1024; kt = r & 15; nt = r >> 4; }
        else if (r < 928) { r -= 672; src = p->in[I_WOUT] + (size_t)l * 1024 * 1024; K = 1024; ld = 1024; perm = 0; dst = (bf16_t*)(p->ws + OFF_WOUT) + (size_t)l * 1024 * 1024; kt = r & 15; nt = r >> 4; }
        else if (r < 928 + 8320) { r -= 928; const int e = r >> 7, q = r & 127; kt = q & 15; nt = q >> 4; K = 1024; ld = 512; perm = 1;
            src = (e < 64) ? p->in[I_W13] + (size_t)(l * 64 + e) * 1024 * 512 : p->in[I_WS13] + (size_t)l * 1024 * 512;
            dst = (bf16_t*)(p->ws + OFF_W13) + (size_t)(l * 65 + e) * 512 * 1024; }
        else { r -= 9248; const int e = r >> 6, q = r & 63; kt = q & 3; nt = q >> 2; K = 256; ld = 1024; perm = 0;
            src = (e < 64) ? p->in[I_W2] + (size_t)(l * 64 + e) * 256 * 1024 : p->in[I_WS2] + (size_t)l * 256 * 1024;
            dst = (bf16_t*)(p->ws + OFF_W2) + (size_t)(l * 65 + e) * 1024 * 256; }
        const int k0 = kt * 64, r0 = nt * 64;
        {
            const int nn = tid & 63; const int drow = r0 + nn;
            int scol = drow;
            if (perm) { const int g = drow >> 5, i = drow & 31; scol = (i < 16) ? (g * 16 + i) : (256 + g * 16 + (i - 16)); }
#pragma unroll
            for (int j = 0; j < 16; ++j) { const int kk = (tid >> 6) + 4 * j; tile[kk * 65 + nn] = src[(size_t)(k0 + kk) * ld + scol]; }
        }
        __syncthreads();
        {
            const int kp = (tid & 31) * 2;
#pragma unroll
            for (int j = 0; j < 8; ++j) { const int rr = (tid >> 5) + 8 * j;
                *(unsigned*)(dst + (size_t)(r0 + rr) * K + k0 + kp) = pack2(tile[kp * 65 + rr], tile[(kp + 1) * 65 + rr]); }
        }
        __syncthreads();
    }
}

DEVINL void phaseF0(KP p) {
    const int tid = TIDX(), nb = gridDim.x, blk = BIDX();
    const float* mod = (const float*)(p->ws + OFF_MOD);
    bf16_t* ubuf = (bf16_t*)(p->ws + OFF_UBUF);
    for (int row = blk; row < NTOK; row += nb) {
        const int b = row >> 12, col = tid * 4;
        const float4 x = *(const float4*)(p->in[I_X] + (size_t)row * DM + col);
        const float4 sh = *(const float4*)(mod + (size_t)b * 6144 + col);
        const float4 sc = *(const float4*)(mod + (size_t)b * 6144 + 1024 + col);
        uint2 o; o.x = pack2(x.x * (1.f + sc.x) + sh.x, x.y * (1.f + sc.y) + sh.y); o.y = pack2(x.z * (1.f + sc.z) + sh.z, x.w * (1.f + sc.w) + sh.w);
        *(uint2*)(ubuf + (size_t)row * DM + col) = o;
    }
}

DEVINL void phaseA(KP p, int l, char* lds) {
    const int nb = gridDim.x, blk = BIDX();
    const bf16_t* ubuf = (const bf16_t*)(p->ws + OFF_UBUF);
    const bf16_t* Wt = (const bf16_t*)(p->ws + OFF_WIN) + (size_t)l * 2688 * 1024;
    bf16_t* P = (bf16_t*)(p->ws + A_P);
    for (int t = blk; t < 256 * 21; t += nb) {
        const int pn = t % 21, pm = t / 21;
        auto arow = [&](int R) { return ubuf + (size_t)(pm * 128 + R) * DM; };
        auto epi = [&](f32x4 (&acc)[4][4], int wr, int wc, int fr, int fq) {
#pragma unroll
            for (int m = 0; m < 4; ++m) {
                const int row = pm * 128 + wr * 64 + m * 16 + fr;
#pragma unroll
                for (int n = 0; n < 4; ++n) {
                    const int col = pn * 128 + wc * 64 + n * 16 + fq * 4;
                    uint2 o; o.x = pack2(acc[m][n][0], acc[m][n][1]); o.y = pack2(acc[m][n][2], acc[m][n][3]);
                    *(uint2*)(P + (size_t)row * PIN + col) = o;
                }
            }
        };
        gemm_tile128(lds, arow, Wt + (size_t)(pn * 128) * 1024, 1024, epi);
    }
}

DEVINL void b1_conformer(KP p, int l, char* lds, int item) {
    const int tid = TIDX(), b = item >> 7, tt = item & 127, t0 = tt * 32, rowbase = b * SEQ;
    const bf16_t* P = (const bf16_t*)(p->ws + A_P);
    bf16_t* ymix = (bf16_t*)(p->ws + A_YMIX);
    float w[31];
#pragma unroll
    for (int k = 0; k < 31; ++k) w[k] = p->in[I_CONVA][(size_t)(l * 31 + k) * 256 + tid];
    float acc[32];
    const float bias = p->in[I_CONVAB][l * 256 + tid];
#pragma unroll
    for (int j = 0; j < 32; ++j) acc[j] = bias;
#pragma unroll
    for (int rr = 0; rr < 62; ++rr) {
        const int t = t0 - 30 + rr;
        float h = 0.f;
        if (t >= 0) { const bf16_t* pr = P + (size_t)(rowbase + t) * PIN; const float val = bf2f(pr[tid]), gate = bf2f(pr[256 + tid]); h = val * sigm(gate); }
#pragma unroll
        for (int j = 0; j < 32; ++j) { const int k = rr - j; if (k >= 0 && k <= 30) acc[j] = fmaf(w[k], h, acc[j]); }
    }
    float* outb = (float*)lds;
#pragma unroll
    for (int j = 0; j < 32; ++j) outb[j * 256 + tid] = acc[j];
    __syncthreads();
    const int wid = tid >> 6, lane = tid & 63;
    const float4 g4 = *(const float4*)(p->in[I_LNAG] + l * 256 + lane * 4), b4 = *(const float4*)(p->in[I_LNAB] + l * 256 + lane * 4);
    for (int j = wid; j < 32; j += 4) {
        const float4 v = *(const float4*)(outb + j * 256 + lane * 4);
        const float mean = wave_sum(v.x + v.y + v.z + v.w) * (1.f / 256.f);
        const float d0 = v.x - mean, d1 = v.y - mean, d2 = v.z - mean, d3 = v.w - mean;
        const float var = wave_sum(d0 * d0 + d1 * d1 + d2 * d2 + d3 * d3) * (1.f / 256.f);
        const float rs = rsqrtf(var + LN_EPS);
        float y0 = d0 * rs * g4.x + b4.x, y1 = d1 * rs * g4.y + b4.y, y2 = d2 * rs * g4.z + b4.z, y3 = d3 * rs * g4.w + b4.w;
        y0 *= sigm(y0); y1 *= sigm(y1); y2 *= sigm(y2); y3 *= sigm(y3);
        uint2 o; o.x = pack2(y0, y1); o.y = pack2(y2, y3);
        *(uint2*)(ymix + (size_t)(rowbase + t0 + j) * DM + lane * 4) = o;
    }
    __syncthreads();
}

DEVINL void b1_shortconv(KP p, int l, int item) {
    const int c = TIDX(), b = item >> 6, t0 = (item & 63) * 64, rowbase = b * SEQ;
    const bf16_t* P = (const bf16_t*)(p->ws + A_P);
    bf16_t* ymix = (bf16_t*)(p->ws + A_YMIX);
    const float w0 = p->in[I_CONVD][(l * 3 + 0) * 256 + c], w1 = p->in[I_CONVD][(l * 3 + 1) * 256 + c], w2 = p->in[I_CONVD][(l * 3 + 2) * 256 + c];
    float q2 = 0.f, q1 = 0.f;
    if (t0 >= 2) {
        const bf16_t* a = P + (size_t)(rowbase + t0 - 2) * PIN + 1920 + c; q2 = bf2f(a[256]) * bf2f(a[512]);
        const bf16_t* a1 = a + PIN; q1 = bf2f(a1[256]) * bf2f(a1[512]);
    }
#pragma unroll 4
    for (int j = 0; j < 64; ++j) {
        const bf16_t* a = P + (size_t)(rowbase + t0 + j) * PIN + 1920 + c;
        const float gb = bf2f(a[0]), q0 = bf2f(a[256]) * bf2f(a[512]);
        const float y = gb * (w0 * q2 + w1 * q1 + w2 * q0);
        ymix[(size_t)(rowbase + t0 + j) * DM + 768 + c] = f2bf(y);
        q2 = q1; q1 = q0;
    }
}

DEVINL void b1_lru(KP p, int l, char* lds, int item) {
    const int c = TIDX(), b = item >> 7, tt = item & 127, t0 = tt * 32, rowbase = b * SEQ;
    const int h = c >> 6, lane = c & 63;
    const bf16_t* P = (const bf16_t*)(p->ws + A_P);
    float* uT = (float*)lds;
    float ureg[32];
    {
        const float cb0 = p->in[I_CONVB][(l * 4 + 0) * 256 + c], cb1 = p->in[I_CONVB][(l * 4 + 1) * 256 + c], cb2 = p->in[I_CONVB][(l * 4 + 2) * 256 + c], cb3 = p->in[I_CONVB][(l * 4 + 3) * 256 + c];
        const float bias = p->in[I_CONVBB][l * 256 + c];
        float xm3 = 0.f, xm2 = 0.f, xm1 = 0.f;
        if (t0 >= 3) { const bf16_t* a = P + (size_t)(rowbase + t0 - 3) * PIN + 512 + c; xm3 = bf2f(a[0]); xm2 = bf2f(a[PIN]); xm1 = bf2f(a[2 * PIN]); }
#pragma unroll
        for (int j = 0; j < 32; ++j) {
            const float x0 = bf2f(P[(size_t)(rowbase + t0 + j) * PIN + 512 + c]);
            ureg[j] = cb0 * xm3 + cb1 * xm2 + cb2 * xm1 + cb3 * x0 + bias;
            xm3 = xm2; xm2 = xm1; xm1 = x0;
            uT[c * 36 + j] = ureg[j];
        }
    }
    __syncthreads();
    float ar[32], ai[32];
#pragma unroll
    for (int j = 0; j < 32; ++j) { ar[j] = 0.f; ai[j] = 0.f; }
    {
        const float* wrg = p->in[I_WRG] + (size_t)((l * 4 + h) * 64) * 64 + lane;
        const float* wig = p->in[I_WIG] + (size_t)((l * 4 + h) * 64) * 64 + lane;
#pragma unroll 2
        for (int d = 0; d < 64; ++d) {
            const float wr = wrg[d * 64], wi = wig[d * 64];
            const float4* up = (const float4*)(uT + (h * 64 + d) * 36);
#pragma unroll
            for (int jj = 0; jj < 8; ++jj) {
                const float4 u4 = up[jj];
                ar[4 * jj + 0] = fmaf(u4.x, wr, ar[4 * jj + 0]); ai[4 * jj + 0] = fmaf(u4.x, wi, ai[4 * jj + 0]);
                ar[4 * jj + 1] = fmaf(u4.y, wr, ar[4 * jj + 1]); ai[4 * jj + 1] = fmaf(u4.y, wi, ai[4 * jj + 1]);
                ar[4 * jj + 2] = fmaf(u4.z, wr, ar[4 * jj + 2]); ai[4 * jj + 2] = fmaf(u4.z, wi, ai[4 * jj + 2]);
                ar[4 * jj + 3] = fmaf(u4.w, wr, ar[4 * jj + 3]); ai[4 * jj + 3] = fmaf(u4.w, wi, ai[4 * jj + 3]);
            }
        }
    }
    {
        const float brg = p->in[I_BRG][l * 256 + c], big = p->in[I_BIG][l * 256 + c];
        const float sp = softplusf(-p->in[I_LAMBDA][l * 256 + c]);
        float* hloc = (float*)(p->ws + A_HLOC); float* cuma = (float*)(p->ws + A_CUMA);
        float hs = 0.f, cA = 1.f;
#pragma unroll
        for (int j = 0; j < 32; ++j) {
            const float r = sigm(ar[j] + brg), ig = sigm(ai[j] + big);
            const float log_a = -8.0f * r * sp;
            const float a = __expf(log_a);
            const float mult = sqrtf(fmaxf(-expm1f(2.f * log_a), 0.f));
            const float bx = mult * (ig * ureg[j]);
            hs = fmaf(a, hs, bx); cA *= a;
            const size_t o = (size_t)(rowbase + t0 + j) * 256 + c;
            hloc[o] = hs; cuma[o] = cA;
        }
        ((float*)(p->ws + A_CARRYA))[(size_t)(b * 128 + tt) * 256 + c] = cA;
        ((float*)(p->ws + A_CARRYH))[(size_t)(b * 128 + tt) * 256 + c] = hs;
    }
    __syncthreads();
}

DEVINL void b1_rwkv(KP p, int l, char* lds, int item) {
    const int c = TIDX(), b = item >> 7, tt = item & 127, t0 = tt * 32, rowbase = b * SEQ;
    const bf16_t* P = (const bf16_t*)(p->ws + A_P);
    float* featT = (float*)lds;
    const float* muc = p->in[I_MUC] + l * 896;
    if (c < 128) {
        const int col = 1024 + 768 + c; const float mu = muc[768 + c];
        float prev = (t0 > 0) ? bf2f(P[(size_t)(rowbase + t0 - 1) * PIN + col]) : 0.f;
#pragma unroll 4
        for (int j = 0; j < 32; ++j) {
            const float cur = bf2f(P[(size_t)(rowbase + t0 + j) * PIN + col]);
            const float xs = cur + (prev - cur) * mu;
            const float val = (c < 32) ? tanhf(xs) : ((c < 64) ? xs : sigm(xs));
            featT[c * 36 + j] = val; prev = cur;
        }
    }
    __syncthreads();
    float acc[32], dec[32], aa[32];
#pragma unroll
    for (int j = 0; j < 32; ++j) acc[j] = 0.f;
#pragma unroll 2
    for (int jf = 0; jf < 32; ++jf) {
        const float wv = p->in[I_WW2][(size_t)(l * 32 + jf) * 256 + c]; const float4* fp = (const float4*)(featT + jf * 36);
#pragma unroll
        for (int jj = 0; jj < 8; ++jj) { const float4 u4 = fp[jj]; acc[4 * jj] = fmaf(u4.x, wv, acc[4 * jj]); acc[4 * jj + 1] = fmaf(u4.y, wv, acc[4 * jj + 1]); acc[4 * jj + 2] = fmaf(u4.z, wv, acc[4 * jj + 2]); acc[4 * jj + 3] = fmaf(u4.w, wv, acc[4 * jj + 3]); }
    }
    {
        const float w0 = p->in[I_W0][l * 256 + c];
#pragma unroll
        for (int j = 0; j < 32; ++j) { const float z = w0 + acc[j]; const float wlog = -softplusf(-z) - 0.5f; dec[j] = __expf(-__expf(wlog)); acc[j] = 0.f; }
    }
#pragma unroll 2
    for (int jf = 0; jf < 32; ++jf) {
        const float wv = p->in[I_WA2][(size_t)(l * 32 + jf) * 256 + c]; const float4* fp = (const float4*)(featT + (32 + jf) * 36);
#pragma unroll
        for (int jj = 0; jj < 8; ++jj) { const float4 u4 = fp[jj]; acc[4 * jj] = fmaf(u4.x, wv, acc[4 * jj]); acc[4 * jj + 1] = fmaf(u4.y, wv, acc[4 * jj + 1]); acc[4 * jj + 2] = fmaf(u4.z, wv, acc[4 * jj + 2]); acc[4 * jj + 3] = fmaf(u4.w, wv, acc[4 * jj + 3]); }
    }
    {
        const float a0 = p->in[I_A0][l * 256 + c];
#pragma unroll
        for (int j = 0; j < 32; ++j) { aa[j] = sigm(a0 + acc[j]); acc[j] = 0.f; }
    }
#pragma unroll 2
    for (int jf = 0; jf < 64; ++jf) {
        const float wv = p->in[I_WG2][(size_t)(l * 64 + jf) * 256 + c]; const float4* fp = (const float4*)(featT + (64 + jf) * 36);
#pragma unroll
        for (int jj = 0; jj < 8; ++jj) { const float4 u4 = fp[jj]; acc[4 * jj] = fmaf(u4.x, wv, acc[4 * jj]); acc[4 * jj + 1] = fmaf(u4.y, wv, acc[4 * jj + 1]); acc[4 * jj + 2] = fmaf(u4.z, wv, acc[4 * jj + 2]); acc[4 * jj + 3] = fmaf(u4.w, wv, acc[4 * jj + 3]); }
    }
    {
        float* gbuf = (float*)(p->ws + A_G); float* bonus = (float*)(p->ws + A_BONUS); uint4* scan = (uint4*)(p->ws + A_SCAN);
        const float mur = muc[c], muk = muc[256 + c], muv = muc[512 + c];
        const float kkw = p->in[I_KK][l * 256 + c], kaw = p->in[I_KA][l * 256 + c], rkw = p->in[I_RK][l * 256 + c];
        float pr = 0.f, pk = 0.f, pv = 0.f;
        if (t0 > 0) { const bf16_t* a = P + (size_t)(rowbase + t0 - 1) * PIN + 1024 + c; pr = bf2f(a[0]); pk = bf2f(a[256]); pv = bf2f(a[512]); }
#pragma unroll 4
        for (int j = 0; j < 32; ++j) {
            const size_t row = (size_t)(rowbase + t0 + j);
            const bf16_t* a = P + row * PIN + 1024 + c;
            const float cr = bf2f(a[0]), ck = bf2f(a[256]), cv = bf2f(a[512]);
            const float r = cr + (pr - cr) * mur, k = ck + (pk - ck) * muk, v = cv + (pv - cv) * muv;
            pr = cr; pk = ck; pv = cv;
            const float kk = k * kkw;
            const float ss = wave_sum(kk * kk);
            const float kkn = kk * rsqrtf(ss + 1e-12f);
            const float kf = k * (1.f + (aa[j] - 1.f) * kaw);
            const float bs = wave_sum(r * kf * rkw);
            bonus[row * 256 + c] = bs * v;
            gbuf[row * 256 + c] = acc[j];
            uint4 o; o.x = pack2(kkn, kkn * aa[j]); o.y = pack2(kf, r); o.z = pack2(v, 0.f); o.w = __float_as_uint(dec[j]);
            scan[row * 256 + c] = o;
        }
    }
    __syncthreads();
}

DEVINL void phaseB1(KP p, int l, char* lds) {
    const int nb = gridDim.x, blk = BIDX();
    for (int it = blk; it < 3584; it += nb) {
        if (it < 1024) b1_rwkv(p, l, lds, it);
        else if (it < 2048) b1_lru(p, l, lds, it - 1024);
        else if (it < 3072) b1_conformer(p, l, lds, it - 2048);
        else b1_shortconv(p, l, it - 3072);
    }
}

DEVINL void phaseB2(KP p, int l) {
    const int tid = TIDX(), nb = gridDim.x, blk = BIDX();
    if (blk < 8) {
        const float* ca = (const float*)(p->ws + A_CARRYA) + (size_t)blk * 128 * 256 + tid;
        const float* ch = (const float*)(p->ws + A_CARRYH) + (size_t)blk * 128 * 256 + tid;
        float* hst = (float*)(p->ws + A_HSTART) + (size_t)blk * 128 * 256 + tid;
        float hs = 0.f;
#pragma unroll 8
        for (int tt = 0; tt < 128; ++tt) { hst[tt * 256] = hs; hs = fmaf(ca[tt * 256], hs, ch[tt * 256]); }
    }
    const int wid = tid >> 6, lane = tid & 63;
    const uint4* scan = (const uint4*)(p->ws + A_SCAN);
    float* yraw = (float*)(p->ws + A_YRAW);
    for (int rid = blk * 4 + wid; rid < 2048; rid += nb * 4) {
        const int bh = rid >> 6, i = rid & 63, b = bh >> 2, h = bh & 3;
        const uint4* sp = scan + (size_t)b * SEQ * 256 + h * 64 + lane;
        float* yo = yraw + (size_t)b * SEQ * 256 + h * 64 + i;
        float s = 0.f;
        uint4 cur[8], nxt[8];
#pragma unroll
        for (int u = 0; u < 8; ++u) cur[u] = sp[(size_t)u * 256];
        for (int t0 = 0; t0 < SEQ; t0 += 8) {
            if (t0 + 8 < SEQ) {
#pragma unroll
                for (int u = 0; u < 8; ++u) nxt[u] = sp[(size_t)(t0 + 8 + u) * 256];
            }
#pragma unroll
            for (int u = 0; u < 8; ++u) {
                const float kk = __uint_as_float(cur[u].x << 16), bb = __uint_as_float(cur[u].x & 0xFFFF0000u);
                const float kf = __uint_as_float(cur[u].y << 16), r = __uint_as_float(cur[u].y & 0xFFFF0000u);
                const float vj = __uint_as_float(cur[u].z << 16), w = __uint_as_float(cur[u].w);
                const float vi = __builtin_bit_cast(float, __builtin_amdgcn_readlane(__builtin_bit_cast(int, vj), i));
                const float sk = wave_sum_dpp(s * kk);
                s = fmaf(s, w, fmaf(-sk, bb, vi * kf));
                const float y = wave_sum_dpp(s * r);
                if (lane == 0) yo[(size_t)(t0 + u) * 256] = y;
            }
#pragma unroll
            for (int u = 0; u < 8; ++u) cur[u] = nxt[u];
        }
    }
}

DEVINL void phaseB3(KP p, int l) {
    const int c = TIDX(), nb = gridDim.x, blk = BIDX();
    const bf16_t* P = (const bf16_t*)(p->ws + A_P);
    bf16_t* ymix = (bf16_t*)(p->ws + A_YMIX);
    const float* yraw = (const float*)(p->ws + A_YRAW); const float* bonus = (const float*)(p->ws + A_BONUS); const float* gbuf = (const float*)(p->ws + A_G);
    const float* hloc = (const float*)(p->ws + A_HLOC); const float* cuma = (const float*)(p->ws + A_CUMA); const float* hst = (const float*)(p->ws + A_HSTART);
    const float gng = p->in[I_GNG][l * 256 + c], gnb = p->in[I_GNB][l * 256 + c];
    for (int it = blk; it < 512; it += nb) {
#pragma unroll 4
        for (int rr = 0; rr < 64; ++rr) {
            const int row = it * 64 + rr, b = row >> 12, tt = (row & 4095) >> 5;
            const size_t o = (size_t)row * 256 + c;
            const float y = yraw[o];
            const float mu = wave_sum(y) * (1.f / 64.f);
            const float d = y - mu;
            const float var = wave_sum(d * d) * (1.f / 64.f);
            const float yn = d * rsqrtf(var + GN_EPS) * gng + gnb;
            ymix[(size_t)row * DM + 512 + c] = f2bf((yn + bonus[o]) * gbuf[o]);
            const float hh = fmaf(cuma[o], hst[(size_t)(b * 128 + tt) * 256 + c], hloc[o]);
            const float gb = bf2f(P[(size_t)row * PIN + 768 + c]);
            ymix[(size_t)row * DM + 256 + c] = f2bf(hh * gelu_tanh(gb));
        }
    }
}

DEVINL void phaseC(KP p, int l, char* lds) {
    const int nb = gridDim.x, blk = BIDX();
    const bf16_t* ymix = (const bf16_t*)(p->ws + A_YMIX);
    const bf16_t* Wt = (const bf16_t*)(p->ws + OFF_WOUT) + (size_t)l * 1024 * 1024;
    const float* res = (l == 0) ? p->in[I_X] : p->out;
    float* xbuf = p->out;
    const float* mod = (const float*)(p->ws + OFF_MOD);
    for (int t = blk; t < 256 * 8; t += nb) {
        const int pn = t & 7, pm = t >> 3;
        auto arow = [&](int R) { return ymix + (size_t)(pm * 128 + R) * DM; };
        auto epi = [&](f32x4 (&acc)[4][4], int wr, int wc, int fr, int fq) {
#pragma unroll
            for (int m = 0; m < 4; ++m) {
                const int row = pm * 128 + wr * 64 + m * 16 + fr, b = row >> 12;
#pragma unroll
                for (int n = 0; n < 4; ++n) {
                    const int col = pn * 128 + wc * 64 + n * 16 + fq * 4;
                    const float4 g1 = *(const float4*)(mod + (size_t)(l * 8 + b) * 6144 + 2048 + col);
                    const float4 rx = *(const float4*)(res + (size_t)row * DM + col);
                    float4 z;
                    z.x = ALPHA * rx.x + (1.f + g1.x) * acc[m][n][0]; z.y = ALPHA * rx.y + (1.f + g1.y) * acc[m][n][1];
                    z.z = ALPHA * rx.z + (1.f + g1.z) * acc[m][n][2]; z.w = ALPHA * rx.w + (1.f + g1.w) * acc[m][n][3];
                    *(float4*)(xbuf + (size_t)row * DM + col) = z;
                }
            }
        };
        gemm_tile128(lds, arow, Wt + (size_t)(pn * 128) * 1024, 1024, epi);
    }
}

DEVINL void phaseD(KP p, int l, char* lds) {
    const int tid = TIDX(), nb = gridDim.x, blk = BIDX(), wid = tid >> 6, lane = tid & 63;
    float* ul = (float*)lds;
    int* sel_e = (int*)(lds + 65536);
    int* lpos = (int*)(lds + 65536 + 2048);
    int* hist = (int*)(lds + 65536 + 4096);
    int* basep = (int*)(lds + 65536 + 4096 + 256);
    float* xbuf = p->out;
    bf16_t* ubuf = (bf16_t*)(p->ws + OFF_UBUF);
    const float* mod = (const float*)(p->ws + OFF_MOD);
    const float* wr = p->in[I_WROUTER] + (size_t)l * 1024 * 64 + lane;
    const float ebias = p->in[I_EBIAS][l * 64 + lane];
    unsigned* cnt = (unsigned*)(p->ws + OFF_CNT) + l * 64;
    int* list = (int*)(p->ws + M_LIST);
    float* wsel = (float*)(p->ws + M_WSEL);
    for (int it = blk; it < 512; it += nb) {
        const int tok0 = it * 64;
        if (tid < 64) hist[tid] = 0;
        for (int sb = 0; sb < 4; ++sb) {
#pragma unroll
            for (int j = 0; j < 4; ++j) {
                const int tl = wid * 4 + j, row = tok0 + sb * 16 + tl, b = row >> 12;
                float4 z[4];
                float s = 0.f;
#pragma unroll
                for (int i = 0; i < 4; ++i) { z[i] = *(const float4*)(xbuf + (size_t)row * DM + i * 256 + lane * 4); s += z[i].x + z[i].y + z[i].z + z[i].w; }
                const float mean = wave_sum(s) * (1.f / 1024.f);
                float q = 0.f;
#pragma unroll
                for (int i = 0; i < 4; ++i) { z[i].x -= mean; z[i].y -= mean; z[i].z -= mean; z[i].w -= mean; q += z[i].x * z[i].x + z[i].y * z[i].y + z[i].z * z[i].z + z[i].w * z[i].w; }
                const float rs = rsqrtf(wave_sum(q) * (1.f / 1024.f) + LN_EPS);
#pragma unroll
                for (int i = 0; i < 4; ++i) {
                    const int col = i * 256 + lane * 4;
                    const float4 g = *(const float4*)(p->in[I_LN1G] + l * 1024 + col), bb = *(const float4*)(p->in[I_LN1B] + l * 1024 + col);
                    const float4 sh = *(const float4*)(mod + (size_t)(l * 8 + b) * 6144 + 3072 + col), sc = *(const float4*)(mod + (size_t)(l * 8 + b) * 6144 + 4096 + col);
                    float4 x1; x1.x = z[i].x * rs * g.x + bb.x; x1.y = z[i].y * rs * g.y + bb.y; x1.z = z[i].z * rs * g.z + bb.z; x1.w = z[i].w * rs * g.w + bb.w;
                    *(float4*)(xbuf + (size_t)row * DM + col) = x1;
                    float4 u; u.x = x1.x * (1.f + sc.x) + sh.x; u.y = x1.y * (1.f + sc.y) + sh.y; u.z = x1.z * (1.f + sc.z) + sh.z; u.w = x1.w * (1.f + sc.w) + sh.w;
                    *(float4*)(ul + tl * 1024 + col) = u;
                    uint2 o; o.x = pack2(u.x, u.y); o.y = pack2(u.z, u.w);
                    *(uint2*)(ubuf + (size_t)row * DM + col) = o;
                }
            }
            __syncthreads();
            float acc[4] = {0.f, 0.f, 0.f, 0.f};
            const float* u0 = ul + (wid * 4) * 1024;
#pragma unroll 2
            for (int k = 0; k < 1024; k += 4) {
                const float w0 = wr[(size_t)(k + 0) * 64], w1 = wr[(size_t)(k + 1) * 64], w2 = wr[(size_t)(k + 2) * 64], w3 = wr[(size_t)(k + 3) * 64];
#pragma unroll
                for (int j = 0; j < 4; ++j) {
                    const float4 u4 = *(const float4*)(u0 + j * 1024 + k);
                    acc[j] = fmaf(u4.x, w0, acc[j]); acc[j] = fmaf(u4.y, w1, acc[j]); acc[j] = fmaf(u4.z, w2, acc[j]); acc[j] = fmaf(u4.w, w3, acc[j]);
                }
            }
#pragma unroll
            for (int j = 0; j < 4; ++j) {
                const int tl = sb * 16 + wid * 4 + j;
                const float score = 1.f / (1.f + expf(-acc[j]));
                const float biased = score + ebias;
                float m1 = biased;
                m1 = fmaxf(m1, __shfl_xor(m1, 1)); m1 = fmaxf(m1, __shfl_xor(m1, 2)); m1 = fmaxf(m1, __shfl_xor(m1, 4));
                const unsigned long long eq = __ballot(biased == m1);
                const int g = lane >> 3;
                const unsigned gm = (unsigned)(eq >> (g * 8)) & 0xFFu;
                const int first = __ffs((int)gm) - 1;
                const float v2 = ((lane & 7) == first) ? -INFINITY : biased;
                float m2 = v2;
                m2 = fmaxf(m2, __shfl_xor(m2, 1)); m2 = fmaxf(m2, __shfl_xor(m2, 2)); m2 = fmaxf(m2, __shfl_xor(m2, 4));
                const float gs = m1 + m2;
                int rg = 0;
#pragma unroll
                for (int g2 = 0; g2 < 8; ++g2) { const float o = __builtin_bit_cast(float, __builtin_amdgcn_readlane(__builtin_bit_cast(int, gs), g2 * 8)); rg += ((o > gs) || (o == gs && g2 < g)) ? 1 : 0; }
                const bool keep = rg < 4;
                const float mk = keep ? biased : -INFINITY;
                int rk = 0;
#pragma unroll
                for (int e2 = 0; e2 < 64; ++e2) { const float o = __builtin_bit_cast(float, __builtin_amdgcn_readlane(__builtin_bit_cast(int, mk), e2)); rk += ((o > mk) || (o == mk && e2 < lane)) ? 1 : 0; }
                const bool sel = keep && (rk < 8);
                const float ssum = wave_sum(sel ? score : 0.f);
                const float wgt = score / ssum * 2.5f;
                const unsigned long long sm = __ballot(sel);
                const int kidx = __popcll(sm & ((1ull << lane) - 1ull));
                if (sel) { wsel[(size_t)(tok0 + tl) * 8 + kidx] = wgt; sel_e[tl * 8 + kidx] = lane; }
            }
            __syncthreads();
        }
        for (int i = tid; i < 512; i += NTHREADS) lpos[i] = atomicAdd(&hist[sel_e[i]], 1);
        __syncthreads();
        if (tid < 64) basep[tid] = (int)atomicAdd(&cnt[tid], (unsigned)hist[tid]);
        __syncthreads();
        for (int i = tid; i < 512; i += NTHREADS) { const int e = sel_e[i]; list[(size_t)e * NTOK + basep[e] + lpos[i]] = tok0 * 8 + i; }
        __syncthreads();
    }
}

DEVINL void moe_directory(KP p, int l, char* lds) {
    int* pref = (int*)(lds + 65536);
    int* cntl = (int*)(lds + 65536 + 512);
    if (TIDX() == 0) {
        unsigned* cnt = (unsigned*)(p->ws + OFF_CNT) + l * 64;
        int s = 0;
        for (int e = 0; e < 64; ++e) { const int c = (int)__hip_atomic_load(&cnt[e], __ATOMIC_RELAXED, __HIP_MEMORY_SCOPE_AGENT); cntl[e] = c; pref[e] = s; s += (c + 127) >> 7; }
        pref[64] = s; cntl[64] = NTOK; pref[65] = s + 256;
    }
    __syncthreads();
}

DEVINL void phaseE1(KP p, int l, char* lds) {
    const int nb = gridDim.x, blk = BIDX();
    moe_directory(p, l, lds);
    const int* pref = (const int*)(lds + 65536); const int* cntl = (const int*)(lds + 65536 + 512);
    const bf16_t* ubuf = (const bf16_t*)(p->ws + OFF_UBUF);
    const int* list = (const int*)(p->ws + M_LIST);
    bf16_t* hbuf = (bf16_t*)(p->ws + M_HBUF);
    const int total = pref[65] * 4;
    for (int t = blk; t < total; t += nb) {
        const int mg = t >> 2, nt = t & 3;
        int e = 0; while (pref[e + 1] <= mg) ++e;
        const int mt = mg - pref[e], Me = cntl[e];
        const bf16_t* Wt = (const bf16_t*)(p->ws + OFF_W13) + (size_t)(l * 65 + e) * 512 * 1024 + (size_t)(nt * 128) * 1024;
        auto arow = [&](int R) {
            const int idx = mt * 128 + R; int tok;
            if (e < 64) tok = (idx < Me) ? (list[(size_t)e * NTOK + idx] >> 3) : 0; else tok = idx;
            return ubuf + (size_t)tok * DM;
        };
        auto epi = [&](f32x4 (&acc)[4][4], int wr, int wc, int fr, int fq) {
#pragma unroll
            for (int m = 0; m < 4; ++m) {
                const size_t hrow = (size_t)pref[e] * 128 + mt * 128 + wr * 64 + m * 16 + fr;
#pragma unroll
                for (int q = 0; q < 2; ++q) {
                    const int hcol = nt * 64 + wc * 32 + q * 16 + fq * 4;
                    float hv[4];
#pragma unroll
                    for (int j = 0; j < 4; ++j) { const float gt = acc[m][2 * q][j], up = acc[m][2 * q + 1][j]; hv[j] = gt * sigm(gt) * up; }
                    uint2 o; o.x = pack2(hv[0], hv[1]); o.y = pack2(hv[2], hv[3]);
                    *(uint2*)(hbuf + hrow * 256 + hcol) = o;
                }
            }
        };
        gemm_tile128(lds, arow, Wt, 1024, epi);
    }
}

DEVINL void phaseE2(KP p, int l, char* lds) {
    const int nb = gridDim.x, blk = BIDX();
    moe_directory(p, l, lds);
    const int* pref = (const int*)(lds + 65536); const int* cntl = (const int*)(lds + 65536 + 512);
    const int* list = (const int*)(p->ws + M_LIST);
    const float* wsel = (const float*)(p->ws + M_WSEL);
    const bf16_t* hbuf = (const bf16_t*)(p->ws + M_HBUF);
    bf16_t* ybuf = (bf16_t*)(p->ws + M_YBUF);
    const int total = pref[65] * 8;
    for (int t = blk; t < total; t += nb) {
        const int mg = t >> 3, nt = t & 7;
        int e = 0; while (pref[e + 1] <= mg) ++e;
        const int mt = mg - pref[e], Me = cntl[e];
        const bf16_t* Wt = (const bf16_t*)(p->ws + OFF_W2) + (size_t)(l * 65 + e) * 1024 * 256 + (size_t)(nt * 128) * 256;
        const bf16_t* A0 = hbuf + ((size_t)pref[e] * 128 + mt * 128) * 256;
        auto arow = [&](int R) { return A0 + (size_t)R * 256; };
        auto epi = [&](f32x4 (&acc)[4][4], int wr, int wc, int fr, int fq) {
#pragma unroll
            for (int m = 0; m < 4; ++m) {
                const int idx = mt * 128 + wr * 64 + m * 16 + fr;
                if (idx < Me) {
                    size_t drow; float w;
                    if (e < 64) { const int ts = list[(size_t)e * NTOK + idx]; w = wsel[ts]; drow = (size_t)(ts >> 3) * 9 + (ts & 7); }
                    else { w = 1.f; drow = (size_t)idx * 9 + 8; }
#pragma unroll
                    for (int n = 0; n < 4; ++n) {
                        const int col = nt * 128 + wc * 64 + n * 16 + fq * 4;
                        uint2 o; o.x = pack2(w * acc[m][n][0], w * acc[m][n][1]); o.y = pack2(w * acc[m][n][2], w * acc[m][n][3]);
                        *(uint2*)(ybuf + drow * 1024 + col) = o;
                    }
                }
            }
        };
        gemm_tile128(lds, arow, Wt, 256, epi);
    }
}

DEVINL void phaseF(KP p, int l) {
    const int tid = TIDX(), nb = gridDim.x, blk = BIDX(), wid = tid >> 6, lane = tid & 63;
    float* xbuf = p->out;
    const bf16_t* ybuf = (const bf16_t*)(p->ws + M_YBUF);
    bf16_t* ubuf = (bf16_t*)(p->ws + OFF_UBUF);
    const float* mod = (const float*)(p->ws + OFF_MOD);
    for (int row = blk * 4 + wid; row < NTOK; row += nb * 4) {
        const int b = row >> 12;
        float4 z[4]; float s = 0.f;
#pragma unroll
        for (int i = 0; i < 4; ++i) {
            const int col = i * 256 + lane * 4;
            const float4 x1 = *(const float4*)(xbuf + (size_t)row * DM + col);
            float f0 = 0.f, f1 = 0.f, f2 = 0.f, f3 = 0.f;
#pragma unroll
            for (int k = 0; k < 9; ++k) {
                const uint2 yv = *(const uint2*)(ybuf + ((size_t)row * 9 + k) * 1024 + col);
                f0 += __uint_as_float(yv.x << 16); f1 += __uint_as_float(yv.x & 0xFFFF0000u); f2 += __uint_as_float(yv.y << 16); f3 += __uint_as_float(yv.y & 0xFFFF0000u);
            }
            const float4 g2 = *(const float4*)(mod + (size_t)(l * 8 + b) * 6144 + 5120 + col);
            z[i].x = ALPHA * x1.x + (1.f + g2.x) * f0; z[i].y = ALPHA * x1.y + (1.f + g2.y) * f1; z[i].z = ALPHA * x1.z + (1.f + g2.z) * f2; z[i].w = ALPHA * x1.w + (1.f + g2.w) * f3;
            s += z[i].x + z[i].y + z[i].z + z[i].w;
        }
        const float mean = wave_sum(s) * (1.f / 1024.f);
        float q = 0.f;
#pragma unroll
        for (int i = 0; i < 4; ++i) { z[i].x -= mean; z[i].y -= mean; z[i].z -= mean; z[i].w -= mean; q += z[i].x * z[i].x + z[i].y * z[i].y + z[i].z * z[i].z + z[i].w * z[i].w; }
        const float rs = rsqrtf(wave_sum(q) * (1.f / 1024.f) + LN_EPS);
#pragma unroll
        for (int i = 0; i < 4; ++i) {
            const int col = i * 256 + lane * 4;
            const float4 g = *(const float4*)(p->in[I_LN2G] + l * 1024 + col), bb = *(const float4*)(p->in[I_LN2B] + l * 1024 + col);
            float4 x2; x2.x = z[i].x * rs * g.x + bb.x; x2.y = z[i].y * rs * g.y + bb.y; x2.z = z[i].z * rs * g.z + bb.z; x2.w = z[i].w * rs * g.w + bb.w;
            *(float4*)(xbuf + (size_t)row * DM + col) = x2;
            if (l + 1 < DEPTH) {
                const float4 sh = *(const float4*)(mod + (size_t)((l + 1) * 8 + b) * 6144 + col), sc = *(const float4*)(mod + (size_t)((l + 1) * 8 + b) * 6144 + 1024 + col);
                uint2 o; o.x = pack2(x2.x * (1.f + sc.x) + sh.x, x2.y * (1.f + sc.y) + sh.y); o.y = pack2(x2.z * (1.f + sc.z) + sh.z, x2.w * (1.f + sc.w) + sh.w);
                *(uint2*)(ubuf + (size_t)row * DM + col) = o;
            }
        }
    }
}

constexpr int NPHASE = 2 + 9 * DEPTH;
__global__ void __launch_bounds__(NTHREADS, 2) mega(Params p_arg, int ph_lo, int ph_hi) {
    extern __shared__ __attribute__((aligned(16))) char lds[];
    cg::grid_group grid = cg::this_grid();
    for (int ph = ph_lo; ph < ph_hi; ++ph) {
        KP p = (KP)__builtin_amdgcn_kernarg_segment_ptr();
        asm volatile("" : "+s"(p));
        const int l = (ph >= 2) ? (ph - 2) / 9 : 0;
        const int q = (ph >= 2) ? (ph - 2) % 9 : -1;
        if (ph == 0) phase0(p, lds);
        else if (ph == 1) phaseF0(p);
        else {
            switch (q) {
                case 0: phaseA(p, l, lds); break;
                case 1: phaseB1(p, l, lds); break;
                case 2: phaseB2(p, l); break;
                case 3: phaseB3(p, l); break;
                case 4: phaseC(p, l, lds); break;
                case 5: phaseD(p, l, lds); break;
                case 6: phaseE1(p, l, lds); break;
                case 7: phaseE2(p, l, lds); break;
                default: phaseF(p, l); break;
            }
        }
        if (ph + 1 < ph_hi) grid.sync();
    }
}

extern "C" void kernel_launch(void* const* d_in, const int* in_sizes, int n_in, void* d_out, int out_size, void* d_ws, size_t ws_size, hipStream_t stream) {
    static int grid_blocks = 0;
    if (grid_blocks == 0) {
        if (n_in != 39 || out_size != NTOK * DM || ws_size < WS_NEED) { fprintf(stderr, "kernel_launch: unexpected shapes (n_in %d out %d ws %zu need %zu)\n", n_in, out_size, ws_size, (size_t)WS_NEED); grid_blocks = -1; return; }
        int dev = 0, cus = 0, per_cu = 0;
        hipGetDevice(&dev);
        hipDeviceGetAttribute(&cus, hipDeviceAttributeMultiprocessorCount, dev);
        hipFuncSetAttribute((const void*)mega, hipFuncAttributeMaxDynamicSharedMemorySize, LDS_BYTES);
        hipOccupancyMaxActiveBlocksPerMultiprocessor(&per_cu, (const void*)mega, NTHREADS, LDS_BYTES);
        if (per_cu < 1) { fprintf(stderr, "kernel_launch: occupancy query returned %d\n", per_cu); grid_blocks = -1; return; }
        if (per_cu > 2) per_cu = 2;
        grid_blocks = cus * per_cu;
    }
    if (grid_blocks < 0) return;
    Params p{};
    for (int i = 0; i < 39; ++i) p.in[i] = (const float*)d_in[i];
    p.out = (float*)d_out; p.ws = (unsigned char*)d_ws;
    int ph_lo = 0, ph_hi = NPHASE;
    void* args[] = {&p, &ph_lo, &ph_hi};
    hipError_t e = hipLaunchCooperativeKernel((const void*)mega, dim3(grid_blocks), dim3(NTHREADS), args, LDS_BYTES, stream);
    if (e != hipSuccess) fprintf(stderr, "cooperative launch failed: %s (grid %d)\n", hipGetErrorString(e), grid_blocks);
}
```

```cpp
#include <hip/hip_runtime.h>
#include <hip/hip_cooperative_groups.h>
#include <stdio.h>
#include <stdint.h>
namespace cg = cooperative_groups;

typedef unsigned short bf16_t;
typedef short bf16x8 __attribute__((ext_vector_type(8)));
typedef float f32x4 __attribute__((ext_vector_type(4)));
#define DEVINL __device__ __forceinline__

constexpr int NTOK = 32768, SEQ = 4096, NBATCH = 8, DM = 1024, PIN = 2688, DEPTH = 2;
constexpr int NEXP = 64;
constexpr float ALPHA = 1.41421356237f;
constexpr float LN_EPS = 1e-5f, GN_EPS = 64e-5f;
constexpr int NTHREADS = 256;
constexpr int LDS_BYTES = 77824;

constexpr size_t OFF_CNT   = 0;
constexpr size_t OFF_BAR   = 4096;
constexpr size_t OFF_MOD   = 65536;
constexpr size_t OFF_WIN   = 1048576;
constexpr size_t OFF_WOUT  = OFF_WIN + 11010048;
constexpr size_t OFF_W13   = OFF_WOUT + 4194304;
constexpr size_t OFF_W2    = OFF_W13 + 136314880;
constexpr size_t OFF_UBUF  = OFF_W2 + 68157440;
constexpr size_t OFF_ARENA = OFF_UBUF + 67108864;
constexpr size_t A_P      = OFF_ARENA;
constexpr size_t A_YMIX   = A_P + 176160768;
constexpr size_t A_SCAN   = A_YMIX + 67108864;
constexpr size_t A_HLOC   = A_SCAN + 134217728;
constexpr size_t A_CUMA   = A_HLOC + 33554432;
constexpr size_t A_G      = A_CUMA + 33554432;
constexpr size_t A_BONUS  = A_G + 33554432;
constexpr size_t A_YRAW   = A_BONUS + 33554432;
constexpr size_t A_CARRYA = A_YRAW + 33554432;
constexpr size_t A_CARRYH = A_CARRYA + 1048576;
constexpr size_t A_HSTART = A_CARRYH + 1048576;
constexpr size_t A_CHAIN  = A_HSTART + 1048576;
constexpr size_t CHAIN_UNIT = 49152;
constexpr size_t M_YBUF   = OFF_ARENA;
constexpr size_t M_HBUF   = M_YBUF + 603979776;
constexpr size_t M_LIST   = M_HBUF + 155189248;
constexpr size_t M_WSEL   = M_LIST + 8388608;
constexpr size_t WS_NEED  = M_WSEL + 1048576;

struct Params {
    const float* in[39];
    float* out;
    unsigned char* ws;
};
typedef const __attribute__((address_space(4))) Params* KP;
__device__ __forceinline__ int TIDX() { int t = threadIdx.x; asm volatile("" : "+v"(t)); return t; }
__device__ __forceinline__ int BIDX() { int b = blockIdx.x; asm volatile("" : "+s"(b)); return b; }
enum { I_X = 0, I_C, I_WMOD, I_BMOD, I_WIN, I_WOUT, I_CONVA, I_CONVAB, I_LNAG, I_LNAB, I_CONVB, I_CONVBB, I_WRG, I_BRG, I_WIG, I_BIG,
       I_LAMBDA, I_MUC, I_W0, I_WW2, I_A0, I_WA2, I_WG2, I_KK, I_KA, I_RK, I_GNG, I_GNB, I_CONVD, I_LN1G, I_LN1B, I_WROUTER, I_EBIAS,
       I_W13, I_W2, I_WS13, I_WS2, I_LN2G, I_LN2B };

DEVINL bf16_t f2bf(float f) { unsigned u = __float_as_uint(f); u += 0x7FFFu + ((u >> 16) & 1u); return (bf16_t)(u >> 16); }
DEVINL float bf2f(bf16_t h) { return __uint_as_float(((unsigned)h) << 16); }
typedef __bf16 bf2_t __attribute__((ext_vector_type(2)));
typedef float f2_t __attribute__((ext_vector_type(2)));
typedef float f32x16 __attribute__((ext_vector_type(16)));
DEVINL unsigned pack2(float a, float b) { f2_t v = {a, b}; return __builtin_bit_cast(unsigned, __builtin_convertvector(v, bf2_t)); }
DEVINL float sigm(float x) { return 1.f / (1.f + __expf(-x)); }
DEVINL float softplusf(float z) { return fmaxf(z, 0.f) + log1pf(__expf(-fabsf(z))); }
DEVINL float gelu_tanh(float x) { float u = 0.7978845608028654f * (x + 0.044715f * x * x * x); return 0.5f * x * (1.f + tanhf(u)); }
DEVINL float wave_sum(float x) {
#pragma unroll
    for (int o = 32; o > 0; o >>= 1) x += __shfl_xor(x, o);
    return x;
}
DEVINL float dppf(float x, const int ctrl_unused) { return x; }
DEVINL float wave_sum_dpp(float x) {
    x += __builtin_bit_cast(float, __builtin_amdgcn_update_dpp(0, __builtin_bit_cast(int, x), 0xB1, 0xf, 0xf, true));
    x += __builtin_bit_cast(float, __builtin_amdgcn_update_dpp(0, __builtin_bit_cast(int, x), 0x4E, 0xf, 0xf, true));
    x += __builtin_bit_cast(float, __builtin_amdgcn_update_dpp(0, __builtin_bit_cast(int, x), 0x141, 0xf, 0xf, true));
    x += __builtin_bit_cast(float, __builtin_amdgcn_update_dpp(0, __builtin_bit_cast(int, x), 0x140, 0xf, 0xf, true));
    x += __builtin_bit_cast(float, __builtin_amdgcn_update_dpp(0, __builtin_bit_cast(int, x), 0x142, 0xa, 0xf, false));
    x += __builtin_bit_cast(float, __builtin_amdgcn_update_dpp(0, __builtin_bit_cast(int, x), 0x143, 0xc, 0xf, false));
    return __builtin_bit_cast(float, __builtin_amdgcn_readlane(__builtin_bit_cast(int, x), 63));
}

DEVINL int lds_byte(int r, int c) { int st = (r >> 4) * 2 + (c >> 5), rr = r & 15, cc = c & 31, ob = rr * 64 + cc * 2; return st * 1024 + (ob ^ (((ob >> 9) & 1) << 5)); }
DEVINL void stage_rc(int b, int& R, int& C) { int st = b / 1024, sb = b % 1024, swz = sb ^ (((sb >> 9) & 1) << 5); R = (st >> 1) * 16 + swz / 64; C = (st & 1) * 32 + (swz % 64) / 2; }

template <class RowPtr, class Epi>
DEVINL void gemm_tile128(char* lds, RowPtr arow, const bf16_t* Bt, int K, Epi epi) {
    const int tid = TIDX();
    const bf16_t* ap[4]; const bf16_t* bp[4];
#pragma unroll
    for (int i = 0; i < 4; ++i) { int R, C; stage_rc(tid * 16 + i * 4096, R, C); ap[i] = arow(R) + C; bp[i] = Bt + (size_t)R * K + C; }
    const int wid = tid >> 6, lane = tid & 63, wr = wid >> 1, wc = wid & 1, fr = lane & 15, fq = lane >> 4;
    f32x4 acc[4][4];
#pragma unroll
    for (int m = 0; m < 4; ++m)
#pragma unroll
        for (int n = 0; n < 4; ++n) acc[m][n] = (f32x4){0.f, 0.f, 0.f, 0.f};
    const int nk = K >> 6;
#pragma unroll
    for (int i = 0; i < 4; ++i) {
        __builtin_amdgcn_global_load_lds((const unsigned*)(ap[i]), (unsigned*)(lds + tid * 16 + i * 4096), 16, 0, 0);
        __builtin_amdgcn_global_load_lds((const unsigned*)(bp[i]), (unsigned*)(lds + 16384 + tid * 16 + i * 4096), 16, 0, 0);
    }
    for (int kt = 0; kt < nk; ++kt) {
        asm volatile("s_waitcnt vmcnt(0)" ::: "memory");
        __syncthreads();
        char* cur = lds + (kt & 1) * 32768;
        if (kt + 1 < nk) {
            char* nxt = lds + ((kt + 1) & 1) * 32768;
            const int ko = (kt + 1) * 64;
#pragma unroll
            for (int i = 0; i < 4; ++i) {
                __builtin_amdgcn_global_load_lds((const unsigned*)(ap[i] + ko), (unsigned*)(nxt + tid * 16 + i * 4096), 16, 0, 0);
                __builtin_amdgcn_global_load_lds((const unsigned*)(bp[i] + ko), (unsigned*)(nxt + 16384 + tid * 16 + i * 4096), 16, 0, 0);
            }
        }
        bf16x8 af[4][2], bfr[4][2];
#pragma unroll
        for (int m = 0; m < 4; ++m)
#pragma unroll
            for (int kk = 0; kk < 2; ++kk) af[m][kk] = *reinterpret_cast<const bf16x8*>(cur + lds_byte(wr * 64 + m * 16 + fr, kk * 32 + fq * 8));
#pragma unroll
        for (int n = 0; n < 4; ++n)
#pragma unroll
            for (int kk = 0; kk < 2; ++kk) bfr[n][kk] = *reinterpret_cast<const bf16x8*>(cur + 16384 + lds_byte(wc * 64 + n * 16 + fr, kk * 32 + fq * 8));
#pragma unroll
        for (int kk = 0; kk < 2; ++kk)
#pragma unroll
            for (int m = 0; m < 4; ++m)
#pragma unroll
                for (int n = 0; n < 4; ++n) acc[m][n] = __builtin_amdgcn_mfma_f32_16x16x32_bf16(bfr[n][kk], af[m][kk], acc[m][n], 0, 0, 0);
    }
    __syncthreads();
    epi(acc, wr, wc, fr, fq);
}

DEVINL void phase0(KP p, char* lds) {
    const int tid = TIDX(), nb = gridDim.x, blk = BIDX();
    if (blk == 0 && tid < 128) ((unsigned*)(p->ws + OFF_CNT))[tid] = 0u;
    if (blk < 48) {
        float* sc = (float*)lds;
        for (int i = tid; i < 8192; i += NTHREADS) { float c = p->in[I_C][i]; sc[i] = c * sigm(c); }
        __syncthreads();
        const int n = blk * 256 + tid, l = n / 6144, nn = n % 6144;
        const float* w = p->in[I_WMOD] + (size_t)l * 1024 * 6144 + nn;
        float acc[8];
#pragma unroll
        for (int b = 0; b < 8; ++b) acc[b] = 0.f;
#pragma unroll 8
        for (int k = 0; k < 1024; ++k) {
            const float wv = w[(size_t)k * 6144];
#pragma unroll
            for (int b = 0; b < 8; ++b) acc[b] = fmaf(sc[b * 1024 + k], wv, acc[b]);
        }
        const float bm = p->in[I_BMOD][l * 6144 + nn];
        float* mod = (float*)(p->ws + OFF_MOD);
#pragma unroll
        for (int b = 0; b < 8; ++b) mod[(size_t)(l * 8 + b) * 6144 + nn] = acc[b] + bm;
        __syncthreads();
    }
    float* tile = (float*)lds;
    const int PER_L = 672 + 256 + 8320 + 4160;
    for (int id = blk; id < 2 * PER_L; id += nb) {
        const int l = id / PER_L; int r = id % PER_L;
        const float* src; bf16_t* dst; int K, ld, perm, kt, nt;
        if (r < 672) { src = p->in[I_WIN] + (size_t)l * 1024 * 2688; K = 1024; ld = 2688; perm = 0; dst = (bf16_t*)(p->ws + OFF_WIN) + (size_t)l * 2688 * 1024; kt = r & 15; nt = r >> 4; }
        else if (r < 928) { r -= 672; src = p->in[I_WOUT] + (size_t)l * 1024 * 1024; K = 1024; ld = 1024; perm = 0; dst = (bf16_t*)(p->ws + OFF_WOUT) + (size_t)l * 1024 * 1024; kt = r & 15; nt = r >> 4; }
        else if (r < 928 + 8320) { r -= 928; const int e = r >> 7, q = r & 127; kt = q & 15; nt = q >> 4; K = 1024; ld = 512; perm = 1;
            src = (e < 64) ? p->in[I_W13] + (size_t)(l * 64 + e) * 1024 * 512 : p->in[I_WS13] + (size_t)l * 1024 * 512;
            dst = (bf16_t*)(p->ws + OFF_W13) + (size_t)(l * 65 + e) * 512 * 1024; }
        else { r -= 9248; const int e = r >> 6, q = r & 63; kt = q & 3; nt = q >> 2; K = 256; ld = 1024; perm = 0;
            src = (e < 64) ? p->in[I_W2] + (size_t)(l * 64 + e) * 256 * 1024 : p->in[I_WS2] + (size_t)l * 256 * 1024;
            dst = (bf16_t*)(p->ws + OFF_W2) + (size_t)(l * 65 + e) * 1024 * 256; }
        const int k0 = kt * 64, r0 = nt * 64;
        {
            const int nn = tid & 63; const int drow = r0 + nn;
            int scol = drow;
            if (perm) { const int g = drow >> 5, i = drow & 31; scol = (i < 16) ? (g * 16 + i) : (256 + g * 16 + (i - 16)); }
#pragma unroll
            for (int j = 0; j < 16; ++j) { const int kk = (tid >> 6) + 4 * j; tile[kk * 65 + nn] = src[(size_t)(k0 + kk) * ld + scol]; }
        }
        __syncthreads();
        {
            const int kp = (tid & 31) * 2;
#pragma unroll
            for (int j = 0; j < 8; ++j) { const int rr = (tid >> 5) + 8 * j;
                *(unsigned*)(dst + (size_t)(r0 + rr) * K + k0 + kp) = pack2(tile[kp * 65 + rr], tile[(kp + 1) * 65 + rr]); }
        }
        __syncthreads();
    }
}

DEVINL void phaseF0(KP p) {
    const int tid = TIDX(), nb = gridDim.x, blk = BIDX();
    const float* mod = (const float*)(p->ws + OFF_MOD);
    bf16_t* ubuf = (bf16_t*)(p->ws + OFF_UBUF);
    for (int row = blk; row < NTOK; row += nb) {
        const int b = row >> 12, col = tid * 4;
        const float4 x = *(const float4*)(p->in[I_X] + (size_t)row * DM + col);
        const float4 sh = *(const float4*)(mod + (size_t)b * 6144 + col);
        const float4 sc = *(const float4*)(mod + (size_t)b * 6144 + 1024 + col);
        uint2 o; o.x = pack2(x.x * (1.f + sc.x) + sh.x, x.y * (1.f + sc.y) + sh.y); o.y = pack2(x.z * (1.f + sc.z) + sh.z, x.w * (1.f + sc.w) + sh.w);
        *(uint2*)(ubuf + (size_t)row * DM + col) = o;
    }
}

DEVINL void phaseA(KP p, int l, char* lds) {
    const int nb = gridDim.x, blk = BIDX();
    const bf16_t* ubuf = (const bf16_t*)(p->ws + OFF_UBUF);
    const bf16_t* Wt = (const bf16_t*)(p->ws + OFF_WIN) + (size_t)l * 2688 * 1024;
    bf16_t* P = (bf16_t*)(p->ws + A_P);
    for (int t = blk; t < 256 * 21; t += nb) {
        const int pn = t % 21, pm = t / 21;
        auto arow = [&](int R) { return ubuf + (size_t)(pm * 128 + R) * DM; };
        auto epi = [&](f32x4 (&acc)[4][4], int wr, int wc, int fr, int fq) {
#pragma unroll
            for (int m = 0; m < 4; ++m) {
                const int row = pm * 128 + wr * 64 + m * 16 + fr;
#pragma unroll
                for (int n = 0; n < 4; ++n) {
                    const int col = pn * 128 + wc * 64 + n * 16 + fq * 4;
                    uint2 o; o.x = pack2(acc[m][n][0], acc[m][n][1]); o.y = pack2(acc[m][n][2], acc[m][n][3]);
                    *(uint2*)(P + (size_t)row * PIN + col) = o;
                }
            }
        };
        gemm_tile128(lds, arow, Wt + (size_t)(pn * 128) * 1024, 1024, epi);
    }
}

DEVINL void b1_conformer(KP p, int l, char* lds, int item) {
    const int tid = TIDX(), b = item >> 7, tt = item & 127, t0 = tt * 32, rowbase = b * SEQ;
    const bf16_t* P = (const bf16_t*)(p->ws + A_P);
    bf16_t* ymix = (bf16_t*)(p->ws + A_YMIX);
    float w[31];
#pragma unroll
    for (int k = 0; k < 31; ++k) w[k] = p->in[I_CONVA][(size_t)(l * 31 + k) * 256 + tid];
    float acc[32];
    const float bias = p->in[I_CONVAB][l * 256 + tid];
#pragma unroll
    for (int j = 0; j < 32; ++j) acc[j] = bias;
#pragma unroll
    for (int rr = 0; rr < 62; ++rr) {
        const int t = t0 - 30 + rr;
        float h = 0.f;
        if (t >= 0) { const bf16_t* pr = P + (size_t)(rowbase + t) * PIN; const float val = bf2f(pr[tid]), gate = bf2f(pr[256 + tid]); h = val * sigm(gate); }
#pragma unroll
        for (int j = 0; j < 32; ++j) { const int k = rr - j; if (k >= 0 && k <= 30) acc[j] = fmaf(w[k], h, acc[j]); }
    }
    float* outb = (float*)lds;
#pragma unroll
    for (int j = 0; j < 32; ++j) outb[j * 256 + tid] = acc[j];
    __syncthreads();
    const int wid = tid >> 6, lane = tid & 63;
    const float4 g4 = *(const float4*)(p->in[I_LNAG] + l * 256 + lane * 4), b4 = *(const float4*)(p->in[I_LNAB] + l * 256 + lane * 4);
    for (int j = wid; j < 32; j += 4) {
        const float4 v = *(const float4*)(outb + j * 256 + lane * 4);
        const float mean = wave_sum(v.x + v.y + v.z + v.w) * (1.f / 256.f);
        const float d0 = v.x - mean, d1 = v.y - mean, d2 = v.z - mean, d3 = v.w - mean;
        const float var = wave_sum(d0 * d0 + d1 * d1 + d2 * d2 + d3 * d3) * (1.f / 256.f);
        const float rs = rsqrtf(var + LN_EPS);
        float y0 = d0 * rs * g4.x + b4.x, y1 = d1 * rs * g4.y + b4.y, y2 = d2 * rs * g4.z + b4.z, y3 = d3 * rs * g4.w + b4.w;
        y0 *= sigm(y0); y1 *= sigm(y1); y2 *= sigm(y2); y3 *= sigm(y3);
        uint2 o; o.x = pack2(y0, y1); o.y = pack2(y2, y3);
        *(uint2*)(ymix + (size_t)(rowbase + t0 + j) * DM + lane * 4) = o;
    }
    __syncthreads();
}

DEVINL void b1_shortconv(KP p, int l, int item) {
    const int c = TIDX(), b = item >> 6, t0 = (item & 63) * 64, rowbase = b * SEQ;
    const bf16_t* P = (const bf16_t*)(p->ws + A_P);
    bf16_t* ymix = (bf16_t*)(p->ws + A_YMIX);
    const float w0 = p->in[I_CONVD][(l * 3 + 0) * 256 + c], w1 = p->in[I_CONVD][(l * 3 + 1) * 256 + c], w2 = p->in[I_CONVD][(l * 3 + 2) * 256 + c];
    float q2 = 0.f, q1 = 0.f;
    if (t0 >= 2) {
        const bf16_t* a = P + (size_t)(rowbase + t0 - 2) * PIN + 1920 + c; q2 = bf2f(a[256]) * bf2f(a[512]);
        const bf16_t* a1 = a + PIN; q1 = bf2f(a1[256]) * bf2f(a1[512]);
    }
#pragma unroll 4
    for (int j = 0; j < 64; ++j) {
        const bf16_t* a = P + (size_t)(rowbase + t0 + j) * PIN + 1920 + c;
        const float gb = bf2f(a[0]), q0 = bf2f(a[256]) * bf2f(a[512]);
        const float y = gb * (w0 * q2 + w1 * q1 + w2 * q0);
        ymix[(size_t)(rowbase + t0 + j) * DM + 768 + c] = f2bf(y);
        q2 = q1; q1 = q0;
    }
}

DEVINL void b1_lru(KP p, int l, char* lds, int item) {
    const int c = TIDX(), b = item >> 7, tt = item & 127, t0 = tt * 32, rowbase = b * SEQ;
    const int h = c >> 6, lane = c & 63;
    const bf16_t* P = (const bf16_t*)(p->ws + A_P);
    float* uT = (float*)lds;
    float ureg[32];
    {
        const float cb0 = p->in[I_CONVB][(l * 4 + 0) * 256 + c], cb1 = p->in[I_CONVB][(l * 4 + 1) * 256 + c], cb2 = p->in[I_CONVB][(l * 4 + 2) * 256 + c], cb3 = p->in[I_CONVB][(l * 4 + 3) * 256 + c];
        const float bias = p->in[I_CONVBB][l * 256 + c];
        float xm3 = 0.f, xm2 = 0.f, xm1 = 0.f;
        if (t0 >= 3) { const bf16_t* a = P + (size_t)(rowbase + t0 - 3) * PIN + 512 + c; xm3 = bf2f(a[0]); xm2 = bf2f(a[PIN]); xm1 = bf2f(a[2 * PIN]); }
#pragma unroll
        for (int j = 0; j < 32; ++j) {
            const float x0 = bf2f(P[(size_t)(rowbase + t0 + j) * PIN + 512 + c]);
            ureg[j] = cb0 * xm3 + cb1 * xm2 + cb2 * xm1 + cb3 * x0 + bias;
            xm3 = xm2; xm2 = xm1; xm1 = x0;
            uT[c * 36 + j] = ureg[j];
        }
    }
    __syncthreads();
    float ar[32], ai[32];
#pragma unroll
    for (int j = 0; j < 32; ++j) { ar[j] = 0.f; ai[j] = 0.f; }
    {
        const float* wrg = p->in[I_WRG] + (size_t)((l * 4 + h) * 64) * 64 + lane;
        const float* wig = p->in[I_WIG] + (size_t)((l * 4 + h) * 64) * 64 + lane;
#pragma unroll 2
        for (int d = 0; d < 64; ++d) {
            const float wr = wrg[d * 64], wi = wig[d * 64];
            const float4* up = (const float4*)(uT + (h * 64 + d) * 36);
#pragma unroll
            for (int jj = 0; jj < 8; ++jj) {
                const float4 u4 = up[jj];
                ar[4 * jj + 0] = fmaf(u4.x, wr, ar[4 * jj + 0]); ai[4 * jj + 0] = fmaf(u4.x, wi, ai[4 * jj + 0]);
                ar[4 * jj + 1] = fmaf(u4.y, wr, ar[4 * jj + 1]); ai[4 * jj + 1] = fmaf(u4.y, wi, ai[4 * jj + 1]);
                ar[4 * jj + 2] = fmaf(u4.z, wr, ar[4 * jj + 2]); ai[4 * jj + 2] = fmaf(u4.z, wi, ai[4 * jj + 2]);
                ar[4 * jj + 3] = fmaf(u4.w, wr, ar[4 * jj + 3]); ai[4 * jj + 3] = fmaf(u4.w, wi, ai[4 * jj + 3]);
            }
        }
    }
    {
        const float brg = p->in[I_BRG][l * 256 + c], big = p->in[I_BIG][l * 256 + c];
        const float sp = softplusf(-p->in[I_LAMBDA][l * 256 + c]);
        float* hloc = (float*)(p->ws + A_HLOC); float* cuma = (float*)(p->ws + A_CUMA);
        float hs = 0.f, cA = 1.f;
#pragma unroll
        for (int j = 0; j < 32; ++j) {
            const float r = sigm(ar[j] + brg), ig = sigm(ai[j] + big);
            const float log_a = -8.0f * r * sp;
            const float a = __expf(log_a);
            const float mult = sqrtf(fmaxf(-expm1f(2.f * log_a), 0.f));
            const float bx = mult * (ig * ureg[j]);
            hs = fmaf(a, hs, bx); cA *= a;
            const size_t o = (size_t)(rowbase + t0 + j) * 256 + c;
            hloc[o] = hs; cuma[o] = cA;
        }
        ((float*)(p->ws + A_CARRYA))[(size_t)(b * 128 + tt) * 256 + c] = cA;
        ((float*)(p->ws + A_CARRYH))[(size_t)(b * 128 + tt) * 256 + c] = hs;
    }
    __syncthreads();
}

DEVINL void b1_rwkv(KP p, int l, char* lds, int item) {
    const int c = TIDX(), b = item >> 7, tt = item & 127, t0 = tt * 32, rowbase = b * SEQ;
    const bf16_t* P = (const bf16_t*)(p->ws + A_P);
    float* featT = (float*)lds;
    const float* muc = p->in[I_MUC] + l * 896;
    if (c < 128) {
        const int col = 1024 + 768 + c; const float mu = muc[768 + c];
        float prev = (t0 > 0) ? bf2f(P[(size_t)(rowbase + t0 - 1) * PIN + col]) : 0.f;
#pragma unroll 4
        for (int j = 0; j < 32; ++j) {
            const float cur = bf2f(P[(size_t)(rowbase + t0 + j) * PIN + col]);
            const float xs = cur + (prev - cur) * mu;
            const float val = (c < 32) ? tanhf(xs) : ((c < 64) ? xs : sigm(xs));
            featT[c * 36 + j] = val; prev = cur;
        }
    }
    __syncthreads();
    float acc[32], dec[32], aa[32];
#pragma unroll
    for (int j = 0; j < 32; ++j) acc[j] = 0.f;
#pragma unroll 2
    for (int jf = 0; jf < 32; ++jf) {
        const float wv = p->in[I_WW2][(size_t)(l * 32 + jf) * 256 + c]; const float4* fp = (const float4*)(featT + jf * 36);
#pragma unroll
        for (int jj = 0; jj < 8; ++jj) { const float4 u4 = fp[jj]; acc[4 * jj] = fmaf(u4.x, wv, acc[4 * jj]); acc[4 * jj + 1] = fmaf(u4.y, wv, acc[4 * jj + 1]); acc[4 * jj + 2] = fmaf(u4.z, wv, acc[4 * jj + 2]); acc[4 * jj + 3] = fmaf(u4.w, wv, acc[4 * jj + 3]); }
    }
    {
        const float w0 = p->in[I_W0][l * 256 + c];
#pragma unroll
        for (int j = 0; j < 32; ++j) { const float z = w0 + acc[j]; const float wlog = -softplusf(-z) - 0.5f; dec[j] = -__expf(wlog); acc[j] = 0.f; }
    }
#pragma unroll 2
    for (int jf = 0; jf < 32; ++jf) {
        const float wv = p->in[I_WA2][(size_t)(l * 32 + jf) * 256 + c]; const float4* fp = (const float4*)(featT + (32 + jf) * 36);
#pragma unroll
        for (int jj = 0; jj < 8; ++jj) { const float4 u4 = fp[jj]; acc[4 * jj] = fmaf(u4.x, wv, acc[4 * jj]); acc[4 * jj + 1] = fmaf(u4.y, wv, acc[4 * jj + 1]); acc[4 * jj + 2] = fmaf(u4.z, wv, acc[4 * jj + 2]); acc[4 * jj + 3] = fmaf(u4.w, wv, acc[4 * jj + 3]); }
    }
    {
        const float a0 = p->in[I_A0][l * 256 + c];
#pragma unroll
        for (int j = 0; j < 32; ++j) { aa[j] = sigm(a0 + acc[j]); acc[j] = 0.f; }
    }
#pragma unroll 2
    for (int jf = 0; jf < 64; ++jf) {
        const float wv = p->in[I_WG2][(size_t)(l * 64 + jf) * 256 + c]; const float4* fp = (const float4*)(featT + (64 + jf) * 36);
#pragma unroll
        for (int jj = 0; jj < 8; ++jj) { const float4 u4 = fp[jj]; acc[4 * jj] = fmaf(u4.x, wv, acc[4 * jj]); acc[4 * jj + 1] = fmaf(u4.y, wv, acc[4 * jj + 1]); acc[4 * jj + 2] = fmaf(u4.z, wv, acc[4 * jj + 2]); acc[4 * jj + 3] = fmaf(u4.w, wv, acc[4 * jj + 3]); }
    }
    {
        float* gbuf = (float*)(p->ws + A_G); float* bonus = (float*)(p->ws + A_BONUS); uint4* scan = (uint4*)(p->ws + A_SCAN);
        const float mur = muc[c], muk = muc[256 + c], muv = muc[512 + c];
        const float kkw = p->in[I_KK][l * 256 + c], kaw = p->in[I_KA][l * 256 + c], rkw = p->in[I_RK][l * 256 + c];
        float pr = 0.f, pk = 0.f, pv = 0.f;
        if (t0 > 0) { const bf16_t* a = P + (size_t)(rowbase + t0 - 1) * PIN + 1024 + c; pr = bf2f(a[0]); pk = bf2f(a[256]); pv = bf2f(a[512]); }
#pragma unroll 4
        for (int j = 0; j < 32; ++j) {
            const size_t row = (size_t)(rowbase + t0 + j);
            const bf16_t* a = P + row * PIN + 1024 + c;
            const float cr = bf2f(a[0]), ck = bf2f(a[256]), cv = bf2f(a[512]);
            const float r = cr + (pr - cr) * mur, k = ck + (pk - ck) * muk, v = cv + (pv - cv) * muv;
            pr = cr; pk = ck; pv = cv;
            const float kk = k * kkw;
            const float ss = wave_sum(kk * kk);
            const float kkn = kk * rsqrtf(ss + 1e-12f);
            const float kf = k * (1.f + (aa[j] - 1.f) * kaw);
            const float bs = wave_sum(r * kf * rkw);
            bonus[row * 256 + c] = bs * v;
            gbuf[row * 256 + c] = acc[j];
            uint4 o; o.x = pack2(kkn, kkn * aa[j]); o.y = pack2(kf, r); o.z = pack2(v, 0.f); o.w = __float_as_uint(dec[j]);
            scan[row * 256 + c] = o;
        }
    }
    __syncthreads();
}

constexpr int S_AL = 0, S_BE = 8192, S_KA = 16384, S_RH = 24576, S_BET = 32768, S_KAT = 40960, S_VT = 49152, S_L2F = 57344  , S_GT = 73728  ;
constexpr int S_L1F = S_BE;
constexpr int S_M1 = S_BE, S_M2 = S_KA;
constexpr int S_APT = S_L2F, S_W2T = S_L2F + 8192;
constexpr int S_RP = S_AL, S_GTR = S_RH;
DEVINL int crow32(int reg, int h) { return (reg & 3) + 8 * (reg >> 2) + 4 * h; }
DEVINL bf16x8 frag64(const char* lds, int slot, int row, int kel) { return *reinterpret_cast<const bf16x8*>(lds + slot + row * 128 + kel * 2); }
#define MFMA32(a, b, c) __builtin_amdgcn_mfma_f32_32x32x16_bf16((a), (b), (c), 0, 0, 0)
DEVINL float dpp_xor1(float x) { return __builtin_bit_cast(float, __builtin_amdgcn_update_dpp(0, __builtin_bit_cast(int, x), 0xB1, 0xf, 0xf, true)); }

DEVINL f32x16 mm64(const char* lds, int slotA, int slotB, int tm, int tn, int r, int hh, f32x16 acc) {
#pragma unroll
    for (int ks = 0; ks < 4; ++ks) acc = MFMA32(frag64(lds, slotA, tm * 32 + r, ks * 16 + 8 * hh), frag64(lds, slotB, tn * 32 + r, ks * 16 + 8 * hh), acc);
    return acc;
}

DEVINL void b1e_unit(KP p, char* lds, int b, int h, int c) {
    const int tid = TIDX(), wv = tid >> 6, lane = tid & 63, r = lane & 31, hh = lane >> 5;
    const uint4* scan = (const uint4*)(p->ws + A_SCAN) + ((size_t)(b * SEQ + c * 64)) * 256 + h * 64;
    float* gtot = (float*)(lds + S_GT); float* gamC = gtot + 256;
    {
        const int j = lane;
        float lw[16]; unsigned px[16], py[16], pz[16];
#pragma unroll
        for (int u = 0; u < 16; ++u) { const uint4 q = scan[(size_t)(wv * 16 + u) * 256 + j]; px[u] = q.x; py[u] = q.y; pz[u] = q.z; lw[u] = __uint_as_float(q.w); }
        float tot = 0.f;
#pragma unroll
        for (int u = 0; u < 16; ++u) tot += lw[u];
        gtot[wv * 64 + j] = tot;
        __syncthreads();
        float off = 0.f, all = 0.f;
#pragma unroll
        for (int g = 0; g < 4; ++g) { const float v = gtot[g * 64 + j]; all += v; off += (g < wv) ? v : 0.f; }
        if (wv == 0) gamC[j] = __expf(all);
        float cum = off;
        unsigned tb[8], tk[8], tv[8];
#pragma unroll
        for (int u = 0; u < 16; ++u) {
            const float kkn = __uint_as_float(px[u] << 16), bb = __uint_as_float(px[u] & 0xFFFF0000u);
            const float kf = __uint_as_float(py[u] << 16), rr = __uint_as_float(py[u] & 0xFFFF0000u);
            const float gp = __expf(cum); cum += lw[u];
            const float g = __expf(cum), en = __expf(-cum);
            const int t = wv * 16 + u;
            const unsigned be = f2bf(bb * en), ka = f2bf(kf * en);
            *(bf16_t*)(lds + S_AL + t * 128 + j * 2) = f2bf(gp * kkn);
            *(bf16_t*)(lds + S_BE + t * 128 + j * 2) = (bf16_t)be;
            *(bf16_t*)(lds + S_KA + t * 128 + j * 2) = (bf16_t)ka;
            *(bf16_t*)(lds + S_RH + t * 128 + j * 2) = f2bf(g * rr);
            if (u & 1) { tb[u >> 1] |= be << 16; tk[u >> 1] |= ka << 16; tv[u >> 1] |= (pz[u] << 16); }
            else { tb[u >> 1] = be; tk[u >> 1] = ka; tv[u >> 1] = pz[u] & 0xFFFFu; }
        }
        *(uint4*)(lds + S_BET + j * 128 + wv * 32) = make_uint4(tb[0], tb[1], tb[2], tb[3]); *(uint4*)(lds + S_BET + j * 128 + wv * 32 + 16) = make_uint4(tb[4], tb[5], tb[6], tb[7]);
        *(uint4*)(lds + S_KAT + j * 128 + wv * 32) = make_uint4(tk[0], tk[1], tk[2], tk[3]); *(uint4*)(lds + S_KAT + j * 128 + wv * 32 + 16) = make_uint4(tk[4], tk[5], tk[6], tk[7]);
        *(uint4*)(lds + S_VT + j * 128 + wv * 32) = make_uint4(tv[0], tv[1], tv[2], tv[3]); *(uint4*)(lds + S_VT + j * 128 + wv * 32 + 16) = make_uint4(tv[4], tv[5], tv[6], tv[7]);
    }
    __syncthreads();
    const int tm = wv >> 1, tn = wv & 1;
    f32x16 aM1, aM2;
    {
        f32x16 aL1, aL2;
#pragma unroll
        for (int i = 0; i < 16; ++i) { aL1[i] = 0.f; aL2[i] = 0.f; aM1[i] = 0.f; aM2[i] = 0.f; }
#pragma unroll
        for (int ks = 0; ks < 4; ++ks) {
            const bf16x8 fa = frag64(lds, S_AL, tm * 32 + r, ks * 16 + 8 * hh), fr = frag64(lds, S_RH, tm * 32 + r, ks * 16 + 8 * hh);
            const bf16x8 fb = frag64(lds, S_BE, tn * 32 + r, ks * 16 + 8 * hh), fk = frag64(lds, S_KA, tn * 32 + r, ks * 16 + 8 * hh);
            aL1 = MFMA32(fa, fb, aL1); aL2 = MFMA32(fa, fk, aL2); aM1 = MFMA32(fr, fb, aM1); aM2 = MFMA32(fr, fk, aM2);
        }
        __syncthreads();
#pragma unroll
        for (int reg = 0; reg < 16; ++reg) {
            const int t = tm * 32 + crow32(reg, hh), sidx = tn * 32 + r;
            const int o = (t * 64 + (sidx & 1) * 32 + (sidx >> 1)) * 4;
            *(float*)(lds + S_L1F + o) = (sidx < t) ? aL1[reg] : 0.f;
            *(float*)(lds + S_L2F + o) = (sidx < t) ? aL2[reg] : 0.f;
            aM1[reg] = (sidx <= t) ? aM1[reg] : 0.f; aM2[reg] = (sidx <= t) ? aM2[reg] : 0.f;
        }
    }
    __syncthreads();
    unsigned outp[32];
    {
        const int col = (wv & 1) * 32 + (lane >> 1), q = lane & 1;
        float xq[32];
#pragma unroll
        for (int k = 0; k < 32; ++k) xq[k] = 0.f;
        const char* l1row = lds + S_L1F + q * 128;
        const char* l2row = lds + S_L2F + q * 128;
        if (wv < 2) {
#pragma unroll
            for (int t = 0; t < 64; ++t) {
                float acc = 0.f;
#pragma unroll
                for (int k4 = 0; k4 * 4 < (t + 1) / 2; ++k4) {
                    const float4 a = *(const float4*)(l1row + t * 256 + k4 * 16);
                    acc = fmaf(a.x, xq[4 * k4 + 0], acc); acc = fmaf(a.y, xq[4 * k4 + 1], acc); acc = fmaf(a.z, xq[4 * k4 + 2], acc); acc = fmaf(a.w, xq[4 * k4 + 3], acc);
                }
                acc += dpp_xor1(acc);
                const float x = bf2f(*(const bf16_t*)(lds + S_AL + t * 128 + col * 2)) - acc;
                xq[t >> 1] = ((t & 1) == q) ? x : xq[t >> 1];
            }
        } else {
            float vq[32];
#pragma unroll
            for (int k8 = 0; k8 < 8; ++k8) {
                const uint4 d = *(const uint4*)(lds + S_VT + col * 128 + k8 * 16);
                vq[4 * k8 + 0] = q ? __uint_as_float(d.x & 0xFFFF0000u) : __uint_as_float(d.x << 16);
                vq[4 * k8 + 1] = q ? __uint_as_float(d.y & 0xFFFF0000u) : __uint_as_float(d.y << 16);
                vq[4 * k8 + 2] = q ? __uint_as_float(d.z & 0xFFFF0000u) : __uint_as_float(d.z << 16);
                vq[4 * k8 + 3] = q ? __uint_as_float(d.w & 0xFFFF0000u) : __uint_as_float(d.w << 16);
            }
#pragma unroll
            for (int t = 0; t < 64; ++t) {
                float acc = 0.f;
#pragma unroll
                for (int k4 = 0; k4 * 4 < (t + 1) / 2; ++k4) {
                    const float4 a = *(const float4*)(l1row + t * 256 + k4 * 16);
                    const float4 bq = *(const float4*)(l2row + t * 256 + k4 * 16);
                    acc = fmaf(bq.x, vq[4 * k4 + 0], acc); acc = fmaf(bq.y, vq[4 * k4 + 1], acc); acc = fmaf(bq.z, vq[4 * k4 + 2], acc); acc = fmaf(bq.w, vq[4 * k4 + 3], acc);
                    acc = fmaf(-a.x, xq[4 * k4 + 0], acc); acc = fmaf(-a.y, xq[4 * k4 + 1], acc); acc = fmaf(-a.z, xq[4 * k4 + 2], acc); acc = fmaf(-a.w, xq[4 * k4 + 3], acc);
                }
                acc += dpp_xor1(acc);
                xq[t >> 1] = ((t & 1) == q) ? acc : xq[t >> 1];
            }
        }
#pragma unroll
        for (int k = 0; k < 32; ++k) { const float o = dpp_xor1(xq[k]); outp[k] = q ? pack2(o, xq[k]) : pack2(xq[k], o); }
    }
    __syncthreads();
    {
        const int col = (wv & 1) * 32 + (lane >> 1), q = lane & 1;
        char* dst = lds + ((wv < 2) ? S_APT : S_W2T) + col * 128 + q * 64;
#pragma unroll
        for (int i = 0; i < 4; ++i) *(uint4*)(dst + i * 16) = q ? make_uint4(outp[16 + 4 * i], outp[17 + 4 * i], outp[18 + 4 * i], outp[19 + 4 * i]) : make_uint4(outp[4 * i], outp[4 * i + 1], outp[4 * i + 2], outp[4 * i + 3]);
#pragma unroll
        for (int reg = 0; reg < 16; ++reg) {
            const int t = tm * 32 + crow32(reg, hh), sidx = tn * 32 + r;
            *(bf16_t*)(lds + S_M1 + t * 128 + sidx * 2) = f2bf(aM1[reg]);
            *(bf16_t*)(lds + S_M2 + t * 128 + sidx * 2) = f2bf(aM2[reg]);
        }
    }
    __syncthreads();
    unsigned char* ubase = p->ws + A_CHAIN + (size_t)((b * 4 + h) * 64 + c) * CHAIN_UNIT;
    f32x16 zero;
#pragma unroll
    for (int i = 0; i < 16; ++i) zero[i] = 0.f;
    f32x16 gt;
    {
        const f32x16 qv = mm64(lds, S_M1, S_APT, tm, tn, r, hh, zero);
        const f32x16 y0 = mm64(lds, S_M2, S_VT, tm, tn, r, hh, zero) - mm64(lds, S_M1, S_W2T, tm, tn, r, hh, zero);
        gt = mm64(lds, S_BET, S_APT, tm, tn, r, hh, zero);
        const f32x16 ht = mm64(lds, S_KAT, S_VT, tm, tn, r, hh, zero) - mm64(lds, S_BET, S_W2T, tm, tn, r, hh, zero);
#pragma unroll
        for (int reg = 0; reg < 16; ++reg) {
            const int t = tm * 32 + crow32(reg, hh), jc = tn * 32 + r;
            const float rh = bf2f(*(const bf16_t*)(lds + S_RH + t * 128 + jc * 2));
            *(bf16_t*)(lds + S_RP + t * 128 + jc * 2) = f2bf(rh - qv[reg]);
            const int jr = tm * 32 + crow32(reg, hh);
            const float gc = gamC[jr];
            gt[reg] = gc * (((jr == jc) ? 1.f : 0.f) - gt[reg]);
        }
        float4* himg = (float4*)(ubase + 16384); float4* yimg = (float4*)(ubase + 32768);
#pragma unroll
        for (int rq = 0; rq < 4; ++rq) {
            float4 hv, yv;
            hv.x = gamC[tm * 32 + crow32(4 * rq + 0, hh)] * ht[4 * rq + 0]; hv.y = gamC[tm * 32 + crow32(4 * rq + 1, hh)] * ht[4 * rq + 1];
            hv.z = gamC[tm * 32 + crow32(4 * rq + 2, hh)] * ht[4 * rq + 2]; hv.w = gamC[tm * 32 + crow32(4 * rq + 3, hh)] * ht[4 * rq + 3];
            yv.x = y0[4 * rq + 0]; yv.y = y0[4 * rq + 1]; yv.z = y0[4 * rq + 2]; yv.w = y0[4 * rq + 3];
            himg[((tn * 2 + tm) * 4 + rq) * 64 + lane] = hv;
            yimg[((tn * 2 + tm) * 4 + rq) * 64 + lane] = yv;
        }
    }
    __syncthreads();
#pragma unroll
    for (int reg = 0; reg < 16; ++reg) {
        const int jr = tm * 32 + crow32(reg, hh), jc = tn * 32 + r;
        *(bf16_t*)(lds + S_GTR + jr * 128 + jc * 2) = f2bf(gt[reg]);
    }
    __syncthreads();
    {
        uint4* gimg = (uint4*)(ubase); uint4* rimg = (uint4*)(ubase + 8192);
#pragma unroll
        for (int ii = 0; ii < 2; ++ii) {
            const int im = wv * 2 + ii, mt = im >> 2, jb = (im >> 1) & 1, s2 = im & 1;
            const int cbase = (32 * jb + 16 * s2 + 4 * hh) * 2;
            const uint2 g0 = *(const uint2*)(lds + S_GTR + (mt * 32 + r) * 128 + cbase), g1 = *(const uint2*)(lds + S_GTR + (mt * 32 + r) * 128 + cbase + 16);
            const uint2 r0 = *(const uint2*)(lds + S_RP + (mt * 32 + r) * 128 + cbase), r1 = *(const uint2*)(lds + S_RP + (mt * 32 + r) * 128 + cbase + 16);
            gimg[im * 64 + lane] = make_uint4(g0.x, g0.y, g1.x, g1.y);
            rimg[im * 64 + lane] = make_uint4(r0.x, r0.y, r1.x, r1.y);
        }
    }
    __syncthreads();
}

DEVINL void phaseB1(KP p, int l, char* lds) {
    const int nb = gridDim.x, blk = BIDX();
    for (int it = blk; it < 512 + 2560; it += nb) {
        if (it < 512) {
            b1_rwkv(p, l, lds, it * 2); b1_rwkv(p, l, lds, it * 2 + 1);
            __threadfence_block(); __syncthreads();
            const int b = it >> 6, c = it & 63;
            for (int h = 0; h < 4; ++h) b1e_unit(p, lds, b, h, c);
        }
        else if (it < 1536) b1_lru(p, l, lds, it - 512);
        else if (it < 2560) b1_conformer(p, l, lds, it - 1536);
        else b1_shortconv(p, l, it - 2560);
    }
}

DEVINL void phaseB2(KP p, int l) {
    const int tid = TIDX(), blk = BIDX();
    if (blk >= 64 && blk < 72) {
        const int bb = blk - 64;
        const float* ca = (const float*)(p->ws + A_CARRYA) + (size_t)bb * 128 * 256 + tid;
        const float* ch = (const float*)(p->ws + A_CARRYH) + (size_t)bb * 128 * 256 + tid;
        float* hst = (float*)(p->ws + A_HSTART) + (size_t)bb * 128 * 256 + tid;
        float hs = 0.f;
#pragma unroll 8
        for (int tt = 0; tt < 128; ++tt) { hst[tt * 256] = hs; hs = fmaf(ca[tt * 256], hs, ch[tt * 256]); }
    }
    if (blk < 64 && tid < 64) {
        const int lane = tid, r = lane & 31, hh = lane >> 5;
        const int bh = blk >> 1, w = blk & 1, b = bh >> 2, h = bh & 3;
        float* yraw = (float*)(p->ws + A_YRAW) + (size_t)b * SEQ * 256 + h * 64 + 32 * w + r;
        f32x16 X0, X1;
#pragma unroll
        for (int i = 0; i < 16; ++i) { X0[i] = 0.f; X1[i] = 0.f; }
        for (int c = 0; c < 64; ++c) {
            const unsigned char* ubase = p->ws + A_CHAIN + (size_t)(bh * 64 + c) * CHAIN_UNIT;
            const uint4* gimg = (const uint4*)ubase; const uint4* rimg = (const uint4*)(ubase + 8192);
            const float4* himg = (const float4*)(ubase + 16384); const float4* yimg = (const float4*)(ubase + 32768);
            uint4 gq[8], rq8[8]; float4 hq[8], yq[8];
#pragma unroll
            for (int i = 0; i < 8; ++i) { gq[i] = gimg[i * 64 + lane]; rq8[i] = rimg[i * 64 + lane]; }
#pragma unroll
            for (int i = 0; i < 8; ++i) { hq[i] = himg[(w * 8 + i) * 64 + lane]; yq[i] = yimg[(w * 8 + i) * 64 + lane]; }
            bf16x8 xp[4];
#pragma unroll
            for (int s2 = 0; s2 < 2; ++s2) {
                uint4 a, bq;
                a.x = pack2(X0[8 * s2 + 0], X0[8 * s2 + 1]); a.y = pack2(X0[8 * s2 + 2], X0[8 * s2 + 3]); a.z = pack2(X0[8 * s2 + 4], X0[8 * s2 + 5]); a.w = pack2(X0[8 * s2 + 6], X0[8 * s2 + 7]);
                bq.x = pack2(X1[8 * s2 + 0], X1[8 * s2 + 1]); bq.y = pack2(X1[8 * s2 + 2], X1[8 * s2 + 3]); bq.z = pack2(X1[8 * s2 + 4], X1[8 * s2 + 5]); bq.w = pack2(X1[8 * s2 + 6], X1[8 * s2 + 7]);
                xp[s2] = __builtin_bit_cast(bf16x8, a); xp[2 + s2] = __builtin_bit_cast(bf16x8, bq);
            }
#pragma unroll
            for (int mt = 0; mt < 2; ++mt) {
                f32x16 acc;
#pragma unroll
                for (int i = 0; i < 4; ++i) { acc[4 * i] = yq[mt * 4 + i].x; acc[4 * i + 1] = yq[mt * 4 + i].y; acc[4 * i + 2] = yq[mt * 4 + i].z; acc[4 * i + 3] = yq[mt * 4 + i].w; }
#pragma unroll
                for (int f = 0; f < 4; ++f) acc = MFMA32(__builtin_bit_cast(bf16x8, rq8[mt * 4 + f]), xp[f], acc);
#pragma unroll
                for (int reg = 0; reg < 16; ++reg) yraw[(size_t)(c * 64 + mt * 32 + crow32(reg, hh)) * 256] = acc[reg];
            }
            f32x16 n0, n1;
#pragma unroll
            for (int i = 0; i < 4; ++i) { n0[4 * i] = hq[i].x; n0[4 * i + 1] = hq[i].y; n0[4 * i + 2] = hq[i].z; n0[4 * i + 3] = hq[i].w;
                                          n1[4 * i] = hq[4 + i].x; n1[4 * i + 1] = hq[4 + i].y; n1[4 * i + 2] = hq[4 + i].z; n1[4 * i + 3] = hq[4 + i].w; }
#pragma unroll
            for (int f = 0; f < 4; ++f) { n0 = MFMA32(__builtin_bit_cast(bf16x8, gq[f]), xp[f], n0); n1 = MFMA32(__builtin_bit_cast(bf16x8, gq[4 + f]), xp[f], n1); }
            X0 = n0; X1 = n1;
        }
    }
}

DEVINL void phaseB3(KP p, int l) {
    const int c = TIDX(), nb = gridDim.x, blk = BIDX();
    const bf16_t* P = (const bf16_t*)(p->ws + A_P);
    bf16_t* ymix = (bf16_t*)(p->ws + A_YMIX);
    const float* yraw = (const float*)(p->ws + A_YRAW); const float* bonus = (const float*)(p->ws + A_BONUS); const float* gbuf = (const float*)(p->ws + A_G);
    const float* hloc = (const float*)(p->ws + A_HLOC); const float* cuma = (const float*)(p->ws + A_CUMA); const float* hst = (const float*)(p->ws + A_HSTART);
    const float gng = p->in[I_GNG][l * 256 + c], gnb = p->in[I_GNB][l * 256 + c];
    for (int it = blk; it < 512; it += nb) {
#pragma unroll 4
        for (int rr = 0; rr < 64; ++rr) {
            const int row = it * 64 + rr, b = row >> 12, tt = (row & 4095) >> 5;
            const size_t o = (size_t)row * 256 + c;
            const float y = yraw[o];
            const float mu = wave_sum(y) * (1.f / 64.f);
            const float d = y - mu;
            const float var = wave_sum(d * d) * (1.f / 64.f);
            const float yn = d * rsqrtf(var + GN_EPS) * gng + gnb;
            ymix[(size_t)row * DM + 512 + c] = f2bf((yn + bonus[o]) * gbuf[o]);
            const float hh = fmaf(cuma[o], hst[(size_t)(b * 128 + tt) * 256 + c], hloc[o]);
            const float gb = bf2f(P[(size_t)row * PIN + 768 + c]);
            ymix[(size_t)row * DM + 256 + c] = f2bf(hh * gelu_tanh(gb));
        }
    }
}

DEVINL void phaseC(KP p, int l, char* lds) {
    const int nb = gridDim.x, blk = BIDX();
    const bf16_t* ymix = (const bf16_t*)(p->ws + A_YMIX);
    const bf16_t* Wt = (const bf16_t*)(p->ws + OFF_WOUT) + (size_t)l * 1024 * 1024;
    const float* res = (l == 0) ? p->in[I_X] : p->out;
    float* xbuf = p->out;
    const float* mod = (const float*)(p->ws + OFF_MOD);
    for (int t = blk; t < 256 * 8; t += nb) {
        const int pn = t & 7, pm = t >> 3;
        auto arow = [&](int R) { return ymix + (size_t)(pm * 128 + R) * DM; };
        auto epi = [&](f32x4 (&acc)[4][4], int wr, int wc, int fr, int fq) {
#pragma unroll
            for (int m = 0; m < 4; ++m) {
                const int row = pm * 128 + wr * 64 + m * 16 + fr, b = row >> 12;
#pragma unroll
                for (int n = 0; n < 4; ++n) {
                    const int col = pn * 128 + wc * 64 + n * 16 + fq * 4;
                    const float4 g1 = *(const float4*)(mod + (size_t)(l * 8 + b) * 6144 + 2048 + col);
                    const float4 rx = *(const float4*)(res + (size_t)row * DM + col);
                    float4 z;
                    z.x = ALPHA * rx.x + (1.f + g1.x) * acc[m][n][0]; z.y = ALPHA * rx.y + (1.f + g1.y) * acc[m][n][1];
                    z.z = ALPHA * rx.z + (1.f + g1.z) * acc[m][n][2]; z.w = ALPHA * rx.w + (1.f + g1.w) * acc[m][n][3];
                    *(float4*)(xbuf + (size_t)row * DM + col) = z;
                }
            }
        };
        gemm_tile128(lds, arow, Wt + (size_t)(pn * 128) * 1024, 1024, epi);
    }
}

DEVINL void phaseD(KP p, int l, char* lds, const int dry = 0) {
    const int tid = TIDX(), nb = gridDim.x, blk = BIDX(), wid = tid >> 6, lane = tid & 63;
    float* ul = (float*)lds;
    int* sel_e = (int*)(lds + 65536);
    int* lpos = (int*)(lds + 65536 + 2048);
    int* hist = (int*)(lds + 65536 + 4096);
    int* basep = (int*)(lds + 65536 + 4096 + 256);
    const float* xbuf = p->out;
    float* xout = dry ? (float*)(p->ws + A_P) : p->out;
    bf16_t* ubuf = (bf16_t*)(p->ws + (dry ? A_YMIX : OFF_UBUF));
    const float* mod = (const float*)(p->ws + OFF_MOD);
    const float* wr = p->in[I_WROUTER] + (size_t)l * 1024 * 64 + lane;
    const float ebias = p->in[I_EBIAS][l * 64 + lane];
    unsigned* cnt = (unsigned*)(p->ws + OFF_CNT) + l * 64 + (dry ? 256 : 0);
    int* list = (int*)(p->ws + (dry ? M_HBUF : M_LIST));
    float* wsel = (float*)(p->ws + (dry ? M_HBUF + 16777216 : M_WSEL));
    for (int it = blk; it < 512; it += nb) {
        const int tok0 = it * 64;
        if (tid < 64) hist[tid] = 0;
        for (int sb = 0; sb < 4; ++sb) {
#pragma unroll
            for (int j = 0; j < 4; ++j) {
                const int tl = wid * 4 + j, row = tok0 + sb * 16 + tl, b = row >> 12;
                float4 z[4];
                float s = 0.f;
#pragma unroll
                for (int i = 0; i < 4; ++i) { z[i] = *(const float4*)(xbuf + (size_t)row * DM + i * 256 + lane * 4); s += z[i].x + z[i].y + z[i].z + z[i].w; }
                const float mean = wave_sum(s) * (1.f / 1024.f);
                float q = 0.f;
#pragma unroll
                for (int i = 0; i < 4; ++i) { z[i].x -= mean; z[i].y -= mean; z[i].z -= mean; z[i].w -= mean; q += z[i].x * z[i].x + z[i].y * z[i].y + z[i].z * z[i].z + z[i].w * z[i].w; }
                const float rs = rsqrtf(wave_sum(q) * (1.f / 1024.f) + LN_EPS);
#pragma unroll
                for (int i = 0; i < 4; ++i) {
                    const int col = i * 256 + lane * 4;
                    const float4 g = *(const float4*)(p->in[I_LN1G] + l * 1024 + col), bb = *(const float4*)(p->in[I_LN1B] + l * 1024 + col);
                    const float4 sh = *(const float4*)(mod + (size_t)(l * 8 + b) * 6144 + 3072 + col), sc = *(const float4*)(mod + (size_t)(l * 8 + b) * 6144 + 4096 + col);
                    float4 x1; x1.x = z[i].x * rs * g.x + bb.x; x1.y = z[i].y * rs * g.y + bb.y; x1.z = z[i].z * rs * g.z + bb.z; x1.w = z[i].w * rs * g.w + bb.w;
                    *(float4*)(xout + (size_t)row * DM + col) = x1;
                    float4 u; u.x = x1.x * (1.f + sc.x) + sh.x; u.y = x1.y * (1.f + sc.y) + sh.y; u.z = x1.z * (1.f + sc.z) + sh.z; u.w = x1.w * (1.f + sc.w) + sh.w;
                    *(float4*)(ul + tl * 1024 + col) = u;
                    uint2 o; o.x = pack2(u.x, u.y); o.y = pack2(u.z, u.w);
                    *(uint2*)(ubuf + (size_t)row * DM + col) = o;
                }
            }
            __syncthreads();
            float acc[4] = {0.f, 0.f, 0.f, 0.f};
            const float* u0 = ul + (wid * 4) * 1024;
#pragma unroll 2
            for (int k = 0; k < 1024; k += 4) {
                const float w0 = wr[(size_t)(k + 0) * 64], w1 = wr[(size_t)(k + 1) * 64], w2 = wr[(size_t)(k + 2) * 64], w3 = wr[(size_t)(k + 3) * 64];
#pragma unroll
                for (int j = 0; j < 4; ++j) {
                    const float4 u4 = *(const float4*)(u0 + j * 1024 + k);
                    acc[j] = fmaf(u4.x, w0, acc[j]); acc[j] = fmaf(u4.y, w1, acc[j]); acc[j] = fmaf(u4.z, w2, acc[j]); acc[j] = fmaf(u4.w, w3, acc[j]);
                }
            }
#pragma unroll
            for (int j = 0; j < 4; ++j) {
                const int tl = sb * 16 + wid * 4 + j;
                const float score = 1.f / (1.f + expf(-acc[j]));
                const float biased = score + ebias;
                float m1 = biased;
                m1 = fmaxf(m1, __shfl_xor(m1, 1)); m1 = fmaxf(m1, __shfl_xor(m1, 2)); m1 = fmaxf(m1, __shfl_xor(m1, 4));
                const unsigned long long eq = __ballot(biased == m1);
                const int g = lane >> 3;
                const unsigned gm = (unsigned)(eq >> (g * 8)) & 0xFFu;
                const int first = __ffs((int)gm) - 1;
                const float v2 = ((lane & 7) == first) ? -INFINITY : biased;
                float m2 = v2;
                m2 = fmaxf(m2, __shfl_xor(m2, 1)); m2 = fmaxf(m2, __shfl_xor(m2, 2)); m2 = fmaxf(m2, __shfl_xor(m2, 4));
                const float gs = m1 + m2;
                int rg = 0;
#pragma unroll
                for (int g2 = 0; g2 < 8; ++g2) { const float o = __builtin_bit_cast(float, __builtin_amdgcn_readlane(__builtin_bit_cast(int, gs), g2 * 8)); rg += ((o > gs) || (o == gs && g2 < g)) ? 1 : 0; }
                const bool keep = rg < 4;
                const float mk = keep ? biased : -INFINITY;
                int rk = 0;
#pragma unroll
                for (int e2 = 0; e2 < 64; ++e2) { const float o = __builtin_bit_cast(float, __builtin_amdgcn_readlane(__builtin_bit_cast(int, mk), e2)); rk += ((o > mk) || (o == mk && e2 < lane)) ? 1 : 0; }
                const bool sel = keep && (rk < 8);
                const float ssum = wave_sum(sel ? score : 0.f);
                const float wgt = score / ssum * 2.5f;
                const unsigned long long sm = __ballot(sel);
                const int kidx = __popcll(sm & ((1ull << lane) - 1ull));
                if (sel) { wsel[(size_t)(tok0 + tl) * 8 + kidx] = wgt; sel_e[tl * 8 + kidx] = lane; }
            }
            __syncthreads();
        }
        for (int i = tid; i < 512; i += NTHREADS) lpos[i] = atomicAdd(&hist[sel_e[i]], 1);
        __syncthreads();
        if (tid < 64) basep[tid] = (int)atomicAdd(&cnt[tid], (unsigned)hist[tid]);
        __syncthreads();
        for (int i = tid; i < 512; i += NTHREADS) { const int e = sel_e[i]; list[(size_t)e * NTOK + basep[e] + lpos[i]] = tok0 * 8 + i; }
        __syncthreads();
    }
}

DEVINL void moe_directory(KP p, int l, char* lds) {
    int* pref = (int*)(lds + 65536);
    int* cntl = (int*)(lds + 65536 + 512);
    if (TIDX() == 0) {
        unsigned* cnt = (unsigned*)(p->ws + OFF_CNT) + l * 64;
        int s = 0;
        for (int e = 0; e < 64; ++e) { const int c = (int)__hip_atomic_load(&cnt[e], __ATOMIC_RELAXED, __HIP_MEMORY_SCOPE_AGENT); cntl[e] = c; pref[e] = s; s += (c + 127) >> 7; }
        pref[64] = s; cntl[64] = NTOK; pref[65] = s + 256;
    }
    __syncthreads();
}

DEVINL void phaseE1(KP p, int l, char* lds) {
    const int nb = gridDim.x, blk = BIDX();
    moe_directory(p, l, lds);
    const int* pref = (const int*)(lds + 65536); const int* cntl = (const int*)(lds + 65536 + 512);
    const bf16_t* ubuf = (const bf16_t*)(p->ws + OFF_UBUF);
    const int* list = (const int*)(p->ws + M_LIST);
    bf16_t* hbuf = (bf16_t*)(p->ws + M_HBUF);
    const int total = pref[65] * 4;
    for (int t = blk; t < total; t += nb) {
        const int mg = t >> 2, nt = t & 3;
        int e = 0; while (pref[e + 1] <= mg) ++e;
        const int mt = mg - pref[e], Me = cntl[e];
        const bf16_t* Wt = (const bf16_t*)(p->ws + OFF_W13) + (size_t)(l * 65 + e) * 512 * 1024 + (size_t)(nt * 128) * 1024;
        auto arow = [&](int R) {
            const int idx = mt * 128 + R; int tok;
            if (e < 64) tok = (idx < Me) ? (list[(size_t)e * NTOK + idx] >> 3) : 0; else tok = idx;
            return ubuf + (size_t)tok * DM;
        };
        auto epi = [&](f32x4 (&acc)[4][4], int wr, int wc, int fr, int fq) {
#pragma unroll
            for (int m = 0; m < 4; ++m) {
                const size_t hrow = (size_t)pref[e] * 128 + mt * 128 + wr * 64 + m * 16 + fr;
#pragma unroll
                for (int q = 0; q < 2; ++q) {
                    const int hcol = nt * 64 + wc * 32 + q * 16 + fq * 4;
                    float hv[4];
#pragma unroll
                    for (int j = 0; j < 4; ++j) { const float gt = acc[m][2 * q][j], up = acc[m][2 * q + 1][j]; hv[j] = gt * sigm(gt) * up; }
                    uint2 o; o.x = pack2(hv[0], hv[1]); o.y = pack2(hv[2], hv[3]);
                    *(uint2*)(hbuf + hrow * 256 + hcol) = o;
                }
            }
        };
        gemm_tile128(lds, arow, Wt, 1024, epi);
    }
}

DEVINL void phaseE2(KP p, int l, char* lds) {
    const int nb = gridDim.x, blk = BIDX();
    moe_directory(p, l, lds);
    const int* pref = (const int*)(lds + 65536); const int* cntl = (const int*)(lds + 65536 + 512);
    const int* list = (const int*)(p->ws + M_LIST);
    const float* wsel = (const float*)(p->ws + M_WSEL);
    const bf16_t* hbuf = (const bf16_t*)(p->ws + M_HBUF);
    bf16_t* ybuf = (bf16_t*)(p->ws + M_YBUF);
    const int total = pref[65] * 8;
    for (int t = blk; t < total; t += nb) {
        const int mg = t >> 3, nt = t & 7;
        int e = 0; while (pref[e + 1] <= mg) ++e;
        const int mt = mg - pref[e], Me = cntl[e];
        const bf16_t* Wt = (const bf16_t*)(p->ws + OFF_W2) + (size_t)(l * 65 + e) * 1024 * 256 + (size_t)(nt * 128) * 256;
        const bf16_t* A0 = hbuf + ((size_t)pref[e] * 128 + mt * 128) * 256;
        auto arow = [&](int R) { return A0 + (size_t)R * 256; };
        auto epi = [&](f32x4 (&acc)[4][4], int wr, int wc, int fr, int fq) {
#pragma unroll
            for (int m = 0; m < 4; ++m) {
                const int idx = mt * 128 + wr * 64 + m * 16 + fr;
                if (idx < Me) {
                    size_t drow; float w;
                    if (e < 64) { const int ts = list[(size_t)e * NTOK + idx]; w = wsel[ts]; drow = (size_t)(ts >> 3) * 9 + (ts & 7); }
                    else { w = 1.f; drow = (size_t)idx * 9 + 8; }
#pragma unroll
                    for (int n = 0; n < 4; ++n) {
                        const int col = nt * 128 + wc * 64 + n * 16 + fq * 4;
                        uint2 o; o.x = pack2(w * acc[m][n][0], w * acc[m][n][1]); o.y = pack2(w * acc[m][n][2], w * acc[m][n][3]);
                        *(uint2*)(ybuf + drow * 1024 + col) = o;
                    }
                }
            }
        };
        gemm_tile128(lds, arow, Wt, 256, epi);
    }
}

DEVINL void phaseF(KP p, int l, const int dry = 0) {
    const int tid = TIDX(), nb = gridDim.x, blk = BIDX(), wid = tid >> 6, lane = tid & 63;
    const float* xbuf = p->out;
    float* xout = dry ? (float*)(p->ws + M_HBUF) : p->out;
    const bf16_t* ybuf = (const bf16_t*)(p->ws + M_YBUF);
    bf16_t* ubuf = (bf16_t*)(p->ws + OFF_UBUF);
    const float* mod = (const float*)(p->ws + OFF_MOD);
    for (int row = blk * 4 + wid; row < NTOK; row += nb * 4) {
        const int b = row >> 12;
        float4 z[4]; float s = 0.f;
#pragma unroll
        for (int i = 0; i < 4; ++i) {
            const int col = i * 256 + lane * 4;
            const float4 x1 = *(const float4*)(xbuf + (size_t)row * DM + col);
            float f0 = 0.f, f1 = 0.f, f2 = 0.f, f3 = 0.f;
#pragma unroll
            for (int k = 0; k < 9; ++k) {
                const uint2 yv = *(const uint2*)(ybuf + ((size_t)row * 9 + k) * 1024 + col);
                f0 += __uint_as_float(yv.x << 16); f1 += __uint_as_float(yv.x & 0xFFFF0000u); f2 += __uint_as_float(yv.y << 16); f3 += __uint_as_float(yv.y & 0xFFFF0000u);
            }
            const float4 g2 = *(const float4*)(mod + (size_t)(l * 8 + b) * 6144 + 5120 + col);
            z[i].x = ALPHA * x1.x + (1.f + g2.x) * f0; z[i].y = ALPHA * x1.y + (1.f + g2.y) * f1; z[i].z = ALPHA * x1.z + (1.f + g2.z) * f2; z[i].w = ALPHA * x1.w + (1.f + g2.w) * f3;
            s += z[i].x + z[i].y + z[i].z + z[i].w;
        }
        const float mean = wave_sum(s) * (1.f / 1024.f);
        float q = 0.f;
#pragma unroll
        for (int i = 0; i < 4; ++i) { z[i].x -= mean; z[i].y -= mean; z[i].z -= mean; z[i].w -= mean; q += z[i].x * z[i].x + z[i].y * z[i].y + z[i].z * z[i].z + z[i].w * z[i].w; }
        const float rs = rsqrtf(wave_sum(q) * (1.f / 1024.f) + LN_EPS);
#pragma unroll
        for (int i = 0; i < 4; ++i) {
            const int col = i * 256 + lane * 4;
            const float4 g = *(const float4*)(p->in[I_LN2G] + l * 1024 + col), bb = *(const float4*)(p->in[I_LN2B] + l * 1024 + col);
            float4 x2; x2.x = z[i].x * rs * g.x + bb.x; x2.y = z[i].y * rs * g.y + bb.y; x2.z = z[i].z * rs * g.z + bb.z; x2.w = z[i].w * rs * g.w + bb.w;
            *(float4*)(xout + (size_t)row * DM + col) = x2;
            if (l + 1 < DEPTH) {
                const float4 sh = *(const float4*)(mod + (size_t)((l + 1) * 8 + b) * 6144 + col), sc = *(const float4*)(mod + (size_t)((l + 1) * 8 + b) * 6144 + 1024 + col);
                uint2 o; o.x = pack2(x2.x * (1.f + sc.x) + sh.x, x2.y * (1.f + sc.y) + sh.y); o.y = pack2(x2.z * (1.f + sc.z) + sh.z, x2.w * (1.f + sc.w) + sh.w);
                *(uint2*)(ubuf + (size_t)row * DM + col) = o;
            }
        }
    }
}

#define XB_TMO      128
#define XB_XCNT(j)  (256  + 64 * (j))
#define XB_XSUB(j)  (1280 + 64 * (j))
#define XB_XGEN(j)  (2304 + 64 * (j))
#define XB_TOP      3328
#define XB_TOPGEN   3392
#define XCD_BAR_WORDS 3456
#define XB_SPIN_CAP (1u << 20)
#define LAS __attribute__((address_space(3)))
DEVINL unsigned xb_ld(unsigned* p)              { return __hip_atomic_load(p, __ATOMIC_RELAXED, __HIP_MEMORY_SCOPE_AGENT); }
DEVINL unsigned xb_add(unsigned* p, unsigned v) { return __hip_atomic_fetch_add(p, v, __ATOMIC_RELAXED, __HIP_MEMORY_SCOPE_AGENT); }
DEVINL unsigned xb_xcc_id() { return (unsigned)__builtin_amdgcn_s_getreg((3 << 11) | 20) & 0xFu; }
#define XB_SPIN(cond, bar) do { unsigned _sp = 0; while (cond) { __builtin_amdgcn_s_sleep(1); \
    if ((++_sp & 255u) == 0u) { if (xb_ld(&(bar)[XB_TMO])) break; if (_sp > XB_SPIN_CAP) { atomicAdd(&(bar)[XB_TMO], 1u); break; } } } } while (0)
struct XcdBarrier { unsigned* bar; unsigned x; volatile LAS unsigned* st; };
DEVINL XcdBarrier xcd_barrier_post(unsigned* bar, volatile LAS unsigned* st) {
    XcdBarrier b; b.bar = bar; b.x = xb_xcc_id(); b.st = st;
    if (threadIdx.x == 0) (void)xb_add(&bar[XB_XCNT(b.x)], 1u);
    return b;
}
DEVINL void xcd_barrier_complete(unsigned* bar, unsigned x, unsigned& nloc, unsigned& nx) {
    const unsigned G = gridDim.x * gridDim.y * gridDim.z;
    unsigned sum, cnt, mine, sp = 0u;
    for (;;) {
        sum = 0u; cnt = 0u; mine = 0u;
#pragma unroll
        for (unsigned j = 0; j < 16; ++j) { const unsigned c = xb_ld(&bar[XB_XCNT(j)]); sum += c; cnt += (c > 0u) ? 1u : 0u; mine = (j == x) ? c : mine; }
        if (sum == G) break;
        __builtin_amdgcn_s_sleep(1);
        if ((++sp & 255u) == 0u) { if (xb_ld(&bar[XB_TMO])) break; if (sp > XB_SPIN_CAP) { atomicAdd(&bar[XB_TMO], 1u); break; } }
    }
    nloc = mine > 0u ? mine : 1u; nx = cnt > 0u ? cnt : 1u;
}
DEVINL void xcd_barrier(const XcdBarrier& b) {
    asm volatile("s_waitcnt vmcnt(0)" ::: "memory");
    __syncthreads();
    if (threadIdx.x == 0) {
        unsigned* bar = b.bar;
        __builtin_amdgcn_s_waitcnt(0);
        unsigned nloc = b.st[0], nx = b.st[1];
        if (nloc == 0u) { xcd_barrier_complete(bar, b.x, nloc, nx); b.st[0] = nloc; b.st[1] = nx; }
        const unsigned old = xb_add(&bar[XB_XSUB(b.x)], 1u);
        const unsigned gen = old / nloc;
        if (old + 1u == (gen + 1u) * nloc) {
            __builtin_amdgcn_fence(__ATOMIC_RELEASE, "agent");
            asm volatile("s_waitcnt vmcnt(0)" ::: "memory");
            const unsigned og = xb_add(&bar[XB_TOP], 1u);
            const unsigned tg = og / nx;
            if (og + 1u == (tg + 1u) * nx) xb_add(&bar[XB_TOPGEN], 1u);
            else XB_SPIN(xb_ld(&bar[XB_TOPGEN]) == tg, bar);
            __builtin_amdgcn_fence(__ATOMIC_ACQUIRE, "agent");
            xb_add(&bar[XB_XGEN(b.x)], 1u);
            asm volatile("s_waitcnt vmcnt(0)" ::: "memory");
        } else {
            XB_SPIN(xb_ld(&bar[XB_XGEN(b.x)]) == gen, bar);
            __builtin_amdgcn_fence(__ATOMIC_ACQUIRE, "agent");
            asm volatile("s_waitcnt vmcnt(0)" ::: "memory");
        }
    }
    __syncthreads();
}

constexpr int NPHASE = 2 + 9 * DEPTH;
#ifndef PROBE_REP
#define PROBE_REP (-1)
#endif
__global__ void __launch_bounds__(NTHREADS, 2) mega(Params p_arg, int ph_lo, int ph_hi) {
    extern __shared__ __attribute__((aligned(16))) char lds[];
    cg::grid_group grid = cg::this_grid();
    volatile LAS unsigned* st = (volatile LAS unsigned*)(lds + LDS_BYTES - 16);
    if (threadIdx.x == 0) { st[0] = 0u; st[1] = 0u; }
    __syncthreads();
    XcdBarrier xb = xcd_barrier_post((unsigned*)(p_arg.ws + OFF_BAR), st);
    for (int ph = ph_lo; ph < ph_hi; ++ph) {
        KP p = (KP)__builtin_amdgcn_kernarg_segment_ptr();
        asm volatile("" : "+s"(p));
        const int l = (ph >= 2) ? (ph - 2) / 9 : 0;
        const int q = (ph >= 2) ? (ph - 2) % 9 : -1;
        for (int rep = 0; rep < ((ph == PROBE_REP) ? 2 : 1); ++rep) {
            if (ph == 0) phase0(p, lds);
            else if (ph == 1) phaseF0(p);
            else {
                switch (q) {
                    case 0: phaseA(p, l, lds); break;
                    case 1: phaseB1(p, l, lds); break;
                    case 2: phaseB2(p, l); break;
                    case 3: phaseB3(p, l); break;
                    case 4: phaseC(p, l, lds); break;
                    case 5: phaseD(p, l, lds, (ph == PROBE_REP && rep == 0) ? 1 : 0); break;
                    case 6: phaseE1(p, l, lds); break;
                    case 7: phaseE2(p, l, lds); break;
                    default: phaseF(p, l, (ph == PROBE_REP && rep == 0) ? 1 : 0); break;
                }
            }
            if (rep == 0 && ph == PROBE_REP) xcd_barrier(xb);
        }
        if (ph + 1 < ph_hi) { if (ph == ph_lo) grid.sync(); else xcd_barrier(xb); }
    }
}

extern "C" void kernel_launch(void* const* d_in, const int* in_sizes, int n_in, void* d_out, int out_size, void* d_ws, size_t ws_size, hipStream_t stream) {
    static int grid_blocks = 0;
    if (grid_blocks == 0) {
        if (n_in != 39 || out_size != NTOK * DM || ws_size < WS_NEED) { fprintf(stderr, "kernel_launch: unexpected shapes (n_in %d out %d ws %zu need %zu)\n", n_in, out_size, ws_size, (size_t)WS_NEED); grid_blocks = -1; return; }
        int dev = 0, cus = 0, per_cu = 0;
        hipGetDevice(&dev);
        hipDeviceGetAttribute(&cus, hipDeviceAttributeMultiprocessorCount, dev);
        hipFuncSetAttribute((const void*)mega, hipFuncAttributeMaxDynamicSharedMemorySize, LDS_BYTES);
        hipOccupancyMaxActiveBlocksPerMultiprocessor(&per_cu, (const void*)mega, NTHREADS, LDS_BYTES);
        if (per_cu < 1) { fprintf(stderr, "kernel_launch: occupancy query returned %d\n", per_cu); grid_blocks = -1; return; }
        if (per_cu > 2) per_cu = 2;
        grid_blocks = cus * per_cu;
    }
    if (grid_blocks < 0) return;
    if (hipMemsetAsync(d_ws, 0, 32768, stream) != hipSuccess) { fprintf(stderr, "kernel_launch: memset failed\n"); return; }
    Params p{};
    for (int i = 0; i < 39; ++i) p.in[i] = (const float*)d_in[i];
    p.out = (float*)d_out; p.ws = (unsigned char*)d_ws;
    int ph_lo = 0, ph_hi = NPHASE;
    void* args[] = {&p, &ph_lo, &ph_hi};
    hipError_t e = hipLaunchCooperativeKernel((const void*)mega, dim3(grid_blocks), dim3(NTHREADS), args, LDS_BYTES, stream);
    if (e != hipSuccess) fprintf(stderr, "cooperative launch failed: %s (grid %d)\n", hipGetErrorString(e), grid_blocks);
}
```

```cpp
#include <hip/hip_runtime.h>
#include <hip/hip_cooperative_groups.h>
#include <stdio.h>
#include <stdint.h>
namespace cg = cooperative_groups;

typedef unsigned short bf16_t;
typedef short bf16x8 __attribute__((ext_vector_type(8)));
typedef float f32x4 __attribute__((ext_vector_type(4)));
#define DEVINL __device__ __forceinline__

constexpr int NTOK = 32768, SEQ = 4096, NBATCH = 8, DM = 1024, PIN = 2688, DEPTH = 2;
constexpr int NEXP = 64;
constexpr float ALPHA = 1.41421356237f;
constexpr float LN_EPS = 1e-5f, GN_EPS = 64e-5f;
constexpr int NTHREADS = 256;
constexpr int LDS_BYTES = 77824;

constexpr size_t OFF_CNT   = 0;
constexpr size_t OFF_BAR   = 4096;
constexpr size_t OFF_MOD   = 65536;
constexpr size_t OFF_WIN   = 1048576;
constexpr size_t OFF_WOUT  = OFF_WIN + 11010048;
constexpr size_t OFF_W13   = OFF_WOUT + 4194304;
constexpr size_t OFF_W2    = OFF_W13 + 136314880;
constexpr size_t OFF_UBUF  = OFF_W2 + 68157440;
constexpr size_t OFF_ARENA = OFF_UBUF + 67108864;
constexpr size_t A_P      = OFF_ARENA;
constexpr size_t A_YMIX   = A_P + 176160768;
constexpr size_t A_SCAN   = A_YMIX + 67108864;
constexpr size_t A_HLOC   = A_SCAN + 134217728;
constexpr size_t A_CUMA   = A_HLOC + 33554432;
constexpr size_t A_G      = A_CUMA + 33554432;
constexpr size_t A_BONUS  = A_G + 33554432;
constexpr size_t A_YRAW   = A_BONUS + 33554432;
constexpr size_t A_CARRYA = A_YRAW + 33554432;
constexpr size_t A_CARRYH = A_CARRYA + 1048576;
constexpr size_t A_HSTART = A_CARRYH + 1048576;
constexpr size_t A_CHAIN  = A_HSTART + 1048576;
constexpr size_t CHAIN_UNIT = 49152;
constexpr size_t M_YBUF   = OFF_ARENA;
constexpr size_t M_HBUF   = M_YBUF + 603979776;
constexpr size_t M_LIST   = M_HBUF + 155189248;
constexpr size_t M_WSEL   = M_LIST + 8388608;
constexpr size_t WS_NEED  = M_WSEL + 1048576;

struct Params {
    const float* in[39];
    float* out;
    unsigned char* ws;
};
typedef const __attribute__((address_space(4))) Params* KP;
__device__ __forceinline__ int TIDX() { int t = threadIdx.x; asm volatile("" : "+v"(t)); __builtin_assume(t >= 0 && t < 256); return t; }
__device__ __forceinline__ int BIDX() { int b = blockIdx.x; asm volatile("" : "+s"(b)); __builtin_assume(b >= 0 && b < 65536); return b; }
enum { I_X = 0, I_C, I_WMOD, I_BMOD, I_WIN, I_WOUT, I_CONVA, I_CONVAB, I_LNAG, I_LNAB, I_CONVB, I_CONVBB, I_WRG, I_BRG, I_WIG, I_BIG,
       I_LAMBDA, I_MUC, I_W0, I_WW2, I_A0, I_WA2, I_WG2, I_KK, I_KA, I_RK, I_GNG, I_GNB, I_CONVD, I_LN1G, I_LN1B, I_WROUTER, I_EBIAS,
       I_W13, I_W2, I_WS13, I_WS2, I_LN2G, I_LN2B };

DEVINL bf16_t f2bf(float f) { unsigned u = __float_as_uint(f); u += 0x7FFFu + ((u >> 16) & 1u); return (bf16_t)(u >> 16); }
DEVINL float bf2f(bf16_t h) { return __uint_as_float(((unsigned)h) << 16); }
typedef __bf16 bf2_t __attribute__((ext_vector_type(2)));
typedef float f2_t __attribute__((ext_vector_type(2)));
typedef float f32x16 __attribute__((ext_vector_type(16)));
DEVINL unsigned pack2(float a, float b) { f2_t v = {a, b}; return __builtin_bit_cast(unsigned, __builtin_convertvector(v, bf2_t)); }
DEVINL float sigm(float x) { return 1.f / (1.f + __expf(-x)); }
DEVINL float softplusf(float z) { return fmaxf(z, 0.f) + log1pf(__expf(-fabsf(z))); }
DEVINL float gelu_tanh(float x) { float u = 0.7978845608028654f * (x + 0.044715f * x * x * x); return 0.5f * x * (1.f + tanhf(u)); }
DEVINL float wave_sum(float x) {
#pragma unroll
    for (int o = 32; o > 0; o >>= 1) x += __shfl_xor(x, o);
    return x;
}
DEVINL float dppf(float x, const int ctrl_unused) { return x; }
DEVINL float wave_sum_dpp(float x) {
    x += __builtin_bit_cast(float, __builtin_amdgcn_update_dpp(0, __builtin_bit_cast(int, x), 0xB1, 0xf, 0xf, true));
    x += __builtin_bit_cast(float, __builtin_amdgcn_update_dpp(0, __builtin_bit_cast(int, x), 0x4E, 0xf, 0xf, true));
    x += __builtin_bit_cast(float, __builtin_amdgcn_update_dpp(0, __builtin_bit_cast(int, x), 0x141, 0xf, 0xf, true));
    x += __builtin_bit_cast(float, __builtin_amdgcn_update_dpp(0, __builtin_bit_cast(int, x), 0x140, 0xf, 0xf, true));
    x += __builtin_bit_cast(float, __builtin_amdgcn_update_dpp(0, __builtin_bit_cast(int, x), 0x142, 0xa, 0xf, false));
    x += __builtin_bit_cast(float, __builtin_amdgcn_update_dpp(0, __builtin_bit_cast(int, x), 0x143, 0xc, 0xf, false));
    return __builtin_bit_cast(float, __builtin_amdgcn_readlane(__builtin_bit_cast(int, x), 63));
}

DEVINL int lds_byte(int r, int c) { int st = (r >> 4) * 2 + (c >> 5), rr = r & 15, cc = c & 31, ob = rr * 64 + cc * 2; return st * 1024 + (ob ^ (((ob >> 9) & 1) << 5)); }
DEVINL void stage_rc(int b, int& R, int& C) { int st = b / 1024, sb = b % 1024, swz = sb ^ (((sb >> 9) & 1) << 5); R = (st >> 1) * 16 + swz / 64; C = (st & 1) * 32 + (swz % 64) / 2; }

template <class RowPtr, class Epi>
DEVINL void gemm_tile128(char* lds, RowPtr arow, const bf16_t* Bt, int K, Epi epi) {
    const int tid = TIDX();
    const bf16_t* ap[4]; const bf16_t* bp[4];
#pragma unroll
    for (int i = 0; i < 4; ++i) { int R, C; stage_rc(tid * 16 + i * 4096, R, C); ap[i] = arow(R) + C; bp[i] = Bt + (size_t)R * K + C; }
    const int wid = tid >> 6, lane = tid & 63, wr = wid >> 1, wc = wid & 1, fr = lane & 15, fq = lane >> 4;
    f32x4 acc[4][4];
#pragma unroll
    for (int m = 0; m < 4; ++m)
#pragma unroll
        for (int n = 0; n < 4; ++n) acc[m][n] = (f32x4){0.f, 0.f, 0.f, 0.f};
    const int nk = K >> 6;
#pragma unroll
    for (int i = 0; i < 4; ++i) {
        __builtin_amdgcn_global_load_lds((const unsigned*)(ap[i]), (unsigned*)(lds + tid * 16 + i * 4096), 16, 0, 0);
        __builtin_amdgcn_global_load_lds((const unsigned*)(bp[i]), (unsigned*)(lds + 16384 + tid * 16 + i * 4096), 16, 0, 0);
    }
    for (int kt = 0; kt < nk; ++kt) {
        asm volatile("s_waitcnt vmcnt(0)" ::: "memory");
        __syncthreads();
        char* cur = lds + (kt & 1) * 32768;
        if (kt + 1 < nk) {
            char* nxt = lds + ((kt + 1) & 1) * 32768;
            const int ko = (kt + 1) * 64;
#pragma unroll
            for (int i = 0; i < 4; ++i) {
                __builtin_amdgcn_global_load_lds((const unsigned*)(ap[i] + ko), (unsigned*)(nxt + tid * 16 + i * 4096), 16, 0, 0);
                __builtin_amdgcn_global_load_lds((const unsigned*)(bp[i] + ko), (unsigned*)(nxt + 16384 + tid * 16 + i * 4096), 16, 0, 0);
            }
        }
        bf16x8 af[4][2], bfr[4][2];
#pragma unroll
        for (int m = 0; m < 4; ++m)
#pragma unroll
            for (int kk = 0; kk < 2; ++kk) af[m][kk] = *reinterpret_cast<const bf16x8*>(cur + lds_byte(wr * 64 + m * 16 + fr, kk * 32 + fq * 8));
#pragma unroll
        for (int n = 0; n < 4; ++n)
#pragma unroll
            for (int kk = 0; kk < 2; ++kk) bfr[n][kk] = *reinterpret_cast<const bf16x8*>(cur + 16384 + lds_byte(wc * 64 + n * 16 + fr, kk * 32 + fq * 8));
#pragma unroll
        for (int kk = 0; kk < 2; ++kk)
#pragma unroll
            for (int m = 0; m < 4; ++m)
#pragma unroll
                for (int n = 0; n < 4; ++n) acc[m][n] = __builtin_amdgcn_mfma_f32_16x16x32_bf16(bfr[n][kk], af[m][kk], acc[m][n], 0, 0, 0);
    }
    __syncthreads();
    epi(acc, wr, wc, fr, fq);
}

template <class Ptrs, class Epi>
DEVINL void gemm_stream128(char* lds, int K, int blk, int nb, int total, Ptrs ptrs, Epi epi) {
    const int qx = nb >> 3, first = (blk & 7) * qx + (blk >> 3), stride = nb;
    if (first >= total) return;
    const int tid = TIDX();
    const int wid = tid >> 6, lane = tid & 63, wr = wid >> 1, wc = wid & 1, fr = lane & 15, fq = lane >> 4;
    const int nk = K >> 6;
    const bf16_t* ap[4]; const bf16_t* bp[4];
    const bf16_t* an[4]; const bf16_t* bn[4];
    int t = first;
    ptrs(t, ap, bp);
#pragma unroll
    for (int i = 0; i < 4; ++i) {
        __builtin_amdgcn_global_load_lds((const unsigned*)(ap[i]), (unsigned*)(lds + tid * 16 + i * 4096), 16, 0, 0);
        __builtin_amdgcn_global_load_lds((const unsigned*)(bp[i]), (unsigned*)(lds + 16384 + tid * 16 + i * 4096), 16, 0, 0);
    }
    for (;;) {
        const int tn = t + stride;
        const bool has_next = tn < total;
        if (has_next) ptrs(tn, an, bn);
        f32x4 acc[4][4];
#pragma unroll
        for (int m = 0; m < 4; ++m)
#pragma unroll
            for (int n = 0; n < 4; ++n) acc[m][n] = (f32x4){0.f, 0.f, 0.f, 0.f};
        for (int kt = 0; kt < nk; ++kt) {
            asm volatile("s_waitcnt vmcnt(0)" ::: "memory");
            __syncthreads();
            char* cur = lds + (kt & 1) * 32768;
            if (kt + 1 < nk) {
                char* nxt = lds + ((kt + 1) & 1) * 32768;
                const int ko = (kt + 1) * 64;
#pragma unroll
                for (int i = 0; i < 4; ++i) {
                    __builtin_amdgcn_global_load_lds((const unsigned*)(ap[i] + ko), (unsigned*)(nxt + tid * 16 + i * 4096), 16, 0, 0);
                    __builtin_amdgcn_global_load_lds((const unsigned*)(bp[i] + ko), (unsigned*)(nxt + 16384 + tid * 16 + i * 4096), 16, 0, 0);
                }
            } else if (has_next) {
#pragma unroll
                for (int i = 0; i < 4; ++i) {
                    __builtin_amdgcn_global_load_lds((const unsigned*)(an[i]), (unsigned*)(lds + tid * 16 + i * 4096), 16, 0, 0);
                    __builtin_amdgcn_global_load_lds((const unsigned*)(bn[i]), (unsigned*)(lds + 16384 + tid * 16 + i * 4096), 16, 0, 0);
                }
            }
            bf16x8 af[4][2], bfr[4][2];
#pragma unroll
            for (int m = 0; m < 4; ++m)
#pragma unroll
                for (int kk = 0; kk < 2; ++kk) af[m][kk] = *reinterpret_cast<const bf16x8*>(cur + lds_byte(wr * 64 + m * 16 + fr, kk * 32 + fq * 8));
#pragma unroll
            for (int n = 0; n < 4; ++n)
#pragma unroll
                for (int kk = 0; kk < 2; ++kk) bfr[n][kk] = *reinterpret_cast<const bf16x8*>(cur + 16384 + lds_byte(wc * 64 + n * 16 + fr, kk * 32 + fq * 8));
#pragma unroll
            for (int kk = 0; kk < 2; ++kk)
#pragma unroll
                for (int m = 0; m < 4; ++m)
#pragma unroll
                    for (int n = 0; n < 4; ++n) acc[m][n] = __builtin_amdgcn_mfma_f32_16x16x32_bf16(bfr[n][kk], af[m][kk], acc[m][n], 0, 0, 0);
        }
        epi(t, acc, wr, wc, fr, fq);
        if (!has_next) break;
        t = tn;
#pragma unroll
        for (int i = 0; i < 4; ++i) { ap[i] = an[i]; bp[i] = bn[i]; }
    }
    __syncthreads();
}
DEVINL void stage_coords(int (&R)[4], int (&C)[4]) {
    const int tid = TIDX();
#pragma unroll
    for (int i = 0; i < 4; ++i) stage_rc(tid * 16 + i * 4096, R[i], C[i]);
}

DEVINL void phase0(KP p, char* lds) {
    const int tid = TIDX(), nb = gridDim.x, blk = BIDX();
    if (blk == 0 && tid < 128) ((unsigned*)(p->ws + OFF_CNT))[tid] = 0u;
    if (blk < 192) {
        float* sc = (float*)lds;
        float* part = (float*)(lds + 32768);
        for (int i = tid; i < 8192; i += NTHREADS) { float c = p->in[I_C][i]; sc[i] = c * sigm(c); }
        __syncthreads();
        const int cl = tid & 63, ks = tid >> 6, n = blk * 64 + cl, l = n / 6144, nn = n % 6144;
        const float* w = p->in[I_WMOD] + (size_t)l * 1024 * 6144 + (size_t)(ks * 256) * 6144 + nn;
        float acc[8];
#pragma unroll
        for (int b = 0; b < 8; ++b) acc[b] = 0.f;
#pragma unroll 16
        for (int k = 0; k < 256; ++k) {
            const float wv = w[(size_t)k * 6144];
#pragma unroll
            for (int b = 0; b < 8; ++b) acc[b] = fmaf(sc[b * 1024 + ks * 256 + k], wv, acc[b]);
        }
#pragma unroll
        for (int b = 0; b < 8; ++b) part[(ks * 8 + b) * 64 + cl] = acc[b];
        __syncthreads();
        if (tid < 64) {
            const float bm = p->in[I_BMOD][l * 6144 + nn];
            float* mod = (float*)(p->ws + OFF_MOD);
#pragma unroll
            for (int b = 0; b < 8; ++b) mod[(size_t)(l * 8 + b) * 6144 + nn] = part[(0 * 8 + b) * 64 + cl] + part[(1 * 8 + b) * 64 + cl] + part[(2 * 8 + b) * 64 + cl] + part[(3 * 8 + b) * 64 + cl] + bm;
        }
        __syncthreads();
    }
    float* tile = (float*)lds;
    const int PER_L = 672 + 256 + 8320 + 4160;
    for (int id = blk; id < 2 * PER_L; id += nb) {
        const int l = id / PER_L; int r = id % PER_L;
        const float* src; bf16_t* dst; int K, ld, perm, kt, nt;
        if (r < 672) { src = p->in[I_WIN] + (size_t)l * 1024 * 2688; K = 1024; ld = 2688; perm = 0; dst = (bf16_t*)(p->ws + OFF_WIN) + (size_t)l * 2688 * 1024; kt = r & 15; nt = r >> 4; }
        else if (r < 928) { r -= 672; src = p->in[I_WOUT] + (size_t)l * 1024 * 1024; K = 1024; ld = 1024; perm = 0; dst = (bf16_t*)(p->ws + OFF_WOUT) + (size_t)l * 1024 * 1024; kt = r & 15; nt = r >> 4; }
        else if (r < 928 + 8320) { r -= 928; const int e = r >> 7, q = r & 127; kt = q & 15; nt = q >> 4; K = 1024; ld = 512; perm = 1;
            src = (e < 64) ? p->in[I_W13] + (size_t)(l * 64 + e) * 1024 * 512 : p->in[I_WS13] + (size_t)l * 1024 * 512;
            dst = (bf16_t*)(p->ws + OFF_W13) + (size_t)(l * 65 + e) * 512 * 1024; }
        else { r -= 9248; const int e = r >> 6, q = r & 63; kt = q & 3; nt = q >> 2; K = 256; ld = 1024; perm = 0;
            src = (e < 64) ? p->in[I_W2] + (size_t)(l * 64 + e) * 256 * 1024 : p->in[I_WS2] + (size_t)l * 256 * 1024;
            dst = (bf16_t*)(p->ws + OFF_W2) + (size_t)(l * 65 + e) * 1024 * 256; }
        const int k0 = kt * 64, r0 = nt * 64;
        {
            const int nn = tid & 63; const int drow = r0 + nn;
            int scol = drow;
            if (perm) { const int g = drow >> 5, i = drow & 31; scol = (i < 16) ? (g * 16 + i) : (256 + g * 16 + (i - 16)); }
#pragma unroll
            for (int j = 0; j < 16; ++j) { const int kk = (tid >> 6) + 4 * j; tile[kk * 65 + nn] = src[(size_t)(k0 + kk) * ld + scol]; }
        }
        __syncthreads();
        {
            const int kp = (tid & 31) * 2;
#pragma unroll
            for (int j = 0; j < 8; ++j) { const int rr = (tid >> 5) + 8 * j;
                *(unsigned*)(dst + (size_t)(r0 + rr) * K + k0 + kp) = pack2(tile[kp * 65 + rr], tile[(kp + 1) * 65 + rr]); }
        }
        __syncthreads();
    }
}

DEVINL void phaseF0(KP p) {
    const int tid = TIDX(), nb = gridDim.x, blk = BIDX();
    const float* mod = (const float*)(p->ws + OFF_MOD);
    bf16_t* ubuf = (bf16_t*)(p->ws + OFF_UBUF);
    for (int row = blk; row < NTOK; row += nb) {
        const int b = row >> 12, col = tid * 4;
        const float4 x = *(const float4*)(p->in[I_X] + (size_t)row * DM + col);
        const float4 sh = *(const float4*)(mod + (size_t)b * 6144 + col);
        const float4 sc = *(const float4*)(mod + (size_t)b * 6144 + 1024 + col);
        uint2 o; o.x = pack2(x.x * (1.f + sc.x) + sh.x, x.y * (1.f + sc.y) + sh.y); o.y = pack2(x.z * (1.f + sc.z) + sh.z, x.w * (1.f + sc.w) + sh.w);
        *(uint2*)(ubuf + (size_t)row * DM + col) = o;
    }
}

DEVINL void phaseA(KP p, int l, char* lds) {
    const int nb = gridDim.x, blk = BIDX();
    const bf16_t* ubuf = (const bf16_t*)(p->ws + OFF_UBUF);
    const bf16_t* Wt = (const bf16_t*)(p->ws + OFF_WIN) + (size_t)l * 2688 * 1024;
    bf16_t* P = (bf16_t*)(p->ws + A_P);
    int R[4], C[4]; stage_coords(R, C);
    auto ptrs = [&](int t, const bf16_t* (&ap)[4], const bf16_t* (&bp)[4]) {
        const int sx = t / 1792, rem = t - sx * 1792, pm = rem / 7, pn = sx * 7 + (rem - pm * 7);
#pragma unroll
        for (int i = 0; i < 4; ++i) { ap[i] = ubuf + (size_t)(pm * 128 + R[i]) * DM + C[i]; bp[i] = Wt + (size_t)(pn * 128 + R[i]) * 1024 + C[i]; }
    };
    auto epi = [&](int t, f32x4 (&acc)[4][4], int wr, int wc, int fr, int fq) {
        const int sx = t / 1792, rem = t - sx * 1792, pm = rem / 7, pn = sx * 7 + (rem - pm * 7);
#pragma unroll
        for (int m = 0; m < 4; ++m) {
            const int row = pm * 128 + wr * 64 + m * 16 + fr;
#pragma unroll
            for (int n = 0; n < 4; ++n) {
                const int col = pn * 128 + wc * 64 + n * 16 + fq * 4;
                uint2 o; o.x = pack2(acc[m][n][0], acc[m][n][1]); o.y = pack2(acc[m][n][2], acc[m][n][3]);
                *(uint2*)(P + (size_t)row * PIN + col) = o;
            }
        }
    };
    gemm_stream128(lds, 1024, blk, nb, 256 * 21, ptrs, epi);
}

DEVINL void b1_conformer(KP p, int l, char* lds, int item) {
    const int tid = TIDX(), b = item >> 7, tt = item & 127, t0 = tt * 32, rowbase = b * SEQ;
    const bf16_t* P = (const bf16_t*)(p->ws + A_P);
    bf16_t* ymix = (bf16_t*)(p->ws + A_YMIX);
    float w[31];
#pragma unroll
    for (int k = 0; k < 31; ++k) w[k] = p->in[I_CONVA][(size_t)(l * 31 + k) * 256 + tid];
    float acc[32];
    const float bias = p->in[I_CONVAB][l * 256 + tid];
#pragma unroll
    for (int j = 0; j < 32; ++j) acc[j] = bias;
#pragma unroll
    for (int rr = 0; rr < 62; ++rr) {
        const int t = t0 - 30 + rr;
        const bf16_t* pr = P + ((long)(rowbase + t0 - 30) * PIN + tid) + (long)rr * PIN;
        const float val = bf2f(pr[0]), gate = bf2f(pr[256]);
        const float h = (t >= 0) ? val * sigm(gate) : 0.f;
#pragma unroll
        for (int j = 0; j < 32; ++j) { const int k = rr - j; if (k >= 0 && k <= 30) acc[j] = fmaf(w[k], h, acc[j]); }
    }
    float* outb = (float*)lds;
#pragma unroll
    for (int j = 0; j < 32; ++j) outb[j * 256 + tid] = acc[j];
    __syncthreads();
    const int wid = tid >> 6, lane = tid & 63;
    const float4 g4 = *(const float4*)(p->in[I_LNAG] + l * 256 + lane * 4), b4 = *(const float4*)(p->in[I_LNAB] + l * 256 + lane * 4);
    for (int j = wid; j < 32; j += 4) {
        const float4 v = *(const float4*)(outb + j * 256 + lane * 4);
        const float mean = wave_sum(v.x + v.y + v.z + v.w) * (1.f / 256.f);
        const float d0 = v.x - mean, d1 = v.y - mean, d2 = v.z - mean, d3 = v.w - mean;
        const float var = wave_sum(d0 * d0 + d1 * d1 + d2 * d2 + d3 * d3) * (1.f / 256.f);
        const float rs = rsqrtf(var + LN_EPS);
        float y0 = d0 * rs * g4.x + b4.x, y1 = d1 * rs * g4.y + b4.y, y2 = d2 * rs * g4.z + b4.z, y3 = d3 * rs * g4.w + b4.w;
        y0 *= sigm(y0); y1 *= sigm(y1); y2 *= sigm(y2); y3 *= sigm(y3);
        uint2 o; o.x = pack2(y0, y1); o.y = pack2(y2, y3);
        *(uint2*)(ymix + (size_t)(rowbase + t0 + j) * DM + lane * 4) = o;
    }
    __syncthreads();
}

DEVINL void b1_shortconv(KP p, int l, int item) {
    const int tid = TIDX(), cg = tid & 31, tl = tid >> 5, b = item >> 6, t0 = (item & 63) * 64 + tl * 8, rowbase = b * SEQ;
    const bf16_t* P = (const bf16_t*)(p->ws + A_P);
    bf16_t* ymix = (bf16_t*)(p->ws + A_YMIX);
    float w0[8], w1[8], w2[8];
#pragma unroll
    for (int e = 0; e < 8; ++e) { w0[e] = p->in[I_CONVD][(l * 3 + 0) * 256 + cg * 8 + e]; w1[e] = p->in[I_CONVD][(l * 3 + 1) * 256 + cg * 8 + e]; w2[e] = p->in[I_CONVD][(l * 3 + 2) * 256 + cg * 8 + e]; }
    uint4 gbv[8], gcv[10], hdv[10];
#pragma unroll
    for (int u = 0; u < 10; ++u) {
        const int t = t0 - 2 + u;
        const bf16_t* a = P + (size_t)(rowbase + (t >= 0 ? t : 0)) * PIN + 1920 + cg * 8;
        gcv[u] = *(const uint4*)(a + 256); hdv[u] = *(const uint4*)(a + 512);
        if (u >= 2) gbv[u - 2] = *(const uint4*)(a);
    }
    float q2[8], q1[8];
#pragma unroll
    for (int u = 0; u < 10; ++u) {
        const int t = t0 - 2 + u;
        const unsigned gcw[4] = {gcv[u].x, gcv[u].y, gcv[u].z, gcv[u].w}, hdw[4] = {hdv[u].x, hdv[u].y, hdv[u].z, hdv[u].w};
        float q0[8];
#pragma unroll
        for (int e = 0; e < 4; ++e) {
            q0[2 * e] = __uint_as_float(gcw[e] << 16) * __uint_as_float(hdw[e] << 16);
            q0[2 * e + 1] = __uint_as_float(gcw[e] & 0xFFFF0000u) * __uint_as_float(hdw[e] & 0xFFFF0000u);
        }
        if (t < 0) {
#pragma unroll
            for (int e = 0; e < 8; ++e) q0[e] = 0.f;
        }
        if (u >= 2) {
            const unsigned gbw[4] = {gbv[u - 2].x, gbv[u - 2].y, gbv[u - 2].z, gbv[u - 2].w};
            float y[8];
#pragma unroll
            for (int e = 0; e < 4; ++e) {
                y[2 * e] = __uint_as_float(gbw[e] << 16) * (w0[2 * e] * q2[2 * e] + w1[2 * e] * q1[2 * e] + w2[2 * e] * q0[2 * e]);
                y[2 * e + 1] = __uint_as_float(gbw[e] & 0xFFFF0000u) * (w0[2 * e + 1] * q2[2 * e + 1] + w1[2 * e + 1] * q1[2 * e + 1] + w2[2 * e + 1] * q0[2 * e + 1]);
            }
            *(uint4*)(ymix + (size_t)(rowbase + t) * DM + 768 + cg * 8) = make_uint4(pack2(y[0], y[1]), pack2(y[2], y[3]), pack2(y[4], y[5]), pack2(y[6], y[7]));
        }
#pragma unroll
        for (int e = 0; e < 8; ++e) { q2[e] = (u >= 1) ? q1[e] : 0.f; q1[e] = q0[e]; }
    }
}

DEVINL void b1_lru(KP p, int l, char* lds, int item) {
    const int c = TIDX(), b = item >> 7, tt = item & 127, t0 = tt * 32, rowbase = b * SEQ;
    const int h = c >> 6, lane = c & 63;
    const bf16_t* P = (const bf16_t*)(p->ws + A_P);
    float* uT = (float*)lds;
    {
        const float cb0 = p->in[I_CONVB][(l * 4 + 0) * 256 + c], cb1 = p->in[I_CONVB][(l * 4 + 1) * 256 + c], cb2 = p->in[I_CONVB][(l * 4 + 2) * 256 + c], cb3 = p->in[I_CONVB][(l * 4 + 3) * 256 + c];
        const float bias = p->in[I_CONVBB][l * 256 + c];
        float xm3 = 0.f, xm2 = 0.f, xm1 = 0.f;
        if (t0 >= 3) { const bf16_t* a = P + (size_t)(rowbase + t0 - 3) * PIN + 512 + c; xm3 = bf2f(a[0]); xm2 = bf2f(a[PIN]); xm1 = bf2f(a[2 * PIN]); }
        bf16_t xr[32];
#pragma unroll
        for (int j = 0; j < 32; ++j) xr[j] = P[(size_t)(rowbase + t0 + j) * PIN + 512 + c];
#pragma unroll
        for (int j = 0; j < 32; ++j) {
            const float x0 = bf2f(xr[j]);
            uT[c * 36 + j] = cb0 * xm3 + cb1 * xm2 + cb2 * xm1 + cb3 * x0 + bias;
            xm3 = xm2; xm2 = xm1; xm1 = x0;
        }
    }
    __syncthreads();
    const float brg = p->in[I_BRG][l * 256 + c], big = p->in[I_BIG][l * 256 + c];
    const float sp = softplusf(-p->in[I_LAMBDA][l * 256 + c]);
    float* hloc = (float*)(p->ws + A_HLOC); float* cuma = (float*)(p->ws + A_CUMA);
    const float* wrg = p->in[I_WRG] + (size_t)((l * 4 + h) * 64) * 64 + lane;
    const float* wig = p->in[I_WIG] + (size_t)((l * 4 + h) * 64) * 64 + lane;
    float hs = 0.f, cA = 1.f;
#pragma unroll 1
    for (int half = 0; half < 2; ++half) {
        float ar[16], ai[16];
#pragma unroll
        for (int j = 0; j < 16; ++j) { ar[j] = 0.f; ai[j] = 0.f; }
#pragma unroll 1
        for (int dh = 0; dh < 4; ++dh) {
            float wrv[16], wiv[16];
#pragma unroll
            for (int d = 0; d < 16; ++d) { wrv[d] = wrg[(dh * 16 + d) * 64]; wiv[d] = wig[(dh * 16 + d) * 64]; }
#pragma unroll
            for (int d = 0; d < 16; ++d) {
                const float wr = wrv[d], wi = wiv[d];
                const float4* up = (const float4*)(uT + (h * 64 + dh * 16 + d) * 36 + half * 16);
#pragma unroll
                for (int jj = 0; jj < 4; ++jj) {
                    const float4 u4 = up[jj];
                    ar[4 * jj + 0] = fmaf(u4.x, wr, ar[4 * jj + 0]); ai[4 * jj + 0] = fmaf(u4.x, wi, ai[4 * jj + 0]);
                    ar[4 * jj + 1] = fmaf(u4.y, wr, ar[4 * jj + 1]); ai[4 * jj + 1] = fmaf(u4.y, wi, ai[4 * jj + 1]);
                    ar[4 * jj + 2] = fmaf(u4.z, wr, ar[4 * jj + 2]); ai[4 * jj + 2] = fmaf(u4.z, wi, ai[4 * jj + 2]);
                    ar[4 * jj + 3] = fmaf(u4.w, wr, ar[4 * jj + 3]); ai[4 * jj + 3] = fmaf(u4.w, wi, ai[4 * jj + 3]);
                }
            }
        }
        float ureg[16];
#pragma unroll
        for (int jj = 0; jj < 4; ++jj) { const float4 u4 = *(const float4*)(uT + c * 36 + half * 16 + 4 * jj); ureg[4 * jj] = u4.x; ureg[4 * jj + 1] = u4.y; ureg[4 * jj + 2] = u4.z; ureg[4 * jj + 3] = u4.w; }
        float* hp = hloc + (size_t)(rowbase + t0 + half * 16) * 256 + c;
        float* cp = cuma + (size_t)(rowbase + t0 + half * 16) * 256 + c;
#pragma unroll
        for (int j = 0; j < 16; ++j) {
            const float r = sigm(ar[j] + brg), ig = sigm(ai[j] + big);
            const float log_a = -8.0f * r * sp;
            const float a = __expf(log_a);
            const float mult = sqrtf(fmaxf(-expm1f(2.f * log_a), 0.f));
            const float bx = mult * (ig * ureg[j]);
            hs = fmaf(a, hs, bx); cA *= a;
            hp[j * 256] = hs; cp[j * 256] = cA;
        }
    }
    ((float*)(p->ws + A_CARRYA))[(size_t)(b * 128 + tt) * 256 + c] = cA;
    ((float*)(p->ws + A_CARRYH))[(size_t)(b * 128 + tt) * 256 + c] = hs;
    __syncthreads();
}

DEVINL void b1_rwkv(KP p, int l, char* lds, int item) {
    const int c = TIDX(), b = item >> 7, tt = item & 127, t0 = tt * 32, rowbase = b * SEQ;
    const bf16_t* P = (const bf16_t*)(p->ws + A_P);
    float* featT = (float*)lds;
    const float* muc = p->in[I_MUC] + l * 896;
    if (c < 128) {
        const int col = 1024 + 768 + c; const float mu = muc[768 + c];
        float prev;
        { const float x = bf2f(P[(size_t)(rowbase + (t0 > 0 ? t0 - 1 : 0)) * PIN + col]); prev = (t0 > 0) ? x : 0.f; }
#pragma unroll 1
        for (int jb = 0; jb < 2; ++jb) {
            bf16_t raw[16];
#pragma unroll
            for (int u = 0; u < 16; ++u) raw[u] = P[(size_t)(rowbase + t0 + jb * 16 + u) * PIN + col];
#pragma unroll
            for (int u = 0; u < 16; ++u) {
                const float cur = bf2f(raw[u]);
                const float xs = cur + (prev - cur) * mu;
                const float val = (c < 32) ? tanhf(xs) : ((c < 64) ? xs : sigm(xs));
                featT[c * 36 + jb * 16 + u] = val; prev = cur;
            }
        }
    }
    __syncthreads();
    float acc[32], dec[32], aa[32];
#define LORA32(WPTR, FOFF) do { float wv_[32]; \
    _Pragma("unroll") for (int jf = 0; jf < 32; ++jf) wv_[jf] = (WPTR)[(size_t)jf * 256 + c]; \
    _Pragma("unroll") for (int jf = 0; jf < 32; ++jf) { const float4* fp = (const float4*)(featT + ((FOFF) + jf) * 36); const float wv = wv_[jf]; \
        _Pragma("unroll") for (int jj = 0; jj < 8; ++jj) { const float4 u4 = fp[jj]; acc[4 * jj] = fmaf(u4.x, wv, acc[4 * jj]); acc[4 * jj + 1] = fmaf(u4.y, wv, acc[4 * jj + 1]); acc[4 * jj + 2] = fmaf(u4.z, wv, acc[4 * jj + 2]); acc[4 * jj + 3] = fmaf(u4.w, wv, acc[4 * jj + 3]); } } } while (0)
#pragma unroll
    for (int j = 0; j < 32; ++j) acc[j] = 0.f;
    LORA32(p->in[I_WG2] + (size_t)(l * 64) * 256, 64);
    LORA32(p->in[I_WG2] + (size_t)(l * 64 + 32) * 256, 96);
    {
        float* gbuf = (float*)(p->ws + A_G);
#pragma unroll
        for (int j = 0; j < 32; ++j) { gbuf[(size_t)(rowbase + t0 + j) * 256 + c] = acc[j]; acc[j] = 0.f; }
    }
    LORA32(p->in[I_WW2] + (size_t)(l * 32) * 256, 0);
    {
        const float w0 = p->in[I_W0][l * 256 + c];
#pragma unroll
        for (int j = 0; j < 32; ++j) { const float z = w0 + acc[j]; const float wlog = -softplusf(-z) - 0.5f; dec[j] = -__expf(wlog); acc[j] = 0.f; }
    }
    LORA32(p->in[I_WA2] + (size_t)(l * 32) * 256, 32);
    {
        const float a0 = p->in[I_A0][l * 256 + c];
#pragma unroll
        for (int j = 0; j < 32; ++j) aa[j] = sigm(a0 + acc[j]);
    }
#undef LORA32
    {
        float* bonus = (float*)(p->ws + A_BONUS); uint4* scan = (uint4*)(p->ws + A_SCAN);
        const float mur = muc[c], muk = muc[256 + c], muv = muc[512 + c];
        const float kkw = p->in[I_KK][l * 256 + c], kaw = p->in[I_KA][l * 256 + c], rkw = p->in[I_RK][l * 256 + c];
        float pr, pk, pv;
        { const bf16_t* a = P + (size_t)(rowbase + (t0 > 0 ? t0 - 1 : 0)) * PIN + 1024 + c; const float x0 = bf2f(a[0]), x1 = bf2f(a[256]), x2 = bf2f(a[512]);
          pr = (t0 > 0) ? x0 : 0.f; pk = (t0 > 0) ? x1 : 0.f; pv = (t0 > 0) ? x2 : 0.f; }
#pragma unroll
        for (int jb = 0; jb < 4; ++jb) {
            bf16_t rr_[8], rk_[8], rv_[8];
#pragma unroll
            for (int u = 0; u < 8; ++u) { const bf16_t* a = P + (size_t)(rowbase + t0 + jb * 8 + u) * PIN + 1024 + c; rr_[u] = a[0]; rk_[u] = a[256]; rv_[u] = a[512]; }
#pragma unroll
            for (int u = 0; u < 8; ++u) {
                const int j = jb * 8 + u;
                const size_t row = (size_t)(rowbase + t0 + j);
                const float cr = bf2f(rr_[u]), ck = bf2f(rk_[u]), cv = bf2f(rv_[u]);
                const float r = cr + (pr - cr) * mur, k = ck + (pk - ck) * muk, v = cv + (pv - cv) * muv;
                pr = cr; pk = ck; pv = cv;
                const float kk = k * kkw;
                const float ss = wave_sum(kk * kk);
                const float kkn = kk * rsqrtf(ss + 1e-12f);
                const float kf = k * (1.f + (aa[j] - 1.f) * kaw);
                const float bs = wave_sum(r * kf * rkw);
                bonus[row * 256 + c] = bs * v;
                uint4 o; o.x = pack2(kkn, kkn * aa[j]); o.y = pack2(kf, r); o.z = pack2(v, 0.f); o.w = __float_as_uint(dec[j]);
                scan[row * 256 + c] = o;
            }
            asm volatile("" ::: "memory");
        }
    }
    __syncthreads();
}

constexpr int S_AL = 0, S_BE = 8192, S_KA = 16384, S_RH = 24576, S_BET = 32768, S_KAT = 40960, S_VT = 49152, S_L2F = 57344  , S_GT = 73728  ;
constexpr int S_L1F = S_BE;
constexpr int S_M1 = S_BE, S_M2 = S_KA;
constexpr int S_APT = S_L2F, S_W2T = S_L2F + 8192;
constexpr int S_RP = S_AL, S_GTR = S_RH;
DEVINL int crow32(int reg, int h) { return (reg & 3) + 8 * (reg >> 2) + 4 * h; }
DEVINL bf16x8 frag64(const char* lds, int slot, int row, int kel) { return *reinterpret_cast<const bf16x8*>(lds + slot + row * 128 + kel * 2); }
#define MFMA32(a, b, c) __builtin_amdgcn_mfma_f32_32x32x16_bf16((a), (b), (c), 0, 0, 0)
DEVINL float dpp_xor1(float x) { return __builtin_bit_cast(float, __builtin_amdgcn_update_dpp(0, __builtin_bit_cast(int, x), 0xB1, 0xf, 0xf, true)); }

DEVINL f32x16 mm64(const char* lds, int slotA, int slotB, int tm, int tn, int r, int hh, f32x16 acc) {
#pragma unroll
    for (int ks = 0; ks < 4; ++ks) acc = MFMA32(frag64(lds, slotA, tm * 32 + r, ks * 16 + 8 * hh), frag64(lds, slotB, tn * 32 + r, ks * 16 + 8 * hh), acc);
    return acc;
}

DEVINL void b1e_unit(KP p, char* lds, int b, int h, int c) {
    const int tid = TIDX(), wv = tid >> 6, lane = tid & 63, r = lane & 31, hh = lane >> 5;
    const uint4* scan = (const uint4*)(p->ws + A_SCAN) + ((size_t)(b * SEQ + c * 64)) * 256 + h * 64;
    float* gtot = (float*)(lds + S_GT); float* gamC = gtot + 256;
    {
        const int j = lane;
        float lw[16]; unsigned px[16], py[16], pz[16];
#pragma unroll
        for (int u = 0; u < 16; ++u) { const uint4 q = scan[(size_t)(wv * 16 + u) * 256 + j]; px[u] = q.x; py[u] = q.y; pz[u] = q.z; lw[u] = __uint_as_float(q.w); }
        float tot = 0.f;
#pragma unroll
        for (int u = 0; u < 16; ++u) tot += lw[u];
        gtot[wv * 64 + j] = tot;
        __syncthreads();
        float off = 0.f, all = 0.f;
#pragma unroll
        for (int g = 0; g < 4; ++g) { const float v = gtot[g * 64 + j]; all += v; off += (g < wv) ? v : 0.f; }
        if (wv == 0) gamC[j] = __expf(all);
        float cum = off;
        unsigned tb[8], tk[8], tv[8];
#pragma unroll
        for (int u = 0; u < 16; ++u) {
            const float kkn = __uint_as_float(px[u] << 16), bb = __uint_as_float(px[u] & 0xFFFF0000u);
            const float kf = __uint_as_float(py[u] << 16), rr = __uint_as_float(py[u] & 0xFFFF0000u);
            const float gp = __expf(cum); cum += lw[u];
            const float g = __expf(cum), en = __expf(-cum);
            const int t = wv * 16 + u;
            const unsigned be = f2bf(bb * en), ka = f2bf(kf * en);
            *(bf16_t*)(lds + S_AL + t * 128 + j * 2) = f2bf(gp * kkn);
            *(bf16_t*)(lds + S_BE + t * 128 + j * 2) = (bf16_t)be;
            *(bf16_t*)(lds + S_KA + t * 128 + j * 2) = (bf16_t)ka;
            *(bf16_t*)(lds + S_RH + t * 128 + j * 2) = f2bf(g * rr);
            if (u & 1) { tb[u >> 1] |= be << 16; tk[u >> 1] |= ka << 16; tv[u >> 1] |= (pz[u] << 16); }
            else { tb[u >> 1] = be; tk[u >> 1] = ka; tv[u >> 1] = pz[u] & 0xFFFFu; }
        }
        *(uint4*)(lds + S_BET + j * 128 + wv * 32) = make_uint4(tb[0], tb[1], tb[2], tb[3]); *(uint4*)(lds + S_BET + j * 128 + wv * 32 + 16) = make_uint4(tb[4], tb[5], tb[6], tb[7]);
        *(uint4*)(lds + S_KAT + j * 128 + wv * 32) = make_uint4(tk[0], tk[1], tk[2], tk[3]); *(uint4*)(lds + S_KAT + j * 128 + wv * 32 + 16) = make_uint4(tk[4], tk[5], tk[6], tk[7]);
        *(uint4*)(lds + S_VT + j * 128 + wv * 32) = make_uint4(tv[0], tv[1], tv[2], tv[3]); *(uint4*)(lds + S_VT + j * 128 + wv * 32 + 16) = make_uint4(tv[4], tv[5], tv[6], tv[7]);
    }
    __syncthreads();
    const int tm = wv >> 1, tn = wv & 1;
    f32x16 aM1, aM2;
    {
        f32x16 aL1, aL2;
#pragma unroll
        for (int i = 0; i < 16; ++i) { aL1[i] = 0.f; aL2[i] = 0.f; aM1[i] = 0.f; aM2[i] = 0.f; }
#pragma unroll
        for (int ks = 0; ks < 4; ++ks) {
            const bf16x8 fa = frag64(lds, S_AL, tm * 32 + r, ks * 16 + 8 * hh), fr = frag64(lds, S_RH, tm * 32 + r, ks * 16 + 8 * hh);
            const bf16x8 fb = frag64(lds, S_BE, tn * 32 + r, ks * 16 + 8 * hh), fk = frag64(lds, S_KA, tn * 32 + r, ks * 16 + 8 * hh);
            aL1 = MFMA32(fa, fb, aL1); aL2 = MFMA32(fa, fk, aL2); aM1 = MFMA32(fr, fb, aM1); aM2 = MFMA32(fr, fk, aM2);
        }
        __syncthreads();
#pragma unroll
        for (int reg = 0; reg < 16; ++reg) {
            const int t = tm * 32 + crow32(reg, hh), sidx = tn * 32 + r;
            const int o = (t * 64 + (sidx & 1) * 32 + (sidx >> 1)) * 4;
            *(float*)(lds + S_L1F + o) = (sidx < t) ? aL1[reg] : 0.f;
            *(float*)(lds + S_L2F + o) = (sidx < t) ? aL2[reg] : 0.f;
            aM1[reg] = (sidx <= t) ? aM1[reg] : 0.f; aM2[reg] = (sidx <= t) ? aM2[reg] : 0.f;
        }
    }
    __syncthreads();
    unsigned outp[32];
    {
        const int col = (wv & 1) * 32 + (lane >> 1), q = lane & 1;
        float xq[32];
#pragma unroll
        for (int k = 0; k < 32; ++k) xq[k] = 0.f;
        const char* l1row = lds + S_L1F + q * 128;
        const char* l2row = lds + S_L2F + q * 128;
        if (wv < 2) {
#pragma unroll
            for (int t = 0; t < 64; ++t) {
                float acc = 0.f;
#pragma unroll
                for (int k4 = 0; k4 * 4 < (t + 1) / 2; ++k4) {
                    const float4 a = *(const float4*)(l1row + t * 256 + k4 * 16);
                    acc = fmaf(a.x, xq[4 * k4 + 0], acc); acc = fmaf(a.y, xq[4 * k4 + 1], acc); acc = fmaf(a.z, xq[4 * k4 + 2], acc); acc = fmaf(a.w, xq[4 * k4 + 3], acc);
                }
                acc += dpp_xor1(acc);
                const float x = bf2f(*(const bf16_t*)(lds + S_AL + t * 128 + col * 2)) - acc;
                xq[t >> 1] = ((t & 1) == q) ? x : xq[t >> 1];
            }
        } else {
            float vq[32];
#pragma unroll
            for (int k8 = 0; k8 < 8; ++k8) {
                const uint4 d = *(const uint4*)(lds + S_VT + col * 128 + k8 * 16);
                vq[4 * k8 + 0] = q ? __uint_as_float(d.x & 0xFFFF0000u) : __uint_as_float(d.x << 16);
                vq[4 * k8 + 1] = q ? __uint_as_float(d.y & 0xFFFF0000u) : __uint_as_float(d.y << 16);
                vq[4 * k8 + 2] = q ? __uint_as_float(d.z & 0xFFFF0000u) : __uint_as_float(d.z << 16);
                vq[4 * k8 + 3] = q ? __uint_as_float(d.w & 0xFFFF0000u) : __uint_as_float(d.w << 16);
            }
#pragma unroll
            for (int t = 0; t < 64; ++t) {
                float acc = 0.f;
#pragma unroll
                for (int k4 = 0; k4 * 4 < (t + 1) / 2; ++k4) {
                    const float4 a = *(const float4*)(l1row + t * 256 + k4 * 16);
                    const float4 bq = *(const float4*)(l2row + t * 256 + k4 * 16);
                    acc = fmaf(bq.x, vq[4 * k4 + 0], acc); acc = fmaf(bq.y, vq[4 * k4 + 1], acc); acc = fmaf(bq.z, vq[4 * k4 + 2], acc); acc = fmaf(bq.w, vq[4 * k4 + 3], acc);
                    acc = fmaf(-a.x, xq[4 * k4 + 0], acc); acc = fmaf(-a.y, xq[4 * k4 + 1], acc); acc = fmaf(-a.z, xq[4 * k4 + 2], acc); acc = fmaf(-a.w, xq[4 * k4 + 3], acc);
                }
                acc += dpp_xor1(acc);
                xq[t >> 1] = ((t & 1) == q) ? acc : xq[t >> 1];
            }
        }
#pragma unroll
        for (int k = 0; k < 32; ++k) { const float o = dpp_xor1(xq[k]); outp[k] = q ? pack2(o, xq[k]) : pack2(xq[k], o); }
    }
    __syncthreads();
    {
        const int col = (wv & 1) * 32 + (lane >> 1), q = lane & 1;
        char* dst = lds + ((wv < 2) ? S_APT : S_W2T) + col * 128 + q * 64;
#pragma unroll
        for (int i = 0; i < 4; ++i) *(uint4*)(dst + i * 16) = q ? make_uint4(outp[16 + 4 * i], outp[17 + 4 * i], outp[18 + 4 * i], outp[19 + 4 * i]) : make_uint4(outp[4 * i], outp[4 * i + 1], outp[4 * i + 2], outp[4 * i + 3]);
#pragma unroll
        for (int reg = 0; reg < 16; ++reg) {
            const int t = tm * 32 + crow32(reg, hh), sidx = tn * 32 + r;
            *(bf16_t*)(lds + S_M1 + t * 128 + sidx * 2) = f2bf(aM1[reg]);
            *(bf16_t*)(lds + S_M2 + t * 128 + sidx * 2) = f2bf(aM2[reg]);
        }
    }
    __syncthreads();
    unsigned char* ubase = p->ws + A_CHAIN + (size_t)((b * 4 + h) * 64 + c) * CHAIN_UNIT;
    f32x16 zero;
#pragma unroll
    for (int i = 0; i < 16; ++i) zero[i] = 0.f;
    f32x16 gt;
    {
        const f32x16 qv = mm64(lds, S_M1, S_APT, tm, tn, r, hh, zero);
        const f32x16 y0 = mm64(lds, S_M2, S_VT, tm, tn, r, hh, zero) - mm64(lds, S_M1, S_W2T, tm, tn, r, hh, zero);
        gt = mm64(lds, S_BET, S_APT, tm, tn, r, hh, zero);
        const f32x16 ht = mm64(lds, S_KAT, S_VT, tm, tn, r, hh, zero) - mm64(lds, S_BET, S_W2T, tm, tn, r, hh, zero);
#pragma unroll
        for (int reg = 0; reg < 16; ++reg) {
            const int t = tm * 32 + crow32(reg, hh), jc = tn * 32 + r;
            const float rh = bf2f(*(const bf16_t*)(lds + S_RH + t * 128 + jc * 2));
            *(bf16_t*)(lds + S_RP + t * 128 + jc * 2) = f2bf(rh - qv[reg]);
            const int jr = tm * 32 + crow32(reg, hh);
            const float gc = gamC[jr];
            gt[reg] = gc * (((jr == jc) ? 1.f : 0.f) - gt[reg]);
        }
        float4* himg = (float4*)(ubase + 16384); float4* yimg = (float4*)(ubase + 32768);
#pragma unroll
        for (int rq = 0; rq < 4; ++rq) {
            float4 hv, yv;
            hv.x = gamC[tm * 32 + crow32(4 * rq + 0, hh)] * ht[4 * rq + 0]; hv.y = gamC[tm * 32 + crow32(4 * rq + 1, hh)] * ht[4 * rq + 1];
            hv.z = gamC[tm * 32 + crow32(4 * rq + 2, hh)] * ht[4 * rq + 2]; hv.w = gamC[tm * 32 + crow32(4 * rq + 3, hh)] * ht[4 * rq + 3];
            yv.x = y0[4 * rq + 0]; yv.y = y0[4 * rq + 1]; yv.z = y0[4 * rq + 2]; yv.w = y0[4 * rq + 3];
            himg[((tn * 2 + tm) * 4 + rq) * 64 + lane] = hv;
            yimg[((tn * 2 + tm) * 4 + rq) * 64 + lane] = yv;
        }
    }
    __syncthreads();
#pragma unroll
    for (int reg = 0; reg < 16; ++reg) {
        const int jr = tm * 32 + crow32(reg, hh), jc = tn * 32 + r;
        *(bf16_t*)(lds + S_GTR + jr * 128 + jc * 2) = f2bf(gt[reg]);
    }
    __syncthreads();
    {
        uint4* gimg = (uint4*)(ubase); uint4* rimg = (uint4*)(ubase + 8192);
#pragma unroll
        for (int ii = 0; ii < 2; ++ii) {
            const int im = wv * 2 + ii, mt = im >> 2, jb = (im >> 1) & 1, s2 = im & 1;
            const int cbase = (32 * jb + 16 * s2 + 4 * hh) * 2;
            const uint2 g0 = *(const uint2*)(lds + S_GTR + (mt * 32 + r) * 128 + cbase), g1 = *(const uint2*)(lds + S_GTR + (mt * 32 + r) * 128 + cbase + 16);
            const uint2 r0 = *(const uint2*)(lds + S_RP + (mt * 32 + r) * 128 + cbase), r1 = *(const uint2*)(lds + S_RP + (mt * 32 + r) * 128 + cbase + 16);
            gimg[im * 64 + lane] = make_uint4(g0.x, g0.y, g1.x, g1.y);
            rimg[im * 64 + lane] = make_uint4(r0.x, r0.y, r1.x, r1.y);
        }
    }
    __syncthreads();
}

DEVINL void phaseB1(KP p, int l, char* lds, const int mask = 15, const int sub = 3) {
    const int nb = gridDim.x;
    if (mask & 1) {
        const int blk = BIDX();
        for (int it = blk; it < 512; it += nb) {
            if (sub & 1) { b1_rwkv(p, l, lds, it * 2); b1_rwkv(p, l, lds, it * 2 + 1); }
            __threadfence_block(); __syncthreads();
            const int b = it >> 6, c = it & 63;
            if (sub & 2) {
#pragma unroll 1
                for (int h = 0; h < 4; ++h) b1e_unit(p, lds, b, h, c);
            }
        }
    }
    if (mask & 2) { const int blk = BIDX(); for (int it = blk; it < 1024; it += nb) b1_lru(p, l, lds, it); }
    if (mask & 4) { const int blk = BIDX(); for (int it = blk; it < 1024; it += nb) b1_conformer(p, l, lds, it); }
    if (mask & 8) { const int blk = BIDX(); for (int it = blk; it < 512; it += nb) b1_shortconv(p, l, it); }
}

DEVINL void phaseB2(KP p, int l) {
    const int tid = TIDX(), blk = BIDX();
    if (blk >= 64 && blk < 72) {
        const int bb = blk - 64;
        const float* ca = (const float*)(p->ws + A_CARRYA) + (size_t)bb * 128 * 256 + tid;
        const float* ch = (const float*)(p->ws + A_CARRYH) + (size_t)bb * 128 * 256 + tid;
        float* hst = (float*)(p->ws + A_HSTART) + (size_t)bb * 128 * 256 + tid;
        float hs = 0.f;
#pragma unroll 8
        for (int tt = 0; tt < 128; ++tt) { hst[tt * 256] = hs; hs = fmaf(ca[tt * 256], hs, ch[tt * 256]); }
    }
    if (blk < 64 && tid < 64) {
        const int lane = tid, r = lane & 31, hh = lane >> 5;
        const int bh = blk >> 1, w = blk & 1, b = bh >> 2, h = bh & 3;
        float* yraw = (float*)(p->ws + A_YRAW) + (size_t)b * SEQ * 256 + h * 64 + 32 * w + r;
        f32x16 X0, X1;
#pragma unroll
        for (int i = 0; i < 16; ++i) { X0[i] = 0.f; X1[i] = 0.f; }
        for (int c = 0; c < 64; ++c) {
            const unsigned char* ubase = p->ws + A_CHAIN + (size_t)(bh * 64 + c) * CHAIN_UNIT;
            const uint4* gimg = (const uint4*)ubase; const uint4* rimg = (const uint4*)(ubase + 8192);
            const float4* himg = (const float4*)(ubase + 16384); const float4* yimg = (const float4*)(ubase + 32768);
            uint4 gq[8], rq8[8]; float4 hq[8], yq[8];
#pragma unroll
            for (int i = 0; i < 8; ++i) { gq[i] = gimg[i * 64 + lane]; rq8[i] = rimg[i * 64 + lane]; }
#pragma unroll
            for (int i = 0; i < 8; ++i) { hq[i] = himg[(w * 8 + i) * 64 + lane]; yq[i] = yimg[(w * 8 + i) * 64 + lane]; }
            bf16x8 xp[4];
#pragma unroll
            for (int s2 = 0; s2 < 2; ++s2) {
                uint4 a, bq;
                a.x = pack2(X0[8 * s2 + 0], X0[8 * s2 + 1]); a.y = pack2(X0[8 * s2 + 2], X0[8 * s2 + 3]); a.z = pack2(X0[8 * s2 + 4], X0[8 * s2 + 5]); a.w = pack2(X0[8 * s2 + 6], X0[8 * s2 + 7]);
                bq.x = pack2(X1[8 * s2 + 0], X1[8 * s2 + 1]); bq.y = pack2(X1[8 * s2 + 2], X1[8 * s2 + 3]); bq.z = pack2(X1[8 * s2 + 4], X1[8 * s2 + 5]); bq.w = pack2(X1[8 * s2 + 6], X1[8 * s2 + 7]);
                xp[s2] = __builtin_bit_cast(bf16x8, a); xp[2 + s2] = __builtin_bit_cast(bf16x8, bq);
            }
#pragma unroll
            for (int mt = 0; mt < 2; ++mt) {
                f32x16 acc;
#pragma unroll
                for (int i = 0; i < 4; ++i) { acc[4 * i] = yq[mt * 4 + i].x; acc[4 * i + 1] = yq[mt * 4 + i].y; acc[4 * i + 2] = yq[mt * 4 + i].z; acc[4 * i + 3] = yq[mt * 4 + i].w; }
#pragma unroll
                for (int f = 0; f < 4; ++f) acc = MFMA32(__builtin_bit_cast(bf16x8, rq8[mt * 4 + f]), xp[f], acc);
#pragma unroll
                for (int reg = 0; reg < 16; ++reg) yraw[(size_t)(c * 64 + mt * 32 + crow32(reg, hh)) * 256] = acc[reg];
            }
            f32x16 n0, n1;
#pragma unroll
            for (int i = 0; i < 4; ++i) { n0[4 * i] = hq[i].x; n0[4 * i + 1] = hq[i].y; n0[4 * i + 2] = hq[i].z; n0[4 * i + 3] = hq[i].w;
                                          n1[4 * i] = hq[4 + i].x; n1[4 * i + 1] = hq[4 + i].y; n1[4 * i + 2] = hq[4 + i].z; n1[4 * i + 3] = hq[4 + i].w; }
#pragma unroll
            for (int f = 0; f < 4; ++f) { n0 = MFMA32(__builtin_bit_cast(bf16x8, gq[f]), xp[f], n0); n1 = MFMA32(__builtin_bit_cast(bf16x8, gq[4 + f]), xp[f], n1); }
            X0 = n0; X1 = n1;
        }
    }
}

DEVINL void phaseB3(KP p, int l) {
    const int c = TIDX(), nb = gridDim.x, blk = BIDX();
    const bf16_t* P = (const bf16_t*)(p->ws + A_P);
    bf16_t* ymix = (bf16_t*)(p->ws + A_YMIX);
    const float* yraw = (const float*)(p->ws + A_YRAW); const float* bonus = (const float*)(p->ws + A_BONUS); const float* gbuf = (const float*)(p->ws + A_G);
    const float* hloc = (const float*)(p->ws + A_HLOC); const float* cuma = (const float*)(p->ws + A_CUMA); const float* hst = (const float*)(p->ws + A_HSTART);
    const float gng = p->in[I_GNG][l * 256 + c], gnb = p->in[I_GNB][l * 256 + c];
    for (int it = blk; it < 512; it += nb) {
#pragma unroll 4
        for (int rr = 0; rr < 64; ++rr) {
            const int row = it * 64 + rr, b = row >> 12, tt = (row & 4095) >> 5;
            const size_t o = (size_t)row * 256 + c;
            const float y = yraw[o];
            const float mu = wave_sum(y) * (1.f / 64.f);
            const float d = y - mu;
            const float var = wave_sum(d * d) * (1.f / 64.f);
            const float yn = d * rsqrtf(var + GN_EPS) * gng + gnb;
            ymix[(size_t)row * DM + 512 + c] = f2bf((yn + bonus[o]) * gbuf[o]);
            const float hh = fmaf(cuma[o], hst[(size_t)(b * 128 + tt) * 256 + c], hloc[o]);
            const float gb = bf2f(P[(size_t)row * PIN + 768 + c]);
            ymix[(size_t)row * DM + 256 + c] = f2bf(hh * gelu_tanh(gb));
        }
    }
}

DEVINL void phaseC(KP p, int l, char* lds) {
    const int nb = gridDim.x, blk = BIDX();
    const bf16_t* ymix = (const bf16_t*)(p->ws + A_YMIX);
    const bf16_t* Wt = (const bf16_t*)(p->ws + OFF_WOUT) + (size_t)l * 1024 * 1024;
    const float* res = (l == 0) ? p->in[I_X] : p->out;
    float* xbuf = p->out;
    const float* mod = (const float*)(p->ws + OFF_MOD);
    int R[4], C[4]; stage_coords(R, C);
    auto ptrs = [&](int t, const bf16_t* (&ap)[4], const bf16_t* (&bp)[4]) {
        const int pn = t & 7, pm = t >> 3;
#pragma unroll
        for (int i = 0; i < 4; ++i) { ap[i] = ymix + (size_t)(pm * 128 + R[i]) * DM + C[i]; bp[i] = Wt + (size_t)(pn * 128 + R[i]) * 1024 + C[i]; }
    };
    auto epi = [&](int t, f32x4 (&acc)[4][4], int wr, int wc, int fr, int fq) {
        const int pn = t & 7, pm = t >> 3;
#pragma unroll
        for (int m = 0; m < 4; ++m) {
            const int row = pm * 128 + wr * 64 + m * 16 + fr, b = row >> 12;
#pragma unroll
            for (int n = 0; n < 4; ++n) {
                const int col = pn * 128 + wc * 64 + n * 16 + fq * 4;
                const float4 g1 = *(const float4*)(mod + (size_t)(l * 8 + b) * 6144 + 2048 + col);
                const float4 rx = *(const float4*)(res + (size_t)row * DM + col);
                float4 z;
                z.x = ALPHA * rx.x + (1.f + g1.x) * acc[m][n][0]; z.y = ALPHA * rx.y + (1.f + g1.y) * acc[m][n][1];
                z.z = ALPHA * rx.z + (1.f + g1.z) * acc[m][n][2]; z.w = ALPHA * rx.w + (1.f + g1.w) * acc[m][n][3];
                *(float4*)(xbuf + (size_t)row * DM + col) = z;
            }
        }
    };
    gemm_stream128(lds, 1024, blk, nb, 256 * 8, ptrs, epi);
}

DEVINL void phaseD(KP p, int l, char* lds, const int dry = 0) {
    const int tid = TIDX(), nb = gridDim.x, blk = BIDX(), wid = tid >> 6, lane = tid & 63;
    float* ul = (float*)lds;
    int* sel_e = (int*)(lds + 65536);
    int* lpos = (int*)(lds + 65536 + 2048);
    int* hist = (int*)(lds + 65536 + 4096);
    int* basep = (int*)(lds + 65536 + 4096 + 256);
    const float* xbuf = p->out;
    float* xout = dry ? (float*)(p->ws + A_P) : p->out;
    bf16_t* ubuf = (bf16_t*)(p->ws + (dry ? A_YMIX : OFF_UBUF));
    const float* mod = (const float*)(p->ws + OFF_MOD);
    const float* wr = p->in[I_WROUTER] + (size_t)l * 1024 * 64 + lane;
    const float ebias = p->in[I_EBIAS][l * 64 + lane];
    unsigned* cnt = (unsigned*)(p->ws + OFF_CNT) + l * 64 + (dry ? 256 : 0);
    int* list = (int*)(p->ws + (dry ? M_HBUF : M_LIST));
    float* wsel = (float*)(p->ws + (dry ? M_HBUF + 16777216 : M_WSEL));
    for (int it = blk; it < 512; it += nb) {
        const int tok0 = it * 64;
        if (tid < 64) hist[tid] = 0;
        for (int sb = 0; sb < 4; ++sb) {
#pragma unroll
            for (int j = 0; j < 4; ++j) {
                const int tl = wid * 4 + j, row = tok0 + sb * 16 + tl, b = row >> 12;
                float4 z[4];
                float s = 0.f;
#pragma unroll
                for (int i = 0; i < 4; ++i) { z[i] = *(const float4*)(xbuf + (size_t)row * DM + i * 256 + lane * 4); s += z[i].x + z[i].y + z[i].z + z[i].w; }
                const float mean = wave_sum(s) * (1.f / 1024.f);
                float q = 0.f;
#pragma unroll
                for (int i = 0; i < 4; ++i) { z[i].x -= mean; z[i].y -= mean; z[i].z -= mean; z[i].w -= mean; q += z[i].x * z[i].x + z[i].y * z[i].y + z[i].z * z[i].z + z[i].w * z[i].w; }
                const float rs = rsqrtf(wave_sum(q) * (1.f / 1024.f) + LN_EPS);
#pragma unroll
                for (int i = 0; i < 4; ++i) {
                    const int col = i * 256 + lane * 4;
                    const float4 g = *(const float4*)(p->in[I_LN1G] + l * 1024 + col), bb = *(const float4*)(p->in[I_LN1B] + l * 1024 + col);
                    const float4 sh = *(const float4*)(mod + (size_t)(l * 8 + b) * 6144 + 3072 + col), sc = *(const float4*)(mod + (size_t)(l * 8 + b) * 6144 + 4096 + col);
                    float4 x1; x1.x = z[i].x * rs * g.x + bb.x; x1.y = z[i].y * rs * g.y + bb.y; x1.z = z[i].z * rs * g.z + bb.z; x1.w = z[i].w * rs * g.w + bb.w;
                    *(float4*)(xout + (size_t)row * DM + col) = x1;
                    float4 u; u.x = x1.x * (1.f + sc.x) + sh.x; u.y = x1.y * (1.f + sc.y) + sh.y; u.z = x1.z * (1.f + sc.z) + sh.z; u.w = x1.w * (1.f + sc.w) + sh.w;
                    *(float4*)(ul + tl * 1024 + col) = u;
                    uint2 o; o.x = pack2(u.x, u.y); o.y = pack2(u.z, u.w);
                    *(uint2*)(ubuf + (size_t)row * DM + col) = o;
                }
            }
            __syncthreads();
            float acc[4] = {0.f, 0.f, 0.f, 0.f};
            const float* u0 = ul + (wid * 4) * 1024;
#pragma unroll 2
            for (int k = 0; k < 1024; k += 4) {
                const float w0 = wr[(size_t)(k + 0) * 64], w1 = wr[(size_t)(k + 1) * 64], w2 = wr[(size_t)(k + 2) * 64], w3 = wr[(size_t)(k + 3) * 64];
#pragma unroll
                for (int j = 0; j < 4; ++j) {
                    const float4 u4 = *(const float4*)(u0 + j * 1024 + k);
                    acc[j] = fmaf(u4.x, w0, acc[j]); acc[j] = fmaf(u4.y, w1, acc[j]); acc[j] = fmaf(u4.z, w2, acc[j]); acc[j] = fmaf(u4.w, w3, acc[j]);
                }
            }
#pragma unroll
            for (int j = 0; j < 4; ++j) {
                const int tl = sb * 16 + wid * 4 + j;
                const float score = 1.f / (1.f + expf(-acc[j]));
                const float biased = score + ebias;
                float m1 = biased;
                m1 = fmaxf(m1, __shfl_xor(m1, 1)); m1 = fmaxf(m1, __shfl_xor(m1, 2)); m1 = fmaxf(m1, __shfl_xor(m1, 4));
                const unsigned long long eq = __ballot(biased == m1);
                const int g = lane >> 3;
                const unsigned gm = (unsigned)(eq >> (g * 8)) & 0xFFu;
                const int first = __ffs((int)gm) - 1;
                const float v2 = ((lane & 7) == first) ? -INFINITY : biased;
                float m2 = v2;
                m2 = fmaxf(m2, __shfl_xor(m2, 1)); m2 = fmaxf(m2, __shfl_xor(m2, 2)); m2 = fmaxf(m2, __shfl_xor(m2, 4));
                const float gs = m1 + m2;
                int rg = 0;
#pragma unroll
                for (int g2 = 0; g2 < 8; ++g2) { const float o = __builtin_bit_cast(float, __builtin_amdgcn_readlane(__builtin_bit_cast(int, gs), g2 * 8)); rg += ((o > gs) || (o == gs && g2 < g)) ? 1 : 0; }
                const bool keep = rg < 4;
                const float mk = keep ? biased : -INFINITY;
                int rk = 0;
#pragma unroll
                for (int e2 = 0; e2 < 64; ++e2) { const float o = __builtin_bit_cast(float, __builtin_amdgcn_readlane(__builtin_bit_cast(int, mk), e2)); rk += ((o > mk) || (o == mk && e2 < lane)) ? 1 : 0; }
                const bool sel = keep && (rk < 8);
                const float ssum = wave_sum(sel ? score : 0.f);
                const float wgt = score / ssum * 2.5f;
                const unsigned long long sm = __ballot(sel);
                const int kidx = __popcll(sm & ((1ull << lane) - 1ull));
                if (sel) { wsel[(size_t)(tok0 + tl) * 8 + kidx] = wgt; sel_e[tl * 8 + kidx] = lane; }
            }
            __syncthreads();
        }
        for (int i = tid; i < 512; i += NTHREADS) lpos[i] = atomicAdd(&hist[sel_e[i]], 1);
        __syncthreads();
        if (tid < 64) basep[tid] = (int)atomicAdd(&cnt[tid], (unsigned)hist[tid]);
        __syncthreads();
        for (int i = tid; i < 512; i += NTHREADS) { const int e = sel_e[i]; list[(size_t)e * NTOK + basep[e] + lpos[i]] = tok0 * 8 + i; }
        __syncthreads();
    }
}

DEVINL void moe_directory(KP p, int l, char* lds) {
    int* pref = (int*)(lds + 65536);
    int* cntl = (int*)(lds + 65536 + 512);
    if (TIDX() == 0) {
        unsigned* cnt = (unsigned*)(p->ws + OFF_CNT) + l * 64;
        int s = 0;
        for (int e = 0; e < 64; ++e) { const int c = (int)__hip_atomic_load(&cnt[e], __ATOMIC_RELAXED, __HIP_MEMORY_SCOPE_AGENT); cntl[e] = c; pref[e] = s; s += (c + 127) >> 7; }
        pref[64] = s; cntl[64] = NTOK; pref[65] = s + 256;
    }
    __syncthreads();
}

DEVINL void phaseE1(KP p, int l, char* lds) {
    const int nb = gridDim.x, blk = BIDX();
    moe_directory(p, l, lds);
    const int* pref = (const int*)(lds + 65536); const int* cntl = (const int*)(lds + 65536 + 512);
    const bf16_t* ubuf = (const bf16_t*)(p->ws + OFF_UBUF);
    const int* list = (const int*)(p->ws + M_LIST);
    bf16_t* hbuf = (bf16_t*)(p->ws + M_HBUF);
    const bf16_t* W13 = (const bf16_t*)(p->ws + OFF_W13) + (size_t)(l * 65) * 512 * 1024;
    const int total = pref[65] * 4;
    int R[4], C[4]; stage_coords(R, C);
    auto ptrs = [&](int t, const bf16_t* (&ap)[4], const bf16_t* (&bp)[4]) {
        const int mg = t >> 2, nt = t & 3;
        int e = 0; while (pref[e + 1] <= mg) ++e;
        const int mt = mg - pref[e], Me = cntl[e];
#pragma unroll
        for (int i = 0; i < 4; ++i) {
            const int idx = mt * 128 + R[i]; int tok;
            if (e < 64) tok = (idx < Me) ? (list[(size_t)e * NTOK + idx] >> 3) : 0; else tok = idx;
            ap[i] = ubuf + (size_t)tok * DM + C[i];
            bp[i] = W13 + ((size_t)e * 512 + nt * 128 + R[i]) * 1024 + C[i];
        }
    };
    auto epi = [&](int t, f32x4 (&acc)[4][4], int wr, int wc, int fr, int fq) {
        const int mg = t >> 2, nt = t & 3;
#pragma unroll
        for (int m = 0; m < 4; ++m) {
            const size_t hrow = (size_t)mg * 128 + wr * 64 + m * 16 + fr;
#pragma unroll
            for (int q = 0; q < 2; ++q) {
                const int hcol = nt * 64 + wc * 32 + q * 16 + fq * 4;
                float hv[4];
#pragma unroll
                for (int j = 0; j < 4; ++j) { const float gt = acc[m][2 * q][j], up = acc[m][2 * q + 1][j]; hv[j] = gt * sigm(gt) * up; }
                uint2 o; o.x = pack2(hv[0], hv[1]); o.y = pack2(hv[2], hv[3]);
                *(uint2*)(hbuf + hrow * 256 + hcol) = o;
            }
        }
    };
    gemm_stream128(lds, 1024, blk, nb, total, ptrs, epi);
}

DEVINL void phaseE2(KP p, int l, char* lds) {
    const int nb = gridDim.x, blk = BIDX();
    moe_directory(p, l, lds);
    const int* pref = (const int*)(lds + 65536); const int* cntl = (const int*)(lds + 65536 + 512);
    int* rowdst = (int*)(lds + 65536 + 1024);
    const int* list = (const int*)(p->ws + M_LIST);
    const float* wsel = (const float*)(p->ws + M_WSEL);
    const bf16_t* hbuf = (const bf16_t*)(p->ws + M_HBUF);
    bf16_t* ybuf = (bf16_t*)(p->ws + M_YBUF);
    const bf16_t* W2 = (const bf16_t*)(p->ws + OFF_W2) + (size_t)(l * 65) * 1024 * 256;
    const int total = pref[65] * 8;
    int R[4], C[4]; stage_coords(R, C);
    const int tid = TIDX();
    auto ptrs = [&](int t, const bf16_t* (&ap)[4], const bf16_t* (&bp)[4]) {
        const int mg = t >> 3, nt = t & 7;
        int e = 0; while (pref[e + 1] <= mg) ++e;
#pragma unroll
        for (int i = 0; i < 4; ++i) {
            ap[i] = hbuf + ((size_t)mg * 128 + R[i]) * 256 + C[i];
            bp[i] = W2 + ((size_t)e * 1024 + nt * 128 + R[i]) * 256 + C[i];
        }
    };
    auto epi = [&](int t, f32x4 (&acc)[4][4], int wr, int wc, int fr, int fq) {
        const int mg = t >> 3, nt = t & 7;
        int e = 0; while (pref[e + 1] <= mg) ++e;
        const int mt = mg - pref[e], Me = cntl[e];
        char* stg = lds + 32768;
        __syncthreads();
#pragma unroll
        for (int m = 0; m < 4; ++m) {
            const int lrow = wr * 64 + m * 16 + fr, idx = mt * 128 + lrow;
            int drow = -1; float w = 0.f;
            if (idx < Me) {
                if (e < 64) { const int ts = list[(size_t)e * NTOK + idx]; w = wsel[ts]; drow = (ts >> 3) * 9 + (ts & 7); }
                else { w = 1.f; drow = idx * 9 + 8; }
            }
            if (wc == 0 && fq == 0) rowdst[lrow] = drow;
#pragma unroll
            for (int n = 0; n < 4; ++n) {
                uint2 o; o.x = pack2(w * acc[m][n][0], w * acc[m][n][1]); o.y = pack2(w * acc[m][n][2], w * acc[m][n][3]);
                *(uint2*)(stg + lrow * 256 + (wc * 64 + n * 16 + fq * 4) * 2) = o;
            }
        }
        __syncthreads();
#pragma unroll
        for (int i = 0; i < 8; ++i) {
            const int lrow = i * 16 + (tid >> 4), ch = tid & 15;
            const int drow = rowdst[lrow];
            const uint4 v = *(const uint4*)(stg + lrow * 256 + ch * 16);
            if (drow >= 0) *(uint4*)(ybuf + (size_t)drow * 1024 + nt * 128 + ch * 8) = v;
        }
    };
    gemm_stream128(lds, 256, blk, nb, total, ptrs, epi);
}

DEVINL void phaseF(KP p, int l, const int dry = 0) {
    const int tid = TIDX(), nb = gridDim.x, blk = BIDX(), wid = tid >> 6, lane = tid & 63;
    const float* xbuf = p->out;
    float* xout = dry ? (float*)(p->ws + M_HBUF) : p->out;
    const bf16_t* ybuf = (const bf16_t*)(p->ws + M_YBUF);
    bf16_t* ubuf = (bf16_t*)(p->ws + OFF_UBUF);
    const float* mod = (const float*)(p->ws + OFF_MOD);
    for (int row = blk * 4 + wid; row < NTOK; row += nb * 4) {
        const int b = row >> 12;
        float4 z[4]; float s = 0.f;
#pragma unroll
        for (int i = 0; i < 4; ++i) {
            const int col = i * 256 + lane * 4;
            const float4 x1 = *(const float4*)(xbuf + (size_t)row * DM + col);
            float f0 = 0.f, f1 = 0.f, f2 = 0.f, f3 = 0.f;
#pragma unroll
            for (int k = 0; k < 9; ++k) {
                const uint2 yv = *(const uint2*)(ybuf + ((size_t)row * 9 + k) * 1024 + col);
                f0 += __uint_as_float(yv.x << 16); f1 += __uint_as_float(yv.x & 0xFFFF0000u); f2 += __uint_as_float(yv.y << 16); f3 += __uint_as_float(yv.y & 0xFFFF0000u);
            }
            const float4 g2 = *(const float4*)(mod + (size_t)(l * 8 + b) * 6144 + 5120 + col);
            z[i].x = ALPHA * x1.x + (1.f + g2.x) * f0; z[i].y = ALPHA * x1.y + (1.f + g2.y) * f1; z[i].z = ALPHA * x1.z + (1.f + g2.z) * f2; z[i].w = ALPHA * x1.w + (1.f + g2.w) * f3;
            s += z[i].x + z[i].y + z[i].z + z[i].w;
        }
        const float mean = wave_sum(s) * (1.f / 1024.f);
        float q = 0.f;
#pragma unroll
        for (int i = 0; i < 4; ++i) { z[i].x -= mean; z[i].y -= mean; z[i].z -= mean; z[i].w -= mean; q += z[i].x * z[i].x + z[i].y * z[i].y + z[i].z * z[i].z + z[i].w * z[i].w; }
        const float rs = rsqrtf(wave_sum(q) * (1.f / 1024.f) + LN_EPS);
#pragma unroll
        for (int i = 0; i < 4; ++i) {
            const int col = i * 256 + lane * 4;
            const float4 g = *(const float4*)(p->in[I_LN2G] + l * 1024 + col), bb = *(const float4*)(p->in[I_LN2B] + l * 1024 + col);
            float4 x2; x2.x = z[i].x * rs * g.x + bb.x; x2.y = z[i].y * rs * g.y + bb.y; x2.z = z[i].z * rs * g.z + bb.z; x2.w = z[i].w * rs * g.w + bb.w;
            *(float4*)(xout + (size_t)row * DM + col) = x2;
            if (l + 1 < DEPTH) {
                const float4 sh = *(const float4*)(mod + (size_t)((l + 1) * 8 + b) * 6144 + col), sc = *(const float4*)(mod + (size_t)((l + 1) * 8 + b) * 6144 + 1024 + col);
                uint2 o; o.x = pack2(x2.x * (1.f + sc.x) + sh.x, x2.y * (1.f + sc.y) + sh.y); o.y = pack2(x2.z * (1.f + sc.z) + sh.z, x2.w * (1.f + sc.w) + sh.w);
                *(uint2*)(ubuf + (size_t)row * DM + col) = o;
            }
        }
    }
}

#define XB_TMO      128
#define XB_XCNT(j)  (256  + 64 * (j))
#define XB_XSUB(j)  (1280 + 64 * (j))
#define XB_XGEN(j)  (2304 + 64 * (j))
#define XB_TOP      3328
#define XB_TOPGEN   3392
#define XCD_BAR_WORDS 3456
#define XB_SPIN_CAP (1u << 20)
#define LAS __attribute__((address_space(3)))
DEVINL unsigned xb_ld(unsigned* p)              { return __hip_atomic_load(p, __ATOMIC_RELAXED, __HIP_MEMORY_SCOPE_AGENT); }
DEVINL unsigned xb_add(unsigned* p, unsigned v) { return __hip_atomic_fetch_add(p, v, __ATOMIC_RELAXED, __HIP_MEMORY_SCOPE_AGENT); }
DEVINL unsigned xb_xcc_id() { return (unsigned)__builtin_amdgcn_s_getreg((3 << 11) | 20) & 0xFu; }
#define XB_SPIN(cond, bar) do { unsigned _sp = 0; while (cond) { __builtin_amdgcn_s_sleep(1); \
    if ((++_sp & 255u) == 0u) { if (xb_ld(&(bar)[XB_TMO])) break; if (_sp > XB_SPIN_CAP) { atomicAdd(&(bar)[XB_TMO], 1u); break; } } } } while (0)
struct XcdBarrier { unsigned* bar; unsigned x; volatile LAS unsigned* st; };
DEVINL XcdBarrier xcd_barrier_post(unsigned* bar, volatile LAS unsigned* st) {
    XcdBarrier b; b.bar = bar; b.x = xb_xcc_id(); b.st = st;
    if (threadIdx.x == 0) (void)xb_add(&bar[XB_XCNT(b.x)], 1u);
    return b;
}
DEVINL void xcd_barrier_complete(unsigned* bar, unsigned x, unsigned& nloc, unsigned& nx) {
    const unsigned G = gridDim.x * gridDim.y * gridDim.z;
    unsigned sum, cnt, mine, sp = 0u;
    for (;;) {
        sum = 0u; cnt = 0u; mine = 0u;
#pragma unroll
        for (unsigned j = 0; j < 16; ++j) { const unsigned c = xb_ld(&bar[XB_XCNT(j)]); sum += c; cnt += (c > 0u) ? 1u : 0u; mine = (j == x) ? c : mine; }
        if (sum == G) break;
        __builtin_amdgcn_s_sleep(1);
        if ((++sp & 255u) == 0u) { if (xb_ld(&bar[XB_TMO])) break; if (sp > XB_SPIN_CAP) { atomicAdd(&bar[XB_TMO], 1u); break; } }
    }
    nloc = mine > 0u ? mine : 1u; nx = cnt > 0u ? cnt : 1u;
}
DEVINL void xcd_barrier(const XcdBarrier& b) {
    asm volatile("s_waitcnt vmcnt(0)" ::: "memory");
    __syncthreads();
    if (threadIdx.x == 0) {
        unsigned* bar = b.bar;
        __builtin_amdgcn_s_waitcnt(0);
        unsigned nloc = b.st[0], nx = b.st[1];
        if (nloc == 0u) { xcd_barrier_complete(bar, b.x, nloc, nx); b.st[0] = nloc; b.st[1] = nx; }
        const unsigned old = xb_add(&bar[XB_XSUB(b.x)], 1u);
        const unsigned gen = old / nloc;
        if (old + 1u == (gen + 1u) * nloc) {
            __builtin_amdgcn_fence(__ATOMIC_RELEASE, "agent");
            asm volatile("s_waitcnt vmcnt(0)" ::: "memory");
            const unsigned og = xb_add(&bar[XB_TOP], 1u);
            const unsigned tg = og / nx;
            if (og + 1u == (tg + 1u) * nx) xb_add(&bar[XB_TOPGEN], 1u);
            else XB_SPIN(xb_ld(&bar[XB_TOPGEN]) == tg, bar);
            __builtin_amdgcn_fence(__ATOMIC_ACQUIRE, "agent");
            xb_add(&bar[XB_XGEN(b.x)], 1u);
            asm volatile("s_waitcnt vmcnt(0)" ::: "memory");
        } else {
            XB_SPIN(xb_ld(&bar[XB_XGEN(b.x)]) == gen, bar);
            __builtin_amdgcn_fence(__ATOMIC_ACQUIRE, "agent");
            asm volatile("s_waitcnt vmcnt(0)" ::: "memory");
        }
    }
    __syncthreads();
}

constexpr int PPL = 12;
constexpr int NPHASE = 2 + PPL * DEPTH;
#ifndef PROBE_SUB
#define PROBE_SUB 3
#endif
#ifndef PROBE_REP
#define PROBE_REP (-1)
#endif
__global__ void __launch_bounds__(NTHREADS, 2) mega(Params p_arg, int ph_lo, int ph_hi) {
    extern __shared__ __attribute__((aligned(16))) char lds[];
    cg::grid_group grid = cg::this_grid();
    volatile LAS unsigned* st = (volatile LAS unsigned*)(lds + LDS_BYTES - 16);
    if (threadIdx.x == 0) { st[0] = 0u; st[1] = 0u; }
    __syncthreads();
    XcdBarrier xb = xcd_barrier_post((unsigned*)(p_arg.ws + OFF_BAR), st);
    for (int ph = ph_lo; ph < ph_hi; ++ph) {
        KP p = (KP)__builtin_amdgcn_kernarg_segment_ptr();
        asm volatile("" : "+s"(p));
        const int l = (ph >= 2) ? (ph - 2) / PPL : 0;
        const int q = (ph >= 2) ? (ph - 2) % PPL : -1;
        for (int rep = 0; rep < ((ph == PROBE_REP) ? 2 : 1); ++rep) {
            const int dry = (ph == PROBE_REP && rep == 0) ? 1 : 0;
            if (ph == 0) phase0(p, lds);
            else if (ph == 1) phaseF0(p);
            else {
                switch (q) {
                    case 0: phaseA(p, l, lds); break;
                    case 1: phaseB1(p, l, lds, 1, (ph == PROBE_REP && rep == 1) ? PROBE_SUB : 3); break;
                    case 2: phaseB1(p, l, lds, 2); break;
                    case 3: phaseB1(p, l, lds, 4); break;
                    case 4: phaseB1(p, l, lds, 8); break;
                    case 5: phaseB2(p, l); break;
                    case 6: phaseB3(p, l); break;
                    case 7: phaseC(p, l, lds); break;
                    case 8: phaseD(p, l, lds, dry); break;
                    case 9: phaseE1(p, l, lds); break;
                    case 10: phaseE2(p, l, lds); break;
                    default: phaseF(p, l, dry); break;
                }
            }
            if (rep == 0 && ph == PROBE_REP) xcd_barrier(xb);
        }
        const bool nobar = (q >= 1 && q <= 3);
        if (ph + 1 < ph_hi && !nobar) { if (ph == ph_lo) grid.sync(); else xcd_barrier(xb); }
    }
}

extern "C" void kernel_launch(void* const* d_in, const int* in_sizes, int n_in, void* d_out, int out_size, void* d_ws, size_t ws_size, hipStream_t stream) {
    static int grid_blocks = 0;
    if (grid_blocks == 0) {
        if (n_in != 39 || out_size != NTOK * DM || ws_size < WS_NEED) { fprintf(stderr, "kernel_launch: unexpected shapes (n_in %d out %d ws %zu need %zu)\n", n_in, out_size, ws_size, (size_t)WS_NEED); grid_blocks = -1; return; }
        int dev = 0, cus = 0, per_cu = 0;
        hipGetDevice(&dev);
        hipDeviceGetAttribute(&cus, hipDeviceAttributeMultiprocessorCount, dev);
        hipFuncSetAttribute((const void*)mega, hipFuncAttributeMaxDynamicSharedMemorySize, LDS_BYTES);
        hipOccupancyMaxActiveBlocksPerMultiprocessor(&per_cu, (const void*)mega, NTHREADS, LDS_BYTES);
        if (per_cu < 1) { fprintf(stderr, "kernel_launch: occupancy query returned %d\n", per_cu); grid_blocks = -1; return; }
        if (per_cu > 2) per_cu = 2;
        grid_blocks = cus * per_cu;
    }
    if (grid_blocks < 0) return;
    if (hipMemsetAsync(d_ws, 0, 32768, stream) != hipSuccess) { fprintf(stderr, "kernel_launch: memset failed\n"); return; }
    Params p{};
    for (int i = 0; i < 39; ++i) p.in[i] = (const float*)d_in[i];
    p.out = (float*)d_out; p.ws = (unsigned char*)d_ws;
    int ph_lo = 0, ph_hi = NPHASE;
    void* args[] = {&p, &ph_lo, &ph_hi};
    hipError_t e = hipLaunchCooperativeKernel((const void*)mega, dim3(grid_blocks), dim3(NTHREADS), args, LDS_BYTES, stream);
    if (e != hipSuccess) fprintf(stderr, "cooperative launch failed: %s (grid %d)\n", hipGetErrorString(e), grid_blocks);
}
```

```cpp
#include <hip/hip_runtime.h>
#include <hip/hip_cooperative_groups.h>
#include <stdio.h>
#include <stdint.h>
namespace cg = cooperative_groups;

typedef unsigned short bf16_t;
typedef short bf16x8 __attribute__((ext_vector_type(8)));
typedef float f32x4 __attribute__((ext_vector_type(4)));
#define DEVINL __device__ __forceinline__
#define LAS __attribute__((address_space(3)))

constexpr int NTOK = 32768, SEQ = 4096, NBATCH = 8, DM = 1024, PIN = 2688, DEPTH = 2;
constexpr int NEXP = 64;
constexpr float ALPHA = 1.41421356237f;
constexpr float LN_EPS = 1e-5f, GN_EPS = 64e-5f;
constexpr int NTHREADS = 512;
constexpr int VTHREADS = 256;
constexpr int LDS_HALF = 75776;
constexpr int LDS_BYTES = 152064;

constexpr size_t OFF_CNT   = 0;
constexpr size_t OFF_BAR   = 4096;
constexpr size_t OFF_MOD   = 65536;
constexpr size_t OFF_WIN   = 1048576;
constexpr int WIN_ROWS = 2816;
constexpr size_t OFF_WOUT  = OFF_WIN + 2 * (size_t)WIN_ROWS * 1024 * 2;
constexpr size_t OFF_W13   = OFF_WOUT + 4194304;
constexpr size_t OFF_W2    = OFF_W13 + 136314880;
constexpr size_t OFF_UBUF  = OFF_W2 + 68157440;
constexpr size_t OFF_ARENA = OFF_UBUF + 67108864;
constexpr size_t A_P      = OFF_ARENA;
constexpr size_t A_YMIX   = A_P + 176160768;
constexpr size_t A_SCAN   = A_YMIX + 67108864;
constexpr size_t A_HLOC   = A_SCAN + 134217728;
constexpr size_t A_CUMA   = A_HLOC + 33554432;
constexpr size_t A_G      = A_CUMA + 33554432;
constexpr size_t A_BONUS  = A_G + 33554432;
constexpr size_t A_YRAW   = A_BONUS + 33554432;
constexpr size_t A_CARRYA = A_YRAW + 33554432;
constexpr size_t A_CARRYH = A_CARRYA + 1048576;
constexpr size_t A_HSTART = A_CARRYH + 1048576;
constexpr size_t A_CHAIN  = A_HSTART + 1048576;
constexpr size_t CHAIN_UNIT = 49152;
constexpr size_t M_YBUF   = OFF_ARENA;
constexpr size_t M_HBUF   = M_YBUF + 603979776;
constexpr size_t M_LIST   = M_HBUF + 159383552;
constexpr size_t M_WSEL   = M_LIST + 8388608;
constexpr size_t WS_NEED  = M_WSEL + 1048576;

struct Params {
    const float* in[39];
    float* out;
    unsigned char* ws;
};
typedef const __attribute__((address_space(4))) Params* KP;
__device__ __forceinline__ int TIDX() { int t = threadIdx.x & 255; asm volatile("" : "+v"(t)); __builtin_assume(t >= 0 && t < 256); return t; }
__device__ __forceinline__ int BIDX() { int b = blockIdx.x * 2 + __builtin_amdgcn_readfirstlane((int)(threadIdx.x >> 8)); asm volatile("" : "+s"(b)); __builtin_assume(b >= 0 && b < 65536); return b; }
__device__ __forceinline__ int NBV() { return gridDim.x * 2; }
__device__ __forceinline__ int TID512() { int t = threadIdx.x; asm volatile("" : "+v"(t)); __builtin_assume(t >= 0 && t < 512); return t; }
enum { I_X = 0, I_C, I_WMOD, I_BMOD, I_WIN, I_WOUT, I_CONVA, I_CONVAB, I_LNAG, I_LNAB, I_CONVB, I_CONVBB, I_WRG, I_BRG, I_WIG, I_BIG,
       I_LAMBDA, I_MUC, I_W0, I_WW2, I_A0, I_WA2, I_WG2, I_KK, I_KA, I_RK, I_GNG, I_GNB, I_CONVD, I_LN1G, I_LN1B, I_WROUTER, I_EBIAS,
       I_W13, I_W2, I_WS13, I_WS2, I_LN2G, I_LN2B };

DEVINL bf16_t f2bf(float f) { unsigned u = __float_as_uint(f); u += 0x7FFFu + ((u >> 16) & 1u); return (bf16_t)(u >> 16); }
DEVINL float bf2f(bf16_t h) { return __uint_as_float(((unsigned)h) << 16); }
typedef __bf16 bf2_t __attribute__((ext_vector_type(2)));
typedef float f2_t __attribute__((ext_vector_type(2)));
typedef float f32x16 __attribute__((ext_vector_type(16)));
DEVINL unsigned pack2(float a, float b) { f2_t v = {a, b}; return __builtin_bit_cast(unsigned, __builtin_convertvector(v, bf2_t)); }
DEVINL float sigm(float x) { return 1.f / (1.f + __expf(-x)); }
DEVINL float tanh_fast(float x) { const float e = __expf(2.f * x); return 1.f - 2.f / (1.f + e); }
DEVINL float softplusf(float z) { return fmaxf(z, 0.f) + __logf(1.f + __expf(-fabsf(z))); }
DEVINL float softplus_acc(float z) { return fmaxf(z, 0.f) + log1pf(__expf(-fabsf(z))); }
DEVINL float gelu_tanh(float x) { float u = 0.7978845608028654f * (x + 0.044715f * x * x * x); return 0.5f * x * (1.f + tanh_fast(u)); }
DEVINL float wave_sum(float x) {
#pragma unroll
    for (int o = 32; o > 0; o >>= 1) x += __shfl_xor(x, o);
    return x;
}
DEVINL float dppf(float x, const int ctrl_unused) { return x; }
DEVINL float wave_sum_dpp(float x) {
    x += __builtin_bit_cast(float, __builtin_amdgcn_update_dpp(0, __builtin_bit_cast(int, x), 0xB1, 0xf, 0xf, true));
    x += __builtin_bit_cast(float, __builtin_amdgcn_update_dpp(0, __builtin_bit_cast(int, x), 0x4E, 0xf, 0xf, true));
    x += __builtin_bit_cast(float, __builtin_amdgcn_update_dpp(0, __builtin_bit_cast(int, x), 0x141, 0xf, 0xf, true));
    x += __builtin_bit_cast(float, __builtin_amdgcn_update_dpp(0, __builtin_bit_cast(int, x), 0x140, 0xf, 0xf, true));
    x += __builtin_bit_cast(float, __builtin_amdgcn_update_dpp(0, __builtin_bit_cast(int, x), 0x142, 0xa, 0xf, false));
    x += __builtin_bit_cast(float, __builtin_amdgcn_update_dpp(0, __builtin_bit_cast(int, x), 0x143, 0xc, 0xf, false));
    return __builtin_bit_cast(float, __builtin_amdgcn_readlane(__builtin_bit_cast(int, x), 63));
}

DEVINL int lds_byte(int r, int c) { int st = (r >> 4) * 2 + (c >> 5), rr = r & 15, cc = c & 31, ob = rr * 64 + cc * 2; return st * 1024 + (ob ^ (((ob >> 9) & 1) << 5)); }
DEVINL void stage_rc(int b, int& R, int& C) { int st = b / 1024, sb = b % 1024, swz = sb ^ (((sb >> 9) & 1) << 5); R = (st >> 1) * 16 + swz / 64; C = (st & 1) * 32 + (swz % 64) / 2; }

template <class RowPtr, class Epi>
DEVINL void gemm_tile128(char* lds, RowPtr arow, const bf16_t* Bt, int K, Epi epi) {
    const int tid = TIDX();
    const bf16_t* ap[4]; const bf16_t* bp[4];
#pragma unroll
    for (int i = 0; i < 4; ++i) { int R, C; stage_rc(tid * 16 + i * 4096, R, C); ap[i] = arow(R) + C; bp[i] = Bt + (size_t)R * K + C; }
    const int wid = tid >> 6, lane = tid & 63, wr = wid >> 1, wc = wid & 1, fr = lane & 15, fq = lane >> 4;
    f32x4 acc[4][4];
#pragma unroll
    for (int m = 0; m < 4; ++m)
#pragma unroll
        for (int n = 0; n < 4; ++n) acc[m][n] = (f32x4){0.f, 0.f, 0.f, 0.f};
    const int nk = K >> 6;
#pragma unroll
    for (int i = 0; i < 4; ++i) {
        __builtin_amdgcn_global_load_lds((const unsigned*)(ap[i]), (unsigned*)(lds + tid * 16 + i * 4096), 16, 0, 0);
        __builtin_amdgcn_global_load_lds((const unsigned*)(bp[i]), (unsigned*)(lds + 16384 + tid * 16 + i * 4096), 16, 0, 0);
    }
    for (int kt = 0; kt < nk; ++kt) {
        asm volatile("s_waitcnt vmcnt(0)" ::: "memory");
        __syncthreads();
        char* cur = lds + (kt & 1) * 32768;
        if (kt + 1 < nk) {
            char* nxt = lds + ((kt + 1) & 1) * 32768;
            const int ko = (kt + 1) * 64;
#pragma unroll
            for (int i = 0; i < 4; ++i) {
                __builtin_amdgcn_global_load_lds((const unsigned*)(ap[i] + ko), (unsigned*)(nxt + tid * 16 + i * 4096), 16, 0, 0);
                __builtin_amdgcn_global_load_lds((const unsigned*)(bp[i] + ko), (unsigned*)(nxt + 16384 + tid * 16 + i * 4096), 16, 0, 0);
            }
        }
        bf16x8 af[4][2], bfr[4][2];
#pragma unroll
        for (int m = 0; m < 4; ++m)
#pragma unroll
            for (int kk = 0; kk < 2; ++kk) af[m][kk] = *reinterpret_cast<const bf16x8*>(cur + lds_byte(wr * 64 + m * 16 + fr, kk * 32 + fq * 8));
#pragma unroll
        for (int n = 0; n < 4; ++n)
#pragma unroll
            for (int kk = 0; kk < 2; ++kk) bfr[n][kk] = *reinterpret_cast<const bf16x8*>(cur + 16384 + lds_byte(wc * 64 + n * 16 + fr, kk * 32 + fq * 8));
#pragma unroll
        for (int kk = 0; kk < 2; ++kk)
#pragma unroll
            for (int m = 0; m < 4; ++m)
#pragma unroll
                for (int n = 0; n < 4; ++n) acc[m][n] = __builtin_amdgcn_mfma_f32_16x16x32_bf16(bfr[n][kk], af[m][kk], acc[m][n], 0, 0, 0);
    }
    __syncthreads();
    epi(acc, wr, wc, fr, fq);
}

template <class Ptrs, class Epi>
DEVINL void gemm_stream128(char* lds, int K, int blk, int nb, int total, Ptrs ptrs, Epi epi) {
    const int qx = nb >> 3, first = (blk & 7) * qx + (blk >> 3), stride = nb;
    if (first >= total) return;
    const int tid = TIDX();
    const int wid = tid >> 6, lane = tid & 63, wr = wid >> 1, wc = wid & 1, fr = lane & 15, fq = lane >> 4;
    const int nk = K >> 6;
    const bf16_t* ap[4]; const bf16_t* bp[4];
    const bf16_t* an[4]; const bf16_t* bn[4];
    int t = first;
    ptrs(t, ap, bp);
#pragma unroll
    for (int i = 0; i < 4; ++i) {
        __builtin_amdgcn_global_load_lds((const unsigned*)(ap[i]), (unsigned*)(lds + tid * 16 + i * 4096), 16, 0, 0);
        __builtin_amdgcn_global_load_lds((const unsigned*)(bp[i]), (unsigned*)(lds + 16384 + tid * 16 + i * 4096), 16, 0, 0);
    }
    for (;;) {
        const int tn = t + stride;
        const bool has_next = tn < total;
        if (has_next) ptrs(tn, an, bn);
        f32x4 acc[4][4];
#pragma unroll
        for (int m = 0; m < 4; ++m)
#pragma unroll
            for (int n = 0; n < 4; ++n) acc[m][n] = (f32x4){0.f, 0.f, 0.f, 0.f};
        for (int kt = 0; kt < nk; ++kt) {
            asm volatile("s_waitcnt vmcnt(0)" ::: "memory");
            __syncthreads();
            char* cur = lds + (kt & 1) * 32768;
            if (kt + 1 < nk) {
                char* nxt = lds + ((kt + 1) & 1) * 32768;
                const int ko = (kt + 1) * 64;
#pragma unroll
                for (int i = 0; i < 4; ++i) {
                    __builtin_amdgcn_global_load_lds((const unsigned*)(ap[i] + ko), (unsigned*)(nxt + tid * 16 + i * 4096), 16, 0, 0);
                    __builtin_amdgcn_global_load_lds((const unsigned*)(bp[i] + ko), (unsigned*)(nxt + 16384 + tid * 16 + i * 4096), 16, 0, 0);
                }
            } else if (has_next) {
#pragma unroll
                for (int i = 0; i < 4; ++i) {
                    __builtin_amdgcn_global_load_lds((const unsigned*)(an[i]), (unsigned*)(lds + tid * 16 + i * 4096), 16, 0, 0);
                    __builtin_amdgcn_global_load_lds((const unsigned*)(bn[i]), (unsigned*)(lds + 16384 + tid * 16 + i * 4096), 16, 0, 0);
                }
            }
            bf16x8 af[4][2], bfr[4][2];
#pragma unroll
            for (int m = 0; m < 4; ++m)
#pragma unroll
                for (int kk = 0; kk < 2; ++kk) af[m][kk] = *reinterpret_cast<const bf16x8*>(cur + lds_byte(wr * 64 + m * 16 + fr, kk * 32 + fq * 8));
#pragma unroll
            for (int n = 0; n < 4; ++n)
#pragma unroll
                for (int kk = 0; kk < 2; ++kk) bfr[n][kk] = *reinterpret_cast<const bf16x8*>(cur + 16384 + lds_byte(wc * 64 + n * 16 + fr, kk * 32 + fq * 8));
#pragma unroll
            for (int kk = 0; kk < 2; ++kk)
#pragma unroll
                for (int m = 0; m < 4; ++m)
#pragma unroll
                    for (int n = 0; n < 4; ++n) acc[m][n] = __builtin_amdgcn_mfma_f32_16x16x32_bf16(bfr[n][kk], af[m][kk], acc[m][n], 0, 0, 0);
        }
        epi(t, acc, wr, wc, fr, fq);
        if (!has_next) break;
        t = tn;
#pragma unroll
        for (int i = 0; i < 4; ++i) { ap[i] = an[i]; bp[i] = bn[i]; }
    }
    __syncthreads();
}
DEVINL void stage_coords(int (&R)[4], int (&C)[4]) {
    const int tid = TIDX();
#pragma unroll
    for (int i = 0; i < 4; ++i) stage_rc(tid * 16 + i * 4096, R[i], C[i]);
}

struct GUnit {
    const char* A;
    const char* B;
    unsigned va[2][2] = {{0u, 0u}, {0u, 0u}};
    int i0, i1, i2;
};
constexpr int G_HTB = 128 * 64 * 2;
constexpr int G_STAGE_BYTES = 8 * G_HTB;
DEVINL int perm32(int rho) { const int n = rho >> 4, i = rho & 15; return 8 * (i >> 2) + 4 * n + (i & 3); }
DEVINL void stage_coords512(int tid, int (&R)[2], int (&C)[2]) {
#pragma unroll
    for (int i = 0; i < 2; ++i) stage_rc(tid * 16 + i * 8192, R[i], C[i]);
}

template <bool PERM, bool GATHER, class Sched, class Epi>
DEVINL void gemm256(char* lds_generic, int K, int lda, Sched sched, Epi epi) {
    LAS unsigned char* lds = (LAS unsigned char*)lds_generic;
    const int tid = TID512(), wid = __builtin_amdgcn_readfirstlane(tid >> 6), lane = tid & 63, wr = wid >> 2, wc = wid & 3, fr = lane & 15, fq = lane >> 4;
    const int nt = K / 64;
    unsigned voffB[2];
#pragma unroll
    for (int i = 0; i < 2; ++i) { int R, C; stage_rc(tid * 16 + i * 8192, R, C); const int Rb = PERM ? ((R & ~31) + perm32(R & 31)) : R; voffB[i] = (unsigned)(Rb * K + C) * 2u; }
    unsigned voffA[2];
#pragma unroll
    for (int i = 0; i < 2; ++i) { int R, C; stage_rc(tid * 16 + i * 8192, R, C); voffA[i] = (unsigned)(R * lda + C) * 2u; }
    const size_t hstepA = GATHER ? 0 : (size_t)128 * lda * 2;
    const size_t kstep = (size_t)(64 * 2);
    const size_t hstepB = (size_t)128 * K * 2;
    const unsigned ldsw = (unsigned)wid * 1024u;
    const int aoff = lds_byte(wr * 64 + fr, fq * 8), boff = lds_byte(wc * 32 + fr, fq * 8);
#define G_SA(b, h) (((b) * 2 + (h)) * G_HTB)
#define G_SB(b, h) ((4 + (b) * 2 + (h)) * G_HTB)
#define G_STAGE(bufoff, gbase, voff) do { _Pragma("unroll") for (int _i = 0; _i < 2; ++_i) { unsigned _vo = (voff)[_i]; asm volatile("" : "+v"(_vo)); \
        __builtin_amdgcn_global_load_lds((const unsigned*)((const char*)(gbase) + _vo), (LAS unsigned*)(lds + (bufoff) + ldsw + _i * 8192), 16, 0, 0); } } while (0)
#define G_STAGE_A(bufoff, ptr, vg, h) do { if constexpr (GATHER) { G_STAGE(bufoff, ptr, vg); } else { G_STAGE(bufoff, (ptr) + (h) * hstepA, voffA); } } while (0)
#define G_LDA(dst, b, h) do { _Pragma("unroll") for (int m = 0; m < 4; ++m) _Pragma("unroll") for (int k = 0; k < 2; ++k) dst[m][k] = *(const LAS bf16x8*)(lds + G_SA(b, h) + aoff + m * 2048 + k * 1024); } while (0)
#define G_LDB(dst, b, h) do { _Pragma("unroll") for (int n = 0; n < 2; ++n) _Pragma("unroll") for (int k = 0; k < 2; ++k) dst[n][k] = *(const LAS bf16x8*)(lds + G_SB(b, h) + boff + n * 2048 + k * 1024); } while (0)
#define G_MMA(ai, bj, At, Bt) do { __builtin_amdgcn_s_setprio(1); _Pragma("unroll") for (int m = 0; m < 4; ++m) _Pragma("unroll") for (int n = 0; n < 2; ++n) _Pragma("unroll") for (int k = 0; k < 2; ++k) \
        acc[ai][bj][m][n] = __builtin_amdgcn_mfma_f32_16x16x32_bf16(Bt[n][k], At[m][k], acc[ai][bj][m][n], 0, 0, 0); __builtin_amdgcn_s_setprio(0); } while (0)
#define G_WAIT_V(n) asm volatile("s_waitcnt vmcnt(" #n ")" ::: "memory")
#define G_WAIT_L(n) asm volatile("s_waitcnt lgkmcnt(" #n ")" ::: "memory")
#define G_BAR __builtin_amdgcn_s_barrier()
#define G_SCHED __builtin_amdgcn_sched_barrier(0)
    GUnit cur, nxt; int ui = 0;
    if (!sched(0, cur)) return;
    f32x4 acc[2][2][4][2];
#pragma unroll
    for (int a = 0; a < 2; ++a)
#pragma unroll
        for (int b = 0; b < 2; ++b)
#pragma unroll
            for (int m = 0; m < 4; ++m)
#pragma unroll
                for (int n = 0; n < 2; ++n) acc[a][b][m][n] = (f32x4){0.f, 0.f, 0.f, 0.f};
    bf16x8 At[4][2], B0[2][2], B1[2][2];
    G_STAGE(G_SB(0, 0), cur.B, voffB); G_STAGE_A(G_SA(0, 0), cur.A, cur.va[0], 0); G_STAGE(G_SB(0, 1), cur.B + hstepB, voffB); G_STAGE_A(G_SA(0, 1), cur.A, cur.va[1], 1);
    if (wr == 1) G_BAR;
    G_WAIT_V(4); G_BAR;
    G_STAGE(G_SB(1, 0), cur.B + kstep, voffB); G_STAGE_A(G_SA(1, 0), cur.A + kstep, cur.va[0], 0); G_STAGE(G_SB(1, 1), cur.B + hstepB + kstep, voffB);
    G_WAIT_V(6); G_BAR;
    for (;;) {
        const bool has_next = sched(ui + 1, nxt);
        if (!has_next) nxt = cur;
        for (int t = 0; t < nt; t += 2) {
            const bool last = (t == nt - 2);
            const char* a1 = cur.A + (size_t)(t + 1) * kstep;
            const char* a2 = last ? nxt.A : cur.A + (size_t)(t + 2) * kstep; const char* b2 = last ? nxt.B : cur.B + (size_t)(t + 2) * kstep;
            const char* a3 = a2 + kstep; const char* b3 = b2 + kstep;
            unsigned vh0[2] = {0u, 0u}, vh1[2] = {0u, 0u};
            if constexpr (GATHER) { vh0[0] = last ? nxt.va[0][0] : cur.va[0][0]; vh0[1] = last ? nxt.va[0][1] : cur.va[0][1]; vh1[0] = last ? nxt.va[1][0] : cur.va[1][0]; vh1[1] = last ? nxt.va[1][1] : cur.va[1][1]; }
            G_LDB(B0, 0, 0); G_SCHED; G_LDA(At, 0, 0); G_STAGE_A(G_SA(1, 1), a1, cur.va[1], 1);
            G_WAIT_L(8); G_BAR; G_WAIT_L(0); G_MMA(0, 0, At, B0); G_BAR; G_SCHED;
            G_LDB(B1, 0, 1); G_STAGE(G_SB(0, 0), b2, voffB);
            G_BAR; G_WAIT_L(0); G_MMA(0, 1, At, B1); G_BAR;
            G_LDA(At, 0, 1); G_STAGE_A(G_SA(0, 0), a2, vh0, 0);
            G_BAR; G_WAIT_L(0); G_MMA(1, 0, At, B0); G_BAR; G_SCHED;
            G_STAGE(G_SB(0, 1), b2 + hstepB, voffB);
            G_WAIT_V(6); G_BAR; G_MMA(1, 1, At, B1); G_BAR;
            G_LDB(B0, 1, 0); G_SCHED; G_LDA(At, 1, 0); G_STAGE_A(G_SA(0, 1), a2, vh1, 1);
            G_WAIT_L(8); G_BAR; G_WAIT_L(0); G_MMA(0, 0, At, B0); G_BAR; G_SCHED;
            G_LDB(B1, 1, 1); G_STAGE(G_SB(1, 0), b3, voffB);
            G_BAR; G_WAIT_L(0); G_MMA(0, 1, At, B1); G_BAR;
            G_LDA(At, 1, 1); G_STAGE_A(G_SA(1, 0), a3, vh0, 0);
            G_BAR; G_WAIT_L(0); G_MMA(1, 0, At, B0); G_BAR; G_SCHED;
            G_STAGE(G_SB(1, 1), b3 + hstepB, voffB);
            G_WAIT_V(6); G_BAR; G_MMA(1, 1, At, B1); G_BAR;
        }
        { const int l2 = TID512() & 63; epi(acc, cur, wr, wc, l2 & 15, l2 >> 4); }
        if (!has_next) break;
#pragma unroll
        for (int a = 0; a < 2; ++a)
#pragma unroll
            for (int b = 0; b < 2; ++b)
#pragma unroll
                for (int m = 0; m < 4; ++m)
#pragma unroll
                    for (int n = 0; n < 2; ++n) acc[a][b][m][n] = (f32x4){0.f, 0.f, 0.f, 0.f};
        cur = nxt; ++ui;
    }
    G_WAIT_V(0);
    if (wr == 0) G_BAR;
    G_BAR;
#undef G_SA
#undef G_STAGE_A
#undef G_SB
#undef G_STAGE
#undef G_LDA
#undef G_LDB
#undef G_MMA
#undef G_WAIT_V
#undef G_WAIT_L
#undef G_BAR
#undef G_SCHED
}
DEVINL long unit_linear(int i, int c, int G) { const int q = G >> 3; return ((long)i * 8 + (c & 7)) * q + (c >> 3); }

DEVINL void phase0(KP p, char* lds) {
    const int tid = TIDX(), nb = NBV(), blk = BIDX();
    if (blk == 0 && tid < 128) ((unsigned*)(p->ws + OFF_CNT))[tid] = 0u;
    if (blk < 192) {
        float* sc = (float*)lds;
        float* part = (float*)(lds + 32768);
        for (int i = tid; i < 8192; i += VTHREADS) { float c = p->in[I_C][i]; sc[i] = c * sigm(c); }
        __syncthreads();
        const int cl = tid & 63, ks = tid >> 6, n = blk * 64 + cl, l = n / 6144, nn = n % 6144;
        const float* w = p->in[I_WMOD] + (size_t)l * 1024 * 6144 + (size_t)(ks * 256) * 6144 + nn;
        float acc[8];
#pragma unroll
        for (int b = 0; b < 8; ++b) acc[b] = 0.f;
#pragma unroll 16
        for (int k = 0; k < 256; ++k) {
            const float wv = w[(size_t)k * 6144];
#pragma unroll
            for (int b = 0; b < 8; ++b) acc[b] = fmaf(sc[b * 1024 + ks * 256 + k], wv, acc[b]);
        }
#pragma unroll
        for (int b = 0; b < 8; ++b) part[(ks * 8 + b) * 64 + cl] = acc[b];
        __syncthreads();
        if (tid < 64) {
            const float bm = p->in[I_BMOD][l * 6144 + nn];
            float* mod = (float*)(p->ws + OFF_MOD);
#pragma unroll
            for (int b = 0; b < 8; ++b) mod[(size_t)(l * 8 + b) * 6144 + nn] = part[(0 * 8 + b) * 64 + cl] + part[(1 * 8 + b) * 64 + cl] + part[(2 * 8 + b) * 64 + cl] + part[(3 * 8 + b) * 64 + cl] + bm;
        }
        __syncthreads();
    }
    float* tile = (float*)lds;
    const int PER_L = 672 + 256 + 8320 + 4160;
    for (int base = 0; base < 2 * PER_L; base += nb) {
        const int id = (base + blk < 2 * PER_L) ? base + blk : 2 * PER_L - 1;
        const int l = id / PER_L; int r = id % PER_L;
        const float* src; bf16_t* dst; int K, ld, perm, kt, nt;
        if (r < 672) { src = p->in[I_WIN] + (size_t)l * 1024 * 2688; K = 1024; ld = 2688; perm = 0; dst = (bf16_t*)(p->ws + OFF_WIN) + (size_t)l * WIN_ROWS * 1024; kt = r & 15; nt = r >> 4; }
        else if (r < 928) { r -= 672; src = p->in[I_WOUT] + (size_t)l * 1024 * 1024; K = 1024; ld = 1024; perm = 0; dst = (bf16_t*)(p->ws + OFF_WOUT) + (size_t)l * 1024 * 1024; kt = r & 15; nt = r >> 4; }
        else if (r < 928 + 8320) { r -= 928; const int e = r >> 7, q = r & 127; kt = q & 15; nt = q >> 4; K = 1024; ld = 512; perm = 1;
            src = (e < 64) ? p->in[I_W13] + (size_t)(l * 64 + e) * 1024 * 512 : p->in[I_WS13] + (size_t)l * 1024 * 512;
            dst = (bf16_t*)(p->ws + OFF_W13) + (size_t)(l * 65 + e) * 512 * 1024; }
        else { r -= 9248; const int e = r >> 6, q = r & 63; kt = q & 3; nt = q >> 2; K = 256; ld = 1024; perm = 0;
            src = (e < 64) ? p->in[I_W2] + (size_t)(l * 64 + e) * 256 * 1024 : p->in[I_WS2] + (size_t)l * 256 * 1024;
            dst = (bf16_t*)(p->ws + OFF_W2) + (size_t)(l * 65 + e) * 1024 * 256; }
        const int k0 = kt * 64, r0 = nt * 64;
        {
            const int nn = tid & 63; const int drow = r0 + nn;
            int scol = drow;
            if (perm) { const int g = drow >> 5, i = drow & 31; scol = (i < 16) ? (g * 16 + i) : (256 + g * 16 + (i - 16)); }
#pragma unroll
            for (int j = 0; j < 16; ++j) { const int kk = (tid >> 6) + 4 * j; tile[kk * 65 + nn] = src[(size_t)(k0 + kk) * ld + scol]; }
        }
        __syncthreads();
        {
            const int kp = (tid & 31) * 2;
#pragma unroll
            for (int j = 0; j < 8; ++j) { const int rr = (tid >> 5) + 8 * j;
                *(unsigned*)(dst + (size_t)(r0 + rr) * K + k0 + kp) = pack2(tile[kp * 65 + rr], tile[(kp + 1) * 65 + rr]); }
        }
        __syncthreads();
    }
}

DEVINL void phaseF0(KP p) {
    const int tid = TIDX(), nb = NBV(), blk = BIDX();
    const float* mod = (const float*)(p->ws + OFF_MOD);
    bf16_t* ubuf = (bf16_t*)(p->ws + OFF_UBUF);
    for (int row = blk; row < NTOK; row += nb) {
        const int b = row >> 12, col = tid * 4;
        const float4 x = *(const float4*)(p->in[I_X] + (size_t)row * DM + col);
        const float4 sh = *(const float4*)(mod + (size_t)b * 6144 + col);
        const float4 sc = *(const float4*)(mod + (size_t)b * 6144 + 1024 + col);
        uint2 o; o.x = pack2(x.x * (1.f + sc.x) + sh.x, x.y * (1.f + sc.y) + sh.y); o.y = pack2(x.z * (1.f + sc.z) + sh.z, x.w * (1.f + sc.w) + sh.w);
        *(uint2*)(ubuf + (size_t)row * DM + col) = o;
    }
}

DEVINL void b1_conformer(KP p, int l, char* lds, int item) {
    const int tid = TIDX(), b = item >> 7, tt = item & 127, t0 = tt * 32, rowbase = b * SEQ;
    const bf16_t* P = (const bf16_t*)(p->ws + A_P);
    bf16_t* ymix = (bf16_t*)(p->ws + A_YMIX);
    float w[31];
#pragma unroll
    for (int k = 0; k < 31; ++k) w[k] = p->in[I_CONVA][(size_t)(l * 31 + k) * 256 + tid];
    float acc[32];
    const float bias = p->in[I_CONVAB][l * 256 + tid];
#pragma unroll
    for (int j = 0; j < 32; ++j) acc[j] = bias;
#pragma unroll
    for (int rr = 0; rr < 62; ++rr) {
        const int t = t0 - 30 + rr;
        const bf16_t* pr = P + ((long)(rowbase + t0 - 30) * PIN + tid) + (long)rr * PIN;
        const float val = bf2f(pr[0]), gate = bf2f(pr[256]);
        const float h = (t >= 0) ? val * sigm(gate) : 0.f;
#pragma unroll
        for (int j = 0; j < 32; ++j) { const int k = rr - j; if (k >= 0 && k <= 30) acc[j] = fmaf(w[k], h, acc[j]); }
    }
    float* outb = (float*)lds;
#pragma unroll
    for (int j = 0; j < 32; ++j) outb[j * 256 + tid] = acc[j];
    __syncthreads();
    const int wid = tid >> 6, lane = tid & 63;
    const float4 g4 = *(const float4*)(p->in[I_LNAG] + l * 256 + lane * 4), b4 = *(const float4*)(p->in[I_LNAB] + l * 256 + lane * 4);
    for (int j = wid; j < 32; j += 4) {
        const float4 v = *(const float4*)(outb + j * 256 + lane * 4);
        const float mean = wave_sum(v.x + v.y + v.z + v.w) * (1.f / 256.f);
        const float d0 = v.x - mean, d1 = v.y - mean, d2 = v.z - mean, d3 = v.w - mean;
        const float var = wave_sum(d0 * d0 + d1 * d1 + d2 * d2 + d3 * d3) * (1.f / 256.f);
        const float rs = rsqrtf(var + LN_EPS);
        float y0 = d0 * rs * g4.x + b4.x, y1 = d1 * rs * g4.y + b4.y, y2 = d2 * rs * g4.z + b4.z, y3 = d3 * rs * g4.w + b4.w;
        y0 *= sigm(y0); y1 *= sigm(y1); y2 *= sigm(y2); y3 *= sigm(y3);
        uint2 o; o.x = pack2(y0, y1); o.y = pack2(y2, y3);
        *(uint2*)(ymix + (size_t)(rowbase + t0 + j) * DM + lane * 4) = o;
    }
    __syncthreads();
}

DEVINL void b1_shortconv(KP p, int l, int item) {
    const int tid = TIDX(), cg = tid & 31, tl = tid >> 5, b = item >> 6, t0 = (item & 63) * 64 + tl * 8, rowbase = b * SEQ;
    const bf16_t* P = (const bf16_t*)(p->ws + A_P);
    bf16_t* ymix = (bf16_t*)(p->ws + A_YMIX);
    float w0[8], w1[8], w2[8];
#pragma unroll
    for (int e = 0; e < 8; ++e) { w0[e] = p->in[I_CONVD][(l * 3 + 0) * 256 + cg * 8 + e]; w1[e] = p->in[I_CONVD][(l * 3 + 1) * 256 + cg * 8 + e]; w2[e] = p->in[I_CONVD][(l * 3 + 2) * 256 + cg * 8 + e]; }
    uint4 gbv[8], gcv[10], hdv[10];
#pragma unroll
    for (int u = 0; u < 10; ++u) {
        const int t = t0 - 2 + u;
        const bf16_t* a = P + (size_t)(rowbase + (t >= 0 ? t : 0)) * PIN + 1920 + cg * 8;
        gcv[u] = *(const uint4*)(a + 256); hdv[u] = *(const uint4*)(a + 512);
        if (u >= 2) gbv[u - 2] = *(const uint4*)(a);
    }
    float q2[8], q1[8];
#pragma unroll
    for (int u = 0; u < 10; ++u) {
        const int t = t0 - 2 + u;
        const unsigned gcw[4] = {gcv[u].x, gcv[u].y, gcv[u].z, gcv[u].w}, hdw[4] = {hdv[u].x, hdv[u].y, hdv[u].z, hdv[u].w};
        float q0[8];
#pragma unroll
        for (int e = 0; e < 4; ++e) {
            q0[2 * e] = __uint_as_float(gcw[e] << 16) * __uint_as_float(hdw[e] << 16);
            q0[2 * e + 1] = __uint_as_float(gcw[e] & 0xFFFF0000u) * __uint_as_float(hdw[e] & 0xFFFF0000u);
        }
        if (t < 0) {
#pragma unroll
            for (int e = 0; e < 8; ++e) q0[e] = 0.f;
        }
        if (u >= 2) {
            const unsigned gbw[4] = {gbv[u - 2].x, gbv[u - 2].y, gbv[u - 2].z, gbv[u - 2].w};
            float y[8];
#pragma unroll
            for (int e = 0; e < 4; ++e) {
                y[2 * e] = __uint_as_float(gbw[e] << 16) * (w0[2 * e] * q2[2 * e] + w1[2 * e] * q1[2 * e] + w2[2 * e] * q0[2 * e]);
                y[2 * e + 1] = __uint_as_float(gbw[e] & 0xFFFF0000u) * (w0[2 * e + 1] * q2[2 * e + 1] + w1[2 * e + 1] * q1[2 * e + 1] + w2[2 * e + 1] * q0[2 * e + 1]);
            }
            *(uint4*)(ymix + (size_t)(rowbase + t) * DM + 768 + cg * 8) = make_uint4(pack2(y[0], y[1]), pack2(y[2], y[3]), pack2(y[4], y[5]), pack2(y[6], y[7]));
        }
#pragma unroll
        for (int e = 0; e < 8; ++e) { q2[e] = (u >= 1) ? q1[e] : 0.f; q1[e] = q0[e]; }
    }
}

DEVINL void b1_lru(KP p, int l, char* lds, int item) {
    const int c = TIDX(), b = item >> 7, tt = item & 127, t0 = tt * 32, rowbase = b * SEQ;
    const int h = c >> 6, lane = c & 63;
    const bf16_t* P = (const bf16_t*)(p->ws + A_P);
    float* uT = (float*)lds;
    {
        const float cb0 = p->in[I_CONVB][(l * 4 + 0) * 256 + c], cb1 = p->in[I_CONVB][(l * 4 + 1) * 256 + c], cb2 = p->in[I_CONVB][(l * 4 + 2) * 256 + c], cb3 = p->in[I_CONVB][(l * 4 + 3) * 256 + c];
        const float bias = p->in[I_CONVBB][l * 256 + c];
        float xm3 = 0.f, xm2 = 0.f, xm1 = 0.f;
        if (t0 >= 3) { const bf16_t* a = P + (size_t)(rowbase + t0 - 3) * PIN + 512 + c; xm3 = bf2f(a[0]); xm2 = bf2f(a[PIN]); xm1 = bf2f(a[2 * PIN]); }
        bf16_t xr[32];
#pragma unroll
        for (int j = 0; j < 32; ++j) xr[j] = P[(size_t)(rowbase + t0 + j) * PIN + 512 + c];
#pragma unroll
        for (int j = 0; j < 32; ++j) {
            const float x0 = bf2f(xr[j]);
            uT[c * 36 + j] = cb0 * xm3 + cb1 * xm2 + cb2 * xm1 + cb3 * x0 + bias;
            xm3 = xm2; xm2 = xm1; xm1 = x0;
        }
    }
    __syncthreads();
    const float brg = p->in[I_BRG][l * 256 + c], big = p->in[I_BIG][l * 256 + c];
    const float sp = softplus_acc(-p->in[I_LAMBDA][l * 256 + c]);
    float* hloc = (float*)(p->ws + A_HLOC); float* cuma = (float*)(p->ws + A_CUMA);
    const float* wrg = p->in[I_WRG] + (size_t)((l * 4 + h) * 64) * 64 + lane;
    const float* wig = p->in[I_WIG] + (size_t)((l * 4 + h) * 64) * 64 + lane;
    float hs = 0.f, cA = 1.f;
#pragma unroll 1
    for (int half = 0; half < 2; ++half) {
        float ar[16], ai[16];
#pragma unroll
        for (int j = 0; j < 16; ++j) { ar[j] = 0.f; ai[j] = 0.f; }
#pragma unroll 1
        for (int dh = 0; dh < 4; ++dh) {
            float wrv[16], wiv[16];
#pragma unroll
            for (int d = 0; d < 16; ++d) { wrv[d] = wrg[(dh * 16 + d) * 64]; wiv[d] = wig[(dh * 16 + d) * 64]; }
#pragma unroll
            for (int d = 0; d < 16; ++d) {
                const float wr = wrv[d], wi = wiv[d];
                const float4* up = (const float4*)(uT + (h * 64 + dh * 16 + d) * 36 + half * 16);
#pragma unroll
                for (int jj = 0; jj < 4; ++jj) {
                    const float4 u4 = up[jj];
                    ar[4 * jj + 0] = fmaf(u4.x, wr, ar[4 * jj + 0]); ai[4 * jj + 0] = fmaf(u4.x, wi, ai[4 * jj + 0]);
                    ar[4 * jj + 1] = fmaf(u4.y, wr, ar[4 * jj + 1]); ai[4 * jj + 1] = fmaf(u4.y, wi, ai[4 * jj + 1]);
                    ar[4 * jj + 2] = fmaf(u4.z, wr, ar[4 * jj + 2]); ai[4 * jj + 2] = fmaf(u4.z, wi, ai[4 * jj + 2]);
                    ar[4 * jj + 3] = fmaf(u4.w, wr, ar[4 * jj + 3]); ai[4 * jj + 3] = fmaf(u4.w, wi, ai[4 * jj + 3]);
                }
            }
        }
        float ureg[16];
#pragma unroll
        for (int jj = 0; jj < 4; ++jj) { const float4 u4 = *(const float4*)(uT + c * 36 + half * 16 + 4 * jj); ureg[4 * jj] = u4.x; ureg[4 * jj + 1] = u4.y; ureg[4 * jj + 2] = u4.z; ureg[4 * jj + 3] = u4.w; }
        float* hp = hloc + (size_t)(rowbase + t0 + half * 16) * 256 + c;
        float* cp = cuma + (size_t)(rowbase + t0 + half * 16) * 256 + c;
#pragma unroll
        for (int j = 0; j < 16; ++j) {
            const float r = sigm(ar[j] + brg), ig = sigm(ai[j] + big);
            const float log_a = -8.0f * r * sp;
            const float a = __expf(log_a);
            const float mult = sqrtf(fmaxf(1.f - a * a, 0.f));
            const float bx = mult * (ig * ureg[j]);
            hs = fmaf(a, hs, bx); cA *= a;
            hp[j * 256] = hs; cp[j * 256] = cA;
        }
    }
    ((float*)(p->ws + A_CARRYA))[(size_t)(b * 128 + tt) * 256 + c] = cA;
    ((float*)(p->ws + A_CARRYH))[(size_t)(b * 128 + tt) * 256 + c] = hs;
    __syncthreads();
}

DEVINL void b1_rwkv(KP p, int l, char* lds, int item) {
    const int c = TIDX(), b = item >> 7, tt = item & 127, t0 = tt * 32, rowbase = b * SEQ;
    const bf16_t* P = (const bf16_t*)(p->ws + A_P);
    float* featT = (float*)lds;
    const float* muc = p->in[I_MUC] + l * 896;
    if (c < 128) {
        const int col = 1024 + 768 + c; const float mu = muc[768 + c];
        float prev;
        { const float x = bf2f(P[(size_t)(rowbase + (t0 > 0 ? t0 - 1 : 0)) * PIN + col]); prev = (t0 > 0) ? x : 0.f; }
#pragma unroll 1
        for (int jb = 0; jb < 2; ++jb) {
            bf16_t raw[16];
#pragma unroll
            for (int u = 0; u < 16; ++u) raw[u] = P[(size_t)(rowbase + t0 + jb * 16 + u) * PIN + col];
#pragma unroll
            for (int u = 0; u < 16; ++u) {
                const float cur = bf2f(raw[u]);
                const float xs = cur + (prev - cur) * mu;
                const float val = (c < 32) ? tanh_fast(xs) : ((c < 64) ? xs : sigm(xs));
                featT[c * 36 + jb * 16 + u] = val; prev = cur;
            }
        }
    }
    __syncthreads();
    float acc[32], dec[32], aa[32];
#define LORA32(WPTR, FOFF) do { float wv_[32]; \
    _Pragma("unroll") for (int jf = 0; jf < 32; ++jf) wv_[jf] = (WPTR)[(size_t)jf * 256 + c]; \
    _Pragma("unroll") for (int jf = 0; jf < 32; ++jf) { const float4* fp = (const float4*)(featT + ((FOFF) + jf) * 36); const float wv = wv_[jf]; \
        _Pragma("unroll") for (int jj = 0; jj < 8; ++jj) { const float4 u4 = fp[jj]; acc[4 * jj] = fmaf(u4.x, wv, acc[4 * jj]); acc[4 * jj + 1] = fmaf(u4.y, wv, acc[4 * jj + 1]); acc[4 * jj + 2] = fmaf(u4.z, wv, acc[4 * jj + 2]); acc[4 * jj + 3] = fmaf(u4.w, wv, acc[4 * jj + 3]); } } } while (0)
#pragma unroll
    for (int j = 0; j < 32; ++j) acc[j] = 0.f;
    LORA32(p->in[I_WG2] + (size_t)(l * 64) * 256, 64);
    LORA32(p->in[I_WG2] + (size_t)(l * 64 + 32) * 256, 96);
    {
        float* gbuf = (float*)(p->ws + A_G);
#pragma unroll
        for (int j = 0; j < 32; ++j) { gbuf[(size_t)(rowbase + t0 + j) * 256 + c] = acc[j]; acc[j] = 0.f; }
    }
    LORA32(p->in[I_WW2] + (size_t)(l * 32) * 256, 0);
    {
        const float w0 = p->in[I_W0][l * 256 + c];
#pragma unroll
        for (int j = 0; j < 32; ++j) { const float z = w0 + acc[j]; const float wlog = -softplusf(-z) - 0.5f; dec[j] = -__expf(wlog); acc[j] = 0.f; }
    }
    LORA32(p->in[I_WA2] + (size_t)(l * 32) * 256, 32);
    {
        const float a0 = p->in[I_A0][l * 256 + c];
#pragma unroll
        for (int j = 0; j < 32; ++j) aa[j] = sigm(a0 + acc[j]);
    }
#undef LORA32
    {
        float* bonus = (float*)(p->ws + A_BONUS); uint4* scan = (uint4*)(p->ws + A_SCAN);
        const float mur = muc[c], muk = muc[256 + c], muv = muc[512 + c];
        const float kkw = p->in[I_KK][l * 256 + c], kaw = p->in[I_KA][l * 256 + c], rkw = p->in[I_RK][l * 256 + c];
        float pr, pk, pv;
        { const bf16_t* a = P + (size_t)(rowbase + (t0 > 0 ? t0 - 1 : 0)) * PIN + 1024 + c; const float x0 = bf2f(a[0]), x1 = bf2f(a[256]), x2 = bf2f(a[512]);
          pr = (t0 > 0) ? x0 : 0.f; pk = (t0 > 0) ? x1 : 0.f; pv = (t0 > 0) ? x2 : 0.f; }
#pragma unroll
        for (int jb = 0; jb < 4; ++jb) {
            bf16_t rr_[8], rk_[8], rv_[8];
#pragma unroll
            for (int u = 0; u < 8; ++u) { const bf16_t* a = P + (size_t)(rowbase + t0 + jb * 8 + u) * PIN + 1024 + c; rr_[u] = a[0]; rk_[u] = a[256]; rv_[u] = a[512]; }
#pragma unroll
            for (int u = 0; u < 8; ++u) {
                const int j = jb * 8 + u;
                const size_t row = (size_t)(rowbase + t0 + j);
                const float cr = bf2f(rr_[u]), ck = bf2f(rk_[u]), cv = bf2f(rv_[u]);
                const float r = cr + (pr - cr) * mur, k = ck + (pk - ck) * muk, v = cv + (pv - cv) * muv;
                pr = cr; pk = ck; pv = cv;
                const float kk = k * kkw;
                const float ss = wave_sum(kk * kk);
                const float kkn = kk * rsqrtf(ss + 1e-12f);
                const float kf = k * (1.f + (aa[j] - 1.f) * kaw);
                const float bs = wave_sum(r * kf * rkw);
                bonus[row * 256 + c] = bs * v;
                uint4 o; o.x = pack2(kkn, kkn * aa[j]); o.y = pack2(kf, r); o.z = pack2(v, 0.f); o.w = __float_as_uint(dec[j]);
                scan[row * 256 + c] = o;
            }
            asm volatile("" ::: "memory");
        }
    }
    __syncthreads();
}

constexpr int S_AL = 0, S_BE = 8192, S_KA = 16384, S_RH = 24576, S_BET = 32768, S_KAT = 40960, S_VT = 49152, S_L2F = 57344  , S_GT = 73728  ;
constexpr int S_L1F = S_BE;
constexpr int S_M1 = S_BE, S_M2 = S_KA;
constexpr int S_APT = S_L2F, S_W2T = S_L2F + 8192;
constexpr int S_RP = S_AL, S_GTR = S_RH;
DEVINL int crow32(int reg, int h) { return (reg & 3) + 8 * (reg >> 2) + 4 * h; }
DEVINL bf16x8 frag64(const char* lds, int slot, int row, int kel) { return *reinterpret_cast<const bf16x8*>(lds + slot + row * 128 + kel * 2); }
#define MFMA32(a, b, c) __builtin_amdgcn_mfma_f32_32x32x16_bf16((a), (b), (c), 0, 0, 0)
DEVINL float dpp_xor1(float x) { return __builtin_bit_cast(float, __builtin_amdgcn_update_dpp(0, __builtin_bit_cast(int, x), 0xB1, 0xf, 0xf, true)); }

DEVINL f32x16 mm64(const char* lds, int slotA, int slotB, int tm, int tn, int r, int hh, f32x16 acc) {
#pragma unroll
    for (int ks = 0; ks < 4; ++ks) acc = MFMA32(frag64(lds, slotA, tm * 32 + r, ks * 16 + 8 * hh), frag64(lds, slotB, tn * 32 + r, ks * 16 + 8 * hh), acc);
    return acc;
}

DEVINL void b1e_unit(KP p, char* lds, int b, int h, int c) {
    const int tid = TIDX(), wv = tid >> 6, lane = tid & 63, r = lane & 31, hh = lane >> 5;
    const uint4* scan = (const uint4*)(p->ws + A_SCAN) + ((size_t)(b * SEQ + c * 64)) * 256 + h * 64;
    float* gtot = (float*)(lds + S_GT); float* gamC = gtot + 256;
    {
        const int j = lane;
        float lw[16]; unsigned px[16], py[16], pz[16];
#pragma unroll
        for (int u = 0; u < 16; ++u) { const uint4 q = scan[(size_t)(wv * 16 + u) * 256 + j]; px[u] = q.x; py[u] = q.y; pz[u] = q.z; lw[u] = __uint_as_float(q.w); }
        float tot = 0.f;
#pragma unroll
        for (int u = 0; u < 16; ++u) tot += lw[u];
        gtot[wv * 64 + j] = tot;
        __syncthreads();
        float off = 0.f, all = 0.f;
#pragma unroll
        for (int g = 0; g < 4; ++g) { const float v = gtot[g * 64 + j]; all += v; off += (g < wv) ? v : 0.f; }
        if (wv == 0) gamC[j] = __expf(all);
        float cum = off;
        unsigned tb[8], tk[8], tv[8];
#pragma unroll
        for (int u = 0; u < 16; ++u) {
            const float kkn = __uint_as_float(px[u] << 16), bb = __uint_as_float(px[u] & 0xFFFF0000u);
            const float kf = __uint_as_float(py[u] << 16), rr = __uint_as_float(py[u] & 0xFFFF0000u);
            const float gp = __expf(cum); cum += lw[u];
            const float g = __expf(cum), en = __expf(-cum);
            const int t = wv * 16 + u;
            const unsigned be = f2bf(bb * en), ka = f2bf(kf * en);
            *(bf16_t*)(lds + S_AL + t * 128 + j * 2) = f2bf(gp * kkn);
            *(bf16_t*)(lds + S_BE + t * 128 + j * 2) = (bf16_t)be;
            *(bf16_t*)(lds + S_KA + t * 128 + j * 2) = (bf16_t)ka;
            *(bf16_t*)(lds + S_RH + t * 128 + j * 2) = f2bf(g * rr);
            if (u & 1) { tb[u >> 1] |= be << 16; tk[u >> 1] |= ka << 16; tv[u >> 1] |= (pz[u] << 16); }
            else { tb[u >> 1] = be; tk[u >> 1] = ka; tv[u >> 1] = pz[u] & 0xFFFFu; }
        }
        *(uint4*)(lds + S_BET + j * 128 + wv * 32) = make_uint4(tb[0], tb[1], tb[2], tb[3]); *(uint4*)(lds + S_BET + j * 128 + wv * 32 + 16) = make_uint4(tb[4], tb[5], tb[6], tb[7]);
        *(uint4*)(lds + S_KAT + j * 128 + wv * 32) = make_uint4(tk[0], tk[1], tk[2], tk[3]); *(uint4*)(lds + S_KAT + j * 128 + wv * 32 + 16) = make_uint4(tk[4], tk[5], tk[6], tk[7]);
        *(uint4*)(lds + S_VT + j * 128 + wv * 32) = make_uint4(tv[0], tv[1], tv[2], tv[3]); *(uint4*)(lds + S_VT + j * 128 + wv * 32 + 16) = make_uint4(tv[4], tv[5], tv[6], tv[7]);
    }
    __syncthreads();
    const int tm = wv >> 1, tn = wv & 1;
    f32x16 aM1, aM2;
    {
        f32x16 aL1, aL2;
#pragma unroll
        for (int i = 0; i < 16; ++i) { aL1[i] = 0.f; aL2[i] = 0.f; aM1[i] = 0.f; aM2[i] = 0.f; }
#pragma unroll
        for (int ks = 0; ks < 4; ++ks) {
            const bf16x8 fa = frag64(lds, S_AL, tm * 32 + r, ks * 16 + 8 * hh), fr = frag64(lds, S_RH, tm * 32 + r, ks * 16 + 8 * hh);
            const bf16x8 fb = frag64(lds, S_BE, tn * 32 + r, ks * 16 + 8 * hh), fk = frag64(lds, S_KA, tn * 32 + r, ks * 16 + 8 * hh);
            aL1 = MFMA32(fa, fb, aL1); aL2 = MFMA32(fa, fk, aL2); aM1 = MFMA32(fr, fb, aM1); aM2 = MFMA32(fr, fk, aM2);
        }
        __syncthreads();
#pragma unroll
        for (int reg = 0; reg < 16; ++reg) {
            const int t = tm * 32 + crow32(reg, hh), sidx = tn * 32 + r;
            const int o = (t * 64 + (sidx & 1) * 32 + (sidx >> 1)) * 4;
            *(float*)(lds + S_L1F + o) = (sidx < t) ? aL1[reg] : 0.f;
            *(float*)(lds + S_L2F + o) = (sidx < t) ? aL2[reg] : 0.f;
            aM1[reg] = (sidx <= t) ? aM1[reg] : 0.f; aM2[reg] = (sidx <= t) ? aM2[reg] : 0.f;
        }
    }
    __syncthreads();
    unsigned outp[32];
    {
        const int col = (wv & 1) * 32 + (lane >> 1), q = lane & 1;
        float xq[32];
#pragma unroll
        for (int k = 0; k < 32; ++k) xq[k] = 0.f;
        const char* l1row = lds + S_L1F + q * 128;
        const char* l2row = lds + S_L2F + q * 128;
        if (wv < 2) {
#pragma unroll
            for (int t = 0; t < 64; ++t) {
                float acc = 0.f;
#pragma unroll
                for (int k4 = 0; k4 * 4 < (t + 1) / 2; ++k4) {
                    const float4 a = *(const float4*)(l1row + t * 256 + k4 * 16);
                    acc = fmaf(a.x, xq[4 * k4 + 0], acc); acc = fmaf(a.y, xq[4 * k4 + 1], acc); acc = fmaf(a.z, xq[4 * k4 + 2], acc); acc = fmaf(a.w, xq[4 * k4 + 3], acc);
                }
                acc += dpp_xor1(acc);
                const float x = bf2f(*(const bf16_t*)(lds + S_AL + t * 128 + col * 2)) - acc;
                xq[t >> 1] = ((t & 1) == q) ? x : xq[t >> 1];
            }
        } else {
            float vq[32];
#pragma unroll
            for (int k8 = 0; k8 < 8; ++k8) {
                const uint4 d = *(const uint4*)(lds + S_VT + col * 128 + k8 * 16);
                vq[4 * k8 + 0] = q ? __uint_as_float(d.x & 0xFFFF0000u) : __uint_as_float(d.x << 16);
                vq[4 * k8 + 1] = q ? __uint_as_float(d.y & 0xFFFF0000u) : __uint_as_float(d.y << 16);
                vq[4 * k8 + 2] = q ? __uint_as_float(d.z & 0xFFFF0000u) : __uint_as_float(d.z << 16);
                vq[4 * k8 + 3] = q ? __uint_as_float(d.w & 0xFFFF0000u) : __uint_as_float(d.w << 16);
            }
#pragma unroll
            for (int t = 0; t < 64; ++t) {
                float acc = 0.f;
#pragma unroll
                for (int k4 = 0; k4 * 4 < (t + 1) / 2; ++k4) {
                    const float4 a = *(const float4*)(l1row + t * 256 + k4 * 16);
                    const float4 bq = *(const float4*)(l2row + t * 256 + k4 * 16);
                    acc = fmaf(bq.x, vq[4 * k4 + 0], acc); acc = fmaf(bq.y, vq[4 * k4 + 1], acc); acc = fmaf(bq.z, vq[4 * k4 + 2], acc); acc = fmaf(bq.w, vq[4 * k4 + 3], acc);
                    acc = fmaf(-a.x, xq[4 * k4 + 0], acc); acc = fmaf(-a.y, xq[4 * k4 + 1], acc); acc = fmaf(-a.z, xq[4 * k4 + 2], acc); acc = fmaf(-a.w, xq[4 * k4 + 3], acc);
                }
                acc += dpp_xor1(acc);
                xq[t >> 1] = ((t & 1) == q) ? acc : xq[t >> 1];
            }
        }
#pragma unroll
        for (int k = 0; k < 32; ++k) { const float o = dpp_xor1(xq[k]); outp[k] = q ? pack2(o, xq[k]) : pack2(xq[k], o); }
    }
    __syncthreads();
    {
        const int col = (wv & 1) * 32 + (lane >> 1), q = lane & 1;
        char* dst = lds + ((wv < 2) ? S_APT : S_W2T) + col * 128 + q * 64;
#pragma unroll
        for (int i = 0; i < 4; ++i) *(uint4*)(dst + i * 16) = q ? make_uint4(outp[16 + 4 * i], outp[17 + 4 * i], outp[18 + 4 * i], outp[19 + 4 * i]) : make_uint4(outp[4 * i], outp[4 * i + 1], outp[4 * i + 2], outp[4 * i + 3]);
#pragma unroll
        for (int reg = 0; reg < 16; ++reg) {
            const int t = tm * 32 + crow32(reg, hh), sidx = tn * 32 + r;
            *(bf16_t*)(lds + S_M1 + t * 128 + sidx * 2) = f2bf(aM1[reg]);
            *(bf16_t*)(lds + S_M2 + t * 128 + sidx * 2) = f2bf(aM2[reg]);
        }
    }
    __syncthreads();
    unsigned char* ubase = p->ws + A_CHAIN + (size_t)((b * 4 + h) * 64 + c) * CHAIN_UNIT;
    f32x16 zero;
#pragma unroll
    for (int i = 0; i < 16; ++i) zero[i] = 0.f;
    f32x16 gt;
    {
        const f32x16 qv = mm64(lds, S_M1, S_APT, tm, tn, r, hh, zero);
        const f32x16 y0 = mm64(lds, S_M2, S_VT, tm, tn, r, hh, zero) - mm64(lds, S_M1, S_W2T, tm, tn, r, hh, zero);
        gt = mm64(lds, S_BET, S_APT, tm, tn, r, hh, zero);
        const f32x16 ht = mm64(lds, S_KAT, S_VT, tm, tn, r, hh, zero) - mm64(lds, S_BET, S_W2T, tm, tn, r, hh, zero);
#pragma unroll
        for (int reg = 0; reg < 16; ++reg) {
            const int t = tm * 32 + crow32(reg, hh), jc = tn * 32 + r;
            const float rh = bf2f(*(const bf16_t*)(lds + S_RH + t * 128 + jc * 2));
            *(bf16_t*)(lds + S_RP + t * 128 + jc * 2) = f2bf(rh - qv[reg]);
            const int jr = tm * 32 + crow32(reg, hh);
            const float gc = gamC[jr];
            gt[reg] = gc * (((jr == jc) ? 1.f : 0.f) - gt[reg]);
        }
        float4* himg = (float4*)(ubase + 16384); float4* yimg = (float4*)(ubase + 32768);
#pragma unroll
        for (int rq = 0; rq < 4; ++rq) {
            float4 hv, yv;
            hv.x = gamC[tm * 32 + crow32(4 * rq + 0, hh)] * ht[4 * rq + 0]; hv.y = gamC[tm * 32 + crow32(4 * rq + 1, hh)] * ht[4 * rq + 1];
            hv.z = gamC[tm * 32 + crow32(4 * rq + 2, hh)] * ht[4 * rq + 2]; hv.w = gamC[tm * 32 + crow32(4 * rq + 3, hh)] * ht[4 * rq + 3];
            yv.x = y0[4 * rq + 0]; yv.y = y0[4 * rq + 1]; yv.z = y0[4 * rq + 2]; yv.w = y0[4 * rq + 3];
            himg[((tn * 2 + tm) * 4 + rq) * 64 + lane] = hv;
            yimg[((tn * 2 + tm) * 4 + rq) * 64 + lane] = yv;
        }
    }
    __syncthreads();
#pragma unroll
    for (int reg = 0; reg < 16; ++reg) {
        const int jr = tm * 32 + crow32(reg, hh), jc = tn * 32 + r;
        *(bf16_t*)(lds + S_GTR + jr * 128 + jc * 2) = f2bf(gt[reg]);
    }
    __syncthreads();
    {
        uint4* gimg = (uint4*)(ubase); uint4* rimg = (uint4*)(ubase + 8192);
#pragma unroll
        for (int ii = 0; ii < 2; ++ii) {
            const int im = wv * 2 + ii, mt = im >> 2, jb = (im >> 1) & 1, s2 = im & 1;
            const int cbase = (32 * jb + 16 * s2 + 4 * hh) * 2;
            const uint2 g0 = *(const uint2*)(lds + S_GTR + (mt * 32 + r) * 128 + cbase), g1 = *(const uint2*)(lds + S_GTR + (mt * 32 + r) * 128 + cbase + 16);
            const uint2 r0 = *(const uint2*)(lds + S_RP + (mt * 32 + r) * 128 + cbase), r1 = *(const uint2*)(lds + S_RP + (mt * 32 + r) * 128 + cbase + 16);
            gimg[im * 64 + lane] = make_uint4(g0.x, g0.y, g1.x, g1.y);
            rimg[im * 64 + lane] = make_uint4(r0.x, r0.y, r1.x, r1.y);
        }
    }
    __syncthreads();
}

DEVINL void phaseB1(KP p, int l, char* lds, const int mask = 15, const int sub = 3) {
    const int nb = NBV();
    if (mask & 1) {
        const int blk = BIDX();
        for (int it = blk; it < 512; it += nb) {
            if (sub & 1) { b1_rwkv(p, l, lds, it * 2); b1_rwkv(p, l, lds, it * 2 + 1); }
            __threadfence_block(); __syncthreads();
            const int b = it >> 6, c = it & 63;
            if (sub & 2) {
#pragma unroll 1
                for (int h = 0; h < 4; ++h) b1e_unit(p, lds, b, h, c);
            }
        }
    }
    if (mask & 2) { const int blk = BIDX(); for (int it = blk; it < 1024; it += nb) b1_lru(p, l, lds, it); }
    if (mask & 4) { const int blk = BIDX(); for (int it = blk; it < 1024; it += nb) b1_conformer(p, l, lds, it); }
    if (mask & 8) { const int blk = BIDX(); for (int it = blk; it < 512; it += nb) b1_shortconv(p, l, it); }
}

DEVINL void phaseB2(KP p, int l) {
    const int tid = TIDX(), blk = BIDX();
    if (blk >= 64 && blk < 72) {
        const int bb = blk - 64;
        const float* ca = (const float*)(p->ws + A_CARRYA) + (size_t)bb * 128 * 256 + tid;
        const float* ch = (const float*)(p->ws + A_CARRYH) + (size_t)bb * 128 * 256 + tid;
        float* hst = (float*)(p->ws + A_HSTART) + (size_t)bb * 128 * 256 + tid;
        float hs = 0.f;
#pragma unroll 8
        for (int tt = 0; tt < 128; ++tt) { hst[tt * 256] = hs; hs = fmaf(ca[tt * 256], hs, ch[tt * 256]); }
    }
    if (blk < 64 && tid < 64) {
        const int lane = tid, r = lane & 31, hh = lane >> 5;
        const int bh = blk >> 1, w = blk & 1, b = bh >> 2, h = bh & 3;
        float* yraw = (float*)(p->ws + A_YRAW) + (size_t)b * SEQ * 256 + h * 64 + 32 * w + r;
        f32x16 X0, X1;
#pragma unroll
        for (int i = 0; i < 16; ++i) { X0[i] = 0.f; X1[i] = 0.f; }
        for (int c = 0; c < 64; ++c) {
            const unsigned char* ubase = p->ws + A_CHAIN + (size_t)(bh * 64 + c) * CHAIN_UNIT;
            const uint4* gimg = (const uint4*)ubase; const uint4* rimg = (const uint4*)(ubase + 8192);
            const float4* himg = (const float4*)(ubase + 16384); const float4* yimg = (const float4*)(ubase + 32768);
            uint4 gq[8], rq8[8]; float4 hq[8], yq[8];
#pragma unroll
            for (int i = 0; i < 8; ++i) { gq[i] = gimg[i * 64 + lane]; rq8[i] = rimg[i * 64 + lane]; }
#pragma unroll
            for (int i = 0; i < 8; ++i) { hq[i] = himg[(w * 8 + i) * 64 + lane]; yq[i] = yimg[(w * 8 + i) * 64 + lane]; }
            bf16x8 xp[4];
#pragma unroll
            for (int s2 = 0; s2 < 2; ++s2) {
                uint4 a, bq;
                a.x = pack2(X0[8 * s2 + 0], X0[8 * s2 + 1]); a.y = pack2(X0[8 * s2 + 2], X0[8 * s2 + 3]); a.z = pack2(X0[8 * s2 + 4], X0[8 * s2 + 5]); a.w = pack2(X0[8 * s2 + 6], X0[8 * s2 + 7]);
                bq.x = pack2(X1[8 * s2 + 0], X1[8 * s2 + 1]); bq.y = pack2(X1[8 * s2 + 2], X1[8 * s2 + 3]); bq.z = pack2(X1[8 * s2 + 4], X1[8 * s2 + 5]); bq.w = pack2(X1[8 * s2 + 6], X1[8 * s2 + 7]);
                xp[s2] = __builtin_bit_cast(bf16x8, a); xp[2 + s2] = __builtin_bit_cast(bf16x8, bq);
            }
#pragma unroll
            for (int mt = 0; mt < 2; ++mt) {
                f32x16 acc;
#pragma unroll
                for (int i = 0; i < 4; ++i) { acc[4 * i] = yq[mt * 4 + i].x; acc[4 * i + 1] = yq[mt * 4 + i].y; acc[4 * i + 2] = yq[mt * 4 + i].z; acc[4 * i + 3] = yq[mt * 4 + i].w; }
#pragma unroll
                for (int f = 0; f < 4; ++f) acc = MFMA32(__builtin_bit_cast(bf16x8, rq8[mt * 4 + f]), xp[f], acc);
#pragma unroll
                for (int reg = 0; reg < 16; ++reg) yraw[(size_t)(c * 64 + mt * 32 + crow32(reg, hh)) * 256] = acc[reg];
            }
            f32x16 n0, n1;
#pragma unroll
            for (int i = 0; i < 4; ++i) { n0[4 * i] = hq[i].x; n0[4 * i + 1] = hq[i].y; n0[4 * i + 2] = hq[i].z; n0[4 * i + 3] = hq[i].w;
                                          n1[4 * i] = hq[4 + i].x; n1[4 * i + 1] = hq[4 + i].y; n1[4 * i + 2] = hq[4 + i].z; n1[4 * i + 3] = hq[4 + i].w; }
#pragma unroll
            for (int f = 0; f < 4; ++f) { n0 = MFMA32(__builtin_bit_cast(bf16x8, gq[f]), xp[f], n0); n1 = MFMA32(__builtin_bit_cast(bf16x8, gq[4 + f]), xp[f], n1); }
            X0 = n0; X1 = n1;
        }
    }
}

DEVINL void phaseB3(KP p, int l) {
    const int c = TIDX(), nb = NBV(), blk = BIDX();
    const bf16_t* P = (const bf16_t*)(p->ws + A_P);
    bf16_t* ymix = (bf16_t*)(p->ws + A_YMIX);
    const float* yraw = (const float*)(p->ws + A_YRAW); const float* bonus = (const float*)(p->ws + A_BONUS); const float* gbuf = (const float*)(p->ws + A_G);
    const float* hloc = (const float*)(p->ws + A_HLOC); const float* cuma = (const float*)(p->ws + A_CUMA); const float* hst = (const float*)(p->ws + A_HSTART);
    const float gng = p->in[I_GNG][l * 256 + c], gnb = p->in[I_GNB][l * 256 + c];
    for (int it = blk; it < 512; it += nb) {
#pragma unroll 4
        for (int rr = 0; rr < 64; ++rr) {
            const int row = it * 64 + rr, b = row >> 12, tt = (row & 4095) >> 5;
            const size_t o = (size_t)row * 256 + c;
            const float y = yraw[o];
            const float mu = wave_sum(y) * (1.f / 64.f);
            const float d = y - mu;
            const float var = wave_sum(d * d) * (1.f / 64.f);
            const float yn = d * rsqrtf(var + GN_EPS) * gng + gnb;
            ymix[(size_t)row * DM + 512 + c] = f2bf((yn + bonus[o]) * gbuf[o]);
            const float hh = fmaf(cuma[o], hst[(size_t)(b * 128 + tt) * 256 + c], hloc[o]);
            const float gb = bf2f(P[(size_t)row * PIN + 768 + c]);
            ymix[(size_t)row * DM + 256 + c] = f2bf(hh * gelu_tanh(gb));
        }
    }
}

DEVINL void phaseD(KP p, int l, char* lds, const int dry = 0) {
    const int tid = TIDX(), nb = NBV(), blk = BIDX(), wid = tid >> 6, lane = tid & 63;
    float* ul = (float*)lds;
    int* sel_e = (int*)(lds + 65536);
    int* lpos = (int*)(lds + 65536 + 2048);
    int* hist = (int*)(lds + 65536 + 4096);
    int* basep = (int*)(lds + 65536 + 4096 + 256);
    const float* xbuf = p->out;
    float* xout = dry ? (float*)(p->ws + A_P) : p->out;
    bf16_t* ubuf = (bf16_t*)(p->ws + (dry ? A_YMIX : OFF_UBUF));
    const float* mod = (const float*)(p->ws + OFF_MOD);
    const float* wr = p->in[I_WROUTER] + (size_t)l * 1024 * 64 + lane;
    const float ebias = p->in[I_EBIAS][l * 64 + lane];
    unsigned* cnt = (unsigned*)(p->ws + OFF_CNT) + l * 64 + (dry ? 256 : 0);
    int* list = (int*)(p->ws + (dry ? M_HBUF : M_LIST));
    float* wsel = (float*)(p->ws + (dry ? M_HBUF + 16777216 : M_WSEL));
    for (int it = blk; it < 512; it += nb) {
        const int tok0 = it * 64;
        if (tid < 64) hist[tid] = 0;
        for (int sb = 0; sb < 4; ++sb) {
#pragma unroll
            for (int j = 0; j < 4; ++j) {
                const int tl = wid * 4 + j, row = tok0 + sb * 16 + tl, b = row >> 12;
                float4 z[4];
                float s = 0.f;
#pragma unroll
                for (int i = 0; i < 4; ++i) { z[i] = *(const float4*)(xbuf + (size_t)row * DM + i * 256 + lane * 4); s += z[i].x + z[i].y + z[i].z + z[i].w; }
                const float mean = wave_sum(s) * (1.f / 1024.f);
                float q = 0.f;
#pragma unroll
                for (int i = 0; i < 4; ++i) { z[i].x -= mean; z[i].y -= mean; z[i].z -= mean; z[i].w -= mean; q += z[i].x * z[i].x + z[i].y * z[i].y + z[i].z * z[i].z + z[i].w * z[i].w; }
                const float rs = rsqrtf(wave_sum(q) * (1.f / 1024.f) + LN_EPS);
#pragma unroll
                for (int i = 0; i < 4; ++i) {
                    const int col = i * 256 + lane * 4;
                    const float4 g = *(const float4*)(p->in[I_LN1G] + l * 1024 + col), bb = *(const float4*)(p->in[I_LN1B] + l * 1024 + col);
                    const float4 sh = *(const float4*)(mod + (size_t)(l * 8 + b) * 6144 + 3072 + col), sc = *(const float4*)(mod + (size_t)(l * 8 + b) * 6144 + 4096 + col);
                    float4 x1; x1.x = z[i].x * rs * g.x + bb.x; x1.y = z[i].y * rs * g.y + bb.y; x1.z = z[i].z * rs * g.z + bb.z; x1.w = z[i].w * rs * g.w + bb.w;
                    *(float4*)(xout + (size_t)row * DM + col) = x1;
                    float4 u; u.x = x1.x * (1.f + sc.x) + sh.x; u.y = x1.y * (1.f + sc.y) + sh.y; u.z = x1.z * (1.f + sc.z) + sh.z; u.w = x1.w * (1.f + sc.w) + sh.w;
                    *(float4*)(ul + tl * 1024 + col) = u;
                    uint2 o; o.x = pack2(u.x, u.y); o.y = pack2(u.z, u.w);
                    *(uint2*)(ubuf + (size_t)row * DM + col) = o;
                }
            }
            __syncthreads();
            float acc[4] = {0.f, 0.f, 0.f, 0.f};
            const float* u0 = ul + (wid * 4) * 1024;
#pragma unroll 2
            for (int k = 0; k < 1024; k += 4) {
                const float w0 = wr[(size_t)(k + 0) * 64], w1 = wr[(size_t)(k + 1) * 64], w2 = wr[(size_t)(k + 2) * 64], w3 = wr[(size_t)(k + 3) * 64];
#pragma unroll
                for (int j = 0; j < 4; ++j) {
                    const float4 u4 = *(const float4*)(u0 + j * 1024 + k);
                    acc[j] = fmaf(u4.x, w0, acc[j]); acc[j] = fmaf(u4.y, w1, acc[j]); acc[j] = fmaf(u4.z, w2, acc[j]); acc[j] = fmaf(u4.w, w3, acc[j]);
                }
            }
#pragma unroll
            for (int j = 0; j < 4; ++j) {
                const int tl = sb * 16 + wid * 4 + j;
                const float score = 1.f / (1.f + __expf(-acc[j]));
                const float biased = score + ebias;
                float m1 = biased;
                m1 = fmaxf(m1, __shfl_xor(m1, 1)); m1 = fmaxf(m1, __shfl_xor(m1, 2)); m1 = fmaxf(m1, __shfl_xor(m1, 4));
                const unsigned long long eq = __ballot(biased == m1);
                const int g = lane >> 3;
                const unsigned gm = (unsigned)(eq >> (g * 8)) & 0xFFu;
                const int first = __ffs((int)gm) - 1;
                const float v2 = ((lane & 7) == first) ? -INFINITY : biased;
                float m2 = v2;
                m2 = fmaxf(m2, __shfl_xor(m2, 1)); m2 = fmaxf(m2, __shfl_xor(m2, 2)); m2 = fmaxf(m2, __shfl_xor(m2, 4));
                const float gs = m1 + m2;
                int rg = 0;
#pragma unroll
                for (int g2 = 0; g2 < 8; ++g2) { const float o = __builtin_bit_cast(float, __builtin_amdgcn_readlane(__builtin_bit_cast(int, gs), g2 * 8)); rg += ((o > gs) || (o == gs && g2 < g)) ? 1 : 0; }
                const bool keep = rg < 4;
                const float mk = keep ? biased : -INFINITY;
                int rk = 0;
#pragma unroll
                for (int e2 = 0; e2 < 64; ++e2) { const float o = __builtin_bit_cast(float, __builtin_amdgcn_readlane(__builtin_bit_cast(int, mk), e2)); rk += ((o > mk) || (o == mk && e2 < lane)) ? 1 : 0; }
                const bool sel = keep && (rk < 8);
                const float ssum = wave_sum(sel ? score : 0.f);
                const float wgt = score / ssum * 2.5f;
                const unsigned long long sm = __ballot(sel);
                const int kidx = __popcll(sm & ((1ull << lane) - 1ull));
                if (sel) { wsel[(size_t)(tok0 + tl) * 8 + kidx] = wgt; sel_e[tl * 8 + kidx] = lane; }
            }
            __syncthreads();
        }
        for (int i = tid; i < 512; i += VTHREADS) lpos[i] = atomicAdd(&hist[sel_e[i]], 1);
        __syncthreads();
        if (tid < 64) basep[tid] = (int)atomicAdd(&cnt[tid], (unsigned)hist[tid]);
        __syncthreads();
        for (int i = tid; i < 512; i += VTHREADS) { const int e = sel_e[i]; list[(size_t)e * NTOK + basep[e] + lpos[i]] = tok0 * 8 + i; }
        __syncthreads();
    }
}

DEVINL void phaseA(KP p, int l, char* lds) {
    const int tid = TID512(), c = blockIdx.x, G = gridDim.x;
    const char* ubuf = (const char*)(p->ws + OFF_UBUF);
    const char* Wt = (const char*)(p->ws + OFF_WIN) + (size_t)l * WIN_ROWS * 1024 * 2;
    bf16_t* P = (bf16_t*)(p->ws + A_P);
    auto sched = [&](int i, GUnit& u) -> bool {
        const long L = unit_linear(i, c, G); if (L >= 128 * 11) return false;
        const int Li = (int)L, sx = Li >> 9, w = (sx == 2) ? 3 : 4, rem = Li - (sx << 9), pm = rem / w, pn = sx * 4 + (rem - pm * w);
        u.A = ubuf + (size_t)pm * 256 * 2048; u.B = Wt + (size_t)pn * 256 * 2048; u.i0 = pm; u.i1 = pn; u.i2 = 0;
        return true;
    };
    auto epi = [&](f32x4 (&acc)[2][2][4][2], const GUnit& u, int wr, int wc, int fr, int fq) {
        asm volatile("" : "+v"(fr), "+v"(fq));
        const int row0 = u.i0 * 256 + wr * 64 + fr, col0 = u.i1 * 256 + wc * 32 + 8 * fq;
#pragma unroll
        for (int ai = 0; ai < 2; ++ai)
#pragma unroll
            for (int m = 0; m < 4; ++m) {
                bf16_t* rowp = P + (size_t)(row0 + ai * 128 + m * 16) * PIN + col0;
#pragma unroll
                for (int bj = 0; bj < 2; ++bj) {
                    if (col0 + bj * 128 < PIN) {
                        const f32x4 v0 = acc[ai][bj][m][0], v1 = acc[ai][bj][m][1];
                        *(uint4*)(rowp + bj * 128) = make_uint4(pack2(v0[0], v0[1]), pack2(v0[2], v0[3]), pack2(v1[0], v1[1]), pack2(v1[2], v1[3]));
                    }
                }
            }
    };
    gemm256<true, false>(lds, 1024, 1024, sched, epi);
}

DEVINL void phaseC(KP p, int l, char* lds) {
    const int tid = TID512(), c = blockIdx.x, G = gridDim.x;
    const char* ymix = (const char*)(p->ws + A_YMIX);
    const char* Wt = (const char*)(p->ws + OFF_WOUT) + (size_t)l * 1024 * 1024 * 2;
    const float* res = (l == 0) ? p->in[I_X] : p->out;
    float* xbuf = p->out;
    const float* mod = (const float*)(p->ws + OFF_MOD);
    auto sched = [&](int i, GUnit& u) -> bool {
        const long L = unit_linear(i, c, G); if (L >= 128 * 4) return false;
        const int pm = (int)L >> 2, pn = (int)L & 3;
        u.A = ymix + (size_t)pm * 256 * 2048; u.B = Wt + (size_t)pn * 256 * 2048; u.i0 = pm; u.i1 = pn; u.i2 = 0;
        return true;
    };
    auto epi = [&](f32x4 (&acc)[2][2][4][2], const GUnit& u, int wr, int wc, int fr, int fq) {
        asm volatile("" : "+v"(fr), "+v"(fq));
        const int row0 = u.i0 * 256 + wr * 64 + fr, col0 = u.i1 * 256 + wc * 32 + 4 * fq;
#pragma unroll
        for (int ai = 0; ai < 2; ++ai)
#pragma unroll
            for (int m = 0; m < 4; ++m) {
                const int row = row0 + ai * 128 + m * 16, b = row >> 12;
#pragma unroll
                for (int bj = 0; bj < 2; ++bj)
#pragma unroll
                    for (int n = 0; n < 2; ++n) {
                        const int col = col0 + bj * 128 + n * 16;
                        const float4 g1 = *(const float4*)(mod + (size_t)(l * 8 + b) * 6144 + 2048 + col);
                        const float4 rx = *(const float4*)(res + (size_t)row * DM + col);
                        const f32x4 a = acc[ai][bj][m][n];
                        float4 z;
                        z.x = ALPHA * rx.x + (1.f + g1.x) * a[0]; z.y = ALPHA * rx.y + (1.f + g1.y) * a[1];
                        z.z = ALPHA * rx.z + (1.f + g1.z) * a[2]; z.w = ALPHA * rx.w + (1.f + g1.w) * a[3];
                        *(float4*)(xbuf + (size_t)row * DM + col) = z;
                    }
            }
    };
    gemm256<false, false>(lds, 1024, 1024, sched, epi);
}

constexpr int DIR_OFF = 131072;
DEVINL void moe_directory(KP p, int l, char* lds) {
    int* pref = (int*)(lds + DIR_OFF);
    int* cntl = (int*)(lds + DIR_OFF + 512);
    unsigned* cnt = (unsigned*)(p->ws + OFF_CNT) + l * 64;
    asm volatile("" : "+s"(cnt));
    if (threadIdx.x == 0) {
        int s = 0;
        for (int e = 0; e < 64; ++e) { const int c = (int)__hip_atomic_load(&cnt[e], __ATOMIC_RELAXED, __HIP_MEMORY_SCOPE_AGENT); cntl[e] = c; pref[e] = s; s += (c + 255) >> 8; }
        pref[64] = s; cntl[64] = NTOK; pref[65] = s + 128;
    }
    __syncthreads();
}

DEVINL void phaseE1(KP p, int l, char* lds) {
    const int tid = TID512(), c = blockIdx.x, G = gridDim.x;
    moe_directory(p, l, lds);
    const int* pref = (const int*)(lds + DIR_OFF); const int* cntl = (const int*)(lds + DIR_OFF + 512);
    const char* ubuf = (const char*)(p->ws + OFF_UBUF);
    const int* list = (const int*)(p->ws + M_LIST);
    bf16_t* hbuf = (bf16_t*)(p->ws + M_HBUF);
    const char* W13 = (const char*)(p->ws + OFF_W13) + (size_t)(l * 65) * 512 * 1024 * 2;
    const int total = __builtin_amdgcn_readfirstlane(pref[65]) * 2;
    auto sched = [&](int i, GUnit& u) -> bool {
        const long L = unit_linear(i, c, G); if (L >= total) return false;
        const int mg = (int)L >> 1, nt = (int)L & 1;
        int e = 0; while (pref[e + 1] <= mg) ++e;
        e = __builtin_amdgcn_readfirstlane(e);
        const int mt = __builtin_amdgcn_readfirstlane(mg - pref[e]), Me = __builtin_amdgcn_readfirstlane(cntl[e]);
        u.A = ubuf; u.B = W13 + ((size_t)e * 512 + nt * 256) * 2048; u.i0 = mg; u.i1 = nt; u.i2 = e;
        int R[2], C[2]; stage_coords512(TID512(), R, C);
#pragma unroll
        for (int h = 0; h < 2; ++h)
#pragma unroll
            for (int i2 = 0; i2 < 2; ++i2) {
                const int idx = mt * 256 + h * 128 + R[i2]; int tok;
                if (e < 64) tok = (idx < Me) ? (list[(size_t)e * NTOK + idx] >> 3) : 0; else tok = idx;
                u.va[h][i2] = (unsigned)(tok * 1024 + C[i2]) * 2u;
            }
        return true;
    };
    auto epi = [&](f32x4 (&acc)[2][2][4][2], const GUnit& u, int wr, int wc, int fr, int fq) {
        asm volatile("" : "+v"(fr), "+v"(fq));
        const size_t row0 = (size_t)u.i0 * 256 + wr * 64 + fr;
#pragma unroll
        for (int ai = 0; ai < 2; ++ai)
#pragma unroll
            for (int m = 0; m < 4; ++m) {
                bf16_t* rowp = hbuf + (row0 + ai * 128 + m * 16) * 256;
#pragma unroll
                for (int bj = 0; bj < 2; ++bj) {
                    const int hcol = (u.i1 * 8 + bj * 4 + wc) * 16 + 4 * fq;
                    const f32x4 gt = acc[ai][bj][m][0], up = acc[ai][bj][m][1];
                    float hv[4];
#pragma unroll
                    for (int j = 0; j < 4; ++j) hv[j] = gt[j] * sigm(gt[j]) * up[j];
                    uint2 o; o.x = pack2(hv[0], hv[1]); o.y = pack2(hv[2], hv[3]);
                    *(uint2*)(rowp + hcol) = o;
                }
            }
    };
    gemm256<false, true>(lds, 1024, 1024, sched, epi);
}

DEVINL void phaseE2(KP p, int l, char* lds) {
    const int tid = TID512(), c = blockIdx.x, G = gridDim.x;
    moe_directory(p, l, lds);
    const int* pref = (const int*)(lds + DIR_OFF); const int* cntl = (const int*)(lds + DIR_OFF + 512);
    const int* list = (const int*)(p->ws + M_LIST);
    const float* wsel = (const float*)(p->ws + M_WSEL);
    const char* hbuf = (const char*)(p->ws + M_HBUF);
    bf16_t* ybuf = (bf16_t*)(p->ws + M_YBUF);
    const char* W2 = (const char*)(p->ws + OFF_W2) + (size_t)(l * 65) * 1024 * 256 * 2;
    const int total = __builtin_amdgcn_readfirstlane(pref[65]) * 4;
    auto sched = [&](int i, GUnit& u) -> bool {
        const long L = unit_linear(i, c, G); if (L >= total) return false;
        const int mg = (int)L >> 2, nt = (int)L & 3;
        int e = 0; while (pref[e + 1] <= mg) ++e;
        e = __builtin_amdgcn_readfirstlane(e);
        u.A = hbuf + (size_t)mg * 256 * 512; u.B = W2 + ((size_t)e * 1024 + nt * 256) * 512; u.i0 = mg; u.i1 = nt; u.i2 = e;
        return true;
    };
    auto epi = [&](f32x4 (&acc)[2][2][4][2], const GUnit& u, int wr, int wc, int fr, int fq) {
        asm volatile("" : "+v"(fr), "+v"(fq));
        const int e = __builtin_amdgcn_readfirstlane(u.i2), mt = __builtin_amdgcn_readfirstlane(u.i0 - pref[e]), Me = __builtin_amdgcn_readfirstlane(cntl[e]);
        const int col0 = u.i1 * 256 + wc * 32 + 8 * fq;
        const int* lrow = list + (size_t)(e < 64 ? e : 0) * NTOK + mt * 256 + wr * 64 + fr;
#pragma unroll
        for (int ai = 0; ai < 2; ++ai)
#pragma unroll
            for (int m = 0; m < 4; ++m) {
                const int loc = ai * 128 + m * 16, idx = mt * 256 + loc + wr * 64 + fr;
                if (idx < Me) {
                    int dr; float w;
                    if (e < 64) { const int ts = lrow[loc]; w = wsel[ts]; dr = (ts >> 3) * 9 + (ts & 7); }
                    else { w = 1.f; dr = idx * 9 + 8; }
                    bf16_t* rowp = ybuf + (size_t)dr * 1024 + col0;
#pragma unroll
                    for (int bj = 0; bj < 2; ++bj) {
                        const f32x4 v0 = acc[ai][bj][m][0], v1 = acc[ai][bj][m][1];
                        *(uint4*)(rowp + bj * 128) = make_uint4(pack2(w * v0[0], w * v0[1]), pack2(w * v0[2], w * v0[3]), pack2(w * v1[0], w * v1[1]), pack2(w * v1[2], w * v1[3]));
                    }
                }
                asm volatile("" ::: "memory");
            }
    };
    gemm256<true, false>(lds, 256, 256, sched, epi);
}

DEVINL void phaseF(KP p, int l, const int dry = 0) {
    const int tid = TIDX(), nb = NBV(), blk = BIDX(), wid = tid >> 6, lane = tid & 63;
    const float* xbuf = p->out;
    float* xout = dry ? (float*)(p->ws + M_HBUF) : p->out;
    const bf16_t* ybuf = (const bf16_t*)(p->ws + M_YBUF);
    bf16_t* ubuf = (bf16_t*)(p->ws + OFF_UBUF);
    const float* mod = (const float*)(p->ws + OFF_MOD);
    for (int row = blk * 4 + wid; row < NTOK; row += nb * 4) {
        const int b = row >> 12;
        float4 z[4]; float s = 0.f;
#pragma unroll
        for (int i = 0; i < 4; ++i) {
            const int col = i * 256 + lane * 4;
            const float4 x1 = *(const float4*)(xbuf + (size_t)row * DM + col);
            float f0 = 0.f, f1 = 0.f, f2 = 0.f, f3 = 0.f;
#pragma unroll
            for (int k = 0; k < 9; ++k) {
                const uint2 yv = *(const uint2*)(ybuf + ((size_t)row * 9 + k) * 1024 + col);
                f0 += __uint_as_float(yv.x << 16); f1 += __uint_as_float(yv.x & 0xFFFF0000u); f2 += __uint_as_float(yv.y << 16); f3 += __uint_as_float(yv.y & 0xFFFF0000u);
            }
            const float4 g2 = *(const float4*)(mod + (size_t)(l * 8 + b) * 6144 + 5120 + col);
            z[i].x = ALPHA * x1.x + (1.f + g2.x) * f0; z[i].y = ALPHA * x1.y + (1.f + g2.y) * f1; z[i].z = ALPHA * x1.z + (1.f + g2.z) * f2; z[i].w = ALPHA * x1.w + (1.f + g2.w) * f3;
            s += z[i].x + z[i].y + z[i].z + z[i].w;
        }
        const float mean = wave_sum(s) * (1.f / 1024.f);
        float q = 0.f;
#pragma unroll
        for (int i = 0; i < 4; ++i) { z[i].x -= mean; z[i].y -= mean; z[i].z -= mean; z[i].w -= mean; q += z[i].x * z[i].x + z[i].y * z[i].y + z[i].z * z[i].z + z[i].w * z[i].w; }
        const float rs = rsqrtf(wave_sum(q) * (1.f / 1024.f) + LN_EPS);
#pragma unroll
        for (int i = 0; i < 4; ++i) {
            const int col = i * 256 + lane * 4;
            const float4 g = *(const float4*)(p->in[I_LN2G] + l * 1024 + col), bb = *(const float4*)(p->in[I_LN2B] + l * 1024 + col);
            float4 x2; x2.x = z[i].x * rs * g.x + bb.x; x2.y = z[i].y * rs * g.y + bb.y; x2.z = z[i].z * rs * g.z + bb.z; x2.w = z[i].w * rs * g.w + bb.w;
            *(float4*)(xout + (size_t)row * DM + col) = x2;
            if (l + 1 < DEPTH) {
                const float4 sh = *(const float4*)(mod + (size_t)((l + 1) * 8 + b) * 6144 + col), sc = *(const float4*)(mod + (size_t)((l + 1) * 8 + b) * 6144 + 1024 + col);
                uint2 o; o.x = pack2(x2.x * (1.f + sc.x) + sh.x, x2.y * (1.f + sc.y) + sh.y); o.y = pack2(x2.z * (1.f + sc.z) + sh.z, x2.w * (1.f + sc.w) + sh.w);
                *(uint2*)(ubuf + (size_t)row * DM + col) = o;
            }
        }
    }
}

#define XB_TMO      128
#define XB_XCNT(j)  (256  + 64 * (j))
#define XB_XSUB(j)  (1280 + 64 * (j))
#define XB_XGEN(j)  (2304 + 64 * (j))
#define XB_TOP      3328
#define XB_TOPGEN   3392
#define XCD_BAR_WORDS 3456
#define XB_SPIN_CAP (1u << 20)
DEVINL unsigned xb_ld(unsigned* p)              { return __hip_atomic_load(p, __ATOMIC_RELAXED, __HIP_MEMORY_SCOPE_AGENT); }
DEVINL unsigned xb_add(unsigned* p, unsigned v) { return __hip_atomic_fetch_add(p, v, __ATOMIC_RELAXED, __HIP_MEMORY_SCOPE_AGENT); }
DEVINL unsigned xb_xcc_id() { return (unsigned)__builtin_amdgcn_s_getreg((3 << 11) | 20) & 0xFu; }
#define XB_SPIN(cond, bar) do { unsigned _sp = 0; while (cond) { __builtin_amdgcn_s_sleep(1); \
    if ((++_sp & 255u) == 0u) { if (xb_ld(&(bar)[XB_TMO])) break; if (_sp > XB_SPIN_CAP) { atomicAdd(&(bar)[XB_TMO], 1u); break; } } } } while (0)
struct XcdBarrier { unsigned* bar; unsigned x; volatile LAS unsigned* st; };
DEVINL XcdBarrier xcd_barrier_post(unsigned* bar, volatile LAS unsigned* st) {
    XcdBarrier b; b.bar = bar; b.x = xb_xcc_id(); b.st = st;
    if (threadIdx.x == 0) (void)xb_add(&bar[XB_XCNT(b.x)], 1u);
    return b;
}
DEVINL void xcd_barrier_complete(unsigned* bar, unsigned x, unsigned& nloc, unsigned& nx) {
    const unsigned G = gridDim.x * gridDim.y * gridDim.z;
    unsigned sum, cnt, mine, sp = 0u;
    for (;;) {
        sum = 0u; cnt = 0u; mine = 0u;
#pragma unroll 1
        for (unsigned j = 0; j < 16; ++j) { const unsigned c = xb_ld(&bar[XB_XCNT(j)]); sum += c; cnt += (c > 0u) ? 1u : 0u; mine = (j == x) ? c : mine; }
        if (sum == G) break;
        __builtin_amdgcn_s_sleep(1);
        if ((++sp & 255u) == 0u) { if (xb_ld(&bar[XB_TMO])) break; if (sp > XB_SPIN_CAP) { atomicAdd(&bar[XB_TMO], 1u); break; } }
    }
    nloc = mine > 0u ? mine : 1u; nx = cnt > 0u ? cnt : 1u;
}
DEVINL void xcd_barrier(const XcdBarrier& b) {
    asm volatile("s_waitcnt vmcnt(0)" ::: "memory");
    __syncthreads();
    if (threadIdx.x == 0) {
        unsigned* bar = b.bar;
        __builtin_amdgcn_s_waitcnt(0);
        unsigned nloc = b.st[0], nx = b.st[1];
        if (nloc == 0u) { xcd_barrier_complete(bar, b.x, nloc, nx); b.st[0] = nloc; b.st[1] = nx; }
        const unsigned old = xb_add(&bar[XB_XSUB(b.x)], 1u);
        const unsigned gen = old / nloc;
        if (old + 1u == (gen + 1u) * nloc) {
            __builtin_amdgcn_fence(__ATOMIC_RELEASE, "agent");
            asm volatile("s_waitcnt vmcnt(0)" ::: "memory");
            const unsigned og = xb_add(&bar[XB_TOP], 1u);
            const unsigned tg = og / nx;
            if (og + 1u == (tg + 1u) * nx) xb_add(&bar[XB_TOPGEN], 1u);
            else XB_SPIN(xb_ld(&bar[XB_TOPGEN]) == tg, bar);
            __builtin_amdgcn_fence(__ATOMIC_ACQUIRE, "agent");
            xb_add(&bar[XB_XGEN(b.x)], 1u);
            asm volatile("s_waitcnt vmcnt(0)" ::: "memory");
        } else {
            XB_SPIN(xb_ld(&bar[XB_XGEN(b.x)]) == gen, bar);
            __builtin_amdgcn_fence(__ATOMIC_ACQUIRE, "agent");
            asm volatile("s_waitcnt vmcnt(0)" ::: "memory");
        }
    }
    __syncthreads();
}

constexpr int PPL = 12;
constexpr int NPHASE = 2 + PPL * DEPTH;
#ifndef PROBE_SUB
#define PROBE_SUB 3
#endif
#ifndef PROBE_REP
#define PROBE_REP (-1)
#endif
__global__ void __launch_bounds__(NTHREADS, 2) mega(Params p_arg, int ph_lo, int ph_hi) {
    extern __shared__ __attribute__((aligned(16))) char lds[];
    cg::grid_group grid = cg::this_grid();
    volatile LAS unsigned* st = (volatile LAS unsigned*)(lds + LDS_BYTES - 16);
    if (threadIdx.x == 0) { st[0] = 0u; st[1] = 0u; }
    __syncthreads();
    XcdBarrier xb = xcd_barrier_post((unsigned*)(p_arg.ws + OFF_BAR), st);
    for (int ph = ph_lo; ph < ph_hi; ++ph) {
        KP p = (KP)__builtin_amdgcn_kernarg_segment_ptr();
        asm volatile("" : "+s"(p));
        const int l = (ph >= 2) ? (ph - 2) / PPL : 0;
        const int q = (ph >= 2) ? (ph - 2) % PPL : -1;
        const bool nobar = (q >= 1 && q <= 3);
        const int nrep = (ph == PROBE_REP) ? 2 : 1;
        for (int rep = 0; rep < nrep; ++rep) {
            const int dry = (ph == PROBE_REP && rep == 0) ? 1 : 0;
            char* ldsh = lds + (threadIdx.x >> 8) * LDS_HALF;
            if (ph == 0) phase0(p, ldsh);
            else if (ph == 1) phaseF0(p);
            else {
                switch (q) {
                    case 0: phaseA(p, l, lds); break;
                    case 1: phaseB1(p, l, ldsh, 1, (ph == PROBE_REP && rep == 1) ? PROBE_SUB : 3); break;
                    case 2: phaseB1(p, l, ldsh, 2); break;
                    case 3: phaseB1(p, l, ldsh, 4); break;
                    case 4: phaseB1(p, l, ldsh, 8); break;
                    case 5: phaseB2(p, l); break;
                    case 6: phaseB3(p, l); break;
                    case 7: phaseC(p, l, lds); break;
                    case 8: phaseD(p, l, ldsh, dry); break;
                    case 9: phaseE1(p, l, lds); break;
                    case 10: phaseE2(p, l, lds); break;
                    default: phaseF(p, l, dry); break;
                }
            }
            const bool lastrep = (rep + 1 == nrep);
            if (!lastrep || (ph + 1 < ph_hi && !nobar)) { if (lastrep && ph == ph_lo) grid.sync(); else xcd_barrier(xb); }
        }
    }
}

extern "C" void kernel_launch(void* const* d_in, const int* in_sizes, int n_in, void* d_out, int out_size, void* d_ws, size_t ws_size, hipStream_t stream) {
    static int grid_blocks = 0;
    if (grid_blocks == 0) {
        if (n_in != 39 || out_size != NTOK * DM || ws_size < WS_NEED) { fprintf(stderr, "kernel_launch: unexpected shapes (n_in %d out %d ws %zu need %zu)\n", n_in, out_size, ws_size, (size_t)WS_NEED); grid_blocks = -1; return; }
        int dev = 0, cus = 0, per_cu = 0;
        hipGetDevice(&dev);
        hipDeviceGetAttribute(&cus, hipDeviceAttributeMultiprocessorCount, dev);
        hipFuncSetAttribute((const void*)mega, hipFuncAttributeMaxDynamicSharedMemorySize, LDS_BYTES);
        hipOccupancyMaxActiveBlocksPerMultiprocessor(&per_cu, (const void*)mega, NTHREADS, LDS_BYTES);
        if (per_cu < 1) { fprintf(stderr, "kernel_launch: occupancy query returned %d\n", per_cu); grid_blocks = -1; return; }
        if (cus < 256) { fprintf(stderr, "kernel_launch: this build needs 256 CUs (found %d)\n", cus); grid_blocks = -1; return; }
        grid_blocks = 256;
    }
    if (grid_blocks < 0) return;
    if (hipMemsetAsync(d_ws, 0, 32768, stream) != hipSuccess) { fprintf(stderr, "kernel_launch: memset failed\n"); return; }
    Params p{};
    for (int i = 0; i < 39; ++i) p.in[i] = (const float*)d_in[i];
    p.out = (float*)d_out; p.ws = (unsigned char*)d_ws;
    int ph_lo = 0, ph_hi = NPHASE;
    void* args[] = {&p, &ph_lo, &ph_hi};
    hipError_t e = hipLaunchCooperativeKernel((const void*)mega, dim3(grid_blocks), dim3(NTHREADS), args, LDS_BYTES, stream);
    if (e != hipSuccess) fprintf(stderr, "cooperative launch failed: %s (grid %d)\n", hipGetErrorString(e), grid_blocks);
}
```

```cpp
#include <hip/hip_runtime.h>
#include <hip/hip_cooperative_groups.h>
#include <stdio.h>
#include <stdint.h>
namespace cg = cooperative_groups;

typedef unsigned short bf16_t;
typedef short bf16x8 __attribute__((ext_vector_type(8)));
typedef float f32x4 __attribute__((ext_vector_type(4)));
#define DEVINL __device__ __forceinline__
#define LAS __attribute__((address_space(3)))

constexpr int NTOK = 32768, SEQ = 4096, NBATCH = 8, DM = 1024, PIN = 2688, DEPTH = 2;
constexpr int NEXP = 64;
constexpr float ALPHA = 1.41421356237f;
constexpr float LN_EPS = 1e-5f, GN_EPS = 64e-5f;
constexpr int NTHREADS = 512;
constexpr int VTHREADS = 256;
constexpr int LDS_HALF = 75776;
constexpr int LDS_BYTES = 152064;

constexpr size_t OFF_CNT   = 0;
constexpr size_t OFF_BAR   = 4096;
constexpr size_t OFF_MOD   = 65536;
constexpr size_t OFF_WIN   = 1048576;
constexpr int WIN_ROWS = 2816;
constexpr size_t OFF_WOUT  = OFF_WIN + 2 * (size_t)WIN_ROWS * 1024 * 2;
constexpr size_t OFF_W13   = OFF_WOUT + 4194304;
constexpr size_t OFF_W2    = OFF_W13 + 136314880;
constexpr size_t OFF_UBUF  = OFF_W2 + 68157440;
constexpr size_t OFF_ARENA = OFF_UBUF + 67108864;
constexpr size_t A_P      = OFF_ARENA;
constexpr size_t A_YMIX   = A_P + 176160768;
constexpr size_t A_SCAN   = A_YMIX + 67108864;
constexpr size_t A_HLOC   = A_SCAN + 134217728;
constexpr size_t A_CUMA   = A_HLOC + 33554432;
constexpr size_t A_G      = A_CUMA + 33554432;
constexpr size_t A_BONUS  = A_G + 33554432;
constexpr size_t A_YRAW   = A_BONUS + 33554432;
constexpr size_t A_CARRYA = A_YRAW + 33554432;
constexpr size_t A_CARRYH = A_CARRYA + 1048576;
constexpr size_t A_HSTART = A_CARRYH + 1048576;
constexpr size_t A_CHAIN  = A_HSTART + 1048576;
constexpr size_t CHAIN_UNIT = 49152;
constexpr size_t M_YBUF   = OFF_ARENA;
constexpr size_t M_HBUF   = M_YBUF + 603979776;
constexpr size_t M_LIST   = M_HBUF + 159383552;
constexpr size_t M_WSEL   = M_LIST + 8388608;
constexpr size_t M_PMAP   = M_WSEL + 1048576;
constexpr size_t WS_NEED  = M_PMAP + 1048576;

struct Params {
    const float* in[39];
    float* out;
    unsigned char* ws;
};
typedef const __attribute__((address_space(4))) Params* KP;
__device__ __forceinline__ int TIDX() { int t = threadIdx.x & 255; asm volatile("" : "+v"(t)); __builtin_assume(t >= 0 && t < 256); return t; }
__device__ __forceinline__ int BIDX() { int b = blockIdx.x * 2 + __builtin_amdgcn_readfirstlane((int)(threadIdx.x >> 8)); asm volatile("" : "+s"(b)); __builtin_assume(b >= 0 && b < 65536); return b; }
__device__ __forceinline__ int NBV() { return gridDim.x * 2; }
__device__ __forceinline__ int TID512() { int t = threadIdx.x; asm volatile("" : "+v"(t)); __builtin_assume(t >= 0 && t < 512); return t; }
enum { I_X = 0, I_C, I_WMOD, I_BMOD, I_WIN, I_WOUT, I_CONVA, I_CONVAB, I_LNAG, I_LNAB, I_CONVB, I_CONVBB, I_WRG, I_BRG, I_WIG, I_BIG,
       I_LAMBDA, I_MUC, I_W0, I_WW2, I_A0, I_WA2, I_WG2, I_KK, I_KA, I_RK, I_GNG, I_GNB, I_CONVD, I_LN1G, I_LN1B, I_WROUTER, I_EBIAS,
       I_W13, I_W2, I_WS13, I_WS2, I_LN2G, I_LN2B };

DEVINL bf16_t f2bf(float f) { unsigned u = __float_as_uint(f); u += 0x7FFFu + ((u >> 16) & 1u); return (bf16_t)(u >> 16); }
DEVINL float bf2f(bf16_t h) { return __uint_as_float(((unsigned)h) << 16); }
typedef __bf16 bf2_t __attribute__((ext_vector_type(2)));
typedef float f2_t __attribute__((ext_vector_type(2)));
typedef float f32x16 __attribute__((ext_vector_type(16)));
DEVINL unsigned pack2(float a, float b) { f2_t v = {a, b}; return __builtin_bit_cast(unsigned, __builtin_convertvector(v, bf2_t)); }
DEVINL float sigm(float x) { return 1.f / (1.f + __expf(-x)); }
DEVINL float tanh_fast(float x) { const float e = __expf(2.f * x); return 1.f - 2.f / (1.f + e); }
DEVINL float softplusf(float z) { return fmaxf(z, 0.f) + __logf(1.f + __expf(-fabsf(z))); }
DEVINL float softplus_acc(float z) { return fmaxf(z, 0.f) + log1pf(__expf(-fabsf(z))); }
DEVINL float gelu_tanh(float x) { float u = 0.7978845608028654f * (x + 0.044715f * x * x * x); return 0.5f * x * (1.f + tanh_fast(u)); }
DEVINL float group8_max(float x) {
    x = fmaxf(x, __builtin_bit_cast(float, __builtin_amdgcn_update_dpp(0, __builtin_bit_cast(int, x), 0xB1, 0xf, 0xf, true)));
    x = fmaxf(x, __builtin_bit_cast(float, __builtin_amdgcn_update_dpp(0, __builtin_bit_cast(int, x), 0x4E, 0xf, 0xf, true)));
    x = fmaxf(x, __builtin_bit_cast(float, __builtin_amdgcn_update_dpp(0, __builtin_bit_cast(int, x), 0x141, 0xf, 0xf, true)));
    return x;
}
DEVINL float wave_sum_dpp(float x);
DEVINL float wave_sum(float x) { return wave_sum_dpp(x); }
DEVINL float wave_sum_dpp(float x) {
    x += __builtin_bit_cast(float, __builtin_amdgcn_update_dpp(0, __builtin_bit_cast(int, x), 0xB1, 0xf, 0xf, true));
    x += __builtin_bit_cast(float, __builtin_amdgcn_update_dpp(0, __builtin_bit_cast(int, x), 0x4E, 0xf, 0xf, true));
    x += __builtin_bit_cast(float, __builtin_amdgcn_update_dpp(0, __builtin_bit_cast(int, x), 0x141, 0xf, 0xf, true));
    x += __builtin_bit_cast(float, __builtin_amdgcn_update_dpp(0, __builtin_bit_cast(int, x), 0x140, 0xf, 0xf, true));
    x += __builtin_bit_cast(float, __builtin_amdgcn_update_dpp(0, __builtin_bit_cast(int, x), 0x142, 0xa, 0xf, false));
    x += __builtin_bit_cast(float, __builtin_amdgcn_update_dpp(0, __builtin_bit_cast(int, x), 0x143, 0xc, 0xf, false));
    return __builtin_bit_cast(float, __builtin_amdgcn_readlane(__builtin_bit_cast(int, x), 63));
}

DEVINL int lds_byte(int r, int c) { int st = (r >> 4) * 2 + (c >> 5), rr = r & 15, cc = c & 31, ob = rr * 64 + cc * 2; return st * 1024 + (ob ^ (((ob >> 9) & 1) << 5)); }
DEVINL void stage_rc(int b, int& R, int& C) { int st = b / 1024, sb = b % 1024, swz = sb ^ (((sb >> 9) & 1) << 5); R = (st >> 1) * 16 + swz / 64; C = (st & 1) * 32 + (swz % 64) / 2; }

template <class RowPtr, class Epi>
DEVINL void gemm_tile128(char* lds, RowPtr arow, const bf16_t* Bt, int K, Epi epi) {
    const int tid = TIDX();
    const bf16_t* ap[4]; const bf16_t* bp[4];
#pragma unroll
    for (int i = 0; i < 4; ++i) { int R, C; stage_rc(tid * 16 + i * 4096, R, C); ap[i] = arow(R) + C; bp[i] = Bt + (size_t)R * K + C; }
    const int wid = tid >> 6, lane = tid & 63, wr = wid >> 1, wc = wid & 1, fr = lane & 15, fq = lane >> 4;
    f32x4 acc[4][4];
#pragma unroll
    for (int m = 0; m < 4; ++m)
#pragma unroll
        for (int n = 0; n < 4; ++n) acc[m][n] = (f32x4){0.f, 0.f, 0.f, 0.f};
    const int nk = K >> 6;
#pragma unroll
    for (int i = 0; i < 4; ++i) {
        __builtin_amdgcn_global_load_lds((const unsigned*)(ap[i]), (unsigned*)(lds + tid * 16 + i * 4096), 16, 0, 0);
        __builtin_amdgcn_global_load_lds((const unsigned*)(bp[i]), (unsigned*)(lds + 16384 + tid * 16 + i * 4096), 16, 0, 0);
    }
    for (int kt = 0; kt < nk; ++kt) {
        asm volatile("s_waitcnt vmcnt(0)" ::: "memory");
        __syncthreads();
        char* cur = lds + (kt & 1) * 32768;
        if (kt + 1 < nk) {
            char* nxt = lds + ((kt + 1) & 1) * 32768;
            const int ko = (kt + 1) * 64;
#pragma unroll
            for (int i = 0; i < 4; ++i) {
                __builtin_amdgcn_global_load_lds((const unsigned*)(ap[i] + ko), (unsigned*)(nxt + tid * 16 + i * 4096), 16, 0, 0);
                __builtin_amdgcn_global_load_lds((const unsigned*)(bp[i] + ko), (unsigned*)(nxt + 16384 + tid * 16 + i * 4096), 16, 0, 0);
            }
        }
        bf16x8 af[4][2], bfr[4][2];
#pragma unroll
        for (int m = 0; m < 4; ++m)
#pragma unroll
            for (int kk = 0; kk < 2; ++kk) af[m][kk] = *reinterpret_cast<const bf16x8*>(cur + lds_byte(wr * 64 + m * 16 + fr, kk * 32 + fq * 8));
#pragma unroll
        for (int n = 0; n < 4; ++n)
#pragma unroll
            for (int kk = 0; kk < 2; ++kk) bfr[n][kk] = *reinterpret_cast<const bf16x8*>(cur + 16384 + lds_byte(wc * 64 + n * 16 + fr, kk * 32 + fq * 8));
#pragma unroll
        for (int kk = 0; kk < 2; ++kk)
#pragma unroll
            for (int m = 0; m < 4; ++m)
#pragma unroll
                for (int n = 0; n < 4; ++n) acc[m][n] = __builtin_amdgcn_mfma_f32_16x16x32_bf16(bfr[n][kk], af[m][kk], acc[m][n], 0, 0, 0);
    }
    __syncthreads();
    epi(acc, wr, wc, fr, fq);
}

template <class Ptrs, class Epi>
DEVINL void gemm_stream128(char* lds, int K, int blk, int nb, int total, Ptrs ptrs, Epi epi) {
    const int qx = nb >> 3, first = (blk & 7) * qx + (blk >> 3), stride = nb;
    if (first >= total) return;
    const int tid = TIDX();
    const int wid = tid >> 6, lane = tid & 63, wr = wid >> 1, wc = wid & 1, fr = lane & 15, fq = lane >> 4;
    const int nk = K >> 6;
    const bf16_t* ap[4]; const bf16_t* bp[4];
    const bf16_t* an[4]; const bf16_t* bn[4];
    int t = first;
    ptrs(t, ap, bp);
#pragma unroll
    for (int i = 0; i < 4; ++i) {
        __builtin_amdgcn_global_load_lds((const unsigned*)(ap[i]), (unsigned*)(lds + tid * 16 + i * 4096), 16, 0, 0);
        __builtin_amdgcn_global_load_lds((const unsigned*)(bp[i]), (unsigned*)(lds + 16384 + tid * 16 + i * 4096), 16, 0, 0);
    }
    for (;;) {
        const int tn = t + stride;
        const bool has_next = tn < total;
        if (has_next) ptrs(tn, an, bn);
        f32x4 acc[4][4];
#pragma unroll
        for (int m = 0; m < 4; ++m)
#pragma unroll
            for (int n = 0; n < 4; ++n) acc[m][n] = (f32x4){0.f, 0.f, 0.f, 0.f};
        for (int kt = 0; kt < nk; ++kt) {
            asm volatile("s_waitcnt vmcnt(0)" ::: "memory");
            __syncthreads();
            char* cur = lds + (kt & 1) * 32768;
            if (kt + 1 < nk) {
                char* nxt = lds + ((kt + 1) & 1) * 32768;
                const int ko = (kt + 1) * 64;
#pragma unroll
                for (int i = 0; i < 4; ++i) {
                    __builtin_amdgcn_global_load_lds((const unsigned*)(ap[i] + ko), (unsigned*)(nxt + tid * 16 + i * 4096), 16, 0, 0);
                    __builtin_amdgcn_global_load_lds((const unsigned*)(bp[i] + ko), (unsigned*)(nxt + 16384 + tid * 16 + i * 4096), 16, 0, 0);
                }
            } else if (has_next) {
#pragma unroll
                for (int i = 0; i < 4; ++i) {
                    __builtin_amdgcn_global_load_lds((const unsigned*)(an[i]), (unsigned*)(lds + tid * 16 + i * 4096), 16, 0, 0);
                    __builtin_amdgcn_global_load_lds((const unsigned*)(bn[i]), (unsigned*)(lds + 16384 + tid * 16 + i * 4096), 16, 0, 0);
                }
            }
            bf16x8 af[4][2], bfr[4][2];
#pragma unroll
            for (int m = 0; m < 4; ++m)
#pragma unroll
                for (int kk = 0; kk < 2; ++kk) af[m][kk] = *reinterpret_cast<const bf16x8*>(cur + lds_byte(wr * 64 + m * 16 + fr, kk * 32 + fq * 8));
#pragma unroll
            for (int n = 0; n < 4; ++n)
#pragma unroll
                for (int kk = 0; kk < 2; ++kk) bfr[n][kk] = *reinterpret_cast<const bf16x8*>(cur + 16384 + lds_byte(wc * 64 + n * 16 + fr, kk * 32 + fq * 8));
#pragma unroll
            for (int kk = 0; kk < 2; ++kk)
#pragma unroll
                for (int m = 0; m < 4; ++m)
#pragma unroll
                    for (int n = 0; n < 4; ++n) acc[m][n] = __builtin_amdgcn_mfma_f32_16x16x32_bf16(bfr[n][kk], af[m][kk], acc[m][n], 0, 0, 0);
        }
        epi(t, acc, wr, wc, fr, fq);
        if (!has_next) break;
        t = tn;
#pragma unroll
        for (int i = 0; i < 4; ++i) { ap[i] = an[i]; bp[i] = bn[i]; }
    }
    __syncthreads();
}
DEVINL void stage_coords(int (&R)[4], int (&C)[4]) {
    const int tid = TIDX();
#pragma unroll
    for (int i = 0; i < 4; ++i) stage_rc(tid * 16 + i * 4096, R[i], C[i]);
}

struct GUnit {
    const char* A;
    const char* B;
    unsigned va[2][2] = {{0u, 0u}, {0u, 0u}};
    int i0, i1, i2;
};
constexpr int G_HTB = 128 * 64 * 2;
constexpr int G_STAGE_BYTES = 8 * G_HTB;
DEVINL int perm32(int rho) { const int n = rho >> 4, i = rho & 15; return 8 * (i >> 2) + 4 * n + (i & 3); }
DEVINL void stage_coords512(int tid, int (&R)[2], int (&C)[2]) {
#pragma unroll
    for (int i = 0; i < 2; ++i) stage_rc(tid * 16 + i * 8192, R[i], C[i]);
}

template <bool PERM, bool GATHER, class Sched, class Epi>
DEVINL void gemm256(char* lds_generic, int K, int lda, Sched sched, Epi epi) {
    LAS unsigned char* lds = (LAS unsigned char*)lds_generic;
    const int tid = TID512(), wid = __builtin_amdgcn_readfirstlane(tid >> 6), lane = tid & 63, wr = wid >> 2, wc = wid & 3, fr = lane & 15, fq = lane >> 4;
    const int nt = K / 64;
    unsigned voffB[2];
#pragma unroll
    for (int i = 0; i < 2; ++i) { int R, C; stage_rc(tid * 16 + i * 8192, R, C); const int Rb = PERM ? ((R & ~31) + perm32(R & 31)) : R; voffB[i] = (unsigned)(Rb * K + C) * 2u; }
    unsigned voffA[2];
#pragma unroll
    for (int i = 0; i < 2; ++i) { int R, C; stage_rc(tid * 16 + i * 8192, R, C); voffA[i] = (unsigned)(R * lda + C) * 2u; }
    const size_t hstepA = GATHER ? 0 : (size_t)128 * lda * 2;
    const size_t kstep = (size_t)(64 * 2);
    const size_t hstepB = (size_t)128 * K * 2;
    const unsigned ldsw = (unsigned)wid * 1024u;
    const int aoff = lds_byte(wr * 64 + fr, fq * 8), boff = lds_byte(wc * 32 + fr, fq * 8);
#define G_SA(b, h) (((b) * 2 + (h)) * G_HTB)
#define G_SB(b, h) ((4 + (b) * 2 + (h)) * G_HTB)
#define G_STAGE(bufoff, gbase, voff) do { _Pragma("unroll") for (int _i = 0; _i < 2; ++_i) { unsigned _vo = (voff)[_i]; asm volatile("" : "+v"(_vo)); \
        __builtin_amdgcn_global_load_lds((const unsigned*)((const char*)(gbase) + _vo), (LAS unsigned*)(lds + (bufoff) + ldsw + _i * 8192), 16, 0, 0); } } while (0)
#define G_STAGE_A(bufoff, ptr, vg, h) do { if constexpr (GATHER) { G_STAGE(bufoff, ptr, vg); } else { G_STAGE(bufoff, (ptr) + (h) * hstepA, voffA); } } while (0)
#define G_LDA(dst, b, h) do { _Pragma("unroll") for (int m = 0; m < 4; ++m) _Pragma("unroll") for (int k = 0; k < 2; ++k) dst[m][k] = *(const LAS bf16x8*)(lds + G_SA(b, h) + aoff + m * 2048 + k * 1024); } while (0)
#define G_LDB(dst, b, h) do { _Pragma("unroll") for (int n = 0; n < 2; ++n) _Pragma("unroll") for (int k = 0; k < 2; ++k) dst[n][k] = *(const LAS bf16x8*)(lds + G_SB(b, h) + boff + n * 2048 + k * 1024); } while (0)
#define G_MMA(ai, bj, At, Bt) do { __builtin_amdgcn_s_setprio(1); _Pragma("unroll") for (int m = 0; m < 4; ++m) _Pragma("unroll") for (int n = 0; n < 2; ++n) _Pragma("unroll") for (int k = 0; k < 2; ++k) \
        acc[ai][bj][m][n] = __builtin_amdgcn_mfma_f32_16x16x32_bf16(Bt[n][k], At[m][k], acc[ai][bj][m][n], 0, 0, 0); __builtin_amdgcn_s_setprio(0); } while (0)
#define G_WAIT_V(n) asm volatile("s_waitcnt vmcnt(" #n ")" ::: "memory")
#define G_WAIT_L(n) asm volatile("s_waitcnt lgkmcnt(" #n ")" ::: "memory")
#define G_BAR __builtin_amdgcn_s_barrier()
#define G_SCHED __builtin_amdgcn_sched_barrier(0)
    GUnit cur, nxt; int ui = 0;
    if (!sched(0, cur)) return;
    f32x4 acc[2][2][4][2];
#pragma unroll
    for (int a = 0; a < 2; ++a)
#pragma unroll
        for (int b = 0; b < 2; ++b)
#pragma unroll
            for (int m = 0; m < 4; ++m)
#pragma unroll
                for (int n = 0; n < 2; ++n) acc[a][b][m][n] = (f32x4){0.f, 0.f, 0.f, 0.f};
    bf16x8 At[4][2], B0[2][2], B1[2][2];
    G_STAGE(G_SB(0, 0), cur.B, voffB); G_STAGE_A(G_SA(0, 0), cur.A, cur.va[0], 0); G_STAGE(G_SB(0, 1), cur.B + hstepB, voffB); G_STAGE_A(G_SA(0, 1), cur.A, cur.va[1], 1);
    if (wr == 1) G_BAR;
    G_WAIT_V(4); G_BAR;
    G_STAGE(G_SB(1, 0), cur.B + kstep, voffB); G_STAGE_A(G_SA(1, 0), cur.A + kstep, cur.va[0], 0); G_STAGE(G_SB(1, 1), cur.B + hstepB + kstep, voffB);
    G_WAIT_V(6); G_BAR;
    for (;;) {
        const bool has_next = sched(ui + 1, nxt);
        if (!has_next) nxt = cur;
        for (int t = 0; t < nt; t += 2) {
            const bool last = (t == nt - 2);
            const char* a1 = cur.A + (size_t)(t + 1) * kstep;
            const char* a2 = last ? nxt.A : cur.A + (size_t)(t + 2) * kstep; const char* b2 = last ? nxt.B : cur.B + (size_t)(t + 2) * kstep;
            const char* a3 = a2 + kstep; const char* b3 = b2 + kstep;
            unsigned vh0[2] = {0u, 0u}, vh1[2] = {0u, 0u};
            if constexpr (GATHER) { vh0[0] = last ? nxt.va[0][0] : cur.va[0][0]; vh0[1] = last ? nxt.va[0][1] : cur.va[0][1]; vh1[0] = last ? nxt.va[1][0] : cur.va[1][0]; vh1[1] = last ? nxt.va[1][1] : cur.va[1][1]; }
            G_LDB(B0, 0, 0); G_SCHED; G_LDA(At, 0, 0); G_STAGE_A(G_SA(1, 1), a1, cur.va[1], 1);
            G_WAIT_L(8); G_BAR; G_WAIT_L(0); G_MMA(0, 0, At, B0); G_BAR; G_SCHED;
            G_LDB(B1, 0, 1); G_STAGE(G_SB(0, 0), b2, voffB);
            G_BAR; G_WAIT_L(0); G_MMA(0, 1, At, B1); G_BAR;
            G_LDA(At, 0, 1); G_STAGE_A(G_SA(0, 0), a2, vh0, 0);
            G_BAR; G_WAIT_L(0); G_MMA(1, 0, At, B0); G_BAR; G_SCHED;
            G_STAGE(G_SB(0, 1), b2 + hstepB, voffB);
            G_WAIT_V(6); G_BAR; G_MMA(1, 1, At, B1); G_BAR;
            G_LDB(B0, 1, 0); G_SCHED; G_LDA(At, 1, 0); G_STAGE_A(G_SA(0, 1), a2, vh1, 1);
            G_WAIT_L(8); G_BAR; G_WAIT_L(0); G_MMA(0, 0, At, B0); G_BAR; G_SCHED;
            G_LDB(B1, 1, 1); G_STAGE(G_SB(1, 0), b3, voffB);
            G_BAR; G_WAIT_L(0); G_MMA(0, 1, At, B1); G_BAR;
            G_LDA(At, 1, 1); G_STAGE_A(G_SA(1, 0), a3, vh0, 0);
            G_BAR; G_WAIT_L(0); G_MMA(1, 0, At, B0); G_BAR; G_SCHED;
            G_STAGE(G_SB(1, 1), b3 + hstepB, voffB);
            G_WAIT_V(6); G_BAR; G_MMA(1, 1, At, B1); G_BAR;
        }
        { const int l2 = TID512() & 63; epi(acc, cur, wr, wc, l2 & 15, l2 >> 4); }
        if (!has_next) break;
#pragma unroll
        for (int a = 0; a < 2; ++a)
#pragma unroll
            for (int b = 0; b < 2; ++b)
#pragma unroll
                for (int m = 0; m < 4; ++m)
#pragma unroll
                    for (int n = 0; n < 2; ++n) acc[a][b][m][n] = (f32x4){0.f, 0.f, 0.f, 0.f};
        cur = nxt; ++ui;
    }
    G_WAIT_V(0);
    if (wr == 0) G_BAR;
    G_BAR;
#undef G_SA
#undef G_STAGE_A
#undef G_SB
#undef G_STAGE
#undef G_LDA
#undef G_LDB
#undef G_MMA
#undef G_WAIT_V
#undef G_WAIT_L
#undef G_BAR
#undef G_SCHED
}
DEVINL long unit_linear(int i, int c, int G) { const int q = G >> 3; return ((long)i * 8 + (c & 7)) * q + (c >> 3); }

DEVINL void phase0(KP p, char* lds) {
    const int tid = TIDX(), nb = NBV(), blk = BIDX();
    if (blk == 0 && tid < 128) ((unsigned*)(p->ws + OFF_CNT))[tid] = 0u;
    if (blk < 192) {
        float* sc = (float*)lds;
        float* part = (float*)(lds + 32768);
        for (int i = tid; i < 8192; i += VTHREADS) { float c = p->in[I_C][i]; sc[i] = c * sigm(c); }
        __syncthreads();
        const int cl = tid & 63, ks = tid >> 6, n = blk * 64 + cl, l = n / 6144, nn = n % 6144;
        const float* w = p->in[I_WMOD] + (size_t)l * 1024 * 6144 + (size_t)(ks * 256) * 6144 + nn;
        float acc[8];
#pragma unroll
        for (int b = 0; b < 8; ++b) acc[b] = 0.f;
#pragma unroll 16
        for (int k = 0; k < 256; ++k) {
            const float wv = w[(size_t)k * 6144];
#pragma unroll
            for (int b = 0; b < 8; ++b) acc[b] = fmaf(sc[b * 1024 + ks * 256 + k], wv, acc[b]);
        }
#pragma unroll
        for (int b = 0; b < 8; ++b) part[(ks * 8 + b) * 64 + cl] = acc[b];
        __syncthreads();
        if (tid < 64) {
            const float bm = p->in[I_BMOD][l * 6144 + nn];
            float* mod = (float*)(p->ws + OFF_MOD);
#pragma unroll
            for (int b = 0; b < 8; ++b) mod[(size_t)(l * 8 + b) * 6144 + nn] = part[(0 * 8 + b) * 64 + cl] + part[(1 * 8 + b) * 64 + cl] + part[(2 * 8 + b) * 64 + cl] + part[(3 * 8 + b) * 64 + cl] + bm;
        }
        __syncthreads();
    }
    float* tile = (float*)lds;
    const int PER_L = 672 + 256 + 8320 + 4160;
    for (int base = 0; base < 2 * PER_L; base += nb) {
        const int id = (base + blk < 2 * PER_L) ? base + blk : 2 * PER_L - 1;
        const int l = id / PER_L; int r = id % PER_L;
        const float* src; bf16_t* dst; int K, ld, perm, kt, nt;
        if (r < 672) { src = p->in[I_WIN] + (size_t)l * 1024 * 2688; K = 1024; ld = 2688; perm = 0; dst = (bf16_t*)(p->ws + OFF_WIN) + (size_t)l * WIN_ROWS * 1024; kt = r & 15; nt = r >> 4; }
        else if (r < 928) { r -= 672; src = p->in[I_WOUT] + (size_t)l * 1024 * 1024; K = 1024; ld = 1024; perm = 0; dst = (bf16_t*)(p->ws + OFF_WOUT) + (size_t)l * 1024 * 1024; kt = r & 15; nt = r >> 4; }
        else if (r < 928 + 8320) { r -= 928; const int e = r >> 7, q = r & 127; kt = q & 15; nt = q >> 4; K = 1024; ld = 512; perm = 1;
            src = (e < 64) ? p->in[I_W13] + (size_t)(l * 64 + e) * 1024 * 512 : p->in[I_WS13] + (size_t)l * 1024 * 512;
            dst = (bf16_t*)(p->ws + OFF_W13) + (size_t)(l * 65 + e) * 512 * 1024; }
        else { r -= 9248; const int e = r >> 6, q = r & 63; kt = q & 3; nt = q >> 2; K = 256; ld = 1024; perm = 0;
            src = (e < 64) ? p->in[I_W2] + (size_t)(l * 64 + e) * 256 * 1024 : p->in[I_WS2] + (size_t)l * 256 * 1024;
            dst = (bf16_t*)(p->ws + OFF_W2) + (size_t)(l * 65 + e) * 1024 * 256; }
        const int k0 = kt * 64, r0 = nt * 64;
        {
            const int nn = tid & 63; const int drow = r0 + nn;
            int scol = drow;
            if (perm) { const int g = drow >> 5, i = drow & 31; scol = (i < 16) ? (g * 16 + i) : (256 + g * 16 + (i - 16)); }
#pragma unroll
            for (int j = 0; j < 16; ++j) { const int kk = (tid >> 6) + 4 * j; tile[kk * 65 + nn] = src[(size_t)(k0 + kk) * ld + scol]; }
        }
        __syncthreads();
        {
            const int kp = (tid & 31) * 2;
#pragma unroll
            for (int j = 0; j < 8; ++j) { const int rr = (tid >> 5) + 8 * j;
                *(unsigned*)(dst + (size_t)(r0 + rr) * K + k0 + kp) = pack2(tile[kp * 65 + rr], tile[(kp + 1) * 65 + rr]); }
        }
        __syncthreads();
    }
}

DEVINL void phaseF0(KP p) {
    const int tid = TIDX(), nb = NBV(), blk = BIDX();
    const float* mod = (const float*)(p->ws + OFF_MOD);
    bf16_t* ubuf = (bf16_t*)(p->ws + OFF_UBUF);
    for (int row = blk; row < NTOK; row += nb) {
        const int b = row >> 12, col = tid * 4;
        const float4 x = *(const float4*)(p->in[I_X] + (size_t)row * DM + col);
        const float4 sh = *(const float4*)(mod + (size_t)b * 6144 + col);
        const float4 sc = *(const float4*)(mod + (size_t)b * 6144 + 1024 + col);
        uint2 o; o.x = pack2(x.x * (1.f + sc.x) + sh.x, x.y * (1.f + sc.y) + sh.y); o.y = pack2(x.z * (1.f + sc.z) + sh.z, x.w * (1.f + sc.w) + sh.w);
        *(uint2*)(ubuf + (size_t)row * DM + col) = o;
    }
}

DEVINL void b1_conformer(KP p, int l, char* lds, int item) {
    const int tid = TIDX(), b = item >> 7, tt = item & 127, t0 = tt * 32, rowbase = b * SEQ;
    const bf16_t* P = (const bf16_t*)(p->ws + A_P);
    bf16_t* ymix = (bf16_t*)(p->ws + A_YMIX);
    float w[31];
#pragma unroll
    for (int k = 0; k < 31; ++k) w[k] = p->in[I_CONVA][(size_t)(l * 31 + k) * 256 + tid];
    float acc[32];
    const float bias = p->in[I_CONVAB][l * 256 + tid];
#pragma unroll
    for (int j = 0; j < 32; ++j) acc[j] = bias;
#pragma unroll
    for (int rr = 0; rr < 62; ++rr) {
        const int t = t0 - 30 + rr;
        const bf16_t* pr = P + ((long)(rowbase + t0 - 30) * PIN + tid) + (long)rr * PIN;
        const float val = bf2f(pr[0]), gate = bf2f(pr[256]);
        const float h = (t >= 0) ? val * sigm(gate) : 0.f;
#pragma unroll
        for (int j = 0; j < 32; ++j) { const int k = rr - j; if (k >= 0 && k <= 30) acc[j] = fmaf(w[k], h, acc[j]); }
    }
    float* outb = (float*)lds;
#pragma unroll
    for (int j = 0; j < 32; ++j) outb[j * 256 + tid] = acc[j];
    __syncthreads();
    const int wid = tid >> 6, lane = tid & 63;
    const float4 g4 = *(const float4*)(p->in[I_LNAG] + l * 256 + lane * 4), b4 = *(const float4*)(p->in[I_LNAB] + l * 256 + lane * 4);
    for (int j = wid; j < 32; j += 4) {
        const float4 v = *(const float4*)(outb + j * 256 + lane * 4);
        const float mean = wave_sum(v.x + v.y + v.z + v.w) * (1.f / 256.f);
        const float d0 = v.x - mean, d1 = v.y - mean, d2 = v.z - mean, d3 = v.w - mean;
        const float var = wave_sum(d0 * d0 + d1 * d1 + d2 * d2 + d3 * d3) * (1.f / 256.f);
        const float rs = rsqrtf(var + LN_EPS);
        float y0 = d0 * rs * g4.x + b4.x, y1 = d1 * rs * g4.y + b4.y, y2 = d2 * rs * g4.z + b4.z, y3 = d3 * rs * g4.w + b4.w;
        y0 *= sigm(y0); y1 *= sigm(y1); y2 *= sigm(y2); y3 *= sigm(y3);
        uint2 o; o.x = pack2(y0, y1); o.y = pack2(y2, y3);
        *(uint2*)(ymix + (size_t)(rowbase + t0 + j) * DM + lane * 4) = o;
    }
    __syncthreads();
}

DEVINL void b1_shortconv(KP p, int l, int item) {
    const int tid = TIDX(), cg = tid & 31, tl = tid >> 5, b = item >> 6, t0 = (item & 63) * 64 + tl * 8, rowbase = b * SEQ;
    const bf16_t* P = (const bf16_t*)(p->ws + A_P);
    bf16_t* ymix = (bf16_t*)(p->ws + A_YMIX);
    float w0[8], w1[8], w2[8];
#pragma unroll
    for (int e = 0; e < 8; ++e) { w0[e] = p->in[I_CONVD][(l * 3 + 0) * 256 + cg * 8 + e]; w1[e] = p->in[I_CONVD][(l * 3 + 1) * 256 + cg * 8 + e]; w2[e] = p->in[I_CONVD][(l * 3 + 2) * 256 + cg * 8 + e]; }
    uint4 gbv[8], gcv[10], hdv[10];
#pragma unroll
    for (int u = 0; u < 10; ++u) {
        const int t = t0 - 2 + u;
        const bf16_t* a = P + (size_t)(rowbase + (t >= 0 ? t : 0)) * PIN + 1920 + cg * 8;
        gcv[u] = *(const uint4*)(a + 256); hdv[u] = *(const uint4*)(a + 512);
        if (u >= 2) gbv[u - 2] = *(const uint4*)(a);
    }
    float q2[8], q1[8];
#pragma unroll
    for (int u = 0; u < 10; ++u) {
        const int t = t0 - 2 + u;
        const unsigned gcw[4] = {gcv[u].x, gcv[u].y, gcv[u].z, gcv[u].w}, hdw[4] = {hdv[u].x, hdv[u].y, hdv[u].z, hdv[u].w};
        float q0[8];
#pragma unroll
        for (int e = 0; e < 4; ++e) {
            q0[2 * e] = __uint_as_float(gcw[e] << 16) * __uint_as_float(hdw[e] << 16);
            q0[2 * e + 1] = __uint_as_float(gcw[e] & 0xFFFF0000u) * __uint_as_float(hdw[e] & 0xFFFF0000u);
        }
        if (t < 0) {
#pragma unroll
            for (int e = 0; e < 8; ++e) q0[e] = 0.f;
        }
        if (u >= 2) {
            const unsigned gbw[4] = {gbv[u - 2].x, gbv[u - 2].y, gbv[u - 2].z, gbv[u - 2].w};
            float y[8];
#pragma unroll
            for (int e = 0; e < 4; ++e) {
                y[2 * e] = __uint_as_float(gbw[e] << 16) * (w0[2 * e] * q2[2 * e] + w1[2 * e] * q1[2 * e] + w2[2 * e] * q0[2 * e]);
                y[2 * e + 1] = __uint_as_float(gbw[e] & 0xFFFF0000u) * (w0[2 * e + 1] * q2[2 * e + 1] + w1[2 * e + 1] * q1[2 * e + 1] + w2[2 * e + 1] * q0[2 * e + 1]);
            }
            *(uint4*)(ymix + (size_t)(rowbase + t) * DM + 768 + cg * 8) = make_uint4(pack2(y[0], y[1]), pack2(y[2], y[3]), pack2(y[4], y[5]), pack2(y[6], y[7]));
        }
#pragma unroll
        for (int e = 0; e < 8; ++e) { q2[e] = (u >= 1) ? q1[e] : 0.f; q1[e] = q0[e]; }
    }
}

DEVINL void b1_lru(KP p, int l, char* lds, int item) {
    const int c = TIDX(), b = item >> 7, tt = item & 127, t0 = tt * 32, rowbase = b * SEQ;
    const int h = c >> 6, lane = c & 63;
    const bf16_t* P = (const bf16_t*)(p->ws + A_P);
    float* uT = (float*)lds;
    {
        const float cb0 = p->in[I_CONVB][(l * 4 + 0) * 256 + c], cb1 = p->in[I_CONVB][(l * 4 + 1) * 256 + c], cb2 = p->in[I_CONVB][(l * 4 + 2) * 256 + c], cb3 = p->in[I_CONVB][(l * 4 + 3) * 256 + c];
        const float bias = p->in[I_CONVBB][l * 256 + c];
        float xm3 = 0.f, xm2 = 0.f, xm1 = 0.f;
        if (t0 >= 3) { const bf16_t* a = P + (size_t)(rowbase + t0 - 3) * PIN + 512 + c; xm3 = bf2f(a[0]); xm2 = bf2f(a[PIN]); xm1 = bf2f(a[2 * PIN]); }
        bf16_t xr[32];
#pragma unroll
        for (int j = 0; j < 32; ++j) xr[j] = P[(size_t)(rowbase + t0 + j) * PIN + 512 + c];
#pragma unroll
        for (int j = 0; j < 32; ++j) {
            const float x0 = bf2f(xr[j]);
            uT[c * 36 + j] = cb0 * xm3 + cb1 * xm2 + cb2 * xm1 + cb3 * x0 + bias;
            xm3 = xm2; xm2 = xm1; xm1 = x0;
        }
    }
    __syncthreads();
    const float brg = p->in[I_BRG][l * 256 + c], big = p->in[I_BIG][l * 256 + c];
    const float sp = softplus_acc(-p->in[I_LAMBDA][l * 256 + c]);
    float* hloc = (float*)(p->ws + A_HLOC); float* cuma = (float*)(p->ws + A_CUMA);
    const float* wrg = p->in[I_WRG] + (size_t)((l * 4 + h) * 64) * 64 + lane;
    const float* wig = p->in[I_WIG] + (size_t)((l * 4 + h) * 64) * 64 + lane;
    float hs = 0.f, cA = 1.f;
#pragma unroll 1
    for (int half = 0; half < 2; ++half) {
        float ar[16], ai[16];
#pragma unroll
        for (int j = 0; j < 16; ++j) { ar[j] = 0.f; ai[j] = 0.f; }
#pragma unroll 1
        for (int dh = 0; dh < 4; ++dh) {
            float wrv[16], wiv[16];
#pragma unroll
            for (int d = 0; d < 16; ++d) { wrv[d] = wrg[(dh * 16 + d) * 64]; wiv[d] = wig[(dh * 16 + d) * 64]; }
#pragma unroll
            for (int d = 0; d < 16; ++d) {
                const float wr = wrv[d], wi = wiv[d];
                const float4* up = (const float4*)(uT + (h * 64 + dh * 16 + d) * 36 + half * 16);
#pragma unroll
                for (int jj = 0; jj < 4; ++jj) {
                    const float4 u4 = up[jj];
                    ar[4 * jj + 0] = fmaf(u4.x, wr, ar[4 * jj + 0]); ai[4 * jj + 0] = fmaf(u4.x, wi, ai[4 * jj + 0]);
                    ar[4 * jj + 1] = fmaf(u4.y, wr, ar[4 * jj + 1]); ai[4 * jj + 1] = fmaf(u4.y, wi, ai[4 * jj + 1]);
                    ar[4 * jj + 2] = fmaf(u4.z, wr, ar[4 * jj + 2]); ai[4 * jj + 2] = fmaf(u4.z, wi, ai[4 * jj + 2]);
                    ar[4 * jj + 3] = fmaf(u4.w, wr, ar[4 * jj + 3]); ai[4 * jj + 3] = fmaf(u4.w, wi, ai[4 * jj + 3]);
                }
            }
        }
        float ureg[16];
#pragma unroll
        for (int jj = 0; jj < 4; ++jj) { const float4 u4 = *(const float4*)(uT + c * 36 + half * 16 + 4 * jj); ureg[4 * jj] = u4.x; ureg[4 * jj + 1] = u4.y; ureg[4 * jj + 2] = u4.z; ureg[4 * jj + 3] = u4.w; }
        float* hp = hloc + (size_t)(rowbase + t0 + half * 16) * 256 + c;
        float* cp = cuma + (size_t)(rowbase + t0 + half * 16) * 256 + c;
#pragma unroll
        for (int j = 0; j < 16; ++j) {
            const float r = sigm(ar[j] + brg), ig = sigm(ai[j] + big);
            const float log_a = -8.0f * r * sp;
            const float a = __expf(log_a);
            const float mult = sqrtf(fmaxf(1.f - a * a, 0.f));
            const float bx = mult * (ig * ureg[j]);
            hs = fmaf(a, hs, bx); cA *= a;
            hp[j * 256] = hs; cp[j * 256] = cA;
        }
    }
    ((float*)(p->ws + A_CARRYA))[(size_t)(b * 128 + tt) * 256 + c] = cA;
    ((float*)(p->ws + A_CARRYH))[(size_t)(b * 128 + tt) * 256 + c] = hs;
    __syncthreads();
}

DEVINL void b1_rwkv(KP p, int l, char* lds, int item) {
    const int c = TIDX(), b = item >> 7, tt = item & 127, t0 = tt * 32, rowbase = b * SEQ;
    const bf16_t* P = (const bf16_t*)(p->ws + A_P);
    float* featT = (float*)lds;
    const float* muc = p->in[I_MUC] + l * 896;
    if (c < 128) {
        const int col = 1024 + 768 + c; const float mu = muc[768 + c];
        float prev;
        { const float x = bf2f(P[(size_t)(rowbase + (t0 > 0 ? t0 - 1 : 0)) * PIN + col]); prev = (t0 > 0) ? x : 0.f; }
#pragma unroll 1
        for (int jb = 0; jb < 2; ++jb) {
            bf16_t raw[16];
#pragma unroll
            for (int u = 0; u < 16; ++u) raw[u] = P[(size_t)(rowbase + t0 + jb * 16 + u) * PIN + col];
#pragma unroll
            for (int u = 0; u < 16; ++u) {
                const float cur = bf2f(raw[u]);
                const float xs = cur + (prev - cur) * mu;
                const float val = (c < 32) ? tanh_fast(xs) : ((c < 64) ? xs : sigm(xs));
                featT[c * 36 + jb * 16 + u] = val; prev = cur;
            }
        }
    }
    __syncthreads();
    float acc[32], dec[32], aa[32];
#define LORA32(WPTR, FOFF) do { float wv_[32]; \
    _Pragma("unroll") for (int jf = 0; jf < 32; ++jf) wv_[jf] = (WPTR)[(size_t)jf * 256 + c]; \
    _Pragma("unroll") for (int jf = 0; jf < 32; ++jf) { const float4* fp = (const float4*)(featT + ((FOFF) + jf) * 36); const float wv = wv_[jf]; \
        _Pragma("unroll") for (int jj = 0; jj < 8; ++jj) { const float4 u4 = fp[jj]; acc[4 * jj] = fmaf(u4.x, wv, acc[4 * jj]); acc[4 * jj + 1] = fmaf(u4.y, wv, acc[4 * jj + 1]); acc[4 * jj + 2] = fmaf(u4.z, wv, acc[4 * jj + 2]); acc[4 * jj + 3] = fmaf(u4.w, wv, acc[4 * jj + 3]); } } } while (0)
#pragma unroll
    for (int j = 0; j < 32; ++j) acc[j] = 0.f;
    LORA32(p->in[I_WG2] + (size_t)(l * 64) * 256, 64);
    LORA32(p->in[I_WG2] + (size_t)(l * 64 + 32) * 256, 96);
    {
        float* gbuf = (float*)(p->ws + A_G);
#pragma unroll
        for (int j = 0; j < 32; ++j) { gbuf[(size_t)(rowbase + t0 + j) * 256 + c] = acc[j]; acc[j] = 0.f; }
    }
    LORA32(p->in[I_WW2] + (size_t)(l * 32) * 256, 0);
    {
        const float w0 = p->in[I_W0][l * 256 + c];
#pragma unroll
        for (int j = 0; j < 32; ++j) { const float z = w0 + acc[j]; const float wlog = -softplusf(-z) - 0.5f; dec[j] = -__expf(wlog); acc[j] = 0.f; }
    }
    LORA32(p->in[I_WA2] + (size_t)(l * 32) * 256, 32);
    {
        const float a0 = p->in[I_A0][l * 256 + c];
#pragma unroll
        for (int j = 0; j < 32; ++j) aa[j] = sigm(a0 + acc[j]);
    }
#undef LORA32
    {
        float* bonus = (float*)(p->ws + A_BONUS); uint4* scan = (uint4*)(p->ws + A_SCAN);
        const float mur = muc[c], muk = muc[256 + c], muv = muc[512 + c];
        const float kkw = p->in[I_KK][l * 256 + c], kaw = p->in[I_KA][l * 256 + c], rkw = p->in[I_RK][l * 256 + c];
        float pr, pk, pv;
        { const bf16_t* a = P + (size_t)(rowbase + (t0 > 0 ? t0 - 1 : 0)) * PIN + 1024 + c; const float x0 = bf2f(a[0]), x1 = bf2f(a[256]), x2 = bf2f(a[512]);
          pr = (t0 > 0) ? x0 : 0.f; pk = (t0 > 0) ? x1 : 0.f; pv = (t0 > 0) ? x2 : 0.f; }
#pragma unroll
        for (int jb = 0; jb < 4; ++jb) {
            bf16_t rr_[8], rk_[8], rv_[8];
#pragma unroll
            for (int u = 0; u < 8; ++u) { const bf16_t* a = P + (size_t)(rowbase + t0 + jb * 8 + u) * PIN + 1024 + c; rr_[u] = a[0]; rk_[u] = a[256]; rv_[u] = a[512]; }
#pragma unroll
            for (int u = 0; u < 8; ++u) {
                const int j = jb * 8 + u;
                const size_t row = (size_t)(rowbase + t0 + j);
                const float cr = bf2f(rr_[u]), ck = bf2f(rk_[u]), cv = bf2f(rv_[u]);
                const float r = cr + (pr - cr) * mur, k = ck + (pk - ck) * muk, v = cv + (pv - cv) * muv;
                pr = cr; pk = ck; pv = cv;
                const float kk = k * kkw;
                const float ss = wave_sum(kk * kk);
                const float kkn = kk * rsqrtf(ss + 1e-12f);
                const float kf = k * (1.f + (aa[j] - 1.f) * kaw);
                const float bs = wave_sum(r * kf * rkw);
                bonus[row * 256 + c] = bs * v;
                uint4 o; o.x = pack2(kkn, kkn * aa[j]); o.y = pack2(kf, r); o.z = pack2(v, 0.f); o.w = __float_as_uint(dec[j]);
                scan[row * 256 + c] = o;
            }
            asm volatile("" ::: "memory");
        }
    }
    __syncthreads();
}

constexpr int S_AL = 0, S_BE = 8192, S_KA = 16384, S_RH = 24576, S_BET = 32768, S_KAT = 40960, S_VT = 49152, S_L2F = 57344  , S_GT = 73728  ;
constexpr int S_L1F = S_BE;
constexpr int S_M1 = S_BE, S_M2 = S_KA;
constexpr int S_APT = S_L2F, S_W2T = S_L2F + 8192;
constexpr int S_RP = S_AL, S_GTR = S_RH;
DEVINL int crow32(int reg, int h) { return (reg & 3) + 8 * (reg >> 2) + 4 * h; }
DEVINL bf16x8 frag64(const char* lds, int slot, int row, int kel) { return *reinterpret_cast<const bf16x8*>(lds + slot + row * 128 + kel * 2); }
#define MFMA32(a, b, c) __builtin_amdgcn_mfma_f32_32x32x16_bf16((a), (b), (c), 0, 0, 0)
DEVINL float dpp_xor1(float x) { return __builtin_bit_cast(float, __builtin_amdgcn_update_dpp(0, __builtin_bit_cast(int, x), 0xB1, 0xf, 0xf, true)); }

DEVINL f32x16 mm64(const char* lds, int slotA, int slotB, int tm, int tn, int r, int hh, f32x16 acc) {
#pragma unroll
    for (int ks = 0; ks < 4; ++ks) acc = MFMA32(frag64(lds, slotA, tm * 32 + r, ks * 16 + 8 * hh), frag64(lds, slotB, tn * 32 + r, ks * 16 + 8 * hh), acc);
    return acc;
}

DEVINL void b1e_unit(KP p, char* lds, int b, int h, int c) {
    const int tid = TIDX(), wv = tid >> 6, lane = tid & 63, r = lane & 31, hh = lane >> 5;
    const uint4* scan = (const uint4*)(p->ws + A_SCAN) + ((size_t)(b * SEQ + c * 64)) * 256 + h * 64;
    float* gtot = (float*)(lds + S_GT); float* gamC = gtot + 256;
    {
        const int j = lane;
        float lw[16]; unsigned px[16], py[16], pz[16];
#pragma unroll
        for (int u = 0; u < 16; ++u) { const uint4 q = scan[(size_t)(wv * 16 + u) * 256 + j]; px[u] = q.x; py[u] = q.y; pz[u] = q.z; lw[u] = __uint_as_float(q.w); }
        float tot = 0.f;
#pragma unroll
        for (int u = 0; u < 16; ++u) tot += lw[u];
        gtot[wv * 64 + j] = tot;
        __syncthreads();
        float off = 0.f, all = 0.f;
#pragma unroll
        for (int g = 0; g < 4; ++g) { const float v = gtot[g * 64 + j]; all += v; off += (g < wv) ? v : 0.f; }
        if (wv == 0) gamC[j] = __expf(all);
        float cum = off;
        unsigned tb[8], tk[8], tv[8];
#pragma unroll
        for (int u = 0; u < 16; ++u) {
            const float kkn = __uint_as_float(px[u] << 16), bb = __uint_as_float(px[u] & 0xFFFF0000u);
            const float kf = __uint_as_float(py[u] << 16), rr = __uint_as_float(py[u] & 0xFFFF0000u);
            const float gp = __expf(cum); cum += lw[u];
            const float g = __expf(cum), en = __expf(-cum);
            const int t = wv * 16 + u;
            const unsigned be = f2bf(bb * en), ka = f2bf(kf * en);
            *(bf16_t*)(lds + S_AL + t * 128 + j * 2) = f2bf(gp * kkn);
            *(bf16_t*)(lds + S_BE + t * 128 + j * 2) = (bf16_t)be;
            *(bf16_t*)(lds + S_KA + t * 128 + j * 2) = (bf16_t)ka;
            *(bf16_t*)(lds + S_RH + t * 128 + j * 2) = f2bf(g * rr);
            if (u & 1) { tb[u >> 1] |= be << 16; tk[u >> 1] |= ka << 16; tv[u >> 1] |= (pz[u] << 16); }
            else { tb[u >> 1] = be; tk[u >> 1] = ka; tv[u >> 1] = pz[u] & 0xFFFFu; }
        }
        *(uint4*)(lds + S_BET + j * 128 + wv * 32) = make_uint4(tb[0], tb[1], tb[2], tb[3]); *(uint4*)(lds + S_BET + j * 128 + wv * 32 + 16) = make_uint4(tb[4], tb[5], tb[6], tb[7]);
        *(uint4*)(lds + S_KAT + j * 128 + wv * 32) = make_uint4(tk[0], tk[1], tk[2], tk[3]); *(uint4*)(lds + S_KAT + j * 128 + wv * 32 + 16) = make_uint4(tk[4], tk[5], tk[6], tk[7]);
        *(uint4*)(lds + S_VT + j * 128 + wv * 32) = make_uint4(tv[0], tv[1], tv[2], tv[3]); *(uint4*)(lds + S_VT + j * 128 + wv * 32 + 16) = make_uint4(tv[4], tv[5], tv[6], tv[7]);
    }
    __syncthreads();
    const int tm = wv >> 1, tn = wv & 1;
    f32x16 aM1, aM2;
    {
        f32x16 aL1, aL2;
#pragma unroll
        for (int i = 0; i < 16; ++i) { aL1[i] = 0.f; aL2[i] = 0.f; aM1[i] = 0.f; aM2[i] = 0.f; }
#pragma unroll
        for (int ks = 0; ks < 4; ++ks) {
            const bf16x8 fa = frag64(lds, S_AL, tm * 32 + r, ks * 16 + 8 * hh), fr = frag64(lds, S_RH, tm * 32 + r, ks * 16 + 8 * hh);
            const bf16x8 fb = frag64(lds, S_BE, tn * 32 + r, ks * 16 + 8 * hh), fk = frag64(lds, S_KA, tn * 32 + r, ks * 16 + 8 * hh);
            aL1 = MFMA32(fa, fb, aL1); aL2 = MFMA32(fa, fk, aL2); aM1 = MFMA32(fr, fb, aM1); aM2 = MFMA32(fr, fk, aM2);
        }
        __syncthreads();
#pragma unroll
        for (int reg = 0; reg < 16; ++reg) {
            const int t = tm * 32 + crow32(reg, hh), sidx = tn * 32 + r;
            const int o = (t * 64 + (sidx & 1) * 32 + (sidx >> 1)) * 4;
            *(float*)(lds + S_L1F + o) = (sidx < t) ? aL1[reg] : 0.f;
            *(float*)(lds + S_L2F + o) = (sidx < t) ? aL2[reg] : 0.f;
            aM1[reg] = (sidx <= t) ? aM1[reg] : 0.f; aM2[reg] = (sidx <= t) ? aM2[reg] : 0.f;
        }
    }
    __syncthreads();
    unsigned outp[32];
    {
        const int col = (wv & 1) * 32 + (lane >> 1), q = lane & 1;
        float xq[32];
#pragma unroll
        for (int k = 0; k < 32; ++k) xq[k] = 0.f;
        const char* l1row = lds + S_L1F + q * 128;
        const char* l2row = lds + S_L2F + q * 128;
        if (wv < 2) {
#pragma unroll
            for (int t = 0; t < 64; ++t) {
                float acc = 0.f;
#pragma unroll
                for (int k4 = 0; k4 * 4 < (t + 1) / 2; ++k4) {
                    const float4 a = *(const float4*)(l1row + t * 256 + k4 * 16);
                    acc = fmaf(a.x, xq[4 * k4 + 0], acc); acc = fmaf(a.y, xq[4 * k4 + 1], acc); acc = fmaf(a.z, xq[4 * k4 + 2], acc); acc = fmaf(a.w, xq[4 * k4 + 3], acc);
                }
                acc += dpp_xor1(acc);
                const float x = bf2f(*(const bf16_t*)(lds + S_AL + t * 128 + col * 2)) - acc;
                xq[t >> 1] = ((t & 1) == q) ? x : xq[t >> 1];
            }
        } else {
            float vq[32];
#pragma unroll
            for (int k8 = 0; k8 < 8; ++k8) {
                const uint4 d = *(const uint4*)(lds + S_VT + col * 128 + k8 * 16);
                vq[4 * k8 + 0] = q ? __uint_as_float(d.x & 0xFFFF0000u) : __uint_as_float(d.x << 16);
                vq[4 * k8 + 1] = q ? __uint_as_float(d.y & 0xFFFF0000u) : __uint_as_float(d.y << 16);
                vq[4 * k8 + 2] = q ? __uint_as_float(d.z & 0xFFFF0000u) : __uint_as_float(d.z << 16);
                vq[4 * k8 + 3] = q ? __uint_as_float(d.w & 0xFFFF0000u) : __uint_as_float(d.w << 16);
            }
#pragma unroll
            for (int t = 0; t < 64; ++t) {
                float acc = 0.f;
#pragma unroll
                for (int k4 = 0; k4 * 4 < (t + 1) / 2; ++k4) {
                    const float4 a = *(const float4*)(l1row + t * 256 + k4 * 16);
                    const float4 bq = *(const float4*)(l2row + t * 256 + k4 * 16);
                    acc = fmaf(bq.x, vq[4 * k4 + 0], acc); acc = fmaf(bq.y, vq[4 * k4 + 1], acc); acc = fmaf(bq.z, vq[4 * k4 + 2], acc); acc = fmaf(bq.w, vq[4 * k4 + 3], acc);
                    acc = fmaf(-a.x, xq[4 * k4 + 0], acc); acc = fmaf(-a.y, xq[4 * k4 + 1], acc); acc = fmaf(-a.z, xq[4 * k4 + 2], acc); acc = fmaf(-a.w, xq[4 * k4 + 3], acc);
                }
                acc += dpp_xor1(acc);
                xq[t >> 1] = ((t & 1) == q) ? acc : xq[t >> 1];
            }
        }
#pragma unroll
        for (int k = 0; k < 32; ++k) { const float o = dpp_xor1(xq[k]); outp[k] = q ? pack2(o, xq[k]) : pack2(xq[k], o); }
    }
    __syncthreads();
    {
        const int col = (wv & 1) * 32 + (lane >> 1), q = lane & 1;
        char* dst = lds + ((wv < 2) ? S_APT : S_W2T) + col * 128 + q * 64;
#pragma unroll
        for (int i = 0; i < 4; ++i) *(uint4*)(dst + i * 16) = q ? make_uint4(outp[16 + 4 * i], outp[17 + 4 * i], outp[18 + 4 * i], outp[19 + 4 * i]) : make_uint4(outp[4 * i], outp[4 * i + 1], outp[4 * i + 2], outp[4 * i + 3]);
#pragma unroll
        for (int reg = 0; reg < 16; ++reg) {
            const int t = tm * 32 + crow32(reg, hh), sidx = tn * 32 + r;
            *(bf16_t*)(lds + S_M1 + t * 128 + sidx * 2) = f2bf(aM1[reg]);
            *(bf16_t*)(lds + S_M2 + t * 128 + sidx * 2) = f2bf(aM2[reg]);
        }
    }
    __syncthreads();
    unsigned char* ubase = p->ws + A_CHAIN + (size_t)((b * 4 + h) * 64 + c) * CHAIN_UNIT;
    f32x16 zero;
#pragma unroll
    for (int i = 0; i < 16; ++i) zero[i] = 0.f;
    f32x16 gt;
    {
        const f32x16 qv = mm64(lds, S_M1, S_APT, tm, tn, r, hh, zero);
        const f32x16 y0 = mm64(lds, S_M2, S_VT, tm, tn, r, hh, zero) - mm64(lds, S_M1, S_W2T, tm, tn, r, hh, zero);
        gt = mm64(lds, S_BET, S_APT, tm, tn, r, hh, zero);
        const f32x16 ht = mm64(lds, S_KAT, S_VT, tm, tn, r, hh, zero) - mm64(lds, S_BET, S_W2T, tm, tn, r, hh, zero);
#pragma unroll
        for (int reg = 0; reg < 16; ++reg) {
            const int t = tm * 32 + crow32(reg, hh), jc = tn * 32 + r;
            const float rh = bf2f(*(const bf16_t*)(lds + S_RH + t * 128 + jc * 2));
            *(bf16_t*)(lds + S_RP + t * 128 + jc * 2) = f2bf(rh - qv[reg]);
            const int jr = tm * 32 + crow32(reg, hh);
            const float gc = gamC[jr];
            gt[reg] = gc * (((jr == jc) ? 1.f : 0.f) - gt[reg]);
        }
        float4* himg = (float4*)(ubase + 16384); float4* yimg = (float4*)(ubase + 32768);
#pragma unroll
        for (int rq = 0; rq < 4; ++rq) {
            float4 hv, yv;
            hv.x = gamC[tm * 32 + crow32(4 * rq + 0, hh)] * ht[4 * rq + 0]; hv.y = gamC[tm * 32 + crow32(4 * rq + 1, hh)] * ht[4 * rq + 1];
            hv.z = gamC[tm * 32 + crow32(4 * rq + 2, hh)] * ht[4 * rq + 2]; hv.w = gamC[tm * 32 + crow32(4 * rq + 3, hh)] * ht[4 * rq + 3];
            yv.x = y0[4 * rq + 0]; yv.y = y0[4 * rq + 1]; yv.z = y0[4 * rq + 2]; yv.w = y0[4 * rq + 3];
            himg[((tn * 2 + tm) * 4 + rq) * 64 + lane] = hv;
            yimg[((tn * 2 + tm) * 4 + rq) * 64 + lane] = yv;
        }
    }
    __syncthreads();
#pragma unroll
    for (int reg = 0; reg < 16; ++reg) {
        const int jr = tm * 32 + crow32(reg, hh), jc = tn * 32 + r;
        *(bf16_t*)(lds + S_GTR + jr * 128 + jc * 2) = f2bf(gt[reg]);
    }
    __syncthreads();
    {
        uint4* gimg = (uint4*)(ubase); uint4* rimg = (uint4*)(ubase + 8192);
#pragma unroll
        for (int ii = 0; ii < 2; ++ii) {
            const int im = wv * 2 + ii, mt = im >> 2, jb = (im >> 1) & 1, s2 = im & 1;
            const int cbase = (32 * jb + 16 * s2 + 4 * hh) * 2;
            const uint2 g0 = *(const uint2*)(lds + S_GTR + (mt * 32 + r) * 128 + cbase), g1 = *(const uint2*)(lds + S_GTR + (mt * 32 + r) * 128 + cbase + 16);
            const uint2 r0 = *(const uint2*)(lds + S_RP + (mt * 32 + r) * 128 + cbase), r1 = *(const uint2*)(lds + S_RP + (mt * 32 + r) * 128 + cbase + 16);
            gimg[im * 64 + lane] = make_uint4(g0.x, g0.y, g1.x, g1.y);
            rimg[im * 64 + lane] = make_uint4(r0.x, r0.y, r1.x, r1.y);
        }
    }
    __syncthreads();
}

DEVINL void phaseB1(KP p, int l, char* lds, const int mask = 15, const int sub = 3) {
    const int nb = NBV();
    if (mask & 1) {
        const int blk = BIDX();
        for (int it = blk; it < 512; it += nb) {
            if (sub & 1) { b1_rwkv(p, l, lds, it * 2); b1_rwkv(p, l, lds, it * 2 + 1); }
            __threadfence_block(); __syncthreads();
            const int b = it >> 6, c = it & 63;
            if (sub & 2) {
#pragma unroll 1
                for (int h = 0; h < 4; ++h) b1e_unit(p, lds, b, h, c);
            }
        }
    }
    if (mask & 2) { const int blk = BIDX(); for (int it = blk; it < 1024; it += nb) b1_lru(p, l, lds, it); }
    if (mask & 4) { const int blk = BIDX(); for (int it = blk; it < 1024; it += nb) b1_conformer(p, l, lds, it); }
    if (mask & 8) { const int blk = BIDX(); for (int it = blk; it < 512; it += nb) b1_shortconv(p, l, it); }
}

DEVINL void phaseB2(KP p, int l) {
    const int tid = TIDX(), blk = BIDX();
    if (blk >= 64 && blk < 72) {
        const int bb = blk - 64;
        const float* ca = (const float*)(p->ws + A_CARRYA) + (size_t)bb * 128 * 256 + tid;
        const float* ch = (const float*)(p->ws + A_CARRYH) + (size_t)bb * 128 * 256 + tid;
        float* hst = (float*)(p->ws + A_HSTART) + (size_t)bb * 128 * 256 + tid;
        float hs = 0.f;
#pragma unroll 8
        for (int tt = 0; tt < 128; ++tt) { hst[tt * 256] = hs; hs = fmaf(ca[tt * 256], hs, ch[tt * 256]); }
    }
    if (blk < 64 && tid < 64) {
        const int lane = tid, r = lane & 31, hh = lane >> 5;
        const int bh = blk >> 1, w = blk & 1, b = bh >> 2, h = bh & 3;
        float* yraw = (float*)(p->ws + A_YRAW) + (size_t)b * SEQ * 256 + h * 64 + 32 * w + r;
        f32x16 X0, X1;
#pragma unroll
        for (int i = 0; i < 16; ++i) { X0[i] = 0.f; X1[i] = 0.f; }
        for (int c = 0; c < 64; ++c) {
            const unsigned char* ubase = p->ws + A_CHAIN + (size_t)(bh * 64 + c) * CHAIN_UNIT;
            const uint4* gimg = (const uint4*)ubase; const uint4* rimg = (const uint4*)(ubase + 8192);
            const float4* himg = (const float4*)(ubase + 16384); const float4* yimg = (const float4*)(ubase + 32768);
            uint4 gq[8], rq8[8]; float4 hq[8], yq[8];
#pragma unroll
            for (int i = 0; i < 8; ++i) { gq[i] = gimg[i * 64 + lane]; rq8[i] = rimg[i * 64 + lane]; }
#pragma unroll
            for (int i = 0; i < 8; ++i) { hq[i] = himg[(w * 8 + i) * 64 + lane]; yq[i] = yimg[(w * 8 + i) * 64 + lane]; }
            bf16x8 xp[4];
#pragma unroll
            for (int s2 = 0; s2 < 2; ++s2) {
                uint4 a, bq;
                a.x = pack2(X0[8 * s2 + 0], X0[8 * s2 + 1]); a.y = pack2(X0[8 * s2 + 2], X0[8 * s2 + 3]); a.z = pack2(X0[8 * s2 + 4], X0[8 * s2 + 5]); a.w = pack2(X0[8 * s2 + 6], X0[8 * s2 + 7]);
                bq.x = pack2(X1[8 * s2 + 0], X1[8 * s2 + 1]); bq.y = pack2(X1[8 * s2 + 2], X1[8 * s2 + 3]); bq.z = pack2(X1[8 * s2 + 4], X1[8 * s2 + 5]); bq.w = pack2(X1[8 * s2 + 6], X1[8 * s2 + 7]);
                xp[s2] = __builtin_bit_cast(bf16x8, a); xp[2 + s2] = __builtin_bit_cast(bf16x8, bq);
            }
#pragma unroll
            for (int mt = 0; mt < 2; ++mt) {
                f32x16 acc;
#pragma unroll
                for (int i = 0; i < 4; ++i) { acc[4 * i] = yq[mt * 4 + i].x; acc[4 * i + 1] = yq[mt * 4 + i].y; acc[4 * i + 2] = yq[mt * 4 + i].z; acc[4 * i + 3] = yq[mt * 4 + i].w; }
#pragma unroll
                for (int f = 0; f < 4; ++f) acc = MFMA32(__builtin_bit_cast(bf16x8, rq8[mt * 4 + f]), xp[f], acc);
#pragma unroll
                for (int reg = 0; reg < 16; ++reg) yraw[(size_t)(c * 64 + mt * 32 + crow32(reg, hh)) * 256] = acc[reg];
            }
            f32x16 n0, n1;
#pragma unroll
            for (int i = 0; i < 4; ++i) { n0[4 * i] = hq[i].x; n0[4 * i + 1] = hq[i].y; n0[4 * i + 2] = hq[i].z; n0[4 * i + 3] = hq[i].w;
                                          n1[4 * i] = hq[4 + i].x; n1[4 * i + 1] = hq[4 + i].y; n1[4 * i + 2] = hq[4 + i].z; n1[4 * i + 3] = hq[4 + i].w; }
#pragma unroll
            for (int f = 0; f < 4; ++f) { n0 = MFMA32(__builtin_bit_cast(bf16x8, gq[f]), xp[f], n0); n1 = MFMA32(__builtin_bit_cast(bf16x8, gq[4 + f]), xp[f], n1); }
            X0 = n0; X1 = n1;
        }
    }
}

DEVINL void phaseB3(KP p, int l) {
    const int c = TIDX(), nb = NBV(), blk = BIDX();
    const bf16_t* P = (const bf16_t*)(p->ws + A_P);
    bf16_t* ymix = (bf16_t*)(p->ws + A_YMIX);
    const float* yraw = (const float*)(p->ws + A_YRAW); const float* bonus = (const float*)(p->ws + A_BONUS); const float* gbuf = (const float*)(p->ws + A_G);
    const float* hloc = (const float*)(p->ws + A_HLOC); const float* cuma = (const float*)(p->ws + A_CUMA); const float* hst = (const float*)(p->ws + A_HSTART);
    const float gng = p->in[I_GNG][l * 256 + c], gnb = p->in[I_GNB][l * 256 + c];
    for (int it = blk; it < 512; it += nb) {
#pragma unroll 4
        for (int rr = 0; rr < 64; ++rr) {
            const int row = it * 64 + rr, b = row >> 12, tt = (row & 4095) >> 5;
            const size_t o = (size_t)row * 256 + c;
            const float y = yraw[o];
            const float mu = wave_sum(y) * (1.f / 64.f);
            const float d = y - mu;
            const float var = wave_sum(d * d) * (1.f / 64.f);
            const float yn = d * rsqrtf(var + GN_EPS) * gng + gnb;
            ymix[(size_t)row * DM + 512 + c] = f2bf((yn + bonus[o]) * gbuf[o]);
            const float hh = fmaf(cuma[o], hst[(size_t)(b * 128 + tt) * 256 + c], hloc[o]);
            const float gb = bf2f(P[(size_t)row * PIN + 768 + c]);
            ymix[(size_t)row * DM + 256 + c] = f2bf(hh * gelu_tanh(gb));
        }
    }
}

DEVINL void phaseD(KP p, int l, char* lds, const int dry = 0) {
    const int tid = TIDX(), nb = NBV(), blk = BIDX(), wid = tid >> 6, lane = tid & 63;
    float* ul = (float*)lds;
    int* sel_e = (int*)(lds + 65536);
    int* lpos = (int*)(lds + 65536 + 2048);
    int* hist = (int*)(lds + 65536 + 4096);
    int* basep = (int*)(lds + 65536 + 4096 + 256);
    const float* xbuf = p->out;
    float* xout = dry ? (float*)(p->ws + A_P) : p->out;
    bf16_t* ubuf = (bf16_t*)(p->ws + (dry ? A_YMIX : OFF_UBUF));
    const float* mod = (const float*)(p->ws + OFF_MOD);
    const float* wr = p->in[I_WROUTER] + (size_t)l * 1024 * 64 + lane;
    const float ebias = p->in[I_EBIAS][l * 64 + lane];
    unsigned* cnt = (unsigned*)(p->ws + OFF_CNT) + l * 64 + (dry ? 256 : 0);
    int* list = (int*)(p->ws + (dry ? M_HBUF : M_LIST));
    float* wsel = (float*)(p->ws + (dry ? M_HBUF + 16777216 : M_WSEL));
    int* pmap = (int*)(p->ws + (dry ? M_HBUF + 33554432 : M_PMAP));
    for (int it = blk; it < 512; it += nb) {
        const int tok0 = it * 64;
        if (tid < 64) hist[tid] = 0;
        for (int sb = 0; sb < 4; ++sb) {
#pragma unroll
            for (int j = 0; j < 4; ++j) {
                const int tl = wid * 4 + j, row = tok0 + sb * 16 + tl, b = row >> 12;
                float4 z[4];
                float s = 0.f;
#pragma unroll
                for (int i = 0; i < 4; ++i) { z[i] = *(const float4*)(xbuf + (size_t)row * DM + i * 256 + lane * 4); s += z[i].x + z[i].y + z[i].z + z[i].w; }
                const float mean = wave_sum(s) * (1.f / 1024.f);
                float q = 0.f;
#pragma unroll
                for (int i = 0; i < 4; ++i) { z[i].x -= mean; z[i].y -= mean; z[i].z -= mean; z[i].w -= mean; q += z[i].x * z[i].x + z[i].y * z[i].y + z[i].z * z[i].z + z[i].w * z[i].w; }
                const float rs = rsqrtf(wave_sum(q) * (1.f / 1024.f) + LN_EPS);
#pragma unroll
                for (int i = 0; i < 4; ++i) {
                    const int col = i * 256 + lane * 4;
                    const float4 g = *(const float4*)(p->in[I_LN1G] + l * 1024 + col), bb = *(const float4*)(p->in[I_LN1B] + l * 1024 + col);
                    const float4 sh = *(const float4*)(mod + (size_t)(l * 8 + b) * 6144 + 3072 + col), sc = *(const float4*)(mod + (size_t)(l * 8 + b) * 6144 + 4096 + col);
                    float4 x1; x1.x = z[i].x * rs * g.x + bb.x; x1.y = z[i].y * rs * g.y + bb.y; x1.z = z[i].z * rs * g.z + bb.z; x1.w = z[i].w * rs * g.w + bb.w;
                    *(float4*)(xout + (size_t)row * DM + col) = x1;
                    float4 u; u.x = x1.x * (1.f + sc.x) + sh.x; u.y = x1.y * (1.f + sc.y) + sh.y; u.z = x1.z * (1.f + sc.z) + sh.z; u.w = x1.w * (1.f + sc.w) + sh.w;
                    *(float4*)(ul + tl * 1024 + col) = u;
                    uint2 o; o.x = pack2(u.x, u.y); o.y = pack2(u.z, u.w);
                    *(uint2*)(ubuf + (size_t)row * DM + col) = o;
                }
            }
            __syncthreads();
            float acc[4] = {0.f, 0.f, 0.f, 0.f};
            const float* u0 = ul + (wid * 4) * 1024;
#pragma unroll 2
            for (int k = 0; k < 1024; k += 4) {
                const float w0 = wr[(size_t)(k + 0) * 64], w1 = wr[(size_t)(k + 1) * 64], w2 = wr[(size_t)(k + 2) * 64], w3 = wr[(size_t)(k + 3) * 64];
#pragma unroll
                for (int j = 0; j < 4; ++j) {
                    const float4 u4 = *(const float4*)(u0 + j * 1024 + k);
                    acc[j] = fmaf(u4.x, w0, acc[j]); acc[j] = fmaf(u4.y, w1, acc[j]); acc[j] = fmaf(u4.z, w2, acc[j]); acc[j] = fmaf(u4.w, w3, acc[j]);
                }
            }
#pragma unroll
            for (int j = 0; j < 4; ++j) {
                const int tl = sb * 16 + wid * 4 + j;
                const float score = 1.f / (1.f + __expf(-acc[j]));
                const float biased = score + ebias;
                const float m1 = group8_max(biased);
                const unsigned long long eq = __ballot(biased == m1);
                const int g = lane >> 3;
                const unsigned gm = (unsigned)(eq >> (g * 8)) & 0xFFu;
                const int first = __ffs((int)gm) - 1;
                const float v2 = ((lane & 7) == first) ? -INFINITY : biased;
                const float m2 = group8_max(v2);
                const float gs = m1 + m2;
                int rg = 0;
#pragma unroll
                for (int g2 = 0; g2 < 8; ++g2) { const float o = __builtin_bit_cast(float, __builtin_amdgcn_readlane(__builtin_bit_cast(int, gs), g2 * 8)); rg += ((o > gs) || (o == gs && g2 < g)) ? 1 : 0; }
                const bool keep = rg < 4;
                const float mk = keep ? biased : -INFINITY;
                int rk = 0;
#pragma unroll
                for (int e2 = 0; e2 < 64; ++e2) { const float o = __builtin_bit_cast(float, __builtin_amdgcn_readlane(__builtin_bit_cast(int, mk), e2)); rk += ((o > mk) || (o == mk && e2 < lane)) ? 1 : 0; }
                const bool sel = keep && (rk < 8);
                const float ssum = wave_sum(sel ? score : 0.f);
                const float wgt = score / ssum * 2.5f;
                const unsigned long long sm = __ballot(sel);
                const int kidx = __popcll(sm & ((1ull << lane) - 1ull));
                if (sel) { wsel[(size_t)(tok0 + tl) * 8 + kidx] = wgt; sel_e[tl * 8 + kidx] = lane; }
            }
            __syncthreads();
        }
        for (int i = tid; i < 512; i += VTHREADS) lpos[i] = atomicAdd(&hist[sel_e[i]], 1);
        __syncthreads();
        if (tid < 64) basep[tid] = (int)atomicAdd(&cnt[tid], (unsigned)hist[tid]);
        __syncthreads();
        for (int i = tid; i < 512; i += VTHREADS) { const int e = sel_e[i], pos = basep[e] + lpos[i]; list[(size_t)e * NTOK + pos] = tok0 * 8 + i; pmap[tok0 * 8 + i] = (e << 16) | pos; }
        __syncthreads();
    }
}

DEVINL void phaseA(KP p, int l, char* lds) {
    const int tid = TID512(), c = blockIdx.x, G = gridDim.x;
    const char* ubuf = (const char*)(p->ws + OFF_UBUF);
    const char* Wt = (const char*)(p->ws + OFF_WIN) + (size_t)l * WIN_ROWS * 1024 * 2;
    bf16_t* P = (bf16_t*)(p->ws + A_P);
    auto sched = [&](int i, GUnit& u) -> bool {
        const long L = unit_linear(i, c, G); if (L >= 128 * 11) return false;
        const int Li = (int)L, sx = Li >> 9, w = (sx == 2) ? 3 : 4, rem = Li - (sx << 9), pm = rem / w, pn = sx * 4 + (rem - pm * w);
        u.A = ubuf + (size_t)pm * 256 * 2048; u.B = Wt + (size_t)pn * 256 * 2048; u.i0 = pm; u.i1 = pn; u.i2 = 0;
        return true;
    };
    auto epi = [&](f32x4 (&acc)[2][2][4][2], const GUnit& u, int wr, int wc, int fr, int fq) {
        asm volatile("" : "+v"(fr), "+v"(fq));
        const int row0 = u.i0 * 256 + wr * 64 + fr, col0 = u.i1 * 256 + wc * 32 + 8 * fq;
#pragma unroll
        for (int ai = 0; ai < 2; ++ai)
#pragma unroll
            for (int m = 0; m < 4; ++m) {
                bf16_t* rowp = P + (size_t)(row0 + ai * 128 + m * 16) * PIN + col0;
#pragma unroll
                for (int bj = 0; bj < 2; ++bj) {
                    if (col0 + bj * 128 < PIN) {
                        const f32x4 v0 = acc[ai][bj][m][0], v1 = acc[ai][bj][m][1];
                        *(uint4*)(rowp + bj * 128) = make_uint4(pack2(v0[0], v0[1]), pack2(v0[2], v0[3]), pack2(v1[0], v1[1]), pack2(v1[2], v1[3]));
                    }
                }
            }
    };
    gemm256<true, false>(lds, 1024, 1024, sched, epi);
}

DEVINL void phaseC(KP p, int l, char* lds) {
    const int tid = TID512(), c = blockIdx.x, G = gridDim.x;
    const char* ymix = (const char*)(p->ws + A_YMIX);
    const char* Wt = (const char*)(p->ws + OFF_WOUT) + (size_t)l * 1024 * 1024 * 2;
    const float* res = (l == 0) ? p->in[I_X] : p->out;
    float* xbuf = p->out;
    const float* mod = (const float*)(p->ws + OFF_MOD);
    auto sched = [&](int i, GUnit& u) -> bool {
        const long L = unit_linear(i, c, G); if (L >= 128 * 4) return false;
        const int pm = (int)L >> 2, pn = (int)L & 3;
        u.A = ymix + (size_t)pm * 256 * 2048; u.B = Wt + (size_t)pn * 256 * 2048; u.i0 = pm; u.i1 = pn; u.i2 = 0;
        return true;
    };
    auto epi = [&](f32x4 (&acc)[2][2][4][2], const GUnit& u, int wr, int wc, int fr, int fq) {
        asm volatile("" : "+v"(fr), "+v"(fq));
        const int row0 = u.i0 * 256 + wr * 64 + fr, col0 = u.i1 * 256 + wc * 32 + 4 * fq;
#pragma unroll
        for (int ai = 0; ai < 2; ++ai)
#pragma unroll
            for (int m = 0; m < 4; ++m) {
                const int row = row0 + ai * 128 + m * 16, b = row >> 12;
#pragma unroll
                for (int bj = 0; bj < 2; ++bj)
#pragma unroll
                    for (int n = 0; n < 2; ++n) {
                        const int col = col0 + bj * 128 + n * 16;
                        const float4 g1 = *(const float4*)(mod + (size_t)(l * 8 + b) * 6144 + 2048 + col);
                        const float4 rx = *(const float4*)(res + (size_t)row * DM + col);
                        const f32x4 a = acc[ai][bj][m][n];
                        float4 z;
                        z.x = ALPHA * rx.x + (1.f + g1.x) * a[0]; z.y = ALPHA * rx.y + (1.f + g1.y) * a[1];
                        z.z = ALPHA * rx.z + (1.f + g1.z) * a[2]; z.w = ALPHA * rx.w + (1.f + g1.w) * a[3];
                        *(float4*)(xbuf + (size_t)row * DM + col) = z;
                    }
            }
    };
    gemm256<false, false>(lds, 1024, 1024, sched, epi);
}

constexpr int DIR_OFF = 131072;
DEVINL void moe_directory(KP p, int l, char* lds) {
    int* pref = (int*)(lds + DIR_OFF);
    int* cntl = (int*)(lds + DIR_OFF + 512);
    unsigned* cnt = (unsigned*)(p->ws + OFF_CNT) + l * 64;
    asm volatile("" : "+s"(cnt));
    if (threadIdx.x == 0) {
        int s = 0;
        int* xpre = (int*)(lds + DIR_OFF + 1024);
        int x = 0;
        for (int e = 0; e < 64; ++e) { const int c = (int)__hip_atomic_load(&cnt[e], __ATOMIC_RELAXED, __HIP_MEMORY_SCOPE_AGENT); cntl[e] = c; pref[e] = s; s += (c + 255) >> 8; xpre[e] = x; x += c; }
        pref[64] = s; cntl[64] = NTOK; pref[65] = s + 128; xpre[64] = x;
    }
    __syncthreads();
}

DEVINL void phaseE1(KP p, int l, char* lds) {
    const int tid = TID512(), c = blockIdx.x, G = gridDim.x;
    moe_directory(p, l, lds);
    const int* pref = (const int*)(lds + DIR_OFF); const int* cntl = (const int*)(lds + DIR_OFF + 512);
    const char* ubuf = (const char*)(p->ws + OFF_UBUF);
    const int* list = (const int*)(p->ws + M_LIST);
    bf16_t* hbuf = (bf16_t*)(p->ws + M_HBUF);
    const char* W13 = (const char*)(p->ws + OFF_W13) + (size_t)(l * 65) * 512 * 1024 * 2;
    const int total = __builtin_amdgcn_readfirstlane(pref[65]) * 2;
    auto sched = [&](int i, GUnit& u) -> bool {
        const long L = unit_linear(i, c, G); if (L >= total) return false;
        const int mg = (int)L >> 1, nt = (int)L & 1;
        int e = 0; while (pref[e + 1] <= mg) ++e;
        e = __builtin_amdgcn_readfirstlane(e);
        const int mt = __builtin_amdgcn_readfirstlane(mg - pref[e]), Me = __builtin_amdgcn_readfirstlane(cntl[e]);
        u.A = ubuf; u.B = W13 + ((size_t)e * 512 + nt * 256) * 2048; u.i0 = mg; u.i1 = nt; u.i2 = e;
        int R[2], C[2]; stage_coords512(TID512(), R, C);
#pragma unroll
        for (int h = 0; h < 2; ++h)
#pragma unroll
            for (int i2 = 0; i2 < 2; ++i2) {
                const int idx = mt * 256 + h * 128 + R[i2]; int tok;
                if (e < 64) tok = (idx < Me) ? (list[(size_t)e * NTOK + idx] >> 3) : 0; else tok = idx;
                u.va[h][i2] = (unsigned)(tok * 1024 + C[i2]) * 2u;
            }
        return true;
    };
    auto epi = [&](f32x4 (&acc)[2][2][4][2], const GUnit& u, int wr, int wc, int fr, int fq) {
        asm volatile("" : "+v"(fr), "+v"(fq));
        const size_t row0 = (size_t)u.i0 * 256 + wr * 64 + fr;
#pragma unroll
        for (int ai = 0; ai < 2; ++ai)
#pragma unroll
            for (int m = 0; m < 4; ++m) {
                bf16_t* rowp = hbuf + (row0 + ai * 128 + m * 16) * 256;
#pragma unroll
                for (int bj = 0; bj < 2; ++bj) {
                    const int hcol = (u.i1 * 8 + bj * 4 + wc) * 16 + 4 * fq;
                    const f32x4 gt = acc[ai][bj][m][0], up = acc[ai][bj][m][1];
                    float hv[4];
#pragma unroll
                    for (int j = 0; j < 4; ++j) hv[j] = gt[j] * sigm(gt[j]) * up[j];
                    uint2 o; o.x = pack2(hv[0], hv[1]); o.y = pack2(hv[2], hv[3]);
                    *(uint2*)(rowp + hcol) = o;
                }
            }
    };
    gemm256<false, true>(lds, 1024, 1024, sched, epi);
}

DEVINL void phaseE2(KP p, int l, char* lds) {
    const int tid = TID512(), c = blockIdx.x, G = gridDim.x;
    moe_directory(p, l, lds);
    const int* pref = (const int*)(lds + DIR_OFF); const int* cntl = (const int*)(lds + DIR_OFF + 512);
    const int* xpre = (const int*)(lds + DIR_OFF + 1024);
    const char* hbuf = (const char*)(p->ws + M_HBUF);
    bf16_t* ybuf = (bf16_t*)(p->ws + M_YBUF);
    const char* W2 = (const char*)(p->ws + OFF_W2) + (size_t)(l * 65) * 1024 * 256 * 2;
    const int total = __builtin_amdgcn_readfirstlane(pref[65]) * 4;
    auto sched = [&](int i, GUnit& u) -> bool {
        const long L = unit_linear(i, c, G); if (L >= total) return false;
        const int mg = (int)L >> 2, nt = (int)L & 3;
        int e = 0; while (pref[e + 1] <= mg) ++e;
        e = __builtin_amdgcn_readfirstlane(e);
        u.A = hbuf + (size_t)mg * 256 * 512; u.B = W2 + ((size_t)e * 1024 + nt * 256) * 512; u.i0 = mg; u.i1 = nt; u.i2 = e;
        return true;
    };
    auto epi = [&](f32x4 (&acc)[2][2][4][2], const GUnit& u, int wr, int wc, int fr, int fq) {
        asm volatile("" : "+v"(fr), "+v"(fq));
        const int e = __builtin_amdgcn_readfirstlane(u.i2), mt = __builtin_amdgcn_readfirstlane(u.i0 - pref[e]), Me = __builtin_amdgcn_readfirstlane(cntl[e]);
        const int yrow0 = __builtin_amdgcn_readfirstlane(xpre[e]) + mt * 256;
        const int col0 = u.i1 * 256 + wc * 32 + 8 * fq, loc0 = wr * 64 + fr;
#pragma unroll
        for (int ai = 0; ai < 2; ++ai)
#pragma unroll
            for (int m = 0; m < 4; ++m) {
                const int loc = loc0 + ai * 128 + m * 16;
                if (mt * 256 + loc < Me) {
                    bf16_t* rowp = ybuf + (size_t)(yrow0 + loc) * 1024 + col0;
#pragma unroll
                    for (int bj = 0; bj < 2; ++bj) {
                        const f32x4 v0 = acc[ai][bj][m][0], v1 = acc[ai][bj][m][1];
                        *(uint4*)(rowp + bj * 128) = make_uint4(pack2(v0[0], v0[1]), pack2(v0[2], v0[3]), pack2(v1[0], v1[1]), pack2(v1[2], v1[3]));
                    }
                }
            }
    };
    gemm256<true, false>(lds, 256, 256, sched, epi);
}

DEVINL void phaseF(KP p, int l, const int dry = 0) {
    const int tid = TIDX(), nb = NBV(), blk = BIDX(), wid = tid >> 6, lane = tid & 63;
    const float* xbuf = p->out;
    float* xout = dry ? (float*)(p->ws + M_HBUF) : p->out;
    const bf16_t* ybuf = (const bf16_t*)(p->ws + M_YBUF);
    bf16_t* ubuf = (bf16_t*)(p->ws + OFF_UBUF);
    const float* mod = (const float*)(p->ws + OFF_MOD);
    const int* pmap = (const int*)(p->ws + M_PMAP); const float* wsel = (const float*)(p->ws + M_WSEL);
    int xoff;
    {
        const unsigned* cnt = (const unsigned*)(p->ws + OFF_CNT) + l * 64;
        const int c = (int)__hip_atomic_load(&cnt[lane], __ATOMIC_RELAXED, __HIP_MEMORY_SCOPE_AGENT);
        xoff = 0;
#pragma unroll
        for (int j = 0; j < 64; ++j) { const int cj = __builtin_amdgcn_readlane(c, j); xoff += (j < lane) ? cj : 0; }
    }
    for (int row = blk * 4 + wid; row < NTOK; row += nb * 4) {
        const int b = row >> 12;
        int yr = 0; float yw = 0.f;
        if (lane < 8) { const int pm = pmap[row * 8 + lane]; yr = pm; yw = wsel[row * 8 + lane]; }
        { const int e = (yr >> 16) & 63; const int xo = __builtin_amdgcn_ds_bpermute(e << 2, xoff); yr = xo + (yr & 0xFFFF); }
        int yrow[8]; float yww[8];
#pragma unroll
        for (int k = 0; k < 8; ++k) { yrow[k] = __builtin_amdgcn_readlane(yr, k); yww[k] = __builtin_bit_cast(float, __builtin_amdgcn_readlane(__builtin_bit_cast(int, yw), k)); }
        float4 z[4]; float s = 0.f;
#pragma unroll
        for (int i = 0; i < 4; ++i) {
            const int col = i * 256 + lane * 4;
            const float4 x1 = *(const float4*)(xbuf + (size_t)row * DM + col);
            float f0, f1, f2, f3;
            { const uint2 yv = *(const uint2*)(ybuf + ((size_t)(262144 + row)) * 1024 + col);
              f0 = __uint_as_float(yv.x << 16); f1 = __uint_as_float(yv.x & 0xFFFF0000u); f2 = __uint_as_float(yv.y << 16); f3 = __uint_as_float(yv.y & 0xFFFF0000u); }
#pragma unroll
            for (int k = 0; k < 8; ++k) {
                const uint2 yv = *(const uint2*)(ybuf + (size_t)yrow[k] * 1024 + col);
                const float w = yww[k];
                f0 = fmaf(w, __uint_as_float(yv.x << 16), f0); f1 = fmaf(w, __uint_as_float(yv.x & 0xFFFF0000u), f1); f2 = fmaf(w, __uint_as_float(yv.y << 16), f2); f3 = fmaf(w, __uint_as_float(yv.y & 0xFFFF0000u), f3);
            }
            const float4 g2 = *(const float4*)(mod + (size_t)(l * 8 + b) * 6144 + 5120 + col);
            z[i].x = ALPHA * x1.x + (1.f + g2.x) * f0; z[i].y = ALPHA * x1.y + (1.f + g2.y) * f1; z[i].z = ALPHA * x1.z + (1.f + g2.z) * f2; z[i].w = ALPHA * x1.w + (1.f + g2.w) * f3;
            s += z[i].x + z[i].y + z[i].z + z[i].w;
        }
        const float mean = wave_sum(s) * (1.f / 1024.f);
        float q = 0.f;
#pragma unroll
        for (int i = 0; i < 4; ++i) { z[i].x -= mean; z[i].y -= mean; z[i].z -= mean; z[i].w -= mean; q += z[i].x * z[i].x + z[i].y * z[i].y + z[i].z * z[i].z + z[i].w * z[i].w; }
        const float rs = rsqrtf(wave_sum(q) * (1.f / 1024.f) + LN_EPS);
#pragma unroll
        for (int i = 0; i < 4; ++i) {
            const int col = i * 256 + lane * 4;
            const float4 g = *(const float4*)(p->in[I_LN2G] + l * 1024 + col), bb = *(const float4*)(p->in[I_LN2B] + l * 1024 + col);
            float4 x2; x2.x = z[i].x * rs * g.x + bb.x; x2.y = z[i].y * rs * g.y + bb.y; x2.z = z[i].z * rs * g.z + bb.z; x2.w = z[i].w * rs * g.w + bb.w;
            *(float4*)(xout + (size_t)row * DM + col) = x2;
            if (l + 1 < DEPTH) {
                const float4 sh = *(const float4*)(mod + (size_t)((l + 1) * 8 + b) * 6144 + col), sc = *(const float4*)(mod + (size_t)((l + 1) * 8 + b) * 6144 + 1024 + col);
                uint2 o; o.x = pack2(x2.x * (1.f + sc.x) + sh.x, x2.y * (1.f + sc.y) + sh.y); o.y = pack2(x2.z * (1.f + sc.z) + sh.z, x2.w * (1.f + sc.w) + sh.w);
                *(uint2*)(ubuf + (size_t)row * DM + col) = o;
            }
        }
    }
}

#define XB_TMO      128
#define XB_XCNT(j)  (256  + 64 * (j))
#define XB_XSUB(j)  (1280 + 64 * (j))
#define XB_XGEN(j)  (2304 + 64 * (j))
#define XB_TOP      3328
#define XB_TOPGEN   3392
#define XCD_BAR_WORDS 3456
#define XB_SPIN_CAP (1u << 20)
DEVINL unsigned xb_ld(unsigned* p)              { return __hip_atomic_load(p, __ATOMIC_RELAXED, __HIP_MEMORY_SCOPE_AGENT); }
DEVINL unsigned xb_add(unsigned* p, unsigned v) { return __hip_atomic_fetch_add(p, v, __ATOMIC_RELAXED, __HIP_MEMORY_SCOPE_AGENT); }
DEVINL unsigned xb_xcc_id() { return (unsigned)__builtin_amdgcn_s_getreg((3 << 11) | 20) & 0xFu; }
#define XB_SPIN(cond, bar) do { unsigned _sp = 0; while (cond) { __builtin_amdgcn_s_sleep(1); \
    if ((++_sp & 255u) == 0u) { if (xb_ld(&(bar)[XB_TMO])) break; if (_sp > XB_SPIN_CAP) { atomicAdd(&(bar)[XB_TMO], 1u); break; } } } } while (0)
struct XcdBarrier { unsigned* bar; unsigned x; volatile LAS unsigned* st; };
DEVINL XcdBarrier xcd_barrier_post(unsigned* bar, volatile LAS unsigned* st) {
    XcdBarrier b; b.bar = bar; b.x = xb_xcc_id(); b.st = st;
    if (threadIdx.x == 0) (void)xb_add(&bar[XB_XCNT(b.x)], 1u);
    return b;
}
DEVINL void xcd_barrier_complete(unsigned* bar, unsigned x, unsigned& nloc, unsigned& nx) {
    const unsigned G = gridDim.x * gridDim.y * gridDim.z;
    unsigned sum, cnt, mine, sp = 0u;
    for (;;) {
        sum = 0u; cnt = 0u; mine = 0u;
#pragma unroll 1
        for (unsigned j = 0; j < 16; ++j) { const unsigned c = xb_ld(&bar[XB_XCNT(j)]); sum += c; cnt += (c > 0u) ? 1u : 0u; mine = (j == x) ? c : mine; }
        if (sum == G) break;
        __builtin_amdgcn_s_sleep(1);
        if ((++sp & 255u) == 0u) { if (xb_ld(&bar[XB_TMO])) break; if (sp > XB_SPIN_CAP) { atomicAdd(&bar[XB_TMO], 1u); break; } }
    }
    nloc = mine > 0u ? mine : 1u; nx = cnt > 0u ? cnt : 1u;
}
DEVINL void xcd_barrier(const XcdBarrier& b) {
    asm volatile("s_waitcnt vmcnt(0)" ::: "memory");
    __syncthreads();
    if (threadIdx.x == 0) {
        unsigned* bar = b.bar;
        __builtin_amdgcn_s_waitcnt(0);
        unsigned nloc = b.st[0], nx = b.st[1];
        if (nloc == 0u) { xcd_barrier_complete(bar, b.x, nloc, nx); b.st[0] = nloc; b.st[1] = nx; }
        const unsigned old = xb_add(&bar[XB_XSUB(b.x)], 1u);
        const unsigned gen = old / nloc;
        if (old + 1u == (gen + 1u) * nloc) {
            __builtin_amdgcn_fence(__ATOMIC_RELEASE, "agent");
            asm volatile("s_waitcnt vmcnt(0)" ::: "memory");
            const unsigned og = xb_add(&bar[XB_TOP], 1u);
            const unsigned tg = og / nx;
            if (og + 1u == (tg + 1u) * nx) xb_add(&bar[XB_TOPGEN], 1u);
            else XB_SPIN(xb_ld(&bar[XB_TOPGEN]) == tg, bar);
            __builtin_amdgcn_fence(__ATOMIC_ACQUIRE, "agent");
            xb_add(&bar[XB_XGEN(b.x)], 1u);
            asm volatile("s_waitcnt vmcnt(0)" ::: "memory");
        } else {
            XB_SPIN(xb_ld(&bar[XB_XGEN(b.x)]) == gen, bar);
            __builtin_amdgcn_fence(__ATOMIC_ACQUIRE, "agent");
            asm volatile("s_waitcnt vmcnt(0)" ::: "memory");
        }
    }
    __syncthreads();
}

constexpr int PPL = 12;
constexpr int NPHASE = 2 + PPL * DEPTH;
#ifndef PROBE_SUB
#define PROBE_SUB 3
#endif
#ifndef PROBE_REP
#define PROBE_REP (-1)
#endif
__global__ void __launch_bounds__(NTHREADS, 2) mega(Params p_arg, int ph_lo, int ph_hi) {
    extern __shared__ __attribute__((aligned(16))) char lds[];
    cg::grid_group grid = cg::this_grid();
    volatile LAS unsigned* st = (volatile LAS unsigned*)(lds + LDS_BYTES - 16);
    if (threadIdx.x == 0) { st[0] = 0u; st[1] = 0u; }
    __syncthreads();
    XcdBarrier xb = xcd_barrier_post((unsigned*)(p_arg.ws + OFF_BAR), st);
    for (int ph = ph_lo; ph < ph_hi; ++ph) {
        KP p = (KP)__builtin_amdgcn_kernarg_segment_ptr();
        asm volatile("" : "+s"(p));
        const int l = (ph >= 2) ? (ph - 2) / PPL : 0;
        const int q = (ph >= 2) ? (ph - 2) % PPL : -1;
        const bool nobar = (q >= 1 && q <= 3);
        const int nrep = (ph == PROBE_REP) ? 2 : 1;
        for (int rep = 0; rep < nrep; ++rep) {
            const int dry = (ph == PROBE_REP && rep == 0) ? 1 : 0;
            char* ldsh = lds + (threadIdx.x >> 8) * LDS_HALF;
            if (ph == 0) phase0(p, ldsh);
            else if (ph == 1) phaseF0(p);
            else {
                switch (q) {
                    case 0: phaseA(p, l, lds); break;
                    case 1: phaseB1(p, l, ldsh, 1, (ph == PROBE_REP && rep == 1) ? PROBE_SUB : 3); break;
                    case 2: phaseB1(p, l, ldsh, 2); break;
                    case 3: phaseB1(p, l, ldsh, 4); break;
                    case 4: phaseB1(p, l, ldsh, 8); break;
                    case 5: phaseB2(p, l); break;
                    case 6: phaseB3(p, l); break;
                    case 7: phaseC(p, l, lds); break;
                    case 8: phaseD(p, l, ldsh, dry); break;
                    case 9: phaseE1(p, l, lds); break;
                    case 10: phaseE2(p, l, lds); break;
                    default: phaseF(p, l, dry); break;
                }
            }
            const bool lastrep = (rep + 1 == nrep);
            if (!lastrep || (ph + 1 < ph_hi && !nobar)) { if (lastrep && ph == ph_lo) grid.sync(); else xcd_barrier(xb); }
        }
    }
}

extern "C" void kernel_launch(void* const* d_in, const int* in_sizes, int n_in, void* d_out, int out_size, void* d_ws, size_t ws_size, hipStream_t stream) {
    static int grid_blocks = 0;
    if (grid_blocks == 0) {
        if (n_in != 39 || out_size != NTOK * DM || ws_size < WS_NEED) { fprintf(stderr, "kernel_launch: unexpected shapes (n_in %d out %d ws %zu need %zu)\n", n_in, out_size, ws_size, (size_t)WS_NEED); grid_blocks = -1; return; }
        int dev = 0, cus = 0, per_cu = 0;
        hipGetDevice(&dev);
        hipDeviceGetAttribute(&cus, hipDeviceAttributeMultiprocessorCount, dev);
        hipFuncSetAttribute((const void*)mega, hipFuncAttributeMaxDynamicSharedMemorySize, LDS_BYTES);
        hipOccupancyMaxActiveBlocksPerMultiprocessor(&per_cu, (const void*)mega, NTHREADS, LDS_BYTES);
        if (per_cu < 1) { fprintf(stderr, "kernel_launch: occupancy query returned %d\n", per_cu); grid_blocks = -1; return; }
        if (cus < 256) { fprintf(stderr, "kernel_launch: this build needs 256 CUs (found %d)\n", cus); grid_blocks = -1; return; }
        grid_blocks = 256;
    }
    if (grid_blocks < 0) return;
    if (hipMemsetAsync(d_ws, 0, 32768, stream) != hipSuccess) { fprintf(stderr, "kernel_launch: memset failed\n"); return; }
    Params p{};
    for (int i = 0; i < 39; ++i) p.in[i] = (const float*)d_in[i];
    p.out = (float*)d_out; p.ws = (unsigned char*)d_ws;
    int ph_lo = 0, ph_hi = NPHASE;
    void* args[] = {&p, &ph_lo, &ph_hi};
    hipError_t e = hipLaunchCooperativeKernel((const void*)mega, dim3(grid_blocks), dim3(NTHREADS), args, LDS_BYTES, stream);
    if (e != hipSuccess) fprintf(stderr, "cooperative launch failed: %s (grid %d)\n", hipGetErrorString(e), grid_blocks);
}
```

```cpp
#include <hip/hip_runtime.h>
#include <hip/hip_cooperative_groups.h>
#include <stdio.h>
#include <stdint.h>
namespace cg = cooperative_groups;

typedef unsigned short bf16_t;
typedef short bf16x8 __attribute__((ext_vector_type(8)));
typedef float f32x4 __attribute__((ext_vector_type(4)));
#define DEVINL __device__ __forceinline__
#define LAS __attribute__((address_space(3)))

constexpr int NTOK = 32768, SEQ = 4096, NBATCH = 8, DM = 1024, PIN = 2688, DEPTH = 2;
constexpr int NEXP = 64;
constexpr float ALPHA = 1.41421356237f;
constexpr float LN_EPS = 1e-5f, GN_EPS = 64e-5f;
constexpr int NTHREADS = 512;
constexpr int VTHREADS = 256;
constexpr int LDS_HALF = 75776;
constexpr int LDS_BYTES = 152064;

constexpr size_t OFF_CNT   = 0;
constexpr size_t OFF_BAR   = 4096;
constexpr size_t OFF_MOD   = 65536;
constexpr size_t OFF_WR    = 524288;
constexpr size_t OFF_WIN   = 1048576;
constexpr int WIN_ROWS = 2816;
constexpr size_t OFF_WOUT  = OFF_WIN + 2 * (size_t)WIN_ROWS * 1024 * 2;
constexpr size_t OFF_W13   = OFF_WOUT + 4194304;
constexpr size_t OFF_W2    = OFF_W13 + 136314880;
constexpr size_t OFF_UBUF  = OFF_W2 + 68157440;
constexpr size_t OFF_ARENA = OFF_UBUF + 67108864;
constexpr size_t A_P      = OFF_ARENA;
constexpr size_t A_YMIX   = A_P + 176160768;
constexpr size_t A_SCAN   = A_YMIX + 67108864;
constexpr size_t A_HLOC   = A_SCAN + 134217728;
constexpr size_t A_CUMA   = A_HLOC + 33554432;
constexpr size_t A_G      = A_CUMA + 33554432;
constexpr size_t A_BONUS  = A_G + 33554432;
constexpr size_t A_YRAW   = A_BONUS + 33554432;
constexpr size_t A_CARRYA = A_YRAW + 33554432;
constexpr size_t A_CARRYH = A_CARRYA + 1048576;
constexpr size_t A_HSTART = A_CARRYH + 1048576;
constexpr size_t A_CHAIN  = A_HSTART + 1048576;
constexpr size_t CHAIN_UNIT = 49152;
constexpr size_t M_YBUF   = OFF_ARENA;
constexpr size_t M_HBUF   = M_YBUF + 603979776;
constexpr size_t M_LIST   = M_HBUF + 159383552;
constexpr size_t M_WSEL   = M_LIST + 8388608;
constexpr size_t M_PMAP   = M_WSEL + 1048576;
constexpr size_t WS_NEED  = M_PMAP + 1048576;

struct Params {
    const float* in[39];
    float* out;
    unsigned char* ws;
};
typedef const __attribute__((address_space(4))) Params* KP;
__device__ __forceinline__ int TIDX() { int t = threadIdx.x & 255; asm volatile("" : "+v"(t)); __builtin_assume(t >= 0 && t < 256); return t; }
__device__ __forceinline__ int BIDX() { int b = blockIdx.x * 2 + __builtin_amdgcn_readfirstlane((int)(threadIdx.x >> 8)); asm volatile("" : "+s"(b)); __builtin_assume(b >= 0 && b < 65536); return b; }
__device__ __forceinline__ int NBV() { return gridDim.x * 2; }
__device__ __forceinline__ int TID512() { int t = threadIdx.x; asm volatile("" : "+v"(t)); __builtin_assume(t >= 0 && t < 512); return t; }
enum { I_X = 0, I_C, I_WMOD, I_BMOD, I_WIN, I_WOUT, I_CONVA, I_CONVAB, I_LNAG, I_LNAB, I_CONVB, I_CONVBB, I_WRG, I_BRG, I_WIG, I_BIG,
       I_LAMBDA, I_MUC, I_W0, I_WW2, I_A0, I_WA2, I_WG2, I_KK, I_KA, I_RK, I_GNG, I_GNB, I_CONVD, I_LN1G, I_LN1B, I_WROUTER, I_EBIAS,
       I_W13, I_W2, I_WS13, I_WS2, I_LN2G, I_LN2B };

DEVINL bf16_t f2bf(float f) { unsigned u = __float_as_uint(f); u += 0x7FFFu + ((u >> 16) & 1u); return (bf16_t)(u >> 16); }
DEVINL float bf2f(bf16_t h) { return __uint_as_float(((unsigned)h) << 16); }
typedef __bf16 bf2_t __attribute__((ext_vector_type(2)));
typedef float f2_t __attribute__((ext_vector_type(2)));
typedef float f32x16 __attribute__((ext_vector_type(16)));
DEVINL unsigned pack2(float a, float b) { f2_t v = {a, b}; return __builtin_bit_cast(unsigned, __builtin_convertvector(v, bf2_t)); }
DEVINL float sigm(float x) { return 1.f / (1.f + __expf(-x)); }
DEVINL float tanh_fast(float x) { const float e = __expf(2.f * x); return 1.f - 2.f / (1.f + e); }
DEVINL float softplusf(float z) { return fmaxf(z, 0.f) + __logf(1.f + __expf(-fabsf(z))); }
DEVINL float softplus_acc(float z) { return fmaxf(z, 0.f) + log1pf(__expf(-fabsf(z))); }
DEVINL float gelu_tanh(float x) { float u = 0.7978845608028654f * (x + 0.044715f * x * x * x); return 0.5f * x * (1.f + tanh_fast(u)); }
DEVINL float group8_max(float x) {
    x = fmaxf(x, __builtin_bit_cast(float, __builtin_amdgcn_update_dpp(0, __builtin_bit_cast(int, x), 0xB1, 0xf, 0xf, true)));
    x = fmaxf(x, __builtin_bit_cast(float, __builtin_amdgcn_update_dpp(0, __builtin_bit_cast(int, x), 0x4E, 0xf, 0xf, true)));
    x = fmaxf(x, __builtin_bit_cast(float, __builtin_amdgcn_update_dpp(0, __builtin_bit_cast(int, x), 0x141, 0xf, 0xf, true)));
    return x;
}
DEVINL float wave_sum_dpp(float x);
DEVINL float wave_sum(float x) { return wave_sum_dpp(x); }
DEVINL float wave_sum_dpp(float x) {
    x += __builtin_bit_cast(float, __builtin_amdgcn_update_dpp(0, __builtin_bit_cast(int, x), 0xB1, 0xf, 0xf, true));
    x += __builtin_bit_cast(float, __builtin_amdgcn_update_dpp(0, __builtin_bit_cast(int, x), 0x4E, 0xf, 0xf, true));
    x += __builtin_bit_cast(float, __builtin_amdgcn_update_dpp(0, __builtin_bit_cast(int, x), 0x141, 0xf, 0xf, true));
    x += __builtin_bit_cast(float, __builtin_amdgcn_update_dpp(0, __builtin_bit_cast(int, x), 0x140, 0xf, 0xf, true));
    x += __builtin_bit_cast(float, __builtin_amdgcn_update_dpp(0, __builtin_bit_cast(int, x), 0x142, 0xa, 0xf, false));
    x += __builtin_bit_cast(float, __builtin_amdgcn_update_dpp(0, __builtin_bit_cast(int, x), 0x143, 0xc, 0xf, false));
    return __builtin_bit_cast(float, __builtin_amdgcn_readlane(__builtin_bit_cast(int, x), 63));
}

DEVINL int lds_byte(int r, int c) { int st = (r >> 4) * 2 + (c >> 5), rr = r & 15, cc = c & 31, ob = rr * 64 + cc * 2; return st * 1024 + (ob ^ (((ob >> 9) & 1) << 5)); }
DEVINL void stage_rc(int b, int& R, int& C) { int st = b / 1024, sb = b % 1024, swz = sb ^ (((sb >> 9) & 1) << 5); R = (st >> 1) * 16 + swz / 64; C = (st & 1) * 32 + (swz % 64) / 2; }

template <class RowPtr, class Epi>
DEVINL void gemm_tile128(char* lds, RowPtr arow, const bf16_t* Bt, int K, Epi epi) {
    const int tid = TIDX();
    const bf16_t* ap[4]; const bf16_t* bp[4];
#pragma unroll
    for (int i = 0; i < 4; ++i) { int R, C; stage_rc(tid * 16 + i * 4096, R, C); ap[i] = arow(R) + C; bp[i] = Bt + (size_t)R * K + C; }
    const int wid = tid >> 6, lane = tid & 63, wr = wid >> 1, wc = wid & 1, fr = lane & 15, fq = lane >> 4;
    f32x4 acc[4][4];
#pragma unroll
    for (int m = 0; m < 4; ++m)
#pragma unroll
        for (int n = 0; n < 4; ++n) acc[m][n] = (f32x4){0.f, 0.f, 0.f, 0.f};
    const int nk = K >> 6;
#pragma unroll
    for (int i = 0; i < 4; ++i) {
        __builtin_amdgcn_global_load_lds((const unsigned*)(ap[i]), (unsigned*)(lds + tid * 16 + i * 4096), 16, 0, 0);
        __builtin_amdgcn_global_load_lds((const unsigned*)(bp[i]), (unsigned*)(lds + 16384 + tid * 16 + i * 4096), 16, 0, 0);
    }
    for (int kt = 0; kt < nk; ++kt) {
        asm volatile("s_waitcnt vmcnt(0)" ::: "memory");
        __syncthreads();
        char* cur = lds + (kt & 1) * 32768;
        if (kt + 1 < nk) {
            char* nxt = lds + ((kt + 1) & 1) * 32768;
            const int ko = (kt + 1) * 64;
#pragma unroll
            for (int i = 0; i < 4; ++i) {
                __builtin_amdgcn_global_load_lds((const unsigned*)(ap[i] + ko), (unsigned*)(nxt + tid * 16 + i * 4096), 16, 0, 0);
                __builtin_amdgcn_global_load_lds((const unsigned*)(bp[i] + ko), (unsigned*)(nxt + 16384 + tid * 16 + i * 4096), 16, 0, 0);
            }
        }
        bf16x8 af[4][2], bfr[4][2];
#pragma unroll
        for (int m = 0; m < 4; ++m)
#pragma unroll
            for (int kk = 0; kk < 2; ++kk) af[m][kk] = *reinterpret_cast<const bf16x8*>(cur + lds_byte(wr * 64 + m * 16 + fr, kk * 32 + fq * 8));
#pragma unroll
        for (int n = 0; n < 4; ++n)
#pragma unroll
            for (int kk = 0; kk < 2; ++kk) bfr[n][kk] = *reinterpret_cast<const bf16x8*>(cur + 16384 + lds_byte(wc * 64 + n * 16 + fr, kk * 32 + fq * 8));
#pragma unroll
        for (int kk = 0; kk < 2; ++kk)
#pragma unroll
            for (int m = 0; m < 4; ++m)
#pragma unroll
                for (int n = 0; n < 4; ++n) acc[m][n] = __builtin_amdgcn_mfma_f32_16x16x32_bf16(bfr[n][kk], af[m][kk], acc[m][n], 0, 0, 0);
    }
    __syncthreads();
    epi(acc, wr, wc, fr, fq);
}

template <class Ptrs, class Epi>
DEVINL void gemm_stream128(char* lds, int K, int blk, int nb, int total, Ptrs ptrs, Epi epi) {
    const int qx = nb >> 3, first = (blk & 7) * qx + (blk >> 3), stride = nb;
    if (first >= total) return;
    const int tid = TIDX();
    const int wid = tid >> 6, lane = tid & 63, wr = wid >> 1, wc = wid & 1, fr = lane & 15, fq = lane >> 4;
    const int nk = K >> 6;
    const bf16_t* ap[4]; const bf16_t* bp[4];
    const bf16_t* an[4]; const bf16_t* bn[4];
    int t = first;
    ptrs(t, ap, bp);
#pragma unroll
    for (int i = 0; i < 4; ++i) {
        __builtin_amdgcn_global_load_lds((const unsigned*)(ap[i]), (unsigned*)(lds + tid * 16 + i * 4096), 16, 0, 0);
        __builtin_amdgcn_global_load_lds((const unsigned*)(bp[i]), (unsigned*)(lds + 16384 + tid * 16 + i * 4096), 16, 0, 0);
    }
    for (;;) {
        const int tn = t + stride;
        const bool has_next = tn < total;
        if (has_next) ptrs(tn, an, bn);
        f32x4 acc[4][4];
#pragma unroll
        for (int m = 0; m < 4; ++m)
#pragma unroll
            for (int n = 0; n < 4; ++n) acc[m][n] = (f32x4){0.f, 0.f, 0.f, 0.f};
        for (int kt = 0; kt < nk; ++kt) {
            asm volatile("s_waitcnt vmcnt(0)" ::: "memory");
            __syncthreads();
            char* cur = lds + (kt & 1) * 32768;
            if (kt + 1 < nk) {
                char* nxt = lds + ((kt + 1) & 1) * 32768;
                const int ko = (kt + 1) * 64;
#pragma unroll
                for (int i = 0; i < 4; ++i) {
                    __builtin_amdgcn_global_load_lds((const unsigned*)(ap[i] + ko), (unsigned*)(nxt + tid * 16 + i * 4096), 16, 0, 0);
                    __builtin_amdgcn_global_load_lds((const unsigned*)(bp[i] + ko), (unsigned*)(nxt + 16384 + tid * 16 + i * 4096), 16, 0, 0);
                }
            } else if (has_next) {
#pragma unroll
                for (int i = 0; i < 4; ++i) {
                    __builtin_amdgcn_global_load_lds((const unsigned*)(an[i]), (unsigned*)(lds + tid * 16 + i * 4096), 16, 0, 0);
                    __builtin_amdgcn_global_load_lds((const unsigned*)(bn[i]), (unsigned*)(lds + 16384 + tid * 16 + i * 4096), 16, 0, 0);
                }
            }
            bf16x8 af[4][2], bfr[4][2];
#pragma unroll
            for (int m = 0; m < 4; ++m)
#pragma unroll
                for (int kk = 0; kk < 2; ++kk) af[m][kk] = *reinterpret_cast<const bf16x8*>(cur + lds_byte(wr * 64 + m * 16 + fr, kk * 32 + fq * 8));
#pragma unroll
            for (int n = 0; n < 4; ++n)
#pragma unroll
                for (int kk = 0; kk < 2; ++kk) bfr[n][kk] = *reinterpret_cast<const bf16x8*>(cur + 16384 + lds_byte(wc * 64 + n * 16 + fr, kk * 32 + fq * 8));
#pragma unroll
            for (int kk = 0; kk < 2; ++kk)
#pragma unroll
                for (int m = 0; m < 4; ++m)
#pragma unroll
                    for (int n = 0; n < 4; ++n) acc[m][n] = __builtin_amdgcn_mfma_f32_16x16x32_bf16(bfr[n][kk], af[m][kk], acc[m][n], 0, 0, 0);
        }
        epi(t, acc, wr, wc, fr, fq);
        if (!has_next) break;
        t = tn;
#pragma unroll
        for (int i = 0; i < 4; ++i) { ap[i] = an[i]; bp[i] = bn[i]; }
    }
    __syncthreads();
}
DEVINL void stage_coords(int (&R)[4], int (&C)[4]) {
    const int tid = TIDX();
#pragma unroll
    for (int i = 0; i < 4; ++i) stage_rc(tid * 16 + i * 4096, R[i], C[i]);
}

struct GUnit {
    const char* A;
    const char* B;
    unsigned va[2][2] = {{0u, 0u}, {0u, 0u}};
    int i0, i1, i2;
};
constexpr int G_HTB = 128 * 64 * 2;
constexpr int G_STAGE_BYTES = 8 * G_HTB;
DEVINL int perm32(int rho) { const int n = rho >> 4, i = rho & 15; return 8 * (i >> 2) + 4 * n + (i & 3); }
DEVINL void stage_coords512(int tid, int (&R)[2], int (&C)[2]) {
#pragma unroll
    for (int i = 0; i < 2; ++i) stage_rc(tid * 16 + i * 8192, R[i], C[i]);
}

template <bool PERM, bool GATHER, class Sched, class Epi>
DEVINL void gemm256(char* lds_generic, int K, int lda, Sched sched, Epi epi) {
    LAS unsigned char* lds = (LAS unsigned char*)lds_generic;
    const int tid = TID512(), wid = __builtin_amdgcn_readfirstlane(tid >> 6), lane = tid & 63, wr = wid >> 2, wc = wid & 3, fr = lane & 15, fq = lane >> 4;
    const int nt = K / 64;
    unsigned voffB[2];
#pragma unroll
    for (int i = 0; i < 2; ++i) { int R, C; stage_rc(tid * 16 + i * 8192, R, C); const int Rb = PERM ? ((R & ~31) + perm32(R & 31)) : R; voffB[i] = (unsigned)(Rb * K + C) * 2u; }
    unsigned voffA[2];
#pragma unroll
    for (int i = 0; i < 2; ++i) { int R, C; stage_rc(tid * 16 + i * 8192, R, C); voffA[i] = (unsigned)(R * lda + C) * 2u; }
    const size_t hstepA = GATHER ? 0 : (size_t)128 * lda * 2;
    const size_t kstep = (size_t)(64 * 2);
    const size_t hstepB = (size_t)128 * K * 2;
    const unsigned ldsw = (unsigned)wid * 1024u;
    const int aoff = lds_byte(wr * 64 + fr, fq * 8), boff = lds_byte(wc * 32 + fr, fq * 8);
#define G_SA(b, h) (((b) * 2 + (h)) * G_HTB)
#define G_SB(b, h) ((4 + (b) * 2 + (h)) * G_HTB)
#define G_STAGE(bufoff, gbase, voff) do { _Pragma("unroll") for (int _i = 0; _i < 2; ++_i) { unsigned _vo = (voff)[_i]; asm volatile("" : "+v"(_vo)); \
        __builtin_amdgcn_global_load_lds((const unsigned*)((const char*)(gbase) + _vo), (LAS unsigned*)(lds + (bufoff) + ldsw + _i * 8192), 16, 0, 0); } } while (0)
#define G_STAGE_A(bufoff, ptr, vg, h) do { if constexpr (GATHER) { G_STAGE(bufoff, ptr, vg); } else { G_STAGE(bufoff, (ptr) + (h) * hstepA, voffA); } } while (0)
#define G_LDA(dst, b, h) do { _Pragma("unroll") for (int m = 0; m < 4; ++m) _Pragma("unroll") for (int k = 0; k < 2; ++k) dst[m][k] = *(const LAS bf16x8*)(lds + G_SA(b, h) + aoff + m * 2048 + k * 1024); } while (0)
#define G_LDB(dst, b, h) do { _Pragma("unroll") for (int n = 0; n < 2; ++n) _Pragma("unroll") for (int k = 0; k < 2; ++k) dst[n][k] = *(const LAS bf16x8*)(lds + G_SB(b, h) + boff + n * 2048 + k * 1024); } while (0)
#define G_MMA(ai, bj, At, Bt) do { __builtin_amdgcn_s_setprio(1); _Pragma("unroll") for (int m = 0; m < 4; ++m) _Pragma("unroll") for (int n = 0; n < 2; ++n) _Pragma("unroll") for (int k = 0; k < 2; ++k) \
        acc[ai][bj][m][n] = __builtin_amdgcn_mfma_f32_16x16x32_bf16(Bt[n][k], At[m][k], acc[ai][bj][m][n], 0, 0, 0); __builtin_amdgcn_s_setprio(0); } while (0)
#define G_WAIT_V(n) asm volatile("s_waitcnt vmcnt(" #n ")" ::: "memory")
#define G_WAIT_L(n) asm volatile("s_waitcnt lgkmcnt(" #n ")" ::: "memory")
#define G_BAR __builtin_amdgcn_s_barrier()
#define G_SCHED __builtin_amdgcn_sched_barrier(0)
    GUnit cur, nxt; int ui = 0;
    if (!sched(0, cur)) return;
    f32x4 acc[2][2][4][2];
#pragma unroll
    for (int a = 0; a < 2; ++a)
#pragma unroll
        for (int b = 0; b < 2; ++b)
#pragma unroll
            for (int m = 0; m < 4; ++m)
#pragma unroll
                for (int n = 0; n < 2; ++n) acc[a][b][m][n] = (f32x4){0.f, 0.f, 0.f, 0.f};
    bf16x8 At[4][2], B0[2][2], B1[2][2];
    G_STAGE(G_SB(0, 0), cur.B, voffB); G_STAGE_A(G_SA(0, 0), cur.A, cur.va[0], 0); G_STAGE(G_SB(0, 1), cur.B + hstepB, voffB); G_STAGE_A(G_SA(0, 1), cur.A, cur.va[1], 1);
    if (wr == 1) G_BAR;
    G_WAIT_V(4); G_BAR;
    G_STAGE(G_SB(1, 0), cur.B + kstep, voffB); G_STAGE_A(G_SA(1, 0), cur.A + kstep, cur.va[0], 0); G_STAGE(G_SB(1, 1), cur.B + hstepB + kstep, voffB);
    G_WAIT_V(6); G_BAR;
    for (;;) {
        const bool has_next = sched(ui + 1, nxt);
        if (!has_next) nxt = cur;
        for (int t = 0; t < nt; t += 2) {
            const bool last = (t == nt - 2);
            const char* a1 = cur.A + (size_t)(t + 1) * kstep;
            const char* a2 = last ? nxt.A : cur.A + (size_t)(t + 2) * kstep; const char* b2 = last ? nxt.B : cur.B + (size_t)(t + 2) * kstep;
            const char* a3 = a2 + kstep; const char* b3 = b2 + kstep;
            unsigned vh0[2] = {0u, 0u}, vh1[2] = {0u, 0u};
            if constexpr (GATHER) { vh0[0] = last ? nxt.va[0][0] : cur.va[0][0]; vh0[1] = last ? nxt.va[0][1] : cur.va[0][1]; vh1[0] = last ? nxt.va[1][0] : cur.va[1][0]; vh1[1] = last ? nxt.va[1][1] : cur.va[1][1]; }
            G_LDB(B0, 0, 0); G_SCHED; G_LDA(At, 0, 0); G_STAGE_A(G_SA(1, 1), a1, cur.va[1], 1);
            G_WAIT_L(8); G_BAR; G_WAIT_L(0); G_MMA(0, 0, At, B0); G_BAR; G_SCHED;
            G_LDB(B1, 0, 1); G_STAGE(G_SB(0, 0), b2, voffB);
            G_BAR; G_WAIT_L(0); G_MMA(0, 1, At, B1); G_BAR;
            G_LDA(At, 0, 1); G_STAGE_A(G_SA(0, 0), a2, vh0, 0);
            G_BAR; G_WAIT_L(0); G_MMA(1, 0, At, B0); G_BAR; G_SCHED;
            G_STAGE(G_SB(0, 1), b2 + hstepB, voffB);
            G_WAIT_V(6); G_BAR; G_MMA(1, 1, At, B1); G_BAR;
            G_LDB(B0, 1, 0); G_SCHED; G_LDA(At, 1, 0); G_STAGE_A(G_SA(0, 1), a2, vh1, 1);
            G_WAIT_L(8); G_BAR; G_WAIT_L(0); G_MMA(0, 0, At, B0); G_BAR; G_SCHED;
            G_LDB(B1, 1, 1); G_STAGE(G_SB(1, 0), b3, voffB);
            G_BAR; G_WAIT_L(0); G_MMA(0, 1, At, B1); G_BAR;
            G_LDA(At, 1, 1); G_STAGE_A(G_SA(1, 0), a3, vh0, 0);
            G_BAR; G_WAIT_L(0); G_MMA(1, 0, At, B0); G_BAR; G_SCHED;
            G_STAGE(G_SB(1, 1), b3 + hstepB, voffB);
            G_WAIT_V(6); G_BAR; G_MMA(1, 1, At, B1); G_BAR;
        }
        { const int l2 = TID512() & 63; epi(acc, cur, wr, wc, l2 & 15, l2 >> 4); }
        if (!has_next) break;
#pragma unroll
        for (int a = 0; a < 2; ++a)
#pragma unroll
            for (int b = 0; b < 2; ++b)
#pragma unroll
                for (int m = 0; m < 4; ++m)
#pragma unroll
                    for (int n = 0; n < 2; ++n) acc[a][b][m][n] = (f32x4){0.f, 0.f, 0.f, 0.f};
        cur = nxt; ++ui;
    }
    G_WAIT_V(0);
    if (wr == 0) G_BAR;
    G_BAR;
#undef G_SA
#undef G_STAGE_A
#undef G_SB
#undef G_STAGE
#undef G_LDA
#undef G_LDB
#undef G_MMA
#undef G_WAIT_V
#undef G_WAIT_L
#undef G_BAR
#undef G_SCHED
}
DEVINL long unit_linear(int i, int c, int G) { const int q = G >> 3; return ((long)i * 8 + (c & 7)) * q + (c >> 3); }

DEVINL void phase0(KP p, char* lds) {
    const int tid = TIDX(), nb = NBV(), blk = BIDX();
    if (blk == 0 && tid < 128) ((unsigned*)(p->ws + OFF_CNT))[tid] = 0u;
    if (blk < 192) {
        float* sc = (float*)lds;
        float* part = (float*)(lds + 32768);
        for (int i = tid; i < 8192; i += VTHREADS) { float c = p->in[I_C][i]; sc[i] = c * sigm(c); }
        __syncthreads();
        const int cl = tid & 63, ks = tid >> 6, n = blk * 64 + cl, l = n / 6144, nn = n % 6144;
        const float* w = p->in[I_WMOD] + (size_t)l * 1024 * 6144 + (size_t)(ks * 256) * 6144 + nn;
        float acc[8];
#pragma unroll
        for (int b = 0; b < 8; ++b) acc[b] = 0.f;
#pragma unroll 16
        for (int k = 0; k < 256; ++k) {
            const float wv = w[(size_t)k * 6144];
#pragma unroll
            for (int b = 0; b < 8; ++b) acc[b] = fmaf(sc[b * 1024 + ks * 256 + k], wv, acc[b]);
        }
#pragma unroll
        for (int b = 0; b < 8; ++b) part[(ks * 8 + b) * 64 + cl] = acc[b];
        __syncthreads();
        if (tid < 64) {
            const float bm = p->in[I_BMOD][l * 6144 + nn];
            float* mod = (float*)(p->ws + OFF_MOD);
#pragma unroll
            for (int b = 0; b < 8; ++b) mod[(size_t)(l * 8 + b) * 6144 + nn] = part[(0 * 8 + b) * 64 + cl] + part[(1 * 8 + b) * 64 + cl] + part[(2 * 8 + b) * 64 + cl] + part[(3 * 8 + b) * 64 + cl] + bm;
        }
        __syncthreads();
    }
    if (blk >= 192 && blk < 256) {
        bf16_t* wrt = (bf16_t*)(p->ws + OFF_WR);
#pragma unroll
        for (int j = 0; j < 8; ++j) {
            const int idx = (blk - 192) * 2048 + j * 256 + tid, l2 = idx >> 16, rem = idx & 65535, k = rem >> 6, e = rem & 63;
            const float w = p->in[I_WROUTER][idx];
            const bf16_t hi = f2bf(w); const bf16_t lo = f2bf(w - bf2f(hi));
            wrt[(size_t)((l2 * 2 + 0) * 64 + e) * 1024 + k] = hi; wrt[(size_t)((l2 * 2 + 1) * 64 + e) * 1024 + k] = lo;
        }
    }
    float* tile = (float*)lds;
    const int PER_L = 672 + 256 + 8320 + 4160;
    for (int base = 0; base < 2 * PER_L; base += nb) {
        const int id = (base + blk < 2 * PER_L) ? base + blk : 2 * PER_L - 1;
        const int l = id / PER_L; int r = id % PER_L;
        const float* src; bf16_t* dst; int K, ld, perm, kt, nt;
        if (r < 672) { src = p->in[I_WIN] + (size_t)l * 1024 * 2688; K = 1024; ld = 2688; perm = 0; dst = (bf16_t*)(p->ws + OFF_WIN) + (size_t)l * WIN_ROWS * 1024; kt = r & 15; nt = r >> 4; }
        else if (r < 928) { r -= 672; src = p->in[I_WOUT] + (size_t)l * 1024 * 1024; K = 1024; ld = 1024; perm = 0; dst = (bf16_t*)(p->ws + OFF_WOUT) + (size_t)l * 1024 * 1024; kt = r & 15; nt = r >> 4; }
        else if (r < 928 + 8320) { r -= 928; const int e = r >> 7, q = r & 127; kt = q & 15; nt = q >> 4; K = 1024; ld = 512; perm = 1;
            src = (e < 64) ? p->in[I_W13] + (size_t)(l * 64 + e) * 1024 * 512 : p->in[I_WS13] + (size_t)l * 1024 * 512;
            dst = (bf16_t*)(p->ws + OFF_W13) + (size_t)(l * 65 + e) * 512 * 1024; }
        else { r -= 9248; const int e = r >> 6, q = r & 63; kt = q & 3; nt = q >> 2; K = 256; ld = 1024; perm = 0;
            src = (e < 64) ? p->in[I_W2] + (size_t)(l * 64 + e) * 256 * 1024 : p->in[I_WS2] + (size_t)l * 256 * 1024;
            dst = (bf16_t*)(p->ws + OFF_W2) + (size_t)(l * 65 + e) * 1024 * 256; }
        const int k0 = kt * 64, r0 = nt * 64;
        {
            const int nn = tid & 63; const int drow = r0 + nn;
            int scol = drow;
            if (perm) { const int g = drow >> 5, i = drow & 31; scol = (i < 16) ? (g * 16 + i) : (256 + g * 16 + (i - 16)); }
#pragma unroll
            for (int j = 0; j < 16; ++j) { const int kk = (tid >> 6) + 4 * j; tile[kk * 65 + nn] = src[(size_t)(k0 + kk) * ld + scol]; }
        }
        __syncthreads();
        {
            const int kp = (tid & 31) * 2;
#pragma unroll
            for (int j = 0; j < 8; ++j) { const int rr = (tid >> 5) + 8 * j;
                *(unsigned*)(dst + (size_t)(r0 + rr) * K + k0 + kp) = pack2(tile[kp * 65 + rr], tile[(kp + 1) * 65 + rr]); }
        }
        __syncthreads();
    }
}

DEVINL void phaseF0(KP p) {
    const int tid = TIDX(), nb = NBV(), blk = BIDX();
    const float* mod = (const float*)(p->ws + OFF_MOD);
    bf16_t* ubuf = (bf16_t*)(p->ws + OFF_UBUF);
    for (int row = blk; row < NTOK; row += nb) {
        const int b = row >> 12, col = tid * 4;
        const float4 x = *(const float4*)(p->in[I_X] + (size_t)row * DM + col);
        const float4 sh = *(const float4*)(mod + (size_t)b * 6144 + col);
        const float4 sc = *(const float4*)(mod + (size_t)b * 6144 + 1024 + col);
        uint2 o; o.x = pack2(x.x * (1.f + sc.x) + sh.x, x.y * (1.f + sc.y) + sh.y); o.y = pack2(x.z * (1.f + sc.z) + sh.z, x.w * (1.f + sc.w) + sh.w);
        *(uint2*)(ubuf + (size_t)row * DM + col) = o;
    }
}

DEVINL void b1_conformer(KP p, int l, char* lds, int item) {
    const int tid = TIDX(), b = item >> 7, tt = item & 127, t0 = tt * 32, rowbase = b * SEQ;
    const bf16_t* P = (const bf16_t*)(p->ws + A_P);
    bf16_t* ymix = (bf16_t*)(p->ws + A_YMIX);
    float w[31];
#pragma unroll
    for (int k = 0; k < 31; ++k) w[k] = p->in[I_CONVA][(size_t)(l * 31 + k) * 256 + tid];
    float acc[32];
    const float bias = p->in[I_CONVAB][l * 256 + tid];
#pragma unroll
    for (int j = 0; j < 32; ++j) acc[j] = bias;
#pragma unroll
    for (int rr = 0; rr < 62; ++rr) {
        const int t = t0 - 30 + rr;
        const bf16_t* pr = P + ((long)(rowbase + t0 - 30) * PIN + tid) + (long)rr * PIN;
        const float val = bf2f(pr[0]), gate = bf2f(pr[256]);
        const float h = (t >= 0) ? val * sigm(gate) : 0.f;
#pragma unroll
        for (int j = 0; j < 32; ++j) { const int k = rr - j; if (k >= 0 && k <= 30) acc[j] = fmaf(w[k], h, acc[j]); }
    }
    float* outb = (float*)lds;
#pragma unroll
    for (int j = 0; j < 32; ++j) outb[j * 256 + tid] = acc[j];
    __syncthreads();
    const int wid = tid >> 6, lane = tid & 63;
    const float4 g4 = *(const float4*)(p->in[I_LNAG] + l * 256 + lane * 4), b4 = *(const float4*)(p->in[I_LNAB] + l * 256 + lane * 4);
    for (int j = wid; j < 32; j += 4) {
        const float4 v = *(const float4*)(outb + j * 256 + lane * 4);
        const float mean = wave_sum(v.x + v.y + v.z + v.w) * (1.f / 256.f);
        const float d0 = v.x - mean, d1 = v.y - mean, d2 = v.z - mean, d3 = v.w - mean;
        const float var = wave_sum(d0 * d0 + d1 * d1 + d2 * d2 + d3 * d3) * (1.f / 256.f);
        const float rs = rsqrtf(var + LN_EPS);
        float y0 = d0 * rs * g4.x + b4.x, y1 = d1 * rs * g4.y + b4.y, y2 = d2 * rs * g4.z + b4.z, y3 = d3 * rs * g4.w + b4.w;
        y0 *= sigm(y0); y1 *= sigm(y1); y2 *= sigm(y2); y3 *= sigm(y3);
        uint2 o; o.x = pack2(y0, y1); o.y = pack2(y2, y3);
        *(uint2*)(ymix + (size_t)(rowbase + t0 + j) * DM + lane * 4) = o;
    }
    __syncthreads();
}

DEVINL void b1_shortconv(KP p, int l, int item) {
    const int tid = TIDX(), cg = tid & 31, tl = tid >> 5, b = item >> 6, t0 = (item & 63) * 64 + tl * 8, rowbase = b * SEQ;
    const bf16_t* P = (const bf16_t*)(p->ws + A_P);
    bf16_t* ymix = (bf16_t*)(p->ws + A_YMIX);
    float w0[8], w1[8], w2[8];
#pragma unroll
    for (int e = 0; e < 8; ++e) { w0[e] = p->in[I_CONVD][(l * 3 + 0) * 256 + cg * 8 + e]; w1[e] = p->in[I_CONVD][(l * 3 + 1) * 256 + cg * 8 + e]; w2[e] = p->in[I_CONVD][(l * 3 + 2) * 256 + cg * 8 + e]; }
    uint4 gbv[8], gcv[10], hdv[10];
#pragma unroll
    for (int u = 0; u < 10; ++u) {
        const int t = t0 - 2 + u;
        const bf16_t* a = P + (size_t)(rowbase + (t >= 0 ? t : 0)) * PIN + 1920 + cg * 8;
        gcv[u] = *(const uint4*)(a + 256); hdv[u] = *(const uint4*)(a + 512);
        if (u >= 2) gbv[u - 2] = *(const uint4*)(a);
    }
    float q2[8], q1[8];
#pragma unroll
    for (int u = 0; u < 10; ++u) {
        const int t = t0 - 2 + u;
        const unsigned gcw[4] = {gcv[u].x, gcv[u].y, gcv[u].z, gcv[u].w}, hdw[4] = {hdv[u].x, hdv[u].y, hdv[u].z, hdv[u].w};
        float q0[8];
#pragma unroll
        for (int e = 0; e < 4; ++e) {
            q0[2 * e] = __uint_as_float(gcw[e] << 16) * __uint_as_float(hdw[e] << 16);
            q0[2 * e + 1] = __uint_as_float(gcw[e] & 0xFFFF0000u) * __uint_as_float(hdw[e] & 0xFFFF0000u);
        }
        if (t < 0) {
#pragma unroll
            for (int e = 0; e < 8; ++e) q0[e] = 0.f;
        }
        if (u >= 2) {
            const unsigned gbw[4] = {gbv[u - 2].x, gbv[u - 2].y, gbv[u - 2].z, gbv[u - 2].w};
            float y[8];
#pragma unroll
            for (int e = 0; e < 4; ++e) {
                y[2 * e] = __uint_as_float(gbw[e] << 16) * (w0[2 * e] * q2[2 * e] + w1[2 * e] * q1[2 * e] + w2[2 * e] * q0[2 * e]);
                y[2 * e + 1] = __uint_as_float(gbw[e] & 0xFFFF0000u) * (w0[2 * e + 1] * q2[2 * e + 1] + w1[2 * e + 1] * q1[2 * e + 1] + w2[2 * e + 1] * q0[2 * e + 1]);
            }
            *(uint4*)(ymix + (size_t)(rowbase + t) * DM + 768 + cg * 8) = make_uint4(pack2(y[0], y[1]), pack2(y[2], y[3]), pack2(y[4], y[5]), pack2(y[6], y[7]));
        }
#pragma unroll
        for (int e = 0; e < 8; ++e) { q2[e] = (u >= 1) ? q1[e] : 0.f; q1[e] = q0[e]; }
    }
}

DEVINL void b1_lru(KP p, int l, char* lds, int item) {
    const int c = TIDX(), b = item >> 7, tt = item & 127, t0 = tt * 32, rowbase = b * SEQ;
    const int h = c >> 6, lane = c & 63;
    const bf16_t* P = (const bf16_t*)(p->ws + A_P);
    float* uT = (float*)lds;
    {
        const float cb0 = p->in[I_CONVB][(l * 4 + 0) * 256 + c], cb1 = p->in[I_CONVB][(l * 4 + 1) * 256 + c], cb2 = p->in[I_CONVB][(l * 4 + 2) * 256 + c], cb3 = p->in[I_CONVB][(l * 4 + 3) * 256 + c];
        const float bias = p->in[I_CONVBB][l * 256 + c];
        float xm3 = 0.f, xm2 = 0.f, xm1 = 0.f;
        if (t0 >= 3) { const bf16_t* a = P + (size_t)(rowbase + t0 - 3) * PIN + 512 + c; xm3 = bf2f(a[0]); xm2 = bf2f(a[PIN]); xm1 = bf2f(a[2 * PIN]); }
        bf16_t xr[32];
#pragma unroll
        for (int j = 0; j < 32; ++j) xr[j] = P[(size_t)(rowbase + t0 + j) * PIN + 512 + c];
#pragma unroll
        for (int j = 0; j < 32; ++j) {
            const float x0 = bf2f(xr[j]);
            uT[c * 36 + j] = cb0 * xm3 + cb1 * xm2 + cb2 * xm1 + cb3 * x0 + bias;
            xm3 = xm2; xm2 = xm1; xm1 = x0;
        }
    }
    __syncthreads();
    const float brg = p->in[I_BRG][l * 256 + c], big = p->in[I_BIG][l * 256 + c];
    const float sp = softplus_acc(-p->in[I_LAMBDA][l * 256 + c]);
    float* hloc = (float*)(p->ws + A_HLOC); float* cuma = (float*)(p->ws + A_CUMA);
    const float* wrg = p->in[I_WRG] + (size_t)((l * 4 + h) * 64) * 64 + lane;
    const float* wig = p->in[I_WIG] + (size_t)((l * 4 + h) * 64) * 64 + lane;
    float hs = 0.f, cA = 1.f;
#pragma unroll 1
    for (int half = 0; half < 2; ++half) {
        float ar[16], ai[16];
#pragma unroll
        for (int j = 0; j < 16; ++j) { ar[j] = 0.f; ai[j] = 0.f; }
#pragma unroll 1
        for (int dh = 0; dh < 4; ++dh) {
            float wrv[16], wiv[16];
#pragma unroll
            for (int d = 0; d < 16; ++d) { wrv[d] = wrg[(dh * 16 + d) * 64]; wiv[d] = wig[(dh * 16 + d) * 64]; }
#pragma unroll
            for (int d = 0; d < 16; ++d) {
                const float wr = wrv[d], wi = wiv[d];
                const float4* up = (const float4*)(uT + (h * 64 + dh * 16 + d) * 36 + half * 16);
#pragma unroll
                for (int jj = 0; jj < 4; ++jj) {
                    const float4 u4 = up[jj];
                    ar[4 * jj + 0] = fmaf(u4.x, wr, ar[4 * jj + 0]); ai[4 * jj + 0] = fmaf(u4.x, wi, ai[4 * jj + 0]);
                    ar[4 * jj + 1] = fmaf(u4.y, wr, ar[4 * jj + 1]); ai[4 * jj + 1] = fmaf(u4.y, wi, ai[4 * jj + 1]);
                    ar[4 * jj + 2] = fmaf(u4.z, wr, ar[4 * jj + 2]); ai[4 * jj + 2] = fmaf(u4.z, wi, ai[4 * jj + 2]);
                    ar[4 * jj + 3] = fmaf(u4.w, wr, ar[4 * jj + 3]); ai[4 * jj + 3] = fmaf(u4.w, wi, ai[4 * jj + 3]);
                }
            }
        }
        float ureg[16];
#pragma unroll
        for (int jj = 0; jj < 4; ++jj) { const float4 u4 = *(const float4*)(uT + c * 36 + half * 16 + 4 * jj); ureg[4 * jj] = u4.x; ureg[4 * jj + 1] = u4.y; ureg[4 * jj + 2] = u4.z; ureg[4 * jj + 3] = u4.w; }
        float* hp = hloc + (size_t)(rowbase + t0 + half * 16) * 256 + c;
        float* cp = cuma + (size_t)(rowbase + t0 + half * 16) * 256 + c;
#pragma unroll
        for (int j = 0; j < 16; ++j) {
            const float r = sigm(ar[j] + brg), ig = sigm(ai[j] + big);
            const float log_a = -8.0f * r * sp;
            const float a = __expf(log_a);
            const float mult = sqrtf(fmaxf(1.f - a * a, 0.f));
            const float bx = mult * (ig * ureg[j]);
            hs = fmaf(a, hs, bx); cA *= a;
            hp[j * 256] = hs; cp[j * 256] = cA;
        }
    }
    ((float*)(p->ws + A_CARRYA))[(size_t)(b * 128 + tt) * 256 + c] = cA;
    ((float*)(p->ws + A_CARRYH))[(size_t)(b * 128 + tt) * 256 + c] = hs;
    __syncthreads();
}

DEVINL void b1_rwkv(KP p, int l, char* lds, int item) {
    const int c = TIDX(), b = item >> 7, tt = item & 127, t0 = tt * 32, rowbase = b * SEQ;
    const bf16_t* P = (const bf16_t*)(p->ws + A_P);
    float* featT = (float*)lds;
    const float* muc = p->in[I_MUC] + l * 896;
    if (c < 128) {
        const int col = 1024 + 768 + c; const float mu = muc[768 + c];
        float prev;
        { const float x = bf2f(P[(size_t)(rowbase + (t0 > 0 ? t0 - 1 : 0)) * PIN + col]); prev = (t0 > 0) ? x : 0.f; }
#pragma unroll 1
        for (int jb = 0; jb < 2; ++jb) {
            bf16_t raw[16];
#pragma unroll
            for (int u = 0; u < 16; ++u) raw[u] = P[(size_t)(rowbase + t0 + jb * 16 + u) * PIN + col];
#pragma unroll
            for (int u = 0; u < 16; ++u) {
                const float cur = bf2f(raw[u]);
                const float xs = cur + (prev - cur) * mu;
                const float val = (c < 32) ? tanh_fast(xs) : ((c < 64) ? xs : sigm(xs));
                featT[c * 36 + jb * 16 + u] = val; prev = cur;
            }
        }
    }
    __syncthreads();
    float acc[32], dec[32], aa[32];
#define LORA32(WPTR, FOFF) do { float wv_[32]; \
    _Pragma("unroll") for (int jf = 0; jf < 32; ++jf) wv_[jf] = (WPTR)[(size_t)jf * 256 + c]; \
    _Pragma("unroll") for (int jf = 0; jf < 32; ++jf) { const float4* fp = (const float4*)(featT + ((FOFF) + jf) * 36); const float wv = wv_[jf]; \
        _Pragma("unroll") for (int jj = 0; jj < 8; ++jj) { const float4 u4 = fp[jj]; acc[4 * jj] = fmaf(u4.x, wv, acc[4 * jj]); acc[4 * jj + 1] = fmaf(u4.y, wv, acc[4 * jj + 1]); acc[4 * jj + 2] = fmaf(u4.z, wv, acc[4 * jj + 2]); acc[4 * jj + 3] = fmaf(u4.w, wv, acc[4 * jj + 3]); } } } while (0)
#pragma unroll
    for (int j = 0; j < 32; ++j) acc[j] = 0.f;
    LORA32(p->in[I_WG2] + (size_t)(l * 64) * 256, 64);
    LORA32(p->in[I_WG2] + (size_t)(l * 64 + 32) * 256, 96);
    {
        float* gbuf = (float*)(p->ws + A_G);
#pragma unroll
        for (int j = 0; j < 32; ++j) { gbuf[(size_t)(rowbase + t0 + j) * 256 + c] = acc[j]; acc[j] = 0.f; }
    }
    LORA32(p->in[I_WW2] + (size_t)(l * 32) * 256, 0);
    {
        const float w0 = p->in[I_W0][l * 256 + c];
#pragma unroll
        for (int j = 0; j < 32; ++j) { const float z = w0 + acc[j]; const float wlog = -softplusf(-z) - 0.5f; dec[j] = -__expf(wlog); acc[j] = 0.f; }
    }
    LORA32(p->in[I_WA2] + (size_t)(l * 32) * 256, 32);
    {
        const float a0 = p->in[I_A0][l * 256 + c];
#pragma unroll
        for (int j = 0; j < 32; ++j) aa[j] = sigm(a0 + acc[j]);
    }
#undef LORA32
    {
        float* bonus = (float*)(p->ws + A_BONUS); uint4* scan = (uint4*)(p->ws + A_SCAN);
        const float mur = muc[c], muk = muc[256 + c], muv = muc[512 + c];
        const float kkw = p->in[I_KK][l * 256 + c], kaw = p->in[I_KA][l * 256 + c], rkw = p->in[I_RK][l * 256 + c];
        float pr, pk, pv;
        { const bf16_t* a = P + (size_t)(rowbase + (t0 > 0 ? t0 - 1 : 0)) * PIN + 1024 + c; const float x0 = bf2f(a[0]), x1 = bf2f(a[256]), x2 = bf2f(a[512]);
          pr = (t0 > 0) ? x0 : 0.f; pk = (t0 > 0) ? x1 : 0.f; pv = (t0 > 0) ? x2 : 0.f; }
#pragma unroll
        for (int jb = 0; jb < 4; ++jb) {
            bf16_t rr_[8], rk_[8], rv_[8];
#pragma unroll
            for (int u = 0; u < 8; ++u) { const bf16_t* a = P + (size_t)(rowbase + t0 + jb * 8 + u) * PIN + 1024 + c; rr_[u] = a[0]; rk_[u] = a[256]; rv_[u] = a[512]; }
#pragma unroll
            for (int u = 0; u < 8; ++u) {
                const int j = jb * 8 + u;
                const size_t row = (size_t)(rowbase + t0 + j);
                const float cr = bf2f(rr_[u]), ck = bf2f(rk_[u]), cv = bf2f(rv_[u]);
                const float r = cr + (pr - cr) * mur, k = ck + (pk - ck) * muk, v = cv + (pv - cv) * muv;
                pr = cr; pk = ck; pv = cv;
                const float kk = k * kkw;
                const float ss = wave_sum(kk * kk);
                const float kkn = kk * rsqrtf(ss + 1e-12f);
                const float kf = k * (1.f + (aa[j] - 1.f) * kaw);
                const float bs = wave_sum(r * kf * rkw);
                bonus[row * 256 + c] = bs * v;
                uint4 o; o.x = pack2(kkn, kkn * aa[j]); o.y = pack2(kf, r); o.z = pack2(v, 0.f); o.w = __float_as_uint(dec[j]);
                scan[row * 256 + c] = o;
            }
            asm volatile("" ::: "memory");
        }
    }
    __syncthreads();
}

constexpr int S_AL = 0, S_BE = 8192, S_KA = 16384, S_RH = 24576, S_BET = 32768, S_KAT = 40960, S_VT = 49152, S_L2F = 57344  , S_GT = 73728  ;
constexpr int S_L1F = S_BE;
constexpr int S_M1 = S_BE, S_M2 = S_KA;
constexpr int S_APT = S_L2F, S_W2T = S_L2F + 8192;
constexpr int S_RP = S_AL, S_GTR = S_RH;
DEVINL int crow32(int reg, int h) { return (reg & 3) + 8 * (reg >> 2) + 4 * h; }
DEVINL bf16x8 frag64(const char* lds, int slot, int row, int kel) { return *reinterpret_cast<const bf16x8*>(lds + slot + row * 128 + kel * 2); }
#define MFMA32(a, b, c) __builtin_amdgcn_mfma_f32_32x32x16_bf16((a), (b), (c), 0, 0, 0)
DEVINL float dpp_xor1(float x) { return __builtin_bit_cast(float, __builtin_amdgcn_update_dpp(0, __builtin_bit_cast(int, x), 0xB1, 0xf, 0xf, true)); }

DEVINL f32x16 mm64(const char* lds, int slotA, int slotB, int tm, int tn, int r, int hh, f32x16 acc) {
#pragma unroll
    for (int ks = 0; ks < 4; ++ks) acc = MFMA32(frag64(lds, slotA, tm * 32 + r, ks * 16 + 8 * hh), frag64(lds, slotB, tn * 32 + r, ks * 16 + 8 * hh), acc);
    return acc;
}

DEVINL void b1e_unit(KP p, char* lds, int b, int h, int c) {
    const int tid = TIDX(), wv = tid >> 6, lane = tid & 63, r = lane & 31, hh = lane >> 5;
    const uint4* scan = (const uint4*)(p->ws + A_SCAN) + ((size_t)(b * SEQ + c * 64)) * 256 + h * 64;
    float* gtot = (float*)(lds + S_GT); float* gamC = gtot + 256;
    {
        const int j = lane;
        float lw[16]; unsigned px[16], py[16], pz[16];
#pragma unroll
        for (int u = 0; u < 16; ++u) { const uint4 q = scan[(size_t)(wv * 16 + u) * 256 + j]; px[u] = q.x; py[u] = q.y; pz[u] = q.z; lw[u] = __uint_as_float(q.w); }
        float tot = 0.f;
#pragma unroll
        for (int u = 0; u < 16; ++u) tot += lw[u];
        gtot[wv * 64 + j] = tot;
        __syncthreads();
        float off = 0.f, all = 0.f;
#pragma unroll
        for (int g = 0; g < 4; ++g) { const float v = gtot[g * 64 + j]; all += v; off += (g < wv) ? v : 0.f; }
        if (wv == 0) gamC[j] = __expf(all);
        float cum = off;
        unsigned tb[8], tk[8], tv[8];
#pragma unroll
        for (int u = 0; u < 16; ++u) {
            const float kkn = __uint_as_float(px[u] << 16), bb = __uint_as_float(px[u] & 0xFFFF0000u);
            const float kf = __uint_as_float(py[u] << 16), rr = __uint_as_float(py[u] & 0xFFFF0000u);
            const float gp = __expf(cum); cum += lw[u];
            const float g = __expf(cum), en = __expf(-cum);
            const int t = wv * 16 + u;
            const unsigned be = f2bf(bb * en), ka = f2bf(kf * en);
            *(bf16_t*)(lds + S_AL + t * 128 + j * 2) = f2bf(gp * kkn);
            *(bf16_t*)(lds + S_BE + t * 128 + j * 2) = (bf16_t)be;
            *(bf16_t*)(lds + S_KA + t * 128 + j * 2) = (bf16_t)ka;
            *(bf16_t*)(lds + S_RH + t * 128 + j * 2) = f2bf(g * rr);
            if (u & 1) { tb[u >> 1] |= be << 16; tk[u >> 1] |= ka << 16; tv[u >> 1] |= (pz[u] << 16); }
            else { tb[u >> 1] = be; tk[u >> 1] = ka; tv[u >> 1] = pz[u] & 0xFFFFu; }
        }
        *(uint4*)(lds + S_BET + j * 128 + wv * 32) = make_uint4(tb[0], tb[1], tb[2], tb[3]); *(uint4*)(lds + S_BET + j * 128 + wv * 32 + 16) = make_uint4(tb[4], tb[5], tb[6], tb[7]);
        *(uint4*)(lds + S_KAT + j * 128 + wv * 32) = make_uint4(tk[0], tk[1], tk[2], tk[3]); *(uint4*)(lds + S_KAT + j * 128 + wv * 32 + 16) = make_uint4(tk[4], tk[5], tk[6], tk[7]);
        *(uint4*)(lds + S_VT + j * 128 + wv * 32) = make_uint4(tv[0], tv[1], tv[2], tv[3]); *(uint4*)(lds + S_VT + j * 128 + wv * 32 + 16) = make_uint4(tv[4], tv[5], tv[6], tv[7]);
    }
    __syncthreads();
    const int tm = wv >> 1, tn = wv & 1;
    f32x16 aM1, aM2;
    {
        f32x16 aL1, aL2;
#pragma unroll
        for (int i = 0; i < 16; ++i) { aL1[i] = 0.f; aL2[i] = 0.f; aM1[i] = 0.f; aM2[i] = 0.f; }
#pragma unroll
        for (int ks = 0; ks < 4; ++ks) {
            const bf16x8 fa = frag64(lds, S_AL, tm * 32 + r, ks * 16 + 8 * hh), fr = frag64(lds, S_RH, tm * 32 + r, ks * 16 + 8 * hh);
            const bf16x8 fb = frag64(lds, S_BE, tn * 32 + r, ks * 16 + 8 * hh), fk = frag64(lds, S_KA, tn * 32 + r, ks * 16 + 8 * hh);
            aL1 = MFMA32(fa, fb, aL1); aL2 = MFMA32(fa, fk, aL2); aM1 = MFMA32(fr, fb, aM1); aM2 = MFMA32(fr, fk, aM2);
        }
        __syncthreads();
#pragma unroll
        for (int reg = 0; reg < 16; ++reg) {
            const int t = tm * 32 + crow32(reg, hh), sidx = tn * 32 + r;
            const int o = (t * 64 + (sidx & 1) * 32 + (sidx >> 1)) * 4;
            *(float*)(lds + S_L1F + o) = (sidx < t) ? aL1[reg] : 0.f;
            *(float*)(lds + S_L2F + o) = (sidx < t) ? aL2[reg] : 0.f;
            aM1[reg] = (sidx <= t) ? aM1[reg] : 0.f; aM2[reg] = (sidx <= t) ? aM2[reg] : 0.f;
        }
    }
    __syncthreads();
    unsigned outp[32];
    {
        const int col = (wv & 1) * 32 + (lane >> 1), q = lane & 1;
        float xq[32];
#pragma unroll
        for (int k = 0; k < 32; ++k) xq[k] = 0.f;
        const char* l1row = lds + S_L1F + q * 128;
        const char* l2row = lds + S_L2F + q * 128;
        if (wv < 2) {
#pragma unroll
            for (int t = 0; t < 64; ++t) {
                float acc = 0.f;
#pragma unroll
                for (int k4 = 0; k4 * 4 < (t + 1) / 2; ++k4) {
                    const float4 a = *(const float4*)(l1row + t * 256 + k4 * 16);
                    acc = fmaf(a.x, xq[4 * k4 + 0], acc); acc = fmaf(a.y, xq[4 * k4 + 1], acc); acc = fmaf(a.z, xq[4 * k4 + 2], acc); acc = fmaf(a.w, xq[4 * k4 + 3], acc);
                }
                acc += dpp_xor1(acc);
                const float x = bf2f(*(const bf16_t*)(lds + S_AL + t * 128 + col * 2)) - acc;
                xq[t >> 1] = ((t & 1) == q) ? x : xq[t >> 1];
            }
        } else {
            float vq[32];
#pragma unroll
            for (int k8 = 0; k8 < 8; ++k8) {
                const uint4 d = *(const uint4*)(lds + S_VT + col * 128 + k8 * 16);
                vq[4 * k8 + 0] = q ? __uint_as_float(d.x & 0xFFFF0000u) : __uint_as_float(d.x << 16);
                vq[4 * k8 + 1] = q ? __uint_as_float(d.y & 0xFFFF0000u) : __uint_as_float(d.y << 16);
                vq[4 * k8 + 2] = q ? __uint_as_float(d.z & 0xFFFF0000u) : __uint_as_float(d.z << 16);
                vq[4 * k8 + 3] = q ? __uint_as_float(d.w & 0xFFFF0000u) : __uint_as_float(d.w << 16);
            }
#pragma unroll
            for (int t = 0; t < 64; ++t) {
                float acc = 0.f;
#pragma unroll
                for (int k4 = 0; k4 * 4 < (t + 1) / 2; ++k4) {
                    const float4 a = *(const float4*)(l1row + t * 256 + k4 * 16);
                    const float4 bq = *(const float4*)(l2row + t * 256 + k4 * 16);
                    acc = fmaf(bq.x, vq[4 * k4 + 0], acc); acc = fmaf(bq.y, vq[4 * k4 + 1], acc); acc = fmaf(bq.z, vq[4 * k4 + 2], acc); acc = fmaf(bq.w, vq[4 * k4 + 3], acc);
                    acc = fmaf(-a.x, xq[4 * k4 + 0], acc); acc = fmaf(-a.y, xq[4 * k4 + 1], acc); acc = fmaf(-a.z, xq[4 * k4 + 2], acc); acc = fmaf(-a.w, xq[4 * k4 + 3], acc);
                }
                acc += dpp_xor1(acc);
                xq[t >> 1] = ((t & 1) == q) ? acc : xq[t >> 1];
            }
        }
#pragma unroll
        for (int k = 0; k < 32; ++k) { const float o = dpp_xor1(xq[k]); outp[k] = q ? pack2(o, xq[k]) : pack2(xq[k], o); }
    }
    __syncthreads();
    {
        const int col = (wv & 1) * 32 + (lane >> 1), q = lane & 1;
        char* dst = lds + ((wv < 2) ? S_APT : S_W2T) + col * 128 + q * 64;
#pragma unroll
        for (int i = 0; i < 4; ++i) *(uint4*)(dst + i * 16) = q ? make_uint4(outp[16 + 4 * i], outp[17 + 4 * i], outp[18 + 4 * i], outp[19 + 4 * i]) : make_uint4(outp[4 * i], outp[4 * i + 1], outp[4 * i + 2], outp[4 * i + 3]);
#pragma unroll
        for (int reg = 0; reg < 16; ++reg) {
            const int t = tm * 32 + crow32(reg, hh), sidx = tn * 32 + r;
            *(bf16_t*)(lds + S_M1 + t * 128 + sidx * 2) = f2bf(aM1[reg]);
            *(bf16_t*)(lds + S_M2 + t * 128 + sidx * 2) = f2bf(aM2[reg]);
        }
    }
    __syncthreads();
    unsigned char* ubase = p->ws + A_CHAIN + (size_t)((b * 4 + h) * 64 + c) * CHAIN_UNIT;
    f32x16 zero;
#pragma unroll
    for (int i = 0; i < 16; ++i) zero[i] = 0.f;
    f32x16 gt;
    {
        const f32x16 qv = mm64(lds, S_M1, S_APT, tm, tn, r, hh, zero);
        const f32x16 y0 = mm64(lds, S_M2, S_VT, tm, tn, r, hh, zero) - mm64(lds, S_M1, S_W2T, tm, tn, r, hh, zero);
        gt = mm64(lds, S_BET, S_APT, tm, tn, r, hh, zero);
        const f32x16 ht = mm64(lds, S_KAT, S_VT, tm, tn, r, hh, zero) - mm64(lds, S_BET, S_W2T, tm, tn, r, hh, zero);
#pragma unroll
        for (int reg = 0; reg < 16; ++reg) {
            const int t = tm * 32 + crow32(reg, hh), jc = tn * 32 + r;
            const float rh = bf2f(*(const bf16_t*)(lds + S_RH + t * 128 + jc * 2));
            *(bf16_t*)(lds + S_RP + t * 128 + jc * 2) = f2bf(rh - qv[reg]);
            const int jr = tm * 32 + crow32(reg, hh);
            const float gc = gamC[jr];
            gt[reg] = gc * (((jr == jc) ? 1.f : 0.f) - gt[reg]);
        }
        float4* himg = (float4*)(ubase + 16384); float4* yimg = (float4*)(ubase + 32768);
#pragma unroll
        for (int rq = 0; rq < 4; ++rq) {
            float4 hv, yv;
            hv.x = gamC[tm * 32 + crow32(4 * rq + 0, hh)] * ht[4 * rq + 0]; hv.y = gamC[tm * 32 + crow32(4 * rq + 1, hh)] * ht[4 * rq + 1];
            hv.z = gamC[tm * 32 + crow32(4 * rq + 2, hh)] * ht[4 * rq + 2]; hv.w = gamC[tm * 32 + crow32(4 * rq + 3, hh)] * ht[4 * rq + 3];
            yv.x = y0[4 * rq + 0]; yv.y = y0[4 * rq + 1]; yv.z = y0[4 * rq + 2]; yv.w = y0[4 * rq + 3];
            himg[((tn * 2 + tm) * 4 + rq) * 64 + lane] = hv;
            yimg[((tn * 2 + tm) * 4 + rq) * 64 + lane] = yv;
        }
    }
    __syncthreads();
#pragma unroll
    for (int reg = 0; reg < 16; ++reg) {
        const int jr = tm * 32 + crow32(reg, hh), jc = tn * 32 + r;
        *(bf16_t*)(lds + S_GTR + jr * 128 + jc * 2) = f2bf(gt[reg]);
    }
    __syncthreads();
    {
        uint4* gimg = (uint4*)(ubase); uint4* rimg = (uint4*)(ubase + 8192);
#pragma unroll
        for (int ii = 0; ii < 2; ++ii) {
            const int im = wv * 2 + ii, mt = im >> 2, jb = (im >> 1) & 1, s2 = im & 1;
            const int cbase = (32 * jb + 16 * s2 + 4 * hh) * 2;
            const uint2 g0 = *(const uint2*)(lds + S_GTR + (mt * 32 + r) * 128 + cbase), g1 = *(const uint2*)(lds + S_GTR + (mt * 32 + r) * 128 + cbase + 16);
            const uint2 r0 = *(const uint2*)(lds + S_RP + (mt * 32 + r) * 128 + cbase), r1 = *(const uint2*)(lds + S_RP + (mt * 32 + r) * 128 + cbase + 16);
            gimg[im * 64 + lane] = make_uint4(g0.x, g0.y, g1.x, g1.y);
            rimg[im * 64 + lane] = make_uint4(r0.x, r0.y, r1.x, r1.y);
        }
    }
    __syncthreads();
}

DEVINL void phaseB1(KP p, int l, char* lds, const int mask = 15, const int sub = 3) {
    const int nb = NBV();
    if (mask & 1) {
        const int blk = BIDX();
        for (int it = blk; it < 512; it += nb) {
            if (sub & 1) { b1_rwkv(p, l, lds, it * 2); b1_rwkv(p, l, lds, it * 2 + 1); }
            __threadfence_block(); __syncthreads();
            const int b = it >> 6, c = it & 63;
            if (sub & 2) {
#pragma unroll 1
                for (int h = 0; h < 4; ++h) b1e_unit(p, lds, b, h, c);
            }
        }
    }
    if (mask & 2) { const int blk = BIDX(); for (int it = blk; it < 1024; it += nb) b1_lru(p, l, lds, it); }
    if (mask & 4) { const int blk = BIDX(); for (int it = blk; it < 1024; it += nb) b1_conformer(p, l, lds, it); }
    if (mask & 8) { const int blk = BIDX(); for (int it = blk; it < 512; it += nb) b1_shortconv(p, l, it); }
}

DEVINL void phaseB2(KP p, int l) {
    const int tid = TIDX(), blk = BIDX();
    if (blk >= 64 && blk < 72) {
        const int bb = blk - 64;
        const float* ca = (const float*)(p->ws + A_CARRYA) + (size_t)bb * 128 * 256 + tid;
        const float* ch = (const float*)(p->ws + A_CARRYH) + (size_t)bb * 128 * 256 + tid;
        float* hst = (float*)(p->ws + A_HSTART) + (size_t)bb * 128 * 256 + tid;
        float hs = 0.f;
#pragma unroll 8
        for (int tt = 0; tt < 128; ++tt) { hst[tt * 256] = hs; hs = fmaf(ca[tt * 256], hs, ch[tt * 256]); }
    }
    if (blk < 64 && tid < 64) {
        const int lane = tid, r = lane & 31, hh = lane >> 5;
        const int bh = blk >> 1, w = blk & 1, b = bh >> 2, h = bh & 3;
        float* yraw = (float*)(p->ws + A_YRAW) + (size_t)b * SEQ * 256 + h * 64 + 32 * w + r;
        f32x16 X0, X1;
#pragma unroll
        for (int i = 0; i < 16; ++i) { X0[i] = 0.f; X1[i] = 0.f; }
        for (int c = 0; c < 64; ++c) {
            const unsigned char* ubase = p->ws + A_CHAIN + (size_t)(bh * 64 + c) * CHAIN_UNIT;
            const uint4* gimg = (const uint4*)ubase; const uint4* rimg = (const uint4*)(ubase + 8192);
            const float4* himg = (const float4*)(ubase + 16384); const float4* yimg = (const float4*)(ubase + 32768);
            uint4 gq[8], rq8[8]; float4 hq[8], yq[8];
#pragma unroll
            for (int i = 0; i < 8; ++i) { gq[i] = gimg[i * 64 + lane]; rq8[i] = rimg[i * 64 + lane]; }
#pragma unroll
            for (int i = 0; i < 8; ++i) { hq[i] = himg[(w * 8 + i) * 64 + lane]; yq[i] = yimg[(w * 8 + i) * 64 + lane]; }
            bf16x8 xp[4];
#pragma unroll
            for (int s2 = 0; s2 < 2; ++s2) {
                uint4 a, bq;
                a.x = pack2(X0[8 * s2 + 0], X0[8 * s2 + 1]); a.y = pack2(X0[8 * s2 + 2], X0[8 * s2 + 3]); a.z = pack2(X0[8 * s2 + 4], X0[8 * s2 + 5]); a.w = pack2(X0[8 * s2 + 6], X0[8 * s2 + 7]);
                bq.x = pack2(X1[8 * s2 + 0], X1[8 * s2 + 1]); bq.y = pack2(X1[8 * s2 + 2], X1[8 * s2 + 3]); bq.z = pack2(X1[8 * s2 + 4], X1[8 * s2 + 5]); bq.w = pack2(X1[8 * s2 + 6], X1[8 * s2 + 7]);
                xp[s2] = __builtin_bit_cast(bf16x8, a); xp[2 + s2] = __builtin_bit_cast(bf16x8, bq);
            }
#pragma unroll
            for (int mt = 0; mt < 2; ++mt) {
                f32x16 acc;
#pragma unroll
                for (int i = 0; i < 4; ++i) { acc[4 * i] = yq[mt * 4 + i].x; acc[4 * i + 1] = yq[mt * 4 + i].y; acc[4 * i + 2] = yq[mt * 4 + i].z; acc[4 * i + 3] = yq[mt * 4 + i].w; }
#pragma unroll
                for (int f = 0; f < 4; ++f) acc = MFMA32(__builtin_bit_cast(bf16x8, rq8[mt * 4 + f]), xp[f], acc);
#pragma unroll
                for (int reg = 0; reg < 16; ++reg) yraw[(size_t)(c * 64 + mt * 32 + crow32(reg, hh)) * 256] = acc[reg];
            }
            f32x16 n0, n1;
#pragma unroll
            for (int i = 0; i < 4; ++i) { n0[4 * i] = hq[i].x; n0[4 * i + 1] = hq[i].y; n0[4 * i + 2] = hq[i].z; n0[4 * i + 3] = hq[i].w;
                                          n1[4 * i] = hq[4 + i].x; n1[4 * i + 1] = hq[4 + i].y; n1[4 * i + 2] = hq[4 + i].z; n1[4 * i + 3] = hq[4 + i].w; }
#pragma unroll
            for (int f = 0; f < 4; ++f) { n0 = MFMA32(__builtin_bit_cast(bf16x8, gq[f]), xp[f], n0); n1 = MFMA32(__builtin_bit_cast(bf16x8, gq[4 + f]), xp[f], n1); }
            X0 = n0; X1 = n1;
        }
    }
}

DEVINL void phaseB3(KP p, int l) {
    const int c = TIDX(), nb = NBV(), blk = BIDX();
    const bf16_t* P = (const bf16_t*)(p->ws + A_P);
    bf16_t* ymix = (bf16_t*)(p->ws + A_YMIX);
    const float* yraw = (const float*)(p->ws + A_YRAW); const float* bonus = (const float*)(p->ws + A_BONUS); const float* gbuf = (const float*)(p->ws + A_G);
    const float* hloc = (const float*)(p->ws + A_HLOC); const float* cuma = (const float*)(p->ws + A_CUMA); const float* hst = (const float*)(p->ws + A_HSTART);
    const float gng = p->in[I_GNG][l * 256 + c], gnb = p->in[I_GNB][l * 256 + c];
    for (int it = blk; it < 512; it += nb) {
#pragma unroll 4
        for (int rr = 0; rr < 64; ++rr) {
            const int row = it * 64 + rr, b = row >> 12, tt = (row & 4095) >> 5;
            const size_t o = (size_t)row * 256 + c;
            const float y = yraw[o];
            const float mu = wave_sum(y) * (1.f / 64.f);
            const float d = y - mu;
            const float var = wave_sum(d * d) * (1.f / 64.f);
            const float yn = d * rsqrtf(var + GN_EPS) * gng + gnb;
            ymix[(size_t)row * DM + 512 + c] = f2bf((yn + bonus[o]) * gbuf[o]);
            const float hh = fmaf(cuma[o], hst[(size_t)(b * 128 + tt) * 256 + c], hloc[o]);
            const float gb = bf2f(P[(size_t)row * PIN + 768 + c]);
            ymix[(size_t)row * DM + 256 + c] = f2bf(hh * gelu_tanh(gb));
        }
    }
}

DEVINL void phaseD(KP p, int l, char* lds, const int dry = 0) {
    const int tid = TIDX(), nb = NBV(), blk = BIDX(), wid = tid >> 6, lane = tid & 63;
    constexpr int URS = 2064;
    char* uh = lds;
    char* ulo = lds + 16 * URS;
    float* logit = (float*)(lds + 32 * URS);
    int* sel_e = (int*)(lds + 32 * URS + 4096);
    int* lpos = sel_e + 512;
    int* hist = lpos + 512;
    int* basep = hist + 64;
    const bf16_t* wrt_hi = (const bf16_t*)(p->ws + OFF_WR) + (size_t)(l * 2 + 0) * 64 * 1024;
    const bf16_t* wrt_lo = (const bf16_t*)(p->ws + OFF_WR) + (size_t)(l * 2 + 1) * 64 * 1024;
    const float* xbuf = p->out;
    float* xout = dry ? (float*)(p->ws + A_P) : p->out;
    bf16_t* ubuf = (bf16_t*)(p->ws + (dry ? A_YMIX : OFF_UBUF));
    const float* mod = (const float*)(p->ws + OFF_MOD);
    const float* wr = p->in[I_WROUTER] + (size_t)l * 1024 * 64 + lane;
    const float ebias = p->in[I_EBIAS][l * 64 + lane];
    unsigned* cnt = (unsigned*)(p->ws + OFF_CNT) + l * 64 + (dry ? 256 : 0);
    int* list = (int*)(p->ws + (dry ? M_HBUF : M_LIST));
    float* wsel = (float*)(p->ws + (dry ? M_HBUF + 16777216 : M_WSEL));
    int* pmap = (int*)(p->ws + (dry ? M_HBUF + 33554432 : M_PMAP));
    for (int it = blk; it < 512; it += nb) {
        const int tok0 = it * 64;
        if (tid < 64) hist[tid] = 0;
        for (int sb = 0; sb < 4; ++sb) {
#pragma unroll
            for (int j = 0; j < 4; ++j) {
                const int tl = wid * 4 + j, row = tok0 + sb * 16 + tl, b = row >> 12;
                float4 z[4];
                float s = 0.f;
#pragma unroll
                for (int i = 0; i < 4; ++i) { z[i] = *(const float4*)(xbuf + (size_t)row * DM + i * 256 + lane * 4); s += z[i].x + z[i].y + z[i].z + z[i].w; }
                const float mean = wave_sum(s) * (1.f / 1024.f);
                float q = 0.f;
#pragma unroll
                for (int i = 0; i < 4; ++i) { z[i].x -= mean; z[i].y -= mean; z[i].z -= mean; z[i].w -= mean; q += z[i].x * z[i].x + z[i].y * z[i].y + z[i].z * z[i].z + z[i].w * z[i].w; }
                const float rs = rsqrtf(wave_sum(q) * (1.f / 1024.f) + LN_EPS);
#pragma unroll
                for (int i = 0; i < 4; ++i) {
                    const int col = i * 256 + lane * 4;
                    const float4 g = *(const float4*)(p->in[I_LN1G] + l * 1024 + col), bb = *(const float4*)(p->in[I_LN1B] + l * 1024 + col);
                    const float4 sh = *(const float4*)(mod + (size_t)(l * 8 + b) * 6144 + 3072 + col), sc = *(const float4*)(mod + (size_t)(l * 8 + b) * 6144 + 4096 + col);
                    float4 x1; x1.x = z[i].x * rs * g.x + bb.x; x1.y = z[i].y * rs * g.y + bb.y; x1.z = z[i].z * rs * g.z + bb.z; x1.w = z[i].w * rs * g.w + bb.w;
                    *(float4*)(xout + (size_t)row * DM + col) = x1;
                    float4 u; u.x = x1.x * (1.f + sc.x) + sh.x; u.y = x1.y * (1.f + sc.y) + sh.y; u.z = x1.z * (1.f + sc.z) + sh.z; u.w = x1.w * (1.f + sc.w) + sh.w;
                    uint2 o; o.x = pack2(u.x, u.y); o.y = pack2(u.z, u.w);
                    *(uint2*)(ubuf + (size_t)row * DM + col) = o;
                    *(uint2*)(uh + tl * URS + col * 2) = o;
                    uint2 o2; o2.x = pack2(u.x - __uint_as_float(o.x << 16), u.y - __uint_as_float(o.x & 0xFFFF0000u)); o2.y = pack2(u.z - __uint_as_float(o.y << 16), u.w - __uint_as_float(o.y & 0xFFFF0000u));
                    *(uint2*)(ulo + tl * URS + col * 2) = o2;
                }
            }
            __syncthreads();
            {
                const int fr = lane & 15, fq = lane >> 4;
                f32x4 lacc = (f32x4){0.f, 0.f, 0.f, 0.f};
                const bf16_t* bh = wrt_hi + (size_t)(wid * 16 + fr) * 1024 + fq * 8;
                const bf16_t* bl = wrt_lo + (size_t)(wid * 16 + fr) * 1024 + fq * 8;
#pragma unroll 1
                for (int k8 = 0; k8 < 4; ++k8) {
                    bf16x8 bhv[8], blv[8];
#pragma unroll
                    for (int kk = 0; kk < 8; ++kk) { bhv[kk] = *(const bf16x8*)(bh + (k8 * 8 + kk) * 32); blv[kk] = *(const bf16x8*)(bl + (k8 * 8 + kk) * 32); }
#pragma unroll
                    for (int kk = 0; kk < 8; ++kk) {
                        const int ko = (k8 * 8 + kk) * 64 + fq * 16;
                        const bf16x8 ah = *(const bf16x8*)(uh + fr * URS + ko), al = *(const bf16x8*)(ulo + fr * URS + ko);
                        lacc = __builtin_amdgcn_mfma_f32_16x16x32_bf16(ah, bhv[kk], lacc, 0, 0, 0);
                        lacc = __builtin_amdgcn_mfma_f32_16x16x32_bf16(al, bhv[kk], lacc, 0, 0, 0);
                        lacc = __builtin_amdgcn_mfma_f32_16x16x32_bf16(ah, blv[kk], lacc, 0, 0, 0);
                    }
                }
#pragma unroll
                for (int j = 0; j < 4; ++j) logit[(fq * 4 + j) * 64 + wid * 16 + fr] = lacc[j];
            }
            __syncthreads();
            float acc[4];
#pragma unroll
            for (int j = 0; j < 4; ++j) acc[j] = logit[(wid * 4 + j) * 64 + lane];
#pragma unroll
            for (int j = 0; j < 4; ++j) {
                const int tl = sb * 16 + wid * 4 + j;
                const float score = 1.f / (1.f + __expf(-acc[j]));
                const float biased = score + ebias;
                const float m1 = group8_max(biased);
                const unsigned long long eq = __ballot(biased == m1);
                const int g = lane >> 3;
                const unsigned gm = (unsigned)(eq >> (g * 8)) & 0xFFu;
                const int first = __ffs((int)gm) - 1;
                const float v2 = ((lane & 7) == first) ? -INFINITY : biased;
                const float m2 = group8_max(v2);
                const float gs = m1 + m2;
                int rg = 0;
#pragma unroll
                for (int g2 = 0; g2 < 8; ++g2) { const float o = __builtin_bit_cast(float, __builtin_amdgcn_readlane(__builtin_bit_cast(int, gs), g2 * 8)); rg += ((o > gs) || (o == gs && g2 < g)) ? 1 : 0; }
                const bool keep = rg < 4;
                const float mk = keep ? biased : -INFINITY;
                int rk = 0;
#pragma unroll
                for (int e2 = 0; e2 < 64; ++e2) { const float o = __builtin_bit_cast(float, __builtin_amdgcn_readlane(__builtin_bit_cast(int, mk), e2)); rk += ((o > mk) || (o == mk && e2 < lane)) ? 1 : 0; }
                const bool sel = keep && (rk < 8);
                const float ssum = wave_sum(sel ? score : 0.f);
                const float wgt = score / ssum * 2.5f;
                const unsigned long long sm = __ballot(sel);
                const int kidx = __popcll(sm & ((1ull << lane) - 1ull));
                if (sel) { wsel[(size_t)(tok0 + tl) * 8 + kidx] = wgt; sel_e[tl * 8 + kidx] = lane; }
            }
            __syncthreads();
        }
        for (int i = tid; i < 512; i += VTHREADS) lpos[i] = atomicAdd(&hist[sel_e[i]], 1);
        __syncthreads();
        if (tid < 64) basep[tid] = (int)atomicAdd(&cnt[tid], (unsigned)hist[tid]);
        __syncthreads();
        for (int i = tid; i < 512; i += VTHREADS) { const int e = sel_e[i], pos = basep[e] + lpos[i]; list[(size_t)e * NTOK + pos] = tok0 * 8 + i; pmap[tok0 * 8 + i] = (e << 16) | pos; }
        __syncthreads();
    }
}

DEVINL void phaseA(KP p, int l, char* lds) {
    const int tid = TID512(), c = blockIdx.x, G = gridDim.x;
    const char* ubuf = (const char*)(p->ws + OFF_UBUF);
    const char* Wt = (const char*)(p->ws + OFF_WIN) + (size_t)l * WIN_ROWS * 1024 * 2;
    bf16_t* P = (bf16_t*)(p->ws + A_P);
    auto sched = [&](int i, GUnit& u) -> bool {
        const long L = unit_linear(i, c, G); if (L >= 128 * 11) return false;
        const int Li = (int)L, sx = Li >> 9, w = (sx == 2) ? 3 : 4, rem = Li - (sx << 9), pm = rem / w, pn = sx * 4 + (rem - pm * w);
        u.A = ubuf + (size_t)pm * 256 * 2048; u.B = Wt + (size_t)pn * 256 * 2048; u.i0 = pm; u.i1 = pn; u.i2 = 0;
        return true;
    };
    auto epi = [&](f32x4 (&acc)[2][2][4][2], const GUnit& u, int wr, int wc, int fr, int fq) {
        asm volatile("" : "+v"(fr), "+v"(fq));
        const int row0 = u.i0 * 256 + wr * 64 + fr, col0 = u.i1 * 256 + wc * 32 + 8 * fq;
#pragma unroll
        for (int ai = 0; ai < 2; ++ai)
#pragma unroll
            for (int m = 0; m < 4; ++m) {
                bf16_t* rowp = P + (size_t)(row0 + ai * 128 + m * 16) * PIN + col0;
#pragma unroll
                for (int bj = 0; bj < 2; ++bj) {
                    if (col0 + bj * 128 < PIN) {
                        const f32x4 v0 = acc[ai][bj][m][0], v1 = acc[ai][bj][m][1];
                        *(uint4*)(rowp + bj * 128) = make_uint4(pack2(v0[0], v0[1]), pack2(v0[2], v0[3]), pack2(v1[0], v1[1]), pack2(v1[2], v1[3]));
                    }
                }
            }
    };
    gemm256<true, false>(lds, 1024, 1024, sched, epi);
}

DEVINL void phaseC(KP p, int l, char* lds) {
    const int tid = TID512(), c = blockIdx.x, G = gridDim.x;
    const char* ymix = (const char*)(p->ws + A_YMIX);
    const char* Wt = (const char*)(p->ws + OFF_WOUT) + (size_t)l * 1024 * 1024 * 2;
    const float* res = (l == 0) ? p->in[I_X] : p->out;
    float* xbuf = p->out;
    const float* mod = (const float*)(p->ws + OFF_MOD);
    auto sched = [&](int i, GUnit& u) -> bool {
        const long L = unit_linear(i, c, G); if (L >= 128 * 4) return false;
        const int pm = (int)L >> 2, pn = (int)L & 3;
        u.A = ymix + (size_t)pm * 256 * 2048; u.B = Wt + (size_t)pn * 256 * 2048; u.i0 = pm; u.i1 = pn; u.i2 = 0;
        return true;
    };
    auto epi = [&](f32x4 (&acc)[2][2][4][2], const GUnit& u, int wr, int wc, int fr, int fq) {
        asm volatile("" : "+v"(fr), "+v"(fq));
        const int row0 = u.i0 * 256 + wr * 64 + fr, col0 = u.i1 * 256 + wc * 32 + 4 * fq;
#pragma unroll
        for (int ai = 0; ai < 2; ++ai)
#pragma unroll
            for (int m = 0; m < 4; ++m) {
                const int row = row0 + ai * 128 + m * 16, b = row >> 12;
#pragma unroll
                for (int bj = 0; bj < 2; ++bj)
#pragma unroll
                    for (int n = 0; n < 2; ++n) {
                        const int col = col0 + bj * 128 + n * 16;
                        const float4 g1 = *(const float4*)(mod + (size_t)(l * 8 + b) * 6144 + 2048 + col);
                        const float4 rx = *(const float4*)(res + (size_t)row * DM + col);
                        const f32x4 a = acc[ai][bj][m][n];
                        float4 z;
                        z.x = ALPHA * rx.x + (1.f + g1.x) * a[0]; z.y = ALPHA * rx.y + (1.f + g1.y) * a[1];
                        z.z = ALPHA * rx.z + (1.f + g1.z) * a[2]; z.w = ALPHA * rx.w + (1.f + g1.w) * a[3];
                        *(float4*)(xbuf + (size_t)row * DM + col) = z;
                    }
            }
    };
    gemm256<false, false>(lds, 1024, 1024, sched, epi);
}

constexpr int DIR_OFF = 131072;
DEVINL void moe_directory(KP p, int l, char* lds) {
    int* pref = (int*)(lds + DIR_OFF);
    int* cntl = (int*)(lds + DIR_OFF + 512);
    unsigned* cnt = (unsigned*)(p->ws + OFF_CNT) + l * 64;
    asm volatile("" : "+s"(cnt));
    if (threadIdx.x == 0) {
        int s = 0;
        int* xpre = (int*)(lds + DIR_OFF + 1024);
        int x = 0;
        for (int e = 0; e < 64; ++e) { const int c = (int)__hip_atomic_load(&cnt[e], __ATOMIC_RELAXED, __HIP_MEMORY_SCOPE_AGENT); cntl[e] = c; pref[e] = s; s += (c + 255) >> 8; xpre[e] = x; x += c; }
        pref[64] = s; cntl[64] = NTOK; pref[65] = s + 128; xpre[64] = x;
    }
    __syncthreads();
}

DEVINL void phaseE1(KP p, int l, char* lds) {
    const int tid = TID512(), c = blockIdx.x, G = gridDim.x;
    moe_directory(p, l, lds);
    const int* pref = (const int*)(lds + DIR_OFF); const int* cntl = (const int*)(lds + DIR_OFF + 512);
    const char* ubuf = (const char*)(p->ws + OFF_UBUF);
    const int* list = (const int*)(p->ws + M_LIST);
    bf16_t* hbuf = (bf16_t*)(p->ws + M_HBUF);
    const char* W13 = (const char*)(p->ws + OFF_W13) + (size_t)(l * 65) * 512 * 1024 * 2;
    const int total = __builtin_amdgcn_readfirstlane(pref[65]) * 2;
    auto sched = [&](int i, GUnit& u) -> bool {
        const long L = unit_linear(i, c, G); if (L >= total) return false;
        const int mg = (int)L >> 1, nt = (int)L & 1;
        int e = 0; while (pref[e + 1] <= mg) ++e;
        e = __builtin_amdgcn_readfirstlane(e);
        const int mt = __builtin_amdgcn_readfirstlane(mg - pref[e]), Me = __builtin_amdgcn_readfirstlane(cntl[e]);
        u.A = ubuf; u.B = W13 + ((size_t)e * 512 + nt * 256) * 2048; u.i0 = mg; u.i1 = nt; u.i2 = e;
        int R[2], C[2]; stage_coords512(TID512(), R, C);
#pragma unroll
        for (int h = 0; h < 2; ++h)
#pragma unroll
            for (int i2 = 0; i2 < 2; ++i2) {
                const int idx = mt * 256 + h * 128 + R[i2]; int tok;
                if (e < 64) tok = (idx < Me) ? (list[(size_t)e * NTOK + idx] >> 3) : 0; else tok = idx;
                u.va[h][i2] = (unsigned)(tok * 1024 + C[i2]) * 2u;
            }
        return true;
    };
    auto epi = [&](f32x4 (&acc)[2][2][4][2], const GUnit& u, int wr, int wc, int fr, int fq) {
        asm volatile("" : "+v"(fr), "+v"(fq));
        const size_t row0 = (size_t)u.i0 * 256 + wr * 64 + fr;
#pragma unroll
        for (int ai = 0; ai < 2; ++ai)
#pragma unroll
            for (int m = 0; m < 4; ++m) {
                bf16_t* rowp = hbuf + (row0 + ai * 128 + m * 16) * 256;
#pragma unroll
                for (int bj = 0; bj < 2; ++bj) {
                    const int hcol = (u.i1 * 8 + bj * 4 + wc) * 16 + 4 * fq;
                    const f32x4 gt = acc[ai][bj][m][0], up = acc[ai][bj][m][1];
                    float hv[4];
#pragma unroll
                    for (int j = 0; j < 4; ++j) hv[j] = gt[j] * sigm(gt[j]) * up[j];
                    uint2 o; o.x = pack2(hv[0], hv[1]); o.y = pack2(hv[2], hv[3]);
                    *(uint2*)(rowp + hcol) = o;
                }
            }
    };
    gemm256<false, true>(lds, 1024, 1024, sched, epi);
}

DEVINL void phaseE2(KP p, int l, char* lds) {
    const int tid = TID512(), c = blockIdx.x, G = gridDim.x;
    moe_directory(p, l, lds);
    const int* pref = (const int*)(lds + DIR_OFF); const int* cntl = (const int*)(lds + DIR_OFF + 512);
    const int* xpre = (const int*)(lds + DIR_OFF + 1024);
    const char* hbuf = (const char*)(p->ws + M_HBUF);
    bf16_t* ybuf = (bf16_t*)(p->ws + M_YBUF);
    const char* W2 = (const char*)(p->ws + OFF_W2) + (size_t)(l * 65) * 1024 * 256 * 2;
    const int total = __builtin_amdgcn_readfirstlane(pref[65]) * 4;
    auto sched = [&](int i, GUnit& u) -> bool {
        const long L = unit_linear(i, c, G); if (L >= total) return false;
        const int mg = (int)L >> 2, nt = (int)L & 3;
        int e = 0; while (pref[e + 1] <= mg) ++e;
        e = __builtin_amdgcn_readfirstlane(e);
        u.A = hbuf + (size_t)mg * 256 * 512; u.B = W2 + ((size_t)e * 1024 + nt * 256) * 512; u.i0 = mg; u.i1 = nt; u.i2 = e;
        return true;
    };
    auto epi = [&](f32x4 (&acc)[2][2][4][2], const GUnit& u, int wr, int wc, int fr, int fq) {
        asm volatile("" : "+v"(fr), "+v"(fq));
        const int e = __builtin_amdgcn_readfirstlane(u.i2), mt = __builtin_amdgcn_readfirstlane(u.i0 - pref[e]), Me = __builtin_amdgcn_readfirstlane(cntl[e]);
        const int yrow0 = __builtin_amdgcn_readfirstlane(xpre[e]) + mt * 256;
        const int col0 = u.i1 * 256 + wc * 32 + 8 * fq, loc0 = wr * 64 + fr;
#pragma unroll
        for (int ai = 0; ai < 2; ++ai)
#pragma unroll
            for (int m = 0; m < 4; ++m) {
                const int loc = loc0 + ai * 128 + m * 16;
                if (mt * 256 + loc < Me) {
                    bf16_t* rowp = ybuf + (size_t)(yrow0 + loc) * 1024 + col0;
#pragma unroll
                    for (int bj = 0; bj < 2; ++bj) {
                        const f32x4 v0 = acc[ai][bj][m][0], v1 = acc[ai][bj][m][1];
                        *(uint4*)(rowp + bj * 128) = make_uint4(pack2(v0[0], v0[1]), pack2(v0[2], v0[3]), pack2(v1[0], v1[1]), pack2(v1[2], v1[3]));
                    }
                }
            }
    };
    gemm256<true, false>(lds, 256, 256, sched, epi);
}

DEVINL void phaseF(KP p, int l, const int dry = 0) {
    const int tid = TIDX(), nb = NBV(), blk = BIDX(), wid = tid >> 6, lane = tid & 63;
    const float* xbuf = p->out;
    float* xout = dry ? (float*)(p->ws + M_HBUF) : p->out;
    const bf16_t* ybuf = (const bf16_t*)(p->ws + M_YBUF);
    bf16_t* ubuf = (bf16_t*)(p->ws + OFF_UBUF);
    const float* mod = (const float*)(p->ws + OFF_MOD);
    const int* pmap = (const int*)(p->ws + M_PMAP); const float* wsel = (const float*)(p->ws + M_WSEL);
    int xoff;
    {
        const unsigned* cnt = (const unsigned*)(p->ws + OFF_CNT) + l * 64;
        const int c = (int)__hip_atomic_load(&cnt[lane], __ATOMIC_RELAXED, __HIP_MEMORY_SCOPE_AGENT);
        xoff = 0;
#pragma unroll
        for (int j = 0; j < 64; ++j) { const int cj = __builtin_amdgcn_readlane(c, j); xoff += (j < lane) ? cj : 0; }
    }
    for (int row = blk * 4 + wid; row < NTOK; row += nb * 4) {
        const int b = row >> 12;
        int yr = 0; float yw = 0.f;
        if (lane < 8) { const int pm = pmap[row * 8 + lane]; yr = pm; yw = wsel[row * 8 + lane]; }
        { const int e = (yr >> 16) & 63; const int xo = __builtin_amdgcn_ds_bpermute(e << 2, xoff); yr = xo + (yr & 0xFFFF); }
        int yrow[8]; float yww[8];
#pragma unroll
        for (int k = 0; k < 8; ++k) { yrow[k] = __builtin_amdgcn_readlane(yr, k); yww[k] = __builtin_bit_cast(float, __builtin_amdgcn_readlane(__builtin_bit_cast(int, yw), k)); }
        float4 z[4]; float s = 0.f;
#pragma unroll
        for (int i = 0; i < 4; ++i) {
            const int col = i * 256 + lane * 4;
            const float4 x1 = *(const float4*)(xbuf + (size_t)row * DM + col);
            float f0, f1, f2, f3;
            { const uint2 yv = *(const uint2*)(ybuf + ((size_t)(262144 + row)) * 1024 + col);
              f0 = __uint_as_float(yv.x << 16); f1 = __uint_as_float(yv.x & 0xFFFF0000u); f2 = __uint_as_float(yv.y << 16); f3 = __uint_as_float(yv.y & 0xFFFF0000u); }
#pragma unroll
            for (int k = 0; k < 8; ++k) {
                const uint2 yv = *(const uint2*)(ybuf + (size_t)yrow[k] * 1024 + col);
                const float w = yww[k];
                f0 = fmaf(w, __uint_as_float(yv.x << 16), f0); f1 = fmaf(w, __uint_as_float(yv.x & 0xFFFF0000u), f1); f2 = fmaf(w, __uint_as_float(yv.y << 16), f2); f3 = fmaf(w, __uint_as_float(yv.y & 0xFFFF0000u), f3);
            }
            const float4 g2 = *(const float4*)(mod + (size_t)(l * 8 + b) * 6144 + 5120 + col);
            z[i].x = ALPHA * x1.x + (1.f + g2.x) * f0; z[i].y = ALPHA * x1.y + (1.f + g2.y) * f1; z[i].z = ALPHA * x1.z + (1.f + g2.z) * f2; z[i].w = ALPHA * x1.w + (1.f + g2.w) * f3;
            s += z[i].x + z[i].y + z[i].z + z[i].w;
        }
        const float mean = wave_sum(s) * (1.f / 1024.f);
        float q = 0.f;
#pragma unroll
        for (int i = 0; i < 4; ++i) { z[i].x -= mean; z[i].y -= mean; z[i].z -= mean; z[i].w -= mean; q += z[i].x * z[i].x + z[i].y * z[i].y + z[i].z * z[i].z + z[i].w * z[i].w; }
        const float rs = rsqrtf(wave_sum(q) * (1.f / 1024.f) + LN_EPS);
#pragma unroll
        for (int i = 0; i < 4; ++i) {
            const int col = i * 256 + lane * 4;
            const float4 g = *(const float4*)(p->in[I_LN2G] + l * 1024 + col), bb = *(const float4*)(p->in[I_LN2B] + l * 1024 + col);
            float4 x2; x2.x = z[i].x * rs * g.x + bb.x; x2.y = z[i].y * rs * g.y + bb.y; x2.z = z[i].z * rs * g.z + bb.z; x2.w = z[i].w * rs * g.w + bb.w;
            *(float4*)(xout + (size_t)row * DM + col) = x2;
            if (l + 1 < DEPTH) {
                const float4 sh = *(const float4*)(mod + (size_t)((l + 1) * 8 + b) * 6144 + col), sc = *(const float4*)(mod + (size_t)((l + 1) * 8 + b) * 6144 + 1024 + col);
                uint2 o; o.x = pack2(x2.x * (1.f + sc.x) + sh.x, x2.y * (1.f + sc.y) + sh.y); o.y = pack2(x2.z * (1.f + sc.z) + sh.z, x2.w * (1.f + sc.w) + sh.w);
                *(uint2*)(ubuf + (size_t)row * DM + col) = o;
            }
        }
    }
}

#define XB_TMO      128
#define XB_XCNT(j)  (256  + 64 * (j))
#define XB_XSUB(j)  (1280 + 64 * (j))
#define XB_XGEN(j)  (2304 + 64 * (j))
#define XB_TOP      3328
#define XB_TOPGEN   3392
#define XCD_BAR_WORDS 3456
#define XB_SPIN_CAP (1u << 20)
DEVINL unsigned xb_ld(unsigned* p)              { return __hip_atomic_load(p, __ATOMIC_RELAXED, __HIP_MEMORY_SCOPE_AGENT); }
DEVINL unsigned xb_add(unsigned* p, unsigned v) { return __hip_atomic_fetch_add(p, v, __ATOMIC_RELAXED, __HIP_MEMORY_SCOPE_AGENT); }
DEVINL unsigned xb_xcc_id() { return (unsigned)__builtin_amdgcn_s_getreg((3 << 11) | 20) & 0xFu; }
#define XB_SPIN(cond, bar) do { unsigned _sp = 0; while (cond) { __builtin_amdgcn_s_sleep(1); \
    if ((++_sp & 255u) == 0u) { if (xb_ld(&(bar)[XB_TMO])) break; if (_sp > XB_SPIN_CAP) { atomicAdd(&(bar)[XB_TMO], 1u); break; } } } } while (0)
struct XcdBarrier { unsigned* bar; unsigned x; volatile LAS unsigned* st; };
DEVINL XcdBarrier xcd_barrier_post(unsigned* bar, volatile LAS unsigned* st) {
    XcdBarrier b; b.bar = bar; b.x = xb_xcc_id(); b.st = st;
    if (threadIdx.x == 0) (void)xb_add(&bar[XB_XCNT(b.x)], 1u);
    return b;
}
DEVINL void xcd_barrier_complete(unsigned* bar, unsigned x, unsigned& nloc, unsigned& nx) {
    const unsigned G = gridDim.x * gridDim.y * gridDim.z;
    unsigned sum, cnt, mine, sp = 0u;
    for (;;) {
        sum = 0u; cnt = 0u; mine = 0u;
#pragma unroll 1
        for (unsigned j = 0; j < 16; ++j) { const unsigned c = xb_ld(&bar[XB_XCNT(j)]); sum += c; cnt += (c > 0u) ? 1u : 0u; mine = (j == x) ? c : mine; }
        if (sum == G) break;
        __builtin_amdgcn_s_sleep(1);
        if ((++sp & 255u) == 0u) { if (xb_ld(&bar[XB_TMO])) break; if (sp > XB_SPIN_CAP) { atomicAdd(&bar[XB_TMO], 1u); break; } }
    }
    nloc = mine > 0u ? mine : 1u; nx = cnt > 0u ? cnt : 1u;
}
DEVINL void xcd_barrier(const XcdBarrier& b) {
    asm volatile("s_waitcnt vmcnt(0)" ::: "memory");
    __syncthreads();
    if (threadIdx.x == 0) {
        unsigned* bar = b.bar;
        __builtin_amdgcn_s_waitcnt(0);
        unsigned nloc = b.st[0], nx = b.st[1];
        if (nloc == 0u) { xcd_barrier_complete(bar, b.x, nloc, nx); b.st[0] = nloc; b.st[1] = nx; }
        const unsigned old = xb_add(&bar[XB_XSUB(b.x)], 1u);
        const unsigned gen = old / nloc;
        if (old + 1u == (gen + 1u) * nloc) {
            __builtin_amdgcn_fence(__ATOMIC_RELEASE, "agent");
            asm volatile("s_waitcnt vmcnt(0)" ::: "memory");
            const unsigned og = xb_add(&bar[XB_TOP], 1u);
            const unsigned tg = og / nx;
            if (og + 1u == (tg + 1u) * nx) xb_add(&bar[XB_TOPGEN], 1u);
            else XB_SPIN(xb_ld(&bar[XB_TOPGEN]) == tg, bar);
            __builtin_amdgcn_fence(__ATOMIC_ACQUIRE, "agent");
            xb_add(&bar[XB_XGEN(b.x)], 1u);
            asm volatile("s_waitcnt vmcnt(0)" ::: "memory");
        } else {
            XB_SPIN(xb_ld(&bar[XB_XGEN(b.x)]) == gen, bar);
            __builtin_amdgcn_fence(__ATOMIC_ACQUIRE, "agent");
            asm volatile("s_waitcnt vmcnt(0)" ::: "memory");
        }
    }
    __syncthreads();
}

constexpr int PPL = 12;
constexpr int NPHASE = 2 + PPL * DEPTH;
#ifndef PROBE_SUB
#define PROBE_SUB 3
#endif
#ifndef PROBE_REP
#define PROBE_REP (-1)
#endif
__global__ void __launch_bounds__(NTHREADS, 2) mega(Params p_arg, int ph_lo, int ph_hi) {
    extern __shared__ __attribute__((aligned(16))) char lds[];
    cg::grid_group grid = cg::this_grid();
    volatile LAS unsigned* st = (volatile LAS unsigned*)(lds + LDS_BYTES - 16);
    if (threadIdx.x == 0) { st[0] = 0u; st[1] = 0u; }
    __syncthreads();
    XcdBarrier xb = xcd_barrier_post((unsigned*)(p_arg.ws + OFF_BAR), st);
    for (int ph = ph_lo; ph < ph_hi; ++ph) {
        KP p = (KP)__builtin_amdgcn_kernarg_segment_ptr();
        asm volatile("" : "+s"(p));
        const int l = (ph >= 2) ? (ph - 2) / PPL : 0;
        const int q = (ph >= 2) ? (ph - 2) % PPL : -1;
        const bool nobar = (q >= 1 && q <= 3);
        const int nrep = (ph == PROBE_REP) ? 2 : 1;
        for (int rep = 0; rep < nrep; ++rep) {
            const int dry = (ph == PROBE_REP && rep == 0) ? 1 : 0;
            char* ldsh = lds + (threadIdx.x >> 8) * LDS_HALF;
            if (ph == 0) phase0(p, ldsh);
            else if (ph == 1) phaseF0(p);
            else {
                switch (q) {
                    case 0: phaseA(p, l, lds); break;
                    case 1: phaseB1(p, l, ldsh, 1, (ph == PROBE_REP && rep == 1) ? PROBE_SUB : 3); break;
                    case 2: phaseB1(p, l, ldsh, 2); break;
                    case 3: phaseB1(p, l, ldsh, 4); break;
                    case 4: phaseB1(p, l, ldsh, 8); break;
                    case 5: phaseB2(p, l); break;
                    case 6: phaseB3(p, l); break;
                    case 7: phaseC(p, l, lds); break;
                    case 8: phaseD(p, l, ldsh, dry); break;
                    case 9: phaseE1(p, l, lds); break;
                    case 10: phaseE2(p, l, lds); break;
                    default: phaseF(p, l, dry); break;
                }
            }
            const bool lastrep = (rep + 1 == nrep);
            if (!lastrep || (ph + 1 < ph_hi && !nobar)) { if (lastrep && ph == ph_lo) grid.sync(); else xcd_barrier(xb); }
        }
    }
}

extern "C" void kernel_launch(void* const* d_in, const int* in_sizes, int n_in, void* d_out, int out_size, void* d_ws, size_t ws_size, hipStream_t stream) {
    static int grid_blocks = 0;
    if (grid_blocks == 0) {
        if (n_in != 39 || out_size != NTOK * DM || ws_size < WS_NEED) { fprintf(stderr, "kernel_launch: unexpected shapes (n_in %d out %d ws %zu need %zu)\n", n_in, out_size, ws_size, (size_t)WS_NEED); grid_blocks = -1; return; }
        int dev = 0, cus = 0, per_cu = 0;
        hipGetDevice(&dev);
        hipDeviceGetAttribute(&cus, hipDeviceAttributeMultiprocessorCount, dev);
        hipFuncSetAttribute((const void*)mega, hipFuncAttributeMaxDynamicSharedMemorySize, LDS_BYTES);
        hipOccupancyMaxActiveBlocksPerMultiprocessor(&per_cu, (const void*)mega, NTHREADS, LDS_BYTES);
        if (per_cu < 1) { fprintf(stderr, "kernel_launch: occupancy query returned %d\n", per_cu); grid_blocks = -1; return; }
        if (cus < 256) { fprintf(stderr, "kernel_launch: this build needs 256 CUs (found %d)\n", cus); grid_blocks = -1; return; }
        grid_blocks = 256;
    }
    if (grid_blocks < 0) return;
    if (hipMemsetAsync(d_ws, 0, 32768, stream) != hipSuccess) { fprintf(stderr, "kernel_launch: memset failed\n"); return; }
    Params p{};
    for (int i = 0; i < 39; ++i) p.in[i] = (const float*)d_in[i];
    p.out = (float*)d_out; p.ws = (unsigned char*)d_ws;
    int ph_lo = 0, ph_hi = NPHASE;
    void* args[] = {&p, &ph_lo, &ph_hi};
    hipError_t e = hipLaunchCooperativeKernel((const void*)mega, dim3(grid_blocks), dim3(NTHREADS), args, LDS_BYTES, stream);
    if (e != hipSuccess) fprintf(stderr, "cooperative launch failed: %s (grid %d)\n", hipGetErrorString(e), grid_blocks);
}
```

```cpp
#include <hip/hip_runtime.h>
#include <hip/hip_cooperative_groups.h>
#include <stdio.h>
#include <stdint.h>
namespace cg = cooperative_groups;

typedef unsigned short bf16_t;
typedef short bf16x8 __attribute__((ext_vector_type(8)));
typedef float f32x4 __attribute__((ext_vector_type(4)));
#define DEVINL __device__ __forceinline__
#define LAS __attribute__((address_space(3)))

constexpr int NTOK = 32768, SEQ = 4096, NBATCH = 8, DM = 1024, PIN = 2688, DEPTH = 2;
constexpr int NEXP = 64;
constexpr float ALPHA = 1.41421356237f;
constexpr float LN_EPS = 1e-5f, GN_EPS = 64e-5f;
constexpr int NTHREADS = 512;
constexpr int VTHREADS = 256;
constexpr int LDS_HALF = 75776;
constexpr int LDS_BYTES = 152064;

constexpr size_t OFF_CNT   = 0;
constexpr size_t OFF_BAR   = 4096;
constexpr size_t OFF_MOD   = 65536;
constexpr size_t OFF_WR    = 524288;
constexpr size_t OFF_WIN   = 1048576;
constexpr int WIN_ROWS = 2816;
constexpr size_t OFF_WOUT  = OFF_WIN + 2 * (size_t)WIN_ROWS * 1024 * 2;
constexpr size_t OFF_W13   = OFF_WOUT + 4194304;
constexpr size_t OFF_W2    = OFF_W13 + 136314880;
constexpr size_t OFF_UBUF  = OFF_W2 + 68157440;
constexpr size_t OFF_ARENA = OFF_UBUF + 67108864;
constexpr size_t A_P      = OFF_ARENA;
constexpr size_t A_YMIX   = A_P + 176160768;
constexpr size_t A_SCAN   = A_YMIX + 67108864;
constexpr size_t A_HLOC   = A_SCAN + 134217728;
constexpr size_t A_CUMA   = A_HLOC + 33554432;
constexpr size_t A_G      = A_CUMA + 33554432;
constexpr size_t A_BONUS  = A_G + 33554432;
constexpr size_t A_YRAW   = A_BONUS + 33554432;
constexpr size_t A_CARRYA = A_YRAW + 33554432;
constexpr size_t A_CARRYH = A_CARRYA + 1048576;
constexpr size_t A_HSTART = A_CARRYH + 1048576;
constexpr size_t A_CHAIN  = A_HSTART + 1048576;
constexpr size_t CHAIN_UNIT = 49152;
constexpr size_t M_YBUF   = OFF_ARENA;
constexpr size_t M_HBUF   = M_YBUF + 603979776;
constexpr size_t M_LIST   = M_HBUF + 159383552;
constexpr size_t M_WSEL   = M_LIST + 8388608;
constexpr size_t M_PMAP   = M_WSEL + 1048576;
constexpr size_t WS_NEED  = M_PMAP + 1048576;

struct Params {
    const float* in[39];
    float* out;
    unsigned char* ws;
};
typedef const __attribute__((address_space(4))) Params* KP;
__device__ __forceinline__ int TIDX() { int t = threadIdx.x; asm volatile("" : "+v"(t)); t &= 255; return t; }
__device__ __forceinline__ int BIDX() { int b = blockIdx.x * 2 + __builtin_amdgcn_readfirstlane((int)(threadIdx.x >> 8)); asm volatile("" : "+s"(b)); __builtin_assume(b >= 0 && b < 65536); return b; }
__device__ __forceinline__ int NBV() { return gridDim.x * 2; }
__device__ __forceinline__ int TID512() { int t = threadIdx.x; asm volatile("" : "+v"(t)); __builtin_assume(t >= 0 && t < 512); return t; }
enum { I_X = 0, I_C, I_WMOD, I_BMOD, I_WIN, I_WOUT, I_CONVA, I_CONVAB, I_LNAG, I_LNAB, I_CONVB, I_CONVBB, I_WRG, I_BRG, I_WIG, I_BIG,
       I_LAMBDA, I_MUC, I_W0, I_WW2, I_A0, I_WA2, I_WG2, I_KK, I_KA, I_RK, I_GNG, I_GNB, I_CONVD, I_LN1G, I_LN1B, I_WROUTER, I_EBIAS,
       I_W13, I_W2, I_WS13, I_WS2, I_LN2G, I_LN2B };

DEVINL bf16_t f2bf(float f) { unsigned u = __float_as_uint(f); u += 0x7FFFu + ((u >> 16) & 1u); return (bf16_t)(u >> 16); }
DEVINL float bf2f(bf16_t h) { return __uint_as_float(((unsigned)h) << 16); }
typedef __bf16 bf2_t __attribute__((ext_vector_type(2)));
typedef float f2_t __attribute__((ext_vector_type(2)));
typedef float f32x16 __attribute__((ext_vector_type(16)));
DEVINL unsigned pack2(float a, float b) { f2_t v = {a, b}; return __builtin_bit_cast(unsigned, __builtin_convertvector(v, bf2_t)); }
DEVINL float sigm(float x) { return 1.f / (1.f + __expf(-x)); }
DEVINL float tanh_fast(float x) { const float e = __expf(2.f * x); return 1.f - 2.f / (1.f + e); }
DEVINL float softplusf(float z) { return fmaxf(z, 0.f) + __logf(1.f + __expf(-fabsf(z))); }
DEVINL float softplus_acc(float z) { return fmaxf(z, 0.f) + log1pf(__expf(-fabsf(z))); }
DEVINL float gelu_tanh(float x) { float u = 0.7978845608028654f * (x + 0.044715f * x * x * x); return 0.5f * x * (1.f + tanh_fast(u)); }
DEVINL float group8_max(float x) {
    x = fmaxf(x, __builtin_bit_cast(float, __builtin_amdgcn_update_dpp(0, __builtin_bit_cast(int, x), 0xB1, 0xf, 0xf, true)));
    x = fmaxf(x, __builtin_bit_cast(float, __builtin_amdgcn_update_dpp(0, __builtin_bit_cast(int, x), 0x4E, 0xf, 0xf, true)));
    x = fmaxf(x, __builtin_bit_cast(float, __builtin_amdgcn_update_dpp(0, __builtin_bit_cast(int, x), 0x141, 0xf, 0xf, true)));
    return x;
}
DEVINL float wave_sum_dpp(float x);
DEVINL float wave_sum(float x) { return wave_sum_dpp(x); }
DEVINL float wave_sum_dpp(float x) {
    x += __builtin_bit_cast(float, __builtin_amdgcn_update_dpp(0, __builtin_bit_cast(int, x), 0xB1, 0xf, 0xf, true));
    x += __builtin_bit_cast(float, __builtin_amdgcn_update_dpp(0, __builtin_bit_cast(int, x), 0x4E, 0xf, 0xf, true));
    x += __builtin_bit_cast(float, __builtin_amdgcn_update_dpp(0, __builtin_bit_cast(int, x), 0x141, 0xf, 0xf, true));
    x += __builtin_bit_cast(float, __builtin_amdgcn_update_dpp(0, __builtin_bit_cast(int, x), 0x140, 0xf, 0xf, true));
    x += __builtin_bit_cast(float, __builtin_amdgcn_update_dpp(0, __builtin_bit_cast(int, x), 0x142, 0xa, 0xf, false));
    x += __builtin_bit_cast(float, __builtin_amdgcn_update_dpp(0, __builtin_bit_cast(int, x), 0x143, 0xc, 0xf, false));
    return __builtin_bit_cast(float, __builtin_amdgcn_readlane(__builtin_bit_cast(int, x), 63));
}

DEVINL int lds_byte(int r, int c) { int st = (r >> 4) * 2 + (c >> 5), rr = r & 15, cc = c & 31, ob = rr * 64 + cc * 2; return st * 1024 + (ob ^ (((ob >> 9) & 1) << 5)); }
DEVINL void stage_rc(int b, int& R, int& C) { int st = b / 1024, sb = b % 1024, swz = sb ^ (((sb >> 9) & 1) << 5); R = (st >> 1) * 16 + swz / 64; C = (st & 1) * 32 + (swz % 64) / 2; }

template <class RowPtr, class Epi>
DEVINL void gemm_tile128(char* lds, RowPtr arow, const bf16_t* Bt, int K, Epi epi) {
    const int tid = TIDX();
    const bf16_t* ap[4]; const bf16_t* bp[4];
#pragma unroll
    for (int i = 0; i < 4; ++i) { int R, C; stage_rc(tid * 16 + i * 4096, R, C); ap[i] = arow(R) + C; bp[i] = Bt + (size_t)R * K + C; }
    const int wid = tid >> 6, lane = tid & 63, wr = wid >> 1, wc = wid & 1, fr = lane & 15, fq = lane >> 4;
    f32x4 acc[4][4];
#pragma unroll
    for (int m = 0; m < 4; ++m)
#pragma unroll
        for (int n = 0; n < 4; ++n) acc[m][n] = (f32x4){0.f, 0.f, 0.f, 0.f};
    const int nk = K >> 6;
#pragma unroll
    for (int i = 0; i < 4; ++i) {
        __builtin_amdgcn_global_load_lds((const unsigned*)(ap[i]), (unsigned*)(lds + tid * 16 + i * 4096), 16, 0, 0);
        __builtin_amdgcn_global_load_lds((const unsigned*)(bp[i]), (unsigned*)(lds + 16384 + tid * 16 + i * 4096), 16, 0, 0);
    }
    for (int kt = 0; kt < nk; ++kt) {
        asm volatile("s_waitcnt vmcnt(0)" ::: "memory");
        __syncthreads();
        char* cur = lds + (kt & 1) * 32768;
        if (kt + 1 < nk) {
            char* nxt = lds + ((kt + 1) & 1) * 32768;
            const int ko = (kt + 1) * 64;
#pragma unroll
            for (int i = 0; i < 4; ++i) {
                __builtin_amdgcn_global_load_lds((const unsigned*)(ap[i] + ko), (unsigned*)(nxt + tid * 16 + i * 4096), 16, 0, 0);
                __builtin_amdgcn_global_load_lds((const unsigned*)(bp[i] + ko), (unsigned*)(nxt + 16384 + tid * 16 + i * 4096), 16, 0, 0);
            }
        }
        bf16x8 af[4][2], bfr[4][2];
#pragma unroll
        for (int m = 0; m < 4; ++m)
#pragma unroll
            for (int kk = 0; kk < 2; ++kk) af[m][kk] = *reinterpret_cast<const bf16x8*>(cur + lds_byte(wr * 64 + m * 16 + fr, kk * 32 + fq * 8));
#pragma unroll
        for (int n = 0; n < 4; ++n)
#pragma unroll
            for (int kk = 0; kk < 2; ++kk) bfr[n][kk] = *reinterpret_cast<const bf16x8*>(cur + 16384 + lds_byte(wc * 64 + n * 16 + fr, kk * 32 + fq * 8));
#pragma unroll
        for (int kk = 0; kk < 2; ++kk)
#pragma unroll
            for (int m = 0; m < 4; ++m)
#pragma unroll
                for (int n = 0; n < 4; ++n) acc[m][n] = __builtin_amdgcn_mfma_f32_16x16x32_bf16(bfr[n][kk], af[m][kk], acc[m][n], 0, 0, 0);
    }
    __syncthreads();
    epi(acc, wr, wc, fr, fq);
}

template <class Ptrs, class Epi>
DEVINL void gemm_stream128(char* lds, int K, int blk, int nb, int total, Ptrs ptrs, Epi epi) {
    const int qx = nb >> 3, first = (blk & 7) * qx + (blk >> 3), stride = nb;
    if (first >= total) return;
    const int tid = TIDX();
    const int wid = tid >> 6, lane = tid & 63, wr = wid >> 1, wc = wid & 1, fr = lane & 15, fq = lane >> 4;
    const int nk = K >> 6;
    const bf16_t* ap[4]; const bf16_t* bp[4];
    const bf16_t* an[4]; const bf16_t* bn[4];
    int t = first;
    ptrs(t, ap, bp);
#pragma unroll
    for (int i = 0; i < 4; ++i) {
        __builtin_amdgcn_global_load_lds((const unsigned*)(ap[i]), (unsigned*)(lds + tid * 16 + i * 4096), 16, 0, 0);
        __builtin_amdgcn_global_load_lds((const unsigned*)(bp[i]), (unsigned*)(lds + 16384 + tid * 16 + i * 4096), 16, 0, 0);
    }
    for (;;) {
        const int tn = t + stride;
        const bool has_next = tn < total;
        if (has_next) ptrs(tn, an, bn);
        f32x4 acc[4][4];
#pragma unroll
        for (int m = 0; m < 4; ++m)
#pragma unroll
            for (int n = 0; n < 4; ++n) acc[m][n] = (f32x4){0.f, 0.f, 0.f, 0.f};
        for (int kt = 0; kt < nk; ++kt) {
            asm volatile("s_waitcnt vmcnt(0)" ::: "memory");
            __syncthreads();
            char* cur = lds + (kt & 1) * 32768;
            if (kt + 1 < nk) {
                char* nxt = lds + ((kt + 1) & 1) * 32768;
                const int ko = (kt + 1) * 64;
#pragma unroll
                for (int i = 0; i < 4; ++i) {
                    __builtin_amdgcn_global_load_lds((const unsigned*)(ap[i] + ko), (unsigned*)(nxt + tid * 16 + i * 4096), 16, 0, 0);
                    __builtin_amdgcn_global_load_lds((const unsigned*)(bp[i] + ko), (unsigned*)(nxt + 16384 + tid * 16 + i * 4096), 16, 0, 0);
                }
            } else if (has_next) {
#pragma unroll
                for (int i = 0; i < 4; ++i) {
                    __builtin_amdgcn_global_load_lds((const unsigned*)(an[i]), (unsigned*)(lds + tid * 16 + i * 4096), 16, 0, 0);
                    __builtin_amdgcn_global_load_lds((const unsigned*)(bn[i]), (unsigned*)(lds + 16384 + tid * 16 + i * 4096), 16, 0, 0);
                }
            }
            bf16x8 af[4][2], bfr[4][2];
#pragma unroll
            for (int m = 0; m < 4; ++m)
#pragma unroll
                for (int kk = 0; kk < 2; ++kk) af[m][kk] = *reinterpret_cast<const bf16x8*>(cur + lds_byte(wr * 64 + m * 16 + fr, kk * 32 + fq * 8));
#pragma unroll
            for (int n = 0; n < 4; ++n)
#pragma unroll
                for (int kk = 0; kk < 2; ++kk) bfr[n][kk] = *reinterpret_cast<const bf16x8*>(cur + 16384 + lds_byte(wc * 64 + n * 16 + fr, kk * 32 + fq * 8));
#pragma unroll
            for (int kk = 0; kk < 2; ++kk)
#pragma unroll
                for (int m = 0; m < 4; ++m)
#pragma unroll
                    for (int n = 0; n < 4; ++n) acc[m][n] = __builtin_amdgcn_mfma_f32_16x16x32_bf16(bfr[n][kk], af[m][kk], acc[m][n], 0, 0, 0);
        }
        epi(t, acc, wr, wc, fr, fq);
        if (!has_next) break;
        t = tn;
#pragma unroll
        for (int i = 0; i < 4; ++i) { ap[i] = an[i]; bp[i] = bn[i]; }
    }
    __syncthreads();
}
DEVINL void stage_coords(int (&R)[4], int (&C)[4]) {
    const int tid = TIDX();
#pragma unroll
    for (int i = 0; i < 4; ++i) stage_rc(tid * 16 + i * 4096, R[i], C[i]);
}

struct GUnit {
    const char* A;
    const char* B;
    unsigned va[2][2] = {{0u, 0u}, {0u, 0u}};
    int i0, i1, i2;
};
constexpr int G_HTB = 128 * 64 * 2;
constexpr int G_STAGE_BYTES = 8 * G_HTB;
DEVINL int perm32(int rho) { const int n = rho >> 4, i = rho & 15; return 8 * (i >> 2) + 4 * n + (i & 3); }
DEVINL void stage_coords512(int tid, int (&R)[2], int (&C)[2]) {
#pragma unroll
    for (int i = 0; i < 2; ++i) stage_rc(tid * 16 + i * 8192, R[i], C[i]);
}

template <bool PERM, bool GATHER, class Sched, class Epi>
DEVINL void gemm256(char* lds_generic, int K, int lda, Sched sched, Epi epi) {
    LAS unsigned char* lds = (LAS unsigned char*)lds_generic;
    const int tid = TID512(), wid = __builtin_amdgcn_readfirstlane(tid >> 6), lane = tid & 63, wr = wid >> 2, wc = wid & 3, fr = lane & 15, fq = lane >> 4;
    const int nt = K / 64;
    unsigned voffB[2];
#pragma unroll
    for (int i = 0; i < 2; ++i) { int R, C; stage_rc(tid * 16 + i * 8192, R, C); const int Rb = PERM ? ((R & ~31) + perm32(R & 31)) : R; voffB[i] = (unsigned)(Rb * K + C) * 2u; }
    unsigned voffA[2];
#pragma unroll
    for (int i = 0; i < 2; ++i) { int R, C; stage_rc(tid * 16 + i * 8192, R, C); voffA[i] = (unsigned)(R * lda + C) * 2u; }
    const size_t hstepA = GATHER ? 0 : (size_t)128 * lda * 2;
    const size_t kstep = (size_t)(64 * 2);
    const size_t hstepB = (size_t)128 * K * 2;
    const unsigned ldsw = (unsigned)wid * 1024u;
    const int aoff = lds_byte(wr * 64 + fr, fq * 8), boff = lds_byte(wc * 32 + fr, fq * 8);
#define G_SA(b, h) (((b) * 2 + (h)) * G_HTB)
#define G_SB(b, h) ((4 + (b) * 2 + (h)) * G_HTB)
#define G_STAGE(bufoff, gbase, voff) do { _Pragma("unroll") for (int _i = 0; _i < 2; ++_i) { unsigned _vo = (voff)[_i]; asm volatile("" : "+v"(_vo)); \
        __builtin_amdgcn_global_load_lds((const unsigned*)((const char*)(gbase) + _vo), (LAS unsigned*)(lds + (bufoff) + ldsw + _i * 8192), 16, 0, 0); } } while (0)
#define G_STAGE_A(bufoff, ptr, vg, h) do { if constexpr (GATHER) { G_STAGE(bufoff, ptr, vg); } else { G_STAGE(bufoff, (ptr) + (h) * hstepA, voffA); } } while (0)
#define G_LDA(dst, b, h) do { _Pragma("unroll") for (int m = 0; m < 4; ++m) _Pragma("unroll") for (int k = 0; k < 2; ++k) dst[m][k] = *(const LAS bf16x8*)(lds + G_SA(b, h) + aoff + m * 2048 + k * 1024); } while (0)
#define G_LDB(dst, b, h) do { _Pragma("unroll") for (int n = 0; n < 2; ++n) _Pragma("unroll") for (int k = 0; k < 2; ++k) dst[n][k] = *(const LAS bf16x8*)(lds + G_SB(b, h) + boff + n * 2048 + k * 1024); } while (0)
#define G_MMA(ai, bj, At, Bt) do { __builtin_amdgcn_s_setprio(1); _Pragma("unroll") for (int m = 0; m < 4; ++m) _Pragma("unroll") for (int n = 0; n < 2; ++n) _Pragma("unroll") for (int k = 0; k < 2; ++k) \
        acc[ai][bj][m][n] = __builtin_amdgcn_mfma_f32_16x16x32_bf16(Bt[n][k], At[m][k], acc[ai][bj][m][n], 0, 0, 0); __builtin_amdgcn_s_setprio(0); } while (0)
#define G_WAIT_V(n) asm volatile("s_waitcnt vmcnt(" #n ")" ::: "memory")
#define G_WAIT_L(n) asm volatile("s_waitcnt lgkmcnt(" #n ")" ::: "memory")
#define G_BAR __builtin_amdgcn_s_barrier()
#define G_SCHED __builtin_amdgcn_sched_barrier(0)
    GUnit cur, nxt; int ui = 0;
    if (!sched(0, cur)) return;
    f32x4 acc[2][2][4][2];
#pragma unroll
    for (int a = 0; a < 2; ++a)
#pragma unroll
        for (int b = 0; b < 2; ++b)
#pragma unroll
            for (int m = 0; m < 4; ++m)
#pragma unroll
                for (int n = 0; n < 2; ++n) acc[a][b][m][n] = (f32x4){0.f, 0.f, 0.f, 0.f};
    bf16x8 At[4][2], B0[2][2], B1[2][2];
    G_STAGE(G_SB(0, 0), cur.B, voffB); G_STAGE_A(G_SA(0, 0), cur.A, cur.va[0], 0); G_STAGE(G_SB(0, 1), cur.B + hstepB, voffB); G_STAGE_A(G_SA(0, 1), cur.A, cur.va[1], 1);
    if (wr == 1) G_BAR;
    G_WAIT_V(4); G_BAR;
    G_STAGE(G_SB(1, 0), cur.B + kstep, voffB); G_STAGE_A(G_SA(1, 0), cur.A + kstep, cur.va[0], 0); G_STAGE(G_SB(1, 1), cur.B + hstepB + kstep, voffB);
    G_WAIT_V(6); G_BAR;
    for (;;) {
        const bool has_next = sched(ui + 1, nxt);
        if (!has_next) nxt = cur;
        for (int t = 0; t < nt; t += 2) {
            const bool last = (t == nt - 2);
            const char* a1 = cur.A + (size_t)(t + 1) * kstep;
            const char* a2 = last ? nxt.A : cur.A + (size_t)(t + 2) * kstep; const char* b2 = last ? nxt.B : cur.B + (size_t)(t + 2) * kstep;
            const char* a3 = a2 + kstep; const char* b3 = b2 + kstep;
            G_LDB(B0, 0, 0); G_SCHED; G_LDA(At, 0, 0); G_STAGE_A(G_SA(1, 1), a1, cur.va[1], 1);
            G_WAIT_L(8); G_BAR; G_WAIT_L(0); G_MMA(0, 0, At, B0); G_BAR; G_SCHED;
            G_LDB(B1, 0, 1); G_STAGE(G_SB(0, 0), b2, voffB);
            G_BAR; G_WAIT_L(0); G_MMA(0, 1, At, B1); G_BAR;
            G_LDA(At, 0, 1); if (last) { G_STAGE_A(G_SA(0, 0), a2, nxt.va[0], 0); } else { G_STAGE_A(G_SA(0, 0), a2, cur.va[0], 0); }
            G_BAR; G_WAIT_L(0); G_MMA(1, 0, At, B0); G_BAR; G_SCHED;
            G_STAGE(G_SB(0, 1), b2 + hstepB, voffB);
            G_WAIT_V(6); G_BAR; G_MMA(1, 1, At, B1); G_BAR;
            G_LDB(B0, 1, 0); G_SCHED; G_LDA(At, 1, 0); if (last) { G_STAGE_A(G_SA(0, 1), a2, nxt.va[1], 1); } else { G_STAGE_A(G_SA(0, 1), a2, cur.va[1], 1); }
            G_WAIT_L(8); G_BAR; G_WAIT_L(0); G_MMA(0, 0, At, B0); G_BAR; G_SCHED;
            G_LDB(B1, 1, 1); G_STAGE(G_SB(1, 0), b3, voffB);
            G_BAR; G_WAIT_L(0); G_MMA(0, 1, At, B1); G_BAR;
            G_LDA(At, 1, 1); if (last) { G_STAGE_A(G_SA(1, 0), a3, nxt.va[0], 0); } else { G_STAGE_A(G_SA(1, 0), a3, cur.va[0], 0); }
            G_BAR; G_WAIT_L(0); G_MMA(1, 0, At, B0); G_BAR; G_SCHED;
            G_STAGE(G_SB(1, 1), b3 + hstepB, voffB);
            G_WAIT_V(6); G_BAR; G_MMA(1, 1, At, B1); G_BAR;
        }
        { const int l2 = TID512() & 63; epi(acc, cur, wr, wc, l2 & 15, l2 >> 4); }
        if (!has_next) break;
#pragma unroll
        for (int a = 0; a < 2; ++a)
#pragma unroll
            for (int b = 0; b < 2; ++b)
#pragma unroll
                for (int m = 0; m < 4; ++m)
#pragma unroll
                    for (int n = 0; n < 2; ++n) acc[a][b][m][n] = (f32x4){0.f, 0.f, 0.f, 0.f};
        cur = nxt; ++ui;
    }
    G_WAIT_V(0);
    if (wr == 0) G_BAR;
    G_BAR;
#undef G_SA
#undef G_STAGE_A
#undef G_SB
#undef G_STAGE
#undef G_LDA
#undef G_LDB
#undef G_MMA
#undef G_WAIT_V
#undef G_WAIT_L
#undef G_BAR
#undef G_SCHED
}
DEVINL long unit_linear(int i, int c, int G) { const int q = G >> 3; return ((long)i * 8 + (c & 7)) * q + (c >> 3); }

constexpr int CONV_PER_L = 672 + 256 + 8320 + 4160;
struct ConvJob { const float* src; bf16_t* dst; int K, ld, k0, r0, perm; };
DEVINL ConvJob conv_decode(KP p, int id) {
    ConvJob j; const int l = id / CONV_PER_L; int r = id % CONV_PER_L; int kt, nt;
    if (r < 672) { j.src = p->in[I_WIN] + (size_t)l * 1024 * 2688; j.K = 1024; j.ld = 2688; j.perm = 0; j.dst = (bf16_t*)(p->ws + OFF_WIN) + (size_t)l * WIN_ROWS * 1024; kt = r & 15; nt = r >> 4; }
    else if (r < 928) { r -= 672; j.src = p->in[I_WOUT] + (size_t)l * 1024 * 1024; j.K = 1024; j.ld = 1024; j.perm = 0; j.dst = (bf16_t*)(p->ws + OFF_WOUT) + (size_t)l * 1024 * 1024; kt = r & 15; nt = r >> 4; }
    else if (r < 928 + 8320) { r -= 928; const int e = r >> 7, q = r & 127; kt = q & 15; nt = q >> 4; j.K = 1024; j.ld = 512; j.perm = 1;
        j.src = (e < 64) ? p->in[I_W13] + (size_t)(l * 64 + e) * 1024 * 512 : p->in[I_WS13] + (size_t)l * 1024 * 512;
        j.dst = (bf16_t*)(p->ws + OFF_W13) + (size_t)(l * 65 + e) * 512 * 1024; }
    else { r -= 9248; const int e = r >> 6, q = r & 63; kt = q & 3; nt = q >> 2; j.K = 256; j.ld = 1024; j.perm = 0;
        j.src = (e < 64) ? p->in[I_W2] + (size_t)(l * 64 + e) * 256 * 1024 : p->in[I_WS2] + (size_t)l * 256 * 1024;
        j.dst = (bf16_t*)(p->ws + OFF_W2) + (size_t)(l * 65 + e) * 1024 * 256; }
    j.k0 = kt * 64; j.r0 = nt * 64; return j;
}
DEVINL void conv_issue(const ConvJob& j, char* buf, int tid) {
    const int nn = tid & 63, drow = j.r0 + nn;
    int scol = drow;
    if (j.perm) { const int g = drow >> 5, i = drow & 31; scol = (i < 16) ? (g * 16 + i) : (256 + g * 16 + (i - 16)); }
    const float* sp = j.src + (size_t)j.k0 * j.ld + scol;
#pragma unroll
    for (int q = 0; q < 16; ++q) { const int kk = (tid >> 6) + 4 * q;
        __builtin_amdgcn_global_load_lds((const unsigned*)(sp + (size_t)kk * j.ld), (unsigned*)(buf + kk * 260 + nn * 4), 4, 0, 0); }
}
DEVINL void convert_ids(KP p, char* lds, int id_lo, int id_hi, int wb, int nwb) {
    const int tid = TIDX();
    const int n = (id_hi - id_lo + nwb - 1) / nwb;
    auto idof = [&](int i) { const int id = id_lo + i * nwb + wb; return (id < id_hi) ? id : id_hi - 1; };
    ConvJob j0 = conv_decode(p, idof(0)), j1 = conv_decode(p, idof(n > 1 ? 1 : 0));
    conv_issue(j0, lds, tid);
    conv_issue(j1, lds + 16640, tid);
    bf16_t* d0 = j0.dst + (size_t)j0.r0 * j0.K + j0.k0; int K0 = j0.K;
    bf16_t* d1 = j1.dst + (size_t)j1.r0 * j1.K + j1.k0; int K1 = j1.K;
    for (int i = 0; i < n; ++i) {
        const ConvJob j2 = conv_decode(p, idof(i + 2 < n ? i + 2 : n - 1));
        conv_issue(j2, lds + ((i + 2) % 3) * 16640, tid);
        asm volatile("s_waitcnt vmcnt(32)" ::: "memory");
        __builtin_amdgcn_s_barrier();
        const float* tile = (const float*)(lds + (i % 3) * 16640);
        {
            const int kp = (tid & 31) * 2;
#pragma unroll
            for (int q = 0; q < 8; ++q) { const int rr = (tid >> 5) + 8 * q;
                *(unsigned*)(d0 + (size_t)rr * K0 + kp) = pack2(tile[kp * 65 + rr], tile[(kp + 1) * 65 + rr]); }
        }
        asm volatile("s_waitcnt lgkmcnt(0)" ::: "memory");
        __builtin_amdgcn_s_barrier();
        d0 = d1; K0 = K1; d1 = j2.dst + (size_t)j2.r0 * j2.K + j2.k0; K1 = j2.K;
    }
    asm volatile("s_waitcnt vmcnt(0)" ::: "memory");
    __syncthreads();
}

DEVINL void phase0(KP p, char* lds) {
    const int tid = TIDX(), nb = NBV(), blk = BIDX();
    if (blk == 0 && tid < 128) ((unsigned*)(p->ws + OFF_CNT))[tid] = 0u;
    if (blk < 192) {
        float* sc = (float*)lds;
        float* part = (float*)(lds + 32768);
        for (int i = tid; i < 8192; i += VTHREADS) { float c = p->in[I_C][i]; sc[i] = c * sigm(c); }
        __syncthreads();
        const int cl = tid & 63, ks = tid >> 6, n = blk * 64 + cl, l = n / 6144, nn = n % 6144;
        const float* w = p->in[I_WMOD] + (size_t)l * 1024 * 6144 + (size_t)(ks * 256) * 6144 + nn;
        float acc[8];
#pragma unroll
        for (int b = 0; b < 8; ++b) acc[b] = 0.f;
#pragma unroll 16
        for (int k = 0; k < 256; ++k) {
            const float wv = w[(size_t)k * 6144];
#pragma unroll
            for (int b = 0; b < 8; ++b) acc[b] = fmaf(sc[b * 1024 + ks * 256 + k], wv, acc[b]);
        }
#pragma unroll
        for (int b = 0; b < 8; ++b) part[(ks * 8 + b) * 64 + cl] = acc[b];
        __syncthreads();
        if (tid < 64) {
            const float bm = p->in[I_BMOD][l * 6144 + nn];
            float* mod = (float*)(p->ws + OFF_MOD);
#pragma unroll
            for (int b = 0; b < 8; ++b) mod[(size_t)(l * 8 + b) * 6144 + nn] = part[(0 * 8 + b) * 64 + cl] + part[(1 * 8 + b) * 64 + cl] + part[(2 * 8 + b) * 64 + cl] + part[(3 * 8 + b) * 64 + cl] + bm;
        }
        __syncthreads();
    }
    if (blk >= 192 && blk < 256) {
        bf16_t* wrt = (bf16_t*)(p->ws + OFF_WR);
#pragma unroll
        for (int j = 0; j < 8; ++j) {
            const int idx = (blk - 192) * 2048 + j * 256 + tid, l2 = idx >> 16, rem = idx & 65535, k = rem >> 6, e = rem & 63;
            const float w = p->in[I_WROUTER][idx];
            const bf16_t hi = f2bf(w); const bf16_t lo = f2bf(w - bf2f(hi));
            wrt[(size_t)((l2 * 2 + 0) * 64 + e) * 1024 + k] = hi; wrt[(size_t)((l2 * 2 + 1) * 64 + e) * 1024 + k] = lo;
        }
    }
    convert_ids(p, lds, 0, 928, blk, nb);
}

DEVINL void phaseF0(KP p) {
    const int tid = TIDX(), nb = NBV(), blk = BIDX();
    const float* mod = (const float*)(p->ws + OFF_MOD);
    bf16_t* ubuf = (bf16_t*)(p->ws + OFF_UBUF);
    for (int row = blk; row < NTOK; row += nb) {
        const int b = row >> 12, col = tid * 4;
        const float4 x = *(const float4*)(p->in[I_X] + (size_t)row * DM + col);
        const float4 sh = *(const float4*)(mod + (size_t)b * 6144 + col);
        const float4 sc = *(const float4*)(mod + (size_t)b * 6144 + 1024 + col);
        uint2 o; o.x = pack2(x.x * (1.f + sc.x) + sh.x, x.y * (1.f + sc.y) + sh.y); o.y = pack2(x.z * (1.f + sc.z) + sh.z, x.w * (1.f + sc.w) + sh.w);
        *(uint2*)(ubuf + (size_t)row * DM + col) = o;
    }
}

DEVINL void b1_conformer(KP p, int l, char* lds, int item) {
    const int tid = TIDX(), b = item >> 7, tt = item & 127, t0 = tt * 32, rowbase = b * SEQ;
    const bf16_t* P = (const bf16_t*)(p->ws + A_P);
    bf16_t* ymix = (bf16_t*)(p->ws + A_YMIX);
    float w[31];
#pragma unroll
    for (int k = 0; k < 31; ++k) w[k] = p->in[I_CONVA][(size_t)(l * 31 + k) * 256 + tid];
    float acc[32];
    const float bias = p->in[I_CONVAB][l * 256 + tid];
#pragma unroll
    for (int j = 0; j < 32; ++j) acc[j] = bias;
#pragma unroll
    for (int rr = 0; rr < 62; ++rr) {
        const int t = t0 - 30 + rr;
        const bf16_t* pr = P + ((long)(rowbase + t0 - 30) * PIN + tid) + (long)rr * PIN;
        const float val = bf2f(pr[0]), gate = bf2f(pr[256]);
        const float h = (t >= 0) ? val * sigm(gate) : 0.f;
#pragma unroll
        for (int j = 0; j < 32; ++j) { const int k = rr - j; if (k >= 0 && k <= 30) acc[j] = fmaf(w[k], h, acc[j]); }
    }
    float* outb = (float*)lds;
#pragma unroll
    for (int j = 0; j < 32; ++j) outb[j * 256 + tid] = acc[j];
    __syncthreads();
    const int wid = tid >> 6, lane = tid & 63;
    const float4 g4 = *(const float4*)(p->in[I_LNAG] + l * 256 + lane * 4), b4 = *(const float4*)(p->in[I_LNAB] + l * 256 + lane * 4);
    for (int j = wid; j < 32; j += 4) {
        const float4 v = *(const float4*)(outb + j * 256 + lane * 4);
        const float mean = wave_sum(v.x + v.y + v.z + v.w) * (1.f / 256.f);
        const float d0 = v.x - mean, d1 = v.y - mean, d2 = v.z - mean, d3 = v.w - mean;
        const float var = wave_sum(d0 * d0 + d1 * d1 + d2 * d2 + d3 * d3) * (1.f / 256.f);
        const float rs = rsqrtf(var + LN_EPS);
        float y0 = d0 * rs * g4.x + b4.x, y1 = d1 * rs * g4.y + b4.y, y2 = d2 * rs * g4.z + b4.z, y3 = d3 * rs * g4.w + b4.w;
        y0 *= sigm(y0); y1 *= sigm(y1); y2 *= sigm(y2); y3 *= sigm(y3);
        uint2 o; o.x = pack2(y0, y1); o.y = pack2(y2, y3);
        *(uint2*)(ymix + (size_t)(rowbase + t0 + j) * DM + lane * 4) = o;
    }
    __syncthreads();
}

DEVINL void b1_shortconv(KP p, int l, int item) {
    const int tid = TIDX(), cg = tid & 31, tl = tid >> 5, b = item >> 6, t0 = (item & 63) * 64 + tl * 8, rowbase = b * SEQ;
    const bf16_t* P = (const bf16_t*)(p->ws + A_P);
    bf16_t* ymix = (bf16_t*)(p->ws + A_YMIX);
    float w0[8], w1[8], w2[8];
#pragma unroll
    for (int e = 0; e < 8; ++e) { w0[e] = p->in[I_CONVD][(l * 3 + 0) * 256 + cg * 8 + e]; w1[e] = p->in[I_CONVD][(l * 3 + 1) * 256 + cg * 8 + e]; w2[e] = p->in[I_CONVD][(l * 3 + 2) * 256 + cg * 8 + e]; }
    uint4 gbv[8], gcv[10], hdv[10];
#pragma unroll
    for (int u = 0; u < 10; ++u) {
        const int t = t0 - 2 + u;
        const bf16_t* a = P + (size_t)(rowbase + (t >= 0 ? t : 0)) * PIN + 1920 + cg * 8;
        gcv[u] = *(const uint4*)(a + 256); hdv[u] = *(const uint4*)(a + 512);
        if (u >= 2) gbv[u - 2] = *(const uint4*)(a);
    }
    float q2[8], q1[8];
#pragma unroll
    for (int u = 0; u < 10; ++u) {
        const int t = t0 - 2 + u;
        const unsigned gcw[4] = {gcv[u].x, gcv[u].y, gcv[u].z, gcv[u].w}, hdw[4] = {hdv[u].x, hdv[u].y, hdv[u].z, hdv[u].w};
        float q0[8];
#pragma unroll
        for (int e = 0; e < 4; ++e) {
            q0[2 * e] = __uint_as_float(gcw[e] << 16) * __uint_as_float(hdw[e] << 16);
            q0[2 * e + 1] = __uint_as_float(gcw[e] & 0xFFFF0000u) * __uint_as_float(hdw[e] & 0xFFFF0000u);
        }
        if (t < 0) {
#pragma unroll
            for (int e = 0; e < 8; ++e) q0[e] = 0.f;
        }
        if (u >= 2) {
            const unsigned gbw[4] = {gbv[u - 2].x, gbv[u - 2].y, gbv[u - 2].z, gbv[u - 2].w};
            float y[8];
#pragma unroll
            for (int e = 0; e < 4; ++e) {
                y[2 * e] = __uint_as_float(gbw[e] << 16) * (w0[2 * e] * q2[2 * e] + w1[2 * e] * q1[2 * e] + w2[2 * e] * q0[2 * e]);
                y[2 * e + 1] = __uint_as_float(gbw[e] & 0xFFFF0000u) * (w0[2 * e + 1] * q2[2 * e + 1] + w1[2 * e + 1] * q1[2 * e + 1] + w2[2 * e + 1] * q0[2 * e + 1]);
            }
            *(uint4*)(ymix + (size_t)(rowbase + t) * DM + 768 + cg * 8) = make_uint4(pack2(y[0], y[1]), pack2(y[2], y[3]), pack2(y[4], y[5]), pack2(y[6], y[7]));
        }
#pragma unroll
        for (int e = 0; e < 8; ++e) { q2[e] = (u >= 1) ? q1[e] : 0.f; q1[e] = q0[e]; }
    }
}

DEVINL void b1_lru(KP p, int l, char* lds, int item) {
    const int c = TIDX(), b = item >> 7, tt = item & 127, t0 = tt * 32, rowbase = b * SEQ;
    const int h = c >> 6, lane = c & 63;
    const bf16_t* P = (const bf16_t*)(p->ws + A_P);
    float* uT = (float*)lds;
    {
        const float cb0 = p->in[I_CONVB][(l * 4 + 0) * 256 + c], cb1 = p->in[I_CONVB][(l * 4 + 1) * 256 + c], cb2 = p->in[I_CONVB][(l * 4 + 2) * 256 + c], cb3 = p->in[I_CONVB][(l * 4 + 3) * 256 + c];
        const float bias = p->in[I_CONVBB][l * 256 + c];
        float xm3 = 0.f, xm2 = 0.f, xm1 = 0.f;
        if (t0 >= 3) { const bf16_t* a = P + (size_t)(rowbase + t0 - 3) * PIN + 512 + c; xm3 = bf2f(a[0]); xm2 = bf2f(a[PIN]); xm1 = bf2f(a[2 * PIN]); }
        bf16_t xr[32];
#pragma unroll
        for (int j = 0; j < 32; ++j) xr[j] = P[(size_t)(rowbase + t0 + j) * PIN + 512 + c];
#pragma unroll
        for (int j = 0; j < 32; ++j) {
            const float x0 = bf2f(xr[j]);
            uT[c * 36 + j] = cb0 * xm3 + cb1 * xm2 + cb2 * xm1 + cb3 * x0 + bias;
            xm3 = xm2; xm2 = xm1; xm1 = x0;
        }
    }
    __syncthreads();
    const float brg = p->in[I_BRG][l * 256 + c], big = p->in[I_BIG][l * 256 + c];
    const float sp = softplus_acc(-p->in[I_LAMBDA][l * 256 + c]);
    float* hloc = (float*)(p->ws + A_HLOC); float* cuma = (float*)(p->ws + A_CUMA);
    const float* wrg = p->in[I_WRG] + (size_t)((l * 4 + h) * 64) * 64 + lane;
    const float* wig = p->in[I_WIG] + (size_t)((l * 4 + h) * 64) * 64 + lane;
    float hs = 0.f, cA = 1.f;
#pragma unroll 1
    for (int half = 0; half < 2; ++half) {
        float ar[16], ai[16];
#pragma unroll
        for (int j = 0; j < 16; ++j) { ar[j] = 0.f; ai[j] = 0.f; }
#pragma unroll 1
        for (int dh = 0; dh < 4; ++dh) {
            float wrv[16], wiv[16];
#pragma unroll
            for (int d = 0; d < 16; ++d) { wrv[d] = wrg[(dh * 16 + d) * 64]; wiv[d] = wig[(dh * 16 + d) * 64]; }
#pragma unroll
            for (int d = 0; d < 16; ++d) {
                const float wr = wrv[d], wi = wiv[d];
                const float4* up = (const float4*)(uT + (h * 64 + dh * 16 + d) * 36 + half * 16);
#pragma unroll
                for (int jj = 0; jj < 4; ++jj) {
                    const float4 u4 = up[jj];
                    ar[4 * jj + 0] = fmaf(u4.x, wr, ar[4 * jj + 0]); ai[4 * jj + 0] = fmaf(u4.x, wi, ai[4 * jj + 0]);
                    ar[4 * jj + 1] = fmaf(u4.y, wr, ar[4 * jj + 1]); ai[4 * jj + 1] = fmaf(u4.y, wi, ai[4 * jj + 1]);
                    ar[4 * jj + 2] = fmaf(u4.z, wr, ar[4 * jj + 2]); ai[4 * jj + 2] = fmaf(u4.z, wi, ai[4 * jj + 2]);
                    ar[4 * jj + 3] = fmaf(u4.w, wr, ar[4 * jj + 3]); ai[4 * jj + 3] = fmaf(u4.w, wi, ai[4 * jj + 3]);
                }
            }
        }
        float ureg[16];
#pragma unroll
        for (int jj = 0; jj < 4; ++jj) { const float4 u4 = *(const float4*)(uT + c * 36 + half * 16 + 4 * jj); ureg[4 * jj] = u4.x; ureg[4 * jj + 1] = u4.y; ureg[4 * jj + 2] = u4.z; ureg[4 * jj + 3] = u4.w; }
        float* hp = hloc + (size_t)(rowbase + t0 + half * 16) * 256 + c;
        float* cp = cuma + (size_t)(rowbase + t0 + half * 16) * 256 + c;
#pragma unroll
        for (int j = 0; j < 16; ++j) {
            const float r = sigm(ar[j] + brg), ig = sigm(ai[j] + big);
            const float log_a = -8.0f * r * sp;
            const float a = __expf(log_a);
            const float mult = sqrtf(fmaxf(1.f - a * a, 0.f));
            const float bx = mult * (ig * ureg[j]);
            hs = fmaf(a, hs, bx); cA *= a;
            hp[j * 256] = hs; cp[j * 256] = cA;
        }
    }
    ((float*)(p->ws + A_CARRYA))[(size_t)(b * 128 + tt) * 256 + c] = cA;
    ((float*)(p->ws + A_CARRYH))[(size_t)(b * 128 + tt) * 256 + c] = hs;
    __syncthreads();
}

DEVINL void b1_rwkv(KP p, int l, char* lds, int item) {
    const int c = TIDX(), b = item >> 7, tt = item & 127, t0 = tt * 32, rowbase = b * SEQ;
    const bf16_t* P = (const bf16_t*)(p->ws + A_P);
    float* featT = (float*)lds;
    const float* muc = p->in[I_MUC] + l * 896;
    if (c < 128) {
        const int col = 1024 + 768 + c; const float mu = muc[768 + c];
        float prev;
        { const float x = bf2f(P[(size_t)(rowbase + (t0 > 0 ? t0 - 1 : 0)) * PIN + col]); prev = (t0 > 0) ? x : 0.f; }
#pragma unroll 1
        for (int jb = 0; jb < 2; ++jb) {
            bf16_t raw[16];
#pragma unroll
            for (int u = 0; u < 16; ++u) raw[u] = P[(size_t)(rowbase + t0 + jb * 16 + u) * PIN + col];
#pragma unroll
            for (int u = 0; u < 16; ++u) {
                const float cur = bf2f(raw[u]);
                const float xs = cur + (prev - cur) * mu;
                const float val = (c < 32) ? tanh_fast(xs) : ((c < 64) ? xs : sigm(xs));
                featT[c * 36 + jb * 16 + u] = val; prev = cur;
            }
        }
    }
    __syncthreads();
    float acc[32], dec[32], aa[32];
#define LORA32(WPTR, FOFF) do { float wv_[32]; \
    _Pragma("unroll") for (int jf = 0; jf < 32; ++jf) wv_[jf] = (WPTR)[(size_t)jf * 256 + c]; \
    _Pragma("unroll") for (int jf = 0; jf < 32; ++jf) { const float4* fp = (const float4*)(featT + ((FOFF) + jf) * 36); const float wv = wv_[jf]; \
        _Pragma("unroll") for (int jj = 0; jj < 8; ++jj) { const float4 u4 = fp[jj]; acc[4 * jj] = fmaf(u4.x, wv, acc[4 * jj]); acc[4 * jj + 1] = fmaf(u4.y, wv, acc[4 * jj + 1]); acc[4 * jj + 2] = fmaf(u4.z, wv, acc[4 * jj + 2]); acc[4 * jj + 3] = fmaf(u4.w, wv, acc[4 * jj + 3]); } } } while (0)
#pragma unroll
    for (int j = 0; j < 32; ++j) acc[j] = 0.f;
    LORA32(p->in[I_WG2] + (size_t)(l * 64) * 256, 64);
    LORA32(p->in[I_WG2] + (size_t)(l * 64 + 32) * 256, 96);
    {
        float* gbuf = (float*)(p->ws + A_G);
#pragma unroll
        for (int j = 0; j < 32; ++j) { gbuf[(size_t)(rowbase + t0 + j) * 256 + c] = acc[j]; acc[j] = 0.f; }
    }
    LORA32(p->in[I_WW2] + (size_t)(l * 32) * 256, 0);
    {
        const float w0 = p->in[I_W0][l * 256 + c];
#pragma unroll
        for (int j = 0; j < 32; ++j) { const float z = w0 + acc[j]; const float wlog = -softplusf(-z) - 0.5f; dec[j] = -__expf(wlog); acc[j] = 0.f; }
    }
    LORA32(p->in[I_WA2] + (size_t)(l * 32) * 256, 32);
    {
        const float a0 = p->in[I_A0][l * 256 + c];
#pragma unroll
        for (int j = 0; j < 32; ++j) aa[j] = sigm(a0 + acc[j]);
    }
#undef LORA32
    {
        float* bonus = (float*)(p->ws + A_BONUS); uint4* scan = (uint4*)(p->ws + A_SCAN);
        const float mur = muc[c], muk = muc[256 + c], muv = muc[512 + c];
        const float kkw = p->in[I_KK][l * 256 + c], kaw = p->in[I_KA][l * 256 + c], rkw = p->in[I_RK][l * 256 + c];
        float pr, pk, pv;
        { const bf16_t* a = P + (size_t)(rowbase + (t0 > 0 ? t0 - 1 : 0)) * PIN + 1024 + c; const float x0 = bf2f(a[0]), x1 = bf2f(a[256]), x2 = bf2f(a[512]);
          pr = (t0 > 0) ? x0 : 0.f; pk = (t0 > 0) ? x1 : 0.f; pv = (t0 > 0) ? x2 : 0.f; }
#pragma unroll
        for (int jb = 0; jb < 4; ++jb) {
            bf16_t rr_[8], rk_[8], rv_[8];
#pragma unroll
            for (int u = 0; u < 8; ++u) { const bf16_t* a = P + (size_t)(rowbase + t0 + jb * 8 + u) * PIN + 1024 + c; rr_[u] = a[0]; rk_[u] = a[256]; rv_[u] = a[512]; }
#pragma unroll
            for (int u = 0; u < 8; ++u) {
                const int j = jb * 8 + u;
                const size_t row = (size_t)(rowbase + t0 + j);
                const float cr = bf2f(rr_[u]), ck = bf2f(rk_[u]), cv = bf2f(rv_[u]);
                const float r = cr + (pr - cr) * mur, k = ck + (pk - ck) * muk, v = cv + (pv - cv) * muv;
                pr = cr; pk = ck; pv = cv;
                const float kk = k * kkw;
                const float ss = wave_sum(kk * kk);
                const float kkn = kk * rsqrtf(ss + 1e-12f);
                const float kf = k * (1.f + (aa[j] - 1.f) * kaw);
                const float bs = wave_sum(r * kf * rkw);
                bonus[row * 256 + c] = bs * v;
                uint4 o; o.x = pack2(kkn, kkn * aa[j]); o.y = pack2(kf, r); o.z = pack2(v, 0.f); o.w = __float_as_uint(dec[j]);
                scan[row * 256 + c] = o;
            }
            asm volatile("" ::: "memory");
        }
    }
    __syncthreads();
}

constexpr int S_AL = 0, S_BE = 8192, S_KA = 16384, S_RH = 24576, S_BET = 32768, S_KAT = 40960, S_VT = 49152, S_L2F = 57344  , S_GT = 73728  ;
constexpr int S_L1F = S_BE;
constexpr int S_M1 = S_BE, S_M2 = S_KA;
constexpr int S_APT = S_L2F, S_W2T = S_L2F + 8192;
constexpr int S_RP = S_AL, S_GTR = S_RH;
DEVINL int crow32(int reg, int h) { return (reg & 3) + 8 * (reg >> 2) + 4 * h; }
DEVINL bf16x8 frag64(const char* lds, int slot, int row, int kel) { return *reinterpret_cast<const bf16x8*>(lds + slot + row * 128 + kel * 2); }
#define MFMA32(a, b, c) __builtin_amdgcn_mfma_f32_32x32x16_bf16((a), (b), (c), 0, 0, 0)
DEVINL float dpp_xor1(float x) { return __builtin_bit_cast(float, __builtin_amdgcn_update_dpp(0, __builtin_bit_cast(int, x), 0xB1, 0xf, 0xf, true)); }

DEVINL f32x16 mm64(const char* lds, int slotA, int slotB, int tm, int tn, int r, int hh, f32x16 acc) {
#pragma unroll
    for (int ks = 0; ks < 4; ++ks) acc = MFMA32(frag64(lds, slotA, tm * 32 + r, ks * 16 + 8 * hh), frag64(lds, slotB, tn * 32 + r, ks * 16 + 8 * hh), acc);
    return acc;
}

DEVINL void b1e_unit(KP p, char* lds, int b, int h, int c) {
    const int tid = TIDX(), wv = tid >> 6, lane = tid & 63, r = lane & 31, hh = lane >> 5;
    const uint4* scan = (const uint4*)(p->ws + A_SCAN) + ((size_t)(b * SEQ + c * 64)) * 256 + h * 64;
    float* gtot = (float*)(lds + S_GT); float* gamC = gtot + 256;
    {
        const int j = lane;
        float lw[16]; unsigned px[16], py[16], pz[16];
#pragma unroll
        for (int u = 0; u < 16; ++u) { const uint4 q = scan[(size_t)(wv * 16 + u) * 256 + j]; px[u] = q.x; py[u] = q.y; pz[u] = q.z; lw[u] = __uint_as_float(q.w); }
        float tot = 0.f;
#pragma unroll
        for (int u = 0; u < 16; ++u) tot += lw[u];
        gtot[wv * 64 + j] = tot;
        __syncthreads();
        float off = 0.f, all = 0.f;
#pragma unroll
        for (int g = 0; g < 4; ++g) { const float v = gtot[g * 64 + j]; all += v; off += (g < wv) ? v : 0.f; }
        if (wv == 0) gamC[j] = __expf(all);
        float cum = off;
        unsigned tb[8], tk[8], tv[8];
#pragma unroll
        for (int u = 0; u < 16; ++u) {
            const float kkn = __uint_as_float(px[u] << 16), bb = __uint_as_float(px[u] & 0xFFFF0000u);
            const float kf = __uint_as_float(py[u] << 16), rr = __uint_as_float(py[u] & 0xFFFF0000u);
            const float gp = __expf(cum); cum += lw[u];
            const float g = __expf(cum), en = __expf(-cum);
            const int t = wv * 16 + u;
            const unsigned be = f2bf(bb * en), ka = f2bf(kf * en);
            *(bf16_t*)(lds + S_AL + t * 128 + j * 2) = f2bf(gp * kkn);
            *(bf16_t*)(lds + S_BE + t * 128 + j * 2) = (bf16_t)be;
            *(bf16_t*)(lds + S_KA + t * 128 + j * 2) = (bf16_t)ka;
            *(bf16_t*)(lds + S_RH + t * 128 + j * 2) = f2bf(g * rr);
            if (u & 1) { tb[u >> 1] |= be << 16; tk[u >> 1] |= ka << 16; tv[u >> 1] |= (pz[u] << 16); }
            else { tb[u >> 1] = be; tk[u >> 1] = ka; tv[u >> 1] = pz[u] & 0xFFFFu; }
        }
        *(uint4*)(lds + S_BET + j * 128 + wv * 32) = make_uint4(tb[0], tb[1], tb[2], tb[3]); *(uint4*)(lds + S_BET + j * 128 + wv * 32 + 16) = make_uint4(tb[4], tb[5], tb[6], tb[7]);
        *(uint4*)(lds + S_KAT + j * 128 + wv * 32) = make_uint4(tk[0], tk[1], tk[2], tk[3]); *(uint4*)(lds + S_KAT + j * 128 + wv * 32 + 16) = make_uint4(tk[4], tk[5], tk[6], tk[7]);
        *(uint4*)(lds + S_VT + j * 128 + wv * 32) = make_uint4(tv[0], tv[1], tv[2], tv[3]); *(uint4*)(lds + S_VT + j * 128 + wv * 32 + 16) = make_uint4(tv[4], tv[5], tv[6], tv[7]);
    }
    __syncthreads();
    const int tm = wv >> 1, tn = wv & 1;
    f32x16 aM1, aM2;
    {
        f32x16 aL1, aL2;
#pragma unroll
        for (int i = 0; i < 16; ++i) { aL1[i] = 0.f; aL2[i] = 0.f; aM1[i] = 0.f; aM2[i] = 0.f; }
#pragma unroll
        for (int ks = 0; ks < 4; ++ks) {
            const bf16x8 fa = frag64(lds, S_AL, tm * 32 + r, ks * 16 + 8 * hh), fr = frag64(lds, S_RH, tm * 32 + r, ks * 16 + 8 * hh);
            const bf16x8 fb = frag64(lds, S_BE, tn * 32 + r, ks * 16 + 8 * hh), fk = frag64(lds, S_KA, tn * 32 + r, ks * 16 + 8 * hh);
            aL1 = MFMA32(fa, fb, aL1); aL2 = MFMA32(fa, fk, aL2); aM1 = MFMA32(fr, fb, aM1); aM2 = MFMA32(fr, fk, aM2);
        }
        __syncthreads();
#pragma unroll
        for (int reg = 0; reg < 16; ++reg) {
            const int t = tm * 32 + crow32(reg, hh), sidx = tn * 32 + r;
            const int o = (t * 64 + (sidx & 1) * 32 + (sidx >> 1)) * 4;
            *(float*)(lds + S_L1F + o) = (sidx < t) ? aL1[reg] : 0.f;
            *(float*)(lds + S_L2F + o) = (sidx < t) ? aL2[reg] : 0.f;
            aM1[reg] = (sidx <= t) ? aM1[reg] : 0.f; aM2[reg] = (sidx <= t) ? aM2[reg] : 0.f;
        }
    }
    __syncthreads();
    unsigned outp[32];
    {
        const int col = (wv & 1) * 32 + (lane >> 1), q = lane & 1;
        float xq[32];
#pragma unroll
        for (int k = 0; k < 32; ++k) xq[k] = 0.f;
        const char* l1row = lds + S_L1F + q * 128;
        const char* l2row = lds + S_L2F + q * 128;
        if (wv < 2) {
#pragma unroll
            for (int t = 0; t < 64; ++t) {
                float acc = 0.f;
#pragma unroll
                for (int k4 = 0; k4 * 4 < (t + 1) / 2; ++k4) {
                    const float4 a = *(const float4*)(l1row + t * 256 + k4 * 16);
                    acc = fmaf(a.x, xq[4 * k4 + 0], acc); acc = fmaf(a.y, xq[4 * k4 + 1], acc); acc = fmaf(a.z, xq[4 * k4 + 2], acc); acc = fmaf(a.w, xq[4 * k4 + 3], acc);
                }
                acc += dpp_xor1(acc);
                const float x = bf2f(*(const bf16_t*)(lds + S_AL + t * 128 + col * 2)) - acc;
                xq[t >> 1] = ((t & 1) == q) ? x : xq[t >> 1];
            }
        } else {
            float vq[32];
#pragma unroll
            for (int k8 = 0; k8 < 8; ++k8) {
                const uint4 d = *(const uint4*)(lds + S_VT + col * 128 + k8 * 16);
                vq[4 * k8 + 0] = q ? __uint_as_float(d.x & 0xFFFF0000u) : __uint_as_float(d.x << 16);
                vq[4 * k8 + 1] = q ? __uint_as_float(d.y & 0xFFFF0000u) : __uint_as_float(d.y << 16);
                vq[4 * k8 + 2] = q ? __uint_as_float(d.z & 0xFFFF0000u) : __uint_as_float(d.z << 16);
                vq[4 * k8 + 3] = q ? __uint_as_float(d.w & 0xFFFF0000u) : __uint_as_float(d.w << 16);
            }
#pragma unroll
            for (int t = 0; t < 64; ++t) {
                float acc = 0.f;
#pragma unroll
                for (int k4 = 0; k4 * 4 < (t + 1) / 2; ++k4) {
                    const float4 a = *(const float4*)(l1row + t * 256 + k4 * 16);
                    const float4 bq = *(const float4*)(l2row + t * 256 + k4 * 16);
                    acc = fmaf(bq.x, vq[4 * k4 + 0], acc); acc = fmaf(bq.y, vq[4 * k4 + 1], acc); acc = fmaf(bq.z, vq[4 * k4 + 2], acc); acc = fmaf(bq.w, vq[4 * k4 + 3], acc);
                    acc = fmaf(-a.x, xq[4 * k4 + 0], acc); acc = fmaf(-a.y, xq[4 * k4 + 1], acc); acc = fmaf(-a.z, xq[4 * k4 + 2], acc); acc = fmaf(-a.w, xq[4 * k4 + 3], acc);
                }
                acc += dpp_xor1(acc);
                xq[t >> 1] = ((t & 1) == q) ? acc : xq[t >> 1];
            }
        }
#pragma unroll
        for (int k = 0; k < 32; ++k) { const float o = dpp_xor1(xq[k]); outp[k] = q ? pack2(o, xq[k]) : pack2(xq[k], o); }
    }
    __syncthreads();
    {
        const int col = (wv & 1) * 32 + (lane >> 1), q = lane & 1;
        char* dst = lds + ((wv < 2) ? S_APT : S_W2T) + col * 128 + q * 64;
#pragma unroll
        for (int i = 0; i < 4; ++i) *(uint4*)(dst + i * 16) = q ? make_uint4(outp[16 + 4 * i], outp[17 + 4 * i], outp[18 + 4 * i], outp[19 + 4 * i]) : make_uint4(outp[4 * i], outp[4 * i + 1], outp[4 * i + 2], outp[4 * i + 3]);
#pragma unroll
        for (int reg = 0; reg < 16; ++reg) {
            const int t = tm * 32 + crow32(reg, hh), sidx = tn * 32 + r;
            *(bf16_t*)(lds + S_M1 + t * 128 + sidx * 2) = f2bf(aM1[reg]);
            *(bf16_t*)(lds + S_M2 + t * 128 + sidx * 2) = f2bf(aM2[reg]);
        }
    }
    __syncthreads();
    unsigned char* ubase = p->ws + A_CHAIN + (size_t)((b * 4 + h) * 64 + c) * CHAIN_UNIT;
    f32x16 zero;
#pragma unroll
    for (int i = 0; i < 16; ++i) zero[i] = 0.f;
    f32x16 gt;
    {
        const f32x16 qv = mm64(lds, S_M1, S_APT, tm, tn, r, hh, zero);
        const f32x16 y0 = mm64(lds, S_M2, S_VT, tm, tn, r, hh, zero) - mm64(lds, S_M1, S_W2T, tm, tn, r, hh, zero);
        gt = mm64(lds, S_BET, S_APT, tm, tn, r, hh, zero);
        const f32x16 ht = mm64(lds, S_KAT, S_VT, tm, tn, r, hh, zero) - mm64(lds, S_BET, S_W2T, tm, tn, r, hh, zero);
#pragma unroll
        for (int reg = 0; reg < 16; ++reg) {
            const int t = tm * 32 + crow32(reg, hh), jc = tn * 32 + r;
            const float rh = bf2f(*(const bf16_t*)(lds + S_RH + t * 128 + jc * 2));
            *(bf16_t*)(lds + S_RP + t * 128 + jc * 2) = f2bf(rh - qv[reg]);
            const int jr = tm * 32 + crow32(reg, hh);
            const float gc = gamC[jr];
            gt[reg] = gc * (((jr == jc) ? 1.f : 0.f) - gt[reg]);
        }
        float4* himg = (float4*)(ubase + 16384); float4* yimg = (float4*)(ubase + 32768);
#pragma unroll
        for (int rq = 0; rq < 4; ++rq) {
            float4 hv, yv;
            hv.x = gamC[tm * 32 + crow32(4 * rq + 0, hh)] * ht[4 * rq + 0]; hv.y = gamC[tm * 32 + crow32(4 * rq + 1, hh)] * ht[4 * rq + 1];
            hv.z = gamC[tm * 32 + crow32(4 * rq + 2, hh)] * ht[4 * rq + 2]; hv.w = gamC[tm * 32 + crow32(4 * rq + 3, hh)] * ht[4 * rq + 3];
            yv.x = y0[4 * rq + 0]; yv.y = y0[4 * rq + 1]; yv.z = y0[4 * rq + 2]; yv.w = y0[4 * rq + 3];
            himg[((tn * 2 + tm) * 4 + rq) * 64 + lane] = hv;
            yimg[((tn * 2 + tm) * 4 + rq) * 64 + lane] = yv;
        }
    }
    __syncthreads();
#pragma unroll
    for (int reg = 0; reg < 16; ++reg) {
        const int jr = tm * 32 + crow32(reg, hh), jc = tn * 32 + r;
        *(bf16_t*)(lds + S_GTR + jr * 128 + jc * 2) = f2bf(gt[reg]);
    }
    __syncthreads();
    {
        uint4* gimg = (uint4*)(ubase); uint4* rimg = (uint4*)(ubase + 8192);
#pragma unroll
        for (int ii = 0; ii < 2; ++ii) {
            const int im = wv * 2 + ii, mt = im >> 2, jb = (im >> 1) & 1, s2 = im & 1;
            const int cbase = (32 * jb + 16 * s2 + 4 * hh) * 2;
            const uint2 g0 = *(const uint2*)(lds + S_GTR + (mt * 32 + r) * 128 + cbase), g1 = *(const uint2*)(lds + S_GTR + (mt * 32 + r) * 128 + cbase + 16);
            const uint2 r0 = *(const uint2*)(lds + S_RP + (mt * 32 + r) * 128 + cbase), r1 = *(const uint2*)(lds + S_RP + (mt * 32 + r) * 128 + cbase + 16);
            gimg[im * 64 + lane] = make_uint4(g0.x, g0.y, g1.x, g1.y);
            rimg[im * 64 + lane] = make_uint4(r0.x, r0.y, r1.x, r1.y);
        }
    }
    __syncthreads();
}

DEVINL void phaseB1(KP p, int l, char* lds, const int mask = 15, const int sub = 3) {
    const int nb = NBV();
    if (mask & 1) {
        const int blk = BIDX();
        for (int it = blk; it < 512; it += nb) {
            if (sub & 1) { b1_rwkv(p, l, lds, it * 2); b1_rwkv(p, l, lds, it * 2 + 1); }
            __threadfence_block(); __syncthreads();
            const int b = it >> 6, c = it & 63;
            if (sub & 2) {
#pragma unroll 1
                for (int h = 0; h < 4; ++h) b1e_unit(p, lds, b, h, c);
            }
        }
    }
    if (mask & 2) { const int blk = BIDX(); for (int it = blk; it < 1024; it += nb) b1_lru(p, l, lds, it); }
    if (mask & 4) { const int blk = BIDX(); for (int it = blk; it < 1024; it += nb) b1_conformer(p, l, lds, it); }
    if (mask & 8) { const int blk = BIDX(); for (int it = blk; it < 512; it += nb) b1_shortconv(p, l, it); }
}

DEVINL void phaseB2(KP p, int l, char* lds) {
    const int tid = TIDX(), blk = BIDX();
    if (blk >= 72) {
        if (l == 0) convert_ids(p, lds, 928, CONV_PER_L + 928, blk - 72, NBV() - 72);
        else convert_ids(p, lds, CONV_PER_L + 928, 2 * CONV_PER_L, blk - 72, NBV() - 72);
        return;
    }
    if (blk >= 64 && blk < 72) {
        const int bb = blk - 64;
        const float* ca = (const float*)(p->ws + A_CARRYA) + (size_t)bb * 128 * 256 + tid;
        const float* ch = (const float*)(p->ws + A_CARRYH) + (size_t)bb * 128 * 256 + tid;
        float* hst = (float*)(p->ws + A_HSTART) + (size_t)bb * 128 * 256 + tid;
        float hs = 0.f;
#pragma unroll 8
        for (int tt = 0; tt < 128; ++tt) { hst[tt * 256] = hs; hs = fmaf(ca[tt * 256], hs, ch[tt * 256]); }
    }
    if (blk < 64 && tid < 64) {
        const int lane = tid, r = lane & 31, hh = lane >> 5;
        const int bh = blk >> 1, w = blk & 1, b = bh >> 2, h = bh & 3;
        float* yraw = (float*)(p->ws + A_YRAW) + (size_t)b * SEQ * 256 + h * 64 + 32 * w + r;
        f32x16 X0, X1;
#pragma unroll
        for (int i = 0; i < 16; ++i) { X0[i] = 0.f; X1[i] = 0.f; }
        for (int c = 0; c < 64; ++c) {
            const unsigned char* ubase = p->ws + A_CHAIN + (size_t)(bh * 64 + c) * CHAIN_UNIT;
            const uint4* gimg = (const uint4*)ubase; const uint4* rimg = (const uint4*)(ubase + 8192);
            const float4* himg = (const float4*)(ubase + 16384); const float4* yimg = (const float4*)(ubase + 32768);
            uint4 gq[8], rq8[8]; float4 hq[8], yq[8];
#pragma unroll
            for (int i = 0; i < 8; ++i) { gq[i] = gimg[i * 64 + lane]; rq8[i] = rimg[i * 64 + lane]; }
#pragma unroll
            for (int i = 0; i < 8; ++i) { hq[i] = himg[(w * 8 + i) * 64 + lane]; yq[i] = yimg[(w * 8 + i) * 64 + lane]; }
            bf16x8 xp[4];
#pragma unroll
            for (int s2 = 0; s2 < 2; ++s2) {
                uint4 a, bq;
                a.x = pack2(X0[8 * s2 + 0], X0[8 * s2 + 1]); a.y = pack2(X0[8 * s2 + 2], X0[8 * s2 + 3]); a.z = pack2(X0[8 * s2 + 4], X0[8 * s2 + 5]); a.w = pack2(X0[8 * s2 + 6], X0[8 * s2 + 7]);
                bq.x = pack2(X1[8 * s2 + 0], X1[8 * s2 + 1]); bq.y = pack2(X1[8 * s2 + 2], X1[8 * s2 + 3]); bq.z = pack2(X1[8 * s2 + 4], X1[8 * s2 + 5]); bq.w = pack2(X1[8 * s2 + 6], X1[8 * s2 + 7]);
                xp[s2] = __builtin_bit_cast(bf16x8, a); xp[2 + s2] = __builtin_bit_cast(bf16x8, bq);
            }
#pragma unroll
            for (int mt = 0; mt < 2; ++mt) {
                f32x16 acc;
#pragma unroll
                for (int i = 0; i < 4; ++i) { acc[4 * i] = yq[mt * 4 + i].x; acc[4 * i + 1] = yq[mt * 4 + i].y; acc[4 * i + 2] = yq[mt * 4 + i].z; acc[4 * i + 3] = yq[mt * 4 + i].w; }
#pragma unroll
                for (int f = 0; f < 4; ++f) acc = MFMA32(__builtin_bit_cast(bf16x8, rq8[mt * 4 + f]), xp[f], acc);
#pragma unroll
                for (int reg = 0; reg < 16; ++reg) yraw[(size_t)(c * 64 + mt * 32 + crow32(reg, hh)) * 256] = acc[reg];
            }
            f32x16 n0, n1;
#pragma unroll
            for (int i = 0; i < 4; ++i) { n0[4 * i] = hq[i].x; n0[4 * i + 1] = hq[i].y; n0[4 * i + 2] = hq[i].z; n0[4 * i + 3] = hq[i].w;
                                          n1[4 * i] = hq[4 + i].x; n1[4 * i + 1] = hq[4 + i].y; n1[4 * i + 2] = hq[4 + i].z; n1[4 * i + 3] = hq[4 + i].w; }
#pragma unroll
            for (int f = 0; f < 4; ++f) { n0 = MFMA32(__builtin_bit_cast(bf16x8, gq[f]), xp[f], n0); n1 = MFMA32(__builtin_bit_cast(bf16x8, gq[4 + f]), xp[f], n1); }
            X0 = n0; X1 = n1;
        }
    }
}

DEVINL void phaseB3(KP p, int l) {
    const int c = TIDX(), nb = NBV(), blk = BIDX();
    const bf16_t* P = (const bf16_t*)(p->ws + A_P);
    bf16_t* ymix = (bf16_t*)(p->ws + A_YMIX);
    const float* yraw = (const float*)(p->ws + A_YRAW); const float* bonus = (const float*)(p->ws + A_BONUS); const float* gbuf = (const float*)(p->ws + A_G);
    const float* hloc = (const float*)(p->ws + A_HLOC); const float* cuma = (const float*)(p->ws + A_CUMA); const float* hst = (const float*)(p->ws + A_HSTART);
    const float gng = p->in[I_GNG][l * 256 + c], gnb = p->in[I_GNB][l * 256 + c];
    for (int it = blk; it < 512; it += nb) {
#pragma unroll 4
        for (int rr = 0; rr < 64; ++rr) {
            const int row = it * 64 + rr, b = row >> 12, tt = (row & 4095) >> 5;
            const size_t o = (size_t)row * 256 + c;
            const float y = yraw[o];
            const float mu = wave_sum(y) * (1.f / 64.f);
            const float d = y - mu;
            const float var = wave_sum(d * d) * (1.f / 64.f);
            const float yn = d * rsqrtf(var + GN_EPS) * gng + gnb;
            ymix[(size_t)row * DM + 512 + c] = f2bf((yn + bonus[o]) * gbuf[o]);
            const float hh = fmaf(cuma[o], hst[(size_t)(b * 128 + tt) * 256 + c], hloc[o]);
            const float gb = bf2f(P[(size_t)row * PIN + 768 + c]);
            ymix[(size_t)row * DM + 256 + c] = f2bf(hh * gelu_tanh(gb));
        }
    }
}

DEVINL void phaseD(KP p, int l, char* lds, const int dry = 0) {
    const int tid = TIDX(), nb = NBV(), blk = BIDX(), wid = tid >> 6, lane = tid & 63;
    constexpr int URS = 2064;
    char* uh = lds;
    char* ulo = lds + 16 * URS;
    float* logit = (float*)(lds + 32 * URS);
    int* sel_e = (int*)(lds + 32 * URS + 4096);
    int* lpos = sel_e + 512;
    int* hist = lpos + 512;
    int* basep = hist + 64;
    const bf16_t* wrt_hi = (const bf16_t*)(p->ws + OFF_WR) + (size_t)(l * 2 + 0) * 64 * 1024;
    const bf16_t* wrt_lo = (const bf16_t*)(p->ws + OFF_WR) + (size_t)(l * 2 + 1) * 64 * 1024;
    const float* xbuf = p->out;
    float* xout = dry ? (float*)(p->ws + A_P) : p->out;
    bf16_t* ubuf = (bf16_t*)(p->ws + (dry ? A_YMIX : OFF_UBUF));
    const float* mod = (const float*)(p->ws + OFF_MOD);
    const float* wr = p->in[I_WROUTER] + (size_t)l * 1024 * 64 + lane;
    const float ebias = p->in[I_EBIAS][l * 64 + lane];
    unsigned* cnt = (unsigned*)(p->ws + OFF_CNT) + l * 64 + (dry ? 256 : 0);
    int* list = (int*)(p->ws + (dry ? M_HBUF : M_LIST));
    float* wsel = (float*)(p->ws + (dry ? M_HBUF + 16777216 : M_WSEL));
    int* pmap = (int*)(p->ws + (dry ? M_HBUF + 33554432 : M_PMAP));
    for (int it = blk; it < 512; it += nb) {
        const int tok0 = it * 64;
        if (tid < 64) hist[tid] = 0;
        for (int sb = 0; sb < 4; ++sb) {
#pragma unroll
            for (int j = 0; j < 4; ++j) {
                const int tl = wid * 4 + j, row = tok0 + sb * 16 + tl, b = row >> 12;
                float4 z[4];
                float s = 0.f;
#pragma unroll
                for (int i = 0; i < 4; ++i) { z[i] = *(const float4*)(xbuf + (size_t)row * DM + i * 256 + lane * 4); s += z[i].x + z[i].y + z[i].z + z[i].w; }
                const float mean = wave_sum(s) * (1.f / 1024.f);
                float q = 0.f;
#pragma unroll
                for (int i = 0; i < 4; ++i) { z[i].x -= mean; z[i].y -= mean; z[i].z -= mean; z[i].w -= mean; q += z[i].x * z[i].x + z[i].y * z[i].y + z[i].z * z[i].z + z[i].w * z[i].w; }
                const float rs = rsqrtf(wave_sum(q) * (1.f / 1024.f) + LN_EPS);
#pragma unroll
                for (int i = 0; i < 4; ++i) {
                    const int col = i * 256 + lane * 4;
                    const float4 g = *(const float4*)(p->in[I_LN1G] + l * 1024 + col), bb = *(const float4*)(p->in[I_LN1B] + l * 1024 + col);
                    const float4 sh = *(const float4*)(mod + (size_t)(l * 8 + b) * 6144 + 3072 + col), sc = *(const float4*)(mod + (size_t)(l * 8 + b) * 6144 + 4096 + col);
                    float4 x1; x1.x = z[i].x * rs * g.x + bb.x; x1.y = z[i].y * rs * g.y + bb.y; x1.z = z[i].z * rs * g.z + bb.z; x1.w = z[i].w * rs * g.w + bb.w;
                    *(float4*)(xout + (size_t)row * DM + col) = x1;
                    float4 u; u.x = x1.x * (1.f + sc.x) + sh.x; u.y = x1.y * (1.f + sc.y) + sh.y; u.z = x1.z * (1.f + sc.z) + sh.z; u.w = x1.w * (1.f + sc.w) + sh.w;
                    uint2 o; o.x = pack2(u.x, u.y); o.y = pack2(u.z, u.w);
                    *(uint2*)(ubuf + (size_t)row * DM + col) = o;
                    *(uint2*)(uh + tl * URS + col * 2) = o;
                    uint2 o2; o2.x = pack2(u.x - __uint_as_float(o.x << 16), u.y - __uint_as_float(o.x & 0xFFFF0000u)); o2.y = pack2(u.z - __uint_as_float(o.y << 16), u.w - __uint_as_float(o.y & 0xFFFF0000u));
                    *(uint2*)(ulo + tl * URS + col * 2) = o2;
                }
            }
            __syncthreads();
            {
                const int fr = lane & 15, fq = lane >> 4;
                f32x4 lacc = (f32x4){0.f, 0.f, 0.f, 0.f};
                const bf16_t* bh = wrt_hi + (size_t)(wid * 16 + fr) * 1024 + fq * 8;
                const bf16_t* bl = wrt_lo + (size_t)(wid * 16 + fr) * 1024 + fq * 8;
#pragma unroll 1
                for (int k8 = 0; k8 < 4; ++k8) {
                    bf16x8 bhv[8], blv[8];
#pragma unroll
                    for (int kk = 0; kk < 8; ++kk) { bhv[kk] = *(const bf16x8*)(bh + (k8 * 8 + kk) * 32); blv[kk] = *(const bf16x8*)(bl + (k8 * 8 + kk) * 32); }
#pragma unroll
                    for (int kk = 0; kk < 8; ++kk) {
                        const int ko = (k8 * 8 + kk) * 64 + fq * 16;
                        const bf16x8 ah = *(const bf16x8*)(uh + fr * URS + ko), al = *(const bf16x8*)(ulo + fr * URS + ko);
                        lacc = __builtin_amdgcn_mfma_f32_16x16x32_bf16(ah, bhv[kk], lacc, 0, 0, 0);
                        lacc = __builtin_amdgcn_mfma_f32_16x16x32_bf16(al, bhv[kk], lacc, 0, 0, 0);
                        lacc = __builtin_amdgcn_mfma_f32_16x16x32_bf16(ah, blv[kk], lacc, 0, 0, 0);
                    }
                }
#pragma unroll
                for (int j = 0; j < 4; ++j) logit[(fq * 4 + j) * 64 + wid * 16 + fr] = lacc[j];
            }
            __syncthreads();
            float acc[4];
#pragma unroll
            for (int j = 0; j < 4; ++j) acc[j] = logit[(wid * 4 + j) * 64 + lane];
#pragma unroll
            for (int j = 0; j < 4; ++j) {
                const int tl = sb * 16 + wid * 4 + j;
                const float score = 1.f / (1.f + __expf(-acc[j]));
                const float biased = score + ebias;
                const float m1 = group8_max(biased);
                const unsigned long long eq = __ballot(biased == m1);
                const int g = lane >> 3;
                const unsigned gm = (unsigned)(eq >> (g * 8)) & 0xFFu;
                const int first = __ffs((int)gm) - 1;
                const float v2 = ((lane & 7) == first) ? -INFINITY : biased;
                const float m2 = group8_max(v2);
                const float gs = m1 + m2;
                int rg = 0;
#pragma unroll
                for (int g2 = 0; g2 < 8; ++g2) { const float o = __builtin_bit_cast(float, __builtin_amdgcn_readlane(__builtin_bit_cast(int, gs), g2 * 8)); rg += ((o > gs) || (o == gs && g2 < g)) ? 1 : 0; }
                const bool keep = rg < 4;
                const float mk = keep ? biased : -INFINITY;
                int rk = 0;
#pragma unroll
                for (int e2 = 0; e2 < 64; ++e2) { const float o = __builtin_bit_cast(float, __builtin_amdgcn_readlane(__builtin_bit_cast(int, mk), e2)); rk += ((o > mk) || (o == mk && e2 < lane)) ? 1 : 0; }
                const bool sel = keep && (rk < 8);
                const float ssum = wave_sum(sel ? score : 0.f);
                const float wgt = score / ssum * 2.5f;
                const unsigned long long sm = __ballot(sel);
                const int kidx = __popcll(sm & ((1ull << lane) - 1ull));
                if (sel) { wsel[(size_t)(tok0 + tl) * 8 + kidx] = wgt; sel_e[tl * 8 + kidx] = lane; }
            }
            __syncthreads();
        }
        for (int i = tid; i < 512; i += VTHREADS) lpos[i] = atomicAdd(&hist[sel_e[i]], 1);
        __syncthreads();
        if (tid < 64) basep[tid] = (int)atomicAdd(&cnt[tid], (unsigned)hist[tid]);
        __syncthreads();
        for (int i = tid; i < 512; i += VTHREADS) { const int e = sel_e[i], pos = basep[e] + lpos[i]; list[(size_t)e * NTOK + pos] = tok0 * 8 + i; pmap[tok0 * 8 + i] = (e << 16) | pos; }
        __syncthreads();
    }
}

DEVINL void phaseA(KP p, int l, char* lds) {
    const int tid = TID512(), c = blockIdx.x, G = gridDim.x;
    const char* ubuf = (const char*)(p->ws + OFF_UBUF);
    const char* Wt = (const char*)(p->ws + OFF_WIN) + (size_t)l * WIN_ROWS * 1024 * 2;
    bf16_t* P = (bf16_t*)(p->ws + A_P);
    auto sched = [&](int i, GUnit& u) -> bool {
        const long L = unit_linear(i, c, G); if (L >= 128 * 11) return false;
        const int Li = (int)L, sx = Li >> 9, w = (sx == 2) ? 3 : 4, rem = Li - (sx << 9), pm = rem / w, pn = sx * 4 + (rem - pm * w);
        u.A = ubuf + (size_t)pm * 256 * 2048; u.B = Wt + (size_t)pn * 256 * 2048; u.i0 = pm; u.i1 = pn; u.i2 = 0;
        return true;
    };
    auto epi = [&](f32x4 (&acc)[2][2][4][2], const GUnit& u, int wr, int wc, int fr, int fq) {
        asm volatile("" : "+v"(fr), "+v"(fq));
        const int row0 = u.i0 * 256 + wr * 64 + fr, col0 = u.i1 * 256 + wc * 32 + 8 * fq;
#pragma unroll
        for (int ai = 0; ai < 2; ++ai)
#pragma unroll
            for (int m = 0; m < 4; ++m) {
                bf16_t* rowp = P + (size_t)(row0 + ai * 128 + m * 16) * PIN + col0;
#pragma unroll
                for (int bj = 0; bj < 2; ++bj) {
                    if (col0 + bj * 128 < PIN) {
                        const f32x4 v0 = acc[ai][bj][m][0], v1 = acc[ai][bj][m][1];
                        *(uint4*)(rowp + bj * 128) = make_uint4(pack2(v0[0], v0[1]), pack2(v0[2], v0[3]), pack2(v1[0], v1[1]), pack2(v1[2], v1[3]));
                    }
                }
            }
    };
    gemm256<true, false>(lds, 1024, 1024, sched, epi);
}

DEVINL void phaseC(KP p, int l, char* lds) {
    const int tid = TID512(), c = blockIdx.x, G = gridDim.x;
    const char* ymix = (const char*)(p->ws + A_YMIX);
    const char* Wt = (const char*)(p->ws + OFF_WOUT) + (size_t)l * 1024 * 1024 * 2;
    const float* res = (l == 0) ? p->in[I_X] : p->out;
    float* xbuf = p->out;
    const float* mod = (const float*)(p->ws + OFF_MOD);
    auto sched = [&](int i, GUnit& u) -> bool {
        const long L = unit_linear(i, c, G); if (L >= 128 * 4) return false;
        const int pm = (int)L >> 2, pn = (int)L & 3;
        u.A = ymix + (size_t)pm * 256 * 2048; u.B = Wt + (size_t)pn * 256 * 2048; u.i0 = pm; u.i1 = pn; u.i2 = 0;
        return true;
    };
    auto epi = [&](f32x4 (&acc)[2][2][4][2], const GUnit& u, int wr, int wc, int fr, int fq) {
        asm volatile("" : "+v"(fr), "+v"(fq));
        const int row0 = u.i0 * 256 + wr * 64 + fr, col0 = u.i1 * 256 + wc * 32 + 4 * fq;
#pragma unroll
        for (int ai = 0; ai < 2; ++ai)
#pragma unroll
            for (int m = 0; m < 4; ++m) {
                const int row = row0 + ai * 128 + m * 16, b = row >> 12;
#pragma unroll
                for (int bj = 0; bj < 2; ++bj)
#pragma unroll
                    for (int n = 0; n < 2; ++n) {
                        const int col = col0 + bj * 128 + n * 16;
                        const float4 g1 = *(const float4*)(mod + (size_t)(l * 8 + b) * 6144 + 2048 + col);
                        const float4 rx = *(const float4*)(res + (size_t)row * DM + col);
                        const f32x4 a = acc[ai][bj][m][n];
                        float4 z;
                        z.x = ALPHA * rx.x + (1.f + g1.x) * a[0]; z.y = ALPHA * rx.y + (1.f + g1.y) * a[1];
                        z.z = ALPHA * rx.z + (1.f + g1.z) * a[2]; z.w = ALPHA * rx.w + (1.f + g1.w) * a[3];
                        *(float4*)(xbuf + (size_t)row * DM + col) = z;
                    }
            }
    };
    gemm256<false, false>(lds, 1024, 1024, sched, epi);
}

constexpr int DIR_OFF = 131072;
DEVINL void moe_directory(KP p, int l, char* lds) {
    int* pref = (int*)(lds + DIR_OFF);
    int* cntl = (int*)(lds + DIR_OFF + 512);
    unsigned* cnt = (unsigned*)(p->ws + OFF_CNT) + l * 64;
    asm volatile("" : "+s"(cnt));
    if (threadIdx.x == 0) {
        int s = 0;
        int* xpre = (int*)(lds + DIR_OFF + 1024);
        int x = 0;
        for (int e = 0; e < 64; ++e) { const int c = (int)__hip_atomic_load(&cnt[e], __ATOMIC_RELAXED, __HIP_MEMORY_SCOPE_AGENT); cntl[e] = c; pref[e] = s; s += (c + 255) >> 8; xpre[e] = x; x += c; }
        pref[64] = s; cntl[64] = NTOK; pref[65] = s + 128; xpre[64] = x;
    }
    __syncthreads();
}

DEVINL void phaseE1(KP p, int l, char* lds) {
    const int tid = TID512(), c = blockIdx.x, G = gridDim.x;
    moe_directory(p, l, lds);
    const int* pref = (const int*)(lds + DIR_OFF); const int* cntl = (const int*)(lds + DIR_OFF + 512);
    const char* ubuf = (const char*)(p->ws + OFF_UBUF);
    const int* list = (const int*)(p->ws + M_LIST);
    bf16_t* hbuf = (bf16_t*)(p->ws + M_HBUF);
    const char* W13 = (const char*)(p->ws + OFF_W13) + (size_t)(l * 65) * 512 * 1024 * 2;
    const int total = __builtin_amdgcn_readfirstlane(pref[65]) * 2;
    auto sched = [&](int i, GUnit& u) -> bool {
        const long L = unit_linear(i, c, G); if (L >= total) return false;
        const int mg = (int)L >> 1, nt = (int)L & 1;
        int e = 0; while (pref[e + 1] <= mg) ++e;
        e = __builtin_amdgcn_readfirstlane(e);
        const int mt = __builtin_amdgcn_readfirstlane(mg - pref[e]), Me = __builtin_amdgcn_readfirstlane(cntl[e]);
        u.A = ubuf; u.B = W13 + ((size_t)e * 512 + nt * 256) * 2048; u.i0 = mg; u.i1 = nt; u.i2 = e;
        int R[2], C[2]; stage_coords512(TID512(), R, C);
#pragma unroll
        for (int h = 0; h < 2; ++h)
#pragma unroll
            for (int i2 = 0; i2 < 2; ++i2) {
                const int idx = mt * 256 + h * 128 + R[i2]; int tok;
                if (e < 64) tok = (idx < Me) ? (list[(size_t)e * NTOK + idx] >> 3) : 0; else tok = idx;
                u.va[h][i2] = (unsigned)(tok * 1024 + C[i2]) * 2u;
            }
        return true;
    };
    auto epi = [&](f32x4 (&acc)[2][2][4][2], const GUnit& u, int wr, int wc, int fr, int fq) {
        asm volatile("" : "+v"(fr), "+v"(fq));
        const size_t row0 = (size_t)u.i0 * 256 + wr * 64 + fr;
#pragma unroll
        for (int ai = 0; ai < 2; ++ai)
#pragma unroll
            for (int m = 0; m < 4; ++m) {
                bf16_t* rowp = hbuf + (row0 + ai * 128 + m * 16) * 256;
#pragma unroll
                for (int bj = 0; bj < 2; ++bj) {
                    const int hcol = (u.i1 * 8 + bj * 4 + wc) * 16 + 4 * fq;
                    const f32x4 gt = acc[ai][bj][m][0], up = acc[ai][bj][m][1];
                    float hv[4];
#pragma unroll
                    for (int j = 0; j < 4; ++j) hv[j] = gt[j] * sigm(gt[j]) * up[j];
                    uint2 o; o.x = pack2(hv[0], hv[1]); o.y = pack2(hv[2], hv[3]);
                    *(uint2*)(rowp + hcol) = o;
                }
            }
    };
    gemm256<false, true>(lds, 1024, 1024, sched, epi);
}

DEVINL void phaseE2(KP p, int l, char* lds) {
    const int tid = TID512(), c = blockIdx.x, G = gridDim.x;
    moe_directory(p, l, lds);
    const int* pref = (const int*)(lds + DIR_OFF); const int* cntl = (const int*)(lds + DIR_OFF + 512);
    const int* xpre = (const int*)(lds + DIR_OFF + 1024);
    const char* hbuf = (const char*)(p->ws + M_HBUF);
    unsigned char* ybuf = (unsigned char*)(p->ws + M_YBUF);
    const char* W2 = (const char*)(p->ws + OFF_W2) + (size_t)(l * 65) * 1024 * 256 * 2;
    const int total = __builtin_amdgcn_readfirstlane(pref[65]) * 4;
    auto sched = [&](int i, GUnit& u) -> bool {
        const long L = unit_linear(i, c, G); if (L >= total) return false;
        const int mg = (int)L >> 2, nt = (int)L & 3;
        int e = 0; while (pref[e + 1] <= mg) ++e;
        e = __builtin_amdgcn_readfirstlane(e);
        u.A = hbuf + (size_t)mg * 256 * 512; u.B = W2 + ((size_t)e * 1024 + nt * 256) * 512; u.i0 = mg; u.i1 = nt; u.i2 = e;
        return true;
    };
    auto epi = [&](f32x4 (&acc)[2][2][4][2], const GUnit& u, int wr, int wc, int fr, int fq) {
        asm volatile("" : "+v"(fr), "+v"(fq));
        const int e = __builtin_amdgcn_readfirstlane(u.i2), mt = __builtin_amdgcn_readfirstlane(u.i0 - pref[e]), Me = __builtin_amdgcn_readfirstlane(cntl[e]);
        const int yrow0 = __builtin_amdgcn_readfirstlane(xpre[e]) + mt * 256;
        const int col0 = u.i1 * 256 + wc * 32 + 8 * fq, loc0 = wr * 64 + fr;
#pragma unroll
        for (int ai = 0; ai < 2; ++ai)
#pragma unroll
            for (int m = 0; m < 4; ++m) {
                const int loc = loc0 + ai * 128 + m * 16;
                if (mt * 256 + loc < Me) {
                    unsigned char* rowp = ybuf + (size_t)(yrow0 + loc) * 1024 + col0;
#pragma unroll
                    for (int bj = 0; bj < 2; ++bj) {
                        const f32x4 v0 = acc[ai][bj][m][0], v1 = acc[ai][bj][m][1];
                        int w0 = __builtin_amdgcn_cvt_pk_fp8_f32(v0[0], v0[1], 0, false); w0 = __builtin_amdgcn_cvt_pk_fp8_f32(v0[2], v0[3], w0, true);
                        int w1 = __builtin_amdgcn_cvt_pk_fp8_f32(v1[0], v1[1], 0, false); w1 = __builtin_amdgcn_cvt_pk_fp8_f32(v1[2], v1[3], w1, true);
                        *(uint2*)(rowp + bj * 128) = make_uint2((unsigned)w0, (unsigned)w1);
                    }
                }
            }
    };
    gemm256<true, false>(lds, 256, 256, sched, epi);
}

DEVINL void phaseF(KP p, int l, const int dry = 0) {
    const int tid = TIDX(), nb = NBV(), blk = BIDX(), wid = tid >> 6, lane = tid & 63;
    const float* xbuf = p->out;
    float* xout = dry ? (float*)(p->ws + M_HBUF) : p->out;
    const unsigned char* ybuf = (const unsigned char*)(p->ws + M_YBUF);
    bf16_t* ubuf = (bf16_t*)(p->ws + OFF_UBUF);
    const float* mod = (const float*)(p->ws + OFF_MOD);
    const int* pmap = (const int*)(p->ws + M_PMAP); const float* wsel = (const float*)(p->ws + M_WSEL);
    int xoff;
    {
        const unsigned* cnt = (const unsigned*)(p->ws + OFF_CNT) + l * 64;
        const int c = (int)__hip_atomic_load(&cnt[lane], __ATOMIC_RELAXED, __HIP_MEMORY_SCOPE_AGENT);
        xoff = 0;
#pragma unroll
        for (int j = 0; j < 64; ++j) { const int cj = __builtin_amdgcn_readlane(c, j); xoff += (j < lane) ? cj : 0; }
    }
    for (int row = blk * 4 + wid; row < NTOK; row += nb * 4) {
        const int b = row >> 12;
        int yr = 0; float yw = 0.f;
        if (lane < 8) { const int pm = pmap[row * 8 + lane]; yr = pm; yw = wsel[row * 8 + lane]; }
        { const int e = (yr >> 16) & 63; const int xo = __builtin_amdgcn_ds_bpermute(e << 2, xoff); yr = xo + (yr & 0xFFFF); }
        int yrow[8]; float yww[8];
#pragma unroll
        for (int k = 0; k < 8; ++k) { yrow[k] = __builtin_amdgcn_readlane(yr, k); yww[k] = __builtin_bit_cast(float, __builtin_amdgcn_readlane(__builtin_bit_cast(int, yw), k)); }
        float4 z[4]; float s = 0.f;
#pragma unroll
        for (int i = 0; i < 4; ++i) {
            const int col = i * 256 + lane * 4;
            const float4 x1 = *(const float4*)(xbuf + (size_t)row * DM + col);
            float f0, f1, f2, f3;
            { const int yv = *(const int*)(ybuf + ((size_t)(262144 + row)) * 1024 + col);
              const f2_t lo = __builtin_amdgcn_cvt_pk_f32_fp8(yv, false), hi = __builtin_amdgcn_cvt_pk_f32_fp8(yv, true);
              f0 = lo[0]; f1 = lo[1]; f2 = hi[0]; f3 = hi[1]; }
            int yvk[8];
#pragma unroll
            for (int k = 0; k < 8; ++k) yvk[k] = *(const int*)(ybuf + (size_t)yrow[k] * 1024 + col);
#pragma unroll
            for (int k = 0; k < 8; ++k) {
                const f2_t lo = __builtin_amdgcn_cvt_pk_f32_fp8(yvk[k], false), hi = __builtin_amdgcn_cvt_pk_f32_fp8(yvk[k], true);
                const float w = yww[k];
                f0 = fmaf(w, lo[0], f0); f1 = fmaf(w, lo[1], f1); f2 = fmaf(w, hi[0], f2); f3 = fmaf(w, hi[1], f3);
            }
            const float4 g2 = *(const float4*)(mod + (size_t)(l * 8 + b) * 6144 + 5120 + col);
            z[i].x = ALPHA * x1.x + (1.f + g2.x) * f0; z[i].y = ALPHA * x1.y + (1.f + g2.y) * f1; z[i].z = ALPHA * x1.z + (1.f + g2.z) * f2; z[i].w = ALPHA * x1.w + (1.f + g2.w) * f3;
            s += z[i].x + z[i].y + z[i].z + z[i].w;
        }
        const float mean = wave_sum(s) * (1.f / 1024.f);
        float q = 0.f;
#pragma unroll
        for (int i = 0; i < 4; ++i) { z[i].x -= mean; z[i].y -= mean; z[i].z -= mean; z[i].w -= mean; q += z[i].x * z[i].x + z[i].y * z[i].y + z[i].z * z[i].z + z[i].w * z[i].w; }
        const float rs = rsqrtf(wave_sum(q) * (1.f / 1024.f) + LN_EPS);
#pragma unroll
        for (int i = 0; i < 4; ++i) {
            const int col = i * 256 + lane * 4;
            const float4 g = *(const float4*)(p->in[I_LN2G] + l * 1024 + col), bb = *(const float4*)(p->in[I_LN2B] + l * 1024 + col);
            float4 x2; x2.x = z[i].x * rs * g.x + bb.x; x2.y = z[i].y * rs * g.y + bb.y; x2.z = z[i].z * rs * g.z + bb.z; x2.w = z[i].w * rs * g.w + bb.w;
            *(float4*)(xout + (size_t)row * DM + col) = x2;
            if (l + 1 < DEPTH) {
                const float4 sh = *(const float4*)(mod + (size_t)((l + 1) * 8 + b) * 6144 + col), sc = *(const float4*)(mod + (size_t)((l + 1) * 8 + b) * 6144 + 1024 + col);
                uint2 o; o.x = pack2(x2.x * (1.f + sc.x) + sh.x, x2.y * (1.f + sc.y) + sh.y); o.y = pack2(x2.z * (1.f + sc.z) + sh.z, x2.w * (1.f + sc.w) + sh.w);
                *(uint2*)(ubuf + (size_t)row * DM + col) = o;
            }
        }
    }
}

#define XB_TMO      128
#define XB_XCNT(j)  (256  + 64 * (j))
#define XB_XSUB(j)  (1280 + 64 * (j))
#define XB_XGEN(j)  (2304 + 64 * (j))
#define XB_TOP      3328
#define XB_TOPGEN   3392
#define XCD_BAR_WORDS 3456
#define XB_SPIN_CAP (1u << 20)
DEVINL unsigned xb_ld(unsigned* p)              { return __hip_atomic_load(p, __ATOMIC_RELAXED, __HIP_MEMORY_SCOPE_AGENT); }
DEVINL unsigned xb_add(unsigned* p, unsigned v) { return __hip_atomic_fetch_add(p, v, __ATOMIC_RELAXED, __HIP_MEMORY_SCOPE_AGENT); }
DEVINL unsigned xb_xcc_id() { return (unsigned)__builtin_amdgcn_s_getreg((3 << 11) | 20) & 0xFu; }
#define XB_SPIN(cond, bar) do { unsigned _sp = 0; while (cond) { __builtin_amdgcn_s_sleep(1); \
    if ((++_sp & 255u) == 0u) { if (xb_ld(&(bar)[XB_TMO])) break; if (_sp > XB_SPIN_CAP) { atomicAdd(&(bar)[XB_TMO], 1u); break; } } } } while (0)
struct XcdBarrier { unsigned* bar; unsigned x; volatile LAS unsigned* st; };
DEVINL XcdBarrier xcd_barrier_post(unsigned* bar, volatile LAS unsigned* st) {
    XcdBarrier b; b.bar = bar; b.x = xb_xcc_id(); b.st = st;
    if (threadIdx.x == 0) (void)xb_add(&bar[XB_XCNT(b.x)], 1u);
    return b;
}
DEVINL void xcd_barrier_complete(unsigned* bar, unsigned x, unsigned& nloc, unsigned& nx) {
    const unsigned G = gridDim.x * gridDim.y * gridDim.z;
    unsigned sum, cnt, mine, sp = 0u;
    for (;;) {
        sum = 0u; cnt = 0u; mine = 0u;
#pragma unroll 1
        for (unsigned j = 0; j < 16; ++j) { const unsigned c = xb_ld(&bar[XB_XCNT(j)]); sum += c; cnt += (c > 0u) ? 1u : 0u; mine = (j == x) ? c : mine; }
        if (sum == G) break;
        __builtin_amdgcn_s_sleep(1);
        if ((++sp & 255u) == 0u) { if (xb_ld(&bar[XB_TMO])) break; if (sp > XB_SPIN_CAP) { atomicAdd(&bar[XB_TMO], 1u); break; } }
    }
    nloc = mine > 0u ? mine : 1u; nx = cnt > 0u ? cnt : 1u;
}
DEVINL void xcd_barrier(const XcdBarrier& b) {
    asm volatile("s_waitcnt vmcnt(0)" ::: "memory");
    __syncthreads();
    if (threadIdx.x == 0) {
        unsigned* bar = b.bar;
        __builtin_amdgcn_s_waitcnt(0);
        unsigned nloc = b.st[0], nx = b.st[1];
        if (nloc == 0u) { xcd_barrier_complete(bar, b.x, nloc, nx); b.st[0] = nloc; b.st[1] = nx; }
        const unsigned old = xb_add(&bar[XB_XSUB(b.x)], 1u);
        const unsigned gen = old / nloc;
        if (old + 1u == (gen + 1u) * nloc) {
            __builtin_amdgcn_fence(__ATOMIC_RELEASE, "agent");
            asm volatile("s_waitcnt vmcnt(0)" ::: "memory");
            const unsigned og = xb_add(&bar[XB_TOP], 1u);
            const unsigned tg = og / nx;
            if (og + 1u == (tg + 1u) * nx) xb_add(&bar[XB_TOPGEN], 1u);
            else XB_SPIN(xb_ld(&bar[XB_TOPGEN]) == tg, bar);
            __builtin_amdgcn_fence(__ATOMIC_ACQUIRE, "agent");
            xb_add(&bar[XB_XGEN(b.x)], 1u);
            asm volatile("s_waitcnt vmcnt(0)" ::: "memory");
        } else {
            XB_SPIN(xb_ld(&bar[XB_XGEN(b.x)]) == gen, bar);
            __builtin_amdgcn_fence(__ATOMIC_ACQUIRE, "agent");
            asm volatile("s_waitcnt vmcnt(0)" ::: "memory");
        }
    }
    __syncthreads();
}

constexpr int PPL = 12;
constexpr int NPHASE = 2 + PPL * DEPTH;
#ifndef PROBE_SUB
#define PROBE_SUB 3
#endif
#ifndef PROBE_REP
#define PROBE_REP (-1)
#endif
__global__ void __launch_bounds__(NTHREADS, 2) mega(Params p_arg, int ph_lo, int ph_hi) {
    extern __shared__ __attribute__((aligned(16))) char lds[];
    cg::grid_group grid = cg::this_grid();
    volatile LAS unsigned* st = (volatile LAS unsigned*)(lds + LDS_BYTES - 16);
    if (threadIdx.x == 0) { st[0] = 0u; st[1] = 0u; }
    __syncthreads();
    XcdBarrier xb = xcd_barrier_post((unsigned*)(p_arg.ws + OFF_BAR), st);
    for (int ph = ph_lo; ph < ph_hi; ++ph) {
        KP p = (KP)__builtin_amdgcn_kernarg_segment_ptr();
        asm volatile("" : "+s"(p));
        const int l = (ph >= 2) ? (ph - 2) / PPL : 0;
        const int q = (ph >= 2) ? (ph - 2) % PPL : -1;
        const bool nobar = (q >= 1 && q <= 3);
        const int nrep = (PROBE_REP >= 0 && ph == PROBE_REP) ? 2 : 1;
        for (int rep = 0; rep < nrep; ++rep) {
            const int dry = (PROBE_REP >= 0 && ph == PROBE_REP && rep == 0) ? 1 : 0;
            char* ldsh = lds + (threadIdx.x >> 8) * LDS_HALF;
            if (ph == 0) phase0(p, ldsh);
            else if (ph == 1) phaseF0(p);
            else {
                switch (q) {
                    case 0: phaseA(p, l, lds); break;
                    case 1: phaseB1(p, l, ldsh, 1, (PROBE_REP >= 0 && ph == PROBE_REP && rep == 1) ? PROBE_SUB : 3); break;
                    case 2: phaseB1(p, l, ldsh, 2); break;
                    case 3: phaseB1(p, l, ldsh, 4); break;
                    case 4: phaseB1(p, l, ldsh, 8); break;
                    case 5: phaseB2(p, l, ldsh); break;
                    case 6: phaseB3(p, l); break;
                    case 7: phaseC(p, l, lds); break;
                    case 8: phaseD(p, l, ldsh, dry); break;
                    case 9: phaseE1(p, l, lds); break;
                    case 10: phaseE2(p, l, lds); break;
                    default: phaseF(p, l, dry); break;
                }
            }
            const bool lastrep = (rep + 1 == nrep);
            if (!lastrep || (ph + 1 < ph_hi && !nobar)) { if (lastrep && ph == ph_lo) grid.sync(); else xcd_barrier(xb); }
        }
    }
}

extern "C" void kernel_launch(void* const* d_in, const int* in_sizes, int n_in, void* d_out, int out_size, void* d_ws, size_t ws_size, hipStream_t stream) {
    static int grid_blocks = 0;
    if (grid_blocks == 0) {
        if (n_in != 39 || out_size != NTOK * DM || ws_size < WS_NEED) { fprintf(stderr, "kernel_launch: unexpected shapes (n_in %d out %d ws %zu need %zu)\n", n_in, out_size, ws_size, (size_t)WS_NEED); grid_blocks = -1; return; }
        int dev = 0, cus = 0, per_cu = 0;
        hipGetDevice(&dev);
        hipDeviceGetAttribute(&cus, hipDeviceAttributeMultiprocessorCount, dev);
        hipFuncSetAttribute((const void*)mega, hipFuncAttributeMaxDynamicSharedMemorySize, LDS_BYTES);
        hipOccupancyMaxActiveBlocksPerMultiprocessor(&per_cu, (const void*)mega, NTHREADS, LDS_BYTES);
        if (per_cu < 1) { fprintf(stderr, "kernel_launch: occupancy query returned %d\n", per_cu); grid_blocks = -1; return; }
        if (cus < 256) { fprintf(stderr, "kernel_launch: this build needs 256 CUs (found %d)\n", cus); grid_blocks = -1; return; }
        grid_blocks = 256;
    }
    if (grid_blocks < 0) return;
    if (hipMemsetAsync(d_ws, 0, 32768, stream) != hipSuccess) { fprintf(stderr, "kernel_launch: memset failed\n"); return; }
    Params p{};
    for (int i = 0; i < 39; ++i) p.in[i] = (const float*)d_in[i];
    p.out = (float*)d_out; p.ws = (unsigned char*)d_ws;
    int ph_lo = 0, ph_hi = NPHASE;
    void* args[] = {&p, &ph_lo, &ph_hi};
    hipError_t e = hipLaunchCooperativeKernel((const void*)mega, dim3(grid_blocks), dim3(NTHREADS), args, LDS_BYTES, stream);
    if (e != hipSuccess) fprintf(stderr, "cooperative launch failed: %s (grid %d)\n", hipGetErrorString(e), grid_blocks);
}
```

```cpp
#include <hip/hip_runtime.h>
#include <hip/hip_cooperative_groups.h>
#include <stdio.h>
#include <stdint.h>
namespace cg = cooperative_groups;

typedef unsigned short bf16_t;
typedef short bf16x8 __attribute__((ext_vector_type(8)));
typedef float f32x4 __attribute__((ext_vector_type(4)));
#define DEVINL __device__ __forceinline__
#define LAS __attribute__((address_space(3)))

constexpr int NTOK = 32768, SEQ = 4096, NBATCH = 8, DM = 1024, PIN = 2688, DEPTH = 2;
constexpr int NEXP = 64;
constexpr float ALPHA = 1.41421356237f;
constexpr float LN_EPS = 1e-5f, GN_EPS = 64e-5f;
constexpr int NTHREADS = 512;
constexpr int VTHREADS = 256;
constexpr int LDS_HALF = 75776;
constexpr int LDS_BYTES = 152064;

constexpr size_t OFF_CNT   = 0;
constexpr size_t OFF_BAR   = 4096;
constexpr size_t OFF_MOD   = 65536;
constexpr size_t OFF_WR    = 524288;
constexpr size_t OFF_WIN   = 1048576;
constexpr int WIN_ROWS = 2816;
constexpr size_t OFF_WOUT  = OFF_WIN + 2 * (size_t)WIN_ROWS * 1024 * 2;
constexpr size_t OFF_W13   = OFF_WOUT + 4194304;
constexpr size_t OFF_W2    = OFF_W13 + 136314880;
constexpr size_t OFF_UBUF  = OFF_W2 + 68157440;
constexpr size_t OFF_ARENA = OFF_UBUF + 67108864;
constexpr size_t A_P      = OFF_ARENA;
constexpr size_t A_YMIX   = A_P + 176160768;
constexpr size_t A_SCAN   = A_YMIX + 67108864;
constexpr size_t A_HLOC   = A_SCAN + 134217728;
constexpr size_t A_CUMA   = A_HLOC + 33554432;
constexpr size_t A_G      = A_CUMA + 33554432;
constexpr size_t A_BONUS  = A_G + 33554432;
constexpr size_t A_YRAW   = A_BONUS + 33554432;
constexpr size_t A_CARRYA = A_YRAW + 33554432;
constexpr size_t A_CARRYH = A_CARRYA + 1048576;
constexpr size_t A_HSTART = A_CARRYH + 1048576;
constexpr size_t A_CHAIN  = A_HSTART + 1048576;
constexpr size_t CHAIN_UNIT = 49152;
constexpr size_t M_YBUF   = OFF_ARENA;
constexpr size_t M_ZB     = OFF_ARENA + 335544320;
constexpr size_t M_HBUF   = M_YBUF + 603979776;
constexpr size_t M_LIST   = M_HBUF + 159383552;
constexpr size_t M_WSEL   = M_LIST + 8388608;
constexpr size_t M_PMAP   = M_WSEL + 1048576;
constexpr size_t M_STAT   = M_PMAP + 1048576;
constexpr size_t WS_NEED  = M_STAT + 262144;

struct Params {
    const float* in[39];
    float* out;
    unsigned char* ws;
};
typedef const __attribute__((address_space(4))) Params* KP;
__device__ __forceinline__ int TIDX() { int t = threadIdx.x; asm volatile("" : "+v"(t)); t &= 255; return t; }
__device__ __forceinline__ int BIDX() { int b = blockIdx.x * 2 + __builtin_amdgcn_readfirstlane((int)(threadIdx.x >> 8)); asm volatile("" : "+s"(b)); __builtin_assume(b >= 0 && b < 65536); return b; }
__device__ __forceinline__ int NBV() { return gridDim.x * 2; }
__device__ __forceinline__ int TID512() { int t = threadIdx.x; asm volatile("" : "+v"(t)); __builtin_assume(t >= 0 && t < 512); return t; }
enum { I_X = 0, I_C, I_WMOD, I_BMOD, I_WIN, I_WOUT, I_CONVA, I_CONVAB, I_LNAG, I_LNAB, I_CONVB, I_CONVBB, I_WRG, I_BRG, I_WIG, I_BIG,
       I_LAMBDA, I_MUC, I_W0, I_WW2, I_A0, I_WA2, I_WG2, I_KK, I_KA, I_RK, I_GNG, I_GNB, I_CONVD, I_LN1G, I_LN1B, I_WROUTER, I_EBIAS,
       I_W13, I_W2, I_WS13, I_WS2, I_LN2G, I_LN2B };

DEVINL bf16_t f2bf(float f) { unsigned u = __float_as_uint(f); u += 0x7FFFu + ((u >> 16) & 1u); return (bf16_t)(u >> 16); }
DEVINL float bf2f(bf16_t h) { return __uint_as_float(((unsigned)h) << 16); }
typedef __bf16 bf2_t __attribute__((ext_vector_type(2)));
typedef float f2_t __attribute__((ext_vector_type(2)));
typedef float f32x16 __attribute__((ext_vector_type(16)));
DEVINL unsigned pack2(float a, float b) { f2_t v = {a, b}; return __builtin_bit_cast(unsigned, __builtin_convertvector(v, bf2_t)); }
DEVINL float sigm(float x) { return 1.f / (1.f + __expf(-x)); }
DEVINL float tanh_fast(float x) { const float e = __expf(2.f * x); return 1.f - 2.f / (1.f + e); }
DEVINL float softplusf(float z) { return fmaxf(z, 0.f) + __logf(1.f + __expf(-fabsf(z))); }
DEVINL float softplus_acc(float z) { return fmaxf(z, 0.f) + log1pf(__expf(-fabsf(z))); }
DEVINL float gelu_tanh(float x) { float u = 0.7978845608028654f * (x + 0.044715f * x * x * x); return 0.5f * x * (1.f + tanh_fast(u)); }
DEVINL float group8_max(float x) {
    x = fmaxf(x, __builtin_bit_cast(float, __builtin_amdgcn_update_dpp(0, __builtin_bit_cast(int, x), 0xB1, 0xf, 0xf, true)));
    x = fmaxf(x, __builtin_bit_cast(float, __builtin_amdgcn_update_dpp(0, __builtin_bit_cast(int, x), 0x4E, 0xf, 0xf, true)));
    x = fmaxf(x, __builtin_bit_cast(float, __builtin_amdgcn_update_dpp(0, __builtin_bit_cast(int, x), 0x141, 0xf, 0xf, true)));
    return x;
}
DEVINL float wave_sum_dpp(float x);
DEVINL float wave_sum(float x) { return wave_sum_dpp(x); }
DEVINL float wave_sum_dpp(float x) {
    x += __builtin_bit_cast(float, __builtin_amdgcn_update_dpp(0, __builtin_bit_cast(int, x), 0xB1, 0xf, 0xf, true));
    x += __builtin_bit_cast(float, __builtin_amdgcn_update_dpp(0, __builtin_bit_cast(int, x), 0x4E, 0xf, 0xf, true));
    x += __builtin_bit_cast(float, __builtin_amdgcn_update_dpp(0, __builtin_bit_cast(int, x), 0x141, 0xf, 0xf, true));
    x += __builtin_bit_cast(float, __builtin_amdgcn_update_dpp(0, __builtin_bit_cast(int, x), 0x140, 0xf, 0xf, true));
    x += __builtin_bit_cast(float, __builtin_amdgcn_update_dpp(0, __builtin_bit_cast(int, x), 0x142, 0xa, 0xf, false));
    x += __builtin_bit_cast(float, __builtin_amdgcn_update_dpp(0, __builtin_bit_cast(int, x), 0x143, 0xc, 0xf, false));
    return __builtin_bit_cast(float, __builtin_amdgcn_readlane(__builtin_bit_cast(int, x), 63));
}

DEVINL int lds_byte(int r, int c) { int st = (r >> 4) * 2 + (c >> 5), rr = r & 15, cc = c & 31, ob = rr * 64 + cc * 2; return st * 1024 + (ob ^ (((ob >> 9) & 1) << 5)); }
DEVINL void stage_rc(int b, int& R, int& C) { int st = b / 1024, sb = b % 1024, swz = sb ^ (((sb >> 9) & 1) << 5); R = (st >> 1) * 16 + swz / 64; C = (st & 1) * 32 + (swz % 64) / 2; }

template <class RowPtr, class Epi>
DEVINL void gemm_tile128(char* lds, RowPtr arow, const bf16_t* Bt, int K, Epi epi) {
    const int tid = TIDX();
    const bf16_t* ap[4]; const bf16_t* bp[4];
#pragma unroll
    for (int i = 0; i < 4; ++i) { int R, C; stage_rc(tid * 16 + i * 4096, R, C); ap[i] = arow(R) + C; bp[i] = Bt + (size_t)R * K + C; }
    const int wid = tid >> 6, lane = tid & 63, wr = wid >> 1, wc = wid & 1, fr = lane & 15, fq = lane >> 4;
    f32x4 acc[4][4];
#pragma unroll
    for (int m = 0; m < 4; ++m)
#pragma unroll
        for (int n = 0; n < 4; ++n) acc[m][n] = (f32x4){0.f, 0.f, 0.f, 0.f};
    const int nk = K >> 6;
#pragma unroll
    for (int i = 0; i < 4; ++i) {
        __builtin_amdgcn_global_load_lds((const unsigned*)(ap[i]), (unsigned*)(lds + tid * 16 + i * 4096), 16, 0, 0);
        __builtin_amdgcn_global_load_lds((const unsigned*)(bp[i]), (unsigned*)(lds + 16384 + tid * 16 + i * 4096), 16, 0, 0);
    }
    for (int kt = 0; kt < nk; ++kt) {
        asm volatile("s_waitcnt vmcnt(0)" ::: "memory");
        __syncthreads();
        char* cur = lds + (kt & 1) * 32768;
        if (kt + 1 < nk) {
            char* nxt = lds + ((kt + 1) & 1) * 32768;
            const int ko = (kt + 1) * 64;
#pragma unroll
            for (int i = 0; i < 4; ++i) {
                __builtin_amdgcn_global_load_lds((const unsigned*)(ap[i] + ko), (unsigned*)(nxt + tid * 16 + i * 4096), 16, 0, 0);
                __builtin_amdgcn_global_load_lds((const unsigned*)(bp[i] + ko), (unsigned*)(nxt + 16384 + tid * 16 + i * 4096), 16, 0, 0);
            }
        }
        bf16x8 af[4][2], bfr[4][2];
#pragma unroll
        for (int m = 0; m < 4; ++m)
#pragma unroll
            for (int kk = 0; kk < 2; ++kk) af[m][kk] = *reinterpret_cast<const bf16x8*>(cur + lds_byte(wr * 64 + m * 16 + fr, kk * 32 + fq * 8));
#pragma unroll
        for (int n = 0; n < 4; ++n)
#pragma unroll
            for (int kk = 0; kk < 2; ++kk) bfr[n][kk] = *reinterpret_cast<const bf16x8*>(cur + 16384 + lds_byte(wc * 64 + n * 16 + fr, kk * 32 + fq * 8));
#pragma unroll
        for (int kk = 0; kk < 2; ++kk)
#pragma unroll
            for (int m = 0; m < 4; ++m)
#pragma unroll
                for (int n = 0; n < 4; ++n) acc[m][n] = __builtin_amdgcn_mfma_f32_16x16x32_bf16(bfr[n][kk], af[m][kk], acc[m][n], 0, 0, 0);
    }
    __syncthreads();
    epi(acc, wr, wc, fr, fq);
}

template <class Ptrs, class Epi>
DEVINL void gemm_stream128(char* lds, int K, int blk, int nb, int total, Ptrs ptrs, Epi epi) {
    const int qx = nb >> 3, first = (blk & 7) * qx + (blk >> 3), stride = nb;
    if (first >= total) return;
    const int tid = TIDX();
    const int wid = tid >> 6, lane = tid & 63, wr = wid >> 1, wc = wid & 1, fr = lane & 15, fq = lane >> 4;
    const int nk = K >> 6;
    const bf16_t* ap[4]; const bf16_t* bp[4];
    const bf16_t* an[4]; const bf16_t* bn[4];
    int t = first;
    ptrs(t, ap, bp);
#pragma unroll
    for (int i = 0; i < 4; ++i) {
        __builtin_amdgcn_global_load_lds((const unsigned*)(ap[i]), (unsigned*)(lds + tid * 16 + i * 4096), 16, 0, 0);
        __builtin_amdgcn_global_load_lds((const unsigned*)(bp[i]), (unsigned*)(lds + 16384 + tid * 16 + i * 4096), 16, 0, 0);
    }
    for (;;) {
        const int tn = t + stride;
        const bool has_next = tn < total;
        if (has_next) ptrs(tn, an, bn);
        f32x4 acc[4][4];
#pragma unroll
        for (int m = 0; m < 4; ++m)
#pragma unroll
            for (int n = 0; n < 4; ++n) acc[m][n] = (f32x4){0.f, 0.f, 0.f, 0.f};
        for (int kt = 0; kt < nk; ++kt) {
            asm volatile("s_waitcnt vmcnt(0)" ::: "memory");
            __syncthreads();
            char* cur = lds + (kt & 1) * 32768;
            if (kt + 1 < nk) {
                char* nxt = lds + ((kt + 1) & 1) * 32768;
                const int ko = (kt + 1) * 64;
#pragma unroll
                for (int i = 0; i < 4; ++i) {
                    __builtin_amdgcn_global_load_lds((const unsigned*)(ap[i] + ko), (unsigned*)(nxt + tid * 16 + i * 4096), 16, 0, 0);
                    __builtin_amdgcn_global_load_lds((const unsigned*)(bp[i] + ko), (unsigned*)(nxt + 16384 + tid * 16 + i * 4096), 16, 0, 0);
                }
            } else if (has_next) {
#pragma unroll
                for (int i = 0; i < 4; ++i) {
                    __builtin_amdgcn_global_load_lds((const unsigned*)(an[i]), (unsigned*)(lds + tid * 16 + i * 4096), 16, 0, 0);
                    __builtin_amdgcn_global_load_lds((const unsigned*)(bn[i]), (unsigned*)(lds + 16384 + tid * 16 + i * 4096), 16, 0, 0);
                }
            }
            bf16x8 af[4][2], bfr[4][2];
#pragma unroll
            for (int m = 0; m < 4; ++m)
#pragma unroll
                for (int kk = 0; kk < 2; ++kk) af[m][kk] = *reinterpret_cast<const bf16x8*>(cur + lds_byte(wr * 64 + m * 16 + fr, kk * 32 + fq * 8));
#pragma unroll
            for (int n = 0; n < 4; ++n)
#pragma unroll
                for (int kk = 0; kk < 2; ++kk) bfr[n][kk] = *reinterpret_cast<const bf16x8*>(cur + 16384 + lds_byte(wc * 64 + n * 16 + fr, kk * 32 + fq * 8));
#pragma unroll
            for (int kk = 0; kk < 2; ++kk)
#pragma unroll
                for (int m = 0; m < 4; ++m)
#pragma unroll
                    for (int n = 0; n < 4; ++n) acc[m][n] = __builtin_amdgcn_mfma_f32_16x16x32_bf16(bfr[n][kk], af[m][kk], acc[m][n], 0, 0, 0);
        }
        epi(t, acc, wr, wc, fr, fq);
        if (!has_next) break;
        t = tn;
#pragma unroll
        for (int i = 0; i < 4; ++i) { ap[i] = an[i]; bp[i] = bn[i]; }
    }
    __syncthreads();
}
DEVINL void stage_coords(int (&R)[4], int (&C)[4]) {
    const int tid = TIDX();
#pragma unroll
    for (int i = 0; i < 4; ++i) stage_rc(tid * 16 + i * 4096, R[i], C[i]);
}

struct GUnit {
    const char* A;
    const char* B;
    unsigned va[2][2] = {{0u, 0u}, {0u, 0u}};
    int i0, i1, i2;
};
constexpr int G_HTB = 128 * 64 * 2;
constexpr int G_STAGE_BYTES = 8 * G_HTB;
DEVINL int perm32(int rho) { const int n = rho >> 4, i = rho & 15; return 8 * (i >> 2) + 4 * n + (i & 3); }
DEVINL void stage_coords512(int tid, int (&R)[2], int (&C)[2]) {
#pragma unroll
    for (int i = 0; i < 2; ++i) stage_rc(tid * 16 + i * 8192, R[i], C[i]);
}

template <bool PERM, bool GATHER, class Sched, class Epi>
DEVINL void gemm256(char* lds_generic, int K, int lda, Sched sched, Epi epi) {
    LAS unsigned char* lds = (LAS unsigned char*)lds_generic;
    const int tid = TID512(), wid = __builtin_amdgcn_readfirstlane(tid >> 6), lane = tid & 63, wr = wid >> 2, wc = wid & 3, fr = lane & 15, fq = lane >> 4;
    const int nt = K / 64;
    unsigned voffB[2];
#pragma unroll
    for (int i = 0; i < 2; ++i) { int R, C; stage_rc(tid * 16 + i * 8192, R, C); const int Rb = PERM ? ((R & ~31) + perm32(R & 31)) : R; voffB[i] = (unsigned)(Rb * K + C) * 2u; }
    unsigned voffA[2];
#pragma unroll
    for (int i = 0; i < 2; ++i) { int R, C; stage_rc(tid * 16 + i * 8192, R, C); voffA[i] = (unsigned)(R * lda + C) * 2u; }
    const size_t hstepA = GATHER ? 0 : (size_t)128 * lda * 2;
    const size_t kstep = (size_t)(64 * 2);
    const size_t hstepB = (size_t)128 * K * 2;
    const unsigned ldsw = (unsigned)wid * 1024u;
    const int aoff = lds_byte(wr * 64 + fr, fq * 8), boff = lds_byte(wc * 32 + fr, fq * 8);
#define G_SA(b, h) (((b) * 2 + (h)) * G_HTB)
#define G_SB(b, h) ((4 + (b) * 2 + (h)) * G_HTB)
#define G_STAGE(bufoff, gbase, voff) do { _Pragma("unroll") for (int _i = 0; _i < 2; ++_i) { unsigned _vo = (voff)[_i]; asm volatile("" : "+v"(_vo)); \
        __builtin_amdgcn_global_load_lds((const unsigned*)((const char*)(gbase) + _vo), (LAS unsigned*)(lds + (bufoff) + ldsw + _i * 8192), 16, 0, 0); } } while (0)
#define G_STAGE_A(bufoff, ptr, vg, h) do { if constexpr (GATHER) { G_STAGE(bufoff, ptr, vg); } else { G_STAGE(bufoff, (ptr) + (h) * hstepA, voffA); } } while (0)
#define G_LDA(dst, b, h) do { _Pragma("unroll") for (int m = 0; m < 4; ++m) _Pragma("unroll") for (int k = 0; k < 2; ++k) dst[m][k] = *(const LAS bf16x8*)(lds + G_SA(b, h) + aoff + m * 2048 + k * 1024); } while (0)
#define G_LDB(dst, b, h) do { _Pragma("unroll") for (int n = 0; n < 2; ++n) _Pragma("unroll") for (int k = 0; k < 2; ++k) dst[n][k] = *(const LAS bf16x8*)(lds + G_SB(b, h) + boff + n * 2048 + k * 1024); } while (0)
#define G_MMA(ai, bj, At, Bt) do { __builtin_amdgcn_s_setprio(1); _Pragma("unroll") for (int m = 0; m < 4; ++m) _Pragma("unroll") for (int n = 0; n < 2; ++n) _Pragma("unroll") for (int k = 0; k < 2; ++k) \
        acc[ai][bj][m][n] = __builtin_amdgcn_mfma_f32_16x16x32_bf16(Bt[n][k], At[m][k], acc[ai][bj][m][n], 0, 0, 0); __builtin_amdgcn_s_setprio(0); } while (0)
#define G_WAIT_V(n) asm volatile("s_waitcnt vmcnt(" #n ")" ::: "memory")
#define G_WAIT_L(n) asm volatile("s_waitcnt lgkmcnt(" #n ")" ::: "memory")
#define G_BAR __builtin_amdgcn_s_barrier()
#define G_SCHED __builtin_amdgcn_sched_barrier(0)
    GUnit cur, nxt; int ui = 0;
    if (!sched(0, cur)) return;
    f32x4 acc[2][2][4][2];
#pragma unroll
    for (int a = 0; a < 2; ++a)
#pragma unroll
        for (int b = 0; b < 2; ++b)
#pragma unroll
            for (int m = 0; m < 4; ++m)
#pragma unroll
                for (int n = 0; n < 2; ++n) acc[a][b][m][n] = (f32x4){0.f, 0.f, 0.f, 0.f};
    bf16x8 At[4][2], B0[2][2], B1[2][2];
    G_STAGE(G_SB(0, 0), cur.B, voffB); G_STAGE_A(G_SA(0, 0), cur.A, cur.va[0], 0); G_STAGE(G_SB(0, 1), cur.B + hstepB, voffB); G_STAGE_A(G_SA(0, 1), cur.A, cur.va[1], 1);
    if (wr == 1) G_BAR;
    G_WAIT_V(4); G_BAR;
    G_STAGE(G_SB(1, 0), cur.B + kstep, voffB); G_STAGE_A(G_SA(1, 0), cur.A + kstep, cur.va[0], 0); G_STAGE(G_SB(1, 1), cur.B + hstepB + kstep, voffB);
    G_WAIT_V(6); G_BAR;
    for (;;) {
        const bool has_next = sched(ui + 1, nxt);
        if (!has_next) nxt = cur;
        for (int t = 0; t < nt; t += 2) {
            const bool last = (t == nt - 2);
            const char* a1 = cur.A + (size_t)(t + 1) * kstep;
            const char* a2 = last ? nxt.A : cur.A + (size_t)(t + 2) * kstep; const char* b2 = last ? nxt.B : cur.B + (size_t)(t + 2) * kstep;
            const char* a3 = a2 + kstep; const char* b3 = b2 + kstep;
            G_LDB(B0, 0, 0); G_SCHED; G_LDA(At, 0, 0); G_STAGE_A(G_SA(1, 1), a1, cur.va[1], 1);
            G_WAIT_L(8); G_BAR; G_WAIT_L(0); G_MMA(0, 0, At, B0); G_BAR; G_SCHED;
            G_LDB(B1, 0, 1); G_STAGE(G_SB(0, 0), b2, voffB);
            G_BAR; G_WAIT_L(0); G_MMA(0, 1, At, B1); G_BAR;
            G_LDA(At, 0, 1); if (last) { G_STAGE_A(G_SA(0, 0), a2, nxt.va[0], 0); } else { G_STAGE_A(G_SA(0, 0), a2, cur.va[0], 0); }
            G_BAR; G_WAIT_L(0); G_MMA(1, 0, At, B0); G_BAR; G_SCHED;
            G_STAGE(G_SB(0, 1), b2 + hstepB, voffB);
            G_WAIT_V(6); G_BAR; G_MMA(1, 1, At, B1); G_BAR;
            G_LDB(B0, 1, 0); G_SCHED; G_LDA(At, 1, 0); if (last) { G_STAGE_A(G_SA(0, 1), a2, nxt.va[1], 1); } else { G_STAGE_A(G_SA(0, 1), a2, cur.va[1], 1); }
            G_WAIT_L(8); G_BAR; G_WAIT_L(0); G_MMA(0, 0, At, B0); G_BAR; G_SCHED;
            G_LDB(B1, 1, 1); G_STAGE(G_SB(1, 0), b3, voffB);
            G_BAR; G_WAIT_L(0); G_MMA(0, 1, At, B1); G_BAR;
            G_LDA(At, 1, 1); if (last) { G_STAGE_A(G_SA(1, 0), a3, nxt.va[0], 0); } else { G_STAGE_A(G_SA(1, 0), a3, cur.va[0], 0); }
            G_BAR; G_WAIT_L(0); G_MMA(1, 0, At, B0); G_BAR; G_SCHED;
            G_STAGE(G_SB(1, 1), b3 + hstepB, voffB);
            G_WAIT_V(6); G_BAR; G_MMA(1, 1, At, B1); G_BAR;
        }
        { const int l2 = TID512() & 63; epi(acc, cur, wr, wc, l2 & 15, l2 >> 4); }
        if (!has_next) break;
#pragma unroll
        for (int a = 0; a < 2; ++a)
#pragma unroll
            for (int b = 0; b < 2; ++b)
#pragma unroll
                for (int m = 0; m < 4; ++m)
#pragma unroll
                    for (int n = 0; n < 2; ++n) acc[a][b][m][n] = (f32x4){0.f, 0.f, 0.f, 0.f};
        cur = nxt; ++ui;
    }
    G_WAIT_V(0);
    if (wr == 0) G_BAR;
    G_BAR;
#undef G_SA
#undef G_STAGE_A
#undef G_SB
#undef G_STAGE
#undef G_LDA
#undef G_LDB
#undef G_MMA
#undef G_WAIT_V
#undef G_WAIT_L
#undef G_BAR
#undef G_SCHED
}
DEVINL long unit_linear(int i, int c, int G) { const int q = G >> 3; return ((long)i * 8 + (c & 7)) * q + (c >> 3); }

constexpr int CONV_PER_L = 672 + 256 + 8320 + 4160;
struct ConvJob { const float* src; bf16_t* dst; int K, ld, k0, r0, perm; };
DEVINL ConvJob conv_decode(KP p, int id) {
    ConvJob j; const int l = id / CONV_PER_L; int r = id % CONV_PER_L; int kt, nt;
    if (r < 672) { j.src = p->in[I_WIN] + (size_t)l * 1024 * 2688; j.K = 1024; j.ld = 2688; j.perm = 0; j.dst = (bf16_t*)(p->ws + OFF_WIN) + (size_t)l * WIN_ROWS * 1024; nt = r % 42; kt = r / 42; }
    else if (r < 928) { r -= 672; j.src = p->in[I_WOUT] + (size_t)l * 1024 * 1024; j.K = 1024; j.ld = 1024; j.perm = 0; j.dst = (bf16_t*)(p->ws + OFF_WOUT) + (size_t)l * 1024 * 1024; nt = r & 15; kt = r >> 4; }
    else if (r < 928 + 8320) { r -= 928; const int e = r >> 7, q = r & 127; nt = q & 7; kt = q >> 3; j.K = 1024; j.ld = 512; j.perm = 1;
        j.src = (e < 64) ? p->in[I_W13] + (size_t)(l * 64 + e) * 1024 * 512 : p->in[I_WS13] + (size_t)l * 1024 * 512;
        j.dst = (bf16_t*)(p->ws + OFF_W13) + (size_t)(l * 65 + e) * 512 * 1024; }
    else { r -= 9248; const int e = r >> 6, q = r & 63; nt = q & 15; kt = q >> 4; j.K = 256; j.ld = 1024; j.perm = 0;
        j.src = (e < 64) ? p->in[I_W2] + (size_t)(l * 64 + e) * 256 * 1024 : p->in[I_WS2] + (size_t)l * 256 * 1024;
        j.dst = (bf16_t*)(p->ws + OFF_W2) + (size_t)(l * 65 + e) * 1024 * 256; }
    j.k0 = kt * 64; j.r0 = nt * 64; return j;
}
DEVINL void conv_issue(const ConvJob& j, char* buf, int tid) {
    const int nn = tid & 63, drow = j.r0 + nn;
    int scol = drow;
    if (j.perm) { const int g = drow >> 5, i = drow & 31; scol = (i < 16) ? (g * 16 + i) : (256 + g * 16 + (i - 16)); }
    const float* sp = j.src + (size_t)j.k0 * j.ld + scol;
#pragma unroll
    for (int q = 0; q < 16; ++q) { const int kk = (tid >> 6) + 4 * q;
        __builtin_amdgcn_global_load_lds((const unsigned*)(sp + (size_t)kk * j.ld), (unsigned*)(buf + kk * 260 + nn * 4), 4, 0, 0); }
}
DEVINL void convert_ids(KP p, char* lds, int id_lo, int id_hi, int wb, int nwb) {
    const int tid = TIDX();
    const int n = (id_hi - id_lo + nwb - 1) / nwb;
    auto idof = [&](int i) { const int id = id_lo + i * nwb + wb; return (id < id_hi) ? id : id_hi - 1; };
    ConvJob j0 = conv_decode(p, idof(0)), j1 = conv_decode(p, idof(n > 1 ? 1 : 0));
    conv_issue(j0, lds, tid);
    conv_issue(j1, lds + 16640, tid);
    bf16_t* d0 = j0.dst + (size_t)j0.r0 * j0.K + j0.k0; int K0 = j0.K;
    bf16_t* d1 = j1.dst + (size_t)j1.r0 * j1.K + j1.k0; int K1 = j1.K;
    for (int i = 0; i < n; ++i) {
        const ConvJob j2 = conv_decode(p, idof(i + 2 < n ? i + 2 : n - 1));
        conv_issue(j2, lds + ((i + 2) % 3) * 16640, tid);
        asm volatile("s_waitcnt vmcnt(32)" ::: "memory");
        __builtin_amdgcn_s_barrier();
        const float* tile = (const float*)(lds + (i % 3) * 16640);
        {
            const int kp = (tid & 31) * 2;
#pragma unroll
            for (int q = 0; q < 8; ++q) { const int rr = (tid >> 5) + 8 * q;
                *(unsigned*)(d0 + (size_t)rr * K0 + kp) = pack2(tile[kp * 65 + rr], tile[(kp + 1) * 65 + rr]); }
        }
        asm volatile("s_waitcnt lgkmcnt(0)" ::: "memory");
        __builtin_amdgcn_s_barrier();
        d0 = d1; K0 = K1; d1 = j2.dst + (size_t)j2.r0 * j2.K + j2.k0; K1 = j2.K;
    }
    asm volatile("s_waitcnt vmcnt(0)" ::: "memory");
    __syncthreads();
}

DEVINL void phase0(KP p, char* lds) {
    const int tid = TIDX(), nb = NBV(), blk = BIDX();
    if (blk == 0 && tid < 128) ((unsigned*)(p->ws + OFF_CNT))[tid] = 0u;
    if (blk < 192) {
        float* sc = (float*)lds;
        float* part = (float*)(lds + 32768);
        for (int i = tid; i < 8192; i += VTHREADS) { float c = p->in[I_C][i]; sc[i] = c * sigm(c); }
        __syncthreads();
        const int cl = tid & 63, ks = tid >> 6, n = blk * 64 + cl, l = n / 6144, nn = n % 6144;
        const float* w = p->in[I_WMOD] + (size_t)l * 1024 * 6144 + (size_t)(ks * 256) * 6144 + nn;
        float acc[8];
#pragma unroll
        for (int b = 0; b < 8; ++b) acc[b] = 0.f;
#pragma unroll 16
        for (int k = 0; k < 256; ++k) {
            const float wv = w[(size_t)k * 6144];
#pragma unroll
            for (int b = 0; b < 8; ++b) acc[b] = fmaf(sc[b * 1024 + ks * 256 + k], wv, acc[b]);
        }
#pragma unroll
        for (int b = 0; b < 8; ++b) part[(ks * 8 + b) * 64 + cl] = acc[b];
        __syncthreads();
        if (tid < 64) {
            const float bm = p->in[I_BMOD][l * 6144 + nn];
            float* mod = (float*)(p->ws + OFF_MOD);
#pragma unroll
            for (int b = 0; b < 8; ++b) mod[(size_t)(l * 8 + b) * 6144 + nn] = part[(0 * 8 + b) * 64 + cl] + part[(1 * 8 + b) * 64 + cl] + part[(2 * 8 + b) * 64 + cl] + part[(3 * 8 + b) * 64 + cl] + bm;
        }
        __syncthreads();
    }
    if (blk >= 192 && blk < 256) {
        bf16_t* wrt = (bf16_t*)(p->ws + OFF_WR);
#pragma unroll
        for (int j = 0; j < 8; ++j) {
            const int idx = (blk - 192) * 2048 + j * 256 + tid, l2 = idx >> 16, rem = idx & 65535, k = rem >> 6, e = rem & 63;
            const float w = p->in[I_WROUTER][idx];
            const bf16_t hi = f2bf(w); const bf16_t lo = f2bf(w - bf2f(hi));
            wrt[(size_t)((l2 * 2 + 0) * 64 + e) * 1024 + k] = hi; wrt[(size_t)((l2 * 2 + 1) * 64 + e) * 1024 + k] = lo;
        }
    }
    convert_ids(p, lds, 0, 2 * CONV_PER_L, blk, nb);
}

DEVINL void phaseF0(KP p) {
    const int tid = TIDX(), nb = NBV(), blk = BIDX();
    const float* mod = (const float*)(p->ws + OFF_MOD);
    bf16_t* ubuf = (bf16_t*)(p->ws + OFF_UBUF);
    for (int row = blk; row < NTOK; row += nb) {
        const int b = row >> 12, col = tid * 4;
        const float4 x = *(const float4*)(p->in[I_X] + (size_t)row * DM + col);
        const float4 sh = *(const float4*)(mod + (size_t)b * 6144 + col);
        const float4 sc = *(const float4*)(mod + (size_t)b * 6144 + 1024 + col);
        uint2 o; o.x = pack2(x.x * (1.f + sc.x) + sh.x, x.y * (1.f + sc.y) + sh.y); o.y = pack2(x.z * (1.f + sc.z) + sh.z, x.w * (1.f + sc.w) + sh.w);
        *(uint2*)(ubuf + (size_t)row * DM + col) = o;
    }
}

DEVINL void b1_conformer(KP p, int l, char* lds, int item) {
    const int tid = TIDX(), b = item >> 7, tt = item & 127, t0 = tt * 32, rowbase = b * SEQ;
    const bf16_t* P = (const bf16_t*)(p->ws + A_P);
    bf16_t* ymix = (bf16_t*)(p->ws + A_YMIX);
    float w[31];
#pragma unroll
    for (int k = 0; k < 31; ++k) w[k] = p->in[I_CONVA][(size_t)(l * 31 + k) * 256 + tid];
    float acc[32];
    const float bias = p->in[I_CONVAB][l * 256 + tid];
#pragma unroll
    for (int j = 0; j < 32; ++j) acc[j] = bias;
#pragma unroll
    for (int rr = 0; rr < 62; ++rr) {
        const int t = t0 - 30 + rr;
        const bf16_t* pr = P + ((long)(rowbase + t0 - 30) * PIN + tid) + (long)rr * PIN;
        const float val = bf2f(pr[0]), gate = bf2f(pr[256]);
        const float h = (t >= 0) ? val * sigm(gate) : 0.f;
#pragma unroll
        for (int j = 0; j < 32; ++j) { const int k = rr - j; if (k >= 0 && k <= 30) acc[j] = fmaf(w[k], h, acc[j]); }
    }
    float* outb = (float*)lds;
#pragma unroll
    for (int j = 0; j < 32; ++j) outb[j * 256 + tid] = acc[j];
    __syncthreads();
    const int wid = tid >> 6, lane = tid & 63;
    const float4 g4 = *(const float4*)(p->in[I_LNAG] + l * 256 + lane * 4), b4 = *(const float4*)(p->in[I_LNAB] + l * 256 + lane * 4);
    for (int j = wid; j < 32; j += 4) {
        const float4 v = *(const float4*)(outb + j * 256 + lane * 4);
        const float mean = wave_sum(v.x + v.y + v.z + v.w) * (1.f / 256.f);
        const float d0 = v.x - mean, d1 = v.y - mean, d2 = v.z - mean, d3 = v.w - mean;
        const float var = wave_sum(d0 * d0 + d1 * d1 + d2 * d2 + d3 * d3) * (1.f / 256.f);
        const float rs = rsqrtf(var + LN_EPS);
        float y0 = d0 * rs * g4.x + b4.x, y1 = d1 * rs * g4.y + b4.y, y2 = d2 * rs * g4.z + b4.z, y3 = d3 * rs * g4.w + b4.w;
        y0 *= sigm(y0); y1 *= sigm(y1); y2 *= sigm(y2); y3 *= sigm(y3);
        uint2 o; o.x = pack2(y0, y1); o.y = pack2(y2, y3);
        *(uint2*)(ymix + (size_t)(rowbase + t0 + j) * DM + lane * 4) = o;
    }
    __syncthreads();
}

DEVINL void b1_shortconv(KP p, int l, int item) {
    const int tid = TIDX(), cg = tid & 31, tl = tid >> 5, b = item >> 6, t0 = (item & 63) * 64 + tl * 8, rowbase = b * SEQ;
    const bf16_t* P = (const bf16_t*)(p->ws + A_P);
    bf16_t* ymix = (bf16_t*)(p->ws + A_YMIX);
    float w0[8], w1[8], w2[8];
#pragma unroll
    for (int e = 0; e < 8; ++e) { w0[e] = p->in[I_CONVD][(l * 3 + 0) * 256 + cg * 8 + e]; w1[e] = p->in[I_CONVD][(l * 3 + 1) * 256 + cg * 8 + e]; w2[e] = p->in[I_CONVD][(l * 3 + 2) * 256 + cg * 8 + e]; }
    uint4 gbv[8], gcv[10], hdv[10];
#pragma unroll
    for (int u = 0; u < 10; ++u) {
        const int t = t0 - 2 + u;
        const bf16_t* a = P + (size_t)(rowbase + (t >= 0 ? t : 0)) * PIN + 1920 + cg * 8;
        gcv[u] = *(const uint4*)(a + 256); hdv[u] = *(const uint4*)(a + 512);
        if (u >= 2) gbv[u - 2] = *(const uint4*)(a);
    }
    float q2[8], q1[8];
#pragma unroll
    for (int u = 0; u < 10; ++u) {
        const int t = t0 - 2 + u;
        const unsigned gcw[4] = {gcv[u].x, gcv[u].y, gcv[u].z, gcv[u].w}, hdw[4] = {hdv[u].x, hdv[u].y, hdv[u].z, hdv[u].w};
        float q0[8];
#pragma unroll
        for (int e = 0; e < 4; ++e) {
            q0[2 * e] = __uint_as_float(gcw[e] << 16) * __uint_as_float(hdw[e] << 16);
            q0[2 * e + 1] = __uint_as_float(gcw[e] & 0xFFFF0000u) * __uint_as_float(hdw[e] & 0xFFFF0000u);
        }
        if (t < 0) {
#pragma unroll
            for (int e = 0; e < 8; ++e) q0[e] = 0.f;
        }
        if (u >= 2) {
            const unsigned gbw[4] = {gbv[u - 2].x, gbv[u - 2].y, gbv[u - 2].z, gbv[u - 2].w};
            float y[8];
#pragma unroll
            for (int e = 0; e < 4; ++e) {
                y[2 * e] = __uint_as_float(gbw[e] << 16) * (w0[2 * e] * q2[2 * e] + w1[2 * e] * q1[2 * e] + w2[2 * e] * q0[2 * e]);
                y[2 * e + 1] = __uint_as_float(gbw[e] & 0xFFFF0000u) * (w0[2 * e + 1] * q2[2 * e + 1] + w1[2 * e + 1] * q1[2 * e + 1] + w2[2 * e + 1] * q0[2 * e + 1]);
            }
            *(uint4*)(ymix + (size_t)(rowbase + t) * DM + 768 + cg * 8) = make_uint4(pack2(y[0], y[1]), pack2(y[2], y[3]), pack2(y[4], y[5]), pack2(y[6], y[7]));
        }
#pragma unroll
        for (int e = 0; e < 8; ++e) { q2[e] = (u >= 1) ? q1[e] : 0.f; q1[e] = q0[e]; }
    }
}

DEVINL void b1_lru(KP p, int l, char* lds, int item) {
    const int c = TIDX(), b = item >> 7, tt = item & 127, t0 = tt * 32, rowbase = b * SEQ;
    const int h = c >> 6, lane = c & 63;
    const bf16_t* P = (const bf16_t*)(p->ws + A_P);
    float* uT = (float*)lds;
    {
        const float cb0 = p->in[I_CONVB][(l * 4 + 0) * 256 + c], cb1 = p->in[I_CONVB][(l * 4 + 1) * 256 + c], cb2 = p->in[I_CONVB][(l * 4 + 2) * 256 + c], cb3 = p->in[I_CONVB][(l * 4 + 3) * 256 + c];
        const float bias = p->in[I_CONVBB][l * 256 + c];
        float xm3 = 0.f, xm2 = 0.f, xm1 = 0.f;
        if (t0 >= 3) { const bf16_t* a = P + (size_t)(rowbase + t0 - 3) * PIN + 512 + c; xm3 = bf2f(a[0]); xm2 = bf2f(a[PIN]); xm1 = bf2f(a[2 * PIN]); }
        bf16_t xr[32];
#pragma unroll
        for (int j = 0; j < 32; ++j) xr[j] = P[(size_t)(rowbase + t0 + j) * PIN + 512 + c];
#pragma unroll
        for (int j = 0; j < 32; ++j) {
            const float x0 = bf2f(xr[j]);
            uT[c * 36 + j] = cb0 * xm3 + cb1 * xm2 + cb2 * xm1 + cb3 * x0 + bias;
            xm3 = xm2; xm2 = xm1; xm1 = x0;
        }
    }
    __syncthreads();
    const float brg = p->in[I_BRG][l * 256 + c], big = p->in[I_BIG][l * 256 + c];
    const float sp = softplus_acc(-p->in[I_LAMBDA][l * 256 + c]);
    unsigned* hcbuf = (unsigned*)(p->ws + A_HLOC);
    const float* wrg = p->in[I_WRG] + (size_t)((l * 4 + h) * 64) * 64 + lane;
    const float* wig = p->in[I_WIG] + (size_t)((l * 4 + h) * 64) * 64 + lane;
    float hs = 0.f, cA = 1.f;
#pragma unroll 1
    for (int half = 0; half < 2; ++half) {
        float ar[16], ai[16];
#pragma unroll
        for (int j = 0; j < 16; ++j) { ar[j] = 0.f; ai[j] = 0.f; }
#pragma unroll 1
        for (int dh = 0; dh < 4; ++dh) {
            float wrv[16], wiv[16];
#pragma unroll
            for (int d = 0; d < 16; ++d) { wrv[d] = wrg[(dh * 16 + d) * 64]; wiv[d] = wig[(dh * 16 + d) * 64]; }
#pragma unroll
            for (int d = 0; d < 16; ++d) {
                const float wr = wrv[d], wi = wiv[d];
                const float4* up = (const float4*)(uT + (h * 64 + dh * 16 + d) * 36 + half * 16);
#pragma unroll
                for (int jj = 0; jj < 4; ++jj) {
                    const float4 u4 = up[jj];
                    ar[4 * jj + 0] = fmaf(u4.x, wr, ar[4 * jj + 0]); ai[4 * jj + 0] = fmaf(u4.x, wi, ai[4 * jj + 0]);
                    ar[4 * jj + 1] = fmaf(u4.y, wr, ar[4 * jj + 1]); ai[4 * jj + 1] = fmaf(u4.y, wi, ai[4 * jj + 1]);
                    ar[4 * jj + 2] = fmaf(u4.z, wr, ar[4 * jj + 2]); ai[4 * jj + 2] = fmaf(u4.z, wi, ai[4 * jj + 2]);
                    ar[4 * jj + 3] = fmaf(u4.w, wr, ar[4 * jj + 3]); ai[4 * jj + 3] = fmaf(u4.w, wi, ai[4 * jj + 3]);
                }
            }
        }
        float ureg[16];
#pragma unroll
        for (int jj = 0; jj < 4; ++jj) { const float4 u4 = *(const float4*)(uT + c * 36 + half * 16 + 4 * jj); ureg[4 * jj] = u4.x; ureg[4 * jj + 1] = u4.y; ureg[4 * jj + 2] = u4.z; ureg[4 * jj + 3] = u4.w; }
        unsigned* hp = hcbuf + (size_t)(rowbase + t0 + half * 16) * 256 + c;
#pragma unroll
        for (int j = 0; j < 16; ++j) {
            const float r = sigm(ar[j] + brg), ig = sigm(ai[j] + big);
            const float log_a = -8.0f * r * sp;
            const float a = __expf(log_a);
            const float mult = sqrtf(fmaxf(1.f - a * a, 0.f));
            const float bx = mult * (ig * ureg[j]);
            hs = fmaf(a, hs, bx); cA *= a;
            hp[j * 256] = pack2(hs, cA);
        }
    }
    ((float*)(p->ws + A_CARRYA))[(size_t)(b * 128 + tt) * 256 + c] = cA;
    ((float*)(p->ws + A_CARRYH))[(size_t)(b * 128 + tt) * 256 + c] = hs;
    __syncthreads();
}

DEVINL void b1_rwkv(KP p, int l, char* lds, int item) {
    const int c = TIDX(), b = item >> 7, tt = item & 127, t0 = tt * 32, rowbase = b * SEQ;
    const bf16_t* P = (const bf16_t*)(p->ws + A_P);
    float* featT = (float*)lds;
    const float* muc = p->in[I_MUC] + l * 896;
    if (c < 128) {
        const int col = 1024 + 768 + c; const float mu = muc[768 + c];
        float prev;
        { const float x = bf2f(P[(size_t)(rowbase + (t0 > 0 ? t0 - 1 : 0)) * PIN + col]); prev = (t0 > 0) ? x : 0.f; }
#pragma unroll 1
        for (int jb = 0; jb < 2; ++jb) {
            bf16_t raw[16];
#pragma unroll
            for (int u = 0; u < 16; ++u) raw[u] = P[(size_t)(rowbase + t0 + jb * 16 + u) * PIN + col];
#pragma unroll
            for (int u = 0; u < 16; ++u) {
                const float cur = bf2f(raw[u]);
                const float xs = cur + (prev - cur) * mu;
                const float val = (c < 32) ? tanh_fast(xs) : ((c < 64) ? xs : sigm(xs));
                featT[c * 36 + jb * 16 + u] = val; prev = cur;
            }
        }
    }
    __syncthreads();
    float acc[32], dec[32], aa[32];
#define LORA32(WPTR, FOFF) do { float wv_[32]; \
    _Pragma("unroll") for (int jf = 0; jf < 32; ++jf) wv_[jf] = (WPTR)[(size_t)jf * 256 + c]; \
    _Pragma("unroll") for (int jf = 0; jf < 32; ++jf) { const float4* fp = (const float4*)(featT + ((FOFF) + jf) * 36); const float wv = wv_[jf]; \
        _Pragma("unroll") for (int jj = 0; jj < 8; ++jj) { const float4 u4 = fp[jj]; acc[4 * jj] = fmaf(u4.x, wv, acc[4 * jj]); acc[4 * jj + 1] = fmaf(u4.y, wv, acc[4 * jj + 1]); acc[4 * jj + 2] = fmaf(u4.z, wv, acc[4 * jj + 2]); acc[4 * jj + 3] = fmaf(u4.w, wv, acc[4 * jj + 3]); } } } while (0)
#pragma unroll
    for (int j = 0; j < 32; ++j) acc[j] = 0.f;
    LORA32(p->in[I_WG2] + (size_t)(l * 64) * 256, 64);
    LORA32(p->in[I_WG2] + (size_t)(l * 64 + 32) * 256, 96);
    {
        bf16_t* gbuf = (bf16_t*)(p->ws + A_G);
#pragma unroll
        for (int j = 0; j < 32; ++j) { gbuf[(size_t)(rowbase + t0 + j) * 256 + c] = f2bf(acc[j]); acc[j] = 0.f; }
    }
    LORA32(p->in[I_WW2] + (size_t)(l * 32) * 256, 0);
    {
        const float w0 = p->in[I_W0][l * 256 + c];
#pragma unroll
        for (int j = 0; j < 32; ++j) { const float z = w0 + acc[j]; const float wlog = -softplusf(-z) - 0.5f; dec[j] = -__expf(wlog); acc[j] = 0.f; }
    }
    LORA32(p->in[I_WA2] + (size_t)(l * 32) * 256, 32);
    {
        const float a0 = p->in[I_A0][l * 256 + c];
#pragma unroll
        for (int j = 0; j < 32; ++j) aa[j] = sigm(a0 + acc[j]);
    }
#undef LORA32
    {
        bf16_t* bonus = (bf16_t*)(p->ws + A_BONUS); uint4* scan = (uint4*)(p->ws + A_SCAN);
        const float mur = muc[c], muk = muc[256 + c], muv = muc[512 + c];
        const float kkw = p->in[I_KK][l * 256 + c], kaw = p->in[I_KA][l * 256 + c], rkw = p->in[I_RK][l * 256 + c];
        float pr, pk, pv;
        { const bf16_t* a = P + (size_t)(rowbase + (t0 > 0 ? t0 - 1 : 0)) * PIN + 1024 + c; const float x0 = bf2f(a[0]), x1 = bf2f(a[256]), x2 = bf2f(a[512]);
          pr = (t0 > 0) ? x0 : 0.f; pk = (t0 > 0) ? x1 : 0.f; pv = (t0 > 0) ? x2 : 0.f; }
#pragma unroll
        for (int jb = 0; jb < 4; ++jb) {
            bf16_t rr_[8], rk_[8], rv_[8];
#pragma unroll
            for (int u = 0; u < 8; ++u) { const bf16_t* a = P + (size_t)(rowbase + t0 + jb * 8 + u) * PIN + 1024 + c; rr_[u] = a[0]; rk_[u] = a[256]; rv_[u] = a[512]; }
#pragma unroll
            for (int u = 0; u < 8; ++u) {
                const int j = jb * 8 + u;
                const size_t row = (size_t)(rowbase + t0 + j);
                const float cr = bf2f(rr_[u]), ck = bf2f(rk_[u]), cv = bf2f(rv_[u]);
                const float r = cr + (pr - cr) * mur, k = ck + (pk - ck) * muk, v = cv + (pv - cv) * muv;
                pr = cr; pk = ck; pv = cv;
                const float kk = k * kkw;
                const float ss = wave_sum(kk * kk);
                const float kkn = kk * rsqrtf(ss + 1e-12f);
                const float kf = k * (1.f + (aa[j] - 1.f) * kaw);
                const float bs = wave_sum(r * kf * rkw);
                bonus[row * 256 + c] = f2bf(bs * v);
                uint4 o; o.x = pack2(kkn, kkn * aa[j]); o.y = pack2(kf, r); o.z = pack2(v, 0.f); o.w = __float_as_uint(dec[j]);
                scan[row * 256 + c] = o;
            }
            asm volatile("" ::: "memory");
        }
    }
    __syncthreads();
}

constexpr int S_AL = 0, S_BE = 8192, S_KA = 16384, S_RH = 24576, S_BET = 32768, S_KAT = 40960, S_VT = 49152, S_L2F = 57344  , S_GT = 73728  ;
constexpr int S_L1F = S_BE;
constexpr int S_M1 = S_BE, S_M2 = S_KA;
constexpr int S_APT = S_L2F, S_W2T = S_L2F + 8192;
constexpr int S_RP = S_AL, S_GTR = S_RH;
DEVINL int crow32(int reg, int h) { return (reg & 3) + 8 * (reg >> 2) + 4 * h; }
DEVINL bf16x8 frag64(const char* lds, int slot, int row, int kel) { return *reinterpret_cast<const bf16x8*>(lds + slot + row * 128 + kel * 2); }
#define MFMA32(a, b, c) __builtin_amdgcn_mfma_f32_32x32x16_bf16((a), (b), (c), 0, 0, 0)
DEVINL float dpp_xor1(float x) { return __builtin_bit_cast(float, __builtin_amdgcn_update_dpp(0, __builtin_bit_cast(int, x), 0xB1, 0xf, 0xf, true)); }

DEVINL f32x16 mm64(const char* lds, int slotA, int slotB, int tm, int tn, int r, int hh, f32x16 acc) {
#pragma unroll
    for (int ks = 0; ks < 4; ++ks) acc = MFMA32(frag64(lds, slotA, tm * 32 + r, ks * 16 + 8 * hh), frag64(lds, slotB, tn * 32 + r, ks * 16 + 8 * hh), acc);
    return acc;
}

DEVINL void b1e_unit(KP p, char* lds, int b, int h, int c) {
    const int tid = TIDX(), wv = tid >> 6, lane = tid & 63, r = lane & 31, hh = lane >> 5;
    const uint4* scan = (const uint4*)(p->ws + A_SCAN) + ((size_t)(b * SEQ + c * 64)) * 256 + h * 64;
    float* gtot = (float*)(lds + S_GT); float* gamC = gtot + 256;
    {
        const int j = lane;
        float lw[16]; unsigned px[16], py[16], pz[16];
#pragma unroll
        for (int u = 0; u < 16; ++u) { const uint4 q = scan[(size_t)(wv * 16 + u) * 256 + j]; px[u] = q.x; py[u] = q.y; pz[u] = q.z; lw[u] = __uint_as_float(q.w); }
        float tot = 0.f;
#pragma unroll
        for (int u = 0; u < 16; ++u) tot += lw[u];
        gtot[wv * 64 + j] = tot;
        __syncthreads();
        float off = 0.f, all = 0.f;
#pragma unroll
        for (int g = 0; g < 4; ++g) { const float v = gtot[g * 64 + j]; all += v; off += (g < wv) ? v : 0.f; }
        if (wv == 0) gamC[j] = __expf(all);
        float cum = off;
        unsigned tb[8], tk[8], tv[8];
#pragma unroll
        for (int u = 0; u < 16; ++u) {
            const float kkn = __uint_as_float(px[u] << 16), bb = __uint_as_float(px[u] & 0xFFFF0000u);
            const float kf = __uint_as_float(py[u] << 16), rr = __uint_as_float(py[u] & 0xFFFF0000u);
            const float gp = __expf(cum); cum += lw[u];
            const float g = __expf(cum), en = __expf(-cum);
            const int t = wv * 16 + u;
            const unsigned be = f2bf(bb * en), ka = f2bf(kf * en);
            *(bf16_t*)(lds + S_AL + t * 128 + j * 2) = f2bf(gp * kkn);
            *(bf16_t*)(lds + S_BE + t * 128 + j * 2) = (bf16_t)be;
            *(bf16_t*)(lds + S_KA + t * 128 + j * 2) = (bf16_t)ka;
            *(bf16_t*)(lds + S_RH + t * 128 + j * 2) = f2bf(g * rr);
            if (u & 1) { tb[u >> 1] |= be << 16; tk[u >> 1] |= ka << 16; tv[u >> 1] |= (pz[u] << 16); }
            else { tb[u >> 1] = be; tk[u >> 1] = ka; tv[u >> 1] = pz[u] & 0xFFFFu; }
        }
        *(uint4*)(lds + S_BET + j * 128 + wv * 32) = make_uint4(tb[0], tb[1], tb[2], tb[3]); *(uint4*)(lds + S_BET + j * 128 + wv * 32 + 16) = make_uint4(tb[4], tb[5], tb[6], tb[7]);
        *(uint4*)(lds + S_KAT + j * 128 + wv * 32) = make_uint4(tk[0], tk[1], tk[2], tk[3]); *(uint4*)(lds + S_KAT + j * 128 + wv * 32 + 16) = make_uint4(tk[4], tk[5], tk[6], tk[7]);
        *(uint4*)(lds + S_VT + j * 128 + wv * 32) = make_uint4(tv[0], tv[1], tv[2], tv[3]); *(uint4*)(lds + S_VT + j * 128 + wv * 32 + 16) = make_uint4(tv[4], tv[5], tv[6], tv[7]);
    }
    __syncthreads();
    const int tm = wv >> 1, tn = wv & 1;
    f32x16 aM1, aM2;
    {
        f32x16 aL1, aL2;
#pragma unroll
        for (int i = 0; i < 16; ++i) { aL1[i] = 0.f; aL2[i] = 0.f; aM1[i] = 0.f; aM2[i] = 0.f; }
#pragma unroll
        for (int ks = 0; ks < 4; ++ks) {
            const bf16x8 fa = frag64(lds, S_AL, tm * 32 + r, ks * 16 + 8 * hh), fr = frag64(lds, S_RH, tm * 32 + r, ks * 16 + 8 * hh);
            const bf16x8 fb = frag64(lds, S_BE, tn * 32 + r, ks * 16 + 8 * hh), fk = frag64(lds, S_KA, tn * 32 + r, ks * 16 + 8 * hh);
            aL1 = MFMA32(fa, fb, aL1); aL2 = MFMA32(fa, fk, aL2); aM1 = MFMA32(fr, fb, aM1); aM2 = MFMA32(fr, fk, aM2);
        }
        __syncthreads();
#pragma unroll
        for (int reg = 0; reg < 16; ++reg) {
            const int t = tm * 32 + crow32(reg, hh), sidx = tn * 32 + r;
            const int o = (t * 64 + (sidx & 1) * 32 + (sidx >> 1)) * 4;
            *(float*)(lds + S_L1F + o) = (sidx < t) ? aL1[reg] : 0.f;
            *(float*)(lds + S_L2F + o) = (sidx < t) ? aL2[reg] : 0.f;
            aM1[reg] = (sidx <= t) ? aM1[reg] : 0.f; aM2[reg] = (sidx <= t) ? aM2[reg] : 0.f;
        }
    }
    __syncthreads();
    unsigned outp[32];
    {
        const int col = (wv & 1) * 32 + (lane >> 1), q = lane & 1;
        float xq[32];
#pragma unroll
        for (int k = 0; k < 32; ++k) xq[k] = 0.f;
        const char* l1row = lds + S_L1F + q * 128;
        const char* l2row = lds + S_L2F + q * 128;
        if (wv < 2) {
#pragma unroll
            for (int t = 0; t < 64; ++t) {
                float acc = 0.f;
#pragma unroll
                for (int k4 = 0; k4 * 4 < (t + 1) / 2; ++k4) {
                    const float4 a = *(const float4*)(l1row + t * 256 + k4 * 16);
                    acc = fmaf(a.x, xq[4 * k4 + 0], acc); acc = fmaf(a.y, xq[4 * k4 + 1], acc); acc = fmaf(a.z, xq[4 * k4 + 2], acc); acc = fmaf(a.w, xq[4 * k4 + 3], acc);
                }
                acc += dpp_xor1(acc);
                const float x = bf2f(*(const bf16_t*)(lds + S_AL + t * 128 + col * 2)) - acc;
                xq[t >> 1] = ((t & 1) == q) ? x : xq[t >> 1];
            }
        } else {
            float vq[32];
#pragma unroll
            for (int k8 = 0; k8 < 8; ++k8) {
                const uint4 d = *(const uint4*)(lds + S_VT + col * 128 + k8 * 16);
                vq[4 * k8 + 0] = q ? __uint_as_float(d.x & 0xFFFF0000u) : __uint_as_float(d.x << 16);
                vq[4 * k8 + 1] = q ? __uint_as_float(d.y & 0xFFFF0000u) : __uint_as_float(d.y << 16);
                vq[4 * k8 + 2] = q ? __uint_as_float(d.z & 0xFFFF0000u) : __uint_as_float(d.z << 16);
                vq[4 * k8 + 3] = q ? __uint_as_float(d.w & 0xFFFF0000u) : __uint_as_float(d.w << 16);
            }
#pragma unroll
            for (int t = 0; t < 64; ++t) {
                float acc = 0.f;
#pragma unroll
                for (int k4 = 0; k4 * 4 < (t + 1) / 2; ++k4) {
                    const float4 a = *(const float4*)(l1row + t * 256 + k4 * 16);
                    const float4 bq = *(const float4*)(l2row + t * 256 + k4 * 16);
                    acc = fmaf(bq.x, vq[4 * k4 + 0], acc); acc = fmaf(bq.y, vq[4 * k4 + 1], acc); acc = fmaf(bq.z, vq[4 * k4 + 2], acc); acc = fmaf(bq.w, vq[4 * k4 + 3], acc);
                    acc = fmaf(-a.x, xq[4 * k4 + 0], acc); acc = fmaf(-a.y, xq[4 * k4 + 1], acc); acc = fmaf(-a.z, xq[4 * k4 + 2], acc); acc = fmaf(-a.w, xq[4 * k4 + 3], acc);
                }
                acc += dpp_xor1(acc);
                xq[t >> 1] = ((t & 1) == q) ? acc : xq[t >> 1];
            }
        }
#pragma unroll
        for (int k = 0; k < 32; ++k) { const float o = dpp_xor1(xq[k]); outp[k] = q ? pack2(o, xq[k]) : pack2(xq[k], o); }
    }
    __syncthreads();
    {
        const int col = (wv & 1) * 32 + (lane >> 1), q = lane & 1;
        char* dst = lds + ((wv < 2) ? S_APT : S_W2T) + col * 128 + q * 64;
#pragma unroll
        for (int i = 0; i < 4; ++i) *(uint4*)(dst + i * 16) = q ? make_uint4(outp[16 + 4 * i], outp[17 + 4 * i], outp[18 + 4 * i], outp[19 + 4 * i]) : make_uint4(outp[4 * i], outp[4 * i + 1], outp[4 * i + 2], outp[4 * i + 3]);
#pragma unroll
        for (int reg = 0; reg < 16; ++reg) {
            const int t = tm * 32 + crow32(reg, hh), sidx = tn * 32 + r;
            *(bf16_t*)(lds + S_M1 + t * 128 + sidx * 2) = f2bf(aM1[reg]);
            *(bf16_t*)(lds + S_M2 + t * 128 + sidx * 2) = f2bf(aM2[reg]);
        }
    }
    __syncthreads();
    unsigned char* ubase = p->ws + A_CHAIN + (size_t)((b * 4 + h) * 64 + c) * CHAIN_UNIT;
    f32x16 zero;
#pragma unroll
    for (int i = 0; i < 16; ++i) zero[i] = 0.f;
    f32x16 gt;
    {
        const f32x16 qv = mm64(lds, S_M1, S_APT, tm, tn, r, hh, zero);
        const f32x16 y0 = mm64(lds, S_M2, S_VT, tm, tn, r, hh, zero) - mm64(lds, S_M1, S_W2T, tm, tn, r, hh, zero);
        gt = mm64(lds, S_BET, S_APT, tm, tn, r, hh, zero);
        const f32x16 ht = mm64(lds, S_KAT, S_VT, tm, tn, r, hh, zero) - mm64(lds, S_BET, S_W2T, tm, tn, r, hh, zero);
#pragma unroll
        for (int reg = 0; reg < 16; ++reg) {
            const int t = tm * 32 + crow32(reg, hh), jc = tn * 32 + r;
            const float rh = bf2f(*(const bf16_t*)(lds + S_RH + t * 128 + jc * 2));
            *(bf16_t*)(lds + S_RP + t * 128 + jc * 2) = f2bf(rh - qv[reg]);
            const int jr = tm * 32 + crow32(reg, hh);
            const float gc = gamC[jr];
            gt[reg] = gc * (((jr == jc) ? 1.f : 0.f) - gt[reg]);
        }
        float4* himg = (float4*)(ubase + 16384); float4* yimg = (float4*)(ubase + 32768);
#pragma unroll
        for (int rq = 0; rq < 4; ++rq) {
            float4 hv, yv;
            hv.x = gamC[tm * 32 + crow32(4 * rq + 0, hh)] * ht[4 * rq + 0]; hv.y = gamC[tm * 32 + crow32(4 * rq + 1, hh)] * ht[4 * rq + 1];
            hv.z = gamC[tm * 32 + crow32(4 * rq + 2, hh)] * ht[4 * rq + 2]; hv.w = gamC[tm * 32 + crow32(4 * rq + 3, hh)] * ht[4 * rq + 3];
            yv.x = y0[4 * rq + 0]; yv.y = y0[4 * rq + 1]; yv.z = y0[4 * rq + 2]; yv.w = y0[4 * rq + 3];
            himg[((tn * 2 + tm) * 4 + rq) * 64 + lane] = hv;
            yimg[((tn * 2 + tm) * 4 + rq) * 64 + lane] = yv;
        }
    }
    __syncthreads();
#pragma unroll
    for (int reg = 0; reg < 16; ++reg) {
        const int jr = tm * 32 + crow32(reg, hh), jc = tn * 32 + r;
        *(bf16_t*)(lds + S_GTR + jr * 128 + jc * 2) = f2bf(gt[reg]);
    }
    __syncthreads();
    {
        uint4* gimg = (uint4*)(ubase); uint4* rimg = (uint4*)(ubase + 8192);
#pragma unroll
        for (int ii = 0; ii < 2; ++ii) {
            const int im = wv * 2 + ii, mt = im >> 2, jb = (im >> 1) & 1, s2 = im & 1;
            const int cbase = (32 * jb + 16 * s2 + 4 * hh) * 2;
            const uint2 g0 = *(const uint2*)(lds + S_GTR + (mt * 32 + r) * 128 + cbase), g1 = *(const uint2*)(lds + S_GTR + (mt * 32 + r) * 128 + cbase + 16);
            const uint2 r0 = *(const uint2*)(lds + S_RP + (mt * 32 + r) * 128 + cbase), r1 = *(const uint2*)(lds + S_RP + (mt * 32 + r) * 128 + cbase + 16);
            gimg[im * 64 + lane] = make_uint4(g0.x, g0.y, g1.x, g1.y);
            rimg[im * 64 + lane] = make_uint4(r0.x, r0.y, r1.x, r1.y);
        }
    }
    __syncthreads();
}

DEVINL void phaseB1(KP p, int l, char* lds, const int mask = 15, const int sub = 3) {
    const int nb = NBV();
    if (mask & 1) {
        const int blk = BIDX();
        for (int it = blk; it < 512; it += nb) {
            if (sub & 1) { b1_rwkv(p, l, lds, it * 2); b1_rwkv(p, l, lds, it * 2 + 1); }
            __threadfence_block(); __syncthreads();
            const int b = it >> 6, c = it & 63;
            if (sub & 2) {
#pragma unroll 1
                for (int h = 0; h < 4; ++h) b1e_unit(p, lds, b, h, c);
            }
        }
    }
    if (mask & 2) { const int blk = BIDX(); for (int it = blk; it < 1024; it += nb) b1_lru(p, l, lds, it); }
    if (mask & 4) { const int blk = BIDX(); for (int it = blk; it < 1024; it += nb) b1_conformer(p, l, lds, it); }
    if (mask & 8) { const int blk = BIDX(); for (int it = blk; it < 512; it += nb) b1_shortconv(p, l, it); }
}

DEVINL void phaseB2(KP p, int l, char* lds) {
    const int tid = TIDX(), blk = BIDX();
    if (blk >= 64 && blk < 72) {
        const int bb = blk - 64;
        const float* ca = (const float*)(p->ws + A_CARRYA) + (size_t)bb * 128 * 256 + tid;
        const float* ch = (const float*)(p->ws + A_CARRYH) + (size_t)bb * 128 * 256 + tid;
        float* hst = (float*)(p->ws + A_HSTART) + (size_t)bb * 128 * 256 + tid;
        float hs = 0.f;
#pragma unroll 8
        for (int tt = 0; tt < 128; ++tt) { hst[tt * 256] = hs; hs = fmaf(ca[tt * 256], hs, ch[tt * 256]); }
    }
    if (blk < 64 && tid < 64) {
        const int lane = tid, r = lane & 31, hh = lane >> 5;
        const int bh = blk >> 1, w = blk & 1, b = bh >> 2, h = bh & 3;
        float* yraw = (float*)(p->ws + A_YRAW) + (size_t)b * SEQ * 256 + h * 64 + 32 * w + r;
        f32x16 X0, X1;
#pragma unroll
        for (int i = 0; i < 16; ++i) { X0[i] = 0.f; X1[i] = 0.f; }
        auto issue = [&](int c, char* buf) {
            const unsigned char* ubase = p->ws + A_CHAIN + (size_t)(bh * 64 + c) * CHAIN_UNIT;
#pragma unroll
            for (int i = 0; i < 8; ++i) {
                __builtin_amdgcn_global_load_lds((const unsigned*)(ubase + i * 1024 + lane * 16), (unsigned*)(buf + i * 1024 + lane * 16), 16, 0, 0);
                __builtin_amdgcn_global_load_lds((const unsigned*)(ubase + 8192 + i * 1024 + lane * 16), (unsigned*)(buf + 8192 + i * 1024 + lane * 16), 16, 0, 0);
                __builtin_amdgcn_global_load_lds((const unsigned*)(ubase + 16384 + (w * 8 + i) * 1024 + lane * 16), (unsigned*)(buf + 16384 + i * 1024 + lane * 16), 16, 0, 0);
                __builtin_amdgcn_global_load_lds((const unsigned*)(ubase + 32768 + (w * 8 + i) * 1024 + lane * 16), (unsigned*)(buf + 24576 + i * 1024 + lane * 16), 16, 0, 0);
            }
        };
        issue(0, lds);
        for (int c = 0; c < 64; ++c) {
            char* buf = lds + (c & 1) * 32768;
            if (c + 1 < 64) { issue(c + 1, lds + ((c + 1) & 1) * 32768); asm volatile("s_waitcnt vmcnt(32)" ::: "memory"); }
            else asm volatile("s_waitcnt vmcnt(0)" ::: "memory");
            uint4 gq[8], rq8[8]; float4 hq[8], yq[8];
#pragma unroll
            for (int i = 0; i < 8; ++i) { gq[i] = *(const uint4*)(buf + i * 1024 + lane * 16); rq8[i] = *(const uint4*)(buf + 8192 + i * 1024 + lane * 16); }
#pragma unroll
            for (int i = 0; i < 8; ++i) { hq[i] = *(const float4*)(buf + 16384 + i * 1024 + lane * 16); yq[i] = *(const float4*)(buf + 24576 + i * 1024 + lane * 16); }
            bf16x8 xp[4];
#pragma unroll
            for (int s2 = 0; s2 < 2; ++s2) {
                uint4 a, bq;
                a.x = pack2(X0[8 * s2 + 0], X0[8 * s2 + 1]); a.y = pack2(X0[8 * s2 + 2], X0[8 * s2 + 3]); a.z = pack2(X0[8 * s2 + 4], X0[8 * s2 + 5]); a.w = pack2(X0[8 * s2 + 6], X0[8 * s2 + 7]);
                bq.x = pack2(X1[8 * s2 + 0], X1[8 * s2 + 1]); bq.y = pack2(X1[8 * s2 + 2], X1[8 * s2 + 3]); bq.z = pack2(X1[8 * s2 + 4], X1[8 * s2 + 5]); bq.w = pack2(X1[8 * s2 + 6], X1[8 * s2 + 7]);
                xp[s2] = __builtin_bit_cast(bf16x8, a); xp[2 + s2] = __builtin_bit_cast(bf16x8, bq);
            }
#pragma unroll
            for (int mt = 0; mt < 2; ++mt) {
                f32x16 acc;
#pragma unroll
                for (int i = 0; i < 4; ++i) { acc[4 * i] = yq[mt * 4 + i].x; acc[4 * i + 1] = yq[mt * 4 + i].y; acc[4 * i + 2] = yq[mt * 4 + i].z; acc[4 * i + 3] = yq[mt * 4 + i].w; }
#pragma unroll
                for (int f = 0; f < 4; ++f) acc = MFMA32(__builtin_bit_cast(bf16x8, rq8[mt * 4 + f]), xp[f], acc);
#pragma unroll
                for (int reg = 0; reg < 16; ++reg) yraw[(size_t)(c * 64 + mt * 32 + crow32(reg, hh)) * 256] = acc[reg];
            }
            f32x16 n0, n1;
#pragma unroll
            for (int i = 0; i < 4; ++i) { n0[4 * i] = hq[i].x; n0[4 * i + 1] = hq[i].y; n0[4 * i + 2] = hq[i].z; n0[4 * i + 3] = hq[i].w;
                                          n1[4 * i] = hq[4 + i].x; n1[4 * i + 1] = hq[4 + i].y; n1[4 * i + 2] = hq[4 + i].z; n1[4 * i + 3] = hq[4 + i].w; }
#pragma unroll
            for (int f = 0; f < 4; ++f) { n0 = MFMA32(__builtin_bit_cast(bf16x8, gq[f]), xp[f], n0); n1 = MFMA32(__builtin_bit_cast(bf16x8, gq[4 + f]), xp[f], n1); }
            X0 = n0; X1 = n1;
        }
    }
}

DEVINL void phaseB3(KP p, int l) {
    const int c = TIDX(), nb = NBV(), blk = BIDX();
    const bf16_t* P = (const bf16_t*)(p->ws + A_P);
    bf16_t* ymix = (bf16_t*)(p->ws + A_YMIX);
    const float* yraw = (const float*)(p->ws + A_YRAW); const bf16_t* bonus = (const bf16_t*)(p->ws + A_BONUS); const bf16_t* gbuf = (const bf16_t*)(p->ws + A_G);
    const unsigned* hcbuf = (const unsigned*)(p->ws + A_HLOC); const float* hst = (const float*)(p->ws + A_HSTART);
    const float gng = p->in[I_GNG][l * 256 + c], gnb = p->in[I_GNB][l * 256 + c];
    for (int it = blk; it < 512; it += nb) {
#pragma unroll 4
        for (int rr = 0; rr < 64; ++rr) {
            const int row = it * 64 + rr, b = row >> 12, tt = (row & 4095) >> 5;
            const size_t o = (size_t)row * 256 + c;
            const float y = yraw[o];
            const float mu = wave_sum(y) * (1.f / 64.f);
            const float d = y - mu;
            const float var = wave_sum(d * d) * (1.f / 64.f);
            const float yn = d * rsqrtf(var + GN_EPS) * gng + gnb;
            ymix[(size_t)row * DM + 512 + c] = f2bf((yn + bf2f(bonus[o])) * bf2f(gbuf[o]));
            const unsigned hc = hcbuf[o];
            const float hh = fmaf(__uint_as_float(hc & 0xFFFF0000u), hst[(size_t)(b * 128 + tt) * 256 + c], __uint_as_float(hc << 16));
            const float gb = bf2f(P[(size_t)row * PIN + 768 + c]);
            ymix[(size_t)row * DM + 256 + c] = f2bf(hh * gelu_tanh(gb));
        }
    }
}

DEVINL void phaseD(KP p, int l, char* lds, const int dry = 0) {
    const int tid = TIDX(), nb = NBV(), blk = BIDX(), wid = tid >> 6, lane = tid & 63;
    constexpr int URS = 2064;
    char* uh = lds;
    char* ulo = lds + 16 * URS;
    float* logit = (float*)(lds + 32 * URS);
    int* sel_e = (int*)(lds + 32 * URS + 4096);
    int* lpos = sel_e + 512;
    int* hist = lpos + 512;
    int* basep = hist + 64;
    const bf16_t* wrt_hi = (const bf16_t*)(p->ws + OFF_WR) + (size_t)(l * 2 + 0) * 64 * 1024;
    const bf16_t* wrt_lo = (const bf16_t*)(p->ws + OFF_WR) + (size_t)(l * 2 + 1) * 64 * 1024;
    const bf16_t* zbuf = (const bf16_t*)(p->ws + M_ZB);
    float2* lnstat = (float2*)(p->ws + M_STAT);
    bf16_t* ubuf = (bf16_t*)(p->ws + (dry ? A_YMIX : OFF_UBUF));
    const float* mod = (const float*)(p->ws + OFF_MOD);
    const float* wr = p->in[I_WROUTER] + (size_t)l * 1024 * 64 + lane;
    const float ebias = p->in[I_EBIAS][l * 64 + lane];
    unsigned* cnt = (unsigned*)(p->ws + OFF_CNT) + l * 64 + (dry ? 256 : 0);
    int* list = (int*)(p->ws + (dry ? M_HBUF : M_LIST));
    float* wsel = (float*)(p->ws + (dry ? M_HBUF + 16777216 : M_WSEL));
    int* pmap = (int*)(p->ws + (dry ? M_HBUF + 33554432 : M_PMAP));
    for (int it = blk; it < 512; it += nb) {
        const int tok0 = it * 64;
        if (tid < 64) hist[tid] = 0;
        for (int sb = 0; sb < 4; ++sb) {
#pragma unroll
            for (int j = 0; j < 4; ++j) {
                const int tl = wid * 4 + j, row = tok0 + sb * 16 + tl, b = row >> 12;
                float4 z[4];
                float s = 0.f;
#pragma unroll
                for (int i = 0; i < 4; ++i) { const uint2 zv = *(const uint2*)(zbuf + (size_t)row * DM + i * 256 + lane * 4);
                    z[i].x = __uint_as_float(zv.x << 16); z[i].y = __uint_as_float(zv.x & 0xFFFF0000u); z[i].z = __uint_as_float(zv.y << 16); z[i].w = __uint_as_float(zv.y & 0xFFFF0000u); s += z[i].x + z[i].y + z[i].z + z[i].w; }
                const float mean = wave_sum(s) * (1.f / 1024.f);
                float q = 0.f;
#pragma unroll
                for (int i = 0; i < 4; ++i) { z[i].x -= mean; z[i].y -= mean; z[i].z -= mean; z[i].w -= mean; q += z[i].x * z[i].x + z[i].y * z[i].y + z[i].z * z[i].z + z[i].w * z[i].w; }
                const float rs = rsqrtf(wave_sum(q) * (1.f / 1024.f) + LN_EPS);
                if (lane == 0) lnstat[row] = make_float2(mean, rs);
#pragma unroll
                for (int i = 0; i < 4; ++i) {
                    const int col = i * 256 + lane * 4;
                    const float4 g = *(const float4*)(p->in[I_LN1G] + l * 1024 + col), bb = *(const float4*)(p->in[I_LN1B] + l * 1024 + col);
                    const float4 sh = *(const float4*)(mod + (size_t)(l * 8 + b) * 6144 + 3072 + col), sc = *(const float4*)(mod + (size_t)(l * 8 + b) * 6144 + 4096 + col);
                    float4 x1; x1.x = z[i].x * rs * g.x + bb.x; x1.y = z[i].y * rs * g.y + bb.y; x1.z = z[i].z * rs * g.z + bb.z; x1.w = z[i].w * rs * g.w + bb.w;
                    float4 u; u.x = x1.x * (1.f + sc.x) + sh.x; u.y = x1.y * (1.f + sc.y) + sh.y; u.z = x1.z * (1.f + sc.z) + sh.z; u.w = x1.w * (1.f + sc.w) + sh.w;
                    uint2 o; o.x = pack2(u.x, u.y); o.y = pack2(u.z, u.w);
                    *(uint2*)(ubuf + (size_t)row * DM + col) = o;
                    *(uint2*)(uh + tl * URS + col * 2) = o;
                    uint2 o2; o2.x = pack2(u.x - __uint_as_float(o.x << 16), u.y - __uint_as_float(o.x & 0xFFFF0000u)); o2.y = pack2(u.z - __uint_as_float(o.y << 16), u.w - __uint_as_float(o.y & 0xFFFF0000u));
                    *(uint2*)(ulo + tl * URS + col * 2) = o2;
                }
            }
            __syncthreads();
            {
                const int fr = lane & 15, fq = lane >> 4;
                f32x4 lacc = (f32x4){0.f, 0.f, 0.f, 0.f};
                const bf16_t* bh = wrt_hi + (size_t)(wid * 16 + fr) * 1024 + fq * 8;
                const bf16_t* bl = wrt_lo + (size_t)(wid * 16 + fr) * 1024 + fq * 8;
#pragma unroll 1
                for (int k8 = 0; k8 < 4; ++k8) {
                    bf16x8 bhv[8], blv[8];
#pragma unroll
                    for (int kk = 0; kk < 8; ++kk) { bhv[kk] = *(const bf16x8*)(bh + (k8 * 8 + kk) * 32); blv[kk] = *(const bf16x8*)(bl + (k8 * 8 + kk) * 32); }
#pragma unroll
                    for (int kk = 0; kk < 8; ++kk) {
                        const int ko = (k8 * 8 + kk) * 64 + fq * 16;
                        const bf16x8 ah = *(const bf16x8*)(uh + fr * URS + ko), al = *(const bf16x8*)(ulo + fr * URS + ko);
                        lacc = __builtin_amdgcn_mfma_f32_16x16x32_bf16(ah, bhv[kk], lacc, 0, 0, 0);
                        lacc = __builtin_amdgcn_mfma_f32_16x16x32_bf16(al, bhv[kk], lacc, 0, 0, 0);
                        lacc = __builtin_amdgcn_mfma_f32_16x16x32_bf16(ah, blv[kk], lacc, 0, 0, 0);
                    }
                }
#pragma unroll
                for (int j = 0; j < 4; ++j) logit[(fq * 4 + j) * 64 + wid * 16 + fr] = lacc[j];
            }
            __syncthreads();
            float acc[4];
#pragma unroll
            for (int j = 0; j < 4; ++j) acc[j] = logit[(wid * 4 + j) * 64 + lane];
#pragma unroll
            for (int j = 0; j < 4; ++j) {
                const int tl = sb * 16 + wid * 4 + j;
                const float score = 1.f / (1.f + __expf(-acc[j]));
                const float biased = score + ebias;
                const float m1 = group8_max(biased);
                const unsigned long long eq = __ballot(biased == m1);
                const int g = lane >> 3;
                const unsigned gm = (unsigned)(eq >> (g * 8)) & 0xFFu;
                const int first = __ffs((int)gm) - 1;
                const float v2 = ((lane & 7) == first) ? -INFINITY : biased;
                const float m2 = group8_max(v2);
                const float gs = m1 + m2;
                int rg = 0;
#pragma unroll
                for (int g2 = 0; g2 < 8; ++g2) { const float o = __builtin_bit_cast(float, __builtin_amdgcn_readlane(__builtin_bit_cast(int, gs), g2 * 8)); rg += ((o > gs) || (o == gs && g2 < g)) ? 1 : 0; }
                const bool keep = rg < 4;
                const float mk = keep ? biased : -INFINITY;
                int rk = 0;
#pragma unroll
                for (int e2 = 0; e2 < 64; ++e2) { const float o = __builtin_bit_cast(float, __builtin_amdgcn_readlane(__builtin_bit_cast(int, mk), e2)); rk += ((o > mk) || (o == mk && e2 < lane)) ? 1 : 0; }
                const bool sel = keep && (rk < 8);
                const float ssum = wave_sum(sel ? score : 0.f);
                const float wgt = score / ssum * 2.5f;
                const unsigned long long sm = __ballot(sel);
                const int kidx = __popcll(sm & ((1ull << lane) - 1ull));
                if (sel) { wsel[(size_t)(tok0 + tl) * 8 + kidx] = wgt; sel_e[tl * 8 + kidx] = lane; }
            }
            __syncthreads();
        }
        for (int i = tid; i < 512; i += VTHREADS) lpos[i] = atomicAdd(&hist[sel_e[i]], 1);
        __syncthreads();
        if (tid < 64) basep[tid] = (int)atomicAdd(&cnt[tid], (unsigned)hist[tid]);
        __syncthreads();
        for (int i = tid; i < 512; i += VTHREADS) { const int e = sel_e[i], pos = basep[e] + lpos[i]; list[(size_t)e * NTOK + pos] = tok0 * 8 + i; pmap[tok0 * 8 + i] = (e << 16) | pos; }
        __syncthreads();
    }
}

DEVINL void phaseA(KP p, int l, char* lds) {
    const int tid = TID512(), c = blockIdx.x, G = gridDim.x;
    const char* ubuf = (const char*)(p->ws + OFF_UBUF);
    const char* Wt = (const char*)(p->ws + OFF_WIN) + (size_t)l * WIN_ROWS * 1024 * 2;
    bf16_t* P = (bf16_t*)(p->ws + A_P);
    auto sched = [&](int i, GUnit& u) -> bool {
        const long L = unit_linear(i, c, G); if (L >= 128 * 11) return false;
        const int Li = (int)L, sx = Li >> 9, w = (sx == 2) ? 3 : 4, rem = Li - (sx << 9), pm = rem / w, pn = sx * 4 + (rem - pm * w);
        u.A = ubuf + (size_t)pm * 256 * 2048; u.B = Wt + (size_t)pn * 256 * 2048; u.i0 = pm; u.i1 = pn; u.i2 = 0;
        return true;
    };
    auto epi = [&](f32x4 (&acc)[2][2][4][2], const GUnit& u, int wr, int wc, int fr, int fq) {
        asm volatile("" : "+v"(fr), "+v"(fq));
        const int row0 = u.i0 * 256 + wr * 64 + fr, col0 = u.i1 * 256 + wc * 32 + 8 * fq;
#pragma unroll
        for (int ai = 0; ai < 2; ++ai)
#pragma unroll
            for (int m = 0; m < 4; ++m) {
                bf16_t* rowp = P + (size_t)(row0 + ai * 128 + m * 16) * PIN + col0;
#pragma unroll
                for (int bj = 0; bj < 2; ++bj) {
                    if (col0 + bj * 128 < PIN) {
                        const f32x4 v0 = acc[ai][bj][m][0], v1 = acc[ai][bj][m][1];
                        *(uint4*)(rowp + bj * 128) = make_uint4(pack2(v0[0], v0[1]), pack2(v0[2], v0[3]), pack2(v1[0], v1[1]), pack2(v1[2], v1[3]));
                    }
                }
            }
    };
    gemm256<true, false>(lds, 1024, 1024, sched, epi);
}

DEVINL void phaseC(KP p, int l, char* lds) {
    const int tid = TID512(), c = blockIdx.x, G = gridDim.x;
    const char* ymix = (const char*)(p->ws + A_YMIX);
    const char* Wt = (const char*)(p->ws + OFF_WOUT) + (size_t)l * 1024 * 1024 * 2;
    const float* res32 = p->in[I_X];
    const bf16_t* res16 = (const bf16_t*)p->out;
    bf16_t* zbuf = (bf16_t*)(p->ws + M_ZB);
    const float* mod = (const float*)(p->ws + OFF_MOD);
    auto sched = [&](int i, GUnit& u) -> bool {
        const long L = unit_linear(i, c, G); if (L >= 128 * 4) return false;
        const int pm = (int)L >> 2, pn = (int)L & 3;
        u.A = ymix + (size_t)pm * 256 * 2048; u.B = Wt + (size_t)pn * 256 * 2048; u.i0 = pm; u.i1 = pn; u.i2 = 0;
        return true;
    };
    auto epi = [&](f32x4 (&acc)[2][2][4][2], const GUnit& u, int wr, int wc, int fr, int fq) {
        asm volatile("" : "+v"(fr), "+v"(fq));
        const int row0 = u.i0 * 256 + wr * 64 + fr, col0 = u.i1 * 256 + wc * 32 + 8 * fq;
#pragma unroll
        for (int ai = 0; ai < 2; ++ai)
#pragma unroll
            for (int m = 0; m < 4; ++m) {
                const int row = row0 + ai * 128 + m * 16, b = row >> 12;
#pragma unroll
                for (int bj = 0; bj < 2; ++bj) {
                    const int col = col0 + bj * 128;
                    const float4 ga = *(const float4*)(mod + (size_t)(l * 8 + b) * 6144 + 2048 + col), gb = *(const float4*)(mod + (size_t)(l * 8 + b) * 6144 + 2048 + col + 4);
                    float r[8];
                    if (l == 0) {
                        const float4 ra = *(const float4*)(res32 + (size_t)row * DM + col), rb = *(const float4*)(res32 + (size_t)row * DM + col + 4);
                        r[0] = ra.x; r[1] = ra.y; r[2] = ra.z; r[3] = ra.w; r[4] = rb.x; r[5] = rb.y; r[6] = rb.z; r[7] = rb.w;
                    } else {
                        const uint4 rv = *(const uint4*)(res16 + (size_t)row * DM + col);
                        r[0] = __uint_as_float(rv.x << 16); r[1] = __uint_as_float(rv.x & 0xFFFF0000u); r[2] = __uint_as_float(rv.y << 16); r[3] = __uint_as_float(rv.y & 0xFFFF0000u);
                        r[4] = __uint_as_float(rv.z << 16); r[5] = __uint_as_float(rv.z & 0xFFFF0000u); r[6] = __uint_as_float(rv.w << 16); r[7] = __uint_as_float(rv.w & 0xFFFF0000u);
                    }
                    const f32x4 a0 = acc[ai][bj][m][0], a1 = acc[ai][bj][m][1];
                    const float z0 = ALPHA * r[0] + (1.f + ga.x) * a0[0], z1 = ALPHA * r[1] + (1.f + ga.y) * a0[1], z2 = ALPHA * r[2] + (1.f + ga.z) * a0[2], z3 = ALPHA * r[3] + (1.f + ga.w) * a0[3];
                    const float z4 = ALPHA * r[4] + (1.f + gb.x) * a1[0], z5 = ALPHA * r[5] + (1.f + gb.y) * a1[1], z6 = ALPHA * r[6] + (1.f + gb.z) * a1[2], z7 = ALPHA * r[7] + (1.f + gb.w) * a1[3];
                    *(uint4*)(zbuf + (size_t)row * DM + col) = make_uint4(pack2(z0, z1), pack2(z2, z3), pack2(z4, z5), pack2(z6, z7));
                }
            }
    };
    gemm256<true, false>(lds, 1024, 1024, sched, epi);
}

constexpr int DIR_OFF = 131072;
DEVINL void moe_directory(KP p, int l, char* lds) {
    int* pref = (int*)(lds + DIR_OFF);
    int* cntl = (int*)(lds + DIR_OFF + 512);
    unsigned* cnt = (unsigned*)(p->ws + OFF_CNT) + l * 64;
    asm volatile("" : "+s"(cnt));
    if (threadIdx.x == 0) {
        int s = 0;
        int* xpre = (int*)(lds + DIR_OFF + 1024);
        int x = 0;
        for (int e = 0; e < 64; ++e) { const int c = (int)__hip_atomic_load(&cnt[e], __ATOMIC_RELAXED, __HIP_MEMORY_SCOPE_AGENT); cntl[e] = c; pref[e] = s; s += (c + 255) >> 8; xpre[e] = x; x += c; }
        pref[64] = s; cntl[64] = NTOK; pref[65] = s + 128; xpre[64] = x;
    }
    __syncthreads();
    {
        int* m2e = (int*)(lds + DIR_OFF + 2048);
        const int tot = pref[65];
        for (int mg = threadIdx.x; mg < tot; mg += NTHREADS) { int e = 0; while (pref[e + 1] <= mg) ++e; m2e[mg] = e; }
    }
    __syncthreads();
}

DEVINL void phaseE1(KP p, int l, char* lds) {
    const int tid = TID512(), c = blockIdx.x, G = gridDim.x;
    moe_directory(p, l, lds);
    const int* pref = (const int*)(lds + DIR_OFF); const int* cntl = (const int*)(lds + DIR_OFF + 512);
    const char* ubuf = (const char*)(p->ws + OFF_UBUF);
    const int* list = (const int*)(p->ws + M_LIST);
    bf16_t* hbuf = (bf16_t*)(p->ws + M_HBUF);
    const char* W13 = (const char*)(p->ws + OFF_W13) + (size_t)(l * 65) * 512 * 1024 * 2;
    const int total = __builtin_amdgcn_readfirstlane(pref[65]) * 2;
    auto sched = [&](int i, GUnit& u) -> bool {
        const long L = unit_linear(i, c, G); if (L >= total) return false;
        const int mg = (int)L >> 1, nt = (int)L & 1;
        const int e = __builtin_amdgcn_readfirstlane(((const int*)(lds + DIR_OFF + 2048))[mg]);
        const int mt = __builtin_amdgcn_readfirstlane(mg - pref[e]), Me = __builtin_amdgcn_readfirstlane(cntl[e]);
        u.A = ubuf; u.B = W13 + ((size_t)e * 512 + nt * 256) * 2048; u.i0 = mg; u.i1 = nt; u.i2 = e;
        int R[2], C[2]; stage_coords512(TID512(), R, C);
#pragma unroll
        for (int h = 0; h < 2; ++h)
#pragma unroll
            for (int i2 = 0; i2 < 2; ++i2) {
                const int idx = mt * 256 + h * 128 + R[i2]; int tok;
                if (e < 64) tok = (idx < Me) ? (list[(size_t)e * NTOK + idx] >> 3) : 0; else tok = idx;
                u.va[h][i2] = (unsigned)(tok * 1024 + C[i2]) * 2u;
            }
        return true;
    };
    auto epi = [&](f32x4 (&acc)[2][2][4][2], const GUnit& u, int wr, int wc, int fr, int fq) {
        asm volatile("" : "+v"(fr), "+v"(fq));
        const size_t row0 = (size_t)u.i0 * 256 + wr * 64 + fr;
#pragma unroll
        for (int ai = 0; ai < 2; ++ai)
#pragma unroll
            for (int m = 0; m < 4; ++m) {
                bf16_t* rowp = hbuf + (row0 + ai * 128 + m * 16) * 256;
#pragma unroll
                for (int bj = 0; bj < 2; ++bj) {
                    const int hcol = (u.i1 * 8 + bj * 4 + wc) * 16 + 4 * fq;
                    const f32x4 gt = acc[ai][bj][m][0], up = acc[ai][bj][m][1];
                    float hv[4];
#pragma unroll
                    for (int j = 0; j < 4; ++j) hv[j] = gt[j] * sigm(gt[j]) * up[j];
                    uint2 o; o.x = pack2(hv[0], hv[1]); o.y = pack2(hv[2], hv[3]);
                    *(uint2*)(rowp + hcol) = o;
                }
            }
    };
    gemm256<false, true>(lds, 1024, 1024, sched, epi);
}

DEVINL void phaseE2(KP p, int l, char* lds) {
    const int tid = TID512(), c = blockIdx.x, G = gridDim.x;
    moe_directory(p, l, lds);
    const int* pref = (const int*)(lds + DIR_OFF); const int* cntl = (const int*)(lds + DIR_OFF + 512);
    const int* xpre = (const int*)(lds + DIR_OFF + 1024);
    const char* hbuf = (const char*)(p->ws + M_HBUF);
    unsigned char* ybuf = (unsigned char*)(p->ws + M_YBUF);
    const char* W2 = (const char*)(p->ws + OFF_W2) + (size_t)(l * 65) * 1024 * 256 * 2;
    const int total = __builtin_amdgcn_readfirstlane(pref[65]) * 4;
    auto sched = [&](int i, GUnit& u) -> bool {
        const long L = unit_linear(i, c, G); if (L >= total) return false;
        const int mg = (int)L >> 2, nt = (int)L & 3;
        const int e = __builtin_amdgcn_readfirstlane(((const int*)(lds + DIR_OFF + 2048))[mg]);
        u.A = hbuf + (size_t)mg * 256 * 512; u.B = W2 + ((size_t)e * 1024 + nt * 256) * 512; u.i0 = mg; u.i1 = nt; u.i2 = e;
        return true;
    };
    auto epi = [&](f32x4 (&acc)[2][2][4][2], const GUnit& u, int wr, int wc, int fr, int fq) {
        asm volatile("" : "+v"(fr), "+v"(fq));
        const int e = __builtin_amdgcn_readfirstlane(u.i2), mt = __builtin_amdgcn_readfirstlane(u.i0 - pref[e]), Me = __builtin_amdgcn_readfirstlane(cntl[e]);
        const int yrow0 = __builtin_amdgcn_readfirstlane(xpre[e]) + mt * 256;
        const int col0 = u.i1 * 256 + wc * 32 + 8 * fq, loc0 = wr * 64 + fr;
#pragma unroll
        for (int ai = 0; ai < 2; ++ai)
#pragma unroll
            for (int m = 0; m < 4; ++m) {
                const int loc = loc0 + ai * 128 + m * 16;
                if (mt * 256 + loc < Me) {
                    unsigned char* rowp = ybuf + (size_t)(yrow0 + loc) * 1024 + col0;
#pragma unroll
                    for (int bj = 0; bj < 2; ++bj) {
                        const f32x4 v0 = acc[ai][bj][m][0], v1 = acc[ai][bj][m][1];
                        int w0 = __builtin_amdgcn_cvt_pk_fp8_f32(v0[0], v0[1], 0, false); w0 = __builtin_amdgcn_cvt_pk_fp8_f32(v0[2], v0[3], w0, true);
                        int w1 = __builtin_amdgcn_cvt_pk_fp8_f32(v1[0], v1[1], 0, false); w1 = __builtin_amdgcn_cvt_pk_fp8_f32(v1[2], v1[3], w1, true);
                        *(uint2*)(rowp + bj * 128) = make_uint2((unsigned)w0, (unsigned)w1);
                    }
                }
            }
    };
    gemm256<true, false>(lds, 256, 256, sched, epi);
}

DEVINL void phaseF(KP p, int l, const int dry = 0) {
    const int tid = TIDX(), nb = NBV(), blk = BIDX(), wid = tid >> 6, lane = tid & 63;
    const bf16_t* zbuf = (const bf16_t*)(p->ws + M_ZB);
    float* xout = dry ? (float*)(p->ws + M_HBUF) : p->out;
    const unsigned char* ybuf = (const unsigned char*)(p->ws + M_YBUF);
    bf16_t* ubuf = (bf16_t*)(p->ws + OFF_UBUF);
    const float* mod = (const float*)(p->ws + OFF_MOD);
    const int* pmap = (const int*)(p->ws + M_PMAP); const float* wsel = (const float*)(p->ws + M_WSEL);
    const float2* lnstat = (const float2*)(p->ws + M_STAT);
    int xoff;
    {
        const unsigned* cnt = (const unsigned*)(p->ws + OFF_CNT) + l * 64;
        const int c = (int)__hip_atomic_load(&cnt[lane], __ATOMIC_RELAXED, __HIP_MEMORY_SCOPE_AGENT);
        xoff = 0;
#pragma unroll
        for (int j = 0; j < 64; ++j) { const int cj = __builtin_amdgcn_readlane(c, j); xoff += (j < lane) ? cj : 0; }
    }
    for (int row = blk * 4 + wid; row < NTOK; row += nb * 4) {
        const int b = row >> 12;
        int yr = 0; float yw = 0.f;
        if (lane < 8) { const int pm = pmap[row * 8 + lane]; yr = pm; yw = wsel[row * 8 + lane]; }
        { const int e = (yr >> 16) & 63; const int xo = __builtin_amdgcn_ds_bpermute(e << 2, xoff); yr = xo + (yr & 0xFFFF); }
        int yrow[8]; float yww[8];
#pragma unroll
        for (int k = 0; k < 8; ++k) { yrow[k] = __builtin_amdgcn_readlane(yr, k); yww[k] = __builtin_bit_cast(float, __builtin_amdgcn_readlane(__builtin_bit_cast(int, yw), k)); }
        float4 z[4]; float s = 0.f;
        const float2 st1 = lnstat[row];
#pragma unroll
        for (int i = 0; i < 4; ++i) {
            const int col = i * 256 + lane * 4;
            float4 x1;
            { const uint2 zv = *(const uint2*)(zbuf + (size_t)row * DM + col);
              float4 z1; z1.x = __uint_as_float(zv.x << 16); z1.y = __uint_as_float(zv.x & 0xFFFF0000u); z1.z = __uint_as_float(zv.y << 16); z1.w = __uint_as_float(zv.y & 0xFFFF0000u);
              const float4 g1 = *(const float4*)(p->in[I_LN1G] + l * 1024 + col), b1 = *(const float4*)(p->in[I_LN1B] + l * 1024 + col);
              x1.x = (z1.x - st1.x) * st1.y * g1.x + b1.x; x1.y = (z1.y - st1.x) * st1.y * g1.y + b1.y; x1.z = (z1.z - st1.x) * st1.y * g1.z + b1.z; x1.w = (z1.w - st1.x) * st1.y * g1.w + b1.w; }
            float f0, f1, f2, f3;
            { const int yv = *(const int*)(ybuf + ((size_t)(262144 + row)) * 1024 + col);
              const f2_t lo = __builtin_amdgcn_cvt_pk_f32_fp8(yv, false), hi = __builtin_amdgcn_cvt_pk_f32_fp8(yv, true);
              f0 = lo[0]; f1 = lo[1]; f2 = hi[0]; f3 = hi[1]; }
            int yvk[8];
#pragma unroll
            for (int k = 0; k < 8; ++k) yvk[k] = *(const int*)(ybuf + (size_t)yrow[k] * 1024 + col);
#pragma unroll
            for (int k = 0; k < 8; ++k) {
                const f2_t lo = __builtin_amdgcn_cvt_pk_f32_fp8(yvk[k], false), hi = __builtin_amdgcn_cvt_pk_f32_fp8(yvk[k], true);
                const float w = yww[k];
                f0 = fmaf(w, lo[0], f0); f1 = fmaf(w, lo[1], f1); f2 = fmaf(w, hi[0], f2); f3 = fmaf(w, hi[1], f3);
            }
            const float4 g2 = *(const float4*)(mod + (size_t)(l * 8 + b) * 6144 + 5120 + col);
            z[i].x = ALPHA * x1.x + (1.f + g2.x) * f0; z[i].y = ALPHA * x1.y + (1.f + g2.y) * f1; z[i].z = ALPHA * x1.z + (1.f + g2.z) * f2; z[i].w = ALPHA * x1.w + (1.f + g2.w) * f3;
            s += z[i].x + z[i].y + z[i].z + z[i].w;
        }
        const float mean = wave_sum(s) * (1.f / 1024.f);
        float q = 0.f;
#pragma unroll
        for (int i = 0; i < 4; ++i) { z[i].x -= mean; z[i].y -= mean; z[i].z -= mean; z[i].w -= mean; q += z[i].x * z[i].x + z[i].y * z[i].y + z[i].z * z[i].z + z[i].w * z[i].w; }
        const float rs = rsqrtf(wave_sum(q) * (1.f / 1024.f) + LN_EPS);
#pragma unroll
        for (int i = 0; i < 4; ++i) {
            const int col = i * 256 + lane * 4;
            const float4 g = *(const float4*)(p->in[I_LN2G] + l * 1024 + col), bb = *(const float4*)(p->in[I_LN2B] + l * 1024 + col);
            float4 x2; x2.x = z[i].x * rs * g.x + bb.x; x2.y = z[i].y * rs * g.y + bb.y; x2.z = z[i].z * rs * g.z + bb.z; x2.w = z[i].w * rs * g.w + bb.w;
            if (l + 1 < DEPTH) { uint2 ox; ox.x = pack2(x2.x, x2.y); ox.y = pack2(x2.z, x2.w); *(uint2*)((bf16_t*)xout + (size_t)row * DM + col) = ox; }
            else *(float4*)(xout + (size_t)row * DM + col) = x2;
            if (l + 1 < DEPTH) {
                const float4 sh = *(const float4*)(mod + (size_t)((l + 1) * 8 + b) * 6144 + col), sc = *(const float4*)(mod + (size_t)((l + 1) * 8 + b) * 6144 + 1024 + col);
                uint2 o; o.x = pack2(x2.x * (1.f + sc.x) + sh.x, x2.y * (1.f + sc.y) + sh.y); o.y = pack2(x2.z * (1.f + sc.z) + sh.z, x2.w * (1.f + sc.w) + sh.w);
                *(uint2*)(ubuf + (size_t)row * DM + col) = o;
            }
        }
    }
}

#define XB_TMO      128
#define XB_XCNT(j)  (256  + 64 * (j))
#define XB_XSUB(j)  (1280 + 64 * (j))
#define XB_XGEN(j)  (2304 + 64 * (j))
#define XB_TOP      3328
#define XB_TOPGEN   3392
#define XCD_BAR_WORDS 3456
#define XB_SPIN_CAP (1u << 20)
DEVINL unsigned xb_ld(unsigned* p)              { return __hip_atomic_load(p, __ATOMIC_RELAXED, __HIP_MEMORY_SCOPE_AGENT); }
DEVINL unsigned xb_add(unsigned* p, unsigned v) { return __hip_atomic_fetch_add(p, v, __ATOMIC_RELAXED, __HIP_MEMORY_SCOPE_AGENT); }
DEVINL unsigned xb_xcc_id() { return (unsigned)__builtin_amdgcn_s_getreg((3 << 11) | 20) & 0xFu; }
#define XB_SPIN(cond, bar) do { unsigned _sp = 0; while (cond) { __builtin_amdgcn_s_sleep(1); \
    if ((++_sp & 255u) == 0u) { if (xb_ld(&(bar)[XB_TMO])) break; if (_sp > XB_SPIN_CAP) { atomicAdd(&(bar)[XB_TMO], 1u); break; } } } } while (0)
struct XcdBarrier { unsigned* bar; unsigned x; volatile LAS unsigned* st; };
DEVINL XcdBarrier xcd_barrier_post(unsigned* bar, volatile LAS unsigned* st) {
    XcdBarrier b; b.bar = bar; b.x = xb_xcc_id(); b.st = st;
    if (threadIdx.x == 0) (void)xb_add(&bar[XB_XCNT(b.x)], 1u);
    return b;
}
DEVINL void xcd_barrier_complete(unsigned* bar, unsigned x, unsigned& nloc, unsigned& nx) {
    const unsigned G = gridDim.x * gridDim.y * gridDim.z;
    unsigned sum, cnt, mine, sp = 0u;
    for (;;) {
        sum = 0u; cnt = 0u; mine = 0u;
#pragma unroll 1
        for (unsigned j = 0; j < 16; ++j) { const unsigned c = xb_ld(&bar[XB_XCNT(j)]); sum += c; cnt += (c > 0u) ? 1u : 0u; mine = (j == x) ? c : mine; }
        if (sum == G) break;
        __builtin_amdgcn_s_sleep(1);
        if ((++sp & 255u) == 0u) { if (xb_ld(&bar[XB_TMO])) break; if (sp > XB_SPIN_CAP) { atomicAdd(&bar[XB_TMO], 1u); break; } }
    }
    nloc = mine > 0u ? mine : 1u; nx = cnt > 0u ? cnt : 1u;
}
DEVINL void xcd_barrier(const XcdBarrier& b) {
    asm volatile("s_waitcnt vmcnt(0)" ::: "memory");
    __syncthreads();
    if (threadIdx.x == 0) {
        unsigned* bar = b.bar;
        __builtin_amdgcn_s_waitcnt(0);
        unsigned nloc = b.st[0], nx = b.st[1];
        if (nloc == 0u) { xcd_barrier_complete(bar, b.x, nloc, nx); b.st[0] = nloc; b.st[1] = nx; }
        const unsigned old = xb_add(&bar[XB_XSUB(b.x)], 1u);
        const unsigned gen = old / nloc;
        if (old + 1u == (gen + 1u) * nloc) {
            __builtin_amdgcn_fence(__ATOMIC_RELEASE, "agent");
            asm volatile("s_waitcnt vmcnt(0)" ::: "memory");
            const unsigned og = xb_add(&bar[XB_TOP], 1u);
            const unsigned tg = og / nx;
            if (og + 1u == (tg + 1u) * nx) xb_add(&bar[XB_TOPGEN], 1u);
            else XB_SPIN(xb_ld(&bar[XB_TOPGEN]) == tg, bar);
            __builtin_amdgcn_fence(__ATOMIC_ACQUIRE, "agent");
            xb_add(&bar[XB_XGEN(b.x)], 1u);
            asm volatile("s_waitcnt vmcnt(0)" ::: "memory");
        } else {
            XB_SPIN(xb_ld(&bar[XB_XGEN(b.x)]) == gen, bar);
            __builtin_amdgcn_fence(__ATOMIC_ACQUIRE, "agent");
            asm volatile("s_waitcnt vmcnt(0)" ::: "memory");
        }
    }
    __syncthreads();
}

constexpr int PPL = 12;
constexpr int NPHASE = 2 + PPL * DEPTH;
#ifndef PROBE_SUB
#define PROBE_SUB 3
#endif
#ifndef PROBE_REP
#define PROBE_REP (-1)
#endif
__global__ void __launch_bounds__(NTHREADS, 2) mega(Params p_arg, int ph_lo, int ph_hi) {
    extern __shared__ __attribute__((aligned(16))) char lds[];
    cg::grid_group grid = cg::this_grid();
    volatile LAS unsigned* st = (volatile LAS unsigned*)(lds + LDS_BYTES - 16);
    if (threadIdx.x == 0) { st[0] = 0u; st[1] = 0u; }
    __syncthreads();
    XcdBarrier xb = xcd_barrier_post((unsigned*)(p_arg.ws + OFF_BAR), st);
    for (int ph = ph_lo; ph < ph_hi; ++ph) {
        KP p = (KP)__builtin_amdgcn_kernarg_segment_ptr();
        asm volatile("" : "+s"(p));
        const int l = (ph >= 2) ? (ph - 2) / PPL : 0;
        const int q = (ph >= 2) ? (ph - 2) % PPL : -1;
        const bool nobar = (q >= 1 && q <= 3);
        const int nrep = (PROBE_REP >= 0 && ph == PROBE_REP) ? 2 : 1;
        for (int rep = 0; rep < nrep; ++rep) {
            const int dry = (PROBE_REP >= 0 && ph == PROBE_REP && rep == 0) ? 1 : 0;
            char* ldsh = lds + (threadIdx.x >> 8) * LDS_HALF;
            if (ph == 0) phase0(p, ldsh);
            else if (ph == 1) phaseF0(p);
            else {
                switch (q) {
                    case 0: phaseA(p, l, lds); break;
                    case 1: phaseB1(p, l, ldsh, 1, (PROBE_REP >= 0 && ph == PROBE_REP && rep == 1) ? PROBE_SUB : 3); break;
                    case 2: phaseB1(p, l, ldsh, 2); break;
                    case 3: phaseB1(p, l, ldsh, 4); break;
                    case 4: phaseB1(p, l, ldsh, 8); break;
                    case 5: phaseB2(p, l, ldsh); break;
                    case 6: phaseB3(p, l); break;
                    case 7: phaseC(p, l, lds); break;
                    case 8: phaseD(p, l, ldsh, dry); break;
                    case 9: phaseE1(p, l, lds); break;
                    case 10: phaseE2(p, l, lds); break;
                    default: phaseF(p, l, dry); break;
                }
            }
            const bool lastrep = (rep + 1 == nrep);
            if (!lastrep || (ph + 1 < ph_hi && !nobar)) { if (lastrep && ph == ph_lo) grid.sync(); else xcd_barrier(xb); }
        }
    }
}

extern "C" void kernel_launch(void* const* d_in, const int* in_sizes, int n_in, void* d_out, int out_size, void* d_ws, size_t ws_size, hipStream_t stream) {
    static int grid_blocks = 0;
    if (grid_blocks == 0) {
        if (n_in != 39 || out_size != NTOK * DM || ws_size < WS_NEED) { fprintf(stderr, "kernel_launch: unexpected shapes (n_in %d out %d ws %zu need %zu)\n", n_in, out_size, ws_size, (size_t)WS_NEED); grid_blocks = -1; return; }
        int dev = 0, cus = 0, per_cu = 0;
        hipGetDevice(&dev);
        hipDeviceGetAttribute(&cus, hipDeviceAttributeMultiprocessorCount, dev);
        hipFuncSetAttribute((const void*)mega, hipFuncAttributeMaxDynamicSharedMemorySize, LDS_BYTES);
        hipOccupancyMaxActiveBlocksPerMultiprocessor(&per_cu, (const void*)mega, NTHREADS, LDS_BYTES);
        if (per_cu < 1) { fprintf(stderr, "kernel_launch: occupancy query returned %d\n", per_cu); grid_blocks = -1; return; }
        if (cus < 256) { fprintf(stderr, "kernel_launch: this build needs 256 CUs (found %d)\n", cus); grid_blocks = -1; return; }
        grid_blocks = 256;
    }
    if (grid_blocks < 0) return;
    if (hipMemsetAsync(d_ws, 0, 32768, stream) != hipSuccess) { fprintf(stderr, "kernel_launch: memset failed\n"); return; }
    Params p{};
    for (int i = 0; i < 39; ++i) p.in[i] = (const float*)d_in[i];
    p.out = (float*)d_out; p.ws = (unsigned char*)d_ws;
    int ph_lo = 0, ph_hi = NPHASE;
    void* args[] = {&p, &ph_lo, &ph_hi};
    hipError_t e = hipLaunchCooperativeKernel((const void*)mega, dim3(grid_blocks), dim3(NTHREADS), args, LDS_BYTES, stream);
    if (e != hipSuccess) fprintf(stderr, "cooperative launch failed: %s (grid %d)\n", hipGetErrorString(e), grid_blocks);
}
```

```cpp
#include <hip/hip_runtime.h>
#include <hip/hip_cooperative_groups.h>
#include <stdio.h>
#include <stdint.h>
namespace cg = cooperative_groups;

typedef unsigned short bf16_t;
typedef short bf16x8 __attribute__((ext_vector_type(8)));
typedef float f32x4 __attribute__((ext_vector_type(4)));
#define DEVINL __device__ __forceinline__
#define LAS __attribute__((address_space(3)))

constexpr int NTOK = 32768, SEQ = 4096, NBATCH = 8, DM = 1024, PIN = 2688, DEPTH = 2;
constexpr int NEXP = 64;
constexpr float ALPHA = 1.41421356237f;
constexpr float LN_EPS = 1e-5f, GN_EPS = 64e-5f;
constexpr int NTHREADS = 512;
constexpr int VTHREADS = 256;
constexpr int LDS_HALF = 75776;
constexpr int LDS_BYTES = 152064;

constexpr size_t OFF_CNT   = 0;
constexpr size_t OFF_BAR   = 4096;
constexpr size_t OFF_MOD   = 65536;
constexpr size_t OFF_WR    = 524288;
constexpr size_t OFF_WIN   = 1048576;
constexpr int WIN_ROWS = 2816;
constexpr size_t OFF_WOUT  = OFF_WIN + 2 * (size_t)WIN_ROWS * 1024 * 2;
constexpr size_t OFF_W13   = OFF_WOUT + 4194304;
constexpr size_t OFF_W2    = OFF_W13 + 136314880;
constexpr size_t OFF_UBUF  = OFF_W2 + 68157440;
constexpr size_t OFF_ARENA = OFF_UBUF + 67108864;
constexpr size_t A_P      = OFF_ARENA;
constexpr size_t A_YMIX   = A_P + 176160768;
constexpr size_t A_SCAN   = A_YMIX + 67108864;
constexpr size_t A_HLOC   = A_SCAN + 134217728;
constexpr size_t A_CUMA   = A_HLOC + 33554432;
constexpr size_t A_G      = A_CUMA + 33554432;
constexpr size_t A_BONUS  = A_G + 33554432;
constexpr size_t A_YRAW   = A_BONUS + 33554432;
constexpr size_t A_CARRYA = A_YRAW + 33554432;
constexpr size_t A_CARRYH = A_CARRYA + 1048576;
constexpr size_t A_HSTART = A_CARRYH + 1048576;
constexpr size_t A_CHAIN  = A_HSTART + 1048576;
constexpr size_t CHAIN_UNIT = 49152;
constexpr size_t M_YBUF   = OFF_ARENA;
constexpr size_t M_ZB     = OFF_ARENA + 335544320;
constexpr size_t M_HBUF   = M_YBUF + 603979776;
constexpr size_t M_LIST   = M_HBUF + 159383552;
constexpr size_t M_WSEL   = M_LIST + 8388608;
constexpr size_t M_PMAP   = M_WSEL + 1048576;
constexpr size_t M_STAT   = M_PMAP + 1048576;
constexpr size_t WS_NEED  = M_STAT + 262144;

struct Params {
    const float* in[39];
    float* out;
    unsigned char* ws;
};
typedef const __attribute__((address_space(4))) Params* KP;
__device__ __forceinline__ int TIDX() { int t = threadIdx.x; asm volatile("" : "+v"(t)); t &= 255; return t; }
__device__ __forceinline__ int BIDX() { int b = blockIdx.x * 2 + __builtin_amdgcn_readfirstlane((int)(threadIdx.x >> 8)); asm volatile("" : "+s"(b)); __builtin_assume(b >= 0 && b < 65536); return b; }
__device__ __forceinline__ int NBV() { return gridDim.x * 2; }
__device__ __forceinline__ int TID512() { int t = threadIdx.x; asm volatile("" : "+v"(t)); __builtin_assume(t >= 0 && t < 512); return t; }
enum { I_X = 0, I_C, I_WMOD, I_BMOD, I_WIN, I_WOUT, I_CONVA, I_CONVAB, I_LNAG, I_LNAB, I_CONVB, I_CONVBB, I_WRG, I_BRG, I_WIG, I_BIG,
       I_LAMBDA, I_MUC, I_W0, I_WW2, I_A0, I_WA2, I_WG2, I_KK, I_KA, I_RK, I_GNG, I_GNB, I_CONVD, I_LN1G, I_LN1B, I_WROUTER, I_EBIAS,
       I_W13, I_W2, I_WS13, I_WS2, I_LN2G, I_LN2B };

DEVINL bf16_t f2bf(float f) { unsigned u = __float_as_uint(f); u += 0x7FFFu + ((u >> 16) & 1u); return (bf16_t)(u >> 16); }
DEVINL float bf2f(bf16_t h) { return __uint_as_float(((unsigned)h) << 16); }
typedef __bf16 bf2_t __attribute__((ext_vector_type(2)));
typedef float f2_t __attribute__((ext_vector_type(2)));
typedef float f32x16 __attribute__((ext_vector_type(16)));
DEVINL unsigned pack2(float a, float b) { f2_t v = {a, b}; return __builtin_bit_cast(unsigned, __builtin_convertvector(v, bf2_t)); }
DEVINL float sigm(float x) { return 1.f / (1.f + __expf(-x)); }
DEVINL float tanh_fast(float x) { const float e = __expf(2.f * x); return 1.f - 2.f / (1.f + e); }
DEVINL float softplusf(float z) { return fmaxf(z, 0.f) + __logf(1.f + __expf(-fabsf(z))); }
DEVINL float softplus_acc(float z) { return fmaxf(z, 0.f) + log1pf(__expf(-fabsf(z))); }
DEVINL float gelu_tanh(float x) { float u = 0.7978845608028654f * (x + 0.044715f * x * x * x); return 0.5f * x * (1.f + tanh_fast(u)); }
DEVINL float group8_max(float x) {
    x = fmaxf(x, __builtin_bit_cast(float, __builtin_amdgcn_update_dpp(0, __builtin_bit_cast(int, x), 0xB1, 0xf, 0xf, true)));
    x = fmaxf(x, __builtin_bit_cast(float, __builtin_amdgcn_update_dpp(0, __builtin_bit_cast(int, x), 0x4E, 0xf, 0xf, true)));
    x = fmaxf(x, __builtin_bit_cast(float, __builtin_amdgcn_update_dpp(0, __builtin_bit_cast(int, x), 0x141, 0xf, 0xf, true)));
    return x;
}
DEVINL float wave_sum_dpp(float x);
DEVINL float wave_sum(float x) { return wave_sum_dpp(x); }
DEVINL float wave_sum_dpp(float x) {
    x += __builtin_bit_cast(float, __builtin_amdgcn_update_dpp(0, __builtin_bit_cast(int, x), 0xB1, 0xf, 0xf, true));
    x += __builtin_bit_cast(float, __builtin_amdgcn_update_dpp(0, __builtin_bit_cast(int, x), 0x4E, 0xf, 0xf, true));
    x += __builtin_bit_cast(float, __builtin_amdgcn_update_dpp(0, __builtin_bit_cast(int, x), 0x141, 0xf, 0xf, true));
    x += __builtin_bit_cast(float, __builtin_amdgcn_update_dpp(0, __builtin_bit_cast(int, x), 0x140, 0xf, 0xf, true));
    x += __builtin_bit_cast(float, __builtin_amdgcn_update_dpp(0, __builtin_bit_cast(int, x), 0x142, 0xa, 0xf, false));
    x += __builtin_bit_cast(float, __builtin_amdgcn_update_dpp(0, __builtin_bit_cast(int, x), 0x143, 0xc, 0xf, false));
    return __builtin_bit_cast(float, __builtin_amdgcn_readlane(__builtin_bit_cast(int, x), 63));
}

DEVINL int lds_byte(int r, int c) { int st = (r >> 4) * 2 + (c >> 5), rr = r & 15, cc = c & 31, ob = rr * 64 + cc * 2; return st * 1024 + (ob ^ (((ob >> 9) & 1) << 5)); }
DEVINL void stage_rc(int b, int& R, int& C) { int st = b / 1024, sb = b % 1024, swz = sb ^ (((sb >> 9) & 1) << 5); R = (st >> 1) * 16 + swz / 64; C = (st & 1) * 32 + (swz % 64) / 2; }

template <class RowPtr, class Epi>
DEVINL void gemm_tile128(char* lds, RowPtr arow, const bf16_t* Bt, int K, Epi epi) {
    const int tid = TIDX();
    const bf16_t* ap[4]; const bf16_t* bp[4];
#pragma unroll
    for (int i = 0; i < 4; ++i) { int R, C; stage_rc(tid * 16 + i * 4096, R, C); ap[i] = arow(R) + C; bp[i] = Bt + (size_t)R * K + C; }
    const int wid = tid >> 6, lane = tid & 63, wr = wid >> 1, wc = wid & 1, fr = lane & 15, fq = lane >> 4;
    f32x4 acc[4][4];
#pragma unroll
    for (int m = 0; m < 4; ++m)
#pragma unroll
        for (int n = 0; n < 4; ++n) acc[m][n] = (f32x4){0.f, 0.f, 0.f, 0.f};
    const int nk = K >> 6;
#pragma unroll
    for (int i = 0; i < 4; ++i) {
        __builtin_amdgcn_global_load_lds((const unsigned*)(ap[i]), (unsigned*)(lds + tid * 16 + i * 4096), 16, 0, 0);
        __builtin_amdgcn_global_load_lds((const unsigned*)(bp[i]), (unsigned*)(lds + 16384 + tid * 16 + i * 4096), 16, 0, 0);
    }
    for (int kt = 0; kt < nk; ++kt) {
        asm volatile("s_waitcnt vmcnt(0)" ::: "memory");
        __syncthreads();
        char* cur = lds + (kt & 1) * 32768;
        if (kt + 1 < nk) {
            char* nxt = lds + ((kt + 1) & 1) * 32768;
            const int ko = (kt + 1) * 64;
#pragma unroll
            for (int i = 0; i < 4; ++i) {
                __builtin_amdgcn_global_load_lds((const unsigned*)(ap[i] + ko), (unsigned*)(nxt + tid * 16 + i * 4096), 16, 0, 0);
                __builtin_amdgcn_global_load_lds((const unsigned*)(bp[i] + ko), (unsigned*)(nxt + 16384 + tid * 16 + i * 4096), 16, 0, 0);
            }
        }
        bf16x8 af[4][2], bfr[4][2];
#pragma unroll
        for (int m = 0; m < 4; ++m)
#pragma unroll
            for (int kk = 0; kk < 2; ++kk) af[m][kk] = *reinterpret_cast<const bf16x8*>(cur + lds_byte(wr * 64 + m * 16 + fr, kk * 32 + fq * 8));
#pragma unroll
        for (int n = 0; n < 4; ++n)
#pragma unroll
            for (int kk = 0; kk < 2; ++kk) bfr[n][kk] = *reinterpret_cast<const bf16x8*>(cur + 16384 + lds_byte(wc * 64 + n * 16 + fr, kk * 32 + fq * 8));
#pragma unroll
        for (int kk = 0; kk < 2; ++kk)
#pragma unroll
            for (int m = 0; m < 4; ++m)
#pragma unroll
                for (int n = 0; n < 4; ++n) acc[m][n] = __builtin_amdgcn_mfma_f32_16x16x32_bf16(bfr[n][kk], af[m][kk], acc[m][n], 0, 0, 0);
    }
    __syncthreads();
    epi(acc, wr, wc, fr, fq);
}

template <class Ptrs, class Epi>
DEVINL void gemm_stream128(char* lds, int K, int blk, int nb, int total, Ptrs ptrs, Epi epi) {
    const int qx = nb >> 3, first = (blk & 7) * qx + (blk >> 3), stride = nb;
    if (first >= total) return;
    const int tid = TIDX();
    const int wid = tid >> 6, lane = tid & 63, wr = wid >> 1, wc = wid & 1, fr = lane & 15, fq = lane >> 4;
    const int nk = K >> 6;
    const bf16_t* ap[4]; const bf16_t* bp[4];
    const bf16_t* an[4]; const bf16_t* bn[4];
    int t = first;
    ptrs(t, ap, bp);
#pragma unroll
    for (int i = 0; i < 4; ++i) {
        __builtin_amdgcn_global_load_lds((const unsigned*)(ap[i]), (unsigned*)(lds + tid * 16 + i * 4096), 16, 0, 0);
        __builtin_amdgcn_global_load_lds((const unsigned*)(bp[i]), (unsigned*)(lds + 16384 + tid * 16 + i * 4096), 16, 0, 0);
    }
    for (;;) {
        const int tn = t + stride;
        const bool has_next = tn < total;
        if (has_next) ptrs(tn, an, bn);
        f32x4 acc[4][4];
#pragma unroll
        for (int m = 0; m < 4; ++m)
#pragma unroll
            for (int n = 0; n < 4; ++n) acc[m][n] = (f32x4){0.f, 0.f, 0.f, 0.f};
        for (int kt = 0; kt < nk; ++kt) {
            asm volatile("s_waitcnt vmcnt(0)" ::: "memory");
            __syncthreads();
            char* cur = lds + (kt & 1) * 32768;
            if (kt + 1 < nk) {
                char* nxt = lds + ((kt + 1) & 1) * 32768;
                const int ko = (kt + 1) * 64;
#pragma unroll
                for (int i = 0; i < 4; ++i) {
                    __builtin_amdgcn_global_load_lds((const unsigned*)(ap[i] + ko), (unsigned*)(nxt + tid * 16 + i * 4096), 16, 0, 0);
                    __builtin_amdgcn_global_load_lds((const unsigned*)(bp[i] + ko), (unsigned*)(nxt + 16384 + tid * 16 + i * 4096), 16, 0, 0);
                }
            } else if (has_next) {
#pragma unroll
                for (int i = 0; i < 4; ++i) {
                    __builtin_amdgcn_global_load_lds((const unsigned*)(an[i]), (unsigned*)(lds + tid * 16 + i * 4096), 16, 0, 0);
                    __builtin_amdgcn_global_load_lds((const unsigned*)(bn[i]), (unsigned*)(lds + 16384 + tid * 16 + i * 4096), 16, 0, 0);
                }
            }
            bf16x8 af[4][2], bfr[4][2];
#pragma unroll
            for (int m = 0; m < 4; ++m)
#pragma unroll
                for (int kk = 0; kk < 2; ++kk) af[m][kk] = *reinterpret_cast<const bf16x8*>(cur + lds_byte(wr * 64 + m * 16 + fr, kk * 32 + fq * 8));
#pragma unroll
            for (int n = 0; n < 4; ++n)
#pragma unroll
                for (int kk = 0; kk < 2; ++kk) bfr[n][kk] = *reinterpret_cast<const bf16x8*>(cur + 16384 + lds_byte(wc * 64 + n * 16 + fr, kk * 32 + fq * 8));
#pragma unroll
            for (int kk = 0; kk < 2; ++kk)
#pragma unroll
                for (int m = 0; m < 4; ++m)
#pragma unroll
                    for (int n = 0; n < 4; ++n) acc[m][n] = __builtin_amdgcn_mfma_f32_16x16x32_bf16(bfr[n][kk], af[m][kk], acc[m][n], 0, 0, 0);
        }
        epi(t, acc, wr, wc, fr, fq);
        if (!has_next) break;
        t = tn;
#pragma unroll
        for (int i = 0; i < 4; ++i) { ap[i] = an[i]; bp[i] = bn[i]; }
    }
    __syncthreads();
}
DEVINL void stage_coords(int (&R)[4], int (&C)[4]) {
    const int tid = TIDX();
#pragma unroll
    for (int i = 0; i < 4; ++i) stage_rc(tid * 16 + i * 4096, R[i], C[i]);
}

struct GUnit {
    const char* A;
    const char* B;
    unsigned va[2][2] = {{0u, 0u}, {0u, 0u}};
    int i0, i1, i2;
};
constexpr int G_HTB = 128 * 64 * 2;
constexpr int G_STAGE_BYTES = 8 * G_HTB;
DEVINL int perm32(int rho) { const int n = rho >> 4, i = rho & 15; return 8 * (i >> 2) + 4 * n + (i & 3); }
DEVINL void stage_coords512(int tid, int (&R)[2], int (&C)[2]) {
#pragma unroll
    for (int i = 0; i < 2; ++i) stage_rc(tid * 16 + i * 8192, R[i], C[i]);
}

template <bool PERM, bool GATHER, class Sched, class Epi>
DEVINL void gemm256(char* lds_generic, int K, int lda, Sched sched, Epi epi) {
    LAS unsigned char* lds = (LAS unsigned char*)lds_generic;
    const int tid = TID512(), wid = __builtin_amdgcn_readfirstlane(tid >> 6), lane = tid & 63, wr = wid >> 2, wc = wid & 3, fr = lane & 15, fq = lane >> 4;
    const int nt = K / 64;
    unsigned voffB[2];
#pragma unroll
    for (int i = 0; i < 2; ++i) { int R, C; stage_rc(tid * 16 + i * 8192, R, C); const int Rb = PERM ? ((R & ~31) + perm32(R & 31)) : R; voffB[i] = (unsigned)(Rb * K + C) * 2u; }
    unsigned voffA[2];
#pragma unroll
    for (int i = 0; i < 2; ++i) { int R, C; stage_rc(tid * 16 + i * 8192, R, C); voffA[i] = (unsigned)(R * lda + C) * 2u; }
    const size_t hstepA = GATHER ? 0 : (size_t)128 * lda * 2;
    const size_t kstep = (size_t)(64 * 2);
    const size_t hstepB = (size_t)128 * K * 2;
    const unsigned ldsw = (unsigned)wid * 1024u;
    const int aoff = lds_byte(wr * 64 + fr, fq * 8), boff = lds_byte(wc * 32 + fr, fq * 8);
#define G_SA(b, h) (((b) * 2 + (h)) * G_HTB)
#define G_SB(b, h) ((4 + (b) * 2 + (h)) * G_HTB)
#define G_STAGE(bufoff, gbase, voff) do { _Pragma("unroll") for (int _i = 0; _i < 2; ++_i) { unsigned _vo = (voff)[_i]; asm volatile("" : "+v"(_vo)); \
        __builtin_amdgcn_global_load_lds((const unsigned*)((const char*)(gbase) + _vo), (LAS unsigned*)(lds + (bufoff) + ldsw + _i * 8192), 16, 0, 0); } } while (0)
#define G_STAGE_A(bufoff, ptr, vg, h) do { if constexpr (GATHER) { G_STAGE(bufoff, ptr, vg); } else { G_STAGE(bufoff, (ptr) + (h) * hstepA, voffA); } } while (0)
#define G_LDA(dst, b, h) do { _Pragma("unroll") for (int m = 0; m < 4; ++m) _Pragma("unroll") for (int k = 0; k < 2; ++k) dst[m][k] = *(const LAS bf16x8*)(lds + G_SA(b, h) + aoff + m * 2048 + k * 1024); } while (0)
#define G_LDB(dst, b, h) do { _Pragma("unroll") for (int n = 0; n < 2; ++n) _Pragma("unroll") for (int k = 0; k < 2; ++k) dst[n][k] = *(const LAS bf16x8*)(lds + G_SB(b, h) + boff + n * 2048 + k * 1024); } while (0)
#define G_MMA(ai, bj, At, Bt) do { __builtin_amdgcn_s_setprio(1); _Pragma("unroll") for (int m = 0; m < 4; ++m) _Pragma("unroll") for (int n = 0; n < 2; ++n) _Pragma("unroll") for (int k = 0; k < 2; ++k) \
        acc[ai][bj][m][n] = __builtin_amdgcn_mfma_f32_16x16x32_bf16(Bt[n][k], At[m][k], acc[ai][bj][m][n], 0, 0, 0); __builtin_amdgcn_s_setprio(0); } while (0)
#define G_WAIT_V(n) asm volatile("s_waitcnt vmcnt(" #n ")" ::: "memory")
#define G_WAIT_L(n) asm volatile("s_waitcnt lgkmcnt(" #n ")" ::: "memory")
#define G_BAR __builtin_amdgcn_s_barrier()
#define G_SCHED __builtin_amdgcn_sched_barrier(0)
    GUnit cur, nxt; int ui = 0;
    if (!sched(0, cur)) return;
    f32x4 acc[2][2][4][2];
#pragma unroll
    for (int a = 0; a < 2; ++a)
#pragma unroll
        for (int b = 0; b < 2; ++b)
#pragma unroll
            for (int m = 0; m < 4; ++m)
#pragma unroll
                for (int n = 0; n < 2; ++n) acc[a][b][m][n] = (f32x4){0.f, 0.f, 0.f, 0.f};
    bf16x8 At[4][2], B0[2][2], B1[2][2];
    G_STAGE(G_SB(0, 0), cur.B, voffB); G_STAGE_A(G_SA(0, 0), cur.A, cur.va[0], 0); G_STAGE(G_SB(0, 1), cur.B + hstepB, voffB); G_STAGE_A(G_SA(0, 1), cur.A, cur.va[1], 1);
    if (wr == 1) G_BAR;
    G_WAIT_V(4); G_BAR;
    G_STAGE(G_SB(1, 0), cur.B + kstep, voffB); G_STAGE_A(G_SA(1, 0), cur.A + kstep, cur.va[0], 0); G_STAGE(G_SB(1, 1), cur.B + hstepB + kstep, voffB);
    G_WAIT_V(6); G_BAR;
    for (;;) {
        const bool has_next = sched(ui + 1, nxt);
        if (!has_next) nxt = cur;
        for (int t = 0; t < nt; t += 2) {
            const bool last = (t == nt - 2);
            const char* a1 = cur.A + (size_t)(t + 1) * kstep;
            const char* a2 = last ? nxt.A : cur.A + (size_t)(t + 2) * kstep; const char* b2 = last ? nxt.B : cur.B + (size_t)(t + 2) * kstep;
            const char* a3 = a2 + kstep; const char* b3 = b2 + kstep;
            G_LDB(B0, 0, 0); G_SCHED; G_LDA(At, 0, 0); G_STAGE_A(G_SA(1, 1), a1, cur.va[1], 1);
            G_WAIT_L(8); G_BAR; G_WAIT_L(0); G_MMA(0, 0, At, B0); G_BAR; G_SCHED;
            G_LDB(B1, 0, 1); G_STAGE(G_SB(0, 0), b2, voffB);
            G_BAR; G_WAIT_L(0); G_MMA(0, 1, At, B1); G_BAR;
            G_LDA(At, 0, 1); if (last) { G_STAGE_A(G_SA(0, 0), a2, nxt.va[0], 0); } else { G_STAGE_A(G_SA(0, 0), a2, cur.va[0], 0); }
            G_BAR; G_WAIT_L(0); G_MMA(1, 0, At, B0); G_BAR; G_SCHED;
            G_STAGE(G_SB(0, 1), b2 + hstepB, voffB);
            G_WAIT_V(6); G_BAR; G_MMA(1, 1, At, B1); G_BAR;
            G_LDB(B0, 1, 0); G_SCHED; G_LDA(At, 1, 0); if (last) { G_STAGE_A(G_SA(0, 1), a2, nxt.va[1], 1); } else { G_STAGE_A(G_SA(0, 1), a2, cur.va[1], 1); }
            G_WAIT_L(8); G_BAR; G_WAIT_L(0); G_MMA(0, 0, At, B0); G_BAR; G_SCHED;
            G_LDB(B1, 1, 1); G_STAGE(G_SB(1, 0), b3, voffB);
            G_BAR; G_WAIT_L(0); G_MMA(0, 1, At, B1); G_BAR;
            G_LDA(At, 1, 1); if (last) { G_STAGE_A(G_SA(1, 0), a3, nxt.va[0], 0); } else { G_STAGE_A(G_SA(1, 0), a3, cur.va[0], 0); }
            G_BAR; G_WAIT_L(0); G_MMA(1, 0, At, B0); G_BAR; G_SCHED;
            G_STAGE(G_SB(1, 1), b3 + hstepB, voffB);
            G_WAIT_V(6); G_BAR; G_MMA(1, 1, At, B1); G_BAR;
        }
        { const int l2 = TID512() & 63; epi(acc, cur, wr, wc, l2 & 15, l2 >> 4); }
        if (!has_next) break;
#pragma unroll
        for (int a = 0; a < 2; ++a)
#pragma unroll
            for (int b = 0; b < 2; ++b)
#pragma unroll
                for (int m = 0; m < 4; ++m)
#pragma unroll
                    for (int n = 0; n < 2; ++n) acc[a][b][m][n] = (f32x4){0.f, 0.f, 0.f, 0.f};
        cur = nxt; ++ui;
    }
    G_WAIT_V(0);
    if (wr == 0) G_BAR;
    G_BAR;
#undef G_SA
#undef G_STAGE_A
#undef G_SB
#undef G_STAGE
#undef G_LDA
#undef G_LDB
#undef G_MMA
#undef G_WAIT_V
#undef G_WAIT_L
#undef G_BAR
#undef G_SCHED
}
DEVINL long unit_linear(int i, int c, int G) { const int q = G >> 3; return ((long)i * 8 + (c & 7)) * q + (c >> 3); }

constexpr int CONV_PER_L = 672 + 256 + 8320 + 4160;
struct ConvJob { const float* src; bf16_t* dst; int K, ld, k0, r0, perm; };
DEVINL ConvJob conv_decode(KP p, int id) {
    ConvJob j; const int l = id / CONV_PER_L; int r = id % CONV_PER_L; int kt, nt;
    if (r < 672) { j.src = p->in[I_WIN] + (size_t)l * 1024 * 2688; j.K = 1024; j.ld = 2688; j.perm = 0; j.dst = (bf16_t*)(p->ws + OFF_WIN) + (size_t)l * WIN_ROWS * 1024; nt = r % 42; kt = r / 42; }
    else if (r < 928) { r -= 672; j.src = p->in[I_WOUT] + (size_t)l * 1024 * 1024; j.K = 1024; j.ld = 1024; j.perm = 0; j.dst = (bf16_t*)(p->ws + OFF_WOUT) + (size_t)l * 1024 * 1024; nt = r & 15; kt = r >> 4; }
    else if (r < 928 + 8320) { r -= 928; const int e = r >> 7, q = r & 127; nt = q & 7; kt = q >> 3; j.K = 1024; j.ld = 512; j.perm = 1;
        j.src = (e < 64) ? p->in[I_W13] + (size_t)(l * 64 + e) * 1024 * 512 : p->in[I_WS13] + (size_t)l * 1024 * 512;
        j.dst = (bf16_t*)(p->ws + OFF_W13) + (size_t)(l * 65 + e) * 512 * 1024; }
    else { r -= 9248; const int e = r >> 6, q = r & 63; nt = q & 15; kt = q >> 4; j.K = 256; j.ld = 1024; j.perm = 0;
        j.src = (e < 64) ? p->in[I_W2] + (size_t)(l * 64 + e) * 256 * 1024 : p->in[I_WS2] + (size_t)l * 256 * 1024;
        j.dst = (bf16_t*)(p->ws + OFF_W2) + (size_t)(l * 65 + e) * 1024 * 256; }
    j.k0 = kt * 64; j.r0 = nt * 64; return j;
}
DEVINL void conv_issue(const ConvJob& j, char* buf, int tid) {
    const int nn = tid & 63, drow = j.r0 + nn;
    int scol = drow;
    if (j.perm) { const int g = drow >> 5, i = drow & 31; scol = (i < 16) ? (g * 16 + i) : (256 + g * 16 + (i - 16)); }
    const float* sp = j.src + (size_t)j.k0 * j.ld + scol;
#pragma unroll
    for (int q = 0; q < 16; ++q) { const int kk = (tid >> 6) + 4 * q;
        __builtin_amdgcn_global_load_lds((const unsigned*)(sp + (size_t)kk * j.ld), (unsigned*)(buf + kk * 260 + nn * 4), 4, 0, 0); }
}
DEVINL void convert_ids(KP p, char* lds, int id_lo, int id_hi, int wb, int nwb) {
    const int tid = TIDX();
    const int n = (id_hi - id_lo + nwb - 1) / nwb;
    auto idof = [&](int i) { const int id = id_lo + i * nwb + wb; return (id < id_hi) ? id : id_hi - 1; };
    ConvJob j0 = conv_decode(p, idof(0)), j1 = conv_decode(p, idof(n > 1 ? 1 : 0));
    conv_issue(j0, lds, tid);
    conv_issue(j1, lds + 16640, tid);
    bf16_t* d0 = j0.dst + (size_t)j0.r0 * j0.K + j0.k0; int K0 = j0.K;
    bf16_t* d1 = j1.dst + (size_t)j1.r0 * j1.K + j1.k0; int K1 = j1.K;
    for (int i = 0; i < n; ++i) {
        const ConvJob j2 = conv_decode(p, idof(i + 2 < n ? i + 2 : n - 1));
        conv_issue(j2, lds + ((i + 2) % 3) * 16640, tid);
        asm volatile("s_waitcnt vmcnt(32)" ::: "memory");
        __builtin_amdgcn_s_barrier();
        const float* tile = (const float*)(lds + (i % 3) * 16640);
        {
            const int kp = (tid & 31) * 2;
#pragma unroll
            for (int q = 0; q < 8; ++q) { const int rr = (tid >> 5) + 8 * q;
                *(unsigned*)(d0 + (size_t)rr * K0 + kp) = pack2(tile[kp * 65 + rr], tile[(kp + 1) * 65 + rr]); }
        }
        asm volatile("s_waitcnt lgkmcnt(0)" ::: "memory");
        __builtin_amdgcn_s_barrier();
        d0 = d1; K0 = K1; d1 = j2.dst + (size_t)j2.r0 * j2.K + j2.k0; K1 = j2.K;
    }
    asm volatile("s_waitcnt vmcnt(0)" ::: "memory");
    __syncthreads();
}

DEVINL void phase0(KP p, char* lds) {
    const int tid = TIDX(), nb = NBV(), blk = BIDX();
    if (blk == 0 && tid < 128) ((unsigned*)(p->ws + OFF_CNT))[tid] = 0u;
    if (blk < 192) {
        float* sc = (float*)lds;
        float* part = (float*)(lds + 32768);
        for (int i = tid; i < 8192; i += VTHREADS) { float c = p->in[I_C][i]; sc[i] = c * sigm(c); }
        __syncthreads();
        const int cl = tid & 63, ks = tid >> 6, n = blk * 64 + cl, l = n / 6144, nn = n % 6144;
        const float* w = p->in[I_WMOD] + (size_t)l * 1024 * 6144 + (size_t)(ks * 256) * 6144 + nn;
        float acc[8];
#pragma unroll
        for (int b = 0; b < 8; ++b) acc[b] = 0.f;
#pragma unroll 32
        for (int k = 0; k < 256; ++k) {
            const float wv = w[(size_t)k * 6144];
#pragma unroll
            for (int b = 0; b < 8; ++b) acc[b] = fmaf(sc[b * 1024 + ks * 256 + k], wv, acc[b]);
        }
#pragma unroll
        for (int b = 0; b < 8; ++b) part[(ks * 8 + b) * 64 + cl] = acc[b];
        __syncthreads();
        if (tid < 64) {
            const float bm = p->in[I_BMOD][l * 6144 + nn];
            float* mod = (float*)(p->ws + OFF_MOD);
#pragma unroll
            for (int b = 0; b < 8; ++b) mod[(size_t)(l * 8 + b) * 6144 + nn] = part[(0 * 8 + b) * 64 + cl] + part[(1 * 8 + b) * 64 + cl] + part[(2 * 8 + b) * 64 + cl] + part[(3 * 8 + b) * 64 + cl] + bm;
        }
        __syncthreads();
    }
    if (blk >= 192 && blk < 256) {
        bf16_t* wrt = (bf16_t*)(p->ws + OFF_WR);
#pragma unroll
        for (int j = 0; j < 8; ++j) {
            const int idx = (blk - 192) * 2048 + j * 256 + tid, l2 = idx >> 16, rem = idx & 65535, k = rem >> 6, e = rem & 63;
            const float w = p->in[I_WROUTER][idx];
            const bf16_t hi = f2bf(w); const bf16_t lo = f2bf(w - bf2f(hi));
            wrt[(size_t)((l2 * 2 + 0) * 64 + e) * 1024 + k] = hi; wrt[(size_t)((l2 * 2 + 1) * 64 + e) * 1024 + k] = lo;
        }
    }
    convert_ids(p, lds, 0, 2 * CONV_PER_L, blk, nb);
}

DEVINL void phaseF0(KP p) {
    const int tid = TIDX(), nb = NBV(), blk = BIDX();
    const float* mod = (const float*)(p->ws + OFF_MOD);
    bf16_t* ubuf = (bf16_t*)(p->ws + OFF_UBUF);
    const int col = tid * 4;
    for (int row0 = blk * 8; row0 < NTOK; row0 += nb * 8) {
        float4 x[8];
#pragma unroll
        for (int u = 0; u < 8; ++u) x[u] = *(const float4*)(p->in[I_X] + (size_t)(row0 + u) * DM + col);
        const int b = row0 >> 12;
        const float4 sh = *(const float4*)(mod + (size_t)b * 6144 + col);
        const float4 sc = *(const float4*)(mod + (size_t)b * 6144 + 1024 + col);
#pragma unroll
        for (int u = 0; u < 8; ++u) {
            uint2 o; o.x = pack2(x[u].x * (1.f + sc.x) + sh.x, x[u].y * (1.f + sc.y) + sh.y); o.y = pack2(x[u].z * (1.f + sc.z) + sh.z, x[u].w * (1.f + sc.w) + sh.w);
            *(uint2*)(ubuf + (size_t)(row0 + u) * DM + col) = o;
        }
    }
}

DEVINL void b1_conformer(KP p, int l, char* lds, int item) {
    const int tid = TIDX(), b = item >> 7, tt = item & 127, t0 = tt * 32, rowbase = b * SEQ;
    const bf16_t* P = (const bf16_t*)(p->ws + A_P);
    bf16_t* ymix = (bf16_t*)(p->ws + A_YMIX);
    float w[31];
#pragma unroll
    for (int k = 0; k < 31; ++k) w[k] = p->in[I_CONVA][(size_t)(l * 31 + k) * 256 + tid];
    float acc[32];
    const float bias = p->in[I_CONVAB][l * 256 + tid];
#pragma unroll
    for (int j = 0; j < 32; ++j) acc[j] = bias;
#pragma unroll
    for (int rr = 0; rr < 62; ++rr) {
        const int t = t0 - 30 + rr;
        const bf16_t* pr = P + ((long)(rowbase + t0 - 30) * PIN + tid) + (long)rr * PIN;
        const float val = bf2f(pr[0]), gate = bf2f(pr[256]);
        const float h = (t >= 0) ? val * sigm(gate) : 0.f;
#pragma unroll
        for (int j = 0; j < 32; ++j) { const int k = rr - j; if (k >= 0 && k <= 30) acc[j] = fmaf(w[k], h, acc[j]); }
    }
    float* outb = (float*)lds;
#pragma unroll
    for (int j = 0; j < 32; ++j) outb[j * 256 + tid] = acc[j];
    __syncthreads();
    const int wid = tid >> 6, lane = tid & 63;
    const float4 g4 = *(const float4*)(p->in[I_LNAG] + l * 256 + lane * 4), b4 = *(const float4*)(p->in[I_LNAB] + l * 256 + lane * 4);
    for (int j = wid; j < 32; j += 4) {
        const float4 v = *(const float4*)(outb + j * 256 + lane * 4);
        const float mean = wave_sum(v.x + v.y + v.z + v.w) * (1.f / 256.f);
        const float d0 = v.x - mean, d1 = v.y - mean, d2 = v.z - mean, d3 = v.w - mean;
        const float var = wave_sum(d0 * d0 + d1 * d1 + d2 * d2 + d3 * d3) * (1.f / 256.f);
        const float rs = rsqrtf(var + LN_EPS);
        float y0 = d0 * rs * g4.x + b4.x, y1 = d1 * rs * g4.y + b4.y, y2 = d2 * rs * g4.z + b4.z, y3 = d3 * rs * g4.w + b4.w;
        y0 *= sigm(y0); y1 *= sigm(y1); y2 *= sigm(y2); y3 *= sigm(y3);
        uint2 o; o.x = pack2(y0, y1); o.y = pack2(y2, y3);
        *(uint2*)(ymix + (size_t)(rowbase + t0 + j) * DM + lane * 4) = o;
    }
    __syncthreads();
}

DEVINL void b1_shortconv(KP p, int l, int item) {
    const int tid = TIDX(), cg = tid & 31, tl = tid >> 5, b = item >> 6, t0 = (item & 63) * 64 + tl * 8, rowbase = b * SEQ;
    const bf16_t* P = (const bf16_t*)(p->ws + A_P);
    bf16_t* ymix = (bf16_t*)(p->ws + A_YMIX);
    float w0[8], w1[8], w2[8];
#pragma unroll
    for (int e = 0; e < 8; ++e) { w0[e] = p->in[I_CONVD][(l * 3 + 0) * 256 + cg * 8 + e]; w1[e] = p->in[I_CONVD][(l * 3 + 1) * 256 + cg * 8 + e]; w2[e] = p->in[I_CONVD][(l * 3 + 2) * 256 + cg * 8 + e]; }
    uint4 gbv[8], gcv[10], hdv[10];
#pragma unroll
    for (int u = 0; u < 10; ++u) {
        const int t = t0 - 2 + u;
        const bf16_t* a = P + (size_t)(rowbase + (t >= 0 ? t : 0)) * PIN + 1920 + cg * 8;
        gcv[u] = *(const uint4*)(a + 256); hdv[u] = *(const uint4*)(a + 512);
        if (u >= 2) gbv[u - 2] = *(const uint4*)(a);
    }
    float q2[8], q1[8];
#pragma unroll
    for (int u = 0; u < 10; ++u) {
        const int t = t0 - 2 + u;
        const unsigned gcw[4] = {gcv[u].x, gcv[u].y, gcv[u].z, gcv[u].w}, hdw[4] = {hdv[u].x, hdv[u].y, hdv[u].z, hdv[u].w};
        float q0[8];
#pragma unroll
        for (int e = 0; e < 4; ++e) {
            q0[2 * e] = __uint_as_float(gcw[e] << 16) * __uint_as_float(hdw[e] << 16);
            q0[2 * e + 1] = __uint_as_float(gcw[e] & 0xFFFF0000u) * __uint_as_float(hdw[e] & 0xFFFF0000u);
        }
        if (t < 0) {
#pragma unroll
            for (int e = 0; e < 8; ++e) q0[e] = 0.f;
        }
        if (u >= 2) {
            const unsigned gbw[4] = {gbv[u - 2].x, gbv[u - 2].y, gbv[u - 2].z, gbv[u - 2].w};
            float y[8];
#pragma unroll
            for (int e = 0; e < 4; ++e) {
                y[2 * e] = __uint_as_float(gbw[e] << 16) * (w0[2 * e] * q2[2 * e] + w1[2 * e] * q1[2 * e] + w2[2 * e] * q0[2 * e]);
                y[2 * e + 1] = __uint_as_float(gbw[e] & 0xFFFF0000u) * (w0[2 * e + 1] * q2[2 * e + 1] + w1[2 * e + 1] * q1[2 * e + 1] + w2[2 * e + 1] * q0[2 * e + 1]);
            }
            *(uint4*)(ymix + (size_t)(rowbase + t) * DM + 768 + cg * 8) = make_uint4(pack2(y[0], y[1]), pack2(y[2], y[3]), pack2(y[4], y[5]), pack2(y[6], y[7]));
        }
#pragma unroll
        for (int e = 0; e < 8; ++e) { q2[e] = (u >= 1) ? q1[e] : 0.f; q1[e] = q0[e]; }
    }
}

DEVINL void b1_lru(KP p, int l, char* lds, int item) {
    const int c = TIDX(), b = item >> 7, tt = item & 127, t0 = tt * 32, rowbase = b * SEQ;
    const int h = c >> 6, lane = c & 63;
    const bf16_t* P = (const bf16_t*)(p->ws + A_P);
    float* uT = (float*)lds;
    {
        const float cb0 = p->in[I_CONVB][(l * 4 + 0) * 256 + c], cb1 = p->in[I_CONVB][(l * 4 + 1) * 256 + c], cb2 = p->in[I_CONVB][(l * 4 + 2) * 256 + c], cb3 = p->in[I_CONVB][(l * 4 + 3) * 256 + c];
        const float bias = p->in[I_CONVBB][l * 256 + c];
        float xm3 = 0.f, xm2 = 0.f, xm1 = 0.f;
        if (t0 >= 3) { const bf16_t* a = P + (size_t)(rowbase + t0 - 3) * PIN + 512 + c; xm3 = bf2f(a[0]); xm2 = bf2f(a[PIN]); xm1 = bf2f(a[2 * PIN]); }
        bf16_t xr[32];
#pragma unroll
        for (int j = 0; j < 32; ++j) xr[j] = P[(size_t)(rowbase + t0 + j) * PIN + 512 + c];
#pragma unroll
        for (int j = 0; j < 32; ++j) {
            const float x0 = bf2f(xr[j]);
            uT[c * 36 + j] = cb0 * xm3 + cb1 * xm2 + cb2 * xm1 + cb3 * x0 + bias;
            xm3 = xm2; xm2 = xm1; xm1 = x0;
        }
    }
    __syncthreads();
    const float brg = p->in[I_BRG][l * 256 + c], big = p->in[I_BIG][l * 256 + c];
    const float sp = softplus_acc(-p->in[I_LAMBDA][l * 256 + c]);
    unsigned* hcbuf = (unsigned*)(p->ws + A_HLOC);
    const float* wrg = p->in[I_WRG] + (size_t)((l * 4 + h) * 64) * 64 + lane;
    const float* wig = p->in[I_WIG] + (size_t)((l * 4 + h) * 64) * 64 + lane;
    float hs = 0.f, cA = 1.f;
#pragma unroll 1
    for (int half = 0; half < 2; ++half) {
        float ar[16], ai[16];
#pragma unroll
        for (int j = 0; j < 16; ++j) { ar[j] = 0.f; ai[j] = 0.f; }
#pragma unroll 1
        for (int dh = 0; dh < 4; ++dh) {
            float wrv[16], wiv[16];
#pragma unroll
            for (int d = 0; d < 16; ++d) { wrv[d] = wrg[(dh * 16 + d) * 64]; wiv[d] = wig[(dh * 16 + d) * 64]; }
#pragma unroll
            for (int d = 0; d < 16; ++d) {
                const float wr = wrv[d], wi = wiv[d];
                const float4* up = (const float4*)(uT + (h * 64 + dh * 16 + d) * 36 + half * 16);
#pragma unroll
                for (int jj = 0; jj < 4; ++jj) {
                    const float4 u4 = up[jj];
                    ar[4 * jj + 0] = fmaf(u4.x, wr, ar[4 * jj + 0]); ai[4 * jj + 0] = fmaf(u4.x, wi, ai[4 * jj + 0]);
                    ar[4 * jj + 1] = fmaf(u4.y, wr, ar[4 * jj + 1]); ai[4 * jj + 1] = fmaf(u4.y, wi, ai[4 * jj + 1]);
                    ar[4 * jj + 2] = fmaf(u4.z, wr, ar[4 * jj + 2]); ai[4 * jj + 2] = fmaf(u4.z, wi, ai[4 * jj + 2]);
                    ar[4 * jj + 3] = fmaf(u4.w, wr, ar[4 * jj + 3]); ai[4 * jj + 3] = fmaf(u4.w, wi, ai[4 * jj + 3]);
                }
            }
        }
        float ureg[16];
#pragma unroll
        for (int jj = 0; jj < 4; ++jj) { const float4 u4 = *(const float4*)(uT + c * 36 + half * 16 + 4 * jj); ureg[4 * jj] = u4.x; ureg[4 * jj + 1] = u4.y; ureg[4 * jj + 2] = u4.z; ureg[4 * jj + 3] = u4.w; }
        unsigned* hp = hcbuf + (size_t)(rowbase + t0 + half * 16) * 256 + c;
#pragma unroll
        for (int j = 0; j < 16; ++j) {
            const float r = sigm(ar[j] + brg), ig = sigm(ai[j] + big);
            const float log_a = -8.0f * r * sp;
            const float a = __expf(log_a);
            const float mult = sqrtf(fmaxf(1.f - a * a, 0.f));
            const float bx = mult * (ig * ureg[j]);
            hs = fmaf(a, hs, bx); cA *= a;
            hp[j * 256] = pack2(hs, cA);
        }
    }
    ((float*)(p->ws + A_CARRYA))[(size_t)(b * 128 + tt) * 256 + c] = cA;
    ((float*)(p->ws + A_CARRYH))[(size_t)(b * 128 + tt) * 256 + c] = hs;
    __syncthreads();
}

DEVINL void b1_rwkv(KP p, int l, char* lds, int item) {
    const int c = TIDX(), b = item >> 7, tt = item & 127, t0 = tt * 32, rowbase = b * SEQ;
    const bf16_t* P = (const bf16_t*)(p->ws + A_P);
    float* featT = (float*)lds;
    const float* muc = p->in[I_MUC] + l * 896;
    if (c < 128) {
        const int col = 1024 + 768 + c; const float mu = muc[768 + c];
        float prev;
        { const float x = bf2f(P[(size_t)(rowbase + (t0 > 0 ? t0 - 1 : 0)) * PIN + col]); prev = (t0 > 0) ? x : 0.f; }
#pragma unroll 1
        for (int jb = 0; jb < 2; ++jb) {
            bf16_t raw[16];
#pragma unroll
            for (int u = 0; u < 16; ++u) raw[u] = P[(size_t)(rowbase + t0 + jb * 16 + u) * PIN + col];
#pragma unroll
            for (int u = 0; u < 16; ++u) {
                const float cur = bf2f(raw[u]);
                const float xs = cur + (prev - cur) * mu;
                const float val = (c < 32) ? tanh_fast(xs) : ((c < 64) ? xs : sigm(xs));
                featT[c * 36 + jb * 16 + u] = val; prev = cur;
            }
        }
    }
    __syncthreads();
    float acc[32], dec[32], aa[32];
#define LORA32(WPTR, FOFF) do { float wv_[32]; \
    _Pragma("unroll") for (int jf = 0; jf < 32; ++jf) wv_[jf] = (WPTR)[(size_t)jf * 256 + c]; \
    _Pragma("unroll") for (int jf = 0; jf < 32; ++jf) { const float4* fp = (const float4*)(featT + ((FOFF) + jf) * 36); const float wv = wv_[jf]; \
        _Pragma("unroll") for (int jj = 0; jj < 8; ++jj) { const float4 u4 = fp[jj]; acc[4 * jj] = fmaf(u4.x, wv, acc[4 * jj]); acc[4 * jj + 1] = fmaf(u4.y, wv, acc[4 * jj + 1]); acc[4 * jj + 2] = fmaf(u4.z, wv, acc[4 * jj + 2]); acc[4 * jj + 3] = fmaf(u4.w, wv, acc[4 * jj + 3]); } } } while (0)
#pragma unroll
    for (int j = 0; j < 32; ++j) acc[j] = 0.f;
    LORA32(p->in[I_WG2] + (size_t)(l * 64) * 256, 64);
    LORA32(p->in[I_WG2] + (size_t)(l * 64 + 32) * 256, 96);
    {
        bf16_t* gbuf = (bf16_t*)(p->ws + A_G);
#pragma unroll
        for (int j = 0; j < 32; ++j) { gbuf[(size_t)(rowbase + t0 + j) * 256 + c] = f2bf(acc[j]); acc[j] = 0.f; }
    }
    LORA32(p->in[I_WW2] + (size_t)(l * 32) * 256, 0);
    {
        const float w0 = p->in[I_W0][l * 256 + c];
#pragma unroll
        for (int j = 0; j < 32; ++j) { const float z = w0 + acc[j]; const float wlog = -softplusf(-z) - 0.5f; dec[j] = -__expf(wlog); acc[j] = 0.f; }
    }
    LORA32(p->in[I_WA2] + (size_t)(l * 32) * 256, 32);
    {
        const float a0 = p->in[I_A0][l * 256 + c];
#pragma unroll
        for (int j = 0; j < 32; ++j) aa[j] = sigm(a0 + acc[j]);
    }
#undef LORA32
    {
        bf16_t* bonus = (bf16_t*)(p->ws + A_BONUS); uint4* scan = (uint4*)(p->ws + A_SCAN);
        const float mur = muc[c], muk = muc[256 + c], muv = muc[512 + c];
        const float kkw = p->in[I_KK][l * 256 + c], kaw = p->in[I_KA][l * 256 + c], rkw = p->in[I_RK][l * 256 + c];
        float pr, pk, pv;
        { const bf16_t* a = P + (size_t)(rowbase + (t0 > 0 ? t0 - 1 : 0)) * PIN + 1024 + c; const float x0 = bf2f(a[0]), x1 = bf2f(a[256]), x2 = bf2f(a[512]);
          pr = (t0 > 0) ? x0 : 0.f; pk = (t0 > 0) ? x1 : 0.f; pv = (t0 > 0) ? x2 : 0.f; }
#pragma unroll
        for (int jb = 0; jb < 2; ++jb) {
            bf16_t rr_[16], rk_[16], rv_[16];
#pragma unroll
            for (int u = 0; u < 16; ++u) { const bf16_t* a = P + (size_t)(rowbase + t0 + jb * 16 + u) * PIN + 1024 + c; rr_[u] = a[0]; rk_[u] = a[256]; rv_[u] = a[512]; }
#pragma unroll
            for (int u = 0; u < 16; ++u) {
                const int j = jb * 16 + u;
                const size_t row = (size_t)(rowbase + t0 + j);
                const float cr = bf2f(rr_[u]), ck = bf2f(rk_[u]), cv = bf2f(rv_[u]);
                const float r = cr + (pr - cr) * mur, k = ck + (pk - ck) * muk, v = cv + (pv - cv) * muv;
                pr = cr; pk = ck; pv = cv;
                const float kk = k * kkw;
                const float ss = wave_sum(kk * kk);
                const float kkn = kk * rsqrtf(ss + 1e-12f);
                const float kf = k * (1.f + (aa[j] - 1.f) * kaw);
                const float bs = wave_sum(r * kf * rkw);
                bonus[row * 256 + c] = f2bf(bs * v);
                uint4 o; o.x = pack2(kkn, kkn * aa[j]); o.y = pack2(kf, r); o.z = pack2(v, 0.f); o.w = __float_as_uint(dec[j]);
                scan[row * 256 + c] = o;
            }
            asm volatile("" ::: "memory");
        }
    }
    __syncthreads();
}

constexpr int S_AL = 0, S_BE = 8192, S_KA = 16384, S_RH = 24576, S_BET = 32768, S_KAT = 40960, S_VT = 49152, S_L2F = 57344  , S_GT = 73728  ;
constexpr int S_L1F = S_BE;
constexpr int S_M1 = S_BE, S_M2 = S_KA;
constexpr int S_APT = S_L2F, S_W2T = S_L2F + 8192;
constexpr int S_RP = S_AL, S_GTR = S_RH;
DEVINL int crow32(int reg, int h) { return (reg & 3) + 8 * (reg >> 2) + 4 * h; }
DEVINL bf16x8 frag64(const char* lds, int slot, int row, int kel) { return *reinterpret_cast<const bf16x8*>(lds + slot + row * 128 + kel * 2); }
#define MFMA32(a, b, c) __builtin_amdgcn_mfma_f32_32x32x16_bf16((a), (b), (c), 0, 0, 0)
DEVINL float dpp_xor1(float x) { return __builtin_bit_cast(float, __builtin_amdgcn_update_dpp(0, __builtin_bit_cast(int, x), 0xB1, 0xf, 0xf, true)); }

DEVINL f32x16 mm64(const char* lds, int slotA, int slotB, int tm, int tn, int r, int hh, f32x16 acc) {
#pragma unroll
    for (int ks = 0; ks < 4; ++ks) acc = MFMA32(frag64(lds, slotA, tm * 32 + r, ks * 16 + 8 * hh), frag64(lds, slotB, tn * 32 + r, ks * 16 + 8 * hh), acc);
    return acc;
}

DEVINL void b1e_unit(KP p, char* lds, int b, int h, int c) {
    const int tid = TIDX(), wv = tid >> 6, lane = tid & 63, r = lane & 31, hh = lane >> 5;
    const uint4* scan = (const uint4*)(p->ws + A_SCAN) + ((size_t)(b * SEQ + c * 64)) * 256 + h * 64;
    float* gtot = (float*)(lds + S_GT); float* gamC = gtot + 256;
    {
        const int j = lane;
        float lw[16]; unsigned px[16], py[16], pz[16];
#pragma unroll
        for (int u = 0; u < 16; ++u) { const uint4 q = scan[(size_t)(wv * 16 + u) * 256 + j]; px[u] = q.x; py[u] = q.y; pz[u] = q.z; lw[u] = __uint_as_float(q.w); }
        float tot = 0.f;
#pragma unroll
        for (int u = 0; u < 16; ++u) tot += lw[u];
        gtot[wv * 64 + j] = tot;
        __syncthreads();
        float off = 0.f, all = 0.f;
#pragma unroll
        for (int g = 0; g < 4; ++g) { const float v = gtot[g * 64 + j]; all += v; off += (g < wv) ? v : 0.f; }
        if (wv == 0) gamC[j] = __expf(all);
        float cum = off;
        unsigned tb[8], tk[8], tv[8];
#pragma unroll
        for (int u = 0; u < 16; ++u) {
            const float kkn = __uint_as_float(px[u] << 16), bb = __uint_as_float(px[u] & 0xFFFF0000u);
            const float kf = __uint_as_float(py[u] << 16), rr = __uint_as_float(py[u] & 0xFFFF0000u);
            const float gp = __expf(cum); cum += lw[u];
            const float g = __expf(cum), en = __expf(-cum);
            const int t = wv * 16 + u;
            const unsigned be = f2bf(bb * en), ka = f2bf(kf * en);
            *(bf16_t*)(lds + S_AL + t * 128 + j * 2) = f2bf(gp * kkn);
            *(bf16_t*)(lds + S_BE + t * 128 + j * 2) = (bf16_t)be;
            *(bf16_t*)(lds + S_KA + t * 128 + j * 2) = (bf16_t)ka;
            *(bf16_t*)(lds + S_RH + t * 128 + j * 2) = f2bf(g * rr);
            if (u & 1) { tb[u >> 1] |= be << 16; tk[u >> 1] |= ka << 16; tv[u >> 1] |= (pz[u] << 16); }
            else { tb[u >> 1] = be; tk[u >> 1] = ka; tv[u >> 1] = pz[u] & 0xFFFFu; }
        }
        *(uint4*)(lds + S_BET + j * 128 + wv * 32) = make_uint4(tb[0], tb[1], tb[2], tb[3]); *(uint4*)(lds + S_BET + j * 128 + wv * 32 + 16) = make_uint4(tb[4], tb[5], tb[6], tb[7]);
        *(uint4*)(lds + S_KAT + j * 128 + wv * 32) = make_uint4(tk[0], tk[1], tk[2], tk[3]); *(uint4*)(lds + S_KAT + j * 128 + wv * 32 + 16) = make_uint4(tk[4], tk[5], tk[6], tk[7]);
        *(uint4*)(lds + S_VT + j * 128 + wv * 32) = make_uint4(tv[0], tv[1], tv[2], tv[3]); *(uint4*)(lds + S_VT + j * 128 + wv * 32 + 16) = make_uint4(tv[4], tv[5], tv[6], tv[7]);
    }
    __syncthreads();
    const int tm = wv >> 1, tn = wv & 1;
    f32x16 aM1, aM2;
    {
        f32x16 aL1, aL2;
#pragma unroll
        for (int i = 0; i < 16; ++i) { aL1[i] = 0.f; aL2[i] = 0.f; aM1[i] = 0.f; aM2[i] = 0.f; }
#pragma unroll
        for (int ks = 0; ks < 4; ++ks) {
            const bf16x8 fa = frag64(lds, S_AL, tm * 32 + r, ks * 16 + 8 * hh), fr = frag64(lds, S_RH, tm * 32 + r, ks * 16 + 8 * hh);
            const bf16x8 fb = frag64(lds, S_BE, tn * 32 + r, ks * 16 + 8 * hh), fk = frag64(lds, S_KA, tn * 32 + r, ks * 16 + 8 * hh);
            aL1 = MFMA32(fa, fb, aL1); aL2 = MFMA32(fa, fk, aL2); aM1 = MFMA32(fr, fb, aM1); aM2 = MFMA32(fr, fk, aM2);
        }
        __syncthreads();
#pragma unroll
        for (int reg = 0; reg < 16; ++reg) {
            const int t = tm * 32 + crow32(reg, hh), sidx = tn * 32 + r;
            const int o = (t * 64 + (sidx & 1) * 32 + (sidx >> 1)) * 4;
            *(float*)(lds + S_L1F + o) = (sidx < t) ? aL1[reg] : 0.f;
            *(float*)(lds + S_L2F + o) = (sidx < t) ? aL2[reg] : 0.f;
            aM1[reg] = (sidx <= t) ? aM1[reg] : 0.f; aM2[reg] = (sidx <= t) ? aM2[reg] : 0.f;
        }
    }
    __syncthreads();
    unsigned outp[32];
    {
        const int col = (wv & 1) * 32 + (lane >> 1), q = lane & 1;
        float xq[32];
#pragma unroll
        for (int k = 0; k < 32; ++k) xq[k] = 0.f;
        const char* l1row = lds + S_L1F + q * 128;
        const char* l2row = lds + S_L2F + q * 128;
        if (wv < 2) {
#pragma unroll
            for (int t = 0; t < 64; ++t) {
                float acc = 0.f;
#pragma unroll
                for (int k4 = 0; k4 * 4 < (t + 1) / 2; ++k4) {
                    const float4 a = *(const float4*)(l1row + t * 256 + k4 * 16);
                    acc = fmaf(a.x, xq[4 * k4 + 0], acc); acc = fmaf(a.y, xq[4 * k4 + 1], acc); acc = fmaf(a.z, xq[4 * k4 + 2], acc); acc = fmaf(a.w, xq[4 * k4 + 3], acc);
                }
                acc += dpp_xor1(acc);
                const float x = bf2f(*(const bf16_t*)(lds + S_AL + t * 128 + col * 2)) - acc;
                xq[t >> 1] = ((t & 1) == q) ? x : xq[t >> 1];
            }
        } else {
            float vq[32];
#pragma unroll
            for (int k8 = 0; k8 < 8; ++k8) {
                const uint4 d = *(const uint4*)(lds + S_VT + col * 128 + k8 * 16);
                vq[4 * k8 + 0] = q ? __uint_as_float(d.x & 0xFFFF0000u) : __uint_as_float(d.x << 16);
                vq[4 * k8 + 1] = q ? __uint_as_float(d.y & 0xFFFF0000u) : __uint_as_float(d.y << 16);
                vq[4 * k8 + 2] = q ? __uint_as_float(d.z & 0xFFFF0000u) : __uint_as_float(d.z << 16);
                vq[4 * k8 + 3] = q ? __uint_as_float(d.w & 0xFFFF0000u) : __uint_as_float(d.w << 16);
            }
#pragma unroll
            for (int t = 0; t < 64; ++t) {
                float acc = 0.f;
#pragma unroll
                for (int k4 = 0; k4 * 4 < (t + 1) / 2; ++k4) {
                    const float4 a = *(const float4*)(l1row + t * 256 + k4 * 16);
                    const float4 bq = *(const float4*)(l2row + t * 256 + k4 * 16);
                    acc = fmaf(bq.x, vq[4 * k4 + 0], acc); acc = fmaf(bq.y, vq[4 * k4 + 1], acc); acc = fmaf(bq.z, vq[4 * k4 + 2], acc); acc = fmaf(bq.w, vq[4 * k4 + 3], acc);
                    acc = fmaf(-a.x, xq[4 * k4 + 0], acc); acc = fmaf(-a.y, xq[4 * k4 + 1], acc); acc = fmaf(-a.z, xq[4 * k4 + 2], acc); acc = fmaf(-a.w, xq[4 * k4 + 3], acc);
                }
                acc += dpp_xor1(acc);
                xq[t >> 1] = ((t & 1) == q) ? acc : xq[t >> 1];
            }
        }
#pragma unroll
        for (int k = 0; k < 32; ++k) { const float o = dpp_xor1(xq[k]); outp[k] = q ? pack2(o, xq[k]) : pack2(xq[k], o); }
    }
    __syncthreads();
    {
        const int col = (wv & 1) * 32 + (lane >> 1), q = lane & 1;
        char* dst = lds + ((wv < 2) ? S_APT : S_W2T) + col * 128 + q * 64;
#pragma unroll
        for (int i = 0; i < 4; ++i) *(uint4*)(dst + i * 16) = q ? make_uint4(outp[16 + 4 * i], outp[17 + 4 * i], outp[18 + 4 * i], outp[19 + 4 * i]) : make_uint4(outp[4 * i], outp[4 * i + 1], outp[4 * i + 2], outp[4 * i + 3]);
#pragma unroll
        for (int reg = 0; reg < 16; ++reg) {
            const int t = tm * 32 + crow32(reg, hh), sidx = tn * 32 + r;
            *(bf16_t*)(lds + S_M1 + t * 128 + sidx * 2) = f2bf(aM1[reg]);
            *(bf16_t*)(lds + S_M2 + t * 128 + sidx * 2) = f2bf(aM2[reg]);
        }
    }
    __syncthreads();
    unsigned char* ubase = p->ws + A_CHAIN + (size_t)((b * 4 + h) * 64 + c) * CHAIN_UNIT;
    f32x16 zero;
#pragma unroll
    for (int i = 0; i < 16; ++i) zero[i] = 0.f;
    f32x16 gt;
    {
        const f32x16 qv = mm64(lds, S_M1, S_APT, tm, tn, r, hh, zero);
        const f32x16 y0 = mm64(lds, S_M2, S_VT, tm, tn, r, hh, zero) - mm64(lds, S_M1, S_W2T, tm, tn, r, hh, zero);
        gt = mm64(lds, S_BET, S_APT, tm, tn, r, hh, zero);
        const f32x16 ht = mm64(lds, S_KAT, S_VT, tm, tn, r, hh, zero) - mm64(lds, S_BET, S_W2T, tm, tn, r, hh, zero);
#pragma unroll
        for (int reg = 0; reg < 16; ++reg) {
            const int t = tm * 32 + crow32(reg, hh), jc = tn * 32 + r;
            const float rh = bf2f(*(const bf16_t*)(lds + S_RH + t * 128 + jc * 2));
            *(bf16_t*)(lds + S_RP + t * 128 + jc * 2) = f2bf(rh - qv[reg]);
            const int jr = tm * 32 + crow32(reg, hh);
            const float gc = gamC[jr];
            gt[reg] = gc * (((jr == jc) ? 1.f : 0.f) - gt[reg]);
        }
        float4* himg = (float4*)(ubase + 16384); float4* yimg = (float4*)(ubase + 32768);
#pragma unroll
        for (int rq = 0; rq < 4; ++rq) {
            float4 hv, yv;
            hv.x = gamC[tm * 32 + crow32(4 * rq + 0, hh)] * ht[4 * rq + 0]; hv.y = gamC[tm * 32 + crow32(4 * rq + 1, hh)] * ht[4 * rq + 1];
            hv.z = gamC[tm * 32 + crow32(4 * rq + 2, hh)] * ht[4 * rq + 2]; hv.w = gamC[tm * 32 + crow32(4 * rq + 3, hh)] * ht[4 * rq + 3];
            yv.x = y0[4 * rq + 0]; yv.y = y0[4 * rq + 1]; yv.z = y0[4 * rq + 2]; yv.w = y0[4 * rq + 3];
            himg[((tn * 2 + tm) * 4 + rq) * 64 + lane] = hv;
            yimg[((tn * 2 + tm) * 4 + rq) * 64 + lane] = yv;
        }
    }
    __syncthreads();
#pragma unroll
    for (int reg = 0; reg < 16; ++reg) {
        const int jr = tm * 32 + crow32(reg, hh), jc = tn * 32 + r;
        *(bf16_t*)(lds + S_GTR + jr * 128 + jc * 2) = f2bf(gt[reg]);
    }
    __syncthreads();
    {
        uint4* gimg = (uint4*)(ubase); uint4* rimg = (uint4*)(ubase + 8192);
#pragma unroll
        for (int ii = 0; ii < 2; ++ii) {
            const int im = wv * 2 + ii, mt = im >> 2, jb = (im >> 1) & 1, s2 = im & 1;
            const int cbase = (32 * jb + 16 * s2 + 4 * hh) * 2;
            const uint2 g0 = *(const uint2*)(lds + S_GTR + (mt * 32 + r) * 128 + cbase), g1 = *(const uint2*)(lds + S_GTR + (mt * 32 + r) * 128 + cbase + 16);
            const uint2 r0 = *(const uint2*)(lds + S_RP + (mt * 32 + r) * 128 + cbase), r1 = *(const uint2*)(lds + S_RP + (mt * 32 + r) * 128 + cbase + 16);
            gimg[im * 64 + lane] = make_uint4(g0.x, g0.y, g1.x, g1.y);
            rimg[im * 64 + lane] = make_uint4(r0.x, r0.y, r1.x, r1.y);
        }
    }
    __syncthreads();
}

DEVINL void phaseB1(KP p, int l, char* lds, const int mask = 15, const int sub = 3) {
    const int nb = NBV();
    if (mask & 1) {
        const int blk = BIDX();
        for (int it = blk; it < 512; it += nb) {
            if (sub & 1) { b1_rwkv(p, l, lds, it * 2); b1_rwkv(p, l, lds, it * 2 + 1); }
            __threadfence_block(); __syncthreads();
            const int b = it >> 6, c = it & 63;
            if (sub & 2) {
#pragma unroll 1
                for (int h = 0; h < 4; ++h) b1e_unit(p, lds, b, h, c);
            }
        }
    }
    if (mask & 2) { const int blk = BIDX(); for (int it = blk; it < 1024; it += nb) b1_lru(p, l, lds, it); }
    if (mask & 4) { const int blk = BIDX(); for (int it = blk; it < 1024; it += nb) b1_conformer(p, l, lds, it); }
    if (mask & 8) { const int blk = BIDX(); for (int it = blk; it < 512; it += nb) b1_shortconv(p, l, it); }
}

DEVINL void phaseB2(KP p, int l, char* lds) {
    const int tid = TIDX(), blk = BIDX();
    if (blk >= 64 && blk < 72) {
        const int bb = blk - 64;
        const float* ca = (const float*)(p->ws + A_CARRYA) + (size_t)bb * 128 * 256 + tid;
        const float* ch = (const float*)(p->ws + A_CARRYH) + (size_t)bb * 128 * 256 + tid;
        float* hst = (float*)(p->ws + A_HSTART) + (size_t)bb * 128 * 256 + tid;
        float hs = 0.f;
#pragma unroll 8
        for (int tt = 0; tt < 128; ++tt) { hst[tt * 256] = hs; hs = fmaf(ca[tt * 256], hs, ch[tt * 256]); }
    }
    if (blk < 64 && tid < 64) {
        const int lane = tid, r = lane & 31, hh = lane >> 5;
        const int bh = blk >> 1, w = blk & 1, b = bh >> 2, h = bh & 3;
        float* yraw = (float*)(p->ws + A_YRAW) + (size_t)b * SEQ * 256 + h * 64 + 32 * w + r;
        f32x16 X0, X1;
#pragma unroll
        for (int i = 0; i < 16; ++i) { X0[i] = 0.f; X1[i] = 0.f; }
        auto issue = [&](int c, char* buf) {
            const unsigned char* ubase = p->ws + A_CHAIN + (size_t)(bh * 64 + c) * CHAIN_UNIT;
#pragma unroll
            for (int i = 0; i < 8; ++i) {
                __builtin_amdgcn_global_load_lds((const unsigned*)(ubase + i * 1024 + lane * 16), (unsigned*)(buf + i * 1024 + lane * 16), 16, 0, 0);
                __builtin_amdgcn_global_load_lds((const unsigned*)(ubase + 8192 + i * 1024 + lane * 16), (unsigned*)(buf + 8192 + i * 1024 + lane * 16), 16, 0, 0);
                __builtin_amdgcn_global_load_lds((const unsigned*)(ubase + 16384 + (w * 8 + i) * 1024 + lane * 16), (unsigned*)(buf + 16384 + i * 1024 + lane * 16), 16, 0, 0);
                __builtin_amdgcn_global_load_lds((const unsigned*)(ubase + 32768 + (w * 8 + i) * 1024 + lane * 16), (unsigned*)(buf + 24576 + i * 1024 + lane * 16), 16, 0, 0);
            }
        };
        issue(0, lds);
        for (int c = 0; c < 64; ++c) {
            char* buf = lds + (c & 1) * 32768;
            if (c + 1 < 64) { issue(c + 1, lds + ((c + 1) & 1) * 32768); asm volatile("s_waitcnt vmcnt(32)" ::: "memory"); }
            else asm volatile("s_waitcnt vmcnt(0)" ::: "memory");
            uint4 gq[8], rq8[8]; float4 hq[8], yq[8];
#pragma unroll
            for (int i = 0; i < 8; ++i) { gq[i] = *(const uint4*)(buf + i * 1024 + lane * 16); rq8[i] = *(const uint4*)(buf + 8192 + i * 1024 + lane * 16); }
#pragma unroll
            for (int i = 0; i < 8; ++i) { hq[i] = *(const float4*)(buf + 16384 + i * 1024 + lane * 16); yq[i] = *(const float4*)(buf + 24576 + i * 1024 + lane * 16); }
            bf16x8 xp[4];
#pragma unroll
            for (int s2 = 0; s2 < 2; ++s2) {
                uint4 a, bq;
                a.x = pack2(X0[8 * s2 + 0], X0[8 * s2 + 1]); a.y = pack2(X0[8 * s2 + 2], X0[8 * s2 + 3]); a.z = pack2(X0[8 * s2 + 4], X0[8 * s2 + 5]); a.w = pack2(X0[8 * s2 + 6], X0[8 * s2 + 7]);
                bq.x = pack2(X1[8 * s2 + 0], X1[8 * s2 + 1]); bq.y = pack2(X1[8 * s2 + 2], X1[8 * s2 + 3]); bq.z = pack2(X1[8 * s2 + 4], X1[8 * s2 + 5]); bq.w = pack2(X1[8 * s2 + 6], X1[8 * s2 + 7]);
                xp[s2] = __builtin_bit_cast(bf16x8, a); xp[2 + s2] = __builtin_bit_cast(bf16x8, bq);
            }
#pragma unroll
            for (int mt = 0; mt < 2; ++mt) {
                f32x16 acc;
#pragma unroll
                for (int i = 0; i < 4; ++i) { acc[4 * i] = yq[mt * 4 + i].x; acc[4 * i + 1] = yq[mt * 4 + i].y; acc[4 * i + 2] = yq[mt * 4 + i].z; acc[4 * i + 3] = yq[mt * 4 + i].w; }
#pragma unroll
                for (int f = 0; f < 4; ++f) acc = MFMA32(__builtin_bit_cast(bf16x8, rq8[mt * 4 + f]), xp[f], acc);
#pragma unroll
                for (int reg = 0; reg < 16; ++reg) yraw[(size_t)(c * 64 + mt * 32 + crow32(reg, hh)) * 256] = acc[reg];
            }
            f32x16 n0, n1;
#pragma unroll
            for (int i = 0; i < 4; ++i) { n0[4 * i] = hq[i].x; n0[4 * i + 1] = hq[i].y; n0[4 * i + 2] = hq[i].z; n0[4 * i + 3] = hq[i].w;
                                          n1[4 * i] = hq[4 + i].x; n1[4 * i + 1] = hq[4 + i].y; n1[4 * i + 2] = hq[4 + i].z; n1[4 * i + 3] = hq[4 + i].w; }
#pragma unroll
            for (int f = 0; f < 4; ++f) { n0 = MFMA32(__builtin_bit_cast(bf16x8, gq[f]), xp[f], n0); n1 = MFMA32(__builtin_bit_cast(bf16x8, gq[4 + f]), xp[f], n1); }
            X0 = n0; X1 = n1;
        }
    }
}

DEVINL void phaseB3(KP p, int l) {
    const int c = TIDX(), nb = NBV(), blk = BIDX();
    const bf16_t* P = (const bf16_t*)(p->ws + A_P);
    bf16_t* ymix = (bf16_t*)(p->ws + A_YMIX);
    const float* yraw = (const float*)(p->ws + A_YRAW); const bf16_t* bonus = (const bf16_t*)(p->ws + A_BONUS); const bf16_t* gbuf = (const bf16_t*)(p->ws + A_G);
    const unsigned* hcbuf = (const unsigned*)(p->ws + A_HLOC); const float* hst = (const float*)(p->ws + A_HSTART);
    const float gng = p->in[I_GNG][l * 256 + c], gnb = p->in[I_GNB][l * 256 + c];
    for (int it = blk; it < 512; it += nb) {
#pragma unroll 1
        for (int r8 = 0; r8 < 64; r8 += 8) {
            float yv[8]; bf16_t bo[8], gg[8], gbv[8]; unsigned hcv[8]; float hsv[8];
#pragma unroll
            for (int u = 0; u < 8; ++u) {
                const int row = it * 64 + r8 + u, b = row >> 12, tt = (row & 4095) >> 5;
                const size_t o = (size_t)row * 256 + c;
                yv[u] = yraw[o]; bo[u] = bonus[o]; gg[u] = gbuf[o]; hcv[u] = hcbuf[o]; hsv[u] = hst[(size_t)(b * 128 + tt) * 256 + c];
                gbv[u] = P[(size_t)row * PIN + 768 + c];
            }
#pragma unroll
            for (int u = 0; u < 8; ++u) {
                const int row = it * 64 + r8 + u;
                const float y = yv[u];
                const float mu = wave_sum(y) * (1.f / 64.f);
                const float d = y - mu;
                const float var = wave_sum(d * d) * (1.f / 64.f);
                const float yn = d * rsqrtf(var + GN_EPS) * gng + gnb;
                ymix[(size_t)row * DM + 512 + c] = f2bf((yn + bf2f(bo[u])) * bf2f(gg[u]));
                const float hh = fmaf(__uint_as_float(hcv[u] & 0xFFFF0000u), hsv[u], __uint_as_float(hcv[u] << 16));
                ymix[(size_t)row * DM + 256 + c] = f2bf(hh * gelu_tanh(bf2f(gbv[u])));
            }
        }
    }
}

DEVINL void phaseD(KP p, int l, char* lds, const int dry = 0) {
    const int tid = TIDX(), nb = NBV(), blk = BIDX(), wid = tid >> 6, lane = tid & 63;
    constexpr int URS = 2064;
    char* uh = lds;
    char* ulo = lds + 16 * URS;
    float* logit = (float*)(lds + 32 * URS);
    int* sel_e = (int*)(lds + 32 * URS + 4096);
    int* lpos = sel_e + 512;
    int* hist = lpos + 512;
    int* basep = hist + 64;
    const bf16_t* wrt_hi = (const bf16_t*)(p->ws + OFF_WR) + (size_t)(l * 2 + 0) * 64 * 1024;
    const bf16_t* wrt_lo = (const bf16_t*)(p->ws + OFF_WR) + (size_t)(l * 2 + 1) * 64 * 1024;
    const bf16_t* zbuf = (const bf16_t*)(p->ws + M_ZB);
    float2* lnstat = (float2*)(p->ws + M_STAT);
    bf16_t* ubuf = (bf16_t*)(p->ws + (dry ? A_YMIX : OFF_UBUF));
    const float* mod = (const float*)(p->ws + OFF_MOD);
    const float* wr = p->in[I_WROUTER] + (size_t)l * 1024 * 64 + lane;
    const float ebias = p->in[I_EBIAS][l * 64 + lane];
    unsigned* cnt = (unsigned*)(p->ws + OFF_CNT) + l * 64 + (dry ? 256 : 0);
    int* list = (int*)(p->ws + (dry ? M_HBUF : M_LIST));
    float* wsel = (float*)(p->ws + (dry ? M_HBUF + 16777216 : M_WSEL));
    int* pmap = (int*)(p->ws + (dry ? M_HBUF + 33554432 : M_PMAP));
    for (int it = blk; it < 512; it += nb) {
        const int tok0 = it * 64;
        if (tid < 64) hist[tid] = 0;
        for (int sb = 0; sb < 4; ++sb) {
#pragma unroll
            for (int j = 0; j < 4; ++j) {
                const int tl = wid * 4 + j, row = tok0 + sb * 16 + tl, b = row >> 12;
                float4 z[4];
                float s = 0.f;
#pragma unroll
                for (int i = 0; i < 4; ++i) { const uint2 zv = *(const uint2*)(zbuf + (size_t)row * DM + i * 256 + lane * 4);
                    z[i].x = __uint_as_float(zv.x << 16); z[i].y = __uint_as_float(zv.x & 0xFFFF0000u); z[i].z = __uint_as_float(zv.y << 16); z[i].w = __uint_as_float(zv.y & 0xFFFF0000u); s += z[i].x + z[i].y + z[i].z + z[i].w; }
                const float mean = wave_sum(s) * (1.f / 1024.f);
                float q = 0.f;
#pragma unroll
                for (int i = 0; i < 4; ++i) { z[i].x -= mean; z[i].y -= mean; z[i].z -= mean; z[i].w -= mean; q += z[i].x * z[i].x + z[i].y * z[i].y + z[i].z * z[i].z + z[i].w * z[i].w; }
                const float rs = rsqrtf(wave_sum(q) * (1.f / 1024.f) + LN_EPS);
                if (lane == 0) lnstat[row] = make_float2(mean, rs);
#pragma unroll
                for (int i = 0; i < 4; ++i) {
                    const int col = i * 256 + lane * 4;
                    const float4 g = *(const float4*)(p->in[I_LN1G] + l * 1024 + col), bb = *(const float4*)(p->in[I_LN1B] + l * 1024 + col);
                    const float4 sh = *(const float4*)(mod + (size_t)(l * 8 + b) * 6144 + 3072 + col), sc = *(const float4*)(mod + (size_t)(l * 8 + b) * 6144 + 4096 + col);
                    float4 x1; x1.x = z[i].x * rs * g.x + bb.x; x1.y = z[i].y * rs * g.y + bb.y; x1.z = z[i].z * rs * g.z + bb.z; x1.w = z[i].w * rs * g.w + bb.w;
                    float4 u; u.x = x1.x * (1.f + sc.x) + sh.x; u.y = x1.y * (1.f + sc.y) + sh.y; u.z = x1.z * (1.f + sc.z) + sh.z; u.w = x1.w * (1.f + sc.w) + sh.w;
                    uint2 o; o.x = pack2(u.x, u.y); o.y = pack2(u.z, u.w);
                    *(uint2*)(ubuf + (size_t)row * DM + col) = o;
                    *(uint2*)(uh + tl * URS + col * 2) = o;
                    uint2 o2; o2.x = pack2(u.x - __uint_as_float(o.x << 16), u.y - __uint_as_float(o.x & 0xFFFF0000u)); o2.y = pack2(u.z - __uint_as_float(o.y << 16), u.w - __uint_as_float(o.y & 0xFFFF0000u));
                    *(uint2*)(ulo + tl * URS + col * 2) = o2;
                }
            }
            __syncthreads();
            {
                const int fr = lane & 15, fq = lane >> 4;
                f32x4 lacc = (f32x4){0.f, 0.f, 0.f, 0.f};
                const bf16_t* bh = wrt_hi + (size_t)(wid * 16 + fr) * 1024 + fq * 8;
                const bf16_t* bl = wrt_lo + (size_t)(wid * 16 + fr) * 1024 + fq * 8;
#pragma unroll 1
                for (int k8 = 0; k8 < 4; ++k8) {
                    bf16x8 bhv[8], blv[8];
#pragma unroll
                    for (int kk = 0; kk < 8; ++kk) { bhv[kk] = *(const bf16x8*)(bh + (k8 * 8 + kk) * 32); blv[kk] = *(const bf16x8*)(bl + (k8 * 8 + kk) * 32); }
#pragma unroll
                    for (int kk = 0; kk < 8; ++kk) {
                        const int ko = (k8 * 8 + kk) * 64 + fq * 16;
                        const bf16x8 ah = *(const bf16x8*)(uh + fr * URS + ko), al = *(const bf16x8*)(ulo + fr * URS + ko);
                        lacc = __builtin_amdgcn_mfma_f32_16x16x32_bf16(ah, bhv[kk], lacc, 0, 0, 0);
                        lacc = __builtin_amdgcn_mfma_f32_16x16x32_bf16(al, bhv[kk], lacc, 0, 0, 0);
                        lacc = __builtin_amdgcn_mfma_f32_16x16x32_bf16(ah, blv[kk], lacc, 0, 0, 0);
                    }
                }
#pragma unroll
                for (int j = 0; j < 4; ++j) logit[(fq * 4 + j) * 64 + wid * 16 + fr] = lacc[j];
            }
            __syncthreads();
            float acc[4];
#pragma unroll
            for (int j = 0; j < 4; ++j) acc[j] = logit[(wid * 4 + j) * 64 + lane];
#pragma unroll
            for (int j = 0; j < 4; ++j) {
                const int tl = sb * 16 + wid * 4 + j;
                const float score = 1.f / (1.f + __expf(-acc[j]));
                const float biased = score + ebias;
                const float m1 = group8_max(biased);
                const unsigned long long eq = __ballot(biased == m1);
                const int g = lane >> 3;
                const unsigned gm = (unsigned)(eq >> (g * 8)) & 0xFFu;
                const int first = __ffs((int)gm) - 1;
                const float v2 = ((lane & 7) == first) ? -INFINITY : biased;
                const float m2 = group8_max(v2);
                const float gs = m1 + m2;
                int rg = 0;
#pragma unroll
                for (int g2 = 0; g2 < 8; ++g2) { const float o = __builtin_bit_cast(float, __builtin_amdgcn_readlane(__builtin_bit_cast(int, gs), g2 * 8)); rg += ((o > gs) || (o == gs && g2 < g)) ? 1 : 0; }
                const bool keep = rg < 4;
                const float mk = keep ? biased : -INFINITY;
                int rk = 0;
#pragma unroll
                for (int e2 = 0; e2 < 64; ++e2) { const float o = __builtin_bit_cast(float, __builtin_amdgcn_readlane(__builtin_bit_cast(int, mk), e2)); rk += ((o > mk) || (o == mk && e2 < lane)) ? 1 : 0; }
                const bool sel = keep && (rk < 8);
                const float ssum = wave_sum(sel ? score : 0.f);
                const float wgt = score / ssum * 2.5f;
                const unsigned long long sm = __ballot(sel);
                const int kidx = __popcll(sm & ((1ull << lane) - 1ull));
                if (sel) { wsel[(size_t)(tok0 + tl) * 8 + kidx] = wgt; sel_e[tl * 8 + kidx] = lane; }
            }
            __syncthreads();
        }
        for (int i = tid; i < 512; i += VTHREADS) lpos[i] = atomicAdd(&hist[sel_e[i]], 1);
        __syncthreads();
        if (tid < 64) basep[tid] = (int)atomicAdd(&cnt[tid], (unsigned)hist[tid]);
        __syncthreads();
        for (int i = tid; i < 512; i += VTHREADS) { const int e = sel_e[i], pos = basep[e] + lpos[i]; list[(size_t)e * NTOK + pos] = tok0 * 8 + i; pmap[tok0 * 8 + i] = (e << 16) | pos; }
        __syncthreads();
    }
}

DEVINL void phaseA(KP p, int l, char* lds) {
    const int tid = TID512(), c = blockIdx.x, G = gridDim.x;
    const char* ubuf = (const char*)(p->ws + OFF_UBUF);
    const char* Wt = (const char*)(p->ws + OFF_WIN) + (size_t)l * WIN_ROWS * 1024 * 2;
    bf16_t* P = (bf16_t*)(p->ws + A_P);
    auto sched = [&](int i, GUnit& u) -> bool {
        const long L = unit_linear(i, c, G); if (L >= 128 * 11) return false;
        const int Li = (int)L, sx = Li >> 9, w = (sx == 2) ? 3 : 4, rem = Li - (sx << 9), pm = rem / w, pn = sx * 4 + (rem - pm * w);
        u.A = ubuf + (size_t)pm * 256 * 2048; u.B = Wt + (size_t)pn * 256 * 2048; u.i0 = pm; u.i1 = pn; u.i2 = 0;
        return true;
    };
    auto epi = [&](f32x4 (&acc)[2][2][4][2], const GUnit& u, int wr, int wc, int fr, int fq) {
        asm volatile("" : "+v"(fr), "+v"(fq));
        const int row0 = u.i0 * 256 + wr * 64 + fr, col0 = u.i1 * 256 + wc * 32 + 8 * fq;
#pragma unroll
        for (int ai = 0; ai < 2; ++ai)
#pragma unroll
            for (int m = 0; m < 4; ++m) {
                bf16_t* rowp = P + (size_t)(row0 + ai * 128 + m * 16) * PIN + col0;
#pragma unroll
                for (int bj = 0; bj < 2; ++bj) {
                    if (col0 + bj * 128 < PIN) {
                        const f32x4 v0 = acc[ai][bj][m][0], v1 = acc[ai][bj][m][1];
                        *(uint4*)(rowp + bj * 128) = make_uint4(pack2(v0[0], v0[1]), pack2(v0[2], v0[3]), pack2(v1[0], v1[1]), pack2(v1[2], v1[3]));
                    }
                }
            }
    };
    gemm256<true, false>(lds, 1024, 1024, sched, epi);
}

DEVINL void phaseC(KP p, int l, char* lds) {
    const int tid = TID512(), c = blockIdx.x, G = gridDim.x;
    const char* ymix = (const char*)(p->ws + A_YMIX);
    const char* Wt = (const char*)(p->ws + OFF_WOUT) + (size_t)l * 1024 * 1024 * 2;
    const float* res32 = p->in[I_X];
    const bf16_t* res16 = (const bf16_t*)p->out;
    bf16_t* zbuf = (bf16_t*)(p->ws + M_ZB);
    const float* mod = (const float*)(p->ws + OFF_MOD);
    auto sched = [&](int i, GUnit& u) -> bool {
        const long L = unit_linear(i, c, G); if (L >= 128 * 4) return false;
        const int pm = (int)L >> 2, pn = (int)L & 3;
        u.A = ymix + (size_t)pm * 256 * 2048; u.B = Wt + (size_t)pn * 256 * 2048; u.i0 = pm; u.i1 = pn; u.i2 = 0;
        return true;
    };
    auto epi = [&](f32x4 (&acc)[2][2][4][2], const GUnit& u, int wr, int wc, int fr, int fq) {
        asm volatile("" : "+v"(fr), "+v"(fq));
        const int row0 = u.i0 * 256 + wr * 64 + fr, col0 = u.i1 * 256 + wc * 32 + 8 * fq;
#pragma unroll
        for (int ai = 0; ai < 2; ++ai)
#pragma unroll
            for (int m = 0; m < 4; ++m) {
                const int row = row0 + ai * 128 + m * 16, b = row >> 12;
#pragma unroll
                for (int bj = 0; bj < 2; ++bj) {
                    const int col = col0 + bj * 128;
                    const float4 ga = *(const float4*)(mod + (size_t)(l * 8 + b) * 6144 + 2048 + col), gb = *(const float4*)(mod + (size_t)(l * 8 + b) * 6144 + 2048 + col + 4);
                    float r[8];
                    if (l == 0) {
                        const float4 ra = *(const float4*)(res32 + (size_t)row * DM + col), rb = *(const float4*)(res32 + (size_t)row * DM + col + 4);
                        r[0] = ra.x; r[1] = ra.y; r[2] = ra.z; r[3] = ra.w; r[4] = rb.x; r[5] = rb.y; r[6] = rb.z; r[7] = rb.w;
                    } else {
                        const uint4 rv = *(const uint4*)(res16 + (size_t)row * DM + col);
                        r[0] = __uint_as_float(rv.x << 16); r[1] = __uint_as_float(rv.x & 0xFFFF0000u); r[2] = __uint_as_float(rv.y << 16); r[3] = __uint_as_float(rv.y & 0xFFFF0000u);
                        r[4] = __uint_as_float(rv.z << 16); r[5] = __uint_as_float(rv.z & 0xFFFF0000u); r[6] = __uint_as_float(rv.w << 16); r[7] = __uint_as_float(rv.w & 0xFFFF0000u);
                    }
                    const f32x4 a0 = acc[ai][bj][m][0], a1 = acc[ai][bj][m][1];
                    const float z0 = ALPHA * r[0] + (1.f + ga.x) * a0[0], z1 = ALPHA * r[1] + (1.f + ga.y) * a0[1], z2 = ALPHA * r[2] + (1.f + ga.z) * a0[2], z3 = ALPHA * r[3] + (1.f + ga.w) * a0[3];
                    const float z4 = ALPHA * r[4] + (1.f + gb.x) * a1[0], z5 = ALPHA * r[5] + (1.f + gb.y) * a1[1], z6 = ALPHA * r[6] + (1.f + gb.z) * a1[2], z7 = ALPHA * r[7] + (1.f + gb.w) * a1[3];
                    *(uint4*)(zbuf + (size_t)row * DM + col) = make_uint4(pack2(z0, z1), pack2(z2, z3), pack2(z4, z5), pack2(z6, z7));
                }
            }
    };
    gemm256<true, false>(lds, 1024, 1024, sched, epi);
}

constexpr int DIR_OFF = 131072;
DEVINL void moe_directory(KP p, int l, char* lds) {
    int* pref = (int*)(lds + DIR_OFF);
    int* cntl = (int*)(lds + DIR_OFF + 512);
    unsigned* cnt = (unsigned*)(p->ws + OFF_CNT) + l * 64;
    asm volatile("" : "+s"(cnt));
    if (threadIdx.x == 0) {
        int s = 0;
        int* xpre = (int*)(lds + DIR_OFF + 1024);
        int x = 0;
        for (int e = 0; e < 64; ++e) { const int c = (int)__hip_atomic_load(&cnt[e], __ATOMIC_RELAXED, __HIP_MEMORY_SCOPE_AGENT); cntl[e] = c; pref[e] = s; s += (c + 255) >> 8; xpre[e] = x; x += c; }
        pref[64] = s; cntl[64] = NTOK; pref[65] = s + 128; xpre[64] = x;
    }
    __syncthreads();
    {
        int* m2e = (int*)(lds + DIR_OFF + 2048);
        const int tot = pref[65];
        for (int mg = threadIdx.x; mg < tot; mg += NTHREADS) { int e = 0; while (pref[e + 1] <= mg) ++e; m2e[mg] = e; }
    }
    __syncthreads();
}

DEVINL void phaseE1(KP p, int l, char* lds) {
    const int tid = TID512(), c = blockIdx.x, G = gridDim.x;
    moe_directory(p, l, lds);
    const int* pref = (const int*)(lds + DIR_OFF); const int* cntl = (const int*)(lds + DIR_OFF + 512);
    const char* ubuf = (const char*)(p->ws + OFF_UBUF);
    const int* list = (const int*)(p->ws + M_LIST);
    bf16_t* hbuf = (bf16_t*)(p->ws + M_HBUF);
    const char* W13 = (const char*)(p->ws + OFF_W13) + (size_t)(l * 65) * 512 * 1024 * 2;
    const int total = __builtin_amdgcn_readfirstlane(pref[65]) * 2;
    auto sched = [&](int i, GUnit& u) -> bool {
        const long L = unit_linear(i, c, G); if (L >= total) return false;
        const int mg = (int)L >> 1, nt = (int)L & 1;
        const int e = __builtin_amdgcn_readfirstlane(((const int*)(lds + DIR_OFF + 2048))[mg]);
        const int mt = __builtin_amdgcn_readfirstlane(mg - pref[e]), Me = __builtin_amdgcn_readfirstlane(cntl[e]);
        u.A = ubuf; u.B = W13 + ((size_t)e * 512 + nt * 256) * 2048; u.i0 = mg; u.i1 = nt; u.i2 = e;
        int R[2], C[2]; stage_coords512(TID512(), R, C);
#pragma unroll
        for (int h = 0; h < 2; ++h)
#pragma unroll
            for (int i2 = 0; i2 < 2; ++i2) {
                const int idx = mt * 256 + h * 128 + R[i2]; int tok;
                if (e < 64) tok = (idx < Me) ? (list[(size_t)e * NTOK + idx] >> 3) : 0; else tok = idx;
                u.va[h][i2] = (unsigned)(tok * 1024 + C[i2]) * 2u;
            }
        return true;
    };
    auto epi = [&](f32x4 (&acc)[2][2][4][2], const GUnit& u, int wr, int wc, int fr, int fq) {
        asm volatile("" : "+v"(fr), "+v"(fq));
        const size_t row0 = (size_t)u.i0 * 256 + wr * 64 + fr;
#pragma unroll
        for (int ai = 0; ai < 2; ++ai)
#pragma unroll
            for (int m = 0; m < 4; ++m) {
                bf16_t* rowp = hbuf + (row0 + ai * 128 + m * 16) * 256;
#pragma unroll
                for (int bj = 0; bj < 2; ++bj) {
                    const int hcol = (u.i1 * 8 + bj * 4 + wc) * 16 + 4 * fq;
                    const f32x4 gt = acc[ai][bj][m][0], up = acc[ai][bj][m][1];
                    float hv[4];
#pragma unroll
                    for (int j = 0; j < 4; ++j) hv[j] = gt[j] * sigm(gt[j]) * up[j];
                    uint2 o; o.x = pack2(hv[0], hv[1]); o.y = pack2(hv[2], hv[3]);
                    *(uint2*)(rowp + hcol) = o;
                }
            }
    };
    gemm256<false, true>(lds, 1024, 1024, sched, epi);
}

DEVINL void phaseE2(KP p, int l, char* lds) {
    const int tid = TID512(), c = blockIdx.x, G = gridDim.x;
    moe_directory(p, l, lds);
    const int* pref = (const int*)(lds + DIR_OFF); const int* cntl = (const int*)(lds + DIR_OFF + 512);
    const int* xpre = (const int*)(lds + DIR_OFF + 1024);
    const char* hbuf = (const char*)(p->ws + M_HBUF);
    unsigned char* ybuf = (unsigned char*)(p->ws + M_YBUF);
    const char* W2 = (const char*)(p->ws + OFF_W2) + (size_t)(l * 65) * 1024 * 256 * 2;
    const int total = __builtin_amdgcn_readfirstlane(pref[65]) * 4;
    auto sched = [&](int i, GUnit& u) -> bool {
        const long L = unit_linear(i, c, G); if (L >= total) return false;
        const int mg = (int)L >> 2, nt = (int)L & 3;
        const int e = __builtin_amdgcn_readfirstlane(((const int*)(lds + DIR_OFF + 2048))[mg]);
        u.A = hbuf + (size_t)mg * 256 * 512; u.B = W2 + ((size_t)e * 1024 + nt * 256) * 512; u.i0 = mg; u.i1 = nt; u.i2 = e;
        return true;
    };
    auto epi = [&](f32x4 (&acc)[2][2][4][2], const GUnit& u, int wr, int wc, int fr, int fq) {
        asm volatile("" : "+v"(fr), "+v"(fq));
        const int e = __builtin_amdgcn_readfirstlane(u.i2), mt = __builtin_amdgcn_readfirstlane(u.i0 - pref[e]), Me = __builtin_amdgcn_readfirstlane(cntl[e]);
        const int yrow0 = __builtin_amdgcn_readfirstlane(xpre[e]) + mt * 256;
        const int col0 = u.i1 * 256 + wc * 32 + 8 * fq, loc0 = wr * 64 + fr;
#pragma unroll
        for (int ai = 0; ai < 2; ++ai)
#pragma unroll
            for (int m = 0; m < 4; ++m) {
                const int loc = loc0 + ai * 128 + m * 16;
                if (mt * 256 + loc < Me) {
                    unsigned char* rowp = ybuf + (size_t)(yrow0 + loc) * 1024 + col0;
#pragma unroll
                    for (int bj = 0; bj < 2; ++bj) {
                        const f32x4 v0 = acc[ai][bj][m][0], v1 = acc[ai][bj][m][1];
                        int w0 = __builtin_amdgcn_cvt_pk_fp8_f32(v0[0], v0[1], 0, false); w0 = __builtin_amdgcn_cvt_pk_fp8_f32(v0[2], v0[3], w0, true);
                        int w1 = __builtin_amdgcn_cvt_pk_fp8_f32(v1[0], v1[1], 0, false); w1 = __builtin_amdgcn_cvt_pk_fp8_f32(v1[2], v1[3], w1, true);
                        *(uint2*)(rowp + bj * 128) = make_uint2((unsigned)w0, (unsigned)w1);
                    }
                }
            }
    };
    gemm256<true, false>(lds, 256, 256, sched, epi);
}

DEVINL void phaseF(KP p, int l, const int dry = 0) {
    const int tid = TIDX(), nb = NBV(), blk = BIDX(), wid = tid >> 6, lane = tid & 63;
    const bf16_t* zbuf = (const bf16_t*)(p->ws + M_ZB);
    float* xout = dry ? (float*)(p->ws + M_HBUF) : p->out;
    const unsigned char* ybuf = (const unsigned char*)(p->ws + M_YBUF);
    bf16_t* ubuf = (bf16_t*)(p->ws + OFF_UBUF);
    const float* mod = (const float*)(p->ws + OFF_MOD);
    const int* pmap = (const int*)(p->ws + M_PMAP); const float* wsel = (const float*)(p->ws + M_WSEL);
    const float2* lnstat = (const float2*)(p->ws + M_STAT);
    int xoff;
    {
        const unsigned* cnt = (const unsigned*)(p->ws + OFF_CNT) + l * 64;
        const int c = (int)__hip_atomic_load(&cnt[lane], __ATOMIC_RELAXED, __HIP_MEMORY_SCOPE_AGENT);
        xoff = 0;
#pragma unroll
        for (int j = 0; j < 64; ++j) { const int cj = __builtin_amdgcn_readlane(c, j); xoff += (j < lane) ? cj : 0; }
    }
    int pmn = 0; float wn = 0.f; float2 stn = make_float2(0.f, 0.f);
    {
        const int row = blk * 4 + wid;
        if (row < NTOK) { if (lane < 8) { pmn = pmap[row * 8 + lane]; wn = wsel[row * 8 + lane]; } stn = lnstat[row]; }
    }
    for (int row = blk * 4 + wid; row < NTOK; row += nb * 4) {
        const int b = row >> 12;
        int yr = pmn; const float yw = wn; const float2 st1 = stn;
        {
            const int nrow = row + nb * 4;
            if (nrow < NTOK) { if (lane < 8) { pmn = pmap[nrow * 8 + lane]; wn = wsel[nrow * 8 + lane]; } stn = lnstat[nrow]; }
        }
        { const int e = (yr >> 16) & 63; const int xo = __builtin_amdgcn_ds_bpermute(e << 2, xoff); yr = xo + (yr & 0xFFFF); }
        int yrow[8]; float yww[8];
#pragma unroll
        for (int k = 0; k < 8; ++k) { yrow[k] = __builtin_amdgcn_readlane(yr, k); yww[k] = __builtin_bit_cast(float, __builtin_amdgcn_readlane(__builtin_bit_cast(int, yw), k)); }
        uint2 zvv[4]; int ysh[4]; int yvk[4][8];
#pragma unroll
        for (int i = 0; i < 4; ++i) {
            const int col = i * 256 + lane * 4;
            zvv[i] = *(const uint2*)(zbuf + (size_t)row * DM + col);
            ysh[i] = *(const int*)(ybuf + ((size_t)(262144 + row)) * 1024 + col);
#pragma unroll
            for (int k = 0; k < 8; ++k) yvk[i][k] = *(const int*)(ybuf + (size_t)yrow[k] * 1024 + col);
        }
        float4 z[4]; float s = 0.f;
#pragma unroll
        for (int i = 0; i < 4; ++i) {
            const int col = i * 256 + lane * 4;
            float4 x1;
            { const uint2 zv = zvv[i];
              float4 z1; z1.x = __uint_as_float(zv.x << 16); z1.y = __uint_as_float(zv.x & 0xFFFF0000u); z1.z = __uint_as_float(zv.y << 16); z1.w = __uint_as_float(zv.y & 0xFFFF0000u);
              const float4 g1 = *(const float4*)(p->in[I_LN1G] + l * 1024 + col), b1 = *(const float4*)(p->in[I_LN1B] + l * 1024 + col);
              x1.x = (z1.x - st1.x) * st1.y * g1.x + b1.x; x1.y = (z1.y - st1.x) * st1.y * g1.y + b1.y; x1.z = (z1.z - st1.x) * st1.y * g1.z + b1.z; x1.w = (z1.w - st1.x) * st1.y * g1.w + b1.w; }
            float f0, f1, f2, f3;
            { const int yv = ysh[i];
              const f2_t lo = __builtin_amdgcn_cvt_pk_f32_fp8(yv, false), hi = __builtin_amdgcn_cvt_pk_f32_fp8(yv, true);
              f0 = lo[0]; f1 = lo[1]; f2 = hi[0]; f3 = hi[1]; }
#pragma unroll
            for (int k = 0; k < 8; ++k) {
                const f2_t lo = __builtin_amdgcn_cvt_pk_f32_fp8(yvk[i][k], false), hi = __builtin_amdgcn_cvt_pk_f32_fp8(yvk[i][k], true);
                const float w = yww[k];
                f0 = fmaf(w, lo[0], f0); f1 = fmaf(w, lo[1], f1); f2 = fmaf(w, hi[0], f2); f3 = fmaf(w, hi[1], f3);
            }
            const float4 g2 = *(const float4*)(mod + (size_t)(l * 8 + b) * 6144 + 5120 + col);
            z[i].x = ALPHA * x1.x + (1.f + g2.x) * f0; z[i].y = ALPHA * x1.y + (1.f + g2.y) * f1; z[i].z = ALPHA * x1.z + (1.f + g2.z) * f2; z[i].w = ALPHA * x1.w + (1.f + g2.w) * f3;
            s += z[i].x + z[i].y + z[i].z + z[i].w;
        }
        const float mean = wave_sum(s) * (1.f / 1024.f);
        float q = 0.f;
#pragma unroll
        for (int i = 0; i < 4; ++i) { z[i].x -= mean; z[i].y -= mean; z[i].z -= mean; z[i].w -= mean; q += z[i].x * z[i].x + z[i].y * z[i].y + z[i].z * z[i].z + z[i].w * z[i].w; }
        const float rs = rsqrtf(wave_sum(q) * (1.f / 1024.f) + LN_EPS);
#pragma unroll
        for (int i = 0; i < 4; ++i) {
            const int col = i * 256 + lane * 4;
            const float4 g = *(const float4*)(p->in[I_LN2G] + l * 1024 + col), bb = *(const float4*)(p->in[I_LN2B] + l * 1024 + col);
            float4 x2; x2.x = z[i].x * rs * g.x + bb.x; x2.y = z[i].y * rs * g.y + bb.y; x2.z = z[i].z * rs * g.z + bb.z; x2.w = z[i].w * rs * g.w + bb.w;
            if (l + 1 < DEPTH) { uint2 ox; ox.x = pack2(x2.x, x2.y); ox.y = pack2(x2.z, x2.w); *(uint2*)((bf16_t*)xout + (size_t)row * DM + col) = ox; }
            else *(float4*)(xout + (size_t)row * DM + col) = x2;
            if (l + 1 < DEPTH) {
                const float4 sh = *(const float4*)(mod + (size_t)((l + 1) * 8 + b) * 6144 + col), sc = *(const float4*)(mod + (size_t)((l + 1) * 8 + b) * 6144 + 1024 + col);
                uint2 o; o.x = pack2(x2.x * (1.f + sc.x) + sh.x, x2.y * (1.f + sc.y) + sh.y); o.y = pack2(x2.z * (1.f + sc.z) + sh.z, x2.w * (1.f + sc.w) + sh.w);
                *(uint2*)(ubuf + (size_t)row * DM + col) = o;
            }
        }
    }
}

#define XB_TMO      128
#define XB_XCNT(j)  (256  + 64 * (j))
#define XB_XSUB(j)  (1280 + 64 * (j))
#define XB_XGEN(j)  (2304 + 64 * (j))
#define XB_TOP      3328
#define XB_TOPGEN   3392
#define XCD_BAR_WORDS 3456
#define XB_SPIN_CAP (1u << 20)
DEVINL unsigned xb_ld(unsigned* p)              { return __hip_atomic_load(p, __ATOMIC_RELAXED, __HIP_MEMORY_SCOPE_AGENT); }
DEVINL unsigned xb_add(unsigned* p, unsigned v) { return __hip_atomic_fetch_add(p, v, __ATOMIC_RELAXED, __HIP_MEMORY_SCOPE_AGENT); }
DEVINL unsigned xb_xcc_id() { return (unsigned)__builtin_amdgcn_s_getreg((3 << 11) | 20) & 0xFu; }
#define XB_SPIN(cond, bar) do { unsigned _sp = 0; while (cond) { __builtin_amdgcn_s_sleep(1); \
    if ((++_sp & 255u) == 0u) { if (xb_ld(&(bar)[XB_TMO])) break; if (_sp > XB_SPIN_CAP) { atomicAdd(&(bar)[XB_TMO], 1u); break; } } } } while (0)
struct XcdBarrier { unsigned* bar; unsigned x; volatile LAS unsigned* st; };
DEVINL XcdBarrier xcd_barrier_post(unsigned* bar, volatile LAS unsigned* st) {
    XcdBarrier b; b.bar = bar; b.x = xb_xcc_id(); b.st = st;
    if (threadIdx.x == 0) (void)xb_add(&bar[XB_XCNT(b.x)], 1u);
    return b;
}
DEVINL void xcd_barrier_complete(unsigned* bar, unsigned x, unsigned& nloc, unsigned& nx) {
    const unsigned G = gridDim.x * gridDim.y * gridDim.z;
    unsigned sum, cnt, mine, sp = 0u;
    for (;;) {
        sum = 0u; cnt = 0u; mine = 0u;
#pragma unroll 1
        for (unsigned j = 0; j < 16; ++j) { const unsigned c = xb_ld(&bar[XB_XCNT(j)]); sum += c; cnt += (c > 0u) ? 1u : 0u; mine = (j == x) ? c : mine; }
        if (sum == G) break;
        __builtin_amdgcn_s_sleep(1);
        if ((++sp & 255u) == 0u) { if (xb_ld(&bar[XB_TMO])) break; if (sp > XB_SPIN_CAP) { atomicAdd(&bar[XB_TMO], 1u); break; } }
    }
    nloc = mine > 0u ? mine : 1u; nx = cnt > 0u ? cnt : 1u;
}
DEVINL void xcd_barrier(const XcdBarrier& b) {
    asm volatile("s_waitcnt vmcnt(0)" ::: "memory");
    __syncthreads();
    if (threadIdx.x == 0) {
        unsigned* bar = b.bar;
        __builtin_amdgcn_s_waitcnt(0);
        unsigned nloc = b.st[0], nx = b.st[1];
        if (nloc == 0u) { xcd_barrier_complete(bar, b.x, nloc, nx); b.st[0] = nloc; b.st[1] = nx; }
        const unsigned old = xb_add(&bar[XB_XSUB(b.x)], 1u);
        const unsigned gen = old / nloc;
        if (old + 1u == (gen + 1u) * nloc) {
            __builtin_amdgcn_fence(__ATOMIC_RELEASE, "agent");
            asm volatile("s_waitcnt vmcnt(0)" ::: "memory");
            const unsigned og = xb_add(&bar[XB_TOP], 1u);
            const unsigned tg = og / nx;
            if (og + 1u == (tg + 1u) * nx) xb_add(&bar[XB_TOPGEN], 1u);
            else XB_SPIN(xb_ld(&bar[XB_TOPGEN]) == tg, bar);
            __builtin_amdgcn_fence(__ATOMIC_ACQUIRE, "agent");
            xb_add(&bar[XB_XGEN(b.x)], 1u);
            asm volatile("s_waitcnt vmcnt(0)" ::: "memory");
        } else {
            XB_SPIN(xb_ld(&bar[XB_XGEN(b.x)]) == gen, bar);
            __builtin_amdgcn_fence(__ATOMIC_ACQUIRE, "agent");
            asm volatile("s_waitcnt vmcnt(0)" ::: "memory");
        }
    }
    __syncthreads();
}

constexpr int PPL = 12;
constexpr int NPHASE = 2 + PPL * DEPTH;
#ifndef PROBE_SUB
#define PROBE_SUB 3
#endif
#ifndef PROBE_REP
#define PROBE_REP (-1)
#endif
__global__ void __launch_bounds__(NTHREADS, 2) mega(Params p_arg, int ph_lo, int ph_hi) {
    extern __shared__ __attribute__((aligned(16))) char lds[];
    cg::grid_group grid = cg::this_grid();
    volatile LAS unsigned* st = (volatile LAS unsigned*)(lds + LDS_BYTES - 16);
    if (threadIdx.x == 0) { st[0] = 0u; st[1] = 0u; }
    __syncthreads();
    XcdBarrier xb = xcd_barrier_post((unsigned*)(p_arg.ws + OFF_BAR), st);
    for (int ph = ph_lo; ph < ph_hi; ++ph) {
        KP p = (KP)__builtin_amdgcn_kernarg_segment_ptr();
        asm volatile("" : "+s"(p));
        const int l = (ph >= 2) ? (ph - 2) / PPL : 0;
        const int q = (ph >= 2) ? (ph - 2) % PPL : -1;
        const bool nobar = (q >= 1 && q <= 3);
        const int nrep = (PROBE_REP >= 0 && ph == PROBE_REP) ? 2 : 1;
        for (int rep = 0; rep < nrep; ++rep) {
            const int dry = (PROBE_REP >= 0 && ph == PROBE_REP && rep == 0) ? 1 : 0;
            char* ldsh = lds + (threadIdx.x >> 8) * LDS_HALF;
            if (ph == 0) phase0(p, ldsh);
            else if (ph == 1) phaseF0(p);
            else {
                switch (q) {
                    case 0: phaseA(p, l, lds); break;
                    case 1: phaseB1(p, l, ldsh, 1, (PROBE_REP >= 0 && ph == PROBE_REP && rep == 1) ? PROBE_SUB : 3); break;
                    case 2: phaseB1(p, l, ldsh, 2); break;
                    case 3: phaseB1(p, l, ldsh, 4); break;
                    case 4: phaseB1(p, l, ldsh, 8); break;
                    case 5: phaseB2(p, l, ldsh); break;
                    case 6: phaseB3(p, l); break;
                    case 7: phaseC(p, l, lds); break;
                    case 8: phaseD(p, l, ldsh, dry); break;
                    case 9: phaseE1(p, l, lds); break;
                    case 10: phaseE2(p, l, lds); break;
                    default: phaseF(p, l, dry); break;
                }
            }
            const bool lastrep = (rep + 1 == nrep);
            if (!lastrep || (ph + 1 < ph_hi && !nobar)) { if (lastrep && ph == ph_lo) grid.sync(); else xcd_barrier(xb); }
        }
    }
}

extern "C" void kernel_launch(void* const* d_in, const int* in_sizes, int n_in, void* d_out, int out_size, void* d_ws, size_t ws_size, hipStream_t stream) {
    static int grid_blocks = 0;
    if (grid_blocks == 0) {
        if (n_in != 39 || out_size != NTOK * DM || ws_size < WS_NEED) { fprintf(stderr, "kernel_launch: unexpected shapes (n_in %d out %d ws %zu need %zu)\n", n_in, out_size, ws_size, (size_t)WS_NEED); grid_blocks = -1; return; }
        int dev = 0, cus = 0, per_cu = 0;
        hipGetDevice(&dev);
        hipDeviceGetAttribute(&cus, hipDeviceAttributeMultiprocessorCount, dev);
        hipFuncSetAttribute((const void*)mega, hipFuncAttributeMaxDynamicSharedMemorySize, LDS_BYTES);
        hipOccupancyMaxActiveBlocksPerMultiprocessor(&per_cu, (const void*)mega, NTHREADS, LDS_BYTES);
        if (per_cu < 1) { fprintf(stderr, "kernel_launch: occupancy query returned %d\n", per_cu); grid_blocks = -1; return; }
        if (cus < 256) { fprintf(stderr, "kernel_launch: this build needs 256 CUs (found %d)\n", cus); grid_blocks = -1; return; }
        grid_blocks = 256;
    }
    if (grid_blocks < 0) return;
    if (hipMemsetAsync(d_ws, 0, 32768, stream) != hipSuccess) { fprintf(stderr, "kernel_launch: memset failed\n"); return; }
    Params p{};
    for (int i = 0; i < 39; ++i) p.in[i] = (const float*)d_in[i];
    p.out = (float*)d_out; p.ws = (unsigned char*)d_ws;
    int ph_lo = 0, ph_hi = NPHASE;
    void* args[] = {&p, &ph_lo, &ph_hi};
    hipError_t e = hipLaunchCooperativeKernel((const void*)mega, dim3(grid_blocks), dim3(NTHREADS), args, LDS_BYTES, stream);
    if (e != hipSuccess) fprintf(stderr, "cooperative launch failed: %s (grid %d)\n", hipGetErrorString(e), grid_blocks);
}
```

```cpp
#include <hip/hip_runtime.h>
#include <hip/hip_cooperative_groups.h>
#include <stdio.h>
#include <stdint.h>
namespace cg = cooperative_groups;

typedef unsigned short bf16_t;
typedef short bf16x8 __attribute__((ext_vector_type(8)));
typedef float f32x4 __attribute__((ext_vector_type(4)));
#define DEVINL __device__ __forceinline__
#define LAS __attribute__((address_space(3)))
#define MFMA32(a, b, c) __builtin_amdgcn_mfma_f32_32x32x16_bf16((a), (b), (c), 0, 0, 0)

constexpr int NTOK = 32768, SEQ = 4096, NBATCH = 8, DM = 1024, PIN = 2688, DEPTH = 2;
constexpr int NEXP = 64;
constexpr float ALPHA = 1.41421356237f;
constexpr float LN_EPS = 1e-5f, GN_EPS = 64e-5f;
constexpr int NTHREADS = 512;
constexpr int VTHREADS = 256;
constexpr int LDS_HALF = 75776;
constexpr int LDS_BYTES = 159744;

constexpr size_t OFF_CNT   = 0;
constexpr size_t OFF_BAR   = 4096;
constexpr size_t OFF_MOD   = 65536;
constexpr size_t OFF_WR    = 524288;
constexpr size_t OFF_WIN   = 1048576;
constexpr int WIN_ROWS = 2816;
constexpr size_t OFF_WOUT  = OFF_WIN + 2 * (size_t)WIN_ROWS * 1024 * 2;
constexpr size_t OFF_W13   = OFF_WOUT + 4194304;
constexpr size_t OFF_W2    = OFF_W13 + 136314880;
constexpr size_t OFF_UBUF  = OFF_W2 + 68157440;
constexpr size_t OFF_ARENA = OFF_UBUF + 67108864;
constexpr size_t A_P      = OFF_ARENA;
constexpr size_t A_YMIX   = A_P + 176160768;
constexpr size_t A_SCAN   = A_YMIX + 67108864;
constexpr size_t A_HLOC   = A_SCAN + 134217728;
constexpr size_t A_CUMA   = A_HLOC + 33554432;
constexpr size_t A_G      = A_CUMA + 33554432;
constexpr size_t A_BONUS  = A_G + 33554432;
constexpr size_t A_YRAW   = A_BONUS + 33554432;
constexpr size_t A_CARRYA = A_YRAW + 33554432;
constexpr size_t A_CARRYH = A_CARRYA + 1048576;
constexpr size_t A_HSTART = A_CARRYH + 1048576;
constexpr size_t A_CHAIN  = A_HSTART + 1048576;
constexpr size_t CHAIN_UNIT = 49152;
constexpr size_t M_YBUF   = OFF_ARENA;
constexpr size_t M_ZB     = OFF_ARENA + 335544320;
constexpr size_t M_HBUF   = M_YBUF + 603979776;
constexpr size_t M_LIST   = M_HBUF + 159383552;
constexpr size_t M_WSEL   = M_LIST + 8388608;
constexpr size_t M_PMAP   = M_WSEL + 1048576;
constexpr size_t M_STAT   = M_PMAP + 1048576;
constexpr size_t OFF_WLT  = M_STAT + 262144;
constexpr size_t WS_NEED  = OFF_WLT + 131072;
static_assert(WS_NEED <= (size_t)1 << 30, "workspace layout exceeds the guaranteed 1 GiB");

struct Params {
    const float* in[39];
    float* out;
    unsigned char* ws;
};
typedef const __attribute__((address_space(4))) Params* KP;
__device__ __forceinline__ int TIDX() { int t = threadIdx.x; asm volatile("" : "+v"(t)); t &= 255; return t; }
__device__ __forceinline__ int BIDX() { int b = blockIdx.x * 2 + __builtin_amdgcn_readfirstlane((int)(threadIdx.x >> 8)); asm volatile("" : "+s"(b)); __builtin_assume(b >= 0 && b < 65536); return b; }
__device__ __forceinline__ int NBV() { return gridDim.x * 2; }
__device__ __forceinline__ int TID512() { int t = threadIdx.x; asm volatile("" : "+v"(t)); __builtin_assume(t >= 0 && t < 512); return t; }
enum { I_X = 0, I_C, I_WMOD, I_BMOD, I_WIN, I_WOUT, I_CONVA, I_CONVAB, I_LNAG, I_LNAB, I_CONVB, I_CONVBB, I_WRG, I_BRG, I_WIG, I_BIG,
       I_LAMBDA, I_MUC, I_W0, I_WW2, I_A0, I_WA2, I_WG2, I_KK, I_KA, I_RK, I_GNG, I_GNB, I_CONVD, I_LN1G, I_LN1B, I_WROUTER, I_EBIAS,
       I_W13, I_W2, I_WS13, I_WS2, I_LN2G, I_LN2B };

DEVINL bf16_t f2bf(float f) { unsigned u = __float_as_uint(f); u += 0x7FFFu + ((u >> 16) & 1u); return (bf16_t)(u >> 16); }
DEVINL float bf2f(bf16_t h) { return __uint_as_float(((unsigned)h) << 16); }
typedef __bf16 bf2_t __attribute__((ext_vector_type(2)));
typedef float f2_t __attribute__((ext_vector_type(2)));
typedef float f32x16 __attribute__((ext_vector_type(16)));
DEVINL unsigned pack2(float a, float b) { f2_t v = {a, b}; return __builtin_bit_cast(unsigned, __builtin_convertvector(v, bf2_t)); }
DEVINL float sigm(float x) { return __builtin_amdgcn_rcpf(1.f + __expf(-x)); }
DEVINL float tanh_fast(float x) { const float e = __expf(2.f * x); return 1.f - 2.f * __builtin_amdgcn_rcpf(1.f + e); }
DEVINL float softplusf(float z) { return fmaxf(z, 0.f) + __logf(1.f + __expf(-fabsf(z))); }
DEVINL float softplus_acc(float z) { return fmaxf(z, 0.f) + log1pf(__expf(-fabsf(z))); }
DEVINL float gelu_tanh(float x) { float u = 0.7978845608028654f * (x + 0.044715f * x * x * x); return 0.5f * x * (1.f + tanh_fast(u)); }
DEVINL float group8_max(float x) {
    x = fmaxf(x, __builtin_bit_cast(float, __builtin_amdgcn_update_dpp(0, __builtin_bit_cast(int, x), 0xB1, 0xf, 0xf, true)));
    x = fmaxf(x, __builtin_bit_cast(float, __builtin_amdgcn_update_dpp(0, __builtin_bit_cast(int, x), 0x4E, 0xf, 0xf, true)));
    x = fmaxf(x, __builtin_bit_cast(float, __builtin_amdgcn_update_dpp(0, __builtin_bit_cast(int, x), 0x141, 0xf, 0xf, true)));
    return x;
}
DEVINL float wave_sum_dpp(float x);
DEVINL float wave_sum(float x) { return wave_sum_dpp(x); }
DEVINL float wave_sum_dpp(float x) {
    x += __builtin_bit_cast(float, __builtin_amdgcn_update_dpp(0, __builtin_bit_cast(int, x), 0xB1, 0xf, 0xf, true));
    x += __builtin_bit_cast(float, __builtin_amdgcn_update_dpp(0, __builtin_bit_cast(int, x), 0x4E, 0xf, 0xf, true));
    x += __builtin_bit_cast(float, __builtin_amdgcn_update_dpp(0, __builtin_bit_cast(int, x), 0x141, 0xf, 0xf, true));
    x += __builtin_bit_cast(float, __builtin_amdgcn_update_dpp(0, __builtin_bit_cast(int, x), 0x140, 0xf, 0xf, true));
    x += __builtin_bit_cast(float, __builtin_amdgcn_update_dpp(0, __builtin_bit_cast(int, x), 0x142, 0xa, 0xf, false));
    x += __builtin_bit_cast(float, __builtin_amdgcn_update_dpp(0, __builtin_bit_cast(int, x), 0x143, 0xc, 0xf, false));
    return __builtin_bit_cast(float, __builtin_amdgcn_readlane(__builtin_bit_cast(int, x), 63));
}

DEVINL int lds_byte(int r, int c) { int st = (r >> 4) * 2 + (c >> 5), rr = r & 15, cc = c & 31, ob = rr * 64 + cc * 2; return st * 1024 + (ob ^ (((ob >> 9) & 1) << 5)); }
DEVINL void stage_rc(int b, int& R, int& C) { int st = b / 1024, sb = b % 1024, swz = sb ^ (((sb >> 9) & 1) << 5); R = (st >> 1) * 16 + swz / 64; C = (st & 1) * 32 + (swz % 64) / 2; }

template <class RowPtr, class Epi>
DEVINL void gemm_tile128(char* lds, RowPtr arow, const bf16_t* Bt, int K, Epi epi) {
    const int tid = TIDX();
    const bf16_t* ap[4]; const bf16_t* bp[4];
#pragma unroll
    for (int i = 0; i < 4; ++i) { int R, C; stage_rc(tid * 16 + i * 4096, R, C); ap[i] = arow(R) + C; bp[i] = Bt + (size_t)R * K + C; }
    const int wid = tid >> 6, lane = tid & 63, wr = wid >> 1, wc = wid & 1, fr = lane & 15, fq = lane >> 4;
    f32x4 acc[4][4];
#pragma unroll
    for (int m = 0; m < 4; ++m)
#pragma unroll
        for (int n = 0; n < 4; ++n) acc[m][n] = (f32x4){0.f, 0.f, 0.f, 0.f};
    const int nk = K >> 6;
#pragma unroll
    for (int i = 0; i < 4; ++i) {
        __builtin_amdgcn_global_load_lds((const unsigned*)(ap[i]), (unsigned*)(lds + tid * 16 + i * 4096), 16, 0, 0);
        __builtin_amdgcn_global_load_lds((const unsigned*)(bp[i]), (unsigned*)(lds + 16384 + tid * 16 + i * 4096), 16, 0, 0);
    }
    for (int kt = 0; kt < nk; ++kt) {
        asm volatile("s_waitcnt vmcnt(0)" ::: "memory");
        __syncthreads();
        char* cur = lds + (kt & 1) * 32768;
        if (kt + 1 < nk) {
            char* nxt = lds + ((kt + 1) & 1) * 32768;
            const int ko = (kt + 1) * 64;
#pragma unroll
            for (int i = 0; i < 4; ++i) {
                __builtin_amdgcn_global_load_lds((const unsigned*)(ap[i] + ko), (unsigned*)(nxt + tid * 16 + i * 4096), 16, 0, 0);
                __builtin_amdgcn_global_load_lds((const unsigned*)(bp[i] + ko), (unsigned*)(nxt + 16384 + tid * 16 + i * 4096), 16, 0, 0);
            }
        }
        bf16x8 af[4][2], bfr[4][2];
#pragma unroll
        for (int m = 0; m < 4; ++m)
#pragma unroll
            for (int kk = 0; kk < 2; ++kk) af[m][kk] = *reinterpret_cast<const bf16x8*>(cur + lds_byte(wr * 64 + m * 16 + fr, kk * 32 + fq * 8));
#pragma unroll
        for (int n = 0; n < 4; ++n)
#pragma unroll
            for (int kk = 0; kk < 2; ++kk) bfr[n][kk] = *reinterpret_cast<const bf16x8*>(cur + 16384 + lds_byte(wc * 64 + n * 16 + fr, kk * 32 + fq * 8));
#pragma unroll
        for (int kk = 0; kk < 2; ++kk)
#pragma unroll
            for (int m = 0; m < 4; ++m)
#pragma unroll
                for (int n = 0; n < 4; ++n) acc[m][n] = __builtin_amdgcn_mfma_f32_16x16x32_bf16(bfr[n][kk], af[m][kk], acc[m][n], 0, 0, 0);
    }
    __syncthreads();
    epi(acc, wr, wc, fr, fq);
}

template <class Ptrs, class Epi>
DEVINL void gemm_stream128(char* lds, int K, int blk, int nb, int total, Ptrs ptrs, Epi epi) {
    const int qx = nb >> 3, first = (blk & 7) * qx + (blk >> 3), stride = nb;
    if (first >= total) return;
    const int tid = TIDX();
    const int wid = tid >> 6, lane = tid & 63, wr = wid >> 1, wc = wid & 1, fr = lane & 15, fq = lane >> 4;
    const int nk = K >> 6;
    const bf16_t* ap[4]; const bf16_t* bp[4];
    const bf16_t* an[4]; const bf16_t* bn[4];
    int t = first;
    ptrs(t, ap, bp);
#pragma unroll
    for (int i = 0; i < 4; ++i) {
        __builtin_amdgcn_global_load_lds((const unsigned*)(ap[i]), (unsigned*)(lds + tid * 16 + i * 4096), 16, 0, 0);
        __builtin_amdgcn_global_load_lds((const unsigned*)(bp[i]), (unsigned*)(lds + 16384 + tid * 16 + i * 4096), 16, 0, 0);
    }
    for (;;) {
        const int tn = t + stride;
        const bool has_next = tn < total;
        if (has_next) ptrs(tn, an, bn);
        f32x4 acc[4][4];
#pragma unroll
        for (int m = 0; m < 4; ++m)
#pragma unroll
            for (int n = 0; n < 4; ++n) acc[m][n] = (f32x4){0.f, 0.f, 0.f, 0.f};
        for (int kt = 0; kt < nk; ++kt) {
            asm volatile("s_waitcnt vmcnt(0)" ::: "memory");
            __syncthreads();
            char* cur = lds + (kt & 1) * 32768;
            if (kt + 1 < nk) {
                char* nxt = lds + ((kt + 1) & 1) * 32768;
                const int ko = (kt + 1) * 64;
#pragma unroll
                for (int i = 0; i < 4; ++i) {
                    __builtin_amdgcn_global_load_lds((const unsigned*)(ap[i] + ko), (unsigned*)(nxt + tid * 16 + i * 4096), 16, 0, 0);
                    __builtin_amdgcn_global_load_lds((const unsigned*)(bp[i] + ko), (unsigned*)(nxt + 16384 + tid * 16 + i * 4096), 16, 0, 0);
                }
            } else if (has_next) {
#pragma unroll
                for (int i = 0; i < 4; ++i) {
                    __builtin_amdgcn_global_load_lds((const unsigned*)(an[i]), (unsigned*)(lds + tid * 16 + i * 4096), 16, 0, 0);
                    __builtin_amdgcn_global_load_lds((const unsigned*)(bn[i]), (unsigned*)(lds + 16384 + tid * 16 + i * 4096), 16, 0, 0);
                }
            }
            bf16x8 af[4][2], bfr[4][2];
#pragma unroll
            for (int m = 0; m < 4; ++m)
#pragma unroll
                for (int kk = 0; kk < 2; ++kk) af[m][kk] = *reinterpret_cast<const bf16x8*>(cur + lds_byte(wr * 64 + m * 16 + fr, kk * 32 + fq * 8));
#pragma unroll
            for (int n = 0; n < 4; ++n)
#pragma unroll
                for (int kk = 0; kk < 2; ++kk) bfr[n][kk] = *reinterpret_cast<const bf16x8*>(cur + 16384 + lds_byte(wc * 64 + n * 16 + fr, kk * 32 + fq * 8));
#pragma unroll
            for (int kk = 0; kk < 2; ++kk)
#pragma unroll
                for (int m = 0; m < 4; ++m)
#pragma unroll
                    for (int n = 0; n < 4; ++n) acc[m][n] = __builtin_amdgcn_mfma_f32_16x16x32_bf16(bfr[n][kk], af[m][kk], acc[m][n], 0, 0, 0);
        }
        epi(t, acc, wr, wc, fr, fq);
        if (!has_next) break;
        t = tn;
#pragma unroll
        for (int i = 0; i < 4; ++i) { ap[i] = an[i]; bp[i] = bn[i]; }
    }
    __syncthreads();
}
DEVINL void stage_coords(int (&R)[4], int (&C)[4]) {
    const int tid = TIDX();
#pragma unroll
    for (int i = 0; i < 4; ++i) stage_rc(tid * 16 + i * 4096, R[i], C[i]);
}

struct GUnit {
    const char* A;
    const char* B;
    unsigned va[2][2] = {{0u, 0u}, {0u, 0u}};
    int i0, i1, i2;
};
constexpr int G_HTB = 128 * 64 * 2;
constexpr int G_STAGE_BYTES = 8 * G_HTB;
DEVINL int perm32(int rho) { const int n = rho >> 4, i = rho & 15; return 8 * (i >> 2) + 4 * n + (i & 3); }
DEVINL void stage_coords512(int tid, int (&R)[2], int (&C)[2]) {
#pragma unroll
    for (int i = 0; i < 2; ++i) stage_rc(tid * 16 + i * 8192, R[i], C[i]);
}

template <bool PERM, bool GATHER, class Sched, class Epi>
DEVINL void gemm256(char* lds_generic, int K, int lda, Sched sched, Epi epi) {
    LAS unsigned char* lds = (LAS unsigned char*)lds_generic;
    const int tid = TID512(), wid = __builtin_amdgcn_readfirstlane(tid >> 6), lane = tid & 63, wr = wid >> 2, wc = wid & 3, fr = lane & 15, fq = lane >> 4;
    const int nt = K / 64;
    unsigned voffB[2];
#pragma unroll
    for (int i = 0; i < 2; ++i) { int R, C; stage_rc(tid * 16 + i * 8192, R, C); const int Rb = PERM ? ((R & ~31) + perm32(R & 31)) : R; voffB[i] = (unsigned)(Rb * K + C) * 2u; }
    unsigned voffA[2];
#pragma unroll
    for (int i = 0; i < 2; ++i) { int R, C; stage_rc(tid * 16 + i * 8192, R, C); voffA[i] = (unsigned)(R * lda + C) * 2u; }
    const size_t hstepA = GATHER ? 0 : (size_t)128 * lda * 2;
    const size_t kstep = (size_t)(64 * 2);
    const size_t hstepB = (size_t)128 * K * 2;
    const unsigned ldsw = (unsigned)wid * 1024u;
    const int aoff = lds_byte(wr * 64 + fr, fq * 8), boff = lds_byte(wc * 32 + fr, fq * 8);
#define G_SA(b, h) (((b) * 2 + (h)) * G_HTB)
#define G_SB(b, h) ((4 + (b) * 2 + (h)) * G_HTB)
#define G_STAGE(bufoff, gbase, voff) do { _Pragma("unroll") for (int _i = 0; _i < 2; ++_i) { unsigned _vo = (voff)[_i]; asm volatile("" : "+v"(_vo)); \
        __builtin_amdgcn_global_load_lds((const unsigned*)((const char*)(gbase) + _vo), (LAS unsigned*)(lds + (bufoff) + ldsw + _i * 8192), 16, 0, 0); } } while (0)
#define G_STAGE_A(bufoff, ptr, vg, h) do { if constexpr (GATHER) { G_STAGE(bufoff, ptr, vg); } else { G_STAGE(bufoff, (ptr) + (h) * hstepA, voffA); } } while (0)
#define G_LDA(dst, b, h) do { _Pragma("unroll") for (int m = 0; m < 4; ++m) _Pragma("unroll") for (int k = 0; k < 2; ++k) dst[m][k] = *(const LAS bf16x8*)(lds + G_SA(b, h) + aoff + m * 2048 + k * 1024); } while (0)
#define G_LDB(dst, b, h) do { _Pragma("unroll") for (int n = 0; n < 2; ++n) _Pragma("unroll") for (int k = 0; k < 2; ++k) dst[n][k] = *(const LAS bf16x8*)(lds + G_SB(b, h) + boff + n * 2048 + k * 1024); } while (0)
#define G_MMA(ai, bj, At, Bt) do { __builtin_amdgcn_s_setprio(1); _Pragma("unroll") for (int m = 0; m < 4; ++m) _Pragma("unroll") for (int n = 0; n < 2; ++n) _Pragma("unroll") for (int k = 0; k < 2; ++k) \
        acc[ai][bj][m][n] = __builtin_amdgcn_mfma_f32_16x16x32_bf16(Bt[n][k], At[m][k], acc[ai][bj][m][n], 0, 0, 0); __builtin_amdgcn_s_setprio(0); } while (0)
#define G_WAIT_V(n) asm volatile("s_waitcnt vmcnt(" #n ")" ::: "memory")
#define G_WAIT_L(n) asm volatile("s_waitcnt lgkmcnt(" #n ")" ::: "memory")
#define G_BAR __builtin_amdgcn_s_barrier()
#define G_SCHED __builtin_amdgcn_sched_barrier(0)
    GUnit cur, nxt; int ui = 0;
    if (!sched(0, cur)) return;
    LAS unsigned* vst = (LAS unsigned*)(lds + 131072 + 8192) + tid * 8;
    if constexpr (GATHER) { vst[0] = cur.va[0][0]; vst[1] = cur.va[0][1]; vst[2] = cur.va[1][0]; vst[3] = cur.va[1][1]; }
    f32x4 acc[2][2][4][2];
#pragma unroll
    for (int a = 0; a < 2; ++a)
#pragma unroll
        for (int b = 0; b < 2; ++b)
#pragma unroll
            for (int m = 0; m < 4; ++m)
#pragma unroll
                for (int n = 0; n < 2; ++n) acc[a][b][m][n] = (f32x4){0.f, 0.f, 0.f, 0.f};
    bf16x8 At[4][2], B0[2][2], B1[2][2];
    G_STAGE(G_SB(0, 0), cur.B, voffB); G_STAGE_A(G_SA(0, 0), cur.A, cur.va[0], 0); G_STAGE(G_SB(0, 1), cur.B + hstepB, voffB); G_STAGE_A(G_SA(0, 1), cur.A, cur.va[1], 1);
    if (wr == 1) G_BAR;
    G_WAIT_V(4); G_BAR;
    G_STAGE(G_SB(1, 0), cur.B + kstep, voffB); G_STAGE_A(G_SA(1, 0), cur.A + kstep, cur.va[0], 0); G_STAGE(G_SB(1, 1), cur.B + hstepB + kstep, voffB);
    G_WAIT_V(6); G_BAR;
    for (;;) {
        const bool has_next = sched(ui + 1, nxt);
        if (!has_next) nxt = cur;
        if constexpr (GATHER) { LAS unsigned* vn = vst + ((ui + 1) & 1) * 4; vn[0] = nxt.va[0][0]; vn[1] = nxt.va[0][1]; vn[2] = nxt.va[1][0]; vn[3] = nxt.va[1][1]; }
        for (int t = 0; t < nt; t += 2) {
            const bool last = (t == nt - 2);
            const char* a1 = cur.A + (size_t)(t + 1) * kstep;
            const char* a2 = last ? nxt.A : cur.A + (size_t)(t + 2) * kstep; const char* b2 = last ? nxt.B : cur.B + (size_t)(t + 2) * kstep;
            const char* a3 = a2 + kstep; const char* b3 = b2 + kstep;
            G_LDB(B0, 0, 0); G_SCHED; G_LDA(At, 0, 0); { unsigned nv[2] = {0u, 0u}; if constexpr (GATHER) { LAS unsigned* q_ = vst + (ui & 1) * 4; nv[0] = q_[2]; nv[1] = q_[3]; } G_STAGE_A(G_SA(1, 1), a1, nv, 1); }
            G_WAIT_L(8); G_BAR; G_WAIT_L(0); G_MMA(0, 0, At, B0); G_BAR; G_SCHED;
            G_LDB(B1, 0, 1); G_STAGE(G_SB(0, 0), b2, voffB);
            G_BAR; G_WAIT_L(0); G_MMA(0, 1, At, B1); G_BAR;
            G_LDA(At, 0, 1); { unsigned nv[2] = {0u, 0u}; if constexpr (GATHER) { LAS unsigned* q_ = vst + ((ui + (last ? 1 : 0)) & 1) * 4; nv[0] = q_[0]; nv[1] = q_[1]; } G_STAGE_A(G_SA(0, 0), a2, nv, 0); }
            G_BAR; G_WAIT_L(0); G_MMA(1, 0, At, B0); G_BAR; G_SCHED;
            G_STAGE(G_SB(0, 1), b2 + hstepB, voffB);
            G_WAIT_V(6); G_BAR; G_MMA(1, 1, At, B1); G_BAR;
            G_LDB(B0, 1, 0); G_SCHED; G_LDA(At, 1, 0); { unsigned nv[2] = {0u, 0u}; if constexpr (GATHER) { LAS unsigned* q_ = vst + ((ui + (last ? 1 : 0)) & 1) * 4; nv[0] = q_[2]; nv[1] = q_[3]; } G_STAGE_A(G_SA(0, 1), a2, nv, 1); }
            G_WAIT_L(8); G_BAR; G_WAIT_L(0); G_MMA(0, 0, At, B0); G_BAR; G_SCHED;
            G_LDB(B1, 1, 1); G_STAGE(G_SB(1, 0), b3, voffB);
            G_BAR; G_WAIT_L(0); G_MMA(0, 1, At, B1); G_BAR;
            G_LDA(At, 1, 1); { unsigned nv[2] = {0u, 0u}; if constexpr (GATHER) { LAS unsigned* q_ = vst + ((ui + (last ? 1 : 0)) & 1) * 4; nv[0] = q_[0]; nv[1] = q_[1]; } G_STAGE_A(G_SA(1, 0), a3, nv, 0); }
            G_BAR; G_WAIT_L(0); G_MMA(1, 0, At, B0); G_BAR; G_SCHED;
            G_STAGE(G_SB(1, 1), b3 + hstepB, voffB);
            G_WAIT_V(6); G_BAR; G_MMA(1, 1, At, B1); G_BAR;
        }
        { const int l2 = TID512() & 63; epi(acc, cur, wr, wc, l2 & 15, l2 >> 4); }
        if (!has_next) break;
#pragma unroll
        for (int a = 0; a < 2; ++a)
#pragma unroll
            for (int b = 0; b < 2; ++b)
#pragma unroll
                for (int m = 0; m < 4; ++m)
#pragma unroll
                    for (int n = 0; n < 2; ++n) acc[a][b][m][n] = (f32x4){0.f, 0.f, 0.f, 0.f};
        cur = nxt; ++ui;
    }
    G_WAIT_V(0);
    if (wr == 0) G_BAR;
    G_BAR;
#undef G_SA
#undef G_STAGE_A
#undef G_SB
#undef G_STAGE
#undef G_LDA
#undef G_LDB
#undef G_MMA
#undef G_WAIT_V
#undef G_WAIT_L
#undef G_BAR
#undef G_SCHED
}
DEVINL long unit_linear(int i, int c, int G) { const int q = G >> 3; return ((long)i * 8 + (c & 7)) * q + (c >> 3); }

constexpr int CONV_PER_L = 672 + 256 + 8320 + 4160;
struct ConvJob { const float* src; bf16_t* dst; int K, ld, k0, r0, perm; };
DEVINL ConvJob conv_decode(KP p, int id) {
    ConvJob j; const int l = id / CONV_PER_L; int r = id % CONV_PER_L; int kt, nt;
    if (r < 672) { j.src = p->in[I_WIN] + (size_t)l * 1024 * 2688; j.K = 1024; j.ld = 2688; j.perm = 0; j.dst = (bf16_t*)(p->ws + OFF_WIN) + (size_t)l * WIN_ROWS * 1024; nt = r % 42; kt = r / 42; }
    else if (r < 928) { r -= 672; j.src = p->in[I_WOUT] + (size_t)l * 1024 * 1024; j.K = 1024; j.ld = 1024; j.perm = 0; j.dst = (bf16_t*)(p->ws + OFF_WOUT) + (size_t)l * 1024 * 1024; nt = r & 15; kt = r >> 4; }
    else if (r < 928 + 8320) { r -= 928; const int e = r >> 7, q = r & 127; nt = q & 7; kt = q >> 3; j.K = 1024; j.ld = 512; j.perm = 1;
        j.src = (e < 64) ? p->in[I_W13] + (size_t)(l * 64 + e) * 1024 * 512 : p->in[I_WS13] + (size_t)l * 1024 * 512;
        j.dst = (bf16_t*)(p->ws + OFF_W13) + (size_t)(l * 65 + e) * 512 * 1024; }
    else { r -= 9248; const int e = r >> 6, q = r & 63; nt = q & 15; kt = q >> 4; j.K = 256; j.ld = 1024; j.perm = 0;
        j.src = (e < 64) ? p->in[I_W2] + (size_t)(l * 64 + e) * 256 * 1024 : p->in[I_WS2] + (size_t)l * 256 * 1024;
        j.dst = (bf16_t*)(p->ws + OFF_W2) + (size_t)(l * 65 + e) * 1024 * 256; }
    j.k0 = kt * 64; j.r0 = nt * 64; return j;
}
DEVINL void conv_issue(const ConvJob& j, char* buf, int tid) {
    const int nn = tid & 63, drow = j.r0 + nn;
    int scol = drow;
    if (j.perm) { const int g = drow >> 5, i = drow & 31; scol = (i < 16) ? (g * 16 + i) : (256 + g * 16 + (i - 16)); }
    const float* sp = j.src + (size_t)j.k0 * j.ld + scol;
#pragma unroll
    for (int q = 0; q < 16; ++q) { const int kk = (tid >> 6) + 4 * q;
        __builtin_amdgcn_global_load_lds((const unsigned*)(sp + (size_t)kk * j.ld), (unsigned*)(buf + kk * 260 + nn * 4), 4, 0, 0); }
}
DEVINL void convert_ids(KP p, char* lds, int id_lo, int id_hi, int wb, int nwb) {
    const int tid = TIDX();
    const int n = (id_hi - id_lo + nwb - 1) / nwb;
    auto idof = [&](int i) { const int id = id_lo + i * nwb + wb; return (id < id_hi) ? id : id_hi - 1; };
    ConvJob j0 = conv_decode(p, idof(0)), j1 = conv_decode(p, idof(n > 1 ? 1 : 0));
    conv_issue(j0, lds, tid);
    conv_issue(j1, lds + 16640, tid);
    bf16_t* d0 = j0.dst + (size_t)j0.r0 * j0.K + j0.k0; int K0 = j0.K;
    bf16_t* d1 = j1.dst + (size_t)j1.r0 * j1.K + j1.k0; int K1 = j1.K;
    for (int i = 0; i < n; ++i) {
        const ConvJob j2 = conv_decode(p, idof(i + 2 < n ? i + 2 : n - 1));
        conv_issue(j2, lds + ((i + 2) % 3) * 16640, tid);
        asm volatile("s_waitcnt vmcnt(32)" ::: "memory");
        __builtin_amdgcn_s_barrier();
        const float* tile = (const float*)(lds + (i % 3) * 16640);
        {
            const int kp = (tid & 31) * 2;
#pragma unroll
            for (int q = 0; q < 8; ++q) { const int rr = (tid >> 5) + 8 * q;
                *(unsigned*)(d0 + (size_t)rr * K0 + kp) = pack2(tile[kp * 65 + rr], tile[(kp + 1) * 65 + rr]); }
        }
        asm volatile("s_waitcnt lgkmcnt(0)" ::: "memory");
        __builtin_amdgcn_s_barrier();
        d0 = d1; K0 = K1; d1 = j2.dst + (size_t)j2.r0 * j2.K + j2.k0; K1 = j2.K;
    }
    asm volatile("s_waitcnt vmcnt(0)" ::: "memory");
    __syncthreads();
}

DEVINL void phase0(KP p, char* lds) {
    const int tid = TIDX(), nb = NBV(), blk = BIDX();
    if (blk == 0 && tid < 128) ((unsigned*)(p->ws + OFF_CNT))[tid] = 0u;
    if (blk < 192) {
        float* sc = (float*)lds;
        float* part = (float*)(lds + 32768);
        for (int i = tid; i < 8192; i += VTHREADS) { float c = p->in[I_C][i]; sc[i] = c * sigm(c); }
        __syncthreads();
        const int cl = tid & 63, ks = tid >> 6, n = blk * 64 + cl, l = n / 6144, nn = n % 6144;
        const float* w = p->in[I_WMOD] + (size_t)l * 1024 * 6144 + (size_t)(ks * 256) * 6144 + nn;
        float acc[8];
#pragma unroll
        for (int b = 0; b < 8; ++b) acc[b] = 0.f;
#pragma unroll 32
        for (int k = 0; k < 256; ++k) {
            const float wv = w[(size_t)k * 6144];
#pragma unroll
            for (int b = 0; b < 8; ++b) acc[b] = fmaf(sc[b * 1024 + ks * 256 + k], wv, acc[b]);
        }
#pragma unroll
        for (int b = 0; b < 8; ++b) part[(ks * 8 + b) * 64 + cl] = acc[b];
        __syncthreads();
        if (tid < 64) {
            const float bm = p->in[I_BMOD][l * 6144 + nn];
            float* mod = (float*)(p->ws + OFF_MOD);
#pragma unroll
            for (int b = 0; b < 8; ++b) mod[(size_t)(l * 8 + b) * 6144 + nn] = part[(0 * 8 + b) * 64 + cl] + part[(1 * 8 + b) * 64 + cl] + part[(2 * 8 + b) * 64 + cl] + part[(3 * 8 + b) * 64 + cl] + bm;
        }
        __syncthreads();
    }
    if (blk >= 256 && blk < 320) {
        bf16_t* wlt = (bf16_t*)(p->ws + OFF_WLT);
#pragma unroll
        for (int j = 0; j < 4; ++j) {
            const int idx = (blk - 256) * 1024 + j * 256 + tid, l2 = idx >> 15, f = (idx >> 8) & 127, c = idx & 255;
            const float w = (f < 32) ? p->in[I_WW2][(size_t)(l2 * 32 + f) * 256 + c] : ((f < 64) ? p->in[I_WA2][(size_t)(l2 * 32 + f - 32) * 256 + c] : p->in[I_WG2][(size_t)(l2 * 64 + f - 64) * 256 + c]);
            wlt[(size_t)(l2 * 256 + c) * 128 + f] = f2bf(w);
        }
    }
    if (blk >= 192 && blk < 256) {
        bf16_t* wrt = (bf16_t*)(p->ws + OFF_WR);
#pragma unroll
        for (int j = 0; j < 8; ++j) {
            const int idx = (blk - 192) * 2048 + j * 256 + tid, l2 = idx >> 16, rem = idx & 65535, k = rem >> 6, e = rem & 63;
            const float w = p->in[I_WROUTER][idx];
            const bf16_t hi = f2bf(w); const bf16_t lo = f2bf(w - bf2f(hi));
            wrt[(size_t)((l2 * 2 + 0) * 64 + e) * 1024 + k] = hi; wrt[(size_t)((l2 * 2 + 1) * 64 + e) * 1024 + k] = lo;
        }
    }
    convert_ids(p, lds, 0, 2 * CONV_PER_L, blk, nb);
}

DEVINL void phaseF0(KP p) {
    const int tid = TIDX(), nb = NBV(), blk = BIDX();
    const float* mod = (const float*)(p->ws + OFF_MOD);
    bf16_t* ubuf = (bf16_t*)(p->ws + OFF_UBUF);
    const int col = tid * 4;
    for (int row0 = blk * 8; row0 < NTOK; row0 += nb * 8) {
        float4 x[8];
#pragma unroll
        for (int u = 0; u < 8; ++u) x[u] = *(const float4*)(p->in[I_X] + (size_t)(row0 + u) * DM + col);
        const int b = row0 >> 12;
        const float4 sh = *(const float4*)(mod + (size_t)b * 6144 + col);
        const float4 sc = *(const float4*)(mod + (size_t)b * 6144 + 1024 + col);
#pragma unroll
        for (int u = 0; u < 8; ++u) {
            uint2 o; o.x = pack2(x[u].x * (1.f + sc.x) + sh.x, x[u].y * (1.f + sc.y) + sh.y); o.y = pack2(x[u].z * (1.f + sc.z) + sh.z, x[u].w * (1.f + sc.w) + sh.w);
            *(uint2*)(ubuf + (size_t)(row0 + u) * DM + col) = o;
        }
    }
}

DEVINL void b1_conformer(KP p, int l, char* lds, int item) {
    const int tid = TIDX(), b = item >> 7, tt = item & 127, t0 = tt * 32, rowbase = b * SEQ;
    const bf16_t* P = (const bf16_t*)(p->ws + A_P);
    bf16_t* ymix = (bf16_t*)(p->ws + A_YMIX);
    float w[31];
#pragma unroll
    for (int k = 0; k < 31; ++k) w[k] = p->in[I_CONVA][(size_t)(l * 31 + k) * 256 + tid];
    float acc[32];
    const float bias = p->in[I_CONVAB][l * 256 + tid];
#pragma unroll
    for (int j = 0; j < 32; ++j) acc[j] = bias;
#pragma unroll
    for (int rr = 0; rr < 62; ++rr) {
        const int t = t0 - 30 + rr;
        const bf16_t* pr = P + ((long)(rowbase + t0 - 30) * PIN + tid) + (long)rr * PIN;
        const float val = bf2f(pr[0]), gate = bf2f(pr[256]);
        const float h = (t >= 0) ? val * sigm(gate) : 0.f;
#pragma unroll
        for (int j = 0; j < 32; ++j) { const int k = rr - j; if (k >= 0 && k <= 30) acc[j] = fmaf(w[k], h, acc[j]); }
    }
    float* outb = (float*)lds;
#pragma unroll
    for (int j = 0; j < 32; ++j) outb[j * 256 + tid] = acc[j];
    __syncthreads();
    const int wid = tid >> 6, lane = tid & 63;
    const float4 g4 = *(const float4*)(p->in[I_LNAG] + l * 256 + lane * 4), b4 = *(const float4*)(p->in[I_LNAB] + l * 256 + lane * 4);
    for (int j = wid; j < 32; j += 4) {
        const float4 v = *(const float4*)(outb + j * 256 + lane * 4);
        const float mean = wave_sum(v.x + v.y + v.z + v.w) * (1.f / 256.f);
        const float d0 = v.x - mean, d1 = v.y - mean, d2 = v.z - mean, d3 = v.w - mean;
        const float var = wave_sum(d0 * d0 + d1 * d1 + d2 * d2 + d3 * d3) * (1.f / 256.f);
        const float rs = rsqrtf(var + LN_EPS);
        float y0 = d0 * rs * g4.x + b4.x, y1 = d1 * rs * g4.y + b4.y, y2 = d2 * rs * g4.z + b4.z, y3 = d3 * rs * g4.w + b4.w;
        y0 *= sigm(y0); y1 *= sigm(y1); y2 *= sigm(y2); y3 *= sigm(y3);
        uint2 o; o.x = pack2(y0, y1); o.y = pack2(y2, y3);
        *(uint2*)(ymix + (size_t)(rowbase + t0 + j) * DM + lane * 4) = o;
    }
    __syncthreads();
}

DEVINL void b1_shortconv(KP p, int l, int item) {
    const int tid = TIDX(), cg = tid & 31, tl = tid >> 5, b = item >> 6, t0 = (item & 63) * 64 + tl * 8, rowbase = b * SEQ;
    const bf16_t* P = (const bf16_t*)(p->ws + A_P);
    bf16_t* ymix = (bf16_t*)(p->ws + A_YMIX);
    float w0[8], w1[8], w2[8];
#pragma unroll
    for (int e = 0; e < 8; ++e) { w0[e] = p->in[I_CONVD][(l * 3 + 0) * 256 + cg * 8 + e]; w1[e] = p->in[I_CONVD][(l * 3 + 1) * 256 + cg * 8 + e]; w2[e] = p->in[I_CONVD][(l * 3 + 2) * 256 + cg * 8 + e]; }
    uint4 gbv[8], gcv[10], hdv[10];
#pragma unroll
    for (int u = 0; u < 10; ++u) {
        const int t = t0 - 2 + u;
        const bf16_t* a = P + (size_t)(rowbase + (t >= 0 ? t : 0)) * PIN + 1920 + cg * 8;
        gcv[u] = *(const uint4*)(a + 256); hdv[u] = *(const uint4*)(a + 512);
        if (u >= 2) gbv[u - 2] = *(const uint4*)(a);
    }
    float q2[8], q1[8];
#pragma unroll
    for (int u = 0; u < 10; ++u) {
        const int t = t0 - 2 + u;
        const unsigned gcw[4] = {gcv[u].x, gcv[u].y, gcv[u].z, gcv[u].w}, hdw[4] = {hdv[u].x, hdv[u].y, hdv[u].z, hdv[u].w};
        float q0[8];
#pragma unroll
        for (int e = 0; e < 4; ++e) {
            q0[2 * e] = __uint_as_float(gcw[e] << 16) * __uint_as_float(hdw[e] << 16);
            q0[2 * e + 1] = __uint_as_float(gcw[e] & 0xFFFF0000u) * __uint_as_float(hdw[e] & 0xFFFF0000u);
        }
        if (t < 0) {
#pragma unroll
            for (int e = 0; e < 8; ++e) q0[e] = 0.f;
        }
        if (u >= 2) {
            const unsigned gbw[4] = {gbv[u - 2].x, gbv[u - 2].y, gbv[u - 2].z, gbv[u - 2].w};
            float y[8];
#pragma unroll
            for (int e = 0; e < 4; ++e) {
                y[2 * e] = __uint_as_float(gbw[e] << 16) * (w0[2 * e] * q2[2 * e] + w1[2 * e] * q1[2 * e] + w2[2 * e] * q0[2 * e]);
                y[2 * e + 1] = __uint_as_float(gbw[e] & 0xFFFF0000u) * (w0[2 * e + 1] * q2[2 * e + 1] + w1[2 * e + 1] * q1[2 * e + 1] + w2[2 * e + 1] * q0[2 * e + 1]);
            }
            *(uint4*)(ymix + (size_t)(rowbase + t) * DM + 768 + cg * 8) = make_uint4(pack2(y[0], y[1]), pack2(y[2], y[3]), pack2(y[4], y[5]), pack2(y[6], y[7]));
        }
#pragma unroll
        for (int e = 0; e < 8; ++e) { q2[e] = (u >= 1) ? q1[e] : 0.f; q1[e] = q0[e]; }
    }
}

DEVINL void b1_lru(KP p, int l, char* lds, int item) {
    const int c = TIDX(), b = item >> 7, tt = item & 127, t0 = tt * 32, rowbase = b * SEQ;
    const int h = c >> 6, lane = c & 63;
    const bf16_t* P = (const bf16_t*)(p->ws + A_P);
    float* uT = (float*)lds;
    {
        const float cb0 = p->in[I_CONVB][(l * 4 + 0) * 256 + c], cb1 = p->in[I_CONVB][(l * 4 + 1) * 256 + c], cb2 = p->in[I_CONVB][(l * 4 + 2) * 256 + c], cb3 = p->in[I_CONVB][(l * 4 + 3) * 256 + c];
        const float bias = p->in[I_CONVBB][l * 256 + c];
        float xm3 = 0.f, xm2 = 0.f, xm1 = 0.f;
        if (t0 >= 3) { const bf16_t* a = P + (size_t)(rowbase + t0 - 3) * PIN + 512 + c; xm3 = bf2f(a[0]); xm2 = bf2f(a[PIN]); xm1 = bf2f(a[2 * PIN]); }
        bf16_t xr[32];
#pragma unroll
        for (int j = 0; j < 32; ++j) xr[j] = P[(size_t)(rowbase + t0 + j) * PIN + 512 + c];
#pragma unroll
        for (int j = 0; j < 32; ++j) {
            const float x0 = bf2f(xr[j]);
            uT[c * 36 + j] = cb0 * xm3 + cb1 * xm2 + cb2 * xm1 + cb3 * x0 + bias;
            xm3 = xm2; xm2 = xm1; xm1 = x0;
        }
    }
    __syncthreads();
    const float brg = p->in[I_BRG][l * 256 + c], big = p->in[I_BIG][l * 256 + c];
    const float sp = softplus_acc(-p->in[I_LAMBDA][l * 256 + c]);
    unsigned* hcbuf = (unsigned*)(p->ws + A_HLOC);
    const float* wrg = p->in[I_WRG] + (size_t)((l * 4 + h) * 64) * 64 + lane;
    const float* wig = p->in[I_WIG] + (size_t)((l * 4 + h) * 64) * 64 + lane;
    float hs = 0.f, cA = 1.f;
#pragma unroll 1
    for (int half = 0; half < 2; ++half) {
        float ar[16], ai[16];
#pragma unroll
        for (int j = 0; j < 16; ++j) { ar[j] = 0.f; ai[j] = 0.f; }
#pragma unroll 1
        for (int dh = 0; dh < 4; ++dh) {
            float wrv[16], wiv[16];
#pragma unroll
            for (int d = 0; d < 16; ++d) { wrv[d] = wrg[(dh * 16 + d) * 64]; wiv[d] = wig[(dh * 16 + d) * 64]; }
#pragma unroll
            for (int d = 0; d < 16; ++d) {
                const float wr = wrv[d], wi = wiv[d];
                const float4* up = (const float4*)(uT + (h * 64 + dh * 16 + d) * 36 + half * 16);
#pragma unroll
                for (int jj = 0; jj < 4; ++jj) {
                    const float4 u4 = up[jj];
                    ar[4 * jj + 0] = fmaf(u4.x, wr, ar[4 * jj + 0]); ai[4 * jj + 0] = fmaf(u4.x, wi, ai[4 * jj + 0]);
                    ar[4 * jj + 1] = fmaf(u4.y, wr, ar[4 * jj + 1]); ai[4 * jj + 1] = fmaf(u4.y, wi, ai[4 * jj + 1]);
                    ar[4 * jj + 2] = fmaf(u4.z, wr, ar[4 * jj + 2]); ai[4 * jj + 2] = fmaf(u4.z, wi, ai[4 * jj + 2]);
                    ar[4 * jj + 3] = fmaf(u4.w, wr, ar[4 * jj + 3]); ai[4 * jj + 3] = fmaf(u4.w, wi, ai[4 * jj + 3]);
                }
            }
        }
        float ureg[16];
#pragma unroll
        for (int jj = 0; jj < 4; ++jj) { const float4 u4 = *(const float4*)(uT + c * 36 + half * 16 + 4 * jj); ureg[4 * jj] = u4.x; ureg[4 * jj + 1] = u4.y; ureg[4 * jj + 2] = u4.z; ureg[4 * jj + 3] = u4.w; }
        unsigned* hp = hcbuf + (size_t)(rowbase + t0 + half * 16) * 256 + c;
#pragma unroll
        for (int j = 0; j < 16; ++j) {
            const float r = sigm(ar[j] + brg), ig = sigm(ai[j] + big);
            const float log_a = -8.0f * r * sp;
            const float a = __expf(log_a);
            const float mult = sqrtf(fmaxf(1.f - a * a, 0.f));
            const float bx = mult * (ig * ureg[j]);
            hs = fmaf(a, hs, bx); cA *= a;
            hp[j * 256] = pack2(hs, cA);
        }
    }
    ((float*)(p->ws + A_CARRYA))[(size_t)(b * 128 + tt) * 256 + c] = cA;
    ((float*)(p->ws + A_CARRYH))[(size_t)(b * 128 + tt) * 256 + c] = hs;
    __syncthreads();
}

DEVINL void b1_rwkv(KP p, int l, char* lds, int item) {
    const int c = TIDX(), b = item >> 7, tt = item & 127, t0 = tt * 32, rowbase = b * SEQ;
    const bf16_t* P = (const bf16_t*)(p->ws + A_P);
    constexpr int FRS = 272;
    char* featA = lds;
    const float* muc = p->in[I_MUC] + l * 896;
    if (c < 128) {
        const int col = 1024 + 768 + c; const float mu = muc[768 + c];
        float prev;
        { const float x = bf2f(P[(size_t)(rowbase + (t0 > 0 ? t0 - 1 : 0)) * PIN + col]); prev = (t0 > 0) ? x : 0.f; }
#pragma unroll 1
        for (int jb = 0; jb < 2; ++jb) {
            bf16_t raw[16];
#pragma unroll
            for (int u = 0; u < 16; ++u) raw[u] = P[(size_t)(rowbase + t0 + jb * 16 + u) * PIN + col];
#pragma unroll
            for (int u = 0; u < 16; ++u) {
                const float cur = bf2f(raw[u]);
                const float xs = cur + (prev - cur) * mu;
                const float val = (c < 32) ? tanh_fast(xs) : ((c < 64) ? xs : sigm(xs));
                *(bf16_t*)(featA + (jb * 16 + u) * FRS + c * 2) = f2bf(val); prev = cur;
            }
        }
    }
    __syncthreads();
    float dec[32], aa[32];
    {
        const int lane = c & 63, h = c >> 6, r = lane & 31, hh = lane >> 5;
        const bf16_t* wl = (const bf16_t*)(p->ws + OFF_WLT) + (size_t)(l * 256 + h * 64 + r) * 128 + 8 * hh;
        f32x16 aW0, aW1, aA0, aA1, aG0, aG1;
#pragma unroll
        for (int i = 0; i < 16; ++i) { aW0[i] = 0.f; aW1[i] = 0.f; aA0[i] = 0.f; aA1[i] = 0.f; aG0[i] = 0.f; aG1[i] = 0.f; }
        bf16x8 b0[8], b1[8];
#pragma unroll
        for (int ks = 0; ks < 8; ++ks) { b0[ks] = *(const bf16x8*)(wl + ks * 16); b1[ks] = *(const bf16x8*)(wl + 32 * 128 + ks * 16); }
#pragma unroll
        for (int ks = 0; ks < 8; ++ks) {
            const bf16x8 af = *(const bf16x8*)(featA + r * FRS + (ks * 16 + 8 * hh) * 2);
            if (ks < 2) { aW0 = MFMA32(af, b0[ks], aW0); aW1 = MFMA32(af, b1[ks], aW1); }
            else if (ks < 4) { aA0 = MFMA32(af, b0[ks], aA0); aA1 = MFMA32(af, b1[ks], aA1); }
            else { aG0 = MFMA32(af, b0[ks], aG0); aG1 = MFMA32(af, b1[ks], aG1); }
        }
        __syncthreads();
        float* xch = (float*)(lds + 9216) + h * 2048;
        float lwv[32], lav[32], lgv[32];
#define XCHG(X0, X1, OUT) do { _Pragma("unroll") for (int i = 0; i < 16; ++i) { const int t_ = (i & 3) + 8 * (i >> 2) + 4 * hh; xch[t_ * 64 + r] = X0[i]; xch[t_ * 64 + 32 + r] = X1[i]; } \
        _Pragma("unroll") for (int t_ = 0; t_ < 32; ++t_) OUT[t_] = xch[t_ * 64 + lane]; } while (0)
        XCHG(aW0, aW1, lwv); XCHG(aA0, aA1, lav); XCHG(aG0, aG1, lgv);
#undef XCHG
#define TOK(X0, X1, t) X0[t]
#define aW0 lwv
#define aA0 lav
#define aG0 lgv
        bf16_t* gbuf = (bf16_t*)(p->ws + A_G);
        const float w0 = p->in[I_W0][l * 256 + c], a0 = p->in[I_A0][l * 256 + c];
#pragma unroll
        for (int j = 0; j < 32; ++j) {
            gbuf[(size_t)(rowbase + t0 + j) * 256 + c] = f2bf(TOK(aG0, aG1, j));
            const float z = w0 + TOK(aW0, aW1, j); const float wlog = -softplusf(-z) - 0.5f; dec[j] = -__expf(wlog);
            aa[j] = sigm(a0 + TOK(aA0, aA1, j));
        }
#undef TOK
#undef aW0
#undef aA0
#undef aG0
    }
    {
        bf16_t* bonus = (bf16_t*)(p->ws + A_BONUS); uint4* scan = (uint4*)(p->ws + A_SCAN);
        const float mur = muc[c], muk = muc[256 + c], muv = muc[512 + c];
        const float kkw = p->in[I_KK][l * 256 + c], kaw = p->in[I_KA][l * 256 + c], rkw = p->in[I_RK][l * 256 + c];
        float pr, pk, pv;
        { const bf16_t* a = P + (size_t)(rowbase + (t0 > 0 ? t0 - 1 : 0)) * PIN + 1024 + c; const float x0 = bf2f(a[0]), x1 = bf2f(a[256]), x2 = bf2f(a[512]);
          pr = (t0 > 0) ? x0 : 0.f; pk = (t0 > 0) ? x1 : 0.f; pv = (t0 > 0) ? x2 : 0.f; }
#pragma unroll
        for (int jb = 0; jb < 2; ++jb) {
            bf16_t rr_[16], rk_[16], rv_[16];
#pragma unroll
            for (int u = 0; u < 16; ++u) { const bf16_t* a = P + (size_t)(rowbase + t0 + jb * 16 + u) * PIN + 1024 + c; rr_[u] = a[0]; rk_[u] = a[256]; rv_[u] = a[512]; }
#pragma unroll
            for (int u = 0; u < 16; ++u) {
                const int j = jb * 16 + u;
                const size_t row = (size_t)(rowbase + t0 + j);
                const float cr = bf2f(rr_[u]), ck = bf2f(rk_[u]), cv = bf2f(rv_[u]);
                const float r = cr + (pr - cr) * mur, k = ck + (pk - ck) * muk, v = cv + (pv - cv) * muv;
                pr = cr; pk = ck; pv = cv;
                const float kk = k * kkw;
                const float ss = wave_sum(kk * kk);
                const float kkn = kk * rsqrtf(ss + 1e-12f);
                const float kf = k * (1.f + (aa[j] - 1.f) * kaw);
                const float bs = wave_sum(r * kf * rkw);
                bonus[row * 256 + c] = f2bf(bs * v);
                uint4 o; o.x = pack2(kkn, kkn * aa[j]); o.y = pack2(kf, r); o.z = pack2(v, 0.f); o.w = __float_as_uint(dec[j]);
                scan[row * 256 + c] = o;
            }
            asm volatile("" ::: "memory");
        }
    }
    __syncthreads();
}

constexpr int S_AL = 0, S_BE = 8192, S_KA = 16384, S_RH = 24576, S_BET = 32768, S_KAT = 40960, S_VT = 49152, S_L2F = 57344  , S_GT = 73728  ;
constexpr int S_L1F = S_BE;
constexpr int S_M1 = S_BE, S_M2 = S_KA;
constexpr int S_APT = S_L2F, S_W2T = S_L2F + 8192;
constexpr int S_RP = S_AL, S_GTR = S_RH;
DEVINL int crow32(int reg, int h) { return (reg & 3) + 8 * (reg >> 2) + 4 * h; }
DEVINL bf16x8 frag64(const char* lds, int slot, int row, int kel) { return *reinterpret_cast<const bf16x8*>(lds + slot + row * 128 + kel * 2); }
DEVINL float dpp_xor1(float x) { return __builtin_bit_cast(float, __builtin_amdgcn_update_dpp(0, __builtin_bit_cast(int, x), 0xB1, 0xf, 0xf, true)); }

DEVINL f32x16 mm64(const char* lds, int slotA, int slotB, int tm, int tn, int r, int hh, f32x16 acc) {
#pragma unroll
    for (int ks = 0; ks < 4; ++ks) acc = MFMA32(frag64(lds, slotA, tm * 32 + r, ks * 16 + 8 * hh), frag64(lds, slotB, tn * 32 + r, ks * 16 + 8 * hh), acc);
    return acc;
}

DEVINL void b1e_unit(KP p, char* lds, int b, int h, int c) {
    const int tid = TIDX(), wv = tid >> 6, lane = tid & 63, r = lane & 31, hh = lane >> 5;
    const uint4* scan = (const uint4*)(p->ws + A_SCAN) + ((size_t)(b * SEQ + c * 64)) * 256 + h * 64;
    float* gtot = (float*)(lds + S_GT); float* gamC = gtot + 256;
    {
        const int j = lane;
        float lw[16]; unsigned px[16], py[16], pz[16];
#pragma unroll
        for (int u = 0; u < 16; ++u) { const uint4 q = scan[(size_t)(wv * 16 + u) * 256 + j]; px[u] = q.x; py[u] = q.y; pz[u] = q.z; lw[u] = __uint_as_float(q.w); }
        float tot = 0.f;
#pragma unroll
        for (int u = 0; u < 16; ++u) tot += lw[u];
        gtot[wv * 64 + j] = tot;
        __syncthreads();
        float off = 0.f, all = 0.f;
#pragma unroll
        for (int g = 0; g < 4; ++g) { const float v = gtot[g * 64 + j]; all += v; off += (g < wv) ? v : 0.f; }
        if (wv == 0) gamC[j] = __expf(all);
        float cum = off;
        unsigned tb[8], tk[8], tv[8];
#pragma unroll
        for (int u = 0; u < 16; ++u) {
            const float kkn = __uint_as_float(px[u] << 16), bb = __uint_as_float(px[u] & 0xFFFF0000u);
            const float kf = __uint_as_float(py[u] << 16), rr = __uint_as_float(py[u] & 0xFFFF0000u);
            const float gp = __expf(cum); cum += lw[u];
            const float g = __expf(cum), en = __expf(-cum);
            const int t = wv * 16 + u;
            const unsigned be = f2bf(bb * en), ka = f2bf(kf * en);
            *(bf16_t*)(lds + S_AL + t * 128 + j * 2) = f2bf(gp * kkn);
            *(bf16_t*)(lds + S_BE + t * 128 + j * 2) = (bf16_t)be;
            *(bf16_t*)(lds + S_KA + t * 128 + j * 2) = (bf16_t)ka;
            *(bf16_t*)(lds + S_RH + t * 128 + j * 2) = f2bf(g * rr);
            if (u & 1) { tb[u >> 1] |= be << 16; tk[u >> 1] |= ka << 16; tv[u >> 1] |= (pz[u] << 16); }
            else { tb[u >> 1] = be; tk[u >> 1] = ka; tv[u >> 1] = pz[u] & 0xFFFFu; }
        }
        *(uint4*)(lds + S_BET + j * 128 + wv * 32) = make_uint4(tb[0], tb[1], tb[2], tb[3]); *(uint4*)(lds + S_BET + j * 128 + wv * 32 + 16) = make_uint4(tb[4], tb[5], tb[6], tb[7]);
        *(uint4*)(lds + S_KAT + j * 128 + wv * 32) = make_uint4(tk[0], tk[1], tk[2], tk[3]); *(uint4*)(lds + S_KAT + j * 128 + wv * 32 + 16) = make_uint4(tk[4], tk[5], tk[6], tk[7]);
        *(uint4*)(lds + S_VT + j * 128 + wv * 32) = make_uint4(tv[0], tv[1], tv[2], tv[3]); *(uint4*)(lds + S_VT + j * 128 + wv * 32 + 16) = make_uint4(tv[4], tv[5], tv[6], tv[7]);
    }
    __syncthreads();
    const int tm = wv >> 1, tn = wv & 1;
    f32x16 aM1, aM2;
    {
        f32x16 aL1, aL2;
#pragma unroll
        for (int i = 0; i < 16; ++i) { aL1[i] = 0.f; aL2[i] = 0.f; aM1[i] = 0.f; aM2[i] = 0.f; }
#pragma unroll
        for (int ks = 0; ks < 4; ++ks) {
            const bf16x8 fa = frag64(lds, S_AL, tm * 32 + r, ks * 16 + 8 * hh), fr = frag64(lds, S_RH, tm * 32 + r, ks * 16 + 8 * hh);
            const bf16x8 fb = frag64(lds, S_BE, tn * 32 + r, ks * 16 + 8 * hh), fk = frag64(lds, S_KA, tn * 32 + r, ks * 16 + 8 * hh);
            aL1 = MFMA32(fa, fb, aL1); aL2 = MFMA32(fa, fk, aL2); aM1 = MFMA32(fr, fb, aM1); aM2 = MFMA32(fr, fk, aM2);
        }
        __syncthreads();
#pragma unroll
        for (int reg = 0; reg < 16; ++reg) {
            const int t = tm * 32 + crow32(reg, hh), sidx = tn * 32 + r;
            const int o = (t * 64 + (sidx & 1) * 32 + (sidx >> 1)) * 4;
            *(float*)(lds + S_L1F + o) = (sidx < t) ? aL1[reg] : 0.f;
            *(float*)(lds + S_L2F + o) = (sidx < t) ? aL2[reg] : 0.f;
            aM1[reg] = (sidx <= t) ? aM1[reg] : 0.f; aM2[reg] = (sidx <= t) ? aM2[reg] : 0.f;
        }
    }
    __syncthreads();
    unsigned outp[32];
    {
        const int col = (wv & 1) * 32 + (lane >> 1), q = lane & 1;
        float xq[32];
#pragma unroll
        for (int k = 0; k < 32; ++k) xq[k] = 0.f;
        const char* l1row = lds + S_L1F + q * 128;
        const char* l2row = lds + S_L2F + q * 128;
        if (wv < 2) {
#pragma unroll
            for (int t = 0; t < 64; ++t) {
                float acc = 0.f;
#pragma unroll
                for (int k4 = 0; k4 * 4 < (t + 1) / 2; ++k4) {
                    const float4 a = *(const float4*)(l1row + t * 256 + k4 * 16);
                    acc = fmaf(a.x, xq[4 * k4 + 0], acc); acc = fmaf(a.y, xq[4 * k4 + 1], acc); acc = fmaf(a.z, xq[4 * k4 + 2], acc); acc = fmaf(a.w, xq[4 * k4 + 3], acc);
                }
                acc += dpp_xor1(acc);
                const float x = bf2f(*(const bf16_t*)(lds + S_AL + t * 128 + col * 2)) - acc;
                xq[t >> 1] = ((t & 1) == q) ? x : xq[t >> 1];
            }
        } else {
            float vq[32];
#pragma unroll
            for (int k8 = 0; k8 < 8; ++k8) {
                const uint4 d = *(const uint4*)(lds + S_VT + col * 128 + k8 * 16);
                vq[4 * k8 + 0] = q ? __uint_as_float(d.x & 0xFFFF0000u) : __uint_as_float(d.x << 16);
                vq[4 * k8 + 1] = q ? __uint_as_float(d.y & 0xFFFF0000u) : __uint_as_float(d.y << 16);
                vq[4 * k8 + 2] = q ? __uint_as_float(d.z & 0xFFFF0000u) : __uint_as_float(d.z << 16);
                vq[4 * k8 + 3] = q ? __uint_as_float(d.w & 0xFFFF0000u) : __uint_as_float(d.w << 16);
            }
#pragma unroll
            for (int t = 0; t < 64; ++t) {
                float acc = 0.f;
#pragma unroll
                for (int k4 = 0; k4 * 4 < (t + 1) / 2; ++k4) {
                    const float4 a = *(const float4*)(l1row + t * 256 + k4 * 16);
                    const float4 bq = *(const float4*)(l2row + t * 256 + k4 * 16);
                    acc = fmaf(bq.x, vq[4 * k4 + 0], acc); acc = fmaf(bq.y, vq[4 * k4 + 1], acc); acc = fmaf(bq.z, vq[4 * k4 + 2], acc); acc = fmaf(bq.w, vq[4 * k4 + 3], acc);
                    acc = fmaf(-a.x, xq[4 * k4 + 0], acc); acc = fmaf(-a.y, xq[4 * k4 + 1], acc); acc = fmaf(-a.z, xq[4 * k4 + 2], acc); acc = fmaf(-a.w, xq[4 * k4 + 3], acc);
                }
                acc += dpp_xor1(acc);
                xq[t >> 1] = ((t & 1) == q) ? acc : xq[t >> 1];
            }
        }
#pragma unroll
        for (int k = 0; k < 32; ++k) { const float o = dpp_xor1(xq[k]); outp[k] = q ? pack2(o, xq[k]) : pack2(xq[k], o); }
    }
    __syncthreads();
    {
        const int col = (wv & 1) * 32 + (lane >> 1), q = lane & 1;
        char* dst = lds + ((wv < 2) ? S_APT : S_W2T) + col * 128 + q * 64;
#pragma unroll
        for (int i = 0; i < 4; ++i) *(uint4*)(dst + i * 16) = q ? make_uint4(outp[16 + 4 * i], outp[17 + 4 * i], outp[18 + 4 * i], outp[19 + 4 * i]) : make_uint4(outp[4 * i], outp[4 * i + 1], outp[4 * i + 2], outp[4 * i + 3]);
#pragma unroll
        for (int reg = 0; reg < 16; ++reg) {
            const int t = tm * 32 + crow32(reg, hh), sidx = tn * 32 + r;
            *(bf16_t*)(lds + S_M1 + t * 128 + sidx * 2) = f2bf(aM1[reg]);
            *(bf16_t*)(lds + S_M2 + t * 128 + sidx * 2) = f2bf(aM2[reg]);
        }
    }
    __syncthreads();
    unsigned char* ubase = p->ws + A_CHAIN + (size_t)((b * 4 + h) * 64 + c) * CHAIN_UNIT;
    f32x16 zero;
#pragma unroll
    for (int i = 0; i < 16; ++i) zero[i] = 0.f;
    f32x16 gt;
    {
        const f32x16 qv = mm64(lds, S_M1, S_APT, tm, tn, r, hh, zero);
        const f32x16 y0 = mm64(lds, S_M2, S_VT, tm, tn, r, hh, zero) - mm64(lds, S_M1, S_W2T, tm, tn, r, hh, zero);
        gt = mm64(lds, S_BET, S_APT, tm, tn, r, hh, zero);
        const f32x16 ht = mm64(lds, S_KAT, S_VT, tm, tn, r, hh, zero) - mm64(lds, S_BET, S_W2T, tm, tn, r, hh, zero);
#pragma unroll
        for (int reg = 0; reg < 16; ++reg) {
            const int t = tm * 32 + crow32(reg, hh), jc = tn * 32 + r;
            const float rh = bf2f(*(const bf16_t*)(lds + S_RH + t * 128 + jc * 2));
            *(bf16_t*)(lds + S_RP + t * 128 + jc * 2) = f2bf(rh - qv[reg]);
            const int jr = tm * 32 + crow32(reg, hh);
            const float gc = gamC[jr];
            gt[reg] = gc * (((jr == jc) ? 1.f : 0.f) - gt[reg]);
        }
        float4* himg = (float4*)(ubase + 16384); float4* yimg = (float4*)(ubase + 32768);
#pragma unroll
        for (int rq = 0; rq < 4; ++rq) {
            float4 hv, yv;
            hv.x = gamC[tm * 32 + crow32(4 * rq + 0, hh)] * ht[4 * rq + 0]; hv.y = gamC[tm * 32 + crow32(4 * rq + 1, hh)] * ht[4 * rq + 1];
            hv.z = gamC[tm * 32 + crow32(4 * rq + 2, hh)] * ht[4 * rq + 2]; hv.w = gamC[tm * 32 + crow32(4 * rq + 3, hh)] * ht[4 * rq + 3];
            yv.x = y0[4 * rq + 0]; yv.y = y0[4 * rq + 1]; yv.z = y0[4 * rq + 2]; yv.w = y0[4 * rq + 3];
            himg[((tn * 2 + tm) * 4 + rq) * 64 + lane] = hv;
            yimg[((tn * 2 + tm) * 4 + rq) * 64 + lane] = yv;
        }
    }
    __syncthreads();
#pragma unroll
    for (int reg = 0; reg < 16; ++reg) {
        const int jr = tm * 32 + crow32(reg, hh), jc = tn * 32 + r;
        *(bf16_t*)(lds + S_GTR + jr * 128 + jc * 2) = f2bf(gt[reg]);
    }
    __syncthreads();
    {
        uint4* gimg = (uint4*)(ubase); uint4* rimg = (uint4*)(ubase + 8192);
#pragma unroll
        for (int ii = 0; ii < 2; ++ii) {
            const int im = wv * 2 + ii, mt = im >> 2, jb = (im >> 1) & 1, s2 = im & 1;
            const int cbase = (32 * jb + 16 * s2 + 4 * hh) * 2;
            const uint2 g0 = *(const uint2*)(lds + S_GTR + (mt * 32 + r) * 128 + cbase), g1 = *(const uint2*)(lds + S_GTR + (mt * 32 + r) * 128 + cbase + 16);
            const uint2 r0 = *(const uint2*)(lds + S_RP + (mt * 32 + r) * 128 + cbase), r1 = *(const uint2*)(lds + S_RP + (mt * 32 + r) * 128 + cbase + 16);
            gimg[im * 64 + lane] = make_uint4(g0.x, g0.y, g1.x, g1.y);
            rimg[im * 64 + lane] = make_uint4(r0.x, r0.y, r1.x, r1.y);
        }
    }
    __syncthreads();
}

DEVINL void phaseB1(KP p, int l, char* lds, const int mask = 15, const int sub = 3) {
    const int nb = NBV();
    if (mask & 1) {
        const int blk = BIDX();
        for (int it = blk; it < 512; it += nb) {
            if (sub & 1) { b1_rwkv(p, l, lds, it * 2); b1_rwkv(p, l, lds, it * 2 + 1); }
            __threadfence_block(); __syncthreads();
            const int b = it >> 6, c = it & 63;
            if (sub & 2) {
#pragma unroll 1
                for (int h = 0; h < 4; ++h) b1e_unit(p, lds, b, h, c);
            }
        }
    }
    if (mask & 2) { const int blk = BIDX(); for (int it = blk; it < 1024; it += nb) b1_lru(p, l, lds, it); }
    if (mask & 4) { const int blk = BIDX(); for (int it = blk; it < 1024; it += nb) b1_conformer(p, l, lds, it); }
    if (mask & 8) { const int blk = BIDX(); for (int it = blk; it < 512; it += nb) b1_shortconv(p, l, it); }
}

DEVINL void phaseB2(KP p, int l, char* lds) {
    const int tid = TIDX(), blk = BIDX();
    if (blk >= 64 && blk < 72) {
        const int bb = blk - 64;
        const float* ca = (const float*)(p->ws + A_CARRYA) + (size_t)bb * 128 * 256 + tid;
        const float* ch = (const float*)(p->ws + A_CARRYH) + (size_t)bb * 128 * 256 + tid;
        float* hst = (float*)(p->ws + A_HSTART) + (size_t)bb * 128 * 256 + tid;
        float hs = 0.f;
#pragma unroll 8
        for (int tt = 0; tt < 128; ++tt) { hst[tt * 256] = hs; hs = fmaf(ca[tt * 256], hs, ch[tt * 256]); }
    }
    if (blk < 64 && tid < 64) {
        const int lane = tid, r = lane & 31, hh = lane >> 5;
        const int bh = blk >> 1, w = blk & 1, b = bh >> 2, h = bh & 3;
        float* yraw = (float*)(p->ws + A_YRAW) + (size_t)b * SEQ * 256 + h * 64 + 32 * w + r;
        f32x16 X0, X1;
#pragma unroll
        for (int i = 0; i < 16; ++i) { X0[i] = 0.f; X1[i] = 0.f; }
        auto issue = [&](int c, char* buf) {
            const unsigned char* ubase = p->ws + A_CHAIN + (size_t)(bh * 64 + c) * CHAIN_UNIT;
#pragma unroll
            for (int i = 0; i < 8; ++i) {
                __builtin_amdgcn_global_load_lds((const unsigned*)(ubase + i * 1024 + lane * 16), (unsigned*)(buf + i * 1024 + lane * 16), 16, 0, 0);
                __builtin_amdgcn_global_load_lds((const unsigned*)(ubase + 8192 + i * 1024 + lane * 16), (unsigned*)(buf + 8192 + i * 1024 + lane * 16), 16, 0, 0);
                __builtin_amdgcn_global_load_lds((const unsigned*)(ubase + 16384 + (w * 8 + i) * 1024 + lane * 16), (unsigned*)(buf + 16384 + i * 1024 + lane * 16), 16, 0, 0);
                __builtin_amdgcn_global_load_lds((const unsigned*)(ubase + 32768 + (w * 8 + i) * 1024 + lane * 16), (unsigned*)(buf + 24576 + i * 1024 + lane * 16), 16, 0, 0);
            }
        };
        issue(0, lds);
        for (int c = 0; c < 64; ++c) {
            char* buf = lds + (c & 1) * 32768;
            if (c + 1 < 64) { issue(c + 1, lds + ((c + 1) & 1) * 32768); asm volatile("s_waitcnt vmcnt(32)" ::: "memory"); }
            else asm volatile("s_waitcnt vmcnt(0)" ::: "memory");
            uint4 gq[8], rq8[8]; float4 hq[8], yq[8];
#pragma unroll
            for (int i = 0; i < 8; ++i) { gq[i] = *(const uint4*)(buf + i * 1024 + lane * 16); rq8[i] = *(const uint4*)(buf + 8192 + i * 1024 + lane * 16); }
#pragma unroll
            for (int i = 0; i < 8; ++i) { hq[i] = *(const float4*)(buf + 16384 + i * 1024 + lane * 16); yq[i] = *(const float4*)(buf + 24576 + i * 1024 + lane * 16); }
            bf16x8 xp[4];
#pragma unroll
            for (int s2 = 0; s2 < 2; ++s2) {
                uint4 a, bq;
                a.x = pack2(X0[8 * s2 + 0], X0[8 * s2 + 1]); a.y = pack2(X0[8 * s2 + 2], X0[8 * s2 + 3]); a.z = pack2(X0[8 * s2 + 4], X0[8 * s2 + 5]); a.w = pack2(X0[8 * s2 + 6], X0[8 * s2 + 7]);
                bq.x = pack2(X1[8 * s2 + 0], X1[8 * s2 + 1]); bq.y = pack2(X1[8 * s2 + 2], X1[8 * s2 + 3]); bq.z = pack2(X1[8 * s2 + 4], X1[8 * s2 + 5]); bq.w = pack2(X1[8 * s2 + 6], X1[8 * s2 + 7]);
                xp[s2] = __builtin_bit_cast(bf16x8, a); xp[2 + s2] = __builtin_bit_cast(bf16x8, bq);
            }
#pragma unroll
            for (int mt = 0; mt < 2; ++mt) {
                f32x16 acc;
#pragma unroll
                for (int i = 0; i < 4; ++i) { acc[4 * i] = yq[mt * 4 + i].x; acc[4 * i + 1] = yq[mt * 4 + i].y; acc[4 * i + 2] = yq[mt * 4 + i].z; acc[4 * i + 3] = yq[mt * 4 + i].w; }
#pragma unroll
                for (int f = 0; f < 4; ++f) acc = MFMA32(__builtin_bit_cast(bf16x8, rq8[mt * 4 + f]), xp[f], acc);
#pragma unroll
                for (int reg = 0; reg < 16; ++reg) yraw[(size_t)(c * 64 + mt * 32 + crow32(reg, hh)) * 256] = acc[reg];
            }
            f32x16 n0, n1;
#pragma unroll
            for (int i = 0; i < 4; ++i) { n0[4 * i] = hq[i].x; n0[4 * i + 1] = hq[i].y; n0[4 * i + 2] = hq[i].z; n0[4 * i + 3] = hq[i].w;
                                          n1[4 * i] = hq[4 + i].x; n1[4 * i + 1] = hq[4 + i].y; n1[4 * i + 2] = hq[4 + i].z; n1[4 * i + 3] = hq[4 + i].w; }
#pragma unroll
            for (int f = 0; f < 4; ++f) { n0 = MFMA32(__builtin_bit_cast(bf16x8, gq[f]), xp[f], n0); n1 = MFMA32(__builtin_bit_cast(bf16x8, gq[4 + f]), xp[f], n1); }
            X0 = n0; X1 = n1;
        }
    }
}

DEVINL void phaseB3(KP p, int l) {
    const int c = TIDX(), nb = NBV(), blk = BIDX();
    const bf16_t* P = (const bf16_t*)(p->ws + A_P);
    bf16_t* ymix = (bf16_t*)(p->ws + A_YMIX);
    const float* yraw = (const float*)(p->ws + A_YRAW); const bf16_t* bonus = (const bf16_t*)(p->ws + A_BONUS); const bf16_t* gbuf = (const bf16_t*)(p->ws + A_G);
    const unsigned* hcbuf = (const unsigned*)(p->ws + A_HLOC); const float* hst = (const float*)(p->ws + A_HSTART);
    const float gng = p->in[I_GNG][l * 256 + c], gnb = p->in[I_GNB][l * 256 + c];
    for (int it = blk; it < 512; it += nb) {
#pragma unroll 1
        for (int r8 = 0; r8 < 64; r8 += 8) {
            float yv[8]; bf16_t bo[8], gg[8], gbv[8]; unsigned hcv[8]; float hsv[8];
#pragma unroll
            for (int u = 0; u < 8; ++u) {
                const int row = it * 64 + r8 + u, b = row >> 12, tt = (row & 4095) >> 5;
                const size_t o = (size_t)row * 256 + c;
                yv[u] = yraw[o]; bo[u] = bonus[o]; gg[u] = gbuf[o]; hcv[u] = hcbuf[o]; hsv[u] = hst[(size_t)(b * 128 + tt) * 256 + c];
                gbv[u] = P[(size_t)row * PIN + 768 + c];
            }
#pragma unroll
            for (int u = 0; u < 8; ++u) {
                const int row = it * 64 + r8 + u;
                const float y = yv[u];
                const float mu = wave_sum(y) * (1.f / 64.f);
                const float d = y - mu;
                const float var = wave_sum(d * d) * (1.f / 64.f);
                const float yn = d * rsqrtf(var + GN_EPS) * gng + gnb;
                ymix[(size_t)row * DM + 512 + c] = f2bf((yn + bf2f(bo[u])) * bf2f(gg[u]));
                const float hh = fmaf(__uint_as_float(hcv[u] & 0xFFFF0000u), hsv[u], __uint_as_float(hcv[u] << 16));
                ymix[(size_t)row * DM + 256 + c] = f2bf(hh * gelu_tanh(bf2f(gbv[u])));
            }
        }
    }
}

DEVINL void phaseD(KP p, int l, char* lds, const int dry = 0) {
    const int tid = TIDX(), nb = NBV(), blk = BIDX(), wid = tid >> 6, lane = tid & 63;
    constexpr int URS = 2064;
    char* uh = lds;
    char* ulo = lds + 16 * URS;
    float* logit = (float*)(lds + 32 * URS);
    int* sel_e = (int*)(lds + 32 * URS + 4096);
    int* lpos = sel_e + 512;
    int* hist = lpos + 512;
    int* basep = hist + 64;
    const bf16_t* wrt_hi = (const bf16_t*)(p->ws + OFF_WR) + (size_t)(l * 2 + 0) * 64 * 1024;
    const bf16_t* wrt_lo = (const bf16_t*)(p->ws + OFF_WR) + (size_t)(l * 2 + 1) * 64 * 1024;
    const bf16_t* zbuf = (const bf16_t*)(p->ws + M_ZB);
    float2* lnstat = (float2*)(p->ws + M_STAT);
    bf16_t* ubuf = (bf16_t*)(p->ws + (dry ? A_YMIX : OFF_UBUF));
    const float* mod = (const float*)(p->ws + OFF_MOD);
    const float* wr = p->in[I_WROUTER] + (size_t)l * 1024 * 64 + lane;
    const float ebias = p->in[I_EBIAS][l * 64 + lane];
    unsigned* cnt = (unsigned*)(p->ws + OFF_CNT) + l * 64 + (dry ? 256 : 0);
    int* list = (int*)(p->ws + (dry ? M_HBUF : M_LIST));
    float* wsel = (float*)(p->ws + (dry ? M_HBUF + 16777216 : M_WSEL));
    int* pmap = (int*)(p->ws + (dry ? M_HBUF + 33554432 : M_PMAP));
    for (int it = blk; it < 512; it += nb) {
        const int tok0 = it * 64;
        if (tid < 64) hist[tid] = 0;
        for (int sb = 0; sb < 4; ++sb) {
#pragma unroll
            for (int j = 0; j < 4; ++j) {
                const int tl = wid * 4 + j, row = tok0 + sb * 16 + tl, b = row >> 12;
                float4 z[4];
                float s = 0.f;
#pragma unroll
                for (int i = 0; i < 4; ++i) { const uint2 zv = *(const uint2*)(zbuf + (size_t)row * DM + i * 256 + lane * 4);
                    z[i].x = __uint_as_float(zv.x << 16); z[i].y = __uint_as_float(zv.x & 0xFFFF0000u); z[i].z = __uint_as_float(zv.y << 16); z[i].w = __uint_as_float(zv.y & 0xFFFF0000u); s += z[i].x + z[i].y + z[i].z + z[i].w; }
                const float mean = wave_sum(s) * (1.f / 1024.f);
                float q = 0.f;
#pragma unroll
                for (int i = 0; i < 4; ++i) { z[i].x -= mean; z[i].y -= mean; z[i].z -= mean; z[i].w -= mean; q += z[i].x * z[i].x + z[i].y * z[i].y + z[i].z * z[i].z + z[i].w * z[i].w; }
                const float rs = rsqrtf(wave_sum(q) * (1.f / 1024.f) + LN_EPS);
                if (lane == 0) lnstat[row] = make_float2(mean, rs);
#pragma unroll
                for (int i = 0; i < 4; ++i) {
                    const int col = i * 256 + lane * 4;
                    const float4 g = *(const float4*)(p->in[I_LN1G] + l * 1024 + col), bb = *(const float4*)(p->in[I_LN1B] + l * 1024 + col);
                    const float4 sh = *(const float4*)(mod + (size_t)(l * 8 + b) * 6144 + 3072 + col), sc = *(const float4*)(mod + (size_t)(l * 8 + b) * 6144 + 4096 + col);
                    float4 x1; x1.x = z[i].x * rs * g.x + bb.x; x1.y = z[i].y * rs * g.y + bb.y; x1.z = z[i].z * rs * g.z + bb.z; x1.w = z[i].w * rs * g.w + bb.w;
                    float4 u; u.x = x1.x * (1.f + sc.x) + sh.x; u.y = x1.y * (1.f + sc.y) + sh.y; u.z = x1.z * (1.f + sc.z) + sh.z; u.w = x1.w * (1.f + sc.w) + sh.w;
                    uint2 o; o.x = pack2(u.x, u.y); o.y = pack2(u.z, u.w);
                    *(uint2*)(ubuf + (size_t)row * DM + col) = o;
                    *(uint2*)(uh + tl * URS + col * 2) = o;
                    uint2 o2; o2.x = pack2(u.x - __uint_as_float(o.x << 16), u.y - __uint_as_float(o.x & 0xFFFF0000u)); o2.y = pack2(u.z - __uint_as_float(o.y << 16), u.w - __uint_as_float(o.y & 0xFFFF0000u));
                    *(uint2*)(ulo + tl * URS + col * 2) = o2;
                }
            }
            __syncthreads();
            {
                const int fr = lane & 15, fq = lane >> 4;
                f32x4 lacc = (f32x4){0.f, 0.f, 0.f, 0.f};
                const bf16_t* bh = wrt_hi + (size_t)(wid * 16 + fr) * 1024 + fq * 8;
                const bf16_t* bl = wrt_lo + (size_t)(wid * 16 + fr) * 1024 + fq * 8;
#pragma unroll 1
                for (int k8 = 0; k8 < 4; ++k8) {
                    bf16x8 bhv[8], blv[8];
#pragma unroll
                    for (int kk = 0; kk < 8; ++kk) { bhv[kk] = *(const bf16x8*)(bh + (k8 * 8 + kk) * 32); blv[kk] = *(const bf16x8*)(bl + (k8 * 8 + kk) * 32); }
#pragma unroll
                    for (int kk = 0; kk < 8; ++kk) {
                        const int ko = (k8 * 8 + kk) * 64 + fq * 16;
                        const bf16x8 ah = *(const bf16x8*)(uh + fr * URS + ko), al = *(const bf16x8*)(ulo + fr * URS + ko);
                        lacc = __builtin_amdgcn_mfma_f32_16x16x32_bf16(ah, bhv[kk], lacc, 0, 0, 0);
                        lacc = __builtin_amdgcn_mfma_f32_16x16x32_bf16(al, bhv[kk], lacc, 0, 0, 0);
                        lacc = __builtin_amdgcn_mfma_f32_16x16x32_bf16(ah, blv[kk], lacc, 0, 0, 0);
                    }
                }
#pragma unroll
                for (int j = 0; j < 4; ++j) logit[(fq * 4 + j) * 64 + wid * 16 + fr] = lacc[j];
            }
            __syncthreads();
            float acc[4];
#pragma unroll
            for (int j = 0; j < 4; ++j) acc[j] = logit[(wid * 4 + j) * 64 + lane];
#pragma unroll
            for (int j = 0; j < 4; ++j) {
                const int tl = sb * 16 + wid * 4 + j;
                const float score = 1.f / (1.f + __expf(-acc[j]));
                const float biased = score + ebias;
                const float m1 = group8_max(biased);
                const unsigned long long eq = __ballot(biased == m1);
                const int g = lane >> 3;
                const unsigned gm = (unsigned)(eq >> (g * 8)) & 0xFFu;
                const int first = __ffs((int)gm) - 1;
                const float v2 = ((lane & 7) == first) ? -INFINITY : biased;
                const float m2 = group8_max(v2);
                const float gs = m1 + m2;
                int rg = 0;
#pragma unroll
                for (int g2 = 0; g2 < 8; ++g2) { const float o = __builtin_bit_cast(float, __builtin_amdgcn_readlane(__builtin_bit_cast(int, gs), g2 * 8)); rg += ((o > gs) || (o == gs && g2 < g)) ? 1 : 0; }
                const bool keep = rg < 4;
                const float mk = keep ? biased : -INFINITY;
                int rk = 0;
#pragma unroll
                for (int e2 = 0; e2 < 64; ++e2) { const float o = __builtin_bit_cast(float, __builtin_amdgcn_readlane(__builtin_bit_cast(int, mk), e2)); rk += ((o > mk) || (o == mk && e2 < lane)) ? 1 : 0; }
                const bool sel = keep && (rk < 8);
                const float ssum = wave_sum(sel ? score : 0.f);
                const float wgt = score / ssum * 2.5f;
                const unsigned long long sm = __ballot(sel);
                const int kidx = __popcll(sm & ((1ull << lane) - 1ull));
                if (sel) { wsel[(size_t)(tok0 + tl) * 8 + kidx] = wgt; sel_e[tl * 8 + kidx] = lane; }
            }
            __syncthreads();
        }
        for (int i = tid; i < 512; i += VTHREADS) lpos[i] = atomicAdd(&hist[sel_e[i]], 1);
        __syncthreads();
        if (tid < 64) basep[tid] = (int)atomicAdd(&cnt[tid], (unsigned)hist[tid]);
        __syncthreads();
        for (int i = tid; i < 512; i += VTHREADS) { const int e = sel_e[i], pos = basep[e] + lpos[i]; list[(size_t)e * NTOK + pos] = tok0 * 8 + i; pmap[tok0 * 8 + i] = (e << 16) | pos; }
        __syncthreads();
    }
}

DEVINL void phaseA(KP p, int l, char* lds) {
    const int tid = TID512(), c = blockIdx.x, G = gridDim.x;
    const char* ubuf = (const char*)(p->ws + OFF_UBUF);
    const char* Wt = (const char*)(p->ws + OFF_WIN) + (size_t)l * WIN_ROWS * 1024 * 2;
    bf16_t* P = (bf16_t*)(p->ws + A_P);
    auto sched = [&](int i, GUnit& u) -> bool {
        const long L = unit_linear(i, c, G); if (L >= 128 * 11) return false;
        const int Li = (int)L, sx = Li >> 9, w = (sx == 2) ? 3 : 4, rem = Li - (sx << 9), pm = rem / w, pn = sx * 4 + (rem - pm * w);
        u.A = ubuf + (size_t)pm * 256 * 2048; u.B = Wt + (size_t)pn * 256 * 2048; u.i0 = pm; u.i1 = pn; u.i2 = 0;
        return true;
    };
    auto epi = [&](f32x4 (&acc)[2][2][4][2], const GUnit& u, int wr, int wc, int fr, int fq) {
        asm volatile("" : "+v"(fr), "+v"(fq));
        const int row0 = u.i0 * 256 + wr * 64 + fr, col0 = u.i1 * 256 + wc * 32 + 8 * fq;
#pragma unroll
        for (int ai = 0; ai < 2; ++ai)
#pragma unroll
            for (int m = 0; m < 4; ++m) {
                bf16_t* rowp = P + (size_t)(row0 + ai * 128 + m * 16) * PIN + col0;
#pragma unroll
                for (int bj = 0; bj < 2; ++bj) {
                    if (col0 + bj * 128 < PIN) {
                        const f32x4 v0 = acc[ai][bj][m][0], v1 = acc[ai][bj][m][1];
                        *(uint4*)(rowp + bj * 128) = make_uint4(pack2(v0[0], v0[1]), pack2(v0[2], v0[3]), pack2(v1[0], v1[1]), pack2(v1[2], v1[3]));
                    }
                }
            }
    };
    gemm256<true, false>(lds, 1024, 1024, sched, epi);
}

DEVINL void phaseC(KP p, int l, char* lds) {
    const int tid = TID512(), c = blockIdx.x, G = gridDim.x;
    const char* ymix = (const char*)(p->ws + A_YMIX);
    const char* Wt = (const char*)(p->ws + OFF_WOUT) + (size_t)l * 1024 * 1024 * 2;
    const float* res32 = p->in[I_X];
    const bf16_t* res16 = (const bf16_t*)p->out;
    bf16_t* zbuf = (bf16_t*)(p->ws + M_ZB);
    const float* mod = (const float*)(p->ws + OFF_MOD);
    auto sched = [&](int i, GUnit& u) -> bool {
        const long L = unit_linear(i, c, G); if (L >= 128 * 4) return false;
        const int pm = (int)L >> 2, pn = (int)L & 3;
        u.A = ymix + (size_t)pm * 256 * 2048; u.B = Wt + (size_t)pn * 256 * 2048; u.i0 = pm; u.i1 = pn; u.i2 = 0;
        return true;
    };
    auto epi = [&](f32x4 (&acc)[2][2][4][2], const GUnit& u, int wr, int wc, int fr, int fq) {
        asm volatile("" : "+v"(fr), "+v"(fq));
        const int row0 = u.i0 * 256 + wr * 64 + fr, col0 = u.i1 * 256 + wc * 32 + 8 * fq;
#pragma unroll
        for (int ai = 0; ai < 2; ++ai)
#pragma unroll
            for (int m = 0; m < 4; ++m) {
                const int row = row0 + ai * 128 + m * 16, b = row >> 12;
#pragma unroll
                for (int bj = 0; bj < 2; ++bj) {
                    const int col = col0 + bj * 128;
                    const float4 ga = *(const float4*)(mod + (size_t)(l * 8 + b) * 6144 + 2048 + col), gb = *(const float4*)(mod + (size_t)(l * 8 + b) * 6144 + 2048 + col + 4);
                    float r[8];
                    if (l == 0) {
                        const float4 ra = *(const float4*)(res32 + (size_t)row * DM + col), rb = *(const float4*)(res32 + (size_t)row * DM + col + 4);
                        r[0] = ra.x; r[1] = ra.y; r[2] = ra.z; r[3] = ra.w; r[4] = rb.x; r[5] = rb.y; r[6] = rb.z; r[7] = rb.w;
                    } else {
                        const uint4 rv = *(const uint4*)(res16 + (size_t)row * DM + col);
                        r[0] = __uint_as_float(rv.x << 16); r[1] = __uint_as_float(rv.x & 0xFFFF0000u); r[2] = __uint_as_float(rv.y << 16); r[3] = __uint_as_float(rv.y & 0xFFFF0000u);
                        r[4] = __uint_as_float(rv.z << 16); r[5] = __uint_as_float(rv.z & 0xFFFF0000u); r[6] = __uint_as_float(rv.w << 16); r[7] = __uint_as_float(rv.w & 0xFFFF0000u);
                    }
                    const f32x4 a0 = acc[ai][bj][m][0], a1 = acc[ai][bj][m][1];
                    const float z0 = ALPHA * r[0] + (1.f + ga.x) * a0[0], z1 = ALPHA * r[1] + (1.f + ga.y) * a0[1], z2 = ALPHA * r[2] + (1.f + ga.z) * a0[2], z3 = ALPHA * r[3] + (1.f + ga.w) * a0[3];
                    const float z4 = ALPHA * r[4] + (1.f + gb.x) * a1[0], z5 = ALPHA * r[5] + (1.f + gb.y) * a1[1], z6 = ALPHA * r[6] + (1.f + gb.z) * a1[2], z7 = ALPHA * r[7] + (1.f + gb.w) * a1[3];
                    *(uint4*)(zbuf + (size_t)row * DM + col) = make_uint4(pack2(z0, z1), pack2(z2, z3), pack2(z4, z5), pack2(z6, z7));
                }
            }
    };
    gemm256<true, false>(lds, 1024, 1024, sched, epi);
}

constexpr int DIR_OFF = 131072;
DEVINL void moe_directory(KP p, int l, char* lds) {
    int* pref = (int*)(lds + DIR_OFF);
    int* cntl = (int*)(lds + DIR_OFF + 512);
    unsigned* cnt = (unsigned*)(p->ws + OFF_CNT) + l * 64;
    asm volatile("" : "+s"(cnt));
    if (threadIdx.x == 0) {
        int s = 0;
        int* xpre = (int*)(lds + DIR_OFF + 1024);
        int x = 0;
        for (int e = 0; e < 64; ++e) { const int c = (int)__hip_atomic_load(&cnt[e], __ATOMIC_RELAXED, __HIP_MEMORY_SCOPE_AGENT); cntl[e] = c; pref[e] = s; s += (c + 255) >> 8; xpre[e] = x; x += c; }
        pref[64] = s; cntl[64] = NTOK; pref[65] = s + 128; xpre[64] = x;
    }
    __syncthreads();
    {
        int* m2e = (int*)(lds + DIR_OFF + 2048);
        const int tot = pref[65];
        for (int mg = threadIdx.x; mg < tot; mg += NTHREADS) { int e = 0; while (pref[e + 1] <= mg) ++e; m2e[mg] = e; }
    }
    __syncthreads();
}

DEVINL void phaseE1(KP p, int l, char* lds) {
    const int tid = TID512(), c = blockIdx.x, G = gridDim.x;
    moe_directory(p, l, lds);
    const int* pref = (const int*)(lds + DIR_OFF); const int* cntl = (const int*)(lds + DIR_OFF + 512);
    const char* ubuf = (const char*)(p->ws + OFF_UBUF);
    const int* list = (const int*)(p->ws + M_LIST);
    bf16_t* hbuf = (bf16_t*)(p->ws + M_HBUF);
    const char* W13 = (const char*)(p->ws + OFF_W13) + (size_t)(l * 65) * 512 * 1024 * 2;
    const int total = __builtin_amdgcn_readfirstlane(pref[65]) * 2;
    auto sched = [&](int i, GUnit& u) -> bool {
        const long L = unit_linear(i, c, G); if (L >= total) return false;
        const int mg = (int)L >> 1, nt = (int)L & 1;
        const int e = __builtin_amdgcn_readfirstlane(((const int*)(lds + DIR_OFF + 2048))[mg]);
        const int mt = __builtin_amdgcn_readfirstlane(mg - pref[e]), Me = __builtin_amdgcn_readfirstlane(cntl[e]);
        u.A = ubuf; u.B = W13 + ((size_t)e * 512 + nt * 256) * 2048; u.i0 = mg; u.i1 = nt; u.i2 = e;
        int R[2], C[2]; stage_coords512(TID512(), R, C);
#pragma unroll
        for (int h = 0; h < 2; ++h)
#pragma unroll
            for (int i2 = 0; i2 < 2; ++i2) {
                const int idx = mt * 256 + h * 128 + R[i2]; int tok;
                if (e < 64) tok = (idx < Me) ? (list[(size_t)e * NTOK + idx] >> 3) : 0; else tok = idx;
                u.va[h][i2] = (unsigned)(tok * 1024 + C[i2]) * 2u;
            }
        return true;
    };
    auto epi = [&](f32x4 (&acc)[2][2][4][2], const GUnit& u, int wr, int wc, int fr, int fq) {
        asm volatile("" : "+v"(fr), "+v"(fq));
        const size_t row0 = (size_t)u.i0 * 256 + wr * 64 + fr;
#pragma unroll
        for (int ai = 0; ai < 2; ++ai)
#pragma unroll
            for (int m = 0; m < 4; ++m) {
                bf16_t* rowp = hbuf + (row0 + ai * 128 + m * 16) * 256;
#pragma unroll
                for (int bj = 0; bj < 2; ++bj) {
                    const int hcol = (u.i1 * 8 + bj * 4 + wc) * 16 + 4 * fq;
                    const f32x4 gt = acc[ai][bj][m][0], up = acc[ai][bj][m][1];
                    float hv[4];
#pragma unroll
                    for (int j = 0; j < 4; ++j) hv[j] = gt[j] * sigm(gt[j]) * up[j];
                    uint2 o; o.x = pack2(hv[0], hv[1]); o.y = pack2(hv[2], hv[3]);
                    *(uint2*)(rowp + hcol) = o;
                }
                asm volatile("" ::: "memory");
            }
    };
    gemm256<false, true>(lds, 1024, 1024, sched, epi);
}

DEVINL void phaseE2(KP p, int l, char* lds) {
    const int tid = TID512(), c = blockIdx.x, G = gridDim.x;
    moe_directory(p, l, lds);
    const int* pref = (const int*)(lds + DIR_OFF); const int* cntl = (const int*)(lds + DIR_OFF + 512);
    const int* xpre = (const int*)(lds + DIR_OFF + 1024);
    const char* hbuf = (const char*)(p->ws + M_HBUF);
    unsigned char* ybuf = (unsigned char*)(p->ws + M_YBUF);
    const char* W2 = (const char*)(p->ws + OFF_W2) + (size_t)(l * 65) * 1024 * 256 * 2;
    const int total = __builtin_amdgcn_readfirstlane(pref[65]) * 4;
    auto sched = [&](int i, GUnit& u) -> bool {
        const long L = unit_linear(i, c, G); if (L >= total) return false;
        const int mg = (int)L >> 2, nt = (int)L & 3;
        const int e = __builtin_amdgcn_readfirstlane(((const int*)(lds + DIR_OFF + 2048))[mg]);
        u.A = hbuf + (size_t)mg * 256 * 512; u.B = W2 + ((size_t)e * 1024 + nt * 256) * 512; u.i0 = mg; u.i1 = nt; u.i2 = e;
        return true;
    };
    auto epi = [&](f32x4 (&acc)[2][2][4][2], const GUnit& u, int wr, int wc, int fr, int fq) {
        asm volatile("" : "+v"(fr), "+v"(fq));
        const int e = __builtin_amdgcn_readfirstlane(u.i2), mt = __builtin_amdgcn_readfirstlane(u.i0 - pref[e]), Me = __builtin_amdgcn_readfirstlane(cntl[e]);
        const int yrow0 = __builtin_amdgcn_readfirstlane(xpre[e]) + mt * 256;
        const int col0 = u.i1 * 256 + wc * 32 + 8 * fq, loc0 = wr * 64 + fr;
#pragma unroll
        for (int ai = 0; ai < 2; ++ai)
#pragma unroll
            for (int m = 0; m < 4; ++m) {
                const int loc = loc0 + ai * 128 + m * 16;
                if (mt * 256 + loc < Me) {
                    unsigned char* rowp = ybuf + (size_t)(yrow0 + loc) * 1024 + col0;
#pragma unroll
                    for (int bj = 0; bj < 2; ++bj) {
                        const f32x4 v0 = acc[ai][bj][m][0], v1 = acc[ai][bj][m][1];
                        int w0 = __builtin_amdgcn_cvt_pk_fp8_f32(v0[0], v0[1], 0, false); w0 = __builtin_amdgcn_cvt_pk_fp8_f32(v0[2], v0[3], w0, true);
                        int w1 = __builtin_amdgcn_cvt_pk_fp8_f32(v1[0], v1[1], 0, false); w1 = __builtin_amdgcn_cvt_pk_fp8_f32(v1[2], v1[3], w1, true);
                        *(uint2*)(rowp + bj * 128) = make_uint2((unsigned)w0, (unsigned)w1);
                    }
                }
            }
    };
    gemm256<true, false>(lds, 256, 256, sched, epi);
}

DEVINL void phaseF(KP p, int l, const int dry = 0) {
    const int tid = TIDX(), nb = NBV(), blk = BIDX(), wid = tid >> 6, lane = tid & 63;
    const bf16_t* zbuf = (const bf16_t*)(p->ws + M_ZB);
    float* xout = dry ? (float*)(p->ws + M_HBUF) : p->out;
    const unsigned char* ybuf = (const unsigned char*)(p->ws + M_YBUF);
    bf16_t* ubuf = (bf16_t*)(p->ws + OFF_UBUF);
    const float* mod = (const float*)(p->ws + OFF_MOD);
    const int* pmap = (const int*)(p->ws + M_PMAP); const float* wsel = (const float*)(p->ws + M_WSEL);
    const float2* lnstat = (const float2*)(p->ws + M_STAT);
    int xoff;
    {
        const unsigned* cnt = (const unsigned*)(p->ws + OFF_CNT) + l * 64;
        const int c = (int)__hip_atomic_load(&cnt[lane], __ATOMIC_RELAXED, __HIP_MEMORY_SCOPE_AGENT);
        xoff = 0;
#pragma unroll
        for (int j = 0; j < 64; ++j) { const int cj = __builtin_amdgcn_readlane(c, j); xoff += (j < lane) ? cj : 0; }
    }
    int pmn = 0; float wn = 0.f; float2 stn = make_float2(0.f, 0.f);
    {
        const int row = blk * 4 + wid;
        if (row < NTOK) { if (lane < 8) { pmn = pmap[row * 8 + lane]; wn = wsel[row * 8 + lane]; } stn = lnstat[row]; }
    }
    for (int row = blk * 4 + wid; row < NTOK; row += nb * 4) {
        const int b = row >> 12;
        int yr = pmn; const float yw = wn; const float2 st1 = stn;
        {
            const int nrow = row + nb * 4;
            if (nrow < NTOK) { if (lane < 8) { pmn = pmap[nrow * 8 + lane]; wn = wsel[nrow * 8 + lane]; } stn = lnstat[nrow]; }
        }
        { const int e = (yr >> 16) & 63; const int xo = __builtin_amdgcn_ds_bpermute(e << 2, xoff); yr = xo + (yr & 0xFFFF); }
        int yrow[8]; float yww[8];
#pragma unroll
        for (int k = 0; k < 8; ++k) { yrow[k] = __builtin_amdgcn_readlane(yr, k); yww[k] = __builtin_bit_cast(float, __builtin_amdgcn_readlane(__builtin_bit_cast(int, yw), k)); }
        uint2 zvv[4]; int ysh[4]; int yvk[4][8];
#pragma unroll
        for (int i = 0; i < 4; ++i) {
            const int col = i * 256 + lane * 4;
            zvv[i] = *(const uint2*)(zbuf + (size_t)row * DM + col);
            ysh[i] = *(const int*)(ybuf + ((size_t)(262144 + row)) * 1024 + col);
#pragma unroll
            for (int k = 0; k < 8; ++k) yvk[i][k] = *(const int*)(ybuf + (size_t)yrow[k] * 1024 + col);
        }
        float4 z[4]; float s = 0.f;
#pragma unroll
        for (int i = 0; i < 4; ++i) {
            const int col = i * 256 + lane * 4;
            float4 x1;
            { const uint2 zv = zvv[i];
              float4 z1; z1.x = __uint_as_float(zv.x << 16); z1.y = __uint_as_float(zv.x & 0xFFFF0000u); z1.z = __uint_as_float(zv.y << 16); z1.w = __uint_as_float(zv.y & 0xFFFF0000u);
              const float4 g1 = *(const float4*)(p->in[I_LN1G] + l * 1024 + col), b1 = *(const float4*)(p->in[I_LN1B] + l * 1024 + col);
              x1.x = (z1.x - st1.x) * st1.y * g1.x + b1.x; x1.y = (z1.y - st1.x) * st1.y * g1.y + b1.y; x1.z = (z1.z - st1.x) * st1.y * g1.z + b1.z; x1.w = (z1.w - st1.x) * st1.y * g1.w + b1.w; }
            float f0, f1, f2, f3;
            { const int yv = ysh[i];
              const f2_t lo = __builtin_amdgcn_cvt_pk_f32_fp8(yv, false), hi = __builtin_amdgcn_cvt_pk_f32_fp8(yv, true);
              f0 = lo[0]; f1 = lo[1]; f2 = hi[0]; f3 = hi[1]; }
#pragma unroll
            for (int k = 0; k < 8; ++k) {
                const f2_t lo = __builtin_amdgcn_cvt_pk_f32_fp8(yvk[i][k], false), hi = __builtin_amdgcn_cvt_pk_f32_fp8(yvk[i][k], true);
                const float w = yww[k];
                f0 = fmaf(w, lo[0], f0); f1 = fmaf(w, lo[1], f1); f2 = fmaf(w, hi[0], f2); f3 = fmaf(w, hi[1], f3);
            }
            const float4 g2 = *(const float4*)(mod + (size_t)(l * 8 + b) * 6144 + 5120 + col);
            z[i].x = ALPHA * x1.x + (1.f + g2.x) * f0; z[i].y = ALPHA * x1.y + (1.f + g2.y) * f1; z[i].z = ALPHA * x1.z + (1.f + g2.z) * f2; z[i].w = ALPHA * x1.w + (1.f + g2.w) * f3;
            s += z[i].x + z[i].y + z[i].z + z[i].w;
        }
        const float mean = wave_sum(s) * (1.f / 1024.f);
        float q = 0.f;
#pragma unroll
        for (int i = 0; i < 4; ++i) { z[i].x -= mean; z[i].y -= mean; z[i].z -= mean; z[i].w -= mean; q += z[i].x * z[i].x + z[i].y * z[i].y + z[i].z * z[i].z + z[i].w * z[i].w; }
        const float rs = rsqrtf(wave_sum(q) * (1.f / 1024.f) + LN_EPS);
#pragma unroll
        for (int i = 0; i < 4; ++i) {
            const int col = i * 256 + lane * 4;
            const float4 g = *(const float4*)(p->in[I_LN2G] + l * 1024 + col), bb = *(const float4*)(p->in[I_LN2B] + l * 1024 + col);
            float4 x2; x2.x = z[i].x * rs * g.x + bb.x; x2.y = z[i].y * rs * g.y + bb.y; x2.z = z[i].z * rs * g.z + bb.z; x2.w = z[i].w * rs * g.w + bb.w;
            if (l + 1 < DEPTH) { uint2 ox; ox.x = pack2(x2.x, x2.y); ox.y = pack2(x2.z, x2.w); *(uint2*)((bf16_t*)xout + (size_t)row * DM + col) = ox; }
            else *(float4*)(xout + (size_t)row * DM + col) = x2;
            if (l + 1 < DEPTH) {
                const float4 sh = *(const float4*)(mod + (size_t)((l + 1) * 8 + b) * 6144 + col), sc = *(const float4*)(mod + (size_t)((l + 1) * 8 + b) * 6144 + 1024 + col);
                uint2 o; o.x = pack2(x2.x * (1.f + sc.x) + sh.x, x2.y * (1.f + sc.y) + sh.y); o.y = pack2(x2.z * (1.f + sc.z) + sh.z, x2.w * (1.f + sc.w) + sh.w);
                *(uint2*)(ubuf + (size_t)row * DM + col) = o;
            }
        }
    }
}

#define XB_TMO      128
#define XB_XCNT(j)  (256  + 64 * (j))
#define XB_XSUB(j)  (1280 + 64 * (j))
#define XB_XGEN(j)  (2304 + 64 * (j))
#define XB_TOP      3328
#define XB_TOPGEN   3392
#define XCD_BAR_WORDS 3456
#define XB_SPIN_CAP (1u << 20)
DEVINL unsigned xb_ld(unsigned* p)              { return __hip_atomic_load(p, __ATOMIC_RELAXED, __HIP_MEMORY_SCOPE_AGENT); }
DEVINL unsigned xb_add(unsigned* p, unsigned v) { return __hip_atomic_fetch_add(p, v, __ATOMIC_RELAXED, __HIP_MEMORY_SCOPE_AGENT); }
DEVINL unsigned xb_xcc_id() { return (unsigned)__builtin_amdgcn_s_getreg((3 << 11) | 20) & 0xFu; }
#define XB_SPIN(cond, bar) do { unsigned _sp = 0; while (cond) { __builtin_amdgcn_s_sleep(1); \
    if ((++_sp & 255u) == 0u) { if (xb_ld(&(bar)[XB_TMO])) break; if (_sp > XB_SPIN_CAP) { atomicAdd(&(bar)[XB_TMO], 1u); break; } } } } while (0)
struct XcdBarrier { unsigned* bar; unsigned x; volatile LAS unsigned* st; };
DEVINL XcdBarrier xcd_barrier_post(unsigned* bar, volatile LAS unsigned* st) {
    XcdBarrier b; b.bar = bar; b.x = xb_xcc_id(); b.st = st;
    if (threadIdx.x == 0) (void)xb_add(&bar[XB_XCNT(b.x)], 1u);
    return b;
}
DEVINL void xcd_barrier_complete(unsigned* bar, unsigned x, unsigned& nloc, unsigned& nx) {
    const unsigned G = gridDim.x * gridDim.y * gridDim.z;
    unsigned sum, cnt, mine, sp = 0u;
    for (;;) {
        sum = 0u; cnt = 0u; mine = 0u;
#pragma unroll 1
        for (unsigned j = 0; j < 16; ++j) { const unsigned c = xb_ld(&bar[XB_XCNT(j)]); sum += c; cnt += (c > 0u) ? 1u : 0u; mine = (j == x) ? c : mine; }
        if (sum == G) break;
        __builtin_amdgcn_s_sleep(1);
        if ((++sp & 255u) == 0u) { if (xb_ld(&bar[XB_TMO])) break; if (sp > XB_SPIN_CAP) { atomicAdd(&bar[XB_TMO], 1u); break; } }
    }
    nloc = mine > 0u ? mine : 1u; nx = cnt > 0u ? cnt : 1u;
}
DEVINL void xcd_barrier(const XcdBarrier& b) {
    asm volatile("s_waitcnt vmcnt(0)" ::: "memory");
    __syncthreads();
    if (threadIdx.x == 0) {
        unsigned* bar = b.bar;
        __builtin_amdgcn_s_waitcnt(0);
        unsigned nloc = b.st[0], nx = b.st[1];
        if (nloc == 0u) { xcd_barrier_complete(bar, b.x, nloc, nx); b.st[0] = nloc; b.st[1] = nx; }
        const unsigned old = xb_add(&bar[XB_XSUB(b.x)], 1u);
        const unsigned gen = old / nloc;
        if (old + 1u == (gen + 1u) * nloc) {
            __builtin_amdgcn_fence(__ATOMIC_RELEASE, "agent");
            asm volatile("s_waitcnt vmcnt(0)" ::: "memory");
            const unsigned og = xb_add(&bar[XB_TOP], 1u);
            const unsigned tg = og / nx;
            if (og + 1u == (tg + 1u) * nx) xb_add(&bar[XB_TOPGEN], 1u);
            else XB_SPIN(xb_ld(&bar[XB_TOPGEN]) == tg, bar);
            __builtin_amdgcn_fence(__ATOMIC_ACQUIRE, "agent");
            xb_add(&bar[XB_XGEN(b.x)], 1u);
            asm volatile("s_waitcnt vmcnt(0)" ::: "memory");
        } else {
            XB_SPIN(xb_ld(&bar[XB_XGEN(b.x)]) == gen, bar);
            __builtin_amdgcn_fence(__ATOMIC_ACQUIRE, "agent");
            asm volatile("s_waitcnt vmcnt(0)" ::: "memory");
        }
    }
    __syncthreads();
}

constexpr int PPL = 12;
constexpr int NPHASE = 2 + PPL * DEPTH;
#ifndef PROBE_SUB
#define PROBE_SUB 3
#endif
#ifndef PROBE_REP
#define PROBE_REP (-1)
#endif
__global__ void __launch_bounds__(NTHREADS, 2) mega(Params p_arg, int ph_lo, int ph_hi) {
    extern __shared__ __attribute__((aligned(16))) char lds[];
    cg::grid_group grid = cg::this_grid();
    volatile LAS unsigned* st = (volatile LAS unsigned*)(lds + LDS_BYTES - 16);
    if (threadIdx.x == 0) { st[0] = 0u; st[1] = 0u; }
    __syncthreads();
    XcdBarrier xb = xcd_barrier_post((unsigned*)(p_arg.ws + OFF_BAR), st);
    for (int ph = ph_lo; ph < ph_hi; ++ph) {
        KP p = (KP)__builtin_amdgcn_kernarg_segment_ptr();
        asm volatile("" : "+s"(p));
        const int l = (ph >= 2) ? (ph - 2) / PPL : 0;
        const int q = (ph >= 2) ? (ph - 2) % PPL : -1;
        const bool nobar = (q >= 1 && q <= 3);
        const int nrep = (PROBE_REP >= 0 && ph == PROBE_REP) ? 2 : 1;
        for (int rep = 0; rep < nrep; ++rep) {
            const int dry = (PROBE_REP >= 0 && ph == PROBE_REP && rep == 0) ? 1 : 0;
            char* ldsh = lds + (threadIdx.x >> 8) * LDS_HALF;
            if (ph == 0) phase0(p, ldsh);
            else if (ph == 1) phaseF0(p);
            else {
                switch (q) {
                    case 0: phaseA(p, l, lds); break;
                    case 1: phaseB1(p, l, ldsh, 1, (PROBE_REP >= 0 && ph == PROBE_REP && rep == 1) ? PROBE_SUB : 3); break;
                    case 2: phaseB1(p, l, ldsh, 2); break;
                    case 3: phaseB1(p, l, ldsh, 4); break;
                    case 4: phaseB1(p, l, ldsh, 8); break;
                    case 5: phaseB2(p, l, ldsh); break;
                    case 6: phaseB3(p, l); break;
                    case 7: phaseC(p, l, lds); break;
                    case 8: phaseD(p, l, ldsh, dry); break;
                    case 9: phaseE1(p, l, lds); break;
                    case 10: phaseE2(p, l, lds); break;
                    default: phaseF(p, l, dry); break;
                }
            }
            const bool lastrep = (rep + 1 == nrep);
            if (!lastrep || (ph + 1 < ph_hi && !nobar)) { if (lastrep && ph == ph_lo) grid.sync(); else xcd_barrier(xb); }
        }
    }
}

extern "C" void kernel_launch(void* const* d_in, const int* in_sizes, int n_in, void* d_out, int out_size, void* d_ws, size_t ws_size, hipStream_t stream) {
    static int grid_blocks = 0;
    if (grid_blocks == 0) {
        if (n_in != 39 || out_size != NTOK * DM || ws_size < WS_NEED) { fprintf(stderr, "kernel_launch: unexpected shapes (n_in %d out %d ws %zu need %zu)\n", n_in, out_size, ws_size, (size_t)WS_NEED); grid_blocks = -1; return; }
        int dev = 0, cus = 0, per_cu = 0;
        hipGetDevice(&dev);
        hipDeviceGetAttribute(&cus, hipDeviceAttributeMultiprocessorCount, dev);
        hipFuncSetAttribute((const void*)mega, hipFuncAttributeMaxDynamicSharedMemorySize, LDS_BYTES);
        hipOccupancyMaxActiveBlocksPerMultiprocessor(&per_cu, (const void*)mega, NTHREADS, LDS_BYTES);
        if (per_cu < 1) { fprintf(stderr, "kernel_launch: occupancy query returned %d\n", per_cu); grid_blocks = -1; return; }
        if (cus < 256) { fprintf(stderr, "kernel_launch: this build needs 256 CUs (found %d)\n", cus); grid_blocks = -1; return; }
        grid_blocks = 256;
    }
    if (grid_blocks < 0) return;
    if (hipMemsetAsync(d_ws, 0, 32768, stream) != hipSuccess) { fprintf(stderr, "kernel_launch: memset failed\n"); return; }
    Params p{};
    for (int i = 0; i < 39; ++i) p.in[i] = (const float*)d_in[i];
    p.out = (float*)d_out; p.ws = (unsigned char*)d_ws;
    int ph_lo = 0, ph_hi = NPHASE;
    void* args[] = {&p, &ph_lo, &ph_hi};
    hipError_t e = hipLaunchCooperativeKernel((const void*)mega, dim3(grid_blocks), dim3(NTHREADS), args, LDS_BYTES, stream);
    if (e != hipSuccess) fprintf(stderr, "cooperative launch failed: %s (grid %d)\n", hipGetErrorString(e), grid_blocks);
}
```

```cpp
#include <hip/hip_runtime.h>
#include <hip/hip_cooperative_groups.h>
#include <stdio.h>
#include <stdint.h>
namespace cg = cooperative_groups;

typedef unsigned short bf16_t;
typedef short bf16x8 __attribute__((ext_vector_type(8)));
typedef float f32x4 __attribute__((ext_vector_type(4)));
#define DEVINL __device__ __forceinline__
#define LAS __attribute__((address_space(3)))
#define MFMA32(a, b, c) __builtin_amdgcn_mfma_f32_32x32x16_bf16((a), (b), (c), 0, 0, 0)

constexpr int NTOK = 32768, SEQ = 4096, NBATCH = 8, DM = 1024, PIN = 2688, DEPTH = 2;
constexpr int NEXP = 64;
constexpr float ALPHA = 1.41421356237f;
constexpr float LN_EPS = 1e-5f, GN_EPS = 64e-5f;
constexpr int NTHREADS = 512;
constexpr int VTHREADS = 256;
constexpr int LDS_HALF = 75776;
constexpr int LDS_BYTES = 159744;

constexpr size_t OFF_CNT   = 0;
constexpr size_t OFF_BAR   = 4096;
constexpr size_t OFF_MOD   = 65536;
constexpr size_t OFF_WR    = 524288;
constexpr size_t OFF_WIN   = 1048576;
constexpr int WIN_ROWS = 2816;
constexpr size_t OFF_WOUT  = OFF_WIN + 2 * (size_t)WIN_ROWS * 1024 * 2;
constexpr size_t OFF_W13   = OFF_WOUT + 4194304;
constexpr size_t OFF_W2    = OFF_W13 + 136314880;
constexpr size_t OFF_UBUF  = OFF_W2 + 68157440;
constexpr size_t OFF_ARENA = OFF_UBUF + 67108864;
constexpr size_t A_P      = OFF_ARENA;
constexpr size_t A_YMIX   = A_P + 176160768;
constexpr size_t A_SCAN   = A_YMIX + 67108864;
constexpr size_t A_HLOC   = A_SCAN + 134217728;
constexpr size_t A_CUMA   = A_HLOC + 33554432;
constexpr size_t A_G      = A_CUMA + 33554432;
constexpr size_t A_BONUS  = A_G + 33554432;
constexpr size_t A_YRAW   = A_BONUS + 33554432;
constexpr size_t A_CARRYA = A_YRAW + 33554432;
constexpr size_t A_CARRYH = A_CARRYA + 1048576;
constexpr size_t A_HSTART = A_CARRYH + 1048576;
constexpr size_t A_CHAIN  = A_HSTART + 1048576;
constexpr size_t CHAIN_UNIT = 49152;
constexpr size_t M_YBUF   = OFF_ARENA;
constexpr size_t M_ZB     = OFF_ARENA + 335544320;
constexpr size_t M_HBUF   = M_YBUF + 603979776;
constexpr size_t M_LIST   = M_HBUF + 159383552;
constexpr size_t M_WSEL   = M_LIST + 8388608;
constexpr size_t M_PMAP   = M_WSEL + 1048576;
constexpr size_t M_STAT   = M_PMAP + 1048576;
constexpr size_t OFF_WLT  = M_STAT + 262144;
constexpr size_t OFF_WGT  = OFF_WLT + 131072;
constexpr size_t WS_NEED  = OFF_WGT + 131072;
static_assert(WS_NEED <= (size_t)1 << 30, "workspace layout exceeds the guaranteed 1 GiB");

struct Params {
    const float* in[39];
    float* out;
    unsigned char* ws;
};
typedef const __attribute__((address_space(4))) Params* KP;
__device__ __forceinline__ int TIDX() { int t = threadIdx.x; asm volatile("" : "+v"(t)); t &= 255; return t; }
__device__ __forceinline__ int BIDX() { int b = blockIdx.x * 2 + __builtin_amdgcn_readfirstlane((int)(threadIdx.x >> 8)); asm volatile("" : "+s"(b)); __builtin_assume(b >= 0 && b < 65536); return b; }
__device__ __forceinline__ int NBV() { return gridDim.x * 2; }
__device__ __forceinline__ int TID512() { int t = threadIdx.x; asm volatile("" : "+v"(t)); __builtin_assume(t >= 0 && t < 512); return t; }
enum { I_X = 0, I_C, I_WMOD, I_BMOD, I_WIN, I_WOUT, I_CONVA, I_CONVAB, I_LNAG, I_LNAB, I_CONVB, I_CONVBB, I_WRG, I_BRG, I_WIG, I_BIG,
       I_LAMBDA, I_MUC, I_W0, I_WW2, I_A0, I_WA2, I_WG2, I_KK, I_KA, I_RK, I_GNG, I_GNB, I_CONVD, I_LN1G, I_LN1B, I_WROUTER, I_EBIAS,
       I_W13, I_W2, I_WS13, I_WS2, I_LN2G, I_LN2B };

DEVINL bf16_t f2bf(float f) { unsigned u = __float_as_uint(f); u += 0x7FFFu + ((u >> 16) & 1u); return (bf16_t)(u >> 16); }
DEVINL float bf2f(bf16_t h) { return __uint_as_float(((unsigned)h) << 16); }
typedef __bf16 bf2_t __attribute__((ext_vector_type(2)));
typedef float f2_t __attribute__((ext_vector_type(2)));
typedef float f32x16 __attribute__((ext_vector_type(16)));
DEVINL unsigned pack2(float a, float b) { f2_t v = {a, b}; return __builtin_bit_cast(unsigned, __builtin_convertvector(v, bf2_t)); }
DEVINL float sigm(float x) { return __builtin_amdgcn_rcpf(1.f + __expf(-x)); }
DEVINL float tanh_fast(float x) { const float e = __expf(2.f * x); return 1.f - 2.f * __builtin_amdgcn_rcpf(1.f + e); }
DEVINL float softplusf(float z) { return fmaxf(z, 0.f) + __logf(1.f + __expf(-fabsf(z))); }
DEVINL float softplus_acc(float z) { return fmaxf(z, 0.f) + log1pf(__expf(-fabsf(z))); }
DEVINL float gelu_tanh(float x) { float u = 0.7978845608028654f * (x + 0.044715f * x * x * x); return 0.5f * x * (1.f + tanh_fast(u)); }
DEVINL float group8_max(float x) {
    x = fmaxf(x, __builtin_bit_cast(float, __builtin_amdgcn_update_dpp(0, __builtin_bit_cast(int, x), 0xB1, 0xf, 0xf, true)));
    x = fmaxf(x, __builtin_bit_cast(float, __builtin_amdgcn_update_dpp(0, __builtin_bit_cast(int, x), 0x4E, 0xf, 0xf, true)));
    x = fmaxf(x, __builtin_bit_cast(float, __builtin_amdgcn_update_dpp(0, __builtin_bit_cast(int, x), 0x141, 0xf, 0xf, true)));
    return x;
}
DEVINL float wave_sum_dpp(float x);
DEVINL float wave_sum(float x) { return wave_sum_dpp(x); }
DEVINL float wave_sum_dpp(float x) {
    x += __builtin_bit_cast(float, __builtin_amdgcn_update_dpp(0, __builtin_bit_cast(int, x), 0xB1, 0xf, 0xf, true));
    x += __builtin_bit_cast(float, __builtin_amdgcn_update_dpp(0, __builtin_bit_cast(int, x), 0x4E, 0xf, 0xf, true));
    x += __builtin_bit_cast(float, __builtin_amdgcn_update_dpp(0, __builtin_bit_cast(int, x), 0x141, 0xf, 0xf, true));
    x += __builtin_bit_cast(float, __builtin_amdgcn_update_dpp(0, __builtin_bit_cast(int, x), 0x140, 0xf, 0xf, true));
    x += __builtin_bit_cast(float, __builtin_amdgcn_update_dpp(0, __builtin_bit_cast(int, x), 0x142, 0xa, 0xf, false));
    x += __builtin_bit_cast(float, __builtin_amdgcn_update_dpp(0, __builtin_bit_cast(int, x), 0x143, 0xc, 0xf, false));
    return __builtin_bit_cast(float, __builtin_amdgcn_readlane(__builtin_bit_cast(int, x), 63));
}

DEVINL int lds_byte(int r, int c) { int st = (r >> 4) * 2 + (c >> 5), rr = r & 15, cc = c & 31, ob = rr * 64 + cc * 2; return st * 1024 + (ob ^ (((ob >> 9) & 1) << 5)); }
DEVINL void stage_rc(int b, int& R, int& C) { int st = b / 1024, sb = b % 1024, swz = sb ^ (((sb >> 9) & 1) << 5); R = (st >> 1) * 16 + swz / 64; C = (st & 1) * 32 + (swz % 64) / 2; }

template <class RowPtr, class Epi>
DEVINL void gemm_tile128(char* lds, RowPtr arow, const bf16_t* Bt, int K, Epi epi) {
    const int tid = TIDX();
    const bf16_t* ap[4]; const bf16_t* bp[4];
#pragma unroll
    for (int i = 0; i < 4; ++i) { int R, C; stage_rc(tid * 16 + i * 4096, R, C); ap[i] = arow(R) + C; bp[i] = Bt + (size_t)R * K + C; }
    const int wid = tid >> 6, lane = tid & 63, wr = wid >> 1, wc = wid & 1, fr = lane & 15, fq = lane >> 4;
    f32x4 acc[4][4];
#pragma unroll
    for (int m = 0; m < 4; ++m)
#pragma unroll
        for (int n = 0; n < 4; ++n) acc[m][n] = (f32x4){0.f, 0.f, 0.f, 0.f};
    const int nk = K >> 6;
#pragma unroll
    for (int i = 0; i < 4; ++i) {
        __builtin_amdgcn_global_load_lds((const unsigned*)(ap[i]), (unsigned*)(lds + tid * 16 + i * 4096), 16, 0, 0);
        __builtin_amdgcn_global_load_lds((const unsigned*)(bp[i]), (unsigned*)(lds + 16384 + tid * 16 + i * 4096), 16, 0, 0);
    }
    for (int kt = 0; kt < nk; ++kt) {
        asm volatile("s_waitcnt vmcnt(0)" ::: "memory");
        __syncthreads();
        char* cur = lds + (kt & 1) * 32768;
        if (kt + 1 < nk) {
            char* nxt = lds + ((kt + 1) & 1) * 32768;
            const int ko = (kt + 1) * 64;
#pragma unroll
            for (int i = 0; i < 4; ++i) {
                __builtin_amdgcn_global_load_lds((const unsigned*)(ap[i] + ko), (unsigned*)(nxt + tid * 16 + i * 4096), 16, 0, 0);
                __builtin_amdgcn_global_load_lds((const unsigned*)(bp[i] + ko), (unsigned*)(nxt + 16384 + tid * 16 + i * 4096), 16, 0, 0);
            }
        }
        bf16x8 af[4][2], bfr[4][2];
#pragma unroll
        for (int m = 0; m < 4; ++m)
#pragma unroll
            for (int kk = 0; kk < 2; ++kk) af[m][kk] = *reinterpret_cast<const bf16x8*>(cur + lds_byte(wr * 64 + m * 16 + fr, kk * 32 + fq * 8));
#pragma unroll
        for (int n = 0; n < 4; ++n)
#pragma unroll
            for (int kk = 0; kk < 2; ++kk) bfr[n][kk] = *reinterpret_cast<const bf16x8*>(cur + 16384 + lds_byte(wc * 64 + n * 16 + fr, kk * 32 + fq * 8));
#pragma unroll
        for (int kk = 0; kk < 2; ++kk)
#pragma unroll
            for (int m = 0; m < 4; ++m)
#pragma unroll
                for (int n = 0; n < 4; ++n) acc[m][n] = __builtin_amdgcn_mfma_f32_16x16x32_bf16(bfr[n][kk], af[m][kk], acc[m][n], 0, 0, 0);
    }
    __syncthreads();
    epi(acc, wr, wc, fr, fq);
}

template <class Ptrs, class Epi>
DEVINL void gemm_stream128(char* lds, int K, int blk, int nb, int total, Ptrs ptrs, Epi epi) {
    const int qx = nb >> 3, first = (blk & 7) * qx + (blk >> 3), stride = nb;
    if (first >= total) return;
    const int tid = TIDX();
    const int wid = tid >> 6, lane = tid & 63, wr = wid >> 1, wc = wid & 1, fr = lane & 15, fq = lane >> 4;
    const int nk = K >> 6;
    const bf16_t* ap[4]; const bf16_t* bp[4];
    const bf16_t* an[4]; const bf16_t* bn[4];
    int t = first;
    ptrs(t, ap, bp);
#pragma unroll
    for (int i = 0; i < 4; ++i) {
        __builtin_amdgcn_global_load_lds((const unsigned*)(ap[i]), (unsigned*)(lds + tid * 16 + i * 4096), 16, 0, 0);
        __builtin_amdgcn_global_load_lds((const unsigned*)(bp[i]), (unsigned*)(lds + 16384 + tid * 16 + i * 4096), 16, 0, 0);
    }
    for (;;) {
        const int tn = t + stride;
        const bool has_next = tn < total;
        if (has_next) ptrs(tn, an, bn);
        f32x4 acc[4][4];
#pragma unroll
        for (int m = 0; m < 4; ++m)
#pragma unroll
            for (int n = 0; n < 4; ++n) acc[m][n] = (f32x4){0.f, 0.f, 0.f, 0.f};
        for (int kt = 0; kt < nk; ++kt) {
            asm volatile("s_waitcnt vmcnt(0)" ::: "memory");
            __syncthreads();
            char* cur = lds + (kt & 1) * 32768;
            if (kt + 1 < nk) {
                char* nxt = lds + ((kt + 1) & 1) * 32768;
                const int ko = (kt + 1) * 64;
#pragma unroll
                for (int i = 0; i < 4; ++i) {
                    __builtin_amdgcn_global_load_lds((const unsigned*)(ap[i] + ko), (unsigned*)(nxt + tid * 16 + i * 4096), 16, 0, 0);
                    __builtin_amdgcn_global_load_lds((const unsigned*)(bp[i] + ko), (unsigned*)(nxt + 16384 + tid * 16 + i * 4096), 16, 0, 0);
                }
            } else if (has_next) {
#pragma unroll
                for (int i = 0; i < 4; ++i) {
                    __builtin_amdgcn_global_load_lds((const unsigned*)(an[i]), (unsigned*)(lds + tid * 16 + i * 4096), 16, 0, 0);
                    __builtin_amdgcn_global_load_lds((const unsigned*)(bn[i]), (unsigned*)(lds + 16384 + tid * 16 + i * 4096), 16, 0, 0);
                }
            }
            bf16x8 af[4][2], bfr[4][2];
#pragma unroll
            for (int m = 0; m < 4; ++m)
#pragma unroll
                for (int kk = 0; kk < 2; ++kk) af[m][kk] = *reinterpret_cast<const bf16x8*>(cur + lds_byte(wr * 64 + m * 16 + fr, kk * 32 + fq * 8));
#pragma unroll
            for (int n = 0; n < 4; ++n)
#pragma unroll
                for (int kk = 0; kk < 2; ++kk) bfr[n][kk] = *reinterpret_cast<const bf16x8*>(cur + 16384 + lds_byte(wc * 64 + n * 16 + fr, kk * 32 + fq * 8));
#pragma unroll
            for (int kk = 0; kk < 2; ++kk)
#pragma unroll
                for (int m = 0; m < 4; ++m)
#pragma unroll
                    for (int n = 0; n < 4; ++n) acc[m][n] = __builtin_amdgcn_mfma_f32_16x16x32_bf16(bfr[n][kk], af[m][kk], acc[m][n], 0, 0, 0);
        }
        epi(t, acc, wr, wc, fr, fq);
        if (!has_next) break;
        t = tn;
#pragma unroll
        for (int i = 0; i < 4; ++i) { ap[i] = an[i]; bp[i] = bn[i]; }
    }
    __syncthreads();
}
DEVINL void stage_coords(int (&R)[4], int (&C)[4]) {
    const int tid = TIDX();
#pragma unroll
    for (int i = 0; i < 4; ++i) stage_rc(tid * 16 + i * 4096, R[i], C[i]);
}

struct GUnit {
    const char* A;
    const char* B;
    unsigned va[2][2] = {{0u, 0u}, {0u, 0u}};
    int i0, i1, i2;
};
constexpr int G_HTB = 128 * 64 * 2;
constexpr int G_STAGE_BYTES = 8 * G_HTB;
DEVINL int perm32(int rho) { const int n = rho >> 4, i = rho & 15; return 8 * (i >> 2) + 4 * n + (i & 3); }
DEVINL void stage_coords512(int tid, int (&R)[2], int (&C)[2]) {
#pragma unroll
    for (int i = 0; i < 2; ++i) stage_rc(tid * 16 + i * 8192, R[i], C[i]);
}

template <bool PERM, bool GATHER, class Sched, class Epi>
DEVINL void gemm256(char* lds_generic, int K, int lda, Sched sched, Epi epi) {
    LAS unsigned char* lds = (LAS unsigned char*)lds_generic;
    const int tid = TID512(), wid = __builtin_amdgcn_readfirstlane(tid >> 6), lane = tid & 63, wr = wid >> 2, wc = wid & 3, fr = lane & 15, fq = lane >> 4;
    const int nt = K / 64;
    unsigned voffB[2];
#pragma unroll
    for (int i = 0; i < 2; ++i) { int R, C; stage_rc(tid * 16 + i * 8192, R, C); const int Rb = PERM ? ((R & ~31) + perm32(R & 31)) : R; voffB[i] = (unsigned)(Rb * K + C) * 2u; }
    unsigned voffA[2];
#pragma unroll
    for (int i = 0; i < 2; ++i) { int R, C; stage_rc(tid * 16 + i * 8192, R, C); voffA[i] = (unsigned)(R * lda + C) * 2u; }
    const size_t hstepA = GATHER ? 0 : (size_t)128 * lda * 2;
    const size_t kstep = (size_t)(64 * 2);
    const size_t hstepB = (size_t)128 * K * 2;
    const unsigned ldsw = (unsigned)wid * 1024u;
    const int aoff = lds_byte(wr * 64 + fr, fq * 8), boff = lds_byte(wc * 32 + fr, fq * 8);
#define G_SA(b, h) (((b) * 2 + (h)) * G_HTB)
#define G_SB(b, h) ((4 + (b) * 2 + (h)) * G_HTB)
#define G_STAGE(bufoff, gbase, voff) do { _Pragma("unroll") for (int _i = 0; _i < 2; ++_i) { unsigned _vo = (voff)[_i]; asm volatile("" : "+v"(_vo)); \
        __builtin_amdgcn_global_load_lds((const unsigned*)((const char*)(gbase) + _vo), (LAS unsigned*)(lds + (bufoff) + ldsw + _i * 8192), 16, 0, 0); } } while (0)
#define G_STAGE_A(bufoff, ptr, vg, h) do { if constexpr (GATHER) { G_STAGE(bufoff, ptr, vg); } else { G_STAGE(bufoff, (ptr) + (h) * hstepA, voffA); } } while (0)
#define G_LDA(dst, b, h) do { _Pragma("unroll") for (int m = 0; m < 4; ++m) _Pragma("unroll") for (int k = 0; k < 2; ++k) dst[m][k] = *(const LAS bf16x8*)(lds + G_SA(b, h) + aoff + m * 2048 + k * 1024); } while (0)
#define G_LDB(dst, b, h) do { _Pragma("unroll") for (int n = 0; n < 2; ++n) _Pragma("unroll") for (int k = 0; k < 2; ++k) dst[n][k] = *(const LAS bf16x8*)(lds + G_SB(b, h) + boff + n * 2048 + k * 1024); } while (0)
#define G_MMA(ai, bj, At, Bt) do { __builtin_amdgcn_s_setprio(1); _Pragma("unroll") for (int m = 0; m < 4; ++m) _Pragma("unroll") for (int n = 0; n < 2; ++n) _Pragma("unroll") for (int k = 0; k < 2; ++k) \
        acc[ai][bj][m][n] = __builtin_amdgcn_mfma_f32_16x16x32_bf16(Bt[n][k], At[m][k], acc[ai][bj][m][n], 0, 0, 0); __builtin_amdgcn_s_setprio(0); } while (0)
#define G_WAIT_V(n) asm volatile("s_waitcnt vmcnt(" #n ")" ::: "memory")
#define G_WAIT_L(n) asm volatile("s_waitcnt lgkmcnt(" #n ")" ::: "memory")
#define G_BAR __builtin_amdgcn_s_barrier()
#define G_SCHED __builtin_amdgcn_sched_barrier(0)
    GUnit cur, nxt; int ui = 0;
    if (!sched(0, cur)) return;
    LAS unsigned* vst = (LAS unsigned*)(lds + 131072 + 8192) + tid * 8;
    if constexpr (GATHER) { vst[0] = cur.va[0][0]; vst[1] = cur.va[0][1]; vst[2] = cur.va[1][0]; vst[3] = cur.va[1][1]; }
    f32x4 acc[2][2][4][2];
#pragma unroll
    for (int a = 0; a < 2; ++a)
#pragma unroll
        for (int b = 0; b < 2; ++b)
#pragma unroll
            for (int m = 0; m < 4; ++m)
#pragma unroll
                for (int n = 0; n < 2; ++n) acc[a][b][m][n] = (f32x4){0.f, 0.f, 0.f, 0.f};
    bf16x8 At[4][2], B0[2][2], B1[2][2];
    G_STAGE(G_SB(0, 0), cur.B, voffB); G_STAGE_A(G_SA(0, 0), cur.A, cur.va[0], 0); G_STAGE(G_SB(0, 1), cur.B + hstepB, voffB); G_STAGE_A(G_SA(0, 1), cur.A, cur.va[1], 1);
    if (wr == 1) G_BAR;
    G_WAIT_V(4); G_BAR;
    G_STAGE(G_SB(1, 0), cur.B + kstep, voffB); G_STAGE_A(G_SA(1, 0), cur.A + kstep, cur.va[0], 0); G_STAGE(G_SB(1, 1), cur.B + hstepB + kstep, voffB);
    G_WAIT_V(6); G_BAR;
    for (;;) {
        const bool has_next = sched(ui + 1, nxt);
        if (!has_next) nxt = cur;
        if constexpr (GATHER) { LAS unsigned* vn = vst + ((ui + 1) & 1) * 4; vn[0] = nxt.va[0][0]; vn[1] = nxt.va[0][1]; vn[2] = nxt.va[1][0]; vn[3] = nxt.va[1][1]; }
        for (int t = 0; t < nt; t += 2) {
            const bool last = (t == nt - 2);
            const char* a1 = cur.A + (size_t)(t + 1) * kstep;
            const char* a2 = last ? nxt.A : cur.A + (size_t)(t + 2) * kstep; const char* b2 = last ? nxt.B : cur.B + (size_t)(t + 2) * kstep;
            const char* a3 = a2 + kstep; const char* b3 = b2 + kstep;
            G_LDB(B0, 0, 0); G_SCHED; G_LDA(At, 0, 0); { unsigned nv[2] = {0u, 0u}; if constexpr (GATHER) { LAS unsigned* q_ = vst + (ui & 1) * 4; nv[0] = q_[2]; nv[1] = q_[3]; } G_STAGE_A(G_SA(1, 1), a1, nv, 1); }
            G_WAIT_L(8); G_BAR; G_WAIT_L(0); G_MMA(0, 0, At, B0); G_BAR; G_SCHED;
            G_LDB(B1, 0, 1); G_STAGE(G_SB(0, 0), b2, voffB);
            G_BAR; G_WAIT_L(0); G_MMA(0, 1, At, B1); G_BAR;
            G_LDA(At, 0, 1); { unsigned nv[2] = {0u, 0u}; if constexpr (GATHER) { LAS unsigned* q_ = vst + ((ui + (last ? 1 : 0)) & 1) * 4; nv[0] = q_[0]; nv[1] = q_[1]; } G_STAGE_A(G_SA(0, 0), a2, nv, 0); }
            G_BAR; G_WAIT_L(0); G_MMA(1, 0, At, B0); G_BAR; G_SCHED;
            G_STAGE(G_SB(0, 1), b2 + hstepB, voffB);
            G_WAIT_V(6); G_BAR; G_MMA(1, 1, At, B1); G_BAR;
            G_LDB(B0, 1, 0); G_SCHED; G_LDA(At, 1, 0); { unsigned nv[2] = {0u, 0u}; if constexpr (GATHER) { LAS unsigned* q_ = vst + ((ui + (last ? 1 : 0)) & 1) * 4; nv[0] = q_[2]; nv[1] = q_[3]; } G_STAGE_A(G_SA(0, 1), a2, nv, 1); }
            G_WAIT_L(8); G_BAR; G_WAIT_L(0); G_MMA(0, 0, At, B0); G_BAR; G_SCHED;
            G_LDB(B1, 1, 1); G_STAGE(G_SB(1, 0), b3, voffB);
            G_BAR; G_WAIT_L(0); G_MMA(0, 1, At, B1); G_BAR;
            G_LDA(At, 1, 1); { unsigned nv[2] = {0u, 0u}; if constexpr (GATHER) { LAS unsigned* q_ = vst + ((ui + (last ? 1 : 0)) & 1) * 4; nv[0] = q_[0]; nv[1] = q_[1]; } G_STAGE_A(G_SA(1, 0), a3, nv, 0); }
            G_BAR; G_WAIT_L(0); G_MMA(1, 0, At, B0); G_BAR; G_SCHED;
            G_STAGE(G_SB(1, 1), b3 + hstepB, voffB);
            G_WAIT_V(6); G_BAR; G_MMA(1, 1, At, B1); G_BAR;
        }
        { const int l2 = TID512() & 63; epi(acc, cur, wr, wc, l2 & 15, l2 >> 4); }
        if (!has_next) break;
#pragma unroll
        for (int a = 0; a < 2; ++a)
#pragma unroll
            for (int b = 0; b < 2; ++b)
#pragma unroll
                for (int m = 0; m < 4; ++m)
#pragma unroll
                    for (int n = 0; n < 2; ++n) acc[a][b][m][n] = (f32x4){0.f, 0.f, 0.f, 0.f};
        cur = nxt; ++ui;
    }
    G_WAIT_V(0);
    if (wr == 0) G_BAR;
    G_BAR;
#undef G_SA
#undef G_STAGE_A
#undef G_SB
#undef G_STAGE
#undef G_LDA
#undef G_LDB
#undef G_MMA
#undef G_WAIT_V
#undef G_WAIT_L
#undef G_BAR
#undef G_SCHED
}
DEVINL long unit_linear(int i, int c, int G) { const int q = G >> 3; return ((long)i * 8 + (c & 7)) * q + (c >> 3); }

constexpr int CONV_PER_L = 672 + 256 + 8320 + 4160;
struct ConvJob { const float* src; bf16_t* dst; int K, ld, k0, r0, perm; };
DEVINL ConvJob conv_decode(KP p, int id) {
    ConvJob j; const int l = id / CONV_PER_L; int r = id % CONV_PER_L; int kt, nt;
    if (r < 672) { j.src = p->in[I_WIN] + (size_t)l * 1024 * 2688; j.K = 1024; j.ld = 2688; j.perm = 0; j.dst = (bf16_t*)(p->ws + OFF_WIN) + (size_t)l * WIN_ROWS * 1024; nt = r % 42; kt = r / 42; }
    else if (r < 928) { r -= 672; j.src = p->in[I_WOUT] + (size_t)l * 1024 * 1024; j.K = 1024; j.ld = 1024; j.perm = 0; j.dst = (bf16_t*)(p->ws + OFF_WOUT) + (size_t)l * 1024 * 1024; nt = r & 15; kt = r >> 4; }
    else if (r < 928 + 8320) { r -= 928; const int e = r >> 7, q = r & 127; nt = q & 7; kt = q >> 3; j.K = 1024; j.ld = 512; j.perm = 1;
        j.src = (e < 64) ? p->in[I_W13] + (size_t)(l * 64 + e) * 1024 * 512 : p->in[I_WS13] + (size_t)l * 1024 * 512;
        j.dst = (bf16_t*)(p->ws + OFF_W13) + (size_t)(l * 65 + e) * 512 * 1024; }
    else { r -= 9248; const int e = r >> 6, q = r & 63; nt = q & 15; kt = q >> 4; j.K = 256; j.ld = 1024; j.perm = 0;
        j.src = (e < 64) ? p->in[I_W2] + (size_t)(l * 64 + e) * 256 * 1024 : p->in[I_WS2] + (size_t)l * 256 * 1024;
        j.dst = (bf16_t*)(p->ws + OFF_W2) + (size_t)(l * 65 + e) * 1024 * 256; }
    j.k0 = kt * 64; j.r0 = nt * 64; return j;
}
DEVINL void conv_issue(const ConvJob& j, char* buf, int tid) {
    const int nn = tid & 63, drow = j.r0 + nn;
    int scol = drow;
    if (j.perm) { const int g = drow >> 5, i = drow & 31; scol = (i < 16) ? (g * 16 + i) : (256 + g * 16 + (i - 16)); }
    const float* sp = j.src + (size_t)j.k0 * j.ld + scol;
#pragma unroll
    for (int q = 0; q < 16; ++q) { const int kk = (tid >> 6) + 4 * q;
        __builtin_amdgcn_global_load_lds((const unsigned*)(sp + (size_t)kk * j.ld), (unsigned*)(buf + kk * 260 + nn * 4), 4, 0, 0); }
}
DEVINL void convert_ids(KP p, char* lds, int id_lo, int id_hi, int wb, int nwb) {
    const int tid = TIDX();
    const int n = (id_hi - id_lo + nwb - 1) / nwb;
    auto idof = [&](int i) { const int id = id_lo + i * nwb + wb; return (id < id_hi) ? id : id_hi - 1; };
    ConvJob j0 = conv_decode(p, idof(0)), j1 = conv_decode(p, idof(n > 1 ? 1 : 0));
    conv_issue(j0, lds, tid);
    conv_issue(j1, lds + 16640, tid);
    bf16_t* d0 = j0.dst + (size_t)j0.r0 * j0.K + j0.k0; int K0 = j0.K;
    bf16_t* d1 = j1.dst + (size_t)j1.r0 * j1.K + j1.k0; int K1 = j1.K;
    for (int i = 0; i < n; ++i) {
        const ConvJob j2 = conv_decode(p, idof(i + 2 < n ? i + 2 : n - 1));
        conv_issue(j2, lds + ((i + 2) % 3) * 16640, tid);
        asm volatile("s_waitcnt vmcnt(32)" ::: "memory");
        __builtin_amdgcn_s_barrier();
        const float* tile = (const float*)(lds + (i % 3) * 16640);
        {
            const int kp = (tid & 31) * 2;
#pragma unroll
            for (int q = 0; q < 8; ++q) { const int rr = (tid >> 5) + 8 * q;
                *(unsigned*)(d0 + (size_t)rr * K0 + kp) = pack2(tile[kp * 65 + rr], tile[(kp + 1) * 65 + rr]); }
        }
        asm volatile("s_waitcnt lgkmcnt(0)" ::: "memory");
        __builtin_amdgcn_s_barrier();
        d0 = d1; K0 = K1; d1 = j2.dst + (size_t)j2.r0 * j2.K + j2.k0; K1 = j2.K;
    }
    asm volatile("s_waitcnt vmcnt(0)" ::: "memory");
    __syncthreads();
}

DEVINL void phase0(KP p, char* lds) {
    const int tid = TIDX(), nb = NBV(), blk = BIDX();
    if (blk == 0 && tid < 128) ((unsigned*)(p->ws + OFF_CNT))[tid] = 0u;
    if (blk < 192) {
        float* sc = (float*)lds;
        float* part = (float*)(lds + 32768);
        for (int i = tid; i < 8192; i += VTHREADS) { float c = p->in[I_C][i]; sc[i] = c * sigm(c); }
        __syncthreads();
        const int cl = tid & 63, ks = tid >> 6, n = blk * 64 + cl, l = n / 6144, nn = n % 6144;
        const float* w = p->in[I_WMOD] + (size_t)l * 1024 * 6144 + (size_t)(ks * 256) * 6144 + nn;
        float acc[8];
#pragma unroll
        for (int b = 0; b < 8; ++b) acc[b] = 0.f;
#pragma unroll 32
        for (int k = 0; k < 256; ++k) {
            const float wv = w[(size_t)k * 6144];
#pragma unroll
            for (int b = 0; b < 8; ++b) acc[b] = fmaf(sc[b * 1024 + ks * 256 + k], wv, acc[b]);
        }
#pragma unroll
        for (int b = 0; b < 8; ++b) part[(ks * 8 + b) * 64 + cl] = acc[b];
        __syncthreads();
        if (tid < 64) {
            const float bm = p->in[I_BMOD][l * 6144 + nn];
            float* mod = (float*)(p->ws + OFF_MOD);
#pragma unroll
            for (int b = 0; b < 8; ++b) mod[(size_t)(l * 8 + b) * 6144 + nn] = part[(0 * 8 + b) * 64 + cl] + part[(1 * 8 + b) * 64 + cl] + part[(2 * 8 + b) * 64 + cl] + part[(3 * 8 + b) * 64 + cl] + bm;
        }
        __syncthreads();
    }
    if (blk >= 320 && blk < 384) {
        bf16_t* wgt = (bf16_t*)(p->ws + OFF_WGT);
#pragma unroll
        for (int j = 0; j < 4; ++j) {
            const int idx = (blk - 320) * 1024 + j * 256 + tid;
            const int mat = idx >> 15, lh = (idx >> 12) & 7, d = (idx >> 6) & 63, e = idx & 63;
            const float w = (mat == 0) ? p->in[I_WRG][idx & 32767] : p->in[I_WIG][idx & 32767];
            wgt[(size_t)((lh * 2 + mat) * 64 + e) * 64 + d] = f2bf(w);
        }
    }
    if (blk >= 256 && blk < 320) {
        bf16_t* wlt = (bf16_t*)(p->ws + OFF_WLT);
#pragma unroll
        for (int j = 0; j < 4; ++j) {
            const int idx = (blk - 256) * 1024 + j * 256 + tid, l2 = idx >> 15, f = (idx >> 8) & 127, c = idx & 255;
            const float w = (f < 32) ? p->in[I_WW2][(size_t)(l2 * 32 + f) * 256 + c] : ((f < 64) ? p->in[I_WA2][(size_t)(l2 * 32 + f - 32) * 256 + c] : p->in[I_WG2][(size_t)(l2 * 64 + f - 64) * 256 + c]);
            wlt[(size_t)(l2 * 256 + c) * 128 + f] = f2bf(w);
        }
    }
    if (blk >= 192 && blk < 256) {
        bf16_t* wrt = (bf16_t*)(p->ws + OFF_WR);
#pragma unroll
        for (int j = 0; j < 8; ++j) {
            const int idx = (blk - 192) * 2048 + j * 256 + tid, l2 = idx >> 16, rem = idx & 65535, k = rem >> 6, e = rem & 63;
            const float w = p->in[I_WROUTER][idx];
            const bf16_t hi = f2bf(w); const bf16_t lo = f2bf(w - bf2f(hi));
            wrt[(size_t)((l2 * 2 + 0) * 64 + e) * 1024 + k] = hi; wrt[(size_t)((l2 * 2 + 1) * 64 + e) * 1024 + k] = lo;
        }
    }
    convert_ids(p, lds, 0, 2 * CONV_PER_L, blk, nb);
}

DEVINL void phaseF0(KP p) {
    const int tid = TIDX(), nb = NBV(), blk = BIDX();
    const float* mod = (const float*)(p->ws + OFF_MOD);
    bf16_t* ubuf = (bf16_t*)(p->ws + OFF_UBUF);
    const int col = tid * 4;
    for (int row0 = blk * 8; row0 < NTOK; row0 += nb * 8) {
        float4 x[8];
#pragma unroll
        for (int u = 0; u < 8; ++u) x[u] = *(const float4*)(p->in[I_X] + (size_t)(row0 + u) * DM + col);
        const int b = row0 >> 12;
        const float4 sh = *(const float4*)(mod + (size_t)b * 6144 + col);
        const float4 sc = *(const float4*)(mod + (size_t)b * 6144 + 1024 + col);
#pragma unroll
        for (int u = 0; u < 8; ++u) {
            uint2 o; o.x = pack2(x[u].x * (1.f + sc.x) + sh.x, x[u].y * (1.f + sc.y) + sh.y); o.y = pack2(x[u].z * (1.f + sc.z) + sh.z, x[u].w * (1.f + sc.w) + sh.w);
            *(uint2*)(ubuf + (size_t)(row0 + u) * DM + col) = o;
        }
    }
}

DEVINL void b1_conformer(KP p, int l, char* lds, int item) {
    const int tid = TIDX(), b = item >> 7, tt = item & 127, t0 = tt * 32, rowbase = b * SEQ;
    const bf16_t* P = (const bf16_t*)(p->ws + A_P);
    bf16_t* ymix = (bf16_t*)(p->ws + A_YMIX);
    float w[31];
#pragma unroll
    for (int k = 0; k < 31; ++k) w[k] = p->in[I_CONVA][(size_t)(l * 31 + k) * 256 + tid];
    float acc[32];
    const float bias = p->in[I_CONVAB][l * 256 + tid];
#pragma unroll
    for (int j = 0; j < 32; ++j) acc[j] = bias;
#pragma unroll
    for (int rr = 0; rr < 62; ++rr) {
        const int t = t0 - 30 + rr;
        const bf16_t* pr = P + ((long)(rowbase + t0 - 30) * PIN + tid) + (long)rr * PIN;
        const float val = bf2f(pr[0]), gate = bf2f(pr[256]);
        const float h = (t >= 0) ? val * sigm(gate) : 0.f;
#pragma unroll
        for (int j = 0; j < 32; ++j) { const int k = rr - j; if (k >= 0 && k <= 30) acc[j] = fmaf(w[k], h, acc[j]); }
    }
    float* outb = (float*)lds;
#pragma unroll
    for (int j = 0; j < 32; ++j) outb[j * 256 + tid] = acc[j];
    __syncthreads();
    const int wid = tid >> 6, lane = tid & 63;
    const float4 g4 = *(const float4*)(p->in[I_LNAG] + l * 256 + lane * 4), b4 = *(const float4*)(p->in[I_LNAB] + l * 256 + lane * 4);
    for (int j = wid; j < 32; j += 4) {
        const float4 v = *(const float4*)(outb + j * 256 + lane * 4);
        const float mean = wave_sum(v.x + v.y + v.z + v.w) * (1.f / 256.f);
        const float d0 = v.x - mean, d1 = v.y - mean, d2 = v.z - mean, d3 = v.w - mean;
        const float var = wave_sum(d0 * d0 + d1 * d1 + d2 * d2 + d3 * d3) * (1.f / 256.f);
        const float rs = rsqrtf(var + LN_EPS);
        float y0 = d0 * rs * g4.x + b4.x, y1 = d1 * rs * g4.y + b4.y, y2 = d2 * rs * g4.z + b4.z, y3 = d3 * rs * g4.w + b4.w;
        y0 *= sigm(y0); y1 *= sigm(y1); y2 *= sigm(y2); y3 *= sigm(y3);
        uint2 o; o.x = pack2(y0, y1); o.y = pack2(y2, y3);
        *(uint2*)(ymix + (size_t)(rowbase + t0 + j) * DM + lane * 4) = o;
    }
    __syncthreads();
}

DEVINL void b1_shortconv(KP p, int l, int item) {
    const int tid = TIDX(), cg = tid & 31, tl = tid >> 5, b = item >> 6, t0 = (item & 63) * 64 + tl * 8, rowbase = b * SEQ;
    const bf16_t* P = (const bf16_t*)(p->ws + A_P);
    bf16_t* ymix = (bf16_t*)(p->ws + A_YMIX);
    float w0[8], w1[8], w2[8];
#pragma unroll
    for (int e = 0; e < 8; ++e) { w0[e] = p->in[I_CONVD][(l * 3 + 0) * 256 + cg * 8 + e]; w1[e] = p->in[I_CONVD][(l * 3 + 1) * 256 + cg * 8 + e]; w2[e] = p->in[I_CONVD][(l * 3 + 2) * 256 + cg * 8 + e]; }
    uint4 gbv[8], gcv[10], hdv[10];
#pragma unroll
    for (int u = 0; u < 10; ++u) {
        const int t = t0 - 2 + u;
        const bf16_t* a = P + (size_t)(rowbase + (t >= 0 ? t : 0)) * PIN + 1920 + cg * 8;
        gcv[u] = *(const uint4*)(a + 256); hdv[u] = *(const uint4*)(a + 512);
        if (u >= 2) gbv[u - 2] = *(const uint4*)(a);
    }
    float q2[8], q1[8];
#pragma unroll
    for (int u = 0; u < 10; ++u) {
        const int t = t0 - 2 + u;
        const unsigned gcw[4] = {gcv[u].x, gcv[u].y, gcv[u].z, gcv[u].w}, hdw[4] = {hdv[u].x, hdv[u].y, hdv[u].z, hdv[u].w};
        float q0[8];
#pragma unroll
        for (int e = 0; e < 4; ++e) {
            q0[2 * e] = __uint_as_float(gcw[e] << 16) * __uint_as_float(hdw[e] << 16);
            q0[2 * e + 1] = __uint_as_float(gcw[e] & 0xFFFF0000u) * __uint_as_float(hdw[e] & 0xFFFF0000u);
        }
        if (t < 0) {
#pragma unroll
            for (int e = 0; e < 8; ++e) q0[e] = 0.f;
        }
        if (u >= 2) {
            const unsigned gbw[4] = {gbv[u - 2].x, gbv[u - 2].y, gbv[u - 2].z, gbv[u - 2].w};
            float y[8];
#pragma unroll
            for (int e = 0; e < 4; ++e) {
                y[2 * e] = __uint_as_float(gbw[e] << 16) * (w0[2 * e] * q2[2 * e] + w1[2 * e] * q1[2 * e] + w2[2 * e] * q0[2 * e]);
                y[2 * e + 1] = __uint_as_float(gbw[e] & 0xFFFF0000u) * (w0[2 * e + 1] * q2[2 * e + 1] + w1[2 * e + 1] * q1[2 * e + 1] + w2[2 * e + 1] * q0[2 * e + 1]);
            }
            *(uint4*)(ymix + (size_t)(rowbase + t) * DM + 768 + cg * 8) = make_uint4(pack2(y[0], y[1]), pack2(y[2], y[3]), pack2(y[4], y[5]), pack2(y[6], y[7]));
        }
#pragma unroll
        for (int e = 0; e < 8; ++e) { q2[e] = (u >= 1) ? q1[e] : 0.f; q1[e] = q0[e]; }
    }
}

DEVINL void b1_lru(KP p, int l, char* lds, int item) {
    const int c = TIDX(), b = item >> 7, tt = item & 127, t0 = tt * 32, rowbase = b * SEQ;
    const int h = c >> 6, lane = c & 63, r = lane & 31, hh = lane >> 5;
    const bf16_t* P = (const bf16_t*)(p->ws + A_P);
    constexpr int URS2 = 528;
    char* uA = lds;
    float ureg[32];
    {
        const float cb0 = p->in[I_CONVB][(l * 4 + 0) * 256 + c], cb1 = p->in[I_CONVB][(l * 4 + 1) * 256 + c], cb2 = p->in[I_CONVB][(l * 4 + 2) * 256 + c], cb3 = p->in[I_CONVB][(l * 4 + 3) * 256 + c];
        const float bias = p->in[I_CONVBB][l * 256 + c];
        float xm3 = 0.f, xm2 = 0.f, xm1 = 0.f;
        if (t0 >= 3) { const bf16_t* a = P + (size_t)(rowbase + t0 - 3) * PIN + 512 + c; xm3 = bf2f(a[0]); xm2 = bf2f(a[PIN]); xm1 = bf2f(a[2 * PIN]); }
        bf16_t xr[32];
#pragma unroll
        for (int j = 0; j < 32; ++j) xr[j] = P[(size_t)(rowbase + t0 + j) * PIN + 512 + c];
#pragma unroll
        for (int j = 0; j < 32; ++j) {
            const float x0 = bf2f(xr[j]);
            ureg[j] = cb0 * xm3 + cb1 * xm2 + cb2 * xm1 + cb3 * x0 + bias;
            *(bf16_t*)(uA + j * URS2 + c * 2) = f2bf(ureg[j]);
            xm3 = xm2; xm2 = xm1; xm1 = x0;
        }
    }
    __syncthreads();
    float ar[32], ai[32];
    {
        const bf16_t* wg = (const bf16_t*)(p->ws + OFF_WGT) + (size_t)((l * 4 + h) * 2) * 4096 + (size_t)r * 64 + 8 * hh;
        f32x16 aR0, aR1, aI0, aI1;
#pragma unroll
        for (int i = 0; i < 16; ++i) { aR0[i] = 0.f; aR1[i] = 0.f; aI0[i] = 0.f; aI1[i] = 0.f; }
#pragma unroll
        for (int ks = 0; ks < 4; ++ks) {
            const bf16x8 af = *(const bf16x8*)(uA + r * URS2 + (h * 64 + ks * 16 + 8 * hh) * 2);
            const bf16x8 r0 = *(const bf16x8*)(wg + ks * 16), r1 = *(const bf16x8*)(wg + 32 * 64 + ks * 16);
            const bf16x8 i0 = *(const bf16x8*)(wg + 4096 + ks * 16), i1 = *(const bf16x8*)(wg + 4096 + 32 * 64 + ks * 16);
            aR0 = MFMA32(af, r0, aR0); aR1 = MFMA32(af, r1, aR1); aI0 = MFMA32(af, i0, aI0); aI1 = MFMA32(af, i1, aI1);
        }
        __syncthreads();
        float* xch = (float*)(lds + 17408) + h * 2048;
#define XCHG(X0, X1, OUT) do { _Pragma("unroll") for (int i = 0; i < 16; ++i) { const int t_ = (i & 3) + 8 * (i >> 2) + 4 * hh; xch[t_ * 64 + r] = X0[i]; xch[t_ * 64 + 32 + r] = X1[i]; } \
        _Pragma("unroll") for (int t_ = 0; t_ < 32; ++t_) OUT[t_] = xch[t_ * 64 + lane]; } while (0)
        XCHG(aR0, aR1, ar); XCHG(aI0, aI1, ai);
#undef XCHG
    }
    const float brg = p->in[I_BRG][l * 256 + c], big = p->in[I_BIG][l * 256 + c];
    const float sp = softplus_acc(-p->in[I_LAMBDA][l * 256 + c]);
    unsigned* hp = (unsigned*)(p->ws + A_HLOC) + (size_t)(rowbase + t0) * 256 + c;
    float hs = 0.f, cA = 1.f;
#pragma unroll
    for (int j = 0; j < 32; ++j) {
        const float rg = sigm(ar[j] + brg), ig = sigm(ai[j] + big);
        const float log_a = -8.0f * rg * sp;
        const float a = __expf(log_a);
        const float mult = sqrtf(fmaxf(1.f - a * a, 0.f));
        const float bx = mult * (ig * ureg[j]);
        hs = fmaf(a, hs, bx); cA *= a;
        hp[j * 256] = pack2(hs, cA);
    }
    ((float*)(p->ws + A_CARRYA))[(size_t)(b * 128 + tt) * 256 + c] = cA;
    ((float*)(p->ws + A_CARRYH))[(size_t)(b * 128 + tt) * 256 + c] = hs;
    __syncthreads();
}

DEVINL void b1_rwkv(KP p, int l, char* lds, int item) {
    const int c = TIDX(), b = item >> 7, tt = item & 127, t0 = tt * 32, rowbase = b * SEQ;
    const bf16_t* P = (const bf16_t*)(p->ws + A_P);
    constexpr int FRS = 272;
    char* featA = lds;
    const float* muc = p->in[I_MUC] + l * 896;
    if (c < 128) {
        const int col = 1024 + 768 + c; const float mu = muc[768 + c];
        float prev;
        { const float x = bf2f(P[(size_t)(rowbase + (t0 > 0 ? t0 - 1 : 0)) * PIN + col]); prev = (t0 > 0) ? x : 0.f; }
#pragma unroll 1
        for (int jb = 0; jb < 2; ++jb) {
            bf16_t raw[16];
#pragma unroll
            for (int u = 0; u < 16; ++u) raw[u] = P[(size_t)(rowbase + t0 + jb * 16 + u) * PIN + col];
#pragma unroll
            for (int u = 0; u < 16; ++u) {
                const float cur = bf2f(raw[u]);
                const float xs = cur + (prev - cur) * mu;
                const float val = (c < 32) ? tanh_fast(xs) : ((c < 64) ? xs : sigm(xs));
                *(bf16_t*)(featA + (jb * 16 + u) * FRS + c * 2) = f2bf(val); prev = cur;
            }
        }
    }
    __syncthreads();
    float dec[32], aa[32];
    {
        const int lane = c & 63, h = c >> 6, r = lane & 31, hh = lane >> 5;
        const bf16_t* wl = (const bf16_t*)(p->ws + OFF_WLT) + (size_t)(l * 256 + h * 64 + r) * 128 + 8 * hh;
        f32x16 aW0, aW1, aA0, aA1, aG0, aG1;
#pragma unroll
        for (int i = 0; i < 16; ++i) { aW0[i] = 0.f; aW1[i] = 0.f; aA0[i] = 0.f; aA1[i] = 0.f; aG0[i] = 0.f; aG1[i] = 0.f; }
        bf16x8 b0[8], b1[8];
#pragma unroll
        for (int ks = 0; ks < 8; ++ks) { b0[ks] = *(const bf16x8*)(wl + ks * 16); b1[ks] = *(const bf16x8*)(wl + 32 * 128 + ks * 16); }
#pragma unroll
        for (int ks = 0; ks < 8; ++ks) {
            const bf16x8 af = *(const bf16x8*)(featA + r * FRS + (ks * 16 + 8 * hh) * 2);
            if (ks < 2) { aW0 = MFMA32(af, b0[ks], aW0); aW1 = MFMA32(af, b1[ks], aW1); }
            else if (ks < 4) { aA0 = MFMA32(af, b0[ks], aA0); aA1 = MFMA32(af, b1[ks], aA1); }
            else { aG0 = MFMA32(af, b0[ks], aG0); aG1 = MFMA32(af, b1[ks], aG1); }
        }
        __syncthreads();
        float* xch = (float*)(lds + 9216) + h * 2048;
        float lwv[32], lav[32], lgv[32];
#define XCHG(X0, X1, OUT) do { _Pragma("unroll") for (int i = 0; i < 16; ++i) { const int t_ = (i & 3) + 8 * (i >> 2) + 4 * hh; xch[t_ * 64 + r] = X0[i]; xch[t_ * 64 + 32 + r] = X1[i]; } \
        _Pragma("unroll") for (int t_ = 0; t_ < 32; ++t_) OUT[t_] = xch[t_ * 64 + lane]; } while (0)
        XCHG(aW0, aW1, lwv); XCHG(aA0, aA1, lav); XCHG(aG0, aG1, lgv);
#undef XCHG
#define TOK(X0, X1, t) X0[t]
#define aW0 lwv
#define aA0 lav
#define aG0 lgv
        bf16_t* gbuf = (bf16_t*)(p->ws + A_G);
        const float w0 = p->in[I_W0][l * 256 + c], a0 = p->in[I_A0][l * 256 + c];
#pragma unroll
        for (int j = 0; j < 32; ++j) {
            gbuf[(size_t)(rowbase + t0 + j) * 256 + c] = f2bf(TOK(aG0, aG1, j));
            const float z = w0 + TOK(aW0, aW1, j); const float wlog = -softplusf(-z) - 0.5f; dec[j] = -__expf(wlog);
            aa[j] = sigm(a0 + TOK(aA0, aA1, j));
        }
#undef TOK
#undef aW0
#undef aA0
#undef aG0
    }
    {
        bf16_t* bonus = (bf16_t*)(p->ws + A_BONUS); uint4* scan = (uint4*)(p->ws + A_SCAN);
        const float mur = muc[c], muk = muc[256 + c], muv = muc[512 + c];
        const float kkw = p->in[I_KK][l * 256 + c], kaw = p->in[I_KA][l * 256 + c], rkw = p->in[I_RK][l * 256 + c];
        float pr, pk, pv;
        { const bf16_t* a = P + (size_t)(rowbase + (t0 > 0 ? t0 - 1 : 0)) * PIN + 1024 + c; const float x0 = bf2f(a[0]), x1 = bf2f(a[256]), x2 = bf2f(a[512]);
          pr = (t0 > 0) ? x0 : 0.f; pk = (t0 > 0) ? x1 : 0.f; pv = (t0 > 0) ? x2 : 0.f; }
#pragma unroll
        for (int jb = 0; jb < 2; ++jb) {
            bf16_t rr_[16], rk_[16], rv_[16];
#pragma unroll
            for (int u = 0; u < 16; ++u) { const bf16_t* a = P + (size_t)(rowbase + t0 + jb * 16 + u) * PIN + 1024 + c; rr_[u] = a[0]; rk_[u] = a[256]; rv_[u] = a[512]; }
#pragma unroll
            for (int u = 0; u < 16; ++u) {
                const int j = jb * 16 + u;
                const size_t row = (size_t)(rowbase + t0 + j);
                const float cr = bf2f(rr_[u]), ck = bf2f(rk_[u]), cv = bf2f(rv_[u]);
                const float r = cr + (pr - cr) * mur, k = ck + (pk - ck) * muk, v = cv + (pv - cv) * muv;
                pr = cr; pk = ck; pv = cv;
                const float kk = k * kkw;
                const float ss = wave_sum(kk * kk);
                const float kkn = kk * rsqrtf(ss + 1e-12f);
                const float kf = k * (1.f + (aa[j] - 1.f) * kaw);
                const float bs = wave_sum(r * kf * rkw);
                bonus[row * 256 + c] = f2bf(bs * v);
                uint4 o; o.x = pack2(kkn, kkn * aa[j]); o.y = pack2(kf, r); o.z = pack2(v, 0.f); o.w = __float_as_uint(dec[j]);
                scan[row * 256 + c] = o;
            }
            asm volatile("" ::: "memory");
        }
    }
    __syncthreads();
}

constexpr int S_AL = 0, S_BE = 8192, S_KA = 16384, S_RH = 24576, S_BET = 32768, S_KAT = 40960, S_VT = 49152, S_L2F = 57344  , S_GT = 73728  ;
constexpr int S_L1F = S_BE;
constexpr int S_M1 = S_BE, S_M2 = S_KA;
constexpr int S_APT = S_L2F, S_W2T = S_L2F + 8192;
constexpr int S_RP = S_AL, S_GTR = S_RH;
DEVINL int crow32(int reg, int h) { return (reg & 3) + 8 * (reg >> 2) + 4 * h; }
DEVINL bf16x8 frag64(const char* lds, int slot, int row, int kel) { return *reinterpret_cast<const bf16x8*>(lds + slot + row * 128 + kel * 2); }
DEVINL float dpp_xor1(float x) { return __builtin_bit_cast(float, __builtin_amdgcn_update_dpp(0, __builtin_bit_cast(int, x), 0xB1, 0xf, 0xf, true)); }

DEVINL f32x16 mm64(const char* lds, int slotA, int slotB, int tm, int tn, int r, int hh, f32x16 acc) {
#pragma unroll
    for (int ks = 0; ks < 4; ++ks) acc = MFMA32(frag64(lds, slotA, tm * 32 + r, ks * 16 + 8 * hh), frag64(lds, slotB, tn * 32 + r, ks * 16 + 8 * hh), acc);
    return acc;
}

DEVINL void b1e_unit(KP p, char* lds, int b, int h, int c) {
    const int tid = TIDX(), wv = tid >> 6, lane = tid & 63, r = lane & 31, hh = lane >> 5;
    const uint4* scan = (const uint4*)(p->ws + A_SCAN) + ((size_t)(b * SEQ + c * 64)) * 256 + h * 64;
    float* gtot = (float*)(lds + S_GT); float* gamC = gtot + 256;
    {
        const int j = lane;
        float lw[16]; unsigned px[16], py[16], pz[16];
#pragma unroll
        for (int u = 0; u < 16; ++u) { const uint4 q = scan[(size_t)(wv * 16 + u) * 256 + j]; px[u] = q.x; py[u] = q.y; pz[u] = q.z; lw[u] = __uint_as_float(q.w); }
        float tot = 0.f;
#pragma unroll
        for (int u = 0; u < 16; ++u) tot += lw[u];
        gtot[wv * 64 + j] = tot;
        __syncthreads();
        float off = 0.f, all = 0.f;
#pragma unroll
        for (int g = 0; g < 4; ++g) { const float v = gtot[g * 64 + j]; all += v; off += (g < wv) ? v : 0.f; }
        if (wv == 0) gamC[j] = __expf(all);
        float cum = off;
        unsigned tb[8], tk[8], tv[8];
#pragma unroll
        for (int u = 0; u < 16; ++u) {
            const float kkn = __uint_as_float(px[u] << 16), bb = __uint_as_float(px[u] & 0xFFFF0000u);
            const float kf = __uint_as_float(py[u] << 16), rr = __uint_as_float(py[u] & 0xFFFF0000u);
            const float gp = __expf(cum); cum += lw[u];
            const float g = __expf(cum), en = __expf(-cum);
            const int t = wv * 16 + u;
            const unsigned be = f2bf(bb * en), ka = f2bf(kf * en);
            *(bf16_t*)(lds + S_AL + t * 128 + j * 2) = f2bf(gp * kkn);
            *(bf16_t*)(lds + S_BE + t * 128 + j * 2) = (bf16_t)be;
            *(bf16_t*)(lds + S_KA + t * 128 + j * 2) = (bf16_t)ka;
            *(bf16_t*)(lds + S_RH + t * 128 + j * 2) = f2bf(g * rr);
            if (u & 1) { tb[u >> 1] |= be << 16; tk[u >> 1] |= ka << 16; tv[u >> 1] |= (pz[u] << 16); }
            else { tb[u >> 1] = be; tk[u >> 1] = ka; tv[u >> 1] = pz[u] & 0xFFFFu; }
        }
        *(uint4*)(lds + S_BET + j * 128 + wv * 32) = make_uint4(tb[0], tb[1], tb[2], tb[3]); *(uint4*)(lds + S_BET + j * 128 + wv * 32 + 16) = make_uint4(tb[4], tb[5], tb[6], tb[7]);
        *(uint4*)(lds + S_KAT + j * 128 + wv * 32) = make_uint4(tk[0], tk[1], tk[2], tk[3]); *(uint4*)(lds + S_KAT + j * 128 + wv * 32 + 16) = make_uint4(tk[4], tk[5], tk[6], tk[7]);
        *(uint4*)(lds + S_VT + j * 128 + wv * 32) = make_uint4(tv[0], tv[1], tv[2], tv[3]); *(uint4*)(lds + S_VT + j * 128 + wv * 32 + 16) = make_uint4(tv[4], tv[5], tv[6], tv[7]);
    }
    __syncthreads();
    const int tm = wv >> 1, tn = wv & 1;
    f32x16 aM1, aM2;
    {
        f32x16 aL1, aL2;
#pragma unroll
        for (int i = 0; i < 16; ++i) { aL1[i] = 0.f; aL2[i] = 0.f; aM1[i] = 0.f; aM2[i] = 0.f; }
#pragma unroll
        for (int ks = 0; ks < 4; ++ks) {
            const bf16x8 fa = frag64(lds, S_AL, tm * 32 + r, ks * 16 + 8 * hh), fr = frag64(lds, S_RH, tm * 32 + r, ks * 16 + 8 * hh);
            const bf16x8 fb = frag64(lds, S_BE, tn * 32 + r, ks * 16 + 8 * hh), fk = frag64(lds, S_KA, tn * 32 + r, ks * 16 + 8 * hh);
            aL1 = MFMA32(fa, fb, aL1); aL2 = MFMA32(fa, fk, aL2); aM1 = MFMA32(fr, fb, aM1); aM2 = MFMA32(fr, fk, aM2);
        }
        __syncthreads();
#pragma unroll
        for (int reg = 0; reg < 16; ++reg) {
            const int t = tm * 32 + crow32(reg, hh), sidx = tn * 32 + r;
            const int o = (t * 64 + (sidx & 1) * 32 + (sidx >> 1)) * 4;
            *(float*)(lds + S_L1F + o) = (sidx < t) ? aL1[reg] : 0.f;
            *(float*)(lds + S_L2F + o) = (sidx < t) ? aL2[reg] : 0.f;
            aM1[reg] = (sidx <= t) ? aM1[reg] : 0.f; aM2[reg] = (sidx <= t) ? aM2[reg] : 0.f;
        }
    }
    __syncthreads();
    unsigned outp[32];
    {
        const int col = (wv & 1) * 32 + (lane >> 1), q = lane & 1;
        float xq[32];
#pragma unroll
        for (int k = 0; k < 32; ++k) xq[k] = 0.f;
        const char* l1row = lds + S_L1F + q * 128;
        const char* l2row = lds + S_L2F + q * 128;
        if (wv < 2) {
#pragma unroll
            for (int t = 0; t < 64; ++t) {
                float acc = 0.f;
#pragma unroll
                for (int k4 = 0; k4 * 4 < (t + 1) / 2; ++k4) {
                    const float4 a = *(const float4*)(l1row + t * 256 + k4 * 16);
                    acc = fmaf(a.x, xq[4 * k4 + 0], acc); acc = fmaf(a.y, xq[4 * k4 + 1], acc); acc = fmaf(a.z, xq[4 * k4 + 2], acc); acc = fmaf(a.w, xq[4 * k4 + 3], acc);
                }
                acc += dpp_xor1(acc);
                const float x = bf2f(*(const bf16_t*)(lds + S_AL + t * 128 + col * 2)) - acc;
                xq[t >> 1] = ((t & 1) == q) ? x : xq[t >> 1];
            }
        } else {
            float vq[32];
#pragma unroll
            for (int k8 = 0; k8 < 8; ++k8) {
                const uint4 d = *(const uint4*)(lds + S_VT + col * 128 + k8 * 16);
                vq[4 * k8 + 0] = q ? __uint_as_float(d.x & 0xFFFF0000u) : __uint_as_float(d.x << 16);
                vq[4 * k8 + 1] = q ? __uint_as_float(d.y & 0xFFFF0000u) : __uint_as_float(d.y << 16);
                vq[4 * k8 + 2] = q ? __uint_as_float(d.z & 0xFFFF0000u) : __uint_as_float(d.z << 16);
                vq[4 * k8 + 3] = q ? __uint_as_float(d.w & 0xFFFF0000u) : __uint_as_float(d.w << 16);
            }
#pragma unroll
            for (int t = 0; t < 64; ++t) {
                float acc = 0.f;
#pragma unroll
                for (int k4 = 0; k4 * 4 < (t + 1) / 2; ++k4) {
                    const float4 a = *(const float4*)(l1row + t * 256 + k4 * 16);
                    const float4 bq = *(const float4*)(l2row + t * 256 + k4 * 16);
                    acc = fmaf(bq.x, vq[4 * k4 + 0], acc); acc = fmaf(bq.y, vq[4 * k4 + 1], acc); acc = fmaf(bq.z, vq[4 * k4 + 2], acc); acc = fmaf(bq.w, vq[4 * k4 + 3], acc);
                    acc = fmaf(-a.x, xq[4 * k4 + 0], acc); acc = fmaf(-a.y, xq[4 * k4 + 1], acc); acc = fmaf(-a.z, xq[4 * k4 + 2], acc); acc = fmaf(-a.w, xq[4 * k4 + 3], acc);
                }
                acc += dpp_xor1(acc);
                xq[t >> 1] = ((t & 1) == q) ? acc : xq[t >> 1];
            }
        }
#pragma unroll
        for (int k = 0; k < 32; ++k) { const float o = dpp_xor1(xq[k]); outp[k] = q ? pack2(o, xq[k]) : pack2(xq[k], o); }
    }
    __syncthreads();
    {
        const int col = (wv & 1) * 32 + (lane >> 1), q = lane & 1;
        char* dst = lds + ((wv < 2) ? S_APT : S_W2T) + col * 128 + q * 64;
#pragma unroll
        for (int i = 0; i < 4; ++i) *(uint4*)(dst + i * 16) = q ? make_uint4(outp[16 + 4 * i], outp[17 + 4 * i], outp[18 + 4 * i], outp[19 + 4 * i]) : make_uint4(outp[4 * i], outp[4 * i + 1], outp[4 * i + 2], outp[4 * i + 3]);
#pragma unroll
        for (int reg = 0; reg < 16; ++reg) {
            const int t = tm * 32 + crow32(reg, hh), sidx = tn * 32 + r;
            *(bf16_t*)(lds + S_M1 + t * 128 + sidx * 2) = f2bf(aM1[reg]);
            *(bf16_t*)(lds + S_M2 + t * 128 + sidx * 2) = f2bf(aM2[reg]);
        }
    }
    __syncthreads();
    unsigned char* ubase = p->ws + A_CHAIN + (size_t)((b * 4 + h) * 64 + c) * CHAIN_UNIT;
    f32x16 zero;
#pragma unroll
    for (int i = 0; i < 16; ++i) zero[i] = 0.f;
    f32x16 gt;
    {
        const f32x16 qv = mm64(lds, S_M1, S_APT, tm, tn, r, hh, zero);
        const f32x16 y0 = mm64(lds, S_M2, S_VT, tm, tn, r, hh, zero) - mm64(lds, S_M1, S_W2T, tm, tn, r, hh, zero);
        gt = mm64(lds, S_BET, S_APT, tm, tn, r, hh, zero);
        const f32x16 ht = mm64(lds, S_KAT, S_VT, tm, tn, r, hh, zero) - mm64(lds, S_BET, S_W2T, tm, tn, r, hh, zero);
#pragma unroll
        for (int reg = 0; reg < 16; ++reg) {
            const int t = tm * 32 + crow32(reg, hh), jc = tn * 32 + r;
            const float rh = bf2f(*(const bf16_t*)(lds + S_RH + t * 128 + jc * 2));
            *(bf16_t*)(lds + S_RP + t * 128 + jc * 2) = f2bf(rh - qv[reg]);
            const int jr = tm * 32 + crow32(reg, hh);
            const float gc = gamC[jr];
            gt[reg] = gc * (((jr == jc) ? 1.f : 0.f) - gt[reg]);
        }
        float4* himg = (float4*)(ubase + 16384); float4* yimg = (float4*)(ubase + 32768);
#pragma unroll
        for (int rq = 0; rq < 4; ++rq) {
            float4 hv, yv;
            hv.x = gamC[tm * 32 + crow32(4 * rq + 0, hh)] * ht[4 * rq + 0]; hv.y = gamC[tm * 32 + crow32(4 * rq + 1, hh)] * ht[4 * rq + 1];
            hv.z = gamC[tm * 32 + crow32(4 * rq + 2, hh)] * ht[4 * rq + 2]; hv.w = gamC[tm * 32 + crow32(4 * rq + 3, hh)] * ht[4 * rq + 3];
            yv.x = y0[4 * rq + 0]; yv.y = y0[4 * rq + 1]; yv.z = y0[4 * rq + 2]; yv.w = y0[4 * rq + 3];
            himg[((tn * 2 + tm) * 4 + rq) * 64 + lane] = hv;
            yimg[((tn * 2 + tm) * 4 + rq) * 64 + lane] = yv;
        }
    }
    __syncthreads();
#pragma unroll
    for (int reg = 0; reg < 16; ++reg) {
        const int jr = tm * 32 + crow32(reg, hh), jc = tn * 32 + r;
        *(bf16_t*)(lds + S_GTR + jr * 128 + jc * 2) = f2bf(gt[reg]);
    }
    __syncthreads();
    {
        uint4* gimg = (uint4*)(ubase); uint4* rimg = (uint4*)(ubase + 8192);
#pragma unroll
        for (int ii = 0; ii < 2; ++ii) {
            const int im = wv * 2 + ii, mt = im >> 2, jb = (im >> 1) & 1, s2 = im & 1;
            const int cbase = (32 * jb + 16 * s2 + 4 * hh) * 2;
            const uint2 g0 = *(const uint2*)(lds + S_GTR + (mt * 32 + r) * 128 + cbase), g1 = *(const uint2*)(lds + S_GTR + (mt * 32 + r) * 128 + cbase + 16);
            const uint2 r0 = *(const uint2*)(lds + S_RP + (mt * 32 + r) * 128 + cbase), r1 = *(const uint2*)(lds + S_RP + (mt * 32 + r) * 128 + cbase + 16);
            gimg[im * 64 + lane] = make_uint4(g0.x, g0.y, g1.x, g1.y);
            rimg[im * 64 + lane] = make_uint4(r0.x, r0.y, r1.x, r1.y);
        }
    }
    __syncthreads();
}

DEVINL void phaseB1(KP p, int l, char* lds, const int mask = 15, const int sub = 3) {
    const int nb = NBV();
    if (mask & 1) {
        const int blk = BIDX();
        for (int it = blk; it < 512; it += nb) {
            if (sub & 1) { b1_rwkv(p, l, lds, it * 2); b1_rwkv(p, l, lds, it * 2 + 1); }
            __threadfence_block(); __syncthreads();
            const int b = it >> 6, c = it & 63;
            if (sub & 2) {
#pragma unroll 1
                for (int h = 0; h < 4; ++h) b1e_unit(p, lds, b, h, c);
            }
        }
    }
    if (mask & 2) { const int blk = BIDX(); for (int it = blk; it < 1024; it += nb) b1_lru(p, l, lds, it); }
    if (mask & 4) { const int blk = BIDX(); for (int it = blk; it < 1024; it += nb) b1_conformer(p, l, lds, it); }
    if (mask & 8) { const int blk = BIDX(); for (int it = blk; it < 512; it += nb) b1_shortconv(p, l, it); }
}

DEVINL void phaseB2(KP p, int l, char* lds) {
    const int tid = TIDX(), blk = BIDX();
    if (blk >= 64 && blk < 72) {
        const int bb = blk - 64;
        const float* ca = (const float*)(p->ws + A_CARRYA) + (size_t)bb * 128 * 256 + tid;
        const float* ch = (const float*)(p->ws + A_CARRYH) + (size_t)bb * 128 * 256 + tid;
        float* hst = (float*)(p->ws + A_HSTART) + (size_t)bb * 128 * 256 + tid;
        float hs = 0.f;
#pragma unroll 8
        for (int tt = 0; tt < 128; ++tt) { hst[tt * 256] = hs; hs = fmaf(ca[tt * 256], hs, ch[tt * 256]); }
    }
    if (blk < 64 && tid < 64) {
        const int lane = tid, r = lane & 31, hh = lane >> 5;
        const int bh = blk >> 1, w = blk & 1, b = bh >> 2, h = bh & 3;
        float* yraw = (float*)(p->ws + A_YRAW) + (size_t)b * SEQ * 256 + h * 64 + 32 * w + r;
        f32x16 X0, X1;
#pragma unroll
        for (int i = 0; i < 16; ++i) { X0[i] = 0.f; X1[i] = 0.f; }
        auto issue = [&](int c, char* buf) {
            const unsigned char* ubase = p->ws + A_CHAIN + (size_t)(bh * 64 + c) * CHAIN_UNIT;
#pragma unroll
            for (int i = 0; i < 8; ++i) {
                __builtin_amdgcn_global_load_lds((const unsigned*)(ubase + i * 1024 + lane * 16), (unsigned*)(buf + i * 1024 + lane * 16), 16, 0, 0);
                __builtin_amdgcn_global_load_lds((const unsigned*)(ubase + 8192 + i * 1024 + lane * 16), (unsigned*)(buf + 8192 + i * 1024 + lane * 16), 16, 0, 0);
                __builtin_amdgcn_global_load_lds((const unsigned*)(ubase + 16384 + (w * 8 + i) * 1024 + lane * 16), (unsigned*)(buf + 16384 + i * 1024 + lane * 16), 16, 0, 0);
                __builtin_amdgcn_global_load_lds((const unsigned*)(ubase + 32768 + (w * 8 + i) * 1024 + lane * 16), (unsigned*)(buf + 24576 + i * 1024 + lane * 16), 16, 0, 0);
            }
        };
        issue(0, lds);
        for (int c = 0; c < 64; ++c) {
            char* buf = lds + (c & 1) * 32768;
            if (c + 1 < 64) { issue(c + 1, lds + ((c + 1) & 1) * 32768); asm volatile("s_waitcnt vmcnt(32)" ::: "memory"); }
            else asm volatile("s_waitcnt vmcnt(0)" ::: "memory");
            uint4 gq[8], rq8[8]; float4 hq[8], yq[8];
#pragma unroll
            for (int i = 0; i < 8; ++i) { gq[i] = *(const uint4*)(buf + i * 1024 + lane * 16); rq8[i] = *(const uint4*)(buf + 8192 + i * 1024 + lane * 16); }
#pragma unroll
            for (int i = 0; i < 8; ++i) { hq[i] = *(const float4*)(buf + 16384 + i * 1024 + lane * 16); yq[i] = *(const float4*)(buf + 24576 + i * 1024 + lane * 16); }
            bf16x8 xp[4];
#pragma unroll
            for (int s2 = 0; s2 < 2; ++s2) {
                uint4 a, bq;
                a.x = pack2(X0[8 * s2 + 0], X0[8 * s2 + 1]); a.y = pack2(X0[8 * s2 + 2], X0[8 * s2 + 3]); a.z = pack2(X0[8 * s2 + 4], X0[8 * s2 + 5]); a.w = pack2(X0[8 * s2 + 6], X0[8 * s2 + 7]);
                bq.x = pack2(X1[8 * s2 + 0], X1[8 * s2 + 1]); bq.y = pack2(X1[8 * s2 + 2], X1[8 * s2 + 3]); bq.z = pack2(X1[8 * s2 + 4], X1[8 * s2 + 5]); bq.w = pack2(X1[8 * s2 + 6], X1[8 * s2 + 7]);
                xp[s2] = __builtin_bit_cast(bf16x8, a); xp[2 + s2] = __builtin_bit_cast(bf16x8, bq);
            }
#pragma unroll
            for (int mt = 0; mt < 2; ++mt) {
                f32x16 acc;
#pragma unroll
                for (int i = 0; i < 4; ++i) { acc[4 * i] = yq[mt * 4 + i].x; acc[4 * i + 1] = yq[mt * 4 + i].y; acc[4 * i + 2] = yq[mt * 4 + i].z; acc[4 * i + 3] = yq[mt * 4 + i].w; }
#pragma unroll
                for (int f = 0; f < 4; ++f) acc = MFMA32(__builtin_bit_cast(bf16x8, rq8[mt * 4 + f]), xp[f], acc);
#pragma unroll
                for (int reg = 0; reg < 16; ++reg) yraw[(size_t)(c * 64 + mt * 32 + crow32(reg, hh)) * 256] = acc[reg];
            }
            f32x16 n0, n1;
#pragma unroll
            for (int i = 0; i < 4; ++i) { n0[4 * i] = hq[i].x; n0[4 * i + 1] = hq[i].y; n0[4 * i + 2] = hq[i].z; n0[4 * i + 3] = hq[i].w;
                                          n1[4 * i] = hq[4 + i].x; n1[4 * i + 1] = hq[4 + i].y; n1[4 * i + 2] = hq[4 + i].z; n1[4 * i + 3] = hq[4 + i].w; }
#pragma unroll
            for (int f = 0; f < 4; ++f) { n0 = MFMA32(__builtin_bit_cast(bf16x8, gq[f]), xp[f], n0); n1 = MFMA32(__builtin_bit_cast(bf16x8, gq[4 + f]), xp[f], n1); }
            X0 = n0; X1 = n1;
        }
    }
}

DEVINL void phaseB3(KP p, int l) {
    const int c = TIDX(), nb = NBV(), blk = BIDX();
    const bf16_t* P = (const bf16_t*)(p->ws + A_P);
    bf16_t* ymix = (bf16_t*)(p->ws + A_YMIX);
    const float* yraw = (const float*)(p->ws + A_YRAW); const bf16_t* bonus = (const bf16_t*)(p->ws + A_BONUS); const bf16_t* gbuf = (const bf16_t*)(p->ws + A_G);
    const unsigned* hcbuf = (const unsigned*)(p->ws + A_HLOC); const float* hst = (const float*)(p->ws + A_HSTART);
    const float gng = p->in[I_GNG][l * 256 + c], gnb = p->in[I_GNB][l * 256 + c];
    for (int it = blk; it < 512; it += nb) {
#pragma unroll 1
        for (int r8 = 0; r8 < 64; r8 += 8) {
            float yv[8]; bf16_t bo[8], gg[8], gbv[8]; unsigned hcv[8]; float hsv[8];
#pragma unroll
            for (int u = 0; u < 8; ++u) {
                const int row = it * 64 + r8 + u, b = row >> 12, tt = (row & 4095) >> 5;
                const size_t o = (size_t)row * 256 + c;
                yv[u] = yraw[o]; bo[u] = bonus[o]; gg[u] = gbuf[o]; hcv[u] = hcbuf[o]; hsv[u] = hst[(size_t)(b * 128 + tt) * 256 + c];
                gbv[u] = P[(size_t)row * PIN + 768 + c];
            }
#pragma unroll
            for (int u = 0; u < 8; ++u) {
                const int row = it * 64 + r8 + u;
                const float y = yv[u];
                const float mu = wave_sum(y) * (1.f / 64.f);
                const float d = y - mu;
                const float var = wave_sum(d * d) * (1.f / 64.f);
                const float yn = d * rsqrtf(var + GN_EPS) * gng + gnb;
                ymix[(size_t)row * DM + 512 + c] = f2bf((yn + bf2f(bo[u])) * bf2f(gg[u]));
                const float hh = fmaf(__uint_as_float(hcv[u] & 0xFFFF0000u), hsv[u], __uint_as_float(hcv[u] << 16));
                ymix[(size_t)row * DM + 256 + c] = f2bf(hh * gelu_tanh(bf2f(gbv[u])));
            }
        }
    }
}

DEVINL void phaseD(KP p, int l, char* lds, const int dry = 0) {
    const int tid = TIDX(), nb = NBV(), blk = BIDX(), wid = tid >> 6, lane = tid & 63;
    constexpr int URS = 2064;
    char* uh = lds;
    char* ulo = lds + 16 * URS;
    float* logit = (float*)(lds + 32 * URS);
    int* sel_e = (int*)(lds + 32 * URS + 4096);
    int* lpos = sel_e + 512;
    int* hist = lpos + 512;
    int* basep = hist + 64;
    const bf16_t* wrt_hi = (const bf16_t*)(p->ws + OFF_WR) + (size_t)(l * 2 + 0) * 64 * 1024;
    const bf16_t* wrt_lo = (const bf16_t*)(p->ws + OFF_WR) + (size_t)(l * 2 + 1) * 64 * 1024;
    const bf16_t* zbuf = (const bf16_t*)(p->ws + M_ZB);
    float2* lnstat = (float2*)(p->ws + M_STAT);
    bf16_t* ubuf = (bf16_t*)(p->ws + (dry ? A_YMIX : OFF_UBUF));
    const float* mod = (const float*)(p->ws + OFF_MOD);
    const float* wr = p->in[I_WROUTER] + (size_t)l * 1024 * 64 + lane;
    const float ebias = p->in[I_EBIAS][l * 64 + lane];
    unsigned* cnt = (unsigned*)(p->ws + OFF_CNT) + l * 64 + (dry ? 256 : 0);
    int* list = (int*)(p->ws + (dry ? M_HBUF : M_LIST));
    float* wsel = (float*)(p->ws + (dry ? M_HBUF + 16777216 : M_WSEL));
    int* pmap = (int*)(p->ws + (dry ? M_HBUF + 33554432 : M_PMAP));
    for (int it = blk; it < 512; it += nb) {
        const int tok0 = it * 64;
        if (tid < 64) hist[tid] = 0;
        for (int sb = 0; sb < 4; ++sb) {
#pragma unroll
            for (int j = 0; j < 4; ++j) {
                const int tl = wid * 4 + j, row = tok0 + sb * 16 + tl, b = row >> 12;
                float4 z[4];
                float s = 0.f;
#pragma unroll
                for (int i = 0; i < 4; ++i) { const uint2 zv = *(const uint2*)(zbuf + (size_t)row * DM + i * 256 + lane * 4);
                    z[i].x = __uint_as_float(zv.x << 16); z[i].y = __uint_as_float(zv.x & 0xFFFF0000u); z[i].z = __uint_as_float(zv.y << 16); z[i].w = __uint_as_float(zv.y & 0xFFFF0000u); s += z[i].x + z[i].y + z[i].z + z[i].w; }
                const float mean = wave_sum(s) * (1.f / 1024.f);
                float q = 0.f;
#pragma unroll
                for (int i = 0; i < 4; ++i) { z[i].x -= mean; z[i].y -= mean; z[i].z -= mean; z[i].w -= mean; q += z[i].x * z[i].x + z[i].y * z[i].y + z[i].z * z[i].z + z[i].w * z[i].w; }
                const float rs = rsqrtf(wave_sum(q) * (1.f / 1024.f) + LN_EPS);
                if (lane == 0) lnstat[row] = make_float2(mean, rs);
#pragma unroll
                for (int i = 0; i < 4; ++i) {
                    const int col = i * 256 + lane * 4;
                    const float4 g = *(const float4*)(p->in[I_LN1G] + l * 1024 + col), bb = *(const float4*)(p->in[I_LN1B] + l * 1024 + col);
                    const float4 sh = *(const float4*)(mod + (size_t)(l * 8 + b) * 6144 + 3072 + col), sc = *(const float4*)(mod + (size_t)(l * 8 + b) * 6144 + 4096 + col);
                    float4 x1; x1.x = z[i].x * rs * g.x + bb.x; x1.y = z[i].y * rs * g.y + bb.y; x1.z = z[i].z * rs * g.z + bb.z; x1.w = z[i].w * rs * g.w + bb.w;
                    float4 u; u.x = x1.x * (1.f + sc.x) + sh.x; u.y = x1.y * (1.f + sc.y) + sh.y; u.z = x1.z * (1.f + sc.z) + sh.z; u.w = x1.w * (1.f + sc.w) + sh.w;
                    uint2 o; o.x = pack2(u.x, u.y); o.y = pack2(u.z, u.w);
                    *(uint2*)(ubuf + (size_t)row * DM + col) = o;
                    *(uint2*)(uh + tl * URS + col * 2) = o;
                    uint2 o2; o2.x = pack2(u.x - __uint_as_float(o.x << 16), u.y - __uint_as_float(o.x & 0xFFFF0000u)); o2.y = pack2(u.z - __uint_as_float(o.y << 16), u.w - __uint_as_float(o.y & 0xFFFF0000u));
                    *(uint2*)(ulo + tl * URS + col * 2) = o2;
                }
            }
            __syncthreads();
            {
                const int fr = lane & 15, fq = lane >> 4;
                f32x4 lacc = (f32x4){0.f, 0.f, 0.f, 0.f};
                const bf16_t* bh = wrt_hi + (size_t)(wid * 16 + fr) * 1024 + fq * 8;
                const bf16_t* bl = wrt_lo + (size_t)(wid * 16 + fr) * 1024 + fq * 8;
#pragma unroll 1
                for (int k8 = 0; k8 < 4; ++k8) {
                    bf16x8 bhv[8], blv[8];
#pragma unroll
                    for (int kk = 0; kk < 8; ++kk) { bhv[kk] = *(const bf16x8*)(bh + (k8 * 8 + kk) * 32); blv[kk] = *(const bf16x8*)(bl + (k8 * 8 + kk) * 32); }
#pragma unroll
                    for (int kk = 0; kk < 8; ++kk) {
                        const int ko = (k8 * 8 + kk) * 64 + fq * 16;
                        const bf16x8 ah = *(const bf16x8*)(uh + fr * URS + ko), al = *(const bf16x8*)(ulo + fr * URS + ko);
                        lacc = __builtin_amdgcn_mfma_f32_16x16x32_bf16(ah, bhv[kk], lacc, 0, 0, 0);
                        lacc = __builtin_amdgcn_mfma_f32_16x16x32_bf16(al, bhv[kk], lacc, 0, 0, 0);
                        lacc = __builtin_amdgcn_mfma_f32_16x16x32_bf16(ah, blv[kk], lacc, 0, 0, 0);
                    }
                }
#pragma unroll
                for (int j = 0; j < 4; ++j) logit[(fq * 4 + j) * 64 + wid * 16 + fr] = lacc[j];
            }
            __syncthreads();
            float acc[4];
#pragma unroll
            for (int j = 0; j < 4; ++j) acc[j] = logit[(wid * 4 + j) * 64 + lane];
#pragma unroll
            for (int j = 0; j < 4; ++j) {
                const int tl = sb * 16 + wid * 4 + j;
                const float score = 1.f / (1.f + __expf(-acc[j]));
                const float biased = score + ebias;
                const float m1 = group8_max(biased);
                const unsigned long long eq = __ballot(biased == m1);
                const int g = lane >> 3;
                const unsigned gm = (unsigned)(eq >> (g * 8)) & 0xFFu;
                const int first = __ffs((int)gm) - 1;
                const float v2 = ((lane & 7) == first) ? -INFINITY : biased;
                const float m2 = group8_max(v2);
                const float gs = m1 + m2;
                int rg = 0;
#pragma unroll
                for (int g2 = 0; g2 < 8; ++g2) { const float o = __builtin_bit_cast(float, __builtin_amdgcn_readlane(__builtin_bit_cast(int, gs), g2 * 8)); rg += ((o > gs) || (o == gs && g2 < g)) ? 1 : 0; }
                const bool keep = rg < 4;
                const float mk = keep ? biased : -INFINITY;
                int rk = 0;
#pragma unroll
                for (int e2 = 0; e2 < 64; ++e2) { const float o = __builtin_bit_cast(float, __builtin_amdgcn_readlane(__builtin_bit_cast(int, mk), e2)); rk += ((o > mk) || (o == mk && e2 < lane)) ? 1 : 0; }
                const bool sel = keep && (rk < 8);
                const float ssum = wave_sum(sel ? score : 0.f);
                const float wgt = score / ssum * 2.5f;
                const unsigned long long sm = __ballot(sel);
                const int kidx = __popcll(sm & ((1ull << lane) - 1ull));
                if (sel) { wsel[(size_t)(tok0 + tl) * 8 + kidx] = wgt; sel_e[tl * 8 + kidx] = lane; }
            }
            __syncthreads();
        }
        for (int i = tid; i < 512; i += VTHREADS) lpos[i] = atomicAdd(&hist[sel_e[i]], 1);
        __syncthreads();
        if (tid < 64) basep[tid] = (int)atomicAdd(&cnt[tid], (unsigned)hist[tid]);
        __syncthreads();
        for (int i = tid; i < 512; i += VTHREADS) { const int e = sel_e[i], pos = basep[e] + lpos[i]; list[(size_t)e * NTOK + pos] = tok0 * 8 + i; pmap[tok0 * 8 + i] = (e << 16) | pos; }
        __syncthreads();
    }
}

DEVINL void phaseA(KP p, int l, char* lds) {
    const int tid = TID512(), c = blockIdx.x, G = gridDim.x;
    const char* ubuf = (const char*)(p->ws + OFF_UBUF);
    const char* Wt = (const char*)(p->ws + OFF_WIN) + (size_t)l * WIN_ROWS * 1024 * 2;
    bf16_t* P = (bf16_t*)(p->ws + A_P);
    auto sched = [&](int i, GUnit& u) -> bool {
        const long L = unit_linear(i, c, G); if (L >= 128 * 11) return false;
        const int Li = (int)L, sx = Li >> 9, w = (sx == 2) ? 3 : 4, rem = Li - (sx << 9), pm = rem / w, pn = sx * 4 + (rem - pm * w);
        u.A = ubuf + (size_t)pm * 256 * 2048; u.B = Wt + (size_t)pn * 256 * 2048; u.i0 = pm; u.i1 = pn; u.i2 = 0;
        return true;
    };
    auto epi = [&](f32x4 (&acc)[2][2][4][2], const GUnit& u, int wr, int wc, int fr, int fq) {
        asm volatile("" : "+v"(fr), "+v"(fq));
        const int row0 = u.i0 * 256 + wr * 64 + fr, col0 = u.i1 * 256 + wc * 32 + 8 * fq;
#pragma unroll
        for (int ai = 0; ai < 2; ++ai)
#pragma unroll
            for (int m = 0; m < 4; ++m) {
                bf16_t* rowp = P + (size_t)(row0 + ai * 128 + m * 16) * PIN + col0;
#pragma unroll
                for (int bj = 0; bj < 2; ++bj) {
                    if (col0 + bj * 128 < PIN) {
                        const f32x4 v0 = acc[ai][bj][m][0], v1 = acc[ai][bj][m][1];
                        *(uint4*)(rowp + bj * 128) = make_uint4(pack2(v0[0], v0[1]), pack2(v0[2], v0[3]), pack2(v1[0], v1[1]), pack2(v1[2], v1[3]));
                    }
                }
            }
    };
    gemm256<true, false>(lds, 1024, 1024, sched, epi);
}

DEVINL void phaseC(KP p, int l, char* lds) {
    const int tid = TID512(), c = blockIdx.x, G = gridDim.x;
    const char* ymix = (const char*)(p->ws + A_YMIX);
    const char* Wt = (const char*)(p->ws + OFF_WOUT) + (size_t)l * 1024 * 1024 * 2;
    const float* res32 = p->in[I_X];
    const bf16_t* res16 = (const bf16_t*)p->out;
    bf16_t* zbuf = (bf16_t*)(p->ws + M_ZB);
    const float* mod = (const float*)(p->ws + OFF_MOD);
    auto sched = [&](int i, GUnit& u) -> bool {
        const long L = unit_linear(i, c, G); if (L >= 128 * 4) return false;
        const int pm = (int)L >> 2, pn = (int)L & 3;
        u.A = ymix + (size_t)pm * 256 * 2048; u.B = Wt + (size_t)pn * 256 * 2048; u.i0 = pm; u.i1 = pn; u.i2 = 0;
        return true;
    };
    auto epi = [&](f32x4 (&acc)[2][2][4][2], const GUnit& u, int wr, int wc, int fr, int fq) {
        asm volatile("" : "+v"(fr), "+v"(fq));
        const int row0 = u.i0 * 256 + wr * 64 + fr, col0 = u.i1 * 256 + wc * 32 + 8 * fq;
#pragma unroll
        for (int ai = 0; ai < 2; ++ai)
#pragma unroll
            for (int m = 0; m < 4; ++m) {
                const int row = row0 + ai * 128 + m * 16, b = row >> 12;
#pragma unroll
                for (int bj = 0; bj < 2; ++bj) {
                    const int col = col0 + bj * 128;
                    const float4 ga = *(const float4*)(mod + (size_t)(l * 8 + b) * 6144 + 2048 + col), gb = *(const float4*)(mod + (size_t)(l * 8 + b) * 6144 + 2048 + col + 4);
                    float r[8];
                    if (l == 0) {
                        const float4 ra = *(const float4*)(res32 + (size_t)row * DM + col), rb = *(const float4*)(res32 + (size_t)row * DM + col + 4);
                        r[0] = ra.x; r[1] = ra.y; r[2] = ra.z; r[3] = ra.w; r[4] = rb.x; r[5] = rb.y; r[6] = rb.z; r[7] = rb.w;
                    } else {
                        const uint4 rv = *(const uint4*)(res16 + (size_t)row * DM + col);
                        r[0] = __uint_as_float(rv.x << 16); r[1] = __uint_as_float(rv.x & 0xFFFF0000u); r[2] = __uint_as_float(rv.y << 16); r[3] = __uint_as_float(rv.y & 0xFFFF0000u);
                        r[4] = __uint_as_float(rv.z << 16); r[5] = __uint_as_float(rv.z & 0xFFFF0000u); r[6] = __uint_as_float(rv.w << 16); r[7] = __uint_as_float(rv.w & 0xFFFF0000u);
                    }
                    const f32x4 a0 = acc[ai][bj][m][0], a1 = acc[ai][bj][m][1];
                    const float z0 = ALPHA * r[0] + (1.f + ga.x) * a0[0], z1 = ALPHA * r[1] + (1.f + ga.y) * a0[1], z2 = ALPHA * r[2] + (1.f + ga.z) * a0[2], z3 = ALPHA * r[3] + (1.f + ga.w) * a0[3];
                    const float z4 = ALPHA * r[4] + (1.f + gb.x) * a1[0], z5 = ALPHA * r[5] + (1.f + gb.y) * a1[1], z6 = ALPHA * r[6] + (1.f + gb.z) * a1[2], z7 = ALPHA * r[7] + (1.f + gb.w) * a1[3];
                    *(uint4*)(zbuf + (size_t)row * DM + col) = make_uint4(pack2(z0, z1), pack2(z2, z3), pack2(z4, z5), pack2(z6, z7));
                }
            }
    };
    gemm256<true, false>(lds, 1024, 1024, sched, epi);
}

constexpr int DIR_OFF = 131072;
DEVINL void moe_directory(KP p, int l, char* lds) {
    int* pref = (int*)(lds + DIR_OFF);
    int* cntl = (int*)(lds + DIR_OFF + 512);
    unsigned* cnt = (unsigned*)(p->ws + OFF_CNT) + l * 64;
    asm volatile("" : "+s"(cnt));
    if (threadIdx.x == 0) {
        int s = 0;
        int* xpre = (int*)(lds + DIR_OFF + 1024);
        int x = 0;
        for (int e = 0; e < 64; ++e) { const int c = (int)__hip_atomic_load(&cnt[e], __ATOMIC_RELAXED, __HIP_MEMORY_SCOPE_AGENT); cntl[e] = c; pref[e] = s; s += (c + 255) >> 8; xpre[e] = x; x += c; }
        pref[64] = s; cntl[64] = NTOK; pref[65] = s + 128; xpre[64] = x;
    }
    __syncthreads();
    {
        int* m2e = (int*)(lds + DIR_OFF + 2048);
        const int tot = pref[65];
        for (int mg = threadIdx.x; mg < tot; mg += NTHREADS) { int e = 0; while (pref[e + 1] <= mg) ++e; m2e[mg] = e; }
    }
    __syncthreads();
}

DEVINL void phaseE1(KP p, int l, char* lds) {
    const int tid = TID512(), c = blockIdx.x, G = gridDim.x;
    moe_directory(p, l, lds);
    const int* pref = (const int*)(lds + DIR_OFF); const int* cntl = (const int*)(lds + DIR_OFF + 512);
    const char* ubuf = (const char*)(p->ws + OFF_UBUF);
    const int* list = (const int*)(p->ws + M_LIST);
    bf16_t* hbuf = (bf16_t*)(p->ws + M_HBUF);
    const char* W13 = (const char*)(p->ws + OFF_W13) + (size_t)(l * 65) * 512 * 1024 * 2;
    const int total = __builtin_amdgcn_readfirstlane(pref[65]) * 2;
    auto sched = [&](int i, GUnit& u) -> bool {
        const long L = unit_linear(i, c, G); if (L >= total) return false;
        const int mg = (int)L >> 1, nt = (int)L & 1;
        const int e = __builtin_amdgcn_readfirstlane(((const int*)(lds + DIR_OFF + 2048))[mg]);
        const int mt = __builtin_amdgcn_readfirstlane(mg - pref[e]), Me = __builtin_amdgcn_readfirstlane(cntl[e]);
        u.A = ubuf; u.B = W13 + ((size_t)e * 512 + nt * 256) * 2048; u.i0 = mg; u.i1 = nt; u.i2 = e;
        int R[2], C[2]; stage_coords512(TID512(), R, C);
#pragma unroll
        for (int h = 0; h < 2; ++h)
#pragma unroll
            for (int i2 = 0; i2 < 2; ++i2) {
                const int idx = mt * 256 + h * 128 + R[i2]; int tok;
                if (e < 64) tok = (idx < Me) ? (list[(size_t)e * NTOK + idx] >> 3) : 0; else tok = idx;
                u.va[h][i2] = (unsigned)(tok * 1024 + C[i2]) * 2u;
            }
        return true;
    };
    auto epi = [&](f32x4 (&acc)[2][2][4][2], const GUnit& u, int wr, int wc, int fr, int fq) {
        asm volatile("" : "+v"(fr), "+v"(fq));
        const size_t row0 = (size_t)u.i0 * 256 + wr * 64 + fr;
#pragma unroll
        for (int ai = 0; ai < 2; ++ai)
#pragma unroll
            for (int m = 0; m < 4; ++m) {
                bf16_t* rowp = hbuf + (row0 + ai * 128 + m * 16) * 256;
#pragma unroll
                for (int bj = 0; bj < 2; ++bj) {
                    const int hcol = (u.i1 * 8 + bj * 4 + wc) * 16 + 4 * fq;
                    const f32x4 gt = acc[ai][bj][m][0], up = acc[ai][bj][m][1];
                    float hv[4];
#pragma unroll
                    for (int j = 0; j < 4; ++j) hv[j] = gt[j] * sigm(gt[j]) * up[j];
                    uint2 o; o.x = pack2(hv[0], hv[1]); o.y = pack2(hv[2], hv[3]);
                    *(uint2*)(rowp + hcol) = o;
                }
                asm volatile("" ::: "memory");
            }
    };
    gemm256<false, true>(lds, 1024, 1024, sched, epi);
}

DEVINL void phaseE2(KP p, int l, char* lds) {
    const int tid = TID512(), c = blockIdx.x, G = gridDim.x;
    moe_directory(p, l, lds);
    const int* pref = (const int*)(lds + DIR_OFF); const int* cntl = (const int*)(lds + DIR_OFF + 512);
    const int* xpre = (const int*)(lds + DIR_OFF + 1024);
    const char* hbuf = (const char*)(p->ws + M_HBUF);
    unsigned char* ybuf = (unsigned char*)(p->ws + M_YBUF);
    const char* W2 = (const char*)(p->ws + OFF_W2) + (size_t)(l * 65) * 1024 * 256 * 2;
    const int total = __builtin_amdgcn_readfirstlane(pref[65]) * 4;
    auto sched = [&](int i, GUnit& u) -> bool {
        const long L = unit_linear(i, c, G); if (L >= total) return false;
        const int mg = (int)L >> 2, nt = (int)L & 3;
        const int e = __builtin_amdgcn_readfirstlane(((const int*)(lds + DIR_OFF + 2048))[mg]);
        u.A = hbuf + (size_t)mg * 256 * 512; u.B = W2 + ((size_t)e * 1024 + nt * 256) * 512; u.i0 = mg; u.i1 = nt; u.i2 = e;
        return true;
    };
    auto epi = [&](f32x4 (&acc)[2][2][4][2], const GUnit& u, int wr, int wc, int fr, int fq) {
        asm volatile("" : "+v"(fr), "+v"(fq));
        const int e = __builtin_amdgcn_readfirstlane(u.i2), mt = __builtin_amdgcn_readfirstlane(u.i0 - pref[e]), Me = __builtin_amdgcn_readfirstlane(cntl[e]);
        const int yrow0 = __builtin_amdgcn_readfirstlane(xpre[e]) + mt * 256;
        const int col0 = u.i1 * 256 + wc * 32 + 8 * fq, loc0 = wr * 64 + fr;
#pragma unroll
        for (int ai = 0; ai < 2; ++ai)
#pragma unroll
            for (int m = 0; m < 4; ++m) {
                const int loc = loc0 + ai * 128 + m * 16;
                if (mt * 256 + loc < Me) {
                    unsigned char* rowp = ybuf + (size_t)(yrow0 + loc) * 1024 + col0;
#pragma unroll
                    for (int bj = 0; bj < 2; ++bj) {
                        const f32x4 v0 = acc[ai][bj][m][0], v1 = acc[ai][bj][m][1];
                        int w0 = __builtin_amdgcn_cvt_pk_fp8_f32(v0[0], v0[1], 0, false); w0 = __builtin_amdgcn_cvt_pk_fp8_f32(v0[2], v0[3], w0, true);
                        int w1 = __builtin_amdgcn_cvt_pk_fp8_f32(v1[0], v1[1], 0, false); w1 = __builtin_amdgcn_cvt_pk_fp8_f32(v1[2], v1[3], w1, true);
                        *(uint2*)(rowp + bj * 128) = make_uint2((unsigned)w0, (unsigned)w1);
                    }
                }
            }
    };
    gemm256<true, false>(lds, 256, 256, sched, epi);
}

DEVINL void phaseF(KP p, int l, const int dry = 0) {
    const int tid = TIDX(), nb = NBV(), blk = BIDX(), wid = tid >> 6, lane = tid & 63;
    const bf16_t* zbuf = (const bf16_t*)(p->ws + M_ZB);
    float* xout = dry ? (float*)(p->ws + M_HBUF) : p->out;
    const unsigned char* ybuf = (const unsigned char*)(p->ws + M_YBUF);
    bf16_t* ubuf = (bf16_t*)(p->ws + OFF_UBUF);
    const float* mod = (const float*)(p->ws + OFF_MOD);
    const int* pmap = (const int*)(p->ws + M_PMAP); const float* wsel = (const float*)(p->ws + M_WSEL);
    const float2* lnstat = (const float2*)(p->ws + M_STAT);
    int xoff;
    {
        const unsigned* cnt = (const unsigned*)(p->ws + OFF_CNT) + l * 64;
        const int c = (int)__hip_atomic_load(&cnt[lane], __ATOMIC_RELAXED, __HIP_MEMORY_SCOPE_AGENT);
        xoff = 0;
#pragma unroll
        for (int j = 0; j < 64; ++j) { const int cj = __builtin_amdgcn_readlane(c, j); xoff += (j < lane) ? cj : 0; }
    }
    int pmn = 0; float wn = 0.f; float2 stn = make_float2(0.f, 0.f);
    {
        const int row = blk * 4 + wid;
        if (row < NTOK) { if (lane < 8) { pmn = pmap[row * 8 + lane]; wn = wsel[row * 8 + lane]; } stn = lnstat[row]; }
    }
    for (int row = blk * 4 + wid; row < NTOK; row += nb * 4) {
        const int b = row >> 12;
        int yr = pmn; const float yw = wn; const float2 st1 = stn;
        {
            const int nrow = row + nb * 4;
            if (nrow < NTOK) { if (lane < 8) { pmn = pmap[nrow * 8 + lane]; wn = wsel[nrow * 8 + lane]; } stn = lnstat[nrow]; }
        }
        { const int e = (yr >> 16) & 63; const int xo = __builtin_amdgcn_ds_bpermute(e << 2, xoff); yr = xo + (yr & 0xFFFF); }
        int yrow[8]; float yww[8];
#pragma unroll
        for (int k = 0; k < 8; ++k) { yrow[k] = __builtin_amdgcn_readlane(yr, k); yww[k] = __builtin_bit_cast(float, __builtin_amdgcn_readlane(__builtin_bit_cast(int, yw), k)); }
        uint2 zvv[4]; int ysh[4]; int yvk[4][8];
#pragma unroll
        for (int i = 0; i < 4; ++i) {
            const int col = i * 256 + lane * 4;
            zvv[i] = *(const uint2*)(zbuf + (size_t)row * DM + col);
            ysh[i] = *(const int*)(ybuf + ((size_t)(262144 + row)) * 1024 + col);
#pragma unroll
            for (int k = 0; k < 8; ++k) yvk[i][k] = *(const int*)(ybuf + (size_t)yrow[k] * 1024 + col);
        }
        float4 z[4]; float s = 0.f;
#pragma unroll
        for (int i = 0; i < 4; ++i) {
            const int col = i * 256 + lane * 4;
            float4 x1;
            { const uint2 zv = zvv[i];
              float4 z1; z1.x = __uint_as_float(zv.x << 16); z1.y = __uint_as_float(zv.x & 0xFFFF0000u); z1.z = __uint_as_float(zv.y << 16); z1.w = __uint_as_float(zv.y & 0xFFFF0000u);
              const float4 g1 = *(const float4*)(p->in[I_LN1G] + l * 1024 + col), b1 = *(const float4*)(p->in[I_LN1B] + l * 1024 + col);
              x1.x = (z1.x - st1.x) * st1.y * g1.x + b1.x; x1.y = (z1.y - st1.x) * st1.y * g1.y + b1.y; x1.z = (z1.z - st1.x) * st1.y * g1.z + b1.z; x1.w = (z1.w - st1.x) * st1.y * g1.w + b1.w; }
            float f0, f1, f2, f3;
            { const int yv = ysh[i];
              const f2_t lo = __builtin_amdgcn_cvt_pk_f32_fp8(yv, false), hi = __builtin_amdgcn_cvt_pk_f32_fp8(yv, true);
              f0 = lo[0]; f1 = lo[1]; f2 = hi[0]; f3 = hi[1]; }
#pragma unroll
            for (int k = 0; k < 8; ++k) {
                const f2_t lo = __builtin_amdgcn_cvt_pk_f32_fp8(yvk[i][k], false), hi = __builtin_amdgcn_cvt_pk_f32_fp8(yvk[i][k], true);
                const float w = yww[k];
                f0 = fmaf(w, lo[0], f0); f1 = fmaf(w, lo[1], f1); f2 = fmaf(w, hi[0], f2); f3 = fmaf(w, hi[1], f3);
            }
            const float4 g2 = *(const float4*)(mod + (size_t)(l * 8 + b) * 6144 + 5120 + col);
            z[i].x = ALPHA * x1.x + (1.f + g2.x) * f0; z[i].y = ALPHA * x1.y + (1.f + g2.y) * f1; z[i].z = ALPHA * x1.z + (1.f + g2.z) * f2; z[i].w = ALPHA * x1.w + (1.f + g2.w) * f3;
            s += z[i].x + z[i].y + z[i].z + z[i].w;
        }
        const float mean = wave_sum(s) * (1.f / 1024.f);
        float q = 0.f;
#pragma unroll
        for (int i = 0; i < 4; ++i) { z[i].x -= mean; z[i].y -= mean; z[i].z -= mean; z[i].w -= mean; q += z[i].x * z[i].x + z[i].y * z[i].y + z[i].z * z[i].z + z[i].w * z[i].w; }
        const float rs = rsqrtf(wave_sum(q) * (1.f / 1024.f) + LN_EPS);
#pragma unroll
        for (int i = 0; i < 4; ++i) {
            const int col = i * 256 + lane * 4;
            const float4 g = *(const float4*)(p->in[I_LN2G] + l * 1024 + col), bb = *(const float4*)(p->in[I_LN2B] + l * 1024 + col);
            float4 x2; x2.x = z[i].x * rs * g.x + bb.x; x2.y = z[i].y * rs * g.y + bb.y; x2.z = z[i].z * rs * g.z + bb.z; x2.w = z[i].w * rs * g.w + bb.w;
            if (l + 1 < DEPTH) { uint2 ox; ox.x = pack2(x2.x, x2.y); ox.y = pack2(x2.z, x2.w); *(uint2*)((bf16_t*)xout + (size_t)row * DM + col) = ox; }
            else *(float4*)(xout + (size_t)row * DM + col) = x2;
            if (l + 1 < DEPTH) {
                const float4 sh = *(const float4*)(mod + (size_t)((l + 1) * 8 + b) * 6144 + col), sc = *(const float4*)(mod + (size_t)((l + 1) * 8 + b) * 6144 + 1024 + col);
                uint2 o; o.x = pack2(x2.x * (1.f + sc.x) + sh.x, x2.y * (1.f + sc.y) + sh.y); o.y = pack2(x2.z * (1.f + sc.z) + sh.z, x2.w * (1.f + sc.w) + sh.w);
                *(uint2*)(ubuf + (size_t)row * DM + col) = o;
            }
        }
    }
}

#define XB_TMO      128
#define XB_XCNT(j)  (256  + 64 * (j))
#define XB_XSUB(j)  (1280 + 64 * (j))
#define XB_XGEN(j)  (2304 + 64 * (j))
#define XB_TOP      3328
#define XB_TOPGEN   3392
#define XCD_BAR_WORDS 3456
#define XB_SPIN_CAP (1u << 20)
DEVINL unsigned xb_ld(unsigned* p)              { return __hip_atomic_load(p, __ATOMIC_RELAXED, __HIP_MEMORY_SCOPE_AGENT); }
DEVINL unsigned xb_add(unsigned* p, unsigned v) { return __hip_atomic_fetch_add(p, v, __ATOMIC_RELAXED, __HIP_MEMORY_SCOPE_AGENT); }
DEVINL unsigned xb_xcc_id() { return (unsigned)__builtin_amdgcn_s_getreg((3 << 11) | 20) & 0xFu; }
#define XB_SPIN(cond, bar) do { unsigned _sp = 0; while (cond) { __builtin_amdgcn_s_sleep(1); \
    if ((++_sp & 255u) == 0u) { if (xb_ld(&(bar)[XB_TMO])) break; if (_sp > XB_SPIN_CAP) { atomicAdd(&(bar)[XB_TMO], 1u); break; } } } } while (0)
struct XcdBarrier { unsigned* bar; unsigned x; volatile LAS unsigned* st; };
DEVINL XcdBarrier xcd_barrier_post(unsigned* bar, volatile LAS unsigned* st) {
    XcdBarrier b; b.bar = bar; b.x = xb_xcc_id(); b.st = st;
    if (threadIdx.x == 0) (void)xb_add(&bar[XB_XCNT(b.x)], 1u);
    return b;
}
DEVINL void xcd_barrier_complete(unsigned* bar, unsigned x, unsigned& nloc, unsigned& nx) {
    const unsigned G = gridDim.x * gridDim.y * gridDim.z;
    unsigned sum, cnt, mine, sp = 0u;
    for (;;) {
        sum = 0u; cnt = 0u; mine = 0u;
#pragma unroll 1
        for (unsigned j = 0; j < 16; ++j) { const unsigned c = xb_ld(&bar[XB_XCNT(j)]); sum += c; cnt += (c > 0u) ? 1u : 0u; mine = (j == x) ? c : mine; }
        if (sum == G) break;
        __builtin_amdgcn_s_sleep(1);
        if ((++sp & 255u) == 0u) { if (xb_ld(&bar[XB_TMO])) break; if (sp > XB_SPIN_CAP) { atomicAdd(&bar[XB_TMO], 1u); break; } }
    }
    nloc = mine > 0u ? mine : 1u; nx = cnt > 0u ? cnt : 1u;
}
DEVINL void xcd_barrier(const XcdBarrier& b) {
    asm volatile("s_waitcnt vmcnt(0)" ::: "memory");
    __syncthreads();
    if (threadIdx.x == 0) {
        unsigned* bar = b.bar;
        __builtin_amdgcn_s_waitcnt(0);
        unsigned nloc = b.st[0], nx = b.st[1];
        if (nloc == 0u) { xcd_barrier_complete(bar, b.x, nloc, nx); b.st[0] = nloc; b.st[1] = nx; }
        const unsigned old = xb_add(&bar[XB_XSUB(b.x)], 1u);
        const unsigned gen = old / nloc;
        if (old + 1u == (gen + 1u) * nloc) {
            __builtin_amdgcn_fence(__ATOMIC_RELEASE, "agent");
            asm volatile("s_waitcnt vmcnt(0)" ::: "memory");
            const unsigned og = xb_add(&bar[XB_TOP], 1u);
            const unsigned tg = og / nx;
            if (og + 1u == (tg + 1u) * nx) xb_add(&bar[XB_TOPGEN], 1u);
            else XB_SPIN(xb_ld(&bar[XB_TOPGEN]) == tg, bar);
            __builtin_amdgcn_fence(__ATOMIC_ACQUIRE, "agent");
            xb_add(&bar[XB_XGEN(b.x)], 1u);
            asm volatile("s_waitcnt vmcnt(0)" ::: "memory");
        } else {
            XB_SPIN(xb_ld(&bar[XB_XGEN(b.x)]) == gen, bar);
            __builtin_amdgcn_fence(__ATOMIC_ACQUIRE, "agent");
            asm volatile("s_waitcnt vmcnt(0)" ::: "memory");
        }
    }
    __syncthreads();
}

constexpr int PPL = 12;
constexpr int NPHASE = 2 + PPL * DEPTH;
#ifndef PROBE_SUB
#define PROBE_SUB 3
#endif
#ifndef PROBE_REP
#define PROBE_REP (-1)
#endif
__global__ void __launch_bounds__(NTHREADS, 2) mega(Params p_arg, int ph_lo, int ph_hi) {
    extern __shared__ __attribute__((aligned(16))) char lds[];
    cg::grid_group grid = cg::this_grid();
    volatile LAS unsigned* st = (volatile LAS unsigned*)(lds + LDS_BYTES - 16);
    if (threadIdx.x == 0) { st[0] = 0u; st[1] = 0u; }
    __syncthreads();
    XcdBarrier xb = xcd_barrier_post((unsigned*)(p_arg.ws + OFF_BAR), st);
    for (int ph = ph_lo; ph < ph_hi; ++ph) {
        KP p = (KP)__builtin_amdgcn_kernarg_segment_ptr();
        asm volatile("" : "+s"(p));
        const int l = (ph >= 2) ? (ph - 2) / PPL : 0;
        const int q = (ph >= 2) ? (ph - 2) % PPL : -1;
        const bool nobar = (q >= 1 && q <= 3);
        const int nrep = (PROBE_REP >= 0 && ph == PROBE_REP) ? 2 : 1;
        for (int rep = 0; rep < nrep; ++rep) {
            const int dry = (PROBE_REP >= 0 && ph == PROBE_REP && rep == 0) ? 1 : 0;
            char* ldsh = lds + (threadIdx.x >> 8) * LDS_HALF;
            if (ph == 0) phase0(p, ldsh);
            else if (ph == 1) phaseF0(p);
            else {
                switch (q) {
                    case 0: phaseA(p, l, lds); break;
                    case 1: phaseB1(p, l, ldsh, 1, (PROBE_REP >= 0 && ph == PROBE_REP && rep == 1) ? PROBE_SUB : 3); break;
                    case 2: phaseB1(p, l, ldsh, 2); break;
                    case 3: phaseB1(p, l, ldsh, 4); break;
                    case 4: phaseB1(p, l, ldsh, 8); break;
                    case 5: phaseB2(p, l, ldsh); break;
                    case 6: phaseB3(p, l); break;
                    case 7: phaseC(p, l, lds); break;
                    case 8: phaseD(p, l, ldsh, dry); break;
                    case 9: phaseE1(p, l, lds); break;
                    case 10: phaseE2(p, l, lds); break;
                    default: phaseF(p, l, dry); break;
                }
            }
            const bool lastrep = (rep + 1 == nrep);
            if (!lastrep || (ph + 1 < ph_hi && !nobar)) { if (lastrep && ph == ph_lo) grid.sync(); else xcd_barrier(xb); }
        }
    }
}

extern "C" void kernel_launch(void* const* d_in, const int* in_sizes, int n_in, void* d_out, int out_size, void* d_ws, size_t ws_size, hipStream_t stream) {
    static int grid_blocks = 0;
    if (grid_blocks == 0) {
        if (n_in != 39 || out_size != NTOK * DM || ws_size < WS_NEED) { fprintf(stderr, "kernel_launch: unexpected shapes (n_in %d out %d ws %zu need %zu)\n", n_in, out_size, ws_size, (size_t)WS_NEED); grid_blocks = -1; return; }
        int dev = 0, cus = 0, per_cu = 0;
        hipGetDevice(&dev);
        hipDeviceGetAttribute(&cus, hipDeviceAttributeMultiprocessorCount, dev);
        hipFuncSetAttribute((const void*)mega, hipFuncAttributeMaxDynamicSharedMemorySize, LDS_BYTES);
        hipOccupancyMaxActiveBlocksPerMultiprocessor(&per_cu, (const void*)mega, NTHREADS, LDS_BYTES);
        if (per_cu < 1) { fprintf(stderr, "kernel_launch: occupancy query returned %d\n", per_cu); grid_blocks = -1; return; }
        if (cus < 256) { fprintf(stderr, "kernel_launch: this build needs 256 CUs (found %d)\n", cus); grid_blocks = -1; return; }
        grid_blocks = 256;
    }
    if (grid_blocks < 0) return;
    if (hipMemsetAsync(d_ws, 0, 32768, stream) != hipSuccess) { fprintf(stderr, "kernel_launch: memset failed\n"); return; }
    Params p{};
    for (int i = 0; i < 39; ++i) p.in[i] = (const float*)d_in[i];
    p.out = (float*)d_out; p.ws = (unsigned char*)d_ws;
    int ph_lo = 0, ph_hi = NPHASE;
    void* args[] = {&p, &ph_lo, &ph_hi};
    hipError_t e = hipLaunchCooperativeKernel((const void*)mega, dim3(grid_blocks), dim3(NTHREADS), args, LDS_BYTES, stream);
    if (e != hipSuccess) fprintf(stderr, "cooperative launch failed: %s (grid %d)\n", hipGetErrorString(e), grid_blocks);
}
```

```cpp
#include <hip/hip_runtime.h>
#include <hip/hip_cooperative_groups.h>
#include <stdio.h>
#include <stdint.h>
namespace cg = cooperative_groups;

typedef unsigned short bf16_t;
typedef short bf16x8 __attribute__((ext_vector_type(8)));
typedef float f32x4 __attribute__((ext_vector_type(4)));
#define DEVINL __device__ __forceinline__
#define LAS __attribute__((address_space(3)))
#define MFMA32(a, b, c) __builtin_amdgcn_mfma_f32_32x32x16_bf16((a), (b), (c), 0, 0, 0)

constexpr int NTOK = 32768, SEQ = 4096, NBATCH = 8, DM = 1024, PIN = 2688, DEPTH = 2;
constexpr int NEXP = 64;
constexpr float ALPHA = 1.41421356237f;
constexpr float LN_EPS = 1e-5f, GN_EPS = 64e-5f;
constexpr int NTHREADS = 512;
constexpr int VTHREADS = 256;
constexpr int LDS_HALF = 75776;
constexpr int LDS_BYTES = 159744;

constexpr size_t OFF_CNT   = 0;
constexpr size_t OFF_BAR   = 4096;
constexpr size_t OFF_MOD   = 65536;
constexpr size_t OFF_WR    = 524288;
constexpr size_t OFF_WIN   = 1048576;
constexpr int WIN_ROWS = 2816;
constexpr size_t OFF_WOUT  = OFF_WIN + 2 * (size_t)WIN_ROWS * 1024 * 2;
constexpr size_t OFF_W13   = OFF_WOUT + 4194304;
constexpr size_t OFF_W2    = OFF_W13 + 136314880;
constexpr size_t OFF_UBUF  = OFF_W2 + 68157440;
constexpr size_t OFF_ARENA = OFF_UBUF + 67108864;
constexpr size_t A_P      = OFF_ARENA;
constexpr size_t A_YMIX   = A_P + 176160768;
constexpr size_t A_SCAN   = A_YMIX + 67108864;
constexpr size_t A_HLOC   = A_SCAN + 134217728;
constexpr size_t A_CUMA   = A_HLOC + 33554432;
constexpr size_t A_G      = A_CUMA + 33554432;
constexpr size_t A_BONUS  = A_G + 33554432;
constexpr size_t A_YRAW   = A_BONUS + 33554432;
constexpr size_t A_CARRYA = A_YRAW + 33554432;
constexpr size_t A_CARRYH = A_CARRYA + 1048576;
constexpr size_t A_HSTART = A_CARRYH + 1048576;
constexpr size_t A_CHAIN  = A_HSTART + 1048576;
constexpr size_t CHAIN_UNIT = 49152;
constexpr size_t M_YBUF   = OFF_ARENA;
constexpr size_t M_ZB     = OFF_ARENA + 335544320;
constexpr size_t M_HBUF   = M_YBUF + 603979776;
constexpr size_t M_LIST   = M_HBUF + 159383552;
constexpr size_t M_WSEL   = M_LIST + 8388608;
constexpr size_t M_PMAP   = M_WSEL + 1048576;
constexpr size_t M_STAT   = M_PMAP + 1048576;
constexpr size_t OFF_WLT  = M_STAT + 262144;
constexpr size_t OFF_WGT  = OFF_WLT + 131072;
constexpr size_t WS_NEED  = OFF_WGT + 131072;
static_assert(WS_NEED <= (size_t)1 << 30, "workspace layout exceeds the guaranteed 1 GiB");

struct Params {
    const float* in[39];
    float* out;
    unsigned char* ws;
};
typedef const __attribute__((address_space(4))) Params* KP;
__device__ __forceinline__ int TIDX() { int t = threadIdx.x; asm volatile("" : "+v"(t)); t &= 255; return t; }
__device__ __forceinline__ int BIDX() { int b = blockIdx.x * 2 + __builtin_amdgcn_readfirstlane((int)(threadIdx.x >> 8)); asm volatile("" : "+s"(b)); __builtin_assume(b >= 0 && b < 65536); return b; }
__device__ __forceinline__ int NBV() { return gridDim.x * 2; }
__device__ __forceinline__ int TID512() { int t = threadIdx.x; asm volatile("" : "+v"(t)); __builtin_assume(t >= 0 && t < 512); return t; }
enum { I_X = 0, I_C, I_WMOD, I_BMOD, I_WIN, I_WOUT, I_CONVA, I_CONVAB, I_LNAG, I_LNAB, I_CONVB, I_CONVBB, I_WRG, I_BRG, I_WIG, I_BIG,
       I_LAMBDA, I_MUC, I_W0, I_WW2, I_A0, I_WA2, I_WG2, I_KK, I_KA, I_RK, I_GNG, I_GNB, I_CONVD, I_LN1G, I_LN1B, I_WROUTER, I_EBIAS,
       I_W13, I_W2, I_WS13, I_WS2, I_LN2G, I_LN2B };

DEVINL bf16_t f2bf(float f) { unsigned u = __float_as_uint(f); u += 0x7FFFu + ((u >> 16) & 1u); return (bf16_t)(u >> 16); }
DEVINL float bf2f(bf16_t h) { return __uint_as_float(((unsigned)h) << 16); }
typedef __bf16 bf2_t __attribute__((ext_vector_type(2)));
typedef float f2_t __attribute__((ext_vector_type(2)));
typedef float f32x16 __attribute__((ext_vector_type(16)));
DEVINL unsigned pack2(float a, float b) { f2_t v = {a, b}; return __builtin_bit_cast(unsigned, __builtin_convertvector(v, bf2_t)); }
DEVINL float sigm(float x) { return __builtin_amdgcn_rcpf(1.f + __expf(-x)); }
DEVINL float tanh_fast(float x) { const float e = __expf(2.f * x); return 1.f - 2.f * __builtin_amdgcn_rcpf(1.f + e); }
DEVINL float softplusf(float z) { return fmaxf(z, 0.f) + __logf(1.f + __expf(-fabsf(z))); }
DEVINL float log1p_s(float y) { return (y < 0.03125f) ? y * (1.f - y * (0.5f - y * (0.33333334f - 0.25f * y))) : __logf(1.f + y); }
DEVINL float softplus_acc(float z) { return fmaxf(z, 0.f) + log1p_s(__expf(-fabsf(z))); }
DEVINL float gelu_tanh(float x) { float u = 0.7978845608028654f * (x + 0.044715f * x * x * x); return 0.5f * x * (1.f + tanh_fast(u)); }
DEVINL float group8_max(float x) {
    x = fmaxf(x, __builtin_bit_cast(float, __builtin_amdgcn_update_dpp(0, __builtin_bit_cast(int, x), 0xB1, 0xf, 0xf, true)));
    x = fmaxf(x, __builtin_bit_cast(float, __builtin_amdgcn_update_dpp(0, __builtin_bit_cast(int, x), 0x4E, 0xf, 0xf, true)));
    x = fmaxf(x, __builtin_bit_cast(float, __builtin_amdgcn_update_dpp(0, __builtin_bit_cast(int, x), 0x141, 0xf, 0xf, true)));
    return x;
}
DEVINL float wave_sum_dpp(float x);
DEVINL float wave_sum(float x) { return wave_sum_dpp(x); }
DEVINL float wave_sum_dpp(float x) {
    x += __builtin_bit_cast(float, __builtin_amdgcn_update_dpp(0, __builtin_bit_cast(int, x), 0xB1, 0xf, 0xf, true));
    x += __builtin_bit_cast(float, __builtin_amdgcn_update_dpp(0, __builtin_bit_cast(int, x), 0x4E, 0xf, 0xf, true));
    x += __builtin_bit_cast(float, __builtin_amdgcn_update_dpp(0, __builtin_bit_cast(int, x), 0x141, 0xf, 0xf, true));
    x += __builtin_bit_cast(float, __builtin_amdgcn_update_dpp(0, __builtin_bit_cast(int, x), 0x140, 0xf, 0xf, true));
    x += __builtin_bit_cast(float, __builtin_amdgcn_update_dpp(0, __builtin_bit_cast(int, x), 0x142, 0xa, 0xf, false));
    x += __builtin_bit_cast(float, __builtin_amdgcn_update_dpp(0, __builtin_bit_cast(int, x), 0x143, 0xc, 0xf, false));
    return __builtin_bit_cast(float, __builtin_amdgcn_readlane(__builtin_bit_cast(int, x), 63));
}

DEVINL int lds_byte(int r, int c) { int st = (r >> 4) * 2 + (c >> 5), rr = r & 15, cc = c & 31, ob = rr * 64 + cc * 2; return st * 1024 + (ob ^ (((ob >> 9) & 1) << 5)); }
DEVINL void stage_rc(int b, int& R, int& C) { int st = b / 1024, sb = b % 1024, swz = sb ^ (((sb >> 9) & 1) << 5); R = (st >> 1) * 16 + swz / 64; C = (st & 1) * 32 + (swz % 64) / 2; }

template <class RowPtr, class Epi>
DEVINL void gemm_tile128(char* lds, RowPtr arow, const bf16_t* Bt, int K, Epi epi) {
    const int tid = TIDX();
    const bf16_t* ap[4]; const bf16_t* bp[4];
#pragma unroll
    for (int i = 0; i < 4; ++i) { int R, C; stage_rc(tid * 16 + i * 4096, R, C); ap[i] = arow(R) + C; bp[i] = Bt + (size_t)R * K + C; }
    const int wid = tid >> 6, lane = tid & 63, wr = wid >> 1, wc = wid & 1, fr = lane & 15, fq = lane >> 4;
    f32x4 acc[4][4];
#pragma unroll
    for (int m = 0; m < 4; ++m)
#pragma unroll
        for (int n = 0; n < 4; ++n) acc[m][n] = (f32x4){0.f, 0.f, 0.f, 0.f};
    const int nk = K >> 6;
#pragma unroll
    for (int i = 0; i < 4; ++i) {
        __builtin_amdgcn_global_load_lds((const unsigned*)(ap[i]), (unsigned*)(lds + tid * 16 + i * 4096), 16, 0, 0);
        __builtin_amdgcn_global_load_lds((const unsigned*)(bp[i]), (unsigned*)(lds + 16384 + tid * 16 + i * 4096), 16, 0, 0);
    }
    for (int kt = 0; kt < nk; ++kt) {
        asm volatile("s_waitcnt vmcnt(0)" ::: "memory");
        __syncthreads();
        char* cur = lds + (kt & 1) * 32768;
        if (kt + 1 < nk) {
            char* nxt = lds + ((kt + 1) & 1) * 32768;
            const int ko = (kt + 1) * 64;
#pragma unroll
            for (int i = 0; i < 4; ++i) {
                __builtin_amdgcn_global_load_lds((const unsigned*)(ap[i] + ko), (unsigned*)(nxt + tid * 16 + i * 4096), 16, 0, 0);
                __builtin_amdgcn_global_load_lds((const unsigned*)(bp[i] + ko), (unsigned*)(nxt + 16384 + tid * 16 + i * 4096), 16, 0, 0);
            }
        }
        bf16x8 af[4][2], bfr[4][2];
#pragma unroll
        for (int m = 0; m < 4; ++m)
#pragma unroll
            for (int kk = 0; kk < 2; ++kk) af[m][kk] = *reinterpret_cast<const bf16x8*>(cur + lds_byte(wr * 64 + m * 16 + fr, kk * 32 + fq * 8));
#pragma unroll
        for (int n = 0; n < 4; ++n)
#pragma unroll
            for (int kk = 0; kk < 2; ++kk) bfr[n][kk] = *reinterpret_cast<const bf16x8*>(cur + 16384 + lds_byte(wc * 64 + n * 16 + fr, kk * 32 + fq * 8));
#pragma unroll
        for (int kk = 0; kk < 2; ++kk)
#pragma unroll
            for (int m = 0; m < 4; ++m)
#pragma unroll
                for (int n = 0; n < 4; ++n) acc[m][n] = __builtin_amdgcn_mfma_f32_16x16x32_bf16(bfr[n][kk], af[m][kk], acc[m][n], 0, 0, 0);
    }
    __syncthreads();
    epi(acc, wr, wc, fr, fq);
}

template <class Ptrs, class Epi>
DEVINL void gemm_stream128(char* lds, int K, int blk, int nb, int total, Ptrs ptrs, Epi epi) {
    const int qx = nb >> 3, first = (blk & 7) * qx + (blk >> 3), stride = nb;
    if (first >= total) return;
    const int tid = TIDX();
    const int wid = tid >> 6, lane = tid & 63, wr = wid >> 1, wc = wid & 1, fr = lane & 15, fq = lane >> 4;
    const int nk = K >> 6;
    const bf16_t* ap[4]; const bf16_t* bp[4];
    const bf16_t* an[4]; const bf16_t* bn[4];
    int t = first;
    ptrs(t, ap, bp);
#pragma unroll
    for (int i = 0; i < 4; ++i) {
        __builtin_amdgcn_global_load_lds((const unsigned*)(ap[i]), (unsigned*)(lds + tid * 16 + i * 4096), 16, 0, 0);
        __builtin_amdgcn_global_load_lds((const unsigned*)(bp[i]), (unsigned*)(lds + 16384 + tid * 16 + i * 4096), 16, 0, 0);
    }
    for (;;) {
        const int tn = t + stride;
        const bool has_next = tn < total;
        if (has_next) ptrs(tn, an, bn);
        f32x4 acc[4][4];
#pragma unroll
        for (int m = 0; m < 4; ++m)
#pragma unroll
            for (int n = 0; n < 4; ++n) acc[m][n] = (f32x4){0.f, 0.f, 0.f, 0.f};
        for (int kt = 0; kt < nk; ++kt) {
            asm volatile("s_waitcnt vmcnt(0)" ::: "memory");
            __syncthreads();
            char* cur = lds + (kt & 1) * 32768;
            if (kt + 1 < nk) {
                char* nxt = lds + ((kt + 1) & 1) * 32768;
                const int ko = (kt + 1) * 64;
#pragma unroll
                for (int i = 0; i < 4; ++i) {
                    __builtin_amdgcn_global_load_lds((const unsigned*)(ap[i] + ko), (unsigned*)(nxt + tid * 16 + i * 4096), 16, 0, 0);
                    __builtin_amdgcn_global_load_lds((const unsigned*)(bp[i] + ko), (unsigned*)(nxt + 16384 + tid * 16 + i * 4096), 16, 0, 0);
                }
            } else if (has_next) {
#pragma unroll
                for (int i = 0; i < 4; ++i) {
                    __builtin_amdgcn_global_load_lds((const unsigned*)(an[i]), (unsigned*)(lds + tid * 16 + i * 4096), 16, 0, 0);
                    __builtin_amdgcn_global_load_lds((const unsigned*)(bn[i]), (unsigned*)(lds + 16384 + tid * 16 + i * 4096), 16, 0, 0);
                }
            }
            bf16x8 af[4][2], bfr[4][2];
#pragma unroll
            for (int m = 0; m < 4; ++m)
#pragma unroll
                for (int kk = 0; kk < 2; ++kk) af[m][kk] = *reinterpret_cast<const bf16x8*>(cur + lds_byte(wr * 64 + m * 16 + fr, kk * 32 + fq * 8));
#pragma unroll
            for (int n = 0; n < 4; ++n)
#pragma unroll
                for (int kk = 0; kk < 2; ++kk) bfr[n][kk] = *reinterpret_cast<const bf16x8*>(cur + 16384 + lds_byte(wc * 64 + n * 16 + fr, kk * 32 + fq * 8));
#pragma unroll
            for (int kk = 0; kk < 2; ++kk)
#pragma unroll
                for (int m = 0; m < 4; ++m)
#pragma unroll
                    for (int n = 0; n < 4; ++n) acc[m][n] = __builtin_amdgcn_mfma_f32_16x16x32_bf16(bfr[n][kk], af[m][kk], acc[m][n], 0, 0, 0);
        }
        epi(t, acc, wr, wc, fr, fq);
        if (!has_next) break;
        t = tn;
#pragma unroll
        for (int i = 0; i < 4; ++i) { ap[i] = an[i]; bp[i] = bn[i]; }
    }
    __syncthreads();
}
DEVINL void stage_coords(int (&R)[4], int (&C)[4]) {
    const int tid = TIDX();
#pragma unroll
    for (int i = 0; i < 4; ++i) stage_rc(tid * 16 + i * 4096, R[i], C[i]);
}

struct GUnit {
    const char* A;
    const char* B;
    unsigned va[2][2] = {{0u, 0u}, {0u, 0u}};
    int i0, i1, i2;
};
constexpr int G_HTB = 128 * 64 * 2;
constexpr int G_STAGE_BYTES = 8 * G_HTB;
DEVINL int perm32(int rho) { const int n = rho >> 4, i = rho & 15; return 8 * (i >> 2) + 4 * n + (i & 3); }
DEVINL void stage_coords512(int tid, int (&R)[2], int (&C)[2]) {
#pragma unroll
    for (int i = 0; i < 2; ++i) stage_rc(tid * 16 + i * 8192, R[i], C[i]);
}

template <bool PERM, bool GATHER, class Sched, class Epi>
DEVINL void gemm256(char* lds_generic, int K, int lda, Sched sched, Epi epi) {
    LAS unsigned char* lds = (LAS unsigned char*)lds_generic;
    const int tid = TID512(), wid = __builtin_amdgcn_readfirstlane(tid >> 6), lane = tid & 63, wr = wid >> 2, wc = wid & 3, fr = lane & 15, fq = lane >> 4;
    const int nt = K / 64;
    unsigned voffB[2];
#pragma unroll
    for (int i = 0; i < 2; ++i) { int R, C; stage_rc(tid * 16 + i * 8192, R, C); const int Rb = PERM ? ((R & ~31) + perm32(R & 31)) : R; voffB[i] = (unsigned)(Rb * K + C) * 2u; }
    unsigned voffA[2];
#pragma unroll
    for (int i = 0; i < 2; ++i) { int R, C; stage_rc(tid * 16 + i * 8192, R, C); voffA[i] = (unsigned)(R * lda + C) * 2u; }
    const size_t hstepA = GATHER ? 0 : (size_t)128 * lda * 2;
    const size_t kstep = (size_t)(64 * 2);
    const size_t hstepB = (size_t)128 * K * 2;
    const unsigned ldsw = (unsigned)wid * 1024u;
    const int aoff = lds_byte(wr * 64 + fr, fq * 8), boff = lds_byte(wc * 32 + fr, fq * 8);
#define G_SA(b, h) (((b) * 2 + (h)) * G_HTB)
#define G_SB(b, h) ((4 + (b) * 2 + (h)) * G_HTB)
#define G_STAGE(bufoff, gbase, voff) do { _Pragma("unroll") for (int _i = 0; _i < 2; ++_i) { unsigned _vo = (voff)[_i]; asm volatile("" : "+v"(_vo)); \
        __builtin_amdgcn_global_load_lds((const unsigned*)((const char*)(gbase) + _vo), (LAS unsigned*)(lds + (bufoff) + ldsw + _i * 8192), 16, 0, 0); } } while (0)
#define G_STAGE_A(bufoff, ptr, vg, h) do { if constexpr (GATHER) { G_STAGE(bufoff, ptr, vg); } else { G_STAGE(bufoff, (ptr) + (h) * hstepA, voffA); } } while (0)
#define G_LDA(dst, b, h) do { _Pragma("unroll") for (int m = 0; m < 4; ++m) _Pragma("unroll") for (int k = 0; k < 2; ++k) dst[m][k] = *(const LAS bf16x8*)(lds + G_SA(b, h) + aoff + m * 2048 + k * 1024); } while (0)
#define G_LDB(dst, b, h) do { _Pragma("unroll") for (int n = 0; n < 2; ++n) _Pragma("unroll") for (int k = 0; k < 2; ++k) dst[n][k] = *(const LAS bf16x8*)(lds + G_SB(b, h) + boff + n * 2048 + k * 1024); } while (0)
#define G_MMA(ai, bj, At, Bt) do { __builtin_amdgcn_s_setprio(1); _Pragma("unroll") for (int m = 0; m < 4; ++m) _Pragma("unroll") for (int n = 0; n < 2; ++n) _Pragma("unroll") for (int k = 0; k < 2; ++k) \
        acc[ai][bj][m][n] = __builtin_amdgcn_mfma_f32_16x16x32_bf16(Bt[n][k], At[m][k], acc[ai][bj][m][n], 0, 0, 0); __builtin_amdgcn_s_setprio(0); } while (0)
#define G_WAIT_V(n) asm volatile("s_waitcnt vmcnt(" #n ")" ::: "memory")
#define G_WAIT_L(n) asm volatile("s_waitcnt lgkmcnt(" #n ")" ::: "memory")
#define G_BAR __builtin_amdgcn_s_barrier()
#define G_SCHED __builtin_amdgcn_sched_barrier(0)
    GUnit cur, nxt; int ui = 0;
    if (!sched(0, cur)) return;
    LAS unsigned* vst = (LAS unsigned*)(lds + 131072 + 8192) + tid * 8;
    if constexpr (GATHER) { vst[0] = cur.va[0][0]; vst[1] = cur.va[0][1]; vst[2] = cur.va[1][0]; vst[3] = cur.va[1][1]; }
    f32x4 acc[2][2][4][2];
#pragma unroll
    for (int a = 0; a < 2; ++a)
#pragma unroll
        for (int b = 0; b < 2; ++b)
#pragma unroll
            for (int m = 0; m < 4; ++m)
#pragma unroll
                for (int n = 0; n < 2; ++n) acc[a][b][m][n] = (f32x4){0.f, 0.f, 0.f, 0.f};
    bf16x8 At[4][2], B0[2][2], B1[2][2];
    G_STAGE(G_SB(0, 0), cur.B, voffB); G_STAGE_A(G_SA(0, 0), cur.A, cur.va[0], 0); G_STAGE(G_SB(0, 1), cur.B + hstepB, voffB); G_STAGE_A(G_SA(0, 1), cur.A, cur.va[1], 1);
    if (wr == 1) G_BAR;
    G_WAIT_V(4); G_BAR;
    G_STAGE(G_SB(1, 0), cur.B + kstep, voffB); G_STAGE_A(G_SA(1, 0), cur.A + kstep, cur.va[0], 0); G_STAGE(G_SB(1, 1), cur.B + hstepB + kstep, voffB);
    G_WAIT_V(6); G_BAR;
    for (;;) {
        const bool has_next = sched(ui + 1, nxt);
        if (!has_next) nxt = cur;
        if constexpr (GATHER) { LAS unsigned* vn = vst + ((ui + 1) & 1) * 4; vn[0] = nxt.va[0][0]; vn[1] = nxt.va[0][1]; vn[2] = nxt.va[1][0]; vn[3] = nxt.va[1][1]; }
        for (int t = 0; t < nt; t += 2) {
            const bool last = (t == nt - 2);
            const char* a1 = cur.A + (size_t)(t + 1) * kstep;
            const char* a2 = last ? nxt.A : cur.A + (size_t)(t + 2) * kstep; const char* b2 = last ? nxt.B : cur.B + (size_t)(t + 2) * kstep;
            const char* a3 = a2 + kstep; const char* b3 = b2 + kstep;
            G_LDB(B0, 0, 0); G_SCHED; G_LDA(At, 0, 0); { unsigned nv[2] = {0u, 0u}; if constexpr (GATHER) { LAS unsigned* q_ = vst + (ui & 1) * 4; nv[0] = q_[2]; nv[1] = q_[3]; } G_STAGE_A(G_SA(1, 1), a1, nv, 1); }
            G_WAIT_L(8); G_BAR; G_WAIT_L(0); G_MMA(0, 0, At, B0); G_BAR; G_SCHED;
            G_LDB(B1, 0, 1); G_STAGE(G_SB(0, 0), b2, voffB);
            G_BAR; G_WAIT_L(0); G_MMA(0, 1, At, B1); G_BAR;
            G_LDA(At, 0, 1); { unsigned nv[2] = {0u, 0u}; if constexpr (GATHER) { LAS unsigned* q_ = vst + ((ui + (last ? 1 : 0)) & 1) * 4; nv[0] = q_[0]; nv[1] = q_[1]; } G_STAGE_A(G_SA(0, 0), a2, nv, 0); }
            G_BAR; G_WAIT_L(0); G_MMA(1, 0, At, B0); G_BAR; G_SCHED;
            G_STAGE(G_SB(0, 1), b2 + hstepB, voffB);
            G_WAIT_V(6); G_BAR; G_MMA(1, 1, At, B1); G_BAR;
            G_LDB(B0, 1, 0); G_SCHED; G_LDA(At, 1, 0); { unsigned nv[2] = {0u, 0u}; if constexpr (GATHER) { LAS unsigned* q_ = vst + ((ui + (last ? 1 : 0)) & 1) * 4; nv[0] = q_[2]; nv[1] = q_[3]; } G_STAGE_A(G_SA(0, 1), a2, nv, 1); }
            G_WAIT_L(8); G_BAR; G_WAIT_L(0); G_MMA(0, 0, At, B0); G_BAR; G_SCHED;
            G_LDB(B1, 1, 1); G_STAGE(G_SB(1, 0), b3, voffB);
            G_BAR; G_WAIT_L(0); G_MMA(0, 1, At, B1); G_BAR;
            G_LDA(At, 1, 1); { unsigned nv[2] = {0u, 0u}; if constexpr (GATHER) { LAS unsigned* q_ = vst + ((ui + (last ? 1 : 0)) & 1) * 4; nv[0] = q_[0]; nv[1] = q_[1]; } G_STAGE_A(G_SA(1, 0), a3, nv, 0); }
            G_BAR; G_WAIT_L(0); G_MMA(1, 0, At, B0); G_BAR; G_SCHED;
            G_STAGE(G_SB(1, 1), b3 + hstepB, voffB);
            G_WAIT_V(6); G_BAR; G_MMA(1, 1, At, B1); G_BAR;
        }
        { const int l2 = TID512() & 63; epi(acc, cur, wr, wc, l2 & 15, l2 >> 4); }
        if (!has_next) break;
#pragma unroll
        for (int a = 0; a < 2; ++a)
#pragma unroll
            for (int b = 0; b < 2; ++b)
#pragma unroll
                for (int m = 0; m < 4; ++m)
#pragma unroll
                    for (int n = 0; n < 2; ++n) acc[a][b][m][n] = (f32x4){0.f, 0.f, 0.f, 0.f};
        cur = nxt; ++ui;
    }
    G_WAIT_V(0);
    if (wr == 0) G_BAR;
    G_BAR;
#undef G_SA
#undef G_STAGE_A
#undef G_SB
#undef G_STAGE
#undef G_LDA
#undef G_LDB
#undef G_MMA
#undef G_WAIT_V
#undef G_WAIT_L
#undef G_BAR
#undef G_SCHED
}
DEVINL long unit_linear(int i, int c, int G) { const int q = G >> 3; return ((long)i * 8 + (c & 7)) * q + (c >> 3); }

constexpr int CONV_PER_L = 672 + 256 + 8320 + 4160;
struct ConvJob { const float* src; bf16_t* dst; int K, ld, k0, r0, perm; };
DEVINL ConvJob conv_decode(KP p, int id) {
    ConvJob j; const int l = id / CONV_PER_L; int r = id % CONV_PER_L; int kt, nt;
    if (r < 672) { j.src = p->in[I_WIN] + (size_t)l * 1024 * 2688; j.K = 1024; j.ld = 2688; j.perm = 0; j.dst = (bf16_t*)(p->ws + OFF_WIN) + (size_t)l * WIN_ROWS * 1024; nt = r % 42; kt = r / 42; }
    else if (r < 928) { r -= 672; j.src = p->in[I_WOUT] + (size_t)l * 1024 * 1024; j.K = 1024; j.ld = 1024; j.perm = 0; j.dst = (bf16_t*)(p->ws + OFF_WOUT) + (size_t)l * 1024 * 1024; nt = r & 15; kt = r >> 4; }
    else if (r < 928 + 8320) { r -= 928; const int e = r >> 7, q = r & 127; nt = q & 7; kt = q >> 3; j.K = 1024; j.ld = 512; j.perm = 1;
        j.src = (e < 64) ? p->in[I_W13] + (size_t)(l * 64 + e) * 1024 * 512 : p->in[I_WS13] + (size_t)l * 1024 * 512;
        j.dst = (bf16_t*)(p->ws + OFF_W13) + (size_t)(l * 65 + e) * 512 * 1024; }
    else { r -= 9248; const int e = r >> 6, q = r & 63; nt = q & 15; kt = q >> 4; j.K = 256; j.ld = 1024; j.perm = 0;
        j.src = (e < 64) ? p->in[I_W2] + (size_t)(l * 64 + e) * 256 * 1024 : p->in[I_WS2] + (size_t)l * 256 * 1024;
        j.dst = (bf16_t*)(p->ws + OFF_W2) + (size_t)(l * 65 + e) * 1024 * 256; }
    j.k0 = kt * 64; j.r0 = nt * 64; return j;
}
DEVINL void conv_issue(const ConvJob& j, char* buf, int tid) {
    const int nn = tid & 63, drow = j.r0 + nn;
    int scol = drow;
    if (j.perm) { const int g = drow >> 5, i = drow & 31; scol = (i < 16) ? (g * 16 + i) : (256 + g * 16 + (i - 16)); }
    const float* sp = j.src + (size_t)j.k0 * j.ld + scol;
#pragma unroll
    for (int q = 0; q < 16; ++q) { const int kk = (tid >> 6) + 4 * q;
        __builtin_amdgcn_global_load_lds((const unsigned*)(sp + (size_t)kk * j.ld), (unsigned*)(buf + kk * 260 + nn * 4), 4, 0, 0); }
}
DEVINL void convert_ids(KP p, char* lds, int id_lo, int id_hi, int wb, int nwb) {
    const int tid = TIDX();
    const int n = (id_hi - id_lo + nwb - 1) / nwb;
    auto idof = [&](int i) { const int id = id_lo + i * nwb + wb; return (id < id_hi) ? id : id_hi - 1; };
    ConvJob j0 = conv_decode(p, idof(0)), j1 = conv_decode(p, idof(n > 1 ? 1 : 0));
    conv_issue(j0, lds, tid);
    conv_issue(j1, lds + 16640, tid);
    bf16_t* d0 = j0.dst + (size_t)j0.r0 * j0.K + j0.k0; int K0 = j0.K;
    bf16_t* d1 = j1.dst + (size_t)j1.r0 * j1.K + j1.k0; int K1 = j1.K;
    for (int i = 0; i < n; ++i) {
        const ConvJob j2 = conv_decode(p, idof(i + 2 < n ? i + 2 : n - 1));
        conv_issue(j2, lds + ((i + 2) % 3) * 16640, tid);
        asm volatile("s_waitcnt vmcnt(32)" ::: "memory");
        __builtin_amdgcn_s_barrier();
        const float* tile = (const float*)(lds + (i % 3) * 16640);
        {
            const int kp = (tid & 31) * 2;
#pragma unroll
            for (int q = 0; q < 8; ++q) { const int rr = (tid >> 5) + 8 * q;
                *(unsigned*)(d0 + (size_t)rr * K0 + kp) = pack2(tile[kp * 65 + rr], tile[(kp + 1) * 65 + rr]); }
        }
        asm volatile("s_waitcnt lgkmcnt(0)" ::: "memory");
        __builtin_amdgcn_s_barrier();
        d0 = d1; K0 = K1; d1 = j2.dst + (size_t)j2.r0 * j2.K + j2.k0; K1 = j2.K;
    }
    asm volatile("s_waitcnt vmcnt(0)" ::: "memory");
    __syncthreads();
}

DEVINL void phase0(KP p, char* lds) {
    const int tid = TIDX(), nb = NBV(), blk = BIDX();
    if (blk == 0 && tid < 128) ((unsigned*)(p->ws + OFF_CNT))[tid] = 0u;
    if (blk < 192) {
        float* sc = (float*)lds;
        float* part = (float*)(lds + 32768);
        for (int i = tid; i < 8192; i += VTHREADS) { float c = p->in[I_C][i]; sc[i] = c * sigm(c); }
        __syncthreads();
        const int cl = tid & 63, ks = tid >> 6, n = blk * 64 + cl, l = n / 6144, nn = n % 6144;
        const float* w = p->in[I_WMOD] + (size_t)l * 1024 * 6144 + (size_t)(ks * 256) * 6144 + nn;
        float acc[8];
#pragma unroll
        for (int b = 0; b < 8; ++b) acc[b] = 0.f;
#pragma unroll 32
        for (int k = 0; k < 256; ++k) {
            const float wv = w[(size_t)k * 6144];
#pragma unroll
            for (int b = 0; b < 8; ++b) acc[b] = fmaf(sc[b * 1024 + ks * 256 + k], wv, acc[b]);
        }
#pragma unroll
        for (int b = 0; b < 8; ++b) part[(ks * 8 + b) * 64 + cl] = acc[b];
        __syncthreads();
        if (tid < 64) {
            const float bm = p->in[I_BMOD][l * 6144 + nn];
            float* mod = (float*)(p->ws + OFF_MOD);
#pragma unroll
            for (int b = 0; b < 8; ++b) mod[(size_t)(l * 8 + b) * 6144 + nn] = part[(0 * 8 + b) * 64 + cl] + part[(1 * 8 + b) * 64 + cl] + part[(2 * 8 + b) * 64 + cl] + part[(3 * 8 + b) * 64 + cl] + bm;
        }
        __syncthreads();
    }
    if (blk >= 320 && blk < 384) {
        bf16_t* wgt = (bf16_t*)(p->ws + OFF_WGT);
#pragma unroll
        for (int j = 0; j < 4; ++j) {
            const int idx = (blk - 320) * 1024 + j * 256 + tid;
            const int mat = idx >> 15, lh = (idx >> 12) & 7, d = (idx >> 6) & 63, e = idx & 63;
            const float w = (mat == 0) ? p->in[I_WRG][idx & 32767] : p->in[I_WIG][idx & 32767];
            wgt[(size_t)((lh * 2 + mat) * 64 + e) * 64 + d] = f2bf(w);
        }
    }
    if (blk >= 256 && blk < 320) {
        bf16_t* wlt = (bf16_t*)(p->ws + OFF_WLT);
#pragma unroll
        for (int j = 0; j < 4; ++j) {
            const int idx = (blk - 256) * 1024 + j * 256 + tid, l2 = idx >> 15, f = (idx >> 8) & 127, c = idx & 255;
            const float w = (f < 32) ? p->in[I_WW2][(size_t)(l2 * 32 + f) * 256 + c] : ((f < 64) ? p->in[I_WA2][(size_t)(l2 * 32 + f - 32) * 256 + c] : p->in[I_WG2][(size_t)(l2 * 64 + f - 64) * 256 + c]);
            wlt[(size_t)(l2 * 256 + c) * 128 + f] = f2bf(w);
        }
    }
    if (blk >= 192 && blk < 256) {
        bf16_t* wrt = (bf16_t*)(p->ws + OFF_WR);
#pragma unroll
        for (int j = 0; j < 8; ++j) {
            const int idx = (blk - 192) * 2048 + j * 256 + tid, l2 = idx >> 16, rem = idx & 65535, k = rem >> 6, e = rem & 63;
            const float w = p->in[I_WROUTER][idx];
            const bf16_t hi = f2bf(w); const bf16_t lo = f2bf(w - bf2f(hi));
            wrt[(size_t)((l2 * 2 + 0) * 64 + e) * 1024 + k] = hi; wrt[(size_t)((l2 * 2 + 1) * 64 + e) * 1024 + k] = lo;
        }
    }
    convert_ids(p, lds, 0, 2 * CONV_PER_L, blk, nb);
}

DEVINL void phaseF0(KP p) {
    const int tid = TIDX(), nb = NBV(), blk = BIDX();
    const float* mod = (const float*)(p->ws + OFF_MOD);
    bf16_t* ubuf = (bf16_t*)(p->ws + OFF_UBUF);
    const int col = tid * 4;
    for (int row0 = blk * 8; row0 < NTOK; row0 += nb * 8) {
        float4 x[8];
#pragma unroll
        for (int u = 0; u < 8; ++u) x[u] = *(const float4*)(p->in[I_X] + (size_t)(row0 + u) * DM + col);
        const int b = row0 >> 12;
        const float4 sh = *(const float4*)(mod + (size_t)b * 6144 + col);
        const float4 sc = *(const float4*)(mod + (size_t)b * 6144 + 1024 + col);
#pragma unroll
        for (int u = 0; u < 8; ++u) {
            uint2 o; o.x = pack2(x[u].x * (1.f + sc.x) + sh.x, x[u].y * (1.f + sc.y) + sh.y); o.y = pack2(x[u].z * (1.f + sc.z) + sh.z, x[u].w * (1.f + sc.w) + sh.w);
            *(uint2*)(ubuf + (size_t)(row0 + u) * DM + col) = o;
        }
    }
}

DEVINL void b1_conformer(KP p, int l, char* lds, int item) {
    const int tid = TIDX(), b = item >> 7, tt = item & 127, t0 = tt * 32, rowbase = b * SEQ;
    const bf16_t* P = (const bf16_t*)(p->ws + A_P);
    bf16_t* ymix = (bf16_t*)(p->ws + A_YMIX);
    float w[31];
#pragma unroll
    for (int k = 0; k < 31; ++k) w[k] = p->in[I_CONVA][(size_t)(l * 31 + k) * 256 + tid];
    float acc[32];
    const float bias = p->in[I_CONVAB][l * 256 + tid];
#pragma unroll
    for (int j = 0; j < 32; ++j) acc[j] = bias;
#pragma unroll
    for (int rr = 0; rr < 62; ++rr) {
        const int t = t0 - 30 + rr;
        const bf16_t* pr = P + ((long)(rowbase + t0 - 30) * PIN + tid) + (long)rr * PIN;
        const float val = bf2f(pr[0]), gate = bf2f(pr[256]);
        const float h = (t >= 0) ? val * sigm(gate) : 0.f;
#pragma unroll
        for (int j = 0; j < 32; ++j) { const int k = rr - j; if (k >= 0 && k <= 30) acc[j] = fmaf(w[k], h, acc[j]); }
    }
    float* outb = (float*)lds;
#pragma unroll
    for (int j = 0; j < 32; ++j) outb[j * 256 + tid] = acc[j];
    __syncthreads();
    const int wid = tid >> 6, lane = tid & 63;
    const float4 g4 = *(const float4*)(p->in[I_LNAG] + l * 256 + lane * 4), b4 = *(const float4*)(p->in[I_LNAB] + l * 256 + lane * 4);
    for (int j = wid; j < 32; j += 4) {
        const float4 v = *(const float4*)(outb + j * 256 + lane * 4);
        const float mean = wave_sum(v.x + v.y + v.z + v.w) * (1.f / 256.f);
        const float d0 = v.x - mean, d1 = v.y - mean, d2 = v.z - mean, d3 = v.w - mean;
        const float var = wave_sum(d0 * d0 + d1 * d1 + d2 * d2 + d3 * d3) * (1.f / 256.f);
        const float rs = rsqrtf(var + LN_EPS);
        float y0 = d0 * rs * g4.x + b4.x, y1 = d1 * rs * g4.y + b4.y, y2 = d2 * rs * g4.z + b4.z, y3 = d3 * rs * g4.w + b4.w;
        y0 *= sigm(y0); y1 *= sigm(y1); y2 *= sigm(y2); y3 *= sigm(y3);
        uint2 o; o.x = pack2(y0, y1); o.y = pack2(y2, y3);
        *(uint2*)(ymix + (size_t)(rowbase + t0 + j) * DM + lane * 4) = o;
    }
    __syncthreads();
}

DEVINL void b1_shortconv(KP p, int l, int item) {
    const int tid = TIDX(), cg = tid & 31, tl = tid >> 5, b = item >> 6, t0 = (item & 63) * 64 + tl * 8, rowbase = b * SEQ;
    const bf16_t* P = (const bf16_t*)(p->ws + A_P);
    bf16_t* ymix = (bf16_t*)(p->ws + A_YMIX);
    float w0[8], w1[8], w2[8];
#pragma unroll
    for (int e = 0; e < 8; ++e) { w0[e] = p->in[I_CONVD][(l * 3 + 0) * 256 + cg * 8 + e]; w1[e] = p->in[I_CONVD][(l * 3 + 1) * 256 + cg * 8 + e]; w2[e] = p->in[I_CONVD][(l * 3 + 2) * 256 + cg * 8 + e]; }
    uint4 gbv[8], gcv[10], hdv[10];
#pragma unroll
    for (int u = 0; u < 10; ++u) {
        const int t = t0 - 2 + u;
        const bf16_t* a = P + (size_t)(rowbase + (t >= 0 ? t : 0)) * PIN + 1920 + cg * 8;
        gcv[u] = *(const uint4*)(a + 256); hdv[u] = *(const uint4*)(a + 512);
        if (u >= 2) gbv[u - 2] = *(const uint4*)(a);
    }
    float q2[8], q1[8];
#pragma unroll
    for (int u = 0; u < 10; ++u) {
        const int t = t0 - 2 + u;
        const unsigned gcw[4] = {gcv[u].x, gcv[u].y, gcv[u].z, gcv[u].w}, hdw[4] = {hdv[u].x, hdv[u].y, hdv[u].z, hdv[u].w};
        float q0[8];
#pragma unroll
        for (int e = 0; e < 4; ++e) {
            q0[2 * e] = __uint_as_float(gcw[e] << 16) * __uint_as_float(hdw[e] << 16);
            q0[2 * e + 1] = __uint_as_float(gcw[e] & 0xFFFF0000u) * __uint_as_float(hdw[e] & 0xFFFF0000u);
        }
        if (t < 0) {
#pragma unroll
            for (int e = 0; e < 8; ++e) q0[e] = 0.f;
        }
        if (u >= 2) {
            const unsigned gbw[4] = {gbv[u - 2].x, gbv[u - 2].y, gbv[u - 2].z, gbv[u - 2].w};
            float y[8];
#pragma unroll
            for (int e = 0; e < 4; ++e) {
                y[2 * e] = __uint_as_float(gbw[e] << 16) * (w0[2 * e] * q2[2 * e] + w1[2 * e] * q1[2 * e] + w2[2 * e] * q0[2 * e]);
                y[2 * e + 1] = __uint_as_float(gbw[e] & 0xFFFF0000u) * (w0[2 * e + 1] * q2[2 * e + 1] + w1[2 * e + 1] * q1[2 * e + 1] + w2[2 * e + 1] * q0[2 * e + 1]);
            }
            *(uint4*)(ymix + (size_t)(rowbase + t) * DM + 768 + cg * 8) = make_uint4(pack2(y[0], y[1]), pack2(y[2], y[3]), pack2(y[4], y[5]), pack2(y[6], y[7]));
        }
#pragma unroll
        for (int e = 0; e < 8; ++e) { q2[e] = (u >= 1) ? q1[e] : 0.f; q1[e] = q0[e]; }
    }
}

DEVINL void b1_lru(KP p, int l, char* lds, int item) {
    const int c = TIDX(), b = item >> 7, tt = item & 127, t0 = tt * 32, rowbase = b * SEQ;
    const int h = c >> 6, lane = c & 63, r = lane & 31, hh = lane >> 5;
    const bf16_t* P = (const bf16_t*)(p->ws + A_P);
    constexpr int URS2 = 528;
    char* uA = lds;
    float ureg[32];
    {
        const float cb0 = p->in[I_CONVB][(l * 4 + 0) * 256 + c], cb1 = p->in[I_CONVB][(l * 4 + 1) * 256 + c], cb2 = p->in[I_CONVB][(l * 4 + 2) * 256 + c], cb3 = p->in[I_CONVB][(l * 4 + 3) * 256 + c];
        const float bias = p->in[I_CONVBB][l * 256 + c];
        float xm3 = 0.f, xm2 = 0.f, xm1 = 0.f;
        if (t0 >= 3) { const bf16_t* a = P + (size_t)(rowbase + t0 - 3) * PIN + 512 + c; xm3 = bf2f(a[0]); xm2 = bf2f(a[PIN]); xm1 = bf2f(a[2 * PIN]); }
        bf16_t xr[32];
#pragma unroll
        for (int j = 0; j < 32; ++j) xr[j] = P[(size_t)(rowbase + t0 + j) * PIN + 512 + c];
#pragma unroll
        for (int j = 0; j < 32; ++j) {
            const float x0 = bf2f(xr[j]);
            ureg[j] = cb0 * xm3 + cb1 * xm2 + cb2 * xm1 + cb3 * x0 + bias;
            *(bf16_t*)(uA + j * URS2 + c * 2) = f2bf(ureg[j]);
            xm3 = xm2; xm2 = xm1; xm1 = x0;
        }
    }
    __syncthreads();
    float ar[32], ai[32];
    {
        const bf16_t* wg = (const bf16_t*)(p->ws + OFF_WGT) + (size_t)((l * 4 + h) * 2) * 4096 + (size_t)r * 64 + 8 * hh;
        f32x16 aR0, aR1, aI0, aI1;
#pragma unroll
        for (int i = 0; i < 16; ++i) { aR0[i] = 0.f; aR1[i] = 0.f; aI0[i] = 0.f; aI1[i] = 0.f; }
#pragma unroll
        for (int ks = 0; ks < 4; ++ks) {
            const bf16x8 af = *(const bf16x8*)(uA + r * URS2 + (h * 64 + ks * 16 + 8 * hh) * 2);
            const bf16x8 r0 = *(const bf16x8*)(wg + ks * 16), r1 = *(const bf16x8*)(wg + 32 * 64 + ks * 16);
            const bf16x8 i0 = *(const bf16x8*)(wg + 4096 + ks * 16), i1 = *(const bf16x8*)(wg + 4096 + 32 * 64 + ks * 16);
            aR0 = MFMA32(af, r0, aR0); aR1 = MFMA32(af, r1, aR1); aI0 = MFMA32(af, i0, aI0); aI1 = MFMA32(af, i1, aI1);
        }
        __syncthreads();
        float* xch = (float*)(lds + 17408) + h * 2048;
#define XCHG(X0, X1, OUT) do { _Pragma("unroll") for (int i = 0; i < 16; ++i) { const int t_ = (i & 3) + 8 * (i >> 2) + 4 * hh; xch[t_ * 64 + r] = X0[i]; xch[t_ * 64 + 32 + r] = X1[i]; } \
        _Pragma("unroll") for (int t_ = 0; t_ < 32; ++t_) OUT[t_] = xch[t_ * 64 + lane]; } while (0)
        XCHG(aR0, aR1, ar); XCHG(aI0, aI1, ai);
#undef XCHG
    }
    const float brg = p->in[I_BRG][l * 256 + c], big = p->in[I_BIG][l * 256 + c];
    const float sp = softplus_acc(-p->in[I_LAMBDA][l * 256 + c]);
    unsigned* hp = (unsigned*)(p->ws + A_HLOC) + (size_t)(rowbase + t0) * 256 + c;
    float hs = 0.f, cA = 1.f;
#pragma unroll
    for (int j = 0; j < 32; ++j) {
        const float rg = sigm(ar[j] + brg), ig = sigm(ai[j] + big);
        const float log_a = -8.0f * rg * sp;
        const float a = __expf(log_a);
        const float mult = sqrtf(fmaxf(1.f - a * a, 0.f));
        const float bx = mult * (ig * ureg[j]);
        hs = fmaf(a, hs, bx); cA *= a;
        hp[j * 256] = pack2(hs, cA);
    }
    ((float*)(p->ws + A_CARRYA))[(size_t)(b * 128 + tt) * 256 + c] = cA;
    ((float*)(p->ws + A_CARRYH))[(size_t)(b * 128 + tt) * 256 + c] = hs;
    __syncthreads();
}

DEVINL void b1_rwkv(KP p, int l, char* lds, int item) {
    const int c = TIDX(), b = item >> 7, tt = item & 127, t0 = tt * 32, rowbase = b * SEQ;
    const bf16_t* P = (const bf16_t*)(p->ws + A_P);
    constexpr int FRS = 272;
    char* featA = lds;
    const float* muc = p->in[I_MUC] + l * 896;
    if (c < 128) {
        const int col = 1024 + 768 + c; const float mu = muc[768 + c];
        float prev;
        { const float x = bf2f(P[(size_t)(rowbase + (t0 > 0 ? t0 - 1 : 0)) * PIN + col]); prev = (t0 > 0) ? x : 0.f; }
#pragma unroll 1
        for (int jb = 0; jb < 2; ++jb) {
            bf16_t raw[16];
#pragma unroll
            for (int u = 0; u < 16; ++u) raw[u] = P[(size_t)(rowbase + t0 + jb * 16 + u) * PIN + col];
#pragma unroll
            for (int u = 0; u < 16; ++u) {
                const float cur = bf2f(raw[u]);
                const float xs = cur + (prev - cur) * mu;
                const float val = (c < 32) ? tanh_fast(xs) : ((c < 64) ? xs : sigm(xs));
                *(bf16_t*)(featA + (jb * 16 + u) * FRS + c * 2) = f2bf(val); prev = cur;
            }
        }
    }
    __syncthreads();
    float dec[32], aa[32];
    {
        const int lane = c & 63, h = c >> 6, r = lane & 31, hh = lane >> 5;
        const bf16_t* wl = (const bf16_t*)(p->ws + OFF_WLT) + (size_t)(l * 256 + h * 64 + r) * 128 + 8 * hh;
        f32x16 aW0, aW1, aA0, aA1, aG0, aG1;
#pragma unroll
        for (int i = 0; i < 16; ++i) { aW0[i] = 0.f; aW1[i] = 0.f; aA0[i] = 0.f; aA1[i] = 0.f; aG0[i] = 0.f; aG1[i] = 0.f; }
        bf16x8 b0[8], b1[8];
#pragma unroll
        for (int ks = 0; ks < 8; ++ks) { b0[ks] = *(const bf16x8*)(wl + ks * 16); b1[ks] = *(const bf16x8*)(wl + 32 * 128 + ks * 16); }
#pragma unroll
        for (int ks = 0; ks < 8; ++ks) {
            const bf16x8 af = *(const bf16x8*)(featA + r * FRS + (ks * 16 + 8 * hh) * 2);
            if (ks < 2) { aW0 = MFMA32(af, b0[ks], aW0); aW1 = MFMA32(af, b1[ks], aW1); }
            else if (ks < 4) { aA0 = MFMA32(af, b0[ks], aA0); aA1 = MFMA32(af, b1[ks], aA1); }
            else { aG0 = MFMA32(af, b0[ks], aG0); aG1 = MFMA32(af, b1[ks], aG1); }
        }
        __syncthreads();
        float* xch = (float*)(lds + 9216) + h * 2048;
        float lwv[32], lav[32], lgv[32];
#define XCHG(X0, X1, OUT) do { _Pragma("unroll") for (int i = 0; i < 16; ++i) { const int t_ = (i & 3) + 8 * (i >> 2) + 4 * hh; xch[t_ * 64 + r] = X0[i]; xch[t_ * 64 + 32 + r] = X1[i]; } \
        _Pragma("unroll") for (int t_ = 0; t_ < 32; ++t_) OUT[t_] = xch[t_ * 64 + lane]; } while (0)
        XCHG(aW0, aW1, lwv); XCHG(aA0, aA1, lav); XCHG(aG0, aG1, lgv);
#undef XCHG
#define TOK(X0, X1, t) X0[t]
#define aW0 lwv
#define aA0 lav
#define aG0 lgv
        bf16_t* gbuf = (bf16_t*)(p->ws + A_G);
        const float w0 = p->in[I_W0][l * 256 + c], a0 = p->in[I_A0][l * 256 + c];
#pragma unroll
        for (int j = 0; j < 32; ++j) {
            gbuf[(size_t)(rowbase + t0 + j) * 256 + c] = f2bf(TOK(aG0, aG1, j));
            const float z = w0 + TOK(aW0, aW1, j); const float wlog = -softplusf(-z) - 0.5f; dec[j] = -__expf(wlog);
            aa[j] = sigm(a0 + TOK(aA0, aA1, j));
        }
#undef TOK
#undef aW0
#undef aA0
#undef aG0
    }
    {
        bf16_t* bonus = (bf16_t*)(p->ws + A_BONUS); uint4* scan = (uint4*)(p->ws + A_SCAN);
        const float mur = muc[c], muk = muc[256 + c], muv = muc[512 + c];
        const float kkw = p->in[I_KK][l * 256 + c], kaw = p->in[I_KA][l * 256 + c], rkw = p->in[I_RK][l * 256 + c];
        float pr, pk, pv;
        { const bf16_t* a = P + (size_t)(rowbase + (t0 > 0 ? t0 - 1 : 0)) * PIN + 1024 + c; const float x0 = bf2f(a[0]), x1 = bf2f(a[256]), x2 = bf2f(a[512]);
          pr = (t0 > 0) ? x0 : 0.f; pk = (t0 > 0) ? x1 : 0.f; pv = (t0 > 0) ? x2 : 0.f; }
#pragma unroll
        for (int jb = 0; jb < 2; ++jb) {
            bf16_t rr_[16], rk_[16], rv_[16];
#pragma unroll
            for (int u = 0; u < 16; ++u) { const bf16_t* a = P + (size_t)(rowbase + t0 + jb * 16 + u) * PIN + 1024 + c; rr_[u] = a[0]; rk_[u] = a[256]; rv_[u] = a[512]; }
#pragma unroll
            for (int u = 0; u < 16; ++u) {
                const int j = jb * 16 + u;
                const size_t row = (size_t)(rowbase + t0 + j);
                const float cr = bf2f(rr_[u]), ck = bf2f(rk_[u]), cv = bf2f(rv_[u]);
                const float r = cr + (pr - cr) * mur, k = ck + (pk - ck) * muk, v = cv + (pv - cv) * muv;
                pr = cr; pk = ck; pv = cv;
                const float kk = k * kkw;
                const float ss = wave_sum(kk * kk);
                const float kkn = kk * rsqrtf(ss + 1e-12f);
                const float kf = k * (1.f + (aa[j] - 1.f) * kaw);
                const float bs = wave_sum(r * kf * rkw);
                bonus[row * 256 + c] = f2bf(bs * v);
                uint4 o; o.x = pack2(kkn, kkn * aa[j]); o.y = pack2(kf, r); o.z = pack2(v, 0.f); o.w = __float_as_uint(dec[j]);
                scan[row * 256 + c] = o;
            }
            asm volatile("" ::: "memory");
        }
    }
    __syncthreads();
}

constexpr int S_AL = 0, S_BE = 8192, S_KA = 16384, S_RH = 24576, S_BET = 32768, S_KAT = 40960, S_VT = 49152, S_L2F = 57344  , S_GT = 73728  ;
constexpr int S_L1F = S_BE;
constexpr int S_M1 = S_BE, S_M2 = S_KA;
constexpr int S_APT = S_L2F, S_W2T = S_L2F + 8192;
constexpr int S_RP = S_AL, S_GTR = S_RH;
DEVINL int crow32(int reg, int h) { return (reg & 3) + 8 * (reg >> 2) + 4 * h; }
DEVINL bf16x8 frag64(const char* lds, int slot, int row, int kel) { return *reinterpret_cast<const bf16x8*>(lds + slot + row * 128 + kel * 2); }
DEVINL float dpp_xor1(float x) { return __builtin_bit_cast(float, __builtin_amdgcn_update_dpp(0, __builtin_bit_cast(int, x), 0xB1, 0xf, 0xf, true)); }

DEVINL f32x16 mm64(const char* lds, int slotA, int slotB, int tm, int tn, int r, int hh, f32x16 acc) {
#pragma unroll
    for (int ks = 0; ks < 4; ++ks) acc = MFMA32(frag64(lds, slotA, tm * 32 + r, ks * 16 + 8 * hh), frag64(lds, slotB, tn * 32 + r, ks * 16 + 8 * hh), acc);
    return acc;
}

DEVINL void b1e_unit(KP p, char* lds, int b, int h, int c) {
    const int tid = TIDX(), wv = tid >> 6, lane = tid & 63, r = lane & 31, hh = lane >> 5;
    const uint4* scan = (const uint4*)(p->ws + A_SCAN) + ((size_t)(b * SEQ + c * 64)) * 256 + h * 64;
    float* gtot = (float*)(lds + S_GT); float* gamC = gtot + 256;
    {
        const int j = lane;
        float lw[16]; unsigned px[16], py[16], pz[16];
#pragma unroll
        for (int u = 0; u < 16; ++u) { const uint4 q = scan[(size_t)(wv * 16 + u) * 256 + j]; px[u] = q.x; py[u] = q.y; pz[u] = q.z; lw[u] = __uint_as_float(q.w); }
        float tot = 0.f;
#pragma unroll
        for (int u = 0; u < 16; ++u) tot += lw[u];
        gtot[wv * 64 + j] = tot;
        __syncthreads();
        float off = 0.f, all = 0.f;
#pragma unroll
        for (int g = 0; g < 4; ++g) { const float v = gtot[g * 64 + j]; all += v; off += (g < wv) ? v : 0.f; }
        if (wv == 0) gamC[j] = __expf(all);
        float cum = off;
        unsigned tb[8], tk[8], tv[8];
#pragma unroll
        for (int u = 0; u < 16; ++u) {
            const float kkn = __uint_as_float(px[u] << 16), bb = __uint_as_float(px[u] & 0xFFFF0000u);
            const float kf = __uint_as_float(py[u] << 16), rr = __uint_as_float(py[u] & 0xFFFF0000u);
            const float gp = __expf(cum); cum += lw[u];
            const float g = __expf(cum), en = __expf(-cum);
            const int t = wv * 16 + u;
            const unsigned be = f2bf(bb * en), ka = f2bf(kf * en);
            *(bf16_t*)(lds + S_AL + t * 128 + j * 2) = f2bf(gp * kkn);
            *(bf16_t*)(lds + S_BE + t * 128 + j * 2) = (bf16_t)be;
            *(bf16_t*)(lds + S_KA + t * 128 + j * 2) = (bf16_t)ka;
            *(bf16_t*)(lds + S_RH + t * 128 + j * 2) = f2bf(g * rr);
            if (u & 1) { tb[u >> 1] |= be << 16; tk[u >> 1] |= ka << 16; tv[u >> 1] |= (pz[u] << 16); }
            else { tb[u >> 1] = be; tk[u >> 1] = ka; tv[u >> 1] = pz[u] & 0xFFFFu; }
        }
        *(uint4*)(lds + S_BET + j * 128 + wv * 32) = make_uint4(tb[0], tb[1], tb[2], tb[3]); *(uint4*)(lds + S_BET + j * 128 + wv * 32 + 16) = make_uint4(tb[4], tb[5], tb[6], tb[7]);
        *(uint4*)(lds + S_KAT + j * 128 + wv * 32) = make_uint4(tk[0], tk[1], tk[2], tk[3]); *(uint4*)(lds + S_KAT + j * 128 + wv * 32 + 16) = make_uint4(tk[4], tk[5], tk[6], tk[7]);
        *(uint4*)(lds + S_VT + j * 128 + wv * 32) = make_uint4(tv[0], tv[1], tv[2], tv[3]); *(uint4*)(lds + S_VT + j * 128 + wv * 32 + 16) = make_uint4(tv[4], tv[5], tv[6], tv[7]);
    }
    __syncthreads();
    const int tm = wv >> 1, tn = wv & 1;
    f32x16 aM1, aM2;
    {
        f32x16 aL1, aL2;
#pragma unroll
        for (int i = 0; i < 16; ++i) { aL1[i] = 0.f; aL2[i] = 0.f; aM1[i] = 0.f; aM2[i] = 0.f; }
#pragma unroll
        for (int ks = 0; ks < 4; ++ks) {
            const bf16x8 fa = frag64(lds, S_AL, tm * 32 + r, ks * 16 + 8 * hh), fr = frag64(lds, S_RH, tm * 32 + r, ks * 16 + 8 * hh);
            const bf16x8 fb = frag64(lds, S_BE, tn * 32 + r, ks * 16 + 8 * hh), fk = frag64(lds, S_KA, tn * 32 + r, ks * 16 + 8 * hh);
            aL1 = MFMA32(fa, fb, aL1); aL2 = MFMA32(fa, fk, aL2); aM1 = MFMA32(fr, fb, aM1); aM2 = MFMA32(fr, fk, aM2);
        }
        __syncthreads();
#pragma unroll
        for (int reg = 0; reg < 16; ++reg) {
            const int t = tm * 32 + crow32(reg, hh), sidx = tn * 32 + r;
            const int o = (t * 64 + (sidx & 1) * 32 + (sidx >> 1)) * 4;
            *(float*)(lds + S_L1F + o) = (sidx < t) ? aL1[reg] : 0.f;
            *(float*)(lds + S_L2F + o) = (sidx < t) ? aL2[reg] : 0.f;
            aM1[reg] = (sidx <= t) ? aM1[reg] : 0.f; aM2[reg] = (sidx <= t) ? aM2[reg] : 0.f;
        }
    }
    __syncthreads();
    unsigned outp[32];
    {
        const int col = (wv & 1) * 32 + (lane >> 1), q = lane & 1;
        float xq[32];
#pragma unroll
        for (int k = 0; k < 32; ++k) xq[k] = 0.f;
        const char* l1row = lds + S_L1F + q * 128;
        const char* l2row = lds + S_L2F + q * 128;
        if (wv < 2) {
#pragma unroll
            for (int t = 0; t < 64; ++t) {
                float acc = 0.f;
#pragma unroll
                for (int k4 = 0; k4 * 4 < (t + 1) / 2; ++k4) {
                    const float4 a = *(const float4*)(l1row + t * 256 + k4 * 16);
                    acc = fmaf(a.x, xq[4 * k4 + 0], acc); acc = fmaf(a.y, xq[4 * k4 + 1], acc); acc = fmaf(a.z, xq[4 * k4 + 2], acc); acc = fmaf(a.w, xq[4 * k4 + 3], acc);
                }
                acc += dpp_xor1(acc);
                const float x = bf2f(*(const bf16_t*)(lds + S_AL + t * 128 + col * 2)) - acc;
                xq[t >> 1] = ((t & 1) == q) ? x : xq[t >> 1];
            }
        } else {
            float vq[32];
#pragma unroll
            for (int k8 = 0; k8 < 8; ++k8) {
                const uint4 d = *(const uint4*)(lds + S_VT + col * 128 + k8 * 16);
                vq[4 * k8 + 0] = q ? __uint_as_float(d.x & 0xFFFF0000u) : __uint_as_float(d.x << 16);
                vq[4 * k8 + 1] = q ? __uint_as_float(d.y & 0xFFFF0000u) : __uint_as_float(d.y << 16);
                vq[4 * k8 + 2] = q ? __uint_as_float(d.z & 0xFFFF0000u) : __uint_as_float(d.z << 16);
                vq[4 * k8 + 3] = q ? __uint_as_float(d.w & 0xFFFF0000u) : __uint_as_float(d.w << 16);
            }
#pragma unroll
            for (int t = 0; t < 64; ++t) {
                float acc = 0.f;
#pragma unroll
                for (int k4 = 0; k4 * 4 < (t + 1) / 2; ++k4) {
                    const float4 a = *(const float4*)(l1row + t * 256 + k4 * 16);
                    const float4 bq = *(const float4*)(l2row + t * 256 + k4 * 16);
                    acc = fmaf(bq.x, vq[4 * k4 + 0], acc); acc = fmaf(bq.y, vq[4 * k4 + 1], acc); acc = fmaf(bq.z, vq[4 * k4 + 2], acc); acc = fmaf(bq.w, vq[4 * k4 + 3], acc);
                    acc = fmaf(-a.x, xq[4 * k4 + 0], acc); acc = fmaf(-a.y, xq[4 * k4 + 1], acc); acc = fmaf(-a.z, xq[4 * k4 + 2], acc); acc = fmaf(-a.w, xq[4 * k4 + 3], acc);
                }
                acc += dpp_xor1(acc);
                xq[t >> 1] = ((t & 1) == q) ? acc : xq[t >> 1];
            }
        }
#pragma unroll
        for (int k = 0; k < 32; ++k) { const float o = dpp_xor1(xq[k]); outp[k] = q ? pack2(o, xq[k]) : pack2(xq[k], o); }
    }
    __syncthreads();
    {
        const int col = (wv & 1) * 32 + (lane >> 1), q = lane & 1;
        char* dst = lds + ((wv < 2) ? S_APT : S_W2T) + col * 128 + q * 64;
#pragma unroll
        for (int i = 0; i < 4; ++i) *(uint4*)(dst + i * 16) = q ? make_uint4(outp[16 + 4 * i], outp[17 + 4 * i], outp[18 + 4 * i], outp[19 + 4 * i]) : make_uint4(outp[4 * i], outp[4 * i + 1], outp[4 * i + 2], outp[4 * i + 3]);
#pragma unroll
        for (int reg = 0; reg < 16; ++reg) {
            const int t = tm * 32 + crow32(reg, hh), sidx = tn * 32 + r;
            *(bf16_t*)(lds + S_M1 + t * 128 + sidx * 2) = f2bf(aM1[reg]);
            *(bf16_t*)(lds + S_M2 + t * 128 + sidx * 2) = f2bf(aM2[reg]);
        }
    }
    __syncthreads();
    unsigned char* ubase = p->ws + A_CHAIN + (size_t)((b * 4 + h) * 64 + c) * CHAIN_UNIT;
    f32x16 zero;
#pragma unroll
    for (int i = 0; i < 16; ++i) zero[i] = 0.f;
    f32x16 gt;
    {
        const f32x16 qv = mm64(lds, S_M1, S_APT, tm, tn, r, hh, zero);
        const f32x16 y0 = mm64(lds, S_M2, S_VT, tm, tn, r, hh, zero) - mm64(lds, S_M1, S_W2T, tm, tn, r, hh, zero);
        gt = mm64(lds, S_BET, S_APT, tm, tn, r, hh, zero);
        const f32x16 ht = mm64(lds, S_KAT, S_VT, tm, tn, r, hh, zero) - mm64(lds, S_BET, S_W2T, tm, tn, r, hh, zero);
#pragma unroll
        for (int reg = 0; reg < 16; ++reg) {
            const int t = tm * 32 + crow32(reg, hh), jc = tn * 32 + r;
            const float rh = bf2f(*(const bf16_t*)(lds + S_RH + t * 128 + jc * 2));
            *(bf16_t*)(lds + S_RP + t * 128 + jc * 2) = f2bf(rh - qv[reg]);
            const int jr = tm * 32 + crow32(reg, hh);
            const float gc = gamC[jr];
            gt[reg] = gc * (((jr == jc) ? 1.f : 0.f) - gt[reg]);
        }
        float4* himg = (float4*)(ubase + 16384); float4* yimg = (float4*)(ubase + 32768);
#pragma unroll
        for (int rq = 0; rq < 4; ++rq) {
            float4 hv, yv;
            hv.x = gamC[tm * 32 + crow32(4 * rq + 0, hh)] * ht[4 * rq + 0]; hv.y = gamC[tm * 32 + crow32(4 * rq + 1, hh)] * ht[4 * rq + 1];
            hv.z = gamC[tm * 32 + crow32(4 * rq + 2, hh)] * ht[4 * rq + 2]; hv.w = gamC[tm * 32 + crow32(4 * rq + 3, hh)] * ht[4 * rq + 3];
            yv.x = y0[4 * rq + 0]; yv.y = y0[4 * rq + 1]; yv.z = y0[4 * rq + 2]; yv.w = y0[4 * rq + 3];
            himg[((tn * 2 + tm) * 4 + rq) * 64 + lane] = hv;
            yimg[((tn * 2 + tm) * 4 + rq) * 64 + lane] = yv;
        }
    }
    __syncthreads();
#pragma unroll
    for (int reg = 0; reg < 16; ++reg) {
        const int jr = tm * 32 + crow32(reg, hh), jc = tn * 32 + r;
        *(bf16_t*)(lds + S_GTR + jr * 128 + jc * 2) = f2bf(gt[reg]);
    }
    __syncthreads();
    {
        uint4* gimg = (uint4*)(ubase); uint4* rimg = (uint4*)(ubase + 8192);
#pragma unroll
        for (int ii = 0; ii < 2; ++ii) {
            const int im = wv * 2 + ii, mt = im >> 2, jb = (im >> 1) & 1, s2 = im & 1;
            const int cbase = (32 * jb + 16 * s2 + 4 * hh) * 2;
            const uint2 g0 = *(const uint2*)(lds + S_GTR + (mt * 32 + r) * 128 + cbase), g1 = *(const uint2*)(lds + S_GTR + (mt * 32 + r) * 128 + cbase + 16);
            const uint2 r0 = *(const uint2*)(lds + S_RP + (mt * 32 + r) * 128 + cbase), r1 = *(const uint2*)(lds + S_RP + (mt * 32 + r) * 128 + cbase + 16);
            gimg[im * 64 + lane] = make_uint4(g0.x, g0.y, g1.x, g1.y);
            rimg[im * 64 + lane] = make_uint4(r0.x, r0.y, r1.x, r1.y);
        }
    }
    __syncthreads();
}

DEVINL void phaseB1(KP p, int l, char* lds, const int mask = 15, const int sub = 3) {
    const int nb = NBV();
    if (mask & 1) {
        const int blk = BIDX();
        for (int it = blk; it < 512; it += nb) {
            if (sub & 1) { b1_rwkv(p, l, lds, it * 2); b1_rwkv(p, l, lds, it * 2 + 1); }
            __threadfence_block(); __syncthreads();
            const int b = it >> 6, c = it & 63;
            if (sub & 2) {
#pragma unroll 1
                for (int h = 0; h < 4; ++h) b1e_unit(p, lds, b, h, c);
            }
        }
    }
    if (mask & 2) { const int blk = BIDX(); for (int it = blk; it < 1024; it += nb) b1_lru(p, l, lds, it); }
    if (mask & 4) { const int blk = BIDX(); for (int it = blk; it < 1024; it += nb) b1_conformer(p, l, lds, it); }
    if (mask & 8) { const int blk = BIDX(); for (int it = blk; it < 512; it += nb) b1_shortconv(p, l, it); }
}

DEVINL void phaseB2(KP p, int l, char* lds) {
    const int tid = TIDX(), blk = BIDX();
    if (blk < 64 && tid < 64) {
        const int lane = tid, r = lane & 31, hh = lane >> 5;
        const int bh = blk >> 1, w = blk & 1, b = bh >> 2, h = bh & 3;
        float* yraw = (float*)(p->ws + A_YRAW) + (size_t)b * SEQ * 256 + h * 64 + 32 * w + r;
        f32x16 X0, X1;
#pragma unroll
        for (int i = 0; i < 16; ++i) { X0[i] = 0.f; X1[i] = 0.f; }
        auto issue = [&](int c, char* buf) {
            const unsigned char* ubase = p->ws + A_CHAIN + (size_t)(bh * 64 + c) * CHAIN_UNIT;
#pragma unroll
            for (int i = 0; i < 8; ++i) {
                __builtin_amdgcn_global_load_lds((const unsigned*)(ubase + i * 1024 + lane * 16), (unsigned*)(buf + i * 1024 + lane * 16), 16, 0, 0);
                __builtin_amdgcn_global_load_lds((const unsigned*)(ubase + 8192 + i * 1024 + lane * 16), (unsigned*)(buf + 8192 + i * 1024 + lane * 16), 16, 0, 0);
                __builtin_amdgcn_global_load_lds((const unsigned*)(ubase + 16384 + (w * 8 + i) * 1024 + lane * 16), (unsigned*)(buf + 16384 + i * 1024 + lane * 16), 16, 0, 0);
                __builtin_amdgcn_global_load_lds((const unsigned*)(ubase + 32768 + (w * 8 + i) * 1024 + lane * 16), (unsigned*)(buf + 24576 + i * 1024 + lane * 16), 16, 0, 0);
            }
        };
        issue(0, lds);
        for (int c = 0; c < 64; ++c) {
            char* buf = lds + (c & 1) * 32768;
            if (c + 1 < 64) { issue(c + 1, lds + ((c + 1) & 1) * 32768); asm volatile("s_waitcnt vmcnt(32)" ::: "memory"); }
            else asm volatile("s_waitcnt vmcnt(0)" ::: "memory");
            uint4 gq[8], rq8[8]; float4 hq[8], yq[8];
#pragma unroll
            for (int i = 0; i < 8; ++i) { gq[i] = *(const uint4*)(buf + i * 1024 + lane * 16); rq8[i] = *(const uint4*)(buf + 8192 + i * 1024 + lane * 16); }
#pragma unroll
            for (int i = 0; i < 8; ++i) { hq[i] = *(const float4*)(buf + 16384 + i * 1024 + lane * 16); yq[i] = *(const float4*)(buf + 24576 + i * 1024 + lane * 16); }
            bf16x8 xp[4];
#pragma unroll
            for (int s2 = 0; s2 < 2; ++s2) {
                uint4 a, bq;
                a.x = pack2(X0[8 * s2 + 0], X0[8 * s2 + 1]); a.y = pack2(X0[8 * s2 + 2], X0[8 * s2 + 3]); a.z = pack2(X0[8 * s2 + 4], X0[8 * s2 + 5]); a.w = pack2(X0[8 * s2 + 6], X0[8 * s2 + 7]);
                bq.x = pack2(X1[8 * s2 + 0], X1[8 * s2 + 1]); bq.y = pack2(X1[8 * s2 + 2], X1[8 * s2 + 3]); bq.z = pack2(X1[8 * s2 + 4], X1[8 * s2 + 5]); bq.w = pack2(X1[8 * s2 + 6], X1[8 * s2 + 7]);
                xp[s2] = __builtin_bit_cast(bf16x8, a); xp[2 + s2] = __builtin_bit_cast(bf16x8, bq);
            }
#pragma unroll
            for (int mt = 0; mt < 2; ++mt) {
                f32x16 acc;
#pragma unroll
                for (int i = 0; i < 4; ++i) { acc[4 * i] = yq[mt * 4 + i].x; acc[4 * i + 1] = yq[mt * 4 + i].y; acc[4 * i + 2] = yq[mt * 4 + i].z; acc[4 * i + 3] = yq[mt * 4 + i].w; }
#pragma unroll
                for (int f = 0; f < 4; ++f) acc = MFMA32(__builtin_bit_cast(bf16x8, rq8[mt * 4 + f]), xp[f], acc);
#pragma unroll
                for (int reg = 0; reg < 16; ++reg) yraw[(size_t)(c * 64 + mt * 32 + crow32(reg, hh)) * 256] = acc[reg];
            }
            f32x16 n0, n1;
#pragma unroll
            for (int i = 0; i < 4; ++i) { n0[4 * i] = hq[i].x; n0[4 * i + 1] = hq[i].y; n0[4 * i + 2] = hq[i].z; n0[4 * i + 3] = hq[i].w;
                                          n1[4 * i] = hq[4 + i].x; n1[4 * i + 1] = hq[4 + i].y; n1[4 * i + 2] = hq[4 + i].z; n1[4 * i + 3] = hq[4 + i].w; }
#pragma unroll
            for (int f = 0; f < 4; ++f) { n0 = MFMA32(__builtin_bit_cast(bf16x8, gq[f]), xp[f], n0); n1 = MFMA32(__builtin_bit_cast(bf16x8, gq[4 + f]), xp[f], n1); }
            X0 = n0; X1 = n1;
        }
    }
}

DEVINL void phaseMix(KP p, int l, char* lds, const int which) {
    const int blk = BIDX(), wg = blk >> 1, half = blk & 1;
    if (wg < 32) { if (which == 0) phaseB2(p, l, lds); return; }
    const int w = wg - 32, NW = 224;
    if (which == 0) { for (int pr = w; pr < 512; pr += NW) b1_lru(p, l, lds, pr * 2 + half); }
    else if (which == 1) { for (int pr = (w + 160) % NW; pr < 512; pr += NW) b1_conformer(p, l, lds, pr * 2 + half); }
    else { for (int pr = (w + 96) % NW; pr < 256; pr += NW) b1_shortconv(p, l, pr * 2 + half); }
}

DEVINL void phaseB3(KP p, int l) {
    const int c = TIDX(), nb = NBV(), blk = BIDX();
    const bf16_t* P = (const bf16_t*)(p->ws + A_P);
    bf16_t* ymix = (bf16_t*)(p->ws + A_YMIX);
    const float* yraw = (const float*)(p->ws + A_YRAW); const bf16_t* bonus = (const bf16_t*)(p->ws + A_BONUS); const bf16_t* gbuf = (const bf16_t*)(p->ws + A_G);
    const unsigned* hcbuf = (const unsigned*)(p->ws + A_HLOC);
    const float gng = p->in[I_GNG][l * 256 + c], gnb = p->in[I_GNB][l * 256 + c];
    for (int it = blk; it < 512; it += nb) {
        float hst0, hst1;
        {
            const int bq = (it * 64) >> 12, tt0 = ((it * 64) & 4095) >> 5;
            const float* ca = (const float*)(p->ws + A_CARRYA) + (size_t)bq * 128 * 256 + c;
            const float* ch = (const float*)(p->ws + A_CARRYH) + (size_t)bq * 128 * 256 + c;
            float hs = 0.f;
#pragma unroll 16
            for (int tq = 0; tq < tt0; ++tq) hs = fmaf(ca[tq * 256], hs, ch[tq * 256]);
            hst0 = hs; hst1 = fmaf(ca[tt0 * 256], hs, ch[tt0 * 256]);
        }
#pragma unroll 1
        for (int r8 = 0; r8 < 64; r8 += 8) {
            float yv[8]; bf16_t bo[8], gg[8], gbv[8]; unsigned hcv[8]; float hsv[8];
#pragma unroll
            for (int u = 0; u < 8; ++u) {
                const int row = it * 64 + r8 + u, b = row >> 12, tt = (row & 4095) >> 5;
                const size_t o = (size_t)row * 256 + c;
                yv[u] = yraw[o]; bo[u] = bonus[o]; gg[u] = gbuf[o]; hcv[u] = hcbuf[o]; hsv[u] = (r8 < 32) ? hst0 : hst1; (void)b; (void)tt;
                gbv[u] = P[(size_t)row * PIN + 768 + c];
            }
#pragma unroll
            for (int u = 0; u < 8; ++u) {
                const int row = it * 64 + r8 + u;
                const float y = yv[u];
                const float mu = wave_sum(y) * (1.f / 64.f);
                const float d = y - mu;
                const float var = wave_sum(d * d) * (1.f / 64.f);
                const float yn = d * rsqrtf(var + GN_EPS) * gng + gnb;
                ymix[(size_t)row * DM + 512 + c] = f2bf((yn + bf2f(bo[u])) * bf2f(gg[u]));
                const float hh = fmaf(__uint_as_float(hcv[u] & 0xFFFF0000u), hsv[u], __uint_as_float(hcv[u] << 16));
                ymix[(size_t)row * DM + 256 + c] = f2bf(hh * gelu_tanh(bf2f(gbv[u])));
            }
        }
    }
}

DEVINL void phaseD(KP p, int l, char* lds, const int dry = 0) {
    const int tid = TIDX(), nb = NBV(), blk = BIDX(), wid = tid >> 6, lane = tid & 63;
    constexpr int URS = 2064;
    char* uh = lds;
    char* ulo = lds + 16 * URS;
    float* logit = (float*)(lds + 32 * URS);
    int* sel_e = (int*)(lds + 32 * URS + 4096);
    int* lpos = sel_e + 512;
    int* hist = lpos + 512;
    int* basep = hist + 64;
    const bf16_t* wrt_hi = (const bf16_t*)(p->ws + OFF_WR) + (size_t)(l * 2 + 0) * 64 * 1024;
    const bf16_t* wrt_lo = (const bf16_t*)(p->ws + OFF_WR) + (size_t)(l * 2 + 1) * 64 * 1024;
    const bf16_t* zbuf = (const bf16_t*)(p->ws + M_ZB);
    float2* lnstat = (float2*)(p->ws + M_STAT);
    bf16_t* ubuf = (bf16_t*)(p->ws + (dry ? A_YMIX : OFF_UBUF));
    const float* mod = (const float*)(p->ws + OFF_MOD);
    const float* wr = p->in[I_WROUTER] + (size_t)l * 1024 * 64 + lane;
    const float ebias = p->in[I_EBIAS][l * 64 + lane];
    unsigned* cnt = (unsigned*)(p->ws + OFF_CNT) + l * 64 + (dry ? 256 : 0);
    int* list = (int*)(p->ws + (dry ? M_HBUF : M_LIST));
    float* wsel = (float*)(p->ws + (dry ? M_HBUF + 16777216 : M_WSEL));
    int* pmap = (int*)(p->ws + (dry ? M_HBUF + 33554432 : M_PMAP));
    for (int it = blk; it < 512; it += nb) {
        const int tok0 = it * 64;
        if (tid < 64) hist[tid] = 0;
        for (int sb = 0; sb < 4; ++sb) {
#pragma unroll
            for (int j = 0; j < 4; ++j) {
                const int tl = wid * 4 + j, row = tok0 + sb * 16 + tl, b = row >> 12;
                float4 z[4];
                float s = 0.f;
#pragma unroll
                for (int i = 0; i < 4; ++i) { const uint2 zv = *(const uint2*)(zbuf + (size_t)row * DM + i * 256 + lane * 4);
                    z[i].x = __uint_as_float(zv.x << 16); z[i].y = __uint_as_float(zv.x & 0xFFFF0000u); z[i].z = __uint_as_float(zv.y << 16); z[i].w = __uint_as_float(zv.y & 0xFFFF0000u); s += z[i].x + z[i].y + z[i].z + z[i].w; }
                const float mean = wave_sum(s) * (1.f / 1024.f);
                float q = 0.f;
#pragma unroll
                for (int i = 0; i < 4; ++i) { z[i].x -= mean; z[i].y -= mean; z[i].z -= mean; z[i].w -= mean; q += z[i].x * z[i].x + z[i].y * z[i].y + z[i].z * z[i].z + z[i].w * z[i].w; }
                const float rs = rsqrtf(wave_sum(q) * (1.f / 1024.f) + LN_EPS);
                if (lane == 0) lnstat[row] = make_float2(mean, rs);
#pragma unroll
                for (int i = 0; i < 4; ++i) {
                    const int col = i * 256 + lane * 4;
                    const float4 g = *(const float4*)(p->in[I_LN1G] + l * 1024 + col), bb = *(const float4*)(p->in[I_LN1B] + l * 1024 + col);
                    const float4 sh = *(const float4*)(mod + (size_t)(l * 8 + b) * 6144 + 3072 + col), sc = *(const float4*)(mod + (size_t)(l * 8 + b) * 6144 + 4096 + col);
                    float4 x1; x1.x = z[i].x * rs * g.x + bb.x; x1.y = z[i].y * rs * g.y + bb.y; x1.z = z[i].z * rs * g.z + bb.z; x1.w = z[i].w * rs * g.w + bb.w;
                    float4 u; u.x = x1.x * (1.f + sc.x) + sh.x; u.y = x1.y * (1.f + sc.y) + sh.y; u.z = x1.z * (1.f + sc.z) + sh.z; u.w = x1.w * (1.f + sc.w) + sh.w;
                    uint2 o; o.x = pack2(u.x, u.y); o.y = pack2(u.z, u.w);
                    *(uint2*)(ubuf + (size_t)row * DM + col) = o;
                    *(uint2*)(uh + tl * URS + col * 2) = o;
                    uint2 o2; o2.x = pack2(u.x - __uint_as_float(o.x << 16), u.y - __uint_as_float(o.x & 0xFFFF0000u)); o2.y = pack2(u.z - __uint_as_float(o.y << 16), u.w - __uint_as_float(o.y & 0xFFFF0000u));
                    *(uint2*)(ulo + tl * URS + col * 2) = o2;
                }
            }
            __syncthreads();
            {
                const int fr = lane & 15, fq = lane >> 4;
                f32x4 lacc = (f32x4){0.f, 0.f, 0.f, 0.f};
                const bf16_t* bh = wrt_hi + (size_t)(wid * 16 + fr) * 1024 + fq * 8;
                const bf16_t* bl = wrt_lo + (size_t)(wid * 16 + fr) * 1024 + fq * 8;
#pragma unroll 1
                for (int k8 = 0; k8 < 4; ++k8) {
                    bf16x8 bhv[8], blv[8];
#pragma unroll
                    for (int kk = 0; kk < 8; ++kk) { bhv[kk] = *(const bf16x8*)(bh + (k8 * 8 + kk) * 32); blv[kk] = *(const bf16x8*)(bl + (k8 * 8 + kk) * 32); }
#pragma unroll
                    for (int kk = 0; kk < 8; ++kk) {
                        const int ko = (k8 * 8 + kk) * 64 + fq * 16;
                        const bf16x8 ah = *(const bf16x8*)(uh + fr * URS + ko), al = *(const bf16x8*)(ulo + fr * URS + ko);
                        lacc = __builtin_amdgcn_mfma_f32_16x16x32_bf16(ah, bhv[kk], lacc, 0, 0, 0);
                        lacc = __builtin_amdgcn_mfma_f32_16x16x32_bf16(al, bhv[kk], lacc, 0, 0, 0);
                        lacc = __builtin_amdgcn_mfma_f32_16x16x32_bf16(ah, blv[kk], lacc, 0, 0, 0);
                    }
                }
#pragma unroll
                for (int j = 0; j < 4; ++j) logit[(fq * 4 + j) * 64 + wid * 16 + fr] = lacc[j];
            }
            __syncthreads();
            float acc[4];
#pragma unroll
            for (int j = 0; j < 4; ++j) acc[j] = logit[(wid * 4 + j) * 64 + lane];
#pragma unroll
            for (int j = 0; j < 4; ++j) {
                const int tl = sb * 16 + wid * 4 + j;
                const float score = 1.f / (1.f + __expf(-acc[j]));
                const float biased = score + ebias;
                const float m1 = group8_max(biased);
                const unsigned long long eq = __ballot(biased == m1);
                const int g = lane >> 3;
                const unsigned gm = (unsigned)(eq >> (g * 8)) & 0xFFu;
                const int first = __ffs((int)gm) - 1;
                const float v2 = ((lane & 7) == first) ? -INFINITY : biased;
                const float m2 = group8_max(v2);
                const float gs = m1 + m2;
                int rg = 0;
#pragma unroll
                for (int g2 = 0; g2 < 8; ++g2) { const float o = __builtin_bit_cast(float, __builtin_amdgcn_readlane(__builtin_bit_cast(int, gs), g2 * 8)); rg += ((o > gs) || (o == gs && g2 < g)) ? 1 : 0; }
                const bool keep = rg < 4;
                const float mk = keep ? biased : -INFINITY;
                int rk = 0;
#pragma unroll
                for (int e2 = 0; e2 < 64; ++e2) { const float o = __builtin_bit_cast(float, __builtin_amdgcn_readlane(__builtin_bit_cast(int, mk), e2)); rk += ((o > mk) || (o == mk && e2 < lane)) ? 1 : 0; }
                const bool sel = keep && (rk < 8);
                const float ssum = wave_sum(sel ? score : 0.f);
                const float wgt = score / ssum * 2.5f;
                const unsigned long long sm = __ballot(sel);
                const int kidx = __popcll(sm & ((1ull << lane) - 1ull));
                if (sel) { wsel[(size_t)(tok0 + tl) * 8 + kidx] = wgt; sel_e[tl * 8 + kidx] = lane; }
            }
            __syncthreads();
        }
        for (int i = tid; i < 512; i += VTHREADS) lpos[i] = atomicAdd(&hist[sel_e[i]], 1);
        __syncthreads();
        if (tid < 64) basep[tid] = (int)atomicAdd(&cnt[tid], (unsigned)hist[tid]);
        __syncthreads();
        for (int i = tid; i < 512; i += VTHREADS) { const int e = sel_e[i], pos = basep[e] + lpos[i]; list[(size_t)e * NTOK + pos] = tok0 * 8 + i; pmap[tok0 * 8 + i] = (e << 16) | pos; }
        __syncthreads();
    }
}

DEVINL void phaseA(KP p, int l, char* lds) {
    const int tid = TID512(), c = blockIdx.x, G = gridDim.x;
    const char* ubuf = (const char*)(p->ws + OFF_UBUF);
    const char* Wt = (const char*)(p->ws + OFF_WIN) + (size_t)l * WIN_ROWS * 1024 * 2;
    bf16_t* P = (bf16_t*)(p->ws + A_P);
    auto sched = [&](int i, GUnit& u) -> bool {
        const long L = unit_linear(i, c, G); if (L >= 128 * 11) return false;
        const int Li = (int)L, sx = Li >> 9, w = (sx == 2) ? 3 : 4, rem = Li - (sx << 9), pm = rem / w, pn = sx * 4 + (rem - pm * w);
        u.A = ubuf + (size_t)pm * 256 * 2048; u.B = Wt + (size_t)pn * 256 * 2048; u.i0 = pm; u.i1 = pn; u.i2 = 0;
        return true;
    };
    auto epi = [&](f32x4 (&acc)[2][2][4][2], const GUnit& u, int wr, int wc, int fr, int fq) {
        asm volatile("" : "+v"(fr), "+v"(fq));
        const int row0 = u.i0 * 256 + wr * 64 + fr, col0 = u.i1 * 256 + wc * 32 + 8 * fq;
#pragma unroll
        for (int ai = 0; ai < 2; ++ai)
#pragma unroll
            for (int m = 0; m < 4; ++m) {
                bf16_t* rowp = P + (size_t)(row0 + ai * 128 + m * 16) * PIN + col0;
#pragma unroll
                for (int bj = 0; bj < 2; ++bj) {
                    if (col0 + bj * 128 < PIN) {
                        const f32x4 v0 = acc[ai][bj][m][0], v1 = acc[ai][bj][m][1];
                        *(uint4*)(rowp + bj * 128) = make_uint4(pack2(v0[0], v0[1]), pack2(v0[2], v0[3]), pack2(v1[0], v1[1]), pack2(v1[2], v1[3]));
                    }
                }
            }
    };
    gemm256<true, false>(lds, 1024, 1024, sched, epi);
}

DEVINL void phaseC(KP p, int l, char* lds) {
    const int tid = TID512(), c = blockIdx.x, G = gridDim.x;
    const char* ymix = (const char*)(p->ws + A_YMIX);
    const char* Wt = (const char*)(p->ws + OFF_WOUT) + (size_t)l * 1024 * 1024 * 2;
    const float* res32 = p->in[I_X];
    const bf16_t* res16 = (const bf16_t*)p->out;
    bf16_t* zbuf = (bf16_t*)(p->ws + M_ZB);
    const float* mod = (const float*)(p->ws + OFF_MOD);
    auto sched = [&](int i, GUnit& u) -> bool {
        const long L = unit_linear(i, c, G); if (L >= 128 * 4) return false;
        const int pm = (int)L >> 2, pn = (int)L & 3;
        u.A = ymix + (size_t)pm * 256 * 2048; u.B = Wt + (size_t)pn * 256 * 2048; u.i0 = pm; u.i1 = pn; u.i2 = 0;
        return true;
    };
    auto epi = [&](f32x4 (&acc)[2][2][4][2], const GUnit& u, int wr, int wc, int fr, int fq) {
        asm volatile("" : "+v"(fr), "+v"(fq));
        const int row0 = u.i0 * 256 + wr * 64 + fr, col0 = u.i1 * 256 + wc * 32 + 8 * fq;
#pragma unroll
        for (int ai = 0; ai < 2; ++ai)
#pragma unroll
            for (int m = 0; m < 4; ++m) {
                const int row = row0 + ai * 128 + m * 16, b = row >> 12;
#pragma unroll
                for (int bj = 0; bj < 2; ++bj) {
                    const int col = col0 + bj * 128;
                    const float4 ga = *(const float4*)(mod + (size_t)(l * 8 + b) * 6144 + 2048 + col), gb = *(const float4*)(mod + (size_t)(l * 8 + b) * 6144 + 2048 + col + 4);
                    float r[8];
                    if (l == 0) {
                        const float4 ra = *(const float4*)(res32 + (size_t)row * DM + col), rb = *(const float4*)(res32 + (size_t)row * DM + col + 4);
                        r[0] = ra.x; r[1] = ra.y; r[2] = ra.z; r[3] = ra.w; r[4] = rb.x; r[5] = rb.y; r[6] = rb.z; r[7] = rb.w;
                    } else {
                        const uint4 rv = *(const uint4*)(res16 + (size_t)row * DM + col);
                        r[0] = __uint_as_float(rv.x << 16); r[1] = __uint_as_float(rv.x & 0xFFFF0000u); r[2] = __uint_as_float(rv.y << 16); r[3] = __uint_as_float(rv.y & 0xFFFF0000u);
                        r[4] = __uint_as_float(rv.z << 16); r[5] = __uint_as_float(rv.z & 0xFFFF0000u); r[6] = __uint_as_float(rv.w << 16); r[7] = __uint_as_float(rv.w & 0xFFFF0000u);
                    }
                    const f32x4 a0 = acc[ai][bj][m][0], a1 = acc[ai][bj][m][1];
                    const float z0 = ALPHA * r[0] + (1.f + ga.x) * a0[0], z1 = ALPHA * r[1] + (1.f + ga.y) * a0[1], z2 = ALPHA * r[2] + (1.f + ga.z) * a0[2], z3 = ALPHA * r[3] + (1.f + ga.w) * a0[3];
                    const float z4 = ALPHA * r[4] + (1.f + gb.x) * a1[0], z5 = ALPHA * r[5] + (1.f + gb.y) * a1[1], z6 = ALPHA * r[6] + (1.f + gb.z) * a1[2], z7 = ALPHA * r[7] + (1.f + gb.w) * a1[3];
                    *(uint4*)(zbuf + (size_t)row * DM + col) = make_uint4(pack2(z0, z1), pack2(z2, z3), pack2(z4, z5), pack2(z6, z7));
                }
            }
    };
    gemm256<true, false>(lds, 1024, 1024, sched, epi);
}

constexpr int DIR_OFF = 131072;
DEVINL void moe_directory(KP p, int l, char* lds) {
    int* pref = (int*)(lds + DIR_OFF);
    int* cntl = (int*)(lds + DIR_OFF + 512);
    unsigned* cnt = (unsigned*)(p->ws + OFF_CNT) + l * 64;
    asm volatile("" : "+s"(cnt));
    if (threadIdx.x == 0) {
        int s = 0;
        int* xpre = (int*)(lds + DIR_OFF + 1024);
        int x = 0;
        for (int e = 0; e < 64; ++e) { const int c = (int)__hip_atomic_load(&cnt[e], __ATOMIC_RELAXED, __HIP_MEMORY_SCOPE_AGENT); cntl[e] = c; pref[e] = s; s += (c + 255) >> 8; xpre[e] = x; x += c; }
        pref[64] = s; cntl[64] = NTOK; pref[65] = s + 128; xpre[64] = x;
    }
    __syncthreads();
    {
        int* m2e = (int*)(lds + DIR_OFF + 2048);
        const int tot = pref[65];
        for (int mg = threadIdx.x; mg < tot; mg += NTHREADS) { int e = 0; while (pref[e + 1] <= mg) ++e; m2e[mg] = e; }
    }
    __syncthreads();
}

DEVINL void phaseE1(KP p, int l, char* lds) {
    const int tid = TID512(), c = blockIdx.x, G = gridDim.x;
    moe_directory(p, l, lds);
    const int* pref = (const int*)(lds + DIR_OFF); const int* cntl = (const int*)(lds + DIR_OFF + 512);
    const char* ubuf = (const char*)(p->ws + OFF_UBUF);
    const int* list = (const int*)(p->ws + M_LIST);
    bf16_t* hbuf = (bf16_t*)(p->ws + M_HBUF);
    const char* W13 = (const char*)(p->ws + OFF_W13) + (size_t)(l * 65) * 512 * 1024 * 2;
    const int total = __builtin_amdgcn_readfirstlane(pref[65]) * 2;
    auto sched = [&](int i, GUnit& u) -> bool {
        const long L = unit_linear(i, c, G); if (L >= total) return false;
        const int mg = (int)L >> 1, nt = (int)L & 1;
        const int e = __builtin_amdgcn_readfirstlane(((const int*)(lds + DIR_OFF + 2048))[mg]);
        const int mt = __builtin_amdgcn_readfirstlane(mg - pref[e]), Me = __builtin_amdgcn_readfirstlane(cntl[e]);
        u.A = ubuf; u.B = W13 + ((size_t)e * 512 + nt * 256) * 2048; u.i0 = mg; u.i1 = nt; u.i2 = e;
        int R[2], C[2]; stage_coords512(TID512(), R, C);
#pragma unroll
        for (int h = 0; h < 2; ++h)
#pragma unroll
            for (int i2 = 0; i2 < 2; ++i2) {
                const int idx = mt * 256 + h * 128 + R[i2]; int tok;
                if (e < 64) tok = (idx < Me) ? (list[(size_t)e * NTOK + idx] >> 3) : 0; else tok = idx;
                u.va[h][i2] = (unsigned)(tok * 1024 + C[i2]) * 2u;
            }
        return true;
    };
    auto epi = [&](f32x4 (&acc)[2][2][4][2], const GUnit& u, int wr, int wc, int fr, int fq) {
        asm volatile("" : "+v"(fr), "+v"(fq));
        const size_t row0 = (size_t)u.i0 * 256 + wr * 64 + fr;
#pragma unroll
        for (int ai = 0; ai < 2; ++ai)
#pragma unroll
            for (int m = 0; m < 4; ++m) {
                bf16_t* rowp = hbuf + (row0 + ai * 128 + m * 16) * 256;
#pragma unroll
                for (int bj = 0; bj < 2; ++bj) {
                    const int hcol = (u.i1 * 8 + bj * 4 + wc) * 16 + 4 * fq;
                    const f32x4 gt = acc[ai][bj][m][0], up = acc[ai][bj][m][1];
                    float hv[4];
#pragma unroll
                    for (int j = 0; j < 4; ++j) hv[j] = gt[j] * sigm(gt[j]) * up[j];
                    uint2 o; o.x = pack2(hv[0], hv[1]); o.y = pack2(hv[2], hv[3]);
                    *(uint2*)(rowp + hcol) = o;
                }
                asm volatile("" ::: "memory");
            }
    };
    gemm256<false, true>(lds, 1024, 1024, sched, epi);
}

DEVINL void phaseE2(KP p, int l, char* lds) {
    const int tid = TID512(), c = blockIdx.x, G = gridDim.x;
    moe_directory(p, l, lds);
    const int* pref = (const int*)(lds + DIR_OFF); const int* cntl = (const int*)(lds + DIR_OFF + 512);
    const int* xpre = (const int*)(lds + DIR_OFF + 1024);
    const char* hbuf = (const char*)(p->ws + M_HBUF);
    unsigned char* ybuf = (unsigned char*)(p->ws + M_YBUF);
    const char* W2 = (const char*)(p->ws + OFF_W2) + (size_t)(l * 65) * 1024 * 256 * 2;
    const int total = __builtin_amdgcn_readfirstlane(pref[65]) * 4;
    auto sched = [&](int i, GUnit& u) -> bool {
        const long L = unit_linear(i, c, G); if (L >= total) return false;
        const int mg = (int)L >> 2, nt = (int)L & 3;
        const int e = __builtin_amdgcn_readfirstlane(((const int*)(lds + DIR_OFF + 2048))[mg]);
        u.A = hbuf + (size_t)mg * 256 * 512; u.B = W2 + ((size_t)e * 1024 + nt * 256) * 512; u.i0 = mg; u.i1 = nt; u.i2 = e;
        return true;
    };
    auto epi = [&](f32x4 (&acc)[2][2][4][2], const GUnit& u, int wr, int wc, int fr, int fq) {
        asm volatile("" : "+v"(fr), "+v"(fq));
        const int e = __builtin_amdgcn_readfirstlane(u.i2), mt = __builtin_amdgcn_readfirstlane(u.i0 - pref[e]), Me = __builtin_amdgcn_readfirstlane(cntl[e]);
        const int yrow0 = __builtin_amdgcn_readfirstlane(xpre[e]) + mt * 256;
        const int col0 = u.i1 * 256 + wc * 32 + 8 * fq, loc0 = wr * 64 + fr;
#pragma unroll
        for (int ai = 0; ai < 2; ++ai)
#pragma unroll
            for (int m = 0; m < 4; ++m) {
                const int loc = loc0 + ai * 128 + m * 16;
                if (mt * 256 + loc < Me) {
                    unsigned char* rowp = ybuf + (size_t)(yrow0 + loc) * 1024 + col0;
#pragma unroll
                    for (int bj = 0; bj < 2; ++bj) {
                        const f32x4 v0 = acc[ai][bj][m][0], v1 = acc[ai][bj][m][1];
                        int w0 = __builtin_amdgcn_cvt_pk_fp8_f32(v0[0], v0[1], 0, false); w0 = __builtin_amdgcn_cvt_pk_fp8_f32(v0[2], v0[3], w0, true);
                        int w1 = __builtin_amdgcn_cvt_pk_fp8_f32(v1[0], v1[1], 0, false); w1 = __builtin_amdgcn_cvt_pk_fp8_f32(v1[2], v1[3], w1, true);
                        *(uint2*)(rowp + bj * 128) = make_uint2((unsigned)w0, (unsigned)w1);
                    }
                }
            }
    };
    gemm256<true, false>(lds, 256, 256, sched, epi);
}

DEVINL void phaseF(KP p, int l, const int dry = 0) {
    const int tid = TIDX(), nb = NBV(), blk = BIDX(), wid = tid >> 6, lane = tid & 63;
    const bf16_t* zbuf = (const bf16_t*)(p->ws + M_ZB);
    float* xout = dry ? (float*)(p->ws + M_HBUF) : p->out;
    const unsigned char* ybuf = (const unsigned char*)(p->ws + M_YBUF);
    bf16_t* ubuf = (bf16_t*)(p->ws + OFF_UBUF);
    const float* mod = (const float*)(p->ws + OFF_MOD);
    const int* pmap = (const int*)(p->ws + M_PMAP); const float* wsel = (const float*)(p->ws + M_WSEL);
    const float2* lnstat = (const float2*)(p->ws + M_STAT);
    int xoff;
    {
        const unsigned* cnt = (const unsigned*)(p->ws + OFF_CNT) + l * 64;
        const int c = (int)__hip_atomic_load(&cnt[lane], __ATOMIC_RELAXED, __HIP_MEMORY_SCOPE_AGENT);
        xoff = 0;
#pragma unroll
        for (int j = 0; j < 64; ++j) { const int cj = __builtin_amdgcn_readlane(c, j); xoff += (j < lane) ? cj : 0; }
    }
    int pmn = 0; float wn = 0.f; float2 stn = make_float2(0.f, 0.f);
    {
        const int row = blk * 4 + wid;
        if (row < NTOK) { if (lane < 8) { pmn = pmap[row * 8 + lane]; wn = wsel[row * 8 + lane]; } stn = lnstat[row]; }
    }
    for (int row = blk * 4 + wid; row < NTOK; row += nb * 4) {
        const int b = row >> 12;
        int yr = pmn; const float yw = wn; const float2 st1 = stn;
        {
            const int nrow = row + nb * 4;
            if (nrow < NTOK) { if (lane < 8) { pmn = pmap[nrow * 8 + lane]; wn = wsel[nrow * 8 + lane]; } stn = lnstat[nrow]; }
        }
        { const int e = (yr >> 16) & 63; const int xo = __builtin_amdgcn_ds_bpermute(e << 2, xoff); yr = xo + (yr & 0xFFFF); }
        int yrow[8]; float yww[8];
#pragma unroll
        for (int k = 0; k < 8; ++k) { yrow[k] = __builtin_amdgcn_readlane(yr, k); yww[k] = __builtin_bit_cast(float, __builtin_amdgcn_readlane(__builtin_bit_cast(int, yw), k)); }
        uint2 zvv[4]; int ysh[4]; int yvk[4][8];
#pragma unroll
        for (int i = 0; i < 4; ++i) {
            const int col = i * 256 + lane * 4;
            zvv[i] = *(const uint2*)(zbuf + (size_t)row * DM + col);
            ysh[i] = *(const int*)(ybuf + ((size_t)(262144 + row)) * 1024 + col);
#pragma unroll
            for (int k = 0; k < 8; ++k) yvk[i][k] = *(const int*)(ybuf + (size_t)yrow[k] * 1024 + col);
        }
        float4 z[4]; float s = 0.f;
#pragma unroll
        for (int i = 0; i < 4; ++i) {
            const int col = i * 256 + lane * 4;
            float4 x1;
            { const uint2 zv = zvv[i];
              float4 z1; z1.x = __uint_as_float(zv.x << 16); z1.y = __uint_as_float(zv.x & 0xFFFF0000u); z1.z = __uint_as_float(zv.y << 16); z1.w = __uint_as_float(zv.y & 0xFFFF0000u);
              const float4 g1 = *(const float4*)(p->in[I_LN1G] + l * 1024 + col), b1 = *(const float4*)(p->in[I_LN1B] + l * 1024 + col);
              x1.x = (z1.x - st1.x) * st1.y * g1.x + b1.x; x1.y = (z1.y - st1.x) * st1.y * g1.y + b1.y; x1.z = (z1.z - st1.x) * st1.y * g1.z + b1.z; x1.w = (z1.w - st1.x) * st1.y * g1.w + b1.w; }
            float f0, f1, f2, f3;
            { const int yv = ysh[i];
              const f2_t lo = __builtin_amdgcn_cvt_pk_f32_fp8(yv, false), hi = __builtin_amdgcn_cvt_pk_f32_fp8(yv, true);
              f0 = lo[0]; f1 = lo[1]; f2 = hi[0]; f3 = hi[1]; }
#pragma unroll
            for (int k = 0; k < 8; ++k) {
                const f2_t lo = __builtin_amdgcn_cvt_pk_f32_fp8(yvk[i][k], false), hi = __builtin_amdgcn_cvt_pk_f32_fp8(yvk[i][k], true);
                const float w = yww[k];
                f0 = fmaf(w, lo[0], f0); f1 = fmaf(w, lo[1], f1); f2 = fmaf(w, hi[0], f2); f3 = fmaf(w, hi[1], f3);
            }
            const float4 g2 = *(const float4*)(mod + (size_t)(l * 8 + b) * 6144 + 5120 + col);
            z[i].x = ALPHA * x1.x + (1.f + g2.x) * f0; z[i].y = ALPHA * x1.y + (1.f + g2.y) * f1; z[i].z = ALPHA * x1.z + (1.f + g2.z) * f2; z[i].w = ALPHA * x1.w + (1.f + g2.w) * f3;
            s += z[i].x + z[i].y + z[i].z + z[i].w;
        }
        const float mean = wave_sum(s) * (1.f / 1024.f);
        float q = 0.f;
#pragma unroll
        for (int i = 0; i < 4; ++i) { z[i].x -= mean; z[i].y -= mean; z[i].z -= mean; z[i].w -= mean; q += z[i].x * z[i].x + z[i].y * z[i].y + z[i].z * z[i].z + z[i].w * z[i].w; }
        const float rs = rsqrtf(wave_sum(q) * (1.f / 1024.f) + LN_EPS);
#pragma unroll
        for (int i = 0; i < 4; ++i) {
            const int col = i * 256 + lane * 4;
            const float4 g = *(const float4*)(p->in[I_LN2G] + l * 1024 + col), bb = *(const float4*)(p->in[I_LN2B] + l * 1024 + col);
            float4 x2; x2.x = z[i].x * rs * g.x + bb.x; x2.y = z[i].y * rs * g.y + bb.y; x2.z = z[i].z * rs * g.z + bb.z; x2.w = z[i].w * rs * g.w + bb.w;
            if (l + 1 < DEPTH) { uint2 ox; ox.x = pack2(x2.x, x2.y); ox.y = pack2(x2.z, x2.w); *(uint2*)((bf16_t*)xout + (size_t)row * DM + col) = ox; }
            else *(float4*)(xout + (size_t)row * DM + col) = x2;
            if (l + 1 < DEPTH) {
                const float4 sh = *(const float4*)(mod + (size_t)((l + 1) * 8 + b) * 6144 + col), sc = *(const float4*)(mod + (size_t)((l + 1) * 8 + b) * 6144 + 1024 + col);
                uint2 o; o.x = pack2(x2.x * (1.f + sc.x) + sh.x, x2.y * (1.f + sc.y) + sh.y); o.y = pack2(x2.z * (1.f + sc.z) + sh.z, x2.w * (1.f + sc.w) + sh.w);
                *(uint2*)(ubuf + (size_t)row * DM + col) = o;
            }
        }
    }
}

#define XB_TMO      128
#define XB_XCNT(j)  (256  + 64 * (j))
#define XB_XSUB(j)  (1280 + 64 * (j))
#define XB_XGEN(j)  (2304 + 64 * (j))
#define XB_TOP      3328
#define XB_TOPGEN   3392
#define XCD_BAR_WORDS 3456
#define XB_SPIN_CAP (1u << 20)
DEVINL unsigned xb_ld(unsigned* p)              { return __hip_atomic_load(p, __ATOMIC_RELAXED, __HIP_MEMORY_SCOPE_AGENT); }
DEVINL unsigned xb_add(unsigned* p, unsigned v) { return __hip_atomic_fetch_add(p, v, __ATOMIC_RELAXED, __HIP_MEMORY_SCOPE_AGENT); }
DEVINL unsigned xb_xcc_id() { return (unsigned)__builtin_amdgcn_s_getreg((3 << 11) | 20) & 0xFu; }
#define XB_SPIN(cond, bar) do { unsigned _sp = 0; while (cond) { __builtin_amdgcn_s_sleep(1); \
    if ((++_sp & 255u) == 0u) { if (xb_ld(&(bar)[XB_TMO])) break; if (_sp > XB_SPIN_CAP) { atomicAdd(&(bar)[XB_TMO], 1u); break; } } } } while (0)
struct XcdBarrier { unsigned* bar; unsigned x; volatile LAS unsigned* st; };
DEVINL XcdBarrier xcd_barrier_post(unsigned* bar, volatile LAS unsigned* st) {
    XcdBarrier b; b.bar = bar; b.x = xb_xcc_id(); b.st = st;
    if (threadIdx.x == 0) (void)xb_add(&bar[XB_XCNT(b.x)], 1u);
    return b;
}
DEVINL void xcd_barrier_complete(unsigned* bar, unsigned x, unsigned& nloc, unsigned& nx) {
    const unsigned G = gridDim.x * gridDim.y * gridDim.z;
    unsigned sum, cnt, mine, sp = 0u;
    for (;;) {
        sum = 0u; cnt = 0u; mine = 0u;
#pragma unroll 1
        for (unsigned j = 0; j < 16; ++j) { const unsigned c = xb_ld(&bar[XB_XCNT(j)]); sum += c; cnt += (c > 0u) ? 1u : 0u; mine = (j == x) ? c : mine; }
        if (sum == G) break;
        __builtin_amdgcn_s_sleep(1);
        if ((++sp & 255u) == 0u) { if (xb_ld(&bar[XB_TMO])) break; if (sp > XB_SPIN_CAP) { atomicAdd(&bar[XB_TMO], 1u); break; } }
    }
    nloc = mine > 0u ? mine : 1u; nx = cnt > 0u ? cnt : 1u;
}
DEVINL void xcd_barrier(const XcdBarrier& b) {
    asm volatile("s_waitcnt vmcnt(0)" ::: "memory");
    __syncthreads();
    if (threadIdx.x == 0) {
        unsigned* bar = b.bar;
        __builtin_amdgcn_s_waitcnt(0);
        unsigned nloc = b.st[0], nx = b.st[1];
        if (nloc == 0u) { xcd_barrier_complete(bar, b.x, nloc, nx); b.st[0] = nloc; b.st[1] = nx; }
        const unsigned old = xb_add(&bar[XB_XSUB(b.x)], 1u);
        const unsigned gen = old / nloc;
        if (old + 1u == (gen + 1u) * nloc) {
            __builtin_amdgcn_fence(__ATOMIC_RELEASE, "agent");
            asm volatile("s_waitcnt vmcnt(0)" ::: "memory");
            const unsigned og = xb_add(&bar[XB_TOP], 1u);
            const unsigned tg = og / nx;
            if (og + 1u == (tg + 1u) * nx) xb_add(&bar[XB_TOPGEN], 1u);
            else XB_SPIN(xb_ld(&bar[XB_TOPGEN]) == tg, bar);
            __builtin_amdgcn_fence(__ATOMIC_ACQUIRE, "agent");
            xb_add(&bar[XB_XGEN(b.x)], 1u);
            asm volatile("s_waitcnt vmcnt(0)" ::: "memory");
        } else {
            XB_SPIN(xb_ld(&bar[XB_XGEN(b.x)]) == gen, bar);
            __builtin_amdgcn_fence(__ATOMIC_ACQUIRE, "agent");
            asm volatile("s_waitcnt vmcnt(0)" ::: "memory");
        }
    }
    __syncthreads();
}

constexpr int PPL = 11;
constexpr int NPHASE = 2 + PPL * DEPTH;
#ifndef PROBE_SUB
#define PROBE_SUB 3
#endif
#ifndef PROBE_REP
#define PROBE_REP (-1)
#endif
__global__ void __launch_bounds__(NTHREADS, 2) mega(Params p_arg, int ph_lo, int ph_hi) {
    extern __shared__ __attribute__((aligned(16))) char lds[];
    cg::grid_group grid = cg::this_grid();
    volatile LAS unsigned* st = (volatile LAS unsigned*)(lds + LDS_BYTES - 16);
    if (threadIdx.x == 0) { st[0] = 0u; st[1] = 0u; }
    __syncthreads();
    XcdBarrier xb = xcd_barrier_post((unsigned*)(p_arg.ws + OFF_BAR), st);
    for (int ph = ph_lo; ph < ph_hi; ++ph) {
        KP p = (KP)__builtin_amdgcn_kernarg_segment_ptr();
        asm volatile("" : "+s"(p));
        const int l = (ph >= 2) ? (ph - 2) / PPL : 0;
        const int q = (ph >= 2) ? (ph - 2) % PPL : -1;
        const bool nobar = (q == 2 || q == 3);
        const int nrep = (PROBE_REP >= 0 && ph == PROBE_REP) ? 2 : 1;
        for (int rep = 0; rep < nrep; ++rep) {
            const int dry = (PROBE_REP >= 0 && ph == PROBE_REP && rep == 0) ? 1 : 0;
            char* ldsh = lds + __builtin_amdgcn_readfirstlane((int)(threadIdx.x >> 8)) * LDS_HALF;
            if (ph == 0) phase0(p, ldsh);
            else if (ph == 1) phaseF0(p);
            else {
                switch (q) {
                    case 0: phaseA(p, l, lds); break;
                    case 1: phaseB1(p, l, ldsh, 1, (PROBE_REP >= 0 && ph == PROBE_REP && rep == 1) ? PROBE_SUB : 3); break;
                    case 2: phaseMix(p, l, ldsh, 0); break;
                    case 3: phaseMix(p, l, ldsh, 1); break;
                    case 4: phaseMix(p, l, ldsh, 2); break;
                    case 5: phaseB3(p, l); break;
                    case 6: phaseC(p, l, lds); break;
                    case 7: phaseD(p, l, ldsh, dry); break;
                    case 8: phaseE1(p, l, lds); break;
                    case 9: phaseE2(p, l, lds); break;
                    default: phaseF(p, l, dry); break;
                }
            }
            const bool lastrep = (rep + 1 == nrep);
            if (!lastrep || (ph + 1 < ph_hi && !nobar)) { if (lastrep && ph == ph_lo) grid.sync(); else xcd_barrier(xb); }
        }
    }
}

extern "C" void kernel_launch(void* const* d_in, const int* in_sizes, int n_in, void* d_out, int out_size, void* d_ws, size_t ws_size, hipStream_t stream) {
    static int grid_blocks = 0;
    if (grid_blocks == 0) {
        if (n_in != 39 || out_size != NTOK * DM || ws_size < WS_NEED) { fprintf(stderr, "kernel_launch: unexpected shapes (n_in %d out %d ws %zu need %zu)\n", n_in, out_size, ws_size, (size_t)WS_NEED); grid_blocks = -1; return; }
        int dev = 0, cus = 0, per_cu = 0;
        hipGetDevice(&dev);
        hipDeviceGetAttribute(&cus, hipDeviceAttributeMultiprocessorCount, dev);
        hipFuncSetAttribute((const void*)mega, hipFuncAttributeMaxDynamicSharedMemorySize, LDS_BYTES);
        hipOccupancyMaxActiveBlocksPerMultiprocessor(&per_cu, (const void*)mega, NTHREADS, LDS_BYTES);
        if (per_cu < 1) { fprintf(stderr, "kernel_launch: occupancy query returned %d\n", per_cu); grid_blocks = -1; return; }
        if (cus < 256) { fprintf(stderr, "kernel_launch: this build needs 256 CUs (found %d)\n", cus); grid_blocks = -1; return; }
        grid_blocks = 256;
    }
    if (grid_blocks < 0) return;
    if (hipMemsetAsync(d_ws, 0, 32768, stream) != hipSuccess) { fprintf(stderr, "kernel_launch: memset failed\n"); return; }
    Params p{};
    for (int i = 0; i < 39; ++i) p.in[i] = (const float*)d_in[i];
    p.out = (float*)d_out; p.ws = (unsigned char*)d_ws;
    int ph_lo = 0, ph_hi = NPHASE;
    void* args[] = {&p, &ph_lo, &ph_hi};
    hipError_t e = hipLaunchCooperativeKernel((const void*)mega, dim3(grid_blocks), dim3(NTHREADS), args, LDS_BYTES, stream);
    if (e != hipSuccess) fprintf(stderr, "cooperative launch failed: %s (grid %d)\n", hipGetErrorString(e), grid_blocks);
}
```

```cpp
#include <hip/hip_runtime.h>
#include <hip/hip_cooperative_groups.h>
#include <stdio.h>
#include <stdint.h>
namespace cg = cooperative_groups;

typedef unsigned short bf16_t;
typedef short bf16x8 __attribute__((ext_vector_type(8)));
typedef float f32x4 __attribute__((ext_vector_type(4)));
#define DEVINL __device__ __forceinline__
#define LAS __attribute__((address_space(3)))
#define MFMA32(a, b, c) __builtin_amdgcn_mfma_f32_32x32x16_bf16((a), (b), (c), 0, 0, 0)

constexpr int NTOK = 32768, SEQ = 4096, NBATCH = 8, DM = 1024, PIN = 2688, DEPTH = 2;
constexpr int NEXP = 64;
constexpr float ALPHA = 1.41421356237f;
constexpr float LN_EPS = 1e-5f, GN_EPS = 64e-5f;
constexpr int NTHREADS = 512;
constexpr int VTHREADS = 256;
constexpr int LDS_HALF = 75776;
constexpr int LDS_BYTES = 159744;

constexpr size_t OFF_CNT   = 0;
constexpr size_t OFF_BAR   = 4096;
constexpr size_t OFF_MOD   = 65536;
constexpr size_t OFF_WR    = 524288;
constexpr size_t OFF_WIN   = 1048576;
constexpr int WIN_ROWS = 2816;
constexpr size_t OFF_WOUT  = OFF_WIN + 2 * (size_t)WIN_ROWS * 1024 * 2;
constexpr size_t OFF_W13   = OFF_WOUT + 4194304;
constexpr size_t OFF_W2    = OFF_W13 + 136314880;
constexpr size_t OFF_UBUF  = OFF_W2 + 68157440;
constexpr size_t OFF_ARENA = OFF_UBUF + 67108864;
constexpr size_t A_P      = OFF_ARENA;
constexpr size_t A_YMIX   = A_P + 176160768;
constexpr size_t A_SCAN   = A_YMIX + 67108864;
constexpr size_t A_HLOC   = A_SCAN + 134217728;
constexpr size_t A_CUMA   = A_HLOC + 33554432;
constexpr size_t A_G      = A_CUMA + 33554432;
constexpr size_t A_BONUS  = A_G + 33554432;
constexpr size_t A_YRAW   = A_BONUS + 33554432;
constexpr size_t A_CARRYA = A_YRAW + 33554432;
constexpr size_t A_CARRYH = A_CARRYA + 1048576;
constexpr size_t A_HSTART = A_CARRYH + 1048576;
constexpr size_t A_CHAIN  = A_HSTART + 1048576;
constexpr size_t CHAIN_UNIT = 49152;
constexpr size_t M_YBUF   = OFF_ARENA;
constexpr size_t M_ZB     = OFF_ARENA + 335544320;
constexpr size_t M_HBUF   = M_YBUF + 603979776;
constexpr size_t M_LIST   = M_HBUF + 159383552;
constexpr size_t M_WSEL   = M_LIST + 8388608;
constexpr size_t M_PMAP   = M_WSEL + 1048576;
constexpr size_t M_STAT   = M_PMAP + 1048576;
constexpr size_t OFF_WLT  = M_STAT + 262144;
constexpr size_t OFF_WGT  = OFF_WLT + 131072;
constexpr size_t WS_NEED  = OFF_WGT + 131072;
static_assert(WS_NEED <= (size_t)1 << 30, "workspace layout exceeds the guaranteed 1 GiB");

struct Params {
    const float* in[39];
    float* out;
    unsigned char* ws;
};
typedef const __attribute__((address_space(4))) Params* KP;
__device__ __forceinline__ int TIDX() { int t = threadIdx.x; asm volatile("" : "+v"(t)); t &= 255; return t; }
__device__ __forceinline__ int BIDX() { int b = blockIdx.x * 2 + __builtin_amdgcn_readfirstlane((int)(threadIdx.x >> 8)); asm volatile("" : "+s"(b)); __builtin_assume(b >= 0 && b < 65536); return b; }
__device__ __forceinline__ int NBV() { return gridDim.x * 2; }
__device__ __forceinline__ int TID512() { int t = threadIdx.x; asm volatile("" : "+v"(t)); __builtin_assume(t >= 0 && t < 512); return t; }
enum { I_X = 0, I_C, I_WMOD, I_BMOD, I_WIN, I_WOUT, I_CONVA, I_CONVAB, I_LNAG, I_LNAB, I_CONVB, I_CONVBB, I_WRG, I_BRG, I_WIG, I_BIG,
       I_LAMBDA, I_MUC, I_W0, I_WW2, I_A0, I_WA2, I_WG2, I_KK, I_KA, I_RK, I_GNG, I_GNB, I_CONVD, I_LN1G, I_LN1B, I_WROUTER, I_EBIAS,
       I_W13, I_W2, I_WS13, I_WS2, I_LN2G, I_LN2B };

DEVINL bf16_t f2bf(float f) { unsigned u = __float_as_uint(f); u += 0x7FFFu + ((u >> 16) & 1u); return (bf16_t)(u >> 16); }
DEVINL float bf2f(bf16_t h) { return __uint_as_float(((unsigned)h) << 16); }
typedef __bf16 bf2_t __attribute__((ext_vector_type(2)));
typedef float f2_t __attribute__((ext_vector_type(2)));
typedef float f32x16 __attribute__((ext_vector_type(16)));
DEVINL unsigned pack2(float a, float b) { f2_t v = {a, b}; return __builtin_bit_cast(unsigned, __builtin_convertvector(v, bf2_t)); }
DEVINL float sigm(float x) { return __builtin_amdgcn_rcpf(1.f + __expf(-x)); }
DEVINL float tanh_fast(float x) { const float e = __expf(2.f * x); return 1.f - 2.f * __builtin_amdgcn_rcpf(1.f + e); }
DEVINL float softplusf(float z) { return fmaxf(z, 0.f) + __logf(1.f + __expf(-fabsf(z))); }
DEVINL float log1p_s(float y) { return (y < 0.03125f) ? y * (1.f - y * (0.5f - y * (0.33333334f - 0.25f * y))) : __logf(1.f + y); }
DEVINL float softplus_acc(float z) { return fmaxf(z, 0.f) + log1p_s(__expf(-fabsf(z))); }
DEVINL float gelu_tanh(float x) { float u = 0.7978845608028654f * (x + 0.044715f * x * x * x); return 0.5f * x * (1.f + tanh_fast(u)); }
DEVINL float group8_max(float x) {
    x = fmaxf(x, __builtin_bit_cast(float, __builtin_amdgcn_update_dpp(0, __builtin_bit_cast(int, x), 0xB1, 0xf, 0xf, true)));
    x = fmaxf(x, __builtin_bit_cast(float, __builtin_amdgcn_update_dpp(0, __builtin_bit_cast(int, x), 0x4E, 0xf, 0xf, true)));
    x = fmaxf(x, __builtin_bit_cast(float, __builtin_amdgcn_update_dpp(0, __builtin_bit_cast(int, x), 0x141, 0xf, 0xf, true)));
    return x;
}
DEVINL float wave_sum_dpp(float x);
DEVINL float wave_sum(float x) { return wave_sum_dpp(x); }
DEVINL float wave_sum_dpp(float x) {
    x += __builtin_bit_cast(float, __builtin_amdgcn_update_dpp(0, __builtin_bit_cast(int, x), 0xB1, 0xf, 0xf, true));
    x += __builtin_bit_cast(float, __builtin_amdgcn_update_dpp(0, __builtin_bit_cast(int, x), 0x4E, 0xf, 0xf, true));
    x += __builtin_bit_cast(float, __builtin_amdgcn_update_dpp(0, __builtin_bit_cast(int, x), 0x141, 0xf, 0xf, true));
    x += __builtin_bit_cast(float, __builtin_amdgcn_update_dpp(0, __builtin_bit_cast(int, x), 0x140, 0xf, 0xf, true));
    x += __builtin_bit_cast(float, __builtin_amdgcn_update_dpp(0, __builtin_bit_cast(int, x), 0x142, 0xa, 0xf, false));
    x += __builtin_bit_cast(float, __builtin_amdgcn_update_dpp(0, __builtin_bit_cast(int, x), 0x143, 0xc, 0xf, false));
    return __builtin_bit_cast(float, __builtin_amdgcn_readlane(__builtin_bit_cast(int, x), 63));
}

DEVINL int lds_byte(int r, int c) { int st = (r >> 4) * 2 + (c >> 5), rr = r & 15, cc = c & 31, ob = rr * 64 + cc * 2; return st * 1024 + (ob ^ (((ob >> 9) & 1) << 5)); }
DEVINL void stage_rc(int b, int& R, int& C) { int st = b / 1024, sb = b % 1024, swz = sb ^ (((sb >> 9) & 1) << 5); R = (st >> 1) * 16 + swz / 64; C = (st & 1) * 32 + (swz % 64) / 2; }

template <class RowPtr, class Epi>
DEVINL void gemm_tile128(char* lds, RowPtr arow, const bf16_t* Bt, int K, Epi epi) {
    const int tid = TIDX();
    const bf16_t* ap[4]; const bf16_t* bp[4];
#pragma unroll
    for (int i = 0; i < 4; ++i) { int R, C; stage_rc(tid * 16 + i * 4096, R, C); ap[i] = arow(R) + C; bp[i] = Bt + (size_t)R * K + C; }
    const int wid = tid >> 6, lane = tid & 63, wr = wid >> 1, wc = wid & 1, fr = lane & 15, fq = lane >> 4;
    f32x4 acc[4][4];
#pragma unroll
    for (int m = 0; m < 4; ++m)
#pragma unroll
        for (int n = 0; n < 4; ++n) acc[m][n] = (f32x4){0.f, 0.f, 0.f, 0.f};
    const int nk = K >> 6;
#pragma unroll
    for (int i = 0; i < 4; ++i) {
        __builtin_amdgcn_global_load_lds((const unsigned*)(ap[i]), (unsigned*)(lds + tid * 16 + i * 4096), 16, 0, 0);
        __builtin_amdgcn_global_load_lds((const unsigned*)(bp[i]), (unsigned*)(lds + 16384 + tid * 16 + i * 4096), 16, 0, 0);
    }
    for (int kt = 0; kt < nk; ++kt) {
        asm volatile("s_waitcnt vmcnt(0)" ::: "memory");
        __syncthreads();
        char* cur = lds + (kt & 1) * 32768;
        if (kt + 1 < nk) {
            char* nxt = lds + ((kt + 1) & 1) * 32768;
            const int ko = (kt + 1) * 64;
#pragma unroll
            for (int i = 0; i < 4; ++i) {
                __builtin_amdgcn_global_load_lds((const unsigned*)(ap[i] + ko), (unsigned*)(nxt + tid * 16 + i * 4096), 16, 0, 0);
                __builtin_amdgcn_global_load_lds((const unsigned*)(bp[i] + ko), (unsigned*)(nxt + 16384 + tid * 16 + i * 4096), 16, 0, 0);
            }
        }
        bf16x8 af[4][2], bfr[4][2];
#pragma unroll
        for (int m = 0; m < 4; ++m)
#pragma unroll
            for (int kk = 0; kk < 2; ++kk) af[m][kk] = *reinterpret_cast<const bf16x8*>(cur + lds_byte(wr * 64 + m * 16 + fr, kk * 32 + fq * 8));
#pragma unroll
        for (int n = 0; n < 4; ++n)
#pragma unroll
            for (int kk = 0; kk < 2; ++kk) bfr[n][kk] = *reinterpret_cast<const bf16x8*>(cur + 16384 + lds_byte(wc * 64 + n * 16 + fr, kk * 32 + fq * 8));
#pragma unroll
        for (int kk = 0; kk < 2; ++kk)
#pragma unroll
            for (int m = 0; m < 4; ++m)
#pragma unroll
                for (int n = 0; n < 4; ++n) acc[m][n] = __builtin_amdgcn_mfma_f32_16x16x32_bf16(bfr[n][kk], af[m][kk], acc[m][n], 0, 0, 0);
    }
    __syncthreads();
    epi(acc, wr, wc, fr, fq);
}

template <class Ptrs, class Epi>
DEVINL void gemm_stream128(char* lds, int K, int blk, int nb, int total, Ptrs ptrs, Epi epi) {
    const int qx = nb >> 3, first = (blk & 7) * qx + (blk >> 3), stride = nb;
    if (first >= total) return;
    const int tid = TIDX();
    const int wid = tid >> 6, lane = tid & 63, wr = wid >> 1, wc = wid & 1, fr = lane & 15, fq = lane >> 4;
    const int nk = K >> 6;
    const bf16_t* ap[4]; const bf16_t* bp[4];
    const bf16_t* an[4]; const bf16_t* bn[4];
    int t = first;
    ptrs(t, ap, bp);
#pragma unroll
    for (int i = 0; i < 4; ++i) {
        __builtin_amdgcn_global_load_lds((const unsigned*)(ap[i]), (unsigned*)(lds + tid * 16 + i * 4096), 16, 0, 0);
        __builtin_amdgcn_global_load_lds((const unsigned*)(bp[i]), (unsigned*)(lds + 16384 + tid * 16 + i * 4096), 16, 0, 0);
    }
    for (;;) {
        const int tn = t + stride;
        const bool has_next = tn < total;
        if (has_next) ptrs(tn, an, bn);
        f32x4 acc[4][4];
#pragma unroll
        for (int m = 0; m < 4; ++m)
#pragma unroll
            for (int n = 0; n < 4; ++n) acc[m][n] = (f32x4){0.f, 0.f, 0.f, 0.f};
        for (int kt = 0; kt < nk; ++kt) {
            asm volatile("s_waitcnt vmcnt(0)" ::: "memory");
            __syncthreads();
            char* cur = lds + (kt & 1) * 32768;
            if (kt + 1 < nk) {
                char* nxt = lds + ((kt + 1) & 1) * 32768;
                const int ko = (kt + 1) * 64;
#pragma unroll
                for (int i = 0; i < 4; ++i) {
                    __builtin_amdgcn_global_load_lds((const unsigned*)(ap[i] + ko), (unsigned*)(nxt + tid * 16 + i * 4096), 16, 0, 0);
                    __builtin_amdgcn_global_load_lds((const unsigned*)(bp[i] + ko), (unsigned*)(nxt + 16384 + tid * 16 + i * 4096), 16, 0, 0);
                }
            } else if (has_next) {
#pragma unroll
                for (int i = 0; i < 4; ++i) {
                    __builtin_amdgcn_global_load_lds((const unsigned*)(an[i]), (unsigned*)(lds + tid * 16 + i * 4096), 16, 0, 0);
                    __builtin_amdgcn_global_load_lds((const unsigned*)(bn[i]), (unsigned*)(lds + 16384 + tid * 16 + i * 4096), 16, 0, 0);
                }
            }
            bf16x8 af[4][2], bfr[4][2];
#pragma unroll
            for (int m = 0; m < 4; ++m)
#pragma unroll
                for (int kk = 0; kk < 2; ++kk) af[m][kk] = *reinterpret_cast<const bf16x8*>(cur + lds_byte(wr * 64 + m * 16 + fr, kk * 32 + fq * 8));
#pragma unroll
            for (int n = 0; n < 4; ++n)
#pragma unroll
                for (int kk = 0; kk < 2; ++kk) bfr[n][kk] = *reinterpret_cast<const bf16x8*>(cur + 16384 + lds_byte(wc * 64 + n * 16 + fr, kk * 32 + fq * 8));
#pragma unroll
            for (int kk = 0; kk < 2; ++kk)
#pragma unroll
                for (int m = 0; m < 4; ++m)
#pragma unroll
                    for (int n = 0; n < 4; ++n) acc[m][n] = __builtin_amdgcn_mfma_f32_16x16x32_bf16(bfr[n][kk], af[m][kk], acc[m][n], 0, 0, 0);
        }
        epi(t, acc, wr, wc, fr, fq);
        if (!has_next) break;
        t = tn;
#pragma unroll
        for (int i = 0; i < 4; ++i) { ap[i] = an[i]; bp[i] = bn[i]; }
    }
    __syncthreads();
}
DEVINL void stage_coords(int (&R)[4], int (&C)[4]) {
    const int tid = TIDX();
#pragma unroll
    for (int i = 0; i < 4; ++i) stage_rc(tid * 16 + i * 4096, R[i], C[i]);
}

struct GUnit {
    const char* A;
    const char* B;
    unsigned va[2][2] = {{0u, 0u}, {0u, 0u}};
    int i0, i1, i2;
};
constexpr int G_HTB = 128 * 64 * 2;
constexpr int G_STAGE_BYTES = 8 * G_HTB;
DEVINL int perm32(int rho) { const int n = rho >> 4, i = rho & 15; return 8 * (i >> 2) + 4 * n + (i & 3); }
DEVINL void stage_coords512(int tid, int (&R)[2], int (&C)[2]) {
#pragma unroll
    for (int i = 0; i < 2; ++i) stage_rc(tid * 16 + i * 8192, R[i], C[i]);
}

typedef int v8i_t __attribute__((ext_vector_type(8)));
typedef int v4i_t __attribute__((ext_vector_type(4)));
DEVINL v8i_t cat8(bf16x8 lo, bf16x8 hi) { return __builtin_shufflevector(__builtin_bit_cast(v4i_t, lo), __builtin_bit_cast(v4i_t, hi), 0, 1, 2, 3, 4, 5, 6, 7); }
template <bool PERM, bool GATHER, bool FP8, class Sched, class Epi>
DEVINL void gemm256(char* lds_generic, int K, int lda, Sched sched, Epi epi) {
    LAS unsigned char* lds = (LAS unsigned char*)lds_generic;
    const int tid = TID512(), wid = __builtin_amdgcn_readfirstlane(tid >> 6), lane = tid & 63, wr = wid >> 2, wc = wid & 3, fr = lane & 15, fq = lane >> 4;
    const int nt = K / 64;
    unsigned voffB[2];
#pragma unroll
    for (int i = 0; i < 2; ++i) { int R, C; stage_rc(tid * 16 + i * 8192, R, C); const int Rb = PERM ? ((R & ~31) + perm32(R & 31)) : R; voffB[i] = (unsigned)(Rb * K + C) * 2u; }
    unsigned voffA[2];
#pragma unroll
    for (int i = 0; i < 2; ++i) { int R, C; stage_rc(tid * 16 + i * 8192, R, C); voffA[i] = (unsigned)(R * lda + C) * 2u; }
    const size_t hstepA = GATHER ? 0 : (size_t)128 * lda * 2;
    const size_t kstep = (size_t)(64 * 2);
    const size_t hstepB = (size_t)128 * K * 2;
    const unsigned ldsw = (unsigned)wid * 1024u;
    const int aoff = lds_byte(wr * 64 + fr, fq * 8), boff = lds_byte(wc * 32 + fr, fq * 8);
#define G_SA(b, h) (((b) * 2 + (h)) * G_HTB)
#define G_SB(b, h) ((4 + (b) * 2 + (h)) * G_HTB)
#define G_STAGE(bufoff, gbase, voff) do { _Pragma("unroll") for (int _i = 0; _i < 2; ++_i) { unsigned _vo = (voff)[_i]; asm volatile("" : "+v"(_vo)); \
        __builtin_amdgcn_global_load_lds((const unsigned*)((const char*)(gbase) + _vo), (LAS unsigned*)(lds + (bufoff) + ldsw + _i * 8192), 16, 0, 0); } } while (0)
#define G_STAGE_A(bufoff, ptr, vg, h) do { if constexpr (GATHER) { G_STAGE(bufoff, ptr, vg); } else { G_STAGE(bufoff, (ptr) + (h) * hstepA, voffA); } } while (0)
#define G_LDA(dst, b, h) do { _Pragma("unroll") for (int m = 0; m < 4; ++m) dst[m] = cat8(*(const LAS bf16x8*)(lds + G_SA(b, h) + aoff + m * 2048), *(const LAS bf16x8*)(lds + G_SA(b, h) + aoff + m * 2048 + 1024)); } while (0)
#define G_LDB(dst, b, h) do { _Pragma("unroll") for (int n = 0; n < 2; ++n) dst[n] = cat8(*(const LAS bf16x8*)(lds + G_SB(b, h) + boff + n * 2048), *(const LAS bf16x8*)(lds + G_SB(b, h) + boff + n * 2048 + 1024)); } while (0)
#define G_LO(x) __builtin_bit_cast(bf16x8, __builtin_shufflevector((x), (x), 0, 1, 2, 3))
#define G_HI(x) __builtin_bit_cast(bf16x8, __builtin_shufflevector((x), (x), 4, 5, 6, 7))
#define G_MMA(ai, bj, At, Bt) do { __builtin_amdgcn_s_setprio(1); \
        if constexpr (FP8) { _Pragma("unroll") for (int m = 0; m < 4; ++m) _Pragma("unroll") for (int n = 0; n < 2; ++n) \
            acc[ai][bj][m][n] = __builtin_amdgcn_mfma_scale_f32_16x16x128_f8f6f4(Bt[n], At[m], acc[ai][bj][m][n], 0, 0, 0, 0x7B7B7B7B, 0, 0x7F7F7F7F); } \
        else { _Pragma("unroll") for (int m = 0; m < 4; ++m) _Pragma("unroll") for (int n = 0; n < 2; ++n) { \
            acc[ai][bj][m][n] = __builtin_amdgcn_mfma_f32_16x16x32_bf16(G_LO(Bt[n]), G_LO(At[m]), acc[ai][bj][m][n], 0, 0, 0); \
            acc[ai][bj][m][n] = __builtin_amdgcn_mfma_f32_16x16x32_bf16(G_HI(Bt[n]), G_HI(At[m]), acc[ai][bj][m][n], 0, 0, 0); } } \
        __builtin_amdgcn_s_setprio(0); } while (0)
#define G_WAIT_V(n) asm volatile("s_waitcnt vmcnt(" #n ")" ::: "memory")
#define G_WAIT_L(n) asm volatile("s_waitcnt lgkmcnt(" #n ")" ::: "memory")
#define G_BAR __builtin_amdgcn_s_barrier()
#define G_SCHED __builtin_amdgcn_sched_barrier(0)
    GUnit cur, nxt; int ui = 0;
    if (!sched(0, cur)) return;
    LAS unsigned* vst = (LAS unsigned*)(lds + 131072 + 8192) + tid * 8;
    if constexpr (GATHER) { vst[0] = cur.va[0][0]; vst[1] = cur.va[0][1]; vst[2] = cur.va[1][0]; vst[3] = cur.va[1][1]; }
    f32x4 acc[2][2][4][2];
#pragma unroll
    for (int a = 0; a < 2; ++a)
#pragma unroll
        for (int b = 0; b < 2; ++b)
#pragma unroll
            for (int m = 0; m < 4; ++m)
#pragma unroll
                for (int n = 0; n < 2; ++n) acc[a][b][m][n] = (f32x4){0.f, 0.f, 0.f, 0.f};
    v8i_t At[4], B0[2], B1[2];
    G_STAGE(G_SB(0, 0), cur.B, voffB); G_STAGE_A(G_SA(0, 0), cur.A, cur.va[0], 0); G_STAGE(G_SB(0, 1), cur.B + hstepB, voffB); G_STAGE_A(G_SA(0, 1), cur.A, cur.va[1], 1);
    if (wr == 1) G_BAR;
    G_WAIT_V(4); G_BAR;
    G_STAGE(G_SB(1, 0), cur.B + kstep, voffB); G_STAGE_A(G_SA(1, 0), cur.A + kstep, cur.va[0], 0); G_STAGE(G_SB(1, 1), cur.B + hstepB + kstep, voffB);
    G_WAIT_V(6); G_BAR;
    for (;;) {
        const bool has_next = sched(ui + 1, nxt);
        if (!has_next) nxt = cur;
        if constexpr (GATHER) { LAS unsigned* vn = vst + ((ui + 1) & 1) * 4; vn[0] = nxt.va[0][0]; vn[1] = nxt.va[0][1]; vn[2] = nxt.va[1][0]; vn[3] = nxt.va[1][1]; }
#pragma unroll 1
        for (int t = 0; t < nt; t += 2) {
            const bool last = (t == nt - 2);
            const char* a1 = cur.A + (size_t)(t + 1) * kstep;
            const char* a2 = last ? nxt.A : cur.A + (size_t)(t + 2) * kstep; const char* b2 = last ? nxt.B : cur.B + (size_t)(t + 2) * kstep;
            const char* a3 = a2 + kstep; const char* b3 = b2 + kstep;
            G_LDB(B0, 0, 0); G_SCHED; G_LDA(At, 0, 0); { unsigned nv[2] = {0u, 0u}; if constexpr (GATHER) { LAS unsigned* q_ = vst + (ui & 1) * 4; nv[0] = q_[2]; nv[1] = q_[3]; } G_STAGE_A(G_SA(1, 1), a1, nv, 1); }
            G_WAIT_L(8); G_BAR; G_WAIT_L(0); G_MMA(0, 0, At, B0); G_BAR; G_SCHED;
            G_LDB(B1, 0, 1); G_STAGE(G_SB(0, 0), b2, voffB);
            G_BAR; G_WAIT_L(0); G_MMA(0, 1, At, B1); G_BAR;
            G_LDA(At, 0, 1); { unsigned nv[2] = {0u, 0u}; if constexpr (GATHER) { LAS unsigned* q_ = vst + ((ui + (last ? 1 : 0)) & 1) * 4; nv[0] = q_[0]; nv[1] = q_[1]; } G_STAGE_A(G_SA(0, 0), a2, nv, 0); }
            G_BAR; G_WAIT_L(0); G_MMA(1, 0, At, B0); G_BAR; G_SCHED;
            G_STAGE(G_SB(0, 1), b2 + hstepB, voffB);
            G_WAIT_V(6); G_BAR; G_MMA(1, 1, At, B1); G_BAR;
            G_LDB(B0, 1, 0); G_SCHED; G_LDA(At, 1, 0); { unsigned nv[2] = {0u, 0u}; if constexpr (GATHER) { LAS unsigned* q_ = vst + ((ui + (last ? 1 : 0)) & 1) * 4; nv[0] = q_[2]; nv[1] = q_[3]; } G_STAGE_A(G_SA(0, 1), a2, nv, 1); }
            G_WAIT_L(8); G_BAR; G_WAIT_L(0); G_MMA(0, 0, At, B0); G_BAR; G_SCHED;
            G_LDB(B1, 1, 1); G_STAGE(G_SB(1, 0), b3, voffB);
            G_BAR; G_WAIT_L(0); G_MMA(0, 1, At, B1); G_BAR;
            G_LDA(At, 1, 1); { unsigned nv[2] = {0u, 0u}; if constexpr (GATHER) { LAS unsigned* q_ = vst + ((ui + (last ? 1 : 0)) & 1) * 4; nv[0] = q_[0]; nv[1] = q_[1]; } G_STAGE_A(G_SA(1, 0), a3, nv, 0); }
            G_BAR; G_WAIT_L(0); G_MMA(1, 0, At, B0); G_BAR; G_SCHED;
            G_STAGE(G_SB(1, 1), b3 + hstepB, voffB);
            G_WAIT_V(6); G_BAR; G_MMA(1, 1, At, B1); G_BAR;
        }
        { const int l2 = TID512() & 63; epi(acc, cur, wr, wc, l2 & 15, l2 >> 4); }
        if (!has_next) break;
#pragma unroll
        for (int a = 0; a < 2; ++a)
#pragma unroll
            for (int b = 0; b < 2; ++b)
#pragma unroll
                for (int m = 0; m < 4; ++m)
#pragma unroll
                    for (int n = 0; n < 2; ++n) acc[a][b][m][n] = (f32x4){0.f, 0.f, 0.f, 0.f};
        cur = nxt; ++ui;
    }
    G_WAIT_V(0);
    if (wr == 0) G_BAR;
    G_BAR;
#undef G_SA
#undef G_STAGE_A
#undef G_SB
#undef G_STAGE
#undef G_LDA
#undef G_LDB
#undef G_MMA
#undef G_LO
#undef G_HI
#undef G_WAIT_V
#undef G_WAIT_L
#undef G_BAR
#undef G_SCHED
}
DEVINL long unit_linear(int i, int c, int G) { const int q = G >> 3; return ((long)i * 8 + (c & 7)) * q + (c >> 3); }

constexpr int CONV_PER_L = 672 + 256 + 8320 + 4160;
struct ConvJob { const float* src; bf16_t* dst; int K, ld, k0, r0, perm, f8; };
DEVINL ConvJob conv_decode(KP p, int id) {
    ConvJob j; const int l = id / CONV_PER_L; int r = id % CONV_PER_L; int kt, nt;
    if (r < 672) { j.src = p->in[I_WIN] + (size_t)l * 1024 * 2688; j.K = 1024; j.ld = 2688; j.perm = 0; j.dst = (bf16_t*)(p->ws + OFF_WIN) + (size_t)l * WIN_ROWS * 1024; j.f8 = 0; nt = r % 42; kt = r / 42; }
    else if (r < 928) { r -= 672; j.src = p->in[I_WOUT] + (size_t)l * 1024 * 1024; j.K = 1024; j.ld = 1024; j.perm = 0; j.dst = (bf16_t*)(p->ws + OFF_WOUT) + (size_t)l * 1024 * 1024; j.f8 = 0; nt = r & 15; kt = r >> 4; }
    else if (r < 928 + 8320) { r -= 928; const int e = r >> 7, q = r & 127; nt = q & 7; kt = q >> 3; j.K = 1024; j.ld = 512; j.perm = 1; j.f8 = 1;
        j.src = (e < 64) ? p->in[I_W13] + (size_t)(l * 64 + e) * 1024 * 512 : p->in[I_WS13] + (size_t)l * 1024 * 512;
        j.dst = (bf16_t*)(p->ws + OFF_W13 + (size_t)(l * 65 + e) * 512 * 1024); }
    else { r -= 9248; const int e = r >> 6, q = r & 63; nt = q & 15; kt = q >> 4; j.K = 256; j.ld = 1024; j.perm = 0; j.f8 = 0;
        j.src = (e < 64) ? p->in[I_W2] + (size_t)(l * 64 + e) * 256 * 1024 : p->in[I_WS2] + (size_t)l * 256 * 1024;
        j.dst = (bf16_t*)(p->ws + OFF_W2) + (size_t)(l * 65 + e) * 1024 * 256; }
    j.k0 = kt * 64; j.r0 = nt * 64; return j;
}
DEVINL void conv_issue(const ConvJob& j, char* buf, int tid) {
    const int nn = tid & 63, drow = j.r0 + nn;
    int scol = drow;
    if (j.perm) { const int g = drow >> 5, i = drow & 31; scol = (i < 16) ? (g * 16 + i) : (256 + g * 16 + (i - 16)); }
    const float* sp = j.src + (size_t)j.k0 * j.ld + scol;
#pragma unroll
    for (int q = 0; q < 16; ++q) { const int kk = (tid >> 6) + 4 * q;
        __builtin_amdgcn_global_load_lds((const unsigned*)(sp + (size_t)kk * j.ld), (unsigned*)(buf + kk * 260 + nn * 4), 4, 0, 0); }
}
DEVINL void convert_ids(KP p, char* lds, int id_lo, int id_hi, int wb, int nwb) {
    const int tid = TIDX();
    const int n = (id_hi - id_lo + nwb - 1) / nwb;
    auto idof = [&](int i) { const int id = id_lo + i * nwb + wb; return (id < id_hi) ? id : id_hi - 1; };
    ConvJob j0 = conv_decode(p, idof(0)), j1 = conv_decode(p, idof(n > 1 ? 1 : 0));
    conv_issue(j0, lds, tid);
    conv_issue(j1, lds + 16640, tid);
    auto dptr = [](const ConvJob& j) { return (char*)j.dst + ((size_t)j.r0 * j.K + j.k0) * (j.f8 ? 1 : 2); };
    char* d0 = dptr(j0); int K0 = j0.K, f0 = j0.f8;
    char* d1 = dptr(j1); int K1 = j1.K, f1 = j1.f8;
    for (int i = 0; i < n; ++i) {
        const ConvJob j2 = conv_decode(p, idof(i + 2 < n ? i + 2 : n - 1));
        conv_issue(j2, lds + ((i + 2) % 3) * 16640, tid);
        asm volatile("s_waitcnt vmcnt(32)" ::: "memory");
        __builtin_amdgcn_s_barrier();
        const float* tile = (const float*)(lds + (i % 3) * 16640);
        if (f0) {
            const int kp = (tid & 15) * 4;
#pragma unroll
            for (int q = 0; q < 4; ++q) { const int rr = (tid >> 4) + 16 * q;
                int w8 = __builtin_amdgcn_cvt_pk_fp8_f32(16.f * tile[kp * 65 + rr], 16.f * tile[(kp + 1) * 65 + rr], 0, false);
                w8 = __builtin_amdgcn_cvt_pk_fp8_f32(16.f * tile[(kp + 2) * 65 + rr], 16.f * tile[(kp + 3) * 65 + rr], w8, true);
                *(int*)(d0 + (size_t)rr * K0 + kp) = w8; }
        } else {
            const int kp = (tid & 31) * 2;
#pragma unroll
            for (int q = 0; q < 8; ++q) { const int rr = (tid >> 5) + 8 * q;
                *(unsigned*)(d0 + ((size_t)rr * K0 + kp) * 2) = pack2(tile[kp * 65 + rr], tile[(kp + 1) * 65 + rr]); }
        }
        asm volatile("s_waitcnt lgkmcnt(0)" ::: "memory");
        __builtin_amdgcn_s_barrier();
        d0 = d1; K0 = K1; f0 = f1; d1 = dptr(j2); K1 = j2.K; f1 = j2.f8;
    }
    asm volatile("s_waitcnt vmcnt(0)" ::: "memory");
    __syncthreads();
}

DEVINL void phase0(KP p, char* lds) {
    const int tid = TIDX(), nb = NBV(), blk = BIDX();
    if (blk == 0 && tid < 128) ((unsigned*)(p->ws + OFF_CNT))[tid] = 0u;
    if (blk < 192) {
        float* sc = (float*)lds;
        float* part = (float*)(lds + 32768);
        for (int i = tid; i < 8192; i += VTHREADS) { float c = p->in[I_C][i]; sc[i] = c * sigm(c); }
        __syncthreads();
        const int cl = tid & 63, ks = tid >> 6, n = blk * 64 + cl, l = n / 6144, nn = n % 6144;
        const float* w = p->in[I_WMOD] + (size_t)l * 1024 * 6144 + (size_t)(ks * 256) * 6144 + nn;
        float acc[8];
#pragma unroll
        for (int b = 0; b < 8; ++b) acc[b] = 0.f;
#pragma unroll 32
        for (int k = 0; k < 256; ++k) {
            const float wv = w[(size_t)k * 6144];
#pragma unroll
            for (int b = 0; b < 8; ++b) acc[b] = fmaf(sc[b * 1024 + ks * 256 + k], wv, acc[b]);
        }
#pragma unroll
        for (int b = 0; b < 8; ++b) part[(ks * 8 + b) * 64 + cl] = acc[b];
        __syncthreads();
        if (tid < 64) {
            const float bm = p->in[I_BMOD][l * 6144 + nn];
            float* mod = (float*)(p->ws + OFF_MOD);
#pragma unroll
            for (int b = 0; b < 8; ++b) mod[(size_t)(l * 8 + b) * 6144 + nn] = part[(0 * 8 + b) * 64 + cl] + part[(1 * 8 + b) * 64 + cl] + part[(2 * 8 + b) * 64 + cl] + part[(3 * 8 + b) * 64 + cl] + bm;
        }
        __syncthreads();
    }
    if (blk >= 320 && blk < 384) {
        bf16_t* wgt = (bf16_t*)(p->ws + OFF_WGT);
#pragma unroll
        for (int j = 0; j < 4; ++j) {
            const int idx = (blk - 320) * 1024 + j * 256 + tid;
            const int mat = idx >> 15, lh = (idx >> 12) & 7, d = (idx >> 6) & 63, e = idx & 63;
            const float w = (mat == 0) ? p->in[I_WRG][idx & 32767] : p->in[I_WIG][idx & 32767];
            wgt[(size_t)((lh * 2 + mat) * 64 + e) * 64 + d] = f2bf(w);
        }
    }
    if (blk >= 256 && blk < 320) {
        bf16_t* wlt = (bf16_t*)(p->ws + OFF_WLT);
#pragma unroll
        for (int j = 0; j < 4; ++j) {
            const int idx = (blk - 256) * 1024 + j * 256 + tid, l2 = idx >> 15, f = (idx >> 8) & 127, c = idx & 255;
            const float w = (f < 32) ? p->in[I_WW2][(size_t)(l2 * 32 + f) * 256 + c] : ((f < 64) ? p->in[I_WA2][(size_t)(l2 * 32 + f - 32) * 256 + c] : p->in[I_WG2][(size_t)(l2 * 64 + f - 64) * 256 + c]);
            wlt[(size_t)(l2 * 256 + c) * 128 + f] = f2bf(w);
        }
    }
    if (blk >= 192 && blk < 256) {
        bf16_t* wrt = (bf16_t*)(p->ws + OFF_WR);
#pragma unroll
        for (int j = 0; j < 8; ++j) {
            const int idx = (blk - 192) * 2048 + j * 256 + tid, l2 = idx >> 16, rem = idx & 65535, k = rem >> 6, e = rem & 63;
            const float w = p->in[I_WROUTER][idx];
            const bf16_t hi = f2bf(w); const bf16_t lo = f2bf(w - bf2f(hi));
            wrt[(size_t)((l2 * 2 + 0) * 64 + e) * 1024 + k] = hi; wrt[(size_t)((l2 * 2 + 1) * 64 + e) * 1024 + k] = lo;
        }
    }
    convert_ids(p, lds, 0, 2 * CONV_PER_L, blk, nb);
}

DEVINL void phaseF0(KP p) {
    const int tid = TIDX(), nb = NBV(), blk = BIDX();
    const float* mod = (const float*)(p->ws + OFF_MOD);
    bf16_t* ubuf = (bf16_t*)(p->ws + OFF_UBUF);
    const int col = tid * 4;
    for (int row0 = blk * 8; row0 < NTOK; row0 += nb * 8) {
        float4 x[8];
#pragma unroll
        for (int u = 0; u < 8; ++u) x[u] = *(const float4*)(p->in[I_X] + (size_t)(row0 + u) * DM + col);
        const int b = row0 >> 12;
        const float4 sh = *(const float4*)(mod + (size_t)b * 6144 + col);
        const float4 sc = *(const float4*)(mod + (size_t)b * 6144 + 1024 + col);
#pragma unroll
        for (int u = 0; u < 8; ++u) {
            uint2 o; o.x = pack2(x[u].x * (1.f + sc.x) + sh.x, x[u].y * (1.f + sc.y) + sh.y); o.y = pack2(x[u].z * (1.f + sc.z) + sh.z, x[u].w * (1.f + sc.w) + sh.w);
            *(uint2*)(ubuf + (size_t)(row0 + u) * DM + col) = o;
        }
    }
}

DEVINL void b1_conformer(KP p, int l, char* lds, int item) {
    const int tid = TIDX(), b = item >> 7, tt = item & 127, t0 = tt * 32, rowbase = b * SEQ;
    const bf16_t* P = (const bf16_t*)(p->ws + A_P);
    bf16_t* ymix = (bf16_t*)(p->ws + A_YMIX);
    float w[31];
#pragma unroll
    for (int k = 0; k < 31; ++k) w[k] = p->in[I_CONVA][(size_t)(l * 31 + k) * 256 + tid];
    float acc[32];
    const float bias = p->in[I_CONVAB][l * 256 + tid];
#pragma unroll
    for (int j = 0; j < 32; ++j) acc[j] = bias;
#pragma unroll
    for (int rr = 0; rr < 62; ++rr) {
        const int t = t0 - 30 + rr;
        const bf16_t* pr = P + ((long)(rowbase + t0 - 30) * PIN + tid) + (long)rr * PIN;
        const float val = bf2f(pr[0]), gate = bf2f(pr[256]);
        const float h = (t >= 0) ? val * sigm(gate) : 0.f;
#pragma unroll
        for (int j = 0; j < 32; ++j) { const int k = rr - j; if (k >= 0 && k <= 30) acc[j] = fmaf(w[k], h, acc[j]); }
    }
    float* outb = (float*)lds;
#pragma unroll
    for (int j = 0; j < 32; ++j) outb[j * 256 + tid] = acc[j];
    __syncthreads();
    const int wid = tid >> 6, lane = tid & 63;
    const float4 g4 = *(const float4*)(p->in[I_LNAG] + l * 256 + lane * 4), b4 = *(const float4*)(p->in[I_LNAB] + l * 256 + lane * 4);
    for (int j = wid; j < 32; j += 4) {
        const float4 v = *(const float4*)(outb + j * 256 + lane * 4);
        const float mean = wave_sum(v.x + v.y + v.z + v.w) * (1.f / 256.f);
        const float d0 = v.x - mean, d1 = v.y - mean, d2 = v.z - mean, d3 = v.w - mean;
        const float var = wave_sum(d0 * d0 + d1 * d1 + d2 * d2 + d3 * d3) * (1.f / 256.f);
        const float rs = rsqrtf(var + LN_EPS);
        float y0 = d0 * rs * g4.x + b4.x, y1 = d1 * rs * g4.y + b4.y, y2 = d2 * rs * g4.z + b4.z, y3 = d3 * rs * g4.w + b4.w;
        y0 *= sigm(y0); y1 *= sigm(y1); y2 *= sigm(y2); y3 *= sigm(y3);
        uint2 o; o.x = pack2(y0, y1); o.y = pack2(y2, y3);
        *(uint2*)(ymix + (size_t)(rowbase + t0 + j) * DM + lane * 4) = o;
    }
    __syncthreads();
}

DEVINL void b1_shortconv(KP p, int l, int item) {
    const int tid = TIDX(), cg = tid & 31, tl = tid >> 5, b = item >> 6, t0 = (item & 63) * 64 + tl * 8, rowbase = b * SEQ;
    const bf16_t* P = (const bf16_t*)(p->ws + A_P);
    bf16_t* ymix = (bf16_t*)(p->ws + A_YMIX);
    float w0[8], w1[8], w2[8];
#pragma unroll
    for (int e = 0; e < 8; ++e) { w0[e] = p->in[I_CONVD][(l * 3 + 0) * 256 + cg * 8 + e]; w1[e] = p->in[I_CONVD][(l * 3 + 1) * 256 + cg * 8 + e]; w2[e] = p->in[I_CONVD][(l * 3 + 2) * 256 + cg * 8 + e]; }
    uint4 gbv[8], gcv[10], hdv[10];
#pragma unroll
    for (int u = 0; u < 10; ++u) {
        const int t = t0 - 2 + u;
        const bf16_t* a = P + (size_t)(rowbase + (t >= 0 ? t : 0)) * PIN + 1920 + cg * 8;
        gcv[u] = *(const uint4*)(a + 256); hdv[u] = *(const uint4*)(a + 512);
        if (u >= 2) gbv[u - 2] = *(const uint4*)(a);
    }
    float q2[8], q1[8];
#pragma unroll
    for (int u = 0; u < 10; ++u) {
        const int t = t0 - 2 + u;
        const unsigned gcw[4] = {gcv[u].x, gcv[u].y, gcv[u].z, gcv[u].w}, hdw[4] = {hdv[u].x, hdv[u].y, hdv[u].z, hdv[u].w};
        float q0[8];
#pragma unroll
        for (int e = 0; e < 4; ++e) {
            q0[2 * e] = __uint_as_float(gcw[e] << 16) * __uint_as_float(hdw[e] << 16);
            q0[2 * e + 1] = __uint_as_float(gcw[e] & 0xFFFF0000u) * __uint_as_float(hdw[e] & 0xFFFF0000u);
        }
        if (t < 0) {
#pragma unroll
            for (int e = 0; e < 8; ++e) q0[e] = 0.f;
        }
        if (u >= 2) {
            const unsigned gbw[4] = {gbv[u - 2].x, gbv[u - 2].y, gbv[u - 2].z, gbv[u - 2].w};
            float y[8];
#pragma unroll
            for (int e = 0; e < 4; ++e) {
                y[2 * e] = __uint_as_float(gbw[e] << 16) * (w0[2 * e] * q2[2 * e] + w1[2 * e] * q1[2 * e] + w2[2 * e] * q0[2 * e]);
                y[2 * e + 1] = __uint_as_float(gbw[e] & 0xFFFF0000u) * (w0[2 * e + 1] * q2[2 * e + 1] + w1[2 * e + 1] * q1[2 * e + 1] + w2[2 * e + 1] * q0[2 * e + 1]);
            }
            *(uint4*)(ymix + (size_t)(rowbase + t) * DM + 768 + cg * 8) = make_uint4(pack2(y[0], y[1]), pack2(y[2], y[3]), pack2(y[4], y[5]), pack2(y[6], y[7]));
        }
#pragma unroll
        for (int e = 0; e < 8; ++e) { q2[e] = (u >= 1) ? q1[e] : 0.f; q1[e] = q0[e]; }
    }
}

DEVINL void b1_lru(KP p, int l, char* lds, int item) {
    const int c = TIDX(), b = item >> 7, tt = item & 127, t0 = tt * 32, rowbase = b * SEQ;
    const int h = c >> 6, lane = c & 63, r = lane & 31, hh = lane >> 5;
    const bf16_t* P = (const bf16_t*)(p->ws + A_P);
    constexpr int URS2 = 528;
    char* uA = lds;
    float ureg[32];
    {
        const float cb0 = p->in[I_CONVB][(l * 4 + 0) * 256 + c], cb1 = p->in[I_CONVB][(l * 4 + 1) * 256 + c], cb2 = p->in[I_CONVB][(l * 4 + 2) * 256 + c], cb3 = p->in[I_CONVB][(l * 4 + 3) * 256 + c];
        const float bias = p->in[I_CONVBB][l * 256 + c];
        float xm3 = 0.f, xm2 = 0.f, xm1 = 0.f;
        if (t0 >= 3) { const bf16_t* a = P + (size_t)(rowbase + t0 - 3) * PIN + 512 + c; xm3 = bf2f(a[0]); xm2 = bf2f(a[PIN]); xm1 = bf2f(a[2 * PIN]); }
        bf16_t xr[32];
#pragma unroll
        for (int j = 0; j < 32; ++j) xr[j] = P[(size_t)(rowbase + t0 + j) * PIN + 512 + c];
#pragma unroll
        for (int j = 0; j < 32; ++j) {
            const float x0 = bf2f(xr[j]);
            ureg[j] = cb0 * xm3 + cb1 * xm2 + cb2 * xm1 + cb3 * x0 + bias;
            *(bf16_t*)(uA + j * URS2 + c * 2) = f2bf(ureg[j]);
            xm3 = xm2; xm2 = xm1; xm1 = x0;
        }
    }
    __syncthreads();
    float ar[32], ai[32];
    {
        const bf16_t* wg = (const bf16_t*)(p->ws + OFF_WGT) + (size_t)((l * 4 + h) * 2) * 4096 + (size_t)r * 64 + 8 * hh;
        f32x16 aR0, aR1, aI0, aI1;
#pragma unroll
        for (int i = 0; i < 16; ++i) { aR0[i] = 0.f; aR1[i] = 0.f; aI0[i] = 0.f; aI1[i] = 0.f; }
#pragma unroll
        for (int ks = 0; ks < 4; ++ks) {
            const bf16x8 af = *(const bf16x8*)(uA + r * URS2 + (h * 64 + ks * 16 + 8 * hh) * 2);
            const bf16x8 r0 = *(const bf16x8*)(wg + ks * 16), r1 = *(const bf16x8*)(wg + 32 * 64 + ks * 16);
            const bf16x8 i0 = *(const bf16x8*)(wg + 4096 + ks * 16), i1 = *(const bf16x8*)(wg + 4096 + 32 * 64 + ks * 16);
            aR0 = MFMA32(af, r0, aR0); aR1 = MFMA32(af, r1, aR1); aI0 = MFMA32(af, i0, aI0); aI1 = MFMA32(af, i1, aI1);
        }
        __syncthreads();
        float* xch = (float*)(lds + 17408) + h * 2048;
#define XCHG(X0, X1, OUT) do { _Pragma("unroll") for (int i = 0; i < 16; ++i) { const int t_ = (i & 3) + 8 * (i >> 2) + 4 * hh; xch[t_ * 64 + r] = X0[i]; xch[t_ * 64 + 32 + r] = X1[i]; } \
        _Pragma("unroll") for (int t_ = 0; t_ < 32; ++t_) OUT[t_] = xch[t_ * 64 + lane]; } while (0)
        XCHG(aR0, aR1, ar); XCHG(aI0, aI1, ai);
#undef XCHG
    }
    const float brg = p->in[I_BRG][l * 256 + c], big = p->in[I_BIG][l * 256 + c];
    const float sp = softplus_acc(-p->in[I_LAMBDA][l * 256 + c]);
    unsigned* hp = (unsigned*)(p->ws + A_HLOC) + (size_t)(rowbase + t0) * 256 + c;
    float hs = 0.f, cA = 1.f;
#pragma unroll
    for (int j = 0; j < 32; ++j) {
        const float rg = sigm(ar[j] + brg), ig = sigm(ai[j] + big);
        const float log_a = -8.0f * rg * sp;
        const float a = __expf(log_a);
        const float mult = sqrtf(fmaxf(1.f - a * a, 0.f));
        const float bx = mult * (ig * ureg[j]);
        hs = fmaf(a, hs, bx); cA *= a;
        hp[j * 256] = pack2(hs, cA);
    }
    ((float*)(p->ws + A_CARRYA))[(size_t)(b * 128 + tt) * 256 + c] = cA;
    ((float*)(p->ws + A_CARRYH))[(size_t)(b * 128 + tt) * 256 + c] = hs;
    __syncthreads();
}

DEVINL void b1_rwkv(KP p, int l, char* lds, int item) {
    const int c = TIDX(), b = item >> 7, tt = item & 127, t0 = tt * 32, rowbase = b * SEQ;
    const bf16_t* P = (const bf16_t*)(p->ws + A_P);
    constexpr int FRS = 272;
    char* featA = lds;
    const float* muc = p->in[I_MUC] + l * 896;
    if (c < 128) {
        const int col = 1024 + 768 + c; const float mu = muc[768 + c];
        float prev;
        { const float x = bf2f(P[(size_t)(rowbase + (t0 > 0 ? t0 - 1 : 0)) * PIN + col]); prev = (t0 > 0) ? x : 0.f; }
#pragma unroll 1
        for (int jb = 0; jb < 2; ++jb) {
            bf16_t raw[16];
#pragma unroll
            for (int u = 0; u < 16; ++u) raw[u] = P[(size_t)(rowbase + t0 + jb * 16 + u) * PIN + col];
#pragma unroll
            for (int u = 0; u < 16; ++u) {
                const float cur = bf2f(raw[u]);
                const float xs = cur + (prev - cur) * mu;
                const float val = (c < 32) ? tanh_fast(xs) : ((c < 64) ? xs : sigm(xs));
                *(bf16_t*)(featA + (jb * 16 + u) * FRS + c * 2) = f2bf(val); prev = cur;
            }
        }
    }
    __syncthreads();
    float dec[32], aa[32];
    {
        const int lane = c & 63, h = c >> 6, r = lane & 31, hh = lane >> 5;
        const bf16_t* wl = (const bf16_t*)(p->ws + OFF_WLT) + (size_t)(l * 256 + h * 64 + r) * 128 + 8 * hh;
        f32x16 aW0, aW1, aA0, aA1, aG0, aG1;
#pragma unroll
        for (int i = 0; i < 16; ++i) { aW0[i] = 0.f; aW1[i] = 0.f; aA0[i] = 0.f; aA1[i] = 0.f; aG0[i] = 0.f; aG1[i] = 0.f; }
        bf16x8 b0[8], b1[8];
#pragma unroll
        for (int ks = 0; ks < 8; ++ks) { b0[ks] = *(const bf16x8*)(wl + ks * 16); b1[ks] = *(const bf16x8*)(wl + 32 * 128 + ks * 16); }
#pragma unroll
        for (int ks = 0; ks < 8; ++ks) {
            const bf16x8 af = *(const bf16x8*)(featA + r * FRS + (ks * 16 + 8 * hh) * 2);
            if (ks < 2) { aW0 = MFMA32(af, b0[ks], aW0); aW1 = MFMA32(af, b1[ks], aW1); }
            else if (ks < 4) { aA0 = MFMA32(af, b0[ks], aA0); aA1 = MFMA32(af, b1[ks], aA1); }
            else { aG0 = MFMA32(af, b0[ks], aG0); aG1 = MFMA32(af, b1[ks], aG1); }
        }
        __syncthreads();
        float* xch = (float*)(lds + 9216) + h * 2048;
        float lwv[32], lav[32], lgv[32];
#define XCHG(X0, X1, OUT) do { _Pragma("unroll") for (int i = 0; i < 16; ++i) { const int t_ = (i & 3) + 8 * (i >> 2) + 4 * hh; xch[t_ * 64 + r] = X0[i]; xch[t_ * 64 + 32 + r] = X1[i]; } \
        _Pragma("unroll") for (int t_ = 0; t_ < 32; ++t_) OUT[t_] = xch[t_ * 64 + lane]; } while (0)
        XCHG(aW0, aW1, lwv); XCHG(aA0, aA1, lav); XCHG(aG0, aG1, lgv);
#undef XCHG
#define TOK(X0, X1, t) X0[t]
#define aW0 lwv
#define aA0 lav
#define aG0 lgv
        bf16_t* gbuf = (bf16_t*)(p->ws + A_G);
        const float w0 = p->in[I_W0][l * 256 + c], a0 = p->in[I_A0][l * 256 + c];
#pragma unroll
        for (int j = 0; j < 32; ++j) {
            gbuf[(size_t)(rowbase + t0 + j) * 256 + c] = f2bf(TOK(aG0, aG1, j));
            const float z = w0 + TOK(aW0, aW1, j); const float wlog = -softplusf(-z) - 0.5f; dec[j] = -__expf(wlog);
            aa[j] = sigm(a0 + TOK(aA0, aA1, j));
        }
#undef TOK
#undef aW0
#undef aA0
#undef aG0
    }
    {
        bf16_t* bonus = (bf16_t*)(p->ws + A_BONUS); uint4* scan = (uint4*)(p->ws + A_SCAN);
        const float mur = muc[c], muk = muc[256 + c], muv = muc[512 + c];
        const float kkw = p->in[I_KK][l * 256 + c], kaw = p->in[I_KA][l * 256 + c], rkw = p->in[I_RK][l * 256 + c];
        float pr, pk, pv;
        { const bf16_t* a = P + (size_t)(rowbase + (t0 > 0 ? t0 - 1 : 0)) * PIN + 1024 + c; const float x0 = bf2f(a[0]), x1 = bf2f(a[256]), x2 = bf2f(a[512]);
          pr = (t0 > 0) ? x0 : 0.f; pk = (t0 > 0) ? x1 : 0.f; pv = (t0 > 0) ? x2 : 0.f; }
#pragma unroll
        for (int jb = 0; jb < 2; ++jb) {
            bf16_t rr_[16], rk_[16], rv_[16];
#pragma unroll
            for (int u = 0; u < 16; ++u) { const bf16_t* a = P + (size_t)(rowbase + t0 + jb * 16 + u) * PIN + 1024 + c; rr_[u] = a[0]; rk_[u] = a[256]; rv_[u] = a[512]; }
#pragma unroll
            for (int u = 0; u < 16; ++u) {
                const int j = jb * 16 + u;
                const size_t row = (size_t)(rowbase + t0 + j);
                const float cr = bf2f(rr_[u]), ck = bf2f(rk_[u]), cv = bf2f(rv_[u]);
                const float r = cr + (pr - cr) * mur, k = ck + (pk - ck) * muk, v = cv + (pv - cv) * muv;
                pr = cr; pk = ck; pv = cv;
                const float kk = k * kkw;
                const float ss = wave_sum(kk * kk);
                const float kkn = kk * rsqrtf(ss + 1e-12f);
                const float kf = k * (1.f + (aa[j] - 1.f) * kaw);
                const float bs = wave_sum(r * kf * rkw);
                bonus[row * 256 + c] = f2bf(bs * v);
                uint4 o; o.x = pack2(kkn, kkn * aa[j]); o.y = pack2(kf, r); o.z = pack2(v, 0.f); o.w = __float_as_uint(dec[j]);
                scan[row * 256 + c] = o;
            }
            asm volatile("" ::: "memory");
        }
    }
    __syncthreads();
}

constexpr int S_AL = 0, S_BE = 8192, S_KA = 16384, S_RH = 24576, S_BET = 32768, S_KAT = 40960, S_VT = 49152, S_L2F = 57344  , S_GT = 73728  ;
constexpr int S_L1F = S_BE;
constexpr int S_M1 = S_BE, S_M2 = S_KA;
constexpr int S_APT = S_L2F, S_W2T = S_L2F + 8192;
constexpr int S_RP = S_AL, S_GTR = S_RH;
DEVINL int crow32(int reg, int h) { return (reg & 3) + 8 * (reg >> 2) + 4 * h; }
DEVINL bf16x8 frag64(const char* lds, int slot, int row, int kel) { return *reinterpret_cast<const bf16x8*>(lds + slot + row * 128 + kel * 2); }
DEVINL float dpp_xor1(float x) { return __builtin_bit_cast(float, __builtin_amdgcn_update_dpp(0, __builtin_bit_cast(int, x), 0xB1, 0xf, 0xf, true)); }

DEVINL f32x16 mm64(const char* lds, int slotA, int slotB, int tm, int tn, int r, int hh, f32x16 acc) {
#pragma unroll
    for (int ks = 0; ks < 4; ++ks) acc = MFMA32(frag64(lds, slotA, tm * 32 + r, ks * 16 + 8 * hh), frag64(lds, slotB, tn * 32 + r, ks * 16 + 8 * hh), acc);
    return acc;
}

DEVINL void b1e_unit(KP p, char* lds, int b, int h, int c) {
    const int tid = TIDX(), wv = tid >> 6, lane = tid & 63, r = lane & 31, hh = lane >> 5;
    const uint4* scan = (const uint4*)(p->ws + A_SCAN) + ((size_t)(b * SEQ + c * 64)) * 256 + h * 64;
    float* gtot = (float*)(lds + S_GT); float* gamC = gtot + 256;
    {
        const int j = lane;
        float lw[16]; unsigned px[16], py[16], pz[16];
#pragma unroll
        for (int u = 0; u < 16; ++u) { const uint4 q = scan[(size_t)(wv * 16 + u) * 256 + j]; px[u] = q.x; py[u] = q.y; pz[u] = q.z; lw[u] = __uint_as_float(q.w); }
        float tot = 0.f;
#pragma unroll
        for (int u = 0; u < 16; ++u) tot += lw[u];
        gtot[wv * 64 + j] = tot;
        __syncthreads();
        float off = 0.f, all = 0.f;
#pragma unroll
        for (int g = 0; g < 4; ++g) { const float v = gtot[g * 64 + j]; all += v; off += (g < wv) ? v : 0.f; }
        if (wv == 0) gamC[j] = __expf(all);
        float cum = off;
        unsigned tb[8], tk[8], tv[8];
#pragma unroll
        for (int u = 0; u < 16; ++u) {
            const float kkn = __uint_as_float(px[u] << 16), bb = __uint_as_float(px[u] & 0xFFFF0000u);
            const float kf = __uint_as_float(py[u] << 16), rr = __uint_as_float(py[u] & 0xFFFF0000u);
            const float gp = __expf(cum); cum += lw[u];
            const float g = __expf(cum), en = __expf(-cum);
            const int t = wv * 16 + u;
            const unsigned be = f2bf(bb * en), ka = f2bf(kf * en);
            *(bf16_t*)(lds + S_AL + t * 128 + j * 2) = f2bf(gp * kkn);
            *(bf16_t*)(lds + S_BE + t * 128 + j * 2) = (bf16_t)be;
            *(bf16_t*)(lds + S_KA + t * 128 + j * 2) = (bf16_t)ka;
            *(bf16_t*)(lds + S_RH + t * 128 + j * 2) = f2bf(g * rr);
            if (u & 1) { tb[u >> 1] |= be << 16; tk[u >> 1] |= ka << 16; tv[u >> 1] |= (pz[u] << 16); }
            else { tb[u >> 1] = be; tk[u >> 1] = ka; tv[u >> 1] = pz[u] & 0xFFFFu; }
        }
        *(uint4*)(lds + S_BET + j * 128 + wv * 32) = make_uint4(tb[0], tb[1], tb[2], tb[3]); *(uint4*)(lds + S_BET + j * 128 + wv * 32 + 16) = make_uint4(tb[4], tb[5], tb[6], tb[7]);
        *(uint4*)(lds + S_KAT + j * 128 + wv * 32) = make_uint4(tk[0], tk[1], tk[2], tk[3]); *(uint4*)(lds + S_KAT + j * 128 + wv * 32 + 16) = make_uint4(tk[4], tk[5], tk[6], tk[7]);
        *(uint4*)(lds + S_VT + j * 128 + wv * 32) = make_uint4(tv[0], tv[1], tv[2], tv[3]); *(uint4*)(lds + S_VT + j * 128 + wv * 32 + 16) = make_uint4(tv[4], tv[5], tv[6], tv[7]);
    }
    __syncthreads();
    const int tm = wv >> 1, tn = wv & 1;
    f32x16 aM1, aM2;
    {
        f32x16 aL1, aL2;
#pragma unroll
        for (int i = 0; i < 16; ++i) { aL1[i] = 0.f; aL2[i] = 0.f; aM1[i] = 0.f; aM2[i] = 0.f; }
#pragma unroll
        for (int ks = 0; ks < 4; ++ks) {
            const bf16x8 fa = frag64(lds, S_AL, tm * 32 + r, ks * 16 + 8 * hh), fr = frag64(lds, S_RH, tm * 32 + r, ks * 16 + 8 * hh);
            const bf16x8 fb = frag64(lds, S_BE, tn * 32 + r, ks * 16 + 8 * hh), fk = frag64(lds, S_KA, tn * 32 + r, ks * 16 + 8 * hh);
            aL1 = MFMA32(fa, fb, aL1); aL2 = MFMA32(fa, fk, aL2); aM1 = MFMA32(fr, fb, aM1); aM2 = MFMA32(fr, fk, aM2);
        }
        __syncthreads();
#pragma unroll
        for (int reg = 0; reg < 16; ++reg) {
            const int t = tm * 32 + crow32(reg, hh), sidx = tn * 32 + r;
            const int o = (t * 64 + (sidx & 1) * 32 + (sidx >> 1)) * 4;
            *(float*)(lds + S_L1F + o) = (sidx < t) ? aL1[reg] : 0.f;
            *(float*)(lds + S_L2F + o) = (sidx < t) ? aL2[reg] : 0.f;
            aM1[reg] = (sidx <= t) ? aM1[reg] : 0.f; aM2[reg] = (sidx <= t) ? aM2[reg] : 0.f;
        }
    }
    __syncthreads();
    unsigned outp[32];
    {
        const int col = (wv & 1) * 32 + (lane >> 1), q = lane & 1;
        float xq[32];
#pragma unroll
        for (int k = 0; k < 32; ++k) xq[k] = 0.f;
        const char* l1row = lds + S_L1F + q * 128;
        const char* l2row = lds + S_L2F + q * 128;
        if (wv < 2) {
#pragma unroll
            for (int t = 0; t < 64; ++t) {
                float acc = 0.f;
#pragma unroll
                for (int k4 = 0; k4 * 4 < (t + 1) / 2; ++k4) {
                    const float4 a = *(const float4*)(l1row + t * 256 + k4 * 16);
                    acc = fmaf(a.x, xq[4 * k4 + 0], acc); acc = fmaf(a.y, xq[4 * k4 + 1], acc); acc = fmaf(a.z, xq[4 * k4 + 2], acc); acc = fmaf(a.w, xq[4 * k4 + 3], acc);
                }
                acc += dpp_xor1(acc);
                const float x = bf2f(*(const bf16_t*)(lds + S_AL + t * 128 + col * 2)) - acc;
                xq[t >> 1] = ((t & 1) == q) ? x : xq[t >> 1];
            }
        } else {
            float vq[32];
#pragma unroll
            for (int k8 = 0; k8 < 8; ++k8) {
                const uint4 d = *(const uint4*)(lds + S_VT + col * 128 + k8 * 16);
                vq[4 * k8 + 0] = q ? __uint_as_float(d.x & 0xFFFF0000u) : __uint_as_float(d.x << 16);
                vq[4 * k8 + 1] = q ? __uint_as_float(d.y & 0xFFFF0000u) : __uint_as_float(d.y << 16);
                vq[4 * k8 + 2] = q ? __uint_as_float(d.z & 0xFFFF0000u) : __uint_as_float(d.z << 16);
                vq[4 * k8 + 3] = q ? __uint_as_float(d.w & 0xFFFF0000u) : __uint_as_float(d.w << 16);
            }
#pragma unroll
            for (int t = 0; t < 64; ++t) {
                float acc = 0.f;
#pragma unroll
                for (int k4 = 0; k4 * 4 < (t + 1) / 2; ++k4) {
                    const float4 a = *(const float4*)(l1row + t * 256 + k4 * 16);
                    const float4 bq = *(const float4*)(l2row + t * 256 + k4 * 16);
                    acc = fmaf(bq.x, vq[4 * k4 + 0], acc); acc = fmaf(bq.y, vq[4 * k4 + 1], acc); acc = fmaf(bq.z, vq[4 * k4 + 2], acc); acc = fmaf(bq.w, vq[4 * k4 + 3], acc);
                    acc = fmaf(-a.x, xq[4 * k4 + 0], acc); acc = fmaf(-a.y, xq[4 * k4 + 1], acc); acc = fmaf(-a.z, xq[4 * k4 + 2], acc); acc = fmaf(-a.w, xq[4 * k4 + 3], acc);
                }
                acc += dpp_xor1(acc);
                xq[t >> 1] = ((t & 1) == q) ? acc : xq[t >> 1];
            }
        }
#pragma unroll
        for (int k = 0; k < 32; ++k) { const float o = dpp_xor1(xq[k]); outp[k] = q ? pack2(o, xq[k]) : pack2(xq[k], o); }
    }
    __syncthreads();
    {
        const int col = (wv & 1) * 32 + (lane >> 1), q = lane & 1;
        char* dst = lds + ((wv < 2) ? S_APT : S_W2T) + col * 128 + q * 64;
#pragma unroll
        for (int i = 0; i < 4; ++i) *(uint4*)(dst + i * 16) = q ? make_uint4(outp[16 + 4 * i], outp[17 + 4 * i], outp[18 + 4 * i], outp[19 + 4 * i]) : make_uint4(outp[4 * i], outp[4 * i + 1], outp[4 * i + 2], outp[4 * i + 3]);
#pragma unroll
        for (int reg = 0; reg < 16; ++reg) {
            const int t = tm * 32 + crow32(reg, hh), sidx = tn * 32 + r;
            *(bf16_t*)(lds + S_M1 + t * 128 + sidx * 2) = f2bf(aM1[reg]);
            *(bf16_t*)(lds + S_M2 + t * 128 + sidx * 2) = f2bf(aM2[reg]);
        }
    }
    __syncthreads();
    unsigned char* ubase = p->ws + A_CHAIN + (size_t)((b * 4 + h) * 64 + c) * CHAIN_UNIT;
    f32x16 zero;
#pragma unroll
    for (int i = 0; i < 16; ++i) zero[i] = 0.f;
    f32x16 gt;
    {
        const f32x16 qv = mm64(lds, S_M1, S_APT, tm, tn, r, hh, zero);
        const f32x16 y0 = mm64(lds, S_M2, S_VT, tm, tn, r, hh, zero) - mm64(lds, S_M1, S_W2T, tm, tn, r, hh, zero);
        gt = mm64(lds, S_BET, S_APT, tm, tn, r, hh, zero);
        const f32x16 ht = mm64(lds, S_KAT, S_VT, tm, tn, r, hh, zero) - mm64(lds, S_BET, S_W2T, tm, tn, r, hh, zero);
#pragma unroll
        for (int reg = 0; reg < 16; ++reg) {
            const int t = tm * 32 + crow32(reg, hh), jc = tn * 32 + r;
            const float rh = bf2f(*(const bf16_t*)(lds + S_RH + t * 128 + jc * 2));
            *(bf16_t*)(lds + S_RP + t * 128 + jc * 2) = f2bf(rh - qv[reg]);
            const int jr = tm * 32 + crow32(reg, hh);
            const float gc = gamC[jr];
            gt[reg] = gc * (((jr == jc) ? 1.f : 0.f) - gt[reg]);
        }
        float4* himg = (float4*)(ubase + 16384); float4* yimg = (float4*)(ubase + 32768);
#pragma unroll
        for (int rq = 0; rq < 4; ++rq) {
            float4 hv, yv;
            hv.x = gamC[tm * 32 + crow32(4 * rq + 0, hh)] * ht[4 * rq + 0]; hv.y = gamC[tm * 32 + crow32(4 * rq + 1, hh)] * ht[4 * rq + 1];
            hv.z = gamC[tm * 32 + crow32(4 * rq + 2, hh)] * ht[4 * rq + 2]; hv.w = gamC[tm * 32 + crow32(4 * rq + 3, hh)] * ht[4 * rq + 3];
            yv.x = y0[4 * rq + 0]; yv.y = y0[4 * rq + 1]; yv.z = y0[4 * rq + 2]; yv.w = y0[4 * rq + 3];
            himg[((tn * 2 + tm) * 4 + rq) * 64 + lane] = hv;
            yimg[((tn * 2 + tm) * 4 + rq) * 64 + lane] = yv;
        }
    }
    __syncthreads();
#pragma unroll
    for (int reg = 0; reg < 16; ++reg) {
        const int jr = tm * 32 + crow32(reg, hh), jc = tn * 32 + r;
        *(bf16_t*)(lds + S_GTR + jr * 128 + jc * 2) = f2bf(gt[reg]);
    }
    __syncthreads();
    {
        uint4* gimg = (uint4*)(ubase); uint4* rimg = (uint4*)(ubase + 8192);
#pragma unroll
        for (int ii = 0; ii < 2; ++ii) {
            const int im = wv * 2 + ii, mt = im >> 2, jb = (im >> 1) & 1, s2 = im & 1;
            const int cbase = (32 * jb + 16 * s2 + 4 * hh) * 2;
            const uint2 g0 = *(const uint2*)(lds + S_GTR + (mt * 32 + r) * 128 + cbase), g1 = *(const uint2*)(lds + S_GTR + (mt * 32 + r) * 128 + cbase + 16);
            const uint2 r0 = *(const uint2*)(lds + S_RP + (mt * 32 + r) * 128 + cbase), r1 = *(const uint2*)(lds + S_RP + (mt * 32 + r) * 128 + cbase + 16);
            gimg[im * 64 + lane] = make_uint4(g0.x, g0.y, g1.x, g1.y);
            rimg[im * 64 + lane] = make_uint4(r0.x, r0.y, r1.x, r1.y);
        }
    }
    __syncthreads();
}

DEVINL void phaseB1(KP p, int l, char* lds, const int mask = 15, const int sub = 3) {
    const int nb = NBV();
    if (mask & 1) {
        const int blk = BIDX();
        for (int it = blk; it < 512; it += nb) {
            if (sub & 1) { b1_rwkv(p, l, lds, it * 2); b1_rwkv(p, l, lds, it * 2 + 1); }
            __threadfence_block(); __syncthreads();
            const int b = it >> 6, c = it & 63;
            if (sub & 2) {
#pragma unroll 1
                for (int h = 0; h < 4; ++h) b1e_unit(p, lds, b, h, c);
            }
        }
    }
    if (mask & 2) { const int blk = BIDX(); for (int it = blk; it < 1024; it += nb) b1_lru(p, l, lds, it); }
    if (mask & 4) { const int blk = BIDX(); for (int it = blk; it < 1024; it += nb) b1_conformer(p, l, lds, it); }
    if (mask & 8) { const int blk = BIDX(); for (int it = blk; it < 512; it += nb) b1_shortconv(p, l, it); }
}

DEVINL void phaseB2(KP p, int l, char* lds) {
    const int tid = TIDX(), blk = BIDX();
    if (blk < 64 && tid < 64) {
        const int lane = tid, r = lane & 31, hh = lane >> 5;
        const int bh = blk >> 1, w = blk & 1, b = bh >> 2, h = bh & 3;
        float* yraw = (float*)(p->ws + A_YRAW) + (size_t)b * SEQ * 256 + h * 64 + 32 * w + r;
        f32x16 X0, X1;
#pragma unroll
        for (int i = 0; i < 16; ++i) { X0[i] = 0.f; X1[i] = 0.f; }
        auto issue = [&](int c, char* buf) {
            const unsigned char* ubase = p->ws + A_CHAIN + (size_t)(bh * 64 + c) * CHAIN_UNIT;
#pragma unroll
            for (int i = 0; i < 8; ++i) {
                __builtin_amdgcn_global_load_lds((const unsigned*)(ubase + i * 1024 + lane * 16), (unsigned*)(buf + i * 1024 + lane * 16), 16, 0, 0);
                __builtin_amdgcn_global_load_lds((const unsigned*)(ubase + 8192 + i * 1024 + lane * 16), (unsigned*)(buf + 8192 + i * 1024 + lane * 16), 16, 0, 0);
                __builtin_amdgcn_global_load_lds((const unsigned*)(ubase + 16384 + (w * 8 + i) * 1024 + lane * 16), (unsigned*)(buf + 16384 + i * 1024 + lane * 16), 16, 0, 0);
                __builtin_amdgcn_global_load_lds((const unsigned*)(ubase + 32768 + (w * 8 + i) * 1024 + lane * 16), (unsigned*)(buf + 24576 + i * 1024 + lane * 16), 16, 0, 0);
            }
        };
        issue(0, lds);
        for (int c = 0; c < 64; ++c) {
            char* buf = lds + (c & 1) * 32768;
            if (c + 1 < 64) { issue(c + 1, lds + ((c + 1) & 1) * 32768); asm volatile("s_waitcnt vmcnt(32)" ::: "memory"); }
            else asm volatile("s_waitcnt vmcnt(0)" ::: "memory");
            uint4 gq[8], rq8[8]; float4 hq[8], yq[8];
#pragma unroll
            for (int i = 0; i < 8; ++i) { gq[i] = *(const uint4*)(buf + i * 1024 + lane * 16); rq8[i] = *(const uint4*)(buf + 8192 + i * 1024 + lane * 16); }
#pragma unroll
            for (int i = 0; i < 8; ++i) { hq[i] = *(const float4*)(buf + 16384 + i * 1024 + lane * 16); yq[i] = *(const float4*)(buf + 24576 + i * 1024 + lane * 16); }
            bf16x8 xp[4];
#pragma unroll
            for (int s2 = 0; s2 < 2; ++s2) {
                uint4 a, bq;
                a.x = pack2(X0[8 * s2 + 0], X0[8 * s2 + 1]); a.y = pack2(X0[8 * s2 + 2], X0[8 * s2 + 3]); a.z = pack2(X0[8 * s2 + 4], X0[8 * s2 + 5]); a.w = pack2(X0[8 * s2 + 6], X0[8 * s2 + 7]);
                bq.x = pack2(X1[8 * s2 + 0], X1[8 * s2 + 1]); bq.y = pack2(X1[8 * s2 + 2], X1[8 * s2 + 3]); bq.z = pack2(X1[8 * s2 + 4], X1[8 * s2 + 5]); bq.w = pack2(X1[8 * s2 + 6], X1[8 * s2 + 7]);
                xp[s2] = __builtin_bit_cast(bf16x8, a); xp[2 + s2] = __builtin_bit_cast(bf16x8, bq);
            }
#pragma unroll
            for (int mt = 0; mt < 2; ++mt) {
                f32x16 acc;
#pragma unroll
                for (int i = 0; i < 4; ++i) { acc[4 * i] = yq[mt * 4 + i].x; acc[4 * i + 1] = yq[mt * 4 + i].y; acc[4 * i + 2] = yq[mt * 4 + i].z; acc[4 * i + 3] = yq[mt * 4 + i].w; }
#pragma unroll
                for (int f = 0; f < 4; ++f) acc = MFMA32(__builtin_bit_cast(bf16x8, rq8[mt * 4 + f]), xp[f], acc);
#pragma unroll
                for (int reg = 0; reg < 16; ++reg) yraw[(size_t)(c * 64 + mt * 32 + crow32(reg, hh)) * 256] = acc[reg];
            }
            f32x16 n0, n1;
#pragma unroll
            for (int i = 0; i < 4; ++i) { n0[4 * i] = hq[i].x; n0[4 * i + 1] = hq[i].y; n0[4 * i + 2] = hq[i].z; n0[4 * i + 3] = hq[i].w;
                                          n1[4 * i] = hq[4 + i].x; n1[4 * i + 1] = hq[4 + i].y; n1[4 * i + 2] = hq[4 + i].z; n1[4 * i + 3] = hq[4 + i].w; }
#pragma unroll
            for (int f = 0; f < 4; ++f) { n0 = MFMA32(__builtin_bit_cast(bf16x8, gq[f]), xp[f], n0); n1 = MFMA32(__builtin_bit_cast(bf16x8, gq[4 + f]), xp[f], n1); }
            X0 = n0; X1 = n1;
        }
    }
}

DEVINL void phaseMix(KP p, int l, char* lds, const int which) {
    const int blk = BIDX(), wg = blk >> 1, half = blk & 1;
    if (wg < 32) { if (which == 0) phaseB2(p, l, lds); return; }
    const int w = wg - 32, NW = 224;
    if (which == 0) { for (int pr = w; pr < 512; pr += NW) b1_lru(p, l, lds, pr * 2 + half); }
    else if (which == 1) { for (int pr = (w + 160) % NW; pr < 512; pr += NW) b1_conformer(p, l, lds, pr * 2 + half); }
    else { for (int pr = (w + 96) % NW; pr < 256; pr += NW) b1_shortconv(p, l, pr * 2 + half); }
}

DEVINL void phaseB3(KP p, int l) {
    const int c = TIDX(), nb = NBV(), blk = BIDX();
    const bf16_t* P = (const bf16_t*)(p->ws + A_P);
    bf16_t* ymix = (bf16_t*)(p->ws + A_YMIX);
    const float* yraw = (const float*)(p->ws + A_YRAW); const bf16_t* bonus = (const bf16_t*)(p->ws + A_BONUS); const bf16_t* gbuf = (const bf16_t*)(p->ws + A_G);
    const unsigned* hcbuf = (const unsigned*)(p->ws + A_HLOC);
    const float gng = p->in[I_GNG][l * 256 + c], gnb = p->in[I_GNB][l * 256 + c];
    for (int it = blk; it < 512; it += nb) {
        float hst0, hst1;
        {
            const int bq = (it * 64) >> 12, tt0 = ((it * 64) & 4095) >> 5;
            const float* ca = (const float*)(p->ws + A_CARRYA) + (size_t)bq * 128 * 256 + c;
            const float* ch = (const float*)(p->ws + A_CARRYH) + (size_t)bq * 128 * 256 + c;
            float hs = 0.f;
#pragma unroll 16
            for (int tq = 0; tq < tt0; ++tq) hs = fmaf(ca[tq * 256], hs, ch[tq * 256]);
            hst0 = hs; hst1 = fmaf(ca[tt0 * 256], hs, ch[tt0 * 256]);
        }
#pragma unroll 1
        for (int r8 = 0; r8 < 64; r8 += 8) {
            float yv[8]; bf16_t bo[8], gg[8], gbv[8]; unsigned hcv[8]; float hsv[8];
#pragma unroll
            for (int u = 0; u < 8; ++u) {
                const int row = it * 64 + r8 + u, b = row >> 12, tt = (row & 4095) >> 5;
                const size_t o = (size_t)row * 256 + c;
                yv[u] = yraw[o]; bo[u] = bonus[o]; gg[u] = gbuf[o]; hcv[u] = hcbuf[o]; hsv[u] = (r8 < 32) ? hst0 : hst1; (void)b; (void)tt;
                gbv[u] = P[(size_t)row * PIN + 768 + c];
            }
#pragma unroll
            for (int u = 0; u < 8; ++u) {
                const int row = it * 64 + r8 + u;
                const float y = yv[u];
                const float mu = wave_sum(y) * (1.f / 64.f);
                const float d = y - mu;
                const float var = wave_sum(d * d) * (1.f / 64.f);
                const float yn = d * rsqrtf(var + GN_EPS) * gng + gnb;
                ymix[(size_t)row * DM + 512 + c] = f2bf((yn + bf2f(bo[u])) * bf2f(gg[u]));
                const float hh = fmaf(__uint_as_float(hcv[u] & 0xFFFF0000u), hsv[u], __uint_as_float(hcv[u] << 16));
                ymix[(size_t)row * DM + 256 + c] = f2bf(hh * gelu_tanh(bf2f(gbv[u])));
            }
        }
    }
}

DEVINL void phaseD(KP p, int l, char* lds, const int dry = 0) {
    const int tid = TIDX(), nb = NBV(), blk = BIDX(), wid = tid >> 6, lane = tid & 63;
    constexpr int URS = 2064;
    char* uh = lds;
    char* ulo = lds + 16 * URS;
    float* logit = (float*)(lds + 32 * URS);
    int* sel_e = (int*)(lds + 32 * URS + 4096);
    int* lpos = sel_e + 512;
    int* hist = lpos + 512;
    int* basep = hist + 64;
    const bf16_t* wrt_hi = (const bf16_t*)(p->ws + OFF_WR) + (size_t)(l * 2 + 0) * 64 * 1024;
    const bf16_t* wrt_lo = (const bf16_t*)(p->ws + OFF_WR) + (size_t)(l * 2 + 1) * 64 * 1024;
    const bf16_t* zbuf = (const bf16_t*)(p->ws + M_ZB);
    float2* lnstat = (float2*)(p->ws + M_STAT);
    bf16_t* ubuf = (bf16_t*)(p->ws + (dry ? A_YMIX : OFF_UBUF));
    const float* mod = (const float*)(p->ws + OFF_MOD);
    const float* wr = p->in[I_WROUTER] + (size_t)l * 1024 * 64 + lane;
    const float ebias = p->in[I_EBIAS][l * 64 + lane];
    unsigned* cnt = (unsigned*)(p->ws + OFF_CNT) + l * 64 + (dry ? 256 : 0);
    int* list = (int*)(p->ws + (dry ? M_HBUF : M_LIST));
    float* wsel = (float*)(p->ws + (dry ? M_HBUF + 16777216 : M_WSEL));
    int* pmap = (int*)(p->ws + (dry ? M_HBUF + 33554432 : M_PMAP));
    for (int it = blk; it < 512; it += nb) {
        const int tok0 = it * 64;
        if (tid < 64) hist[tid] = 0;
        for (int sb = 0; sb < 4; ++sb) {
#pragma unroll
            for (int j = 0; j < 4; ++j) {
                const int tl = wid * 4 + j, row = tok0 + sb * 16 + tl, b = row >> 12;
                float4 z[4];
                float s = 0.f;
#pragma unroll
                for (int i = 0; i < 4; ++i) { const uint2 zv = *(const uint2*)(zbuf + (size_t)row * DM + i * 256 + lane * 4);
                    z[i].x = __uint_as_float(zv.x << 16); z[i].y = __uint_as_float(zv.x & 0xFFFF0000u); z[i].z = __uint_as_float(zv.y << 16); z[i].w = __uint_as_float(zv.y & 0xFFFF0000u); s += z[i].x + z[i].y + z[i].z + z[i].w; }
                const float mean = wave_sum(s) * (1.f / 1024.f);
                float q = 0.f;
#pragma unroll
                for (int i = 0; i < 4; ++i) { z[i].x -= mean; z[i].y -= mean; z[i].z -= mean; z[i].w -= mean; q += z[i].x * z[i].x + z[i].y * z[i].y + z[i].z * z[i].z + z[i].w * z[i].w; }
                const float rs = rsqrtf(wave_sum(q) * (1.f / 1024.f) + LN_EPS);
                if (lane == 0) lnstat[row] = make_float2(mean, rs);
#pragma unroll
                for (int i = 0; i < 4; ++i) {
                    const int col = i * 256 + lane * 4;
                    const float4 g = *(const float4*)(p->in[I_LN1G] + l * 1024 + col), bb = *(const float4*)(p->in[I_LN1B] + l * 1024 + col);
                    const float4 sh = *(const float4*)(mod + (size_t)(l * 8 + b) * 6144 + 3072 + col), sc = *(const float4*)(mod + (size_t)(l * 8 + b) * 6144 + 4096 + col);
                    float4 x1; x1.x = z[i].x * rs * g.x + bb.x; x1.y = z[i].y * rs * g.y + bb.y; x1.z = z[i].z * rs * g.z + bb.z; x1.w = z[i].w * rs * g.w + bb.w;
                    float4 u; u.x = x1.x * (1.f + sc.x) + sh.x; u.y = x1.y * (1.f + sc.y) + sh.y; u.z = x1.z * (1.f + sc.z) + sh.z; u.w = x1.w * (1.f + sc.w) + sh.w;
                    uint2 o; o.x = pack2(u.x, u.y); o.y = pack2(u.z, u.w);
                    { int w8 = __builtin_amdgcn_cvt_pk_fp8_f32(u.x, u.y, 0, false); w8 = __builtin_amdgcn_cvt_pk_fp8_f32(u.z, u.w, w8, true);
                      *(int*)((char*)ubuf + (size_t)row * DM + col) = w8; }
                    *(uint2*)(uh + tl * URS + col * 2) = o;
                    uint2 o2; o2.x = pack2(u.x - __uint_as_float(o.x << 16), u.y - __uint_as_float(o.x & 0xFFFF0000u)); o2.y = pack2(u.z - __uint_as_float(o.y << 16), u.w - __uint_as_float(o.y & 0xFFFF0000u));
                    *(uint2*)(ulo + tl * URS + col * 2) = o2;
                }
            }
            __syncthreads();
            {
                const int fr = lane & 15, fq = lane >> 4;
                f32x4 lacc = (f32x4){0.f, 0.f, 0.f, 0.f};
                const bf16_t* bh = wrt_hi + (size_t)(wid * 16 + fr) * 1024 + fq * 8;
                const bf16_t* bl = wrt_lo + (size_t)(wid * 16 + fr) * 1024 + fq * 8;
#pragma unroll 1
                for (int k8 = 0; k8 < 4; ++k8) {
                    bf16x8 bhv[8], blv[8];
#pragma unroll
                    for (int kk = 0; kk < 8; ++kk) { bhv[kk] = *(const bf16x8*)(bh + (k8 * 8 + kk) * 32); blv[kk] = *(const bf16x8*)(bl + (k8 * 8 + kk) * 32); }
#pragma unroll
                    for (int kk = 0; kk < 8; ++kk) {
                        const int ko = (k8 * 8 + kk) * 64 + fq * 16;
                        const bf16x8 ah = *(const bf16x8*)(uh + fr * URS + ko), al = *(const bf16x8*)(ulo + fr * URS + ko);
                        lacc = __builtin_amdgcn_mfma_f32_16x16x32_bf16(ah, bhv[kk], lacc, 0, 0, 0);
                        lacc = __builtin_amdgcn_mfma_f32_16x16x32_bf16(al, bhv[kk], lacc, 0, 0, 0);
                        lacc = __builtin_amdgcn_mfma_f32_16x16x32_bf16(ah, blv[kk], lacc, 0, 0, 0);
                    }
                }
#pragma unroll
                for (int j = 0; j < 4; ++j) logit[(fq * 4 + j) * 64 + wid * 16 + fr] = lacc[j];
            }
            __syncthreads();
            float acc[4];
#pragma unroll
            for (int j = 0; j < 4; ++j) acc[j] = logit[(wid * 4 + j) * 64 + lane];
#pragma unroll
            for (int j = 0; j < 4; ++j) {
                const int tl = sb * 16 + wid * 4 + j;
                const float score = 1.f / (1.f + __expf(-acc[j]));
                const float biased = score + ebias;
                const float m1 = group8_max(biased);
                const unsigned long long eq = __ballot(biased == m1);
                const int g = lane >> 3;
                const unsigned gm = (unsigned)(eq >> (g * 8)) & 0xFFu;
                const int first = __ffs((int)gm) - 1;
                const float v2 = ((lane & 7) == first) ? -INFINITY : biased;
                const float m2 = group8_max(v2);
                const float gs = m1 + m2;
                int rg = 0;
#pragma unroll
                for (int g2 = 0; g2 < 8; ++g2) { const float o = __builtin_bit_cast(float, __builtin_amdgcn_readlane(__builtin_bit_cast(int, gs), g2 * 8)); rg += ((o > gs) || (o == gs && g2 < g)) ? 1 : 0; }
                const bool keep = rg < 4;
                const float mk = keep ? biased : -INFINITY;
                int rk = 0;
#pragma unroll
                for (int e2 = 0; e2 < 64; ++e2) { const float o = __builtin_bit_cast(float, __builtin_amdgcn_readlane(__builtin_bit_cast(int, mk), e2)); rk += ((o > mk) || (o == mk && e2 < lane)) ? 1 : 0; }
                const bool sel = keep && (rk < 8);
                const float ssum = wave_sum(sel ? score : 0.f);
                const float wgt = score / ssum * 2.5f;
                const unsigned long long sm = __ballot(sel);
                const int kidx = __popcll(sm & ((1ull << lane) - 1ull));
                if (sel) { wsel[(size_t)(tok0 + tl) * 8 + kidx] = wgt; sel_e[tl * 8 + kidx] = lane; }
            }
            __syncthreads();
        }
        for (int i = tid; i < 512; i += VTHREADS) lpos[i] = atomicAdd(&hist[sel_e[i]], 1);
        __syncthreads();
        if (tid < 64) basep[tid] = (int)atomicAdd(&cnt[tid], (unsigned)hist[tid]);
        __syncthreads();
        for (int i = tid; i < 512; i += VTHREADS) { const int e = sel_e[i], pos = basep[e] + lpos[i]; list[(size_t)e * NTOK + pos] = tok0 * 8 + i; pmap[tok0 * 8 + i] = (e << 16) | pos; }
        __syncthreads();
    }
}

DEVINL void phaseA(KP p, int l, char* lds) {
    const int tid = TID512(), c = blockIdx.x, G = gridDim.x;
    const char* ubuf = (const char*)(p->ws + OFF_UBUF);
    const char* Wt = (const char*)(p->ws + OFF_WIN) + (size_t)l * WIN_ROWS * 1024 * 2;
    bf16_t* P = (bf16_t*)(p->ws + A_P);
    auto sched = [&](int i, GUnit& u) -> bool {
        const long L = unit_linear(i, c, G); if (L >= 128 * 11) return false;
        const int Li = (int)L, sx = Li >> 9, w = (sx == 2) ? 3 : 4, rem = Li - (sx << 9), pm = rem / w, pn = sx * 4 + (rem - pm * w);
        u.A = ubuf + (size_t)pm * 256 * 2048; u.B = Wt + (size_t)pn * 256 * 2048; u.i0 = pm; u.i1 = pn; u.i2 = 0;
        return true;
    };
    auto epi = [&](f32x4 (&acc)[2][2][4][2], const GUnit& u, int wr, int wc, int fr, int fq) {
        asm volatile("" : "+v"(fr), "+v"(fq));
        const int row0 = u.i0 * 256 + wr * 64 + fr, col0 = u.i1 * 256 + wc * 32 + 8 * fq;
#pragma unroll
        for (int ai = 0; ai < 2; ++ai)
#pragma unroll
            for (int m = 0; m < 4; ++m) {
                bf16_t* rowp = P + (size_t)(row0 + ai * 128 + m * 16) * PIN + col0;
#pragma unroll
                for (int bj = 0; bj < 2; ++bj) {
                    if (col0 + bj * 128 < PIN) {
                        const f32x4 v0 = acc[ai][bj][m][0], v1 = acc[ai][bj][m][1];
                        *(uint4*)(rowp + bj * 128) = make_uint4(pack2(v0[0], v0[1]), pack2(v0[2], v0[3]), pack2(v1[0], v1[1]), pack2(v1[2], v1[3]));
                    }
                }
            }
    };
    gemm256<true, false, false>(lds, 1024, 1024, sched, epi);
}

DEVINL void phaseC(KP p, int l, char* lds) {
    const int tid = TID512(), c = blockIdx.x, G = gridDim.x;
    const char* ymix = (const char*)(p->ws + A_YMIX);
    const char* Wt = (const char*)(p->ws + OFF_WOUT) + (size_t)l * 1024 * 1024 * 2;
    const float* res32 = p->in[I_X];
    const bf16_t* res16 = (const bf16_t*)p->out;
    bf16_t* zbuf = (bf16_t*)(p->ws + M_ZB);
    const float* mod = (const float*)(p->ws + OFF_MOD);
    auto sched = [&](int i, GUnit& u) -> bool {
        const long L = unit_linear(i, c, G); if (L >= 128 * 4) return false;
        const int pm = (int)L >> 2, pn = (int)L & 3;
        u.A = ymix + (size_t)pm * 256 * 2048; u.B = Wt + (size_t)pn * 256 * 2048; u.i0 = pm; u.i1 = pn; u.i2 = 0;
        return true;
    };
    auto epi = [&](f32x4 (&acc)[2][2][4][2], const GUnit& u, int wr, int wc, int fr, int fq) {
        asm volatile("" : "+v"(fr), "+v"(fq));
        const int row0 = u.i0 * 256 + wr * 64 + fr, col0 = u.i1 * 256 + wc * 32 + 8 * fq;
#pragma unroll
        for (int ai = 0; ai < 2; ++ai)
#pragma unroll
            for (int m = 0; m < 4; ++m) {
                const int row = row0 + ai * 128 + m * 16, b = row >> 12;
#pragma unroll
                for (int bj = 0; bj < 2; ++bj) {
                    const int col = col0 + bj * 128;
                    const float4 ga = *(const float4*)(mod + (size_t)(l * 8 + b) * 6144 + 2048 + col), gb = *(const float4*)(mod + (size_t)(l * 8 + b) * 6144 + 2048 + col + 4);
                    float r[8];
                    if (l == 0) {
                        const float4 ra = *(const float4*)(res32 + (size_t)row * DM + col), rb = *(const float4*)(res32 + (size_t)row * DM + col + 4);
                        r[0] = ra.x; r[1] = ra.y; r[2] = ra.z; r[3] = ra.w; r[4] = rb.x; r[5] = rb.y; r[6] = rb.z; r[7] = rb.w;
                    } else {
                        const uint4 rv = *(const uint4*)(res16 + (size_t)row * DM + col);
                        r[0] = __uint_as_float(rv.x << 16); r[1] = __uint_as_float(rv.x & 0xFFFF0000u); r[2] = __uint_as_float(rv.y << 16); r[3] = __uint_as_float(rv.y & 0xFFFF0000u);
                        r[4] = __uint_as_float(rv.z << 16); r[5] = __uint_as_float(rv.z & 0xFFFF0000u); r[6] = __uint_as_float(rv.w << 16); r[7] = __uint_as_float(rv.w & 0xFFFF0000u);
                    }
                    const f32x4 a0 = acc[ai][bj][m][0], a1 = acc[ai][bj][m][1];
                    const float z0 = ALPHA * r[0] + (1.f + ga.x) * a0[0], z1 = ALPHA * r[1] + (1.f + ga.y) * a0[1], z2 = ALPHA * r[2] + (1.f + ga.z) * a0[2], z3 = ALPHA * r[3] + (1.f + ga.w) * a0[3];
                    const float z4 = ALPHA * r[4] + (1.f + gb.x) * a1[0], z5 = ALPHA * r[5] + (1.f + gb.y) * a1[1], z6 = ALPHA * r[6] + (1.f + gb.z) * a1[2], z7 = ALPHA * r[7] + (1.f + gb.w) * a1[3];
                    *(uint4*)(zbuf + (size_t)row * DM + col) = make_uint4(pack2(z0, z1), pack2(z2, z3), pack2(z4, z5), pack2(z6, z7));
                }
            }
    };
    gemm256<true, false, false>(lds, 1024, 1024, sched, epi);
}

constexpr int DIR_OFF = 131072;
DEVINL void moe_directory(KP p, int l, char* lds) {
    int* pref = (int*)(lds + DIR_OFF);
    int* cntl = (int*)(lds + DIR_OFF + 512);
    unsigned* cnt = (unsigned*)(p->ws + OFF_CNT) + l * 64;
    asm volatile("" : "+s"(cnt));
    if (threadIdx.x == 0) {
        int s = 0;
        int* xpre = (int*)(lds + DIR_OFF + 1024);
        int x = 0;
        for (int e = 0; e < 64; ++e) { const int c = (int)__hip_atomic_load(&cnt[e], __ATOMIC_RELAXED, __HIP_MEMORY_SCOPE_AGENT); cntl[e] = c; pref[e] = s; s += (c + 255) >> 8; xpre[e] = x; x += c; }
        pref[64] = s; cntl[64] = NTOK; pref[65] = s + 128; xpre[64] = x;
    }
    __syncthreads();
    {
        int* m2e = (int*)(lds + DIR_OFF + 2048);
        const int tot = pref[65];
        for (int mg = threadIdx.x; mg < tot; mg += NTHREADS) { int e = 0; while (pref[e + 1] <= mg) ++e; m2e[mg] = e; }
    }
    __syncthreads();
}

DEVINL void phaseE1(KP p, int l, char* lds) {
    const int tid = TID512(), c = blockIdx.x, G = gridDim.x;
    moe_directory(p, l, lds);
    const int* pref = (const int*)(lds + DIR_OFF); const int* cntl = (const int*)(lds + DIR_OFF + 512);
    const char* ubuf = (const char*)(p->ws + OFF_UBUF);
    const int* list = (const int*)(p->ws + M_LIST);
    bf16_t* hbuf = (bf16_t*)(p->ws + M_HBUF);
    const char* W13 = (const char*)(p->ws + OFF_W13) + (size_t)(l * 65) * 512 * 1024;
    const int total = __builtin_amdgcn_readfirstlane(pref[65]) * 2;
    auto sched = [&](int i, GUnit& u) -> bool {
        const long L = unit_linear(i, c, G); if (L >= total) return false;
        const int mg = (int)L >> 1, nt = (int)L & 1;
        const int e = __builtin_amdgcn_readfirstlane(((const int*)(lds + DIR_OFF + 2048))[mg]);
        const int mt = __builtin_amdgcn_readfirstlane(mg - pref[e]), Me = __builtin_amdgcn_readfirstlane(cntl[e]);
        u.A = ubuf; u.B = W13 + ((size_t)e * 512 + nt * 256) * 1024; u.i0 = mg; u.i1 = nt; u.i2 = e;
        int R[2], C[2]; stage_coords512(TID512(), R, C);
#pragma unroll
        for (int h = 0; h < 2; ++h)
#pragma unroll
            for (int i2 = 0; i2 < 2; ++i2) {
                const int idx = mt * 256 + h * 128 + R[i2]; int tok;
                if (e < 64) tok = (idx < Me) ? (list[(size_t)e * NTOK + idx] >> 3) : 0; else tok = idx;
                u.va[h][i2] = (unsigned)(tok * 1024 + C[i2] * 2);
            }
        return true;
    };
    auto epi = [&](f32x4 (&acc)[2][2][4][2], const GUnit& u, int wr, int wc, int fr, int fq) {
        asm volatile("" : "+v"(fr), "+v"(fq));
        const size_t row0 = (size_t)u.i0 * 256 + wr * 64 + fr;
#pragma unroll
        for (int ai = 0; ai < 2; ++ai)
#pragma unroll
            for (int m = 0; m < 4; ++m) {
                bf16_t* rowp = hbuf + (row0 + ai * 128 + m * 16) * 256;
#pragma unroll
                for (int bj = 0; bj < 2; ++bj) {
                    const int hcol = (u.i1 * 8 + bj * 4 + wc) * 16 + 4 * fq;
                    const f32x4 gt = acc[ai][bj][m][0], up = acc[ai][bj][m][1];
                    float hv[4];
#pragma unroll
                    for (int j = 0; j < 4; ++j) hv[j] = gt[j] * sigm(gt[j]) * up[j];
                    uint2 o; o.x = pack2(hv[0], hv[1]); o.y = pack2(hv[2], hv[3]);
                    *(uint2*)(rowp + hcol) = o;
                }
                asm volatile("" ::: "memory");
            }
    };
    gemm256<false, true, true>(lds, 512, 512, sched, epi);
}

DEVINL void phaseE2(KP p, int l, char* lds) {
    const int tid = TID512(), c = blockIdx.x, G = gridDim.x;
    moe_directory(p, l, lds);
    const int* pref = (const int*)(lds + DIR_OFF); const int* cntl = (const int*)(lds + DIR_OFF + 512);
    const int* xpre = (const int*)(lds + DIR_OFF + 1024);
    const char* hbuf = (const char*)(p->ws + M_HBUF);
    unsigned char* ybuf = (unsigned char*)(p->ws + M_YBUF);
    const char* W2 = (const char*)(p->ws + OFF_W2) + (size_t)(l * 65) * 1024 * 256 * 2;
    const int total = __builtin_amdgcn_readfirstlane(pref[65]) * 4;
    auto sched = [&](int i, GUnit& u) -> bool {
        const long L = unit_linear(i, c, G); if (L >= total) return false;
        const int mg = (int)L >> 2, nt = (int)L & 3;
        const int e = __builtin_amdgcn_readfirstlane(((const int*)(lds + DIR_OFF + 2048))[mg]);
        u.A = hbuf + (size_t)mg * 256 * 512; u.B = W2 + ((size_t)e * 1024 + nt * 256) * 512; u.i0 = mg; u.i1 = nt; u.i2 = e;
        return true;
    };
    auto epi = [&](f32x4 (&acc)[2][2][4][2], const GUnit& u, int wr, int wc, int fr, int fq) {
        asm volatile("" : "+v"(fr), "+v"(fq));
        const int e = __builtin_amdgcn_readfirstlane(u.i2), mt = __builtin_amdgcn_readfirstlane(u.i0 - pref[e]), Me = __builtin_amdgcn_readfirstlane(cntl[e]);
        const int yrow0 = __builtin_amdgcn_readfirstlane(xpre[e]) + mt * 256;
        const int col0 = u.i1 * 256 + wc * 32 + 8 * fq, loc0 = wr * 64 + fr;
#pragma unroll
        for (int ai = 0; ai < 2; ++ai)
#pragma unroll
            for (int m = 0; m < 4; ++m) {
                const int loc = loc0 + ai * 128 + m * 16;
                if (mt * 256 + loc < Me) {
                    unsigned char* rowp = ybuf + (size_t)(yrow0 + loc) * 1024 + col0;
#pragma unroll
                    for (int bj = 0; bj < 2; ++bj) {
                        const f32x4 v0 = acc[ai][bj][m][0], v1 = acc[ai][bj][m][1];
                        int w0 = __builtin_amdgcn_cvt_pk_fp8_f32(v0[0], v0[1], 0, false); w0 = __builtin_amdgcn_cvt_pk_fp8_f32(v0[2], v0[3], w0, true);
                        int w1 = __builtin_amdgcn_cvt_pk_fp8_f32(v1[0], v1[1], 0, false); w1 = __builtin_amdgcn_cvt_pk_fp8_f32(v1[2], v1[3], w1, true);
                        *(uint2*)(rowp + bj * 128) = make_uint2((unsigned)w0, (unsigned)w1);
                    }
                }
            }
    };
    gemm256<true, false, false>(lds, 256, 256, sched, epi);
}

DEVINL void phaseF(KP p, int l, const int dry = 0) {
    const int tid = TIDX(), nb = NBV(), blk = BIDX(), wid = tid >> 6, lane = tid & 63;
    const bf16_t* zbuf = (const bf16_t*)(p->ws + M_ZB);
    float* xout = dry ? (float*)(p->ws + M_HBUF) : p->out;
    const unsigned char* ybuf = (const unsigned char*)(p->ws + M_YBUF);
    bf16_t* ubuf = (bf16_t*)(p->ws + OFF_UBUF);
    const float* mod = (const float*)(p->ws + OFF_MOD);
    const int* pmap = (const int*)(p->ws + M_PMAP); const float* wsel = (const float*)(p->ws + M_WSEL);
    const float2* lnstat = (const float2*)(p->ws + M_STAT);
    int xoff;
    {
        const unsigned* cnt = (const unsigned*)(p->ws + OFF_CNT) + l * 64;
        const int c = (int)__hip_atomic_load(&cnt[lane], __ATOMIC_RELAXED, __HIP_MEMORY_SCOPE_AGENT);
        xoff = 0;
#pragma unroll
        for (int j = 0; j < 64; ++j) { const int cj = __builtin_amdgcn_readlane(c, j); xoff += (j < lane) ? cj : 0; }
    }
    int pmn = 0; float wn = 0.f; float2 stn = make_float2(0.f, 0.f);
    {
        const int row = blk * 4 + wid;
        if (row < NTOK) { if (lane < 8) { pmn = pmap[row * 8 + lane]; wn = wsel[row * 8 + lane]; } stn = lnstat[row]; }
    }
    for (int row = blk * 4 + wid; row < NTOK; row += nb * 4) {
        const int b = row >> 12;
        int yr = pmn; const float yw = wn; const float2 st1 = stn;
        {
            const int nrow = row + nb * 4;
            if (nrow < NTOK) { if (lane < 8) { pmn = pmap[nrow * 8 + lane]; wn = wsel[nrow * 8 + lane]; } stn = lnstat[nrow]; }
        }
        { const int e = (yr >> 16) & 63; const int xo = __builtin_amdgcn_ds_bpermute(e << 2, xoff); yr = xo + (yr & 0xFFFF); }
        int yrow[8]; float yww[8];
#pragma unroll
        for (int k = 0; k < 8; ++k) { yrow[k] = __builtin_amdgcn_readlane(yr, k); yww[k] = __builtin_bit_cast(float, __builtin_amdgcn_readlane(__builtin_bit_cast(int, yw), k)); }
        uint2 zvv[4]; int ysh[4]; int yvk[4][8];
#pragma unroll
        for (int i = 0; i < 4; ++i) {
            const int col = i * 256 + lane * 4;
            zvv[i] = *(const uint2*)(zbuf + (size_t)row * DM + col);
            ysh[i] = *(const int*)(ybuf + ((size_t)(262144 + row)) * 1024 + col);
#pragma unroll
            for (int k = 0; k < 8; ++k) yvk[i][k] = *(const int*)(ybuf + (size_t)yrow[k] * 1024 + col);
        }
        float4 z[4]; float s = 0.f;
#pragma unroll
        for (int i = 0; i < 4; ++i) {
            const int col = i * 256 + lane * 4;
            float4 x1;
            { const uint2 zv = zvv[i];
              float4 z1; z1.x = __uint_as_float(zv.x << 16); z1.y = __uint_as_float(zv.x & 0xFFFF0000u); z1.z = __uint_as_float(zv.y << 16); z1.w = __uint_as_float(zv.y & 0xFFFF0000u);
              const float4 g1 = *(const float4*)(p->in[I_LN1G] + l * 1024 + col), b1 = *(const float4*)(p->in[I_LN1B] + l * 1024 + col);
              x1.x = (z1.x - st1.x) * st1.y * g1.x + b1.x; x1.y = (z1.y - st1.x) * st1.y * g1.y + b1.y; x1.z = (z1.z - st1.x) * st1.y * g1.z + b1.z; x1.w = (z1.w - st1.x) * st1.y * g1.w + b1.w; }
            float f0, f1, f2, f3;
            { const int yv = ysh[i];
              const f2_t lo = __builtin_amdgcn_cvt_pk_f32_fp8(yv, false), hi = __builtin_amdgcn_cvt_pk_f32_fp8(yv, true);
              f0 = lo[0]; f1 = lo[1]; f2 = hi[0]; f3 = hi[1]; }
#pragma unroll
            for (int k = 0; k < 8; ++k) {
                const f2_t lo = __builtin_amdgcn_cvt_pk_f32_fp8(yvk[i][k], false), hi = __builtin_amdgcn_cvt_pk_f32_fp8(yvk[i][k], true);
                const float w = yww[k];
                f0 = fmaf(w, lo[0], f0); f1 = fmaf(w, lo[1], f1); f2 = fmaf(w, hi[0], f2); f3 = fmaf(w, hi[1], f3);
            }
            const float4 g2 = *(const float4*)(mod + (size_t)(l * 8 + b) * 6144 + 5120 + col);
            z[i].x = ALPHA * x1.x + (1.f + g2.x) * f0; z[i].y = ALPHA * x1.y + (1.f + g2.y) * f1; z[i].z = ALPHA * x1.z + (1.f + g2.z) * f2; z[i].w = ALPHA * x1.w + (1.f + g2.w) * f3;
            s += z[i].x + z[i].y + z[i].z + z[i].w;
        }
        const float mean = wave_sum(s) * (1.f / 1024.f);
        float q = 0.f;
#pragma unroll
        for (int i = 0; i < 4; ++i) { z[i].x -= mean; z[i].y -= mean; z[i].z -= mean; z[i].w -= mean; q += z[i].x * z[i].x + z[i].y * z[i].y + z[i].z * z[i].z + z[i].w * z[i].w; }
        const float rs = rsqrtf(wave_sum(q) * (1.f / 1024.f) + LN_EPS);
#pragma unroll
        for (int i = 0; i < 4; ++i) {
            const int col = i * 256 + lane * 4;
            const float4 g = *(const float4*)(p->in[I_LN2G] + l * 1024 + col), bb = *(const float4*)(p->in[I_LN2B] + l * 1024 + col);
            float4 x2; x2.x = z[i].x * rs * g.x + bb.x; x2.y = z[i].y * rs * g.y + bb.y; x2.z = z[i].z * rs * g.z + bb.z; x2.w = z[i].w * rs * g.w + bb.w;
            if (l + 1 < DEPTH) { uint2 ox; ox.x = pack2(x2.x, x2.y); ox.y = pack2(x2.z, x2.w); *(uint2*)((bf16_t*)xout + (size_t)row * DM + col) = ox; }
            else *(float4*)(xout + (size_t)row * DM + col) = x2;
            if (l + 1 < DEPTH) {
                const float4 sh = *(const float4*)(mod + (size_t)((l + 1) * 8 + b) * 6144 + col), sc = *(const float4*)(mod + (size_t)((l + 1) * 8 + b) * 6144 + 1024 + col);
                uint2 o; o.x = pack2(x2.x * (1.f + sc.x) + sh.x, x2.y * (1.f + sc.y) + sh.y); o.y = pack2(x2.z * (1.f + sc.z) + sh.z, x2.w * (1.f + sc.w) + sh.w);
                *(uint2*)(ubuf + (size_t)row * DM + col) = o;
            }
        }
    }
}

#define XB_TMO      128
#define XB_XCNT(j)  (256  + 64 * (j))
#define XB_XSUB(j)  (1280 + 64 * (j))
#define XB_XGEN(j)  (2304 + 64 * (j))
#define XB_TOP      3328
#define XB_TOPGEN   3392
#define XCD_BAR_WORDS 3456
#define XB_SPIN_CAP (1u << 20)
DEVINL unsigned xb_ld(unsigned* p)              { return __hip_atomic_load(p, __ATOMIC_RELAXED, __HIP_MEMORY_SCOPE_AGENT); }
DEVINL unsigned xb_add(unsigned* p, unsigned v) { return __hip_atomic_fetch_add(p, v, __ATOMIC_RELAXED, __HIP_MEMORY_SCOPE_AGENT); }
DEVINL unsigned xb_xcc_id() { return (unsigned)__builtin_amdgcn_s_getreg((3 << 11) | 20) & 0xFu; }
#define XB_SPIN(cond, bar) do { unsigned _sp = 0; while (cond) { __builtin_amdgcn_s_sleep(1); \
    if ((++_sp & 255u) == 0u) { if (xb_ld(&(bar)[XB_TMO])) break; if (_sp > XB_SPIN_CAP) { atomicAdd(&(bar)[XB_TMO], 1u); break; } } } } while (0)
struct XcdBarrier { unsigned* bar; unsigned x; volatile LAS unsigned* st; };
DEVINL XcdBarrier xcd_barrier_post(unsigned* bar, volatile LAS unsigned* st) {
    XcdBarrier b; b.bar = bar; b.x = xb_xcc_id(); b.st = st;
    if (threadIdx.x == 0) (void)xb_add(&bar[XB_XCNT(b.x)], 1u);
    return b;
}
DEVINL void xcd_barrier_complete(unsigned* bar, unsigned x, unsigned& nloc, unsigned& nx) {
    const unsigned G = gridDim.x * gridDim.y * gridDim.z;
    unsigned sum, cnt, mine, sp = 0u;
    for (;;) {
        sum = 0u; cnt = 0u; mine = 0u;
#pragma unroll 1
        for (unsigned j = 0; j < 16; ++j) { const unsigned c = xb_ld(&bar[XB_XCNT(j)]); sum += c; cnt += (c > 0u) ? 1u : 0u; mine = (j == x) ? c : mine; }
        if (sum == G) break;
        __builtin_amdgcn_s_sleep(1);
        if ((++sp & 255u) == 0u) { if (xb_ld(&bar[XB_TMO])) break; if (sp > XB_SPIN_CAP) { atomicAdd(&bar[XB_TMO], 1u); break; } }
    }
    nloc = mine > 0u ? mine : 1u; nx = cnt > 0u ? cnt : 1u;
}
DEVINL void xcd_barrier(const XcdBarrier& b) {
    asm volatile("s_waitcnt vmcnt(0)" ::: "memory");
    __syncthreads();
    if (threadIdx.x == 0) {
        unsigned* bar = b.bar;
        __builtin_amdgcn_s_waitcnt(0);
        unsigned nloc = b.st[0], nx = b.st[1];
        if (nloc == 0u) { xcd_barrier_complete(bar, b.x, nloc, nx); b.st[0] = nloc; b.st[1] = nx; }
        const unsigned old = xb_add(&bar[XB_XSUB(b.x)], 1u);
        const unsigned gen = old / nloc;
        if (old + 1u == (gen + 1u) * nloc) {
            __builtin_amdgcn_fence(__ATOMIC_RELEASE, "agent");
            asm volatile("s_waitcnt vmcnt(0)" ::: "memory");
            const unsigned og = xb_add(&bar[XB_TOP], 1u);
            const unsigned tg = og / nx;
            if (og + 1u == (tg + 1u) * nx) xb_add(&bar[XB_TOPGEN], 1u);
            else XB_SPIN(xb_ld(&bar[XB_TOPGEN]) == tg, bar);
            __builtin_amdgcn_fence(__ATOMIC_ACQUIRE, "agent");
            xb_add(&bar[XB_XGEN(b.x)], 1u);
            asm volatile("s_waitcnt vmcnt(0)" ::: "memory");
        } else {
            XB_SPIN(xb_ld(&bar[XB_XGEN(b.x)]) == gen, bar);
            __builtin_amdgcn_fence(__ATOMIC_ACQUIRE, "agent");
            asm volatile("s_waitcnt vmcnt(0)" ::: "memory");
        }
    }
    __syncthreads();
}

constexpr int PPL = 11;
constexpr int NPHASE = 2 + PPL * DEPTH;
#ifndef PROBE_SUB
#define PROBE_SUB 3
#endif
#ifndef PROBE_REP
#define PROBE_REP (-1)
#endif
__global__ void __launch_bounds__(NTHREADS, 2) mega(Params p_arg, int ph_lo, int ph_hi) {
    extern __shared__ __attribute__((aligned(16))) char lds[];
    cg::grid_group grid = cg::this_grid();
    volatile LAS unsigned* st = (volatile LAS unsigned*)(lds + LDS_BYTES - 16);
    if (threadIdx.x == 0) { st[0] = 0u; st[1] = 0u; }
    __syncthreads();
    XcdBarrier xb = xcd_barrier_post((unsigned*)(p_arg.ws + OFF_BAR), st);
    for (int ph = ph_lo; ph < ph_hi; ++ph) {
        KP p = (KP)__builtin_amdgcn_kernarg_segment_ptr();
        asm volatile("" : "+s"(p));
        const int l = (ph >= 2) ? (ph - 2) / PPL : 0;
        const int q = (ph >= 2) ? (ph - 2) % PPL : -1;
        const bool nobar = (q == 2 || q == 3);
        const int nrep = (PROBE_REP >= 0 && ph == PROBE_REP) ? 2 : 1;
        for (int rep = 0; rep < nrep; ++rep) {
            const int dry = (PROBE_REP >= 0 && ph == PROBE_REP && rep == 0) ? 1 : 0;
            char* ldsh = lds + __builtin_amdgcn_readfirstlane((int)(threadIdx.x >> 8)) * LDS_HALF;
            if (ph == 0) phase0(p, ldsh);
            else if (ph == 1) phaseF0(p);
            else {
                switch (q) {
                    case 0: phaseA(p, l, lds); break;
                    case 1: phaseB1(p, l, ldsh, 1, (PROBE_REP >= 0 && ph == PROBE_REP && rep == 1) ? PROBE_SUB : 3); break;
                    case 2: phaseMix(p, l, ldsh, 0); break;
                    case 3: phaseMix(p, l, ldsh, 1); break;
                    case 4: phaseMix(p, l, ldsh, 2); break;
                    case 5: phaseB3(p, l); break;
                    case 6: phaseC(p, l, lds); break;
                    case 7: phaseD(p, l, ldsh, dry); break;
                    case 8: phaseE1(p, l, lds); break;
                    case 9: phaseE2(p, l, lds); break;
                    default: phaseF(p, l, dry); break;
                }
            }
            const bool lastrep = (rep + 1 == nrep);
            if (!lastrep || (ph + 1 < ph_hi && !nobar)) { if (lastrep && ph == ph_lo) grid.sync(); else xcd_barrier(xb); }
        }
    }
}

extern "C" void kernel_launch(void* const* d_in, const int* in_sizes, int n_in, void* d_out, int out_size, void* d_ws, size_t ws_size, hipStream_t stream) {
    static int grid_blocks = 0;
    if (grid_blocks == 0) {
        if (n_in != 39 || out_size != NTOK * DM || ws_size < WS_NEED) { fprintf(stderr, "kernel_launch: unexpected shapes (n_in %d out %d ws %zu need %zu)\n", n_in, out_size, ws_size, (size_t)WS_NEED); grid_blocks = -1; return; }
        int dev = 0, cus = 0, per_cu = 0;
        hipGetDevice(&dev);
        hipDeviceGetAttribute(&cus, hipDeviceAttributeMultiprocessorCount, dev);
        hipFuncSetAttribute((const void*)mega, hipFuncAttributeMaxDynamicSharedMemorySize, LDS_BYTES);
        hipOccupancyMaxActiveBlocksPerMultiprocessor(&per_cu, (const void*)mega, NTHREADS, LDS_BYTES);
        if (per_cu < 1) { fprintf(stderr, "kernel_launch: occupancy query returned %d\n", per_cu); grid_blocks = -1; return; }
        if (cus < 256) { fprintf(stderr, "kernel_launch: this build needs 256 CUs (found %d)\n", cus); grid_blocks = -1; return; }
        grid_blocks = 256;
    }
    if (grid_blocks < 0) return;
    if (hipMemsetAsync(d_ws, 0, 32768, stream) != hipSuccess) { fprintf(stderr, "kernel_launch: memset failed\n"); return; }
    Params p{};
    for (int i = 0; i < 39; ++i) p.in[i] = (const float*)d_in[i];
    p.out = (float*)d_out; p.ws = (unsigned char*)d_ws;
    int ph_lo = 0, ph_hi = NPHASE;
    void* args[] = {&p, &ph_lo, &ph_hi};
    hipError_t e = hipLaunchCooperativeKernel((const void*)mega, dim3(grid_blocks), dim3(NTHREADS), args, LDS_BYTES, stream);
    if (e != hipSuccess) fprintf(stderr, "cooperative launch failed: %s (grid %d)\n", hipGetErrorString(e), grid_blocks);
}
```

```cpp
#include <hip/hip_runtime.h>
#include <hip/hip_cooperative_groups.h>
#include <stdio.h>
#include <stdint.h>
namespace cg = cooperative_groups;

typedef unsigned short bf16_t;
typedef short bf16x8 __attribute__((ext_vector_type(8)));
typedef float f32x4 __attribute__((ext_vector_type(4)));
#define DEVINL __device__ __forceinline__
#define LAS __attribute__((address_space(3)))
#define MFMA32(a, b, c) __builtin_amdgcn_mfma_f32_32x32x16_bf16((a), (b), (c), 0, 0, 0)

constexpr int NTOK = 32768, SEQ = 4096, NBATCH = 8, DM = 1024, PIN = 2688, DEPTH = 2;
constexpr int NEXP = 64;
constexpr float ALPHA = 1.41421356237f;
constexpr float LN_EPS = 1e-5f, GN_EPS = 64e-5f;
constexpr int NTHREADS = 512;
constexpr int VTHREADS = 256;
constexpr int LDS_HALF = 75776;
constexpr int LDS_BYTES = 159744;

constexpr size_t OFF_CNT   = 0;
constexpr size_t OFF_BAR   = 4096;
constexpr size_t OFF_MOD   = 65536;
constexpr size_t OFF_WR    = 524288;
constexpr size_t OFF_WIN   = 1048576;
constexpr int WIN_ROWS = 2816;
constexpr size_t OFF_WOUT  = OFF_WIN + 2 * (size_t)WIN_ROWS * 1024 * 2;
constexpr size_t OFF_W13   = OFF_WOUT + 4194304;
constexpr size_t OFF_W2    = OFF_W13 + 136314880;
constexpr size_t OFF_UBUF  = OFF_W2 + 68157440;
constexpr size_t OFF_ARENA = OFF_UBUF + 67108864;
constexpr size_t A_P      = OFF_ARENA;
constexpr size_t A_YMIX   = A_P + 176160768;
constexpr size_t A_SCAN   = A_YMIX + 67108864;
constexpr size_t A_HLOC   = A_SCAN + 134217728;
constexpr size_t A_CUMA   = A_HLOC + 33554432;
constexpr size_t A_G      = A_CUMA + 33554432;
constexpr size_t A_BONUS  = A_G + 33554432;
constexpr size_t A_YRAW   = A_BONUS + 33554432;
constexpr size_t A_CARRYA = A_YRAW + 33554432;
constexpr size_t A_CARRYH = A_CARRYA + 1048576;
constexpr size_t A_HSTART = A_CARRYH + 1048576;
constexpr size_t A_CHAIN  = A_HSTART + 1048576;
constexpr size_t CHAIN_UNIT = 49152;
constexpr size_t M_YBUF   = OFF_ARENA;
constexpr size_t M_ZB     = OFF_ARENA + 335544320;
constexpr size_t M_HBUF   = M_YBUF + 603979776;
constexpr size_t M_LIST   = M_HBUF + 159383552;
constexpr size_t M_WSEL   = M_LIST + 8388608;
constexpr size_t M_PMAP   = M_WSEL + 1048576;
constexpr size_t M_STAT   = M_PMAP + 1048576;
constexpr size_t OFF_WLT  = M_STAT + 262144;
constexpr size_t OFF_WGT  = OFF_WLT + 131072;
constexpr size_t WS_NEED  = OFF_WGT + 131072;
static_assert(WS_NEED <= (size_t)1 << 30, "workspace layout exceeds the guaranteed 1 GiB");

struct Params {
    const float* in[39];
    float* out;
    unsigned char* ws;
};
typedef const __attribute__((address_space(4))) Params* KP;
constexpr int WTAB_OFF = 159744 - 16 - 256;
__device__ __forceinline__ int wave_index() {
    extern __shared__ __attribute__((aligned(16))) char lds_tab[];
    unsigned hw; asm volatile("s_getreg_b32 %0, hwreg(HW_REG_HW_ID, 0, 6)" : "=s"(hw));
    const int w = ((const volatile LAS int*)(lds_tab + WTAB_OFF))[hw & 63u];
    return __builtin_amdgcn_readfirstlane(w);
}
__device__ __forceinline__ int lane_index() { int l; asm volatile("v_mbcnt_lo_u32_b32 %0, -1, 0\n\tv_mbcnt_hi_u32_b32 %0, -1, %0" : "=v"(l)); return l; }
__device__ __forceinline__ int TID512() { int t = (wave_index() << 6) | lane_index(); asm volatile("" : "+v"(t)); __builtin_assume(t >= 0 && t < 512); return t; }
__device__ __forceinline__ int TIDX() { int t = ((wave_index() & 3) << 6) | lane_index(); asm volatile("" : "+v"(t)); __builtin_assume(t >= 0 && t < 256); return t; }
__device__ __forceinline__ int BIDX() { int b = blockIdx.x * 2 + (wave_index() >> 2); asm volatile("" : "+s"(b)); __builtin_assume(b >= 0 && b < 65536); return b; }
__device__ __forceinline__ int NBV() { return gridDim.x * 2; }
enum { I_X = 0, I_C, I_WMOD, I_BMOD, I_WIN, I_WOUT, I_CONVA, I_CONVAB, I_LNAG, I_LNAB, I_CONVB, I_CONVBB, I_WRG, I_BRG, I_WIG, I_BIG,
       I_LAMBDA, I_MUC, I_W0, I_WW2, I_A0, I_WA2, I_WG2, I_KK, I_KA, I_RK, I_GNG, I_GNB, I_CONVD, I_LN1G, I_LN1B, I_WROUTER, I_EBIAS,
       I_W13, I_W2, I_WS13, I_WS2, I_LN2G, I_LN2B };

DEVINL bf16_t f2bf(float f) { unsigned u = __float_as_uint(f); u += 0x7FFFu + ((u >> 16) & 1u); return (bf16_t)(u >> 16); }
DEVINL float bf2f(bf16_t h) { return __uint_as_float(((unsigned)h) << 16); }
typedef __bf16 bf2_t __attribute__((ext_vector_type(2)));
typedef float f2_t __attribute__((ext_vector_type(2)));
typedef float f32x16 __attribute__((ext_vector_type(16)));
DEVINL unsigned pack2(float a, float b) { f2_t v = {a, b}; return __builtin_bit_cast(unsigned, __builtin_convertvector(v, bf2_t)); }
DEVINL float sigm(float x) { return __builtin_amdgcn_rcpf(1.f + __expf(-x)); }
DEVINL float tanh_fast(float x) { const float e = __expf(2.f * x); return 1.f - 2.f * __builtin_amdgcn_rcpf(1.f + e); }
DEVINL float softplusf(float z) { return fmaxf(z, 0.f) + __logf(1.f + __expf(-fabsf(z))); }
DEVINL float log1p_s(float y) { return (y < 0.03125f) ? y * (1.f - y * (0.5f - y * (0.33333334f - 0.25f * y))) : __logf(1.f + y); }
DEVINL float softplus_acc(float z) { return fmaxf(z, 0.f) + log1p_s(__expf(-fabsf(z))); }
DEVINL float gelu_tanh(float x) { float u = 0.7978845608028654f * (x + 0.044715f * x * x * x); return 0.5f * x * (1.f + tanh_fast(u)); }
DEVINL float group8_max(float x) {
    x = fmaxf(x, __builtin_bit_cast(float, __builtin_amdgcn_update_dpp(0, __builtin_bit_cast(int, x), 0xB1, 0xf, 0xf, true)));
    x = fmaxf(x, __builtin_bit_cast(float, __builtin_amdgcn_update_dpp(0, __builtin_bit_cast(int, x), 0x4E, 0xf, 0xf, true)));
    x = fmaxf(x, __builtin_bit_cast(float, __builtin_amdgcn_update_dpp(0, __builtin_bit_cast(int, x), 0x141, 0xf, 0xf, true)));
    return x;
}
DEVINL float wave_sum_dpp(float x);
DEVINL float wave_sum(float x) { return wave_sum_dpp(x); }
DEVINL float wave_sum_dpp(float x) {
    x += __builtin_bit_cast(float, __builtin_amdgcn_update_dpp(0, __builtin_bit_cast(int, x), 0xB1, 0xf, 0xf, true));
    x += __builtin_bit_cast(float, __builtin_amdgcn_update_dpp(0, __builtin_bit_cast(int, x), 0x4E, 0xf, 0xf, true));
    x += __builtin_bit_cast(float, __builtin_amdgcn_update_dpp(0, __builtin_bit_cast(int, x), 0x141, 0xf, 0xf, true));
    x += __builtin_bit_cast(float, __builtin_amdgcn_update_dpp(0, __builtin_bit_cast(int, x), 0x140, 0xf, 0xf, true));
    x += __builtin_bit_cast(float, __builtin_amdgcn_update_dpp(0, __builtin_bit_cast(int, x), 0x142, 0xa, 0xf, false));
    x += __builtin_bit_cast(float, __builtin_amdgcn_update_dpp(0, __builtin_bit_cast(int, x), 0x143, 0xc, 0xf, false));
    return __builtin_bit_cast(float, __builtin_amdgcn_readlane(__builtin_bit_cast(int, x), 63));
}

DEVINL int lds_byte(int r, int c) { int st = (r >> 4) * 2 + (c >> 5), rr = r & 15, cc = c & 31, ob = rr * 64 + cc * 2; return st * 1024 + (ob ^ (((ob >> 9) & 1) << 5)); }
DEVINL void stage_rc(int b, int& R, int& C) { int st = b / 1024, sb = b % 1024, swz = sb ^ (((sb >> 9) & 1) << 5); R = (st >> 1) * 16 + swz / 64; C = (st & 1) * 32 + (swz % 64) / 2; }

template <class RowPtr, class Epi>
DEVINL void gemm_tile128(char* lds, RowPtr arow, const bf16_t* Bt, int K, Epi epi) {
    const int tid = TIDX();
    const bf16_t* ap[4]; const bf16_t* bp[4];
#pragma unroll
    for (int i = 0; i < 4; ++i) { int R, C; stage_rc(tid * 16 + i * 4096, R, C); ap[i] = arow(R) + C; bp[i] = Bt + (size_t)R * K + C; }
    const int wid = tid >> 6, lane = tid & 63, wr = wid >> 1, wc = wid & 1, fr = lane & 15, fq = lane >> 4;
    f32x4 acc[4][4];
#pragma unroll
    for (int m = 0; m < 4; ++m)
#pragma unroll
        for (int n = 0; n < 4; ++n) acc[m][n] = (f32x4){0.f, 0.f, 0.f, 0.f};
    const int nk = K >> 6;
#pragma unroll
    for (int i = 0; i < 4; ++i) {
        __builtin_amdgcn_global_load_lds((const unsigned*)(ap[i]), (unsigned*)(lds + tid * 16 + i * 4096), 16, 0, 0);
        __builtin_amdgcn_global_load_lds((const unsigned*)(bp[i]), (unsigned*)(lds + 16384 + tid * 16 + i * 4096), 16, 0, 0);
    }
    for (int kt = 0; kt < nk; ++kt) {
        asm volatile("s_waitcnt vmcnt(0)" ::: "memory");
        __syncthreads();
        char* cur = lds + (kt & 1) * 32768;
        if (kt + 1 < nk) {
            char* nxt = lds + ((kt + 1) & 1) * 32768;
            const int ko = (kt + 1) * 64;
#pragma unroll
            for (int i = 0; i < 4; ++i) {
                __builtin_amdgcn_global_load_lds((const unsigned*)(ap[i] + ko), (unsigned*)(nxt + tid * 16 + i * 4096), 16, 0, 0);
                __builtin_amdgcn_global_load_lds((const unsigned*)(bp[i] + ko), (unsigned*)(nxt + 16384 + tid * 16 + i * 4096), 16, 0, 0);
            }
        }
        bf16x8 af[4][2], bfr[4][2];
#pragma unroll
        for (int m = 0; m < 4; ++m)
#pragma unroll
            for (int kk = 0; kk < 2; ++kk) af[m][kk] = *reinterpret_cast<const bf16x8*>(cur + lds_byte(wr * 64 + m * 16 + fr, kk * 32 + fq * 8));
#pragma unroll
        for (int n = 0; n < 4; ++n)
#pragma unroll
            for (int kk = 0; kk < 2; ++kk) bfr[n][kk] = *reinterpret_cast<const bf16x8*>(cur + 16384 + lds_byte(wc * 64 + n * 16 + fr, kk * 32 + fq * 8));
#pragma unroll
        for (int kk = 0; kk < 2; ++kk)
#pragma unroll
            for (int m = 0; m < 4; ++m)
#pragma unroll
                for (int n = 0; n < 4; ++n) acc[m][n] = __builtin_amdgcn_mfma_f32_16x16x32_bf16(bfr[n][kk], af[m][kk], acc[m][n], 0, 0, 0);
    }
    __syncthreads();
    epi(acc, wr, wc, fr, fq);
}

template <class Ptrs, class Epi>
DEVINL void gemm_stream128(char* lds, int K, int blk, int nb, int total, Ptrs ptrs, Epi epi) {
    const int qx = nb >> 3, first = (blk & 7) * qx + (blk >> 3), stride = nb;
    if (first >= total) return;
    const int tid = TIDX();
    const int wid = tid >> 6, lane = tid & 63, wr = wid >> 1, wc = wid & 1, fr = lane & 15, fq = lane >> 4;
    const int nk = K >> 6;
    const bf16_t* ap[4]; const bf16_t* bp[4];
    const bf16_t* an[4]; const bf16_t* bn[4];
    int t = first;
    ptrs(t, ap, bp);
#pragma unroll
    for (int i = 0; i < 4; ++i) {
        __builtin_amdgcn_global_load_lds((const unsigned*)(ap[i]), (unsigned*)(lds + tid * 16 + i * 4096), 16, 0, 0);
        __builtin_amdgcn_global_load_lds((const unsigned*)(bp[i]), (unsigned*)(lds + 16384 + tid * 16 + i * 4096), 16, 0, 0);
    }
    for (;;) {
        const int tn = t + stride;
        const bool has_next = tn < total;
        if (has_next) ptrs(tn, an, bn);
        f32x4 acc[4][4];
#pragma unroll
        for (int m = 0; m < 4; ++m)
#pragma unroll
            for (int n = 0; n < 4; ++n) acc[m][n] = (f32x4){0.f, 0.f, 0.f, 0.f};
        for (int kt = 0; kt < nk; ++kt) {
            asm volatile("s_waitcnt vmcnt(0)" ::: "memory");
            __syncthreads();
            char* cur = lds + (kt & 1) * 32768;
            if (kt + 1 < nk) {
                char* nxt = lds + ((kt + 1) & 1) * 32768;
                const int ko = (kt + 1) * 64;
#pragma unroll
                for (int i = 0; i < 4; ++i) {
                    __builtin_amdgcn_global_load_lds((const unsigned*)(ap[i] + ko), (unsigned*)(nxt + tid * 16 + i * 4096), 16, 0, 0);
                    __builtin_amdgcn_global_load_lds((const unsigned*)(bp[i] + ko), (unsigned*)(nxt + 16384 + tid * 16 + i * 4096), 16, 0, 0);
                }
            } else if (has_next) {
#pragma unroll
                for (int i = 0; i < 4; ++i) {
                    __builtin_amdgcn_global_load_lds((const unsigned*)(an[i]), (unsigned*)(lds + tid * 16 + i * 4096), 16, 0, 0);
                    __builtin_amdgcn_global_load_lds((const unsigned*)(bn[i]), (unsigned*)(lds + 16384 + tid * 16 + i * 4096), 16, 0, 0);
                }
            }
            bf16x8 af[4][2], bfr[4][2];
#pragma unroll
            for (int m = 0; m < 4; ++m)
#pragma unroll
                for (int kk = 0; kk < 2; ++kk) af[m][kk] = *reinterpret_cast<const bf16x8*>(cur + lds_byte(wr * 64 + m * 16 + fr, kk * 32 + fq * 8));
#pragma unroll
            for (int n = 0; n < 4; ++n)
#pragma unroll
                for (int kk = 0; kk < 2; ++kk) bfr[n][kk] = *reinterpret_cast<const bf16x8*>(cur + 16384 + lds_byte(wc * 64 + n * 16 + fr, kk * 32 + fq * 8));
#pragma unroll
            for (int kk = 0; kk < 2; ++kk)
#pragma unroll
                for (int m = 0; m < 4; ++m)
#pragma unroll
                    for (int n = 0; n < 4; ++n) acc[m][n] = __builtin_amdgcn_mfma_f32_16x16x32_bf16(bfr[n][kk], af[m][kk], acc[m][n], 0, 0, 0);
        }
        epi(t, acc, wr, wc, fr, fq);
        if (!has_next) break;
        t = tn;
#pragma unroll
        for (int i = 0; i < 4; ++i) { ap[i] = an[i]; bp[i] = bn[i]; }
    }
    __syncthreads();
}
DEVINL void stage_coords(int (&R)[4], int (&C)[4]) {
    const int tid = TIDX();
#pragma unroll
    for (int i = 0; i < 4; ++i) stage_rc(tid * 16 + i * 4096, R[i], C[i]);
}

struct GUnit {
    const char* A;
    const char* B;
    unsigned va[2][2] = {{0u, 0u}, {0u, 0u}};
    int i0, i1, i2;
};
constexpr int G_HTB = 128 * 64 * 2;
constexpr int G_STAGE_BYTES = 8 * G_HTB;
DEVINL int perm32(int rho) { const int n = rho >> 4, i = rho & 15; return 8 * (i >> 2) + 4 * n + (i & 3); }
DEVINL void stage_coords512(int tid, int (&R)[2], int (&C)[2]) {
#pragma unroll
    for (int i = 0; i < 2; ++i) stage_rc(tid * 16 + i * 8192, R[i], C[i]);
}

typedef int v8i_t __attribute__((ext_vector_type(8)));
typedef int v4i_t __attribute__((ext_vector_type(4)));
DEVINL v8i_t cat8(bf16x8 lo, bf16x8 hi) { return __builtin_shufflevector(__builtin_bit_cast(v4i_t, lo), __builtin_bit_cast(v4i_t, hi), 0, 1, 2, 3, 4, 5, 6, 7); }
template <bool PERM, bool GATHER, bool FP8, class Sched, class Epi>
DEVINL void gemm256(char* lds_generic, int K, int lda, Sched sched, Epi epi) {
    LAS unsigned char* lds = (LAS unsigned char*)lds_generic;
    const int tid = TID512(), wid = __builtin_amdgcn_readfirstlane(tid >> 6), lane = tid & 63, wr = wid >> 2, wc = wid & 3, fr = lane & 15, fq = lane >> 4;
    const int nt = K / 64;
    unsigned voffB[2];
#pragma unroll
    for (int i = 0; i < 2; ++i) { int R, C; stage_rc(tid * 16 + i * 8192, R, C); const int Rb = PERM ? ((R & ~31) + perm32(R & 31)) : R; voffB[i] = (unsigned)(Rb * K + C) * 2u; }
    unsigned voffA[2];
#pragma unroll
    for (int i = 0; i < 2; ++i) { int R, C; stage_rc(tid * 16 + i * 8192, R, C); voffA[i] = (unsigned)(R * lda + C) * 2u; }
    const size_t hstepA = GATHER ? 0 : (size_t)128 * lda * 2;
    const size_t kstep = (size_t)(64 * 2);
    const size_t hstepB = (size_t)128 * K * 2;
    const unsigned ldsw = (unsigned)wid * 1024u;
    const int aoff = lds_byte(wr * 64 + fr, fq * 8), boff = lds_byte(wc * 32 + fr, fq * 8);
#define G_SA(b, h) (((b) * 2 + (h)) * G_HTB)
#define G_SB(b, h) ((4 + (b) * 2 + (h)) * G_HTB)
#define G_STAGE(bufoff, gbase, voff) do { _Pragma("unroll") for (int _i = 0; _i < 2; ++_i) { unsigned _vo = (voff)[_i]; asm volatile("" : "+v"(_vo)); \
        __builtin_amdgcn_global_load_lds((const unsigned*)((const char*)(gbase) + _vo), (LAS unsigned*)(lds + (bufoff) + ldsw + _i * 8192), 16, 0, 0); } } while (0)
#define G_STAGE_A(bufoff, ptr, vg, h) do { if constexpr (GATHER) { G_STAGE(bufoff, ptr, vg); } else { G_STAGE(bufoff, (ptr) + (h) * hstepA, voffA); } } while (0)
#define G_LDA(dst, b, h) do { _Pragma("unroll") for (int m = 0; m < 4; ++m) dst[m] = cat8(*(const LAS bf16x8*)(lds + G_SA(b, h) + aoff + m * 2048), *(const LAS bf16x8*)(lds + G_SA(b, h) + aoff + m * 2048 + 1024)); } while (0)
#define G_LDB(dst, b, h) do { _Pragma("unroll") for (int n = 0; n < 2; ++n) dst[n] = cat8(*(const LAS bf16x8*)(lds + G_SB(b, h) + boff + n * 2048), *(const LAS bf16x8*)(lds + G_SB(b, h) + boff + n * 2048 + 1024)); } while (0)
#define G_LO(x) __builtin_bit_cast(bf16x8, __builtin_shufflevector((x), (x), 0, 1, 2, 3))
#define G_HI(x) __builtin_bit_cast(bf16x8, __builtin_shufflevector((x), (x), 4, 5, 6, 7))
#define G_MMA(ai, bj, At, Bt) do { __builtin_amdgcn_s_setprio(1); \
        if constexpr (FP8) { _Pragma("unroll") for (int m = 0; m < 4; ++m) _Pragma("unroll") for (int n = 0; n < 2; ++n) \
            acc[ai][bj][m][n] = __builtin_amdgcn_mfma_scale_f32_16x16x128_f8f6f4(Bt[n], At[m], acc[ai][bj][m][n], 0, 0, 0, 0x7D7D7D7D, 0, 0x7D7D7D7D); } \
        else { _Pragma("unroll") for (int m = 0; m < 4; ++m) _Pragma("unroll") for (int n = 0; n < 2; ++n) { \
            acc[ai][bj][m][n] = __builtin_amdgcn_mfma_f32_16x16x32_bf16(G_LO(Bt[n]), G_LO(At[m]), acc[ai][bj][m][n], 0, 0, 0); \
            acc[ai][bj][m][n] = __builtin_amdgcn_mfma_f32_16x16x32_bf16(G_HI(Bt[n]), G_HI(At[m]), acc[ai][bj][m][n], 0, 0, 0); } } \
        __builtin_amdgcn_s_setprio(0); } while (0)
#define G_WAIT_V(n) asm volatile("s_waitcnt vmcnt(" #n ")" ::: "memory")
#define G_WAIT_L(n) asm volatile("s_waitcnt lgkmcnt(" #n ")" ::: "memory")
#define G_BAR __builtin_amdgcn_s_barrier()
#define G_SCHED __builtin_amdgcn_sched_barrier(0)
    GUnit cur, nxt; int ui = 0;
    if (!sched(0, cur)) return;
    LAS unsigned* vst = (LAS unsigned*)(lds + 131072 + 8192) + tid * 8;
    if constexpr (GATHER) { vst[0] = cur.va[0][0]; vst[1] = cur.va[0][1]; vst[2] = cur.va[1][0]; vst[3] = cur.va[1][1]; }
    f32x4 acc[2][2][4][2];
#pragma unroll
    for (int a = 0; a < 2; ++a)
#pragma unroll
        for (int b = 0; b < 2; ++b)
#pragma unroll
            for (int m = 0; m < 4; ++m)
#pragma unroll
                for (int n = 0; n < 2; ++n) acc[a][b][m][n] = (f32x4){0.f, 0.f, 0.f, 0.f};
    v8i_t At[4], B0[2], B1[2];
    G_STAGE(G_SB(0, 0), cur.B, voffB); G_STAGE_A(G_SA(0, 0), cur.A, cur.va[0], 0); G_STAGE(G_SB(0, 1), cur.B + hstepB, voffB); G_STAGE_A(G_SA(0, 1), cur.A, cur.va[1], 1);
    if (wr == 1) G_BAR;
    G_WAIT_V(4); G_BAR;
    G_STAGE(G_SB(1, 0), cur.B + kstep, voffB); G_STAGE_A(G_SA(1, 0), cur.A + kstep, cur.va[0], 0); G_STAGE(G_SB(1, 1), cur.B + hstepB + kstep, voffB);
    G_WAIT_V(6); G_BAR;
    for (;;) {
        const bool has_next = sched(ui + 1, nxt);
        if (!has_next) nxt = cur;
        if constexpr (GATHER) { LAS unsigned* vn = vst + ((ui + 1) & 1) * 4; vn[0] = nxt.va[0][0]; vn[1] = nxt.va[0][1]; vn[2] = nxt.va[1][0]; vn[3] = nxt.va[1][1]; }
#pragma unroll 1
        for (int t = 0; t < nt; t += 2) {
            const bool last = (t == nt - 2);
            const char* a1 = cur.A + (size_t)(t + 1) * kstep;
            const char* a2 = last ? nxt.A : cur.A + (size_t)(t + 2) * kstep; const char* b2 = last ? nxt.B : cur.B + (size_t)(t + 2) * kstep;
            const char* a3 = a2 + kstep; const char* b3 = b2 + kstep;
            G_LDB(B0, 0, 0); G_SCHED; G_LDA(At, 0, 0); { unsigned nv[2] = {0u, 0u}; if constexpr (GATHER) { LAS unsigned* q_ = vst + (ui & 1) * 4; nv[0] = q_[2]; nv[1] = q_[3]; } G_STAGE_A(G_SA(1, 1), a1, nv, 1); }
            G_WAIT_L(8); G_BAR; G_WAIT_L(0); G_MMA(0, 0, At, B0); G_BAR; G_SCHED;
            G_LDB(B1, 0, 1); G_STAGE(G_SB(0, 0), b2, voffB);
            G_BAR; G_WAIT_L(0); G_MMA(0, 1, At, B1); G_BAR;
            G_LDA(At, 0, 1); { unsigned nv[2] = {0u, 0u}; if constexpr (GATHER) { LAS unsigned* q_ = vst + ((ui + (last ? 1 : 0)) & 1) * 4; nv[0] = q_[0]; nv[1] = q_[1]; } G_STAGE_A(G_SA(0, 0), a2, nv, 0); }
            G_BAR; G_WAIT_L(0); G_MMA(1, 0, At, B0); G_BAR; G_SCHED;
            G_STAGE(G_SB(0, 1), b2 + hstepB, voffB);
            G_WAIT_V(6); G_BAR; G_MMA(1, 1, At, B1); G_BAR;
            G_LDB(B0, 1, 0); G_SCHED; G_LDA(At, 1, 0); { unsigned nv[2] = {0u, 0u}; if constexpr (GATHER) { LAS unsigned* q_ = vst + ((ui + (last ? 1 : 0)) & 1) * 4; nv[0] = q_[2]; nv[1] = q_[3]; } G_STAGE_A(G_SA(0, 1), a2, nv, 1); }
            G_WAIT_L(8); G_BAR; G_WAIT_L(0); G_MMA(0, 0, At, B0); G_BAR; G_SCHED;
            G_LDB(B1, 1, 1); G_STAGE(G_SB(1, 0), b3, voffB);
            G_BAR; G_WAIT_L(0); G_MMA(0, 1, At, B1); G_BAR;
            G_LDA(At, 1, 1); { unsigned nv[2] = {0u, 0u}; if constexpr (GATHER) { LAS unsigned* q_ = vst + ((ui + (last ? 1 : 0)) & 1) * 4; nv[0] = q_[0]; nv[1] = q_[1]; } G_STAGE_A(G_SA(1, 0), a3, nv, 0); }
            G_BAR; G_WAIT_L(0); G_MMA(1, 0, At, B0); G_BAR; G_SCHED;
            G_STAGE(G_SB(1, 1), b3 + hstepB, voffB);
            G_WAIT_V(6); G_BAR; G_MMA(1, 1, At, B1); G_BAR;
        }
        { const int l2 = TID512() & 63; epi(acc, cur, wr, wc, l2 & 15, l2 >> 4); }
        if (!has_next) break;
#pragma unroll
        for (int a = 0; a < 2; ++a)
#pragma unroll
            for (int b = 0; b < 2; ++b)
#pragma unroll
                for (int m = 0; m < 4; ++m)
#pragma unroll
                    for (int n = 0; n < 2; ++n) acc[a][b][m][n] = (f32x4){0.f, 0.f, 0.f, 0.f};
        cur = nxt; ++ui;
    }
    G_WAIT_V(0);
    if (wr == 0) G_BAR;
    G_BAR;
#undef G_SA
#undef G_STAGE_A
#undef G_SB
#undef G_STAGE
#undef G_LDA
#undef G_LDB
#undef G_MMA
#undef G_LO
#undef G_HI
#undef G_WAIT_V
#undef G_WAIT_L
#undef G_BAR
#undef G_SCHED
}
DEVINL long unit_linear(int i, int c, int G) { const int q = G >> 3; return ((long)i * 8 + (c & 7)) * q + (c >> 3); }

constexpr int CONV_PER_L = 672 + 256 + 8320 + 4160;
struct ConvJob { const float* src; bf16_t* dst; int K, ld, k0, r0, perm, f8; };
DEVINL ConvJob conv_decode(KP p, int id) {
    ConvJob j; const int l = id / CONV_PER_L; int r = id % CONV_PER_L; int kt, nt;
    if (r < 672) { j.src = p->in[I_WIN] + (size_t)l * 1024 * 2688; j.K = 1024; j.ld = 2688; j.perm = 0; j.dst = (bf16_t*)(p->ws + OFF_WIN + (size_t)l * WIN_ROWS * 1024); j.f8 = 1; nt = r % 42; kt = r / 42; }
    else if (r < 928) { r -= 672; j.src = p->in[I_WOUT] + (size_t)l * 1024 * 1024; j.K = 1024; j.ld = 1024; j.perm = 0; j.dst = (bf16_t*)(p->ws + OFF_WOUT) + (size_t)l * 1024 * 1024; j.f8 = 0; nt = r & 15; kt = r >> 4; }
    else if (r < 928 + 8320) { r -= 928; const int e = r >> 7, q = r & 127; nt = q & 7; kt = q >> 3; j.K = 1024; j.ld = 512; j.perm = 1; j.f8 = 1;
        j.src = (e < 64) ? p->in[I_W13] + (size_t)(l * 64 + e) * 1024 * 512 : p->in[I_WS13] + (size_t)l * 1024 * 512;
        j.dst = (bf16_t*)(p->ws + OFF_W13 + (size_t)(l * 65 + e) * 512 * 1024); }
    else { r -= 9248; const int e = r >> 6, q = r & 63; nt = q & 15; kt = q >> 4; j.K = 256; j.ld = 1024; j.perm = 0; j.f8 = 0;
        j.src = (e < 64) ? p->in[I_W2] + (size_t)(l * 64 + e) * 256 * 1024 : p->in[I_WS2] + (size_t)l * 256 * 1024;
        j.dst = (bf16_t*)(p->ws + OFF_W2) + (size_t)(l * 65 + e) * 1024 * 256; }
    j.k0 = kt * 64; j.r0 = nt * 64; return j;
}
DEVINL void conv_issue(const ConvJob& j, char* buf, int tid) {
    const int nn = tid & 63, drow = j.r0 + nn;
    int scol = drow;
    if (j.perm) { const int g = drow >> 5, i = drow & 31; scol = (i < 16) ? (g * 16 + i) : (256 + g * 16 + (i - 16)); }
    const float* sp = j.src + (size_t)j.k0 * j.ld + scol;
#pragma unroll
    for (int q = 0; q < 16; ++q) { const int kk = (tid >> 6) + 4 * q;
        __builtin_amdgcn_global_load_lds((const unsigned*)(sp + (size_t)kk * j.ld), (unsigned*)(buf + kk * 260 + nn * 4), 4, 0, 0); }
}
DEVINL void convert_ids(KP p, char* lds, int id_lo, int id_hi, int wb, int nwb) {
    const int tid = TIDX();
    const int n = (id_hi - id_lo + nwb - 1) / nwb;
    auto idof = [&](int i) { const int id = id_lo + i * nwb + wb; return (id < id_hi) ? id : id_hi - 1; };
    ConvJob j0 = conv_decode(p, idof(0)), j1 = conv_decode(p, idof(n > 1 ? 1 : 0));
    conv_issue(j0, lds, tid);
    conv_issue(j1, lds + 16640, tid);
    auto dptr = [](const ConvJob& j) { return (char*)j.dst + ((size_t)j.r0 * j.K + j.k0) * (j.f8 ? 1 : 2); };
    char* d0 = dptr(j0); int K0 = j0.K, f0 = j0.f8;
    char* d1 = dptr(j1); int K1 = j1.K, f1 = j1.f8;
    for (int i = 0; i < n; ++i) {
        const ConvJob j2 = conv_decode(p, idof(i + 2 < n ? i + 2 : n - 1));
        conv_issue(j2, lds + ((i + 2) % 3) * 16640, tid);
        asm volatile("s_waitcnt vmcnt(32)" ::: "memory");
        __builtin_amdgcn_s_barrier();
        const float* tile = (const float*)(lds + (i % 3) * 16640);
        if (f0) {
            const int kp = (tid & 15) * 4;
#pragma unroll
            for (int q = 0; q < 4; ++q) { const int rr = (tid >> 4) + 16 * q;
                int w8 = __builtin_amdgcn_cvt_pk_fp8_f32(16.f * tile[kp * 65 + rr], 16.f * tile[(kp + 1) * 65 + rr], 0, false);
                w8 = __builtin_amdgcn_cvt_pk_fp8_f32(16.f * tile[(kp + 2) * 65 + rr], 16.f * tile[(kp + 3) * 65 + rr], w8, true);
                *(int*)(d0 + (size_t)rr * K0 + kp) = w8; }
        } else {
            const int kp = (tid & 31) * 2;
#pragma unroll
            for (int q = 0; q < 8; ++q) { const int rr = (tid >> 5) + 8 * q;
                *(unsigned*)(d0 + ((size_t)rr * K0 + kp) * 2) = pack2(tile[kp * 65 + rr], tile[(kp + 1) * 65 + rr]); }
        }
        asm volatile("s_waitcnt lgkmcnt(0)" ::: "memory");
        __builtin_amdgcn_s_barrier();
        d0 = d1; K0 = K1; f0 = f1; d1 = dptr(j2); K1 = j2.K; f1 = j2.f8;
    }
    asm volatile("s_waitcnt vmcnt(0)" ::: "memory");
    __syncthreads();
}

DEVINL void phase0(KP p, char* lds) {
    const int tid = TIDX(), nb = NBV(), blk = BIDX();
    if (blk == 0 && tid < 128) ((unsigned*)(p->ws + OFF_CNT))[tid] = 0u;
    if (blk < 192) {
        float* sc = (float*)lds;
        float* part = (float*)(lds + 32768);
        for (int i = tid; i < 8192; i += VTHREADS) { float c = p->in[I_C][i]; sc[i] = c * sigm(c); }
        __syncthreads();
        const int cl = tid & 63, ks = tid >> 6, n = blk * 64 + cl, l = n / 6144, nn = n % 6144;
        const float* w = p->in[I_WMOD] + (size_t)l * 1024 * 6144 + (size_t)(ks * 256) * 6144 + nn;
        float acc[8];
#pragma unroll
        for (int b = 0; b < 8; ++b) acc[b] = 0.f;
#pragma unroll 32
        for (int k = 0; k < 256; ++k) {
            const float wv = w[(size_t)k * 6144];
#pragma unroll
            for (int b = 0; b < 8; ++b) acc[b] = fmaf(sc[b * 1024 + ks * 256 + k], wv, acc[b]);
        }
#pragma unroll
        for (int b = 0; b < 8; ++b) part[(ks * 8 + b) * 64 + cl] = acc[b];
        __syncthreads();
        if (tid < 64) {
            const float bm = p->in[I_BMOD][l * 6144 + nn];
            float* mod = (float*)(p->ws + OFF_MOD);
#pragma unroll
            for (int b = 0; b < 8; ++b) mod[(size_t)(l * 8 + b) * 6144 + nn] = part[(0 * 8 + b) * 64 + cl] + part[(1 * 8 + b) * 64 + cl] + part[(2 * 8 + b) * 64 + cl] + part[(3 * 8 + b) * 64 + cl] + bm;
        }
        __syncthreads();
    }
    if (blk >= 320 && blk < 384) {
        bf16_t* wgt = (bf16_t*)(p->ws + OFF_WGT);
#pragma unroll
        for (int j = 0; j < 4; ++j) {
            const int idx = (blk - 320) * 1024 + j * 256 + tid;
            const int mat = idx >> 15, lh = (idx >> 12) & 7, d = (idx >> 6) & 63, e = idx & 63;
            const float w = (mat == 0) ? p->in[I_WRG][idx & 32767] : p->in[I_WIG][idx & 32767];
            wgt[(size_t)((lh * 2 + mat) * 64 + e) * 64 + d] = f2bf(w);
        }
    }
    if (blk >= 256 && blk < 320) {
        bf16_t* wlt = (bf16_t*)(p->ws + OFF_WLT);
#pragma unroll
        for (int j = 0; j < 4; ++j) {
            const int idx = (blk - 256) * 1024 + j * 256 + tid, l2 = idx >> 15, f = (idx >> 8) & 127, c = idx & 255;
            const float w = (f < 32) ? p->in[I_WW2][(size_t)(l2 * 32 + f) * 256 + c] : ((f < 64) ? p->in[I_WA2][(size_t)(l2 * 32 + f - 32) * 256 + c] : p->in[I_WG2][(size_t)(l2 * 64 + f - 64) * 256 + c]);
            wlt[(size_t)(l2 * 256 + c) * 128 + f] = f2bf(w);
        }
    }
    if (blk >= 192 && blk < 256) {
        bf16_t* wrt = (bf16_t*)(p->ws + OFF_WR);
#pragma unroll
        for (int j = 0; j < 8; ++j) {
            const int idx = (blk - 192) * 2048 + j * 256 + tid, l2 = idx >> 16, rem = idx & 65535, k = rem >> 6, e = rem & 63;
            const float w = p->in[I_WROUTER][idx];
            const bf16_t hi = f2bf(w); const bf16_t lo = f2bf(w - bf2f(hi));
            wrt[(size_t)((l2 * 2 + 0) * 64 + e) * 1024 + k] = hi; wrt[(size_t)((l2 * 2 + 1) * 64 + e) * 1024 + k] = lo;
        }
    }
    convert_ids(p, lds, 0, 2 * CONV_PER_L, blk, nb);
}

DEVINL void phaseF0(KP p) {
    const int tid = TIDX(), nb = NBV(), blk = BIDX();
    const float* mod = (const float*)(p->ws + OFF_MOD);
    bf16_t* ubuf = (bf16_t*)(p->ws + OFF_UBUF);
    const int col = tid * 4;
    for (int row0 = blk * 8; row0 < NTOK; row0 += nb * 8) {
        float4 x[8];
#pragma unroll
        for (int u = 0; u < 8; ++u) x[u] = *(const float4*)(p->in[I_X] + (size_t)(row0 + u) * DM + col);
        const int b = row0 >> 12;
        const float4 sh = *(const float4*)(mod + (size_t)b * 6144 + col);
        const float4 sc = *(const float4*)(mod + (size_t)b * 6144 + 1024 + col);
#pragma unroll
        for (int u = 0; u < 8; ++u) {
            int w8 = __builtin_amdgcn_cvt_pk_fp8_f32(x[u].x * (1.f + sc.x) + sh.x, x[u].y * (1.f + sc.y) + sh.y, 0, false);
            w8 = __builtin_amdgcn_cvt_pk_fp8_f32(x[u].z * (1.f + sc.z) + sh.z, x[u].w * (1.f + sc.w) + sh.w, w8, true);
            *(int*)((char*)ubuf + (size_t)(row0 + u) * DM + col) = w8;
        }
    }
}

DEVINL void b1_conformer(KP p, int l, char* lds, int item) {
    const int tid = TIDX(), b = item >> 7, tt = item & 127, t0 = tt * 32, rowbase = b * SEQ;
    const bf16_t* P = (const bf16_t*)(p->ws + A_P);
    bf16_t* ymix = (bf16_t*)(p->ws + A_YMIX);
    float w[31];
#pragma unroll
    for (int k = 0; k < 31; ++k) w[k] = p->in[I_CONVA][(size_t)(l * 31 + k) * 256 + tid];
    float acc[32];
    const float bias = p->in[I_CONVAB][l * 256 + tid];
#pragma unroll
    for (int j = 0; j < 32; ++j) acc[j] = bias;
#pragma unroll
    for (int rr = 0; rr < 62; ++rr) {
        const int t = t0 - 30 + rr;
        const bf16_t* pr = P + ((long)(rowbase + t0 - 30) * PIN + tid) + (long)rr * PIN;
        const float val = bf2f(pr[0]), gate = bf2f(pr[256]);
        const float h = (t >= 0) ? val * sigm(gate) : 0.f;
#pragma unroll
        for (int j = 0; j < 32; ++j) { const int k = rr - j; if (k >= 0 && k <= 30) acc[j] = fmaf(w[k], h, acc[j]); }
    }
    float* outb = (float*)lds;
#pragma unroll
    for (int j = 0; j < 32; ++j) outb[j * 256 + tid] = acc[j];
    __syncthreads();
    const int wid = tid >> 6, lane = tid & 63;
    const float4 g4 = *(const float4*)(p->in[I_LNAG] + l * 256 + lane * 4), b4 = *(const float4*)(p->in[I_LNAB] + l * 256 + lane * 4);
    for (int j = wid; j < 32; j += 4) {
        const float4 v = *(const float4*)(outb + j * 256 + lane * 4);
        const float mean = wave_sum(v.x + v.y + v.z + v.w) * (1.f / 256.f);
        const float d0 = v.x - mean, d1 = v.y - mean, d2 = v.z - mean, d3 = v.w - mean;
        const float var = wave_sum(d0 * d0 + d1 * d1 + d2 * d2 + d3 * d3) * (1.f / 256.f);
        const float rs = rsqrtf(var + LN_EPS);
        float y0 = d0 * rs * g4.x + b4.x, y1 = d1 * rs * g4.y + b4.y, y2 = d2 * rs * g4.z + b4.z, y3 = d3 * rs * g4.w + b4.w;
        y0 *= sigm(y0); y1 *= sigm(y1); y2 *= sigm(y2); y3 *= sigm(y3);
        uint2 o; o.x = pack2(y0, y1); o.y = pack2(y2, y3);
        *(uint2*)(ymix + (size_t)(rowbase + t0 + j) * DM + lane * 4) = o;
    }
    __syncthreads();
}

DEVINL void b1_shortconv(KP p, int l, int item) {
    const int tid = TIDX(), cg = tid & 31, tl = tid >> 5, b = item >> 6, t0 = (item & 63) * 64 + tl * 8, rowbase = b * SEQ;
    const bf16_t* P = (const bf16_t*)(p->ws + A_P);
    bf16_t* ymix = (bf16_t*)(p->ws + A_YMIX);
    float w0[8], w1[8], w2[8];
#pragma unroll
    for (int e = 0; e < 8; ++e) { w0[e] = p->in[I_CONVD][(l * 3 + 0) * 256 + cg * 8 + e]; w1[e] = p->in[I_CONVD][(l * 3 + 1) * 256 + cg * 8 + e]; w2[e] = p->in[I_CONVD][(l * 3 + 2) * 256 + cg * 8 + e]; }
    uint4 gbv[8], gcv[10], hdv[10];
#pragma unroll
    for (int u = 0; u < 10; ++u) {
        const int t = t0 - 2 + u;
        const bf16_t* a = P + (size_t)(rowbase + (t >= 0 ? t : 0)) * PIN + 1920 + cg * 8;
        gcv[u] = *(const uint4*)(a + 256); hdv[u] = *(const uint4*)(a + 512);
        if (u >= 2) gbv[u - 2] = *(const uint4*)(a);
    }
    float q2[8], q1[8];
#pragma unroll
    for (int u = 0; u < 10; ++u) {
        const int t = t0 - 2 + u;
        const unsigned gcw[4] = {gcv[u].x, gcv[u].y, gcv[u].z, gcv[u].w}, hdw[4] = {hdv[u].x, hdv[u].y, hdv[u].z, hdv[u].w};
        float q0[8];
#pragma unroll
        for (int e = 0; e < 4; ++e) {
            q0[2 * e] = __uint_as_float(gcw[e] << 16) * __uint_as_float(hdw[e] << 16);
            q0[2 * e + 1] = __uint_as_float(gcw[e] & 0xFFFF0000u) * __uint_as_float(hdw[e] & 0xFFFF0000u);
        }
        if (t < 0) {
#pragma unroll
            for (int e = 0; e < 8; ++e) q0[e] = 0.f;
        }
        if (u >= 2) {
            const unsigned gbw[4] = {gbv[u - 2].x, gbv[u - 2].y, gbv[u - 2].z, gbv[u - 2].w};
            float y[8];
#pragma unroll
            for (int e = 0; e < 4; ++e) {
                y[2 * e] = __uint_as_float(gbw[e] << 16) * (w0[2 * e] * q2[2 * e] + w1[2 * e] * q1[2 * e] + w2[2 * e] * q0[2 * e]);
                y[2 * e + 1] = __uint_as_float(gbw[e] & 0xFFFF0000u) * (w0[2 * e + 1] * q2[2 * e + 1] + w1[2 * e + 1] * q1[2 * e + 1] + w2[2 * e + 1] * q0[2 * e + 1]);
            }
            *(uint4*)(ymix + (size_t)(rowbase + t) * DM + 768 + cg * 8) = make_uint4(pack2(y[0], y[1]), pack2(y[2], y[3]), pack2(y[4], y[5]), pack2(y[6], y[7]));
        }
#pragma unroll
        for (int e = 0; e < 8; ++e) { q2[e] = (u >= 1) ? q1[e] : 0.f; q1[e] = q0[e]; }
    }
}

DEVINL void b1_lru(KP p, int l, char* lds, int item) {
    const int c = TIDX(), b = item >> 7, tt = item & 127, t0 = tt * 32, rowbase = b * SEQ;
    const int h = c >> 6, lane = c & 63, r = lane & 31, hh = lane >> 5;
    const bf16_t* P = (const bf16_t*)(p->ws + A_P);
    constexpr int URS2 = 528;
    char* uA = lds;
    float ureg[32];
    {
        const float cb0 = p->in[I_CONVB][(l * 4 + 0) * 256 + c], cb1 = p->in[I_CONVB][(l * 4 + 1) * 256 + c], cb2 = p->in[I_CONVB][(l * 4 + 2) * 256 + c], cb3 = p->in[I_CONVB][(l * 4 + 3) * 256 + c];
        const float bias = p->in[I_CONVBB][l * 256 + c];
        float xm3 = 0.f, xm2 = 0.f, xm1 = 0.f;
        if (t0 >= 3) { const bf16_t* a = P + (size_t)(rowbase + t0 - 3) * PIN + 512 + c; xm3 = bf2f(a[0]); xm2 = bf2f(a[PIN]); xm1 = bf2f(a[2 * PIN]); }
        bf16_t xr[32];
#pragma unroll
        for (int j = 0; j < 32; ++j) xr[j] = P[(size_t)(rowbase + t0 + j) * PIN + 512 + c];
#pragma unroll
        for (int j = 0; j < 32; ++j) {
            const float x0 = bf2f(xr[j]);
            ureg[j] = cb0 * xm3 + cb1 * xm2 + cb2 * xm1 + cb3 * x0 + bias;
            *(bf16_t*)(uA + j * URS2 + c * 2) = f2bf(ureg[j]);
            xm3 = xm2; xm2 = xm1; xm1 = x0;
        }
    }
    __syncthreads();
    float ar[32], ai[32];
    {
        const bf16_t* wg = (const bf16_t*)(p->ws + OFF_WGT) + (size_t)((l * 4 + h) * 2) * 4096 + (size_t)r * 64 + 8 * hh;
        f32x16 aR0, aR1, aI0, aI1;
#pragma unroll
        for (int i = 0; i < 16; ++i) { aR0[i] = 0.f; aR1[i] = 0.f; aI0[i] = 0.f; aI1[i] = 0.f; }
#pragma unroll
        for (int ks = 0; ks < 4; ++ks) {
            const bf16x8 af = *(const bf16x8*)(uA + r * URS2 + (h * 64 + ks * 16 + 8 * hh) * 2);
            const bf16x8 r0 = *(const bf16x8*)(wg + ks * 16), r1 = *(const bf16x8*)(wg + 32 * 64 + ks * 16);
            const bf16x8 i0 = *(const bf16x8*)(wg + 4096 + ks * 16), i1 = *(const bf16x8*)(wg + 4096 + 32 * 64 + ks * 16);
            aR0 = MFMA32(af, r0, aR0); aR1 = MFMA32(af, r1, aR1); aI0 = MFMA32(af, i0, aI0); aI1 = MFMA32(af, i1, aI1);
        }
        __syncthreads();
        float* xch = (float*)(lds + 17408) + h * 2048;
#define XCHG(X0, X1, OUT) do { _Pragma("unroll") for (int i = 0; i < 16; ++i) { const int t_ = (i & 3) + 8 * (i >> 2) + 4 * hh; xch[t_ * 64 + r] = X0[i]; xch[t_ * 64 + 32 + r] = X1[i]; } \
        _Pragma("unroll") for (int t_ = 0; t_ < 32; ++t_) OUT[t_] = xch[t_ * 64 + lane]; } while (0)
        XCHG(aR0, aR1, ar); XCHG(aI0, aI1, ai);
#undef XCHG
    }
    const float brg = p->in[I_BRG][l * 256 + c], big = p->in[I_BIG][l * 256 + c];
    const float sp = softplus_acc(-p->in[I_LAMBDA][l * 256 + c]);
    unsigned* hp = (unsigned*)(p->ws + A_HLOC) + (size_t)(rowbase + t0) * 256 + c;
    float hs = 0.f, cA = 1.f;
#pragma unroll
    for (int j = 0; j < 32; ++j) {
        const float rg = sigm(ar[j] + brg), ig = sigm(ai[j] + big);
        const float log_a = -8.0f * rg * sp;
        const float a = __expf(log_a);
        const float mult = sqrtf(fmaxf(1.f - a * a, 0.f));
        const float bx = mult * (ig * ureg[j]);
        hs = fmaf(a, hs, bx); cA *= a;
        hp[j * 256] = pack2(hs, cA);
    }
    ((float*)(p->ws + A_CARRYA))[(size_t)(b * 128 + tt) * 256 + c] = cA;
    ((float*)(p->ws + A_CARRYH))[(size_t)(b * 128 + tt) * 256 + c] = hs;
    __syncthreads();
}

DEVINL void b1_rwkv(KP p, int l, char* lds, int item) {
    const int c = TIDX(), b = item >> 7, tt = item & 127, t0 = tt * 32, rowbase = b * SEQ;
    const bf16_t* P = (const bf16_t*)(p->ws + A_P);
    constexpr int FRS = 272;
    char* featA = lds;
    const float* muc = p->in[I_MUC] + l * 896;
    if (c < 128) {
        const int col = 1024 + 768 + c; const float mu = muc[768 + c];
        float prev;
        { const float x = bf2f(P[(size_t)(rowbase + (t0 > 0 ? t0 - 1 : 0)) * PIN + col]); prev = (t0 > 0) ? x : 0.f; }
#pragma unroll 1
        for (int jb = 0; jb < 2; ++jb) {
            bf16_t raw[16];
#pragma unroll
            for (int u = 0; u < 16; ++u) raw[u] = P[(size_t)(rowbase + t0 + jb * 16 + u) * PIN + col];
#pragma unroll
            for (int u = 0; u < 16; ++u) {
                const float cur = bf2f(raw[u]);
                const float xs = cur + (prev - cur) * mu;
                const float val = (c < 32) ? tanh_fast(xs) : ((c < 64) ? xs : sigm(xs));
                *(bf16_t*)(featA + (jb * 16 + u) * FRS + c * 2) = f2bf(val); prev = cur;
            }
        }
    }
    __syncthreads();
    float dec[32], aa[32];
    {
        const int lane = c & 63, h = c >> 6, r = lane & 31, hh = lane >> 5;
        const bf16_t* wl = (const bf16_t*)(p->ws + OFF_WLT) + (size_t)(l * 256 + h * 64 + r) * 128 + 8 * hh;
        f32x16 aW0, aW1, aA0, aA1, aG0, aG1;
#pragma unroll
        for (int i = 0; i < 16; ++i) { aW0[i] = 0.f; aW1[i] = 0.f; aA0[i] = 0.f; aA1[i] = 0.f; aG0[i] = 0.f; aG1[i] = 0.f; }
        bf16x8 b0[8], b1[8];
#pragma unroll
        for (int ks = 0; ks < 8; ++ks) { b0[ks] = *(const bf16x8*)(wl + ks * 16); b1[ks] = *(const bf16x8*)(wl + 32 * 128 + ks * 16); }
#pragma unroll
        for (int ks = 0; ks < 8; ++ks) {
            const bf16x8 af = *(const bf16x8*)(featA + r * FRS + (ks * 16 + 8 * hh) * 2);
            if (ks < 2) { aW0 = MFMA32(af, b0[ks], aW0); aW1 = MFMA32(af, b1[ks], aW1); }
            else if (ks < 4) { aA0 = MFMA32(af, b0[ks], aA0); aA1 = MFMA32(af, b1[ks], aA1); }
            else { aG0 = MFMA32(af, b0[ks], aG0); aG1 = MFMA32(af, b1[ks], aG1); }
        }
        __syncthreads();
        float* xch = (float*)(lds + 9216) + h * 2048;
        float lwv[32], lav[32], lgv[32];
#define XCHG(X0, X1, OUT) do { _Pragma("unroll") for (int i = 0; i < 16; ++i) { const int t_ = (i & 3) + 8 * (i >> 2) + 4 * hh; xch[t_ * 64 + r] = X0[i]; xch[t_ * 64 + 32 + r] = X1[i]; } \
        _Pragma("unroll") for (int t_ = 0; t_ < 32; ++t_) OUT[t_] = xch[t_ * 64 + lane]; } while (0)
        XCHG(aW0, aW1, lwv); XCHG(aA0, aA1, lav); XCHG(aG0, aG1, lgv);
#undef XCHG
#define TOK(X0, X1, t) X0[t]
#define aW0 lwv
#define aA0 lav
#define aG0 lgv
        bf16_t* gbuf = (bf16_t*)(p->ws + A_G);
        const float w0 = p->in[I_W0][l * 256 + c], a0 = p->in[I_A0][l * 256 + c];
#pragma unroll
        for (int j = 0; j < 32; ++j) {
            gbuf[(size_t)(rowbase + t0 + j) * 256 + c] = f2bf(TOK(aG0, aG1, j));
            const float z = w0 + TOK(aW0, aW1, j); const float wlog = -softplusf(-z) - 0.5f; dec[j] = -__expf(wlog);
            aa[j] = sigm(a0 + TOK(aA0, aA1, j));
        }
#undef TOK
#undef aW0
#undef aA0
#undef aG0
    }
    {
        bf16_t* bonus = (bf16_t*)(p->ws + A_BONUS); uint4* scan = (uint4*)(p->ws + A_SCAN);
        const float mur = muc[c], muk = muc[256 + c], muv = muc[512 + c];
        const float kkw = p->in[I_KK][l * 256 + c], kaw = p->in[I_KA][l * 256 + c], rkw = p->in[I_RK][l * 256 + c];
        float pr, pk, pv;
        { const bf16_t* a = P + (size_t)(rowbase + (t0 > 0 ? t0 - 1 : 0)) * PIN + 1024 + c; const float x0 = bf2f(a[0]), x1 = bf2f(a[256]), x2 = bf2f(a[512]);
          pr = (t0 > 0) ? x0 : 0.f; pk = (t0 > 0) ? x1 : 0.f; pv = (t0 > 0) ? x2 : 0.f; }
#pragma unroll
        for (int jb = 0; jb < 2; ++jb) {
            bf16_t rr_[16], rk_[16], rv_[16];
#pragma unroll
            for (int u = 0; u < 16; ++u) { const bf16_t* a = P + (size_t)(rowbase + t0 + jb * 16 + u) * PIN + 1024 + c; rr_[u] = a[0]; rk_[u] = a[256]; rv_[u] = a[512]; }
#pragma unroll
            for (int u = 0; u < 16; ++u) {
                const int j = jb * 16 + u;
                const size_t row = (size_t)(rowbase + t0 + j);
                const float cr = bf2f(rr_[u]), ck = bf2f(rk_[u]), cv = bf2f(rv_[u]);
                const float r = cr + (pr - cr) * mur, k = ck + (pk - ck) * muk, v = cv + (pv - cv) * muv;
                pr = cr; pk = ck; pv = cv;
                const float kk = k * kkw;
                const float ss = wave_sum(kk * kk);
                const float kkn = kk * rsqrtf(ss + 1e-12f);
                const float kf = k * (1.f + (aa[j] - 1.f) * kaw);
                const float bs = wave_sum(r * kf * rkw);
                bonus[row * 256 + c] = f2bf(bs * v);
                uint4 o; o.x = pack2(kkn, kkn * aa[j]); o.y = pack2(kf, r); o.z = pack2(v, 0.f); o.w = __float_as_uint(dec[j]);
                scan[row * 256 + c] = o;
            }
            asm volatile("" ::: "memory");
        }
    }
    __syncthreads();
}

constexpr int S_AL = 0, S_BE = 8192, S_KA = 16384, S_RH = 24576, S_BET = 32768, S_KAT = 40960, S_VT = 49152, S_L2F = 57344  , S_GT = 73728  ;
constexpr int S_L1F = S_BE;
constexpr int S_M1 = S_BE, S_M2 = S_KA;
constexpr int S_APT = S_L2F, S_W2T = S_L2F + 8192;
constexpr int S_RP = S_AL, S_GTR = S_RH;
DEVINL int crow32(int reg, int h) { return (reg & 3) + 8 * (reg >> 2) + 4 * h; }
DEVINL bf16x8 frag64(const char* lds, int slot, int row, int kel) { return *reinterpret_cast<const bf16x8*>(lds + slot + row * 128 + kel * 2); }
DEVINL float dpp_xor1(float x) { return __builtin_bit_cast(float, __builtin_amdgcn_update_dpp(0, __builtin_bit_cast(int, x), 0xB1, 0xf, 0xf, true)); }

DEVINL f32x16 mm64(const char* lds, int slotA, int slotB, int tm, int tn, int r, int hh, f32x16 acc) {
#pragma unroll
    for (int ks = 0; ks < 4; ++ks) acc = MFMA32(frag64(lds, slotA, tm * 32 + r, ks * 16 + 8 * hh), frag64(lds, slotB, tn * 32 + r, ks * 16 + 8 * hh), acc);
    return acc;
}

DEVINL void b1e_unit(KP p, char* lds, int b, int h, int c) {
    const int tid = TIDX(), wv = tid >> 6, lane = tid & 63, r = lane & 31, hh = lane >> 5;
    const uint4* scan = (const uint4*)(p->ws + A_SCAN) + ((size_t)(b * SEQ + c * 64)) * 256 + h * 64;
    float* gtot = (float*)(lds + S_GT); float* gamC = gtot + 256;
    {
        const int j = lane;
        float lw[16]; unsigned px[16], py[16], pz[16];
#pragma unroll
        for (int u = 0; u < 16; ++u) { const uint4 q = scan[(size_t)(wv * 16 + u) * 256 + j]; px[u] = q.x; py[u] = q.y; pz[u] = q.z; lw[u] = __uint_as_float(q.w); }
        float tot = 0.f;
#pragma unroll
        for (int u = 0; u < 16; ++u) tot += lw[u];
        gtot[wv * 64 + j] = tot;
        __syncthreads();
        float off = 0.f, all = 0.f;
#pragma unroll
        for (int g = 0; g < 4; ++g) { const float v = gtot[g * 64 + j]; all += v; off += (g < wv) ? v : 0.f; }
        if (wv == 0) gamC[j] = __expf(all);
        float cum = off;
        unsigned tb[8], tk[8], tv[8];
#pragma unroll
        for (int u = 0; u < 16; ++u) {
            const float kkn = __uint_as_float(px[u] << 16), bb = __uint_as_float(px[u] & 0xFFFF0000u);
            const float kf = __uint_as_float(py[u] << 16), rr = __uint_as_float(py[u] & 0xFFFF0000u);
            const float gp = __expf(cum); cum += lw[u];
            const float g = __expf(cum), en = __expf(-cum);
            const int t = wv * 16 + u;
            const unsigned be = f2bf(bb * en), ka = f2bf(kf * en);
            *(bf16_t*)(lds + S_AL + t * 128 + j * 2) = f2bf(gp * kkn);
            *(bf16_t*)(lds + S_BE + t * 128 + j * 2) = (bf16_t)be;
            *(bf16_t*)(lds + S_KA + t * 128 + j * 2) = (bf16_t)ka;
            *(bf16_t*)(lds + S_RH + t * 128 + j * 2) = f2bf(g * rr);
            if (u & 1) { tb[u >> 1] |= be << 16; tk[u >> 1] |= ka << 16; tv[u >> 1] |= (pz[u] << 16); }
            else { tb[u >> 1] = be; tk[u >> 1] = ka; tv[u >> 1] = pz[u] & 0xFFFFu; }
        }
        *(uint4*)(lds + S_BET + j * 128 + wv * 32) = make_uint4(tb[0], tb[1], tb[2], tb[3]); *(uint4*)(lds + S_BET + j * 128 + wv * 32 + 16) = make_uint4(tb[4], tb[5], tb[6], tb[7]);
        *(uint4*)(lds + S_KAT + j * 128 + wv * 32) = make_uint4(tk[0], tk[1], tk[2], tk[3]); *(uint4*)(lds + S_KAT + j * 128 + wv * 32 + 16) = make_uint4(tk[4], tk[5], tk[6], tk[7]);
        *(uint4*)(lds + S_VT + j * 128 + wv * 32) = make_uint4(tv[0], tv[1], tv[2], tv[3]); *(uint4*)(lds + S_VT + j * 128 + wv * 32 + 16) = make_uint4(tv[4], tv[5], tv[6], tv[7]);
    }
    __syncthreads();
    const int tm = wv >> 1, tn = wv & 1;
    f32x16 aM1, aM2;
    {
        f32x16 aL1, aL2;
#pragma unroll
        for (int i = 0; i < 16; ++i) { aL1[i] = 0.f; aL2[i] = 0.f; aM1[i] = 0.f; aM2[i] = 0.f; }
#pragma unroll
        for (int ks = 0; ks < 4; ++ks) {
            const bf16x8 fa = frag64(lds, S_AL, tm * 32 + r, ks * 16 + 8 * hh), fr = frag64(lds, S_RH, tm * 32 + r, ks * 16 + 8 * hh);
            const bf16x8 fb = frag64(lds, S_BE, tn * 32 + r, ks * 16 + 8 * hh), fk = frag64(lds, S_KA, tn * 32 + r, ks * 16 + 8 * hh);
            aL1 = MFMA32(fa, fb, aL1); aL2 = MFMA32(fa, fk, aL2); aM1 = MFMA32(fr, fb, aM1); aM2 = MFMA32(fr, fk, aM2);
        }
        __syncthreads();
#pragma unroll
        for (int reg = 0; reg < 16; ++reg) {
            const int t = tm * 32 + crow32(reg, hh), sidx = tn * 32 + r;
            const int o = (t * 64 + (sidx & 1) * 32 + (sidx >> 1)) * 4;
            *(float*)(lds + S_L1F + o) = (sidx < t) ? aL1[reg] : 0.f;
            *(float*)(lds + S_L2F + o) = (sidx < t) ? aL2[reg] : 0.f;
            aM1[reg] = (sidx <= t) ? aM1[reg] : 0.f; aM2[reg] = (sidx <= t) ? aM2[reg] : 0.f;
        }
    }
    __syncthreads();
    unsigned outp[32];
    {
        const int col = (wv & 1) * 32 + (lane >> 1), q = lane & 1;
        float xq[32];
#pragma unroll
        for (int k = 0; k < 32; ++k) xq[k] = 0.f;
        const char* l1row = lds + S_L1F + q * 128;
        const char* l2row = lds + S_L2F + q * 128;
        if (wv < 2) {
#pragma unroll
            for (int t = 0; t < 64; ++t) {
                float acc = 0.f;
#pragma unroll
                for (int k4 = 0; k4 * 4 < (t + 1) / 2; ++k4) {
                    const float4 a = *(const float4*)(l1row + t * 256 + k4 * 16);
                    acc = fmaf(a.x, xq[4 * k4 + 0], acc); acc = fmaf(a.y, xq[4 * k4 + 1], acc); acc = fmaf(a.z, xq[4 * k4 + 2], acc); acc = fmaf(a.w, xq[4 * k4 + 3], acc);
                }
                acc += dpp_xor1(acc);
                const float x = bf2f(*(const bf16_t*)(lds + S_AL + t * 128 + col * 2)) - acc;
                xq[t >> 1] = ((t & 1) == q) ? x : xq[t >> 1];
            }
        } else {
            float vq[32];
#pragma unroll
            for (int k8 = 0; k8 < 8; ++k8) {
                const uint4 d = *(const uint4*)(lds + S_VT + col * 128 + k8 * 16);
                vq[4 * k8 + 0] = q ? __uint_as_float(d.x & 0xFFFF0000u) : __uint_as_float(d.x << 16);
                vq[4 * k8 + 1] = q ? __uint_as_float(d.y & 0xFFFF0000u) : __uint_as_float(d.y << 16);
                vq[4 * k8 + 2] = q ? __uint_as_float(d.z & 0xFFFF0000u) : __uint_as_float(d.z << 16);
                vq[4 * k8 + 3] = q ? __uint_as_float(d.w & 0xFFFF0000u) : __uint_as_float(d.w << 16);
            }
#pragma unroll
            for (int t = 0; t < 64; ++t) {
                float acc = 0.f;
#pragma unroll
                for (int k4 = 0; k4 * 4 < (t + 1) / 2; ++k4) {
                    const float4 a = *(const float4*)(l1row + t * 256 + k4 * 16);
                    const float4 bq = *(const float4*)(l2row + t * 256 + k4 * 16);
                    acc = fmaf(bq.x, vq[4 * k4 + 0], acc); acc = fmaf(bq.y, vq[4 * k4 + 1], acc); acc = fmaf(bq.z, vq[4 * k4 + 2], acc); acc = fmaf(bq.w, vq[4 * k4 + 3], acc);
                    acc = fmaf(-a.x, xq[4 * k4 + 0], acc); acc = fmaf(-a.y, xq[4 * k4 + 1], acc); acc = fmaf(-a.z, xq[4 * k4 + 2], acc); acc = fmaf(-a.w, xq[4 * k4 + 3], acc);
                }
                acc += dpp_xor1(acc);
                xq[t >> 1] = ((t & 1) == q) ? acc : xq[t >> 1];
            }
        }
#pragma unroll
        for (int k = 0; k < 32; ++k) { const float o = dpp_xor1(xq[k]); outp[k] = q ? pack2(o, xq[k]) : pack2(xq[k], o); }
    }
    __syncthreads();
    {
        const int col = (wv & 1) * 32 + (lane >> 1), q = lane & 1;
        char* dst = lds + ((wv < 2) ? S_APT : S_W2T) + col * 128 + q * 64;
#pragma unroll
        for (int i = 0; i < 4; ++i) *(uint4*)(dst + i * 16) = q ? make_uint4(outp[16 + 4 * i], outp[17 + 4 * i], outp[18 + 4 * i], outp[19 + 4 * i]) : make_uint4(outp[4 * i], outp[4 * i + 1], outp[4 * i + 2], outp[4 * i + 3]);
#pragma unroll
        for (int reg = 0; reg < 16; ++reg) {
            const int t = tm * 32 + crow32(reg, hh), sidx = tn * 32 + r;
            *(bf16_t*)(lds + S_M1 + t * 128 + sidx * 2) = f2bf(aM1[reg]);
            *(bf16_t*)(lds + S_M2 + t * 128 + sidx * 2) = f2bf(aM2[reg]);
        }
    }
    __syncthreads();
    unsigned char* ubase = p->ws + A_CHAIN + (size_t)((b * 4 + h) * 64 + c) * CHAIN_UNIT;
    f32x16 zero;
#pragma unroll
    for (int i = 0; i < 16; ++i) zero[i] = 0.f;
    f32x16 gt;
    {
        const f32x16 qv = mm64(lds, S_M1, S_APT, tm, tn, r, hh, zero);
        const f32x16 y0 = mm64(lds, S_M2, S_VT, tm, tn, r, hh, zero) - mm64(lds, S_M1, S_W2T, tm, tn, r, hh, zero);
        gt = mm64(lds, S_BET, S_APT, tm, tn, r, hh, zero);
        const f32x16 ht = mm64(lds, S_KAT, S_VT, tm, tn, r, hh, zero) - mm64(lds, S_BET, S_W2T, tm, tn, r, hh, zero);
#pragma unroll
        for (int reg = 0; reg < 16; ++reg) {
            const int t = tm * 32 + crow32(reg, hh), jc = tn * 32 + r;
            const float rh = bf2f(*(const bf16_t*)(lds + S_RH + t * 128 + jc * 2));
            *(bf16_t*)(lds + S_RP + t * 128 + jc * 2) = f2bf(rh - qv[reg]);
            const int jr = tm * 32 + crow32(reg, hh);
            const float gc = gamC[jr];
            gt[reg] = gc * (((jr == jc) ? 1.f : 0.f) - gt[reg]);
        }
        float4* himg = (float4*)(ubase + 16384); float4* yimg = (float4*)(ubase + 32768);
#pragma unroll
        for (int rq = 0; rq < 4; ++rq) {
            float4 hv, yv;
            hv.x = gamC[tm * 32 + crow32(4 * rq + 0, hh)] * ht[4 * rq + 0]; hv.y = gamC[tm * 32 + crow32(4 * rq + 1, hh)] * ht[4 * rq + 1];
            hv.z = gamC[tm * 32 + crow32(4 * rq + 2, hh)] * ht[4 * rq + 2]; hv.w = gamC[tm * 32 + crow32(4 * rq + 3, hh)] * ht[4 * rq + 3];
            yv.x = y0[4 * rq + 0]; yv.y = y0[4 * rq + 1]; yv.z = y0[4 * rq + 2]; yv.w = y0[4 * rq + 3];
            himg[((tn * 2 + tm) * 4 + rq) * 64 + lane] = hv;
            yimg[((tn * 2 + tm) * 4 + rq) * 64 + lane] = yv;
        }
    }
    __syncthreads();
#pragma unroll
    for (int reg = 0; reg < 16; ++reg) {
        const int jr = tm * 32 + crow32(reg, hh), jc = tn * 32 + r;
        *(bf16_t*)(lds + S_GTR + jr * 128 + jc * 2) = f2bf(gt[reg]);
    }
    __syncthreads();
    {
        uint4* gimg = (uint4*)(ubase); uint4* rimg = (uint4*)(ubase + 8192);
#pragma unroll
        for (int ii = 0; ii < 2; ++ii) {
            const int im = wv * 2 + ii, mt = im >> 2, jb = (im >> 1) & 1, s2 = im & 1;
            const int cbase = (32 * jb + 16 * s2 + 4 * hh) * 2;
            const uint2 g0 = *(const uint2*)(lds + S_GTR + (mt * 32 + r) * 128 + cbase), g1 = *(const uint2*)(lds + S_GTR + (mt * 32 + r) * 128 + cbase + 16);
            const uint2 r0 = *(const uint2*)(lds + S_RP + (mt * 32 + r) * 128 + cbase), r1 = *(const uint2*)(lds + S_RP + (mt * 32 + r) * 128 + cbase + 16);
            gimg[im * 64 + lane] = make_uint4(g0.x, g0.y, g1.x, g1.y);
            rimg[im * 64 + lane] = make_uint4(r0.x, r0.y, r1.x, r1.y);
        }
    }
    __syncthreads();
}

DEVINL void phaseB1(KP p, int l, char* lds, const int mask = 15, const int sub = 3) {
    const int nb = NBV();
    if (mask & 1) {
        const int blk = BIDX();
        for (int it = blk; it < 512; it += nb) {
            if (sub & 1) { b1_rwkv(p, l, lds, it * 2); b1_rwkv(p, l, lds, it * 2 + 1); }
            __threadfence_block(); __syncthreads();
            const int b = it >> 6, c = it & 63;
            if (sub & 2) {
#pragma unroll 1
                for (int h = 0; h < 4; ++h) b1e_unit(p, lds, b, h, c);
            }
        }
    }
    if (mask & 2) { const int blk = BIDX(); for (int it = blk; it < 1024; it += nb) b1_lru(p, l, lds, it); }
    if (mask & 4) { const int blk = BIDX(); for (int it = blk; it < 1024; it += nb) b1_conformer(p, l, lds, it); }
    if (mask & 8) { const int blk = BIDX(); for (int it = blk; it < 512; it += nb) b1_shortconv(p, l, it); }
}

DEVINL void phaseB2(KP p, int l, char* lds) {
    const int tid = TIDX(), blk = BIDX();
    if (blk < 64 && tid < 64) {
        const int lane = tid, r = lane & 31, hh = lane >> 5;
        const int bh = blk >> 1, w = blk & 1, b = bh >> 2, h = bh & 3;
        float* yraw = (float*)(p->ws + A_YRAW) + (size_t)b * SEQ * 256 + h * 64 + 32 * w + r;
        f32x16 X0, X1;
#pragma unroll
        for (int i = 0; i < 16; ++i) { X0[i] = 0.f; X1[i] = 0.f; }
        auto issue = [&](int c, char* buf) {
            const unsigned char* ubase = p->ws + A_CHAIN + (size_t)(bh * 64 + c) * CHAIN_UNIT;
#pragma unroll
            for (int i = 0; i < 8; ++i) {
                __builtin_amdgcn_global_load_lds((const unsigned*)(ubase + i * 1024 + lane * 16), (unsigned*)(buf + i * 1024 + lane * 16), 16, 0, 0);
                __builtin_amdgcn_global_load_lds((const unsigned*)(ubase + 8192 + i * 1024 + lane * 16), (unsigned*)(buf + 8192 + i * 1024 + lane * 16), 16, 0, 0);
                __builtin_amdgcn_global_load_lds((const unsigned*)(ubase + 16384 + (w * 8 + i) * 1024 + lane * 16), (unsigned*)(buf + 16384 + i * 1024 + lane * 16), 16, 0, 0);
                __builtin_amdgcn_global_load_lds((const unsigned*)(ubase + 32768 + (w * 8 + i) * 1024 + lane * 16), (unsigned*)(buf + 24576 + i * 1024 + lane * 16), 16, 0, 0);
            }
        };
        issue(0, lds);
        for (int c = 0; c < 64; ++c) {
            char* buf = lds + (c & 1) * 32768;
            if (c + 1 < 64) { issue(c + 1, lds + ((c + 1) & 1) * 32768); asm volatile("s_waitcnt vmcnt(32)" ::: "memory"); }
            else asm volatile("s_waitcnt vmcnt(0)" ::: "memory");
            uint4 gq[8], rq8[8]; float4 hq[8], yq[8];
#pragma unroll
            for (int i = 0; i < 8; ++i) { gq[i] = *(const uint4*)(buf + i * 1024 + lane * 16); rq8[i] = *(const uint4*)(buf + 8192 + i * 1024 + lane * 16); }
#pragma unroll
            for (int i = 0; i < 8; ++i) { hq[i] = *(const float4*)(buf + 16384 + i * 1024 + lane * 16); yq[i] = *(const float4*)(buf + 24576 + i * 1024 + lane * 16); }
            bf16x8 xp[4];
#pragma unroll
            for (int s2 = 0; s2 < 2; ++s2) {
                uint4 a, bq;
                a.x = pack2(X0[8 * s2 + 0], X0[8 * s2 + 1]); a.y = pack2(X0[8 * s2 + 2], X0[8 * s2 + 3]); a.z = pack2(X0[8 * s2 + 4], X0[8 * s2 + 5]); a.w = pack2(X0[8 * s2 + 6], X0[8 * s2 + 7]);
                bq.x = pack2(X1[8 * s2 + 0], X1[8 * s2 + 1]); bq.y = pack2(X1[8 * s2 + 2], X1[8 * s2 + 3]); bq.z = pack2(X1[8 * s2 + 4], X1[8 * s2 + 5]); bq.w = pack2(X1[8 * s2 + 6], X1[8 * s2 + 7]);
                xp[s2] = __builtin_bit_cast(bf16x8, a); xp[2 + s2] = __builtin_bit_cast(bf16x8, bq);
            }
#pragma unroll
            for (int mt = 0; mt < 2; ++mt) {
                f32x16 acc;
#pragma unroll
                for (int i = 0; i < 4; ++i) { acc[4 * i] = yq[mt * 4 + i].x; acc[4 * i + 1] = yq[mt * 4 + i].y; acc[4 * i + 2] = yq[mt * 4 + i].z; acc[4 * i + 3] = yq[mt * 4 + i].w; }
#pragma unroll
                for (int f = 0; f < 4; ++f) acc = MFMA32(__builtin_bit_cast(bf16x8, rq8[mt * 4 + f]), xp[f], acc);
#pragma unroll
                for (int reg = 0; reg < 16; ++reg) yraw[(size_t)(c * 64 + mt * 32 + crow32(reg, hh)) * 256] = acc[reg];
            }
            f32x16 n0, n1;
#pragma unroll
            for (int i = 0; i < 4; ++i) { n0[4 * i] = hq[i].x; n0[4 * i + 1] = hq[i].y; n0[4 * i + 2] = hq[i].z; n0[4 * i + 3] = hq[i].w;
                                          n1[4 * i] = hq[4 + i].x; n1[4 * i + 1] = hq[4 + i].y; n1[4 * i + 2] = hq[4 + i].z; n1[4 * i + 3] = hq[4 + i].w; }
#pragma unroll
            for (int f = 0; f < 4; ++f) { n0 = MFMA32(__builtin_bit_cast(bf16x8, gq[f]), xp[f], n0); n1 = MFMA32(__builtin_bit_cast(bf16x8, gq[4 + f]), xp[f], n1); }
            X0 = n0; X1 = n1;
        }
    }
}

DEVINL void phaseMix(KP p, int l, char* lds, const int which) {
    const int blk = BIDX(), wg = blk >> 1, half = blk & 1;
    if (wg < 32) { if (which == 0) phaseB2(p, l, lds); return; }
    const int w = wg - 32, NW = 224;
    if (which == 0) { for (int pr = w; pr < 512; pr += NW) b1_lru(p, l, lds, pr * 2 + half); }
    else if (which == 1) { for (int pr = (w + 160) % NW; pr < 512; pr += NW) b1_conformer(p, l, lds, pr * 2 + half); }
    else { for (int pr = (w + 96) % NW; pr < 256; pr += NW) b1_shortconv(p, l, pr * 2 + half); }
}

DEVINL void phaseB3(KP p, int l) {
    const int c = TIDX(), nb = NBV(), blk = BIDX();
    const bf16_t* P = (const bf16_t*)(p->ws + A_P);
    bf16_t* ymix = (bf16_t*)(p->ws + A_YMIX);
    const float* yraw = (const float*)(p->ws + A_YRAW); const bf16_t* bonus = (const bf16_t*)(p->ws + A_BONUS); const bf16_t* gbuf = (const bf16_t*)(p->ws + A_G);
    const unsigned* hcbuf = (const unsigned*)(p->ws + A_HLOC);
    const float gng = p->in[I_GNG][l * 256 + c], gnb = p->in[I_GNB][l * 256 + c];
    for (int it = blk; it < 512; it += nb) {
        float hst0, hst1;
        {
            const int bq = (it * 64) >> 12, tt0 = ((it * 64) & 4095) >> 5;
            const float* ca = (const float*)(p->ws + A_CARRYA) + (size_t)bq * 128 * 256 + c;
            const float* ch = (const float*)(p->ws + A_CARRYH) + (size_t)bq * 128 * 256 + c;
            float hs = 0.f;
#pragma unroll 16
            for (int tq = 0; tq < tt0; ++tq) hs = fmaf(ca[tq * 256], hs, ch[tq * 256]);
            hst0 = hs; hst1 = fmaf(ca[tt0 * 256], hs, ch[tt0 * 256]);
        }
#pragma unroll 1
        for (int r8 = 0; r8 < 64; r8 += 8) {
            float yv[8]; bf16_t bo[8], gg[8], gbv[8]; unsigned hcv[8]; float hsv[8];
#pragma unroll
            for (int u = 0; u < 8; ++u) {
                const int row = it * 64 + r8 + u, b = row >> 12, tt = (row & 4095) >> 5;
                const size_t o = (size_t)row * 256 + c;
                yv[u] = yraw[o]; bo[u] = bonus[o]; gg[u] = gbuf[o]; hcv[u] = hcbuf[o]; hsv[u] = (r8 < 32) ? hst0 : hst1; (void)b; (void)tt;
                gbv[u] = P[(size_t)row * PIN + 768 + c];
            }
#pragma unroll
            for (int u = 0; u < 8; ++u) {
                const int row = it * 64 + r8 + u;
                const float y = yv[u];
                const float mu = wave_sum(y) * (1.f / 64.f);
                const float d = y - mu;
                const float var = wave_sum(d * d) * (1.f / 64.f);
                const float yn = d * rsqrtf(var + GN_EPS) * gng + gnb;
                ymix[(size_t)row * DM + 512 + c] = f2bf((yn + bf2f(bo[u])) * bf2f(gg[u]));
                const float hh = fmaf(__uint_as_float(hcv[u] & 0xFFFF0000u), hsv[u], __uint_as_float(hcv[u] << 16));
                ymix[(size_t)row * DM + 256 + c] = f2bf(hh * gelu_tanh(bf2f(gbv[u])));
            }
        }
    }
}

DEVINL void phaseD(KP p, int l, char* lds, const int dry = 0) {
    const int tid = TIDX(), nb = NBV(), blk = BIDX(), wid = tid >> 6, lane = tid & 63;
    constexpr int URS = 2064;
    char* uh = lds;
    char* ulo = lds + 16 * URS;
    float* logit = (float*)(lds + 32 * URS);
    int* sel_e = (int*)(lds + 32 * URS + 4096);
    int* lpos = sel_e + 512;
    int* hist = lpos + 512;
    int* basep = hist + 64;
    const bf16_t* wrt_hi = (const bf16_t*)(p->ws + OFF_WR) + (size_t)(l * 2 + 0) * 64 * 1024;
    const bf16_t* wrt_lo = (const bf16_t*)(p->ws + OFF_WR) + (size_t)(l * 2 + 1) * 64 * 1024;
    const bf16_t* zbuf = (const bf16_t*)(p->ws + M_ZB);
    float2* lnstat = (float2*)(p->ws + M_STAT);
    bf16_t* ubuf = (bf16_t*)(p->ws + (dry ? A_YMIX : OFF_UBUF));
    const float* mod = (const float*)(p->ws + OFF_MOD);
    const float* wr = p->in[I_WROUTER] + (size_t)l * 1024 * 64 + lane;
    const float ebias = p->in[I_EBIAS][l * 64 + lane];
    unsigned* cnt = (unsigned*)(p->ws + OFF_CNT) + l * 64 + (dry ? 256 : 0);
    int* list = (int*)(p->ws + (dry ? M_HBUF : M_LIST));
    float* wsel = (float*)(p->ws + (dry ? M_HBUF + 16777216 : M_WSEL));
    int* pmap = (int*)(p->ws + (dry ? M_HBUF + 33554432 : M_PMAP));
    for (int it = blk; it < 512; it += nb) {
        const int tok0 = it * 64;
        if (tid < 64) hist[tid] = 0;
        for (int sb = 0; sb < 4; ++sb) {
#pragma unroll
            for (int j = 0; j < 4; ++j) {
                const int tl = wid * 4 + j, row = tok0 + sb * 16 + tl, b = row >> 12;
                float4 z[4];
                float s = 0.f;
#pragma unroll
                for (int i = 0; i < 4; ++i) { const uint2 zv = *(const uint2*)(zbuf + (size_t)row * DM + i * 256 + lane * 4);
                    z[i].x = __uint_as_float(zv.x << 16); z[i].y = __uint_as_float(zv.x & 0xFFFF0000u); z[i].z = __uint_as_float(zv.y << 16); z[i].w = __uint_as_float(zv.y & 0xFFFF0000u); s += z[i].x + z[i].y + z[i].z + z[i].w; }
                const float mean = wave_sum(s) * (1.f / 1024.f);
                float q = 0.f;
#pragma unroll
                for (int i = 0; i < 4; ++i) { z[i].x -= mean; z[i].y -= mean; z[i].z -= mean; z[i].w -= mean; q += z[i].x * z[i].x + z[i].y * z[i].y + z[i].z * z[i].z + z[i].w * z[i].w; }
                const float rs = rsqrtf(wave_sum(q) * (1.f / 1024.f) + LN_EPS);
                if (lane == 0) lnstat[row] = make_float2(mean, rs);
#pragma unroll
                for (int i = 0; i < 4; ++i) {
                    const int col = i * 256 + lane * 4;
                    const float4 g = *(const float4*)(p->in[I_LN1G] + l * 1024 + col), bb = *(const float4*)(p->in[I_LN1B] + l * 1024 + col);
                    const float4 sh = *(const float4*)(mod + (size_t)(l * 8 + b) * 6144 + 3072 + col), sc = *(const float4*)(mod + (size_t)(l * 8 + b) * 6144 + 4096 + col);
                    float4 x1; x1.x = z[i].x * rs * g.x + bb.x; x1.y = z[i].y * rs * g.y + bb.y; x1.z = z[i].z * rs * g.z + bb.z; x1.w = z[i].w * rs * g.w + bb.w;
                    float4 u; u.x = x1.x * (1.f + sc.x) + sh.x; u.y = x1.y * (1.f + sc.y) + sh.y; u.z = x1.z * (1.f + sc.z) + sh.z; u.w = x1.w * (1.f + sc.w) + sh.w;
                    uint2 o; o.x = pack2(u.x, u.y); o.y = pack2(u.z, u.w);
                    { int w8 = __builtin_amdgcn_cvt_pk_fp8_f32(u.x, u.y, 0, false); w8 = __builtin_amdgcn_cvt_pk_fp8_f32(u.z, u.w, w8, true);
                      *(int*)((char*)ubuf + (size_t)row * DM + col) = w8; }
                    *(uint2*)(uh + tl * URS + col * 2) = o;
                    uint2 o2; o2.x = pack2(u.x - __uint_as_float(o.x << 16), u.y - __uint_as_float(o.x & 0xFFFF0000u)); o2.y = pack2(u.z - __uint_as_float(o.y << 16), u.w - __uint_as_float(o.y & 0xFFFF0000u));
                    *(uint2*)(ulo + tl * URS + col * 2) = o2;
                }
            }
            __syncthreads();
            {
                const int fr = lane & 15, fq = lane >> 4;
                f32x4 lacc = (f32x4){0.f, 0.f, 0.f, 0.f};
                const bf16_t* bh = wrt_hi + (size_t)(wid * 16 + fr) * 1024 + fq * 8;
                const bf16_t* bl = wrt_lo + (size_t)(wid * 16 + fr) * 1024 + fq * 8;
#pragma unroll 1
                for (int k8 = 0; k8 < 4; ++k8) {
                    bf16x8 bhv[8], blv[8];
#pragma unroll
                    for (int kk = 0; kk < 8; ++kk) { bhv[kk] = *(const bf16x8*)(bh + (k8 * 8 + kk) * 32); blv[kk] = *(const bf16x8*)(bl + (k8 * 8 + kk) * 32); }
#pragma unroll
                    for (int kk = 0; kk < 8; ++kk) {
                        const int ko = (k8 * 8 + kk) * 64 + fq * 16;
                        const bf16x8 ah = *(const bf16x8*)(uh + fr * URS + ko), al = *(const bf16x8*)(ulo + fr * URS + ko);
                        lacc = __builtin_amdgcn_mfma_f32_16x16x32_bf16(ah, bhv[kk], lacc, 0, 0, 0);
                        lacc = __builtin_amdgcn_mfma_f32_16x16x32_bf16(al, bhv[kk], lacc, 0, 0, 0);
                        lacc = __builtin_amdgcn_mfma_f32_16x16x32_bf16(ah, blv[kk], lacc, 0, 0, 0);
                    }
                }
#pragma unroll
                for (int j = 0; j < 4; ++j) logit[(fq * 4 + j) * 64 + wid * 16 + fr] = lacc[j];
            }
            __syncthreads();
            float acc[4];
#pragma unroll
            for (int j = 0; j < 4; ++j) acc[j] = logit[(wid * 4 + j) * 64 + lane];
#pragma unroll
            for (int j = 0; j < 4; ++j) {
                const int tl = sb * 16 + wid * 4 + j;
                const float score = 1.f / (1.f + __expf(-acc[j]));
                const float biased = score + ebias;
                const float m1 = group8_max(biased);
                const unsigned long long eq = __ballot(biased == m1);
                const int g = lane >> 3;
                const unsigned gm = (unsigned)(eq >> (g * 8)) & 0xFFu;
                const int first = __ffs((int)gm) - 1;
                const float v2 = ((lane & 7) == first) ? -INFINITY : biased;
                const float m2 = group8_max(v2);
                const float gs = m1 + m2;
                int rg = 0;
#pragma unroll
                for (int g2 = 0; g2 < 8; ++g2) { const float o = __builtin_bit_cast(float, __builtin_amdgcn_readlane(__builtin_bit_cast(int, gs), g2 * 8)); rg += ((o > gs) || (o == gs && g2 < g)) ? 1 : 0; }
                const bool keep = rg < 4;
                const float mk = keep ? biased : -INFINITY;
                int rk = 0;
#pragma unroll
                for (int e2 = 0; e2 < 64; ++e2) { const float o = __builtin_bit_cast(float, __builtin_amdgcn_readlane(__builtin_bit_cast(int, mk), e2)); rk += ((o > mk) || (o == mk && e2 < lane)) ? 1 : 0; }
                const bool sel = keep && (rk < 8);
                const float ssum = wave_sum(sel ? score : 0.f);
                const float wgt = score / ssum * 2.5f;
                const unsigned long long sm = __ballot(sel);
                const int kidx = __popcll(sm & ((1ull << lane) - 1ull));
                if (sel) { wsel[(size_t)(tok0 + tl) * 8 + kidx] = wgt; sel_e[tl * 8 + kidx] = lane; }
            }
            __syncthreads();
        }
        for (int i = tid; i < 512; i += VTHREADS) lpos[i] = atomicAdd(&hist[sel_e[i]], 1);
        __syncthreads();
        if (tid < 64) basep[tid] = (int)atomicAdd(&cnt[tid], (unsigned)hist[tid]);
        __syncthreads();
        for (int i = tid; i < 512; i += VTHREADS) { const int e = sel_e[i], pos = basep[e] + lpos[i]; list[(size_t)e * NTOK + pos] = tok0 * 8 + i; pmap[tok0 * 8 + i] = (e << 16) | pos; }
        __syncthreads();
    }
}

DEVINL void phaseA(KP p, int l, char* lds) {
    const int tid = TID512(), c = blockIdx.x, G = gridDim.x;
    const char* ubuf = (const char*)(p->ws + OFF_UBUF);
    const char* Wt = (const char*)(p->ws + OFF_WIN) + (size_t)l * WIN_ROWS * 1024;
    bf16_t* P = (bf16_t*)(p->ws + A_P);
    auto sched = [&](int i, GUnit& u) -> bool {
        const long L = unit_linear(i, c, G); if (L >= 128 * 11) return false;
        const int Li = (int)L, sx = Li >> 9, w = (sx == 2) ? 3 : 4, rem = Li - (sx << 9), pm = rem / w, pn = sx * 4 + (rem - pm * w);
        u.A = ubuf + (size_t)pm * 256 * 1024; u.B = Wt + (size_t)pn * 256 * 1024; u.i0 = pm; u.i1 = pn; u.i2 = 0;
        return true;
    };
    auto epi = [&](f32x4 (&acc)[2][2][4][2], const GUnit& u, int wr, int wc, int fr, int fq) {
        asm volatile("" : "+v"(fr), "+v"(fq));
        const int row0 = u.i0 * 256 + wr * 64 + fr, col0 = u.i1 * 256 + wc * 32 + 8 * fq;
#pragma unroll
        for (int ai = 0; ai < 2; ++ai)
#pragma unroll
            for (int m = 0; m < 4; ++m) {
                bf16_t* rowp = P + (size_t)(row0 + ai * 128 + m * 16) * PIN + col0;
#pragma unroll
                for (int bj = 0; bj < 2; ++bj) {
                    if (col0 + bj * 128 < PIN) {
                        const f32x4 v0 = acc[ai][bj][m][0], v1 = acc[ai][bj][m][1];
                        *(uint4*)(rowp + bj * 128) = make_uint4(pack2(v0[0], v0[1]), pack2(v0[2], v0[3]), pack2(v1[0], v1[1]), pack2(v1[2], v1[3]));
                    }
                }
            }
    };
    gemm256<true, false, true>(lds, 512, 512, sched, epi);
}

DEVINL void phaseC(KP p, int l, char* lds) {
    const int tid = TID512(), c = blockIdx.x, G = gridDim.x;
    const char* ymix = (const char*)(p->ws + A_YMIX);
    const char* Wt = (const char*)(p->ws + OFF_WOUT) + (size_t)l * 1024 * 1024 * 2;
    const float* res32 = p->in[I_X];
    const bf16_t* res16 = (const bf16_t*)p->out;
    bf16_t* zbuf = (bf16_t*)(p->ws + M_ZB);
    const float* mod = (const float*)(p->ws + OFF_MOD);
    auto sched = [&](int i, GUnit& u) -> bool {
        const long L = unit_linear(i, c, G); if (L >= 128 * 4) return false;
        const int pm = (int)L >> 2, pn = (int)L & 3;
        u.A = ymix + (size_t)pm * 256 * 2048; u.B = Wt + (size_t)pn * 256 * 2048; u.i0 = pm; u.i1 = pn; u.i2 = 0;
        return true;
    };
    auto epi = [&](f32x4 (&acc)[2][2][4][2], const GUnit& u, int wr, int wc, int fr, int fq) {
        asm volatile("" : "+v"(fr), "+v"(fq));
        const int row0 = u.i0 * 256 + wr * 64 + fr, col0 = u.i1 * 256 + wc * 32 + 8 * fq;
#pragma unroll
        for (int ai = 0; ai < 2; ++ai)
#pragma unroll
            for (int m = 0; m < 4; ++m) {
                const int row = row0 + ai * 128 + m * 16, b = row >> 12;
#pragma unroll
                for (int bj = 0; bj < 2; ++bj) {
                    const int col = col0 + bj * 128;
                    const float4 ga = *(const float4*)(mod + (size_t)(l * 8 + b) * 6144 + 2048 + col), gb = *(const float4*)(mod + (size_t)(l * 8 + b) * 6144 + 2048 + col + 4);
                    float r[8];
                    if (l == 0) {
                        const float4 ra = *(const float4*)(res32 + (size_t)row * DM + col), rb = *(const float4*)(res32 + (size_t)row * DM + col + 4);
                        r[0] = ra.x; r[1] = ra.y; r[2] = ra.z; r[3] = ra.w; r[4] = rb.x; r[5] = rb.y; r[6] = rb.z; r[7] = rb.w;
                    } else {
                        const uint4 rv = *(const uint4*)(res16 + (size_t)row * DM + col);
                        r[0] = __uint_as_float(rv.x << 16); r[1] = __uint_as_float(rv.x & 0xFFFF0000u); r[2] = __uint_as_float(rv.y << 16); r[3] = __uint_as_float(rv.y & 0xFFFF0000u);
                        r[4] = __uint_as_float(rv.z << 16); r[5] = __uint_as_float(rv.z & 0xFFFF0000u); r[6] = __uint_as_float(rv.w << 16); r[7] = __uint_as_float(rv.w & 0xFFFF0000u);
                    }
                    const f32x4 a0 = acc[ai][bj][m][0], a1 = acc[ai][bj][m][1];
                    const float z0 = ALPHA * r[0] + (1.f + ga.x) * a0[0], z1 = ALPHA * r[1] + (1.f + ga.y) * a0[1], z2 = ALPHA * r[2] + (1.f + ga.z) * a0[2], z3 = ALPHA * r[3] + (1.f + ga.w) * a0[3];
                    const float z4 = ALPHA * r[4] + (1.f + gb.x) * a1[0], z5 = ALPHA * r[5] + (1.f + gb.y) * a1[1], z6 = ALPHA * r[6] + (1.f + gb.z) * a1[2], z7 = ALPHA * r[7] + (1.f + gb.w) * a1[3];
                    *(uint4*)(zbuf + (size_t)row * DM + col) = make_uint4(pack2(z0, z1), pack2(z2, z3), pack2(z4, z5), pack2(z6, z7));
                }
            }
    };
    gemm256<true, false, false>(lds, 1024, 1024, sched, epi);
}

constexpr int DIR_OFF = 131072;
DEVINL void moe_directory(KP p, int l, char* lds) {
    int* pref = (int*)(lds + DIR_OFF);
    int* cntl = (int*)(lds + DIR_OFF + 512);
    unsigned* cnt = (unsigned*)(p->ws + OFF_CNT) + l * 64;
    asm volatile("" : "+s"(cnt));
    if (TID512() == 0) {
        int s = 0;
        int* xpre = (int*)(lds + DIR_OFF + 1024);
        int x = 0;
        for (int e = 0; e < 64; ++e) { const int c = (int)__hip_atomic_load(&cnt[e], __ATOMIC_RELAXED, __HIP_MEMORY_SCOPE_AGENT); cntl[e] = c; pref[e] = s; s += (c + 255) >> 8; xpre[e] = x; x += c; }
        pref[64] = s; cntl[64] = NTOK; pref[65] = s + 128; xpre[64] = x;
    }
    __syncthreads();
    {
        int* m2e = (int*)(lds + DIR_OFF + 2048);
        const int tot = pref[65];
        for (int mg = TID512(); mg < tot; mg += NTHREADS) { int e = 0; while (pref[e + 1] <= mg) ++e; m2e[mg] = e; }
    }
    __syncthreads();
}

DEVINL void phaseE1(KP p, int l, char* lds) {
    const int tid = TID512(), c = blockIdx.x, G = gridDim.x;
    moe_directory(p, l, lds);
    const int* pref = (const int*)(lds + DIR_OFF); const int* cntl = (const int*)(lds + DIR_OFF + 512);
    const char* ubuf = (const char*)(p->ws + OFF_UBUF);
    const int* list = (const int*)(p->ws + M_LIST);
    bf16_t* hbuf = (bf16_t*)(p->ws + M_HBUF);
    const char* W13 = (const char*)(p->ws + OFF_W13) + (size_t)(l * 65) * 512 * 1024;
    const int total = __builtin_amdgcn_readfirstlane(pref[65]) * 2;
    auto sched = [&](int i, GUnit& u) -> bool {
        const long L = unit_linear(i, c, G); if (L >= total) return false;
        const int mg = (int)L >> 1, nt = (int)L & 1;
        const int e = __builtin_amdgcn_readfirstlane(((const int*)(lds + DIR_OFF + 2048))[mg]);
        const int mt = __builtin_amdgcn_readfirstlane(mg - pref[e]), Me = __builtin_amdgcn_readfirstlane(cntl[e]);
        u.A = ubuf; u.B = W13 + ((size_t)e * 512 + nt * 256) * 1024; u.i0 = mg; u.i1 = nt; u.i2 = e;
        int R[2], C[2]; stage_coords512(TID512(), R, C);
#pragma unroll
        for (int h = 0; h < 2; ++h)
#pragma unroll
            for (int i2 = 0; i2 < 2; ++i2) {
                const int idx = mt * 256 + h * 128 + R[i2]; int tok;
                if (e < 64) tok = (idx < Me) ? (list[(size_t)e * NTOK + idx] >> 3) : 0; else tok = idx;
                u.va[h][i2] = (unsigned)(tok * 1024 + C[i2] * 2);
            }
        return true;
    };
    auto epi = [&](f32x4 (&acc)[2][2][4][2], const GUnit& u, int wr, int wc, int fr, int fq) {
        asm volatile("" : "+v"(fr), "+v"(fq));
        const size_t row0 = (size_t)u.i0 * 256 + wr * 64 + fr;
#pragma unroll
        for (int ai = 0; ai < 2; ++ai)
#pragma unroll
            for (int m = 0; m < 4; ++m) {
                bf16_t* rowp = hbuf + (row0 + ai * 128 + m * 16) * 256;
#pragma unroll
                for (int bj = 0; bj < 2; ++bj) {
                    const int hcol = (u.i1 * 8 + bj * 4 + wc) * 16 + 4 * fq;
                    const f32x4 gt = acc[ai][bj][m][0], up = acc[ai][bj][m][1];
                    float hv[4];
#pragma unroll
                    for (int j = 0; j < 4; ++j) hv[j] = gt[j] * sigm(gt[j]) * up[j];
                    uint2 o; o.x = pack2(hv[0], hv[1]); o.y = pack2(hv[2], hv[3]);
                    *(uint2*)(rowp + hcol) = o;
                }
                asm volatile("" ::: "memory");
            }
    };
    gemm256<false, true, true>(lds, 512, 512, sched, epi);
}

DEVINL void phaseE2(KP p, int l, char* lds) {
    const int tid = TID512(), c = blockIdx.x, G = gridDim.x;
    moe_directory(p, l, lds);
    const int* pref = (const int*)(lds + DIR_OFF); const int* cntl = (const int*)(lds + DIR_OFF + 512);
    const int* xpre = (const int*)(lds + DIR_OFF + 1024);
    const char* hbuf = (const char*)(p->ws + M_HBUF);
    unsigned char* ybuf = (unsigned char*)(p->ws + M_YBUF);
    const char* W2 = (const char*)(p->ws + OFF_W2) + (size_t)(l * 65) * 1024 * 256 * 2;
    const int total = __builtin_amdgcn_readfirstlane(pref[65]) * 4;
    auto sched = [&](int i, GUnit& u) -> bool {
        const long L = unit_linear(i, c, G); if (L >= total) return false;
        const int mg = (int)L >> 2, nt = (int)L & 3;
        const int e = __builtin_amdgcn_readfirstlane(((const int*)(lds + DIR_OFF + 2048))[mg]);
        u.A = hbuf + (size_t)mg * 256 * 512; u.B = W2 + ((size_t)e * 1024 + nt * 256) * 512; u.i0 = mg; u.i1 = nt; u.i2 = e;
        return true;
    };
    auto epi = [&](f32x4 (&acc)[2][2][4][2], const GUnit& u, int wr, int wc, int fr, int fq) {
        asm volatile("" : "+v"(fr), "+v"(fq));
        const int e = __builtin_amdgcn_readfirstlane(u.i2), mt = __builtin_amdgcn_readfirstlane(u.i0 - pref[e]), Me = __builtin_amdgcn_readfirstlane(cntl[e]);
        const int yrow0 = __builtin_amdgcn_readfirstlane(xpre[e]) + mt * 256;
        const int col0 = u.i1 * 256 + wc * 32 + 8 * fq, loc0 = wr * 64 + fr;
#pragma unroll
        for (int ai = 0; ai < 2; ++ai)
#pragma unroll
            for (int m = 0; m < 4; ++m) {
                const int loc = loc0 + ai * 128 + m * 16;
                if (mt * 256 + loc < Me) {
                    unsigned char* rowp = ybuf + (size_t)(yrow0 + loc) * 1024 + col0;
#pragma unroll
                    for (int bj = 0; bj < 2; ++bj) {
                        const f32x4 v0 = acc[ai][bj][m][0], v1 = acc[ai][bj][m][1];
                        int w0 = __builtin_amdgcn_cvt_pk_fp8_f32(v0[0], v0[1], 0, false); w0 = __builtin_amdgcn_cvt_pk_fp8_f32(v0[2], v0[3], w0, true);
                        int w1 = __builtin_amdgcn_cvt_pk_fp8_f32(v1[0], v1[1], 0, false); w1 = __builtin_amdgcn_cvt_pk_fp8_f32(v1[2], v1[3], w1, true);
                        *(uint2*)(rowp + bj * 128) = make_uint2((unsigned)w0, (unsigned)w1);
                    }
                }
            }
    };
    gemm256<true, false, false>(lds, 256, 256, sched, epi);
}

DEVINL void phaseF(KP p, int l, const int dry = 0) {
    const int tid = TIDX(), nb = NBV(), blk = BIDX(), wid = tid >> 6, lane = tid & 63;
    const bf16_t* zbuf = (const bf16_t*)(p->ws + M_ZB);
    float* xout = dry ? (float*)(p->ws + M_HBUF) : p->out;
    const unsigned char* ybuf = (const unsigned char*)(p->ws + M_YBUF);
    bf16_t* ubuf = (bf16_t*)(p->ws + OFF_UBUF);
    const float* mod = (const float*)(p->ws + OFF_MOD);
    const int* pmap = (const int*)(p->ws + M_PMAP); const float* wsel = (const float*)(p->ws + M_WSEL);
    const float2* lnstat = (const float2*)(p->ws + M_STAT);
    int xoff;
    {
        const unsigned* cnt = (const unsigned*)(p->ws + OFF_CNT) + l * 64;
        const int c = (int)__hip_atomic_load(&cnt[lane], __ATOMIC_RELAXED, __HIP_MEMORY_SCOPE_AGENT);
        xoff = 0;
#pragma unroll
        for (int j = 0; j < 64; ++j) { const int cj = __builtin_amdgcn_readlane(c, j); xoff += (j < lane) ? cj : 0; }
    }
    int pmn = 0; float wn = 0.f; float2 stn = make_float2(0.f, 0.f);
    {
        const int row = blk * 4 + wid;
        if (row < NTOK) { if (lane < 8) { pmn = pmap[row * 8 + lane]; wn = wsel[row * 8 + lane]; } stn = lnstat[row]; }
    }
    for (int row = blk * 4 + wid; row < NTOK; row += nb * 4) {
        const int b = row >> 12;
        int yr = pmn; const float yw = wn; const float2 st1 = stn;
        {
            const int nrow = row + nb * 4;
            if (nrow < NTOK) { if (lane < 8) { pmn = pmap[nrow * 8 + lane]; wn = wsel[nrow * 8 + lane]; } stn = lnstat[nrow]; }
        }
        { const int e = (yr >> 16) & 63; const int xo = __builtin_amdgcn_ds_bpermute(e << 2, xoff); yr = xo + (yr & 0xFFFF); }
        int yrow[8]; float yww[8];
#pragma unroll
        for (int k = 0; k < 8; ++k) { yrow[k] = __builtin_amdgcn_readlane(yr, k); yww[k] = __builtin_bit_cast(float, __builtin_amdgcn_readlane(__builtin_bit_cast(int, yw), k)); }
        uint2 zvv[4]; int ysh[4]; int yvk[4][8];
#pragma unroll
        for (int i = 0; i < 4; ++i) {
            const int col = i * 256 + lane * 4;
            zvv[i] = *(const uint2*)(zbuf + (size_t)row * DM + col);
            ysh[i] = *(const int*)(ybuf + ((size_t)(262144 + row)) * 1024 + col);
#pragma unroll
            for (int k = 0; k < 8; ++k) yvk[i][k] = *(const int*)(ybuf + (size_t)yrow[k] * 1024 + col);
        }
        float4 z[4]; float s = 0.f;
#pragma unroll
        for (int i = 0; i < 4; ++i) {
            const int col = i * 256 + lane * 4;
            float4 x1;
            { const uint2 zv = zvv[i];
              float4 z1; z1.x = __uint_as_float(zv.x << 16); z1.y = __uint_as_float(zv.x & 0xFFFF0000u); z1.z = __uint_as_float(zv.y << 16); z1.w = __uint_as_float(zv.y & 0xFFFF0000u);
              const float4 g1 = *(const float4*)(p->in[I_LN1G] + l * 1024 + col), b1 = *(const float4*)(p->in[I_LN1B] + l * 1024 + col);
              x1.x = (z1.x - st1.x) * st1.y * g1.x + b1.x; x1.y = (z1.y - st1.x) * st1.y * g1.y + b1.y; x1.z = (z1.z - st1.x) * st1.y * g1.z + b1.z; x1.w = (z1.w - st1.x) * st1.y * g1.w + b1.w; }
            float f0, f1, f2, f3;
            { const int yv = ysh[i];
              const f2_t lo = __builtin_amdgcn_cvt_pk_f32_fp8(yv, false), hi = __builtin_amdgcn_cvt_pk_f32_fp8(yv, true);
              f0 = lo[0]; f1 = lo[1]; f2 = hi[0]; f3 = hi[1]; }
#pragma unroll
            for (int k = 0; k < 8; ++k) {
                const f2_t lo = __builtin_amdgcn_cvt_pk_f32_fp8(yvk[i][k], false), hi = __builtin_amdgcn_cvt_pk_f32_fp8(yvk[i][k], true);
                const float w = yww[k];
                f0 = fmaf(w, lo[0], f0); f1 = fmaf(w, lo[1], f1); f2 = fmaf(w, hi[0], f2); f3 = fmaf(w, hi[1], f3);
            }
            const float4 g2 = *(const float4*)(mod + (size_t)(l * 8 + b) * 6144 + 5120 + col);
            z[i].x = ALPHA * x1.x + (1.f + g2.x) * f0; z[i].y = ALPHA * x1.y + (1.f + g2.y) * f1; z[i].z = ALPHA * x1.z + (1.f + g2.z) * f2; z[i].w = ALPHA * x1.w + (1.f + g2.w) * f3;
            s += z[i].x + z[i].y + z[i].z + z[i].w;
        }
        const float mean = wave_sum(s) * (1.f / 1024.f);
        float q = 0.f;
#pragma unroll
        for (int i = 0; i < 4; ++i) { z[i].x -= mean; z[i].y -= mean; z[i].z -= mean; z[i].w -= mean; q += z[i].x * z[i].x + z[i].y * z[i].y + z[i].z * z[i].z + z[i].w * z[i].w; }
        const float rs = rsqrtf(wave_sum(q) * (1.f / 1024.f) + LN_EPS);
#pragma unroll
        for (int i = 0; i < 4; ++i) {
            const int col = i * 256 + lane * 4;
            const float4 g = *(const float4*)(p->in[I_LN2G] + l * 1024 + col), bb = *(const float4*)(p->in[I_LN2B] + l * 1024 + col);
            float4 x2; x2.x = z[i].x * rs * g.x + bb.x; x2.y = z[i].y * rs * g.y + bb.y; x2.z = z[i].z * rs * g.z + bb.z; x2.w = z[i].w * rs * g.w + bb.w;
            if (l + 1 < DEPTH) { uint2 ox; ox.x = pack2(x2.x, x2.y); ox.y = pack2(x2.z, x2.w); *(uint2*)((bf16_t*)xout + (size_t)row * DM + col) = ox; }
            else *(float4*)(xout + (size_t)row * DM + col) = x2;
            if (l + 1 < DEPTH) {
                const float4 sh = *(const float4*)(mod + (size_t)((l + 1) * 8 + b) * 6144 + col), sc = *(const float4*)(mod + (size_t)((l + 1) * 8 + b) * 6144 + 1024 + col);
                int w8 = __builtin_amdgcn_cvt_pk_fp8_f32(x2.x * (1.f + sc.x) + sh.x, x2.y * (1.f + sc.y) + sh.y, 0, false);
                w8 = __builtin_amdgcn_cvt_pk_fp8_f32(x2.z * (1.f + sc.z) + sh.z, x2.w * (1.f + sc.w) + sh.w, w8, true);
                *(int*)((char*)ubuf + (size_t)row * DM + col) = w8;
            }
        }
    }
}

#define XB_TMO      128
#define XB_XCNT(j)  (256  + 64 * (j))
#define XB_XSUB(j)  (1280 + 64 * (j))
#define XB_XGEN(j)  (2304 + 64 * (j))
#define XB_TOP      3328
#define XB_TOPGEN   3392
#define XCD_BAR_WORDS 3456
#define XB_SPIN_CAP (1u << 20)
DEVINL unsigned xb_ld(unsigned* p)              { return __hip_atomic_load(p, __ATOMIC_RELAXED, __HIP_MEMORY_SCOPE_AGENT); }
DEVINL unsigned xb_add(unsigned* p, unsigned v) { return __hip_atomic_fetch_add(p, v, __ATOMIC_RELAXED, __HIP_MEMORY_SCOPE_AGENT); }
DEVINL unsigned xb_xcc_id() { return (unsigned)__builtin_amdgcn_s_getreg((3 << 11) | 20) & 0xFu; }
#define XB_SPIN(cond, bar) do { unsigned _sp = 0; while (cond) { __builtin_amdgcn_s_sleep(1); \
    if ((++_sp & 255u) == 0u) { if (xb_ld(&(bar)[XB_TMO])) break; if (_sp > XB_SPIN_CAP) { atomicAdd(&(bar)[XB_TMO], 1u); break; } } } } while (0)
struct XcdBarrier { unsigned* bar; unsigned x; volatile LAS unsigned* st; };
DEVINL XcdBarrier xcd_barrier_post(unsigned* bar, volatile LAS unsigned* st) {
    XcdBarrier b; b.bar = bar; b.x = xb_xcc_id(); b.st = st;
    if (TID512() == 0) (void)xb_add(&bar[XB_XCNT(b.x)], 1u);
    return b;
}
DEVINL void xcd_barrier_complete(unsigned* bar, unsigned x, unsigned& nloc, unsigned& nx) {
    const unsigned G = gridDim.x * gridDim.y * gridDim.z;
    unsigned sum, cnt, mine, sp = 0u;
    for (;;) {
        sum = 0u; cnt = 0u; mine = 0u;
#pragma unroll 1
        for (unsigned j = 0; j < 16; ++j) { const unsigned c = xb_ld(&bar[XB_XCNT(j)]); sum += c; cnt += (c > 0u) ? 1u : 0u; mine = (j == x) ? c : mine; }
        if (sum == G) break;
        __builtin_amdgcn_s_sleep(1);
        if ((++sp & 255u) == 0u) { if (xb_ld(&bar[XB_TMO])) break; if (sp > XB_SPIN_CAP) { atomicAdd(&bar[XB_TMO], 1u); break; } }
    }
    nloc = mine > 0u ? mine : 1u; nx = cnt > 0u ? cnt : 1u;
}
DEVINL void xcd_barrier(const XcdBarrier& b) {
    asm volatile("s_waitcnt vmcnt(0)" ::: "memory");
    __syncthreads();
    if (TID512() == 0) {
        unsigned* bar = b.bar;
        __builtin_amdgcn_s_waitcnt(0);
        unsigned nloc = b.st[0], nx = b.st[1];
        if (nloc == 0u) { xcd_barrier_complete(bar, b.x, nloc, nx); b.st[0] = nloc; b.st[1] = nx; }
        const unsigned old = xb_add(&bar[XB_XSUB(b.x)], 1u);
        const unsigned gen = old / nloc;
        if (old + 1u == (gen + 1u) * nloc) {
            __builtin_amdgcn_fence(__ATOMIC_RELEASE, "agent");
            asm volatile("s_waitcnt vmcnt(0)" ::: "memory");
            const unsigned og = xb_add(&bar[XB_TOP], 1u);
            const unsigned tg = og / nx;
            if (og + 1u == (tg + 1u) * nx) xb_add(&bar[XB_TOPGEN], 1u);
            else XB_SPIN(xb_ld(&bar[XB_TOPGEN]) == tg, bar);
            __builtin_amdgcn_fence(__ATOMIC_ACQUIRE, "agent");
            xb_add(&bar[XB_XGEN(b.x)], 1u);
            asm volatile("s_waitcnt vmcnt(0)" ::: "memory");
        } else {
            XB_SPIN(xb_ld(&bar[XB_XGEN(b.x)]) == gen, bar);
            __builtin_amdgcn_fence(__ATOMIC_ACQUIRE, "agent");
            asm volatile("s_waitcnt vmcnt(0)" ::: "memory");
        }
    }
    __syncthreads();
}

constexpr int PPL = 11;
constexpr int NPHASE = 2 + PPL * DEPTH;
#ifndef PROBE_SUB
#define PROBE_SUB 3
#endif
#ifndef PROBE_REP
#define PROBE_REP (-1)
#endif
__global__ void __launch_bounds__(NTHREADS, 2) mega(Params p_arg, int ph_lo, int ph_hi) {
    extern __shared__ __attribute__((aligned(16))) char lds[];
    cg::grid_group grid = cg::this_grid();
    volatile LAS unsigned* st = (volatile LAS unsigned*)(lds + LDS_BYTES - 16);
    if (threadIdx.x == 0) { st[0] = 0u; st[1] = 0u; }
    if ((threadIdx.x & 63) == 0) ((volatile LAS int*)(lds + WTAB_OFF))[(unsigned)__builtin_amdgcn_s_getreg((5 << 11) | 4) & 63u] = (int)(threadIdx.x >> 6);
    __syncthreads();
    XcdBarrier xb = xcd_barrier_post((unsigned*)(p_arg.ws + OFF_BAR), st);
    for (int ph = ph_lo; ph < ph_hi; ++ph) {
        KP p = (KP)__builtin_amdgcn_kernarg_segment_ptr();
        asm volatile("" : "+s"(p));
        const int l = (ph >= 2) ? (ph - 2) / PPL : 0;
        const int q = (ph >= 2) ? (ph - 2) % PPL : -1;
        const bool nobar = (q == 2 || q == 3);
        const int nrep = (PROBE_REP >= 0 && ph == PROBE_REP) ? 2 : 1;
        for (int rep = 0; rep < nrep; ++rep) {
            const int dry = (PROBE_REP >= 0 && ph == PROBE_REP && rep == 0) ? 1 : 0;
            char* ldsh = lds + (wave_index() >> 2) * LDS_HALF;
            if (ph == 0) phase0(p, ldsh);
            else if (ph == 1) phaseF0(p);
            else {
                switch (q) {
                    case 0: phaseA(p, l, lds); break;
                    case 1: phaseB1(p, l, ldsh, 1, (PROBE_REP >= 0 && ph == PROBE_REP && rep == 1) ? PROBE_SUB : 3); break;
                    case 2: phaseMix(p, l, ldsh, 0); break;
                    case 3: phaseMix(p, l, ldsh, 1); break;
                    case 4: phaseMix(p, l, ldsh, 2); break;
                    case 5: phaseB3(p, l); break;
                    case 6: phaseC(p, l, lds); break;
                    case 7: phaseD(p, l, ldsh, dry); break;
                    case 8: phaseE1(p, l, lds); break;
                    case 9: phaseE2(p, l, lds); break;
                    default: phaseF(p, l, dry); break;
                }
            }
            const bool lastrep = (rep + 1 == nrep);
            if (!lastrep || (ph + 1 < ph_hi && !nobar)) { if (lastrep && ph == ph_lo) grid.sync(); else xcd_barrier(xb); }
        }
    }
}

extern "C" void kernel_launch(void* const* d_in, const int* in_sizes, int n_in, void* d_out, int out_size, void* d_ws, size_t ws_size, hipStream_t stream) {
    static int grid_blocks = 0;
    if (grid_blocks == 0) {
        if (n_in != 39 || out_size != NTOK * DM || ws_size < WS_NEED) { fprintf(stderr, "kernel_launch: unexpected shapes (n_in %d out %d ws %zu need %zu)\n", n_in, out_size, ws_size, (size_t)WS_NEED); grid_blocks = -1; return; }
        int dev = 0, cus = 0, per_cu = 0;
        hipGetDevice(&dev);
        hipDeviceGetAttribute(&cus, hipDeviceAttributeMultiprocessorCount, dev);
        hipFuncSetAttribute((const void*)mega, hipFuncAttributeMaxDynamicSharedMemorySize, LDS_BYTES);
        hipOccupancyMaxActiveBlocksPerMultiprocessor(&per_cu, (const void*)mega, NTHREADS, LDS_BYTES);
        if (per_cu < 1) { fprintf(stderr, "kernel_launch: occupancy query returned %d\n", per_cu); grid_blocks = -1; return; }
        if (cus < 256) { fprintf(stderr, "kernel_launch: this build needs 256 CUs (found %d)\n", cus); grid_blocks = -1; return; }
        grid_blocks = 256;
    }
    if (grid_blocks < 0) return;
    if (hipMemsetAsync(d_ws, 0, 32768, stream) != hipSuccess) { fprintf(stderr, "kernel_launch: memset failed\n"); return; }
    Params p{};
    for (int i = 0; i < 39; ++i) p.in[i] = (const float*)d_in[i];
    p.out = (float*)d_out; p.ws = (unsigned char*)d_ws;
    int ph_lo = 0, ph_hi = NPHASE;
    void* args[] = {&p, &ph_lo, &ph_hi};
    hipError_t e = hipLaunchCooperativeKernel((const void*)mega, dim3(grid_blocks), dim3(NTHREADS), args, LDS_BYTES, stream);
    if (e != hipSuccess) fprintf(stderr, "cooperative launch failed: %s (grid %d)\n", hipGetErrorString(e), grid_blocks);
}
```

```cpp
#include <hip/hip_runtime.h>
#include <hip/hip_cooperative_groups.h>
#include <stdio.h>
#include <stdint.h>
namespace cg = cooperative_groups;

typedef unsigned short bf16_t;
typedef short bf16x8 __attribute__((ext_vector_type(8)));
typedef float f32x4 __attribute__((ext_vector_type(4)));
#define DEVINL __device__ __forceinline__
#define LAS __attribute__((address_space(3)))
#define MFMA32(a, b, c) __builtin_amdgcn_mfma_f32_32x32x16_bf16((a), (b), (c), 0, 0, 0)

constexpr int NTOK = 32768, SEQ = 4096, NBATCH = 8, DM = 1024, PIN = 2688, DEPTH = 2;
constexpr int NEXP = 64;
constexpr float ALPHA = 1.41421356237f;
constexpr float LN_EPS = 1e-5f, GN_EPS = 64e-5f;
constexpr int NTHREADS = 512;
constexpr int VTHREADS = 256;
constexpr int LDS_HALF = 75776;
constexpr int LDS_BYTES = 159744;

constexpr size_t OFF_CNT   = 0;
constexpr size_t OFF_BAR   = 4096;
constexpr size_t OFF_MOD   = 65536;
constexpr size_t OFF_WR    = 524288;
constexpr size_t OFF_WIN   = 1048576;
constexpr int WIN_ROWS = 2816;
constexpr size_t OFF_WOUT  = OFF_WIN + 2 * (size_t)WIN_ROWS * 1024 * 2;
constexpr size_t OFF_W13   = OFF_WOUT + 4194304;
constexpr size_t OFF_W2    = OFF_W13 + 136314880;
constexpr size_t OFF_UBUF  = OFF_W2 + 68157440;
constexpr size_t OFF_ARENA = OFF_UBUF + 67108864;
constexpr size_t A_P      = OFF_ARENA;
constexpr size_t A_YMIX   = A_P + 176160768;
constexpr size_t A_SCAN   = A_YMIX + 67108864;
constexpr size_t A_HLOC   = A_SCAN + 134217728;
constexpr size_t A_CUMA   = A_HLOC + 33554432;
constexpr size_t A_G      = A_CUMA + 33554432;
constexpr size_t A_BONUS  = A_G + 33554432;
constexpr size_t A_YRAW   = A_BONUS + 33554432;
constexpr size_t A_CARRYA = A_YRAW + 33554432;
constexpr size_t A_CARRYH = A_CARRYA + 1048576;
constexpr size_t A_HSTART = A_CARRYH + 1048576;
constexpr size_t A_CHAIN  = A_HSTART + 1048576;
constexpr size_t CHAIN_UNIT = 49152;
constexpr size_t M_YBUF   = OFF_ARENA;
constexpr size_t M_ZB     = OFF_ARENA + 335544320;
constexpr size_t M_HBUF   = M_YBUF + 603979776;
constexpr size_t M_LIST   = M_HBUF + 159383552;
constexpr size_t M_WSEL   = M_LIST + 8388608;
constexpr size_t M_PMAP   = M_WSEL + 1048576;
constexpr size_t M_STAT   = M_PMAP + 1048576;
constexpr size_t OFF_WLT  = M_STAT + 262144;
constexpr size_t OFF_WGT  = OFF_WLT + 131072;
constexpr size_t WS_NEED  = OFF_WGT + 131072;
static_assert(WS_NEED <= (size_t)1 << 30, "workspace layout exceeds the guaranteed 1 GiB");

struct Params {
    const float* in[39];
    float* out;
    unsigned char* ws;
};
typedef const __attribute__((address_space(4))) Params* KP;
constexpr int WTAB_OFF = 159744 - 16 - 256;
__device__ __forceinline__ int wave_index() {
    extern __shared__ __attribute__((aligned(16))) char lds_tab[];
    unsigned hw; asm volatile("s_getreg_b32 %0, hwreg(HW_REG_HW_ID, 0, 6)" : "=s"(hw));
    const int w = ((const volatile LAS int*)(lds_tab + WTAB_OFF))[hw & 63u];
    return __builtin_amdgcn_readfirstlane(w);
}
__device__ __forceinline__ int lane_index() { int l; asm volatile("v_mbcnt_lo_u32_b32 %0, -1, 0\n\tv_mbcnt_hi_u32_b32 %0, -1, %0" : "=v"(l)); return l; }
__device__ __forceinline__ int TID512() { int t = (wave_index() << 6) | lane_index(); asm volatile("" : "+v"(t)); __builtin_assume(t >= 0 && t < 512); return t; }
__device__ __forceinline__ int TIDX() { int t = ((wave_index() & 3) << 6) | lane_index(); asm volatile("" : "+v"(t)); __builtin_assume(t >= 0 && t < 256); return t; }
__device__ __forceinline__ int BIDX() { int b = blockIdx.x * 2 + (wave_index() >> 2); asm volatile("" : "+s"(b)); __builtin_assume(b >= 0 && b < 65536); return b; }
__device__ __forceinline__ int NBV() { return gridDim.x * 2; }
enum { I_X = 0, I_C, I_WMOD, I_BMOD, I_WIN, I_WOUT, I_CONVA, I_CONVAB, I_LNAG, I_LNAB, I_CONVB, I_CONVBB, I_WRG, I_BRG, I_WIG, I_BIG,
       I_LAMBDA, I_MUC, I_W0, I_WW2, I_A0, I_WA2, I_WG2, I_KK, I_KA, I_RK, I_GNG, I_GNB, I_CONVD, I_LN1G, I_LN1B, I_WROUTER, I_EBIAS,
       I_W13, I_W2, I_WS13, I_WS2, I_LN2G, I_LN2B };

DEVINL bf16_t f2bf(float f) { unsigned u = __float_as_uint(f); u += 0x7FFFu + ((u >> 16) & 1u); return (bf16_t)(u >> 16); }
DEVINL float bf2f(bf16_t h) { return __uint_as_float(((unsigned)h) << 16); }
typedef __bf16 bf2_t __attribute__((ext_vector_type(2)));
typedef float f2_t __attribute__((ext_vector_type(2)));
typedef float f32x16 __attribute__((ext_vector_type(16)));
DEVINL unsigned pack2(float a, float b) { f2_t v = {a, b}; return __builtin_bit_cast(unsigned, __builtin_convertvector(v, bf2_t)); }
DEVINL float sigm(float x) { return __builtin_amdgcn_rcpf(1.f + __expf(-x)); }
DEVINL float tanh_fast(float x) { const float e = __expf(2.f * x); return 1.f - 2.f * __builtin_amdgcn_rcpf(1.f + e); }
DEVINL float softplusf(float z) { return fmaxf(z, 0.f) + __logf(1.f + __expf(-fabsf(z))); }
DEVINL float log1p_s(float y) { return (y < 0.03125f) ? y * (1.f - y * (0.5f - y * (0.33333334f - 0.25f * y))) : __logf(1.f + y); }
DEVINL float softplus_acc(float z) { return fmaxf(z, 0.f) + log1p_s(__expf(-fabsf(z))); }
DEVINL float gelu_tanh(float x) { float u = 0.7978845608028654f * (x + 0.044715f * x * x * x); return 0.5f * x * (1.f + tanh_fast(u)); }
DEVINL float group8_max(float x) {
    x = fmaxf(x, __builtin_bit_cast(float, __builtin_amdgcn_update_dpp(0, __builtin_bit_cast(int, x), 0xB1, 0xf, 0xf, true)));
    x = fmaxf(x, __builtin_bit_cast(float, __builtin_amdgcn_update_dpp(0, __builtin_bit_cast(int, x), 0x4E, 0xf, 0xf, true)));
    x = fmaxf(x, __builtin_bit_cast(float, __builtin_amdgcn_update_dpp(0, __builtin_bit_cast(int, x), 0x141, 0xf, 0xf, true)));
    return x;
}
DEVINL float wave_max(float x) {
#define WM_STEP(ctrl, rmask) x = fmaxf(x, __builtin_bit_cast(float, __builtin_amdgcn_update_dpp(__builtin_bit_cast(int, x), __builtin_bit_cast(int, x), ctrl, rmask, 0xf, false)))
    WM_STEP(0xB1, 0xf); WM_STEP(0x4E, 0xf); WM_STEP(0x141, 0xf); WM_STEP(0x140, 0xf); WM_STEP(0x142, 0xa); WM_STEP(0x143, 0xc);
#undef WM_STEP
    return __builtin_bit_cast(float, __builtin_amdgcn_readlane(__builtin_bit_cast(int, x), 63));
}
DEVINL float wave_sum_dpp(float x);
DEVINL float wave_sum(float x) { return wave_sum_dpp(x); }
DEVINL float wave_sum_dpp(float x) {
    x += __builtin_bit_cast(float, __builtin_amdgcn_update_dpp(0, __builtin_bit_cast(int, x), 0xB1, 0xf, 0xf, true));
    x += __builtin_bit_cast(float, __builtin_amdgcn_update_dpp(0, __builtin_bit_cast(int, x), 0x4E, 0xf, 0xf, true));
    x += __builtin_bit_cast(float, __builtin_amdgcn_update_dpp(0, __builtin_bit_cast(int, x), 0x141, 0xf, 0xf, true));
    x += __builtin_bit_cast(float, __builtin_amdgcn_update_dpp(0, __builtin_bit_cast(int, x), 0x140, 0xf, 0xf, true));
    x += __builtin_bit_cast(float, __builtin_amdgcn_update_dpp(0, __builtin_bit_cast(int, x), 0x142, 0xa, 0xf, false));
    x += __builtin_bit_cast(float, __builtin_amdgcn_update_dpp(0, __builtin_bit_cast(int, x), 0x143, 0xc, 0xf, false));
    return __builtin_bit_cast(float, __builtin_amdgcn_readlane(__builtin_bit_cast(int, x), 63));
}

DEVINL int lds_byte(int r, int c) { int st = (r >> 4) * 2 + (c >> 5), rr = r & 15, cc = c & 31, ob = rr * 64 + cc * 2; return st * 1024 + (ob ^ (((ob >> 9) & 1) << 5)); }
DEVINL void stage_rc(int b, int& R, int& C) { int st = b / 1024, sb = b % 1024, swz = sb ^ (((sb >> 9) & 1) << 5); R = (st >> 1) * 16 + swz / 64; C = (st & 1) * 32 + (swz % 64) / 2; }

template <class RowPtr, class Epi>
DEVINL void gemm_tile128(char* lds, RowPtr arow, const bf16_t* Bt, int K, Epi epi) {
    const int tid = TIDX();
    const bf16_t* ap[4]; const bf16_t* bp[4];
#pragma unroll
    for (int i = 0; i < 4; ++i) { int R, C; stage_rc(tid * 16 + i * 4096, R, C); ap[i] = arow(R) + C; bp[i] = Bt + (size_t)R * K + C; }
    const int wid = tid >> 6, lane = tid & 63, wr = wid >> 1, wc = wid & 1, fr = lane & 15, fq = lane >> 4;
    f32x4 acc[4][4];
#pragma unroll
    for (int m = 0; m < 4; ++m)
#pragma unroll
        for (int n = 0; n < 4; ++n) acc[m][n] = (f32x4){0.f, 0.f, 0.f, 0.f};
    const int nk = K >> 6;
#pragma unroll
    for (int i = 0; i < 4; ++i) {
        __builtin_amdgcn_global_load_lds((const unsigned*)(ap[i]), (unsigned*)(lds + tid * 16 + i * 4096), 16, 0, 0);
        __builtin_amdgcn_global_load_lds((const unsigned*)(bp[i]), (unsigned*)(lds + 16384 + tid * 16 + i * 4096), 16, 0, 0);
    }
    for (int kt = 0; kt < nk; ++kt) {
        asm volatile("s_waitcnt vmcnt(0)" ::: "memory");
        __syncthreads();
        char* cur = lds + (kt & 1) * 32768;
        if (kt + 1 < nk) {
            char* nxt = lds + ((kt + 1) & 1) * 32768;
            const int ko = (kt + 1) * 64;
#pragma unroll
            for (int i = 0; i < 4; ++i) {
                __builtin_amdgcn_global_load_lds((const unsigned*)(ap[i] + ko), (unsigned*)(nxt + tid * 16 + i * 4096), 16, 0, 0);
                __builtin_amdgcn_global_load_lds((const unsigned*)(bp[i] + ko), (unsigned*)(nxt + 16384 + tid * 16 + i * 4096), 16, 0, 0);
            }
        }
        bf16x8 af[4][2], bfr[4][2];
#pragma unroll
        for (int m = 0; m < 4; ++m)
#pragma unroll
            for (int kk = 0; kk < 2; ++kk) af[m][kk] = *reinterpret_cast<const bf16x8*>(cur + lds_byte(wr * 64 + m * 16 + fr, kk * 32 + fq * 8));
#pragma unroll
        for (int n = 0; n < 4; ++n)
#pragma unroll
            for (int kk = 0; kk < 2; ++kk) bfr[n][kk] = *reinterpret_cast<const bf16x8*>(cur + 16384 + lds_byte(wc * 64 + n * 16 + fr, kk * 32 + fq * 8));
#pragma unroll
        for (int kk = 0; kk < 2; ++kk)
#pragma unroll
            for (int m = 0; m < 4; ++m)
#pragma unroll
                for (int n = 0; n < 4; ++n) acc[m][n] = __builtin_amdgcn_mfma_f32_16x16x32_bf16(bfr[n][kk], af[m][kk], acc[m][n], 0, 0, 0);
    }
    __syncthreads();
    epi(acc, wr, wc, fr, fq);
}

template <class Ptrs, class Epi>
DEVINL void gemm_stream128(char* lds, int K, int blk, int nb, int total, Ptrs ptrs, Epi epi) {
    const int qx = nb >> 3, first = (blk & 7) * qx + (blk >> 3), stride = nb;
    if (first >= total) return;
    const int tid = TIDX();
    const int wid = tid >> 6, lane = tid & 63, wr = wid >> 1, wc = wid & 1, fr = lane & 15, fq = lane >> 4;
    const int nk = K >> 6;
    const bf16_t* ap[4]; const bf16_t* bp[4];
    const bf16_t* an[4]; const bf16_t* bn[4];
    int t = first;
    ptrs(t, ap, bp);
#pragma unroll
    for (int i = 0; i < 4; ++i) {
        __builtin_amdgcn_global_load_lds((const unsigned*)(ap[i]), (unsigned*)(lds + tid * 16 + i * 4096), 16, 0, 0);
        __builtin_amdgcn_global_load_lds((const unsigned*)(bp[i]), (unsigned*)(lds + 16384 + tid * 16 + i * 4096), 16, 0, 0);
    }
    for (;;) {
        const int tn = t + stride;
        const bool has_next = tn < total;
        if (has_next) ptrs(tn, an, bn);
        f32x4 acc[4][4];
#pragma unroll
        for (int m = 0; m < 4; ++m)
#pragma unroll
            for (int n = 0; n < 4; ++n) acc[m][n] = (f32x4){0.f, 0.f, 0.f, 0.f};
        for (int kt = 0; kt < nk; ++kt) {
            asm volatile("s_waitcnt vmcnt(0)" ::: "memory");
            __syncthreads();
            char* cur = lds + (kt & 1) * 32768;
            if (kt + 1 < nk) {
                char* nxt = lds + ((kt + 1) & 1) * 32768;
                const int ko = (kt + 1) * 64;
#pragma unroll
                for (int i = 0; i < 4; ++i) {
                    __builtin_amdgcn_global_load_lds((const unsigned*)(ap[i] + ko), (unsigned*)(nxt + tid * 16 + i * 4096), 16, 0, 0);
                    __builtin_amdgcn_global_load_lds((const unsigned*)(bp[i] + ko), (unsigned*)(nxt + 16384 + tid * 16 + i * 4096), 16, 0, 0);
                }
            } else if (has_next) {
#pragma unroll
                for (int i = 0; i < 4; ++i) {
                    __builtin_amdgcn_global_load_lds((const unsigned*)(an[i]), (unsigned*)(lds + tid * 16 + i * 4096), 16, 0, 0);
                    __builtin_amdgcn_global_load_lds((const unsigned*)(bn[i]), (unsigned*)(lds + 16384 + tid * 16 + i * 4096), 16, 0, 0);
                }
            }
            bf16x8 af[4][2], bfr[4][2];
#pragma unroll
            for (int m = 0; m < 4; ++m)
#pragma unroll
                for (int kk = 0; kk < 2; ++kk) af[m][kk] = *reinterpret_cast<const bf16x8*>(cur + lds_byte(wr * 64 + m * 16 + fr, kk * 32 + fq * 8));
#pragma unroll
            for (int n = 0; n < 4; ++n)
#pragma unroll
                for (int kk = 0; kk < 2; ++kk) bfr[n][kk] = *reinterpret_cast<const bf16x8*>(cur + 16384 + lds_byte(wc * 64 + n * 16 + fr, kk * 32 + fq * 8));
#pragma unroll
            for (int kk = 0; kk < 2; ++kk)
#pragma unroll
                for (int m = 0; m < 4; ++m)
#pragma unroll
                    for (int n = 0; n < 4; ++n) acc[m][n] = __builtin_amdgcn_mfma_f32_16x16x32_bf16(bfr[n][kk], af[m][kk], acc[m][n], 0, 0, 0);
        }
        epi(t, acc, wr, wc, fr, fq);
        if (!has_next) break;
        t = tn;
#pragma unroll
        for (int i = 0; i < 4; ++i) { ap[i] = an[i]; bp[i] = bn[i]; }
    }
    __syncthreads();
}
DEVINL void stage_coords(int (&R)[4], int (&C)[4]) {
    const int tid = TIDX();
#pragma unroll
    for (int i = 0; i < 4; ++i) stage_rc(tid * 16 + i * 4096, R[i], C[i]);
}

struct GUnit {
    const char* A;
    const char* B;
    unsigned va[2][2] = {{0u, 0u}, {0u, 0u}};
    int i0, i1, i2;
};
constexpr int G_HTB = 128 * 64 * 2;
constexpr int G_STAGE_BYTES = 8 * G_HTB;
DEVINL int perm32(int rho) { const int n = rho >> 4, i = rho & 15; return 8 * (i >> 2) + 4 * n + (i & 3); }
DEVINL void stage_coords512(int tid, int (&R)[2], int (&C)[2]) {
#pragma unroll
    for (int i = 0; i < 2; ++i) stage_rc(tid * 16 + i * 8192, R[i], C[i]);
}

typedef int v8i_t __attribute__((ext_vector_type(8)));
typedef int v4i_t __attribute__((ext_vector_type(4)));
DEVINL v8i_t cat8(bf16x8 lo, bf16x8 hi) { return __builtin_shufflevector(__builtin_bit_cast(v4i_t, lo), __builtin_bit_cast(v4i_t, hi), 0, 1, 2, 3, 4, 5, 6, 7); }
template <bool PERM, bool GATHER, bool FP8, class Sched, class Epi>
DEVINL void gemm256(char* lds_generic, int K, int lda, Sched sched, Epi epi) {
    LAS unsigned char* lds = (LAS unsigned char*)lds_generic;
    const int tid = TID512(), wid = __builtin_amdgcn_readfirstlane(tid >> 6), lane = tid & 63, wr = wid >> 2, wc = wid & 3, fr = lane & 15, fq = lane >> 4;
    const int nt = K / 64;
    unsigned voffB[2];
#pragma unroll
    for (int i = 0; i < 2; ++i) { int R, C; stage_rc(tid * 16 + i * 8192, R, C); const int Rb = PERM ? ((R & ~31) + perm32(R & 31)) : R; voffB[i] = (unsigned)(Rb * K + C) * 2u; }
    unsigned voffA[2];
#pragma unroll
    for (int i = 0; i < 2; ++i) { int R, C; stage_rc(tid * 16 + i * 8192, R, C); voffA[i] = (unsigned)(R * lda + C) * 2u; }
    const size_t hstepA = GATHER ? 0 : (size_t)128 * lda * 2;
    const size_t kstep = (size_t)(64 * 2);
    const size_t hstepB = (size_t)128 * K * 2;
    const unsigned ldsw = (unsigned)wid * 1024u;
    const int aoff = lds_byte(wr * 64 + fr, fq * 8), boff = lds_byte(wc * 32 + fr, fq * 8);
#define G_SA(b, h) (((b) * 2 + (h)) * G_HTB)
#define G_SB(b, h) ((4 + (b) * 2 + (h)) * G_HTB)
#define G_STAGE(bufoff, gbase, voff) do { _Pragma("unroll") for (int _i = 0; _i < 2; ++_i) { unsigned _vo = (voff)[_i]; asm volatile("" : "+v"(_vo)); \
        __builtin_amdgcn_global_load_lds((const unsigned*)((const char*)(gbase) + _vo), (LAS unsigned*)(lds + (bufoff) + ldsw + _i * 8192), 16, 0, 0); } } while (0)
#define G_STAGE_A(bufoff, ptr, vg, h) do { if constexpr (GATHER) { G_STAGE(bufoff, ptr, vg); } else { G_STAGE(bufoff, (ptr) + (h) * hstepA, voffA); } } while (0)
#define G_LDA(dst, b, h) do { _Pragma("unroll") for (int m = 0; m < 4; ++m) dst[m] = cat8(*(const LAS bf16x8*)(lds + G_SA(b, h) + aoff + m * 2048), *(const LAS bf16x8*)(lds + G_SA(b, h) + aoff + m * 2048 + 1024)); } while (0)
#define G_LDB(dst, b, h) do { _Pragma("unroll") for (int n = 0; n < 2; ++n) dst[n] = cat8(*(const LAS bf16x8*)(lds + G_SB(b, h) + boff + n * 2048), *(const LAS bf16x8*)(lds + G_SB(b, h) + boff + n * 2048 + 1024)); } while (0)
#define G_LO(x) __builtin_bit_cast(bf16x8, __builtin_shufflevector((x), (x), 0, 1, 2, 3))
#define G_HI(x) __builtin_bit_cast(bf16x8, __builtin_shufflevector((x), (x), 4, 5, 6, 7))
#define G_MMA(ai, bj, At, Bt) do { __builtin_amdgcn_s_setprio(1); \
        if constexpr (FP8) { _Pragma("unroll") for (int m = 0; m < 4; ++m) _Pragma("unroll") for (int n = 0; n < 2; ++n) \
            acc[ai][bj][m][n] = __builtin_amdgcn_mfma_scale_f32_16x16x128_f8f6f4(Bt[n], At[m], acc[ai][bj][m][n], 0, 0, 0, 0x7D7D7D7D, 0, 0x7D7D7D7D); } \
        else { _Pragma("unroll") for (int m = 0; m < 4; ++m) _Pragma("unroll") for (int n = 0; n < 2; ++n) { \
            acc[ai][bj][m][n] = __builtin_amdgcn_mfma_f32_16x16x32_bf16(G_LO(Bt[n]), G_LO(At[m]), acc[ai][bj][m][n], 0, 0, 0); \
            acc[ai][bj][m][n] = __builtin_amdgcn_mfma_f32_16x16x32_bf16(G_HI(Bt[n]), G_HI(At[m]), acc[ai][bj][m][n], 0, 0, 0); } } \
        __builtin_amdgcn_s_setprio(0); } while (0)
#define G_WAIT_V(n) asm volatile("s_waitcnt vmcnt(" #n ")" ::: "memory")
#define G_WAIT_L(n) asm volatile("s_waitcnt lgkmcnt(" #n ")" ::: "memory")
#define G_BAR __builtin_amdgcn_s_barrier()
#define G_SCHED __builtin_amdgcn_sched_barrier(0)
    GUnit cur, nxt; int ui = 0;
    if (!sched(0, cur)) return;
    LAS unsigned* vst = (LAS unsigned*)(lds + 131072 + 8192) + tid * 8;
    if constexpr (GATHER) { vst[0] = cur.va[0][0]; vst[1] = cur.va[0][1]; vst[2] = cur.va[1][0]; vst[3] = cur.va[1][1]; }
    f32x4 acc[2][2][4][2];
#pragma unroll
    for (int a = 0; a < 2; ++a)
#pragma unroll
        for (int b = 0; b < 2; ++b)
#pragma unroll
            for (int m = 0; m < 4; ++m)
#pragma unroll
                for (int n = 0; n < 2; ++n) acc[a][b][m][n] = (f32x4){0.f, 0.f, 0.f, 0.f};
    v8i_t At[4], B0[2], B1[2];
    G_STAGE(G_SB(0, 0), cur.B, voffB); G_STAGE_A(G_SA(0, 0), cur.A, cur.va[0], 0); G_STAGE(G_SB(0, 1), cur.B + hstepB, voffB); G_STAGE_A(G_SA(0, 1), cur.A, cur.va[1], 1);
    if (wr == 1) G_BAR;
    G_WAIT_V(4); G_BAR;
    G_STAGE(G_SB(1, 0), cur.B + kstep, voffB); G_STAGE_A(G_SA(1, 0), cur.A + kstep, cur.va[0], 0); G_STAGE(G_SB(1, 1), cur.B + hstepB + kstep, voffB);
    G_WAIT_V(6); G_BAR;
    for (;;) {
        const bool has_next = sched(ui + 1, nxt);
        if (!has_next) nxt = cur;
        if constexpr (GATHER) { LAS unsigned* vn = vst + ((ui + 1) & 1) * 4; vn[0] = nxt.va[0][0]; vn[1] = nxt.va[0][1]; vn[2] = nxt.va[1][0]; vn[3] = nxt.va[1][1]; }
#pragma unroll 1
        for (int t = 0; t < nt; t += 2) {
            const bool last = (t == nt - 2);
            const char* a1 = cur.A + (size_t)(t + 1) * kstep;
            const char* a2 = last ? nxt.A : cur.A + (size_t)(t + 2) * kstep; const char* b2 = last ? nxt.B : cur.B + (size_t)(t + 2) * kstep;
            const char* a3 = a2 + kstep; const char* b3 = b2 + kstep;
            G_LDB(B0, 0, 0); G_SCHED; G_LDA(At, 0, 0); { unsigned nv[2] = {0u, 0u}; if constexpr (GATHER) { LAS unsigned* q_ = vst + (ui & 1) * 4; nv[0] = q_[2]; nv[1] = q_[3]; } G_STAGE_A(G_SA(1, 1), a1, nv, 1); }
            G_WAIT_L(8); G_BAR; G_WAIT_L(0); G_MMA(0, 0, At, B0); G_BAR; G_SCHED;
            G_LDB(B1, 0, 1); G_STAGE(G_SB(0, 0), b2, voffB);
            G_BAR; G_WAIT_L(0); G_MMA(0, 1, At, B1); G_BAR;
            G_LDA(At, 0, 1); { unsigned nv[2] = {0u, 0u}; if constexpr (GATHER) { LAS unsigned* q_ = vst + ((ui + (last ? 1 : 0)) & 1) * 4; nv[0] = q_[0]; nv[1] = q_[1]; } G_STAGE_A(G_SA(0, 0), a2, nv, 0); }
            G_BAR; G_WAIT_L(0); G_MMA(1, 0, At, B0); G_BAR; G_SCHED;
            G_STAGE(G_SB(0, 1), b2 + hstepB, voffB);
            G_WAIT_V(6); G_BAR; G_MMA(1, 1, At, B1); G_BAR;
            G_LDB(B0, 1, 0); G_SCHED; G_LDA(At, 1, 0); { unsigned nv[2] = {0u, 0u}; if constexpr (GATHER) { LAS unsigned* q_ = vst + ((ui + (last ? 1 : 0)) & 1) * 4; nv[0] = q_[2]; nv[1] = q_[3]; } G_STAGE_A(G_SA(0, 1), a2, nv, 1); }
            G_WAIT_L(8); G_BAR; G_WAIT_L(0); G_MMA(0, 0, At, B0); G_BAR; G_SCHED;
            G_LDB(B1, 1, 1); G_STAGE(G_SB(1, 0), b3, voffB);
            G_BAR; G_WAIT_L(0); G_MMA(0, 1, At, B1); G_BAR;
            G_LDA(At, 1, 1); { unsigned nv[2] = {0u, 0u}; if constexpr (GATHER) { LAS unsigned* q_ = vst + ((ui + (last ? 1 : 0)) & 1) * 4; nv[0] = q_[0]; nv[1] = q_[1]; } G_STAGE_A(G_SA(1, 0), a3, nv, 0); }
            G_BAR; G_WAIT_L(0); G_MMA(1, 0, At, B0); G_BAR; G_SCHED;
            G_STAGE(G_SB(1, 1), b3 + hstepB, voffB);
            G_WAIT_V(6); G_BAR; G_MMA(1, 1, At, B1); G_BAR;
        }
        { const int l2 = TID512() & 63; epi(acc, cur, wr, wc, l2 & 15, l2 >> 4); }
        if (!has_next) break;
#pragma unroll
        for (int a = 0; a < 2; ++a)
#pragma unroll
            for (int b = 0; b < 2; ++b)
#pragma unroll
                for (int m = 0; m < 4; ++m)
#pragma unroll
                    for (int n = 0; n < 2; ++n) acc[a][b][m][n] = (f32x4){0.f, 0.f, 0.f, 0.f};
        cur = nxt; ++ui;
    }
    G_WAIT_V(0);
    if (wr == 0) G_BAR;
    G_BAR;
#undef G_SA
#undef G_STAGE_A
#undef G_SB
#undef G_STAGE
#undef G_LDA
#undef G_LDB
#undef G_MMA
#undef G_LO
#undef G_HI
#undef G_WAIT_V
#undef G_WAIT_L
#undef G_BAR
#undef G_SCHED
}
DEVINL long unit_linear(int i, int c, int G) { const int q = G >> 3; return ((long)i * 8 + (c & 7)) * q + (c >> 3); }

constexpr int CONV_PER_L = 672 + 256 + 8320 + 4160;
struct ConvJob { const float* src; bf16_t* dst; int K, ld, k0, r0, perm, f8; };
DEVINL ConvJob conv_decode(KP p, int id) {
    ConvJob j; const int l = id / CONV_PER_L; int r = id % CONV_PER_L; int kt, nt;
    if (r < 672) { j.src = p->in[I_WIN] + (size_t)l * 1024 * 2688; j.K = 1024; j.ld = 2688; j.perm = 0; j.dst = (bf16_t*)(p->ws + OFF_WIN + (size_t)l * WIN_ROWS * 1024); j.f8 = 1; nt = r % 42; kt = r / 42; }
    else if (r < 928) { r -= 672; j.src = p->in[I_WOUT] + (size_t)l * 1024 * 1024; j.K = 1024; j.ld = 1024; j.perm = 0; j.dst = (bf16_t*)(p->ws + OFF_WOUT) + (size_t)l * 1024 * 1024; j.f8 = 0; nt = r & 15; kt = r >> 4; }
    else if (r < 928 + 8320) { r -= 928; const int e = r >> 7, q = r & 127; nt = q & 7; kt = q >> 3; j.K = 1024; j.ld = 512; j.perm = 1; j.f8 = 1;
        j.src = (e < 64) ? p->in[I_W13] + (size_t)(l * 64 + e) * 1024 * 512 : p->in[I_WS13] + (size_t)l * 1024 * 512;
        j.dst = (bf16_t*)(p->ws + OFF_W13 + (size_t)(l * 65 + e) * 512 * 1024); }
    else { r -= 9248; const int e = r >> 6, q = r & 63; nt = q & 15; kt = q >> 4; j.K = 256; j.ld = 1024; j.perm = 0; j.f8 = 0;
        j.src = (e < 64) ? p->in[I_W2] + (size_t)(l * 64 + e) * 256 * 1024 : p->in[I_WS2] + (size_t)l * 256 * 1024;
        j.dst = (bf16_t*)(p->ws + OFF_W2) + (size_t)(l * 65 + e) * 1024 * 256; }
    j.k0 = kt * 64; j.r0 = nt * 64; return j;
}
DEVINL void conv_issue(const ConvJob& j, char* buf, int tid) {
    const int nn = tid & 63, drow = j.r0 + nn;
    int scol = drow;
    if (j.perm) { const int g = drow >> 5, i = drow & 31; scol = (i < 16) ? (g * 16 + i) : (256 + g * 16 + (i - 16)); }
    const float* sp = j.src + (size_t)j.k0 * j.ld + scol;
#pragma unroll
    for (int q = 0; q < 16; ++q) { const int kk = (tid >> 6) + 4 * q;
        __builtin_amdgcn_global_load_lds((const unsigned*)(sp + (size_t)kk * j.ld), (unsigned*)(buf + kk * 260 + nn * 4), 4, 0, 0); }
}
DEVINL void convert_ids(KP p, char* lds, int id_lo, int id_hi, int wb, int nwb) {
    const int tid = TIDX();
    const int n = (id_hi - id_lo + nwb - 1) / nwb;
    auto idof = [&](int i) { const int id = id_lo + i * nwb + wb; return (id < id_hi) ? id : id_hi - 1; };
    ConvJob j0 = conv_decode(p, idof(0)), j1 = conv_decode(p, idof(n > 1 ? 1 : 0));
    conv_issue(j0, lds, tid);
    conv_issue(j1, lds + 16640, tid);
    auto dptr = [](const ConvJob& j) { return (char*)j.dst + ((size_t)j.r0 * j.K + j.k0) * (j.f8 ? 1 : 2); };
    char* d0 = dptr(j0); int K0 = j0.K, f0 = j0.f8;
    char* d1 = dptr(j1); int K1 = j1.K, f1 = j1.f8;
    for (int i = 0; i < n; ++i) {
        const ConvJob j2 = conv_decode(p, idof(i + 2 < n ? i + 2 : n - 1));
        conv_issue(j2, lds + ((i + 2) % 3) * 16640, tid);
        asm volatile("s_waitcnt vmcnt(32)" ::: "memory");
        __builtin_amdgcn_s_barrier();
        const float* tile = (const float*)(lds + (i % 3) * 16640);
        if (f0) {
            const int kp = (tid & 15) * 4;
#pragma unroll
            for (int q = 0; q < 4; ++q) { const int rr = (tid >> 4) + 16 * q;
                int w8 = __builtin_amdgcn_cvt_pk_fp8_f32(16.f * tile[kp * 65 + rr], 16.f * tile[(kp + 1) * 65 + rr], 0, false);
                w8 = __builtin_amdgcn_cvt_pk_fp8_f32(16.f * tile[(kp + 2) * 65 + rr], 16.f * tile[(kp + 3) * 65 + rr], w8, true);
                *(int*)(d0 + (size_t)rr * K0 + kp) = w8; }
        } else {
            const int kp = (tid & 31) * 2;
#pragma unroll
            for (int q = 0; q < 8; ++q) { const int rr = (tid >> 5) + 8 * q;
                *(unsigned*)(d0 + ((size_t)rr * K0 + kp) * 2) = pack2(tile[kp * 65 + rr], tile[(kp + 1) * 65 + rr]); }
        }
        asm volatile("s_waitcnt lgkmcnt(0)" ::: "memory");
        __builtin_amdgcn_s_barrier();
        d0 = d1; K0 = K1; f0 = f1; d1 = dptr(j2); K1 = j2.K; f1 = j2.f8;
    }
    asm volatile("s_waitcnt vmcnt(0)" ::: "memory");
    __syncthreads();
}

DEVINL void phase0(KP p, char* lds) {
    const int tid = TIDX(), nb = NBV(), blk = BIDX();
    if (blk == 0 && tid < 128) ((unsigned*)(p->ws + OFF_CNT))[tid] = 0u;
    if (blk < 192) {
        float* sc = (float*)lds;
        float* part = (float*)(lds + 32768);
        for (int i = tid; i < 8192; i += VTHREADS) { float c = p->in[I_C][i]; sc[i] = c * sigm(c); }
        __syncthreads();
        const int cl = tid & 63, ks = tid >> 6, n = blk * 64 + cl, l = n / 6144, nn = n % 6144;
        const float* w = p->in[I_WMOD] + (size_t)l * 1024 * 6144 + (size_t)(ks * 256) * 6144 + nn;
        float acc[8];
#pragma unroll
        for (int b = 0; b < 8; ++b) acc[b] = 0.f;
#pragma unroll 32
        for (int k = 0; k < 256; ++k) {
            const float wv = w[(size_t)k * 6144];
#pragma unroll
            for (int b = 0; b < 8; ++b) acc[b] = fmaf(sc[b * 1024 + ks * 256 + k], wv, acc[b]);
        }
#pragma unroll
        for (int b = 0; b < 8; ++b) part[(ks * 8 + b) * 64 + cl] = acc[b];
        __syncthreads();
        if (tid < 64) {
            const float bm = p->in[I_BMOD][l * 6144 + nn];
            float* mod = (float*)(p->ws + OFF_MOD);
#pragma unroll
            for (int b = 0; b < 8; ++b) mod[(size_t)(l * 8 + b) * 6144 + nn] = part[(0 * 8 + b) * 64 + cl] + part[(1 * 8 + b) * 64 + cl] + part[(2 * 8 + b) * 64 + cl] + part[(3 * 8 + b) * 64 + cl] + bm;
        }
        __syncthreads();
    }
    if (blk >= 320 && blk < 384) {
        bf16_t* wgt = (bf16_t*)(p->ws + OFF_WGT);
#pragma unroll
        for (int j = 0; j < 4; ++j) {
            const int idx = (blk - 320) * 1024 + j * 256 + tid;
            const int mat = idx >> 15, lh = (idx >> 12) & 7, d = (idx >> 6) & 63, e = idx & 63;
            const float w = (mat == 0) ? p->in[I_WRG][idx & 32767] : p->in[I_WIG][idx & 32767];
            wgt[(size_t)((lh * 2 + mat) * 64 + e) * 64 + d] = f2bf(w);
        }
    }
    if (blk >= 256 && blk < 320) {
        bf16_t* wlt = (bf16_t*)(p->ws + OFF_WLT);
#pragma unroll
        for (int j = 0; j < 4; ++j) {
            const int idx = (blk - 256) * 1024 + j * 256 + tid, l2 = idx >> 15, f = (idx >> 8) & 127, c = idx & 255;
            const float w = (f < 32) ? p->in[I_WW2][(size_t)(l2 * 32 + f) * 256 + c] : ((f < 64) ? p->in[I_WA2][(size_t)(l2 * 32 + f - 32) * 256 + c] : p->in[I_WG2][(size_t)(l2 * 64 + f - 64) * 256 + c]);
            wlt[(size_t)(l2 * 256 + c) * 128 + f] = f2bf(w);
        }
    }
    if (blk >= 192 && blk < 256) {
        bf16_t* wrt = (bf16_t*)(p->ws + OFF_WR);
#pragma unroll
        for (int j = 0; j < 8; ++j) {
            const int idx = (blk - 192) * 2048 + j * 256 + tid, l2 = idx >> 16, rem = idx & 65535, k = rem >> 6, e = rem & 63;
            const float w = p->in[I_WROUTER][idx];
            const bf16_t hi = f2bf(w); const bf16_t lo = f2bf(w - bf2f(hi));
            wrt[(size_t)((l2 * 2 + 0) * 64 + e) * 1024 + k] = hi; wrt[(size_t)((l2 * 2 + 1) * 64 + e) * 1024 + k] = lo;
        }
    }
    convert_ids(p, lds, 0, 2 * CONV_PER_L, blk, nb);
}

DEVINL void phaseF0(KP p) {
    const int tid = TIDX(), nb = NBV(), blk = BIDX();
    const float* mod = (const float*)(p->ws + OFF_MOD);
    bf16_t* ubuf = (bf16_t*)(p->ws + OFF_UBUF);
    const int col = tid * 4;
    for (int row0 = blk * 8; row0 < NTOK; row0 += nb * 8) {
        float4 x[8];
#pragma unroll
        for (int u = 0; u < 8; ++u) x[u] = *(const float4*)(p->in[I_X] + (size_t)(row0 + u) * DM + col);
        const int b = row0 >> 12;
        const float4 sh = *(const float4*)(mod + (size_t)b * 6144 + col);
        const float4 sc = *(const float4*)(mod + (size_t)b * 6144 + 1024 + col);
#pragma unroll
        for (int u = 0; u < 8; ++u) {
            int w8 = __builtin_amdgcn_cvt_pk_fp8_f32(x[u].x * (1.f + sc.x) + sh.x, x[u].y * (1.f + sc.y) + sh.y, 0, false);
            w8 = __builtin_amdgcn_cvt_pk_fp8_f32(x[u].z * (1.f + sc.z) + sh.z, x[u].w * (1.f + sc.w) + sh.w, w8, true);
            *(int*)((char*)ubuf + (size_t)(row0 + u) * DM + col) = w8;
        }
    }
}

DEVINL void b1_conformer(KP p, int l, char* lds, int item) {
    const int tid = TIDX(), b = item >> 7, tt = item & 127, t0 = tt * 32, rowbase = b * SEQ;
    const bf16_t* P = (const bf16_t*)(p->ws + A_P);
    bf16_t* ymix = (bf16_t*)(p->ws + A_YMIX);
    float w[31];
#pragma unroll
    for (int k = 0; k < 31; ++k) w[k] = p->in[I_CONVA][(size_t)(l * 31 + k) * 256 + tid];
    float acc[32];
    const float bias = p->in[I_CONVAB][l * 256 + tid];
#pragma unroll
    for (int j = 0; j < 32; ++j) acc[j] = bias;
#pragma unroll
    for (int rr = 0; rr < 62; ++rr) {
        const int t = t0 - 30 + rr;
        const bf16_t* pr = P + ((long)(rowbase + t0 - 30) * PIN + tid) + (long)rr * PIN;
        const float val = bf2f(pr[0]), gate = bf2f(pr[256]);
        const float h = (t >= 0) ? val * sigm(gate) : 0.f;
#pragma unroll
        for (int j = 0; j < 32; ++j) { const int k = rr - j; if (k >= 0 && k <= 30) acc[j] = fmaf(w[k], h, acc[j]); }
    }
    float* outb = (float*)lds;
#pragma unroll
    for (int j = 0; j < 32; ++j) outb[j * 256 + tid] = acc[j];
    __syncthreads();
    const int wid = tid >> 6, lane = tid & 63;
    const float4 g4 = *(const float4*)(p->in[I_LNAG] + l * 256 + lane * 4), b4 = *(const float4*)(p->in[I_LNAB] + l * 256 + lane * 4);
    for (int j = wid; j < 32; j += 4) {
        const float4 v = *(const float4*)(outb + j * 256 + lane * 4);
        const float mean = wave_sum(v.x + v.y + v.z + v.w) * (1.f / 256.f);
        const float d0 = v.x - mean, d1 = v.y - mean, d2 = v.z - mean, d3 = v.w - mean;
        const float var = wave_sum(d0 * d0 + d1 * d1 + d2 * d2 + d3 * d3) * (1.f / 256.f);
        const float rs = rsqrtf(var + LN_EPS);
        float y0 = d0 * rs * g4.x + b4.x, y1 = d1 * rs * g4.y + b4.y, y2 = d2 * rs * g4.z + b4.z, y3 = d3 * rs * g4.w + b4.w;
        y0 *= sigm(y0); y1 *= sigm(y1); y2 *= sigm(y2); y3 *= sigm(y3);
        uint2 o; o.x = pack2(y0, y1); o.y = pack2(y2, y3);
        *(uint2*)(ymix + (size_t)(rowbase + t0 + j) * DM + lane * 4) = o;
    }
    __syncthreads();
}

DEVINL void b1_shortconv(KP p, int l, int item) {
    const int tid = TIDX(), cg = tid & 31, tl = tid >> 5, b = item >> 6, t0 = (item & 63) * 64 + tl * 8, rowbase = b * SEQ;
    const bf16_t* P = (const bf16_t*)(p->ws + A_P);
    bf16_t* ymix = (bf16_t*)(p->ws + A_YMIX);
    float w0[8], w1[8], w2[8];
#pragma unroll
    for (int e = 0; e < 8; ++e) { w0[e] = p->in[I_CONVD][(l * 3 + 0) * 256 + cg * 8 + e]; w1[e] = p->in[I_CONVD][(l * 3 + 1) * 256 + cg * 8 + e]; w2[e] = p->in[I_CONVD][(l * 3 + 2) * 256 + cg * 8 + e]; }
    uint4 gbv[8], gcv[10], hdv[10];
#pragma unroll
    for (int u = 0; u < 10; ++u) {
        const int t = t0 - 2 + u;
        const bf16_t* a = P + (size_t)(rowbase + (t >= 0 ? t : 0)) * PIN + 1920 + cg * 8;
        gcv[u] = *(const uint4*)(a + 256); hdv[u] = *(const uint4*)(a + 512);
        if (u >= 2) gbv[u - 2] = *(const uint4*)(a);
    }
    float q2[8], q1[8];
#pragma unroll
    for (int u = 0; u < 10; ++u) {
        const int t = t0 - 2 + u;
        const unsigned gcw[4] = {gcv[u].x, gcv[u].y, gcv[u].z, gcv[u].w}, hdw[4] = {hdv[u].x, hdv[u].y, hdv[u].z, hdv[u].w};
        float q0[8];
#pragma unroll
        for (int e = 0; e < 4; ++e) {
            q0[2 * e] = __uint_as_float(gcw[e] << 16) * __uint_as_float(hdw[e] << 16);
            q0[2 * e + 1] = __uint_as_float(gcw[e] & 0xFFFF0000u) * __uint_as_float(hdw[e] & 0xFFFF0000u);
        }
        if (t < 0) {
#pragma unroll
            for (int e = 0; e < 8; ++e) q0[e] = 0.f;
        }
        if (u >= 2) {
            const unsigned gbw[4] = {gbv[u - 2].x, gbv[u - 2].y, gbv[u - 2].z, gbv[u - 2].w};
            float y[8];
#pragma unroll
            for (int e = 0; e < 4; ++e) {
                y[2 * e] = __uint_as_float(gbw[e] << 16) * (w0[2 * e] * q2[2 * e] + w1[2 * e] * q1[2 * e] + w2[2 * e] * q0[2 * e]);
                y[2 * e + 1] = __uint_as_float(gbw[e] & 0xFFFF0000u) * (w0[2 * e + 1] * q2[2 * e + 1] + w1[2 * e + 1] * q1[2 * e + 1] + w2[2 * e + 1] * q0[2 * e + 1]);
            }
            *(uint4*)(ymix + (size_t)(rowbase + t) * DM + 768 + cg * 8) = make_uint4(pack2(y[0], y[1]), pack2(y[2], y[3]), pack2(y[4], y[5]), pack2(y[6], y[7]));
        }
#pragma unroll
        for (int e = 0; e < 8; ++e) { q2[e] = (u >= 1) ? q1[e] : 0.f; q1[e] = q0[e]; }
    }
}

DEVINL void b1_lru(KP p, int l, char* lds, int item) {
    const int c = TIDX(), b = item >> 7, tt = item & 127, t0 = tt * 32, rowbase = b * SEQ;
    const int h = c >> 6, lane = c & 63, r = lane & 31, hh = lane >> 5;
    const bf16_t* P = (const bf16_t*)(p->ws + A_P);
    constexpr int URS2 = 528;
    char* uA = lds;
    float ureg[32];
    {
        const float cb0 = p->in[I_CONVB][(l * 4 + 0) * 256 + c], cb1 = p->in[I_CONVB][(l * 4 + 1) * 256 + c], cb2 = p->in[I_CONVB][(l * 4 + 2) * 256 + c], cb3 = p->in[I_CONVB][(l * 4 + 3) * 256 + c];
        const float bias = p->in[I_CONVBB][l * 256 + c];
        float xm3 = 0.f, xm2 = 0.f, xm1 = 0.f;
        if (t0 >= 3) { const bf16_t* a = P + (size_t)(rowbase + t0 - 3) * PIN + 512 + c; xm3 = bf2f(a[0]); xm2 = bf2f(a[PIN]); xm1 = bf2f(a[2 * PIN]); }
        bf16_t xr[32];
#pragma unroll
        for (int j = 0; j < 32; ++j) xr[j] = P[(size_t)(rowbase + t0 + j) * PIN + 512 + c];
#pragma unroll
        for (int j = 0; j < 32; ++j) {
            const float x0 = bf2f(xr[j]);
            ureg[j] = cb0 * xm3 + cb1 * xm2 + cb2 * xm1 + cb3 * x0 + bias;
            *(bf16_t*)(uA + j * URS2 + c * 2) = f2bf(ureg[j]);
            xm3 = xm2; xm2 = xm1; xm1 = x0;
        }
    }
    __syncthreads();
    float ar[32], ai[32];
    {
        const bf16_t* wg = (const bf16_t*)(p->ws + OFF_WGT) + (size_t)((l * 4 + h) * 2) * 4096 + (size_t)r * 64 + 8 * hh;
        f32x16 aR0, aR1, aI0, aI1;
#pragma unroll
        for (int i = 0; i < 16; ++i) { aR0[i] = 0.f; aR1[i] = 0.f; aI0[i] = 0.f; aI1[i] = 0.f; }
#pragma unroll
        for (int ks = 0; ks < 4; ++ks) {
            const bf16x8 af = *(const bf16x8*)(uA + r * URS2 + (h * 64 + ks * 16 + 8 * hh) * 2);
            const bf16x8 r0 = *(const bf16x8*)(wg + ks * 16), r1 = *(const bf16x8*)(wg + 32 * 64 + ks * 16);
            const bf16x8 i0 = *(const bf16x8*)(wg + 4096 + ks * 16), i1 = *(const bf16x8*)(wg + 4096 + 32 * 64 + ks * 16);
            aR0 = MFMA32(af, r0, aR0); aR1 = MFMA32(af, r1, aR1); aI0 = MFMA32(af, i0, aI0); aI1 = MFMA32(af, i1, aI1);
        }
        __syncthreads();
        float* xch = (float*)(lds + 17408) + h * 2048;
#define XCHG(X0, X1, OUT) do { _Pragma("unroll") for (int i = 0; i < 16; ++i) { const int t_ = (i & 3) + 8 * (i >> 2) + 4 * hh; xch[t_ * 64 + r] = X0[i]; xch[t_ * 64 + 32 + r] = X1[i]; } \
        _Pragma("unroll") for (int t_ = 0; t_ < 32; ++t_) OUT[t_] = xch[t_ * 64 + lane]; } while (0)
        XCHG(aR0, aR1, ar); XCHG(aI0, aI1, ai);
#undef XCHG
    }
    const float brg = p->in[I_BRG][l * 256 + c], big = p->in[I_BIG][l * 256 + c];
    const float sp = softplus_acc(-p->in[I_LAMBDA][l * 256 + c]);
    unsigned* hp = (unsigned*)(p->ws + A_HLOC) + (size_t)(rowbase + t0) * 256 + c;
    float hs = 0.f, cA = 1.f;
#pragma unroll
    for (int j = 0; j < 32; ++j) {
        const float rg = sigm(ar[j] + brg), ig = sigm(ai[j] + big);
        const float log_a = -8.0f * rg * sp;
        const float a = __expf(log_a);
        const float mult = sqrtf(fmaxf(1.f - a * a, 0.f));
        const float bx = mult * (ig * ureg[j]);
        hs = fmaf(a, hs, bx); cA *= a;
        hp[j * 256] = pack2(hs, cA);
    }
    ((float*)(p->ws + A_CARRYA))[(size_t)(b * 128 + tt) * 256 + c] = cA;
    ((float*)(p->ws + A_CARRYH))[(size_t)(b * 128 + tt) * 256 + c] = hs;
    __syncthreads();
}

DEVINL void b1_rwkv(KP p, int l, char* lds, int item) {
    const int c = TIDX(), b = item >> 7, tt = item & 127, t0 = tt * 32, rowbase = b * SEQ;
    const bf16_t* P = (const bf16_t*)(p->ws + A_P);
    constexpr int FRS = 272;
    char* featA = lds;
    const float* muc = p->in[I_MUC] + l * 896;
    if (c < 128) {
        const int col = 1024 + 768 + c; const float mu = muc[768 + c];
        float prev;
        { const float x = bf2f(P[(size_t)(rowbase + (t0 > 0 ? t0 - 1 : 0)) * PIN + col]); prev = (t0 > 0) ? x : 0.f; }
#pragma unroll 1
        for (int jb = 0; jb < 2; ++jb) {
            bf16_t raw[16];
#pragma unroll
            for (int u = 0; u < 16; ++u) raw[u] = P[(size_t)(rowbase + t0 + jb * 16 + u) * PIN + col];
#pragma unroll
            for (int u = 0; u < 16; ++u) {
                const float cur = bf2f(raw[u]);
                const float xs = cur + (prev - cur) * mu;
                const float val = (c < 32) ? tanh_fast(xs) : ((c < 64) ? xs : sigm(xs));
                *(bf16_t*)(featA + (jb * 16 + u) * FRS + c * 2) = f2bf(val); prev = cur;
            }
        }
    }
    __syncthreads();
    float dec[32], aa[32];
    {
        const int lane = c & 63, h = c >> 6, r = lane & 31, hh = lane >> 5;
        const bf16_t* wl = (const bf16_t*)(p->ws + OFF_WLT) + (size_t)(l * 256 + h * 64 + r) * 128 + 8 * hh;
        f32x16 aW0, aW1, aA0, aA1, aG0, aG1;
#pragma unroll
        for (int i = 0; i < 16; ++i) { aW0[i] = 0.f; aW1[i] = 0.f; aA0[i] = 0.f; aA1[i] = 0.f; aG0[i] = 0.f; aG1[i] = 0.f; }
        bf16x8 b0[8], b1[8];
#pragma unroll
        for (int ks = 0; ks < 8; ++ks) { b0[ks] = *(const bf16x8*)(wl + ks * 16); b1[ks] = *(const bf16x8*)(wl + 32 * 128 + ks * 16); }
#pragma unroll
        for (int ks = 0; ks < 8; ++ks) {
            const bf16x8 af = *(const bf16x8*)(featA + r * FRS + (ks * 16 + 8 * hh) * 2);
            if (ks < 2) { aW0 = MFMA32(af, b0[ks], aW0); aW1 = MFMA32(af, b1[ks], aW1); }
            else if (ks < 4) { aA0 = MFMA32(af, b0[ks], aA0); aA1 = MFMA32(af, b1[ks], aA1); }
            else { aG0 = MFMA32(af, b0[ks], aG0); aG1 = MFMA32(af, b1[ks], aG1); }
        }
        __syncthreads();
        float* xch = (float*)(lds + 9216) + h * 2048;
        float lwv[32], lav[32], lgv[32];
#define XCHG(X0, X1, OUT) do { _Pragma("unroll") for (int i = 0; i < 16; ++i) { const int t_ = (i & 3) + 8 * (i >> 2) + 4 * hh; xch[t_ * 64 + r] = X0[i]; xch[t_ * 64 + 32 + r] = X1[i]; } \
        _Pragma("unroll") for (int t_ = 0; t_ < 32; ++t_) OUT[t_] = xch[t_ * 64 + lane]; } while (0)
        XCHG(aW0, aW1, lwv); XCHG(aA0, aA1, lav); XCHG(aG0, aG1, lgv);
#undef XCHG
#define TOK(X0, X1, t) X0[t]
#define aW0 lwv
#define aA0 lav
#define aG0 lgv
        bf16_t* gbuf = (bf16_t*)(p->ws + A_G);
        const float w0 = p->in[I_W0][l * 256 + c], a0 = p->in[I_A0][l * 256 + c];
#pragma unroll
        for (int j = 0; j < 32; ++j) {
            gbuf[(size_t)(rowbase + t0 + j) * 256 + c] = f2bf(TOK(aG0, aG1, j));
            const float z = w0 + TOK(aW0, aW1, j); const float wlog = -softplusf(-z) - 0.5f; dec[j] = -__expf(wlog);
            aa[j] = sigm(a0 + TOK(aA0, aA1, j));
        }
#undef TOK
#undef aW0
#undef aA0
#undef aG0
    }
    {
        bf16_t* bonus = (bf16_t*)(p->ws + A_BONUS); uint4* scan = (uint4*)(p->ws + A_SCAN);
        const float mur = muc[c], muk = muc[256 + c], muv = muc[512 + c];
        const float kkw = p->in[I_KK][l * 256 + c], kaw = p->in[I_KA][l * 256 + c], rkw = p->in[I_RK][l * 256 + c];
        float pr, pk, pv;
        { const bf16_t* a = P + (size_t)(rowbase + (t0 > 0 ? t0 - 1 : 0)) * PIN + 1024 + c; const float x0 = bf2f(a[0]), x1 = bf2f(a[256]), x2 = bf2f(a[512]);
          pr = (t0 > 0) ? x0 : 0.f; pk = (t0 > 0) ? x1 : 0.f; pv = (t0 > 0) ? x2 : 0.f; }
#pragma unroll
        for (int jb = 0; jb < 2; ++jb) {
            bf16_t rr_[16], rk_[16], rv_[16];
#pragma unroll
            for (int u = 0; u < 16; ++u) { const bf16_t* a = P + (size_t)(rowbase + t0 + jb * 16 + u) * PIN + 1024 + c; rr_[u] = a[0]; rk_[u] = a[256]; rv_[u] = a[512]; }
#pragma unroll
            for (int u = 0; u < 16; ++u) {
                const int j = jb * 16 + u;
                const size_t row = (size_t)(rowbase + t0 + j);
                const float cr = bf2f(rr_[u]), ck = bf2f(rk_[u]), cv = bf2f(rv_[u]);
                const float r = cr + (pr - cr) * mur, k = ck + (pk - ck) * muk, v = cv + (pv - cv) * muv;
                pr = cr; pk = ck; pv = cv;
                const float kk = k * kkw;
                const float ss = wave_sum(kk * kk);
                const float kkn = kk * rsqrtf(ss + 1e-12f);
                const float kf = k * (1.f + (aa[j] - 1.f) * kaw);
                const float bs = wave_sum(r * kf * rkw);
                bonus[row * 256 + c] = f2bf(bs * v);
                uint4 o; o.x = pack2(kkn, kkn * aa[j]); o.y = pack2(kf, r); o.z = pack2(v, 0.f); o.w = __float_as_uint(dec[j]);
                scan[row * 256 + c] = o;
            }
            asm volatile("" ::: "memory");
        }
    }
    __syncthreads();
}

constexpr int S_AL = 0, S_BE = 8192, S_KA = 16384, S_RH = 24576, S_BET = 32768, S_KAT = 40960, S_VT = 49152, S_L2F = 57344  , S_GT = 73728  ;
constexpr int S_L1F = S_BE;
constexpr int S_M1 = S_BE, S_M2 = S_KA;
constexpr int S_APT = S_L2F, S_W2T = S_L2F + 8192;
constexpr int S_RP = S_AL, S_GTR = S_RH;
DEVINL int crow32(int reg, int h) { return (reg & 3) + 8 * (reg >> 2) + 4 * h; }
DEVINL bf16x8 frag64(const char* lds, int slot, int row, int kel) { return *reinterpret_cast<const bf16x8*>(lds + slot + row * 128 + kel * 2); }
DEVINL float dpp_xor1(float x) { return __builtin_bit_cast(float, __builtin_amdgcn_update_dpp(0, __builtin_bit_cast(int, x), 0xB1, 0xf, 0xf, true)); }

DEVINL f32x16 mm64(const char* lds, int slotA, int slotB, int tm, int tn, int r, int hh, f32x16 acc) {
#pragma unroll
    for (int ks = 0; ks < 4; ++ks) acc = MFMA32(frag64(lds, slotA, tm * 32 + r, ks * 16 + 8 * hh), frag64(lds, slotB, tn * 32 + r, ks * 16 + 8 * hh), acc);
    return acc;
}

DEVINL void b1e_unit(KP p, char* lds, int b, int h, int c) {
    const int tid = TIDX(), wv = tid >> 6, lane = tid & 63, r = lane & 31, hh = lane >> 5;
    const uint4* scan = (const uint4*)(p->ws + A_SCAN) + ((size_t)(b * SEQ + c * 64)) * 256 + h * 64;
    float* gtot = (float*)(lds + S_GT); float* gamC = gtot + 256;
    {
        const int j = lane;
        float lw[16]; unsigned px[16], py[16], pz[16];
#pragma unroll
        for (int u = 0; u < 16; ++u) { const uint4 q = scan[(size_t)(wv * 16 + u) * 256 + j]; px[u] = q.x; py[u] = q.y; pz[u] = q.z; lw[u] = __uint_as_float(q.w); }
        float tot = 0.f;
#pragma unroll
        for (int u = 0; u < 16; ++u) tot += lw[u];
        gtot[wv * 64 + j] = tot;
        __syncthreads();
        float off = 0.f, all = 0.f;
#pragma unroll
        for (int g = 0; g < 4; ++g) { const float v = gtot[g * 64 + j]; all += v; off += (g < wv) ? v : 0.f; }
        if (wv == 0) gamC[j] = __expf(all);
        float cum = off;
        unsigned tb[8], tk[8], tv[8];
#pragma unroll
        for (int u = 0; u < 16; ++u) {
            const float kkn = __uint_as_float(px[u] << 16), bb = __uint_as_float(px[u] & 0xFFFF0000u);
            const float kf = __uint_as_float(py[u] << 16), rr = __uint_as_float(py[u] & 0xFFFF0000u);
            const float gp = __expf(cum); cum += lw[u];
            const float g = __expf(cum), en = __expf(-cum);
            const int t = wv * 16 + u;
            const unsigned be = f2bf(bb * en), ka = f2bf(kf * en);
            *(bf16_t*)(lds + S_AL + t * 128 + j * 2) = f2bf(gp * kkn);
            *(bf16_t*)(lds + S_BE + t * 128 + j * 2) = (bf16_t)be;
            *(bf16_t*)(lds + S_KA + t * 128 + j * 2) = (bf16_t)ka;
            *(bf16_t*)(lds + S_RH + t * 128 + j * 2) = f2bf(g * rr);
            if (u & 1) { tb[u >> 1] |= be << 16; tk[u >> 1] |= ka << 16; tv[u >> 1] |= (pz[u] << 16); }
            else { tb[u >> 1] = be; tk[u >> 1] = ka; tv[u >> 1] = pz[u] & 0xFFFFu; }
        }
        *(uint4*)(lds + S_BET + j * 128 + wv * 32) = make_uint4(tb[0], tb[1], tb[2], tb[3]); *(uint4*)(lds + S_BET + j * 128 + wv * 32 + 16) = make_uint4(tb[4], tb[5], tb[6], tb[7]);
        *(uint4*)(lds + S_KAT + j * 128 + wv * 32) = make_uint4(tk[0], tk[1], tk[2], tk[3]); *(uint4*)(lds + S_KAT + j * 128 + wv * 32 + 16) = make_uint4(tk[4], tk[5], tk[6], tk[7]);
        *(uint4*)(lds + S_VT + j * 128 + wv * 32) = make_uint4(tv[0], tv[1], tv[2], tv[3]); *(uint4*)(lds + S_VT + j * 128 + wv * 32 + 16) = make_uint4(tv[4], tv[5], tv[6], tv[7]);
    }
    __syncthreads();
    const int tm = wv >> 1, tn = wv & 1;
    f32x16 aM1, aM2;
    {
        f32x16 aL1, aL2;
#pragma unroll
        for (int i = 0; i < 16; ++i) { aL1[i] = 0.f; aL2[i] = 0.f; aM1[i] = 0.f; aM2[i] = 0.f; }
#pragma unroll
        for (int ks = 0; ks < 4; ++ks) {
            const bf16x8 fa = frag64(lds, S_AL, tm * 32 + r, ks * 16 + 8 * hh), fr = frag64(lds, S_RH, tm * 32 + r, ks * 16 + 8 * hh);
            const bf16x8 fb = frag64(lds, S_BE, tn * 32 + r, ks * 16 + 8 * hh), fk = frag64(lds, S_KA, tn * 32 + r, ks * 16 + 8 * hh);
            aL1 = MFMA32(fa, fb, aL1); aL2 = MFMA32(fa, fk, aL2); aM1 = MFMA32(fr, fb, aM1); aM2 = MFMA32(fr, fk, aM2);
        }
        __syncthreads();
#pragma unroll
        for (int reg = 0; reg < 16; ++reg) {
            const int t = tm * 32 + crow32(reg, hh), sidx = tn * 32 + r;
            const int o = (t * 64 + (sidx & 1) * 32 + (sidx >> 1)) * 4;
            *(float*)(lds + S_L1F + o) = (sidx < t) ? aL1[reg] : 0.f;
            *(float*)(lds + S_L2F + o) = (sidx < t) ? aL2[reg] : 0.f;
            aM1[reg] = (sidx <= t) ? aM1[reg] : 0.f; aM2[reg] = (sidx <= t) ? aM2[reg] : 0.f;
        }
    }
    __syncthreads();
    unsigned outp[32];
    {
        const int col = (wv & 1) * 32 + (lane >> 1), q = lane & 1;
        float xq[32];
#pragma unroll
        for (int k = 0; k < 32; ++k) xq[k] = 0.f;
        const char* l1row = lds + S_L1F + q * 128;
        const char* l2row = lds + S_L2F + q * 128;
        if (wv < 2) {
#pragma unroll
            for (int t = 0; t < 64; ++t) {
                float acc = 0.f;
#pragma unroll
                for (int k4 = 0; k4 * 4 < (t + 1) / 2; ++k4) {
                    const float4 a = *(const float4*)(l1row + t * 256 + k4 * 16);
                    acc = fmaf(a.x, xq[4 * k4 + 0], acc); acc = fmaf(a.y, xq[4 * k4 + 1], acc); acc = fmaf(a.z, xq[4 * k4 + 2], acc); acc = fmaf(a.w, xq[4 * k4 + 3], acc);
                }
                acc += dpp_xor1(acc);
                const float x = bf2f(*(const bf16_t*)(lds + S_AL + t * 128 + col * 2)) - acc;
                xq[t >> 1] = ((t & 1) == q) ? x : xq[t >> 1];
            }
        } else {
            float vq[32];
#pragma unroll
            for (int k8 = 0; k8 < 8; ++k8) {
                const uint4 d = *(const uint4*)(lds + S_VT + col * 128 + k8 * 16);
                vq[4 * k8 + 0] = q ? __uint_as_float(d.x & 0xFFFF0000u) : __uint_as_float(d.x << 16);
                vq[4 * k8 + 1] = q ? __uint_as_float(d.y & 0xFFFF0000u) : __uint_as_float(d.y << 16);
                vq[4 * k8 + 2] = q ? __uint_as_float(d.z & 0xFFFF0000u) : __uint_as_float(d.z << 16);
                vq[4 * k8 + 3] = q ? __uint_as_float(d.w & 0xFFFF0000u) : __uint_as_float(d.w << 16);
            }
#pragma unroll
            for (int t = 0; t < 64; ++t) {
                float acc = 0.f;
#pragma unroll
                for (int k4 = 0; k4 * 4 < (t + 1) / 2; ++k4) {
                    const float4 a = *(const float4*)(l1row + t * 256 + k4 * 16);
                    const float4 bq = *(const float4*)(l2row + t * 256 + k4 * 16);
                    acc = fmaf(bq.x, vq[4 * k4 + 0], acc); acc = fmaf(bq.y, vq[4 * k4 + 1], acc); acc = fmaf(bq.z, vq[4 * k4 + 2], acc); acc = fmaf(bq.w, vq[4 * k4 + 3], acc);
                    acc = fmaf(-a.x, xq[4 * k4 + 0], acc); acc = fmaf(-a.y, xq[4 * k4 + 1], acc); acc = fmaf(-a.z, xq[4 * k4 + 2], acc); acc = fmaf(-a.w, xq[4 * k4 + 3], acc);
                }
                acc += dpp_xor1(acc);
                xq[t >> 1] = ((t & 1) == q) ? acc : xq[t >> 1];
            }
        }
#pragma unroll
        for (int k = 0; k < 32; ++k) { const float o = dpp_xor1(xq[k]); outp[k] = q ? pack2(o, xq[k]) : pack2(xq[k], o); }
    }
    __syncthreads();
    {
        const int col = (wv & 1) * 32 + (lane >> 1), q = lane & 1;
        char* dst = lds + ((wv < 2) ? S_APT : S_W2T) + col * 128 + q * 64;
#pragma unroll
        for (int i = 0; i < 4; ++i) *(uint4*)(dst + i * 16) = q ? make_uint4(outp[16 + 4 * i], outp[17 + 4 * i], outp[18 + 4 * i], outp[19 + 4 * i]) : make_uint4(outp[4 * i], outp[4 * i + 1], outp[4 * i + 2], outp[4 * i + 3]);
#pragma unroll
        for (int reg = 0; reg < 16; ++reg) {
            const int t = tm * 32 + crow32(reg, hh), sidx = tn * 32 + r;
            *(bf16_t*)(lds + S_M1 + t * 128 + sidx * 2) = f2bf(aM1[reg]);
            *(bf16_t*)(lds + S_M2 + t * 128 + sidx * 2) = f2bf(aM2[reg]);
        }
    }
    __syncthreads();
    unsigned char* ubase = p->ws + A_CHAIN + (size_t)((b * 4 + h) * 64 + c) * CHAIN_UNIT;
    f32x16 zero;
#pragma unroll
    for (int i = 0; i < 16; ++i) zero[i] = 0.f;
    f32x16 gt;
    {
        const f32x16 qv = mm64(lds, S_M1, S_APT, tm, tn, r, hh, zero);
        const f32x16 y0 = mm64(lds, S_M2, S_VT, tm, tn, r, hh, zero) - mm64(lds, S_M1, S_W2T, tm, tn, r, hh, zero);
        gt = mm64(lds, S_BET, S_APT, tm, tn, r, hh, zero);
        const f32x16 ht = mm64(lds, S_KAT, S_VT, tm, tn, r, hh, zero) - mm64(lds, S_BET, S_W2T, tm, tn, r, hh, zero);
#pragma unroll
        for (int reg = 0; reg < 16; ++reg) {
            const int t = tm * 32 + crow32(reg, hh), jc = tn * 32 + r;
            const float rh = bf2f(*(const bf16_t*)(lds + S_RH + t * 128 + jc * 2));
            *(bf16_t*)(lds + S_RP + t * 128 + jc * 2) = f2bf(rh - qv[reg]);
            const int jr = tm * 32 + crow32(reg, hh);
            const float gc = gamC[jr];
            gt[reg] = gc * (((jr == jc) ? 1.f : 0.f) - gt[reg]);
        }
        float4* himg = (float4*)(ubase + 16384); float4* yimg = (float4*)(ubase + 32768);
#pragma unroll
        for (int rq = 0; rq < 4; ++rq) {
            float4 hv, yv;
            hv.x = gamC[tm * 32 + crow32(4 * rq + 0, hh)] * ht[4 * rq + 0]; hv.y = gamC[tm * 32 + crow32(4 * rq + 1, hh)] * ht[4 * rq + 1];
            hv.z = gamC[tm * 32 + crow32(4 * rq + 2, hh)] * ht[4 * rq + 2]; hv.w = gamC[tm * 32 + crow32(4 * rq + 3, hh)] * ht[4 * rq + 3];
            yv.x = y0[4 * rq + 0]; yv.y = y0[4 * rq + 1]; yv.z = y0[4 * rq + 2]; yv.w = y0[4 * rq + 3];
            himg[((tn * 2 + tm) * 4 + rq) * 64 + lane] = hv;
            yimg[((tn * 2 + tm) * 4 + rq) * 64 + lane] = yv;
        }
    }
    __syncthreads();
#pragma unroll
    for (int reg = 0; reg < 16; ++reg) {
        const int jr = tm * 32 + crow32(reg, hh), jc = tn * 32 + r;
        *(bf16_t*)(lds + S_GTR + jr * 128 + jc * 2) = f2bf(gt[reg]);
    }
    __syncthreads();
    {
        uint4* gimg = (uint4*)(ubase); uint4* rimg = (uint4*)(ubase + 8192);
#pragma unroll
        for (int ii = 0; ii < 2; ++ii) {
            const int im = wv * 2 + ii, mt = im >> 2, jb = (im >> 1) & 1, s2 = im & 1;
            const int cbase = (32 * jb + 16 * s2 + 4 * hh) * 2;
            const uint2 g0 = *(const uint2*)(lds + S_GTR + (mt * 32 + r) * 128 + cbase), g1 = *(const uint2*)(lds + S_GTR + (mt * 32 + r) * 128 + cbase + 16);
            const uint2 r0 = *(const uint2*)(lds + S_RP + (mt * 32 + r) * 128 + cbase), r1 = *(const uint2*)(lds + S_RP + (mt * 32 + r) * 128 + cbase + 16);
            gimg[im * 64 + lane] = make_uint4(g0.x, g0.y, g1.x, g1.y);
            rimg[im * 64 + lane] = make_uint4(r0.x, r0.y, r1.x, r1.y);
        }
    }
    __syncthreads();
}

DEVINL void phaseB1(KP p, int l, char* lds, const int mask = 15, const int sub = 3) {
    const int nb = NBV();
    if (mask & 1) {
        const int blk = BIDX();
        for (int it = blk; it < 512; it += nb) {
            if (sub & 1) { b1_rwkv(p, l, lds, it * 2); b1_rwkv(p, l, lds, it * 2 + 1); }
            __threadfence_block(); __syncthreads();
            const int b = it >> 6, c = it & 63;
            if (sub & 2) {
#pragma unroll 1
                for (int h = 0; h < 4; ++h) b1e_unit(p, lds, b, h, c);
            }
        }
    }
    if (mask & 2) { const int blk = BIDX(); for (int it = blk; it < 1024; it += nb) b1_lru(p, l, lds, it); }
    if (mask & 4) { const int blk = BIDX(); for (int it = blk; it < 1024; it += nb) b1_conformer(p, l, lds, it); }
    if (mask & 8) { const int blk = BIDX(); for (int it = blk; it < 512; it += nb) b1_shortconv(p, l, it); }
}

DEVINL void phaseB2(KP p, int l, char* lds) {
    const int tid = TIDX(), blk = BIDX();
    if (blk < 64 && tid < 64) {
        const int lane = tid, r = lane & 31, hh = lane >> 5;
        const int bh = blk >> 1, w = blk & 1, b = bh >> 2, h = bh & 3;
        float* yraw = (float*)(p->ws + A_YRAW) + (size_t)b * SEQ * 256 + h * 64 + 32 * w + r;
        f32x16 X0, X1;
#pragma unroll
        for (int i = 0; i < 16; ++i) { X0[i] = 0.f; X1[i] = 0.f; }
        auto issue = [&](int c, char* buf) {
            const unsigned char* ubase = p->ws + A_CHAIN + (size_t)(bh * 64 + c) * CHAIN_UNIT;
#pragma unroll
            for (int i = 0; i < 8; ++i) {
                __builtin_amdgcn_global_load_lds((const unsigned*)(ubase + i * 1024 + lane * 16), (unsigned*)(buf + i * 1024 + lane * 16), 16, 0, 0);
                __builtin_amdgcn_global_load_lds((const unsigned*)(ubase + 8192 + i * 1024 + lane * 16), (unsigned*)(buf + 8192 + i * 1024 + lane * 16), 16, 0, 0);
                __builtin_amdgcn_global_load_lds((const unsigned*)(ubase + 16384 + (w * 8 + i) * 1024 + lane * 16), (unsigned*)(buf + 16384 + i * 1024 + lane * 16), 16, 0, 0);
                __builtin_amdgcn_global_load_lds((const unsigned*)(ubase + 32768 + (w * 8 + i) * 1024 + lane * 16), (unsigned*)(buf + 24576 + i * 1024 + lane * 16), 16, 0, 0);
            }
        };
        issue(0, lds);
        for (int c = 0; c < 64; ++c) {
            char* buf = lds + (c & 1) * 32768;
            if (c + 1 < 64) { issue(c + 1, lds + ((c + 1) & 1) * 32768); asm volatile("s_waitcnt vmcnt(32)" ::: "memory"); }
            else asm volatile("s_waitcnt vmcnt(0)" ::: "memory");
            uint4 gq[8], rq8[8]; float4 hq[8], yq[8];
#pragma unroll
            for (int i = 0; i < 8; ++i) { gq[i] = *(const uint4*)(buf + i * 1024 + lane * 16); rq8[i] = *(const uint4*)(buf + 8192 + i * 1024 + lane * 16); }
#pragma unroll
            for (int i = 0; i < 8; ++i) { hq[i] = *(const float4*)(buf + 16384 + i * 1024 + lane * 16); yq[i] = *(const float4*)(buf + 24576 + i * 1024 + lane * 16); }
            bf16x8 xp[4];
#pragma unroll
            for (int s2 = 0; s2 < 2; ++s2) {
                uint4 a, bq;
                a.x = pack2(X0[8 * s2 + 0], X0[8 * s2 + 1]); a.y = pack2(X0[8 * s2 + 2], X0[8 * s2 + 3]); a.z = pack2(X0[8 * s2 + 4], X0[8 * s2 + 5]); a.w = pack2(X0[8 * s2 + 6], X0[8 * s2 + 7]);
                bq.x = pack2(X1[8 * s2 + 0], X1[8 * s2 + 1]); bq.y = pack2(X1[8 * s2 + 2], X1[8 * s2 + 3]); bq.z = pack2(X1[8 * s2 + 4], X1[8 * s2 + 5]); bq.w = pack2(X1[8 * s2 + 6], X1[8 * s2 + 7]);
                xp[s2] = __builtin_bit_cast(bf16x8, a); xp[2 + s2] = __builtin_bit_cast(bf16x8, bq);
            }
#pragma unroll
            for (int mt = 0; mt < 2; ++mt) {
                f32x16 acc;
#pragma unroll
                for (int i = 0; i < 4; ++i) { acc[4 * i] = yq[mt * 4 + i].x; acc[4 * i + 1] = yq[mt * 4 + i].y; acc[4 * i + 2] = yq[mt * 4 + i].z; acc[4 * i + 3] = yq[mt * 4 + i].w; }
#pragma unroll
                for (int f = 0; f < 4; ++f) acc = MFMA32(__builtin_bit_cast(bf16x8, rq8[mt * 4 + f]), xp[f], acc);
#pragma unroll
                for (int reg = 0; reg < 16; ++reg) yraw[(size_t)(c * 64 + mt * 32 + crow32(reg, hh)) * 256] = acc[reg];
            }
            f32x16 n0, n1;
#pragma unroll
            for (int i = 0; i < 4; ++i) { n0[4 * i] = hq[i].x; n0[4 * i + 1] = hq[i].y; n0[4 * i + 2] = hq[i].z; n0[4 * i + 3] = hq[i].w;
                                          n1[4 * i] = hq[4 + i].x; n1[4 * i + 1] = hq[4 + i].y; n1[4 * i + 2] = hq[4 + i].z; n1[4 * i + 3] = hq[4 + i].w; }
#pragma unroll
            for (int f = 0; f < 4; ++f) { n0 = MFMA32(__builtin_bit_cast(bf16x8, gq[f]), xp[f], n0); n1 = MFMA32(__builtin_bit_cast(bf16x8, gq[4 + f]), xp[f], n1); }
            X0 = n0; X1 = n1;
        }
    }
}

DEVINL void phaseMix(KP p, int l, char* lds, const int which) {
    const int blk = BIDX(), wg = blk >> 1, half = blk & 1;
    if (wg < 32) { if (which == 0) phaseB2(p, l, lds); return; }
    const int w = wg - 32, NW = 224;
    if (which == 0) { for (int pr = w; pr < 512; pr += NW) b1_lru(p, l, lds, pr * 2 + half); }
    else if (which == 1) { for (int pr = (w + 160) % NW; pr < 512; pr += NW) b1_conformer(p, l, lds, pr * 2 + half); }
    else { for (int pr = (w + 96) % NW; pr < 256; pr += NW) b1_shortconv(p, l, pr * 2 + half); }
}

DEVINL void phaseB3(KP p, int l) {
    const int c = TIDX(), nb = NBV(), blk = BIDX();
    const bf16_t* P = (const bf16_t*)(p->ws + A_P);
    bf16_t* ymix = (bf16_t*)(p->ws + A_YMIX);
    const float* yraw = (const float*)(p->ws + A_YRAW); const bf16_t* bonus = (const bf16_t*)(p->ws + A_BONUS); const bf16_t* gbuf = (const bf16_t*)(p->ws + A_G);
    const unsigned* hcbuf = (const unsigned*)(p->ws + A_HLOC);
    const float gng = p->in[I_GNG][l * 256 + c], gnb = p->in[I_GNB][l * 256 + c];
    for (int it = blk; it < 512; it += nb) {
        float hst0, hst1;
        {
            const int bq = (it * 64) >> 12, tt0 = ((it * 64) & 4095) >> 5;
            const float* ca = (const float*)(p->ws + A_CARRYA) + (size_t)bq * 128 * 256 + c;
            const float* ch = (const float*)(p->ws + A_CARRYH) + (size_t)bq * 128 * 256 + c;
            float hs = 0.f;
            const float ca1 = ca[tt0 * 256], ch1 = ch[tt0 * 256];
#pragma unroll 1
            for (int t0 = 0; t0 < tt0; t0 += 32) {
                float av[32], hv[32];
#pragma unroll
                for (int i = 0; i < 32; ++i) { av[i] = ca[(t0 + i) * 256]; hv[i] = ch[(t0 + i) * 256]; }
#pragma unroll
                for (int i = 0; i < 32; ++i) hs = (t0 + i < tt0) ? fmaf(av[i], hs, hv[i]) : hs;
            }
            hst0 = hs; hst1 = fmaf(ca1, hs, ch1);
        }
#pragma unroll 1
        for (int r8 = 0; r8 < 64; r8 += 8) {
            float yv[8]; bf16_t bo[8], gg[8], gbv[8]; unsigned hcv[8]; float hsv[8];
#pragma unroll
            for (int u = 0; u < 8; ++u) {
                const int row = it * 64 + r8 + u, b = row >> 12, tt = (row & 4095) >> 5;
                const size_t o = (size_t)row * 256 + c;
                yv[u] = yraw[o]; bo[u] = bonus[o]; gg[u] = gbuf[o]; hcv[u] = hcbuf[o]; hsv[u] = (r8 < 32) ? hst0 : hst1; (void)b; (void)tt;
                gbv[u] = P[(size_t)row * PIN + 768 + c];
            }
#pragma unroll
            for (int u = 0; u < 8; ++u) {
                const int row = it * 64 + r8 + u;
                const float y = yv[u];
                const float mu = wave_sum(y) * (1.f / 64.f);
                const float d = y - mu;
                const float var = wave_sum(d * d) * (1.f / 64.f);
                const float yn = d * rsqrtf(var + GN_EPS) * gng + gnb;
                ymix[(size_t)row * DM + 512 + c] = f2bf((yn + bf2f(bo[u])) * bf2f(gg[u]));
                const float hh = fmaf(__uint_as_float(hcv[u] & 0xFFFF0000u), hsv[u], __uint_as_float(hcv[u] << 16));
                ymix[(size_t)row * DM + 256 + c] = f2bf(hh * gelu_tanh(bf2f(gbv[u])));
            }
        }
    }
}

DEVINL void phaseD(KP p, int l, char* lds, const int dry = 0) {
    const int tid = TIDX(), nb = NBV(), blk = BIDX(), wid = tid >> 6, lane = tid & 63;
    constexpr int URS = 2064;
    char* uh = lds;
    char* ulo = lds + 16 * URS;
    float* logit = (float*)(lds + 32 * URS);
    int* sel_e = (int*)(lds + 32 * URS + 4096);
    int* lpos = sel_e + 512;
    int* hist = lpos + 512;
    int* basep = hist + 64;
    const bf16_t* wrt_hi = (const bf16_t*)(p->ws + OFF_WR) + (size_t)(l * 2 + 0) * 64 * 1024;
    const bf16_t* wrt_lo = (const bf16_t*)(p->ws + OFF_WR) + (size_t)(l * 2 + 1) * 64 * 1024;
    const bf16_t* zbuf = (const bf16_t*)(p->ws + M_ZB);
    float2* lnstat = (float2*)(p->ws + M_STAT);
    bf16_t* ubuf = (bf16_t*)(p->ws + (dry ? A_YMIX : OFF_UBUF));
    const float* mod = (const float*)(p->ws + OFF_MOD);
    const float* wr = p->in[I_WROUTER] + (size_t)l * 1024 * 64 + lane;
    const float ebias = p->in[I_EBIAS][l * 64 + lane];
    unsigned* cnt = (unsigned*)(p->ws + OFF_CNT) + l * 64 + (dry ? 256 : 0);
    int* list = (int*)(p->ws + (dry ? M_HBUF : M_LIST));
    float* wsel = (float*)(p->ws + (dry ? M_HBUF + 16777216 : M_WSEL));
    int* pmap = (int*)(p->ws + (dry ? M_HBUF + 33554432 : M_PMAP));
    for (int it = blk; it < 512; it += nb) {
        const int tok0 = it * 64;
        if (tid < 64) hist[tid] = 0;
        float4 GA[4], GB[4];
        {
            const int b = tok0 >> 12;
#pragma unroll
            for (int i = 0; i < 4; ++i) {
                const int col = i * 256 + lane * 4;
                const float4 g = *(const float4*)(p->in[I_LN1G] + l * 1024 + col), bb = *(const float4*)(p->in[I_LN1B] + l * 1024 + col);
                const float4 sh = *(const float4*)(mod + (size_t)(l * 8 + b) * 6144 + 3072 + col), sc = *(const float4*)(mod + (size_t)(l * 8 + b) * 6144 + 4096 + col);
                GA[i].x = g.x * (1.f + sc.x); GA[i].y = g.y * (1.f + sc.y); GA[i].z = g.z * (1.f + sc.z); GA[i].w = g.w * (1.f + sc.w);
                GB[i].x = bb.x * (1.f + sc.x) + sh.x; GB[i].y = bb.y * (1.f + sc.y) + sh.y; GB[i].z = bb.z * (1.f + sc.z) + sh.z; GB[i].w = bb.w * (1.f + sc.w) + sh.w;
            }
        }
        uint2 zr[4][4];
#pragma unroll
        for (int j = 0; j < 4; ++j)
#pragma unroll
            for (int i = 0; i < 4; ++i) zr[j][i] = *(const uint2*)(zbuf + (size_t)(tok0 + wid * 4 + j) * DM + i * 256 + lane * 4);
        const int fr = lane & 15, fq = lane >> 4;
        const bf16_t* bh = wrt_hi + (size_t)(wid * 16 + fr) * 1024 + fq * 8;
        const bf16_t* bl = wrt_lo + (size_t)(wid * 16 + fr) * 1024 + fq * 8;
#define D_LDW(H, L, k4) do { _Pragma("unroll") for (int kk = 0; kk < 4; ++kk) { H[kk] = *(const bf16x8*)(bh + ((k4) * 4 + kk) * 32); L[kk] = *(const bf16x8*)(bl + ((k4) * 4 + kk) * 32); } } while (0)
#define D_MM(H, L, k4) do { _Pragma("unroll") for (int kk = 0; kk < 4; ++kk) { const int ko = ((k4) * 4 + kk) * 64 + fq * 16; \
            const bf16x8 ah = *(const bf16x8*)(uh + fr * URS + ko), al = *(const bf16x8*)(ulo + fr * URS + ko); \
            lacc = __builtin_amdgcn_mfma_f32_16x16x32_bf16(ah, H[kk], lacc, 0, 0, 0); lacc = __builtin_amdgcn_mfma_f32_16x16x32_bf16(al, H[kk], lacc, 0, 0, 0); \
            lacc = __builtin_amdgcn_mfma_f32_16x16x32_bf16(ah, L[kk], lacc, 0, 0, 0); } } while (0)
#pragma unroll 1
        for (int sb = 0; sb < 4; ++sb) {
            bf16x8 h0[4], l0[4], h1[4], l1[4];
            D_LDW(h0, l0, 0);
            float mean4[4], rs4[4];
#pragma unroll
            for (int j = 0; j < 4; ++j) {
                const int tl = wid * 4 + j, row = tok0 + sb * 16 + tl;
                float4 z[4];
                float s = 0.f;
#pragma unroll
                for (int i = 0; i < 4; ++i) { const uint2 zv = zr[j][i];
                    z[i].x = __uint_as_float(zv.x << 16); z[i].y = __uint_as_float(zv.x & 0xFFFF0000u); z[i].z = __uint_as_float(zv.y << 16); z[i].w = __uint_as_float(zv.y & 0xFFFF0000u); s += z[i].x + z[i].y + z[i].z + z[i].w; }
                const float mean = wave_sum(s) * (1.f / 1024.f);
                float q = 0.f;
#pragma unroll
                for (int i = 0; i < 4; ++i) { z[i].x -= mean; z[i].y -= mean; z[i].z -= mean; z[i].w -= mean; q += z[i].x * z[i].x + z[i].y * z[i].y + z[i].z * z[i].z + z[i].w * z[i].w; }
                const float rs = rsqrtf(wave_sum(q) * (1.f / 1024.f) + LN_EPS);
                mean4[j] = mean; rs4[j] = rs;
#pragma unroll
                for (int i = 0; i < 4; ++i) {
                    const int col = i * 256 + lane * 4;
                    float4 u; u.x = z[i].x * rs * GA[i].x + GB[i].x; u.y = z[i].y * rs * GA[i].y + GB[i].y; u.z = z[i].z * rs * GA[i].z + GB[i].z; u.w = z[i].w * rs * GA[i].w + GB[i].w;
                    uint2 o; o.x = pack2(u.x, u.y); o.y = pack2(u.z, u.w);
                    { int w8 = __builtin_amdgcn_cvt_pk_fp8_f32(u.x, u.y, 0, false); w8 = __builtin_amdgcn_cvt_pk_fp8_f32(u.z, u.w, w8, true);
                      *(int*)((char*)ubuf + (size_t)row * DM + col) = w8; }
                    *(uint2*)(uh + tl * URS + col * 2) = o;
                    uint2 o2; o2.x = pack2(u.x - __uint_as_float(o.x << 16), u.y - __uint_as_float(o.x & 0xFFFF0000u)); o2.y = pack2(u.z - __uint_as_float(o.y << 16), u.w - __uint_as_float(o.y & 0xFFFF0000u));
                    *(uint2*)(ulo + tl * URS + col * 2) = o2;
                }
            }
            {
                float m = mean4[0], r = rs4[0];
                m = (lane == 1) ? mean4[1] : m; r = (lane == 1) ? rs4[1] : r; m = (lane == 2) ? mean4[2] : m; r = (lane == 2) ? rs4[2] : r; m = (lane == 3) ? mean4[3] : m; r = (lane == 3) ? rs4[3] : r;
                if (lane < 4) lnstat[tok0 + sb * 16 + wid * 4 + lane] = make_float2(m, r);
            }
            __syncthreads();
            {
                f32x4 lacc = (f32x4){0.f, 0.f, 0.f, 0.f};
#pragma unroll
                for (int k4 = 0; k4 < 8; k4 += 2) {
                    D_LDW(h1, l1, k4 + 1);
                    D_MM(h0, l0, k4);
                    if (k4 + 2 < 8) D_LDW(h0, l0, k4 + 2);
                    D_MM(h1, l1, k4 + 1);
                }
                if (sb < 3) {
#pragma unroll
                    for (int j = 0; j < 4; ++j)
#pragma unroll
                        for (int i = 0; i < 4; ++i) zr[j][i] = *(const uint2*)(zbuf + (size_t)(tok0 + (sb + 1) * 16 + wid * 4 + j) * DM + i * 256 + lane * 4);
                }
#pragma unroll
                for (int j = 0; j < 4; ++j) logit[(fq * 4 + j) * 64 + wid * 16 + fr] = lacc[j];
            }
            __syncthreads();
            float acc[4];
#pragma unroll
            for (int j = 0; j < 4; ++j) acc[j] = logit[(wid * 4 + j) * 64 + lane];
#pragma unroll
            for (int j = 0; j < 4; ++j) {
                const int tl = sb * 16 + wid * 4 + j;
                const float score = 1.f / (1.f + __expf(-acc[j]));
                const float biased = score + ebias;
                const float m1 = group8_max(biased);
                const unsigned long long eq = __ballot(biased == m1);
                const int g = lane >> 3;
                const unsigned gm = (unsigned)(eq >> (g * 8)) & 0xFFu;
                const int first = __ffs((int)gm) - 1;
                const float v2 = ((lane & 7) == first) ? -INFINITY : biased;
                const float m2 = group8_max(v2);
                const float gs = m1 + m2;
                int rg = 0;
#pragma unroll
                for (int g2 = 0; g2 < 8; ++g2) { const float o = __builtin_bit_cast(float, __builtin_amdgcn_readlane(__builtin_bit_cast(int, gs), g2 * 8)); rg += ((o > gs) || (o == gs && g2 < g)) ? 1 : 0; }
                const bool keep = rg < 4;
                float mk = keep ? biased : -INFINITY;
                bool sel = false;
#pragma unroll
                for (int r8 = 0; r8 < 8; ++r8) {
                    const float mx = wave_max(mk);
                    const unsigned long long em = __ballot(mk == mx);
                    const int fl = __ffsll((long long)em) - 1;
                    const bool me = (lane == fl);
                    sel = sel || me; mk = me ? -INFINITY : mk;
                }
                const float ssum = wave_sum(sel ? score : 0.f);
                const float wgt = score / ssum * 2.5f;
                const unsigned long long sm = __ballot(sel);
                const int kidx = __popcll(sm & ((1ull << lane) - 1ull));
                if (sel) { wsel[(size_t)(tok0 + tl) * 8 + kidx] = wgt; sel_e[tl * 8 + kidx] = lane; }
            }
            __syncthreads();
        }
#undef D_LDW
#undef D_MM
        for (int i = tid; i < 512; i += VTHREADS) lpos[i] = atomicAdd(&hist[sel_e[i]], 1);
        __syncthreads();
        if (tid < 64) basep[tid] = (int)atomicAdd(&cnt[tid], (unsigned)hist[tid]);
        __syncthreads();
        for (int i = tid; i < 512; i += VTHREADS) { const int e = sel_e[i], pos = basep[e] + lpos[i]; list[(size_t)e * NTOK + pos] = tok0 * 8 + i; pmap[tok0 * 8 + i] = (e << 16) | pos; }
        __syncthreads();
    }
}

DEVINL void phaseA(KP p, int l, char* lds) {
    const int tid = TID512(), c = blockIdx.x, G = gridDim.x;
    const char* ubuf = (const char*)(p->ws + OFF_UBUF);
    const char* Wt = (const char*)(p->ws + OFF_WIN) + (size_t)l * WIN_ROWS * 1024;
    bf16_t* P = (bf16_t*)(p->ws + A_P);
    auto sched = [&](int i, GUnit& u) -> bool {
        const long L = unit_linear(i, c, G); if (L >= 128 * 11) return false;
        const int Li = (int)L, sx = Li >> 9, w = (sx == 2) ? 3 : 4, rem = Li - (sx << 9), pm = rem / w, pn = sx * 4 + (rem - pm * w);
        u.A = ubuf + (size_t)pm * 256 * 1024; u.B = Wt + (size_t)pn * 256 * 1024; u.i0 = pm; u.i1 = pn; u.i2 = 0;
        return true;
    };
    auto epi = [&](f32x4 (&acc)[2][2][4][2], const GUnit& u, int wr, int wc, int fr, int fq) {
        asm volatile("" : "+v"(fr), "+v"(fq));
        const int row0 = u.i0 * 256 + wr * 64 + fr, col0 = u.i1 * 256 + wc * 32 + 8 * fq;
#pragma unroll
        for (int ai = 0; ai < 2; ++ai)
#pragma unroll
            for (int m = 0; m < 4; ++m) {
                bf16_t* rowp = P + (size_t)(row0 + ai * 128 + m * 16) * PIN + col0;
#pragma unroll
                for (int bj = 0; bj < 2; ++bj) {
                    if (col0 + bj * 128 < PIN) {
                        const f32x4 v0 = acc[ai][bj][m][0], v1 = acc[ai][bj][m][1];
                        *(uint4*)(rowp + bj * 128) = make_uint4(pack2(v0[0], v0[1]), pack2(v0[2], v0[3]), pack2(v1[0], v1[1]), pack2(v1[2], v1[3]));
                    }
                }
            }
    };
    gemm256<true, false, true>(lds, 512, 512, sched, epi);
}

DEVINL void phaseC(KP p, int l, char* lds) {
    const int tid = TID512(), c = blockIdx.x, G = gridDim.x;
    const char* ymix = (const char*)(p->ws + A_YMIX);
    const char* Wt = (const char*)(p->ws + OFF_WOUT) + (size_t)l * 1024 * 1024 * 2;
    const float* res32 = p->in[I_X];
    const bf16_t* res16 = (const bf16_t*)p->out;
    bf16_t* zbuf = (bf16_t*)(p->ws + M_ZB);
    const float* mod = (const float*)(p->ws + OFF_MOD);
    auto sched = [&](int i, GUnit& u) -> bool {
        const long L = unit_linear(i, c, G); if (L >= 128 * 4) return false;
        const int pm = (int)L >> 2, pn = (int)L & 3;
        u.A = ymix + (size_t)pm * 256 * 2048; u.B = Wt + (size_t)pn * 256 * 2048; u.i0 = pm; u.i1 = pn; u.i2 = 0;
        return true;
    };
    auto epi = [&](f32x4 (&acc)[2][2][4][2], const GUnit& u, int wr, int wc, int fr, int fq) {
        asm volatile("" : "+v"(fr), "+v"(fq));
        const int row0 = u.i0 * 256 + wr * 64 + fr, col0 = u.i1 * 256 + wc * 32 + 8 * fq;
#pragma unroll
        for (int ai = 0; ai < 2; ++ai)
#pragma unroll
            for (int m = 0; m < 4; ++m) {
                const int row = row0 + ai * 128 + m * 16, b = row >> 12;
#pragma unroll
                for (int bj = 0; bj < 2; ++bj) {
                    const int col = col0 + bj * 128;
                    const float4 ga = *(const float4*)(mod + (size_t)(l * 8 + b) * 6144 + 2048 + col), gb = *(const float4*)(mod + (size_t)(l * 8 + b) * 6144 + 2048 + col + 4);
                    float r[8];
                    if (l == 0) {
                        const float4 ra = *(const float4*)(res32 + (size_t)row * DM + col), rb = *(const float4*)(res32 + (size_t)row * DM + col + 4);
                        r[0] = ra.x; r[1] = ra.y; r[2] = ra.z; r[3] = ra.w; r[4] = rb.x; r[5] = rb.y; r[6] = rb.z; r[7] = rb.w;
                    } else {
                        const uint4 rv = *(const uint4*)(res16 + (size_t)row * DM + col);
                        r[0] = __uint_as_float(rv.x << 16); r[1] = __uint_as_float(rv.x & 0xFFFF0000u); r[2] = __uint_as_float(rv.y << 16); r[3] = __uint_as_float(rv.y & 0xFFFF0000u);
                        r[4] = __uint_as_float(rv.z << 16); r[5] = __uint_as_float(rv.z & 0xFFFF0000u); r[6] = __uint_as_float(rv.w << 16); r[7] = __uint_as_float(rv.w & 0xFFFF0000u);
                    }
                    const f32x4 a0 = acc[ai][bj][m][0], a1 = acc[ai][bj][m][1];
                    const float z0 = ALPHA * r[0] + (1.f + ga.x) * a0[0], z1 = ALPHA * r[1] + (1.f + ga.y) * a0[1], z2 = ALPHA * r[2] + (1.f + ga.z) * a0[2], z3 = ALPHA * r[3] + (1.f + ga.w) * a0[3];
                    const float z4 = ALPHA * r[4] + (1.f + gb.x) * a1[0], z5 = ALPHA * r[5] + (1.f + gb.y) * a1[1], z6 = ALPHA * r[6] + (1.f + gb.z) * a1[2], z7 = ALPHA * r[7] + (1.f + gb.w) * a1[3];
                    *(uint4*)(zbuf + (size_t)row * DM + col) = make_uint4(pack2(z0, z1), pack2(z2, z3), pack2(z4, z5), pack2(z6, z7));
                }
            }
    };
    gemm256<true, false, false>(lds, 1024, 1024, sched, epi);
}

constexpr int DIR_OFF = 131072;
DEVINL void moe_directory(KP p, int l, char* lds) {
    int* pref = (int*)(lds + DIR_OFF);
    int* cntl = (int*)(lds + DIR_OFF + 512);
    unsigned* cnt = (unsigned*)(p->ws + OFF_CNT) + l * 64;
    asm volatile("" : "+s"(cnt));
    if (TID512() == 0) {
        int s = 0;
        int* xpre = (int*)(lds + DIR_OFF + 1024);
        int x = 0;
        for (int e = 0; e < 64; ++e) { const int c = (int)__hip_atomic_load(&cnt[e], __ATOMIC_RELAXED, __HIP_MEMORY_SCOPE_AGENT); cntl[e] = c; pref[e] = s; s += (c + 255) >> 8; xpre[e] = x; x += c; }
        pref[64] = s; cntl[64] = NTOK; pref[65] = s + 128; xpre[64] = x;
    }
    __syncthreads();
    {
        int* m2e = (int*)(lds + DIR_OFF + 2048);
        const int tot = pref[65];
        for (int mg = TID512(); mg < tot; mg += NTHREADS) { int e = 0; while (pref[e + 1] <= mg) ++e; m2e[mg] = e; }
    }
    __syncthreads();
}

DEVINL void phaseE1(KP p, int l, char* lds) {
    const int tid = TID512(), c = blockIdx.x, G = gridDim.x;
    moe_directory(p, l, lds);
    const int* pref = (const int*)(lds + DIR_OFF); const int* cntl = (const int*)(lds + DIR_OFF + 512);
    const char* ubuf = (const char*)(p->ws + OFF_UBUF);
    const int* list = (const int*)(p->ws + M_LIST);
    bf16_t* hbuf = (bf16_t*)(p->ws + M_HBUF);
    const char* W13 = (const char*)(p->ws + OFF_W13) + (size_t)(l * 65) * 512 * 1024;
    const int total = __builtin_amdgcn_readfirstlane(pref[65]) * 2;
    auto sched = [&](int i, GUnit& u) -> bool {
        const long L = unit_linear(i, c, G); if (L >= total) return false;
        const int mg = (int)L >> 1, nt = (int)L & 1;
        const int e = __builtin_amdgcn_readfirstlane(((const int*)(lds + DIR_OFF + 2048))[mg]);
        const int mt = __builtin_amdgcn_readfirstlane(mg - pref[e]), Me = __builtin_amdgcn_readfirstlane(cntl[e]);
        u.A = ubuf; u.B = W13 + ((size_t)e * 512 + nt * 256) * 1024; u.i0 = mg; u.i1 = nt; u.i2 = e;
        int R[2], C[2]; stage_coords512(TID512(), R, C);
#pragma unroll
        for (int h = 0; h < 2; ++h)
#pragma unroll
            for (int i2 = 0; i2 < 2; ++i2) {
                const int idx = mt * 256 + h * 128 + R[i2]; int tok;
                if (e < 64) tok = (idx < Me) ? (list[(size_t)e * NTOK + idx] >> 3) : 0; else tok = idx;
                u.va[h][i2] = (unsigned)(tok * 1024 + C[i2] * 2);
            }
        return true;
    };
    auto epi = [&](f32x4 (&acc)[2][2][4][2], const GUnit& u, int wr, int wc, int fr, int fq) {
        asm volatile("" : "+v"(fr), "+v"(fq));
        const size_t row0 = (size_t)u.i0 * 256 + wr * 64 + fr;
#pragma unroll
        for (int ai = 0; ai < 2; ++ai)
#pragma unroll
            for (int m = 0; m < 4; ++m) {
                bf16_t* rowp = hbuf + (row0 + ai * 128 + m * 16) * 256;
#pragma unroll
                for (int bj = 0; bj < 2; ++bj) {
                    const int hcol = (u.i1 * 8 + bj * 4 + wc) * 16 + 4 * fq;
                    const f32x4 gt = acc[ai][bj][m][0], up = acc[ai][bj][m][1];
                    float hv[4];
#pragma unroll
                    for (int j = 0; j < 4; ++j) hv[j] = gt[j] * sigm(gt[j]) * up[j];
                    uint2 o; o.x = pack2(hv[0], hv[1]); o.y = pack2(hv[2], hv[3]);
                    *(uint2*)(rowp + hcol) = o;
                }
                asm volatile("" ::: "memory");
            }
    };
    gemm256<false, true, true>(lds, 512, 512, sched, epi);
}

DEVINL void phaseE2(KP p, int l, char* lds) {
    const int tid = TID512(), c = blockIdx.x, G = gridDim.x;
    moe_directory(p, l, lds);
    const int* pref = (const int*)(lds + DIR_OFF); const int* cntl = (const int*)(lds + DIR_OFF + 512);
    const int* xpre = (const int*)(lds + DIR_OFF + 1024);
    const char* hbuf = (const char*)(p->ws + M_HBUF);
    unsigned char* ybuf = (unsigned char*)(p->ws + M_YBUF);
    const char* W2 = (const char*)(p->ws + OFF_W2) + (size_t)(l * 65) * 1024 * 256 * 2;
    const int total = __builtin_amdgcn_readfirstlane(pref[65]) * 4;
    auto sched = [&](int i, GUnit& u) -> bool {
        const long L = unit_linear(i, c, G); if (L >= total) return false;
        const int mg = (int)L >> 2, nt = (int)L & 3;
        const int e = __builtin_amdgcn_readfirstlane(((const int*)(lds + DIR_OFF + 2048))[mg]);
        u.A = hbuf + (size_t)mg * 256 * 512; u.B = W2 + ((size_t)e * 1024 + nt * 256) * 512; u.i0 = mg; u.i1 = nt; u.i2 = e;
        return true;
    };
    auto epi = [&](f32x4 (&acc)[2][2][4][2], const GUnit& u, int wr, int wc, int fr, int fq) {
        asm volatile("" : "+v"(fr), "+v"(fq));
        const int e = __builtin_amdgcn_readfirstlane(u.i2), mt = __builtin_amdgcn_readfirstlane(u.i0 - pref[e]), Me = __builtin_amdgcn_readfirstlane(cntl[e]);
        const int yrow0 = __builtin_amdgcn_readfirstlane(xpre[e]) + mt * 256;
        const int col0 = u.i1 * 256 + wc * 32 + 8 * fq, loc0 = wr * 64 + fr;
#pragma unroll
        for (int ai = 0; ai < 2; ++ai)
#pragma unroll
            for (int m = 0; m < 4; ++m) {
                const int loc = loc0 + ai * 128 + m * 16;
                if (mt * 256 + loc < Me) {
                    unsigned char* rowp = ybuf + (size_t)(yrow0 + loc) * 1024 + col0;
#pragma unroll
                    for (int bj = 0; bj < 2; ++bj) {
                        const f32x4 v0 = acc[ai][bj][m][0], v1 = acc[ai][bj][m][1];
                        int w0 = __builtin_amdgcn_cvt_pk_fp8_f32(v0[0], v0[1], 0, false); w0 = __builtin_amdgcn_cvt_pk_fp8_f32(v0[2], v0[3], w0, true);
                        int w1 = __builtin_amdgcn_cvt_pk_fp8_f32(v1[0], v1[1], 0, false); w1 = __builtin_amdgcn_cvt_pk_fp8_f32(v1[2], v1[3], w1, true);
                        *(uint2*)(rowp + bj * 128) = make_uint2((unsigned)w0, (unsigned)w1);
                    }
                }
            }
    };
    gemm256<true, false, false>(lds, 256, 256, sched, epi);
}

DEVINL void phaseF(KP p, int l, const int dry = 0) {
    const int tid = TIDX(), nb = NBV(), blk = BIDX(), wid = tid >> 6, lane = tid & 63;
    const bf16_t* zbuf = (const bf16_t*)(p->ws + M_ZB);
    float* xout = dry ? (float*)(p->ws + M_HBUF) : p->out;
    const unsigned char* ybuf = (const unsigned char*)(p->ws + M_YBUF);
    bf16_t* ubuf = (bf16_t*)(p->ws + OFF_UBUF);
    const float* mod = (const float*)(p->ws + OFF_MOD);
    const int* pmap = (const int*)(p->ws + M_PMAP); const float* wsel = (const float*)(p->ws + M_WSEL);
    const float2* lnstat = (const float2*)(p->ws + M_STAT);
    int xoff;
    {
        const unsigned* cnt = (const unsigned*)(p->ws + OFF_CNT) + l * 64;
        const int c = (int)__hip_atomic_load(&cnt[lane], __ATOMIC_RELAXED, __HIP_MEMORY_SCOPE_AGENT);
        xoff = 0;
#pragma unroll
        for (int j = 0; j < 64; ++j) { const int cj = __builtin_amdgcn_readlane(c, j); xoff += (j < lane) ? cj : 0; }
    }
    int pmn = 0; float wn = 0.f; float2 stn = make_float2(0.f, 0.f);
    {
        const int row = blk * 4 + wid;
        if (row < NTOK) { if (lane < 8) { pmn = pmap[row * 8 + lane]; wn = wsel[row * 8 + lane]; } stn = lnstat[row]; }
    }
    for (int row = blk * 4 + wid; row < NTOK; row += nb * 4) {
        const int b = row >> 12;
        int yr = pmn; const float yw = wn; const float2 st1 = stn;
        {
            const int nrow = row + nb * 4;
            if (nrow < NTOK) { if (lane < 8) { pmn = pmap[nrow * 8 + lane]; wn = wsel[nrow * 8 + lane]; } stn = lnstat[nrow]; }
        }
        { const int e = (yr >> 16) & 63; const int xo = __builtin_amdgcn_ds_bpermute(e << 2, xoff); yr = xo + (yr & 0xFFFF); }
        int yrow[8]; float yww[8];
#pragma unroll
        for (int k = 0; k < 8; ++k) { yrow[k] = __builtin_amdgcn_readlane(yr, k); yww[k] = __builtin_bit_cast(float, __builtin_amdgcn_readlane(__builtin_bit_cast(int, yw), k)); }
        uint2 zvv[4]; int ysh[4]; int yvk[4][8];
#pragma unroll
        for (int i = 0; i < 4; ++i) {
            const int col = i * 256 + lane * 4;
            zvv[i] = *(const uint2*)(zbuf + (size_t)row * DM + col);
            ysh[i] = *(const int*)(ybuf + ((size_t)(262144 + row)) * 1024 + col);
#pragma unroll
            for (int k = 0; k < 8; ++k) yvk[i][k] = *(const int*)(ybuf + (size_t)yrow[k] * 1024 + col);
        }
        float4 z[4]; float s = 0.f;
#pragma unroll
        for (int i = 0; i < 4; ++i) {
            const int col = i * 256 + lane * 4;
            float4 x1;
            { const uint2 zv = zvv[i];
              float4 z1; z1.x = __uint_as_float(zv.x << 16); z1.y = __uint_as_float(zv.x & 0xFFFF0000u); z1.z = __uint_as_float(zv.y << 16); z1.w = __uint_as_float(zv.y & 0xFFFF0000u);
              const float4 g1 = *(const float4*)(p->in[I_LN1G] + l * 1024 + col), b1 = *(const float4*)(p->in[I_LN1B] + l * 1024 + col);
              x1.x = (z1.x - st1.x) * st1.y * g1.x + b1.x; x1.y = (z1.y - st1.x) * st1.y * g1.y + b1.y; x1.z = (z1.z - st1.x) * st1.y * g1.z + b1.z; x1.w = (z1.w - st1.x) * st1.y * g1.w + b1.w; }
            float f0, f1, f2, f3;
            { const int yv = ysh[i];
              const f2_t lo = __builtin_amdgcn_cvt_pk_f32_fp8(yv, false), hi = __builtin_amdgcn_cvt_pk_f32_fp8(yv, true);
              f0 = lo[0]; f1 = lo[1]; f2 = hi[0]; f3 = hi[1]; }
#pragma unroll
            for (int k = 0; k < 8; ++k) {
                const f2_t lo = __builtin_amdgcn_cvt_pk_f32_fp8(yvk[i][k], false), hi = __builtin_amdgcn_cvt_pk_f32_fp8(yvk[i][k], true);
                const float w = yww[k];
                f0 = fmaf(w, lo[0], f0); f1 = fmaf(w, lo[1], f1); f2 = fmaf(w, hi[0], f2); f3 = fmaf(w, hi[1], f3);
            }
            const float4 g2 = *(const float4*)(mod + (size_t)(l * 8 + b) * 6144 + 5120 + col);
            z[i].x = ALPHA * x1.x + (1.f + g2.x) * f0; z[i].y = ALPHA * x1.y + (1.f + g2.y) * f1; z[i].z = ALPHA * x1.z + (1.f + g2.z) * f2; z[i].w = ALPHA * x1.w + (1.f + g2.w) * f3;
            s += z[i].x + z[i].y + z[i].z + z[i].w;
        }
        const float mean = wave_sum(s) * (1.f / 1024.f);
        float q = 0.f;
#pragma unroll
        for (int i = 0; i < 4; ++i) { z[i].x -= mean; z[i].y -= mean; z[i].z -= mean; z[i].w -= mean; q += z[i].x * z[i].x + z[i].y * z[i].y + z[i].z * z[i].z + z[i].w * z[i].w; }
        const float rs = rsqrtf(wave_sum(q) * (1.f / 1024.f) + LN_EPS);
#pragma unroll
        for (int i = 0; i < 4; ++i) {
            const int col = i * 256 + lane * 4;
            const float4 g = *(const float4*)(p->in[I_LN2G] + l * 1024 + col), bb = *(const float4*)(p->in[I_LN2B] + l * 1024 + col);
            float4 x2; x2.x = z[i].x * rs * g.x + bb.x; x2.y = z[i].y * rs * g.y + bb.y; x2.z = z[i].z * rs * g.z + bb.z; x2.w = z[i].w * rs * g.w + bb.w;
            if (l + 1 < DEPTH) { uint2 ox; ox.x = pack2(x2.x, x2.y); ox.y = pack2(x2.z, x2.w); *(uint2*)((bf16_t*)xout + (size_t)row * DM + col) = ox; }
            else *(float4*)(xout + (size_t)row * DM + col) = x2;
            if (l + 1 < DEPTH) {
                const float4 sh = *(const float4*)(mod + (size_t)((l + 1) * 8 + b) * 6144 + col), sc = *(const float4*)(mod + (size_t)((l + 1) * 8 + b) * 6144 + 1024 + col);
                int w8 = __builtin_amdgcn_cvt_pk_fp8_f32(x2.x * (1.f + sc.x) + sh.x, x2.y * (1.f + sc.y) + sh.y, 0, false);
                w8 = __builtin_amdgcn_cvt_pk_fp8_f32(x2.z * (1.f + sc.z) + sh.z, x2.w * (1.f + sc.w) + sh.w, w8, true);
                *(int*)((char*)ubuf + (size_t)row * DM + col) = w8;
            }
        }
    }
}

#define XB_TMO      128
#define XB_XCNT(j)  (256  + 64 * (j))
#define XB_XSUB(j)  (1280 + 64 * (j))
#define XB_XGEN(j)  (2304 + 64 * (j))
#define XB_TOP      3328
#define XB_TOPGEN   3392
#define XCD_BAR_WORDS 3456
#define XB_SPIN_CAP (1u << 20)
DEVINL unsigned xb_ld(unsigned* p)              { return __hip_atomic_load(p, __ATOMIC_RELAXED, __HIP_MEMORY_SCOPE_AGENT); }
DEVINL unsigned xb_add(unsigned* p, unsigned v) { return __hip_atomic_fetch_add(p, v, __ATOMIC_RELAXED, __HIP_MEMORY_SCOPE_AGENT); }
DEVINL unsigned xb_xcc_id() { return (unsigned)__builtin_amdgcn_s_getreg((3 << 11) | 20) & 0xFu; }
#define XB_SPIN(cond, bar) do { unsigned _sp = 0; while (cond) { __builtin_amdgcn_s_sleep(1); \
    if ((++_sp & 255u) == 0u) { if (xb_ld(&(bar)[XB_TMO])) break; if (_sp > XB_SPIN_CAP) { atomicAdd(&(bar)[XB_TMO], 1u); break; } } } } while (0)
struct XcdBarrier { unsigned* bar; unsigned x; volatile LAS unsigned* st; };
DEVINL XcdBarrier xcd_barrier_post(unsigned* bar, volatile LAS unsigned* st) {
    XcdBarrier b; b.bar = bar; b.x = xb_xcc_id(); b.st = st;
    if (TID512() == 0) (void)xb_add(&bar[XB_XCNT(b.x)], 1u);
    return b;
}
DEVINL void xcd_barrier_complete(unsigned* bar, unsigned x, unsigned& nloc, unsigned& nx) {
    const unsigned G = gridDim.x * gridDim.y * gridDim.z;
    unsigned sum, cnt, mine, sp = 0u;
    for (;;) {
        sum = 0u; cnt = 0u; mine = 0u;
#pragma unroll 1
        for (unsigned j = 0; j < 16; ++j) { const unsigned c = xb_ld(&bar[XB_XCNT(j)]); sum += c; cnt += (c > 0u) ? 1u : 0u; mine = (j == x) ? c : mine; }
        if (sum == G) break;
        __builtin_amdgcn_s_sleep(1);
        if ((++sp & 255u) == 0u) { if (xb_ld(&bar[XB_TMO])) break; if (sp > XB_SPIN_CAP) { atomicAdd(&bar[XB_TMO], 1u); break; } }
    }
    nloc = mine > 0u ? mine : 1u; nx = cnt > 0u ? cnt : 1u;
}
DEVINL void xcd_barrier(const XcdBarrier& b) {
    asm volatile("s_waitcnt vmcnt(0)" ::: "memory");
    __syncthreads();
    if (TID512() == 0) {
        unsigned* bar = b.bar;
        __builtin_amdgcn_s_waitcnt(0);
        unsigned nloc = b.st[0], nx = b.st[1];
        if (nloc == 0u) { xcd_barrier_complete(bar, b.x, nloc, nx); b.st[0] = nloc; b.st[1] = nx; }
        const unsigned old = xb_add(&bar[XB_XSUB(b.x)], 1u);
        const unsigned gen = old / nloc;
        if (old + 1u == (gen + 1u) * nloc) {
            __builtin_amdgcn_fence(__ATOMIC_RELEASE, "agent");
            asm volatile("s_waitcnt vmcnt(0)" ::: "memory");
            const unsigned og = xb_add(&bar[XB_TOP], 1u);
            const unsigned tg = og / nx;
            if (og + 1u == (tg + 1u) * nx) xb_add(&bar[XB_TOPGEN], 1u);
            else XB_SPIN(xb_ld(&bar[XB_TOPGEN]) == tg, bar);
            __builtin_amdgcn_fence(__ATOMIC_ACQUIRE, "agent");
            xb_add(&bar[XB_XGEN(b.x)], 1u);
            asm volatile("s_waitcnt vmcnt(0)" ::: "memory");
        } else {
            XB_SPIN(xb_ld(&bar[XB_XGEN(b.x)]) == gen, bar);
            __builtin_amdgcn_fence(__ATOMIC_ACQUIRE, "agent");
            asm volatile("s_waitcnt vmcnt(0)" ::: "memory");
        }
    }
    __syncthreads();
}

constexpr int PPL = 11;
constexpr int NPHASE = 2 + PPL * DEPTH;
#ifndef PROBE_SUB
#define PROBE_SUB 3
#endif
#ifndef PROBE_REP
#define PROBE_REP (-1)
#endif
__global__ void __launch_bounds__(NTHREADS, 2) mega(Params p_arg, int ph_lo, int ph_hi) {
    extern __shared__ __attribute__((aligned(16))) char lds[];
    cg::grid_group grid = cg::this_grid();
    volatile LAS unsigned* st = (volatile LAS unsigned*)(lds + LDS_BYTES - 16);
    if (threadIdx.x == 0) { st[0] = 0u; st[1] = 0u; }
    if ((threadIdx.x & 63) == 0) ((volatile LAS int*)(lds + WTAB_OFF))[(unsigned)__builtin_amdgcn_s_getreg((5 << 11) | 4) & 63u] = (int)(threadIdx.x >> 6);
    __syncthreads();
    XcdBarrier xb = xcd_barrier_post((unsigned*)(p_arg.ws + OFF_BAR), st);
    for (int ph = ph_lo; ph < ph_hi; ++ph) {
        KP p = (KP)__builtin_amdgcn_kernarg_segment_ptr();
        asm volatile("" : "+s"(p));
        const int l = (ph >= 2) ? (ph - 2) / PPL : 0;
        const int q = (ph >= 2) ? (ph - 2) % PPL : -1;
        const bool nobar = (q == 2 || q == 3);
        const int nrep = (PROBE_REP >= 0 && ph == PROBE_REP) ? 2 : 1;
        for (int rep = 0; rep < nrep; ++rep) {
            const int dry = (PROBE_REP >= 0 && ph == PROBE_REP && rep == 0) ? 1 : 0;
            char* ldsh = lds + (wave_index() >> 2) * LDS_HALF;
            if (ph == 0) phase0(p, ldsh);
            else if (ph == 1) phaseF0(p);
            else {
                switch (q) {
                    case 0: phaseA(p, l, lds); break;
                    case 1: phaseB1(p, l, ldsh, 1, (PROBE_REP >= 0 && ph == PROBE_REP && rep == 1) ? PROBE_SUB : 3); break;
                    case 2: phaseMix(p, l, ldsh, 0); break;
                    case 3: phaseMix(p, l, ldsh, 1); break;
                    case 4: phaseMix(p, l, ldsh, 2); break;
                    case 5: phaseB3(p, l); break;
                    case 6: phaseC(p, l, lds); break;
                    case 7: phaseD(p, l, ldsh, dry); break;
                    case 8: phaseE1(p, l, lds); break;
                    case 9: phaseE2(p, l, lds); break;
                    default: phaseF(p, l, dry); break;
                }
            }
            const bool lastrep = (rep + 1 == nrep);
            if (!lastrep || (ph + 1 < ph_hi && !nobar)) { if (lastrep && ph == ph_lo) grid.sync(); else xcd_barrier(xb); }
        }
    }
}

extern "C" void kernel_launch(void* const* d_in, const int* in_sizes, int n_in, void* d_out, int out_size, void* d_ws, size_t ws_size, hipStream_t stream) {
    static int grid_blocks = 0;
    if (grid_blocks == 0) {
        if (n_in != 39 || out_size != NTOK * DM || ws_size < WS_NEED) { fprintf(stderr, "kernel_launch: unexpected shapes (n_in %d out %d ws %zu need %zu)\n", n_in, out_size, ws_size, (size_t)WS_NEED); grid_blocks = -1; return; }
        int dev = 0, cus = 0, per_cu = 0;
        hipGetDevice(&dev);
        hipDeviceGetAttribute(&cus, hipDeviceAttributeMultiprocessorCount, dev);
        hipFuncSetAttribute((const void*)mega, hipFuncAttributeMaxDynamicSharedMemorySize, LDS_BYTES);
        hipOccupancyMaxActiveBlocksPerMultiprocessor(&per_cu, (const void*)mega, NTHREADS, LDS_BYTES);
        if (per_cu < 1) { fprintf(stderr, "kernel_launch: occupancy query returned %d\n", per_cu); grid_blocks = -1; return; }
        if (cus < 256) { fprintf(stderr, "kernel_launch: this build needs 256 CUs (found %d)\n", cus); grid_blocks = -1; return; }
        grid_blocks = 256;
    }
    if (grid_blocks < 0) return;
    if (hipMemsetAsync(d_ws, 0, 32768, stream) != hipSuccess) { fprintf(stderr, "kernel_launch: memset failed\n"); return; }
    Params p{};
    for (int i = 0; i < 39; ++i) p.in[i] = (const float*)d_in[i];
    p.out = (float*)d_out; p.ws = (unsigned char*)d_ws;
#ifdef PROBE_PREFIX
    { int lo = 0, hi = PROBE_PREFIX; void* a2[] = {&p, &lo, &hi};
      hipLaunchCooperativeKernel((const void*)mega, dim3(grid_blocks), dim3(NTHREADS), a2, LDS_BYTES, stream);
      hipMemsetAsync(d_ws, 0, 32768, stream); }
#endif
    int ph_lo = 0, ph_hi = NPHASE;
    void* args[] = {&p, &ph_lo, &ph_hi};
    hipError_t e = hipLaunchCooperativeKernel((const void*)mega, dim3(grid_blocks), dim3(NTHREADS), args, LDS_BYTES, stream);
    if (e != hipSuccess) fprintf(stderr, "cooperative launch failed: %s (grid %d)\n", hipGetErrorString(e), grid_blocks);
}
```

```cpp
#include <utility>
#include <hip/hip_runtime.h>
#include <hip/hip_cooperative_groups.h>
#include <stdio.h>
#include <stdint.h>
namespace cg = cooperative_groups;

typedef unsigned short bf16_t;
typedef short bf16x8 __attribute__((ext_vector_type(8)));
typedef float f32x4 __attribute__((ext_vector_type(4)));
#define DEVINL __device__ __forceinline__
#define LAS __attribute__((address_space(3)))
#define MFMA32(a, b, c) __builtin_amdgcn_mfma_f32_32x32x16_bf16((a), (b), (c), 0, 0, 0)

constexpr int NTOK = 32768, SEQ = 4096, NBATCH = 8, DM = 1024, PIN = 2688, DEPTH = 2;
constexpr int NEXP = 64;
constexpr float ALPHA = 1.41421356237f;
constexpr float LN_EPS = 1e-5f, GN_EPS = 64e-5f;
constexpr int NTHREADS = 512;
constexpr int VTHREADS = 256;
constexpr int LDS_HALF = 75776;
constexpr int LDS_BYTES = 159744;

constexpr size_t OFF_CNT   = 0;
constexpr size_t OFF_BAR   = 4096;
constexpr size_t OFF_MOD   = 65536;
constexpr size_t OFF_WR    = 524288;
constexpr size_t OFF_WIN   = 1048576;
constexpr int WIN_ROWS = 2816;
constexpr size_t OFF_WOUT  = OFF_WIN + 2 * (size_t)WIN_ROWS * 1024 * 2;
constexpr size_t OFF_W13   = OFF_WOUT + 4194304;
constexpr size_t OFF_W2    = OFF_W13 + 136314880;
constexpr size_t OFF_UBUF  = OFF_W2 + 68157440;
constexpr size_t OFF_ARENA = OFF_UBUF + 67108864;
constexpr size_t A_P      = OFF_ARENA;
constexpr size_t A_YMIX   = A_P + 176160768;
constexpr size_t A_SCAN   = A_YMIX + 67108864;
constexpr size_t A_HLOC   = A_SCAN + 134217728;
constexpr size_t A_CUMA   = A_HLOC + 33554432;
constexpr size_t A_G      = A_CUMA + 33554432;
constexpr size_t A_BONUS  = A_G + 33554432;
constexpr size_t A_YRAW   = A_BONUS + 33554432;
constexpr size_t A_CARRYA = A_YRAW + 33554432;
constexpr size_t A_CARRYH = A_CARRYA + 1048576;
constexpr size_t A_HSTART = A_CARRYH + 1048576;
constexpr size_t A_CHAIN  = A_HSTART + 1048576;
constexpr size_t CHAIN_UNIT = 49152;
constexpr size_t M_YBUF   = OFF_ARENA;
constexpr size_t M_ZB     = OFF_ARENA + 335544320;
constexpr size_t M_HBUF   = M_YBUF + 603979776;
constexpr size_t M_LIST   = M_HBUF + 159383552;
constexpr size_t M_WSEL   = M_LIST + 8388608;
constexpr size_t M_PMAP   = M_WSEL + 1048576;
constexpr size_t M_STAT   = M_PMAP + 1048576;
constexpr size_t OFF_WLT  = M_STAT + 262144;
constexpr size_t OFF_WGT  = OFF_WLT + 131072;
constexpr size_t WS_NEED  = OFF_WGT + 131072;
static_assert(WS_NEED <= (size_t)1 << 30, "workspace layout exceeds the guaranteed 1 GiB");

struct Params {
    const float* in[39];
    float* out;
    unsigned char* ws;
};
typedef const __attribute__((address_space(4))) Params* KP;
constexpr int WTAB_OFF = 159744 - 16 - 256;
__device__ __forceinline__ int wave_index() {
    extern __shared__ __attribute__((aligned(16))) char lds_tab[];
    unsigned hw; asm volatile("s_getreg_b32 %0, hwreg(HW_REG_HW_ID, 0, 6)" : "=s"(hw));
    const int w = ((const volatile LAS int*)(lds_tab + WTAB_OFF))[hw & 63u];
    return __builtin_amdgcn_readfirstlane(w);
}
__device__ __forceinline__ int lane_index() { int l; asm volatile("v_mbcnt_lo_u32_b32 %0, -1, 0\n\tv_mbcnt_hi_u32_b32 %0, -1, %0" : "=v"(l)); return l; }
__device__ __forceinline__ int TID512() { int t = (wave_index() << 6) | lane_index(); asm volatile("" : "+v"(t)); __builtin_assume(t >= 0 && t < 512); return t; }
__device__ __forceinline__ int TIDX() { int t = ((wave_index() & 3) << 6) | lane_index(); asm volatile("" : "+v"(t)); __builtin_assume(t >= 0 && t < 256); return t; }
__device__ __forceinline__ int BIDX() { int b = blockIdx.x * 2 + (wave_index() >> 2); asm volatile("" : "+s"(b)); __builtin_assume(b >= 0 && b < 65536); return b; }
__device__ __forceinline__ int NBV() { return gridDim.x * 2; }
enum { I_X = 0, I_C, I_WMOD, I_BMOD, I_WIN, I_WOUT, I_CONVA, I_CONVAB, I_LNAG, I_LNAB, I_CONVB, I_CONVBB, I_WRG, I_BRG, I_WIG, I_BIG,
       I_LAMBDA, I_MUC, I_W0, I_WW2, I_A0, I_WA2, I_WG2, I_KK, I_KA, I_RK, I_GNG, I_GNB, I_CONVD, I_LN1G, I_LN1B, I_WROUTER, I_EBIAS,
       I_W13, I_W2, I_WS13, I_WS2, I_LN2G, I_LN2B };

DEVINL bf16_t f2bf(float f) { unsigned u = __float_as_uint(f); u += 0x7FFFu + ((u >> 16) & 1u); return (bf16_t)(u >> 16); }
DEVINL float bf2f(bf16_t h) { return __uint_as_float(((unsigned)h) << 16); }
typedef __bf16 bf2_t __attribute__((ext_vector_type(2)));
typedef float f2_t __attribute__((ext_vector_type(2)));
typedef float f32x16 __attribute__((ext_vector_type(16)));
DEVINL unsigned pack2(float a, float b) { f2_t v = {a, b}; return __builtin_bit_cast(unsigned, __builtin_convertvector(v, bf2_t)); }
DEVINL float sigm(float x) { return __builtin_amdgcn_rcpf(1.f + __expf(-x)); }
DEVINL float tanh_fast(float x) { const float e = __expf(2.f * x); return 1.f - 2.f * __builtin_amdgcn_rcpf(1.f + e); }
DEVINL float softplusf(float z) { return fmaxf(z, 0.f) + __logf(1.f + __expf(-fabsf(z))); }
DEVINL float log1p_s(float y) { return (y < 0.03125f) ? y * (1.f - y * (0.5f - y * (0.33333334f - 0.25f * y))) : __logf(1.f + y); }
DEVINL float softplus_acc(float z) { return fmaxf(z, 0.f) + log1p_s(__expf(-fabsf(z))); }
DEVINL float gelu_tanh(float x) { float u = 0.7978845608028654f * (x + 0.044715f * x * x * x); return 0.5f * x * (1.f + tanh_fast(u)); }
DEVINL float group8_max(float x) {
    x = fmaxf(x, __builtin_bit_cast(float, __builtin_amdgcn_update_dpp(0, __builtin_bit_cast(int, x), 0xB1, 0xf, 0xf, true)));
    x = fmaxf(x, __builtin_bit_cast(float, __builtin_amdgcn_update_dpp(0, __builtin_bit_cast(int, x), 0x4E, 0xf, 0xf, true)));
    x = fmaxf(x, __builtin_bit_cast(float, __builtin_amdgcn_update_dpp(0, __builtin_bit_cast(int, x), 0x141, 0xf, 0xf, true)));
    return x;
}
DEVINL float wave_max(float x) {
#define WM_STEP(ctrl, rmask) x = fmaxf(x, __builtin_bit_cast(float, __builtin_amdgcn_update_dpp(__builtin_bit_cast(int, x), __builtin_bit_cast(int, x), ctrl, rmask, 0xf, false)))
    WM_STEP(0xB1, 0xf); WM_STEP(0x4E, 0xf); WM_STEP(0x141, 0xf); WM_STEP(0x140, 0xf); WM_STEP(0x142, 0xa); WM_STEP(0x143, 0xc);
#undef WM_STEP
    return __builtin_bit_cast(float, __builtin_amdgcn_readlane(__builtin_bit_cast(int, x), 63));
}
DEVINL float wave_sum_dpp(float x);
DEVINL float wave_sum(float x) { return wave_sum_dpp(x); }
DEVINL float wave_sum_dpp(float x) {
    x += __builtin_bit_cast(float, __builtin_amdgcn_update_dpp(0, __builtin_bit_cast(int, x), 0xB1, 0xf, 0xf, true));
    x += __builtin_bit_cast(float, __builtin_amdgcn_update_dpp(0, __builtin_bit_cast(int, x), 0x4E, 0xf, 0xf, true));
    x += __builtin_bit_cast(float, __builtin_amdgcn_update_dpp(0, __builtin_bit_cast(int, x), 0x141, 0xf, 0xf, true));
    x += __builtin_bit_cast(float, __builtin_amdgcn_update_dpp(0, __builtin_bit_cast(int, x), 0x140, 0xf, 0xf, true));
    x += __builtin_bit_cast(float, __builtin_amdgcn_update_dpp(0, __builtin_bit_cast(int, x), 0x142, 0xa, 0xf, false));
    x += __builtin_bit_cast(float, __builtin_amdgcn_update_dpp(0, __builtin_bit_cast(int, x), 0x143, 0xc, 0xf, false));
    return __builtin_bit_cast(float, __builtin_amdgcn_readlane(__builtin_bit_cast(int, x), 63));
}

DEVINL int lds_byte(int r, int c) { int st = (r >> 4) * 2 + (c >> 5), rr = r & 15, cc = c & 31, ob = rr * 64 + cc * 2; return st * 1024 + (ob ^ (((ob >> 9) & 1) << 5)); }
DEVINL void stage_rc(int b, int& R, int& C) { int st = b / 1024, sb = b % 1024, swz = sb ^ (((sb >> 9) & 1) << 5); R = (st >> 1) * 16 + swz / 64; C = (st & 1) * 32 + (swz % 64) / 2; }

template <class RowPtr, class Epi>
DEVINL void gemm_tile128(char* lds, RowPtr arow, const bf16_t* Bt, int K, Epi epi) {
    const int tid = TIDX();
    const bf16_t* ap[4]; const bf16_t* bp[4];
#pragma unroll
    for (int i = 0; i < 4; ++i) { int R, C; stage_rc(tid * 16 + i * 4096, R, C); ap[i] = arow(R) + C; bp[i] = Bt + (size_t)R * K + C; }
    const int wid = tid >> 6, lane = tid & 63, wr = wid >> 1, wc = wid & 1, fr = lane & 15, fq = lane >> 4;
    f32x4 acc[4][4];
#pragma unroll
    for (int m = 0; m < 4; ++m)
#pragma unroll
        for (int n = 0; n < 4; ++n) acc[m][n] = (f32x4){0.f, 0.f, 0.f, 0.f};
    const int nk = K >> 6;
#pragma unroll
    for (int i = 0; i < 4; ++i) {
        __builtin_amdgcn_global_load_lds((const unsigned*)(ap[i]), (unsigned*)(lds + tid * 16 + i * 4096), 16, 0, 0);
        __builtin_amdgcn_global_load_lds((const unsigned*)(bp[i]), (unsigned*)(lds + 16384 + tid * 16 + i * 4096), 16, 0, 0);
    }
    for (int kt = 0; kt < nk; ++kt) {
        asm volatile("s_waitcnt vmcnt(0)" ::: "memory");
        __syncthreads();
        char* cur = lds + (kt & 1) * 32768;
        if (kt + 1 < nk) {
            char* nxt = lds + ((kt + 1) & 1) * 32768;
            const int ko = (kt + 1) * 64;
#pragma unroll
            for (int i = 0; i < 4; ++i) {
                __builtin_amdgcn_global_load_lds((const unsigned*)(ap[i] + ko), (unsigned*)(nxt + tid * 16 + i * 4096), 16, 0, 0);
                __builtin_amdgcn_global_load_lds((const unsigned*)(bp[i] + ko), (unsigned*)(nxt + 16384 + tid * 16 + i * 4096), 16, 0, 0);
            }
        }
        bf16x8 af[4][2], bfr[4][2];
#pragma unroll
        for (int m = 0; m < 4; ++m)
#pragma unroll
            for (int kk = 0; kk < 2; ++kk) af[m][kk] = *reinterpret_cast<const bf16x8*>(cur + lds_byte(wr * 64 + m * 16 + fr, kk * 32 + fq * 8));
#pragma unroll
        for (int n = 0; n < 4; ++n)
#pragma unroll
            for (int kk = 0; kk < 2; ++kk) bfr[n][kk] = *reinterpret_cast<const bf16x8*>(cur + 16384 + lds_byte(wc * 64 + n * 16 + fr, kk * 32 + fq * 8));
#pragma unroll
        for (int kk = 0; kk < 2; ++kk)
#pragma unroll
            for (int m = 0; m < 4; ++m)
#pragma unroll
                for (int n = 0; n < 4; ++n) acc[m][n] = __builtin_amdgcn_mfma_f32_16x16x32_bf16(bfr[n][kk], af[m][kk], acc[m][n], 0, 0, 0);
    }
    __syncthreads();
    epi(acc, wr, wc, fr, fq);
}

template <class Ptrs, class Epi>
DEVINL void gemm_stream128(char* lds, int K, int blk, int nb, int total, Ptrs ptrs, Epi epi) {
    const int qx = nb >> 3, first = (blk & 7) * qx + (blk >> 3), stride = nb;
    if (first >= total) return;
    const int tid = TIDX();
    const int wid = tid >> 6, lane = tid & 63, wr = wid >> 1, wc = wid & 1, fr = lane & 15, fq = lane >> 4;
    const int nk = K >> 6;
    const bf16_t* ap[4]; const bf16_t* bp[4];
    const bf16_t* an[4]; const bf16_t* bn[4];
    int t = first;
    ptrs(t, ap, bp);
#pragma unroll
    for (int i = 0; i < 4; ++i) {
        __builtin_amdgcn_global_load_lds((const unsigned*)(ap[i]), (unsigned*)(lds + tid * 16 + i * 4096), 16, 0, 0);
        __builtin_amdgcn_global_load_lds((const unsigned*)(bp[i]), (unsigned*)(lds + 16384 + tid * 16 + i * 4096), 16, 0, 0);
    }
    for (;;) {
        const int tn = t + stride;
        const bool has_next = tn < total;
        if (has_next) ptrs(tn, an, bn);
        f32x4 acc[4][4];
#pragma unroll
        for (int m = 0; m < 4; ++m)
#pragma unroll
            for (int n = 0; n < 4; ++n) acc[m][n] = (f32x4){0.f, 0.f, 0.f, 0.f};
        for (int kt = 0; kt < nk; ++kt) {
            asm volatile("s_waitcnt vmcnt(0)" ::: "memory");
            __syncthreads();
            char* cur = lds + (kt & 1) * 32768;
            if (kt + 1 < nk) {
                char* nxt = lds + ((kt + 1) & 1) * 32768;
                const int ko = (kt + 1) * 64;
#pragma unroll
                for (int i = 0; i < 4; ++i) {
                    __builtin_amdgcn_global_load_lds((const unsigned*)(ap[i] + ko), (unsigned*)(nxt + tid * 16 + i * 4096), 16, 0, 0);
                    __builtin_amdgcn_global_load_lds((const unsigned*)(bp[i] + ko), (unsigned*)(nxt + 16384 + tid * 16 + i * 4096), 16, 0, 0);
                }
            } else if (has_next) {
#pragma unroll
                for (int i = 0; i < 4; ++i) {
                    __builtin_amdgcn_global_load_lds((const unsigned*)(an[i]), (unsigned*)(lds + tid * 16 + i * 4096), 16, 0, 0);
                    __builtin_amdgcn_global_load_lds((const unsigned*)(bn[i]), (unsigned*)(lds + 16384 + tid * 16 + i * 4096), 16, 0, 0);
                }
            }
            bf16x8 af[4][2], bfr[4][2];
#pragma unroll
            for (int m = 0; m < 4; ++m)
#pragma unroll
                for (int kk = 0; kk < 2; ++kk) af[m][kk] = *reinterpret_cast<const bf16x8*>(cur + lds_byte(wr * 64 + m * 16 + fr, kk * 32 + fq * 8));
#pragma unroll
            for (int n = 0; n < 4; ++n)
#pragma unroll
                for (int kk = 0; kk < 2; ++kk) bfr[n][kk] = *reinterpret_cast<const bf16x8*>(cur + 16384 + lds_byte(wc * 64 + n * 16 + fr, kk * 32 + fq * 8));
#pragma unroll
            for (int kk = 0; kk < 2; ++kk)
#pragma unroll
                for (int m = 0; m < 4; ++m)
#pragma unroll
                    for (int n = 0; n < 4; ++n) acc[m][n] = __builtin_amdgcn_mfma_f32_16x16x32_bf16(bfr[n][kk], af[m][kk], acc[m][n], 0, 0, 0);
        }
        epi(t, acc, wr, wc, fr, fq);
        if (!has_next) break;
        t = tn;
#pragma unroll
        for (int i = 0; i < 4; ++i) { ap[i] = an[i]; bp[i] = bn[i]; }
    }
    __syncthreads();
}
DEVINL void stage_coords(int (&R)[4], int (&C)[4]) {
    const int tid = TIDX();
#pragma unroll
    for (int i = 0; i < 4; ++i) stage_rc(tid * 16 + i * 4096, R[i], C[i]);
}

struct GUnit {
    const char* A;
    const char* B;
    unsigned va[2][2] = {{0u, 0u}, {0u, 0u}};
    int i0, i1, i2;
};
constexpr int G_HTB = 128 * 64 * 2;
constexpr int G_STAGE_BYTES = 8 * G_HTB;
DEVINL int perm32(int rho) { const int n = rho >> 4, i = rho & 15; return 8 * (i >> 2) + 4 * n + (i & 3); }
DEVINL void stage_coords512(int tid, int (&R)[2], int (&C)[2]) {
#pragma unroll
    for (int i = 0; i < 2; ++i) stage_rc(tid * 16 + i * 8192, R[i], C[i]);
}

typedef int v8i_t __attribute__((ext_vector_type(8)));
typedef int v4i_t __attribute__((ext_vector_type(4)));
DEVINL v8i_t cat8(bf16x8 lo, bf16x8 hi) { return __builtin_shufflevector(__builtin_bit_cast(v4i_t, lo), __builtin_bit_cast(v4i_t, hi), 0, 1, 2, 3, 4, 5, 6, 7); }
template <bool PERM, bool GATHER, bool FP8, class Sched, class Epi>
DEVINL void gemm256(char* lds_generic, int K, int lda, Sched sched, Epi epi) {
    LAS unsigned char* lds = (LAS unsigned char*)lds_generic;
    const int tid = TID512(), wid = __builtin_amdgcn_readfirstlane(tid >> 6), lane = tid & 63, wr = wid >> 2, wc = wid & 3, fr = lane & 15, fq = lane >> 4;
    const int nt = K / 64;
    unsigned voffB[2];
#pragma unroll
    for (int i = 0; i < 2; ++i) { int R, C; stage_rc(tid * 16 + i * 8192, R, C); const int Rb = PERM ? ((R & ~31) + perm32(R & 31)) : R; voffB[i] = (unsigned)(Rb * K + C) * 2u; }
    unsigned voffA[2];
#pragma unroll
    for (int i = 0; i < 2; ++i) { int R, C; stage_rc(tid * 16 + i * 8192, R, C); voffA[i] = (unsigned)(R * lda + C) * 2u; }
    const size_t hstepA = GATHER ? 0 : (size_t)128 * lda * 2;
    const size_t kstep = (size_t)(64 * 2);
    const size_t hstepB = (size_t)128 * K * 2;
    const unsigned ldsw = (unsigned)wid * 1024u;
    const int aoff = lds_byte(wr * 64 + fr, fq * 8), boff = lds_byte(wc * 32 + fr, fq * 8);
#define G_SA(b, h) (((b) * 2 + (h)) * G_HTB)
#define G_SB(b, h) ((4 + (b) * 2 + (h)) * G_HTB)
#define G_STAGE(bufoff, gbase, voff) do { _Pragma("unroll") for (int _i = 0; _i < 2; ++_i) { unsigned _vo = (voff)[_i]; asm volatile("" : "+v"(_vo)); \
        __builtin_amdgcn_global_load_lds((const unsigned*)((const char*)(gbase) + _vo), (LAS unsigned*)(lds + (bufoff) + ldsw + _i * 8192), 16, 0, 0); } } while (0)
#define G_STAGE_A(bufoff, ptr, vg, h) do { if constexpr (GATHER) { G_STAGE(bufoff, ptr, vg); } else { G_STAGE(bufoff, (ptr) + (h) * hstepA, voffA); } } while (0)
#define G_LDA(dst, b, h) do { _Pragma("unroll") for (int m = 0; m < 4; ++m) dst[m] = cat8(*(const LAS bf16x8*)(lds + G_SA(b, h) + aoff + m * 2048), *(const LAS bf16x8*)(lds + G_SA(b, h) + aoff + m * 2048 + 1024)); } while (0)
#define G_LDB(dst, b, h) do { _Pragma("unroll") for (int n = 0; n < 2; ++n) dst[n] = cat8(*(const LAS bf16x8*)(lds + G_SB(b, h) + boff + n * 2048), *(const LAS bf16x8*)(lds + G_SB(b, h) + boff + n * 2048 + 1024)); } while (0)
#define G_LO(x) __builtin_bit_cast(bf16x8, __builtin_shufflevector((x), (x), 0, 1, 2, 3))
#define G_HI(x) __builtin_bit_cast(bf16x8, __builtin_shufflevector((x), (x), 4, 5, 6, 7))
#define G_MMA(ai, bj, At, Bt) do { __builtin_amdgcn_s_setprio(1); \
        if constexpr (FP8) { _Pragma("unroll") for (int m = 0; m < 4; ++m) _Pragma("unroll") for (int n = 0; n < 2; ++n) \
            acc[ai][bj][m][n] = __builtin_amdgcn_mfma_scale_f32_16x16x128_f8f6f4(Bt[n], At[m], acc[ai][bj][m][n], 0, 0, 0, 0x7D7D7D7D, 0, 0x7D7D7D7D); } \
        else { _Pragma("unroll") for (int m = 0; m < 4; ++m) _Pragma("unroll") for (int n = 0; n < 2; ++n) { \
            acc[ai][bj][m][n] = __builtin_amdgcn_mfma_f32_16x16x32_bf16(G_LO(Bt[n]), G_LO(At[m]), acc[ai][bj][m][n], 0, 0, 0); \
            acc[ai][bj][m][n] = __builtin_amdgcn_mfma_f32_16x16x32_bf16(G_HI(Bt[n]), G_HI(At[m]), acc[ai][bj][m][n], 0, 0, 0); } } \
        __builtin_amdgcn_s_setprio(0); } while (0)
#define G_WAIT_V(n) asm volatile("s_waitcnt vmcnt(" #n ")" ::: "memory")
#define G_WAIT_L(n) asm volatile("s_waitcnt lgkmcnt(" #n ")" ::: "memory")
#define G_BAR __builtin_amdgcn_s_barrier()
#define G_SCHED __builtin_amdgcn_sched_barrier(0)
    GUnit cur, nxt; int ui = 0;
    if (!sched(0, cur)) return;
    LAS unsigned* vst = (LAS unsigned*)(lds + 131072 + 8192) + tid * 8;
    if constexpr (GATHER) { vst[0] = cur.va[0][0]; vst[1] = cur.va[0][1]; vst[2] = cur.va[1][0]; vst[3] = cur.va[1][1]; }
    f32x4 acc[2][2][4][2];
#pragma unroll
    for (int a = 0; a < 2; ++a)
#pragma unroll
        for (int b = 0; b < 2; ++b)
#pragma unroll
            for (int m = 0; m < 4; ++m)
#pragma unroll
                for (int n = 0; n < 2; ++n) acc[a][b][m][n] = (f32x4){0.f, 0.f, 0.f, 0.f};
    v8i_t At[4], B0[2], B1[2];
    G_STAGE(G_SB(0, 0), cur.B, voffB); G_STAGE_A(G_SA(0, 0), cur.A, cur.va[0], 0); G_STAGE(G_SB(0, 1), cur.B + hstepB, voffB); G_STAGE_A(G_SA(0, 1), cur.A, cur.va[1], 1);
    if (wr == 1) G_BAR;
    G_WAIT_V(4); G_BAR;
    G_STAGE(G_SB(1, 0), cur.B + kstep, voffB); G_STAGE_A(G_SA(1, 0), cur.A + kstep, cur.va[0], 0); G_STAGE(G_SB(1, 1), cur.B + hstepB + kstep, voffB);
    G_WAIT_V(6); G_BAR;
    for (;;) {
        const bool has_next = sched(ui + 1, nxt);
        if (!has_next) nxt = cur;
        if constexpr (GATHER) { LAS unsigned* vn = vst + ((ui + 1) & 1) * 4; vn[0] = nxt.va[0][0]; vn[1] = nxt.va[0][1]; vn[2] = nxt.va[1][0]; vn[3] = nxt.va[1][1]; }
#pragma unroll 1
        for (int t = 0; t < nt; t += 2) {
            const bool last = (t == nt - 2);
            const char* a1 = cur.A + (size_t)(t + 1) * kstep;
            const char* a2 = last ? nxt.A : cur.A + (size_t)(t + 2) * kstep; const char* b2 = last ? nxt.B : cur.B + (size_t)(t + 2) * kstep;
            const char* a3 = a2 + kstep; const char* b3 = b2 + kstep;
            G_LDB(B0, 0, 0); G_SCHED; G_LDA(At, 0, 0); { unsigned nv[2] = {0u, 0u}; if constexpr (GATHER) { LAS unsigned* q_ = vst + (ui & 1) * 4; nv[0] = q_[2]; nv[1] = q_[3]; } G_STAGE_A(G_SA(1, 1), a1, nv, 1); }
            G_WAIT_L(8); G_BAR; G_WAIT_L(0); G_MMA(0, 0, At, B0); G_BAR; G_SCHED;
            G_LDB(B1, 0, 1); G_STAGE(G_SB(0, 0), b2, voffB);
            G_BAR; G_WAIT_L(0); G_MMA(0, 1, At, B1); G_BAR;
            G_LDA(At, 0, 1); { unsigned nv[2] = {0u, 0u}; if constexpr (GATHER) { LAS unsigned* q_ = vst + ((ui + (last ? 1 : 0)) & 1) * 4; nv[0] = q_[0]; nv[1] = q_[1]; } G_STAGE_A(G_SA(0, 0), a2, nv, 0); }
            G_BAR; G_WAIT_L(0); G_MMA(1, 0, At, B0); G_BAR; G_SCHED;
            G_STAGE(G_SB(0, 1), b2 + hstepB, voffB);
            G_WAIT_V(6); G_BAR; G_MMA(1, 1, At, B1); G_BAR;
            G_LDB(B0, 1, 0); G_SCHED; G_LDA(At, 1, 0); { unsigned nv[2] = {0u, 0u}; if constexpr (GATHER) { LAS unsigned* q_ = vst + ((ui + (last ? 1 : 0)) & 1) * 4; nv[0] = q_[2]; nv[1] = q_[3]; } G_STAGE_A(G_SA(0, 1), a2, nv, 1); }
            G_WAIT_L(8); G_BAR; G_WAIT_L(0); G_MMA(0, 0, At, B0); G_BAR; G_SCHED;
            G_LDB(B1, 1, 1); G_STAGE(G_SB(1, 0), b3, voffB);
            G_BAR; G_WAIT_L(0); G_MMA(0, 1, At, B1); G_BAR;
            G_LDA(At, 1, 1); { unsigned nv[2] = {0u, 0u}; if constexpr (GATHER) { LAS unsigned* q_ = vst + ((ui + (last ? 1 : 0)) & 1) * 4; nv[0] = q_[0]; nv[1] = q_[1]; } G_STAGE_A(G_SA(1, 0), a3, nv, 0); }
            G_BAR; G_WAIT_L(0); G_MMA(1, 0, At, B0); G_BAR; G_SCHED;
            G_STAGE(G_SB(1, 1), b3 + hstepB, voffB);
            G_WAIT_V(6); G_BAR; G_MMA(1, 1, At, B1); G_BAR;
        }
        { const int l2 = TID512() & 63; epi(acc, cur, wr, wc, l2 & 15, l2 >> 4); }
        if (!has_next) break;
#pragma unroll
        for (int a = 0; a < 2; ++a)
#pragma unroll
            for (int b = 0; b < 2; ++b)
#pragma unroll
                for (int m = 0; m < 4; ++m)
#pragma unroll
                    for (int n = 0; n < 2; ++n) acc[a][b][m][n] = (f32x4){0.f, 0.f, 0.f, 0.f};
        cur = nxt; ++ui;
    }
    G_WAIT_V(0);
    if (wr == 0) G_BAR;
    G_BAR;
#undef G_SA
#undef G_STAGE_A
#undef G_SB
#undef G_STAGE
#undef G_LDA
#undef G_LDB
#undef G_MMA
#undef G_LO
#undef G_HI
#undef G_WAIT_V
#undef G_WAIT_L
#undef G_BAR
#undef G_SCHED
}
DEVINL long unit_linear(int i, int c, int G) { const int q = G >> 3; return ((long)i * 8 + (c & 7)) * q + (c >> 3); }

constexpr int CONV_PER_L = 672 + 256 + 8320 + 4160;
struct ConvJob { const float* src; bf16_t* dst; int K, ld, k0, r0, perm, f8; };
DEVINL ConvJob conv_decode(KP p, int id) {
    ConvJob j; const int l = id / CONV_PER_L; int r = id % CONV_PER_L; int kt, nt;
    if (r < 672) { j.src = p->in[I_WIN] + (size_t)l * 1024 * 2688; j.K = 1024; j.ld = 2688; j.perm = 0; j.dst = (bf16_t*)(p->ws + OFF_WIN + (size_t)l * WIN_ROWS * 1024); j.f8 = 1; nt = r % 42; kt = r / 42; }
    else if (r < 928) { r -= 672; j.src = p->in[I_WOUT] + (size_t)l * 1024 * 1024; j.K = 1024; j.ld = 1024; j.perm = 0; j.dst = (bf16_t*)(p->ws + OFF_WOUT) + (size_t)l * 1024 * 1024; j.f8 = 0; nt = r & 15; kt = r >> 4; }
    else if (r < 928 + 8320) { r -= 928; const int e = r >> 7, q = r & 127; nt = q & 7; kt = q >> 3; j.K = 1024; j.ld = 512; j.perm = 1; j.f8 = 1;
        j.src = (e < 64) ? p->in[I_W13] + (size_t)(l * 64 + e) * 1024 * 512 : p->in[I_WS13] + (size_t)l * 1024 * 512;
        j.dst = (bf16_t*)(p->ws + OFF_W13 + (size_t)(l * 65 + e) * 512 * 1024); }
    else { r -= 9248; const int e = r >> 6, q = r & 63; nt = q & 15; kt = q >> 4; j.K = 256; j.ld = 1024; j.perm = 0; j.f8 = 0;
        j.src = (e < 64) ? p->in[I_W2] + (size_t)(l * 64 + e) * 256 * 1024 : p->in[I_WS2] + (size_t)l * 256 * 1024;
        j.dst = (bf16_t*)(p->ws + OFF_W2) + (size_t)(l * 65 + e) * 1024 * 256; }
    j.k0 = kt * 64; j.r0 = nt * 64; return j;
}
DEVINL void conv_issue(const ConvJob& j, char* buf, int tid) {
    const int nn = tid & 63, drow = j.r0 + nn;
    int scol = drow;
    if (j.perm) { const int g = drow >> 5, i = drow & 31; scol = (i < 16) ? (g * 16 + i) : (256 + g * 16 + (i - 16)); }
    const float* sp = j.src + (size_t)j.k0 * j.ld + scol;
#pragma unroll
    for (int q = 0; q < 16; ++q) { const int kk = (tid >> 6) + 4 * q;
        __builtin_amdgcn_global_load_lds((const unsigned*)(sp + (size_t)kk * j.ld), (unsigned*)(buf + kk * 260 + nn * 4), 4, 0, 0); }
}
DEVINL void convert_dyn(KP p, char* lds, int total) {
    const int tid = TIDX(), half = BIDX() & 1;
    const bool lead = (TID512() == 0);
    volatile LAS int* slot = (volatile LAS int*)(lds - half * LDS_HALF + 2 * LDS_HALF);
    unsigned* ctr = (unsigned*)(p->ws + OFF_CNT) + 768;
    unsigned gpend = 0u;
    if (lead) { const unsigned b0 = atomicAdd(ctr, 6u); slot[0] = (int)b0; slot[1] = (int)b0 + 2; slot[2] = (int)b0 + 4; gpend = atomicAdd(ctr, 2u); }
    __syncthreads();
    int cur = __builtin_amdgcn_readfirstlane(slot[0]);
    auto jid = [&](int base) { const int id = base + half; return (id < total) ? id : total - 1; };
    ConvJob j0 = conv_decode(p, jid(cur)), j1 = conv_decode(p, jid(__builtin_amdgcn_readfirstlane(slot[1])));
    conv_issue(j0, lds, tid);
    conv_issue(j1, lds + 16640, tid);
    auto dptr = [](const ConvJob& j) { return (char*)j.dst + ((size_t)j.r0 * j.K + j.k0) * (j.f8 ? 1 : 2); };
    char* d0 = dptr(j0); int K0 = j0.K, f0 = j0.f8;
    char* d1 = dptr(j1); int K1 = j1.K, f1 = j1.f8;
    int nxt = __builtin_amdgcn_readfirstlane(slot[1]);
    for (int i = 0; cur < total; ++i) {
        if (lead) { slot[(i + 3) & 3] = (int)gpend; gpend = atomicAdd(ctr, 2u); }
        const int b2 = __builtin_amdgcn_readfirstlane(slot[(i + 2) & 3]);
        const ConvJob j2 = conv_decode(p, jid(b2));
        conv_issue(j2, lds + ((i + 2) % 3) * 16640, tid);
        asm volatile("s_waitcnt vmcnt(32)" ::: "memory");
        __builtin_amdgcn_s_barrier();
        const float* tile = (const float*)(lds + (i % 3) * 16640);
        if (f0) {
            const int kp = (tid & 15) * 4;
#pragma unroll
            for (int q = 0; q < 4; ++q) { const int rr = (tid >> 4) + 16 * q;
                int w8 = __builtin_amdgcn_cvt_pk_fp8_f32(16.f * tile[kp * 65 + rr], 16.f * tile[(kp + 1) * 65 + rr], 0, false);
                w8 = __builtin_amdgcn_cvt_pk_fp8_f32(16.f * tile[(kp + 2) * 65 + rr], 16.f * tile[(kp + 3) * 65 + rr], w8, true);
                *(int*)(d0 + (size_t)rr * K0 + kp) = w8; }
        } else {
            const int kp = (tid & 31) * 2;
#pragma unroll
            for (int q = 0; q < 8; ++q) { const int rr = (tid >> 5) + 8 * q;
                *(unsigned*)(d0 + ((size_t)rr * K0 + kp) * 2) = pack2(tile[kp * 65 + rr], tile[(kp + 1) * 65 + rr]); }
        }
        asm volatile("s_waitcnt lgkmcnt(0)" ::: "memory");
        __builtin_amdgcn_s_barrier();
        d0 = d1; K0 = K1; f0 = f1; d1 = dptr(j2); K1 = j2.K; f1 = j2.f8;
        cur = nxt; nxt = b2;
    }
    asm volatile("s_waitcnt vmcnt(0)" ::: "memory");
    __syncthreads();
}

DEVINL void phase0(KP p, char* lds) {
    const int tid = TIDX(), nb = NBV(), blk = BIDX();
    if (blk == 0 && tid < 128) ((unsigned*)(p->ws + OFF_CNT))[tid] = 0u;
    if (blk < 384) {
        float* sc = (float*)lds;
        float* part = (float*)(lds + 32768);
        {
            float cv[32];
#pragma unroll
            for (int i = 0; i < 32; ++i) cv[i] = p->in[I_C][i * VTHREADS + tid];
#pragma unroll
            for (int i = 0; i < 32; ++i) sc[i * VTHREADS + tid] = cv[i] * sigm(cv[i]);
        }
        __syncthreads();
        const int cl = tid & 31, ks = tid >> 5, n = blk * 32 + cl, l = n / 6144, nn = n % 6144;
        const float* w = p->in[I_WMOD] + (size_t)l * 1024 * 6144 + (size_t)(ks * 128) * 6144 + nn;
        float acc[8];
#pragma unroll
        for (int b = 0; b < 8; ++b) acc[b] = 0.f;
#pragma unroll 1
        for (int k0 = 0; k0 < 128; k0 += 64) {
            float wv[64];
#pragma unroll
            for (int k = 0; k < 64; ++k) wv[k] = w[(size_t)(k0 + k) * 6144];
#pragma unroll
            for (int k = 0; k < 64; ++k)
#pragma unroll
                for (int b = 0; b < 8; ++b) acc[b] = fmaf(sc[b * 1024 + ks * 128 + k0 + k], wv[k], acc[b]);
        }
#pragma unroll
        for (int b = 0; b < 8; ++b) part[(ks * 8 + b) * 32 + cl] = acc[b];
        __syncthreads();
        if (tid < 32) {
            const float bm = p->in[I_BMOD][l * 6144 + nn];
            float* mod = (float*)(p->ws + OFF_MOD);
#pragma unroll
            for (int b = 0; b < 8; ++b) {
                float sum = bm;
#pragma unroll
                for (int q = 0; q < 8; ++q) sum += part[(q * 8 + b) * 32 + cl];
                mod[(size_t)(l * 8 + b) * 6144 + nn] = sum;
            }
        }
        __syncthreads();
    }
    if (blk >= 448) {
        bf16_t* wgt = (bf16_t*)(p->ws + OFF_WGT);
#pragma unroll
        for (int j = 0; j < 4; ++j) {
            const int idx = (blk - 448) * 1024 + j * 256 + tid;
            const int mat = idx >> 15, lh = (idx >> 12) & 7, d = (idx >> 6) & 63, e = idx & 63;
            const float w = (mat == 0) ? p->in[I_WRG][idx & 32767] : p->in[I_WIG][idx & 32767];
            wgt[(size_t)((lh * 2 + mat) * 64 + e) * 64 + d] = f2bf(w);
        }
    }
    if (blk >= 448) {
        bf16_t* wlt = (bf16_t*)(p->ws + OFF_WLT);
#pragma unroll
        for (int j = 0; j < 4; ++j) {
            const int idx = (blk - 448) * 1024 + j * 256 + tid, l2 = idx >> 15, f = (idx >> 8) & 127, c = idx & 255;
            const float w = (f < 32) ? p->in[I_WW2][(size_t)(l2 * 32 + f) * 256 + c] : ((f < 64) ? p->in[I_WA2][(size_t)(l2 * 32 + f - 32) * 256 + c] : p->in[I_WG2][(size_t)(l2 * 64 + f - 64) * 256 + c]);
            wlt[(size_t)(l2 * 256 + c) * 128 + f] = f2bf(w);
        }
    }
    if (blk >= 384 && blk < 448) {
        bf16_t* wrt = (bf16_t*)(p->ws + OFF_WR);
#pragma unroll
        for (int j = 0; j < 8; ++j) {
            const int idx = (blk - 384) * 2048 + j * 256 + tid, l2 = idx >> 16, rem = idx & 65535, k = rem >> 6, e = rem & 63;
            const float w = p->in[I_WROUTER][idx];
            const bf16_t hi = f2bf(w); const bf16_t lo = f2bf(w - bf2f(hi));
            wrt[(size_t)((l2 * 2 + 0) * 64 + e) * 1024 + k] = hi; wrt[(size_t)((l2 * 2 + 1) * 64 + e) * 1024 + k] = lo;
        }
    }
    convert_dyn(p, lds, 2 * CONV_PER_L);
}

DEVINL void phaseF0(KP p) {
    const int tid = TIDX(), nb = NBV(), blk = BIDX();
    const float* mod = (const float*)(p->ws + OFF_MOD);
    bf16_t* ubuf = (bf16_t*)(p->ws + OFF_UBUF);
    const int col = tid * 4;
    for (int row0 = blk * 8; row0 < NTOK; row0 += nb * 8) {
        float4 x[8];
#pragma unroll
        for (int u = 0; u < 8; ++u) x[u] = *(const float4*)(p->in[I_X] + (size_t)(row0 + u) * DM + col);
        const int b = row0 >> 12;
        const float4 sh = *(const float4*)(mod + (size_t)b * 6144 + col);
        const float4 sc = *(const float4*)(mod + (size_t)b * 6144 + 1024 + col);
#pragma unroll
        for (int u = 0; u < 8; ++u) {
            int w8 = __builtin_amdgcn_cvt_pk_fp8_f32(x[u].x * (1.f + sc.x) + sh.x, x[u].y * (1.f + sc.y) + sh.y, 0, false);
            w8 = __builtin_amdgcn_cvt_pk_fp8_f32(x[u].z * (1.f + sc.z) + sh.z, x[u].w * (1.f + sc.w) + sh.w, w8, true);
            *(int*)((char*)ubuf + (size_t)(row0 + u) * DM + col) = w8;
        }
    }
}

template <int K> DEVINL void conf_tap(float (&acc)[32], const float (&w)[31], const float (&hv)[62]) {
#pragma unroll
    for (int j = 0; j < 32; ++j) acc[j] = fmaf(w[K], hv[j + K], acc[j]);
}
template <int... Ks> DEVINL void conf_taps(float (&acc)[32], const float (&w)[31], const float (&hv)[62], std::integer_sequence<int, Ks...>) {
    const int order[] = {(conf_tap<Ks>(acc, w, hv), 0)...}; (void)order;
}
DEVINL void b1_conformer(KP p, int l, char* lds, int item) {
    const int tid = TIDX(), b = item >> 7, tt = item & 127, t0 = tt * 32, rowbase = b * SEQ;
    const bf16_t* P = (const bf16_t*)(p->ws + A_P);
    bf16_t* ymix = (bf16_t*)(p->ws + A_YMIX);
    {
        const int wv = tid >> 6, ln = tid & 63;
        const char* src = (const char*)P + ((long)(rowbase + t0 - 30 + wv) * PIN) * 2 + ln * 16;
#pragma unroll
        for (int i = 0; i < 16; ++i)
            __builtin_amdgcn_global_load_lds((const unsigned*)(src + (long)(4 * i) * PIN * 2), (LAS unsigned*)((LAS unsigned char*)lds + (wv + 4 * i) * 1024), 16, 0, 0);
    }
    float w[31];
#pragma unroll
    for (int k = 0; k < 31; ++k) w[k] = p->in[I_CONVA][(size_t)(l * 31 + k) * 256 + tid];
    float acc[32];
    const float bias = p->in[I_CONVAB][l * 256 + tid];
#pragma unroll
    for (int j = 0; j < 32; ++j) acc[j] = bias;
    asm volatile("s_waitcnt vmcnt(0)" ::: "memory");
    __syncthreads();
    float hv[62];
#pragma unroll
    for (int rr = 0; rr < 62; ++rr) {
        const int t = t0 - 30 + rr;
        const float val = bf2f(*(const bf16_t*)(lds + rr * 1024 + tid * 2)), gate = bf2f(*(const bf16_t*)(lds + rr * 1024 + 512 + tid * 2));
        hv[rr] = (t >= 0) ? val * sigm(gate) : 0.f;
    }
    conf_taps(acc, w, hv, std::make_integer_sequence<int, 31>{});
    __syncthreads();
    float* outb = (float*)lds;
#pragma unroll
    for (int j = 0; j < 32; ++j) outb[j * 256 + tid] = acc[j];
    __syncthreads();
    const int wid = tid >> 6, lane = tid & 63;
    const float4 g4 = *(const float4*)(p->in[I_LNAG] + l * 256 + lane * 4), b4 = *(const float4*)(p->in[I_LNAB] + l * 256 + lane * 4);
    for (int j = wid; j < 32; j += 4) {
        const float4 v = *(const float4*)(outb + j * 256 + lane * 4);
        const float mean = wave_sum(v.x + v.y + v.z + v.w) * (1.f / 256.f);
        const float d0 = v.x - mean, d1 = v.y - mean, d2 = v.z - mean, d3 = v.w - mean;
        const float var = wave_sum(d0 * d0 + d1 * d1 + d2 * d2 + d3 * d3) * (1.f / 256.f);
        const float rs = rsqrtf(var + LN_EPS);
        float y0 = d0 * rs * g4.x + b4.x, y1 = d1 * rs * g4.y + b4.y, y2 = d2 * rs * g4.z + b4.z, y3 = d3 * rs * g4.w + b4.w;
        y0 *= sigm(y0); y1 *= sigm(y1); y2 *= sigm(y2); y3 *= sigm(y3);
        uint2 o; o.x = pack2(y0, y1); o.y = pack2(y2, y3);
        *(uint2*)(ymix + (size_t)(rowbase + t0 + j) * DM + lane * 4) = o;
    }
    __syncthreads();
}

DEVINL void b1_shortconv(KP p, int l, int item) {
    const int tid = TIDX(), cg = tid & 31, tl = tid >> 5, b = item >> 6, t0 = (item & 63) * 64 + tl * 8, rowbase = b * SEQ;
    const bf16_t* P = (const bf16_t*)(p->ws + A_P);
    bf16_t* ymix = (bf16_t*)(p->ws + A_YMIX);
    float w0[8], w1[8], w2[8];
#pragma unroll
    for (int e = 0; e < 8; ++e) { w0[e] = p->in[I_CONVD][(l * 3 + 0) * 256 + cg * 8 + e]; w1[e] = p->in[I_CONVD][(l * 3 + 1) * 256 + cg * 8 + e]; w2[e] = p->in[I_CONVD][(l * 3 + 2) * 256 + cg * 8 + e]; }
    uint4 gbv[8], gcv[10], hdv[10];
#pragma unroll
    for (int u = 0; u < 10; ++u) {
        const int t = t0 - 2 + u;
        const bf16_t* a = P + (size_t)(rowbase + (t >= 0 ? t : 0)) * PIN + 1920 + cg * 8;
        gcv[u] = *(const uint4*)(a + 256); hdv[u] = *(const uint4*)(a + 512);
        if (u >= 2) gbv[u - 2] = *(const uint4*)(a);
    }
    float q2[8], q1[8];
#pragma unroll
    for (int u = 0; u < 10; ++u) {
        const int t = t0 - 2 + u;
        const unsigned gcw[4] = {gcv[u].x, gcv[u].y, gcv[u].z, gcv[u].w}, hdw[4] = {hdv[u].x, hdv[u].y, hdv[u].z, hdv[u].w};
        float q0[8];
#pragma unroll
        for (int e = 0; e < 4; ++e) {
            q0[2 * e] = __uint_as_float(gcw[e] << 16) * __uint_as_float(hdw[e] << 16);
            q0[2 * e + 1] = __uint_as_float(gcw[e] & 0xFFFF0000u) * __uint_as_float(hdw[e] & 0xFFFF0000u);
        }
        if (t < 0) {
#pragma unroll
            for (int e = 0; e < 8; ++e) q0[e] = 0.f;
        }
        if (u >= 2) {
            const unsigned gbw[4] = {gbv[u - 2].x, gbv[u - 2].y, gbv[u - 2].z, gbv[u - 2].w};
            float y[8];
#pragma unroll
            for (int e = 0; e < 4; ++e) {
                y[2 * e] = __uint_as_float(gbw[e] << 16) * (w0[2 * e] * q2[2 * e] + w1[2 * e] * q1[2 * e] + w2[2 * e] * q0[2 * e]);
                y[2 * e + 1] = __uint_as_float(gbw[e] & 0xFFFF0000u) * (w0[2 * e + 1] * q2[2 * e + 1] + w1[2 * e + 1] * q1[2 * e + 1] + w2[2 * e + 1] * q0[2 * e + 1]);
            }
            *(uint4*)(ymix + (size_t)(rowbase + t) * DM + 768 + cg * 8) = make_uint4(pack2(y[0], y[1]), pack2(y[2], y[3]), pack2(y[4], y[5]), pack2(y[6], y[7]));
        }
#pragma unroll
        for (int e = 0; e < 8; ++e) { q2[e] = (u >= 1) ? q1[e] : 0.f; q1[e] = q0[e]; }
    }
}

DEVINL void b1_lru(KP p, int l, char* lds, int item) {
    const int c = TIDX(), b = item >> 7, tt = item & 127, t0 = tt * 32, rowbase = b * SEQ;
    const int h = c >> 6, lane = c & 63, r = lane & 31, hh = lane >> 5;
    const bf16_t* P = (const bf16_t*)(p->ws + A_P);
    constexpr int URS2 = 528;
    char* uA = lds;
    float ureg[32];
    {
        const float cb0 = p->in[I_CONVB][(l * 4 + 0) * 256 + c], cb1 = p->in[I_CONVB][(l * 4 + 1) * 256 + c], cb2 = p->in[I_CONVB][(l * 4 + 2) * 256 + c], cb3 = p->in[I_CONVB][(l * 4 + 3) * 256 + c];
        const float bias = p->in[I_CONVBB][l * 256 + c];
        float xm3 = 0.f, xm2 = 0.f, xm1 = 0.f;
        if (t0 >= 3) { const bf16_t* a = P + (size_t)(rowbase + t0 - 3) * PIN + 512 + c; xm3 = bf2f(a[0]); xm2 = bf2f(a[PIN]); xm1 = bf2f(a[2 * PIN]); }
        bf16_t xr[32];
#pragma unroll
        for (int j = 0; j < 32; ++j) xr[j] = P[(size_t)(rowbase + t0 + j) * PIN + 512 + c];
#pragma unroll
        for (int j = 0; j < 32; ++j) {
            const float x0 = bf2f(xr[j]);
            ureg[j] = cb0 * xm3 + cb1 * xm2 + cb2 * xm1 + cb3 * x0 + bias;
            *(bf16_t*)(uA + j * URS2 + c * 2) = f2bf(ureg[j]);
            xm3 = xm2; xm2 = xm1; xm1 = x0;
        }
    }
    __syncthreads();
    float ar[32], ai[32];
    {
        const bf16_t* wg = (const bf16_t*)(p->ws + OFF_WGT) + (size_t)((l * 4 + h) * 2) * 4096 + (size_t)r * 64 + 8 * hh;
        f32x16 aR0, aR1, aI0, aI1;
#pragma unroll
        for (int i = 0; i < 16; ++i) { aR0[i] = 0.f; aR1[i] = 0.f; aI0[i] = 0.f; aI1[i] = 0.f; }
#pragma unroll
        for (int ks = 0; ks < 4; ++ks) {
            const bf16x8 af = *(const bf16x8*)(uA + r * URS2 + (h * 64 + ks * 16 + 8 * hh) * 2);
            const bf16x8 r0 = *(const bf16x8*)(wg + ks * 16), r1 = *(const bf16x8*)(wg + 32 * 64 + ks * 16);
            const bf16x8 i0 = *(const bf16x8*)(wg + 4096 + ks * 16), i1 = *(const bf16x8*)(wg + 4096 + 32 * 64 + ks * 16);
            aR0 = MFMA32(af, r0, aR0); aR1 = MFMA32(af, r1, aR1); aI0 = MFMA32(af, i0, aI0); aI1 = MFMA32(af, i1, aI1);
        }
        __syncthreads();
        float* xch = (float*)(lds + 17408) + h * 2048;
#define XCHG(X0, X1, OUT) do { _Pragma("unroll") for (int i = 0; i < 16; ++i) { const int t_ = (i & 3) + 8 * (i >> 2) + 4 * hh; xch[t_ * 64 + r] = X0[i]; xch[t_ * 64 + 32 + r] = X1[i]; } \
        _Pragma("unroll") for (int t_ = 0; t_ < 32; ++t_) OUT[t_] = xch[t_ * 64 + lane]; } while (0)
        XCHG(aR0, aR1, ar); XCHG(aI0, aI1, ai);
#undef XCHG
    }
    const float brg = p->in[I_BRG][l * 256 + c], big = p->in[I_BIG][l * 256 + c];
    const float sp = softplus_acc(-p->in[I_LAMBDA][l * 256 + c]);
    unsigned* hp = (unsigned*)(p->ws + A_HLOC) + (size_t)(rowbase + t0) * 256 + c;
    float hs = 0.f, cA = 1.f;
#pragma unroll
    for (int j = 0; j < 32; ++j) {
        const float rg = sigm(ar[j] + brg), ig = sigm(ai[j] + big);
        const float log_a = -8.0f * rg * sp;
        const float a = __expf(log_a);
        const float mult = sqrtf(fmaxf(1.f - a * a, 0.f));
        const float bx = mult * (ig * ureg[j]);
        hs = fmaf(a, hs, bx); cA *= a;
        hp[j * 256] = pack2(hs, cA);
    }
    ((float*)(p->ws + A_CARRYA))[(size_t)(b * 128 + tt) * 256 + c] = cA;
    ((float*)(p->ws + A_CARRYH))[(size_t)(b * 128 + tt) * 256 + c] = hs;
    __syncthreads();
}

DEVINL void b1_rwkv(KP p, int l, char* lds, int item) {
    const int c = TIDX(), b = item >> 7, tt = item & 127, t0 = tt * 32, rowbase = b * SEQ;
    const bf16_t* P = (const bf16_t*)(p->ws + A_P);
    constexpr int FRS = 272;
    char* featA = lds;
    const float* muc = p->in[I_MUC] + l * 896;
    if (c < 128) {
        const int col = 1024 + 768 + c; const float mu = muc[768 + c];
        float prev;
        { const float x = bf2f(P[(size_t)(rowbase + (t0 > 0 ? t0 - 1 : 0)) * PIN + col]); prev = (t0 > 0) ? x : 0.f; }
#pragma unroll 1
        for (int jb = 0; jb < 2; ++jb) {
            bf16_t raw[16];
#pragma unroll
            for (int u = 0; u < 16; ++u) raw[u] = P[(size_t)(rowbase + t0 + jb * 16 + u) * PIN + col];
#pragma unroll
            for (int u = 0; u < 16; ++u) {
                const float cur = bf2f(raw[u]);
                const float xs = cur + (prev - cur) * mu;
                const float val = (c < 32) ? tanh_fast(xs) : ((c < 64) ? xs : sigm(xs));
                *(bf16_t*)(featA + (jb * 16 + u) * FRS + c * 2) = f2bf(val); prev = cur;
            }
        }
    }
    __syncthreads();
    float dec[32], aa[32];
    {
        const int lane = c & 63, h = c >> 6, r = lane & 31, hh = lane >> 5;
        const bf16_t* wl = (const bf16_t*)(p->ws + OFF_WLT) + (size_t)(l * 256 + h * 64 + r) * 128 + 8 * hh;
        f32x16 aW0, aW1, aA0, aA1, aG0, aG1;
#pragma unroll
        for (int i = 0; i < 16; ++i) { aW0[i] = 0.f; aW1[i] = 0.f; aA0[i] = 0.f; aA1[i] = 0.f; aG0[i] = 0.f; aG1[i] = 0.f; }
        bf16x8 b0[8], b1[8];
#pragma unroll
        for (int ks = 0; ks < 8; ++ks) { b0[ks] = *(const bf16x8*)(wl + ks * 16); b1[ks] = *(const bf16x8*)(wl + 32 * 128 + ks * 16); }
#pragma unroll
        for (int ks = 0; ks < 8; ++ks) {
            const bf16x8 af = *(const bf16x8*)(featA + r * FRS + (ks * 16 + 8 * hh) * 2);
            if (ks < 2) { aW0 = MFMA32(af, b0[ks], aW0); aW1 = MFMA32(af, b1[ks], aW1); }
            else if (ks < 4) { aA0 = MFMA32(af, b0[ks], aA0); aA1 = MFMA32(af, b1[ks], aA1); }
            else { aG0 = MFMA32(af, b0[ks], aG0); aG1 = MFMA32(af, b1[ks], aG1); }
        }
        __syncthreads();
        float* xch = (float*)(lds + 9216) + h * 2048;
        float tmpx[32];
#define XCHG(X0, X1, OUT) do { _Pragma("unroll") for (int i = 0; i < 16; ++i) { const int t_ = (i & 3) + 8 * (i >> 2) + 4 * hh; xch[t_ * 64 + r] = X0[i]; xch[t_ * 64 + 32 + r] = X1[i]; } \
        _Pragma("unroll") for (int t_ = 0; t_ < 32; ++t_) OUT[t_] = xch[t_ * 64 + lane]; } while (0)
        bf16_t* gbuf = (bf16_t*)(p->ws + A_G);
        const float w0 = p->in[I_W0][l * 256 + c], a0 = p->in[I_A0][l * 256 + c];
        XCHG(aW0, aW1, tmpx);
#pragma unroll
        for (int j = 0; j < 32; ++j) { const float z = w0 + tmpx[j]; const float wlog = -softplusf(-z) - 0.5f; dec[j] = -__expf(wlog); }
        asm volatile("" ::: "memory");
        XCHG(aA0, aA1, tmpx);
#pragma unroll
        for (int j = 0; j < 32; ++j) aa[j] = sigm(a0 + tmpx[j]);
        asm volatile("" ::: "memory");
        XCHG(aG0, aG1, tmpx);
#pragma unroll
        for (int j = 0; j < 32; ++j) gbuf[(size_t)(rowbase + t0 + j) * 256 + c] = f2bf(tmpx[j]);
#undef XCHG
    }
    {
        bf16_t* bonus = (bf16_t*)(p->ws + A_BONUS); uint4* scan = (uint4*)(p->ws + A_SCAN);
        const float mur = muc[c], muk = muc[256 + c], muv = muc[512 + c];
        const float kkw = p->in[I_KK][l * 256 + c], kaw = p->in[I_KA][l * 256 + c], rkw = p->in[I_RK][l * 256 + c];
        float pr, pk, pv;
        { const bf16_t* a = P + (size_t)(rowbase + (t0 > 0 ? t0 - 1 : 0)) * PIN + 1024 + c; const float x0 = bf2f(a[0]), x1 = bf2f(a[256]), x2 = bf2f(a[512]);
          pr = (t0 > 0) ? x0 : 0.f; pk = (t0 > 0) ? x1 : 0.f; pv = (t0 > 0) ? x2 : 0.f; }
#pragma unroll
        for (int jb = 0; jb < 4; ++jb) {
            bf16_t rr_[8], rk_[8], rv_[8];
#pragma unroll
            for (int u = 0; u < 8; ++u) { const bf16_t* a = P + (size_t)(rowbase + t0 + jb * 8 + u) * PIN + 1024 + c; rr_[u] = a[0]; rk_[u] = a[256]; rv_[u] = a[512]; }
#pragma unroll
            for (int u = 0; u < 8; ++u) {
                const int j = jb * 8 + u;
                const size_t row = (size_t)(rowbase + t0 + j);
                const float cr = bf2f(rr_[u]), ck = bf2f(rk_[u]), cv = bf2f(rv_[u]);
                const float r = cr + (pr - cr) * mur, k = ck + (pk - ck) * muk, v = cv + (pv - cv) * muv;
                pr = cr; pk = ck; pv = cv;
                const float kk = k * kkw;
                const float ss = wave_sum(kk * kk);
                const float kkn = kk * rsqrtf(ss + 1e-12f);
                const float kf = k * (1.f + (aa[j] - 1.f) * kaw);
                const float bs = wave_sum(r * kf * rkw);
                bonus[row * 256 + c] = f2bf(bs * v);
                uint4 o; o.x = pack2(kkn, kkn * aa[j]); o.y = pack2(kf, r); o.z = pack2(v, 0.f); o.w = __float_as_uint(dec[j]);
                scan[row * 256 + c] = o;
            }
            asm volatile("" ::: "memory");
        }
    }
    __syncthreads();
}

constexpr int S_AL = 0, S_BE = 8192, S_KA = 16384, S_RH = 24576, S_BET = 32768, S_KAT = 40960, S_VT = 49152, S_L2F = 57344  , S_GT = 73728  ;
constexpr int S_L2B = S_L2F, S_RHS = S_L2F;
constexpr int S_L1F = S_BE;
constexpr int S_M1 = S_BE, S_M2 = S_KA;
constexpr int S_APT = S_L2F, S_W2T = S_L2F + 8192;
constexpr int S_RP = S_AL, S_GTR = S_RH;
DEVINL int crow32(int reg, int h) { return (reg & 3) + 8 * (reg >> 2) + 4 * h; }
DEVINL int sw64(int row, int off) { return row * 128 + (off ^ ((row & 7) << 4)); }
DEVINL bf16x8 frag64(const char* lds, int slot, int row, int kel) { return *reinterpret_cast<const bf16x8*>(lds + slot + sw64(row, kel * 2)); }
DEVINL float dpp_xor1(float x) { return __builtin_bit_cast(float, __builtin_amdgcn_update_dpp(0, __builtin_bit_cast(int, x), 0xB1, 0xf, 0xf, true)); }

DEVINL f32x16 mm64(const char* lds, int slotA, int slotB, int tm, int tn, int r, int hh, f32x16 acc) {
#pragma unroll
    for (int ks = 0; ks < 4; ++ks) acc = MFMA32(frag64(lds, slotA, tm * 32 + r, ks * 16 + 8 * hh), frag64(lds, slotB, tn * 32 + r, ks * 16 + 8 * hh), acc);
    return acc;
}

DEVINL void b1e_unit(KP p, char* lds, int b, int h, int c) {
    const int tid = TIDX(), wv = tid >> 6, lane = tid & 63, r = lane & 31, hh = lane >> 5;
    const uint4* scan = (const uint4*)(p->ws + A_SCAN) + ((size_t)(b * SEQ + c * 64)) * 256 + h * 64;
    float* gtot = (float*)(lds + S_GT); float* gamC = gtot + 256;
    {
        const int j = lane;
        float lw[16]; unsigned px[16], py[16], pz[16];
#pragma unroll
        for (int u = 0; u < 16; ++u) { const uint4 q = scan[(size_t)(wv * 16 + u) * 256 + j]; px[u] = q.x; py[u] = q.y; pz[u] = q.z; lw[u] = __uint_as_float(q.w); }
        float tot = 0.f;
#pragma unroll
        for (int u = 0; u < 16; ++u) tot += lw[u];
        gtot[wv * 64 + j] = tot;
        __syncthreads();
        float off = 0.f, all = 0.f;
#pragma unroll
        for (int g = 0; g < 4; ++g) { const float v = gtot[g * 64 + j]; all += v; off += (g < wv) ? v : 0.f; }
        if (wv == 0) gamC[j] = __expf(all);
        float cum = off;
        unsigned tb[8], tk[8], tv[8];
#pragma unroll
        for (int u = 0; u < 16; ++u) {
            const float kkn = __uint_as_float(px[u] << 16), bb = __uint_as_float(px[u] & 0xFFFF0000u);
            const float kf = __uint_as_float(py[u] << 16), rr = __uint_as_float(py[u] & 0xFFFF0000u);
            const float gp = __expf(cum); cum += lw[u];
            const float g = __expf(cum), en = __expf(-cum);
            const int t = wv * 16 + u;
            const unsigned be = f2bf(bb * en), ka = f2bf(kf * en);
            *(bf16_t*)(lds + S_AL + sw64(t, j * 2)) = f2bf(gp * kkn);
            *(bf16_t*)(lds + S_BE + sw64(t, j * 2)) = (bf16_t)be;
            *(bf16_t*)(lds + S_KA + sw64(t, j * 2)) = (bf16_t)ka;
            *(bf16_t*)(lds + S_RH + sw64(t, j * 2)) = f2bf(g * rr);
            if (u & 1) { tb[u >> 1] |= be << 16; tk[u >> 1] |= ka << 16; tv[u >> 1] |= (pz[u] << 16); }
            else { tb[u >> 1] = be; tk[u >> 1] = ka; tv[u >> 1] = pz[u] & 0xFFFFu; }
        }
        *(uint4*)(lds + S_BET + sw64(j, wv * 32)) = make_uint4(tb[0], tb[1], tb[2], tb[3]); *(uint4*)(lds + S_BET + sw64(j, wv * 32 + 16)) = make_uint4(tb[4], tb[5], tb[6], tb[7]);
        *(uint4*)(lds + S_KAT + sw64(j, wv * 32)) = make_uint4(tk[0], tk[1], tk[2], tk[3]); *(uint4*)(lds + S_KAT + sw64(j, wv * 32 + 16)) = make_uint4(tk[4], tk[5], tk[6], tk[7]);
        *(uint4*)(lds + S_VT + sw64(j, wv * 32)) = make_uint4(tv[0], tv[1], tv[2], tv[3]); *(uint4*)(lds + S_VT + sw64(j, wv * 32 + 16)) = make_uint4(tv[4], tv[5], tv[6], tv[7]);
    }
    __syncthreads();
    const int tm = wv >> 1, tn = wv & 1;
    f32x16 aM1, aM2;
    {
        f32x16 aL1, aL2;
#pragma unroll
        for (int i = 0; i < 16; ++i) { aL1[i] = 0.f; aL2[i] = 0.f; aM1[i] = 0.f; aM2[i] = 0.f; }
#pragma unroll
        for (int ks = 0; ks < 4; ++ks) {
            const bf16x8 fa = frag64(lds, S_AL, tm * 32 + r, ks * 16 + 8 * hh), fr = frag64(lds, S_RH, tm * 32 + r, ks * 16 + 8 * hh);
            const bf16x8 fb = frag64(lds, S_BE, tn * 32 + r, ks * 16 + 8 * hh), fk = frag64(lds, S_KA, tn * 32 + r, ks * 16 + 8 * hh);
            aL1 = MFMA32(fa, fb, aL1); aL2 = MFMA32(fa, fk, aL2); aM1 = MFMA32(fr, fb, aM1); aM2 = MFMA32(fr, fk, aM2);
        }
        __syncthreads();
#pragma unroll
        for (int reg = 0; reg < 16; ++reg) {
            const int t = tm * 32 + crow32(reg, hh), sidx = tn * 32 + r;
            const int o = (t * 64 + (sidx & 1) * 32 + (sidx >> 1)) * 4;
            *(float*)(lds + S_L1F + o) = (sidx < t) ? aL1[reg] : 0.f;
            *(bf16_t*)(lds + S_L2B + sw64(t, sidx * 2)) = f2bf((sidx < t) ? aL2[reg] : 0.f);
            aM1[reg] = (sidx <= t) ? aM1[reg] : 0.f; aM2[reg] = (sidx <= t) ? aM2[reg] : 0.f;
        }
    }
    __syncthreads();
    f32x16 zero;
#pragma unroll
    for (int i = 0; i < 16; ++i) zero[i] = 0.f;
    {
        const f32x16 rh2 = mm64(lds, S_L2B, S_VT, tm, tn, r, hh, zero);
        __syncthreads();
#pragma unroll
        for (int reg = 0; reg < 16; ++reg) { const int t = tm * 32 + crow32(reg, hh), ic = tn * 32 + r; *(float*)(lds + S_RHS + (t * 64 + ic) * 4) = rh2[reg]; }
    }
    __syncthreads();
    unsigned outp[32];
    {
        const int col = (wv & 1) * 32 + (lane >> 1), q = lane & 1;
        const bool second = wv >= 2;
        float xq[32], rq[32];
#pragma unroll
        for (int k = 0; k < 32; ++k) xq[k] = 0.f;
#pragma unroll
        for (int k = 0; k < 32; ++k) {
            const float ra = bf2f(*(const bf16_t*)(lds + S_AL + (2 * k + q) * 128 + ((col * 2) ^ (((2 * k + q) & 7) << 4)))), rb = *(const float*)(lds + S_RHS + ((2 * k + q) * 64 + col) * 4);
            rq[k] = second ? rb : ra;
        }
        const char* l1row = lds + S_L1F + q * 128;
#pragma unroll
        for (int t = 0; t < 64; ++t) {
            float acc = 0.f;
#pragma unroll
            for (int k4 = 0; k4 * 4 < (t + 1) / 2; ++k4) {
                const float4 a = *(const float4*)(l1row + t * 256 + k4 * 16);
                acc = fmaf(a.x, xq[4 * k4 + 0], acc); acc = fmaf(a.y, xq[4 * k4 + 1], acc); acc = fmaf(a.z, xq[4 * k4 + 2], acc); acc = fmaf(a.w, xq[4 * k4 + 3], acc);
            }
            acc += dpp_xor1(acc);
            const float x = rq[t >> 1] - acc;
            xq[t >> 1] = ((t & 1) == q) ? x : xq[t >> 1];
        }
#pragma unroll
        for (int k = 0; k < 32; ++k) { const float o = dpp_xor1(xq[k]); outp[k] = q ? pack2(o, xq[k]) : pack2(xq[k], o); }
    }
    __syncthreads();
    {
        const int col = (wv & 1) * 32 + (lane >> 1), q = lane & 1;
        char* dst = lds + ((wv < 2) ? S_APT : S_W2T);
#pragma unroll
        for (int i = 0; i < 4; ++i) *(uint4*)(dst + sw64(col, q * 64 + i * 16)) = q ? make_uint4(outp[16 + 4 * i], outp[17 + 4 * i], outp[18 + 4 * i], outp[19 + 4 * i]) : make_uint4(outp[4 * i], outp[4 * i + 1], outp[4 * i + 2], outp[4 * i + 3]);
#pragma unroll
        for (int reg = 0; reg < 16; ++reg) {
            const int t = tm * 32 + crow32(reg, hh), sidx = tn * 32 + r;
            *(bf16_t*)(lds + S_M1 + sw64(t, sidx * 2)) = f2bf(aM1[reg]);
            *(bf16_t*)(lds + S_M2 + sw64(t, sidx * 2)) = f2bf(aM2[reg]);
        }
    }
    __syncthreads();
    unsigned char* ubase = p->ws + A_CHAIN + (size_t)((b * 4 + h) * 64 + c) * CHAIN_UNIT;
    f32x16 gt;
    {
        const f32x16 qv = mm64(lds, S_M1, S_APT, tm, tn, r, hh, zero);
        const f32x16 y0 = mm64(lds, S_M2, S_VT, tm, tn, r, hh, zero) - mm64(lds, S_M1, S_W2T, tm, tn, r, hh, zero);
        gt = mm64(lds, S_BET, S_APT, tm, tn, r, hh, zero);
        const f32x16 ht = mm64(lds, S_KAT, S_VT, tm, tn, r, hh, zero) - mm64(lds, S_BET, S_W2T, tm, tn, r, hh, zero);
#pragma unroll
        for (int reg = 0; reg < 16; ++reg) {
            const int t = tm * 32 + crow32(reg, hh), jc = tn * 32 + r;
            const float rh = bf2f(*(const bf16_t*)(lds + S_RH + sw64(t, jc * 2)));
            *(bf16_t*)(lds + S_RP + sw64(t, jc * 2)) = f2bf(rh - qv[reg]);
            const int jr = tm * 32 + crow32(reg, hh);
            const float gc = gamC[jr];
            gt[reg] = gc * (((jr == jc) ? 1.f : 0.f) - gt[reg]);
        }
        float4* himg = (float4*)(ubase + 16384); float4* yimg = (float4*)(ubase + 32768);
#pragma unroll
        for (int rq = 0; rq < 4; ++rq) {
            float4 hv, yv;
            hv.x = gamC[tm * 32 + crow32(4 * rq + 0, hh)] * ht[4 * rq + 0]; hv.y = gamC[tm * 32 + crow32(4 * rq + 1, hh)] * ht[4 * rq + 1];
            hv.z = gamC[tm * 32 + crow32(4 * rq + 2, hh)] * ht[4 * rq + 2]; hv.w = gamC[tm * 32 + crow32(4 * rq + 3, hh)] * ht[4 * rq + 3];
            yv.x = y0[4 * rq + 0]; yv.y = y0[4 * rq + 1]; yv.z = y0[4 * rq + 2]; yv.w = y0[4 * rq + 3];
            himg[((tn * 2 + tm) * 4 + rq) * 64 + lane] = hv;
            yimg[((tn * 2 + tm) * 4 + rq) * 64 + lane] = yv;
        }
    }
    __syncthreads();
#pragma unroll
    for (int reg = 0; reg < 16; ++reg) {
        const int jr = tm * 32 + crow32(reg, hh), jc = tn * 32 + r;
        *(bf16_t*)(lds + S_GTR + sw64(jr, jc * 2)) = f2bf(gt[reg]);
    }
    __syncthreads();
    {
        uint4* gimg = (uint4*)(ubase); uint4* rimg = (uint4*)(ubase + 8192);
#pragma unroll
        for (int ii = 0; ii < 2; ++ii) {
            const int im = wv * 2 + ii, mt = im >> 2, jb = (im >> 1) & 1, s2 = im & 1;
            const int cbase = (32 * jb + 16 * s2 + 4 * hh) * 2;
            const uint2 g0 = *(const uint2*)(lds + S_GTR + sw64(mt * 32 + r, cbase)), g1 = *(const uint2*)(lds + S_GTR + sw64(mt * 32 + r, cbase + 16));
            const uint2 r0 = *(const uint2*)(lds + S_RP + sw64(mt * 32 + r, cbase)), r1 = *(const uint2*)(lds + S_RP + sw64(mt * 32 + r, cbase + 16));
            gimg[im * 64 + lane] = make_uint4(g0.x, g0.y, g1.x, g1.y);
            rimg[im * 64 + lane] = make_uint4(r0.x, r0.y, r1.x, r1.y);
        }
    }
    __syncthreads();
}

DEVINL void phaseB1(KP p, int l, char* lds, const int mask = 15, const int sub = 3) {
    const int nb = NBV();
    if (mask & 1) {
        const int blk = BIDX();
        for (int it = blk; it < 512; it += nb) {
            if (sub & 1) { b1_rwkv(p, l, lds, it * 2); b1_rwkv(p, l, lds, it * 2 + 1); }
            __threadfence_block(); __syncthreads();
            const int b = it >> 6, c = it & 63;
            if (sub & 2) {
#pragma unroll 1
                for (int h = 0; h < 4; ++h) b1e_unit(p, lds, b, h, c);
            }
        }
    }
    if (mask & 2) { const int blk = BIDX(); for (int it = blk; it < 1024; it += nb) b1_lru(p, l, lds, it); }
    if (mask & 4) { const int blk = BIDX(); for (int it = blk; it < 1024; it += nb) b1_conformer(p, l, lds, it); }
    if (mask & 8) { const int blk = BIDX(); for (int it = blk; it < 512; it += nb) b1_shortconv(p, l, it); }
}

DEVINL void phaseB2(KP p, int l, char* lds) {
    const int wl = wave_index(), half = wl >> 2, lane = lane_index();
    const int bh = blockIdx.x;
    if (bh >= 32) return;
    char* ring = lds - half * LDS_HALF;
    if (wl == 0 || wl == 5) {
        const int w = half, b = bh >> 2, h = bh & 3, r = lane & 31, hh = lane >> 5;
        float* yraw = (float*)(p->ws + A_YRAW) + (size_t)b * SEQ * 256 + h * 64 + 32 * w + r;
        f32x16 X0, X1;
#pragma unroll
        for (int i = 0; i < 16; ++i) { X0[i] = 0.f; X1[i] = 0.f; }
#pragma unroll 1
        for (int c = 0; c < 64; ++c) {
            __builtin_amdgcn_s_barrier();
            asm volatile("" ::: "memory");
            char* buf = ring + (c % 3) * 49152;
            uint4 gq[8], rq8[8]; float4 hq[8], yq[8];
#pragma unroll
            for (int i = 0; i < 8; ++i) { gq[i] = *(const uint4*)(buf + i * 1024 + lane * 16); rq8[i] = *(const uint4*)(buf + 8192 + i * 1024 + lane * 16); }
#pragma unroll
            for (int i = 0; i < 8; ++i) { hq[i] = *(const float4*)(buf + 16384 + (w * 8 + i) * 1024 + lane * 16); yq[i] = *(const float4*)(buf + 32768 + (w * 8 + i) * 1024 + lane * 16); }
            bf16x8 xp[4];
#pragma unroll
            for (int s2 = 0; s2 < 2; ++s2) {
                uint4 a, bq;
                a.x = pack2(X0[8 * s2 + 0], X0[8 * s2 + 1]); a.y = pack2(X0[8 * s2 + 2], X0[8 * s2 + 3]); a.z = pack2(X0[8 * s2 + 4], X0[8 * s2 + 5]); a.w = pack2(X0[8 * s2 + 6], X0[8 * s2 + 7]);
                bq.x = pack2(X1[8 * s2 + 0], X1[8 * s2 + 1]); bq.y = pack2(X1[8 * s2 + 2], X1[8 * s2 + 3]); bq.z = pack2(X1[8 * s2 + 4], X1[8 * s2 + 5]); bq.w = pack2(X1[8 * s2 + 6], X1[8 * s2 + 7]);
                xp[s2] = __builtin_bit_cast(bf16x8, a); xp[2 + s2] = __builtin_bit_cast(bf16x8, bq);
            }
            f32x16 n0, n1;
#pragma unroll
            for (int i = 0; i < 4; ++i) { n0[4 * i] = hq[i].x; n0[4 * i + 1] = hq[i].y; n0[4 * i + 2] = hq[i].z; n0[4 * i + 3] = hq[i].w;
                                          n1[4 * i] = hq[4 + i].x; n1[4 * i + 1] = hq[4 + i].y; n1[4 * i + 2] = hq[4 + i].z; n1[4 * i + 3] = hq[4 + i].w; }
#pragma unroll
            for (int f = 0; f < 4; ++f) { n0 = MFMA32(__builtin_bit_cast(bf16x8, gq[f]), xp[f], n0); n1 = MFMA32(__builtin_bit_cast(bf16x8, gq[4 + f]), xp[f], n1); }
            X0 = n0; X1 = n1;
#pragma unroll
            for (int mt = 0; mt < 2; ++mt) {
                f32x16 acc;
#pragma unroll
                for (int i = 0; i < 4; ++i) { acc[4 * i] = yq[mt * 4 + i].x; acc[4 * i + 1] = yq[mt * 4 + i].y; acc[4 * i + 2] = yq[mt * 4 + i].z; acc[4 * i + 3] = yq[mt * 4 + i].w; }
#pragma unroll
                for (int f = 0; f < 4; ++f) acc = MFMA32(__builtin_bit_cast(bf16x8, rq8[mt * 4 + f]), xp[f], acc);
#pragma unroll
                for (int reg = 0; reg < 16; ++reg) yraw[(size_t)(c * 64 + mt * 32 + crow32(reg, hh)) * 256] = acc[reg];
            }
            asm volatile("s_waitcnt lgkmcnt(0)" ::: "memory");
        }
    } else {
        const int li = (wl < 5) ? wl - 1 : wl - 2;
        auto issue = [&](int c, char* buf) {
            const unsigned char* ubase = p->ws + A_CHAIN + (size_t)(bh * 64 + c) * CHAIN_UNIT + li * 8192;
#pragma unroll
            for (int i = 0; i < 8; ++i)
                __builtin_amdgcn_global_load_lds((const unsigned*)(ubase + i * 1024 + lane * 16), (unsigned*)(buf + li * 8192 + i * 1024 + lane * 16), 16, 0, 0);
        };
        issue(0, ring); issue(1, ring + 49152);
#pragma unroll 1
        for (int c = 0; c < 64; ++c) {
            if (c + 1 < 64) asm volatile("s_waitcnt vmcnt(8)" ::: "memory"); else asm volatile("s_waitcnt vmcnt(0)" ::: "memory");
            __builtin_amdgcn_s_barrier();
            if (c + 2 < 64) issue(c + 2, ring + ((c + 2) % 3) * 49152);
        }
    }
}

DEVINL void phaseMix(KP p, int l, char* lds, const int which) {
    const int blk = BIDX(), wg = blk >> 1, half = blk & 1;
    if (wg < 32) { if (which == 0) phaseB2(p, l, lds); return; }
    const int w = wg - 32, NW = 224;
    if (which == 0) { for (int pr = w; pr < 512; pr += NW) b1_lru(p, l, lds, pr * 2 + half); }
    else if (which == 1) { for (int pr = (w + 160) % NW; pr < 512; pr += NW) b1_conformer(p, l, lds, pr * 2 + half); }
    else { for (int pr = (w + 96) % NW; pr < 256; pr += NW) b1_shortconv(p, l, pr * 2 + half); }
}

DEVINL void phaseB3(KP p, int l) {
    const int c = TIDX(), nb = NBV(), blk = BIDX();
    const bf16_t* P = (const bf16_t*)(p->ws + A_P);
    bf16_t* ymix = (bf16_t*)(p->ws + A_YMIX);
    const float* yraw = (const float*)(p->ws + A_YRAW); const bf16_t* bonus = (const bf16_t*)(p->ws + A_BONUS); const bf16_t* gbuf = (const bf16_t*)(p->ws + A_G);
    const unsigned* hcbuf = (const unsigned*)(p->ws + A_HLOC);
    const float gng = p->in[I_GNG][l * 256 + c], gnb = p->in[I_GNB][l * 256 + c];
    for (int it = blk; it < 512; it += nb) {
        float hst0, hst1;
        {
            const int bq = (it * 64) >> 12, tt0 = ((it * 64) & 4095) >> 5;
            const float* ca = (const float*)(p->ws + A_CARRYA) + (size_t)bq * 128 * 256 + c;
            const float* ch = (const float*)(p->ws + A_CARRYH) + (size_t)bq * 128 * 256 + c;
            float hs = 0.f;
            const float ca1 = ca[tt0 * 256], ch1 = ch[tt0 * 256];
#pragma unroll 1
            for (int t0 = 0; t0 < tt0; t0 += 32) {
                float av[32], hv[32];
#pragma unroll
                for (int i = 0; i < 32; ++i) { av[i] = ca[(t0 + i) * 256]; hv[i] = ch[(t0 + i) * 256]; }
#pragma unroll
                for (int i = 0; i < 32; ++i) hs = (t0 + i < tt0) ? fmaf(av[i], hs, hv[i]) : hs;
            }
            hst0 = hs; hst1 = fmaf(ca1, hs, ch1);
        }
#pragma unroll 1
        for (int r8 = 0; r8 < 64; r8 += 16) {
            float yv[16]; bf16_t bo[16], gg[16], gbv[16]; unsigned hcv[16]; float hsv[16];
#pragma unroll
            for (int u = 0; u < 16; ++u) {
                const int row = it * 64 + r8 + u, b = row >> 12, tt = (row & 4095) >> 5;
                const size_t o = (size_t)row * 256 + c;
                yv[u] = yraw[o]; bo[u] = bonus[o]; gg[u] = gbuf[o]; hcv[u] = hcbuf[o]; hsv[u] = (r8 < 32) ? hst0 : hst1; (void)b; (void)tt;
                gbv[u] = P[(size_t)row * PIN + 768 + c];
            }
#pragma unroll
            for (int u = 0; u < 16; ++u) {
                const int row = it * 64 + r8 + u;
                const float y = yv[u];
                const float mu = wave_sum(y) * (1.f / 64.f);
                const float d = y - mu;
                const float var = wave_sum(d * d) * (1.f / 64.f);
                const float yn = d * rsqrtf(var + GN_EPS) * gng + gnb;
                ymix[(size_t)row * DM + 512 + c] = f2bf((yn + bf2f(bo[u])) * bf2f(gg[u]));
                const float hh = fmaf(__uint_as_float(hcv[u] & 0xFFFF0000u), hsv[u], __uint_as_float(hcv[u] << 16));
                ymix[(size_t)row * DM + 256 + c] = f2bf(hh * gelu_tanh(bf2f(gbv[u])));
            }
        }
    }
}

DEVINL void phaseD(KP p, int l, char* lds, const int dry = 0) {
    const int tid = TIDX(), nb = NBV(), blk = BIDX(), wid = tid >> 6, lane = tid & 63;
    constexpr int URS = 2064;
    char* uh = lds;
    char* ulo = lds + 16 * URS;
    float* logit = (float*)(lds + 32 * URS);
    int* sel_e = (int*)(lds + 32 * URS + 4096);
    int* lpos = sel_e + 512;
    int* hist = lpos + 512;
    int* basep = hist + 64;
    const bf16_t* wrt_hi = (const bf16_t*)(p->ws + OFF_WR) + (size_t)(l * 2 + 0) * 64 * 1024;
    const bf16_t* wrt_lo = (const bf16_t*)(p->ws + OFF_WR) + (size_t)(l * 2 + 1) * 64 * 1024;
    const bf16_t* zbuf = (const bf16_t*)(p->ws + M_ZB);
    float2* lnstat = (float2*)(p->ws + M_STAT);
    bf16_t* ubuf = (bf16_t*)(p->ws + (dry ? A_YMIX : OFF_UBUF));
    const float* mod = (const float*)(p->ws + OFF_MOD);
    const float* wr = p->in[I_WROUTER] + (size_t)l * 1024 * 64 + lane;
    const float ebias = p->in[I_EBIAS][l * 64 + lane];
    unsigned* cnt = (unsigned*)(p->ws + OFF_CNT) + l * 64 + (dry ? 256 : 0);
    int* list = (int*)(p->ws + (dry ? M_HBUF : M_LIST));
    float* wsel = (float*)(p->ws + (dry ? M_HBUF + 16777216 : M_WSEL));
    int* pmap = (int*)(p->ws + (dry ? M_HBUF + 33554432 : M_PMAP));
    for (int it = blk; it < 512; it += nb) {
        const int tok0 = it * 64;
        if (tid < 64) hist[tid] = 0;
        float4 GA[4], GB[4];
        {
            const int b = tok0 >> 12;
#pragma unroll
            for (int i = 0; i < 4; ++i) {
                const int col = i * 256 + lane * 4;
                const float4 g = *(const float4*)(p->in[I_LN1G] + l * 1024 + col), bb = *(const float4*)(p->in[I_LN1B] + l * 1024 + col);
                const float4 sh = *(const float4*)(mod + (size_t)(l * 8 + b) * 6144 + 3072 + col), sc = *(const float4*)(mod + (size_t)(l * 8 + b) * 6144 + 4096 + col);
                GA[i].x = g.x * (1.f + sc.x); GA[i].y = g.y * (1.f + sc.y); GA[i].z = g.z * (1.f + sc.z); GA[i].w = g.w * (1.f + sc.w);
                GB[i].x = bb.x * (1.f + sc.x) + sh.x; GB[i].y = bb.y * (1.f + sc.y) + sh.y; GB[i].z = bb.z * (1.f + sc.z) + sh.z; GB[i].w = bb.w * (1.f + sc.w) + sh.w;
            }
        }
        uint2 zr[4][4];
#pragma unroll
        for (int j = 0; j < 4; ++j)
#pragma unroll
            for (int i = 0; i < 4; ++i) zr[j][i] = *(const uint2*)(zbuf + (size_t)(tok0 + wid * 4 + j) * DM + i * 256 + lane * 4);
        const int fr = lane & 15, fq = lane >> 4;
        const bf16_t* bh = wrt_hi + (size_t)(wid * 16 + fr) * 1024 + fq * 8;
        const bf16_t* bl = wrt_lo + (size_t)(wid * 16 + fr) * 1024 + fq * 8;
#define D_LDW(H, L, k4) do { _Pragma("unroll") for (int kk = 0; kk < 4; ++kk) { H[kk] = *(const bf16x8*)(bh + ((k4) * 4 + kk) * 32); L[kk] = *(const bf16x8*)(bl + ((k4) * 4 + kk) * 32); } } while (0)
#define D_MM(H, L, k4) do { _Pragma("unroll") for (int kk = 0; kk < 4; ++kk) { const int ko = ((k4) * 4 + kk) * 64 + fq * 16; \
            const bf16x8 ah = *(const bf16x8*)(uh + fr * URS + ko), al = *(const bf16x8*)(ulo + fr * URS + ko); \
            lacc = __builtin_amdgcn_mfma_f32_16x16x32_bf16(ah, H[kk], lacc, 0, 0, 0); lacc = __builtin_amdgcn_mfma_f32_16x16x32_bf16(al, H[kk], lacc, 0, 0, 0); \
            lacc = __builtin_amdgcn_mfma_f32_16x16x32_bf16(ah, L[kk], lacc, 0, 0, 0); } } while (0)
#pragma unroll 1
        for (int sb = 0; sb < 4; ++sb) {
            bf16x8 h0[4], l0[4], h1[4], l1[4];
            D_LDW(h0, l0, 0);
            float mean4[4], rs4[4];
#pragma unroll
            for (int j = 0; j < 4; ++j) {
                const int tl = wid * 4 + j, row = tok0 + sb * 16 + tl;
                float4 z[4];
                float s = 0.f;
#pragma unroll
                for (int i = 0; i < 4; ++i) { const uint2 zv = zr[j][i];
                    z[i].x = __uint_as_float(zv.x << 16); z[i].y = __uint_as_float(zv.x & 0xFFFF0000u); z[i].z = __uint_as_float(zv.y << 16); z[i].w = __uint_as_float(zv.y & 0xFFFF0000u); s += z[i].x + z[i].y + z[i].z + z[i].w; }
                const float mean = wave_sum(s) * (1.f / 1024.f);
                float q = 0.f;
#pragma unroll
                for (int i = 0; i < 4; ++i) { z[i].x -= mean; z[i].y -= mean; z[i].z -= mean; z[i].w -= mean; q += z[i].x * z[i].x + z[i].y * z[i].y + z[i].z * z[i].z + z[i].w * z[i].w; }
                const float rs = rsqrtf(wave_sum(q) * (1.f / 1024.f) + LN_EPS);
                mean4[j] = mean; rs4[j] = rs;
#pragma unroll
                for (int i = 0; i < 4; ++i) {
                    const int col = i * 256 + lane * 4;
                    float4 u; u.x = z[i].x * rs * GA[i].x + GB[i].x; u.y = z[i].y * rs * GA[i].y + GB[i].y; u.z = z[i].z * rs * GA[i].z + GB[i].z; u.w = z[i].w * rs * GA[i].w + GB[i].w;
                    uint2 o; o.x = pack2(u.x, u.y); o.y = pack2(u.z, u.w);
                    { int w8 = __builtin_amdgcn_cvt_pk_fp8_f32(u.x, u.y, 0, false); w8 = __builtin_amdgcn_cvt_pk_fp8_f32(u.z, u.w, w8, true);
                      *(int*)((char*)ubuf + (size_t)row * DM + col) = w8; }
                    *(uint2*)(uh + tl * URS + col * 2) = o;
                    uint2 o2; o2.x = pack2(u.x - __uint_as_float(o.x << 16), u.y - __uint_as_float(o.x & 0xFFFF0000u)); o2.y = pack2(u.z - __uint_as_float(o.y << 16), u.w - __uint_as_float(o.y & 0xFFFF0000u));
                    *(uint2*)(ulo + tl * URS + col * 2) = o2;
                }
            }
            {
                float m = mean4[0], r = rs4[0];
                m = (lane == 1) ? mean4[1] : m; r = (lane == 1) ? rs4[1] : r; m = (lane == 2) ? mean4[2] : m; r = (lane == 2) ? rs4[2] : r; m = (lane == 3) ? mean4[3] : m; r = (lane == 3) ? rs4[3] : r;
                if (lane < 4) lnstat[tok0 + sb * 16 + wid * 4 + lane] = make_float2(m, r);
            }
            __syncthreads();
            {
                f32x4 lacc = (f32x4){0.f, 0.f, 0.f, 0.f};
#pragma unroll
                for (int k4 = 0; k4 < 8; k4 += 2) {
                    D_LDW(h1, l1, k4 + 1);
                    D_MM(h0, l0, k4);
                    if (k4 + 2 < 8) D_LDW(h0, l0, k4 + 2);
                    D_MM(h1, l1, k4 + 1);
                }
                if (sb < 3) {
#pragma unroll
                    for (int j = 0; j < 4; ++j)
#pragma unroll
                        for (int i = 0; i < 4; ++i) zr[j][i] = *(const uint2*)(zbuf + (size_t)(tok0 + (sb + 1) * 16 + wid * 4 + j) * DM + i * 256 + lane * 4);
                }
#pragma unroll
                for (int j = 0; j < 4; ++j) logit[(fq * 4 + j) * 64 + wid * 16 + fr] = lacc[j];
            }
            __syncthreads();
            float acc[4];
#pragma unroll
            for (int j = 0; j < 4; ++j) acc[j] = logit[(wid * 4 + j) * 64 + lane];
#pragma unroll
            for (int j = 0; j < 4; ++j) {
                const int tl = sb * 16 + wid * 4 + j;
                const float score = 1.f / (1.f + __expf(-acc[j]));
                const float biased = score + ebias;
                const float m1 = group8_max(biased);
                const unsigned long long eq = __ballot(biased == m1);
                const int g = lane >> 3;
                const unsigned gm = (unsigned)(eq >> (g * 8)) & 0xFFu;
                const int first = __ffs((int)gm) - 1;
                const float v2 = ((lane & 7) == first) ? -INFINITY : biased;
                const float m2 = group8_max(v2);
                const float gs = m1 + m2;
                int rg = 0;
#pragma unroll
                for (int g2 = 0; g2 < 8; ++g2) { const float o = __builtin_bit_cast(float, __builtin_amdgcn_readlane(__builtin_bit_cast(int, gs), g2 * 8)); rg += ((o > gs) || (o == gs && g2 < g)) ? 1 : 0; }
                const bool keep = rg < 4;
                float mk = keep ? biased : -INFINITY;
                bool sel = false;
#pragma unroll
                for (int r8 = 0; r8 < 8; ++r8) {
                    const float mx = wave_max(mk);
                    const unsigned long long em = __ballot(mk == mx);
                    const int fl = __ffsll((long long)em) - 1;
                    const bool me = (lane == fl);
                    sel = sel || me; mk = me ? -INFINITY : mk;
                }
                const float ssum = wave_sum(sel ? score : 0.f);
                const float wgt = score / ssum * 2.5f;
                const unsigned long long sm = __ballot(sel);
                const int kidx = __popcll(sm & ((1ull << lane) - 1ull));
                if (sel) { wsel[(size_t)(tok0 + tl) * 8 + kidx] = wgt; sel_e[tl * 8 + kidx] = lane; }
            }
            __syncthreads();
        }
#undef D_LDW
#undef D_MM
        for (int i = tid; i < 512; i += VTHREADS) lpos[i] = atomicAdd(&hist[sel_e[i]], 1);
        __syncthreads();
        if (tid < 64) basep[tid] = (int)atomicAdd(&cnt[tid], (unsigned)hist[tid]);
        __syncthreads();
        for (int i = tid; i < 512; i += VTHREADS) { const int e = sel_e[i], pos = basep[e] + lpos[i]; list[(size_t)e * NTOK + pos] = tok0 * 8 + i; pmap[tok0 * 8 + i] = (e << 16) | pos; }
        __syncthreads();
    }
}

DEVINL void phaseA(KP p, int l, char* lds) {
    const int tid = TID512(), c = blockIdx.x, G = gridDim.x;
    const char* ubuf = (const char*)(p->ws + OFF_UBUF);
    const char* Wt = (const char*)(p->ws + OFF_WIN) + (size_t)l * WIN_ROWS * 1024;
    bf16_t* P = (bf16_t*)(p->ws + A_P);
    auto sched = [&](int i, GUnit& u) -> bool {
        const long L = unit_linear(i, c, G); if (L >= 128 * 11) return false;
        const int Li = (int)L, sx = Li >> 9, w = (sx == 2) ? 3 : 4, rem = Li - (sx << 9), pm = rem / w, pn = sx * 4 + (rem - pm * w);
        u.A = ubuf + (size_t)pm * 256 * 1024; u.B = Wt + (size_t)pn * 256 * 1024; u.i0 = pm; u.i1 = pn; u.i2 = 0;
        return true;
    };
    auto epi = [&](f32x4 (&acc)[2][2][4][2], const GUnit& u, int wr, int wc, int fr, int fq) {
        asm volatile("" : "+v"(fr), "+v"(fq));
        const int row0 = u.i0 * 256 + wr * 64 + fr, col0 = u.i1 * 256 + wc * 32 + 8 * fq;
#pragma unroll
        for (int ai = 0; ai < 2; ++ai)
#pragma unroll
            for (int m = 0; m < 4; ++m) {
                bf16_t* rowp = P + (size_t)(row0 + ai * 128 + m * 16) * PIN + col0;
#pragma unroll
                for (int bj = 0; bj < 2; ++bj) {
                    if (col0 + bj * 128 < PIN) {
                        const f32x4 v0 = acc[ai][bj][m][0], v1 = acc[ai][bj][m][1];
                        *(uint4*)(rowp + bj * 128) = make_uint4(pack2(v0[0], v0[1]), pack2(v0[2], v0[3]), pack2(v1[0], v1[1]), pack2(v1[2], v1[3]));
                    }
                }
            }
    };
    gemm256<true, false, true>(lds, 512, 512, sched, epi);
}

DEVINL void phaseC(KP p, int l, char* lds) {
    const int tid = TID512(), c = blockIdx.x, G = gridDim.x;
    const char* ymix = (const char*)(p->ws + A_YMIX);
    const char* Wt = (const char*)(p->ws + OFF_WOUT) + (size_t)l * 1024 * 1024 * 2;
    const float* res32 = p->in[I_X];
    const bf16_t* res16 = (const bf16_t*)p->out;
    bf16_t* zbuf = (bf16_t*)(p->ws + M_ZB);
    const float* mod = (const float*)(p->ws + OFF_MOD);
    auto sched = [&](int i, GUnit& u) -> bool {
        const long L = unit_linear(i, c, G); if (L >= 128 * 4) return false;
        const int pm = (int)L >> 2, pn = (int)L & 3;
        u.A = ymix + (size_t)pm * 256 * 2048; u.B = Wt + (size_t)pn * 256 * 2048; u.i0 = pm; u.i1 = pn; u.i2 = 0;
        return true;
    };
    auto epi = [&](f32x4 (&acc)[2][2][4][2], const GUnit& u, int wr, int wc, int fr, int fq) {
        asm volatile("" : "+v"(fr), "+v"(fq));
        const int row0 = u.i0 * 256 + wr * 64 + fr, col0 = u.i1 * 256 + wc * 32 + 8 * fq;
        const int b = (u.i0 * 256) >> 12;
        float4 gA[2], gB[2];
#pragma unroll
        for (int bj = 0; bj < 2; ++bj) {
            const float4 ga = *(const float4*)(mod + (size_t)(l * 8 + b) * 6144 + 2048 + col0 + bj * 128), gb = *(const float4*)(mod + (size_t)(l * 8 + b) * 6144 + 2048 + col0 + bj * 128 + 4);
            gA[bj].x = 1.f + ga.x; gA[bj].y = 1.f + ga.y; gA[bj].z = 1.f + ga.z; gA[bj].w = 1.f + ga.w;
            gB[bj].x = 1.f + gb.x; gB[bj].y = 1.f + gb.y; gB[bj].z = 1.f + gb.z; gB[bj].w = 1.f + gb.w;
        }
#define C_OUT(ai, m, bj, r) do { const f32x4 a0 = acc[ai][bj][(m)][0], a1 = acc[ai][bj][(m)][1]; \
            const float z0 = ALPHA * r[0] + gA[bj].x * a0[0], z1 = ALPHA * r[1] + gA[bj].y * a0[1], z2 = ALPHA * r[2] + gA[bj].z * a0[2], z3 = ALPHA * r[3] + gA[bj].w * a0[3]; \
            const float z4 = ALPHA * r[4] + gB[bj].x * a1[0], z5 = ALPHA * r[5] + gB[bj].y * a1[1], z6 = ALPHA * r[6] + gB[bj].z * a1[2], z7 = ALPHA * r[7] + gB[bj].w * a1[3]; \
            *(uint4*)(zbuf + (size_t)(row0 + (ai) * 128 + (m) * 16) * DM + col0 + (bj) * 128) = make_uint4(pack2(z0, z1), pack2(z2, z3), pack2(z4, z5), pack2(z6, z7)); } while (0)
        if (l == 0) {
#pragma unroll
            for (int ai = 0; ai < 2; ++ai)
#pragma unroll
                for (int mp = 0; mp < 2; ++mp) {
                    float4 ra[2][2], rb[2][2];
#pragma unroll
                    for (int mi = 0; mi < 2; ++mi)
#pragma unroll
                        for (int bj = 0; bj < 2; ++bj) { const float* rp = res32 + (size_t)(row0 + ai * 128 + (mp * 2 + mi) * 16) * DM + col0 + bj * 128; ra[mi][bj] = *(const float4*)rp; rb[mi][bj] = *(const float4*)(rp + 4); }
#pragma unroll
                    for (int mi = 0; mi < 2; ++mi)
#pragma unroll
                        for (int bj = 0; bj < 2; ++bj) {
                            const float r[8] = {ra[mi][bj].x, ra[mi][bj].y, ra[mi][bj].z, ra[mi][bj].w, rb[mi][bj].x, rb[mi][bj].y, rb[mi][bj].z, rb[mi][bj].w};
                            C_OUT(ai, mp * 2 + mi, bj, r);
                        }
                }
        } else {
#pragma unroll
            for (int ai = 0; ai < 2; ++ai) {
                uint4 rv[4][2];
#pragma unroll
                for (int m = 0; m < 4; ++m)
#pragma unroll
                    for (int bj = 0; bj < 2; ++bj) rv[m][bj] = *(const uint4*)(res16 + (size_t)(row0 + ai * 128 + m * 16) * DM + col0 + bj * 128);
#pragma unroll
                for (int m = 0; m < 4; ++m)
#pragma unroll
                    for (int bj = 0; bj < 2; ++bj) {
                        const uint4 q = rv[m][bj];
                        const float r[8] = {__uint_as_float(q.x << 16), __uint_as_float(q.x & 0xFFFF0000u), __uint_as_float(q.y << 16), __uint_as_float(q.y & 0xFFFF0000u),
                                            __uint_as_float(q.z << 16), __uint_as_float(q.z & 0xFFFF0000u), __uint_as_float(q.w << 16), __uint_as_float(q.w & 0xFFFF0000u)};
                        C_OUT(ai, m, bj, r);
                    }
            }
        }
#undef C_OUT
    };
    gemm256<true, false, false>(lds, 1024, 1024, sched, epi);
}

constexpr int DIR_OFF = 131072;
DEVINL void moe_directory(KP p, int l, char* lds) {
    int* pref = (int*)(lds + DIR_OFF);
    int* cntl = (int*)(lds + DIR_OFF + 512);
    unsigned* cnt = (unsigned*)(p->ws + OFF_CNT) + l * 64;
    asm volatile("" : "+s"(cnt));
    if (TID512() == 0) {
        int s = 0;
        int* xpre = (int*)(lds + DIR_OFF + 1024);
        int x = 0;
        for (int e = 0; e < 64; ++e) { const int c = (int)__hip_atomic_load(&cnt[e], __ATOMIC_RELAXED, __HIP_MEMORY_SCOPE_AGENT); cntl[e] = c; pref[e] = s; s += (c + 255) >> 8; xpre[e] = x; x += c; }
        pref[64] = s; cntl[64] = NTOK; pref[65] = s + 128; xpre[64] = x;
    }
    __syncthreads();
    {
        int* m2e = (int*)(lds + DIR_OFF + 2048);
        const int tot = pref[65];
        for (int mg = TID512(); mg < tot; mg += NTHREADS) { int e = 0; while (pref[e + 1] <= mg) ++e; m2e[mg] = e; }
    }
    __syncthreads();
}

DEVINL void phaseE1(KP p, int l, char* lds) {
    const int tid = TID512(), c = blockIdx.x, G = gridDim.x;
    moe_directory(p, l, lds);
    const int* pref = (const int*)(lds + DIR_OFF); const int* cntl = (const int*)(lds + DIR_OFF + 512);
    const char* ubuf = (const char*)(p->ws + OFF_UBUF);
    const int* list = (const int*)(p->ws + M_LIST);
    bf16_t* hbuf = (bf16_t*)(p->ws + M_HBUF);
    const char* W13 = (const char*)(p->ws + OFF_W13) + (size_t)(l * 65) * 512 * 1024;
    const int total = __builtin_amdgcn_readfirstlane(pref[65]) * 2;
    auto sched = [&](int i, GUnit& u) -> bool {
        const long L = unit_linear(i, c, G); if (L >= total) return false;
        const int mg = (int)L >> 1, nt = (int)L & 1;
        const int e = __builtin_amdgcn_readfirstlane(((const int*)(lds + DIR_OFF + 2048))[mg]);
        const int mt = __builtin_amdgcn_readfirstlane(mg - pref[e]), Me = __builtin_amdgcn_readfirstlane(cntl[e]);
        u.A = ubuf; u.B = W13 + ((size_t)e * 512 + nt * 256) * 1024; u.i0 = mg; u.i1 = nt; u.i2 = e;
        int R[2], C[2]; stage_coords512(TID512(), R, C);
#pragma unroll
        for (int h = 0; h < 2; ++h)
#pragma unroll
            for (int i2 = 0; i2 < 2; ++i2) {
                const int idx = mt * 256 + h * 128 + R[i2];
                const int lv = list[(size_t)((e < 64) ? e : 0) * NTOK + ((idx < Me) ? idx : Me - 1)];
                const int tok = (e < 64) ? (lv >> 3) : idx;
                u.va[h][i2] = (unsigned)(tok * 1024 + C[i2] * 2);
            }
        return true;
    };
    auto epi = [&](f32x4 (&acc)[2][2][4][2], const GUnit& u, int wr, int wc, int fr, int fq) {
        asm volatile("" : "+v"(fr), "+v"(fq));
        const size_t row0 = (size_t)u.i0 * 256 + wr * 64 + fr;
#pragma unroll
        for (int ai = 0; ai < 2; ++ai)
#pragma unroll
            for (int m = 0; m < 4; ++m) {
                bf16_t* rowp = hbuf + (row0 + ai * 128 + m * 16) * 256;
#pragma unroll
                for (int bj = 0; bj < 2; ++bj) {
                    const int hcol = (u.i1 * 8 + bj * 4 + wc) * 16 + 4 * fq;
                    const f32x4 gt = acc[ai][bj][m][0], up = acc[ai][bj][m][1];
                    float hv[4];
#pragma unroll
                    for (int j = 0; j < 4; ++j) hv[j] = gt[j] * sigm(gt[j]) * up[j];
                    uint2 o; o.x = pack2(hv[0], hv[1]); o.y = pack2(hv[2], hv[3]);
                    *(uint2*)(rowp + hcol) = o;
                }
                asm volatile("" ::: "memory");
            }
    };
    gemm256<false, true, true>(lds, 512, 512, sched, epi);
}

DEVINL void phaseE2(KP p, int l, char* lds) {
    const int tid = TID512(), c = blockIdx.x, G = gridDim.x;
    const int* pref = (const int*)(lds + DIR_OFF); const int* cntl = (const int*)(lds + DIR_OFF + 512);
    const int* xpre = (const int*)(lds + DIR_OFF + 1024);
    const char* hbuf = (const char*)(p->ws + M_HBUF);
    unsigned char* ybuf = (unsigned char*)(p->ws + M_YBUF);
    const char* W2 = (const char*)(p->ws + OFF_W2) + (size_t)(l * 65) * 1024 * 256 * 2;
    const int total = __builtin_amdgcn_readfirstlane(pref[65]) * 4;
    auto sched = [&](int i, GUnit& u) -> bool {
        const long L = unit_linear(i, c, G); if (L >= total) return false;
        const int mg = (int)L >> 2, nt = (int)L & 3;
        const int e = __builtin_amdgcn_readfirstlane(((const int*)(lds + DIR_OFF + 2048))[mg]);
        u.A = hbuf + (size_t)mg * 256 * 512; u.B = W2 + ((size_t)e * 1024 + nt * 256) * 512; u.i0 = mg; u.i1 = nt; u.i2 = e;
        return true;
    };
    auto epi = [&](f32x4 (&acc)[2][2][4][2], const GUnit& u, int wr, int wc, int fr, int fq) {
        asm volatile("" : "+v"(fr), "+v"(fq));
        const int e = __builtin_amdgcn_readfirstlane(u.i2), mt = __builtin_amdgcn_readfirstlane(u.i0 - pref[e]), Me = __builtin_amdgcn_readfirstlane(cntl[e]);
        const int yrow0 = __builtin_amdgcn_readfirstlane(xpre[e]) + mt * 256;
        const int col0 = u.i1 * 256 + wc * 32 + 8 * fq, loc0 = wr * 64 + fr;
#pragma unroll
        for (int ai = 0; ai < 2; ++ai)
#pragma unroll
            for (int m = 0; m < 4; ++m) {
                const int loc = loc0 + ai * 128 + m * 16;
                if (mt * 256 + loc < Me) {
                    unsigned char* rowp = ybuf + (size_t)(yrow0 + loc) * 1024 + col0;
#pragma unroll
                    for (int bj = 0; bj < 2; ++bj) {
                        const f32x4 v0 = acc[ai][bj][m][0], v1 = acc[ai][bj][m][1];
                        int w0 = __builtin_amdgcn_cvt_pk_fp8_f32(v0[0], v0[1], 0, false); w0 = __builtin_amdgcn_cvt_pk_fp8_f32(v0[2], v0[3], w0, true);
                        int w1 = __builtin_amdgcn_cvt_pk_fp8_f32(v1[0], v1[1], 0, false); w1 = __builtin_amdgcn_cvt_pk_fp8_f32(v1[2], v1[3], w1, true);
                        *(uint2*)(rowp + bj * 128) = make_uint2((unsigned)w0, (unsigned)w1);
                    }
                }
            }
    };
    gemm256<true, false, false>(lds, 256, 256, sched, epi);
}

DEVINL void phaseF(KP p, int l, const int dry = 0) {
    const int tid = TIDX(), nb = NBV(), blk = BIDX(), wid = tid >> 6, lane = tid & 63;
    const bf16_t* zbuf = (const bf16_t*)(p->ws + M_ZB);
    float* xout = dry ? (float*)(p->ws + M_HBUF) : p->out;
    const unsigned char* ybuf = (const unsigned char*)(p->ws + M_YBUF);
    bf16_t* ubuf = (bf16_t*)(p->ws + OFF_UBUF);
    const float* mod = (const float*)(p->ws + OFF_MOD);
    const int* pmap = (const int*)(p->ws + M_PMAP); const float* wsel = (const float*)(p->ws + M_WSEL);
    const float2* lnstat = (const float2*)(p->ws + M_STAT);
    int xoff;
    {
        const unsigned* cnt = (const unsigned*)(p->ws + OFF_CNT) + l * 64;
        const int c = (int)__hip_atomic_load(&cnt[lane], __ATOMIC_RELAXED, __HIP_MEMORY_SCOPE_AGENT);
        xoff = 0;
#pragma unroll
        for (int j = 0; j < 64; ++j) { const int cj = __builtin_amdgcn_readlane(c, j); xoff += (j < lane) ? cj : 0; }
    }
    int pmn = 0; float wn = 0.f; float2 stn = make_float2(0.f, 0.f);
    {
        const int row = blk * 4 + wid;
        if (row < NTOK) { if (lane < 8) { pmn = pmap[row * 8 + lane]; wn = wsel[row * 8 + lane]; } stn = lnstat[row]; }
    }
    float4 g1v[4], b1v[4], g2v[4], bb2v[4];
#pragma unroll
    for (int i = 0; i < 4; ++i) {
        const int col = i * 256 + lane * 4;
        g1v[i] = *(const float4*)(p->in[I_LN1G] + l * 1024 + col); b1v[i] = *(const float4*)(p->in[I_LN1B] + l * 1024 + col);
        g2v[i] = *(const float4*)(p->in[I_LN2G] + l * 1024 + col); bb2v[i] = *(const float4*)(p->in[I_LN2B] + l * 1024 + col);
    }
    for (int row = blk * 4 + wid; row < NTOK; row += nb * 4) {
        const int b = row >> 12;
        int yr = pmn; const float yw = wn; const float2 st1 = stn;
        {
            const int nrow = row + nb * 4;
            if (nrow < NTOK) { if (lane < 8) { pmn = pmap[nrow * 8 + lane]; wn = wsel[nrow * 8 + lane]; } stn = lnstat[nrow]; }
        }
        { const int e = (yr >> 16) & 63; const int xo = __builtin_amdgcn_ds_bpermute(e << 2, xoff); yr = xo + (yr & 0xFFFF); }
        int yrow[8]; float yww[8];
#pragma unroll
        for (int k = 0; k < 8; ++k) { yrow[k] = __builtin_amdgcn_readlane(yr, k); yww[k] = __builtin_bit_cast(float, __builtin_amdgcn_readlane(__builtin_bit_cast(int, yw), k)); }
        uint2 zvv[4]; int ysh[4]; int yvk[4][8]; float4 gm[4], shv[4], scv[4];
#pragma unroll
        for (int i = 0; i < 4; ++i) {
            const int col = i * 256 + lane * 4;
            gm[i] = *(const float4*)(mod + (size_t)(l * 8 + b) * 6144 + 5120 + col);
            shv[i] = *(const float4*)(mod + (size_t)((l + 1) * 8 + b) * 6144 + col); scv[i] = *(const float4*)(mod + (size_t)((l + 1) * 8 + b) * 6144 + 1024 + col);
            zvv[i] = *(const uint2*)(zbuf + (size_t)row * DM + col);
            ysh[i] = *(const int*)(ybuf + ((size_t)(262144 + row)) * 1024 + col);
#pragma unroll
            for (int k = 0; k < 8; ++k) yvk[i][k] = *(const int*)(ybuf + (size_t)yrow[k] * 1024 + col);
        }
        float4 z[4]; float s = 0.f;
#pragma unroll
        for (int i = 0; i < 4; ++i) {
            const int col = i * 256 + lane * 4;
            float4 x1;
            { const uint2 zv = zvv[i];
              float4 z1; z1.x = __uint_as_float(zv.x << 16); z1.y = __uint_as_float(zv.x & 0xFFFF0000u); z1.z = __uint_as_float(zv.y << 16); z1.w = __uint_as_float(zv.y & 0xFFFF0000u);
              const float4 g1 = g1v[i], b1 = b1v[i];
              x1.x = (z1.x - st1.x) * st1.y * g1.x + b1.x; x1.y = (z1.y - st1.x) * st1.y * g1.y + b1.y; x1.z = (z1.z - st1.x) * st1.y * g1.z + b1.z; x1.w = (z1.w - st1.x) * st1.y * g1.w + b1.w; }
            float f0, f1, f2, f3;
            { const int yv = ysh[i];
              const f2_t lo = __builtin_amdgcn_cvt_pk_f32_fp8(yv, false), hi = __builtin_amdgcn_cvt_pk_f32_fp8(yv, true);
              f0 = lo[0]; f1 = lo[1]; f2 = hi[0]; f3 = hi[1]; }
#pragma unroll
            for (int k = 0; k < 8; ++k) {
                const f2_t lo = __builtin_amdgcn_cvt_pk_f32_fp8(yvk[i][k], false), hi = __builtin_amdgcn_cvt_pk_f32_fp8(yvk[i][k], true);
                const float w = yww[k];
                f0 = fmaf(w, lo[0], f0); f1 = fmaf(w, lo[1], f1); f2 = fmaf(w, hi[0], f2); f3 = fmaf(w, hi[1], f3);
            }
            const float4 g2 = gm[i];
            z[i].x = ALPHA * x1.x + (1.f + g2.x) * f0; z[i].y = ALPHA * x1.y + (1.f + g2.y) * f1; z[i].z = ALPHA * x1.z + (1.f + g2.z) * f2; z[i].w = ALPHA * x1.w + (1.f + g2.w) * f3;
            s += z[i].x + z[i].y + z[i].z + z[i].w;
        }
        const float mean = wave_sum(s) * (1.f / 1024.f);
        float q = 0.f;
#pragma unroll
        for (int i = 0; i < 4; ++i) { z[i].x -= mean; z[i].y -= mean; z[i].z -= mean; z[i].w -= mean; q += z[i].x * z[i].x + z[i].y * z[i].y + z[i].z * z[i].z + z[i].w * z[i].w; }
        const float rs = rsqrtf(wave_sum(q) * (1.f / 1024.f) + LN_EPS);
        if (l + 1 < DEPTH) {
#pragma unroll
            for (int i = 0; i < 4; ++i) {
                const int col = i * 256 + lane * 4;
                const float4 g = g2v[i], bb = bb2v[i], sh = shv[i], sc = scv[i];
                float4 x2; x2.x = z[i].x * rs * g.x + bb.x; x2.y = z[i].y * rs * g.y + bb.y; x2.z = z[i].z * rs * g.z + bb.z; x2.w = z[i].w * rs * g.w + bb.w;
                uint2 ox; ox.x = pack2(x2.x, x2.y); ox.y = pack2(x2.z, x2.w); *(uint2*)((bf16_t*)xout + (size_t)row * DM + col) = ox;
                int w8 = __builtin_amdgcn_cvt_pk_fp8_f32(x2.x * (1.f + sc.x) + sh.x, x2.y * (1.f + sc.y) + sh.y, 0, false);
                w8 = __builtin_amdgcn_cvt_pk_fp8_f32(x2.z * (1.f + sc.z) + sh.z, x2.w * (1.f + sc.w) + sh.w, w8, true);
                *(int*)((char*)ubuf + (size_t)row * DM + col) = w8;
            }
        } else {
#pragma unroll
            for (int i = 0; i < 4; ++i) {
                const int col = i * 256 + lane * 4;
                const float4 g = g2v[i], bb = bb2v[i];
                float4 x2; x2.x = z[i].x * rs * g.x + bb.x; x2.y = z[i].y * rs * g.y + bb.y; x2.z = z[i].z * rs * g.z + bb.z; x2.w = z[i].w * rs * g.w + bb.w;
                *(float4*)(xout + (size_t)row * DM + col) = x2;
            }
        }
    }
}

#define XB_TMO      128
#define XB_XCNT(j)  (256  + 64 * (j))
#define XB_XSUB(j)  (1280 + 64 * (j))
#define XB_XGEN(j)  (2304 + 64 * (j))
#define XB_TOP      3328
#define XB_TOPGEN   3392
#define XCD_BAR_WORDS 3456
#define XB_SPIN_CAP (1u << 20)
DEVINL unsigned xb_ld(unsigned* p)              { return __hip_atomic_load(p, __ATOMIC_RELAXED, __HIP_MEMORY_SCOPE_AGENT); }
DEVINL unsigned xb_add(unsigned* p, unsigned v) { return __hip_atomic_fetch_add(p, v, __ATOMIC_RELAXED, __HIP_MEMORY_SCOPE_AGENT); }
DEVINL unsigned xb_xcc_id() { return (unsigned)__builtin_amdgcn_s_getreg((3 << 11) | 20) & 0xFu; }
#define XB_SPIN(cond, bar) do { unsigned _sp = 0; while (cond) { __builtin_amdgcn_s_sleep(1); \
    if ((++_sp & 255u) == 0u) { if (xb_ld(&(bar)[XB_TMO])) break; if (_sp > XB_SPIN_CAP) { atomicAdd(&(bar)[XB_TMO], 1u); break; } } } } while (0)
struct XcdBarrier { unsigned* bar; unsigned x; volatile LAS unsigned* st; };
DEVINL XcdBarrier xcd_barrier_post(unsigned* bar, volatile LAS unsigned* st) {
    XcdBarrier b; b.bar = bar; b.x = xb_xcc_id(); b.st = st;
    if (TID512() == 0) (void)xb_add(&bar[XB_XCNT(b.x)], 1u);
    return b;
}
DEVINL void xcd_barrier_complete(unsigned* bar, unsigned x, unsigned& nloc, unsigned& nx) {
    const unsigned G = gridDim.x * gridDim.y * gridDim.z;
    unsigned sum, cnt, mine, sp = 0u;
    for (;;) {
        sum = 0u; cnt = 0u; mine = 0u;
#pragma unroll 1
        for (unsigned j = 0; j < 16; ++j) { const unsigned c = xb_ld(&bar[XB_XCNT(j)]); sum += c; cnt += (c > 0u) ? 1u : 0u; mine = (j == x) ? c : mine; }
        if (sum == G) break;
        __builtin_amdgcn_s_sleep(1);
        if ((++sp & 255u) == 0u) { if (xb_ld(&bar[XB_TMO])) break; if (sp > XB_SPIN_CAP) { atomicAdd(&bar[XB_TMO], 1u); break; } }
    }
    nloc = mine > 0u ? mine : 1u; nx = cnt > 0u ? cnt : 1u;
}
DEVINL void xcd_barrier(const XcdBarrier& b) {
    asm volatile("s_waitcnt vmcnt(0)" ::: "memory");
    __syncthreads();
    if (TID512() == 0) {
        unsigned* bar = b.bar;
        __builtin_amdgcn_s_waitcnt(0);
        unsigned nloc = b.st[0], nx = b.st[1];
        if (nloc == 0u) { xcd_barrier_complete(bar, b.x, nloc, nx); b.st[0] = nloc; b.st[1] = nx; }
        const unsigned old = xb_add(&bar[XB_XSUB(b.x)], 1u);
        const unsigned gen = old / nloc;
        if (old + 1u == (gen + 1u) * nloc) {
            __builtin_amdgcn_fence(__ATOMIC_RELEASE, "agent");
            asm volatile("s_waitcnt vmcnt(0)" ::: "memory");
            const unsigned og = xb_add(&bar[XB_TOP], 1u);
            const unsigned tg = og / nx;
            if (og + 1u == (tg + 1u) * nx) xb_add(&bar[XB_TOPGEN], 1u);
            else XB_SPIN(xb_ld(&bar[XB_TOPGEN]) == tg, bar);
            __builtin_amdgcn_fence(__ATOMIC_ACQUIRE, "agent");
            xb_add(&bar[XB_XGEN(b.x)], 1u);
            asm volatile("s_waitcnt vmcnt(0)" ::: "memory");
        } else {
            XB_SPIN(xb_ld(&bar[XB_XGEN(b.x)]) == gen, bar);
            __builtin_amdgcn_fence(__ATOMIC_ACQUIRE, "agent");
            asm volatile("s_waitcnt vmcnt(0)" ::: "memory");
        }
    }
    __syncthreads();
}

constexpr int PPL = 11;
constexpr int NPHASE = 2 + PPL * DEPTH;
#ifndef PROBE_SUB
#define PROBE_SUB 3
#endif
#ifndef PROBE_REP
#define PROBE_REP (-1)
#endif
__global__ void __launch_bounds__(NTHREADS, 2) mega(Params p_arg, int ph_lo, int ph_hi) {
    extern __shared__ __attribute__((aligned(16))) char lds[];
    cg::grid_group grid = cg::this_grid();
    volatile LAS unsigned* st = (volatile LAS unsigned*)(lds + LDS_BYTES - 16);
    if (threadIdx.x == 0) { st[0] = 0u; st[1] = 0u; }
    if ((threadIdx.x & 63) == 0) ((volatile LAS int*)(lds + WTAB_OFF))[(unsigned)__builtin_amdgcn_s_getreg((5 << 11) | 4) & 63u] = (int)(threadIdx.x >> 6);
    __syncthreads();
    XcdBarrier xb = xcd_barrier_post((unsigned*)(p_arg.ws + OFF_BAR), st);
    for (int ph = ph_lo; ph < ph_hi; ++ph) {
        KP p = (KP)__builtin_amdgcn_kernarg_segment_ptr();
        asm volatile("" : "+s"(p));
        const int l = (ph >= 2) ? (ph - 2) / PPL : 0;
        const int q = (ph >= 2) ? (ph - 2) % PPL : -1;
        const bool nobar = (q == 2 || q == 3);
        const int nrep = (PROBE_REP >= 0 && ph == PROBE_REP) ? 2 : 1;
        for (int rep = 0; rep < nrep; ++rep) {
            const int dry = (PROBE_REP >= 0 && ph == PROBE_REP && rep == 0) ? 1 : 0;
            char* ldsh = lds + (wave_index() >> 2) * LDS_HALF;
            if (ph == 0) phase0(p, ldsh);
            else if (ph == 1) phaseF0(p);
            else {
                switch (q) {
                    case 0: phaseA(p, l, lds); break;
                    case 1: phaseB1(p, l, ldsh, 1, (PROBE_REP >= 0 && ph == PROBE_REP && rep == 1) ? PROBE_SUB : 3); break;
                    case 2: phaseMix(p, l, ldsh, 0); break;
                    case 3: phaseMix(p, l, ldsh, 1); break;
                    case 4: phaseMix(p, l, ldsh, 2); break;
                    case 5: phaseB3(p, l); break;
                    case 6: phaseC(p, l, lds); break;
                    case 7: phaseD(p, l, ldsh, dry); break;
                    case 8: phaseE1(p, l, lds); break;
                    case 9: phaseE2(p, l, lds); break;
                    default: phaseF(p, l, dry); break;
                }
            }
            const bool lastrep = (rep + 1 == nrep);
            if (!lastrep || (ph + 1 < ph_hi && !nobar)) { if (lastrep && ph == ph_lo) grid.sync(); else xcd_barrier(xb); }
        }
    }
}

extern "C" void kernel_launch(void* const* d_in, const int* in_sizes, int n_in, void* d_out, int out_size, void* d_ws, size_t ws_size, hipStream_t stream) {
    static int grid_blocks = 0;
    if (grid_blocks == 0) {
        if (n_in != 39 || out_size != NTOK * DM || ws_size < WS_NEED) { fprintf(stderr, "kernel_launch: unexpected shapes (n_in %d out %d ws %zu need %zu)\n", n_in, out_size, ws_size, (size_t)WS_NEED); grid_blocks = -1; return; }
        int dev = 0, cus = 0, per_cu = 0;
        hipGetDevice(&dev);
        hipDeviceGetAttribute(&cus, hipDeviceAttributeMultiprocessorCount, dev);
        hipFuncSetAttribute((const void*)mega, hipFuncAttributeMaxDynamicSharedMemorySize, LDS_BYTES);
        hipOccupancyMaxActiveBlocksPerMultiprocessor(&per_cu, (const void*)mega, NTHREADS, LDS_BYTES);
        if (per_cu < 1) { fprintf(stderr, "kernel_launch: occupancy query returned %d\n", per_cu); grid_blocks = -1; return; }
        if (cus < 256) { fprintf(stderr, "kernel_launch: this build needs 256 CUs (found %d)\n", cus); grid_blocks = -1; return; }
        grid_blocks = 256;
    }
    if (grid_blocks < 0) return;
    if (hipMemsetAsync(d_ws, 0, 32768, stream) != hipSuccess) { fprintf(stderr, "kernel_launch: memset failed\n"); return; }
    Params p{};
    for (int i = 0; i < 39; ++i) p.in[i] = (const float*)d_in[i];
    p.out = (float*)d_out; p.ws = (unsigned char*)d_ws;
#ifdef PROBE_PREFIX
    { int lo = 0, hi = PROBE_PREFIX; void* a2[] = {&p, &lo, &hi};
      hipLaunchCooperativeKernel((const void*)mega, dim3(grid_blocks), dim3(NTHREADS), a2, LDS_BYTES, stream);
      hipMemsetAsync(d_ws, 0, 32768, stream); }
#endif
    int ph_lo = 0, ph_hi = NPHASE;
    void* args[] = {&p, &ph_lo, &ph_hi};
    hipError_t e = hipLaunchCooperativeKernel((const void*)mega, dim3(grid_blocks), dim3(NTHREADS), args, LDS_BYTES, stream);
    if (e != hipSuccess) fprintf(stderr, "cooperative launch failed: %s (grid %d)\n", hipGetErrorString(e), grid_blocks);
}
```
